# Optimizing an MI355X kernel written in HIP

```python
import math
import jax, jax.numpy as jnp
from jax import lax
import numpy as np

D_MODEL = 1024
BATCH = 8
SEQ = 2048
DEPTH = 4

DA_HEADS = 4
DA_QK_DIM = 64
DA_V_DIM = 2 * DA_QK_DIM
DA_WIDTH = DA_HEADS * DA_V_DIM
GDN_HEADS = 4
GDN_DIM = 128
GDN_WIDTH = GDN_HEADS * GDN_DIM
MIX_WIDTH = DA_WIDTH + GDN_WIDTH
CONV_K = 4
GDN_CHUNK = 64
Q_BLOCK = 128
DA_Q_COLS = DA_HEADS * 2 * DA_QK_DIM
DA_K_COLS = DA_HEADS * 2 * DA_QK_DIM
DA_V_COLS = DA_WIDTH
GDN_QKV_COLS = 3 * GDN_WIDTH
GDN_Z_COLS = GDN_WIDTH
IN_COLS = DA_Q_COLS + DA_K_COLS + DA_V_COLS + GDN_QKV_COLS + GDN_Z_COLS + 2 * GDN_HEADS
PEER_HEADS = 8
PEER_NKEYS = 128
PEER_N = PEER_NKEYS * PEER_NKEYS
PEER_QDIM = 256
PEER_HALF = PEER_QDIM // 2
PEER_TOPK = 16
PEER_TOKEN_BLOCK = 128
PLE_DIM = 256
EPS = 1e-6

kernel_name = "hybrid_diffattn_gdn_peer_ple"


def rms_norm(x, g):
    xf = x.astype(jnp.float32)
    y = xf * lax.rsqrt(jnp.mean(xf * xf, axis=-1, keepdims=True) + EPS)
    return (y * g.astype(jnp.float32)).astype(x.dtype)


def l2_normalize(x):
    return x * lax.rsqrt(jnp.sum(x * x, axis=-1, keepdims=True) + EPS)


def alibi_slopes(n):
    return jnp.exp2(-8.0 * (jnp.arange(n, dtype=jnp.float32) + 1.0) / n)


def diff_attention(q, k, v, lam, subln_g, lam_init):
    B, T = q.shape[0], q.shape[1]
    nb = T // Q_BLOCK
    scale = DA_QK_DIM ** -0.5
    qh = jnp.transpose(q, (0, 2, 3, 1, 4))
    kh = jnp.transpose(k, (0, 2, 3, 1, 4))
    vh = jnp.transpose(v, (0, 2, 1, 3))
    qb = jnp.moveaxis(qh.reshape(B, DA_HEADS, 2, nb, Q_BLOCK, DA_QK_DIM), 3, 0)
    slopes = alibi_slopes(DA_HEADS)[:, None, None, None]
    kpos = jnp.arange(T)

    def block(args):
        qblk, start = args
        qpos = start + jnp.arange(Q_BLOCK)
        dist = (qpos[:, None] - kpos[None, :]).astype(jnp.float32)
        s = jnp.einsum('bhcqd,bhckd->bhcqk', qblk, kh, preferred_element_type=jnp.float32) * scale
        s = jnp.where(dist >= 0, s - slopes * dist, -jnp.inf)
        a = jax.nn.softmax(s, axis=-1)
        w = a[:, :, 0] - lam * a[:, :, 1]
        return jnp.einsum('bhqk,bhkd->bhqd', w.astype(vh.dtype), vh)

    starts = jnp.arange(nb) * Q_BLOCK
    o = lax.map(block, (qb, starts))
    o = jnp.moveaxis(o, 0, 2).reshape(B, DA_HEADS, T, DA_V_DIM)
    o = jnp.transpose(o, (0, 2, 1, 3))
    o = rms_norm(o, subln_g) * (1.0 - lam_init)
    return o.reshape(B, T, DA_WIDTH)


def short_conv(x, w):
    T = x.shape[1]
    xp = jnp.pad(x, ((0, 0), (CONV_K - 1, 0), (0, 0)))
    y = xp[:, 0:T] * w[0]
    for j in range(1, CONV_K):
        y = y + xp[:, j:j + T] * w[j]
    return jax.nn.silu(y)


def chunk_gated_delta_rule(q, k, v, g, beta):
    B, T, H, dk = q.shape
    dv = v.shape[-1]
    C = GDN_CHUNK
    N = T // C

    def chunks(t):
        t = jnp.moveaxis(t, 2, 1)
        return t.reshape((B, H, N, C) + t.shape[3:])

    q, k, v, g, beta = chunks(q), chunks(k), chunks(v), chunks(g), chunks(beta)
    gc = jnp.cumsum(g, axis=-1)
    incl = jnp.tril(jnp.ones((C, C), dtype=bool))
    strict = jnp.tril(jnp.ones((C, C), dtype=bool), -1)
    decay = jnp.exp(jnp.where(incl, gc[..., :, None] - gc[..., None, :], -jnp.inf))
    kb = k * beta[..., None]
    L = jnp.where(strict, jnp.einsum('bhncd,bhnsd->bhncs', kb, k) * decay, 0.0)
    A = L + jnp.eye(C, dtype=jnp.float32)
    rhs = jnp.concatenate([v * beta[..., None], kb * jnp.exp(gc)[..., None]], axis=-1)
    sol = lax.linalg.triangular_solve(A, rhs, left_side=True, lower=True, unit_diagonal=True)
    u, w = sol[..., :dv], sol[..., dv:]
    intra = jnp.where(incl, jnp.einsum('bhncd,bhnsd->bhncs', q, k) * decay, 0.0)
    q_dec = q * jnp.exp(gc)[..., None]
    g_last = gc[..., -1]
    k_dec = k * jnp.exp(g_last[..., None] - gc)[..., None]

    def step(S, xs):
        qd, kd, ui, wi, ai, gl = xs
        v_new = ui - jnp.einsum('bhck,bhkv->bhcv', wi, S)
        o = jnp.einsum('bhck,bhkv->bhcv', qd, S) + jnp.einsum('bhcs,bhsv->bhcv', ai, v_new)
        S = S * jnp.exp(gl)[..., None, None] + jnp.einsum('bhck,bhcv->bhkv', kd, v_new)
        return S, o

    xs = (jnp.moveaxis(q_dec, 2, 0), jnp.moveaxis(k_dec, 2, 0), jnp.moveaxis(u, 2, 0),
          jnp.moveaxis(w, 2, 0), jnp.moveaxis(intra, 2, 0), jnp.moveaxis(g_last, 2, 0))
    S0 = jnp.zeros((B, H, dk, dv), jnp.float32)
    _, o = lax.scan(step, S0, xs)
    o = jnp.moveaxis(o, 0, 2).reshape(B, H, T, dv)
    return jnp.moveaxis(o, 1, 2)


def gated_deltanet(qkv, z, b, a, conv_w, a_log, dt_bias, norm_g):
    B, T, _ = qkv.shape
    dtype = qkv.dtype
    qkv = short_conv(qkv, conv_w).astype(jnp.float32)
    q = qkv[..., :GDN_WIDTH].reshape(B, T, GDN_HEADS, GDN_DIM)
    k = qkv[..., GDN_WIDTH:2 * GDN_WIDTH].reshape(B, T, GDN_HEADS, GDN_DIM)
    v = qkv[..., 2 * GDN_WIDTH:].reshape(B, T, GDN_HEADS, GDN_DIM)
    q = l2_normalize(q) * (GDN_DIM ** -0.5)
    k = l2_normalize(k)
    beta = jax.nn.sigmoid(b.astype(jnp.float32))
    g = -jnp.exp(a_log.astype(jnp.float32)) * jax.nn.softplus(a.astype(jnp.float32) + dt_bias.astype(jnp.float32))
    o = chunk_gated_delta_rule(q, k, v, g, beta)
    o = rms_norm(o, norm_g) * jax.nn.silu(z.reshape(B, T, GDN_HEADS, GDN_DIM).astype(jnp.float32))
    return o.reshape(B, T, GDN_WIDTH).astype(dtype)


def peer(xn, wq, subkeys, u_tab, v_tab):
    B, T, D = xn.shape
    K = PEER_TOPK
    q = (xn @ wq).reshape(B, T, PEER_HEADS, 2, PEER_HALF)
    s = jnp.einsum('bthcd,hcnd->bthcn', q, subkeys, preferred_element_type=jnp.float32)
    v1, i1 = lax.top_k(s[..., 0, :], K)
    v2, i2 = lax.top_k(s[..., 1, :], K)
    cand = (v1[..., :, None] + v2[..., None, :]).reshape(B, T, PEER_HEADS, K * K)
    cidx = (i1[..., :, None] * PEER_NKEYS + i2[..., None, :]).reshape(B, T, PEER_HEADS, K * K)
    top_v, top_p = lax.top_k(cand, K)
    idx = jnp.take_along_axis(cidx, top_p, axis=-1)
    gate = jax.nn.softmax(top_v, axis=-1)
    M = B * T
    nb = M // PEER_TOKEN_BLOCK
    E = PEER_HEADS * K
    xs = (xn.reshape(nb, PEER_TOKEN_BLOCK, D), idx.reshape(nb, PEER_TOKEN_BLOCK, E),
          gate.reshape(nb, PEER_TOKEN_BLOCK, E).astype(xn.dtype))

    def block(args):
        xb, ib, gb = args
        h = jnp.einsum('md,med->me', xb, u_tab[ib])
        return jnp.einsum('me,med->md', gb * jax.nn.gelu(h, approximate=False), v_tab[ib])

    y = lax.map(block, xs)
    return y.reshape(B, T, D)


def setup_inputs(seed: int = 0) -> dict:
    key = jax.random.key(seed)
    ks = jax.random.split(key, 24)
    f32 = jnp.float32
    nrm = lambda k, shape, s: jax.random.normal(k, shape, f32) * s
    gain = lambda k, shape: 1.0 + 0.02 * jax.random.normal(k, shape, f32)
    A = jax.random.uniform(ks[5], (DEPTH, GDN_HEADS), f32, 1.0, 16.0)
    dt = jnp.exp(jax.random.uniform(ks[6], (DEPTH, GDN_HEADS), f32, math.log(1e-3), math.log(1e-1)))
    return {
        "x": nrm(ks[0], (BATCH, SEQ, D_MODEL), 1.0),
        "p": nrm(ks[1], (DEPTH, BATCH, SEQ, PLE_DIM), 1.0),
        "ln_mix_g": gain(ks[2], (DEPTH, D_MODEL)),
        "w_in": nrm(ks[3], (DEPTH, D_MODEL, IN_COLS), D_MODEL ** -0.5),
        "conv_w": nrm(ks[4], (DEPTH, CONV_K, GDN_QKV_COLS), CONV_K ** -0.5),
        "gdn_a_log": jnp.log(A),
        "gdn_dt_bias": dt + jnp.log(-jnp.expm1(-dt)),
        "gdn_norm_g": gain(ks[7], (DEPTH, GDN_DIM)),
        "diff_lambda": nrm(ks[8], (DEPTH, 4, DA_QK_DIM), 0.1),
        "diff_subln_g": gain(ks[9], (DEPTH, DA_V_DIM)),
        "w_out": nrm(ks[10], (DEPTH, MIX_WIDTH, D_MODEL), MIX_WIDTH ** -0.5),
        "ln_ffn_g": gain(ks[11], (DEPTH, D_MODEL)),
        "peer_wq": nrm(ks[12], (DEPTH, D_MODEL, PEER_HEADS * PEER_QDIM), D_MODEL ** -0.5),
        "peer_subkeys": nrm(ks[13], (DEPTH, PEER_HEADS, 2, PEER_NKEYS, PEER_HALF), PEER_HALF ** -0.5),
        "peer_u": nrm(ks[14], (DEPTH, PEER_N, D_MODEL), D_MODEL ** -0.5),
        "peer_v": nrm(ks[15], (DEPTH, PEER_N, D_MODEL), 0.25),
        "ple_wp": nrm(ks[16], (DEPTH, PLE_DIM, D_MODEL), PLE_DIM ** -0.5),
        "ple_wg": nrm(ks[17], (DEPTH, D_MODEL, D_MODEL), D_MODEL ** -0.5),
        "ple_norm_g": gain(ks[18], (DEPTH, D_MODEL)),
        "final_norm_g": gain(ks[19], (D_MODEL,)),
    }


def reference(x, p, ln_mix_g, w_in, conv_w, gdn_a_log, gdn_dt_bias, gdn_norm_g, diff_lambda,
              diff_subln_g, w_out, ln_ffn_g, peer_wq, peer_subkeys, peer_u, peer_v,
              ple_wp, ple_wg, ple_norm_g, final_norm_g):
    B, T, _ = x.shape
    h = x
    for i in range(DEPTH):
        xn = rms_norm(h, ln_mix_g[i])
        proj = xn @ w_in[i]
        o0 = 0
        dq = proj[..., o0:o0 + DA_Q_COLS]; o0 += DA_Q_COLS
        dk = proj[..., o0:o0 + DA_K_COLS]; o0 += DA_K_COLS
        dv = proj[..., o0:o0 + DA_V_COLS]; o0 += DA_V_COLS
        gqkv = proj[..., o0:o0 + GDN_QKV_COLS]; o0 += GDN_QKV_COLS
        gz = proj[..., o0:o0 + GDN_Z_COLS]; o0 += GDN_Z_COLS
        gb = proj[..., o0:o0 + GDN_HEADS]; o0 += GDN_HEADS
        ga = proj[..., o0:o0 + GDN_HEADS]

        lam_init = 0.8 - 0.6 * math.exp(-0.3 * i)
        lp = diff_lambda[i].astype(jnp.float32)
        lam = jnp.exp(jnp.sum(lp[0] * lp[1])) - jnp.exp(jnp.sum(lp[2] * lp[3])) + lam_init
        o_da = diff_attention(dq.reshape(B, T, DA_HEADS, 2, DA_QK_DIM),
                              dk.reshape(B, T, DA_HEADS, 2, DA_QK_DIM),
                              dv.reshape(B, T, DA_HEADS, DA_V_DIM),
                              lam, diff_subln_g[i], lam_init)
        o_gdn = gated_deltanet(gqkv, gz, gb, ga, conv_w[i], gdn_a_log[i], gdn_dt_bias[i], gdn_norm_g[i])
        h = h + jnp.concatenate([o_da, o_gdn], axis=-1) @ w_out[i]

        h = h + peer(rms_norm(h, ln_ffn_g[i]), peer_wq[i], peer_subkeys[i], peer_u[i], peer_v[i])

        e = rms_norm(p[i] @ ple_wp[i], ple_norm_g[i])
        h = h + jax.nn.sigmoid(h @ ple_wg[i]) * e
    return rms_norm(h, final_norm_g)
```

```cpp
#include <hip/hip_runtime.h>
#include <hip/hip_cooperative_groups.h>
#include <cstdio>
#include <cstdint>
namespace cg = cooperative_groups;

typedef unsigned short bf16;
typedef float f32x4 __attribute__((ext_vector_type(4)));
typedef short bf16x8 __attribute__((ext_vector_type(8)));
typedef unsigned u32x4 __attribute__((ext_vector_type(4)));
typedef unsigned u32x2 __attribute__((ext_vector_type(2)));

constexpr int D = 1024, BATCH = 8, SEQ = 2048, DEPTH = 4, M = BATCH * SEQ;
constexpr int IN_COLS = 3592, IN_PAD = 3840, PROJ_W = 3584;
constexpr int NEXP = 16384;
constexpr float EPS = 1e-6f;
constexpr float QSCALE = 0.125f * 1.4426950408889634f;
constexpr int NWAVES = 8, NTHREADS = 512;
constexpr int LDS_BYTES = 147456;

constexpr size_t MiB = 1u << 20;
constexpr size_t WS_CTL = 0, CTL_ZERO_BYTES = 1 * MiB;
constexpr size_t WS_H = 1 * MiB;
constexpr size_t WS_HB0 = 65 * MiB;
constexpr size_t WS_HB1 = 97 * MiB;
constexpr size_t WS_HB2 = 129 * MiB;
constexpr size_t WS_PROJ = 161 * MiB;
constexpr size_t WS_BA = 273 * MiB;
constexpr size_t WS_OBUF = 274 * MiB;
constexpr size_t WS_Q2 = 306 * MiB;
constexpr size_t WS_EPRE = 370 * MiB;
constexpr size_t WS_IDX = 402 * MiB;
constexpr size_t WS_GATE = 410 * MiB;
constexpr size_t WS_STAT = 418 * MiB;
constexpr size_t WS_ORAW = 422 * MiB;
constexpr size_t WS_WIN = 550 * MiB;
constexpr size_t WS_WOUT = 582 * MiB;
constexpr size_t WS_WQ = 590 * MiB;
constexpr size_t WS_WG = 606 * MiB;
constexpr size_t WS_WP = 614 * MiB;
constexpr size_t WS_SK = 616 * MiB;
constexpr size_t WS_PB = 618 * MiB;
constexpr size_t WS_U = 650 * MiB;
constexpr size_t WS_V = 778 * MiB;
constexpr size_t WS_END = 906 * MiB;

struct Params {
    const float *x, *p, *ln_mix_g, *w_in, *conv_w, *a_log, *dt_bias, *gdn_norm_g, *diff_lambda, *subln_g, *w_out, *ln_ffn_g,
        *peer_wq, *subkeys, *peer_u, *peer_v, *ple_wp, *ple_wg, *ple_norm_g, *final_g;
    float* out;
    unsigned char* ws;
    int step_lo, step_hi;
};

__device__ __forceinline__ float bf2f(bf16 v) { return __uint_as_float((unsigned)v << 16); }
__device__ __forceinline__ unsigned f2bf(float f) { unsigned u = __float_as_uint(f); return (u + 0x7fffu + ((u >> 16) & 1u)) >> 16; }
__device__ __forceinline__ unsigned pk2(float lo, float hi) { return f2bf(lo) | (f2bf(hi) << 16); }
__device__ __forceinline__ float lo16(unsigned w) { return __uint_as_float(w << 16); }
__device__ __forceinline__ float hi16(unsigned w) { return __uint_as_float(w & 0xffff0000u); }
__device__ __forceinline__ float wave_sum(float v) {
#pragma unroll
    for (int o = 32; o; o >>= 1) v += __shfl_xor(v, o);
    return v;
}
__device__ __forceinline__ float wave_max(float v) {
#pragma unroll
    for (int o = 32; o; o >>= 1) v = fmaxf(v, __shfl_xor(v, o));
    return v;
}
__device__ __forceinline__ float sigmoidf_(float x) { return 1.f / (1.f + __expf(-x)); }
__device__ __forceinline__ float dot8(u32x4 a, u32x4 b, float s) {
#pragma unroll
    for (int i = 0; i < 4; ++i) { s += lo16(a[i]) * lo16(b[i]); s += hi16(a[i]) * hi16(b[i]); }
    return s;
}

template <class Epi>
__device__ __forceinline__ void gemm_simple(unsigned char* lds, const bf16* A, const bf16* Bt, int Mm, int N, int K, const Epi& E, int bid, int nblk) {
    bf16* As = (bf16*)lds;
    bf16* Bs = As + 128 * 40;
    const int tid = threadIdx.x, lane = tid & 63, w = tid >> 6, wm = w >> 1, wn = w & 1;
    const int ntn = N / 128, ntm = Mm / 128, ntiles = ntm * ntn;
    const int lr = tid >> 2, lc = (tid & 3) * 8;
    for (int tile = bid; tile < ntiles; tile += nblk) {
        const int tm = tile / ntn, tn = tile % ntn;
        f32x4 acc[2][4];
#pragma unroll
        for (int a = 0; a < 2; ++a)
#pragma unroll
            for (int b = 0; b < 4; ++b) acc[a][b] = (f32x4){0.f, 0.f, 0.f, 0.f};
        const bf16* ag = A + (size_t)(tm * 128 + lr) * K + lc;
        const bf16* bg = Bt + (size_t)(tn * 128 + lr) * K + lc;
        for (int k0 = 0; k0 < K; k0 += 32) {
            const u32x4 av = *(const u32x4*)(ag + k0), bv = *(const u32x4*)(bg + k0);
            __syncthreads();
            *(u32x4*)(As + lr * 40 + lc) = av;
            *(u32x4*)(Bs + lr * 40 + lc) = bv;
            __syncthreads();
            bf16x8 af[2], bfr[4];
#pragma unroll
            for (int mt = 0; mt < 2; ++mt) af[mt] = *(const bf16x8*)(As + (wm * 32 + mt * 16 + (lane & 15)) * 40 + 8 * (lane >> 4));
#pragma unroll
            for (int nt = 0; nt < 4; ++nt) bfr[nt] = *(const bf16x8*)(Bs + (wn * 64 + nt * 16 + (lane & 15)) * 40 + 8 * (lane >> 4));
#pragma unroll
            for (int mt = 0; mt < 2; ++mt)
#pragma unroll
                for (int nt = 0; nt < 4; ++nt) acc[mt][nt] = __builtin_amdgcn_mfma_f32_16x16x32_bf16(bfr[nt], af[mt], acc[mt][nt], 0, 0, 0);
        }
#pragma unroll
        for (int mt = 0; mt < 2; ++mt)
#pragma unroll
            for (int nt = 0; nt < 4; ++nt) E(tm * 128 + wm * 32 + mt * 16 + (lane & 15), tn * 128 + wn * 64 + nt * 16 + 4 * (lane >> 4), acc[mt][nt]);
    }
    __syncthreads();
}

struct EpiProj {
    bf16* proj; float* ba; const float* rstd;
    __device__ __forceinline__ void operator()(int row, int col, f32x4 v) const {
        const float r = rstd[row];
        v = v * r;
        if (col < PROJ_W) { u32x2 o; o.x = pk2(v[0], v[1]); o.y = pk2(v[2], v[3]); *(u32x2*)(proj + (size_t)row * PROJ_W + col) = o; }
        else if (col < IN_COLS) { *(f32x4*)(ba + (size_t)row * 8 + (col - PROJ_W)) = v; }
    }
};
struct EpiRes {
    float* H; bf16* HB;
    __device__ __forceinline__ void operator()(int row, int col, f32x4 v) const {
        f32x4* hp = (f32x4*)(H + (size_t)row * D + col);
        const f32x4 h = *hp + v; *hp = h;
        u32x2 o; o.x = pk2(h[0], h[1]); o.y = pk2(h[2], h[3]); *(u32x2*)(HB + (size_t)row * D + col) = o;
    }
};
struct EpiQ2 {
    bf16* Q2; const float* rstd;
    __device__ __forceinline__ void operator()(int row, int col, f32x4 v) const {
        v = v * rstd[row];
        u32x2 o; o.x = pk2(v[0], v[1]); o.y = pk2(v[2], v[3]); *(u32x2*)(Q2 + (size_t)row * 2048 + col) = o;
    }
};
struct EpiE {
    bf16* E;
    __device__ __forceinline__ void operator()(int row, int col, f32x4 v) const {
        u32x2 o; o.x = pk2(v[0], v[1]); o.y = pk2(v[2], v[3]); *(u32x2*)(E + (size_t)row * D + col) = o;
    }
};
struct EpiPle {
    float* H; bf16* HB; const bf16* E; const float* rstde; const float* g;
    __device__ __forceinline__ void operator()(int row, int col, f32x4 v) const {
        f32x4* hp = (f32x4*)(H + (size_t)row * D + col);
        const u32x2 ev = *(const u32x2*)(E + (size_t)row * D + col);
        const f32x4 gv = *(const f32x4*)(g + col);
        const float r = rstde[row];
        f32x4 e; e[0] = lo16(ev.x); e[1] = hi16(ev.x); e[2] = lo16(ev.y); e[3] = hi16(ev.y);
        f32x4 h = *hp;
#pragma unroll
        for (int i = 0; i < 4; ++i) h[i] += sigmoidf_(v[i]) * (e[i] * r * gv[i]);
        *hp = h;
        u32x2 o; o.x = pk2(h[0], h[1]); o.y = pk2(h[2], h[3]); *(u32x2*)(HB + (size_t)row * D + col) = o;
    }
};

__device__ __forceinline__ void transpose_item(const float* W, int K, int N, int Npad, bf16* WT, const float* rowscale, int qcols, float* scr, int item, int lane) {
    const int nblk = Npad / 32, kb = item / nblk, nb = item % nblk, k0 = 64 * kb, n0 = 32 * nb;
    const int n = n0 + (lane & 31);
#pragma unroll 8
    for (int i = 0; i < 32; ++i) {
        const int kk = 2 * i + (lane >> 5);
        float v = (n < N) ? W[(size_t)(k0 + kk) * N + n] : 0.f;
        if (rowscale) v *= rowscale[k0 + kk];
        if (n < qcols) v *= QSCALE;
        scr[kk * 33 + (lane & 31)] = v;
    }
    asm volatile("s_waitcnt lgkmcnt(0)" ::: "memory");
    const int c = lane & 7;
#pragma unroll
    for (int j = 0; j < 4; ++j) {
        const int nn = (lane >> 3) + 8 * j; const float* s = scr + (8 * c) * 33 + nn;
        u32x4 o; o.x = pk2(s[0 * 33], s[1 * 33]); o.y = pk2(s[2 * 33], s[3 * 33]); o.z = pk2(s[4 * 33], s[5 * 33]); o.w = pk2(s[6 * 33], s[7 * 33]);
        *(u32x4*)(WT + (size_t)(n0 + nn) * K + k0 + 8 * c) = o;
    }
    asm volatile("s_waitcnt lgkmcnt(0)" ::: "memory");
}
__device__ __forceinline__ void convert_bulk(const float* src, bf16* dst, size_t n, size_t gtid, size_t nthr) {
    for (size_t i = gtid * 8; i < n; i += nthr * 8) {
        const f32x4 a = *(const f32x4*)(src + i), b = *(const f32x4*)(src + i + 4);
        u32x4 o; o.x = pk2(a[0], a[1]); o.y = pk2(a[2], a[3]); o.z = pk2(b[0], b[1]); o.w = pk2(b[2], b[3]);
        *(u32x4*)(dst + i) = o;
    }
}
__device__ void phase_prologue(const Params& p, unsigned char* lds, int bid, int nblk) {
    const int tid = threadIdx.x, lane = tid & 63, w = tid >> 6;
    const int gw = bid * NWAVES + w, NGW = nblk * NWAVES;
    float* scr = (float*)(lds + w * 16384);
    constexpr int I_IN = 16 * (IN_PAD / 32), I_OUT = 16 * 32, I_Q = 16 * 64, I_G = 16 * 32, I_P = 4 * 32, I_L = I_IN + I_OUT + I_Q + I_G + I_P;
    for (int it = gw; it < DEPTH * I_L; it += NGW) {
        const int L = it / I_L; int r = it % I_L;
        if (r < I_IN) { transpose_item(p.w_in + (size_t)L * D * IN_COLS, D, IN_COLS, IN_PAD, (bf16*)(p.ws + WS_WIN) + (size_t)L * IN_PAD * D, p.ln_mix_g + L * D, 512, scr, r, lane); continue; } r -= I_IN;
        if (r < I_OUT) { transpose_item(p.w_out + (size_t)L * D * D, D, D, D, (bf16*)(p.ws + WS_WOUT) + (size_t)L * D * D, nullptr, 0, scr, r, lane); continue; } r -= I_OUT;
        if (r < I_Q) { transpose_item(p.peer_wq + (size_t)L * D * 2048, D, 2048, 2048, (bf16*)(p.ws + WS_WQ) + (size_t)L * 2048 * D, p.ln_ffn_g + L * D, 0, scr, r, lane); continue; } r -= I_Q;
        if (r < I_G) { transpose_item(p.ple_wg + (size_t)L * D * D, D, D, D, (bf16*)(p.ws + WS_WG) + (size_t)L * D * D, nullptr, 0, scr, r, lane); continue; } r -= I_G;
        transpose_item(p.ple_wp + (size_t)L * 256 * D, 256, D, D, (bf16*)(p.ws + WS_WP) + (size_t)L * D * 256, nullptr, 0, scr, r, lane);
    }
    const size_t gtid = (size_t)bid * NTHREADS + tid, nthr = (size_t)nblk * NTHREADS;
    convert_bulk(p.peer_u, (bf16*)(p.ws + WS_U), (size_t)DEPTH * NEXP * D, gtid, nthr);
    convert_bulk(p.peer_v, (bf16*)(p.ws + WS_V), (size_t)DEPTH * NEXP * D, gtid, nthr);
    convert_bulk(p.p, (bf16*)(p.ws + WS_PB), (size_t)DEPTH * M * 256, gtid, nthr);
    convert_bulk(p.subkeys, (bf16*)(p.ws + WS_SK), (size_t)DEPTH * 8 * 2 * 128 * 128, gtid, nthr);
    float* H = (float*)(p.ws + WS_H); bf16* HB0 = (bf16*)(p.ws + WS_HB0); float* rstd0 = (float*)(p.ws + WS_STAT);
    for (int m = gw; m < M; m += NGW) {
        const f32x4* xr = (const f32x4*)(p.x + (size_t)m * D) + lane;
        float ss = 0.f;
#pragma unroll
        for (int j = 0; j < 4; ++j) {
            const f32x4 v = xr[64 * j];
            ss += v[0] * v[0] + v[1] * v[1] + v[2] * v[2] + v[3] * v[3];
            ((f32x4*)(H + (size_t)m * D))[lane + 64 * j] = v;
            u32x2 o; o.x = pk2(v[0], v[1]); o.y = pk2(v[2], v[3]);
            ((u32x2*)(HB0 + (size_t)m * D))[lane + 64 * j] = o;
        }
        ss = wave_sum(ss);
        if (lane == 0) rstd0[m] = rsqrtf(ss * (1.f / D) + EPS);
    }
}

__device__ void phase_rowstat_f32(const float* src, float* rstd, int bid, int nblk) {
    const int lane = threadIdx.x & 63, gw = bid * NWAVES + (threadIdx.x >> 6), NGW = nblk * NWAVES;
    for (int m = gw; m < M; m += NGW) {
        const f32x4* xr = (const f32x4*)(src + (size_t)m * D) + lane;
        float ss = 0.f;
#pragma unroll
        for (int j = 0; j < 4; ++j) { const f32x4 v = xr[64 * j]; ss += v[0] * v[0] + v[1] * v[1] + v[2] * v[2] + v[3] * v[3]; }
        ss = wave_sum(ss);
        if (lane == 0) rstd[m] = rsqrtf(ss * (1.f / D) + EPS);
    }
}
__device__ void phase_rowstat_bf16(const bf16* src, float* rstd, int bid, int nblk) {
    const int lane = threadIdx.x & 63, gw = bid * NWAVES + (threadIdx.x >> 6), NGW = nblk * NWAVES;
    for (int m = gw; m < M; m += NGW) {
        const u32x4* xr = (const u32x4*)(src + (size_t)m * D) + lane;
        float ss = 0.f;
#pragma unroll
        for (int j = 0; j < 2; ++j) { const u32x4 v = xr[64 * j];
#pragma unroll
            for (int i = 0; i < 4; ++i) { const float a = lo16(v[i]), b = hi16(v[i]); ss += a * a + b * b; } }
        ss = wave_sum(ss);
        if (lane == 0) rstd[m] = rsqrtf(ss * (1.f / D) + EPS);
    }
}

__device__ void phase_att_simple(const Params& p, int L, unsigned char* lds, int bid, int nblk) {
    const int tid = threadIdx.x, lane = tid & 63, w = tid >> 6;
    float* s1 = (float*)lds + w * 4096; float* s2 = s1 + 2048;
    u32x4* qs = (u32x4*)(lds + 131072) + w * 16;
    const bf16* proj = (const bf16*)(p.ws + WS_PROJ);
    bf16* obuf = (bf16*)(p.ws + WS_OBUF);
    const float* lp = p.diff_lambda + L * 256;
    const float d1 = wave_sum(lp[lane] * lp[64 + lane]), d2 = wave_sum(lp[128 + lane] * lp[192 + lane]);
    const float lam_init = 0.8f - 0.6f * expf(-0.3f * (float)L);
    const float lam = expf(d1) - expf(d2) + lam_init;
    const int gw = bid * NWAVES + w, NGW = nblk * NWAVES;
    for (int it = gw; it < BATCH * 4 * SEQ; it += NGW) {
        const int bh = it & 31, t = it >> 5, hh = bh & 3, b = bh >> 2;
        const size_t row = (size_t)b * SEQ + t;
        const float slope2 = exp2f(-2.f * (float)(hh + 1)) * 1.4426950408889634f;
        if (lane < 16) qs[lane] = ((const u32x4*)(proj + row * PROJ_W + hh * 128))[lane];
        asm volatile("s_waitcnt lgkmcnt(0)" ::: "memory");
        float m1 = -INFINITY, m2 = -INFINITY;
        for (int j = lane; j <= t; j += 64) {
            const u32x4* kp = (const u32x4*)(proj + ((size_t)b * SEQ + j) * PROJ_W + 512 + hh * 128);
            float a1 = 0.f, a2 = 0.f;
#pragma unroll
            for (int c = 0; c < 8; ++c) { a1 = dot8(qs[c], kp[c], a1); a2 = dot8(qs[8 + c], kp[8 + c], a2); }
            const float bias = slope2 * (float)(t - j);
            a1 -= bias; a2 -= bias;
            s1[j] = a1; s2[j] = a2;
            m1 = fmaxf(m1, a1); m2 = fmaxf(m2, a2);
        }
        m1 = wave_max(m1); m2 = wave_max(m2);
        float l1 = 0.f, l2 = 0.f;
        for (int j = lane; j <= t; j += 64) { const float e1 = exp2f(s1[j] - m1), e2 = exp2f(s2[j] - m2); s1[j] = e1; s2[j] = e2; l1 += e1; l2 += e2; }
        l1 = wave_sum(l1); l2 = wave_sum(l2);
        const float i1 = 1.f / l1, i2 = lam / l2;
        for (int j = lane; j <= t; j += 64) s1[j] = s1[j] * i1 - s2[j] * i2;
        asm volatile("s_waitcnt lgkmcnt(0)" ::: "memory");
        float o0 = 0.f, o1 = 0.f;
        const bf16* vp = proj + (size_t)b * SEQ * PROJ_W + 1024 + hh * 128 + 2 * lane;
#pragma unroll 4
        for (int j = 0; j <= t; ++j) { const float wj = s1[j]; const unsigned vv = *(const unsigned*)(vp + (size_t)j * PROJ_W); o0 += wj * lo16(vv); o1 += wj * hi16(vv); }
        const float ss = wave_sum(o0 * o0 + o1 * o1);
        const float r = rsqrtf(ss * (1.f / 128.f) + EPS) * (1.f - lam_init);
        const float* g = p.subln_g + L * 128 + 2 * lane;
        *(unsigned*)(obuf + row * D + hh * 128 + 2 * lane) = pk2(o0 * r * g[0], o1 * r * g[1]);
        asm volatile("s_waitcnt lgkmcnt(0)" ::: "memory");
    }
}

__device__ void phase_gdn_simple(const Params& p, int L, unsigned char* lds, int bid, int nblk) {
    const int tid = threadIdx.x, lane = tid & 63, w = tid >> 6, v = tid & 31, kg = tid >> 5;
    float* raw = (float*)lds;
    float* al = raw + 64 * 288; float* be = al + 64; float* red = be + 64; float* red2 = red + 512;
    const bf16* proj = (const bf16*)(p.ws + WS_PROJ);
    const float* BA = (const float*)(p.ws + WS_BA);
    float* ORAW = (float*)(p.ws + WS_ORAW);
    const float* cw = p.conv_w + (size_t)L * 4 * 1536;
    for (int it = bid; it < 128; it += nblk) {
        const int vq = it & 3, hh = (it >> 2) & 3, b = it >> 4;
        float S[8];
#pragma unroll
        for (int i = 0; i < 8; ++i) S[i] = 0.f;
        const float negA = -expf(p.a_log[L * 4 + hh]), dtb = p.dt_bias[L * 4 + hh];
        for (int n = 0; n < 32; ++n) {
            const int t0 = n * 64;
            __syncthreads();
            for (int idx = tid; idx < 64 * 288; idx += NTHREADS) {
                const int tok = idx / 288, ch = idx % 288;
                int col;
                if (ch < 128) col = hh * 128 + ch; else if (ch < 256) col = 512 + hh * 128 + (ch - 128); else col = 1024 + hh * 128 + vq * 32 + (ch - 256);
                const int t = t0 + tok;
                float y = 0.f;
#pragma unroll
                for (int j = 0; j < 4; ++j) { const int tt = t - 3 + j; if (tt >= 0) y += bf2f(proj[((size_t)b * SEQ + tt) * PROJ_W + 1536 + col]) * cw[j * 1536 + col]; }
                y = y * sigmoidf_(y);
                raw[tok * 288 + ch] = y;
            }
            if (tid < 64) {
                const size_t row = (size_t)b * SEQ + t0 + tid;
                const float bb = BA[row * 8 + hh], aa = BA[row * 8 + 4 + hh] + dtb;
                be[tid] = sigmoidf_(bb);
                const float sp = aa > 20.f ? aa : log1pf(expf(aa));
                al[tid] = expf(negA * sp);
            }
            __syncthreads();
            for (int pr = w; pr < 128; pr += NWAVES) {
                const int tok = pr >> 1, which = pr & 1; float* r = raw + tok * 288 + which * 128;
                const float a0 = r[lane], a1 = r[lane + 64];
                const float ss = wave_sum(a0 * a0 + a1 * a1);
                const float sc = rsqrtf(ss + EPS) * (which == 0 ? 0.08838834764831845f : 1.f);
                r[lane] = a0 * sc; r[lane + 64] = a1 * sc;
            }
            __syncthreads();
            for (int tok = 0; tok < 64; ++tok) {
                const float a = al[tok], bt = be[tok];
                const float* qk = raw + tok * 288;
                float pr = 0.f;
#pragma unroll
                for (int i = 0; i < 8; ++i) { S[i] *= a; pr += qk[128 + kg * 8 + i] * S[i]; }
                red[kg * 32 + v] = pr;
                __syncthreads();
                float r = 0.f;
#pragma unroll
                for (int g2 = 0; g2 < 16; ++g2) r += red[g2 * 32 + v];
                const float dv = bt * (qk[256 + v] - r);
                float po = 0.f;
#pragma unroll
                for (int i = 0; i < 8; ++i) { S[i] += qk[128 + kg * 8 + i] * dv; po += qk[kg * 8 + i] * S[i]; }
                red2[kg * 32 + v] = po;
                __syncthreads();
                if (kg == 0) {
                    float o = 0.f;
#pragma unroll
                    for (int g2 = 0; g2 < 16; ++g2) o += red2[g2 * 32 + v];
                    ORAW[((size_t)b * SEQ + t0 + tok) * 512 + hh * 128 + vq * 32 + v] = o;
                }
            }
        }
    }
    __syncthreads();
}
__device__ void phase_gdn_finish(const Params& p, int L, int bid, int nblk) {
    const int lane = threadIdx.x & 63, gw = bid * NWAVES + (threadIdx.x >> 6), NGW = nblk * NWAVES;
    const float* ORAW = (const float*)(p.ws + WS_ORAW);
    const bf16* proj = (const bf16*)(p.ws + WS_PROJ);
    bf16* obuf = (bf16*)(p.ws + WS_OBUF);
    for (int it = gw; it < M * 4; it += NGW) {
        const int hh = it & 3; const size_t row = it >> 2;
        const float o0 = ORAW[row * 512 + hh * 128 + 2 * lane], o1 = ORAW[row * 512 + hh * 128 + 2 * lane + 1];
        const float ss = wave_sum(o0 * o0 + o1 * o1);
        const float r = rsqrtf(ss * (1.f / 128.f) + EPS);
        const unsigned zz = *(const unsigned*)(proj + row * PROJ_W + 3072 + hh * 128 + 2 * lane);
        const float z0 = lo16(zz), z1 = hi16(zz);
        const float* g = p.gdn_norm_g + L * 128 + 2 * lane;
        *(unsigned*)(obuf + row * D + 512 + hh * 128 + 2 * lane) = pk2(o0 * r * g[0] * (z0 * sigmoidf_(z0)), o1 * r * g[1] * (z1 * sigmoidf_(z1)));
    }
}

__device__ void phase_peer_select_simple(const Params& p, int L, int bid, int nblk) {
    const int lane = threadIdx.x & 63, gw = bid * NWAVES + (threadIdx.x >> 6), NGW = nblk * NWAVES;
    const bf16* Q2 = (const bf16*)(p.ws + WS_Q2);
    const bf16* SK = (const bf16*)(p.ws + WS_SK);
    int* IDX = (int*)(p.ws + WS_IDX); float* GATE = (float*)(p.ws + WS_GATE);
    for (int it = gw; it < M * 8; it += NGW) {
        const int tok = it >> 3, hh = it & 7;
        float tv[2]; int ti[2];
#pragma unroll
        for (int c = 0; c < 2; ++c) {
            const u32x4* qp = (const u32x4*)(Q2 + (size_t)tok * 2048 + hh * 256 + c * 128);
            const u32x4* ka = (const u32x4*)(SK + ((((size_t)L * 8 + hh) * 2 + c) * 128 + lane) * 128);
            const u32x4* kb = ka + 64 * 16;
            float sa = 0.f, sb = 0.f;
#pragma unroll
            for (int ch = 0; ch < 16; ++ch) { const u32x4 q = qp[ch]; sa = dot8(q, ka[ch], sa); sb = dot8(q, kb[ch], sb); }
            float myv = 0.f; int myi = 0;
            for (int r = 0; r < 16; ++r) {
                const float m = wave_max(fmaxf(sa, sb));
                const unsigned long long ba = __ballot(sa == m);
                int win;
                if (ba) { const int ln = __ffsll((long long)ba) - 1; win = ln; if (lane == ln) sa = -INFINITY; }
                else { const unsigned long long bb = __ballot(sb == m); const int ln = __ffsll((long long)bb) - 1; win = 64 + ln; if (lane == ln) sb = -INFINITY; }
                if (lane == r) { myv = m; myi = win; }
            }
            tv[c] = myv; ti[c] = myi;
        }
        float cv[4];
#pragma unroll
        for (int q4 = 0; q4 < 4; ++q4) { const int pp = lane + 64 * q4; cv[q4] = __shfl(tv[0], pp >> 4) + __shfl(tv[1], pp & 15); }
        float gv = 0.f; int gp = 0;
        for (int r = 0; r < 16; ++r) {
            const float m = wave_max(fmaxf(fmaxf(cv[0], cv[1]), fmaxf(cv[2], cv[3])));
            int win = -1;
#pragma unroll
            for (int q4 = 0; q4 < 4; ++q4) {
                const unsigned long long bq = __ballot(cv[q4] == m);
                if (win < 0 && bq) { const int ln = __ffsll((long long)bq) - 1; win = ln + 64 * q4; if (lane == ln) cv[q4] = -INFINITY; }
            }
            if (lane == r) { gv = m; gp = win; }
        }
        const float m0 = __shfl(gv, 0);
        const float e = lane < 16 ? expf(gv - m0) : 0.f;
        const float sum = wave_sum(e);
        const int ia = __shfl(ti[0], gp >> 4), ib = __shfl(ti[1], gp & 15);
        if (lane < 16) { IDX[(size_t)tok * 128 + hh * 16 + lane] = ia * 128 + ib; GATE[(size_t)tok * 128 + hh * 16 + lane] = e / sum; }
    }
}

__device__ void phase_peer_gather(const Params& p, int L, int bid, int nblk) {
    const int lane = threadIdx.x & 63, gw = bid * NWAVES + (threadIdx.x >> 6), NGW = nblk * NWAVES;
    float* H = (float*)(p.ws + WS_H); bf16* HB2 = (bf16*)(p.ws + WS_HB2);
    const int* IDX = (const int*)(p.ws + WS_IDX); const float* GATE = (const float*)(p.ws + WS_GATE);
    const bf16* U = (const bf16*)(p.ws + WS_U) + (size_t)L * NEXP * D;
    const bf16* V = (const bf16*)(p.ws + WS_V) + (size_t)L * NEXP * D;
    const float* g = p.ln_ffn_g + L * D;
    for (int tok = gw; tok < M; tok += NGW) {
        float* hrow = H + (size_t)tok * D;
        float xv[16];
        {
            const f32x4 a0 = *(const f32x4*)(hrow + 8 * lane), a1 = *(const f32x4*)(hrow + 8 * lane + 4), b0 = *(const f32x4*)(hrow + 512 + 8 * lane), b1 = *(const f32x4*)(hrow + 512 + 8 * lane + 4);
#pragma unroll
            for (int i = 0; i < 4; ++i) { xv[i] = a0[i]; xv[4 + i] = a1[i]; xv[8 + i] = b0[i]; xv[12 + i] = b1[i]; }
        }
        float ss = 0.f;
#pragma unroll
        for (int i = 0; i < 16; ++i) ss += xv[i] * xv[i];
        ss = wave_sum(ss);
        const float rstd = rsqrtf(ss * (1.f / D) + EPS);
        float xn[16];
#pragma unroll
        for (int i = 0; i < 8; ++i) { xn[i] = xv[i] * rstd * g[8 * lane + i]; xn[8 + i] = xv[8 + i] * rstd * g[512 + 8 * lane + i]; }
        const int id0 = IDX[(size_t)tok * 128 + lane], id1 = IDX[(size_t)tok * 128 + 64 + lane];
        const float g0 = GATE[(size_t)tok * 128 + lane], g1 = GATE[(size_t)tok * 128 + 64 + lane];
        float w0 = 0.f, w1 = 0.f;
#pragma unroll 4
        for (int e = 0; e < 128; ++e) {
            const int id = __shfl(e < 64 ? id0 : id1, e & 63);
            const bf16* ur = U + (size_t)id * D;
            const u32x4 a = *(const u32x4*)(ur + 8 * lane), b = *(const u32x4*)(ur + 512 + 8 * lane);
            float d = 0.f;
#pragma unroll
            for (int i = 0; i < 4; ++i) { d += xn[2 * i] * lo16(a[i]) + xn[2 * i + 1] * hi16(a[i]); d += xn[8 + 2 * i] * lo16(b[i]) + xn[8 + 2 * i + 1] * hi16(b[i]); }
            d = wave_sum(d);
            const float ge = 0.5f * d * (1.f + erff(d * 0.70710678118654752f));
            if (lane == (e & 63)) { if (e < 64) w0 = g0 * ge; else w1 = g1 * ge; }
        }
        float y[16];
#pragma unroll
        for (int i = 0; i < 16; ++i) y[i] = 0.f;
#pragma unroll 4
        for (int e = 0; e < 128; ++e) {
            const int id = __shfl(e < 64 ? id0 : id1, e & 63);
            const float ww = __shfl(e < 64 ? w0 : w1, e & 63);
            const bf16* vr = V + (size_t)id * D;
            const u32x4 a = *(const u32x4*)(vr + 8 * lane), b = *(const u32x4*)(vr + 512 + 8 * lane);
#pragma unroll
            for (int i = 0; i < 4; ++i) { y[2 * i] += ww * lo16(a[i]); y[2 * i + 1] += ww * hi16(a[i]); y[8 + 2 * i] += ww * lo16(b[i]); y[8 + 2 * i + 1] += ww * hi16(b[i]); }
        }
#pragma unroll
        for (int i = 0; i < 16; ++i) y[i] += xv[i];
        *(f32x4*)(hrow + 8 * lane) = (f32x4){y[0], y[1], y[2], y[3]};
        *(f32x4*)(hrow + 8 * lane + 4) = (f32x4){y[4], y[5], y[6], y[7]};
        *(f32x4*)(hrow + 512 + 8 * lane) = (f32x4){y[8], y[9], y[10], y[11]};
        *(f32x4*)(hrow + 512 + 8 * lane + 4) = (f32x4){y[12], y[13], y[14], y[15]};
        bf16* hb = HB2 + (size_t)tok * D;
        u32x4 o; o.x = pk2(y[0], y[1]); o.y = pk2(y[2], y[3]); o.z = pk2(y[4], y[5]); o.w = pk2(y[6], y[7]);
        *(u32x4*)(hb + 8 * lane) = o;
        o.x = pk2(y[8], y[9]); o.y = pk2(y[10], y[11]); o.z = pk2(y[12], y[13]); o.w = pk2(y[14], y[15]);
        *(u32x4*)(hb + 512 + 8 * lane) = o;
    }
}

__device__ void phase_final(const Params& p, int bid, int nblk) {
    const int lane = threadIdx.x & 63, gw = bid * NWAVES + (threadIdx.x >> 6), NGW = nblk * NWAVES;
    const float* H = (const float*)(p.ws + WS_H); const float* rstd0 = (const float*)(p.ws + WS_STAT);
    for (int m = gw; m < M; m += NGW) {
        const float r = rstd0[m];
#pragma unroll
        for (int j = 0; j < 4; ++j) {
            const f32x4 v = ((const f32x4*)(H + (size_t)m * D))[lane + 64 * j];
            const f32x4 gv = ((const f32x4*)p.final_g)[lane + 64 * j];
            ((f32x4*)(p.out + (size_t)m * D))[lane + 64 * j] = v * r * gv;
        }
    }
}

constexpr int NS = 11;
constexpr int K_PROLOGUE = 11, K_FINAL = 12;
template <int KIND>
__device__ __forceinline__ void run_kind(const Params& p, int L, unsigned char* lds, int bid, int nblk) {
    unsigned char* ws = p.ws;
    float* H = (float*)(ws + WS_H);
    float* rstd0 = (float*)(ws + WS_STAT); float* rstd1 = rstd0 + M; float* rstde = rstd1 + M;
    if constexpr (KIND == K_PROLOGUE) phase_prologue(p, lds, bid, nblk);
    if constexpr (KIND == K_FINAL) phase_final(p, bid, nblk);
    if constexpr (KIND == 0) { EpiProj E{(bf16*)(ws + WS_PROJ), (float*)(ws + WS_BA), rstd0};
        gemm_simple(lds, (const bf16*)(ws + WS_HB0), (const bf16*)(ws + WS_WIN) + (size_t)L * IN_PAD * D, M, IN_PAD, D, E, bid, nblk); }
    if constexpr (KIND == 1) phase_att_simple(p, L, lds, bid, nblk);
    if constexpr (KIND == 2) phase_gdn_simple(p, L, lds, bid, nblk);
    if constexpr (KIND == 3) phase_gdn_finish(p, L, bid, nblk);
    if constexpr (KIND == 4) { EpiRes E{H, (bf16*)(ws + WS_HB1)};
        gemm_simple(lds, (const bf16*)(ws + WS_OBUF), (const bf16*)(ws + WS_WOUT) + (size_t)L * D * D, M, D, D, E, bid, nblk); }
    if constexpr (KIND == 5) phase_rowstat_f32(H, rstd1, bid, nblk);
    if constexpr (KIND == 6) { EpiQ2 E{(bf16*)(ws + WS_Q2), rstd1};
        gemm_simple(lds, (const bf16*)(ws + WS_HB1), (const bf16*)(ws + WS_WQ) + (size_t)L * 2048 * D, M, 2048, D, E, bid, nblk);
        EpiE E2{(bf16*)(ws + WS_EPRE)};
        gemm_simple(lds, (const bf16*)(ws + WS_PB) + (size_t)L * M * 256, (const bf16*)(ws + WS_WP) + (size_t)L * D * 256, M, D, 256, E2, bid, nblk); }
    if constexpr (KIND == 7) { phase_rowstat_bf16((const bf16*)(ws + WS_EPRE), rstde, bid, nblk); phase_peer_select_simple(p, L, bid, nblk); }
    if constexpr (KIND == 8) phase_peer_gather(p, L, bid, nblk);
    if constexpr (KIND == 9) { EpiPle E{H, (bf16*)(ws + WS_HB0), (const bf16*)(ws + WS_EPRE), rstde, p.ple_norm_g + L * D};
        gemm_simple(lds, (const bf16*)(ws + WS_HB2), (const bf16*)(ws + WS_WG) + (size_t)L * D * D, M, D, D, E, bid, nblk); }
    if constexpr (KIND == 10) phase_rowstat_f32(H, rstd0, bid, nblk);
}

template <int KIND>
__global__ void __launch_bounds__(NTHREADS, 2) mk_step(Params p, int L) {
    extern __shared__ __attribute__((aligned(16))) unsigned char lds[];
    run_kind<KIND>(p, L, lds, (int)blockIdx.x, (int)gridDim.x);
}

template <int KIND>
static void launch_kind(const Params& p, int L, int grid, hipStream_t stream) {
    static bool attr_done = false;
    if (!attr_done) { (void)hipFuncSetAttribute((const void*)mk_step<KIND>, hipFuncAttributeMaxDynamicSharedMemorySize, LDS_BYTES); attr_done = true; }
    hipLaunchKernelGGL(mk_step<KIND>, dim3(grid), dim3(NTHREADS), LDS_BYTES, stream, p, L);
}

extern "C" void kernel_launch(void* const* d_in, const int* in_sizes, int n_in, void* d_out, int out_size, void* d_ws, size_t ws_size, hipStream_t stream) {
    static int grid = 0;
    if (grid == 0) {
        if (n_in != 20 || out_size != M * D || ws_size < WS_END) { fprintf(stderr, "kernel_launch: unexpected shapes (n_in %d, out %d, ws %zu < %zu)\n", n_in, out_size, ws_size, (size_t)WS_END); grid = -1; return; }
        int dev = 0, cus = 0;
        (void)hipGetDevice(&dev); (void)hipDeviceGetAttribute(&cus, hipDeviceAttributeMultiprocessorCount, dev);
        grid = cus > 0 ? cus : 256;
    }
    if (grid < 0) return;
    Params p{};
    const float** pp = (const float**)&p;
    for (int i = 0; i < 20; ++i) pp[i] = (const float*)d_in[i];
    p.out = (float*)d_out; p.ws = (unsigned char*)d_ws;
    launch_kind<K_PROLOGUE>(p, 0, grid, stream);
    for (int L = 0; L < DEPTH; ++L) {
        launch_kind<0>(p, L, grid, stream); launch_kind<1>(p, L, grid, stream); launch_kind<2>(p, L, grid, stream); launch_kind<3>(p, L, grid, stream);
        launch_kind<4>(p, L, grid, stream); launch_kind<5>(p, L, grid, stream); launch_kind<6>(p, L, grid, stream); launch_kind<7>(p, L, grid, stream);
        launch_kind<8>(p, L, grid, stream); launch_kind<9>(p, L, grid, stream); launch_kind<10>(p, L, grid, stream);
    }
    launch_kind<K_FINAL>(p, 0, grid, stream);
}
```

```cpp
#include <hip/hip_runtime.h>
#include <hip/hip_cooperative_groups.h>
#include <cstdio>
#include <cstdint>
namespace cg = cooperative_groups;

typedef unsigned short bf16;
typedef float f32x4 __attribute__((ext_vector_type(4)));
typedef short bf16x8 __attribute__((ext_vector_type(8)));
typedef unsigned u32x4 __attribute__((ext_vector_type(4)));
typedef unsigned u32x2 __attribute__((ext_vector_type(2)));

constexpr int D = 1024, BATCH = 8, SEQ = 2048, DEPTH = 4, M = BATCH * SEQ;
constexpr int IN_COLS = 3592, IN_PAD = 3840, PROJ_W = 3584;
constexpr int NEXP = 16384;
constexpr float EPS = 1e-6f;
constexpr float QSCALE = 0.125f * 1.4426950408889634f;
constexpr int NWAVES = 8, NTHREADS = 512;
constexpr int LDS_BYTES = 147456;

constexpr size_t MiB = 1u << 20;
constexpr size_t WS_CTL = 0, CTL_ZERO_BYTES = 1 * MiB;
constexpr size_t WS_H = 1 * MiB;
constexpr size_t WS_HB0 = 65 * MiB;
constexpr size_t WS_HB1 = 97 * MiB;
constexpr size_t WS_HB2 = 129 * MiB;
constexpr size_t WS_PROJ = 161 * MiB;
constexpr size_t WS_BA = 273 * MiB;
constexpr size_t WS_OBUF = 274 * MiB;
constexpr size_t WS_Q2 = 306 * MiB;
constexpr size_t WS_EPRE = 370 * MiB;
constexpr size_t WS_IDX = 402 * MiB;
constexpr size_t WS_GATE = 410 * MiB;
constexpr size_t WS_STAT = 418 * MiB;
constexpr size_t WS_ORAW = 422 * MiB;
constexpr size_t WS_WIN = 550 * MiB;
constexpr size_t WS_WOUT = 582 * MiB;
constexpr size_t WS_WQ = 590 * MiB;
constexpr size_t WS_WG = 606 * MiB;
constexpr size_t WS_WP = 614 * MiB;
constexpr size_t WS_SK = 616 * MiB;
constexpr size_t WS_PB = 618 * MiB;
constexpr size_t WS_U = 650 * MiB;
constexpr size_t WS_V = 778 * MiB;
constexpr size_t WS_END = 906 * MiB;

struct Params {
    const float *x, *p, *ln_mix_g, *w_in, *conv_w, *a_log, *dt_bias, *gdn_norm_g, *diff_lambda, *subln_g, *w_out, *ln_ffn_g,
        *peer_wq, *subkeys, *peer_u, *peer_v, *ple_wp, *ple_wg, *ple_norm_g, *final_g;
    float* out;
    unsigned char* ws;
    int pad0, pad1;
};

__device__ __forceinline__ int tidx() { int t = (int)threadIdx.x; asm volatile("" : "+v"(t)); return t; }
__device__ __forceinline__ float bf2f(bf16 v) { return __uint_as_float((unsigned)v << 16); }
__device__ __forceinline__ unsigned f2bf(float f) { unsigned u = __float_as_uint(f); return (u + 0x7fffu + ((u >> 16) & 1u)) >> 16; }
__device__ __forceinline__ unsigned pk2(float lo, float hi) { return f2bf(lo) | (f2bf(hi) << 16); }
__device__ __forceinline__ float lo16(unsigned w) { return __uint_as_float(w << 16); }
__device__ __forceinline__ float hi16(unsigned w) { return __uint_as_float(w & 0xffff0000u); }
__device__ __forceinline__ float wave_sum(float v) {
#pragma unroll
    for (int o = 32; o; o >>= 1) v += __shfl_xor(v, o);
    return v;
}
__device__ __forceinline__ float wave_max(float v) {
#pragma unroll
    for (int o = 32; o; o >>= 1) v = fmaxf(v, __shfl_xor(v, o));
    return v;
}
__device__ __forceinline__ float sigmoidf_(float x) { return 1.f / (1.f + __expf(-x)); }
__device__ __forceinline__ float dot8(u32x4 a, u32x4 b, float s) {
#pragma unroll
    for (int i = 0; i < 4; ++i) { s += lo16(a[i]) * lo16(b[i]); s += hi16(a[i]) * hi16(b[i]); }
    return s;
}

template <class Epi>
__device__ __forceinline__ void gemm_simple(unsigned char* lds, const bf16* A, const bf16* Bt, int Mm, int N, int K, const Epi& E, int bid, int nblk) {
    bf16* As = (bf16*)lds;
    bf16* Bs = As + 128 * 40;
    const int tid = tidx(), lane = tid & 63, w = tid >> 6, wm = w >> 1, wn = w & 1;
    const int ntn = N / 128, ntm = Mm / 128, ntiles = ntm * ntn;
    const int lr = tid >> 2, lc = (tid & 3) * 8;
    for (int tile = bid; tile < ntiles; tile += nblk) {
        const int tm = tile / ntn, tn = tile % ntn;
        f32x4 acc[2][4];
#pragma unroll
        for (int a = 0; a < 2; ++a)
#pragma unroll
            for (int b = 0; b < 4; ++b) acc[a][b] = (f32x4){0.f, 0.f, 0.f, 0.f};
        const bf16* ag = A + (size_t)(tm * 128 + lr) * K + lc;
        const bf16* bg = Bt + (size_t)(tn * 128 + lr) * K + lc;
        for (int k0 = 0; k0 < K; k0 += 32) {
            const u32x4 av = *(const u32x4*)(ag + k0), bv = *(const u32x4*)(bg + k0);
            __syncthreads();
            *(u32x4*)(As + lr * 40 + lc) = av;
            *(u32x4*)(Bs + lr * 40 + lc) = bv;
            __syncthreads();
            bf16x8 af[2], bfr[4];
#pragma unroll
            for (int mt = 0; mt < 2; ++mt) af[mt] = *(const bf16x8*)(As + (wm * 32 + mt * 16 + (lane & 15)) * 40 + 8 * (lane >> 4));
#pragma unroll
            for (int nt = 0; nt < 4; ++nt) bfr[nt] = *(const bf16x8*)(Bs + (wn * 64 + nt * 16 + (lane & 15)) * 40 + 8 * (lane >> 4));
#pragma unroll
            for (int mt = 0; mt < 2; ++mt)
#pragma unroll
                for (int nt = 0; nt < 4; ++nt) acc[mt][nt] = __builtin_amdgcn_mfma_f32_16x16x32_bf16(bfr[nt], af[mt], acc[mt][nt], 0, 0, 0);
        }
#pragma unroll
        for (int mt = 0; mt < 2; ++mt)
#pragma unroll
            for (int nt = 0; nt < 4; ++nt) E(tm * 128 + wm * 32 + mt * 16 + (lane & 15), tn * 128 + wn * 64 + nt * 16 + 4 * (lane >> 4), acc[mt][nt]);
    }
    __syncthreads();
}

struct EpiProj {
    bf16* proj; float* ba; const float* rstd;
    __device__ __forceinline__ void operator()(int row, int col, f32x4 v) const {
        const float r = rstd[row];
        v = v * r;
        if (col < PROJ_W) { u32x2 o; o.x = pk2(v[0], v[1]); o.y = pk2(v[2], v[3]); *(u32x2*)(proj + (size_t)row * PROJ_W + col) = o; }
        else if (col < IN_COLS) { *(f32x4*)(ba + (size_t)row * 8 + (col - PROJ_W)) = v; }
    }
};
struct EpiRes {
    float* H; bf16* HB;
    __device__ __forceinline__ void operator()(int row, int col, f32x4 v) const {
        f32x4* hp = (f32x4*)(H + (size_t)row * D + col);
        const f32x4 h = *hp + v; *hp = h;
        u32x2 o; o.x = pk2(h[0], h[1]); o.y = pk2(h[2], h[3]); *(u32x2*)(HB + (size_t)row * D + col) = o;
    }
};
struct EpiQ2 {
    bf16* Q2; const float* rstd;
    __device__ __forceinline__ void operator()(int row, int col, f32x4 v) const {
        v = v * rstd[row];
        u32x2 o; o.x = pk2(v[0], v[1]); o.y = pk2(v[2], v[3]); *(u32x2*)(Q2 + (size_t)row * 2048 + col) = o;
    }
};
struct EpiE {
    bf16* E;
    __device__ __forceinline__ void operator()(int row, int col, f32x4 v) const {
        u32x2 o; o.x = pk2(v[0], v[1]); o.y = pk2(v[2], v[3]); *(u32x2*)(E + (size_t)row * D + col) = o;
    }
};
struct EpiPle {
    float* H; bf16* HB; const bf16* E; const float* rstde; const float* g;
    __device__ __forceinline__ void operator()(int row, int col, f32x4 v) const {
        f32x4* hp = (f32x4*)(H + (size_t)row * D + col);
        const u32x2 ev = *(const u32x2*)(E + (size_t)row * D + col);
        const f32x4 gv = *(const f32x4*)(g + col);
        const float r = rstde[row];
        f32x4 e; e[0] = lo16(ev.x); e[1] = hi16(ev.x); e[2] = lo16(ev.y); e[3] = hi16(ev.y);
        f32x4 h = *hp;
#pragma unroll
        for (int i = 0; i < 4; ++i) h[i] += sigmoidf_(v[i]) * (e[i] * r * gv[i]);
        *hp = h;
        u32x2 o; o.x = pk2(h[0], h[1]); o.y = pk2(h[2], h[3]); *(u32x2*)(HB + (size_t)row * D + col) = o;
    }
};

__device__ __forceinline__ void transpose_item(const float* W, int K, int N, int Npad, bf16* WT, const float* rowscale, int qcols, float* scr, int item, int lane) {
    const int nblk = Npad / 32, kb = item / nblk, nb = item % nblk, k0 = 64 * kb, n0 = 32 * nb;
    const int n = n0 + (lane & 31);
#pragma unroll 8
    for (int i = 0; i < 32; ++i) {
        const int kk = 2 * i + (lane >> 5);
        float v = (n < N) ? W[(size_t)(k0 + kk) * N + n] : 0.f;
        if (rowscale) v *= rowscale[k0 + kk];
        if (n < qcols) v *= QSCALE;
        scr[kk * 33 + (lane & 31)] = v;
    }
    asm volatile("s_waitcnt lgkmcnt(0)" ::: "memory");
    const int c = lane & 7;
#pragma unroll
    for (int j = 0; j < 4; ++j) {
        const int nn = (lane >> 3) + 8 * j; const float* s = scr + (8 * c) * 33 + nn;
        u32x4 o; o.x = pk2(s[0 * 33], s[1 * 33]); o.y = pk2(s[2 * 33], s[3 * 33]); o.z = pk2(s[4 * 33], s[5 * 33]); o.w = pk2(s[6 * 33], s[7 * 33]);
        *(u32x4*)(WT + (size_t)(n0 + nn) * K + k0 + 8 * c) = o;
    }
    asm volatile("s_waitcnt lgkmcnt(0)" ::: "memory");
}
__device__ __forceinline__ void convert_bulk(const float* src, bf16* dst, size_t n, size_t gtid, size_t nthr) {
    for (size_t i = gtid * 8; i < n; i += nthr * 8) {
        const f32x4 a = *(const f32x4*)(src + i), b = *(const f32x4*)(src + i + 4);
        u32x4 o; o.x = pk2(a[0], a[1]); o.y = pk2(a[2], a[3]); o.z = pk2(b[0], b[1]); o.w = pk2(b[2], b[3]);
        *(u32x4*)(dst + i) = o;
    }
}
__device__ void phase_prologue(const Params& p, unsigned char* lds, int bid, int nblk) {
    const int tid = tidx(), lane = tid & 63, w = tid >> 6;
    const int gw = bid * NWAVES + w, NGW = nblk * NWAVES;
    float* scr = (float*)(lds + w * 16384);
    constexpr int I_IN = 16 * (IN_PAD / 32), I_OUT = 16 * 32, I_Q = 16 * 64, I_G = 16 * 32, I_P = 4 * 32, I_L = I_IN + I_OUT + I_Q + I_G + I_P;
    for (int it = gw; it < DEPTH * I_L; it += NGW) {
        const int L = it / I_L; int r = it % I_L;
        if (r < I_IN) { transpose_item(p.w_in + (size_t)L * D * IN_COLS, D, IN_COLS, IN_PAD, (bf16*)(p.ws + WS_WIN) + (size_t)L * IN_PAD * D, p.ln_mix_g + L * D, 512, scr, r, lane); continue; } r -= I_IN;
        if (r < I_OUT) { transpose_item(p.w_out + (size_t)L * D * D, D, D, D, (bf16*)(p.ws + WS_WOUT) + (size_t)L * D * D, nullptr, 0, scr, r, lane); continue; } r -= I_OUT;
        if (r < I_Q) { transpose_item(p.peer_wq + (size_t)L * D * 2048, D, 2048, 2048, (bf16*)(p.ws + WS_WQ) + (size_t)L * 2048 * D, p.ln_ffn_g + L * D, 0, scr, r, lane); continue; } r -= I_Q;
        if (r < I_G) { transpose_item(p.ple_wg + (size_t)L * D * D, D, D, D, (bf16*)(p.ws + WS_WG) + (size_t)L * D * D, nullptr, 0, scr, r, lane); continue; } r -= I_G;
        transpose_item(p.ple_wp + (size_t)L * 256 * D, 256, D, D, (bf16*)(p.ws + WS_WP) + (size_t)L * D * 256, nullptr, 0, scr, r, lane);
    }
    const size_t gtid = (size_t)bid * NTHREADS + tid, nthr = (size_t)nblk * NTHREADS;
    convert_bulk(p.peer_u, (bf16*)(p.ws + WS_U), (size_t)DEPTH * NEXP * D, gtid, nthr);
    convert_bulk(p.peer_v, (bf16*)(p.ws + WS_V), (size_t)DEPTH * NEXP * D, gtid, nthr);
    convert_bulk(p.p, (bf16*)(p.ws + WS_PB), (size_t)DEPTH * M * 256, gtid, nthr);
    convert_bulk(p.subkeys, (bf16*)(p.ws + WS_SK), (size_t)DEPTH * 8 * 2 * 128 * 128, gtid, nthr);
    float* H = (float*)(p.ws + WS_H); bf16* HB0 = (bf16*)(p.ws + WS_HB0); float* rstd0 = (float*)(p.ws + WS_STAT);
    for (int m = gw; m < M; m += NGW) {
        const f32x4* xr = (const f32x4*)(p.x + (size_t)m * D) + lane;
        float ss = 0.f;
#pragma unroll
        for (int j = 0; j < 4; ++j) {
            const f32x4 v = xr[64 * j];
            ss += v[0] * v[0] + v[1] * v[1] + v[2] * v[2] + v[3] * v[3];
            ((f32x4*)(H + (size_t)m * D))[lane + 64 * j] = v;
            u32x2 o; o.x = pk2(v[0], v[1]); o.y = pk2(v[2], v[3]);
            ((u32x2*)(HB0 + (size_t)m * D))[lane + 64 * j] = o;
        }
        ss = wave_sum(ss);
        if (lane == 0) rstd0[m] = rsqrtf(ss * (1.f / D) + EPS);
    }
}

__device__ void phase_rowstat_f32(const float* src, float* rstd, int bid, int nblk) {
    const int tid = tidx(), lane = tid & 63, gw = bid * NWAVES + (tid >> 6), NGW = nblk * NWAVES;
    for (int m = gw; m < M; m += NGW) {
        const f32x4* xr = (const f32x4*)(src + (size_t)m * D) + lane;
        float ss = 0.f;
#pragma unroll
        for (int j = 0; j < 4; ++j) { const f32x4 v = xr[64 * j]; ss += v[0] * v[0] + v[1] * v[1] + v[2] * v[2] + v[3] * v[3]; }
        ss = wave_sum(ss);
        if (lane == 0) rstd[m] = rsqrtf(ss * (1.f / D) + EPS);
    }
}
__device__ void phase_rowstat_bf16(const bf16* src, float* rstd, int bid, int nblk) {
    const int tid = tidx(), lane = tid & 63, gw = bid * NWAVES + (tid >> 6), NGW = nblk * NWAVES;
    for (int m = gw; m < M; m += NGW) {
        const u32x4* xr = (const u32x4*)(src + (size_t)m * D) + lane;
        float ss = 0.f;
#pragma unroll
        for (int j = 0; j < 2; ++j) { const u32x4 v = xr[64 * j];
#pragma unroll
            for (int i = 0; i < 4; ++i) { const float a = lo16(v[i]), b = hi16(v[i]); ss += a * a + b * b; } }
        ss = wave_sum(ss);
        if (lane == 0) rstd[m] = rsqrtf(ss * (1.f / D) + EPS);
    }
}

__device__ void phase_att_simple(const Params& p, int L, unsigned char* lds, int bid, int nblk) {
    const int tid = tidx(), lane = tid & 63, w = tid >> 6;
    float* s1 = (float*)lds + w * 4096; float* s2 = s1 + 2048;
    u32x4* qs = (u32x4*)(lds + 131072) + w * 16;
    const bf16* proj = (const bf16*)(p.ws + WS_PROJ);
    bf16* obuf = (bf16*)(p.ws + WS_OBUF);
    const float* lp = p.diff_lambda + L * 256;
    const float d1 = wave_sum(lp[lane] * lp[64 + lane]), d2 = wave_sum(lp[128 + lane] * lp[192 + lane]);
    const float lam_init = 0.8f - 0.6f * expf(-0.3f * (float)L);
    const float lam = expf(d1) - expf(d2) + lam_init;
    const int gw = bid * NWAVES + w, NGW = nblk * NWAVES;
    for (int it = gw; it < BATCH * 4 * SEQ; it += NGW) {
        const int bh = it & 31, t = it >> 5, hh = bh & 3, b = bh >> 2;
        const size_t row = (size_t)b * SEQ + t;
        const float slope2 = exp2f(-2.f * (float)(hh + 1)) * 1.4426950408889634f;
        if (lane < 16) qs[lane] = ((const u32x4*)(proj + row * PROJ_W + hh * 128))[lane];
        asm volatile("s_waitcnt lgkmcnt(0)" ::: "memory");
        float m1 = -INFINITY, m2 = -INFINITY;
        for (int j = lane; j <= t; j += 64) {
            const u32x4* kp = (const u32x4*)(proj + ((size_t)b * SEQ + j) * PROJ_W + 512 + hh * 128);
            float a1 = 0.f, a2 = 0.f;
#pragma unroll
            for (int c = 0; c < 8; ++c) { a1 = dot8(qs[c], kp[c], a1); a2 = dot8(qs[8 + c], kp[8 + c], a2); }
            const float bias = slope2 * (float)(t - j);
            a1 -= bias; a2 -= bias;
            s1[j] = a1; s2[j] = a2;
            m1 = fmaxf(m1, a1); m2 = fmaxf(m2, a2);
        }
        m1 = wave_max(m1); m2 = wave_max(m2);
        float l1 = 0.f, l2 = 0.f;
        for (int j = lane; j <= t; j += 64) { const float e1 = exp2f(s1[j] - m1), e2 = exp2f(s2[j] - m2); s1[j] = e1; s2[j] = e2; l1 += e1; l2 += e2; }
        l1 = wave_sum(l1); l2 = wave_sum(l2);
        const float i1 = 1.f / l1, i2 = lam / l2;
        for (int j = lane; j <= t; j += 64) s1[j] = s1[j] * i1 - s2[j] * i2;
        asm volatile("s_waitcnt lgkmcnt(0)" ::: "memory");
        float o0 = 0.f, o1 = 0.f;
        const bf16* vp = proj + (size_t)b * SEQ * PROJ_W + 1024 + hh * 128 + 2 * lane;
#pragma unroll 4
        for (int j = 0; j <= t; ++j) { const float wj = s1[j]; const unsigned vv = *(const unsigned*)(vp + (size_t)j * PROJ_W); o0 += wj * lo16(vv); o1 += wj * hi16(vv); }
        const float ss = wave_sum(o0 * o0 + o1 * o1);
        const float r = rsqrtf(ss * (1.f / 128.f) + EPS) * (1.f - lam_init);
        const float* g = p.subln_g + L * 128 + 2 * lane;
        *(unsigned*)(obuf + row * D + hh * 128 + 2 * lane) = pk2(o0 * r * g[0], o1 * r * g[1]);
        asm volatile("s_waitcnt lgkmcnt(0)" ::: "memory");
    }
}

__device__ void phase_gdn_simple(const Params& p, int L, unsigned char* lds, int bid, int nblk) {
    const int tid = tidx(), lane = tid & 63, w = tid >> 6, v = tid & 31, kg = tid >> 5;
    float* raw = (float*)lds;
    float* al = raw + 64 * 288; float* be = al + 64; float* red = be + 64; float* red2 = red + 512;
    const bf16* proj = (const bf16*)(p.ws + WS_PROJ);
    const float* BA = (const float*)(p.ws + WS_BA);
    float* ORAW = (float*)(p.ws + WS_ORAW);
    const float* cw = p.conv_w + (size_t)L * 4 * 1536;
    for (int it = bid; it < 128; it += nblk) {
        const int vq = it & 3, hh = (it >> 2) & 3, b = it >> 4;
        float S[8];
#pragma unroll
        for (int i = 0; i < 8; ++i) S[i] = 0.f;
        const float negA = -expf(p.a_log[L * 4 + hh]), dtb = p.dt_bias[L * 4 + hh];
        for (int n = 0; n < 32; ++n) {
            const int t0 = n * 64;
            __syncthreads();
            for (int idx = tid; idx < 64 * 288; idx += NTHREADS) {
                const int tok = idx / 288, ch = idx % 288;
                int col;
                if (ch < 128) col = hh * 128 + ch; else if (ch < 256) col = 512 + hh * 128 + (ch - 128); else col = 1024 + hh * 128 + vq * 32 + (ch - 256);
                const int t = t0 + tok;
                float y = 0.f;
#pragma unroll
                for (int j = 0; j < 4; ++j) { const int tt = t - 3 + j; if (tt >= 0) y += bf2f(proj[((size_t)b * SEQ + tt) * PROJ_W + 1536 + col]) * cw[j * 1536 + col]; }
                y = y * sigmoidf_(y);
                raw[tok * 288 + ch] = y;
            }
            if (tid < 64) {
                const size_t row = (size_t)b * SEQ + t0 + tid;
                const float bb = BA[row * 8 + hh], aa = BA[row * 8 + 4 + hh] + dtb;
                be[tid] = sigmoidf_(bb);
                const float sp = aa > 20.f ? aa : log1pf(expf(aa));
                al[tid] = expf(negA * sp);
            }
            __syncthreads();
            for (int pr = w; pr < 128; pr += NWAVES) {
                const int tok = pr >> 1, which = pr & 1; float* r = raw + tok * 288 + which * 128;
                const float a0 = r[lane], a1 = r[lane + 64];
                const float ss = wave_sum(a0 * a0 + a1 * a1);
                const float sc = rsqrtf(ss + EPS) * (which == 0 ? 0.08838834764831845f : 1.f);
                r[lane] = a0 * sc; r[lane + 64] = a1 * sc;
            }
            __syncthreads();
            for (int tok = 0; tok < 64; ++tok) {
                const float a = al[tok], bt = be[tok];
                const float* qk = raw + tok * 288;
                float pr = 0.f;
#pragma unroll
                for (int i = 0; i < 8; ++i) { S[i] *= a; pr += qk[128 + kg * 8 + i] * S[i]; }
                red[kg * 32 + v] = pr;
                __syncthreads();
                float r = 0.f;
#pragma unroll
                for (int g2 = 0; g2 < 16; ++g2) r += red[g2 * 32 + v];
                const float dv = bt * (qk[256 + v] - r);
                float po = 0.f;
#pragma unroll
                for (int i = 0; i < 8; ++i) { S[i] += qk[128 + kg * 8 + i] * dv; po += qk[kg * 8 + i] * S[i]; }
                red2[kg * 32 + v] = po;
                __syncthreads();
                if (kg == 0) {
                    float o = 0.f;
#pragma unroll
                    for (int g2 = 0; g2 < 16; ++g2) o += red2[g2 * 32 + v];
                    ORAW[((size_t)b * SEQ + t0 + tok) * 512 + hh * 128 + vq * 32 + v] = o;
                }
            }
        }
    }
    __syncthreads();
}
__device__ void phase_gdn_finish(const Params& p, int L, int bid, int nblk) {
    const int tid = tidx(), lane = tid & 63, gw = bid * NWAVES + (tid >> 6), NGW = nblk * NWAVES;
    const float* ORAW = (const float*)(p.ws + WS_ORAW);
    const bf16* proj = (const bf16*)(p.ws + WS_PROJ);
    bf16* obuf = (bf16*)(p.ws + WS_OBUF);
    for (int it = gw; it < M * 4; it += NGW) {
        const int hh = it & 3; const size_t row = it >> 2;
        const float o0 = ORAW[row * 512 + hh * 128 + 2 * lane], o1 = ORAW[row * 512 + hh * 128 + 2 * lane + 1];
        const float ss = wave_sum(o0 * o0 + o1 * o1);
        const float r = rsqrtf(ss * (1.f / 128.f) + EPS);
        const unsigned zz = *(const unsigned*)(proj + row * PROJ_W + 3072 + hh * 128 + 2 * lane);
        const float z0 = lo16(zz), z1 = hi16(zz);
        const float* g = p.gdn_norm_g + L * 128 + 2 * lane;
        *(unsigned*)(obuf + row * D + 512 + hh * 128 + 2 * lane) = pk2(o0 * r * g[0] * (z0 * sigmoidf_(z0)), o1 * r * g[1] * (z1 * sigmoidf_(z1)));
    }
}

__device__ void phase_peer_select_simple(const Params& p, int L, int bid, int nblk) {
    const int tid = tidx(), lane = tid & 63, gw = bid * NWAVES + (tid >> 6), NGW = nblk * NWAVES;
    const bf16* Q2 = (const bf16*)(p.ws + WS_Q2);
    const bf16* SK = (const bf16*)(p.ws + WS_SK);
    int* IDX = (int*)(p.ws + WS_IDX); float* GATE = (float*)(p.ws + WS_GATE);
    for (int it = gw; it < M * 8; it += NGW) {
        const int tok = it >> 3, hh = it & 7;
        float tv[2]; int ti[2];
#pragma unroll
        for (int c = 0; c < 2; ++c) {
            const u32x4* qp = (const u32x4*)(Q2 + (size_t)tok * 2048 + hh * 256 + c * 128);
            const u32x4* ka = (const u32x4*)(SK + ((((size_t)L * 8 + hh) * 2 + c) * 128 + lane) * 128);
            const u32x4* kb = ka + 64 * 16;
            float sa = 0.f, sb = 0.f;
#pragma unroll
            for (int ch = 0; ch < 16; ++ch) { const u32x4 q = qp[ch]; sa = dot8(q, ka[ch], sa); sb = dot8(q, kb[ch], sb); }
            float myv = 0.f; int myi = 0;
            for (int r = 0; r < 16; ++r) {
                const float m = wave_max(fmaxf(sa, sb));
                const unsigned long long ba = __ballot(sa == m);
                int win;
                if (ba) { const int ln = __ffsll((long long)ba) - 1; win = ln; if (lane == ln) sa = -INFINITY; }
                else { const unsigned long long bb = __ballot(sb == m); const int ln = __ffsll((long long)bb) - 1; win = 64 + ln; if (lane == ln) sb = -INFINITY; }
                if (lane == r) { myv = m; myi = win; }
            }
            tv[c] = myv; ti[c] = myi;
        }
        float cv[4];
#pragma unroll
        for (int q4 = 0; q4 < 4; ++q4) { const int pp = lane + 64 * q4; cv[q4] = __shfl(tv[0], pp >> 4) + __shfl(tv[1], pp & 15); }
        float gv = 0.f; int gp = 0;
        for (int r = 0; r < 16; ++r) {
            const float m = wave_max(fmaxf(fmaxf(cv[0], cv[1]), fmaxf(cv[2], cv[3])));
            int win = -1;
#pragma unroll
            for (int q4 = 0; q4 < 4; ++q4) {
                const unsigned long long bq = __ballot(cv[q4] == m);
                if (win < 0 && bq) { const int ln = __ffsll((long long)bq) - 1; win = ln + 64 * q4; if (lane == ln) cv[q4] = -INFINITY; }
            }
            if (lane == r) { gv = m; gp = win; }
        }
        const float m0 = __shfl(gv, 0);
        const float e = lane < 16 ? expf(gv - m0) : 0.f;
        const float sum = wave_sum(e);
        const int ia = __shfl(ti[0], gp >> 4), ib = __shfl(ti[1], gp & 15);
        if (lane < 16) { IDX[(size_t)tok * 128 + hh * 16 + lane] = ia * 128 + ib; GATE[(size_t)tok * 128 + hh * 16 + lane] = e / sum; }
    }
}

__device__ void phase_peer_gather(const Params& p, int L, int bid, int nblk) {
    const int tid = tidx(), lane = tid & 63, gw = bid * NWAVES + (tid >> 6), NGW = nblk * NWAVES;
    float* H = (float*)(p.ws + WS_H); bf16* HB2 = (bf16*)(p.ws + WS_HB2);
    const int* IDX = (const int*)(p.ws + WS_IDX); const float* GATE = (const float*)(p.ws + WS_GATE);
    const bf16* U = (const bf16*)(p.ws + WS_U) + (size_t)L * NEXP * D;
    const bf16* V = (const bf16*)(p.ws + WS_V) + (size_t)L * NEXP * D;
    const float* g = p.ln_ffn_g + L * D;
    for (int tok = gw; tok < M; tok += NGW) {
        float* hrow = H + (size_t)tok * D;
        float xv[16];
        {
            const f32x4 a0 = *(const f32x4*)(hrow + 8 * lane), a1 = *(const f32x4*)(hrow + 8 * lane + 4), b0 = *(const f32x4*)(hrow + 512 + 8 * lane), b1 = *(const f32x4*)(hrow + 512 + 8 * lane + 4);
#pragma unroll
            for (int i = 0; i < 4; ++i) { xv[i] = a0[i]; xv[4 + i] = a1[i]; xv[8 + i] = b0[i]; xv[12 + i] = b1[i]; }
        }
        float ss = 0.f;
#pragma unroll
        for (int i = 0; i < 16; ++i) ss += xv[i] * xv[i];
        ss = wave_sum(ss);
        const float rstd = rsqrtf(ss * (1.f / D) + EPS);
        float xn[16];
#pragma unroll
        for (int i = 0; i < 8; ++i) { xn[i] = xv[i] * rstd * g[8 * lane + i]; xn[8 + i] = xv[8 + i] * rstd * g[512 + 8 * lane + i]; }
        const int id0 = IDX[(size_t)tok * 128 + lane], id1 = IDX[(size_t)tok * 128 + 64 + lane];
        const float g0 = GATE[(size_t)tok * 128 + lane], g1 = GATE[(size_t)tok * 128 + 64 + lane];
        float w0 = 0.f, w1 = 0.f;
#pragma unroll 4
        for (int e = 0; e < 128; ++e) {
            const int id = __shfl(e < 64 ? id0 : id1, e & 63);
            const bf16* ur = U + (size_t)id * D;
            const u32x4 a = *(const u32x4*)(ur + 8 * lane), b = *(const u32x4*)(ur + 512 + 8 * lane);
            float d = 0.f;
#pragma unroll
            for (int i = 0; i < 4; ++i) { d += xn[2 * i] * lo16(a[i]) + xn[2 * i + 1] * hi16(a[i]); d += xn[8 + 2 * i] * lo16(b[i]) + xn[8 + 2 * i + 1] * hi16(b[i]); }
            d = wave_sum(d);
            const float ge = 0.5f * d * (1.f + erff(d * 0.70710678118654752f));
            if (lane == (e & 63)) { if (e < 64) w0 = g0 * ge; else w1 = g1 * ge; }
        }
        float y[16];
#pragma unroll
        for (int i = 0; i < 16; ++i) y[i] = 0.f;
#pragma unroll 4
        for (int e = 0; e < 128; ++e) {
            const int id = __shfl(e < 64 ? id0 : id1, e & 63);
            const float ww = __shfl(e < 64 ? w0 : w1, e & 63);
            const bf16* vr = V + (size_t)id * D;
            const u32x4 a = *(const u32x4*)(vr + 8 * lane), b = *(const u32x4*)(vr + 512 + 8 * lane);
#pragma unroll
            for (int i = 0; i < 4; ++i) { y[2 * i] += ww * lo16(a[i]); y[2 * i + 1] += ww * hi16(a[i]); y[8 + 2 * i] += ww * lo16(b[i]); y[8 + 2 * i + 1] += ww * hi16(b[i]); }
        }
#pragma unroll
        for (int i = 0; i < 16; ++i) y[i] += xv[i];
        *(f32x4*)(hrow + 8 * lane) = (f32x4){y[0], y[1], y[2], y[3]};
        *(f32x4*)(hrow + 8 * lane + 4) = (f32x4){y[4], y[5], y[6], y[7]};
        *(f32x4*)(hrow + 512 + 8 * lane) = (f32x4){y[8], y[9], y[10], y[11]};
        *(f32x4*)(hrow + 512 + 8 * lane + 4) = (f32x4){y[12], y[13], y[14], y[15]};
        bf16* hb = HB2 + (size_t)tok * D;
        u32x4 o; o.x = pk2(y[0], y[1]); o.y = pk2(y[2], y[3]); o.z = pk2(y[4], y[5]); o.w = pk2(y[6], y[7]);
        *(u32x4*)(hb + 8 * lane) = o;
        o.x = pk2(y[8], y[9]); o.y = pk2(y[10], y[11]); o.z = pk2(y[12], y[13]); o.w = pk2(y[14], y[15]);
        *(u32x4*)(hb + 512 + 8 * lane) = o;
    }
}

__device__ void phase_final(const Params& p, int bid, int nblk) {
    const int tid = tidx(), lane = tid & 63, gw = bid * NWAVES + (tid >> 6), NGW = nblk * NWAVES;
    const float* H = (const float*)(p.ws + WS_H); const float* rstd0 = (const float*)(p.ws + WS_STAT);
    for (int m = gw; m < M; m += NGW) {
        const float r = rstd0[m];
#pragma unroll
        for (int j = 0; j < 4; ++j) {
            const f32x4 v = ((const f32x4*)(H + (size_t)m * D))[lane + 64 * j];
            const f32x4 gv = ((const f32x4*)p.final_g)[lane + 64 * j];
            ((f32x4*)(p.out + (size_t)m * D))[lane + 64 * j] = v * r * gv;
        }
    }
}

#define LAS __attribute__((address_space(3)))
#define XB_TMO      128
#define XB_XCNT(j)  (256  + 64 * (j))
#define XB_XSUB(j)  (1280 + 64 * (j))
#define XB_XGEN(j)  (2304 + 64 * (j))
#define XB_TOP      3328
#define XB_TOPGEN   3392
#define XCD_BAR_WORDS 3456
#define XB_SPIN_CAP (1u << 22)
__device__ __forceinline__ unsigned xb_ld(unsigned* p)              { return __hip_atomic_load(p, __ATOMIC_RELAXED, __HIP_MEMORY_SCOPE_AGENT); }
__device__ __forceinline__ unsigned xb_add(unsigned* p, unsigned v) { return __hip_atomic_fetch_add(p, v, __ATOMIC_RELAXED, __HIP_MEMORY_SCOPE_AGENT); }
__device__ __forceinline__ unsigned xb_xcc_id() { return (unsigned)__builtin_amdgcn_s_getreg((3 << 11) | 20) & 0xFu; }
#define XB_SPIN(cond, bar) do { unsigned _sp = 0; while (cond) { __builtin_amdgcn_s_sleep(1); \
    if ((++_sp & 255u) == 0u) { if (xb_ld(&(bar)[XB_TMO])) break; if (_sp > XB_SPIN_CAP) { atomicAdd(&(bar)[XB_TMO], 1u); break; } } } } while (0)
struct XcdBarrier { unsigned* bar; unsigned x; volatile LAS unsigned* st; };
__device__ __forceinline__ XcdBarrier xcd_barrier_post(unsigned* bar, volatile LAS unsigned* st) {
    XcdBarrier b; b.bar = bar; b.x = xb_xcc_id(); b.st = st;
    if (threadIdx.x == 0) (void)xb_add(&bar[XB_XCNT(b.x)], 1u);
    return b;
}
__device__ __forceinline__ void xcd_barrier_complete(unsigned* bar, unsigned x, unsigned& nloc, unsigned& nx) {
    const unsigned G = gridDim.x * gridDim.y * gridDim.z;
    unsigned sum, cnt, mine, sp = 0u;
    for (;;) {
        sum = 0u; cnt = 0u; mine = 0u;
#pragma unroll
        for (unsigned j = 0; j < 16; ++j) { const unsigned c = xb_ld(&bar[XB_XCNT(j)]); sum += c; cnt += (c > 0u) ? 1u : 0u; mine = (j == x) ? c : mine; }
        if (sum == G) break;
        __builtin_amdgcn_s_sleep(1);
        if ((++sp & 255u) == 0u) { if (xb_ld(&bar[XB_TMO])) break; if (sp > XB_SPIN_CAP) { atomicAdd(&bar[XB_TMO], 1u); break; } }
    }
    nloc = mine > 0u ? mine : 1u; nx = cnt > 0u ? cnt : 1u;
}
__device__ __forceinline__ void xcd_barrier(const XcdBarrier& b) {
    asm volatile("s_waitcnt vmcnt(0)" ::: "memory");
    __syncthreads();
    if (threadIdx.x == 0) {
        unsigned* bar = b.bar;
        __builtin_amdgcn_s_waitcnt(0);
        unsigned nloc = b.st[0], nx = b.st[1];
        if (nloc == 0u) { xcd_barrier_complete(bar, b.x, nloc, nx); b.st[0] = nloc; b.st[1] = nx; }
        const unsigned old = xb_add(&bar[XB_XSUB(b.x)], 1u);
        const unsigned gen = old / nloc;
        if (old + 1u == (gen + 1u) * nloc) {
            __builtin_amdgcn_fence(__ATOMIC_RELEASE, "agent");
            asm volatile("s_waitcnt vmcnt(0)" ::: "memory");
            const unsigned og = xb_add(&bar[XB_TOP], 1u);
            const unsigned tg = og / nx;
            if (og + 1u == (tg + 1u) * nx) xb_add(&bar[XB_TOPGEN], 1u);
            else XB_SPIN(xb_ld(&bar[XB_TOPGEN]) == tg, bar);
            __builtin_amdgcn_fence(__ATOMIC_ACQUIRE, "agent");
            xb_add(&bar[XB_XGEN(b.x)], 1u);
            asm volatile("s_waitcnt vmcnt(0)" ::: "memory");
        } else {
            XB_SPIN(xb_ld(&bar[XB_XGEN(b.x)]) == gen, bar);
            __builtin_amdgcn_fence(__ATOMIC_ACQUIRE, "agent");
            asm volatile("s_waitcnt vmcnt(0)" ::: "memory");
        }
    }
    __syncthreads();
}
constexpr int CW_BAR = 4096;
constexpr int LDS_MISC_OFF = LDS_BYTES - 256;

constexpr int NS = 11;
constexpr int K_PROLOGUE = 11, K_FINAL = 12;
template <int KIND>
__device__ __forceinline__ void run_kind(const Params& p, int L, unsigned char* lds, int bid, int nblk) {
    unsigned char* ws = p.ws;
    float* H = (float*)(ws + WS_H);
    float* rstd0 = (float*)(ws + WS_STAT); float* rstd1 = rstd0 + M; float* rstde = rstd1 + M;
    if constexpr (KIND == K_PROLOGUE) phase_prologue(p, lds, bid, nblk);
    if constexpr (KIND == K_FINAL) phase_final(p, bid, nblk);
    if constexpr (KIND == 0) { EpiProj E{(bf16*)(ws + WS_PROJ), (float*)(ws + WS_BA), rstd0};
        gemm_simple(lds, (const bf16*)(ws + WS_HB0), (const bf16*)(ws + WS_WIN) + (size_t)L * IN_PAD * D, M, IN_PAD, D, E, bid, nblk); }
    if constexpr (KIND == 1) phase_att_simple(p, L, lds, bid, nblk);
    if constexpr (KIND == 2) phase_gdn_simple(p, L, lds, bid, nblk);
    if constexpr (KIND == 3) phase_gdn_finish(p, L, bid, nblk);
    if constexpr (KIND == 4) { EpiRes E{H, (bf16*)(ws + WS_HB1)};
        gemm_simple(lds, (const bf16*)(ws + WS_OBUF), (const bf16*)(ws + WS_WOUT) + (size_t)L * D * D, M, D, D, E, bid, nblk); }
    if constexpr (KIND == 5) phase_rowstat_f32(H, rstd1, bid, nblk);
    if constexpr (KIND == 6) { EpiQ2 E{(bf16*)(ws + WS_Q2), rstd1};
        gemm_simple(lds, (const bf16*)(ws + WS_HB1), (const bf16*)(ws + WS_WQ) + (size_t)L * 2048 * D, M, 2048, D, E, bid, nblk);
        EpiE E2{(bf16*)(ws + WS_EPRE)};
        gemm_simple(lds, (const bf16*)(ws + WS_PB) + (size_t)L * M * 256, (const bf16*)(ws + WS_WP) + (size_t)L * D * 256, M, D, 256, E2, bid, nblk); }
    if constexpr (KIND == 7) { phase_rowstat_bf16((const bf16*)(ws + WS_EPRE), rstde, bid, nblk); phase_peer_select_simple(p, L, bid, nblk); }
    if constexpr (KIND == 8) phase_peer_gather(p, L, bid, nblk);
    if constexpr (KIND == 9) { EpiPle E{H, (bf16*)(ws + WS_HB0), (const bf16*)(ws + WS_EPRE), rstde, p.ple_norm_g + L * D};
        gemm_simple(lds, (const bf16*)(ws + WS_HB2), (const bf16*)(ws + WS_WG) + (size_t)L * D * D, M, D, D, E, bid, nblk); }
    if constexpr (KIND == 10) phase_rowstat_f32(H, rstd0, bid, nblk);
}

#define RUN(KIND) do { unsigned char* ws_ = p.ws; int L_ = L; asm volatile("" : "+s"(ws_), "+s"(L_)); Params q = p; q.ws = ws_; run_kind<KIND>(q, L_, lds, bid, nblk); } while (0)
__global__ void __launch_bounds__(NTHREADS, 2) mk_fwd(Params p) {
    extern __shared__ __attribute__((aligned(16))) unsigned char lds[];
    const int bid = (int)blockIdx.x, nblk = (int)gridDim.x;
    volatile LAS unsigned* misc = (volatile LAS unsigned*)((LAS unsigned char*)lds + LDS_MISC_OFF);
    if (threadIdx.x < 64) misc[threadIdx.x] = 0u;
    __syncthreads();
    XcdBarrier bar = xcd_barrier_post((unsigned*)(p.ws + WS_CTL) + CW_BAR, misc + 8);
    { int L = 0; RUN(K_PROLOGUE); }
    cg::this_grid().sync();
#pragma nounroll
    for (int L = 0; L < DEPTH; ++L) {
        RUN(0); xcd_barrier(bar);
        RUN(1); xcd_barrier(bar);
        RUN(2); xcd_barrier(bar);
        RUN(3); xcd_barrier(bar);
        RUN(4); xcd_barrier(bar);
        RUN(5); xcd_barrier(bar);
        RUN(6); xcd_barrier(bar);
        RUN(7); xcd_barrier(bar);
        RUN(8); xcd_barrier(bar);
        RUN(9); xcd_barrier(bar);
        RUN(10); xcd_barrier(bar);
    }
    { int L = 0; RUN(K_FINAL); }
}

extern "C" void kernel_launch(void* const* d_in, const int* in_sizes, int n_in, void* d_out, int out_size, void* d_ws, size_t ws_size, hipStream_t stream) {
    static int grid = 0;
    if (grid == 0) {
        if (n_in != 20 || out_size != M * D || ws_size < WS_END) { fprintf(stderr, "kernel_launch: unexpected shapes (n_in %d, out %d, ws %zu < %zu)\n", n_in, out_size, ws_size, (size_t)WS_END); grid = -1; return; }
        int dev = 0, cus = 0, per_cu = 0;
        (void)hipGetDevice(&dev); (void)hipDeviceGetAttribute(&cus, hipDeviceAttributeMultiprocessorCount, dev);
        if (hipFuncSetAttribute((const void*)mk_fwd, hipFuncAttributeMaxDynamicSharedMemorySize, LDS_BYTES) != hipSuccess) { fprintf(stderr, "kernel_launch: hipFuncSetAttribute failed\n"); grid = -1; return; }
        if (hipOccupancyMaxActiveBlocksPerMultiprocessor(&per_cu, (const void*)mk_fwd, NTHREADS, LDS_BYTES) != hipSuccess || per_cu < 1) { fprintf(stderr, "kernel_launch: occupancy query says %d blocks per CU\n", per_cu); (void)hipGetLastError(); grid = -1; return; }
        grid = (cus > 0 ? cus : 256);
    }
    if (grid < 0) return;
    (void)hipMemsetAsync((char*)d_ws + WS_CTL, 0, CTL_ZERO_BYTES, stream);
    Params p{};
    const float** pp = (const float**)&p;
    for (int i = 0; i < 20; ++i) pp[i] = (const float*)d_in[i];
    p.out = (float*)d_out; p.ws = (unsigned char*)d_ws;
    void* args[] = {&p};
    hipError_t e = hipLaunchCooperativeKernel((const void*)mk_fwd, dim3(grid), dim3(NTHREADS), args, LDS_BYTES, stream);
    if (e != hipSuccess) fprintf(stderr, "kernel_launch: cooperative launch failed: %s (grid %d)\n", hipGetErrorString(e), grid);
}
```

```cpp
#include <hip/hip_runtime.h>
#include <hip/hip_cooperative_groups.h>
#include <cstdio>
#include <cstdint>
namespace cg = cooperative_groups;

typedef unsigned short bf16;
typedef float f32x4 __attribute__((ext_vector_type(4)));
typedef short bf16x8 __attribute__((ext_vector_type(8)));
typedef unsigned u32x4 __attribute__((ext_vector_type(4)));
typedef unsigned u32x2 __attribute__((ext_vector_type(2)));

constexpr int D = 1024, BATCH = 8, SEQ = 2048, DEPTH = 4, M = BATCH * SEQ;
constexpr int IN_COLS = 3592, IN_PAD = 3840, PROJ_W = 3584;
constexpr int NEXP = 16384;
constexpr float EPS = 1e-6f;
constexpr float QSCALE = 0.125f * 1.4426950408889634f;
constexpr int NWAVES = 8, NTHREADS = 512;
constexpr int LDS_BYTES = 147456;

constexpr size_t MiB = 1u << 20;
constexpr size_t WS_CTL = 0, CTL_ZERO_BYTES = 1 * MiB;
constexpr size_t WS_H = 1 * MiB;
constexpr size_t WS_HB0 = 65 * MiB;
constexpr size_t WS_HB1 = 97 * MiB;
constexpr size_t WS_HB2 = 129 * MiB;
constexpr size_t WS_PROJ = 161 * MiB;
constexpr size_t WS_BA = 273 * MiB;
constexpr size_t WS_OBUF = 274 * MiB;
constexpr size_t WS_Q2 = 306 * MiB;
constexpr size_t WS_EPRE = 370 * MiB;
constexpr size_t WS_IDX = 402 * MiB;
constexpr size_t WS_GATE = 410 * MiB;
constexpr size_t WS_STAT = 418 * MiB;
constexpr size_t WS_ORAW = 422 * MiB;
constexpr size_t WS_WIN = 550 * MiB;
constexpr size_t WS_WOUT = 582 * MiB;
constexpr size_t WS_WQ = 590 * MiB;
constexpr size_t WS_WG = 606 * MiB;
constexpr size_t WS_WP = 614 * MiB;
constexpr size_t WS_SK = 616 * MiB;
constexpr size_t WS_PB = 618 * MiB;
constexpr size_t WS_U = 650 * MiB;
constexpr size_t WS_V = 778 * MiB;
constexpr size_t WS_END = 906 * MiB;

struct Params {
    const float *x, *p, *ln_mix_g, *w_in, *conv_w, *a_log, *dt_bias, *gdn_norm_g, *diff_lambda, *subln_g, *w_out, *ln_ffn_g,
        *peer_wq, *subkeys, *peer_u, *peer_v, *ple_wp, *ple_wg, *ple_norm_g, *final_g;
    float* out;
    unsigned char* ws;
    int pad0, pad1;
};

__device__ __forceinline__ int tidx() { int t = (int)threadIdx.x; asm volatile("" : "+v"(t)); return t; }
__device__ __forceinline__ float bf2f(bf16 v) { return __uint_as_float((unsigned)v << 16); }
__device__ __forceinline__ unsigned f2bf(float f) { unsigned u = __float_as_uint(f); return (u + 0x7fffu + ((u >> 16) & 1u)) >> 16; }
__device__ __forceinline__ unsigned pk2(float lo, float hi) { return f2bf(lo) | (f2bf(hi) << 16); }
__device__ __forceinline__ float lo16(unsigned w) { return __uint_as_float(w << 16); }
__device__ __forceinline__ float hi16(unsigned w) { return __uint_as_float(w & 0xffff0000u); }
__device__ __forceinline__ float wave_sum(float v) {
#pragma unroll
    for (int o = 32; o; o >>= 1) v += __shfl_xor(v, o);
    return v;
}
__device__ __forceinline__ float wave_max(float v) {
#pragma unroll
    for (int o = 32; o; o >>= 1) v = fmaxf(v, __shfl_xor(v, o));
    return v;
}
__device__ __forceinline__ float sigmoidf_(float x) { return 1.f / (1.f + __expf(-x)); }
__device__ __forceinline__ float dot8(u32x4 a, u32x4 b, float s) {
#pragma unroll
    for (int i = 0; i < 4; ++i) { s += lo16(a[i]) * lo16(b[i]); s += hi16(a[i]) * hi16(b[i]); }
    return s;
}

#define LAS __attribute__((address_space(3)))
__host__ __device__ __forceinline__ int lds_byte(int r, int c) { const int st = (r >> 4) * 2 + (c >> 5), rr = r & 15, cc = c & 31, ob = rr * 64 + cc * 2; return st * 1024 + (ob ^ (((ob >> 9) & 1) << 5)); }
__host__ __device__ __forceinline__ void stage_rc(int b, int& R, int& C) { const int st = b / 1024, sb = b % 1024, swz = sb ^ (((sb >> 9) & 1) << 5); R = (st >> 1) * 16 + swz / 64; C = (st & 1) * 32 + (swz % 64) / 2; }
constexpr int HTB = 16384;
template <class F>
__device__ __forceinline__ void gemm_run(unsigned char* lds_, const bf16* A, const bf16* Bt, int Mm, int N, int K, const F& f, int bid, int nblk) {
    LAS unsigned char* lds = (LAS unsigned char*)lds_;
    const int tid = tidx(), wid = __builtin_amdgcn_readfirstlane(tid >> 6), lane = tid & 63, wr = wid >> 1, wc = wid & 1, fr = lane & 15, fq = lane >> 4;
    const int nt = K / 64, ntn = N / 128, nunits = (Mm / 256) * ntn;
    unsigned voff[2];
#pragma unroll
    for (int i = 0; i < 2; ++i) { int R, C; stage_rc(tid * 16 + i * 8192, R, C); voff[i] = (unsigned)(R * K + C) * 2u; }
    const unsigned ldsw = (unsigned)wid * 1024u;
    const int aoff = (wr >> 1) * HTB + lds_byte((wr & 1) * 64 + fr, fq * 8), boff = 2 * HTB + lds_byte(wc * 64 + fr, fq * 8);
#define G_STAGE(bufoff, gbase) do { _Pragma("unroll") for (int _i = 0; _i < 2; ++_i) \
        __builtin_amdgcn_global_load_lds((const unsigned*)((const char*)(gbase) + voff[_i]), (LAS unsigned*)(lds + (bufoff) + ldsw + _i * 8192), 16, 0, 0); } while (0)
    for (int u = bid; u < nunits; u += nblk) {
        const int pm = u % (Mm / 256), pn = u / (Mm / 256);
        const char* gA = (const char*)(A + (size_t)pm * 256 * K);
        const char* gB = (const char*)(Bt + (size_t)pn * 128 * K);
        const size_t hstep = (size_t)128 * K * 2;
        f32x4 acc[4][4];
#pragma unroll
        for (int a = 0; a < 4; ++a)
#pragma unroll
            for (int b = 0; b < 4; ++b) acc[a][b] = (f32x4){0.f, 0.f, 0.f, 0.f};
        G_STAGE(0, gA); G_STAGE(HTB, gA + hstep); G_STAGE(2 * HTB, gB);
        for (int t = 0; t < nt; ++t) {
            const int cur = (t & 1) * 3 * HTB, nxt = ((t + 1) & 1) * 3 * HTB;
            asm volatile("s_waitcnt vmcnt(0)" ::: "memory");
            __syncthreads();
            if (t + 1 < nt) { const size_t ko = (size_t)(t + 1) * 128; G_STAGE(nxt, gA + ko); G_STAGE(nxt + HTB, gA + hstep + ko); G_STAGE(nxt + 2 * HTB, gB + ko); }
            bf16x8 af[4][2], bfr[4][2];
#pragma unroll
            for (int m = 0; m < 4; ++m)
#pragma unroll
                for (int k = 0; k < 2; ++k) af[m][k] = *(const LAS bf16x8*)(lds + cur + aoff + m * 2048 + k * 1024);
#pragma unroll
            for (int n = 0; n < 4; ++n)
#pragma unroll
                for (int k = 0; k < 2; ++k) bfr[n][k] = *(const LAS bf16x8*)(lds + cur + boff + n * 2048 + k * 1024);
#pragma unroll
            for (int k = 0; k < 2; ++k)
#pragma unroll
                for (int m = 0; m < 4; ++m)
#pragma unroll
                    for (int n = 0; n < 4; ++n) acc[m][n] = __builtin_amdgcn_mfma_f32_16x16x32_bf16(bfr[n][k], af[m][k], acc[m][n], 0, 0, 0);
        }
#pragma unroll
        for (int m = 0; m < 4; ++m) {
            const int row = pm * 256 + wr * 64 + m * 16 + fr;
#pragma unroll
            for (int n = 0; n < 4; ++n) f(row, pn * 128 + wc * 64 + n * 16 + 4 * fq, acc[m][n]);
        }
        __syncthreads();
    }
#undef G_STAGE
}

__device__ __forceinline__ u32x2 pk4(f32x4 a) { u32x2 o; o.x = pk2(a[0], a[1]); o.y = pk2(a[2], a[3]); return o; }
struct EpiProj {
    bf16* proj; float* ba; const float* rstd;
    __device__ __forceinline__ void operator()(int row, int col, f32x4 v) const {
        v = v * rstd[row];
        if (col < PROJ_W) *(u32x2*)(proj + (size_t)row * PROJ_W + col) = pk4(v);
        else if (col < IN_COLS) *(f32x4*)(ba + (size_t)row * 8 + (col - PROJ_W)) = v;
    }
};
struct EpiRes {
    float* H; bf16* HB;
    __device__ __forceinline__ void operator()(int row, int col, f32x4 v) const {
        f32x4* hp = (f32x4*)(H + (size_t)row * D + col);
        const f32x4 h = *hp + v; *hp = h;
        *(u32x2*)(HB + (size_t)row * D + col) = pk4(h);
    }
};
struct EpiQ2 {
    bf16* Q2; const float* rstd;
    __device__ __forceinline__ void operator()(int row, int col, f32x4 v) const { *(u32x2*)(Q2 + (size_t)row * 2048 + col) = pk4(v * rstd[row]); }
};
struct EpiE {
    bf16* E;
    __device__ __forceinline__ void operator()(int row, int col, f32x4 v) const { *(u32x2*)(E + (size_t)row * D + col) = pk4(v); }
};
struct EpiPle {
    float* H; bf16* HB; const bf16* E; const float* rstde; const float* g;
    __device__ __forceinline__ void operator()(int row, int col, f32x4 v) const {
        f32x4* hp = (f32x4*)(H + (size_t)row * D + col);
        const u32x2 ev = *(const u32x2*)(E + (size_t)row * D + col);
        const f32x4 gv = *(const f32x4*)(g + col);
        const float r = rstde[row];
        f32x4 h = *hp;
        h[0] += sigmoidf_(v[0]) * (lo16(ev.x) * r * gv[0]); h[1] += sigmoidf_(v[1]) * (hi16(ev.x) * r * gv[1]);
        h[2] += sigmoidf_(v[2]) * (lo16(ev.y) * r * gv[2]); h[3] += sigmoidf_(v[3]) * (hi16(ev.y) * r * gv[3]);
        *hp = h;
        *(u32x2*)(HB + (size_t)row * D + col) = pk4(h);
    }
};

__device__ __forceinline__ void transpose_item(const float* W, int K, int N, int Npad, bf16* WT, const float* rowscale, int qcols, float* scr, int item, int lane) {
    const int nblk = Npad / 32, kb = item / nblk, nb = item % nblk, k0 = 64 * kb, n0 = 32 * nb;
    const int n = n0 + (lane & 31);
#pragma unroll 8
    for (int i = 0; i < 32; ++i) {
        const int kk = 2 * i + (lane >> 5);
        float v = (n < N) ? W[(size_t)(k0 + kk) * N + n] : 0.f;
        if (rowscale) v *= rowscale[k0 + kk];
        if (n < qcols) v *= QSCALE;
        scr[kk * 33 + (lane & 31)] = v;
    }
    asm volatile("s_waitcnt lgkmcnt(0)" ::: "memory");
    const int c = lane & 7;
#pragma unroll
    for (int j = 0; j < 4; ++j) {
        const int nn = (lane >> 3) + 8 * j; const float* s = scr + (8 * c) * 33 + nn;
        u32x4 o; o.x = pk2(s[0 * 33], s[1 * 33]); o.y = pk2(s[2 * 33], s[3 * 33]); o.z = pk2(s[4 * 33], s[5 * 33]); o.w = pk2(s[6 * 33], s[7 * 33]);
        *(u32x4*)(WT + (size_t)(n0 + nn) * K + k0 + 8 * c) = o;
    }
    asm volatile("s_waitcnt lgkmcnt(0)" ::: "memory");
}
__device__ __forceinline__ void convert_bulk(const float* src, bf16* dst, size_t n, size_t gtid, size_t nthr) {
    for (size_t i = gtid * 8; i < n; i += nthr * 8) {
        const f32x4 a = *(const f32x4*)(src + i), b = *(const f32x4*)(src + i + 4);
        u32x4 o; o.x = pk2(a[0], a[1]); o.y = pk2(a[2], a[3]); o.z = pk2(b[0], b[1]); o.w = pk2(b[2], b[3]);
        *(u32x4*)(dst + i) = o;
    }
}
__device__ void phase_prologue(const Params& p, unsigned char* lds, int bid, int nblk) {
    const int tid = tidx(), lane = tid & 63, w = tid >> 6;
    const int gw = bid * NWAVES + w, NGW = nblk * NWAVES;
    float* scr = (float*)(lds + w * 16384);
    constexpr int I_IN = 16 * (IN_PAD / 32), I_OUT = 16 * 32, I_Q = 16 * 64, I_G = 16 * 32, I_P = 4 * 32, I_L = I_IN + I_OUT + I_Q + I_G + I_P;
    for (int it = gw; it < DEPTH * I_L; it += NGW) {
        const int L = it / I_L; int r = it % I_L;
        if (r < I_IN) { transpose_item(p.w_in + (size_t)L * D * IN_COLS, D, IN_COLS, IN_PAD, (bf16*)(p.ws + WS_WIN) + (size_t)L * IN_PAD * D, p.ln_mix_g + L * D, 512, scr, r, lane); continue; } r -= I_IN;
        if (r < I_OUT) { transpose_item(p.w_out + (size_t)L * D * D, D, D, D, (bf16*)(p.ws + WS_WOUT) + (size_t)L * D * D, nullptr, 0, scr, r, lane); continue; } r -= I_OUT;
        if (r < I_Q) { transpose_item(p.peer_wq + (size_t)L * D * 2048, D, 2048, 2048, (bf16*)(p.ws + WS_WQ) + (size_t)L * 2048 * D, p.ln_ffn_g + L * D, 0, scr, r, lane); continue; } r -= I_Q;
        if (r < I_G) { transpose_item(p.ple_wg + (size_t)L * D * D, D, D, D, (bf16*)(p.ws + WS_WG) + (size_t)L * D * D, nullptr, 0, scr, r, lane); continue; } r -= I_G;
        transpose_item(p.ple_wp + (size_t)L * 256 * D, 256, D, D, (bf16*)(p.ws + WS_WP) + (size_t)L * D * 256, nullptr, 0, scr, r, lane);
    }
    const size_t gtid = (size_t)bid * NTHREADS + tid, nthr = (size_t)nblk * NTHREADS;
    convert_bulk(p.peer_u, (bf16*)(p.ws + WS_U), (size_t)DEPTH * NEXP * D, gtid, nthr);
    convert_bulk(p.peer_v, (bf16*)(p.ws + WS_V), (size_t)DEPTH * NEXP * D, gtid, nthr);
    convert_bulk(p.p, (bf16*)(p.ws + WS_PB), (size_t)DEPTH * M * 256, gtid, nthr);
    convert_bulk(p.subkeys, (bf16*)(p.ws + WS_SK), (size_t)DEPTH * 8 * 2 * 128 * 128, gtid, nthr);
    float* H = (float*)(p.ws + WS_H); bf16* HB0 = (bf16*)(p.ws + WS_HB0); float* rstd0 = (float*)(p.ws + WS_STAT);
    for (int m = gw; m < M; m += NGW) {
        const f32x4* xr = (const f32x4*)(p.x + (size_t)m * D) + lane;
        float ss = 0.f;
#pragma unroll
        for (int j = 0; j < 4; ++j) {
            const f32x4 v = xr[64 * j];
            ss += v[0] * v[0] + v[1] * v[1] + v[2] * v[2] + v[3] * v[3];
            ((f32x4*)(H + (size_t)m * D))[lane + 64 * j] = v;
            u32x2 o; o.x = pk2(v[0], v[1]); o.y = pk2(v[2], v[3]);
            ((u32x2*)(HB0 + (size_t)m * D))[lane + 64 * j] = o;
        }
        ss = wave_sum(ss);
        if (lane == 0) rstd0[m] = rsqrtf(ss * (1.f / D) + EPS);
    }
}

__device__ void phase_rowstat_f32(const float* src, float* rstd, int bid, int nblk) {
    const int tid = tidx(), lane = tid & 63, gw = bid * NWAVES + (tid >> 6), NGW = nblk * NWAVES;
    for (int m = gw; m < M; m += NGW) {
        const f32x4* xr = (const f32x4*)(src + (size_t)m * D) + lane;
        float ss = 0.f;
#pragma unroll
        for (int j = 0; j < 4; ++j) { const f32x4 v = xr[64 * j]; ss += v[0] * v[0] + v[1] * v[1] + v[2] * v[2] + v[3] * v[3]; }
        ss = wave_sum(ss);
        if (lane == 0) rstd[m] = rsqrtf(ss * (1.f / D) + EPS);
    }
}
__device__ void phase_rowstat_bf16(const bf16* src, float* rstd, int bid, int nblk) {
    const int tid = tidx(), lane = tid & 63, gw = bid * NWAVES + (tid >> 6), NGW = nblk * NWAVES;
    for (int m = gw; m < M; m += NGW) {
        const u32x4* xr = (const u32x4*)(src + (size_t)m * D) + lane;
        float ss = 0.f;
#pragma unroll
        for (int j = 0; j < 2; ++j) { const u32x4 v = xr[64 * j];
#pragma unroll
            for (int i = 0; i < 4; ++i) { const float a = lo16(v[i]), b = hi16(v[i]); ss += a * a + b * b; } }
        ss = wave_sum(ss);
        if (lane == 0) rstd[m] = rsqrtf(ss * (1.f / D) + EPS);
    }
}

__device__ void phase_att_simple(const Params& p, int L, unsigned char* lds, int bid, int nblk) {
    const int tid = tidx(), lane = tid & 63, w = tid >> 6;
    float* s1 = (float*)lds + w * 4096; float* s2 = s1 + 2048;
    u32x4* qs = (u32x4*)(lds + 131072) + w * 16;
    const bf16* proj = (const bf16*)(p.ws + WS_PROJ);
    bf16* obuf = (bf16*)(p.ws + WS_OBUF);
    const float* lp = p.diff_lambda + L * 256;
    const float d1 = wave_sum(lp[lane] * lp[64 + lane]), d2 = wave_sum(lp[128 + lane] * lp[192 + lane]);
    const float lam_init = 0.8f - 0.6f * expf(-0.3f * (float)L);
    const float lam = expf(d1) - expf(d2) + lam_init;
    const int gw = bid * NWAVES + w, NGW = nblk * NWAVES;
    for (int it = gw; it < BATCH * 4 * SEQ; it += NGW) {
        const int bh = it & 31, t = it >> 5, hh = bh & 3, b = bh >> 2;
        const size_t row = (size_t)b * SEQ + t;
        const float slope2 = exp2f(-2.f * (float)(hh + 1)) * 1.4426950408889634f;
        if (lane < 16) qs[lane] = ((const u32x4*)(proj + row * PROJ_W + hh * 128))[lane];
        asm volatile("s_waitcnt lgkmcnt(0)" ::: "memory");
        float m1 = -INFINITY, m2 = -INFINITY;
        for (int j = lane; j <= t; j += 64) {
            const u32x4* kp = (const u32x4*)(proj + ((size_t)b * SEQ + j) * PROJ_W + 512 + hh * 128);
            float a1 = 0.f, a2 = 0.f;
#pragma unroll
            for (int c = 0; c < 8; ++c) { a1 = dot8(qs[c], kp[c], a1); a2 = dot8(qs[8 + c], kp[8 + c], a2); }
            const float bias = slope2 * (float)(t - j);
            a1 -= bias; a2 -= bias;
            s1[j] = a1; s2[j] = a2;
            m1 = fmaxf(m1, a1); m2 = fmaxf(m2, a2);
        }
        m1 = wave_max(m1); m2 = wave_max(m2);
        float l1 = 0.f, l2 = 0.f;
        for (int j = lane; j <= t; j += 64) { const float e1 = exp2f(s1[j] - m1), e2 = exp2f(s2[j] - m2); s1[j] = e1; s2[j] = e2; l1 += e1; l2 += e2; }
        l1 = wave_sum(l1); l2 = wave_sum(l2);
        const float i1 = 1.f / l1, i2 = lam / l2;
        for (int j = lane; j <= t; j += 64) s1[j] = s1[j] * i1 - s2[j] * i2;
        asm volatile("s_waitcnt lgkmcnt(0)" ::: "memory");
        float o0 = 0.f, o1 = 0.f;
        const bf16* vp = proj + (size_t)b * SEQ * PROJ_W + 1024 + hh * 128 + 2 * lane;
#pragma unroll 4
        for (int j = 0; j <= t; ++j) { const float wj = s1[j]; const unsigned vv = *(const unsigned*)(vp + (size_t)j * PROJ_W); o0 += wj * lo16(vv); o1 += wj * hi16(vv); }
        const float ss = wave_sum(o0 * o0 + o1 * o1);
        const float r = rsqrtf(ss * (1.f / 128.f) + EPS) * (1.f - lam_init);
        const float* g = p.subln_g + L * 128 + 2 * lane;
        *(unsigned*)(obuf + row * D + hh * 128 + 2 * lane) = pk2(o0 * r * g[0], o1 * r * g[1]);
        asm volatile("s_waitcnt lgkmcnt(0)" ::: "memory");
    }
}

__device__ void phase_gdn_simple(const Params& p, int L, unsigned char* lds, int bid, int nblk) {
    const int tid = tidx(), lane = tid & 63, w = tid >> 6, v = tid & 31, kg = tid >> 5;
    float* raw = (float*)lds;
    float* al = raw + 64 * 288; float* be = al + 64; float* red = be + 64; float* red2 = red + 512;
    const bf16* proj = (const bf16*)(p.ws + WS_PROJ);
    const float* BA = (const float*)(p.ws + WS_BA);
    float* ORAW = (float*)(p.ws + WS_ORAW);
    const float* cw = p.conv_w + (size_t)L * 4 * 1536;
    for (int it = bid; it < 128; it += nblk) {
        const int vq = it & 3, hh = (it >> 2) & 3, b = it >> 4;
        float S[8];
#pragma unroll
        for (int i = 0; i < 8; ++i) S[i] = 0.f;
        const float negA = -expf(p.a_log[L * 4 + hh]), dtb = p.dt_bias[L * 4 + hh];
        for (int n = 0; n < 32; ++n) {
            const int t0 = n * 64;
            __syncthreads();
            for (int idx = tid; idx < 64 * 288; idx += NTHREADS) {
                const int tok = idx / 288, ch = idx % 288;
                int col;
                if (ch < 128) col = hh * 128 + ch; else if (ch < 256) col = 512 + hh * 128 + (ch - 128); else col = 1024 + hh * 128 + vq * 32 + (ch - 256);
                const int t = t0 + tok;
                float y = 0.f;
#pragma unroll
                for (int j = 0; j < 4; ++j) { const int tt = t - 3 + j; if (tt >= 0) y += bf2f(proj[((size_t)b * SEQ + tt) * PROJ_W + 1536 + col]) * cw[j * 1536 + col]; }
                y = y * sigmoidf_(y);
                raw[tok * 288 + ch] = y;
            }
            if (tid < 64) {
                const size_t row = (size_t)b * SEQ + t0 + tid;
                const float bb = BA[row * 8 + hh], aa = BA[row * 8 + 4 + hh] + dtb;
                be[tid] = sigmoidf_(bb);
                const float sp = aa > 20.f ? aa : log1pf(expf(aa));
                al[tid] = expf(negA * sp);
            }
            __syncthreads();
            for (int pr = w; pr < 128; pr += NWAVES) {
                const int tok = pr >> 1, which = pr & 1; float* r = raw + tok * 288 + which * 128;
                const float a0 = r[lane], a1 = r[lane + 64];
                const float ss = wave_sum(a0 * a0 + a1 * a1);
                const float sc = rsqrtf(ss + EPS) * (which == 0 ? 0.08838834764831845f : 1.f);
                r[lane] = a0 * sc; r[lane + 64] = a1 * sc;
            }
            __syncthreads();
            for (int tok = 0; tok < 64; ++tok) {
                const float a = al[tok], bt = be[tok];
                const float* qk = raw + tok * 288;
                float pr = 0.f;
#pragma unroll
                for (int i = 0; i < 8; ++i) { S[i] *= a; pr += qk[128 + kg * 8 + i] * S[i]; }
                red[kg * 32 + v] = pr;
                __syncthreads();
                float r = 0.f;
#pragma unroll
                for (int g2 = 0; g2 < 16; ++g2) r += red[g2 * 32 + v];
                const float dv = bt * (qk[256 + v] - r);
                float po = 0.f;
#pragma unroll
                for (int i = 0; i < 8; ++i) { S[i] += qk[128 + kg * 8 + i] * dv; po += qk[kg * 8 + i] * S[i]; }
                red2[kg * 32 + v] = po;
                __syncthreads();
                if (kg == 0) {
                    float o = 0.f;
#pragma unroll
                    for (int g2 = 0; g2 < 16; ++g2) o += red2[g2 * 32 + v];
                    ORAW[((size_t)b * SEQ + t0 + tok) * 512 + hh * 128 + vq * 32 + v] = o;
                }
            }
        }
    }
    __syncthreads();
}
__device__ void phase_gdn_finish(const Params& p, int L, int bid, int nblk) {
    const int tid = tidx(), lane = tid & 63, gw = bid * NWAVES + (tid >> 6), NGW = nblk * NWAVES;
    const float* ORAW = (const float*)(p.ws + WS_ORAW);
    const bf16* proj = (const bf16*)(p.ws + WS_PROJ);
    bf16* obuf = (bf16*)(p.ws + WS_OBUF);
    for (int it = gw; it < M * 4; it += NGW) {
        const int hh = it & 3; const size_t row = it >> 2;
        const float o0 = ORAW[row * 512 + hh * 128 + 2 * lane], o1 = ORAW[row * 512 + hh * 128 + 2 * lane + 1];
        const float ss = wave_sum(o0 * o0 + o1 * o1);
        const float r = rsqrtf(ss * (1.f / 128.f) + EPS);
        const unsigned zz = *(const unsigned*)(proj + row * PROJ_W + 3072 + hh * 128 + 2 * lane);
        const float z0 = lo16(zz), z1 = hi16(zz);
        const float* g = p.gdn_norm_g + L * 128 + 2 * lane;
        *(unsigned*)(obuf + row * D + 512 + hh * 128 + 2 * lane) = pk2(o0 * r * g[0] * (z0 * sigmoidf_(z0)), o1 * r * g[1] * (z1 * sigmoidf_(z1)));
    }
}

__device__ void phase_peer_select_simple(const Params& p, int L, int bid, int nblk) {
    const int tid = tidx(), lane = tid & 63, gw = bid * NWAVES + (tid >> 6), NGW = nblk * NWAVES;
    const bf16* Q2 = (const bf16*)(p.ws + WS_Q2);
    const bf16* SK = (const bf16*)(p.ws + WS_SK);
    int* IDX = (int*)(p.ws + WS_IDX); float* GATE = (float*)(p.ws + WS_GATE);
    for (int it = gw; it < M * 8; it += NGW) {
        const int tok = it >> 3, hh = it & 7;
        float tv[2]; int ti[2];
#pragma unroll
        for (int c = 0; c < 2; ++c) {
            const u32x4* qp = (const u32x4*)(Q2 + (size_t)tok * 2048 + hh * 256 + c * 128);
            const u32x4* ka = (const u32x4*)(SK + ((((size_t)L * 8 + hh) * 2 + c) * 128 + lane) * 128);
            const u32x4* kb = ka + 64 * 16;
            float sa = 0.f, sb = 0.f;
#pragma unroll
            for (int ch = 0; ch < 16; ++ch) { const u32x4 q = qp[ch]; sa = dot8(q, ka[ch], sa); sb = dot8(q, kb[ch], sb); }
            float myv = 0.f; int myi = 0;
            for (int r = 0; r < 16; ++r) {
                const float m = wave_max(fmaxf(sa, sb));
                const unsigned long long ba = __ballot(sa == m);
                int win;
                if (ba) { const int ln = __ffsll((long long)ba) - 1; win = ln; if (lane == ln) sa = -INFINITY; }
                else { const unsigned long long bb = __ballot(sb == m); const int ln = __ffsll((long long)bb) - 1; win = 64 + ln; if (lane == ln) sb = -INFINITY; }
                if (lane == r) { myv = m; myi = win; }
            }
            tv[c] = myv; ti[c] = myi;
        }
        float cv[4];
#pragma unroll
        for (int q4 = 0; q4 < 4; ++q4) { const int pp = lane + 64 * q4; cv[q4] = __shfl(tv[0], pp >> 4) + __shfl(tv[1], pp & 15); }
        float gv = 0.f; int gp = 0;
        for (int r = 0; r < 16; ++r) {
            const float m = wave_max(fmaxf(fmaxf(cv[0], cv[1]), fmaxf(cv[2], cv[3])));
            int win = -1;
#pragma unroll
            for (int q4 = 0; q4 < 4; ++q4) {
                const unsigned long long bq = __ballot(cv[q4] == m);
                if (win < 0 && bq) { const int ln = __ffsll((long long)bq) - 1; win = ln + 64 * q4; if (lane == ln) cv[q4] = -INFINITY; }
            }
            if (lane == r) { gv = m; gp = win; }
        }
        const float m0 = __shfl(gv, 0);
        const float e = lane < 16 ? expf(gv - m0) : 0.f;
        const float sum = wave_sum(e);
        const int ia = __shfl(ti[0], gp >> 4), ib = __shfl(ti[1], gp & 15);
        if (lane < 16) { IDX[(size_t)tok * 128 + hh * 16 + lane] = ia * 128 + ib; GATE[(size_t)tok * 128 + hh * 16 + lane] = e / sum; }
    }
}

__device__ void phase_peer_gather(const Params& p, int L, int bid, int nblk) {
    const int tid = tidx(), lane = tid & 63, gw = bid * NWAVES + (tid >> 6), NGW = nblk * NWAVES;
    float* H = (float*)(p.ws + WS_H); bf16* HB2 = (bf16*)(p.ws + WS_HB2);
    const int* IDX = (const int*)(p.ws + WS_IDX); const float* GATE = (const float*)(p.ws + WS_GATE);
    const bf16* U = (const bf16*)(p.ws + WS_U) + (size_t)L * NEXP * D;
    const bf16* V = (const bf16*)(p.ws + WS_V) + (size_t)L * NEXP * D;
    const float* g = p.ln_ffn_g + L * D;
    for (int tok = gw; tok < M; tok += NGW) {
        float* hrow = H + (size_t)tok * D;
        float xv[16];
        {
            const f32x4 a0 = *(const f32x4*)(hrow + 8 * lane), a1 = *(const f32x4*)(hrow + 8 * lane + 4), b0 = *(const f32x4*)(hrow + 512 + 8 * lane), b1 = *(const f32x4*)(hrow + 512 + 8 * lane + 4);
#pragma unroll
            for (int i = 0; i < 4; ++i) { xv[i] = a0[i]; xv[4 + i] = a1[i]; xv[8 + i] = b0[i]; xv[12 + i] = b1[i]; }
        }
        float ss = 0.f;
#pragma unroll
        for (int i = 0; i < 16; ++i) ss += xv[i] * xv[i];
        ss = wave_sum(ss);
        const float rstd = rsqrtf(ss * (1.f / D) + EPS);
        float xn[16];
#pragma unroll
        for (int i = 0; i < 8; ++i) { xn[i] = xv[i] * rstd * g[8 * lane + i]; xn[8 + i] = xv[8 + i] * rstd * g[512 + 8 * lane + i]; }
        const int id0 = IDX[(size_t)tok * 128 + lane], id1 = IDX[(size_t)tok * 128 + 64 + lane];
        const float g0 = GATE[(size_t)tok * 128 + lane], g1 = GATE[(size_t)tok * 128 + 64 + lane];
        float w0 = 0.f, w1 = 0.f;
#pragma unroll 4
        for (int e = 0; e < 128; ++e) {
            const int id = __shfl(e < 64 ? id0 : id1, e & 63);
            const bf16* ur = U + (size_t)id * D;
            const u32x4 a = *(const u32x4*)(ur + 8 * lane), b = *(const u32x4*)(ur + 512 + 8 * lane);
            float d = 0.f;
#pragma unroll
            for (int i = 0; i < 4; ++i) { d += xn[2 * i] * lo16(a[i]) + xn[2 * i + 1] * hi16(a[i]); d += xn[8 + 2 * i] * lo16(b[i]) + xn[8 + 2 * i + 1] * hi16(b[i]); }
            d = wave_sum(d);
            const float ge = 0.5f * d * (1.f + erff(d * 0.70710678118654752f));
            if (lane == (e & 63)) { if (e < 64) w0 = g0 * ge; else w1 = g1 * ge; }
        }
        float y[16];
#pragma unroll
        for (int i = 0; i < 16; ++i) y[i] = 0.f;
#pragma unroll 4
        for (int e = 0; e < 128; ++e) {
            const int id = __shfl(e < 64 ? id0 : id1, e & 63);
            const float ww = __shfl(e < 64 ? w0 : w1, e & 63);
            const bf16* vr = V + (size_t)id * D;
            const u32x4 a = *(const u32x4*)(vr + 8 * lane), b = *(const u32x4*)(vr + 512 + 8 * lane);
#pragma unroll
            for (int i = 0; i < 4; ++i) { y[2 * i] += ww * lo16(a[i]); y[2 * i + 1] += ww * hi16(a[i]); y[8 + 2 * i] += ww * lo16(b[i]); y[8 + 2 * i + 1] += ww * hi16(b[i]); }
        }
#pragma unroll
        for (int i = 0; i < 16; ++i) y[i] += xv[i];
        *(f32x4*)(hrow + 8 * lane) = (f32x4){y[0], y[1], y[2], y[3]};
        *(f32x4*)(hrow + 8 * lane + 4) = (f32x4){y[4], y[5], y[6], y[7]};
        *(f32x4*)(hrow + 512 + 8 * lane) = (f32x4){y[8], y[9], y[10], y[11]};
        *(f32x4*)(hrow + 512 + 8 * lane + 4) = (f32x4){y[12], y[13], y[14], y[15]};
        bf16* hb = HB2 + (size_t)tok * D;
        u32x4 o; o.x = pk2(y[0], y[1]); o.y = pk2(y[2], y[3]); o.z = pk2(y[4], y[5]); o.w = pk2(y[6], y[7]);
        *(u32x4*)(hb + 8 * lane) = o;
        o.x = pk2(y[8], y[9]); o.y = pk2(y[10], y[11]); o.z = pk2(y[12], y[13]); o.w = pk2(y[14], y[15]);
        *(u32x4*)(hb + 512 + 8 * lane) = o;
    }
}

__device__ void phase_final(const Params& p, int bid, int nblk) {
    const int tid = tidx(), lane = tid & 63, gw = bid * NWAVES + (tid >> 6), NGW = nblk * NWAVES;
    const float* H = (const float*)(p.ws + WS_H); const float* rstd0 = (const float*)(p.ws + WS_STAT);
    for (int m = gw; m < M; m += NGW) {
        const float r = rstd0[m];
#pragma unroll
        for (int j = 0; j < 4; ++j) {
            const f32x4 v = ((const f32x4*)(H + (size_t)m * D))[lane + 64 * j];
            const f32x4 gv = ((const f32x4*)p.final_g)[lane + 64 * j];
            ((f32x4*)(p.out + (size_t)m * D))[lane + 64 * j] = v * r * gv;
        }
    }
}

#define XB_TMO      128
#define XB_XCNT(j)  (256  + 64 * (j))
#define XB_XSUB(j)  (1280 + 64 * (j))
#define XB_XGEN(j)  (2304 + 64 * (j))
#define XB_TOP      3328
#define XB_TOPGEN   3392
#define XCD_BAR_WORDS 3456
#define XB_SPIN_CAP (1u << 22)
__device__ __forceinline__ unsigned xb_ld(unsigned* p)              { return __hip_atomic_load(p, __ATOMIC_RELAXED, __HIP_MEMORY_SCOPE_AGENT); }
__device__ __forceinline__ unsigned xb_add(unsigned* p, unsigned v) { return __hip_atomic_fetch_add(p, v, __ATOMIC_RELAXED, __HIP_MEMORY_SCOPE_AGENT); }
__device__ __forceinline__ unsigned xb_xcc_id() { return (unsigned)__builtin_amdgcn_s_getreg((3 << 11) | 20) & 0xFu; }
#define XB_SPIN(cond, bar) do { unsigned _sp = 0; while (cond) { __builtin_amdgcn_s_sleep(1); \
    if ((++_sp & 255u) == 0u) { if (xb_ld(&(bar)[XB_TMO])) break; if (_sp > XB_SPIN_CAP) { atomicAdd(&(bar)[XB_TMO], 1u); break; } } } } while (0)
struct XcdBarrier { unsigned* bar; unsigned x; volatile LAS unsigned* st; };
__device__ __forceinline__ XcdBarrier xcd_barrier_post(unsigned* bar, volatile LAS unsigned* st) {
    XcdBarrier b; b.bar = bar; b.x = xb_xcc_id(); b.st = st;
    if (threadIdx.x == 0) (void)xb_add(&bar[XB_XCNT(b.x)], 1u);
    return b;
}
__device__ __forceinline__ void xcd_barrier_complete(unsigned* bar, unsigned x, unsigned& nloc, unsigned& nx) {
    const unsigned G = gridDim.x * gridDim.y * gridDim.z;
    unsigned sum, cnt, mine, sp = 0u;
    for (;;) {
        sum = 0u; cnt = 0u; mine = 0u;
#pragma unroll
        for (unsigned j = 0; j < 16; ++j) { const unsigned c = xb_ld(&bar[XB_XCNT(j)]); sum += c; cnt += (c > 0u) ? 1u : 0u; mine = (j == x) ? c : mine; }
        if (sum == G) break;
        __builtin_amdgcn_s_sleep(1);
        if ((++sp & 255u) == 0u) { if (xb_ld(&bar[XB_TMO])) break; if (sp > XB_SPIN_CAP) { atomicAdd(&bar[XB_TMO], 1u); break; } }
    }
    nloc = mine > 0u ? mine : 1u; nx = cnt > 0u ? cnt : 1u;
}
__device__ __forceinline__ void xcd_barrier(const XcdBarrier& b) {
    asm volatile("s_waitcnt vmcnt(0)" ::: "memory");
    __syncthreads();
    if (threadIdx.x == 0) {
        unsigned* bar = b.bar;
        __builtin_amdgcn_s_waitcnt(0);
        unsigned nloc = b.st[0], nx = b.st[1];
        if (nloc == 0u) { xcd_barrier_complete(bar, b.x, nloc, nx); b.st[0] = nloc; b.st[1] = nx; }
        const unsigned old = xb_add(&bar[XB_XSUB(b.x)], 1u);
        const unsigned gen = old / nloc;
        if (old + 1u == (gen + 1u) * nloc) {
            __builtin_amdgcn_fence(__ATOMIC_RELEASE, "agent");
            asm volatile("s_waitcnt vmcnt(0)" ::: "memory");
            const unsigned og = xb_add(&bar[XB_TOP], 1u);
            const unsigned tg = og / nx;
            if (og + 1u == (tg + 1u) * nx) xb_add(&bar[XB_TOPGEN], 1u);
            else XB_SPIN(xb_ld(&bar[XB_TOPGEN]) == tg, bar);
            __builtin_amdgcn_fence(__ATOMIC_ACQUIRE, "agent");
            xb_add(&bar[XB_XGEN(b.x)], 1u);
            asm volatile("s_waitcnt vmcnt(0)" ::: "memory");
        } else {
            XB_SPIN(xb_ld(&bar[XB_XGEN(b.x)]) == gen, bar);
            __builtin_amdgcn_fence(__ATOMIC_ACQUIRE, "agent");
            asm volatile("s_waitcnt vmcnt(0)" ::: "memory");
        }
    }
    __syncthreads();
}
constexpr int CW_BAR = 4096;
constexpr int LDS_MISC_OFF = LDS_BYTES - 256;

constexpr int NS = 11;
constexpr int K_PROLOGUE = 11, K_FINAL = 12;
template <int KIND>
__device__ __forceinline__ void run_kind(const Params& p, int L, unsigned char* lds, int bid, int nblk) {
    unsigned char* ws = p.ws;
    float* H = (float*)(ws + WS_H);
    float* rstd0 = (float*)(ws + WS_STAT); float* rstd1 = rstd0 + M; float* rstde = rstd1 + M;
    if constexpr (KIND == K_PROLOGUE) phase_prologue(p, lds, bid, nblk);
    if constexpr (KIND == K_FINAL) phase_final(p, bid, nblk);
    if constexpr (KIND == 0) { EpiProj E{(bf16*)(ws + WS_PROJ), (float*)(ws + WS_BA), rstd0};
        gemm_run(lds, (const bf16*)(ws + WS_HB0), (const bf16*)(ws + WS_WIN) + (size_t)L * IN_PAD * D, M, IN_PAD, D, E, bid, nblk); }
    if constexpr (KIND == 1) phase_att_simple(p, L, lds, bid, nblk);
    if constexpr (KIND == 2) phase_gdn_simple(p, L, lds, bid, nblk);
    if constexpr (KIND == 3) phase_gdn_finish(p, L, bid, nblk);
    if constexpr (KIND == 4) { EpiRes E{H, (bf16*)(ws + WS_HB1)};
        gemm_run(lds, (const bf16*)(ws + WS_OBUF), (const bf16*)(ws + WS_WOUT) + (size_t)L * D * D, M, D, D, E, bid, nblk); }
    if constexpr (KIND == 5) phase_rowstat_f32(H, rstd1, bid, nblk);
    if constexpr (KIND == 6) { EpiQ2 E{(bf16*)(ws + WS_Q2), rstd1};
        gemm_run(lds, (const bf16*)(ws + WS_HB1), (const bf16*)(ws + WS_WQ) + (size_t)L * 2048 * D, M, 2048, D, E, bid, nblk);
        EpiE E2{(bf16*)(ws + WS_EPRE)};
        gemm_run(lds, (const bf16*)(ws + WS_PB) + (size_t)L * M * 256, (const bf16*)(ws + WS_WP) + (size_t)L * D * 256, M, D, 256, E2, bid, nblk); }
    if constexpr (KIND == 7) { phase_rowstat_bf16((const bf16*)(ws + WS_EPRE), rstde, bid, nblk); phase_peer_select_simple(p, L, bid, nblk); }
    if constexpr (KIND == 8) phase_peer_gather(p, L, bid, nblk);
    if constexpr (KIND == 9) { EpiPle E{H, (bf16*)(ws + WS_HB0), (const bf16*)(ws + WS_EPRE), rstde, p.ple_norm_g + L * D};
        gemm_run(lds, (const bf16*)(ws + WS_HB2), (const bf16*)(ws + WS_WG) + (size_t)L * D * D, M, D, D, E, bid, nblk); }
    if constexpr (KIND == 10) phase_rowstat_f32(H, rstd0, bid, nblk);
}

#define RUN(KIND) do { const Params* pp_ = (const Params*)__builtin_amdgcn_kernarg_segment_ptr(); int L_ = L; asm volatile("" : "+s"(pp_), "+s"(L_)); run_kind<KIND>(*pp_, L_, lds, bid, nblk); } while (0)
__global__ void __launch_bounds__(NTHREADS, 2) mk_fwd(Params p) {
    extern __shared__ __attribute__((aligned(16))) unsigned char lds[];
    const int bid = (int)blockIdx.x, nblk = (int)gridDim.x;
    volatile LAS unsigned* misc = (volatile LAS unsigned*)((LAS unsigned char*)lds + LDS_MISC_OFF);
    if (threadIdx.x < 64) misc[threadIdx.x] = 0u;
    __syncthreads();
    XcdBarrier bar = xcd_barrier_post((unsigned*)(((const Params*)__builtin_amdgcn_kernarg_segment_ptr())->ws + WS_CTL) + CW_BAR, misc + 8);
    { int L = 0; RUN(K_PROLOGUE); }
    cg::this_grid().sync();
#pragma nounroll
    for (int L = 0; L < DEPTH; ++L) {
        RUN(0); xcd_barrier(bar);
        RUN(1); xcd_barrier(bar);
        RUN(2); xcd_barrier(bar);
        RUN(3); xcd_barrier(bar);
        RUN(4); xcd_barrier(bar);
        RUN(5); xcd_barrier(bar);
        RUN(6); xcd_barrier(bar);
        RUN(7); xcd_barrier(bar);
        RUN(8); xcd_barrier(bar);
        RUN(9); xcd_barrier(bar);
        RUN(10); xcd_barrier(bar);
    }
    { int L = 0; RUN(K_FINAL); }
}

extern "C" void kernel_launch(void* const* d_in, const int* in_sizes, int n_in, void* d_out, int out_size, void* d_ws, size_t ws_size, hipStream_t stream) {
    static int grid = 0;
    if (grid == 0) {
        if (n_in != 20 || out_size != M * D || ws_size < WS_END) { fprintf(stderr, "kernel_launch: unexpected shapes (n_in %d, out %d, ws %zu < %zu)\n", n_in, out_size, ws_size, (size_t)WS_END); grid = -1; return; }
        int dev = 0, cus = 0, per_cu = 0;
        (void)hipGetDevice(&dev); (void)hipDeviceGetAttribute(&cus, hipDeviceAttributeMultiprocessorCount, dev);
        if (hipFuncSetAttribute((const void*)mk_fwd, hipFuncAttributeMaxDynamicSharedMemorySize, LDS_BYTES) != hipSuccess) { fprintf(stderr, "kernel_launch: hipFuncSetAttribute failed\n"); grid = -1; return; }
        if (hipOccupancyMaxActiveBlocksPerMultiprocessor(&per_cu, (const void*)mk_fwd, NTHREADS, LDS_BYTES) != hipSuccess || per_cu < 1) { fprintf(stderr, "kernel_launch: occupancy query says %d blocks per CU\n", per_cu); (void)hipGetLastError(); grid = -1; return; }
        grid = (cus > 0 ? cus : 256);
    }
    if (grid < 0) return;
    (void)hipMemsetAsync((char*)d_ws + WS_CTL, 0, CTL_ZERO_BYTES, stream);
    Params p{};
    const float** pp = (const float**)&p;
    for (int i = 0; i < 20; ++i) pp[i] = (const float*)d_in[i];
    p.out = (float*)d_out; p.ws = (unsigned char*)d_ws;
    void* args[] = {&p};
    hipError_t e = hipLaunchCooperativeKernel((const void*)mk_fwd, dim3(grid), dim3(NTHREADS), args, LDS_BYTES, stream);
    if (e != hipSuccess) fprintf(stderr, "kernel_launch: cooperative launch failed: %s (grid %d)\n", hipGetErrorString(e), grid);
}
```

```cpp
#include <hip/hip_runtime.h>
#include <hip/hip_cooperative_groups.h>
#include <cstdio>
#include <cstdint>
namespace cg = cooperative_groups;

typedef unsigned short bf16;
typedef float f32x4 __attribute__((ext_vector_type(4)));
typedef short bf16x8 __attribute__((ext_vector_type(8)));
typedef unsigned u32x4 __attribute__((ext_vector_type(4)));
typedef unsigned u32x2 __attribute__((ext_vector_type(2)));

constexpr int D = 1024, BATCH = 8, SEQ = 2048, DEPTH = 4, M = BATCH * SEQ;
constexpr int IN_COLS = 3592, IN_PAD = 3840, PROJ_W = 3584;
constexpr int NEXP = 16384;
constexpr float EPS = 1e-6f;
constexpr float QSCALE = 0.125f * 1.4426950408889634f;
constexpr int NWAVES = 8, NTHREADS = 512;
constexpr int LDS_BYTES = 147456;

constexpr size_t MiB = 1u << 20;
constexpr size_t WS_CTL = 0, CTL_ZERO_BYTES = 1 * MiB;
constexpr size_t WS_H = 1 * MiB;
constexpr size_t WS_HB0 = 65 * MiB;
constexpr size_t WS_HB1 = 97 * MiB;
constexpr size_t WS_HB2 = 129 * MiB;
constexpr size_t WS_PROJ = 161 * MiB;
constexpr size_t WS_BA = 273 * MiB;
constexpr size_t WS_OBUF = 274 * MiB;
constexpr size_t WS_Q2 = 306 * MiB;
constexpr size_t WS_EPRE = 370 * MiB;
constexpr size_t WS_IDX = 402 * MiB;
constexpr size_t WS_GATE = 410 * MiB;
constexpr size_t WS_STAT = 418 * MiB;
constexpr size_t WS_ORAW = 422 * MiB;
constexpr size_t WS_WIN = 550 * MiB;
constexpr size_t WS_WOUT = 582 * MiB;
constexpr size_t WS_WQ = 590 * MiB;
constexpr size_t WS_WG = 606 * MiB;
constexpr size_t WS_WP = 614 * MiB;
constexpr size_t WS_SK = 616 * MiB;
constexpr size_t WS_PB = 618 * MiB;
constexpr size_t WS_U = 650 * MiB;
constexpr size_t WS_V = 778 * MiB;
constexpr size_t WS_END = 906 * MiB;

struct Params {
    const float *x, *p, *ln_mix_g, *w_in, *conv_w, *a_log, *dt_bias, *gdn_norm_g, *diff_lambda, *subln_g, *w_out, *ln_ffn_g,
        *peer_wq, *subkeys, *peer_u, *peer_v, *ple_wp, *ple_wg, *ple_norm_g, *final_g;
    float* out;
    unsigned char* ws;
    int pad0, pad1;
};

__device__ __forceinline__ int tidx() { int t = (int)threadIdx.x; asm volatile("" : "+v"(t)); return t; }
__device__ __forceinline__ float bf2f(bf16 v) { return __uint_as_float((unsigned)v << 16); }
__device__ __forceinline__ unsigned f2bf(float f) { unsigned u = __float_as_uint(f); return (u + 0x7fffu + ((u >> 16) & 1u)) >> 16; }
__device__ __forceinline__ unsigned pk2(float lo, float hi) { return f2bf(lo) | (f2bf(hi) << 16); }
__device__ __forceinline__ float lo16(unsigned w) { return __uint_as_float(w << 16); }
__device__ __forceinline__ float hi16(unsigned w) { return __uint_as_float(w & 0xffff0000u); }
__device__ __forceinline__ float wave_sum(float v) {
#pragma unroll
    for (int o = 32; o; o >>= 1) v += __shfl_xor(v, o);
    return v;
}
__device__ __forceinline__ float wave_max(float v) {
#pragma unroll
    for (int o = 32; o; o >>= 1) v = fmaxf(v, __shfl_xor(v, o));
    return v;
}
__device__ __forceinline__ float sigmoidf_(float x) { return 1.f / (1.f + __expf(-x)); }
__device__ __forceinline__ float dot8(u32x4 a, u32x4 b, float s) {
#pragma unroll
    for (int i = 0; i < 4; ++i) { s += lo16(a[i]) * lo16(b[i]); s += hi16(a[i]) * hi16(b[i]); }
    return s;
}

#define LAS __attribute__((address_space(3)))
__host__ __device__ __forceinline__ int lds_byte(int r, int c) { const int st = (r >> 4) * 2 + (c >> 5), rr = r & 15, cc = c & 31, ob = rr * 64 + cc * 2; return st * 1024 + (ob ^ (((ob >> 9) & 1) << 5)); }
__host__ __device__ __forceinline__ void stage_rc(int b, int& R, int& C) { const int st = b / 1024, sb = b % 1024, swz = sb ^ (((sb >> 9) & 1) << 5); R = (st >> 1) * 16 + swz / 64; C = (st & 1) * 32 + (swz % 64) / 2; }
constexpr int HTB = 16384;
template <class F>
__device__ __forceinline__ void gemm_run(unsigned char* lds_, const bf16* A, const bf16* Bt, int Mm, int N, int K, const F& f, int bid, int nblk) {
    LAS unsigned char* lds = (LAS unsigned char*)lds_;
    const int tid = tidx(), wid = __builtin_amdgcn_readfirstlane(tid >> 6), lane = tid & 63, wr = wid >> 1, wc = wid & 1, fr = lane & 15, fq = lane >> 4;
    const int nt = K / 64, ntn = N / 128, nunits = (Mm / 256) * ntn;
    unsigned voff[2];
#pragma unroll
    for (int i = 0; i < 2; ++i) { int R, C; stage_rc(tid * 16 + i * 8192, R, C); voff[i] = (unsigned)(R * K + C) * 2u; }
    const unsigned ldsw = (unsigned)wid * 1024u;
    const int aoff = (wr >> 1) * HTB + lds_byte((wr & 1) * 64 + fr, fq * 8), boff = 2 * HTB + lds_byte(wc * 64 + fr, fq * 8);
#define G_STAGE(bufoff, gbase) do { _Pragma("unroll") for (int _i = 0; _i < 2; ++_i) \
        __builtin_amdgcn_global_load_lds((const unsigned*)((const char*)(gbase) + voff[_i]), (LAS unsigned*)(lds + (bufoff) + ldsw + _i * 8192), 16, 0, 0); } while (0)
    for (int u = bid; u < nunits; u += nblk) {
        const int pm = u % (Mm / 256), pn = u / (Mm / 256);
        const char* gA = (const char*)(A + (size_t)pm * 256 * K);
        const char* gB = (const char*)(Bt + (size_t)pn * 128 * K);
        const size_t hstep = (size_t)128 * K * 2;
        f32x4 acc[4][4];
#pragma unroll
        for (int a = 0; a < 4; ++a)
#pragma unroll
            for (int b = 0; b < 4; ++b) acc[a][b] = (f32x4){0.f, 0.f, 0.f, 0.f};
        G_STAGE(0, gA); G_STAGE(HTB, gA + hstep); G_STAGE(2 * HTB, gB);
        for (int t = 0; t < nt; ++t) {
            const int cur = (t & 1) * 3 * HTB, nxt = ((t + 1) & 1) * 3 * HTB;
            asm volatile("s_waitcnt vmcnt(0)" ::: "memory");
            __syncthreads();
            if (t + 1 < nt) { const size_t ko = (size_t)(t + 1) * 128; G_STAGE(nxt, gA + ko); G_STAGE(nxt + HTB, gA + hstep + ko); G_STAGE(nxt + 2 * HTB, gB + ko); }
            bf16x8 af[4][2], bfr[4][2];
#pragma unroll
            for (int m = 0; m < 4; ++m)
#pragma unroll
                for (int k = 0; k < 2; ++k) af[m][k] = *(const LAS bf16x8*)(lds + cur + aoff + m * 2048 + k * 1024);
#pragma unroll
            for (int n = 0; n < 4; ++n)
#pragma unroll
                for (int k = 0; k < 2; ++k) bfr[n][k] = *(const LAS bf16x8*)(lds + cur + boff + n * 2048 + k * 1024);
#pragma unroll
            for (int k = 0; k < 2; ++k)
#pragma unroll
                for (int m = 0; m < 4; ++m)
#pragma unroll
                    for (int n = 0; n < 4; ++n) acc[m][n] = __builtin_amdgcn_mfma_f32_16x16x32_bf16(bfr[n][k], af[m][k], acc[m][n], 0, 0, 0);
        }
#pragma unroll
        for (int m = 0; m < 4; ++m) {
            const int row = pm * 256 + wr * 64 + m * 16 + fr;
#pragma unroll
            for (int n = 0; n < 4; ++n) f(row, pn * 128 + wc * 64 + n * 16 + 4 * fq, acc[m][n]);
        }
        __syncthreads();
    }
#undef G_STAGE
}

__device__ __forceinline__ u32x2 pk4(f32x4 a) { u32x2 o; o.x = pk2(a[0], a[1]); o.y = pk2(a[2], a[3]); return o; }
struct EpiProj {
    bf16* proj; float* ba; const float* rstd;
    __device__ __forceinline__ void operator()(int row, int col, f32x4 v) const {
        v = v * rstd[row];
        if (col < PROJ_W) *(u32x2*)(proj + (size_t)row * PROJ_W + col) = pk4(v);
        else if (col < IN_COLS) *(f32x4*)(ba + (size_t)row * 8 + (col - PROJ_W)) = v;
    }
};
struct EpiRes {
    float* H; bf16* HB;
    __device__ __forceinline__ void operator()(int row, int col, f32x4 v) const {
        f32x4* hp = (f32x4*)(H + (size_t)row * D + col);
        const f32x4 h = *hp + v; *hp = h;
        *(u32x2*)(HB + (size_t)row * D + col) = pk4(h);
    }
};
struct EpiQ2 {
    bf16* Q2; const float* rstd;
    __device__ __forceinline__ void operator()(int row, int col, f32x4 v) const { *(u32x2*)(Q2 + (size_t)row * 2048 + col) = pk4(v * rstd[row]); }
};
struct EpiE {
    bf16* E;
    __device__ __forceinline__ void operator()(int row, int col, f32x4 v) const { *(u32x2*)(E + (size_t)row * D + col) = pk4(v); }
};
struct EpiPle {
    float* H; bf16* HB; const bf16* E; const float* rstde; const float* g;
    __device__ __forceinline__ void operator()(int row, int col, f32x4 v) const {
        f32x4* hp = (f32x4*)(H + (size_t)row * D + col);
        const u32x2 ev = *(const u32x2*)(E + (size_t)row * D + col);
        const f32x4 gv = *(const f32x4*)(g + col);
        const float r = rstde[row];
        f32x4 h = *hp;
        h[0] += sigmoidf_(v[0]) * (lo16(ev.x) * r * gv[0]); h[1] += sigmoidf_(v[1]) * (hi16(ev.x) * r * gv[1]);
        h[2] += sigmoidf_(v[2]) * (lo16(ev.y) * r * gv[2]); h[3] += sigmoidf_(v[3]) * (hi16(ev.y) * r * gv[3]);
        *hp = h;
        *(u32x2*)(HB + (size_t)row * D + col) = pk4(h);
    }
};

__device__ __forceinline__ void transpose_item(const float* W, int K, int N, int Npad, bf16* WT, const float* rowscale, int qcols, float* scr, int item, int lane) {
    const int nblk = Npad / 32, kb = item / nblk, nb = item % nblk, k0 = 64 * kb, n0 = 32 * nb;
    const int n = n0 + (lane & 31);
#pragma unroll 8
    for (int i = 0; i < 32; ++i) {
        const int kk = 2 * i + (lane >> 5);
        float v = (n < N) ? W[(size_t)(k0 + kk) * N + n] : 0.f;
        if (rowscale) v *= rowscale[k0 + kk];
        if (n < qcols) v *= QSCALE;
        scr[kk * 33 + (lane & 31)] = v;
    }
    asm volatile("s_waitcnt lgkmcnt(0)" ::: "memory");
    const int c = lane & 7;
#pragma unroll
    for (int j = 0; j < 4; ++j) {
        const int nn = (lane >> 3) + 8 * j; const float* s = scr + (8 * c) * 33 + nn;
        u32x4 o; o.x = pk2(s[0 * 33], s[1 * 33]); o.y = pk2(s[2 * 33], s[3 * 33]); o.z = pk2(s[4 * 33], s[5 * 33]); o.w = pk2(s[6 * 33], s[7 * 33]);
        *(u32x4*)(WT + (size_t)(n0 + nn) * K + k0 + 8 * c) = o;
    }
    asm volatile("s_waitcnt lgkmcnt(0)" ::: "memory");
}
__device__ __forceinline__ void convert_bulk(const float* src, bf16* dst, size_t n, size_t gtid, size_t nthr) {
    for (size_t i = gtid * 8; i < n; i += nthr * 8) {
        const f32x4 a = *(const f32x4*)(src + i), b = *(const f32x4*)(src + i + 4);
        u32x4 o; o.x = pk2(a[0], a[1]); o.y = pk2(a[2], a[3]); o.z = pk2(b[0], b[1]); o.w = pk2(b[2], b[3]);
        *(u32x4*)(dst + i) = o;
    }
}
__device__ void phase_prologue(const Params& p, unsigned char* lds, int bid, int nblk) {
    const int tid = tidx(), lane = tid & 63, w = tid >> 6;
    const int gw = bid * NWAVES + w, NGW = nblk * NWAVES;
    float* scr = (float*)(lds + w * 16384);
    constexpr int I_IN = 16 * (IN_PAD / 32), I_OUT = 16 * 32, I_Q = 16 * 64, I_G = 16 * 32, I_P = 4 * 32, I_L = I_IN + I_OUT + I_Q + I_G + I_P;
    for (int it = gw; it < DEPTH * I_L; it += NGW) {
        const int L = it / I_L; int r = it % I_L;
        if (r < I_IN) { transpose_item(p.w_in + (size_t)L * D * IN_COLS, D, IN_COLS, IN_PAD, (bf16*)(p.ws + WS_WIN) + (size_t)L * IN_PAD * D, p.ln_mix_g + L * D, 512, scr, r, lane); continue; } r -= I_IN;
        if (r < I_OUT) { transpose_item(p.w_out + (size_t)L * D * D, D, D, D, (bf16*)(p.ws + WS_WOUT) + (size_t)L * D * D, nullptr, 0, scr, r, lane); continue; } r -= I_OUT;
        if (r < I_Q) { transpose_item(p.peer_wq + (size_t)L * D * 2048, D, 2048, 2048, (bf16*)(p.ws + WS_WQ) + (size_t)L * 2048 * D, p.ln_ffn_g + L * D, 0, scr, r, lane); continue; } r -= I_Q;
        if (r < I_G) { transpose_item(p.ple_wg + (size_t)L * D * D, D, D, D, (bf16*)(p.ws + WS_WG) + (size_t)L * D * D, nullptr, 0, scr, r, lane); continue; } r -= I_G;
        transpose_item(p.ple_wp + (size_t)L * 256 * D, 256, D, D, (bf16*)(p.ws + WS_WP) + (size_t)L * D * 256, nullptr, 0, scr, r, lane);
    }
    const size_t gtid = (size_t)bid * NTHREADS + tid, nthr = (size_t)nblk * NTHREADS;
    convert_bulk(p.peer_u, (bf16*)(p.ws + WS_U), (size_t)DEPTH * NEXP * D, gtid, nthr);
    convert_bulk(p.peer_v, (bf16*)(p.ws + WS_V), (size_t)DEPTH * NEXP * D, gtid, nthr);
    convert_bulk(p.p, (bf16*)(p.ws + WS_PB), (size_t)DEPTH * M * 256, gtid, nthr);
    convert_bulk(p.subkeys, (bf16*)(p.ws + WS_SK), (size_t)DEPTH * 8 * 2 * 128 * 128, gtid, nthr);
    float* H = (float*)(p.ws + WS_H); bf16* HB0 = (bf16*)(p.ws + WS_HB0); float* rstd0 = (float*)(p.ws + WS_STAT);
    for (int m = gw; m < M; m += NGW) {
        const f32x4* xr = (const f32x4*)(p.x + (size_t)m * D) + lane;
        float ss = 0.f;
#pragma unroll
        for (int j = 0; j < 4; ++j) {
            const f32x4 v = xr[64 * j];
            ss += v[0] * v[0] + v[1] * v[1] + v[2] * v[2] + v[3] * v[3];
            ((f32x4*)(H + (size_t)m * D))[lane + 64 * j] = v;
            u32x2 o; o.x = pk2(v[0], v[1]); o.y = pk2(v[2], v[3]);
            ((u32x2*)(HB0 + (size_t)m * D))[lane + 64 * j] = o;
        }
        ss = wave_sum(ss);
        if (lane == 0) rstd0[m] = rsqrtf(ss * (1.f / D) + EPS);
    }
}

__device__ void phase_rowstat_f32(const float* src, float* rstd, int bid, int nblk) {
    const int tid = tidx(), lane = tid & 63, gw = bid * NWAVES + (tid >> 6), NGW = nblk * NWAVES;
    for (int m = gw; m < M; m += NGW) {
        const f32x4* xr = (const f32x4*)(src + (size_t)m * D) + lane;
        float ss = 0.f;
#pragma unroll
        for (int j = 0; j < 4; ++j) { const f32x4 v = xr[64 * j]; ss += v[0] * v[0] + v[1] * v[1] + v[2] * v[2] + v[3] * v[3]; }
        ss = wave_sum(ss);
        if (lane == 0) rstd[m] = rsqrtf(ss * (1.f / D) + EPS);
    }
}
__device__ void phase_rowstat_bf16(const bf16* src, float* rstd, int bid, int nblk) {
    const int tid = tidx(), lane = tid & 63, gw = bid * NWAVES + (tid >> 6), NGW = nblk * NWAVES;
    for (int m = gw; m < M; m += NGW) {
        const u32x4* xr = (const u32x4*)(src + (size_t)m * D) + lane;
        float ss = 0.f;
#pragma unroll
        for (int j = 0; j < 2; ++j) { const u32x4 v = xr[64 * j];
#pragma unroll
            for (int i = 0; i < 4; ++i) { const float a = lo16(v[i]), b = hi16(v[i]); ss += a * a + b * b; } }
        ss = wave_sum(ss);
        if (lane == 0) rstd[m] = rsqrtf(ss * (1.f / D) + EPS);
    }
}

typedef short v4i16_t __attribute__((ext_vector_type(4)));
typedef __bf16 bf16x2_t __attribute__((ext_vector_type(2)));
typedef float f32x2_t __attribute__((ext_vector_type(2)));
__device__ __forceinline__ unsigned cvtpk(float lo, float hi) { f32x2_t v = {lo, hi}; bf16x2_t b = __builtin_convertvector(v, bf16x2_t); return __builtin_bit_cast(unsigned, b); }
__device__ __forceinline__ float xrow16_max(float x) {
    auto s = __builtin_amdgcn_permlane16_swap(__float_as_uint(x), __float_as_uint(x), false, false);
    x = fmaxf(__uint_as_float(s[0]), __uint_as_float(s[1]));
    auto t = __builtin_amdgcn_permlane32_swap(__float_as_uint(x), __float_as_uint(x), false, false);
    return fmaxf(__uint_as_float(t[0]), __uint_as_float(t[1]));
}
__device__ __forceinline__ float xrow16_sum(float x) {
    auto s = __builtin_amdgcn_permlane16_swap(__float_as_uint(x), __float_as_uint(x), false, false);
    x = __uint_as_float(s[0]) + __uint_as_float(s[1]);
    auto t = __builtin_amdgcn_permlane32_swap(__float_as_uint(x), __float_as_uint(x), false, false);
    return __uint_as_float(t[0]) + __uint_as_float(t[1]);
}
constexpr int ATT_VOFF = 16384, ATT_VPITCH = 288;
__device__ void phase_att_mfma(const Params& p, int L, unsigned char* lds_, int bid, int nblk) {
    LAS unsigned char* lds = (LAS unsigned char*)lds_;
    const int tid = tidx(), lane = tid & 63, w = __builtin_amdgcn_readfirstlane(tid >> 6), fr = lane & 15, fq = lane >> 4;
    const bf16* proj = (const bf16*)(p.ws + WS_PROJ);
    bf16* obuf = (bf16*)(p.ws + WS_OBUF);
    const float* lp = p.diff_lambda + L * 256;
    const float d1 = wave_sum(lp[lane] * lp[64 + lane]), d2 = wave_sum(lp[128 + lane] * lp[192 + lane]);
    const float lam_init = 0.8f - 0.6f * expf(-0.3f * (float)L);
    const float lam = expf(d1) - expf(d2) + lam_init;
    for (int item = bid; item < 256; item += nblk) {
        const int bh = item >> 3, jj = item & 7, b = bh >> 2, hh = bh & 3;
        const float slope2 = exp2f(-2.f * (float)(hh + 1)) * 1.4426950408889634f;
        const bf16* kbase = proj + (size_t)b * SEQ * PROJ_W + 512 + hh * 128;
        const bf16* vbase = proj + (size_t)b * SEQ * PROJ_W + 1024 + hh * 128;
        for (int half = 0; half < 2; ++half) {
            const int qb = half == 0 ? 15 - jj : jj;
            const int qw0 = qb * 128 + w * 16, T = 2 * (qb + 1);
            bf16x8 qf[2][2];
#pragma unroll
            for (int mp = 0; mp < 2; ++mp)
#pragma unroll
                for (int ks = 0; ks < 2; ++ks) qf[mp][ks] = *(const bf16x8*)(proj + ((size_t)b * SEQ + qw0 + fr) * PROJ_W + hh * 128 + mp * 64 + ks * 32 + 8 * fq);
            f32x4 o[2][8];
#pragma unroll
            for (int mp = 0; mp < 2; ++mp)
#pragma unroll
                for (int dt = 0; dt < 8; ++dt) o[mp][dt] = (f32x4){0.f, 0.f, 0.f, 0.f};
            float mrun[2] = {-INFINITY, -INFINITY}, lrun[2] = {0.f, 0.f};
            u32x4 kreg[2], vreg[2];
#pragma unroll
            for (int i = 0; i < 2; ++i) { const int c = tid + 512 * i, key = c >> 4, ch = c & 15;
                kreg[i] = *(const u32x4*)(kbase + (size_t)key * PROJ_W + ch * 8); vreg[i] = *(const u32x4*)(vbase + (size_t)key * PROJ_W + ch * 8); }
            for (int t = 0; t < T; ++t) {
                const int k0 = t * 64;
#pragma unroll
                for (int i = 0; i < 2; ++i) { const int c = tid + 512 * i, key = c >> 4, ch = c & 15;
                    *(LAS u32x4*)(lds + key * 256 + ((ch ^ (key & 15)) << 4)) = kreg[i];
                    *(LAS u32x4*)(lds + ATT_VOFF + key * ATT_VPITCH + ch * 16) = vreg[i]; }
                __syncthreads();
                if (t + 1 < T) {
#pragma unroll
                    for (int i = 0; i < 2; ++i) { const int c = tid + 512 * i, key = k0 + 64 + (c >> 4), ch = c & 15;
                        kreg[i] = *(const u32x4*)(kbase + (size_t)key * PROJ_W + ch * 8); vreg[i] = *(const u32x4*)(vbase + (size_t)key * PROJ_W + ch * 8); }
                }
                if (k0 <= qw0 + 15) {
                    f32x4 s[2][4];
                    const float base = -slope2 * (float)(qw0 + fr - k0 - 4 * fq);
#pragma unroll
                    for (int kt = 0; kt < 4; ++kt)
#pragma unroll
                        for (int r = 0; r < 4; ++r) { const float v = base + slope2 * (float)(16 * kt + r); s[0][kt][r] = v; s[1][kt][r] = v; }
#pragma unroll
                    for (int mp = 0; mp < 2; ++mp)
#pragma unroll
                        for (int kt = 0; kt < 4; ++kt)
#pragma unroll
                            for (int ks = 0; ks < 2; ++ks) {
                                const bf16x8 kf = *(const LAS bf16x8*)(lds + (16 * kt + fr) * 256 + (((mp * 8 + ks * 4 + fq) ^ fr) << 4));
                                s[mp][kt] = __builtin_amdgcn_mfma_f32_16x16x32_bf16(kf, qf[mp][ks], s[mp][kt], 0, 0, 0);
                            }
                    if (k0 + 63 > qw0) {
                        const int lim = qw0 + fr - k0 - 4 * fq;
#pragma unroll
                        for (int mp = 0; mp < 2; ++mp)
#pragma unroll
                            for (int kt = 0; kt < 4; ++kt)
#pragma unroll
                                for (int r = 0; r < 4; ++r) if (16 * kt + r > lim) s[mp][kt][r] = -INFINITY;
                    }
                    bf16x8 pb[2][2];
#pragma unroll
                    for (int mp = 0; mp < 2; ++mp) {
                        float mx = fmaxf(fmaxf(s[mp][0][0], s[mp][0][1]), fmaxf(s[mp][0][2], s[mp][0][3]));
#pragma unroll
                        for (int kt = 1; kt < 4; ++kt) mx = fmaxf(mx, fmaxf(fmaxf(s[mp][kt][0], s[mp][kt][1]), fmaxf(s[mp][kt][2], s[mp][kt][3])));
                        mx = xrow16_max(mx);
                        const float mnew = fmaxf(mrun[mp], mx);
                        const float alpha = __builtin_amdgcn_exp2f(mrun[mp] - mnew);
                        mrun[mp] = mnew;
                        float ps = 0.f;
#pragma unroll
                        for (int kt = 0; kt < 4; ++kt)
#pragma unroll
                            for (int r = 0; r < 4; ++r) { const float e = __builtin_amdgcn_exp2f(s[mp][kt][r] - mnew); s[mp][kt][r] = e; ps += e; }
                        lrun[mp] = lrun[mp] * alpha + ps;
#pragma unroll
                        for (int dt = 0; dt < 8; ++dt) o[mp][dt] = o[mp][dt] * alpha;
#pragma unroll
                        for (int ks = 0; ks < 2; ++ks) {
                            u32x4 pk; pk.x = cvtpk(s[mp][2 * ks][0], s[mp][2 * ks][1]); pk.y = cvtpk(s[mp][2 * ks][2], s[mp][2 * ks][3]);
                            pk.z = cvtpk(s[mp][2 * ks + 1][0], s[mp][2 * ks + 1][1]); pk.w = cvtpk(s[mp][2 * ks + 1][2], s[mp][2 * ks + 1][3]);
                            pb[mp][ks] = __builtin_bit_cast(bf16x8, pk);
                        }
                    }
                    const int gl = lane & 15;
                    LAS unsigned char* vrd = lds + ATT_VOFF + (4 * fq + (gl >> 2)) * ATT_VPITCH + (gl & 3) * 8;
#pragma unroll
                    for (int dt = 0; dt < 8; ++dt)
#pragma unroll
                        for (int ks = 0; ks < 2; ++ks) {
                            const v4i16_t v0 = __builtin_amdgcn_ds_read_tr16_b64_v4i16((LAS v4i16_t*)(vrd + (32 * ks) * ATT_VPITCH + dt * 32));
                            const v4i16_t v1 = __builtin_amdgcn_ds_read_tr16_b64_v4i16((LAS v4i16_t*)(vrd + (32 * ks + 16) * ATT_VPITCH + dt * 32));
                            bf16x8 vf; vf[0] = v0[0]; vf[1] = v0[1]; vf[2] = v0[2]; vf[3] = v0[3]; vf[4] = v1[0]; vf[5] = v1[1]; vf[6] = v1[2]; vf[7] = v1[3];
                            o[0][dt] = __builtin_amdgcn_mfma_f32_16x16x32_bf16(vf, pb[0][ks], o[0][dt], 0, 0, 0);
                            o[1][dt] = __builtin_amdgcn_mfma_f32_16x16x32_bf16(vf, pb[1][ks], o[1][dt], 0, 0, 0);
                        }
                }
                __syncthreads();
            }
            const float i1 = 1.f / xrow16_sum(lrun[0]), i2 = lam / xrow16_sum(lrun[1]);
            float ss = 0.f;
#pragma unroll
            for (int dt = 0; dt < 8; ++dt)
#pragma unroll
                for (int r = 0; r < 4; ++r) { const float v = o[0][dt][r] * i1 - o[1][dt][r] * i2; o[0][dt][r] = v; ss += v * v; }
            ss = xrow16_sum(ss);
            const float rn = rsqrtf(ss * (1.f / 128.f) + EPS) * (1.f - lam_init);
            const float* g = p.subln_g + L * 128;
            bf16* orow = obuf + ((size_t)b * SEQ + qw0 + fr) * D + hh * 128;
#pragma unroll
            for (int dt = 0; dt < 8; ++dt) {
                const f32x4 gv = *(const f32x4*)(g + 16 * dt + 4 * fq);
                u32x2 ov; ov.x = pk2(o[0][dt][0] * rn * gv[0], o[0][dt][1] * rn * gv[1]); ov.y = pk2(o[0][dt][2] * rn * gv[2], o[0][dt][3] * rn * gv[3]);
                *(u32x2*)(orow + 16 * dt + 4 * fq) = ov;
            }
        }
    }
}

__device__ void phase_gdn_simple(const Params& p, int L, unsigned char* lds, int bid, int nblk) {
    const int tid = tidx(), lane = tid & 63, w = tid >> 6, v = tid & 31, kg = tid >> 5;
    float* raw = (float*)lds;
    float* al = raw + 64 * 288; float* be = al + 64; float* red = be + 64; float* red2 = red + 512;
    const bf16* proj = (const bf16*)(p.ws + WS_PROJ);
    const float* BA = (const float*)(p.ws + WS_BA);
    float* ORAW = (float*)(p.ws + WS_ORAW);
    const float* cw = p.conv_w + (size_t)L * 4 * 1536;
    for (int it = bid; it < 128; it += nblk) {
        const int vq = it & 3, hh = (it >> 2) & 3, b = it >> 4;
        float S[8];
#pragma unroll
        for (int i = 0; i < 8; ++i) S[i] = 0.f;
        const float negA = -expf(p.a_log[L * 4 + hh]), dtb = p.dt_bias[L * 4 + hh];
        for (int n = 0; n < 32; ++n) {
            const int t0 = n * 64;
            __syncthreads();
            for (int idx = tid; idx < 64 * 288; idx += NTHREADS) {
                const int tok = idx / 288, ch = idx % 288;
                int col;
                if (ch < 128) col = hh * 128 + ch; else if (ch < 256) col = 512 + hh * 128 + (ch - 128); else col = 1024 + hh * 128 + vq * 32 + (ch - 256);
                const int t = t0 + tok;
                float y = 0.f;
#pragma unroll
                for (int j = 0; j < 4; ++j) { const int tt = t - 3 + j; if (tt >= 0) y += bf2f(proj[((size_t)b * SEQ + tt) * PROJ_W + 1536 + col]) * cw[j * 1536 + col]; }
                y = y * sigmoidf_(y);
                raw[tok * 288 + ch] = y;
            }
            if (tid < 64) {
                const size_t row = (size_t)b * SEQ + t0 + tid;
                const float bb = BA[row * 8 + hh], aa = BA[row * 8 + 4 + hh] + dtb;
                be[tid] = sigmoidf_(bb);
                const float sp = aa > 20.f ? aa : log1pf(expf(aa));
                al[tid] = expf(negA * sp);
            }
            __syncthreads();
            for (int pr = w; pr < 128; pr += NWAVES) {
                const int tok = pr >> 1, which = pr & 1; float* r = raw + tok * 288 + which * 128;
                const float a0 = r[lane], a1 = r[lane + 64];
                const float ss = wave_sum(a0 * a0 + a1 * a1);
                const float sc = rsqrtf(ss + EPS) * (which == 0 ? 0.08838834764831845f : 1.f);
                r[lane] = a0 * sc; r[lane + 64] = a1 * sc;
            }
            __syncthreads();
            for (int tok = 0; tok < 64; ++tok) {
                const float a = al[tok], bt = be[tok];
                const float* qk = raw + tok * 288;
                float pr = 0.f;
#pragma unroll
                for (int i = 0; i < 8; ++i) { S[i] *= a; pr += qk[128 + kg * 8 + i] * S[i]; }
                red[kg * 32 + v] = pr;
                __syncthreads();
                float r = 0.f;
#pragma unroll
                for (int g2 = 0; g2 < 16; ++g2) r += red[g2 * 32 + v];
                const float dv = bt * (qk[256 + v] - r);
                float po = 0.f;
#pragma unroll
                for (int i = 0; i < 8; ++i) { S[i] += qk[128 + kg * 8 + i] * dv; po += qk[kg * 8 + i] * S[i]; }
                red2[kg * 32 + v] = po;
                __syncthreads();
                if (kg == 0) {
                    float o = 0.f;
#pragma unroll
                    for (int g2 = 0; g2 < 16; ++g2) o += red2[g2 * 32 + v];
                    ORAW[((size_t)b * SEQ + t0 + tok) * 512 + hh * 128 + vq * 32 + v] = o;
                }
            }
        }
    }
    __syncthreads();
}
__device__ void phase_gdn_finish(const Params& p, int L, int bid, int nblk) {
    const int tid = tidx(), lane = tid & 63, gw = bid * NWAVES + (tid >> 6), NGW = nblk * NWAVES;
    const float* ORAW = (const float*)(p.ws + WS_ORAW);
    const bf16* proj = (const bf16*)(p.ws + WS_PROJ);
    bf16* obuf = (bf16*)(p.ws + WS_OBUF);
    for (int it = gw; it < M * 4; it += NGW) {
        const int hh = it & 3; const size_t row = it >> 2;
        const float o0 = ORAW[row * 512 + hh * 128 + 2 * lane], o1 = ORAW[row * 512 + hh * 128 + 2 * lane + 1];
        const float ss = wave_sum(o0 * o0 + o1 * o1);
        const float r = rsqrtf(ss * (1.f / 128.f) + EPS);
        const unsigned zz = *(const unsigned*)(proj + row * PROJ_W + 3072 + hh * 128 + 2 * lane);
        const float z0 = lo16(zz), z1 = hi16(zz);
        const float* g = p.gdn_norm_g + L * 128 + 2 * lane;
        *(unsigned*)(obuf + row * D + 512 + hh * 128 + 2 * lane) = pk2(o0 * r * g[0] * (z0 * sigmoidf_(z0)), o1 * r * g[1] * (z1 * sigmoidf_(z1)));
    }
}

__device__ void phase_peer_select_simple(const Params& p, int L, int bid, int nblk) {
    const int tid = tidx(), lane = tid & 63, gw = bid * NWAVES + (tid >> 6), NGW = nblk * NWAVES;
    const bf16* Q2 = (const bf16*)(p.ws + WS_Q2);
    const bf16* SK = (const bf16*)(p.ws + WS_SK);
    int* IDX = (int*)(p.ws + WS_IDX); float* GATE = (float*)(p.ws + WS_GATE);
    for (int it = gw; it < M * 8; it += NGW) {
        const int tok = it >> 3, hh = it & 7;
        float tv[2]; int ti[2];
#pragma unroll
        for (int c = 0; c < 2; ++c) {
            const u32x4* qp = (const u32x4*)(Q2 + (size_t)tok * 2048 + hh * 256 + c * 128);
            const u32x4* ka = (const u32x4*)(SK + ((((size_t)L * 8 + hh) * 2 + c) * 128 + lane) * 128);
            const u32x4* kb = ka + 64 * 16;
            float sa = 0.f, sb = 0.f;
#pragma unroll
            for (int ch = 0; ch < 16; ++ch) { const u32x4 q = qp[ch]; sa = dot8(q, ka[ch], sa); sb = dot8(q, kb[ch], sb); }
            float myv = 0.f; int myi = 0;
            for (int r = 0; r < 16; ++r) {
                const float m = wave_max(fmaxf(sa, sb));
                const unsigned long long ba = __ballot(sa == m);
                int win;
                if (ba) { const int ln = __ffsll((long long)ba) - 1; win = ln; if (lane == ln) sa = -INFINITY; }
                else { const unsigned long long bb = __ballot(sb == m); const int ln = __ffsll((long long)bb) - 1; win = 64 + ln; if (lane == ln) sb = -INFINITY; }
                if (lane == r) { myv = m; myi = win; }
            }
            tv[c] = myv; ti[c] = myi;
        }
        float cv[4];
#pragma unroll
        for (int q4 = 0; q4 < 4; ++q4) { const int pp = lane + 64 * q4; cv[q4] = __shfl(tv[0], pp >> 4) + __shfl(tv[1], pp & 15); }
        float gv = 0.f; int gp = 0;
        for (int r = 0; r < 16; ++r) {
            const float m = wave_max(fmaxf(fmaxf(cv[0], cv[1]), fmaxf(cv[2], cv[3])));
            int win = -1;
#pragma unroll
            for (int q4 = 0; q4 < 4; ++q4) {
                const unsigned long long bq = __ballot(cv[q4] == m);
                if (win < 0 && bq) { const int ln = __ffsll((long long)bq) - 1; win = ln + 64 * q4; if (lane == ln) cv[q4] = -INFINITY; }
            }
            if (lane == r) { gv = m; gp = win; }
        }
        const float m0 = __shfl(gv, 0);
        const float e = lane < 16 ? expf(gv - m0) : 0.f;
        const float sum = wave_sum(e);
        const int ia = __shfl(ti[0], gp >> 4), ib = __shfl(ti[1], gp & 15);
        if (lane < 16) { IDX[(size_t)tok * 128 + hh * 16 + lane] = ia * 128 + ib; GATE[(size_t)tok * 128 + hh * 16 + lane] = e / sum; }
    }
}

__device__ void phase_peer_gather(const Params& p, int L, int bid, int nblk) {
    const int tid = tidx(), lane = tid & 63, gw = bid * NWAVES + (tid >> 6), NGW = nblk * NWAVES;
    float* H = (float*)(p.ws + WS_H); bf16* HB2 = (bf16*)(p.ws + WS_HB2);
    const int* IDX = (const int*)(p.ws + WS_IDX); const float* GATE = (const float*)(p.ws + WS_GATE);
    const bf16* U = (const bf16*)(p.ws + WS_U) + (size_t)L * NEXP * D;
    const bf16* V = (const bf16*)(p.ws + WS_V) + (size_t)L * NEXP * D;
    const float* g = p.ln_ffn_g + L * D;
    for (int tok = gw; tok < M; tok += NGW) {
        float* hrow = H + (size_t)tok * D;
        float xv[16];
        {
            const f32x4 a0 = *(const f32x4*)(hrow + 8 * lane), a1 = *(const f32x4*)(hrow + 8 * lane + 4), b0 = *(const f32x4*)(hrow + 512 + 8 * lane), b1 = *(const f32x4*)(hrow + 512 + 8 * lane + 4);
#pragma unroll
            for (int i = 0; i < 4; ++i) { xv[i] = a0[i]; xv[4 + i] = a1[i]; xv[8 + i] = b0[i]; xv[12 + i] = b1[i]; }
        }
        float ss = 0.f;
#pragma unroll
        for (int i = 0; i < 16; ++i) ss += xv[i] * xv[i];
        ss = wave_sum(ss);
        const float rstd = rsqrtf(ss * (1.f / D) + EPS);
        float xn[16];
#pragma unroll
        for (int i = 0; i < 8; ++i) { xn[i] = xv[i] * rstd * g[8 * lane + i]; xn[8 + i] = xv[8 + i] * rstd * g[512 + 8 * lane + i]; }
        const int id0 = IDX[(size_t)tok * 128 + lane], id1 = IDX[(size_t)tok * 128 + 64 + lane];
        const float g0 = GATE[(size_t)tok * 128 + lane], g1 = GATE[(size_t)tok * 128 + 64 + lane];
        float w0 = 0.f, w1 = 0.f;
#pragma unroll 4
        for (int e = 0; e < 128; ++e) {
            const int id = __shfl(e < 64 ? id0 : id1, e & 63);
            const bf16* ur = U + (size_t)id * D;
            const u32x4 a = *(const u32x4*)(ur + 8 * lane), b = *(const u32x4*)(ur + 512 + 8 * lane);
            float d = 0.f;
#pragma unroll
            for (int i = 0; i < 4; ++i) { d += xn[2 * i] * lo16(a[i]) + xn[2 * i + 1] * hi16(a[i]); d += xn[8 + 2 * i] * lo16(b[i]) + xn[8 + 2 * i + 1] * hi16(b[i]); }
            d = wave_sum(d);
            const float ge = 0.5f * d * (1.f + erff(d * 0.70710678118654752f));
            if (lane == (e & 63)) { if (e < 64) w0 = g0 * ge; else w1 = g1 * ge; }
        }
        float y[16];
#pragma unroll
        for (int i = 0; i < 16; ++i) y[i] = 0.f;
#pragma unroll 4
        for (int e = 0; e < 128; ++e) {
            const int id = __shfl(e < 64 ? id0 : id1, e & 63);
            const float ww = __shfl(e < 64 ? w0 : w1, e & 63);
            const bf16* vr = V + (size_t)id * D;
            const u32x4 a = *(const u32x4*)(vr + 8 * lane), b = *(const u32x4*)(vr + 512 + 8 * lane);
#pragma unroll
            for (int i = 0; i < 4; ++i) { y[2 * i] += ww * lo16(a[i]); y[2 * i + 1] += ww * hi16(a[i]); y[8 + 2 * i] += ww * lo16(b[i]); y[8 + 2 * i + 1] += ww * hi16(b[i]); }
        }
#pragma unroll
        for (int i = 0; i < 16; ++i) y[i] += xv[i];
        *(f32x4*)(hrow + 8 * lane) = (f32x4){y[0], y[1], y[2], y[3]};
        *(f32x4*)(hrow + 8 * lane + 4) = (f32x4){y[4], y[5], y[6], y[7]};
        *(f32x4*)(hrow + 512 + 8 * lane) = (f32x4){y[8], y[9], y[10], y[11]};
        *(f32x4*)(hrow + 512 + 8 * lane + 4) = (f32x4){y[12], y[13], y[14], y[15]};
        bf16* hb = HB2 + (size_t)tok * D;
        u32x4 o; o.x = pk2(y[0], y[1]); o.y = pk2(y[2], y[3]); o.z = pk2(y[4], y[5]); o.w = pk2(y[6], y[7]);
        *(u32x4*)(hb + 8 * lane) = o;
        o.x = pk2(y[8], y[9]); o.y = pk2(y[10], y[11]); o.z = pk2(y[12], y[13]); o.w = pk2(y[14], y[15]);
        *(u32x4*)(hb + 512 + 8 * lane) = o;
    }
}

__device__ void phase_final(const Params& p, int bid, int nblk) {
    const int tid = tidx(), lane = tid & 63, gw = bid * NWAVES + (tid >> 6), NGW = nblk * NWAVES;
    const float* H = (const float*)(p.ws + WS_H); const float* rstd0 = (const float*)(p.ws + WS_STAT);
    for (int m = gw; m < M; m += NGW) {
        const float r = rstd0[m];
#pragma unroll
        for (int j = 0; j < 4; ++j) {
            const f32x4 v = ((const f32x4*)(H + (size_t)m * D))[lane + 64 * j];
            const f32x4 gv = ((const f32x4*)p.final_g)[lane + 64 * j];
            ((f32x4*)(p.out + (size_t)m * D))[lane + 64 * j] = v * r * gv;
        }
    }
}

#define XB_TMO      128
#define XB_XCNT(j)  (256  + 64 * (j))
#define XB_XSUB(j)  (1280 + 64 * (j))
#define XB_XGEN(j)  (2304 + 64 * (j))
#define XB_TOP      3328
#define XB_TOPGEN   3392
#define XCD_BAR_WORDS 3456
#define XB_SPIN_CAP (1u << 22)
__device__ __forceinline__ unsigned xb_ld(unsigned* p)              { return __hip_atomic_load(p, __ATOMIC_RELAXED, __HIP_MEMORY_SCOPE_AGENT); }
__device__ __forceinline__ unsigned xb_add(unsigned* p, unsigned v) { return __hip_atomic_fetch_add(p, v, __ATOMIC_RELAXED, __HIP_MEMORY_SCOPE_AGENT); }
__device__ __forceinline__ unsigned xb_xcc_id() { return (unsigned)__builtin_amdgcn_s_getreg((3 << 11) | 20) & 0xFu; }
#define XB_SPIN(cond, bar) do { unsigned _sp = 0; while (cond) { __builtin_amdgcn_s_sleep(1); \
    if ((++_sp & 255u) == 0u) { if (xb_ld(&(bar)[XB_TMO])) break; if (_sp > XB_SPIN_CAP) { atomicAdd(&(bar)[XB_TMO], 1u); break; } } } } while (0)
struct XcdBarrier { unsigned* bar; unsigned x; volatile LAS unsigned* st; };
__device__ __forceinline__ XcdBarrier xcd_barrier_post(unsigned* bar, volatile LAS unsigned* st) {
    XcdBarrier b; b.bar = bar; b.x = xb_xcc_id(); b.st = st;
    if (threadIdx.x == 0) (void)xb_add(&bar[XB_XCNT(b.x)], 1u);
    return b;
}
__device__ __forceinline__ void xcd_barrier_complete(unsigned* bar, unsigned x, unsigned& nloc, unsigned& nx) {
    const unsigned G = gridDim.x * gridDim.y * gridDim.z;
    unsigned sum, cnt, mine, sp = 0u;
    for (;;) {
        sum = 0u; cnt = 0u; mine = 0u;
#pragma unroll
        for (unsigned j = 0; j < 16; ++j) { const unsigned c = xb_ld(&bar[XB_XCNT(j)]); sum += c; cnt += (c > 0u) ? 1u : 0u; mine = (j == x) ? c : mine; }
        if (sum == G) break;
        __builtin_amdgcn_s_sleep(1);
        if ((++sp & 255u) == 0u) { if (xb_ld(&bar[XB_TMO])) break; if (sp > XB_SPIN_CAP) { atomicAdd(&bar[XB_TMO], 1u); break; } }
    }
    nloc = mine > 0u ? mine : 1u; nx = cnt > 0u ? cnt : 1u;
}
__device__ __forceinline__ void xcd_barrier(const XcdBarrier& b) {
    asm volatile("s_waitcnt vmcnt(0)" ::: "memory");
    __syncthreads();
    if (threadIdx.x == 0) {
        unsigned* bar = b.bar;
        __builtin_amdgcn_s_waitcnt(0);
        unsigned nloc = b.st[0], nx = b.st[1];
        if (nloc == 0u) { xcd_barrier_complete(bar, b.x, nloc, nx); b.st[0] = nloc; b.st[1] = nx; }
        const unsigned old = xb_add(&bar[XB_XSUB(b.x)], 1u);
        const unsigned gen = old / nloc;
        if (old + 1u == (gen + 1u) * nloc) {
            __builtin_amdgcn_fence(__ATOMIC_RELEASE, "agent");
            asm volatile("s_waitcnt vmcnt(0)" ::: "memory");
            const unsigned og = xb_add(&bar[XB_TOP], 1u);
            const unsigned tg = og / nx;
            if (og + 1u == (tg + 1u) * nx) xb_add(&bar[XB_TOPGEN], 1u);
            else XB_SPIN(xb_ld(&bar[XB_TOPGEN]) == tg, bar);
            __builtin_amdgcn_fence(__ATOMIC_ACQUIRE, "agent");
            xb_add(&bar[XB_XGEN(b.x)], 1u);
            asm volatile("s_waitcnt vmcnt(0)" ::: "memory");
        } else {
            XB_SPIN(xb_ld(&bar[XB_XGEN(b.x)]) == gen, bar);
            __builtin_amdgcn_fence(__ATOMIC_ACQUIRE, "agent");
            asm volatile("s_waitcnt vmcnt(0)" ::: "memory");
        }
    }
    __syncthreads();
}
constexpr int CW_BAR = 4096;
constexpr int LDS_MISC_OFF = LDS_BYTES - 256;

constexpr int NS = 11;
constexpr int K_PROLOGUE = 11, K_FINAL = 12;
template <int KIND>
__device__ __forceinline__ void run_kind(const Params& p, int L, unsigned char* lds, int bid, int nblk) {
    unsigned char* ws = p.ws;
    float* H = (float*)(ws + WS_H);
    float* rstd0 = (float*)(ws + WS_STAT); float* rstd1 = rstd0 + M; float* rstde = rstd1 + M;
    if constexpr (KIND == K_PROLOGUE) phase_prologue(p, lds, bid, nblk);
    if constexpr (KIND == K_FINAL) phase_final(p, bid, nblk);
    if constexpr (KIND == 0) { EpiProj E{(bf16*)(ws + WS_PROJ), (float*)(ws + WS_BA), rstd0};
        gemm_run(lds, (const bf16*)(ws + WS_HB0), (const bf16*)(ws + WS_WIN) + (size_t)L * IN_PAD * D, M, IN_PAD, D, E, bid, nblk); }
    if constexpr (KIND == 1) phase_att_mfma(p, L, lds, bid, nblk);
    if constexpr (KIND == 2) phase_gdn_simple(p, L, lds, bid, nblk);
    if constexpr (KIND == 3) phase_gdn_finish(p, L, bid, nblk);
    if constexpr (KIND == 4) { EpiRes E{H, (bf16*)(ws + WS_HB1)};
        gemm_run(lds, (const bf16*)(ws + WS_OBUF), (const bf16*)(ws + WS_WOUT) + (size_t)L * D * D, M, D, D, E, bid, nblk); }
    if constexpr (KIND == 5) phase_rowstat_f32(H, rstd1, bid, nblk);
    if constexpr (KIND == 6) { EpiQ2 E{(bf16*)(ws + WS_Q2), rstd1};
        gemm_run(lds, (const bf16*)(ws + WS_HB1), (const bf16*)(ws + WS_WQ) + (size_t)L * 2048 * D, M, 2048, D, E, bid, nblk);
        EpiE E2{(bf16*)(ws + WS_EPRE)};
        gemm_run(lds, (const bf16*)(ws + WS_PB) + (size_t)L * M * 256, (const bf16*)(ws + WS_WP) + (size_t)L * D * 256, M, D, 256, E2, bid, nblk); }
    if constexpr (KIND == 7) { phase_rowstat_bf16((const bf16*)(ws + WS_EPRE), rstde, bid, nblk); phase_peer_select_simple(p, L, bid, nblk); }
    if constexpr (KIND == 8) phase_peer_gather(p, L, bid, nblk);
    if constexpr (KIND == 9) { EpiPle E{H, (bf16*)(ws + WS_HB0), (const bf16*)(ws + WS_EPRE), rstde, p.ple_norm_g + L * D};
        gemm_run(lds, (const bf16*)(ws + WS_HB2), (const bf16*)(ws + WS_WG) + (size_t)L * D * D, M, D, D, E, bid, nblk); }
    if constexpr (KIND == 10) phase_rowstat_f32(H, rstd0, bid, nblk);
}

#define RUN(KIND) do { const Params* pp_ = (const Params*)__builtin_amdgcn_kernarg_segment_ptr(); int L_ = L; asm volatile("" : "+s"(pp_), "+s"(L_)); run_kind<KIND>(*pp_, L_, lds, bid, nblk); } while (0)
__global__ void __launch_bounds__(NTHREADS, 2) mk_fwd(Params p) {
    extern __shared__ __attribute__((aligned(16))) unsigned char lds[];
    const int bid = (int)blockIdx.x, nblk = (int)gridDim.x;
    volatile LAS unsigned* misc = (volatile LAS unsigned*)((LAS unsigned char*)lds + LDS_MISC_OFF);
    if (threadIdx.x < 64) misc[threadIdx.x] = 0u;
    __syncthreads();
    XcdBarrier bar = xcd_barrier_post((unsigned*)(((const Params*)__builtin_amdgcn_kernarg_segment_ptr())->ws + WS_CTL) + CW_BAR, misc + 8);
    { int L = 0; RUN(K_PROLOGUE); }
    cg::this_grid().sync();
#pragma nounroll
    for (int L = 0; L < DEPTH; ++L) {
        RUN(0); xcd_barrier(bar);
        RUN(1); xcd_barrier(bar);
        RUN(2); xcd_barrier(bar);
        RUN(3); xcd_barrier(bar);
        RUN(4); xcd_barrier(bar);
        RUN(5); xcd_barrier(bar);
        RUN(6); xcd_barrier(bar);
        RUN(7); xcd_barrier(bar);
        RUN(8); xcd_barrier(bar);
        RUN(9); xcd_barrier(bar);
        RUN(10); xcd_barrier(bar);
    }
    { int L = 0; RUN(K_FINAL); }
}

extern "C" void kernel_launch(void* const* d_in, const int* in_sizes, int n_in, void* d_out, int out_size, void* d_ws, size_t ws_size, hipStream_t stream) {
    static int grid = 0;
    if (grid == 0) {
        if (n_in != 20 || out_size != M * D || ws_size < WS_END) { fprintf(stderr, "kernel_launch: unexpected shapes (n_in %d, out %d, ws %zu < %zu)\n", n_in, out_size, ws_size, (size_t)WS_END); grid = -1; return; }
        int dev = 0, cus = 0, per_cu = 0;
        (void)hipGetDevice(&dev); (void)hipDeviceGetAttribute(&cus, hipDeviceAttributeMultiprocessorCount, dev);
        if (hipFuncSetAttribute((const void*)mk_fwd, hipFuncAttributeMaxDynamicSharedMemorySize, LDS_BYTES) != hipSuccess) { fprintf(stderr, "kernel_launch: hipFuncSetAttribute failed\n"); grid = -1; return; }
        if (hipOccupancyMaxActiveBlocksPerMultiprocessor(&per_cu, (const void*)mk_fwd, NTHREADS, LDS_BYTES) != hipSuccess || per_cu < 1) { fprintf(stderr, "kernel_launch: occupancy query says %d blocks per CU\n", per_cu); (void)hipGetLastError(); grid = -1; return; }
        grid = (cus > 0 ? cus : 256);
    }
    if (grid < 0) return;
    (void)hipMemsetAsync((char*)d_ws + WS_CTL, 0, CTL_ZERO_BYTES, stream);
    Params p{};
    const float** pp = (const float**)&p;
    for (int i = 0; i < 20; ++i) pp[i] = (const float*)d_in[i];
    p.out = (float*)d_out; p.ws = (unsigned char*)d_ws;
    void* args[] = {&p};
    hipError_t e = hipLaunchCooperativeKernel((const void*)mk_fwd, dim3(grid), dim3(NTHREADS), args, LDS_BYTES, stream);
    if (e != hipSuccess) fprintf(stderr, "kernel_launch: cooperative launch failed: %s (grid %d)\n", hipGetErrorString(e), grid);
}
```

```cpp
#include <hip/hip_runtime.h>
#include <hip/hip_cooperative_groups.h>
#include <cstdio>
#include <cstdint>
namespace cg = cooperative_groups;

typedef unsigned short bf16;
typedef float f32x4 __attribute__((ext_vector_type(4)));
typedef short bf16x8 __attribute__((ext_vector_type(8)));
typedef unsigned u32x4 __attribute__((ext_vector_type(4)));
typedef unsigned u32x2 __attribute__((ext_vector_type(2)));

constexpr int D = 1024, BATCH = 8, SEQ = 2048, DEPTH = 4, M = BATCH * SEQ;
constexpr int IN_COLS = 3592, IN_PAD = 3840, PROJ_W = 3584;
constexpr int NEXP = 16384;
constexpr float EPS = 1e-6f;
constexpr float QSCALE = 0.125f * 1.4426950408889634f;
constexpr int NWAVES = 8, NTHREADS = 512;
constexpr int LDS_BYTES = 147456;

constexpr size_t MiB = 1u << 20;
constexpr size_t WS_CTL = 0, CTL_ZERO_BYTES = 1 * MiB;
constexpr size_t WS_H = 1 * MiB;
constexpr size_t WS_HB0 = 65 * MiB;
constexpr size_t WS_HB1 = 97 * MiB;
constexpr size_t WS_HB2 = 129 * MiB;
constexpr size_t WS_PROJ = 161 * MiB;
constexpr size_t WS_BA = 273 * MiB;
constexpr size_t WS_OBUF = 274 * MiB;
constexpr size_t WS_Q2 = 306 * MiB;
constexpr size_t WS_EPRE = 370 * MiB;
constexpr size_t WS_IDX = 402 * MiB;
constexpr size_t WS_GATE = 410 * MiB;
constexpr size_t WS_STAT = 418 * MiB;
constexpr size_t WS_ORAW = 422 * MiB;
constexpr size_t WS_WIN = 550 * MiB;
constexpr size_t WS_WOUT = 582 * MiB;
constexpr size_t WS_WQ = 590 * MiB;
constexpr size_t WS_WG = 606 * MiB;
constexpr size_t WS_WP = 614 * MiB;
constexpr size_t WS_SK = 616 * MiB;
constexpr size_t WS_PB = 618 * MiB;
constexpr size_t WS_U = 650 * MiB;
constexpr size_t WS_V = 778 * MiB;
constexpr size_t WS_END = 906 * MiB;

struct Params {
    const float *x, *p, *ln_mix_g, *w_in, *conv_w, *a_log, *dt_bias, *gdn_norm_g, *diff_lambda, *subln_g, *w_out, *ln_ffn_g,
        *peer_wq, *subkeys, *peer_u, *peer_v, *ple_wp, *ple_wg, *ple_norm_g, *final_g;
    float* out;
    unsigned char* ws;
    int pad0, pad1;
};

__device__ __forceinline__ int tidx() { int t = (int)threadIdx.x; asm volatile("" : "+v"(t)); return t; }
__device__ __forceinline__ float bf2f(bf16 v) { return __uint_as_float((unsigned)v << 16); }
__device__ __forceinline__ unsigned f2bf(float f) { unsigned u = __float_as_uint(f); return (u + 0x7fffu + ((u >> 16) & 1u)) >> 16; }
__device__ __forceinline__ unsigned pk2(float lo, float hi) { return f2bf(lo) | (f2bf(hi) << 16); }
__device__ __forceinline__ float lo16(unsigned w) { return __uint_as_float(w << 16); }
__device__ __forceinline__ float hi16(unsigned w) { return __uint_as_float(w & 0xffff0000u); }
__device__ __forceinline__ float wave_sum(float v) {
#pragma unroll
    for (int o = 32; o; o >>= 1) v += __shfl_xor(v, o);
    return v;
}
__device__ __forceinline__ float wave_max(float v) {
#pragma unroll
    for (int o = 32; o; o >>= 1) v = fmaxf(v, __shfl_xor(v, o));
    return v;
}
__device__ __forceinline__ float sigmoidf_(float x) { return 1.f / (1.f + __expf(-x)); }
__device__ __forceinline__ float dot8(u32x4 a, u32x4 b, float s) {
#pragma unroll
    for (int i = 0; i < 4; ++i) { s += lo16(a[i]) * lo16(b[i]); s += hi16(a[i]) * hi16(b[i]); }
    return s;
}

#define LAS __attribute__((address_space(3)))
__host__ __device__ __forceinline__ int lds_byte(int r, int c) { const int st = (r >> 4) * 2 + (c >> 5), rr = r & 15, cc = c & 31, ob = rr * 64 + cc * 2; return st * 1024 + (ob ^ (((ob >> 9) & 1) << 5)); }
__host__ __device__ __forceinline__ void stage_rc(int b, int& R, int& C) { const int st = b / 1024, sb = b % 1024, swz = sb ^ (((sb >> 9) & 1) << 5); R = (st >> 1) * 16 + swz / 64; C = (st & 1) * 32 + (swz % 64) / 2; }
constexpr int HTB = 16384;
template <class F>
__device__ __forceinline__ void gemm_run(unsigned char* lds_, const bf16* A, const bf16* Bt, int Mm, int N, int K, const F& f, int bid, int nblk) {
    LAS unsigned char* lds = (LAS unsigned char*)lds_;
    const int tid = tidx(), wid = __builtin_amdgcn_readfirstlane(tid >> 6), lane = tid & 63, wr = wid >> 1, wc = wid & 1, fr = lane & 15, fq = lane >> 4;
    const int nt = K / 64, ntn = N / 128, nunits = (Mm / 256) * ntn;
    unsigned voff[2];
#pragma unroll
    for (int i = 0; i < 2; ++i) { int R, C; stage_rc(tid * 16 + i * 8192, R, C); voff[i] = (unsigned)(R * K + C) * 2u; }
    const unsigned ldsw = (unsigned)wid * 1024u;
    const int aoff = (wr >> 1) * HTB + lds_byte((wr & 1) * 64 + fr, fq * 8), boff = 2 * HTB + lds_byte(wc * 64 + fr, fq * 8);
#define G_STAGE(bufoff, gbase) do { _Pragma("unroll") for (int _i = 0; _i < 2; ++_i) \
        __builtin_amdgcn_global_load_lds((const unsigned*)((const char*)(gbase) + voff[_i]), (LAS unsigned*)(lds + (bufoff) + ldsw + _i * 8192), 16, 0, 0); } while (0)
    for (int u = bid; u < nunits; u += nblk) {
        const int pm = u % (Mm / 256), pn = u / (Mm / 256);
        const char* gA = (const char*)(A + (size_t)pm * 256 * K);
        const char* gB = (const char*)(Bt + (size_t)pn * 128 * K);
        const size_t hstep = (size_t)128 * K * 2;
        f32x4 acc[4][4];
#pragma unroll
        for (int a = 0; a < 4; ++a)
#pragma unroll
            for (int b = 0; b < 4; ++b) acc[a][b] = (f32x4){0.f, 0.f, 0.f, 0.f};
        G_STAGE(0, gA); G_STAGE(HTB, gA + hstep); G_STAGE(2 * HTB, gB);
        for (int t = 0; t < nt; ++t) {
            const int cur = (t & 1) * 3 * HTB, nxt = ((t + 1) & 1) * 3 * HTB;
            asm volatile("s_waitcnt vmcnt(0)" ::: "memory");
            __syncthreads();
            if (t + 1 < nt) { const size_t ko = (size_t)(t + 1) * 128; G_STAGE(nxt, gA + ko); G_STAGE(nxt + HTB, gA + hstep + ko); G_STAGE(nxt + 2 * HTB, gB + ko); }
            bf16x8 af[4][2], bfr[4][2];
#pragma unroll
            for (int m = 0; m < 4; ++m)
#pragma unroll
                for (int k = 0; k < 2; ++k) af[m][k] = *(const LAS bf16x8*)(lds + cur + aoff + m * 2048 + k * 1024);
#pragma unroll
            for (int n = 0; n < 4; ++n)
#pragma unroll
                for (int k = 0; k < 2; ++k) bfr[n][k] = *(const LAS bf16x8*)(lds + cur + boff + n * 2048 + k * 1024);
#pragma unroll
            for (int k = 0; k < 2; ++k)
#pragma unroll
                for (int m = 0; m < 4; ++m)
#pragma unroll
                    for (int n = 0; n < 4; ++n) acc[m][n] = __builtin_amdgcn_mfma_f32_16x16x32_bf16(bfr[n][k], af[m][k], acc[m][n], 0, 0, 0);
        }
#pragma unroll
        for (int m = 0; m < 4; ++m) {
            const int row = pm * 256 + wr * 64 + m * 16 + fr;
#pragma unroll
            for (int n = 0; n < 4; ++n) f(row, pn * 128 + wc * 64 + n * 16 + 4 * fq, acc[m][n]);
        }
        __syncthreads();
    }
#undef G_STAGE
}

__device__ __forceinline__ u32x2 pk4(f32x4 a) { u32x2 o; o.x = pk2(a[0], a[1]); o.y = pk2(a[2], a[3]); return o; }
struct EpiProj {
    bf16* proj; float* ba; const float* rstd;
    __device__ __forceinline__ void operator()(int row, int col, f32x4 v) const {
        v = v * rstd[row];
        if (col < PROJ_W) *(u32x2*)(proj + (size_t)row * PROJ_W + col) = pk4(v);
        else if (col < IN_COLS) *(f32x4*)(ba + (size_t)row * 8 + (col - PROJ_W)) = v;
    }
};
struct EpiRes {
    float* H; bf16* HB;
    __device__ __forceinline__ void operator()(int row, int col, f32x4 v) const {
        f32x4* hp = (f32x4*)(H + (size_t)row * D + col);
        const f32x4 h = *hp + v; *hp = h;
        *(u32x2*)(HB + (size_t)row * D + col) = pk4(h);
    }
};
struct EpiQ2 {
    bf16* Q2; const float* rstd;
    __device__ __forceinline__ void operator()(int row, int col, f32x4 v) const { *(u32x2*)(Q2 + (size_t)row * 2048 + col) = pk4(v * rstd[row]); }
};
struct EpiE {
    bf16* E;
    __device__ __forceinline__ void operator()(int row, int col, f32x4 v) const { *(u32x2*)(E + (size_t)row * D + col) = pk4(v); }
};
struct EpiPle {
    float* H; bf16* HB; const bf16* E; const float* rstde; const float* g;
    __device__ __forceinline__ void operator()(int row, int col, f32x4 v) const {
        f32x4* hp = (f32x4*)(H + (size_t)row * D + col);
        const u32x2 ev = *(const u32x2*)(E + (size_t)row * D + col);
        const f32x4 gv = *(const f32x4*)(g + col);
        const float r = rstde[row];
        f32x4 h = *hp;
        h[0] += sigmoidf_(v[0]) * (lo16(ev.x) * r * gv[0]); h[1] += sigmoidf_(v[1]) * (hi16(ev.x) * r * gv[1]);
        h[2] += sigmoidf_(v[2]) * (lo16(ev.y) * r * gv[2]); h[3] += sigmoidf_(v[3]) * (hi16(ev.y) * r * gv[3]);
        *hp = h;
        *(u32x2*)(HB + (size_t)row * D + col) = pk4(h);
    }
};

__device__ __forceinline__ void transpose_item(const float* W, int K, int N, int Npad, bf16* WT, const float* rowscale, int qcols, float* scr, int item, int lane) {
    const int nblk = Npad / 32, kb = item / nblk, nb = item % nblk, k0 = 64 * kb, n0 = 32 * nb;
    const int n = n0 + (lane & 31);
#pragma unroll 8
    for (int i = 0; i < 32; ++i) {
        const int kk = 2 * i + (lane >> 5);
        float v = (n < N) ? W[(size_t)(k0 + kk) * N + n] : 0.f;
        if (rowscale) v *= rowscale[k0 + kk];
        if (n < qcols) v *= QSCALE;
        scr[kk * 33 + (lane & 31)] = v;
    }
    asm volatile("s_waitcnt lgkmcnt(0)" ::: "memory");
    const int c = lane & 7;
#pragma unroll
    for (int j = 0; j < 4; ++j) {
        const int nn = (lane >> 3) + 8 * j; const float* s = scr + (8 * c) * 33 + nn;
        u32x4 o; o.x = pk2(s[0 * 33], s[1 * 33]); o.y = pk2(s[2 * 33], s[3 * 33]); o.z = pk2(s[4 * 33], s[5 * 33]); o.w = pk2(s[6 * 33], s[7 * 33]);
        *(u32x4*)(WT + (size_t)(n0 + nn) * K + k0 + 8 * c) = o;
    }
    asm volatile("s_waitcnt lgkmcnt(0)" ::: "memory");
}
__device__ __forceinline__ void convert_bulk(const float* src, bf16* dst, size_t n, size_t gtid, size_t nthr) {
    for (size_t i = gtid * 8; i < n; i += nthr * 8) {
        const f32x4 a = *(const f32x4*)(src + i), b = *(const f32x4*)(src + i + 4);
        u32x4 o; o.x = pk2(a[0], a[1]); o.y = pk2(a[2], a[3]); o.z = pk2(b[0], b[1]); o.w = pk2(b[2], b[3]);
        *(u32x4*)(dst + i) = o;
    }
}
__device__ void phase_prologue(const Params& p, unsigned char* lds, int bid, int nblk) {
    const int tid = tidx(), lane = tid & 63, w = tid >> 6;
    const int gw = bid * NWAVES + w, NGW = nblk * NWAVES;
    float* scr = (float*)(lds + w * 16384);
    constexpr int I_IN = 16 * (IN_PAD / 32), I_OUT = 16 * 32, I_Q = 16 * 64, I_G = 16 * 32, I_P = 4 * 32, I_L = I_IN + I_OUT + I_Q + I_G + I_P;
    for (int it = gw; it < DEPTH * I_L; it += NGW) {
        const int L = it / I_L; int r = it % I_L;
        if (r < I_IN) { transpose_item(p.w_in + (size_t)L * D * IN_COLS, D, IN_COLS, IN_PAD, (bf16*)(p.ws + WS_WIN) + (size_t)L * IN_PAD * D, p.ln_mix_g + L * D, 512, scr, r, lane); continue; } r -= I_IN;
        if (r < I_OUT) { transpose_item(p.w_out + (size_t)L * D * D, D, D, D, (bf16*)(p.ws + WS_WOUT) + (size_t)L * D * D, nullptr, 0, scr, r, lane); continue; } r -= I_OUT;
        if (r < I_Q) { transpose_item(p.peer_wq + (size_t)L * D * 2048, D, 2048, 2048, (bf16*)(p.ws + WS_WQ) + (size_t)L * 2048 * D, p.ln_ffn_g + L * D, 0, scr, r, lane); continue; } r -= I_Q;
        if (r < I_G) { transpose_item(p.ple_wg + (size_t)L * D * D, D, D, D, (bf16*)(p.ws + WS_WG) + (size_t)L * D * D, nullptr, 0, scr, r, lane); continue; } r -= I_G;
        transpose_item(p.ple_wp + (size_t)L * 256 * D, 256, D, D, (bf16*)(p.ws + WS_WP) + (size_t)L * D * 256, nullptr, 0, scr, r, lane);
    }
    const size_t gtid = (size_t)bid * NTHREADS + tid, nthr = (size_t)nblk * NTHREADS;
    convert_bulk(p.peer_u, (bf16*)(p.ws + WS_U), (size_t)DEPTH * NEXP * D, gtid, nthr);
    convert_bulk(p.peer_v, (bf16*)(p.ws + WS_V), (size_t)DEPTH * NEXP * D, gtid, nthr);
    convert_bulk(p.p, (bf16*)(p.ws + WS_PB), (size_t)DEPTH * M * 256, gtid, nthr);
    convert_bulk(p.subkeys, (bf16*)(p.ws + WS_SK), (size_t)DEPTH * 8 * 2 * 128 * 128, gtid, nthr);
    float* H = (float*)(p.ws + WS_H); bf16* HB0 = (bf16*)(p.ws + WS_HB0); float* rstd0 = (float*)(p.ws + WS_STAT);
    for (int m = gw; m < M; m += NGW) {
        const f32x4* xr = (const f32x4*)(p.x + (size_t)m * D) + lane;
        float ss = 0.f;
#pragma unroll
        for (int j = 0; j < 4; ++j) {
            const f32x4 v = xr[64 * j];
            ss += v[0] * v[0] + v[1] * v[1] + v[2] * v[2] + v[3] * v[3];
            ((f32x4*)(H + (size_t)m * D))[lane + 64 * j] = v;
            u32x2 o; o.x = pk2(v[0], v[1]); o.y = pk2(v[2], v[3]);
            ((u32x2*)(HB0 + (size_t)m * D))[lane + 64 * j] = o;
        }
        ss = wave_sum(ss);
        if (lane == 0) rstd0[m] = rsqrtf(ss * (1.f / D) + EPS);
    }
}

__device__ void phase_rowstat_f32(const float* src, float* rstd, int bid, int nblk) {
    const int tid = tidx(), lane = tid & 63, gw = bid * NWAVES + (tid >> 6), NGW = nblk * NWAVES;
    for (int m = gw; m < M; m += NGW) {
        const f32x4* xr = (const f32x4*)(src + (size_t)m * D) + lane;
        float ss = 0.f;
#pragma unroll
        for (int j = 0; j < 4; ++j) { const f32x4 v = xr[64 * j]; ss += v[0] * v[0] + v[1] * v[1] + v[2] * v[2] + v[3] * v[3]; }
        ss = wave_sum(ss);
        if (lane == 0) rstd[m] = rsqrtf(ss * (1.f / D) + EPS);
    }
}
__device__ void phase_rowstat_bf16(const bf16* src, float* rstd, int bid, int nblk) {
    const int tid = tidx(), lane = tid & 63, gw = bid * NWAVES + (tid >> 6), NGW = nblk * NWAVES;
    for (int m = gw; m < M; m += NGW) {
        const u32x4* xr = (const u32x4*)(src + (size_t)m * D) + lane;
        float ss = 0.f;
#pragma unroll
        for (int j = 0; j < 2; ++j) { const u32x4 v = xr[64 * j];
#pragma unroll
            for (int i = 0; i < 4; ++i) { const float a = lo16(v[i]), b = hi16(v[i]); ss += a * a + b * b; } }
        ss = wave_sum(ss);
        if (lane == 0) rstd[m] = rsqrtf(ss * (1.f / D) + EPS);
    }
}

typedef short v4i16_t __attribute__((ext_vector_type(4)));
typedef __bf16 bf16x2_t __attribute__((ext_vector_type(2)));
typedef float f32x2_t __attribute__((ext_vector_type(2)));
__device__ __forceinline__ unsigned cvtpk(float lo, float hi) { f32x2_t v = {lo, hi}; bf16x2_t b = __builtin_convertvector(v, bf16x2_t); return __builtin_bit_cast(unsigned, b); }
__device__ __forceinline__ float xrow16_max(float x) {
    auto s = __builtin_amdgcn_permlane16_swap(__float_as_uint(x), __float_as_uint(x), false, false);
    x = fmaxf(__uint_as_float(s[0]), __uint_as_float(s[1]));
    auto t = __builtin_amdgcn_permlane32_swap(__float_as_uint(x), __float_as_uint(x), false, false);
    return fmaxf(__uint_as_float(t[0]), __uint_as_float(t[1]));
}
__device__ __forceinline__ float xrow16_sum(float x) {
    auto s = __builtin_amdgcn_permlane16_swap(__float_as_uint(x), __float_as_uint(x), false, false);
    x = __uint_as_float(s[0]) + __uint_as_float(s[1]);
    auto t = __builtin_amdgcn_permlane32_swap(__float_as_uint(x), __float_as_uint(x), false, false);
    return __uint_as_float(t[0]) + __uint_as_float(t[1]);
}
constexpr int ATT_VOFF = 16384, ATT_VPITCH = 288;
__device__ void phase_att_mfma(const Params& p, int L, unsigned char* lds_, int bid, int nblk) {
    LAS unsigned char* lds = (LAS unsigned char*)lds_;
    const int tid = tidx(), lane = tid & 63, w = __builtin_amdgcn_readfirstlane(tid >> 6), fr = lane & 15, fq = lane >> 4;
    const bf16* proj = (const bf16*)(p.ws + WS_PROJ);
    bf16* obuf = (bf16*)(p.ws + WS_OBUF);
    const float* lp = p.diff_lambda + L * 256;
    const float d1 = wave_sum(lp[lane] * lp[64 + lane]), d2 = wave_sum(lp[128 + lane] * lp[192 + lane]);
    const float lam_init = 0.8f - 0.6f * expf(-0.3f * (float)L);
    const float lam = expf(d1) - expf(d2) + lam_init;
    for (int item = bid; item < 256; item += nblk) {
        const int bh = item >> 3, jj = item & 7, b = bh >> 2, hh = bh & 3;
        const float slope2 = exp2f(-2.f * (float)(hh + 1)) * 1.4426950408889634f;
        const bf16* kbase = proj + (size_t)b * SEQ * PROJ_W + 512 + hh * 128;
        const bf16* vbase = proj + (size_t)b * SEQ * PROJ_W + 1024 + hh * 128;
        for (int half = 0; half < 2; ++half) {
            const int qb = half == 0 ? 15 - jj : jj;
            const int qw0 = qb * 128 + w * 16, T = 2 * (qb + 1);
            bf16x8 qf[2][2];
#pragma unroll
            for (int mp = 0; mp < 2; ++mp)
#pragma unroll
                for (int ks = 0; ks < 2; ++ks) qf[mp][ks] = *(const bf16x8*)(proj + ((size_t)b * SEQ + qw0 + fr) * PROJ_W + hh * 128 + mp * 64 + ks * 32 + 8 * fq);
            f32x4 o[2][8];
#pragma unroll
            for (int mp = 0; mp < 2; ++mp)
#pragma unroll
                for (int dt = 0; dt < 8; ++dt) o[mp][dt] = (f32x4){0.f, 0.f, 0.f, 0.f};
            float mrun[2] = {-INFINITY, -INFINITY}, lrun[2] = {0.f, 0.f};
            u32x4 kreg[2], vreg[2];
#pragma unroll
            for (int i = 0; i < 2; ++i) { const int c = tid + 512 * i, key = c >> 4, ch = c & 15;
                kreg[i] = *(const u32x4*)(kbase + (size_t)key * PROJ_W + ch * 8); vreg[i] = *(const u32x4*)(vbase + (size_t)key * PROJ_W + ch * 8); }
            for (int t = 0; t < T; ++t) {
                const int k0 = t * 64;
#pragma unroll
                for (int i = 0; i < 2; ++i) { const int c = tid + 512 * i, key = c >> 4, ch = c & 15;
                    *(LAS u32x4*)(lds + key * 256 + ((ch ^ (key & 15)) << 4)) = kreg[i];
                    *(LAS u32x4*)(lds + ATT_VOFF + key * ATT_VPITCH + ch * 16) = vreg[i]; }
                __syncthreads();
                if (t + 1 < T) {
#pragma unroll
                    for (int i = 0; i < 2; ++i) { const int c = tid + 512 * i, key = k0 + 64 + (c >> 4), ch = c & 15;
                        kreg[i] = *(const u32x4*)(kbase + (size_t)key * PROJ_W + ch * 8); vreg[i] = *(const u32x4*)(vbase + (size_t)key * PROJ_W + ch * 8); }
                }
                if (k0 <= qw0 + 15) {
                    f32x4 s[2][4];
                    const float base = -slope2 * (float)(qw0 + fr - k0 - 4 * fq);
#pragma unroll
                    for (int kt = 0; kt < 4; ++kt)
#pragma unroll
                        for (int r = 0; r < 4; ++r) { const float v = base + slope2 * (float)(16 * kt + r); s[0][kt][r] = v; s[1][kt][r] = v; }
#pragma unroll
                    for (int mp = 0; mp < 2; ++mp)
#pragma unroll
                        for (int kt = 0; kt < 4; ++kt)
#pragma unroll
                            for (int ks = 0; ks < 2; ++ks) {
                                const bf16x8 kf = *(const LAS bf16x8*)(lds + (16 * kt + fr) * 256 + (((mp * 8 + ks * 4 + fq) ^ fr) << 4));
                                s[mp][kt] = __builtin_amdgcn_mfma_f32_16x16x32_bf16(kf, qf[mp][ks], s[mp][kt], 0, 0, 0);
                            }
                    if (k0 + 63 > qw0) {
                        const int lim = qw0 + fr - k0 - 4 * fq;
#pragma unroll
                        for (int mp = 0; mp < 2; ++mp)
#pragma unroll
                            for (int kt = 0; kt < 4; ++kt)
#pragma unroll
                                for (int r = 0; r < 4; ++r) if (16 * kt + r > lim) s[mp][kt][r] = -INFINITY;
                    }
                    bf16x8 pb[2][2];
#pragma unroll
                    for (int mp = 0; mp < 2; ++mp) {
                        float mx = fmaxf(fmaxf(s[mp][0][0], s[mp][0][1]), fmaxf(s[mp][0][2], s[mp][0][3]));
#pragma unroll
                        for (int kt = 1; kt < 4; ++kt) mx = fmaxf(mx, fmaxf(fmaxf(s[mp][kt][0], s[mp][kt][1]), fmaxf(s[mp][kt][2], s[mp][kt][3])));
                        mx = xrow16_max(mx);
                        const float mnew = fmaxf(mrun[mp], mx);
                        const float alpha = __builtin_amdgcn_exp2f(mrun[mp] - mnew);
                        mrun[mp] = mnew;
                        float ps = 0.f;
#pragma unroll
                        for (int kt = 0; kt < 4; ++kt)
#pragma unroll
                            for (int r = 0; r < 4; ++r) { const float e = __builtin_amdgcn_exp2f(s[mp][kt][r] - mnew); s[mp][kt][r] = e; ps += e; }
                        lrun[mp] = lrun[mp] * alpha + ps;
#pragma unroll
                        for (int dt = 0; dt < 8; ++dt) o[mp][dt] = o[mp][dt] * alpha;
#pragma unroll
                        for (int ks = 0; ks < 2; ++ks) {
                            u32x4 pk; pk.x = cvtpk(s[mp][2 * ks][0], s[mp][2 * ks][1]); pk.y = cvtpk(s[mp][2 * ks][2], s[mp][2 * ks][3]);
                            pk.z = cvtpk(s[mp][2 * ks + 1][0], s[mp][2 * ks + 1][1]); pk.w = cvtpk(s[mp][2 * ks + 1][2], s[mp][2 * ks + 1][3]);
                            pb[mp][ks] = __builtin_bit_cast(bf16x8, pk);
                        }
                    }
                    const int gl = lane & 15;
                    LAS unsigned char* vrd = lds + ATT_VOFF + (4 * fq + (gl >> 2)) * ATT_VPITCH + (gl & 3) * 8;
#pragma unroll
                    for (int dt = 0; dt < 8; ++dt)
#pragma unroll
                        for (int ks = 0; ks < 2; ++ks) {
                            const v4i16_t v0 = __builtin_amdgcn_ds_read_tr16_b64_v4i16((LAS v4i16_t*)(vrd + (32 * ks) * ATT_VPITCH + dt * 32));
                            const v4i16_t v1 = __builtin_amdgcn_ds_read_tr16_b64_v4i16((LAS v4i16_t*)(vrd + (32 * ks + 16) * ATT_VPITCH + dt * 32));
                            bf16x8 vf; vf[0] = v0[0]; vf[1] = v0[1]; vf[2] = v0[2]; vf[3] = v0[3]; vf[4] = v1[0]; vf[5] = v1[1]; vf[6] = v1[2]; vf[7] = v1[3];
                            o[0][dt] = __builtin_amdgcn_mfma_f32_16x16x32_bf16(vf, pb[0][ks], o[0][dt], 0, 0, 0);
                            o[1][dt] = __builtin_amdgcn_mfma_f32_16x16x32_bf16(vf, pb[1][ks], o[1][dt], 0, 0, 0);
                        }
                }
                __syncthreads();
            }
            const float i1 = 1.f / xrow16_sum(lrun[0]), i2 = lam / xrow16_sum(lrun[1]);
            float ss = 0.f;
#pragma unroll
            for (int dt = 0; dt < 8; ++dt)
#pragma unroll
                for (int r = 0; r < 4; ++r) { const float v = o[0][dt][r] * i1 - o[1][dt][r] * i2; o[0][dt][r] = v; ss += v * v; }
            ss = xrow16_sum(ss);
            const float rn = rsqrtf(ss * (1.f / 128.f) + EPS) * (1.f - lam_init);
            const float* g = p.subln_g + L * 128;
            bf16* orow = obuf + ((size_t)b * SEQ + qw0 + fr) * D + hh * 128;
#pragma unroll
            for (int dt = 0; dt < 8; ++dt) {
                const f32x4 gv = *(const f32x4*)(g + 16 * dt + 4 * fq);
                u32x2 ov; ov.x = pk2(o[0][dt][0] * rn * gv[0], o[0][dt][1] * rn * gv[1]); ov.y = pk2(o[0][dt][2] * rn * gv[2], o[0][dt][3] * rn * gv[3]);
                *(u32x2*)(orow + 16 * dt + 4 * fq) = ov;
            }
        }
    }
}

constexpr size_t GD_WP = WS_ORAW, GD_QD = WS_ORAW + 16 * MiB, GD_AIP = WS_ORAW + 32 * MiB, GD_KDT = WS_ORAW + 40 * MiB, GD_UT = WS_ORAW + 56 * MiB, GD_GL = WS_ORAW + 72 * MiB;
__device__ __forceinline__ int perm_pos(int k) { return (k & ~31) + 8 * ((k >> 2) & 3) + 4 * ((k >> 4) & 1) + (k & 3); }
template <int N> __device__ __forceinline__ float dpp_ror(float x) { return __builtin_bit_cast(float, __builtin_amdgcn_mov_dpp(__builtin_bit_cast(int, x), 0x120 + N, 0xf, 0xf, true)); }
__device__ __forceinline__ float row16_sum(float x) { x += dpp_ror<8>(x); x += dpp_ror<4>(x); x += dpp_ror<2>(x); x += dpp_ror<1>(x); return x; }
__device__ __forceinline__ float softplusf_(float x) { return x > 20.f ? x : log1pf(expf(x)); }

constexpr int GP_KN = 0, GP_QN = 17408, GP_RT = 34816, GP_LM = 71680, GP_TB = 89088, GP_GT = 98304;
constexpr int GP_KP = 272, GP_RP = 144, GP_LP = 68, GP_TP = 144;
__device__ void phase_gdn_prep(const Params& p, int L, unsigned char* lds_, int bid, int nblk) {
    LAS unsigned char* lds = (LAS unsigned char*)lds_;
    const int tid = tidx(), lane = tid & 63, w = __builtin_amdgcn_readfirstlane(tid >> 6), fr = lane & 15, fq = lane >> 4;
    const bf16* proj = (const bf16*)(p.ws + WS_PROJ);
    const float* BA = (const float*)(p.ws + WS_BA);
    bf16* WP = (bf16*)(p.ws + GD_WP); bf16* QD = (bf16*)(p.ws + GD_QD); bf16* AIP = (bf16*)(p.ws + GD_AIP); bf16* KDT = (bf16*)(p.ws + GD_KDT); bf16* UT = (bf16*)(p.ws + GD_UT);
    float* GL = (float*)(p.ws + GD_GL);
    const float* cw = p.conv_w + (size_t)L * 4 * 1536;
    LAS float* beta_s = (LAS float*)(lds + GP_GT); LAS float* gc_s = beta_s + 64; LAS float* egc_s = gc_s + 64; LAS float* edl_s = egc_s + 64;
    LAS float* Lm = (LAS float*)(lds + GP_LM);
    for (int item = bid; item < 1024; item += nblk) {
        const int n = item & 31, bh = item >> 5, hh = bh & 3, b = bh >> 2, t0 = n * 64;
        const size_t row0 = (size_t)b * SEQ + t0;
        __syncthreads();
        if (w == 0) {
            const float negA = -expf(p.a_log[L * 4 + hh]), dtb = p.dt_bias[L * 4 + hh];
            const float bb = BA[(row0 + lane) * 8 + hh], aa = BA[(row0 + lane) * 8 + 4 + hh] + dtb;
            float c = negA * softplusf_(aa);
#pragma unroll
            for (int o = 1; o < 64; o <<= 1) { const float t = __shfl_up(c, o); if (lane >= o) c += t; }
            const float glast = __shfl(c, 63);
            beta_s[lane] = sigmoidf_(bb); gc_s[lane] = c; egc_s[lane] = expf(c); edl_s[lane] = expf(glast - c);
            if (lane == 0) GL[item] = expf(glast);
        }
        __syncthreads();
        {
            const int colq = hh * 128 + 2 * lane;
            {
                float wq[4][2]; unsigned xq[11];
#pragma unroll
                for (int j = 0; j < 4; ++j) { wq[j][0] = cw[j * 1536 + colq]; wq[j][1] = cw[j * 1536 + colq + 1]; }
#pragma unroll
                for (int r = 0; r < 11; ++r) { const int tt = t0 + 8 * w - 3 + r; xq[r] = (tt >= 0) ? *(const unsigned*)(proj + ((size_t)b * SEQ + tt) * PROJ_W + 1536 + colq) : 0u; }
#pragma unroll
                for (int i = 0; i < 8; ++i) {
                    const int c = 8 * w + i;
                    float q0 = 0.f, q1 = 0.f;
#pragma unroll
                    for (int j = 0; j < 4; ++j) { q0 += wq[j][0] * lo16(xq[i + j]); q1 += wq[j][1] * hi16(xq[i + j]); }
                    q0 *= sigmoidf_(q0); q1 *= sigmoidf_(q1);
                    const float sq = rsqrtf(wave_sum(q0 * q0 + q1 * q1) + EPS) * 0.08838834764831845f;
                    q0 *= sq; q1 *= sq;
                    const float eg = egc_s[c];
                    *(LAS unsigned*)(lds + GP_QN + c * GP_KP + lane * 4) = pk2(q0, q1);
                    *(unsigned*)(QD + ((size_t)item * 64 + c) * 128 + perm_pos(2 * lane)) = pk2(q0 * eg, q1 * eg);
                }
            }
            __builtin_amdgcn_sched_barrier(0);
            {
                float wk[4][2]; unsigned xk[11];
#pragma unroll
                for (int j = 0; j < 4; ++j) { wk[j][0] = cw[j * 1536 + 512 + colq]; wk[j][1] = cw[j * 1536 + 512 + colq + 1]; }
#pragma unroll
                for (int r = 0; r < 11; ++r) { const int tt = t0 + 8 * w - 3 + r; xk[r] = (tt >= 0) ? *(const unsigned*)(proj + ((size_t)b * SEQ + tt) * PROJ_W + 1536 + 512 + colq) : 0u; }
                unsigned kd0[8], kd1[8], rk0[8], rk1[8];
#pragma unroll
                for (int i = 0; i < 8; ++i) {
                    const int c = 8 * w + i;
                    float k0 = 0.f, k1 = 0.f;
#pragma unroll
                    for (int j = 0; j < 4; ++j) { k0 += wk[j][0] * lo16(xk[i + j]); k1 += wk[j][1] * hi16(xk[i + j]); }
                    k0 *= sigmoidf_(k0); k1 *= sigmoidf_(k1);
                    const float sk = rsqrtf(wave_sum(k0 * k0 + k1 * k1) + EPS);
                    k0 *= sk; k1 *= sk;
                    const float be = beta_s[c], eg = egc_s[c], ed = edl_s[c];
                    *(LAS unsigned*)(lds + GP_KN + c * GP_KP + lane * 4) = pk2(k0, k1);
                    kd0[i] = f2bf(k0 * ed); kd1[i] = f2bf(k1 * ed);
                    rk0[i] = f2bf(k0 * be * eg); rk1[i] = f2bf(k1 * be * eg);
                }
                u32x4 o;
                o.x = rk0[0] | (rk0[1] << 16); o.y = rk0[2] | (rk0[3] << 16); o.z = rk0[4] | (rk0[5] << 16); o.w = rk0[6] | (rk0[7] << 16); *(LAS u32x4*)(lds + GP_RT + (128 + 2 * lane) * GP_RP + 16 * w) = o;
                o.x = rk1[0] | (rk1[1] << 16); o.y = rk1[2] | (rk1[3] << 16); o.z = rk1[4] | (rk1[5] << 16); o.w = rk1[6] | (rk1[7] << 16); *(LAS u32x4*)(lds + GP_RT + (128 + 2 * lane + 1) * GP_RP + 16 * w) = o;
                const int pa = perm_pos(8 * w), pb = perm_pos(8 * w + 4);
                bf16* kr0 = KDT + ((size_t)item * 128 + 2 * lane) * 64; bf16* kr1 = kr0 + 64;
                u32x2 h2;
                h2.x = kd0[0] | (kd0[1] << 16); h2.y = kd0[2] | (kd0[3] << 16); *(u32x2*)(kr0 + pa) = h2;
                h2.x = kd0[4] | (kd0[5] << 16); h2.y = kd0[6] | (kd0[7] << 16); *(u32x2*)(kr0 + pb) = h2;
                h2.x = kd1[0] | (kd1[1] << 16); h2.y = kd1[2] | (kd1[3] << 16); *(u32x2*)(kr1 + pa) = h2;
                h2.x = kd1[4] | (kd1[5] << 16); h2.y = kd1[6] | (kd1[7] << 16); *(u32x2*)(kr1 + pb) = h2;
            }
            __builtin_amdgcn_sched_barrier(0);
            {
                float wv[4][2]; unsigned xv[11];
#pragma unroll
                for (int j = 0; j < 4; ++j) { wv[j][0] = cw[j * 1536 + 1024 + colq]; wv[j][1] = cw[j * 1536 + 1024 + colq + 1]; }
#pragma unroll
                for (int r = 0; r < 11; ++r) { const int tt = t0 + 8 * w - 3 + r; xv[r] = (tt >= 0) ? *(const unsigned*)(proj + ((size_t)b * SEQ + tt) * PROJ_W + 1536 + 1024 + colq) : 0u; }
                unsigned rv0[8], rv1[8];
#pragma unroll
                for (int i = 0; i < 8; ++i) {
                    float v0 = 0.f, v1 = 0.f;
#pragma unroll
                    for (int j = 0; j < 4; ++j) { v0 += wv[j][0] * lo16(xv[i + j]); v1 += wv[j][1] * hi16(xv[i + j]); }
                    v0 *= sigmoidf_(v0); v1 *= sigmoidf_(v1);
                    const float be = beta_s[8 * w + i];
                    rv0[i] = f2bf(v0 * be); rv1[i] = f2bf(v1 * be);
                }
                u32x4 o;
                o.x = rv0[0] | (rv0[1] << 16); o.y = rv0[2] | (rv0[3] << 16); o.z = rv0[4] | (rv0[5] << 16); o.w = rv0[6] | (rv0[7] << 16); *(LAS u32x4*)(lds + GP_RT + (2 * lane) * GP_RP + 16 * w) = o;
                o.x = rv1[0] | (rv1[1] << 16); o.y = rv1[2] | (rv1[3] << 16); o.z = rv1[4] | (rv1[5] << 16); o.w = rv1[6] | (rv1[7] << 16); *(LAS u32x4*)(lds + GP_RT + (2 * lane + 1) * GP_RP + 16 * w) = o;
            }
        }
        __syncthreads();
#pragma unroll
        for (int q = 0; q < 2; ++q) {
            const int id = 2 * w + q, ct = id >> 2, st = id & 3;
            if (st <= ct) {
                f32x4 acc = (f32x4){0.f, 0.f, 0.f, 0.f};
#pragma unroll
                for (int ks = 0; ks < 4; ++ks) {
                    const bf16x8 a = *(const LAS bf16x8*)(lds + GP_KN + (16 * ct + fr) * GP_KP + (32 * ks + 8 * fq) * 2);
                    const bf16x8 bb = *(const LAS bf16x8*)(lds + GP_KN + (16 * st + fr) * GP_KP + (32 * ks + 8 * fq) * 2);
                    acc = __builtin_amdgcn_mfma_f32_16x16x32_bf16(a, bb, acc, 0, 0, 0);
                }
                const int s = 16 * st + fr; const float gs = gc_s[s];
#pragma unroll
                for (int r = 0; r < 4; ++r) { const int c = 16 * ct + 4 * fq + r;
                    Lm[c * GP_LP + s] = (s < c) ? beta_s[c] * acc[r] * expf(fminf(gc_s[c] - gs, 0.f)) : 0.f; }
            }
        }
        __syncthreads();
        if (w == 0) {
            float t[64];
            int zoff = 0; asm volatile("" : "+v"(zoff));
            const LAS float* Lz = Lm + zoff;
#pragma unroll
            for (int i = 0; i < 64; ++i) {
                float a0 = (i == lane) ? 1.f : 0.f, a1 = 0.f, a2 = 0.f, a3 = 0.f;
#pragma unroll
                for (int s4 = 0; s4 + 4 <= i; s4 += 4) { const f32x4 lv = *(const LAS f32x4*)(Lz + i * GP_LP + s4);
                    a0 -= lv[0] * t[s4]; a1 -= lv[1] * t[s4 + 1]; a2 -= lv[2] * t[s4 + 2]; a3 -= lv[3] * t[s4 + 3]; }
#pragma unroll
                for (int s = i & ~3; s < i; ++s) a0 -= Lz[i * GP_LP + s] * t[s];
                t[i] = (a0 + a1) + (a2 + a3);
                *(LAS bf16*)(lds + GP_TB + i * GP_TP + lane * 2) = (bf16)f2bf(t[i]);
                if ((i & 3) == 3) __builtin_amdgcn_sched_barrier(0);
            }
        } else {
            for (int id = w - 1; id < 16; id += 7) {
                const int ct = id >> 2, st = id & 3;
                f32x4 acc = (f32x4){0.f, 0.f, 0.f, 0.f};
                if (st <= ct) {
#pragma unroll
                    for (int ks = 0; ks < 4; ++ks) {
                        const bf16x8 a = *(const LAS bf16x8*)(lds + GP_QN + (16 * ct + fr) * GP_KP + (32 * ks + 8 * fq) * 2);
                        const bf16x8 bb = *(const LAS bf16x8*)(lds + GP_KN + (16 * st + fr) * GP_KP + (32 * ks + 8 * fq) * 2);
                        acc = __builtin_amdgcn_mfma_f32_16x16x32_bf16(a, bb, acc, 0, 0, 0);
                    }
                }
                const int s = 16 * st + fr; const float gs = gc_s[s]; const int ps = perm_pos(s);
#pragma unroll
                for (int r = 0; r < 4; ++r) { const int c = 16 * ct + 4 * fq + r;
                    const float v = (s <= c) ? acc[r] * expf(fminf(gc_s[c] - gs, 0.f)) : 0.f;
                    AIP[((size_t)item * 64 + c) * 64 + ps] = (bf16)f2bf(v); }
            }
        }
        __syncthreads();
#pragma unroll
        for (int q = 0; q < 2; ++q) {
            const int colt = 2 * w + q;
            bf16x8 af[2];
#pragma unroll
            for (int ks = 0; ks < 2; ++ks) af[ks] = *(const LAS bf16x8*)(lds + GP_RT + (16 * colt + fr) * GP_RP + (32 * ks + 8 * fq) * 2);
#pragma unroll
            for (int ct = 0; ct < 4; ++ct) {
                f32x4 acc = (f32x4){0.f, 0.f, 0.f, 0.f};
#pragma unroll
                for (int ks = 0; ks < 2; ++ks) {
                    const bf16x8 bb = *(const LAS bf16x8*)(lds + GP_TB + (16 * ct + fr) * GP_TP + (32 * ks + 8 * fq) * 2);
                    acc = __builtin_amdgcn_mfma_f32_16x16x32_bf16(af[ks], bb, acc, 0, 0, 0);
                }
                const int c = 16 * ct + fr;
                if (colt < 8) {
#pragma unroll
                    for (int r = 0; r < 4; ++r) UT[((size_t)item * 128 + 16 * colt + 4 * fq + r) * 64 + c] = (bf16)f2bf(acc[r]);
                } else {
                    const int kt = colt - 8;
                    u32x2 h2; h2.x = pk2(-acc[0], -acc[1]); h2.y = pk2(-acc[2], -acc[3]);
                    *(u32x2*)(WP + ((size_t)item * 64 + c) * 128 + 32 * (kt >> 1) + 8 * fq + 4 * (kt & 1)) = h2;
                }
            }
        }
    }
    __syncthreads();
}

constexpr int GS_WP = 0, GS_QD = 17408, GS_AIP = 34816, GS_KDT = 44032, GS_BUF = 62464, GS_SSX = 2 * GS_BUF;
__device__ void phase_gdn_scan(const Params& p, int L, unsigned char* lds_, int bid, int nblk) {
    LAS unsigned char* lds = (LAS unsigned char*)lds_;
    const int tid = tidx(), lane = tid & 63, w = __builtin_amdgcn_readfirstlane(tid >> 6), fr = lane & 15, fq = lane >> 4;
    const bf16* proj = (const bf16*)(p.ws + WS_PROJ);
    const bf16* WP = (const bf16*)(p.ws + GD_WP); const bf16* QD = (const bf16*)(p.ws + GD_QD); const bf16* AIP = (const bf16*)(p.ws + GD_AIP);
    const bf16* KDT = (const bf16*)(p.ws + GD_KDT); const bf16* UT = (const bf16*)(p.ws + GD_UT); const float* GL = (const float*)(p.ws + GD_GL);
    bf16* obuf = (bf16*)(p.ws + WS_OBUF);
    LAS float* ssx = (LAS float*)(lds + GS_SSX);
    for (int item = bid; item < 32; item += nblk) {
        const int hh = item & 3, b = item >> 2;
        const float gn = p.gdn_norm_g[L * 128 + 16 * w + fr];
        f32x4 S[8];
#pragma unroll
        for (int kt = 0; kt < 8; ++kt) S[kt] = (f32x4){0.f, 0.f, 0.f, 0.f};
        f32x4 oprev[4];
#pragma unroll
        for (int ct = 0; ct < 4; ++ct) oprev[ct] = (f32x4){0.f, 0.f, 0.f, 0.f};
        u32x4 st[7];
        auto gload = [&](int ci) {
#pragma unroll
            for (int i = 0; i < 7; ++i) {
                const int pc = tid + 512 * i;
                const bf16* src;
                if (i < 2) src = WP + (size_t)ci * 8192 + pc * 8;
                else if (i < 4) src = QD + (size_t)ci * 8192 + (pc - 1024) * 8;
                else if (i < 5) src = AIP + (size_t)ci * 4096 + (pc - 2048) * 8;
                else src = KDT + (size_t)ci * 8192 + (pc - 2560) * 8;
                st[i] = *(const u32x4*)src;
            }
        };
        auto lstore = [&](int buf) {
#pragma unroll
            for (int i = 0; i < 7; ++i) {
                const int pc = tid + 512 * i;
                int off;
                if (i < 2) off = GS_WP + (pc >> 4) * 272 + (pc & 15) * 16;
                else if (i < 4) { const int q = pc - 1024; off = GS_QD + (q >> 4) * 272 + (q & 15) * 16; }
                else if (i < 5) { const int q = pc - 2048; off = GS_AIP + (q >> 3) * 144 + (q & 7) * 16; }
                else { const int q = pc - 2560; off = GS_KDT + (q >> 3) * 144 + (q & 7) * 16; }
                *(LAS u32x4*)(lds + buf * GS_BUF + off) = st[i];
            }
        };
        __syncthreads();
        gload(item * 32); lstore(0);
        __syncthreads();
        for (int n = 0; n <= 32; ++n) {
            const int ci = item * 32 + n, buf = n & 1;
            f32x4 oacc[4];
            if (n < 32) {
                if (n + 1 < 32) gload(ci + 1);
                const float gl = GL[ci];
                f32x4 vn[4];
#pragma unroll
                for (int ct = 0; ct < 4; ++ct) { const u32x2 uu = *(const u32x2*)(UT + ((size_t)ci * 128 + 16 * w + fr) * 64 + 16 * ct + 4 * fq);
                    vn[ct] = (f32x4){lo16(uu.x), hi16(uu.x), lo16(uu.y), hi16(uu.y)}; }
                bf16x8 sb[4];
#pragma unroll
                for (int ks = 0; ks < 4; ++ks) { u32x4 pk; pk.x = cvtpk(S[2 * ks][0], S[2 * ks][1]); pk.y = cvtpk(S[2 * ks][2], S[2 * ks][3]); pk.z = cvtpk(S[2 * ks + 1][0], S[2 * ks + 1][1]); pk.w = cvtpk(S[2 * ks + 1][2], S[2 * ks + 1][3]);
                    sb[ks] = __builtin_bit_cast(bf16x8, pk); }
                LAS unsigned char* bb = lds + buf * GS_BUF;
#pragma unroll
                for (int ct = 0; ct < 4; ++ct) {
                    oacc[ct] = (f32x4){0.f, 0.f, 0.f, 0.f};
#pragma unroll
                    for (int ks = 0; ks < 4; ++ks) {
                        const bf16x8 aw = *(const LAS bf16x8*)(bb + GS_WP + (16 * ct + fr) * 272 + (32 * ks + 8 * fq) * 2);
                        const bf16x8 aq = *(const LAS bf16x8*)(bb + GS_QD + (16 * ct + fr) * 272 + (32 * ks + 8 * fq) * 2);
                        vn[ct] = __builtin_amdgcn_mfma_f32_16x16x32_bf16(aw, sb[ks], vn[ct], 0, 0, 0);
                        oacc[ct] = __builtin_amdgcn_mfma_f32_16x16x32_bf16(aq, sb[ks], oacc[ct], 0, 0, 0);
                    }
                }
                bf16x8 vb[2];
#pragma unroll
                for (int ss = 0; ss < 2; ++ss) { u32x4 pk; pk.x = cvtpk(vn[2 * ss][0], vn[2 * ss][1]); pk.y = cvtpk(vn[2 * ss][2], vn[2 * ss][3]); pk.z = cvtpk(vn[2 * ss + 1][0], vn[2 * ss + 1][1]); pk.w = cvtpk(vn[2 * ss + 1][2], vn[2 * ss + 1][3]);
                    vb[ss] = __builtin_bit_cast(bf16x8, pk); }
#pragma unroll
                for (int ct = 0; ct < 4; ++ct)
#pragma unroll
                    for (int ss = 0; ss < 2; ++ss) {
                        const bf16x8 aa = *(const LAS bf16x8*)(bb + GS_AIP + (16 * ct + fr) * 144 + (32 * ss + 8 * fq) * 2);
                        oacc[ct] = __builtin_amdgcn_mfma_f32_16x16x32_bf16(aa, vb[ss], oacc[ct], 0, 0, 0);
                    }
#pragma unroll
                for (int kt = 0; kt < 8; ++kt) {
                    S[kt] = S[kt] * gl;
#pragma unroll
                    for (int ss = 0; ss < 2; ++ss) {
                        const bf16x8 ak = *(const LAS bf16x8*)(bb + GS_KDT + (16 * kt + fr) * 144 + (32 * ss + 8 * fq) * 2);
                        S[kt] = __builtin_amdgcn_mfma_f32_16x16x32_bf16(ak, vb[ss], S[kt], 0, 0, 0);
                    }
                }
#pragma unroll
                for (int ct = 0; ct < 4; ++ct)
#pragma unroll
                    for (int r = 0; r < 4; ++r) { const float sq = row16_sum(oacc[ct][r] * oacc[ct][r]); if (fr == 0) ssx[(buf * 64 + 16 * ct + 4 * fq + r) * 8 + w] = sq; }
            }
            if (n > 0) {
                const int pb = (n - 1) & 1; const size_t rowp = (size_t)b * SEQ + (n - 1) * 64;
#pragma unroll
                for (int ct = 0; ct < 4; ++ct)
#pragma unroll
                    for (int r = 0; r < 4; ++r) {
                        const int c = 16 * ct + 4 * fq + r;
                        const f32x4 s0 = *(const LAS f32x4*)(ssx + (pb * 64 + c) * 8), s1 = *(const LAS f32x4*)(ssx + (pb * 64 + c) * 8 + 4);
                        const float tot = ((s0[0] + s0[1]) + (s0[2] + s0[3])) + ((s1[0] + s1[1]) + (s1[2] + s1[3]));
                        const float rn = rsqrtf(tot * (1.f / 128.f) + EPS);
                        const float z = bf2f(proj[(rowp + c) * PROJ_W + 3072 + hh * 128 + 16 * w + fr]);
                        obuf[(rowp + c) * D + 512 + hh * 128 + 16 * w + fr] = (bf16)f2bf(oprev[ct][r] * rn * gn * (z * sigmoidf_(z)));
                    }
            }
            if (n < 32) {
#pragma unroll
                for (int ct = 0; ct < 4; ++ct) oprev[ct] = oacc[ct];
                if (n + 1 < 32) lstore(buf ^ 1);
            }
            __syncthreads();
        }
    }
}

__device__ void phase_peer_select_simple(const Params& p, int L, int bid, int nblk) {
    const int tid = tidx(), lane = tid & 63, gw = bid * NWAVES + (tid >> 6), NGW = nblk * NWAVES;
    const bf16* Q2 = (const bf16*)(p.ws + WS_Q2);
    const bf16* SK = (const bf16*)(p.ws + WS_SK);
    int* IDX = (int*)(p.ws + WS_IDX); float* GATE = (float*)(p.ws + WS_GATE);
    for (int it = gw; it < M * 8; it += NGW) {
        const int tok = it >> 3, hh = it & 7;
        float tv[2]; int ti[2];
#pragma unroll
        for (int c = 0; c < 2; ++c) {
            const u32x4* qp = (const u32x4*)(Q2 + (size_t)tok * 2048 + hh * 256 + c * 128);
            const u32x4* ka = (const u32x4*)(SK + ((((size_t)L * 8 + hh) * 2 + c) * 128 + lane) * 128);
            const u32x4* kb = ka + 64 * 16;
            float sa = 0.f, sb = 0.f;
#pragma unroll
            for (int ch = 0; ch < 16; ++ch) { const u32x4 q = qp[ch]; sa = dot8(q, ka[ch], sa); sb = dot8(q, kb[ch], sb); }
            float myv = 0.f; int myi = 0;
            for (int r = 0; r < 16; ++r) {
                const float m = wave_max(fmaxf(sa, sb));
                const unsigned long long ba = __ballot(sa == m);
                int win;
                if (ba) { const int ln = __ffsll((long long)ba) - 1; win = ln; if (lane == ln) sa = -INFINITY; }
                else { const unsigned long long bb = __ballot(sb == m); const int ln = __ffsll((long long)bb) - 1; win = 64 + ln; if (lane == ln) sb = -INFINITY; }
                if (lane == r) { myv = m; myi = win; }
            }
            tv[c] = myv; ti[c] = myi;
        }
        float cv[4];
#pragma unroll
        for (int q4 = 0; q4 < 4; ++q4) { const int pp = lane + 64 * q4; cv[q4] = __shfl(tv[0], pp >> 4) + __shfl(tv[1], pp & 15); }
        float gv = 0.f; int gp = 0;
        for (int r = 0; r < 16; ++r) {
            const float m = wave_max(fmaxf(fmaxf(cv[0], cv[1]), fmaxf(cv[2], cv[3])));
            int win = -1;
#pragma unroll
            for (int q4 = 0; q4 < 4; ++q4) {
                const unsigned long long bq = __ballot(cv[q4] == m);
                if (win < 0 && bq) { const int ln = __ffsll((long long)bq) - 1; win = ln + 64 * q4; if (lane == ln) cv[q4] = -INFINITY; }
            }
            if (lane == r) { gv = m; gp = win; }
        }
        const float m0 = __shfl(gv, 0);
        const float e = lane < 16 ? expf(gv - m0) : 0.f;
        const float sum = wave_sum(e);
        const int ia = __shfl(ti[0], gp >> 4), ib = __shfl(ti[1], gp & 15);
        if (lane < 16) { IDX[(size_t)tok * 128 + hh * 16 + lane] = ia * 128 + ib; GATE[(size_t)tok * 128 + hh * 16 + lane] = e / sum; }
    }
}

__device__ void phase_peer_gather(const Params& p, int L, int bid, int nblk) {
    const int tid = tidx(), lane = tid & 63, gw = bid * NWAVES + (tid >> 6), NGW = nblk * NWAVES;
    float* H = (float*)(p.ws + WS_H); bf16* HB2 = (bf16*)(p.ws + WS_HB2);
    const int* IDX = (const int*)(p.ws + WS_IDX); const float* GATE = (const float*)(p.ws + WS_GATE);
    const bf16* U = (const bf16*)(p.ws + WS_U) + (size_t)L * NEXP * D;
    const bf16* V = (const bf16*)(p.ws + WS_V) + (size_t)L * NEXP * D;
    const float* g = p.ln_ffn_g + L * D;
    for (int tok = gw; tok < M; tok += NGW) {
        float* hrow = H + (size_t)tok * D;
        float xv[16];
        {
            const f32x4 a0 = *(const f32x4*)(hrow + 8 * lane), a1 = *(const f32x4*)(hrow + 8 * lane + 4), b0 = *(const f32x4*)(hrow + 512 + 8 * lane), b1 = *(const f32x4*)(hrow + 512 + 8 * lane + 4);
#pragma unroll
            for (int i = 0; i < 4; ++i) { xv[i] = a0[i]; xv[4 + i] = a1[i]; xv[8 + i] = b0[i]; xv[12 + i] = b1[i]; }
        }
        float ss = 0.f;
#pragma unroll
        for (int i = 0; i < 16; ++i) ss += xv[i] * xv[i];
        ss = wave_sum(ss);
        const float rstd = rsqrtf(ss * (1.f / D) + EPS);
        float xn[16];
#pragma unroll
        for (int i = 0; i < 8; ++i) { xn[i] = xv[i] * rstd * g[8 * lane + i]; xn[8 + i] = xv[8 + i] * rstd * g[512 + 8 * lane + i]; }
        const int id0 = IDX[(size_t)tok * 128 + lane], id1 = IDX[(size_t)tok * 128 + 64 + lane];
        const float g0 = GATE[(size_t)tok * 128 + lane], g1 = GATE[(size_t)tok * 128 + 64 + lane];
        float w0 = 0.f, w1 = 0.f;
#pragma unroll 4
        for (int e = 0; e < 128; ++e) {
            const int id = __shfl(e < 64 ? id0 : id1, e & 63);
            const bf16* ur = U + (size_t)id * D;
            const u32x4 a = *(const u32x4*)(ur + 8 * lane), b = *(const u32x4*)(ur + 512 + 8 * lane);
            float d = 0.f;
#pragma unroll
            for (int i = 0; i < 4; ++i) { d += xn[2 * i] * lo16(a[i]) + xn[2 * i + 1] * hi16(a[i]); d += xn[8 + 2 * i] * lo16(b[i]) + xn[8 + 2 * i + 1] * hi16(b[i]); }
            d = wave_sum(d);
            const float ge = 0.5f * d * (1.f + erff(d * 0.70710678118654752f));
            if (lane == (e & 63)) { if (e < 64) w0 = g0 * ge; else w1 = g1 * ge; }
        }
        float y[16];
#pragma unroll
        for (int i = 0; i < 16; ++i) y[i] = 0.f;
#pragma unroll 4
        for (int e = 0; e < 128; ++e) {
            const int id = __shfl(e < 64 ? id0 : id1, e & 63);
            const float ww = __shfl(e < 64 ? w0 : w1, e & 63);
            const bf16* vr = V + (size_t)id * D;
            const u32x4 a = *(const u32x4*)(vr + 8 * lane), b = *(const u32x4*)(vr + 512 + 8 * lane);
#pragma unroll
            for (int i = 0; i < 4; ++i) { y[2 * i] += ww * lo16(a[i]); y[2 * i + 1] += ww * hi16(a[i]); y[8 + 2 * i] += ww * lo16(b[i]); y[8 + 2 * i + 1] += ww * hi16(b[i]); }
        }
#pragma unroll
        for (int i = 0; i < 16; ++i) y[i] += xv[i];
        *(f32x4*)(hrow + 8 * lane) = (f32x4){y[0], y[1], y[2], y[3]};
        *(f32x4*)(hrow + 8 * lane + 4) = (f32x4){y[4], y[5], y[6], y[7]};
        *(f32x4*)(hrow + 512 + 8 * lane) = (f32x4){y[8], y[9], y[10], y[11]};
        *(f32x4*)(hrow + 512 + 8 * lane + 4) = (f32x4){y[12], y[13], y[14], y[15]};
        bf16* hb = HB2 + (size_t)tok * D;
        u32x4 o; o.x = pk2(y[0], y[1]); o.y = pk2(y[2], y[3]); o.z = pk2(y[4], y[5]); o.w = pk2(y[6], y[7]);
        *(u32x4*)(hb + 8 * lane) = o;
        o.x = pk2(y[8], y[9]); o.y = pk2(y[10], y[11]); o.z = pk2(y[12], y[13]); o.w = pk2(y[14], y[15]);
        *(u32x4*)(hb + 512 + 8 * lane) = o;
    }
}

__device__ void phase_final(const Params& p, int bid, int nblk) {
    const int tid = tidx(), lane = tid & 63, gw = bid * NWAVES + (tid >> 6), NGW = nblk * NWAVES;
    const float* H = (const float*)(p.ws + WS_H); const float* rstd0 = (const float*)(p.ws + WS_STAT);
    for (int m = gw; m < M; m += NGW) {
        const float r = rstd0[m];
#pragma unroll
        for (int j = 0; j < 4; ++j) {
            const f32x4 v = ((const f32x4*)(H + (size_t)m * D))[lane + 64 * j];
            const f32x4 gv = ((const f32x4*)p.final_g)[lane + 64 * j];
            ((f32x4*)(p.out + (size_t)m * D))[lane + 64 * j] = v * r * gv;
        }
    }
}

#define XB_TMO      128
#define XB_XCNT(j)  (256  + 64 * (j))
#define XB_XSUB(j)  (1280 + 64 * (j))
#define XB_XGEN(j)  (2304 + 64 * (j))
#define XB_TOP      3328
#define XB_TOPGEN   3392
#define XCD_BAR_WORDS 3456
#define XB_SPIN_CAP (1u << 22)
__device__ __forceinline__ unsigned xb_ld(unsigned* p)              { return __hip_atomic_load(p, __ATOMIC_RELAXED, __HIP_MEMORY_SCOPE_AGENT); }
__device__ __forceinline__ unsigned xb_add(unsigned* p, unsigned v) { return __hip_atomic_fetch_add(p, v, __ATOMIC_RELAXED, __HIP_MEMORY_SCOPE_AGENT); }
__device__ __forceinline__ unsigned xb_xcc_id() { return (unsigned)__builtin_amdgcn_s_getreg((3 << 11) | 20) & 0xFu; }
#define XB_SPIN(cond, bar) do { unsigned _sp = 0; while (cond) { __builtin_amdgcn_s_sleep(1); \
    if ((++_sp & 255u) == 0u) { if (xb_ld(&(bar)[XB_TMO])) break; if (_sp > XB_SPIN_CAP) { atomicAdd(&(bar)[XB_TMO], 1u); break; } } } } while (0)
struct XcdBarrier { unsigned* bar; unsigned x; volatile LAS unsigned* st; };
__device__ __forceinline__ XcdBarrier xcd_barrier_post(unsigned* bar, volatile LAS unsigned* st) {
    XcdBarrier b; b.bar = bar; b.x = xb_xcc_id(); b.st = st;
    if (threadIdx.x == 0) (void)xb_add(&bar[XB_XCNT(b.x)], 1u);
    return b;
}
__device__ __forceinline__ void xcd_barrier_complete(unsigned* bar, unsigned x, unsigned& nloc, unsigned& nx) {
    const unsigned G = gridDim.x * gridDim.y * gridDim.z;
    unsigned sum, cnt, mine, sp = 0u;
    for (;;) {
        sum = 0u; cnt = 0u; mine = 0u;
#pragma unroll
        for (unsigned j = 0; j < 16; ++j) { const unsigned c = xb_ld(&bar[XB_XCNT(j)]); sum += c; cnt += (c > 0u) ? 1u : 0u; mine = (j == x) ? c : mine; }
        if (sum == G) break;
        __builtin_amdgcn_s_sleep(1);
        if ((++sp & 255u) == 0u) { if (xb_ld(&bar[XB_TMO])) break; if (sp > XB_SPIN_CAP) { atomicAdd(&bar[XB_TMO], 1u); break; } }
    }
    nloc = mine > 0u ? mine : 1u; nx = cnt > 0u ? cnt : 1u;
}
__device__ __forceinline__ void xcd_barrier(const XcdBarrier& b) {
    asm volatile("s_waitcnt vmcnt(0)" ::: "memory");
    __syncthreads();
    if (threadIdx.x == 0) {
        unsigned* bar = b.bar;
        __builtin_amdgcn_s_waitcnt(0);
        unsigned nloc = b.st[0], nx = b.st[1];
        if (nloc == 0u) { xcd_barrier_complete(bar, b.x, nloc, nx); b.st[0] = nloc; b.st[1] = nx; }
        const unsigned old = xb_add(&bar[XB_XSUB(b.x)], 1u);
        const unsigned gen = old / nloc;
        if (old + 1u == (gen + 1u) * nloc) {
            __builtin_amdgcn_fence(__ATOMIC_RELEASE, "agent");
            asm volatile("s_waitcnt vmcnt(0)" ::: "memory");
            const unsigned og = xb_add(&bar[XB_TOP], 1u);
            const unsigned tg = og / nx;
            if (og + 1u == (tg + 1u) * nx) xb_add(&bar[XB_TOPGEN], 1u);
            else XB_SPIN(xb_ld(&bar[XB_TOPGEN]) == tg, bar);
            __builtin_amdgcn_fence(__ATOMIC_ACQUIRE, "agent");
            xb_add(&bar[XB_XGEN(b.x)], 1u);
            asm volatile("s_waitcnt vmcnt(0)" ::: "memory");
        } else {
            XB_SPIN(xb_ld(&bar[XB_XGEN(b.x)]) == gen, bar);
            __builtin_amdgcn_fence(__ATOMIC_ACQUIRE, "agent");
            asm volatile("s_waitcnt vmcnt(0)" ::: "memory");
        }
    }
    __syncthreads();
}
constexpr int CW_BAR = 4096;
constexpr int LDS_MISC_OFF = LDS_BYTES - 256;

constexpr int NS = 11;
constexpr int K_PROLOGUE = 11, K_FINAL = 12;
template <int KIND>
__device__ __forceinline__ void run_kind(const Params& p, int L, unsigned char* lds, int bid, int nblk) {
    unsigned char* ws = p.ws;
    float* H = (float*)(ws + WS_H);
    float* rstd0 = (float*)(ws + WS_STAT); float* rstd1 = rstd0 + M; float* rstde = rstd1 + M;
    if constexpr (KIND == K_PROLOGUE) phase_prologue(p, lds, bid, nblk);
    if constexpr (KIND == K_FINAL) phase_final(p, bid, nblk);
    if constexpr (KIND == 0) { EpiProj E{(bf16*)(ws + WS_PROJ), (float*)(ws + WS_BA), rstd0};
        gemm_run(lds, (const bf16*)(ws + WS_HB0), (const bf16*)(ws + WS_WIN) + (size_t)L * IN_PAD * D, M, IN_PAD, D, E, bid, nblk); }
    if constexpr (KIND == 1) phase_att_mfma(p, L, lds, bid, nblk);
    if constexpr (KIND == 2) phase_gdn_prep(p, L, lds, bid, nblk);
    if constexpr (KIND == 3) phase_gdn_scan(p, L, lds, bid, nblk);
    if constexpr (KIND == 4) { EpiRes E{H, (bf16*)(ws + WS_HB1)};
        gemm_run(lds, (const bf16*)(ws + WS_OBUF), (const bf16*)(ws + WS_WOUT) + (size_t)L * D * D, M, D, D, E, bid, nblk); }
    if constexpr (KIND == 5) phase_rowstat_f32(H, rstd1, bid, nblk);
    if constexpr (KIND == 6) { EpiQ2 E{(bf16*)(ws + WS_Q2), rstd1};
        gemm_run(lds, (const bf16*)(ws + WS_HB1), (const bf16*)(ws + WS_WQ) + (size_t)L * 2048 * D, M, 2048, D, E, bid, nblk);
        EpiE E2{(bf16*)(ws + WS_EPRE)};
        gemm_run(lds, (const bf16*)(ws + WS_PB) + (size_t)L * M * 256, (const bf16*)(ws + WS_WP) + (size_t)L * D * 256, M, D, 256, E2, bid, nblk); }
    if constexpr (KIND == 7) { phase_rowstat_bf16((const bf16*)(ws + WS_EPRE), rstde, bid, nblk); phase_peer_select_simple(p, L, bid, nblk); }
    if constexpr (KIND == 8) phase_peer_gather(p, L, bid, nblk);
    if constexpr (KIND == 9) { EpiPle E{H, (bf16*)(ws + WS_HB0), (const bf16*)(ws + WS_EPRE), rstde, p.ple_norm_g + L * D};
        gemm_run(lds, (const bf16*)(ws + WS_HB2), (const bf16*)(ws + WS_WG) + (size_t)L * D * D, M, D, D, E, bid, nblk); }
    if constexpr (KIND == 10) phase_rowstat_f32(H, rstd0, bid, nblk);
}

#define RUN(KIND) do { const Params* pp_ = (const Params*)__builtin_amdgcn_kernarg_segment_ptr(); int L_ = L; asm volatile("" : "+s"(pp_), "+s"(L_)); run_kind<KIND>(*pp_, L_, lds, bid, nblk); } while (0)
__global__ void __launch_bounds__(NTHREADS, 2) mk_fwd(Params p) {
    extern __shared__ __attribute__((aligned(16))) unsigned char lds[];
    const int bid = (int)blockIdx.x, nblk = (int)gridDim.x;
    volatile LAS unsigned* misc = (volatile LAS unsigned*)((LAS unsigned char*)lds + LDS_MISC_OFF);
    if (threadIdx.x < 64) misc[threadIdx.x] = 0u;
    __syncthreads();
    XcdBarrier bar = xcd_barrier_post((unsigned*)(((const Params*)__builtin_amdgcn_kernarg_segment_ptr())->ws + WS_CTL) + CW_BAR, misc + 8);
    { int L = 0; RUN(K_PROLOGUE); }
    cg::this_grid().sync();
#pragma nounroll
    for (int L = 0; L < DEPTH; ++L) {
        RUN(0); xcd_barrier(bar);
        RUN(1); xcd_barrier(bar);
        RUN(2); xcd_barrier(bar);
        RUN(3); xcd_barrier(bar);
        RUN(4); xcd_barrier(bar);
        RUN(5); xcd_barrier(bar);
        RUN(6); xcd_barrier(bar);
        RUN(7); xcd_barrier(bar);
        RUN(8); xcd_barrier(bar);
        RUN(9); xcd_barrier(bar);
        RUN(10); xcd_barrier(bar);
    }
    { int L = 0; RUN(K_FINAL); }
}

extern "C" void kernel_launch(void* const* d_in, const int* in_sizes, int n_in, void* d_out, int out_size, void* d_ws, size_t ws_size, hipStream_t stream) {
    static int grid = 0;
    if (grid == 0) {
        if (n_in != 20 || out_size != M * D || ws_size < WS_END) { fprintf(stderr, "kernel_launch: unexpected shapes (n_in %d, out %d, ws %zu < %zu)\n", n_in, out_size, ws_size, (size_t)WS_END); grid = -1; return; }
        int dev = 0, cus = 0, per_cu = 0;
        (void)hipGetDevice(&dev); (void)hipDeviceGetAttribute(&cus, hipDeviceAttributeMultiprocessorCount, dev);
        if (hipFuncSetAttribute((const void*)mk_fwd, hipFuncAttributeMaxDynamicSharedMemorySize, LDS_BYTES) != hipSuccess) { fprintf(stderr, "kernel_launch: hipFuncSetAttribute failed\n"); grid = -1; return; }
        if (hipOccupancyMaxActiveBlocksPerMultiprocessor(&per_cu, (const void*)mk_fwd, NTHREADS, LDS_BYTES) != hipSuccess || per_cu < 1) { fprintf(stderr, "kernel_launch: occupancy query says %d blocks per CU\n", per_cu); (void)hipGetLastError(); grid = -1; return; }
        grid = (cus > 0 ? cus : 256);
    }
    if (grid < 0) return;
    (void)hipMemsetAsync((char*)d_ws + WS_CTL, 0, CTL_ZERO_BYTES, stream);
    Params p{};
    const float** pp = (const float**)&p;
    for (int i = 0; i < 20; ++i) pp[i] = (const float*)d_in[i];
    p.out = (float*)d_out; p.ws = (unsigned char*)d_ws;
    void* args[] = {&p};
    hipError_t e = hipLaunchCooperativeKernel((const void*)mk_fwd, dim3(grid), dim3(NTHREADS), args, LDS_BYTES, stream);
    if (e != hipSuccess) fprintf(stderr, "kernel_launch: cooperative launch failed: %s (grid %d)\n", hipGetErrorString(e), grid);
}
```

```cpp
#include <hip/hip_runtime.h>
#include <hip/hip_cooperative_groups.h>
#include <cstdio>
#include <cstdint>
namespace cg = cooperative_groups;

typedef unsigned short bf16;
typedef float f32x4 __attribute__((ext_vector_type(4)));
typedef short bf16x8 __attribute__((ext_vector_type(8)));
typedef unsigned u32x4 __attribute__((ext_vector_type(4)));
typedef unsigned u32x2 __attribute__((ext_vector_type(2)));

constexpr int D = 1024, BATCH = 8, SEQ = 2048, DEPTH = 4, M = BATCH * SEQ;
constexpr int IN_COLS = 3592, IN_PAD = 3840, PROJ_W = 3584;
constexpr int NEXP = 16384;
constexpr float EPS = 1e-6f;
constexpr float QSCALE = 0.125f * 1.4426950408889634f;
constexpr int NWAVES = 8, NTHREADS = 512;
constexpr int LDS_BYTES = 147456;

constexpr size_t MiB = 1u << 20;
constexpr size_t WS_CTL = 0, CTL_ZERO_BYTES = 1 * MiB;
constexpr size_t WS_H = 1 * MiB;
constexpr size_t WS_HB0 = 65 * MiB;
constexpr size_t WS_HB1 = 97 * MiB;
constexpr size_t WS_HB2 = 129 * MiB;
constexpr size_t WS_PROJ = 161 * MiB;
constexpr size_t WS_BA = 273 * MiB;
constexpr size_t WS_OBUF = 274 * MiB;
constexpr size_t WS_Q2 = 306 * MiB;
constexpr size_t WS_EPRE = 370 * MiB;
constexpr size_t WS_IDX = 402 * MiB;
constexpr size_t WS_GATE = 410 * MiB;
constexpr size_t WS_STAT = 418 * MiB;
constexpr size_t WS_ORAW = 422 * MiB;
constexpr size_t WS_WIN = 550 * MiB;
constexpr size_t WS_WOUT = 582 * MiB;
constexpr size_t WS_WQ = 590 * MiB;
constexpr size_t WS_WG = 606 * MiB;
constexpr size_t WS_WP = 614 * MiB;
constexpr size_t WS_SK = 616 * MiB;
constexpr size_t WS_PB = 618 * MiB;
constexpr size_t WS_U = 650 * MiB;
constexpr size_t WS_V = 778 * MiB;
constexpr size_t WS_END = 906 * MiB;

struct Params {
    const float *x, *p, *ln_mix_g, *w_in, *conv_w, *a_log, *dt_bias, *gdn_norm_g, *diff_lambda, *subln_g, *w_out, *ln_ffn_g,
        *peer_wq, *subkeys, *peer_u, *peer_v, *ple_wp, *ple_wg, *ple_norm_g, *final_g;
    float* out;
    unsigned char* ws;
    int pad0, pad1;
};

__device__ __forceinline__ int tidx() { int t = (int)threadIdx.x; asm volatile("" : "+v"(t)); return t; }
__device__ __forceinline__ float bf2f(bf16 v) { return __uint_as_float((unsigned)v << 16); }
__device__ __forceinline__ unsigned f2bf(float f) { unsigned u = __float_as_uint(f); return (u + 0x7fffu + ((u >> 16) & 1u)) >> 16; }
__device__ __forceinline__ unsigned pk2(float lo, float hi) { return f2bf(lo) | (f2bf(hi) << 16); }
__device__ __forceinline__ float lo16(unsigned w) { return __uint_as_float(w << 16); }
__device__ __forceinline__ float hi16(unsigned w) { return __uint_as_float(w & 0xffff0000u); }
template <int N> __device__ __forceinline__ float dpp_ror(float x) { return __builtin_bit_cast(float, __builtin_amdgcn_mov_dpp(__builtin_bit_cast(int, x), 0x120 + N, 0xf, 0xf, true)); }
template <int N> __device__ __forceinline__ unsigned dpp_ror_u(unsigned x) { return (unsigned)__builtin_amdgcn_mov_dpp((int)x, 0x120 + N, 0xf, 0xf, true); }
__device__ __forceinline__ float row16_sum(float x) { x += dpp_ror<8>(x); x += dpp_ror<4>(x); x += dpp_ror<2>(x); x += dpp_ror<1>(x); return x; }
__device__ __forceinline__ float row16_max(float x) { x = fmaxf(x, dpp_ror<8>(x)); x = fmaxf(x, dpp_ror<4>(x)); x = fmaxf(x, dpp_ror<2>(x)); x = fmaxf(x, dpp_ror<1>(x)); return x; }
__device__ __forceinline__ unsigned row16_umax(unsigned x) { unsigned y;
    y = dpp_ror_u<8>(x); x = x > y ? x : y; y = dpp_ror_u<4>(x); x = x > y ? x : y; y = dpp_ror_u<2>(x); x = x > y ? x : y; y = dpp_ror_u<1>(x); x = x > y ? x : y; return x; }
__device__ __forceinline__ float xrow16_max(float x) {
    auto s = __builtin_amdgcn_permlane16_swap(__float_as_uint(x), __float_as_uint(x), false, false);
    x = fmaxf(__uint_as_float(s[0]), __uint_as_float(s[1]));
    auto t = __builtin_amdgcn_permlane32_swap(__float_as_uint(x), __float_as_uint(x), false, false);
    return fmaxf(__uint_as_float(t[0]), __uint_as_float(t[1]));
}
__device__ __forceinline__ float xrow16_sum(float x) {
    auto s = __builtin_amdgcn_permlane16_swap(__float_as_uint(x), __float_as_uint(x), false, false);
    x = __uint_as_float(s[0]) + __uint_as_float(s[1]);
    auto t = __builtin_amdgcn_permlane32_swap(__float_as_uint(x), __float_as_uint(x), false, false);
    return __uint_as_float(t[0]) + __uint_as_float(t[1]);
}
__device__ __forceinline__ float wave_sum(float v) { return xrow16_sum(row16_sum(v)); }
__device__ __forceinline__ float wave_max(float v) {
#pragma unroll
    for (int o = 32; o; o >>= 1) v = fmaxf(v, __shfl_xor(v, o));
    return v;
}
__device__ __forceinline__ float sigmoidf_(float x) { return 1.f / (1.f + __expf(-x)); }
__device__ __forceinline__ float dot8(u32x4 a, u32x4 b, float s) {
#pragma unroll
    for (int i = 0; i < 4; ++i) { s += lo16(a[i]) * lo16(b[i]); s += hi16(a[i]) * hi16(b[i]); }
    return s;
}

#define LAS __attribute__((address_space(3)))
__host__ __device__ __forceinline__ int lds_byte(int r, int c) { const int st = (r >> 4) * 2 + (c >> 5), rr = r & 15, cc = c & 31, ob = rr * 64 + cc * 2; return st * 1024 + (ob ^ (((ob >> 9) & 1) << 5)); }
__host__ __device__ __forceinline__ void stage_rc(int b, int& R, int& C) { const int st = b / 1024, sb = b % 1024, swz = sb ^ (((sb >> 9) & 1) << 5); R = (st >> 1) * 16 + swz / 64; C = (st & 1) * 32 + (swz % 64) / 2; }
constexpr int HTB = 16384;
template <class F>
__device__ __forceinline__ void gemm_run(unsigned char* lds_, const bf16* A, const bf16* Bt, int Mm, int N, int K, const F& f, int bid, int nblk) {
    LAS unsigned char* lds = (LAS unsigned char*)lds_;
    const int tid = tidx(), wid = __builtin_amdgcn_readfirstlane(tid >> 6), lane = tid & 63, wr = wid >> 1, wc = wid & 1, fr = lane & 15, fq = lane >> 4;
    const int nt = K / 64, ntn = N / 128, nunits = (Mm / 256) * ntn;
    unsigned voff[2];
#pragma unroll
    for (int i = 0; i < 2; ++i) { int R, C; stage_rc(tid * 16 + i * 8192, R, C); voff[i] = (unsigned)(R * K + C) * 2u; }
    const unsigned ldsw = (unsigned)wid * 1024u;
    const int aoff = (wr >> 1) * HTB + lds_byte((wr & 1) * 64 + fr, fq * 8), boff = 2 * HTB + lds_byte(wc * 64 + fr, fq * 8);
#define G_STAGE(bufoff, gbase) do { _Pragma("unroll") for (int _i = 0; _i < 2; ++_i) \
        __builtin_amdgcn_global_load_lds((const unsigned*)((const char*)(gbase) + voff[_i]), (LAS unsigned*)(lds + (bufoff) + ldsw + _i * 8192), 16, 0, 0); } while (0)
    for (int u = bid; u < nunits; u += nblk) {
        const int pm = u % (Mm / 256), pn = u / (Mm / 256);
        const char* gA = (const char*)(A + (size_t)pm * 256 * K);
        const char* gB = (const char*)(Bt + (size_t)pn * 128 * K);
        const size_t hstep = (size_t)128 * K * 2;
        f32x4 acc[4][4];
#pragma unroll
        for (int a = 0; a < 4; ++a)
#pragma unroll
            for (int b = 0; b < 4; ++b) acc[a][b] = (f32x4){0.f, 0.f, 0.f, 0.f};
        G_STAGE(0, gA); G_STAGE(HTB, gA + hstep); G_STAGE(2 * HTB, gB);
        for (int t = 0; t < nt; ++t) {
            const int cur = (t & 1) * 3 * HTB, nxt = ((t + 1) & 1) * 3 * HTB;
            asm volatile("s_waitcnt vmcnt(0)" ::: "memory");
            __syncthreads();
            if (t + 1 < nt) { const size_t ko = (size_t)(t + 1) * 128; G_STAGE(nxt, gA + ko); G_STAGE(nxt + HTB, gA + hstep + ko); G_STAGE(nxt + 2 * HTB, gB + ko); }
            bf16x8 af[4][2], bfr[4][2];
#pragma unroll
            for (int m = 0; m < 4; ++m)
#pragma unroll
                for (int k = 0; k < 2; ++k) af[m][k] = *(const LAS bf16x8*)(lds + cur + aoff + m * 2048 + k * 1024);
#pragma unroll
            for (int n = 0; n < 4; ++n)
#pragma unroll
                for (int k = 0; k < 2; ++k) bfr[n][k] = *(const LAS bf16x8*)(lds + cur + boff + n * 2048 + k * 1024);
#pragma unroll
            for (int k = 0; k < 2; ++k)
#pragma unroll
                for (int m = 0; m < 4; ++m)
#pragma unroll
                    for (int n = 0; n < 4; ++n) acc[m][n] = __builtin_amdgcn_mfma_f32_16x16x32_bf16(bfr[n][k], af[m][k], acc[m][n], 0, 0, 0);
        }
#pragma unroll
        for (int m = 0; m < 4; ++m) {
            const int row = pm * 256 + wr * 64 + m * 16 + fr;
#pragma unroll
            for (int n = 0; n < 4; ++n) f(row, pn * 128 + wc * 64 + n * 16 + 4 * fq, acc[m][n]);
        }
        __syncthreads();
    }
#undef G_STAGE
}

__device__ __forceinline__ u32x2 pk4(f32x4 a) { u32x2 o; o.x = pk2(a[0], a[1]); o.y = pk2(a[2], a[3]); return o; }
struct EpiProj {
    bf16* proj; float* ba; const float* rstd;
    __device__ __forceinline__ void operator()(int row, int col, f32x4 v) const {
        v = v * rstd[row];
        if (col < PROJ_W) *(u32x2*)(proj + (size_t)row * PROJ_W + col) = pk4(v);
        else if (col < IN_COLS) *(f32x4*)(ba + (size_t)row * 8 + (col - PROJ_W)) = v;
    }
};
struct EpiRes {
    float* H; bf16* HB;
    __device__ __forceinline__ void operator()(int row, int col, f32x4 v) const {
        f32x4* hp = (f32x4*)(H + (size_t)row * D + col);
        const f32x4 h = *hp + v; *hp = h;
        *(u32x2*)(HB + (size_t)row * D + col) = pk4(h);
    }
};
struct EpiQ2 {
    bf16* Q2; const float* rstd;
    __device__ __forceinline__ void operator()(int row, int col, f32x4 v) const { *(u32x2*)(Q2 + (size_t)row * 2048 + col) = pk4(v * rstd[row]); }
};
struct EpiE {
    bf16* E;
    __device__ __forceinline__ void operator()(int row, int col, f32x4 v) const { *(u32x2*)(E + (size_t)row * D + col) = pk4(v); }
};
struct EpiPle {
    float* H; bf16* HB; const bf16* E; const float* rstde; const float* g;
    __device__ __forceinline__ void operator()(int row, int col, f32x4 v) const {
        f32x4* hp = (f32x4*)(H + (size_t)row * D + col);
        const u32x2 ev = *(const u32x2*)(E + (size_t)row * D + col);
        const f32x4 gv = *(const f32x4*)(g + col);
        const float r = rstde[row];
        f32x4 h = *hp;
        h[0] += sigmoidf_(v[0]) * (lo16(ev.x) * r * gv[0]); h[1] += sigmoidf_(v[1]) * (hi16(ev.x) * r * gv[1]);
        h[2] += sigmoidf_(v[2]) * (lo16(ev.y) * r * gv[2]); h[3] += sigmoidf_(v[3]) * (hi16(ev.y) * r * gv[3]);
        *hp = h;
        *(u32x2*)(HB + (size_t)row * D + col) = pk4(h);
    }
};

__device__ __forceinline__ void transpose_item(const float* W, int K, int N, int Npad, bf16* WT, const float* rowscale, int qcols, float* scr, int item, int lane) {
    const int nblk = Npad / 32, kb = item / nblk, nb = item % nblk, k0 = 64 * kb, n0 = 32 * nb;
    const int n = n0 + (lane & 31);
#pragma unroll 8
    for (int i = 0; i < 32; ++i) {
        const int kk = 2 * i + (lane >> 5);
        float v = (n < N) ? W[(size_t)(k0 + kk) * N + n] : 0.f;
        if (rowscale) v *= rowscale[k0 + kk];
        if (n < qcols) v *= QSCALE;
        scr[kk * 33 + (lane & 31)] = v;
    }
    asm volatile("s_waitcnt lgkmcnt(0)" ::: "memory");
    const int c = lane & 7;
#pragma unroll
    for (int j = 0; j < 4; ++j) {
        const int nn = (lane >> 3) + 8 * j; const float* s = scr + (8 * c) * 33 + nn;
        u32x4 o; o.x = pk2(s[0 * 33], s[1 * 33]); o.y = pk2(s[2 * 33], s[3 * 33]); o.z = pk2(s[4 * 33], s[5 * 33]); o.w = pk2(s[6 * 33], s[7 * 33]);
        *(u32x4*)(WT + (size_t)(n0 + nn) * K + k0 + 8 * c) = o;
    }
    asm volatile("s_waitcnt lgkmcnt(0)" ::: "memory");
}
__device__ __forceinline__ void convert_bulk(const float* src, bf16* dst, size_t n, size_t gtid, size_t nthr) {
    for (size_t i = gtid * 8; i < n; i += nthr * 8) {
        const f32x4 a = *(const f32x4*)(src + i), b = *(const f32x4*)(src + i + 4);
        u32x4 o; o.x = pk2(a[0], a[1]); o.y = pk2(a[2], a[3]); o.z = pk2(b[0], b[1]); o.w = pk2(b[2], b[3]);
        *(u32x4*)(dst + i) = o;
    }
}
__device__ void phase_prologue(const Params& p, unsigned char* lds, int bid, int nblk) {
    const int tid = tidx(), lane = tid & 63, w = tid >> 6;
    const int gw = bid * NWAVES + w, NGW = nblk * NWAVES;
    float* scr = (float*)(lds + w * 16384);
    constexpr int I_IN = 16 * (IN_PAD / 32), I_OUT = 16 * 32, I_Q = 16 * 64, I_G = 16 * 32, I_P = 4 * 32, I_L = I_IN + I_OUT + I_Q + I_G + I_P;
    for (int it = gw; it < DEPTH * I_L; it += NGW) {
        const int L = it / I_L; int r = it % I_L;
        if (r < I_IN) { transpose_item(p.w_in + (size_t)L * D * IN_COLS, D, IN_COLS, IN_PAD, (bf16*)(p.ws + WS_WIN) + (size_t)L * IN_PAD * D, p.ln_mix_g + L * D, 512, scr, r, lane); continue; } r -= I_IN;
        if (r < I_OUT) { transpose_item(p.w_out + (size_t)L * D * D, D, D, D, (bf16*)(p.ws + WS_WOUT) + (size_t)L * D * D, nullptr, 0, scr, r, lane); continue; } r -= I_OUT;
        if (r < I_Q) { transpose_item(p.peer_wq + (size_t)L * D * 2048, D, 2048, 2048, (bf16*)(p.ws + WS_WQ) + (size_t)L * 2048 * D, p.ln_ffn_g + L * D, 0, scr, r, lane); continue; } r -= I_Q;
        if (r < I_G) { transpose_item(p.ple_wg + (size_t)L * D * D, D, D, D, (bf16*)(p.ws + WS_WG) + (size_t)L * D * D, nullptr, 0, scr, r, lane); continue; } r -= I_G;
        transpose_item(p.ple_wp + (size_t)L * 256 * D, 256, D, D, (bf16*)(p.ws + WS_WP) + (size_t)L * D * 256, nullptr, 0, scr, r, lane);
    }
    const size_t gtid = (size_t)bid * NTHREADS + tid, nthr = (size_t)nblk * NTHREADS;
    convert_bulk(p.peer_u, (bf16*)(p.ws + WS_U), (size_t)DEPTH * NEXP * D, gtid, nthr);
    convert_bulk(p.peer_v, (bf16*)(p.ws + WS_V), (size_t)DEPTH * NEXP * D, gtid, nthr);
    convert_bulk(p.p, (bf16*)(p.ws + WS_PB), (size_t)DEPTH * M * 256, gtid, nthr);
    convert_bulk(p.subkeys, (bf16*)(p.ws + WS_SK), (size_t)DEPTH * 8 * 2 * 128 * 128, gtid, nthr);
    float* H = (float*)(p.ws + WS_H); bf16* HB0 = (bf16*)(p.ws + WS_HB0); float* rstd0 = (float*)(p.ws + WS_STAT);
    for (int m = gw; m < M; m += NGW) {
        const f32x4* xr = (const f32x4*)(p.x + (size_t)m * D) + lane;
        float ss = 0.f;
#pragma unroll
        for (int j = 0; j < 4; ++j) {
            const f32x4 v = xr[64 * j];
            ss += v[0] * v[0] + v[1] * v[1] + v[2] * v[2] + v[3] * v[3];
            ((f32x4*)(H + (size_t)m * D))[lane + 64 * j] = v;
            u32x2 o; o.x = pk2(v[0], v[1]); o.y = pk2(v[2], v[3]);
            ((u32x2*)(HB0 + (size_t)m * D))[lane + 64 * j] = o;
        }
        ss = wave_sum(ss);
        if (lane == 0) rstd0[m] = rsqrtf(ss * (1.f / D) + EPS);
    }
}

__device__ void phase_rowstat_f32(const float* src, float* rstd, int bid, int nblk) {
    const int tid = tidx(), lane = tid & 63, gw = bid * NWAVES + (tid >> 6), NGW = nblk * NWAVES;
    for (int m = gw; m < M; m += NGW) {
        const f32x4* xr = (const f32x4*)(src + (size_t)m * D) + lane;
        float ss = 0.f;
#pragma unroll
        for (int j = 0; j < 4; ++j) { const f32x4 v = xr[64 * j]; ss += v[0] * v[0] + v[1] * v[1] + v[2] * v[2] + v[3] * v[3]; }
        ss = wave_sum(ss);
        if (lane == 0) rstd[m] = rsqrtf(ss * (1.f / D) + EPS);
    }
}
__device__ void phase_rowstat_bf16(const bf16* src, float* rstd, int bid, int nblk) {
    const int tid = tidx(), lane = tid & 63, gw = bid * NWAVES + (tid >> 6), NGW = nblk * NWAVES;
    for (int m = gw; m < M; m += NGW) {
        const u32x4* xr = (const u32x4*)(src + (size_t)m * D) + lane;
        float ss = 0.f;
#pragma unroll
        for (int j = 0; j < 2; ++j) { const u32x4 v = xr[64 * j];
#pragma unroll
            for (int i = 0; i < 4; ++i) { const float a = lo16(v[i]), b = hi16(v[i]); ss += a * a + b * b; } }
        ss = wave_sum(ss);
        if (lane == 0) rstd[m] = rsqrtf(ss * (1.f / D) + EPS);
    }
}

typedef short v4i16_t __attribute__((ext_vector_type(4)));
typedef __bf16 bf16x2_t __attribute__((ext_vector_type(2)));
typedef float f32x2_t __attribute__((ext_vector_type(2)));
__device__ __forceinline__ unsigned cvtpk(float lo, float hi) { f32x2_t v = {lo, hi}; bf16x2_t b = __builtin_convertvector(v, bf16x2_t); return __builtin_bit_cast(unsigned, b); }
constexpr int ATT_VOFF = 16384, ATT_VPITCH = 288;
__device__ void phase_att_mfma(const Params& p, int L, unsigned char* lds_, int bid, int nblk) {
    LAS unsigned char* lds = (LAS unsigned char*)lds_;
    const int tid = tidx(), lane = tid & 63, w = __builtin_amdgcn_readfirstlane(tid >> 6), fr = lane & 15, fq = lane >> 4;
    const bf16* proj = (const bf16*)(p.ws + WS_PROJ);
    bf16* obuf = (bf16*)(p.ws + WS_OBUF);
    const float* lp = p.diff_lambda + L * 256;
    const float d1 = wave_sum(lp[lane] * lp[64 + lane]), d2 = wave_sum(lp[128 + lane] * lp[192 + lane]);
    const float lam_init = 0.8f - 0.6f * expf(-0.3f * (float)L);
    const float lam = expf(d1) - expf(d2) + lam_init;
    for (int item = bid; item < 256; item += nblk) {
        const int bh = item >> 3, jj = item & 7, b = bh >> 2, hh = bh & 3;
        const float slope2 = exp2f(-2.f * (float)(hh + 1)) * 1.4426950408889634f;
        const bf16* kbase = proj + (size_t)b * SEQ * PROJ_W + 512 + hh * 128;
        const bf16* vbase = proj + (size_t)b * SEQ * PROJ_W + 1024 + hh * 128;
        for (int half = 0; half < 2; ++half) {
            const int qb = half == 0 ? 15 - jj : jj;
            const int qw0 = qb * 128 + w * 16, T = 2 * (qb + 1);
            bf16x8 qf[2][2];
#pragma unroll
            for (int mp = 0; mp < 2; ++mp)
#pragma unroll
                for (int ks = 0; ks < 2; ++ks) qf[mp][ks] = *(const bf16x8*)(proj + ((size_t)b * SEQ + qw0 + fr) * PROJ_W + hh * 128 + mp * 64 + ks * 32 + 8 * fq);
            f32x4 o[2][8];
#pragma unroll
            for (int mp = 0; mp < 2; ++mp)
#pragma unroll
                for (int dt = 0; dt < 8; ++dt) o[mp][dt] = (f32x4){0.f, 0.f, 0.f, 0.f};
            float mrun[2] = {-INFINITY, -INFINITY}, lrun[2] = {0.f, 0.f};
            u32x4 kreg[2], vreg[2];
#pragma unroll
            for (int i = 0; i < 2; ++i) { const int c = tid + 512 * i, key = c >> 4, ch = c & 15;
                kreg[i] = *(const u32x4*)(kbase + (size_t)key * PROJ_W + ch * 8); vreg[i] = *(const u32x4*)(vbase + (size_t)key * PROJ_W + ch * 8); }
            for (int t = 0; t < T; ++t) {
                const int k0 = t * 64;
#pragma unroll
                for (int i = 0; i < 2; ++i) { const int c = tid + 512 * i, key = c >> 4, ch = c & 15;
                    *(LAS u32x4*)(lds + key * 256 + ((ch ^ (key & 15)) << 4)) = kreg[i];
                    *(LAS u32x4*)(lds + ATT_VOFF + key * ATT_VPITCH + ch * 16) = vreg[i]; }
                __syncthreads();
                if (t + 1 < T) {
#pragma unroll
                    for (int i = 0; i < 2; ++i) { const int c = tid + 512 * i, key = k0 + 64 + (c >> 4), ch = c & 15;
                        kreg[i] = *(const u32x4*)(kbase + (size_t)key * PROJ_W + ch * 8); vreg[i] = *(const u32x4*)(vbase + (size_t)key * PROJ_W + ch * 8); }
                }
                if (k0 <= qw0 + 15) {
                    f32x4 s[2][4];
                    const float base = -slope2 * (float)(qw0 + fr - k0 - 4 * fq);
#pragma unroll
                    for (int kt = 0; kt < 4; ++kt)
#pragma unroll
                        for (int r = 0; r < 4; ++r) { const float v = base + slope2 * (float)(16 * kt + r); s[0][kt][r] = v; s[1][kt][r] = v; }
#pragma unroll
                    for (int mp = 0; mp < 2; ++mp)
#pragma unroll
                        for (int kt = 0; kt < 4; ++kt)
#pragma unroll
                            for (int ks = 0; ks < 2; ++ks) {
                                const bf16x8 kf = *(const LAS bf16x8*)(lds + (16 * kt + fr) * 256 + (((mp * 8 + ks * 4 + fq) ^ fr) << 4));
                                s[mp][kt] = __builtin_amdgcn_mfma_f32_16x16x32_bf16(kf, qf[mp][ks], s[mp][kt], 0, 0, 0);
                            }
                    if (k0 + 63 > qw0) {
                        const int lim = qw0 + fr - k0 - 4 * fq;
#pragma unroll
                        for (int mp = 0; mp < 2; ++mp)
#pragma unroll
                            for (int kt = 0; kt < 4; ++kt)
#pragma unroll
                                for (int r = 0; r < 4; ++r) if (16 * kt + r > lim) s[mp][kt][r] = -INFINITY;
                    }
                    bf16x8 pb[2][2];
#pragma unroll
                    for (int mp = 0; mp < 2; ++mp) {
                        float mx = fmaxf(fmaxf(s[mp][0][0], s[mp][0][1]), fmaxf(s[mp][0][2], s[mp][0][3]));
#pragma unroll
                        for (int kt = 1; kt < 4; ++kt) mx = fmaxf(mx, fmaxf(fmaxf(s[mp][kt][0], s[mp][kt][1]), fmaxf(s[mp][kt][2], s[mp][kt][3])));
                        mx = xrow16_max(mx);
                        const float mnew = fmaxf(mrun[mp], mx);
                        const float alpha = __builtin_amdgcn_exp2f(mrun[mp] - mnew);
                        mrun[mp] = mnew;
                        float ps = 0.f;
#pragma unroll
                        for (int kt = 0; kt < 4; ++kt)
#pragma unroll
                            for (int r = 0; r < 4; ++r) { const float e = __builtin_amdgcn_exp2f(s[mp][kt][r] - mnew); s[mp][kt][r] = e; ps += e; }
                        lrun[mp] = lrun[mp] * alpha + ps;
#pragma unroll
                        for (int dt = 0; dt < 8; ++dt) o[mp][dt] = o[mp][dt] * alpha;
#pragma unroll
                        for (int ks = 0; ks < 2; ++ks) {
                            u32x4 pk; pk.x = cvtpk(s[mp][2 * ks][0], s[mp][2 * ks][1]); pk.y = cvtpk(s[mp][2 * ks][2], s[mp][2 * ks][3]);
                            pk.z = cvtpk(s[mp][2 * ks + 1][0], s[mp][2 * ks + 1][1]); pk.w = cvtpk(s[mp][2 * ks + 1][2], s[mp][2 * ks + 1][3]);
                            pb[mp][ks] = __builtin_bit_cast(bf16x8, pk);
                        }
                    }
                    const int gl = lane & 15;
                    LAS unsigned char* vrd = lds + ATT_VOFF + (4 * fq + (gl >> 2)) * ATT_VPITCH + (gl & 3) * 8;
#pragma unroll
                    for (int dt = 0; dt < 8; ++dt)
#pragma unroll
                        for (int ks = 0; ks < 2; ++ks) {
                            const v4i16_t v0 = __builtin_amdgcn_ds_read_tr16_b64_v4i16((LAS v4i16_t*)(vrd + (32 * ks) * ATT_VPITCH + dt * 32));
                            const v4i16_t v1 = __builtin_amdgcn_ds_read_tr16_b64_v4i16((LAS v4i16_t*)(vrd + (32 * ks + 16) * ATT_VPITCH + dt * 32));
                            bf16x8 vf; vf[0] = v0[0]; vf[1] = v0[1]; vf[2] = v0[2]; vf[3] = v0[3]; vf[4] = v1[0]; vf[5] = v1[1]; vf[6] = v1[2]; vf[7] = v1[3];
                            o[0][dt] = __builtin_amdgcn_mfma_f32_16x16x32_bf16(vf, pb[0][ks], o[0][dt], 0, 0, 0);
                            o[1][dt] = __builtin_amdgcn_mfma_f32_16x16x32_bf16(vf, pb[1][ks], o[1][dt], 0, 0, 0);
                        }
                }
                __syncthreads();
            }
            const float i1 = 1.f / xrow16_sum(lrun[0]), i2 = lam / xrow16_sum(lrun[1]);
            float ss = 0.f;
#pragma unroll
            for (int dt = 0; dt < 8; ++dt)
#pragma unroll
                for (int r = 0; r < 4; ++r) { const float v = o[0][dt][r] * i1 - o[1][dt][r] * i2; o[0][dt][r] = v; ss += v * v; }
            ss = xrow16_sum(ss);
            const float rn = rsqrtf(ss * (1.f / 128.f) + EPS) * (1.f - lam_init);
            const float* g = p.subln_g + L * 128;
            bf16* orow = obuf + ((size_t)b * SEQ + qw0 + fr) * D + hh * 128;
#pragma unroll
            for (int dt = 0; dt < 8; ++dt) {
                const f32x4 gv = *(const f32x4*)(g + 16 * dt + 4 * fq);
                u32x2 ov; ov.x = pk2(o[0][dt][0] * rn * gv[0], o[0][dt][1] * rn * gv[1]); ov.y = pk2(o[0][dt][2] * rn * gv[2], o[0][dt][3] * rn * gv[3]);
                *(u32x2*)(orow + 16 * dt + 4 * fq) = ov;
            }
        }
    }
}

constexpr size_t GD_WP = WS_ORAW, GD_QD = WS_ORAW + 16 * MiB, GD_AIP = WS_ORAW + 32 * MiB, GD_KDT = WS_ORAW + 40 * MiB, GD_UT = WS_ORAW + 56 * MiB, GD_GL = WS_ORAW + 72 * MiB;
__device__ __forceinline__ int perm_pos(int k) { return (k & ~31) + 8 * ((k >> 2) & 3) + 4 * ((k >> 4) & 1) + (k & 3); }
__device__ __forceinline__ float softplusf_(float x) { return x > 20.f ? x : log1pf(expf(x)); }

constexpr int GP_KN = 0, GP_QN = 17408, GP_RT = 34816, GP_LM = 71680, GP_TB = 89088, GP_GT = 98304;
constexpr int GP_KP = 272, GP_RP = 144, GP_LP = 68, GP_TP = 144;
__device__ void phase_gdn_prep(const Params& p, int L, unsigned char* lds_, int bid, int nblk) {
    LAS unsigned char* lds = (LAS unsigned char*)lds_;
    const int tid = tidx(), lane = tid & 63, w = __builtin_amdgcn_readfirstlane(tid >> 6), fr = lane & 15, fq = lane >> 4;
    const bf16* proj = (const bf16*)(p.ws + WS_PROJ);
    const float* BA = (const float*)(p.ws + WS_BA);
    bf16* WP = (bf16*)(p.ws + GD_WP); bf16* QD = (bf16*)(p.ws + GD_QD); bf16* AIP = (bf16*)(p.ws + GD_AIP); bf16* KDT = (bf16*)(p.ws + GD_KDT); bf16* UT = (bf16*)(p.ws + GD_UT);
    float* GL = (float*)(p.ws + GD_GL);
    const float* cw = p.conv_w + (size_t)L * 4 * 1536;
    LAS float* beta_s = (LAS float*)(lds + GP_GT); LAS float* gc_s = beta_s + 64; LAS float* egc_s = gc_s + 64; LAS float* edl_s = egc_s + 64;
    LAS float* Lm = (LAS float*)(lds + GP_LM);
    for (int item = bid; item < 1024; item += nblk) {
        const int n = item & 31, bh = item >> 5, hh = bh & 3, b = bh >> 2, t0 = n * 64;
        const size_t row0 = (size_t)b * SEQ + t0;
        __syncthreads();
        if (w == 0) {
            const float negA = -expf(p.a_log[L * 4 + hh]), dtb = p.dt_bias[L * 4 + hh];
            const float bb = BA[(row0 + lane) * 8 + hh], aa = BA[(row0 + lane) * 8 + 4 + hh] + dtb;
            float c = negA * softplusf_(aa);
#pragma unroll
            for (int o = 1; o < 64; o <<= 1) { const float t = __shfl_up(c, o); if (lane >= o) c += t; }
            const float glast = __shfl(c, 63);
            beta_s[lane] = sigmoidf_(bb); gc_s[lane] = c; egc_s[lane] = expf(c); edl_s[lane] = expf(glast - c);
            if (lane == 0) GL[item] = expf(glast);
        }
        __syncthreads();
        {
            const int colq = hh * 128 + 2 * lane;
            {
                float wq[4][2]; unsigned xq[11];
#pragma unroll
                for (int j = 0; j < 4; ++j) { wq[j][0] = cw[j * 1536 + colq]; wq[j][1] = cw[j * 1536 + colq + 1]; }
#pragma unroll
                for (int r = 0; r < 11; ++r) { const int tt = t0 + 8 * w - 3 + r; xq[r] = (tt >= 0) ? *(const unsigned*)(proj + ((size_t)b * SEQ + tt) * PROJ_W + 1536 + colq) : 0u; }
#pragma unroll
                for (int i = 0; i < 8; ++i) {
                    const int c = 8 * w + i;
                    float q0 = 0.f, q1 = 0.f;
#pragma unroll
                    for (int j = 0; j < 4; ++j) { q0 += wq[j][0] * lo16(xq[i + j]); q1 += wq[j][1] * hi16(xq[i + j]); }
                    q0 *= sigmoidf_(q0); q1 *= sigmoidf_(q1);
                    const float sq = rsqrtf(wave_sum(q0 * q0 + q1 * q1) + EPS) * 0.08838834764831845f;
                    q0 *= sq; q1 *= sq;
                    const float eg = egc_s[c];
                    *(LAS unsigned*)(lds + GP_QN + c * GP_KP + lane * 4) = pk2(q0, q1);
                    *(unsigned*)(QD + ((size_t)item * 64 + c) * 128 + perm_pos(2 * lane)) = pk2(q0 * eg, q1 * eg);
                }
            }
            __builtin_amdgcn_sched_barrier(0);
            {
                float wk[4][2]; unsigned xk[11];
#pragma unroll
                for (int j = 0; j < 4; ++j) { wk[j][0] = cw[j * 1536 + 512 + colq]; wk[j][1] = cw[j * 1536 + 512 + colq + 1]; }
#pragma unroll
                for (int r = 0; r < 11; ++r) { const int tt = t0 + 8 * w - 3 + r; xk[r] = (tt >= 0) ? *(const unsigned*)(proj + ((size_t)b * SEQ + tt) * PROJ_W + 1536 + 512 + colq) : 0u; }
                unsigned kd0[8], kd1[8], rk0[8], rk1[8];
#pragma unroll
                for (int i = 0; i < 8; ++i) {
                    const int c = 8 * w + i;
                    float k0 = 0.f, k1 = 0.f;
#pragma unroll
                    for (int j = 0; j < 4; ++j) { k0 += wk[j][0] * lo16(xk[i + j]); k1 += wk[j][1] * hi16(xk[i + j]); }
                    k0 *= sigmoidf_(k0); k1 *= sigmoidf_(k1);
                    const float sk = rsqrtf(wave_sum(k0 * k0 + k1 * k1) + EPS);
                    k0 *= sk; k1 *= sk;
                    const float be = beta_s[c], eg = egc_s[c], ed = edl_s[c];
                    *(LAS unsigned*)(lds + GP_KN + c * GP_KP + lane * 4) = pk2(k0, k1);
                    kd0[i] = f2bf(k0 * ed); kd1[i] = f2bf(k1 * ed);
                    rk0[i] = f2bf(k0 * be * eg); rk1[i] = f2bf(k1 * be * eg);
                }
                u32x4 o;
                o.x = rk0[0] | (rk0[1] << 16); o.y = rk0[2] | (rk0[3] << 16); o.z = rk0[4] | (rk0[5] << 16); o.w = rk0[6] | (rk0[7] << 16); *(LAS u32x4*)(lds + GP_RT + (128 + 2 * lane) * GP_RP + 16 * w) = o;
                o.x = rk1[0] | (rk1[1] << 16); o.y = rk1[2] | (rk1[3] << 16); o.z = rk1[4] | (rk1[5] << 16); o.w = rk1[6] | (rk1[7] << 16); *(LAS u32x4*)(lds + GP_RT + (128 + 2 * lane + 1) * GP_RP + 16 * w) = o;
                const int pa = perm_pos(8 * w), pb = perm_pos(8 * w + 4);
                bf16* kr0 = KDT + ((size_t)item * 128 + 2 * lane) * 64; bf16* kr1 = kr0 + 64;
                u32x2 h2;
                h2.x = kd0[0] | (kd0[1] << 16); h2.y = kd0[2] | (kd0[3] << 16); *(u32x2*)(kr0 + pa) = h2;
                h2.x = kd0[4] | (kd0[5] << 16); h2.y = kd0[6] | (kd0[7] << 16); *(u32x2*)(kr0 + pb) = h2;
                h2.x = kd1[0] | (kd1[1] << 16); h2.y = kd1[2] | (kd1[3] << 16); *(u32x2*)(kr1 + pa) = h2;
                h2.x = kd1[4] | (kd1[5] << 16); h2.y = kd1[6] | (kd1[7] << 16); *(u32x2*)(kr1 + pb) = h2;
            }
            __builtin_amdgcn_sched_barrier(0);
            {
                float wv[4][2]; unsigned xv[11];
#pragma unroll
                for (int j = 0; j < 4; ++j) { wv[j][0] = cw[j * 1536 + 1024 + colq]; wv[j][1] = cw[j * 1536 + 1024 + colq + 1]; }
#pragma unroll
                for (int r = 0; r < 11; ++r) { const int tt = t0 + 8 * w - 3 + r; xv[r] = (tt >= 0) ? *(const unsigned*)(proj + ((size_t)b * SEQ + tt) * PROJ_W + 1536 + 1024 + colq) : 0u; }
                unsigned rv0[8], rv1[8];
#pragma unroll
                for (int i = 0; i < 8; ++i) {
                    float v0 = 0.f, v1 = 0.f;
#pragma unroll
                    for (int j = 0; j < 4; ++j) { v0 += wv[j][0] * lo16(xv[i + j]); v1 += wv[j][1] * hi16(xv[i + j]); }
                    v0 *= sigmoidf_(v0); v1 *= sigmoidf_(v1);
                    const float be = beta_s[8 * w + i];
                    rv0[i] = f2bf(v0 * be); rv1[i] = f2bf(v1 * be);
                }
                u32x4 o;
                o.x = rv0[0] | (rv0[1] << 16); o.y = rv0[2] | (rv0[3] << 16); o.z = rv0[4] | (rv0[5] << 16); o.w = rv0[6] | (rv0[7] << 16); *(LAS u32x4*)(lds + GP_RT + (2 * lane) * GP_RP + 16 * w) = o;
                o.x = rv1[0] | (rv1[1] << 16); o.y = rv1[2] | (rv1[3] << 16); o.z = rv1[4] | (rv1[5] << 16); o.w = rv1[6] | (rv1[7] << 16); *(LAS u32x4*)(lds + GP_RT + (2 * lane + 1) * GP_RP + 16 * w) = o;
            }
        }
        __syncthreads();
#pragma unroll
        for (int q = 0; q < 2; ++q) {
            const int id = 2 * w + q, ct = id >> 2, st = id & 3;
            if (st <= ct) {
                f32x4 acc = (f32x4){0.f, 0.f, 0.f, 0.f};
#pragma unroll
                for (int ks = 0; ks < 4; ++ks) {
                    const bf16x8 a = *(const LAS bf16x8*)(lds + GP_KN + (16 * ct + fr) * GP_KP + (32 * ks + 8 * fq) * 2);
                    const bf16x8 bb = *(const LAS bf16x8*)(lds + GP_KN + (16 * st + fr) * GP_KP + (32 * ks + 8 * fq) * 2);
                    acc = __builtin_amdgcn_mfma_f32_16x16x32_bf16(a, bb, acc, 0, 0, 0);
                }
                const int s = 16 * st + fr; const float gs = gc_s[s];
#pragma unroll
                for (int r = 0; r < 4; ++r) { const int c = 16 * ct + 4 * fq + r;
                    Lm[c * GP_LP + s] = (s < c) ? beta_s[c] * acc[r] * expf(fminf(gc_s[c] - gs, 0.f)) : 0.f; }
            }
        }
        __syncthreads();
        if (w == 0) {
            float t[64];
            int zoff = 0; asm volatile("" : "+v"(zoff));
            const LAS float* Lz = Lm + zoff;
#pragma unroll
            for (int i = 0; i < 64; ++i) {
                float a0 = (i == lane) ? 1.f : 0.f, a1 = 0.f, a2 = 0.f, a3 = 0.f;
#pragma unroll
                for (int s4 = 0; s4 + 4 <= i; s4 += 4) { const f32x4 lv = *(const LAS f32x4*)(Lz + i * GP_LP + s4);
                    a0 -= lv[0] * t[s4]; a1 -= lv[1] * t[s4 + 1]; a2 -= lv[2] * t[s4 + 2]; a3 -= lv[3] * t[s4 + 3]; }
#pragma unroll
                for (int s = i & ~3; s < i; ++s) a0 -= Lz[i * GP_LP + s] * t[s];
                t[i] = (a0 + a1) + (a2 + a3);
                *(LAS bf16*)(lds + GP_TB + i * GP_TP + lane * 2) = (bf16)f2bf(t[i]);
                if ((i & 3) == 3) __builtin_amdgcn_sched_barrier(0);
            }
        } else {
            for (int id = w - 1; id < 16; id += 7) {
                const int ct = id >> 2, st = id & 3;
                f32x4 acc = (f32x4){0.f, 0.f, 0.f, 0.f};
                if (st <= ct) {
#pragma unroll
                    for (int ks = 0; ks < 4; ++ks) {
                        const bf16x8 a = *(const LAS bf16x8*)(lds + GP_QN + (16 * ct + fr) * GP_KP + (32 * ks + 8 * fq) * 2);
                        const bf16x8 bb = *(const LAS bf16x8*)(lds + GP_KN + (16 * st + fr) * GP_KP + (32 * ks + 8 * fq) * 2);
                        acc = __builtin_amdgcn_mfma_f32_16x16x32_bf16(a, bb, acc, 0, 0, 0);
                    }
                }
                const int s = 16 * st + fr; const float gs = gc_s[s]; const int ps = perm_pos(s);
#pragma unroll
                for (int r = 0; r < 4; ++r) { const int c = 16 * ct + 4 * fq + r;
                    const float v = (s <= c) ? acc[r] * expf(fminf(gc_s[c] - gs, 0.f)) : 0.f;
                    AIP[((size_t)item * 64 + c) * 64 + ps] = (bf16)f2bf(v); }
            }
        }
        __syncthreads();
#pragma unroll
        for (int q = 0; q < 2; ++q) {
            const int colt = 2 * w + q;
            bf16x8 af[2];
#pragma unroll
            for (int ks = 0; ks < 2; ++ks) af[ks] = *(const LAS bf16x8*)(lds + GP_RT + (16 * colt + fr) * GP_RP + (32 * ks + 8 * fq) * 2);
#pragma unroll
            for (int ct = 0; ct < 4; ++ct) {
                f32x4 acc = (f32x4){0.f, 0.f, 0.f, 0.f};
#pragma unroll
                for (int ks = 0; ks < 2; ++ks) {
                    const bf16x8 bb = *(const LAS bf16x8*)(lds + GP_TB + (16 * ct + fr) * GP_TP + (32 * ks + 8 * fq) * 2);
                    acc = __builtin_amdgcn_mfma_f32_16x16x32_bf16(af[ks], bb, acc, 0, 0, 0);
                }
                const int c = 16 * ct + fr;
                if (colt < 8) {
#pragma unroll
                    for (int r = 0; r < 4; ++r) UT[((size_t)item * 128 + 16 * colt + 4 * fq + r) * 64 + c] = (bf16)f2bf(acc[r]);
                } else {
                    const int kt = colt - 8;
                    u32x2 h2; h2.x = pk2(-acc[0], -acc[1]); h2.y = pk2(-acc[2], -acc[3]);
                    *(u32x2*)(WP + ((size_t)item * 64 + c) * 128 + 32 * (kt >> 1) + 8 * fq + 4 * (kt & 1)) = h2;
                }
            }
        }
    }
    __syncthreads();
}

constexpr int GS_WP = 0, GS_QD = 17408, GS_AIP = 34816, GS_KDT = 44032, GS_BUF = 62464, GS_SSX = 2 * GS_BUF;
__device__ void phase_gdn_scan(const Params& p, int L, unsigned char* lds_, int bid, int nblk) {
    LAS unsigned char* lds = (LAS unsigned char*)lds_;
    const int tid = tidx(), lane = tid & 63, w = __builtin_amdgcn_readfirstlane(tid >> 6), fr = lane & 15, fq = lane >> 4;
    const bf16* proj = (const bf16*)(p.ws + WS_PROJ);
    const bf16* WP = (const bf16*)(p.ws + GD_WP); const bf16* QD = (const bf16*)(p.ws + GD_QD); const bf16* AIP = (const bf16*)(p.ws + GD_AIP);
    const bf16* KDT = (const bf16*)(p.ws + GD_KDT); const bf16* UT = (const bf16*)(p.ws + GD_UT); const float* GL = (const float*)(p.ws + GD_GL);
    bf16* obuf = (bf16*)(p.ws + WS_OBUF);
    LAS float* ssx = (LAS float*)(lds + GS_SSX);
    for (int item = bid; item < 32; item += nblk) {
        const int hh = item & 3, b = item >> 2;
        const float gn = p.gdn_norm_g[L * 128 + 16 * w + fr];
        f32x4 S[8];
#pragma unroll
        for (int kt = 0; kt < 8; ++kt) S[kt] = (f32x4){0.f, 0.f, 0.f, 0.f};
        f32x4 oprev[4];
#pragma unroll
        for (int ct = 0; ct < 4; ++ct) oprev[ct] = (f32x4){0.f, 0.f, 0.f, 0.f};
        u32x4 st[7];
        auto gload = [&](int ci) {
#pragma unroll
            for (int i = 0; i < 7; ++i) {
                const int pc = tid + 512 * i;
                const bf16* src;
                if (i < 2) src = WP + (size_t)ci * 8192 + pc * 8;
                else if (i < 4) src = QD + (size_t)ci * 8192 + (pc - 1024) * 8;
                else if (i < 5) src = AIP + (size_t)ci * 4096 + (pc - 2048) * 8;
                else src = KDT + (size_t)ci * 8192 + (pc - 2560) * 8;
                st[i] = *(const u32x4*)src;
            }
        };
        auto lstore = [&](int buf) {
#pragma unroll
            for (int i = 0; i < 7; ++i) {
                const int pc = tid + 512 * i;
                int off;
                if (i < 2) off = GS_WP + (pc >> 4) * 272 + (pc & 15) * 16;
                else if (i < 4) { const int q = pc - 1024; off = GS_QD + (q >> 4) * 272 + (q & 15) * 16; }
                else if (i < 5) { const int q = pc - 2048; off = GS_AIP + (q >> 3) * 144 + (q & 7) * 16; }
                else { const int q = pc - 2560; off = GS_KDT + (q >> 3) * 144 + (q & 7) * 16; }
                *(LAS u32x4*)(lds + buf * GS_BUF + off) = st[i];
            }
        };
        __syncthreads();
        gload(item * 32); lstore(0);
        __syncthreads();
        for (int n = 0; n <= 32; ++n) {
            const int ci = item * 32 + n, buf = n & 1;
            f32x4 oacc[4];
            if (n < 32) {
                if (n + 1 < 32) gload(ci + 1);
                const float gl = GL[ci];
                f32x4 vn[4];
#pragma unroll
                for (int ct = 0; ct < 4; ++ct) { const u32x2 uu = *(const u32x2*)(UT + ((size_t)ci * 128 + 16 * w + fr) * 64 + 16 * ct + 4 * fq);
                    vn[ct] = (f32x4){lo16(uu.x), hi16(uu.x), lo16(uu.y), hi16(uu.y)}; }
                bf16x8 sb[4];
#pragma unroll
                for (int ks = 0; ks < 4; ++ks) { u32x4 pk; pk.x = cvtpk(S[2 * ks][0], S[2 * ks][1]); pk.y = cvtpk(S[2 * ks][2], S[2 * ks][3]); pk.z = cvtpk(S[2 * ks + 1][0], S[2 * ks + 1][1]); pk.w = cvtpk(S[2 * ks + 1][2], S[2 * ks + 1][3]);
                    sb[ks] = __builtin_bit_cast(bf16x8, pk); }
                LAS unsigned char* bb = lds + buf * GS_BUF;
#pragma unroll
                for (int ct = 0; ct < 4; ++ct) {
                    oacc[ct] = (f32x4){0.f, 0.f, 0.f, 0.f};
#pragma unroll
                    for (int ks = 0; ks < 4; ++ks) {
                        const bf16x8 aw = *(const LAS bf16x8*)(bb + GS_WP + (16 * ct + fr) * 272 + (32 * ks + 8 * fq) * 2);
                        const bf16x8 aq = *(const LAS bf16x8*)(bb + GS_QD + (16 * ct + fr) * 272 + (32 * ks + 8 * fq) * 2);
                        vn[ct] = __builtin_amdgcn_mfma_f32_16x16x32_bf16(aw, sb[ks], vn[ct], 0, 0, 0);
                        oacc[ct] = __builtin_amdgcn_mfma_f32_16x16x32_bf16(aq, sb[ks], oacc[ct], 0, 0, 0);
                    }
                }
                bf16x8 vb[2];
#pragma unroll
                for (int ss = 0; ss < 2; ++ss) { u32x4 pk; pk.x = cvtpk(vn[2 * ss][0], vn[2 * ss][1]); pk.y = cvtpk(vn[2 * ss][2], vn[2 * ss][3]); pk.z = cvtpk(vn[2 * ss + 1][0], vn[2 * ss + 1][1]); pk.w = cvtpk(vn[2 * ss + 1][2], vn[2 * ss + 1][3]);
                    vb[ss] = __builtin_bit_cast(bf16x8, pk); }
#pragma unroll
                for (int ct = 0; ct < 4; ++ct)
#pragma unroll
                    for (int ss = 0; ss < 2; ++ss) {
                        const bf16x8 aa = *(const LAS bf16x8*)(bb + GS_AIP + (16 * ct + fr) * 144 + (32 * ss + 8 * fq) * 2);
                        oacc[ct] = __builtin_amdgcn_mfma_f32_16x16x32_bf16(aa, vb[ss], oacc[ct], 0, 0, 0);
                    }
#pragma unroll
                for (int kt = 0; kt < 8; ++kt) {
                    S[kt] = S[kt] * gl;
#pragma unroll
                    for (int ss = 0; ss < 2; ++ss) {
                        const bf16x8 ak = *(const LAS bf16x8*)(bb + GS_KDT + (16 * kt + fr) * 144 + (32 * ss + 8 * fq) * 2);
                        S[kt] = __builtin_amdgcn_mfma_f32_16x16x32_bf16(ak, vb[ss], S[kt], 0, 0, 0);
                    }
                }
#pragma unroll
                for (int ct = 0; ct < 4; ++ct)
#pragma unroll
                    for (int r = 0; r < 4; ++r) { const float sq = row16_sum(oacc[ct][r] * oacc[ct][r]); if (fr == 0) ssx[(buf * 64 + 16 * ct + 4 * fq + r) * 8 + w] = sq; }
            }
            if (n > 0) {
                const int pb = (n - 1) & 1; const size_t rowp = (size_t)b * SEQ + (n - 1) * 64;
#pragma unroll
                for (int ct = 0; ct < 4; ++ct)
#pragma unroll
                    for (int r = 0; r < 4; ++r) {
                        const int c = 16 * ct + 4 * fq + r;
                        const f32x4 s0 = *(const LAS f32x4*)(ssx + (pb * 64 + c) * 8), s1 = *(const LAS f32x4*)(ssx + (pb * 64 + c) * 8 + 4);
                        const float tot = ((s0[0] + s0[1]) + (s0[2] + s0[3])) + ((s1[0] + s1[1]) + (s1[2] + s1[3]));
                        const float rn = rsqrtf(tot * (1.f / 128.f) + EPS);
                        const float z = bf2f(proj[(rowp + c) * PROJ_W + 3072 + hh * 128 + 16 * w + fr]);
                        obuf[(rowp + c) * D + 512 + hh * 128 + 16 * w + fr] = (bf16)f2bf(oprev[ct][r] * rn * gn * (z * sigmoidf_(z)));
                    }
            }
            if (n < 32) {
#pragma unroll
                for (int ct = 0; ct < 4; ++ct) oprev[ct] = oacc[ct];
                if (n + 1 < 32) lstore(buf ^ 1);
            }
            __syncthreads();
        }
    }
}

__device__ __forceinline__ unsigned sortable(float f) { const unsigned u = __float_as_uint(f); return u ^ ((unsigned)((int)u >> 31) | 0x80000000u); }
__device__ __forceinline__ float unsortable(unsigned s) { return __uint_as_float((s & 0x80000000u) ? (s ^ 0x80000000u) : ~s); }
#define CE(a, b) do { const unsigned _x = k[a], _y = k[b]; k[a] = _x > _y ? _x : _y; k[b] = _x > _y ? _y : _x; } while (0)
constexpr int PE_TK = 0, PE_TAB = 8192, PE_ID = 8448, PE_GT = PE_ID + 32768;
__device__ void phase_peer(const Params& p, int L, unsigned char* lds_, int bid, int nblk) {
    LAS unsigned char* lds = (LAS unsigned char*)lds_;
    const int tid = tidx(), lane = tid & 63, w = __builtin_amdgcn_readfirstlane(tid >> 6), fr = lane & 15, fq = lane >> 4;
    const bf16* Q2 = (const bf16*)(p.ws + WS_Q2);
    const bf16* SK = (const bf16*)(p.ws + WS_SK) + (size_t)L * 8 * 2 * 128 * 128;
    float* H = (float*)(p.ws + WS_H); bf16* HB2 = (bf16*)(p.ws + WS_HB2);
    const bf16* U = (const bf16*)(p.ws + WS_U) + (size_t)L * NEXP * D;
    const bf16* V = (const bf16*)(p.ws + WS_V) + (size_t)L * NEXP * D;
    const float* g = p.ln_ffn_g + L * D;
    LAS unsigned* TK = (LAS unsigned*)(lds + PE_TK);
    LAS unsigned short* TAB = (LAS unsigned short*)(lds + PE_TAB);
    LAS int* IDL = (LAS int*)(lds + PE_ID); LAS float* GTL = (LAS float*)(lds + PE_GT);
    if (tid < 64) {
        int a = 0, base = 0, q = tid; unsigned short v = 0xffff;
        if (q < 50) { for (;;) { const int cnt = 16 / (a + 1); if (q < base + cnt) break; base += cnt; ++a; } v = (unsigned short)((a << 8) | (q - base)); }
        TAB[tid] = v;
    }
    for (int item = bid; item < M / 64; item += nblk) {
        const int tok0 = item * 64;
        __syncthreads();
        const int tg = w & 3, cc = w >> 2;
        for (int hh = 0; hh < 8; ++hh) {
            {
                f32x4 acc[8];
#pragma unroll
                for (int nt = 0; nt < 8; ++nt) acc[nt] = (f32x4){0.f, 0.f, 0.f, 0.f};
                bf16x8 qa[4];
#pragma unroll
                for (int ks = 0; ks < 4; ++ks) qa[ks] = *(const bf16x8*)(Q2 + (size_t)(tok0 + 16 * tg + fr) * 2048 + hh * 256 + cc * 128 + 32 * ks + 8 * fq);
                const bf16* skb = SK + ((size_t)(hh * 2 + cc) * 128 + fr) * 128 + 8 * fq;
#pragma unroll
                for (int nt = 0; nt < 8; ++nt)
#pragma unroll
                    for (int ks = 0; ks < 4; ++ks) {
                        const bf16x8 kb = *(const bf16x8*)(skb + (size_t)nt * 16 * 128 + 32 * ks);
                        acc[nt] = __builtin_amdgcn_mfma_f32_16x16x32_bf16(qa[ks], kb, acc[nt], 0, 0, 0);
                    }
#pragma unroll
                for (int r = 0; r < 4; ++r) {
                    unsigned k[8];
#pragma unroll
                    for (int nt = 0; nt < 8; ++nt) k[nt] = (sortable(acc[nt][r]) & ~0x7Fu) | (unsigned)(127 - (16 * nt + fr));
                    CE(0, 1); CE(2, 3); CE(4, 5); CE(6, 7); CE(0, 2); CE(1, 3); CE(4, 6); CE(5, 7); CE(1, 2); CE(5, 6); CE(0, 4); CE(3, 7);
                    CE(1, 5); CE(2, 6); CE(1, 4); CE(3, 6); CE(2, 4); CE(3, 5); CE(3, 4);
                    unsigned res = 0u;
#pragma unroll
                    for (int rd = 0; rd < 16; ++rd) {
                        const unsigned m = row16_umax(k[0]);
                        const bool win = k[0] == m;
#pragma unroll
                        for (int i = 0; i < 7; ++i) k[i] = win ? k[i + 1] : k[i];
                        k[7] = win ? 0u : k[7];
                        res = (fr == rd) ? m : res;
                    }
                    TK[(cc * 64 + 16 * tg + 4 * fq + r) * 16 + fr] = res;
                }
            }
            __syncthreads();
#pragma unroll
            for (int ps = 0; ps < 2; ++ps) {
                const int tl = 8 * w + 4 * ps + fq;
                unsigned k[4];
#pragma unroll
                for (int sl = 0; sl < 4; ++sl) {
                    const int q = sl * 16 + fr;
                    const unsigned ab = TAB[q];
                    const unsigned k1 = TK[tl * 16 + ((ab >> 8) & 15)], k2 = TK[(64 + tl) * 16 + (ab & 15)];
                    const float v = unsortable(k1 & ~0x7Fu) + unsortable(k2 & ~0x7Fu);
                    k[sl] = (q < 50) ? ((sortable(v) & ~0x3Fu) | (unsigned)(63 - q)) : 0u;
                }
                CE(0, 1); CE(2, 3); CE(0, 2); CE(1, 3); CE(1, 2);
                unsigned res = 0u;
#pragma unroll
                for (int rd = 0; rd < 16; ++rd) {
                    const unsigned m = row16_umax(k[0]);
                    const bool win = k[0] == m;
                    k[0] = win ? k[1] : k[0]; k[1] = win ? k[2] : k[1]; k[2] = win ? k[3] : k[2]; k[3] = win ? 0u : k[3];
                    res = (fr == rd) ? m : res;
                }
                const unsigned ab = TAB[63 - (res & 0x3Fu)];
                const unsigned k1 = TK[tl * 16 + ((ab >> 8) & 15)], k2 = TK[(64 + tl) * 16 + (ab & 15)];
                const float v = unsortable(k1 & ~0x7Fu) + unsortable(k2 & ~0x7Fu);
                const float e = __expf(v - row16_max(v));
                const float sum = row16_sum(e);
                IDL[tl * 128 + hh * 16 + fr] = (int)((127u - (k1 & 0x7Fu)) * 128u + (127u - (k2 & 0x7Fu)));
                GTL[tl * 128 + hh * 16 + fr] = e / sum;
            }
            __syncthreads();
        }
        for (int ti = 0; ti < 8; ++ti) {
            const int tl = 8 * w + ti, tok = tok0 + tl;
            float* hrow = H + (size_t)tok * D;
            float xv[16];
            {
                const f32x4 a0 = *(const f32x4*)(hrow + 8 * lane), a1 = *(const f32x4*)(hrow + 8 * lane + 4), b0 = *(const f32x4*)(hrow + 512 + 8 * lane), b1 = *(const f32x4*)(hrow + 512 + 8 * lane + 4);
#pragma unroll
                for (int i = 0; i < 4; ++i) { xv[i] = a0[i]; xv[4 + i] = a1[i]; xv[8 + i] = b0[i]; xv[12 + i] = b1[i]; }
            }
            float ss = 0.f;
#pragma unroll
            for (int i = 0; i < 16; ++i) ss += xv[i] * xv[i];
            const float rstd = rsqrtf(wave_sum(ss) * (1.f / D) + EPS);
            float xn[16];
#pragma unroll
            for (int i = 0; i < 8; ++i) { xn[i] = xv[i] * rstd * g[8 * lane + i]; xn[8 + i] = xv[8 + i] * rstd * g[512 + 8 * lane + i]; }
            float h0 = 0.f, h1 = 0.f;
#pragma unroll 4
            for (int e = 0; e < 128; ++e) {
                const int id = IDL[tl * 128 + e];
                const bf16* ur = U + (size_t)id * D;
                const u32x4 a = *(const u32x4*)(ur + 8 * lane), b = *(const u32x4*)(ur + 512 + 8 * lane);
                float d = 0.f;
#pragma unroll
                for (int i = 0; i < 4; ++i) { d += xn[2 * i] * lo16(a[i]) + xn[2 * i + 1] * hi16(a[i]); d += xn[8 + 2 * i] * lo16(b[i]) + xn[8 + 2 * i + 1] * hi16(b[i]); }
                d = wave_sum(d);
                if (lane == (e & 63)) { if (e < 64) h0 = d; else h1 = d; }
            }
            const float w0 = GTL[tl * 128 + lane] * 0.5f * h0 * (1.f + erff(h0 * 0.70710678118654752f));
            const float w1 = GTL[tl * 128 + 64 + lane] * 0.5f * h1 * (1.f + erff(h1 * 0.70710678118654752f));
            float y[16];
#pragma unroll
            for (int i = 0; i < 16; ++i) y[i] = 0.f;
#pragma unroll 4
            for (int e = 0; e < 128; ++e) {
                const int id = IDL[tl * 128 + e];
                const float ww = __shfl(e < 64 ? w0 : w1, e & 63);
                const bf16* vr = V + (size_t)id * D;
                const u32x4 a = *(const u32x4*)(vr + 8 * lane), b = *(const u32x4*)(vr + 512 + 8 * lane);
#pragma unroll
                for (int i = 0; i < 4; ++i) { y[2 * i] += ww * lo16(a[i]); y[2 * i + 1] += ww * hi16(a[i]); y[8 + 2 * i] += ww * lo16(b[i]); y[8 + 2 * i + 1] += ww * hi16(b[i]); }
            }
#pragma unroll
            for (int i = 0; i < 16; ++i) y[i] += xv[i];
            *(f32x4*)(hrow + 8 * lane) = (f32x4){y[0], y[1], y[2], y[3]};
            *(f32x4*)(hrow + 8 * lane + 4) = (f32x4){y[4], y[5], y[6], y[7]};
            *(f32x4*)(hrow + 512 + 8 * lane) = (f32x4){y[8], y[9], y[10], y[11]};
            *(f32x4*)(hrow + 512 + 8 * lane + 4) = (f32x4){y[12], y[13], y[14], y[15]};
            bf16* hb = HB2 + (size_t)tok * D;
            u32x4 o; o.x = pk2(y[0], y[1]); o.y = pk2(y[2], y[3]); o.z = pk2(y[4], y[5]); o.w = pk2(y[6], y[7]);
            *(u32x4*)(hb + 8 * lane) = o;
            o.x = pk2(y[8], y[9]); o.y = pk2(y[10], y[11]); o.z = pk2(y[12], y[13]); o.w = pk2(y[14], y[15]);
            *(u32x4*)(hb + 512 + 8 * lane) = o;
        }
    }
    __syncthreads();
}
#undef CE

__device__ void phase_final(const Params& p, int bid, int nblk) {
    const int tid = tidx(), lane = tid & 63, gw = bid * NWAVES + (tid >> 6), NGW = nblk * NWAVES;
    const float* H = (const float*)(p.ws + WS_H); const float* rstd0 = (const float*)(p.ws + WS_STAT);
    for (int m = gw; m < M; m += NGW) {
        const float r = rstd0[m];
#pragma unroll
        for (int j = 0; j < 4; ++j) {
            const f32x4 v = ((const f32x4*)(H + (size_t)m * D))[lane + 64 * j];
            const f32x4 gv = ((const f32x4*)p.final_g)[lane + 64 * j];
            ((f32x4*)(p.out + (size_t)m * D))[lane + 64 * j] = v * r * gv;
        }
    }
}

#define XB_TMO      128
#define XB_XCNT(j)  (256  + 64 * (j))
#define XB_XSUB(j)  (1280 + 64 * (j))
#define XB_XGEN(j)  (2304 + 64 * (j))
#define XB_TOP      3328
#define XB_TOPGEN   3392
#define XCD_BAR_WORDS 3456
#define XB_SPIN_CAP (1u << 22)
__device__ __forceinline__ unsigned xb_ld(unsigned* p)              { return __hip_atomic_load(p, __ATOMIC_RELAXED, __HIP_MEMORY_SCOPE_AGENT); }
__device__ __forceinline__ unsigned xb_add(unsigned* p, unsigned v) { return __hip_atomic_fetch_add(p, v, __ATOMIC_RELAXED, __HIP_MEMORY_SCOPE_AGENT); }
__device__ __forceinline__ unsigned xb_xcc_id() { return (unsigned)__builtin_amdgcn_s_getreg((3 << 11) | 20) & 0xFu; }
#define XB_SPIN(cond, bar) do { unsigned _sp = 0; while (cond) { __builtin_amdgcn_s_sleep(1); \
    if ((++_sp & 255u) == 0u) { if (xb_ld(&(bar)[XB_TMO])) break; if (_sp > XB_SPIN_CAP) { atomicAdd(&(bar)[XB_TMO], 1u); break; } } } } while (0)
struct XcdBarrier { unsigned* bar; unsigned x; volatile LAS unsigned* st; };
__device__ __forceinline__ XcdBarrier xcd_barrier_post(unsigned* bar, volatile LAS unsigned* st) {
    XcdBarrier b; b.bar = bar; b.x = xb_xcc_id(); b.st = st;
    if (threadIdx.x == 0) (void)xb_add(&bar[XB_XCNT(b.x)], 1u);
    return b;
}
__device__ __forceinline__ void xcd_barrier_complete(unsigned* bar, unsigned x, unsigned& nloc, unsigned& nx) {
    const unsigned G = gridDim.x * gridDim.y * gridDim.z;
    unsigned sum, cnt, mine, sp = 0u;
    for (;;) {
        sum = 0u; cnt = 0u; mine = 0u;
#pragma unroll
        for (unsigned j = 0; j < 16; ++j) { const unsigned c = xb_ld(&bar[XB_XCNT(j)]); sum += c; cnt += (c > 0u) ? 1u : 0u; mine = (j == x) ? c : mine; }
        if (sum == G) break;
        __builtin_amdgcn_s_sleep(1);
        if ((++sp & 255u) == 0u) { if (xb_ld(&bar[XB_TMO])) break; if (sp > XB_SPIN_CAP) { atomicAdd(&bar[XB_TMO], 1u); break; } }
    }
    nloc = mine > 0u ? mine : 1u; nx = cnt > 0u ? cnt : 1u;
}
__device__ __forceinline__ void xcd_barrier(const XcdBarrier& b) {
    asm volatile("s_waitcnt vmcnt(0)" ::: "memory");
    __syncthreads();
    if (threadIdx.x == 0) {
        unsigned* bar = b.bar;
        __builtin_amdgcn_s_waitcnt(0);
        unsigned nloc = b.st[0], nx = b.st[1];
        if (nloc == 0u) { xcd_barrier_complete(bar, b.x, nloc, nx); b.st[0] = nloc; b.st[1] = nx; }
        const unsigned old = xb_add(&bar[XB_XSUB(b.x)], 1u);
        const unsigned gen = old / nloc;
        if (old + 1u == (gen + 1u) * nloc) {
            __builtin_amdgcn_fence(__ATOMIC_RELEASE, "agent");
            asm volatile("s_waitcnt vmcnt(0)" ::: "memory");
            const unsigned og = xb_add(&bar[XB_TOP], 1u);
            const unsigned tg = og / nx;
            if (og + 1u == (tg + 1u) * nx) xb_add(&bar[XB_TOPGEN], 1u);
            else XB_SPIN(xb_ld(&bar[XB_TOPGEN]) == tg, bar);
            __builtin_amdgcn_fence(__ATOMIC_ACQUIRE, "agent");
            xb_add(&bar[XB_XGEN(b.x)], 1u);
            asm volatile("s_waitcnt vmcnt(0)" ::: "memory");
        } else {
            XB_SPIN(xb_ld(&bar[XB_XGEN(b.x)]) == gen, bar);
            __builtin_amdgcn_fence(__ATOMIC_ACQUIRE, "agent");
            asm volatile("s_waitcnt vmcnt(0)" ::: "memory");
        }
    }
    __syncthreads();
}
constexpr int CW_BAR = 4096;
constexpr int LDS_MISC_OFF = LDS_BYTES - 256;

constexpr int NS = 11;
constexpr int K_PROLOGUE = 11, K_FINAL = 12;
template <int KIND>
__device__ __forceinline__ void run_kind(const Params& p, int L, unsigned char* lds, int bid, int nblk) {
    unsigned char* ws = p.ws;
    float* H = (float*)(ws + WS_H);
    float* rstd0 = (float*)(ws + WS_STAT); float* rstd1 = rstd0 + M; float* rstde = rstd1 + M;
    if constexpr (KIND == K_PROLOGUE) phase_prologue(p, lds, bid, nblk);
    if constexpr (KIND == K_FINAL) phase_final(p, bid, nblk);
    if constexpr (KIND == 0) { EpiProj E{(bf16*)(ws + WS_PROJ), (float*)(ws + WS_BA), rstd0};
        gemm_run(lds, (const bf16*)(ws + WS_HB0), (const bf16*)(ws + WS_WIN) + (size_t)L * IN_PAD * D, M, IN_PAD, D, E, bid, nblk); }
    if constexpr (KIND == 1) phase_att_mfma(p, L, lds, bid, nblk);
    if constexpr (KIND == 2) phase_gdn_prep(p, L, lds, bid, nblk);
    if constexpr (KIND == 3) phase_gdn_scan(p, L, lds, bid, nblk);
    if constexpr (KIND == 4) { EpiRes E{H, (bf16*)(ws + WS_HB1)};
        gemm_run(lds, (const bf16*)(ws + WS_OBUF), (const bf16*)(ws + WS_WOUT) + (size_t)L * D * D, M, D, D, E, bid, nblk); }
    if constexpr (KIND == 5) phase_rowstat_f32(H, rstd1, bid, nblk);
    if constexpr (KIND == 6) { EpiQ2 E{(bf16*)(ws + WS_Q2), rstd1};
        gemm_run(lds, (const bf16*)(ws + WS_HB1), (const bf16*)(ws + WS_WQ) + (size_t)L * 2048 * D, M, 2048, D, E, bid, nblk);
        EpiE E2{(bf16*)(ws + WS_EPRE)};
        gemm_run(lds, (const bf16*)(ws + WS_PB) + (size_t)L * M * 256, (const bf16*)(ws + WS_WP) + (size_t)L * D * 256, M, D, 256, E2, bid, nblk); }
    if constexpr (KIND == 7) { phase_rowstat_bf16((const bf16*)(ws + WS_EPRE), rstde, bid, nblk); phase_peer(p, L, lds, bid, nblk); }
    if constexpr (KIND == 9) { EpiPle E{H, (bf16*)(ws + WS_HB0), (const bf16*)(ws + WS_EPRE), rstde, p.ple_norm_g + L * D};
        gemm_run(lds, (const bf16*)(ws + WS_HB2), (const bf16*)(ws + WS_WG) + (size_t)L * D * D, M, D, D, E, bid, nblk); }
    if constexpr (KIND == 10) phase_rowstat_f32(H, rstd0, bid, nblk);
}

#define RUN(KIND) do { const Params* pp_ = (const Params*)__builtin_amdgcn_kernarg_segment_ptr(); int L_ = L; asm volatile("" : "+s"(pp_), "+s"(L_)); run_kind<KIND>(*pp_, L_, lds, bid, nblk); } while (0)
__global__ void __launch_bounds__(NTHREADS, 2) mk_fwd(Params p) {
    extern __shared__ __attribute__((aligned(16))) unsigned char lds[];
    const int bid = (int)blockIdx.x, nblk = (int)gridDim.x;
    volatile LAS unsigned* misc = (volatile LAS unsigned*)((LAS unsigned char*)lds + LDS_MISC_OFF);
    if (threadIdx.x < 64) misc[threadIdx.x] = 0u;
    __syncthreads();
    XcdBarrier bar = xcd_barrier_post((unsigned*)(((const Params*)__builtin_amdgcn_kernarg_segment_ptr())->ws + WS_CTL) + CW_BAR, misc + 8);
    { int L = 0; RUN(K_PROLOGUE); }
    cg::this_grid().sync();
#pragma nounroll
    for (int L = 0; L < DEPTH; ++L) {
        RUN(0); xcd_barrier(bar);
        RUN(1); xcd_barrier(bar);
        RUN(2); xcd_barrier(bar);
        RUN(3); xcd_barrier(bar);
        RUN(4); xcd_barrier(bar);
        RUN(5); xcd_barrier(bar);
        RUN(6); xcd_barrier(bar);
        RUN(7); xcd_barrier(bar);
        RUN(9); xcd_barrier(bar);
        RUN(10); xcd_barrier(bar);
    }
    { int L = 0; RUN(K_FINAL); }
}

extern "C" void kernel_launch(void* const* d_in, const int* in_sizes, int n_in, void* d_out, int out_size, void* d_ws, size_t ws_size, hipStream_t stream) {
    static int grid = 0;
    if (grid == 0) {
        if (n_in != 20 || out_size != M * D || ws_size < WS_END) { fprintf(stderr, "kernel_launch: unexpected shapes (n_in %d, out %d, ws %zu < %zu)\n", n_in, out_size, ws_size, (size_t)WS_END); grid = -1; return; }
        int dev = 0, cus = 0, per_cu = 0;
        (void)hipGetDevice(&dev); (void)hipDeviceGetAttribute(&cus, hipDeviceAttributeMultiprocessorCount, dev);
        if (hipFuncSetAttribute((const void*)mk_fwd, hipFuncAttributeMaxDynamicSharedMemorySize, LDS_BYTES) != hipSuccess) { fprintf(stderr, "kernel_launch: hipFuncSetAttribute failed\n"); grid = -1; return; }
        if (hipOccupancyMaxActiveBlocksPerMultiprocessor(&per_cu, (const void*)mk_fwd, NTHREADS, LDS_BYTES) != hipSuccess || per_cu < 1) { fprintf(stderr, "kernel_launch: occupancy query says %d blocks per CU\n", per_cu); (void)hipGetLastError(); grid = -1; return; }
        grid = (cus > 0 ? cus : 256);
    }
    if (grid < 0) return;
    (void)hipMemsetAsync((char*)d_ws + WS_CTL, 0, CTL_ZERO_BYTES, stream);
    Params p{};
    const float** pp = (const float**)&p;
    for (int i = 0; i < 20; ++i) pp[i] = (const float*)d_in[i];
    p.out = (float*)d_out; p.ws = (unsigned char*)d_ws;
    void* args[] = {&p};
    hipError_t e = hipLaunchCooperativeKernel((const void*)mk_fwd, dim3(grid), dim3(NTHREADS), args, LDS_BYTES, stream);
    if (e != hipSuccess) fprintf(stderr, "kernel_launch: cooperative launch failed: %s (grid %d)\n", hipGetErrorString(e), grid);
}
```

```cpp
#include <hip/hip_runtime.h>
#include <hip/hip_cooperative_groups.h>
#include <cstdio>
#include <cstdint>
namespace cg = cooperative_groups;

typedef unsigned short bf16;
typedef float f32x4 __attribute__((ext_vector_type(4)));
typedef short bf16x8 __attribute__((ext_vector_type(8)));
typedef unsigned u32x4 __attribute__((ext_vector_type(4)));
typedef unsigned u32x2 __attribute__((ext_vector_type(2)));

constexpr int D = 1024, BATCH = 8, SEQ = 2048, DEPTH = 4, M = BATCH * SEQ;
constexpr int IN_COLS = 3592, IN_PAD = 3840, PROJ_W = 3584;
constexpr int NEXP = 16384;
constexpr float EPS = 1e-6f;
constexpr float QSCALE = 0.125f * 1.4426950408889634f;
constexpr int NWAVES = 8, NTHREADS = 512;
constexpr int LDS_BYTES = 147456;

constexpr size_t MiB = 1u << 20;
constexpr size_t WS_CTL = 0, CTL_ZERO_BYTES = 1 * MiB;
constexpr size_t WS_H = 1 * MiB;
constexpr size_t WS_HB0 = 65 * MiB;
constexpr size_t WS_HB1 = 97 * MiB;
constexpr size_t WS_HB2 = 129 * MiB;
constexpr size_t WS_PROJ = 161 * MiB;
constexpr size_t WS_BA = 273 * MiB;
constexpr size_t WS_OBUF = 274 * MiB;
constexpr size_t WS_Q2 = 306 * MiB;
constexpr size_t WS_EPRE = 370 * MiB;
constexpr size_t WS_IDX = 402 * MiB;
constexpr size_t WS_GATE = 410 * MiB;
constexpr size_t WS_STAT = 418 * MiB;
constexpr size_t WS_ORAW = 422 * MiB;
constexpr size_t WS_WIN = 550 * MiB;
constexpr size_t WS_WOUT = 582 * MiB;
constexpr size_t WS_WQ = 590 * MiB;
constexpr size_t WS_WG = 606 * MiB;
constexpr size_t WS_WP = 614 * MiB;
constexpr size_t WS_SK = 616 * MiB;
constexpr size_t WS_PB = 618 * MiB;
constexpr size_t WS_U = 650 * MiB;
constexpr size_t WS_V = 778 * MiB;
constexpr size_t WS_END = 906 * MiB;

struct Params {
    const float *x, *p, *ln_mix_g, *w_in, *conv_w, *a_log, *dt_bias, *gdn_norm_g, *diff_lambda, *subln_g, *w_out, *ln_ffn_g,
        *peer_wq, *subkeys, *peer_u, *peer_v, *ple_wp, *ple_wg, *ple_norm_g, *final_g;
    float* out;
    unsigned char* ws;
    int pad0, pad1;
};

__device__ __forceinline__ int tidx() { int t = (int)threadIdx.x; asm volatile("" : "+v"(t)); return t; }
#define LDS_BARRIER() asm volatile("s_waitcnt lgkmcnt(0)\n\ts_barrier" ::: "memory")
__device__ __forceinline__ float bf2f(bf16 v) { return __uint_as_float((unsigned)v << 16); }
__device__ __forceinline__ unsigned f2bf(float f) { unsigned u = __float_as_uint(f); return (u + 0x7fffu + ((u >> 16) & 1u)) >> 16; }
__device__ __forceinline__ unsigned pk2(float lo, float hi) { return f2bf(lo) | (f2bf(hi) << 16); }
__device__ __forceinline__ float lo16(unsigned w) { return __uint_as_float(w << 16); }
__device__ __forceinline__ float hi16(unsigned w) { return __uint_as_float(w & 0xffff0000u); }
template <int N> __device__ __forceinline__ float dpp_ror(float x) { return __builtin_bit_cast(float, __builtin_amdgcn_mov_dpp(__builtin_bit_cast(int, x), 0x120 + N, 0xf, 0xf, true)); }
template <int N> __device__ __forceinline__ unsigned dpp_ror_u(unsigned x) { return (unsigned)__builtin_amdgcn_mov_dpp((int)x, 0x120 + N, 0xf, 0xf, true); }
__device__ __forceinline__ float row16_sum(float x) { x += dpp_ror<8>(x); x += dpp_ror<4>(x); x += dpp_ror<2>(x); x += dpp_ror<1>(x); return x; }
__device__ __forceinline__ float row16_max(float x) { x = fmaxf(x, dpp_ror<8>(x)); x = fmaxf(x, dpp_ror<4>(x)); x = fmaxf(x, dpp_ror<2>(x)); x = fmaxf(x, dpp_ror<1>(x)); return x; }
__device__ __forceinline__ unsigned row16_umax(unsigned x) { unsigned y;
    y = dpp_ror_u<8>(x); x = x > y ? x : y; y = dpp_ror_u<4>(x); x = x > y ? x : y; y = dpp_ror_u<2>(x); x = x > y ? x : y; y = dpp_ror_u<1>(x); x = x > y ? x : y; return x; }
__device__ __forceinline__ float xrow16_max(float x) {
    auto s = __builtin_amdgcn_permlane16_swap(__float_as_uint(x), __float_as_uint(x), false, false);
    x = fmaxf(__uint_as_float(s[0]), __uint_as_float(s[1]));
    auto t = __builtin_amdgcn_permlane32_swap(__float_as_uint(x), __float_as_uint(x), false, false);
    return fmaxf(__uint_as_float(t[0]), __uint_as_float(t[1]));
}
__device__ __forceinline__ float xrow16_sum(float x) {
    auto s = __builtin_amdgcn_permlane16_swap(__float_as_uint(x), __float_as_uint(x), false, false);
    x = __uint_as_float(s[0]) + __uint_as_float(s[1]);
    auto t = __builtin_amdgcn_permlane32_swap(__float_as_uint(x), __float_as_uint(x), false, false);
    return __uint_as_float(t[0]) + __uint_as_float(t[1]);
}
__device__ __forceinline__ float wave_sum(float v) { return xrow16_sum(row16_sum(v)); }
__device__ __forceinline__ float wave_max(float v) {
#pragma unroll
    for (int o = 32; o; o >>= 1) v = fmaxf(v, __shfl_xor(v, o));
    return v;
}
__device__ __forceinline__ float sigmoidf_(float x) { return 1.f / (1.f + __expf(-x)); }
__device__ __forceinline__ float dot8(u32x4 a, u32x4 b, float s) {
#pragma unroll
    for (int i = 0; i < 4; ++i) { s += lo16(a[i]) * lo16(b[i]); s += hi16(a[i]) * hi16(b[i]); }
    return s;
}

#define LAS __attribute__((address_space(3)))
__host__ __device__ __forceinline__ int lds_byte(int r, int c) { const int st = (r >> 4) * 2 + (c >> 5), rr = r & 15, cc = c & 31, ob = rr * 64 + cc * 2; return st * 1024 + (ob ^ (((ob >> 9) & 1) << 5)); }
__host__ __device__ __forceinline__ void stage_rc(int b, int& R, int& C) { const int st = b / 1024, sb = b % 1024, swz = sb ^ (((sb >> 9) & 1) << 5); R = (st >> 1) * 16 + swz / 64; C = (st & 1) * 32 + (swz % 64) / 2; }
constexpr int HTB = 16384;
template <class F>
__device__ __forceinline__ void gemm_run(unsigned char* lds_, const bf16* A, const bf16* Bt, int Mm, int N, int K, const F& f, int bid, int nblk) {
    LAS unsigned char* lds = (LAS unsigned char*)lds_;
    const int tid = tidx(), wid = __builtin_amdgcn_readfirstlane(tid >> 6), lane = tid & 63, wr = wid >> 1, wc = wid & 1, fr = lane & 15, fq = lane >> 4;
    const int nt = K / 64, ntn = N / 128, nunits = (Mm / 256) * ntn;
    unsigned voff[2];
#pragma unroll
    for (int i = 0; i < 2; ++i) { int R, C; stage_rc(tid * 16 + i * 8192, R, C); voff[i] = (unsigned)(R * K + C) * 2u; }
    const unsigned ldsw = (unsigned)wid * 1024u;
    const int aoff = (wr >> 1) * HTB + lds_byte((wr & 1) * 64 + fr, fq * 8), boff = 2 * HTB + lds_byte(wc * 64 + fr, fq * 8);
#define G_STAGE(bufoff, gbase) do { _Pragma("unroll") for (int _i = 0; _i < 2; ++_i) \
        __builtin_amdgcn_global_load_lds((const unsigned*)((const char*)(gbase) + voff[_i]), (LAS unsigned*)(lds + (bufoff) + ldsw + _i * 8192), 16, 0, 0); } while (0)
    for (int u = bid; u < nunits; u += nblk) {
        const int pm = u % (Mm / 256), pn = u / (Mm / 256);
        const char* gA = (const char*)(A + (size_t)pm * 256 * K);
        const char* gB = (const char*)(Bt + (size_t)pn * 128 * K);
        const size_t hstep = (size_t)128 * K * 2;
        f32x4 acc[4][4];
#pragma unroll
        for (int a = 0; a < 4; ++a)
#pragma unroll
            for (int b = 0; b < 4; ++b) acc[a][b] = (f32x4){0.f, 0.f, 0.f, 0.f};
        G_STAGE(0, gA); G_STAGE(HTB, gA + hstep); G_STAGE(2 * HTB, gB);
        for (int t = 0; t < nt; ++t) {
            const int cur = (t & 1) * 3 * HTB, nxt = ((t + 1) & 1) * 3 * HTB;
            asm volatile("s_waitcnt vmcnt(0)" ::: "memory");
            __syncthreads();
            if (t + 1 < nt) { const size_t ko = (size_t)(t + 1) * 128; G_STAGE(nxt, gA + ko); G_STAGE(nxt + HTB, gA + hstep + ko); G_STAGE(nxt + 2 * HTB, gB + ko); }
            bf16x8 af[4][2], bfr[4][2];
#pragma unroll
            for (int m = 0; m < 4; ++m)
#pragma unroll
                for (int k = 0; k < 2; ++k) af[m][k] = *(const LAS bf16x8*)(lds + cur + aoff + m * 2048 + k * 1024);
#pragma unroll
            for (int n = 0; n < 4; ++n)
#pragma unroll
                for (int k = 0; k < 2; ++k) bfr[n][k] = *(const LAS bf16x8*)(lds + cur + boff + n * 2048 + k * 1024);
#pragma unroll
            for (int k = 0; k < 2; ++k)
#pragma unroll
                for (int m = 0; m < 4; ++m)
#pragma unroll
                    for (int n = 0; n < 4; ++n) acc[m][n] = __builtin_amdgcn_mfma_f32_16x16x32_bf16(bfr[n][k], af[m][k], acc[m][n], 0, 0, 0);
        }
#pragma unroll
        for (int m = 0; m < 4; ++m) {
            const int row = pm * 256 + wr * 64 + m * 16 + fr;
#pragma unroll
            for (int n = 0; n < 4; ++n) f(row, pn * 128 + wc * 64 + n * 16 + 4 * fq, acc[m][n]);
        }
        __syncthreads();
    }
#undef G_STAGE
}

__device__ __forceinline__ u32x2 pk4(f32x4 a) { u32x2 o; o.x = pk2(a[0], a[1]); o.y = pk2(a[2], a[3]); return o; }
struct EpiProj {
    bf16* proj; float* ba; const float* rstd;
    __device__ __forceinline__ void operator()(int row, int col, f32x4 v) const {
        v = v * rstd[row];
        if (col < PROJ_W) *(u32x2*)(proj + (size_t)row * PROJ_W + col) = pk4(v);
        else if (col < IN_COLS) *(f32x4*)(ba + (size_t)row * 8 + (col - PROJ_W)) = v;
    }
};
struct EpiRes {
    float* H; bf16* HB;
    __device__ __forceinline__ void operator()(int row, int col, f32x4 v) const {
        f32x4* hp = (f32x4*)(H + (size_t)row * D + col);
        const f32x4 h = *hp + v; *hp = h;
        *(u32x2*)(HB + (size_t)row * D + col) = pk4(h);
    }
};
struct EpiQ2 {
    bf16* Q2; const float* rstd;
    __device__ __forceinline__ void operator()(int row, int col, f32x4 v) const { *(u32x2*)(Q2 + (size_t)row * 2048 + col) = pk4(v * rstd[row]); }
};
struct EpiE {
    bf16* E;
    __device__ __forceinline__ void operator()(int row, int col, f32x4 v) const { *(u32x2*)(E + (size_t)row * D + col) = pk4(v); }
};
struct EpiPle {
    float* H; bf16* HB; const bf16* E; const float* rstde; const float* g;
    __device__ __forceinline__ void operator()(int row, int col, f32x4 v) const {
        f32x4* hp = (f32x4*)(H + (size_t)row * D + col);
        const u32x2 ev = *(const u32x2*)(E + (size_t)row * D + col);
        const f32x4 gv = *(const f32x4*)(g + col);
        const float r = rstde[row];
        f32x4 h = *hp;
        h[0] += sigmoidf_(v[0]) * (lo16(ev.x) * r * gv[0]); h[1] += sigmoidf_(v[1]) * (hi16(ev.x) * r * gv[1]);
        h[2] += sigmoidf_(v[2]) * (lo16(ev.y) * r * gv[2]); h[3] += sigmoidf_(v[3]) * (hi16(ev.y) * r * gv[3]);
        *hp = h;
        *(u32x2*)(HB + (size_t)row * D + col) = pk4(h);
    }
};

__device__ __forceinline__ void transpose_item(const float* W, int K, int N, int Npad, bf16* WT, const float* rowscale, int qcols, float* scr, int item, int lane) {
    const int nblk = Npad / 32, kb = item / nblk, nb = item % nblk, k0 = 64 * kb, n0 = 32 * nb;
    const int n = n0 + (lane & 31);
#pragma unroll 8
    for (int i = 0; i < 32; ++i) {
        const int kk = 2 * i + (lane >> 5);
        float v = (n < N) ? W[(size_t)(k0 + kk) * N + n] : 0.f;
        if (rowscale) v *= rowscale[k0 + kk];
        if (n < qcols) v *= QSCALE;
        scr[kk * 33 + (lane & 31)] = v;
    }
    asm volatile("s_waitcnt lgkmcnt(0)" ::: "memory");
    const int c = lane & 7;
#pragma unroll
    for (int j = 0; j < 4; ++j) {
        const int nn = (lane >> 3) + 8 * j; const float* s = scr + (8 * c) * 33 + nn;
        u32x4 o; o.x = pk2(s[0 * 33], s[1 * 33]); o.y = pk2(s[2 * 33], s[3 * 33]); o.z = pk2(s[4 * 33], s[5 * 33]); o.w = pk2(s[6 * 33], s[7 * 33]);
        *(u32x4*)(WT + (size_t)(n0 + nn) * K + k0 + 8 * c) = o;
    }
    asm volatile("s_waitcnt lgkmcnt(0)" ::: "memory");
}
__device__ __forceinline__ void convert_bulk(const float* src, bf16* dst, size_t n, size_t gtid, size_t nthr) {
    for (size_t i = gtid * 8; i < n; i += nthr * 8) {
        const f32x4 a = *(const f32x4*)(src + i), b = *(const f32x4*)(src + i + 4);
        u32x4 o; o.x = pk2(a[0], a[1]); o.y = pk2(a[2], a[3]); o.z = pk2(b[0], b[1]); o.w = pk2(b[2], b[3]);
        *(u32x4*)(dst + i) = o;
    }
}
__device__ void phase_prologue(const Params& p, unsigned char* lds, int bid, int nblk) {
    const int tid = tidx(), lane = tid & 63, w = tid >> 6;
    const int gw = bid * NWAVES + w, NGW = nblk * NWAVES;
    float* scr = (float*)(lds + w * 16384);
    constexpr int I_IN = 16 * (IN_PAD / 32), I_OUT = 16 * 32, I_Q = 16 * 64, I_G = 16 * 32, I_P = 4 * 32, I_L = I_IN + I_OUT + I_Q + I_G + I_P;
    for (int it = gw; it < DEPTH * I_L; it += NGW) {
        const int L = it / I_L; int r = it % I_L;
        if (r < I_IN) { transpose_item(p.w_in + (size_t)L * D * IN_COLS, D, IN_COLS, IN_PAD, (bf16*)(p.ws + WS_WIN) + (size_t)L * IN_PAD * D, p.ln_mix_g + L * D, 512, scr, r, lane); continue; } r -= I_IN;
        if (r < I_OUT) { transpose_item(p.w_out + (size_t)L * D * D, D, D, D, (bf16*)(p.ws + WS_WOUT) + (size_t)L * D * D, nullptr, 0, scr, r, lane); continue; } r -= I_OUT;
        if (r < I_Q) { transpose_item(p.peer_wq + (size_t)L * D * 2048, D, 2048, 2048, (bf16*)(p.ws + WS_WQ) + (size_t)L * 2048 * D, p.ln_ffn_g + L * D, 0, scr, r, lane); continue; } r -= I_Q;
        if (r < I_G) { transpose_item(p.ple_wg + (size_t)L * D * D, D, D, D, (bf16*)(p.ws + WS_WG) + (size_t)L * D * D, nullptr, 0, scr, r, lane); continue; } r -= I_G;
        transpose_item(p.ple_wp + (size_t)L * 256 * D, 256, D, D, (bf16*)(p.ws + WS_WP) + (size_t)L * D * 256, nullptr, 0, scr, r, lane);
    }
    const size_t gtid = (size_t)bid * NTHREADS + tid, nthr = (size_t)nblk * NTHREADS;
    convert_bulk(p.peer_u, (bf16*)(p.ws + WS_U), (size_t)DEPTH * NEXP * D, gtid, nthr);
    convert_bulk(p.peer_v, (bf16*)(p.ws + WS_V), (size_t)DEPTH * NEXP * D, gtid, nthr);
    convert_bulk(p.p, (bf16*)(p.ws + WS_PB), (size_t)DEPTH * M * 256, gtid, nthr);
    convert_bulk(p.subkeys, (bf16*)(p.ws + WS_SK), (size_t)DEPTH * 8 * 2 * 128 * 128, gtid, nthr);
    float* H = (float*)(p.ws + WS_H); bf16* HB0 = (bf16*)(p.ws + WS_HB0); float* rstd0 = (float*)(p.ws + WS_STAT);
    for (int m = gw; m < M; m += NGW) {
        const f32x4* xr = (const f32x4*)(p.x + (size_t)m * D) + lane;
        float ss = 0.f;
#pragma unroll
        for (int j = 0; j < 4; ++j) {
            const f32x4 v = xr[64 * j];
            ss += v[0] * v[0] + v[1] * v[1] + v[2] * v[2] + v[3] * v[3];
            ((f32x4*)(H + (size_t)m * D))[lane + 64 * j] = v;
            u32x2 o; o.x = pk2(v[0], v[1]); o.y = pk2(v[2], v[3]);
            ((u32x2*)(HB0 + (size_t)m * D))[lane + 64 * j] = o;
        }
        ss = wave_sum(ss);
        if (lane == 0) rstd0[m] = rsqrtf(ss * (1.f / D) + EPS);
    }
}

__device__ void phase_rowstat_f32(const float* src, float* rstd, int bid, int nblk) {
    const int tid = tidx(), lane = tid & 63, gw = bid * NWAVES + (tid >> 6), NGW = nblk * NWAVES;
    for (int m = gw; m < M; m += NGW) {
        const f32x4* xr = (const f32x4*)(src + (size_t)m * D) + lane;
        float ss = 0.f;
#pragma unroll
        for (int j = 0; j < 4; ++j) { const f32x4 v = xr[64 * j]; ss += v[0] * v[0] + v[1] * v[1] + v[2] * v[2] + v[3] * v[3]; }
        ss = wave_sum(ss);
        if (lane == 0) rstd[m] = rsqrtf(ss * (1.f / D) + EPS);
    }
}
__device__ void phase_rowstat_bf16(const bf16* src, float* rstd, int bid, int nblk) {
    const int tid = tidx(), lane = tid & 63, gw = bid * NWAVES + (tid >> 6), NGW = nblk * NWAVES;
    for (int m = gw; m < M; m += NGW) {
        const u32x4* xr = (const u32x4*)(src + (size_t)m * D) + lane;
        float ss = 0.f;
#pragma unroll
        for (int j = 0; j < 2; ++j) { const u32x4 v = xr[64 * j];
#pragma unroll
            for (int i = 0; i < 4; ++i) { const float a = lo16(v[i]), b = hi16(v[i]); ss += a * a + b * b; } }
        ss = wave_sum(ss);
        if (lane == 0) rstd[m] = rsqrtf(ss * (1.f / D) + EPS);
    }
}

typedef short v4i16_t __attribute__((ext_vector_type(4)));
typedef __bf16 bf16x2_t __attribute__((ext_vector_type(2)));
typedef float f32x2_t __attribute__((ext_vector_type(2)));
__device__ __forceinline__ unsigned cvtpk(float lo, float hi) { f32x2_t v = {lo, hi}; bf16x2_t b = __builtin_convertvector(v, bf16x2_t); return __builtin_bit_cast(unsigned, b); }
constexpr int ATT_VOFF = 16384, ATT_VPITCH = 288;
__device__ void phase_att_mfma(const Params& p, int L, unsigned char* lds_, int bid, int nblk) {
    LAS unsigned char* lds = (LAS unsigned char*)lds_;
    const int tid = tidx(), lane = tid & 63, w = __builtin_amdgcn_readfirstlane(tid >> 6), fr = lane & 15, fq = lane >> 4;
    const bf16* proj = (const bf16*)(p.ws + WS_PROJ);
    bf16* obuf = (bf16*)(p.ws + WS_OBUF);
    const float* lp = p.diff_lambda + L * 256;
    const float d1 = wave_sum(lp[lane] * lp[64 + lane]), d2 = wave_sum(lp[128 + lane] * lp[192 + lane]);
    const float lam_init = 0.8f - 0.6f * expf(-0.3f * (float)L);
    const float lam = expf(d1) - expf(d2) + lam_init;
    for (int item = bid; item < 256; item += nblk) {
        const int bh = item >> 3, jj = item & 7, b = bh >> 2, hh = bh & 3;
        const float slope2 = exp2f(-2.f * (float)(hh + 1)) * 1.4426950408889634f;
        const bf16* kbase = proj + (size_t)b * SEQ * PROJ_W + 512 + hh * 128;
        const bf16* vbase = proj + (size_t)b * SEQ * PROJ_W + 1024 + hh * 128;
        for (int half = 0; half < 2; ++half) {
            const int qb = half == 0 ? 15 - jj : jj;
            const int qw0 = qb * 128 + w * 16, T = 2 * (qb + 1);
            bf16x8 qf[2][2];
#pragma unroll
            for (int mp = 0; mp < 2; ++mp)
#pragma unroll
                for (int ks = 0; ks < 2; ++ks) qf[mp][ks] = *(const bf16x8*)(proj + ((size_t)b * SEQ + qw0 + fr) * PROJ_W + hh * 128 + mp * 64 + ks * 32 + 8 * fq);
            f32x4 o[2][8];
#pragma unroll
            for (int mp = 0; mp < 2; ++mp)
#pragma unroll
                for (int dt = 0; dt < 8; ++dt) o[mp][dt] = (f32x4){0.f, 0.f, 0.f, 0.f};
            float mrun[2] = {-INFINITY, -INFINITY}, lrun[2] = {0.f, 0.f};
            u32x4 kreg[2], vreg[2];
#pragma unroll
            for (int i = 0; i < 2; ++i) { const int c = tid + 512 * i, key = c >> 4, ch = c & 15;
                kreg[i] = *(const u32x4*)(kbase + (size_t)key * PROJ_W + ch * 8); vreg[i] = *(const u32x4*)(vbase + (size_t)key * PROJ_W + ch * 8); }
            for (int t = 0; t < T; ++t) {
                const int k0 = t * 64;
#pragma unroll
                for (int i = 0; i < 2; ++i) { const int c = tid + 512 * i, key = c >> 4, ch = c & 15;
                    *(LAS u32x4*)(lds + key * 256 + ((ch ^ (key & 15)) << 4)) = kreg[i];
                    *(LAS u32x4*)(lds + ATT_VOFF + key * ATT_VPITCH + ch * 16) = vreg[i]; }
                LDS_BARRIER();
                if (t + 1 < T) {
#pragma unroll
                    for (int i = 0; i < 2; ++i) { const int c = tid + 512 * i, key = k0 + 64 + (c >> 4), ch = c & 15;
                        kreg[i] = *(const u32x4*)(kbase + (size_t)key * PROJ_W + ch * 8); vreg[i] = *(const u32x4*)(vbase + (size_t)key * PROJ_W + ch * 8); }
                }
                if (k0 <= qw0 + 15) {
                    f32x4 s[2][4];
                    const float base = -slope2 * (float)(qw0 + fr - k0 - 4 * fq);
#pragma unroll
                    for (int kt = 0; kt < 4; ++kt)
#pragma unroll
                        for (int r = 0; r < 4; ++r) { const float v = base + slope2 * (float)(16 * kt + r); s[0][kt][r] = v; s[1][kt][r] = v; }
#pragma unroll
                    for (int mp = 0; mp < 2; ++mp)
#pragma unroll
                        for (int kt = 0; kt < 4; ++kt)
#pragma unroll
                            for (int ks = 0; ks < 2; ++ks) {
                                const bf16x8 kf = *(const LAS bf16x8*)(lds + (16 * kt + fr) * 256 + (((mp * 8 + ks * 4 + fq) ^ fr) << 4));
                                s[mp][kt] = __builtin_amdgcn_mfma_f32_16x16x32_bf16(kf, qf[mp][ks], s[mp][kt], 0, 0, 0);
                            }
                    if (k0 + 63 > qw0) {
                        const int lim = qw0 + fr - k0 - 4 * fq;
#pragma unroll
                        for (int mp = 0; mp < 2; ++mp)
#pragma unroll
                            for (int kt = 0; kt < 4; ++kt)
#pragma unroll
                                for (int r = 0; r < 4; ++r) if (16 * kt + r > lim) s[mp][kt][r] = -INFINITY;
                    }
                    bf16x8 pb[2][2];
#pragma unroll
                    for (int mp = 0; mp < 2; ++mp) {
                        float mx = fmaxf(fmaxf(s[mp][0][0], s[mp][0][1]), fmaxf(s[mp][0][2], s[mp][0][3]));
#pragma unroll
                        for (int kt = 1; kt < 4; ++kt) mx = fmaxf(mx, fmaxf(fmaxf(s[mp][kt][0], s[mp][kt][1]), fmaxf(s[mp][kt][2], s[mp][kt][3])));
                        mx = xrow16_max(mx);
                        const float mnew = fmaxf(mrun[mp], mx);
                        const float alpha = __builtin_amdgcn_exp2f(mrun[mp] - mnew);
                        mrun[mp] = mnew;
                        float ps = 0.f;
#pragma unroll
                        for (int kt = 0; kt < 4; ++kt)
#pragma unroll
                            for (int r = 0; r < 4; ++r) { const float e = __builtin_amdgcn_exp2f(s[mp][kt][r] - mnew); s[mp][kt][r] = e; ps += e; }
                        lrun[mp] = lrun[mp] * alpha + ps;
#pragma unroll
                        for (int dt = 0; dt < 8; ++dt) o[mp][dt] = o[mp][dt] * alpha;
#pragma unroll
                        for (int ks = 0; ks < 2; ++ks) {
                            u32x4 pk; pk.x = cvtpk(s[mp][2 * ks][0], s[mp][2 * ks][1]); pk.y = cvtpk(s[mp][2 * ks][2], s[mp][2 * ks][3]);
                            pk.z = cvtpk(s[mp][2 * ks + 1][0], s[mp][2 * ks + 1][1]); pk.w = cvtpk(s[mp][2 * ks + 1][2], s[mp][2 * ks + 1][3]);
                            pb[mp][ks] = __builtin_bit_cast(bf16x8, pk);
                        }
                    }
                    const int gl = lane & 15;
                    LAS unsigned char* vrd = lds + ATT_VOFF + (4 * fq + (gl >> 2)) * ATT_VPITCH + (gl & 3) * 8;
#pragma unroll
                    for (int dt = 0; dt < 8; ++dt)
#pragma unroll
                        for (int ks = 0; ks < 2; ++ks) {
                            const v4i16_t v0 = __builtin_amdgcn_ds_read_tr16_b64_v4i16((LAS v4i16_t*)(vrd + (32 * ks) * ATT_VPITCH + dt * 32));
                            const v4i16_t v1 = __builtin_amdgcn_ds_read_tr16_b64_v4i16((LAS v4i16_t*)(vrd + (32 * ks + 16) * ATT_VPITCH + dt * 32));
                            bf16x8 vf; vf[0] = v0[0]; vf[1] = v0[1]; vf[2] = v0[2]; vf[3] = v0[3]; vf[4] = v1[0]; vf[5] = v1[1]; vf[6] = v1[2]; vf[7] = v1[3];
                            o[0][dt] = __builtin_amdgcn_mfma_f32_16x16x32_bf16(vf, pb[0][ks], o[0][dt], 0, 0, 0);
                            o[1][dt] = __builtin_amdgcn_mfma_f32_16x16x32_bf16(vf, pb[1][ks], o[1][dt], 0, 0, 0);
                        }
                }
                LDS_BARRIER();
            }
            const float i1 = 1.f / xrow16_sum(lrun[0]), i2 = lam / xrow16_sum(lrun[1]);
            float ss = 0.f;
#pragma unroll
            for (int dt = 0; dt < 8; ++dt)
#pragma unroll
                for (int r = 0; r < 4; ++r) { const float v = o[0][dt][r] * i1 - o[1][dt][r] * i2; o[0][dt][r] = v; ss += v * v; }
            ss = xrow16_sum(ss);
            const float rn = rsqrtf(ss * (1.f / 128.f) + EPS) * (1.f - lam_init);
            const float* g = p.subln_g + L * 128;
            bf16* orow = obuf + ((size_t)b * SEQ + qw0 + fr) * D + hh * 128;
#pragma unroll
            for (int dt = 0; dt < 8; ++dt) {
                const f32x4 gv = *(const f32x4*)(g + 16 * dt + 4 * fq);
                u32x2 ov; ov.x = pk2(o[0][dt][0] * rn * gv[0], o[0][dt][1] * rn * gv[1]); ov.y = pk2(o[0][dt][2] * rn * gv[2], o[0][dt][3] * rn * gv[3]);
                *(u32x2*)(orow + 16 * dt + 4 * fq) = ov;
            }
        }
    }
}

constexpr size_t GD_WP = WS_ORAW, GD_QD = WS_ORAW + 16 * MiB, GD_AIP = WS_ORAW + 32 * MiB, GD_KDT = WS_ORAW + 40 * MiB, GD_UT = WS_ORAW + 56 * MiB, GD_GL = WS_ORAW + 72 * MiB;
__device__ __forceinline__ int perm_pos(int k) { return (k & ~31) + 8 * ((k >> 2) & 3) + 4 * ((k >> 4) & 1) + (k & 3); }
__device__ __forceinline__ float softplusf_(float x) { return x > 20.f ? x : log1pf(expf(x)); }

constexpr int GP_KN = 0, GP_QN = 17408, GP_RT = 34816, GP_LM = 71680, GP_TB = 89088, GP_GT = 98304;
constexpr int GP_KP = 272, GP_RP = 144, GP_LP = 68, GP_TP = 144;
__device__ void phase_gdn_prep(const Params& p, int L, unsigned char* lds_, int bid, int nblk) {
    LAS unsigned char* lds = (LAS unsigned char*)lds_;
    const int tid = tidx(), lane = tid & 63, w = __builtin_amdgcn_readfirstlane(tid >> 6), fr = lane & 15, fq = lane >> 4;
    const bf16* proj = (const bf16*)(p.ws + WS_PROJ);
    const float* BA = (const float*)(p.ws + WS_BA);
    bf16* WP = (bf16*)(p.ws + GD_WP); bf16* QD = (bf16*)(p.ws + GD_QD); bf16* AIP = (bf16*)(p.ws + GD_AIP); bf16* KDT = (bf16*)(p.ws + GD_KDT); bf16* UT = (bf16*)(p.ws + GD_UT);
    float* GL = (float*)(p.ws + GD_GL);
    const float* cw = p.conv_w + (size_t)L * 4 * 1536;
    LAS float* beta_s = (LAS float*)(lds + GP_GT); LAS float* gc_s = beta_s + 64; LAS float* egc_s = gc_s + 64; LAS float* edl_s = egc_s + 64;
    LAS float* Lm = (LAS float*)(lds + GP_LM);
    for (int item = bid; item < 1024; item += nblk) {
        const int n = item & 31, bh = item >> 5, hh = bh & 3, b = bh >> 2, t0 = n * 64;
        const size_t row0 = (size_t)b * SEQ + t0;
        __syncthreads();
        if (w == 0) {
            const float negA = -expf(p.a_log[L * 4 + hh]), dtb = p.dt_bias[L * 4 + hh];
            const float bb = BA[(row0 + lane) * 8 + hh], aa = BA[(row0 + lane) * 8 + 4 + hh] + dtb;
            float c = negA * softplusf_(aa);
#pragma unroll
            for (int o = 1; o < 64; o <<= 1) { const float t = __shfl_up(c, o); if (lane >= o) c += t; }
            const float glast = __shfl(c, 63);
            beta_s[lane] = sigmoidf_(bb); gc_s[lane] = c; egc_s[lane] = expf(c); edl_s[lane] = expf(glast - c);
            if (lane == 0) GL[item] = expf(glast);
        }
        __syncthreads();
        {
            const int colq = hh * 128 + 2 * lane;
            {
                float wq[4][2]; unsigned xq[11];
#pragma unroll
                for (int j = 0; j < 4; ++j) { wq[j][0] = cw[j * 1536 + colq]; wq[j][1] = cw[j * 1536 + colq + 1]; }
#pragma unroll
                for (int r = 0; r < 11; ++r) { const int tt = t0 + 8 * w - 3 + r; xq[r] = (tt >= 0) ? *(const unsigned*)(proj + ((size_t)b * SEQ + tt) * PROJ_W + 1536 + colq) : 0u; }
#pragma unroll
                for (int i = 0; i < 8; ++i) {
                    const int c = 8 * w + i;
                    float q0 = 0.f, q1 = 0.f;
#pragma unroll
                    for (int j = 0; j < 4; ++j) { q0 += wq[j][0] * lo16(xq[i + j]); q1 += wq[j][1] * hi16(xq[i + j]); }
                    q0 *= sigmoidf_(q0); q1 *= sigmoidf_(q1);
                    const float sq = rsqrtf(wave_sum(q0 * q0 + q1 * q1) + EPS) * 0.08838834764831845f;
                    q0 *= sq; q1 *= sq;
                    const float eg = egc_s[c];
                    *(LAS unsigned*)(lds + GP_QN + c * GP_KP + lane * 4) = pk2(q0, q1);
                    *(unsigned*)(QD + ((size_t)item * 64 + c) * 128 + perm_pos(2 * lane)) = pk2(q0 * eg, q1 * eg);
                }
            }
            __builtin_amdgcn_sched_barrier(0);
            {
                float wk[4][2]; unsigned xk[11];
#pragma unroll
                for (int j = 0; j < 4; ++j) { wk[j][0] = cw[j * 1536 + 512 + colq]; wk[j][1] = cw[j * 1536 + 512 + colq + 1]; }
#pragma unroll
                for (int r = 0; r < 11; ++r) { const int tt = t0 + 8 * w - 3 + r; xk[r] = (tt >= 0) ? *(const unsigned*)(proj + ((size_t)b * SEQ + tt) * PROJ_W + 1536 + 512 + colq) : 0u; }
                unsigned kd0[8], kd1[8], rk0[8], rk1[8];
#pragma unroll
                for (int i = 0; i < 8; ++i) {
                    const int c = 8 * w + i;
                    float k0 = 0.f, k1 = 0.f;
#pragma unroll
                    for (int j = 0; j < 4; ++j) { k0 += wk[j][0] * lo16(xk[i + j]); k1 += wk[j][1] * hi16(xk[i + j]); }
                    k0 *= sigmoidf_(k0); k1 *= sigmoidf_(k1);
                    const float sk = rsqrtf(wave_sum(k0 * k0 + k1 * k1) + EPS);
                    k0 *= sk; k1 *= sk;
                    const float be = beta_s[c], eg = egc_s[c], ed = edl_s[c];
                    *(LAS unsigned*)(lds + GP_KN + c * GP_KP + lane * 4) = pk2(k0, k1);
                    kd0[i] = f2bf(k0 * ed); kd1[i] = f2bf(k1 * ed);
                    rk0[i] = f2bf(k0 * be * eg); rk1[i] = f2bf(k1 * be * eg);
                }
                u32x4 o;
                o.x = rk0[0] | (rk0[1] << 16); o.y = rk0[2] | (rk0[3] << 16); o.z = rk0[4] | (rk0[5] << 16); o.w = rk0[6] | (rk0[7] << 16); *(LAS u32x4*)(lds + GP_RT + (128 + 2 * lane) * GP_RP + 16 * w) = o;
                o.x = rk1[0] | (rk1[1] << 16); o.y = rk1[2] | (rk1[3] << 16); o.z = rk1[4] | (rk1[5] << 16); o.w = rk1[6] | (rk1[7] << 16); *(LAS u32x4*)(lds + GP_RT + (128 + 2 * lane + 1) * GP_RP + 16 * w) = o;
                const int pa = perm_pos(8 * w), pb = perm_pos(8 * w + 4);
                bf16* kr0 = KDT + ((size_t)item * 128 + 2 * lane) * 64; bf16* kr1 = kr0 + 64;
                u32x2 h2;
                h2.x = kd0[0] | (kd0[1] << 16); h2.y = kd0[2] | (kd0[3] << 16); *(u32x2*)(kr0 + pa) = h2;
                h2.x = kd0[4] | (kd0[5] << 16); h2.y = kd0[6] | (kd0[7] << 16); *(u32x2*)(kr0 + pb) = h2;
                h2.x = kd1[0] | (kd1[1] << 16); h2.y = kd1[2] | (kd1[3] << 16); *(u32x2*)(kr1 + pa) = h2;
                h2.x = kd1[4] | (kd1[5] << 16); h2.y = kd1[6] | (kd1[7] << 16); *(u32x2*)(kr1 + pb) = h2;
            }
            __builtin_amdgcn_sched_barrier(0);
            {
                float wv[4][2]; unsigned xv[11];
#pragma unroll
                for (int j = 0; j < 4; ++j) { wv[j][0] = cw[j * 1536 + 1024 + colq]; wv[j][1] = cw[j * 1536 + 1024 + colq + 1]; }
#pragma unroll
                for (int r = 0; r < 11; ++r) { const int tt = t0 + 8 * w - 3 + r; xv[r] = (tt >= 0) ? *(const unsigned*)(proj + ((size_t)b * SEQ + tt) * PROJ_W + 1536 + 1024 + colq) : 0u; }
                unsigned rv0[8], rv1[8];
#pragma unroll
                for (int i = 0; i < 8; ++i) {
                    float v0 = 0.f, v1 = 0.f;
#pragma unroll
                    for (int j = 0; j < 4; ++j) { v0 += wv[j][0] * lo16(xv[i + j]); v1 += wv[j][1] * hi16(xv[i + j]); }
                    v0 *= sigmoidf_(v0); v1 *= sigmoidf_(v1);
                    const float be = beta_s[8 * w + i];
                    rv0[i] = f2bf(v0 * be); rv1[i] = f2bf(v1 * be);
                }
                u32x4 o;
                o.x = rv0[0] | (rv0[1] << 16); o.y = rv0[2] | (rv0[3] << 16); o.z = rv0[4] | (rv0[5] << 16); o.w = rv0[6] | (rv0[7] << 16); *(LAS u32x4*)(lds + GP_RT + (2 * lane) * GP_RP + 16 * w) = o;
                o.x = rv1[0] | (rv1[1] << 16); o.y = rv1[2] | (rv1[3] << 16); o.z = rv1[4] | (rv1[5] << 16); o.w = rv1[6] | (rv1[7] << 16); *(LAS u32x4*)(lds + GP_RT + (2 * lane + 1) * GP_RP + 16 * w) = o;
            }
        }
        __syncthreads();
#pragma unroll
        for (int q = 0; q < 2; ++q) {
            const int id = 2 * w + q, ct = id >> 2, st = id & 3;
            if (st <= ct) {
                f32x4 acc = (f32x4){0.f, 0.f, 0.f, 0.f};
#pragma unroll
                for (int ks = 0; ks < 4; ++ks) {
                    const bf16x8 a = *(const LAS bf16x8*)(lds + GP_KN + (16 * ct + fr) * GP_KP + (32 * ks + 8 * fq) * 2);
                    const bf16x8 bb = *(const LAS bf16x8*)(lds + GP_KN + (16 * st + fr) * GP_KP + (32 * ks + 8 * fq) * 2);
                    acc = __builtin_amdgcn_mfma_f32_16x16x32_bf16(a, bb, acc, 0, 0, 0);
                }
                const int s = 16 * st + fr; const float gs = gc_s[s];
#pragma unroll
                for (int r = 0; r < 4; ++r) { const int c = 16 * ct + 4 * fq + r;
                    Lm[c * GP_LP + s] = (s < c) ? beta_s[c] * acc[r] * expf(fminf(gc_s[c] - gs, 0.f)) : 0.f; }
            }
        }
        __syncthreads();
        if (w == 0) {
            float t[64];
            int zoff = 0; asm volatile("" : "+v"(zoff));
            const LAS float* Lz = Lm + zoff;
#pragma unroll
            for (int i = 0; i < 64; ++i) {
                float a0 = (i == lane) ? 1.f : 0.f, a1 = 0.f, a2 = 0.f, a3 = 0.f;
#pragma unroll
                for (int s4 = 0; s4 + 4 <= i; s4 += 4) { const f32x4 lv = *(const LAS f32x4*)(Lz + i * GP_LP + s4);
                    a0 -= lv[0] * t[s4]; a1 -= lv[1] * t[s4 + 1]; a2 -= lv[2] * t[s4 + 2]; a3 -= lv[3] * t[s4 + 3]; }
#pragma unroll
                for (int s = i & ~3; s < i; ++s) a0 -= Lz[i * GP_LP + s] * t[s];
                t[i] = (a0 + a1) + (a2 + a3);
                *(LAS bf16*)(lds + GP_TB + i * GP_TP + lane * 2) = (bf16)f2bf(t[i]);
                if ((i & 3) == 3) __builtin_amdgcn_sched_barrier(0);
            }
        } else {
            for (int id = w - 1; id < 16; id += 7) {
                const int ct = id >> 2, st = id & 3;
                f32x4 acc = (f32x4){0.f, 0.f, 0.f, 0.f};
                if (st <= ct) {
#pragma unroll
                    for (int ks = 0; ks < 4; ++ks) {
                        const bf16x8 a = *(const LAS bf16x8*)(lds + GP_QN + (16 * ct + fr) * GP_KP + (32 * ks + 8 * fq) * 2);
                        const bf16x8 bb = *(const LAS bf16x8*)(lds + GP_KN + (16 * st + fr) * GP_KP + (32 * ks + 8 * fq) * 2);
                        acc = __builtin_amdgcn_mfma_f32_16x16x32_bf16(a, bb, acc, 0, 0, 0);
                    }
                }
                const int s = 16 * st + fr; const float gs = gc_s[s]; const int ps = perm_pos(s);
#pragma unroll
                for (int r = 0; r < 4; ++r) { const int c = 16 * ct + 4 * fq + r;
                    const float v = (s <= c) ? acc[r] * expf(fminf(gc_s[c] - gs, 0.f)) : 0.f;
                    AIP[((size_t)item * 64 + c) * 64 + ps] = (bf16)f2bf(v); }
            }
        }
        __syncthreads();
#pragma unroll
        for (int q = 0; q < 2; ++q) {
            const int colt = 2 * w + q;
            bf16x8 af[2];
#pragma unroll
            for (int ks = 0; ks < 2; ++ks) af[ks] = *(const LAS bf16x8*)(lds + GP_RT + (16 * colt + fr) * GP_RP + (32 * ks + 8 * fq) * 2);
#pragma unroll
            for (int ct = 0; ct < 4; ++ct) {
                f32x4 acc = (f32x4){0.f, 0.f, 0.f, 0.f};
#pragma unroll
                for (int ks = 0; ks < 2; ++ks) {
                    const bf16x8 bb = *(const LAS bf16x8*)(lds + GP_TB + (16 * ct + fr) * GP_TP + (32 * ks + 8 * fq) * 2);
                    acc = __builtin_amdgcn_mfma_f32_16x16x32_bf16(af[ks], bb, acc, 0, 0, 0);
                }
                const int c = 16 * ct + fr;
                if (colt < 8) {
#pragma unroll
                    for (int r = 0; r < 4; ++r) UT[((size_t)item * 128 + 16 * colt + 4 * fq + r) * 64 + c] = (bf16)f2bf(acc[r]);
                } else {
                    const int kt = colt - 8;
                    u32x2 h2; h2.x = pk2(-acc[0], -acc[1]); h2.y = pk2(-acc[2], -acc[3]);
                    *(u32x2*)(WP + ((size_t)item * 64 + c) * 128 + 32 * (kt >> 1) + 8 * fq + 4 * (kt & 1)) = h2;
                }
            }
        }
    }
    __syncthreads();
}

constexpr int GS_WP = 0, GS_QD = 17408, GS_AIP = 34816, GS_KDT = 44032, GS_BUF = 62464, GS_SSX = 2 * GS_BUF;
__device__ void phase_gdn_scan(const Params& p, int L, unsigned char* lds_, int bid, int nblk) {
    LAS unsigned char* lds = (LAS unsigned char*)lds_;
    const int tid = tidx(), lane = tid & 63, w = __builtin_amdgcn_readfirstlane(tid >> 6), fr = lane & 15, fq = lane >> 4;
    const bf16* proj = (const bf16*)(p.ws + WS_PROJ);
    const bf16* WP = (const bf16*)(p.ws + GD_WP); const bf16* QD = (const bf16*)(p.ws + GD_QD); const bf16* AIP = (const bf16*)(p.ws + GD_AIP);
    const bf16* KDT = (const bf16*)(p.ws + GD_KDT); const bf16* UT = (const bf16*)(p.ws + GD_UT); const float* GL = (const float*)(p.ws + GD_GL);
    bf16* obuf = (bf16*)(p.ws + WS_OBUF);
    LAS float* ssx = (LAS float*)(lds + GS_SSX);
    for (int item = bid; item < 32; item += nblk) {
        const int hh = item & 3, b = item >> 2;
        const float gn = p.gdn_norm_g[L * 128 + 16 * w + fr];
        f32x4 S[8];
#pragma unroll
        for (int kt = 0; kt < 8; ++kt) S[kt] = (f32x4){0.f, 0.f, 0.f, 0.f};
        f32x4 oprev[4];
#pragma unroll
        for (int ct = 0; ct < 4; ++ct) oprev[ct] = (f32x4){0.f, 0.f, 0.f, 0.f};
        u32x4 st[7];
        auto gload = [&](int ci) {
#pragma unroll
            for (int i = 0; i < 7; ++i) {
                const int pc = tid + 512 * i;
                const bf16* src;
                if (i < 2) src = WP + (size_t)ci * 8192 + pc * 8;
                else if (i < 4) src = QD + (size_t)ci * 8192 + (pc - 1024) * 8;
                else if (i < 5) src = AIP + (size_t)ci * 4096 + (pc - 2048) * 8;
                else src = KDT + (size_t)ci * 8192 + (pc - 2560) * 8;
                st[i] = *(const u32x4*)src;
            }
        };
        auto lstore = [&](int buf) {
#pragma unroll
            for (int i = 0; i < 7; ++i) {
                const int pc = tid + 512 * i;
                int off;
                if (i < 2) off = GS_WP + (pc >> 4) * 272 + (pc & 15) * 16;
                else if (i < 4) { const int q = pc - 1024; off = GS_QD + (q >> 4) * 272 + (q & 15) * 16; }
                else if (i < 5) { const int q = pc - 2048; off = GS_AIP + (q >> 3) * 144 + (q & 7) * 16; }
                else { const int q = pc - 2560; off = GS_KDT + (q >> 3) * 144 + (q & 7) * 16; }
                *(LAS u32x4*)(lds + buf * GS_BUF + off) = st[i];
            }
        };
        __syncthreads();
        gload(item * 32); lstore(0);
        u32x2 ut[4]; float gl;
        {
            const int ci = item * 32;
#pragma unroll
            for (int ct = 0; ct < 4; ++ct) ut[ct] = *(const u32x2*)(UT + ((size_t)ci * 128 + 16 * w + fr) * 64 + 16 * ct + 4 * fq);
            gl = GL[ci];
        }
        unsigned zr[8];
        __syncthreads();
        for (int n = 0; n <= 32; ++n) {
            const int ci = item * 32 + n, buf = n & 1;
            f32x4 oacc[4];
            u32x2 utn[4]; float gln = 0.f;
            unsigned zn[8];
            if (n < 32) {
                if (n + 1 < 32) {
                    gload(ci + 1);
#pragma unroll
                    for (int ct = 0; ct < 4; ++ct) utn[ct] = *(const u32x2*)(UT + ((size_t)(ci + 1) * 128 + 16 * w + fr) * 64 + 16 * ct + 4 * fq);
                    gln = GL[ci + 1];
                }
                {
                    const size_t rowc = (size_t)b * SEQ + n * 64;
#pragma unroll
                    for (int ct = 0; ct < 4; ++ct)
#pragma unroll
                        for (int r = 0; r < 4; r += 2) {
                            const bf16* zp = proj + (rowc + 16 * ct + 4 * fq + r) * PROJ_W + 3072 + hh * 128 + 16 * w + fr;
                            zn[2 * ct + (r >> 1)] = (unsigned)zp[0] | ((unsigned)zp[PROJ_W] << 16);
                        }
                }
                f32x4 vn[4];
#pragma unroll
                for (int ct = 0; ct < 4; ++ct) vn[ct] = (f32x4){lo16(ut[ct].x), hi16(ut[ct].x), lo16(ut[ct].y), hi16(ut[ct].y)};
                bf16x8 sb[4];
#pragma unroll
                for (int ks = 0; ks < 4; ++ks) { u32x4 pk; pk.x = cvtpk(S[2 * ks][0], S[2 * ks][1]); pk.y = cvtpk(S[2 * ks][2], S[2 * ks][3]); pk.z = cvtpk(S[2 * ks + 1][0], S[2 * ks + 1][1]); pk.w = cvtpk(S[2 * ks + 1][2], S[2 * ks + 1][3]);
                    sb[ks] = __builtin_bit_cast(bf16x8, pk); }
                LAS unsigned char* bb = lds + buf * GS_BUF;
#pragma unroll
                for (int ct = 0; ct < 4; ++ct) {
                    oacc[ct] = (f32x4){0.f, 0.f, 0.f, 0.f};
#pragma unroll
                    for (int ks = 0; ks < 4; ++ks) {
                        const bf16x8 aw = *(const LAS bf16x8*)(bb + GS_WP + (16 * ct + fr) * 272 + (32 * ks + 8 * fq) * 2);
                        const bf16x8 aq = *(const LAS bf16x8*)(bb + GS_QD + (16 * ct + fr) * 272 + (32 * ks + 8 * fq) * 2);
                        vn[ct] = __builtin_amdgcn_mfma_f32_16x16x32_bf16(aw, sb[ks], vn[ct], 0, 0, 0);
                        oacc[ct] = __builtin_amdgcn_mfma_f32_16x16x32_bf16(aq, sb[ks], oacc[ct], 0, 0, 0);
                    }
                }
                bf16x8 vb[2];
#pragma unroll
                for (int ss = 0; ss < 2; ++ss) { u32x4 pk; pk.x = cvtpk(vn[2 * ss][0], vn[2 * ss][1]); pk.y = cvtpk(vn[2 * ss][2], vn[2 * ss][3]); pk.z = cvtpk(vn[2 * ss + 1][0], vn[2 * ss + 1][1]); pk.w = cvtpk(vn[2 * ss + 1][2], vn[2 * ss + 1][3]);
                    vb[ss] = __builtin_bit_cast(bf16x8, pk); }
#pragma unroll
                for (int ct = 0; ct < 4; ++ct)
#pragma unroll
                    for (int ss = 0; ss < 2; ++ss) {
                        const bf16x8 aa = *(const LAS bf16x8*)(bb + GS_AIP + (16 * ct + fr) * 144 + (32 * ss + 8 * fq) * 2);
                        oacc[ct] = __builtin_amdgcn_mfma_f32_16x16x32_bf16(aa, vb[ss], oacc[ct], 0, 0, 0);
                    }
#pragma unroll
                for (int kt = 0; kt < 8; ++kt) {
                    S[kt] = S[kt] * gl;
#pragma unroll
                    for (int ss = 0; ss < 2; ++ss) {
                        const bf16x8 ak = *(const LAS bf16x8*)(bb + GS_KDT + (16 * kt + fr) * 144 + (32 * ss + 8 * fq) * 2);
                        S[kt] = __builtin_amdgcn_mfma_f32_16x16x32_bf16(ak, vb[ss], S[kt], 0, 0, 0);
                    }
                }
#pragma unroll
                for (int ct = 0; ct < 4; ++ct)
#pragma unroll
                    for (int r = 0; r < 4; ++r) { const float sq = row16_sum(oacc[ct][r] * oacc[ct][r]); if (fr == 0) ssx[(buf * 64 + 16 * ct + 4 * fq + r) * 8 + w] = sq; }
            }
            if (n > 0) {
                const int pb = (n - 1) & 1; const size_t rowp = (size_t)b * SEQ + (n - 1) * 64;
#pragma unroll
                for (int ct = 0; ct < 4; ++ct)
#pragma unroll
                    for (int r = 0; r < 4; ++r) {
                        const int c = 16 * ct + 4 * fq + r;
                        const f32x4 s0 = *(const LAS f32x4*)(ssx + (pb * 64 + c) * 8), s1 = *(const LAS f32x4*)(ssx + (pb * 64 + c) * 8 + 4);
                        const float tot = ((s0[0] + s0[1]) + (s0[2] + s0[3])) + ((s1[0] + s1[1]) + (s1[2] + s1[3]));
                        const float rn = rsqrtf(tot * (1.f / 128.f) + EPS);
                        const float z = (r & 1) ? hi16(zr[2 * ct + (r >> 1)]) : lo16(zr[2 * ct + (r >> 1)]);
                        obuf[(rowp + c) * D + 512 + hh * 128 + 16 * w + fr] = (bf16)f2bf(oprev[ct][r] * rn * gn * (z * sigmoidf_(z)));
                    }
            }
            if (n < 32) {
#pragma unroll
                for (int ct = 0; ct < 4; ++ct) oprev[ct] = oacc[ct];
#pragma unroll
                for (int i = 0; i < 8; ++i) zr[i] = zn[i];
                if (n + 1 < 32) {
                    lstore(buf ^ 1);
#pragma unroll
                    for (int ct = 0; ct < 4; ++ct) ut[ct] = utn[ct];
                    gl = gln;
                }
            }
            LDS_BARRIER();
        }
    }
}

__device__ __forceinline__ unsigned sortable(float f) { const unsigned u = __float_as_uint(f); return u ^ ((unsigned)((int)u >> 31) | 0x80000000u); }
__device__ __forceinline__ float unsortable(unsigned s) { return __uint_as_float((s & 0x80000000u) ? (s ^ 0x80000000u) : ~s); }
#define CE(a, b) do { const unsigned _x = k[a], _y = k[b]; k[a] = _x > _y ? _x : _y; k[b] = _x > _y ? _y : _x; } while (0)
constexpr int PE_TK = 0, PE_TAB = 8192, PE_ID = 8448, PE_GT = PE_ID + 32768;
__device__ void phase_peer(const Params& p, int L, unsigned char* lds_, int bid, int nblk) {
    LAS unsigned char* lds = (LAS unsigned char*)lds_;
    const int tid = tidx(), lane = tid & 63, w = __builtin_amdgcn_readfirstlane(tid >> 6), fr = lane & 15, fq = lane >> 4;
    const bf16* Q2 = (const bf16*)(p.ws + WS_Q2);
    const bf16* SK = (const bf16*)(p.ws + WS_SK) + (size_t)L * 8 * 2 * 128 * 128;
    float* H = (float*)(p.ws + WS_H); bf16* HB2 = (bf16*)(p.ws + WS_HB2);
    const bf16* U = (const bf16*)(p.ws + WS_U) + (size_t)L * NEXP * D;
    const bf16* V = (const bf16*)(p.ws + WS_V) + (size_t)L * NEXP * D;
    const float* g = p.ln_ffn_g + L * D;
    LAS unsigned* TK = (LAS unsigned*)(lds + PE_TK);
    LAS unsigned short* TAB = (LAS unsigned short*)(lds + PE_TAB);
    LAS int* IDL = (LAS int*)(lds + PE_ID); LAS float* GTL = (LAS float*)(lds + PE_GT);
    if (tid < 64) {
        int a = 0, base = 0, q = tid; unsigned short v = 0xffff;
        if (q < 50) { for (;;) { const int cnt = 16 / (a + 1); if (q < base + cnt) break; base += cnt; ++a; } v = (unsigned short)((a << 8) | (q - base)); }
        TAB[tid] = v;
    }
    for (int item = bid; item < M / 64; item += nblk) {
        const int tok0 = item * 64;
        __syncthreads();
        const int tg = w & 3, cc = w >> 2;
        for (int hh = 0; hh < 8; ++hh) {
            {
                f32x4 acc[8];
#pragma unroll
                for (int nt = 0; nt < 8; ++nt) acc[nt] = (f32x4){0.f, 0.f, 0.f, 0.f};
                bf16x8 qa[4];
#pragma unroll
                for (int ks = 0; ks < 4; ++ks) qa[ks] = *(const bf16x8*)(Q2 + (size_t)(tok0 + 16 * tg + fr) * 2048 + hh * 256 + cc * 128 + 32 * ks + 8 * fq);
                const bf16* skb = SK + ((size_t)(hh * 2 + cc) * 128 + fr) * 128 + 8 * fq;
#pragma unroll
                for (int nt = 0; nt < 8; ++nt)
#pragma unroll
                    for (int ks = 0; ks < 4; ++ks) {
                        const bf16x8 kb = *(const bf16x8*)(skb + (size_t)nt * 16 * 128 + 32 * ks);
                        acc[nt] = __builtin_amdgcn_mfma_f32_16x16x32_bf16(qa[ks], kb, acc[nt], 0, 0, 0);
                    }
#pragma unroll
                for (int r = 0; r < 4; ++r) {
                    unsigned k[8];
#pragma unroll
                    for (int nt = 0; nt < 8; ++nt) k[nt] = (sortable(acc[nt][r]) & ~0x7Fu) | (unsigned)(127 - (16 * nt + fr));
                    CE(0, 1); CE(2, 3); CE(4, 5); CE(6, 7); CE(0, 2); CE(1, 3); CE(4, 6); CE(5, 7); CE(1, 2); CE(5, 6); CE(0, 4); CE(3, 7);
                    CE(1, 5); CE(2, 6); CE(1, 4); CE(3, 6); CE(2, 4); CE(3, 5); CE(3, 4);
                    unsigned res = 0u;
#pragma unroll
                    for (int rd = 0; rd < 16; ++rd) {
                        const unsigned m = row16_umax(k[0]);
                        const bool win = k[0] == m;
#pragma unroll
                        for (int i = 0; i < 7; ++i) k[i] = win ? k[i + 1] : k[i];
                        k[7] = win ? 0u : k[7];
                        res = (fr == rd) ? m : res;
                    }
                    TK[(cc * 64 + 16 * tg + 4 * fq + r) * 16 + fr] = res;
                }
            }
            __syncthreads();
#pragma unroll
            for (int ps = 0; ps < 2; ++ps) {
                const int tl = 8 * w + 4 * ps + fq;
                unsigned k[4];
#pragma unroll
                for (int sl = 0; sl < 4; ++sl) {
                    const int q = sl * 16 + fr;
                    const unsigned ab = TAB[q];
                    const unsigned k1 = TK[tl * 16 + ((ab >> 8) & 15)], k2 = TK[(64 + tl) * 16 + (ab & 15)];
                    const float v = unsortable(k1 & ~0x7Fu) + unsortable(k2 & ~0x7Fu);
                    k[sl] = (q < 50) ? ((sortable(v) & ~0x3Fu) | (unsigned)(63 - q)) : 0u;
                }
                CE(0, 1); CE(2, 3); CE(0, 2); CE(1, 3); CE(1, 2);
                unsigned res = 0u;
#pragma unroll
                for (int rd = 0; rd < 16; ++rd) {
                    const unsigned m = row16_umax(k[0]);
                    const bool win = k[0] == m;
                    k[0] = win ? k[1] : k[0]; k[1] = win ? k[2] : k[1]; k[2] = win ? k[3] : k[2]; k[3] = win ? 0u : k[3];
                    res = (fr == rd) ? m : res;
                }
                const unsigned ab = TAB[63 - (res & 0x3Fu)];
                const unsigned k1 = TK[tl * 16 + ((ab >> 8) & 15)], k2 = TK[(64 + tl) * 16 + (ab & 15)];
                const float v = unsortable(k1 & ~0x7Fu) + unsortable(k2 & ~0x7Fu);
                const float e = __expf(v - row16_max(v));
                const float sum = row16_sum(e);
                IDL[tl * 128 + hh * 16 + fr] = (int)((127u - (k1 & 0x7Fu)) * 128u + (127u - (k2 & 0x7Fu)));
                GTL[tl * 128 + hh * 16 + fr] = e / sum;
            }
            __syncthreads();
        }
        for (int ti = 0; ti < 8; ++ti) {
            const int tl = 8 * w + ti, tok = tok0 + tl;
            float* hrow = H + (size_t)tok * D;
            float xv[16];
            {
                const f32x4 a0 = *(const f32x4*)(hrow + 8 * lane), a1 = *(const f32x4*)(hrow + 8 * lane + 4), b0 = *(const f32x4*)(hrow + 512 + 8 * lane), b1 = *(const f32x4*)(hrow + 512 + 8 * lane + 4);
#pragma unroll
                for (int i = 0; i < 4; ++i) { xv[i] = a0[i]; xv[4 + i] = a1[i]; xv[8 + i] = b0[i]; xv[12 + i] = b1[i]; }
            }
            float ss = 0.f;
#pragma unroll
            for (int i = 0; i < 16; ++i) ss += xv[i] * xv[i];
            const float rstd = rsqrtf(wave_sum(ss) * (1.f / D) + EPS);
            float xn[16];
#pragma unroll
            for (int i = 0; i < 8; ++i) { xn[i] = xv[i] * rstd * g[8 * lane + i]; xn[8 + i] = xv[8 + i] * rstd * g[512 + 8 * lane + i]; }
            float h0 = 0.f, h1 = 0.f;
#pragma unroll 4
            for (int e = 0; e < 128; ++e) {
                const int id = IDL[tl * 128 + e];
                const bf16* ur = U + (size_t)id * D;
                const u32x4 a = *(const u32x4*)(ur + 8 * lane), b = *(const u32x4*)(ur + 512 + 8 * lane);
                float d = 0.f;
#pragma unroll
                for (int i = 0; i < 4; ++i) { d += xn[2 * i] * lo16(a[i]) + xn[2 * i + 1] * hi16(a[i]); d += xn[8 + 2 * i] * lo16(b[i]) + xn[8 + 2 * i + 1] * hi16(b[i]); }
                d = wave_sum(d);
                if (lane == (e & 63)) { if (e < 64) h0 = d; else h1 = d; }
            }
            const float w0 = GTL[tl * 128 + lane] * 0.5f * h0 * (1.f + erff(h0 * 0.70710678118654752f));
            const float w1 = GTL[tl * 128 + 64 + lane] * 0.5f * h1 * (1.f + erff(h1 * 0.70710678118654752f));
            float y[16];
#pragma unroll
            for (int i = 0; i < 16; ++i) y[i] = 0.f;
#pragma unroll 4
            for (int e = 0; e < 128; ++e) {
                const int id = IDL[tl * 128 + e];
                const float ww = __shfl(e < 64 ? w0 : w1, e & 63);
                const bf16* vr = V + (size_t)id * D;
                const u32x4 a = *(const u32x4*)(vr + 8 * lane), b = *(const u32x4*)(vr + 512 + 8 * lane);
#pragma unroll
                for (int i = 0; i < 4; ++i) { y[2 * i] += ww * lo16(a[i]); y[2 * i + 1] += ww * hi16(a[i]); y[8 + 2 * i] += ww * lo16(b[i]); y[8 + 2 * i + 1] += ww * hi16(b[i]); }
            }
#pragma unroll
            for (int i = 0; i < 16; ++i) y[i] += xv[i];
            *(f32x4*)(hrow + 8 * lane) = (f32x4){y[0], y[1], y[2], y[3]};
            *(f32x4*)(hrow + 8 * lane + 4) = (f32x4){y[4], y[5], y[6], y[7]};
            *(f32x4*)(hrow + 512 + 8 * lane) = (f32x4){y[8], y[9], y[10], y[11]};
            *(f32x4*)(hrow + 512 + 8 * lane + 4) = (f32x4){y[12], y[13], y[14], y[15]};
            bf16* hb = HB2 + (size_t)tok * D;
            u32x4 o; o.x = pk2(y[0], y[1]); o.y = pk2(y[2], y[3]); o.z = pk2(y[4], y[5]); o.w = pk2(y[6], y[7]);
            *(u32x4*)(hb + 8 * lane) = o;
            o.x = pk2(y[8], y[9]); o.y = pk2(y[10], y[11]); o.z = pk2(y[12], y[13]); o.w = pk2(y[14], y[15]);
            *(u32x4*)(hb + 512 + 8 * lane) = o;
        }
    }
    __syncthreads();
}
#undef CE

__device__ void phase_final(const Params& p, int bid, int nblk) {
    const int tid = tidx(), lane = tid & 63, gw = bid * NWAVES + (tid >> 6), NGW = nblk * NWAVES;
    const float* H = (const float*)(p.ws + WS_H); const float* rstd0 = (const float*)(p.ws + WS_STAT);
    for (int m = gw; m < M; m += NGW) {
        const float r = rstd0[m];
#pragma unroll
        for (int j = 0; j < 4; ++j) {
            const f32x4 v = ((const f32x4*)(H + (size_t)m * D))[lane + 64 * j];
            const f32x4 gv = ((const f32x4*)p.final_g)[lane + 64 * j];
            ((f32x4*)(p.out + (size_t)m * D))[lane + 64 * j] = v * r * gv;
        }
    }
}

#define XB_TMO      128
#define XB_XCNT(j)  (256  + 64 * (j))
#define XB_XSUB(j)  (1280 + 64 * (j))
#define XB_XGEN(j)  (2304 + 64 * (j))
#define XB_TOP      3328
#define XB_TOPGEN   3392
#define XCD_BAR_WORDS 3456
#define XB_SPIN_CAP (1u << 22)
__device__ __forceinline__ unsigned xb_ld(unsigned* p)              { return __hip_atomic_load(p, __ATOMIC_RELAXED, __HIP_MEMORY_SCOPE_AGENT); }
__device__ __forceinline__ unsigned xb_add(unsigned* p, unsigned v) { return __hip_atomic_fetch_add(p, v, __ATOMIC_RELAXED, __HIP_MEMORY_SCOPE_AGENT); }
__device__ __forceinline__ unsigned xb_xcc_id() { return (unsigned)__builtin_amdgcn_s_getreg((3 << 11) | 20) & 0xFu; }
#define XB_SPIN(cond, bar) do { unsigned _sp = 0; while (cond) { __builtin_amdgcn_s_sleep(1); \
    if ((++_sp & 255u) == 0u) { if (xb_ld(&(bar)[XB_TMO])) break; if (_sp > XB_SPIN_CAP) { atomicAdd(&(bar)[XB_TMO], 1u); break; } } } } while (0)
struct XcdBarrier { unsigned* bar; unsigned x; volatile LAS unsigned* st; };
__device__ __forceinline__ XcdBarrier xcd_barrier_post(unsigned* bar, volatile LAS unsigned* st) {
    XcdBarrier b; b.bar = bar; b.x = xb_xcc_id(); b.st = st;
    if (threadIdx.x == 0) (void)xb_add(&bar[XB_XCNT(b.x)], 1u);
    return b;
}
__device__ __forceinline__ void xcd_barrier_complete(unsigned* bar, unsigned x, unsigned& nloc, unsigned& nx) {
    const unsigned G = gridDim.x * gridDim.y * gridDim.z;
    unsigned sum, cnt, mine, sp = 0u;
    for (;;) {
        sum = 0u; cnt = 0u; mine = 0u;
#pragma unroll
        for (unsigned j = 0; j < 16; ++j) { const unsigned c = xb_ld(&bar[XB_XCNT(j)]); sum += c; cnt += (c > 0u) ? 1u : 0u; mine = (j == x) ? c : mine; }
        if (sum == G) break;
        __builtin_amdgcn_s_sleep(1);
        if ((++sp & 255u) == 0u) { if (xb_ld(&bar[XB_TMO])) break; if (sp > XB_SPIN_CAP) { atomicAdd(&bar[XB_TMO], 1u); break; } }
    }
    nloc = mine > 0u ? mine : 1u; nx = cnt > 0u ? cnt : 1u;
}
__device__ __forceinline__ void xcd_barrier(const XcdBarrier& b) {
    asm volatile("s_waitcnt vmcnt(0)" ::: "memory");
    __syncthreads();
    if (threadIdx.x == 0) {
        unsigned* bar = b.bar;
        __builtin_amdgcn_s_waitcnt(0);
        unsigned nloc = b.st[0], nx = b.st[1];
        if (nloc == 0u) { xcd_barrier_complete(bar, b.x, nloc, nx); b.st[0] = nloc; b.st[1] = nx; }
        const unsigned old = xb_add(&bar[XB_XSUB(b.x)], 1u);
        const unsigned gen = old / nloc;
        if (old + 1u == (gen + 1u) * nloc) {
            __builtin_amdgcn_fence(__ATOMIC_RELEASE, "agent");
            asm volatile("s_waitcnt vmcnt(0)" ::: "memory");
            const unsigned og = xb_add(&bar[XB_TOP], 1u);
            const unsigned tg = og / nx;
            if (og + 1u == (tg + 1u) * nx) xb_add(&bar[XB_TOPGEN], 1u);
            else XB_SPIN(xb_ld(&bar[XB_TOPGEN]) == tg, bar);
            __builtin_amdgcn_fence(__ATOMIC_ACQUIRE, "agent");
            xb_add(&bar[XB_XGEN(b.x)], 1u);
            asm volatile("s_waitcnt vmcnt(0)" ::: "memory");
        } else {
            XB_SPIN(xb_ld(&bar[XB_XGEN(b.x)]) == gen, bar);
            __builtin_amdgcn_fence(__ATOMIC_ACQUIRE, "agent");
            asm volatile("s_waitcnt vmcnt(0)" ::: "memory");
        }
    }
    __syncthreads();
}
constexpr int CW_BAR = 4096;
constexpr int LDS_MISC_OFF = LDS_BYTES - 256;

constexpr int NS = 11;
constexpr int K_PROLOGUE = 11, K_FINAL = 12;
template <int KIND>
__device__ __forceinline__ void run_kind(const Params& p, int L, unsigned char* lds, int bid, int nblk) {
    unsigned char* ws = p.ws;
    float* H = (float*)(ws + WS_H);
    float* rstd0 = (float*)(ws + WS_STAT); float* rstd1 = rstd0 + M; float* rstde = rstd1 + M;
    if constexpr (KIND == K_PROLOGUE) phase_prologue(p, lds, bid, nblk);
    if constexpr (KIND == K_FINAL) phase_final(p, bid, nblk);
    if constexpr (KIND == 0) { EpiProj E{(bf16*)(ws + WS_PROJ), (float*)(ws + WS_BA), rstd0};
        gemm_run(lds, (const bf16*)(ws + WS_HB0), (const bf16*)(ws + WS_WIN) + (size_t)L * IN_PAD * D, M, IN_PAD, D, E, bid, nblk); }
    if constexpr (KIND == 1) phase_att_mfma(p, L, lds, bid, nblk);
    if constexpr (KIND == 2) phase_gdn_prep(p, L, lds, bid, nblk);
    if constexpr (KIND == 3) phase_gdn_scan(p, L, lds, bid, nblk);
    if constexpr (KIND == 4) { EpiRes E{H, (bf16*)(ws + WS_HB1)};
        gemm_run(lds, (const bf16*)(ws + WS_OBUF), (const bf16*)(ws + WS_WOUT) + (size_t)L * D * D, M, D, D, E, bid, nblk); }
    if constexpr (KIND == 5) phase_rowstat_f32(H, rstd1, bid, nblk);
    if constexpr (KIND == 6) { EpiQ2 E{(bf16*)(ws + WS_Q2), rstd1};
        gemm_run(lds, (const bf16*)(ws + WS_HB1), (const bf16*)(ws + WS_WQ) + (size_t)L * 2048 * D, M, 2048, D, E, bid, nblk);
        EpiE E2{(bf16*)(ws + WS_EPRE)};
        gemm_run(lds, (const bf16*)(ws + WS_PB) + (size_t)L * M * 256, (const bf16*)(ws + WS_WP) + (size_t)L * D * 256, M, D, 256, E2, bid, nblk); }
    if constexpr (KIND == 7) { phase_rowstat_bf16((const bf16*)(ws + WS_EPRE), rstde, bid, nblk); phase_peer(p, L, lds, bid, nblk); }
    if constexpr (KIND == 9) { EpiPle E{H, (bf16*)(ws + WS_HB0), (const bf16*)(ws + WS_EPRE), rstde, p.ple_norm_g + L * D};
        gemm_run(lds, (const bf16*)(ws + WS_HB2), (const bf16*)(ws + WS_WG) + (size_t)L * D * D, M, D, D, E, bid, nblk); }
    if constexpr (KIND == 10) phase_rowstat_f32(H, rstd0, bid, nblk);
}

__device__ __forceinline__ Params params_off(const Params& s, size_t z) {
    Params q;
    q.x = s.x + z; q.p = s.p + z; q.ln_mix_g = s.ln_mix_g + z; q.w_in = s.w_in + z; q.conv_w = s.conv_w + z; q.a_log = s.a_log + z; q.dt_bias = s.dt_bias + z;
    q.gdn_norm_g = s.gdn_norm_g + z; q.diff_lambda = s.diff_lambda + z; q.subln_g = s.subln_g + z; q.w_out = s.w_out + z; q.ln_ffn_g = s.ln_ffn_g + z;
    q.peer_wq = s.peer_wq + z; q.subkeys = s.subkeys + z; q.peer_u = s.peer_u + z; q.peer_v = s.peer_v + z; q.ple_wp = s.ple_wp + z; q.ple_wg = s.ple_wg + z;
    q.ple_norm_g = s.ple_norm_g + z; q.final_g = s.final_g + z; q.out = s.out + z; q.ws = s.ws + z; q.pad0 = 0; q.pad1 = 0;
    return q;
}
#define RUN(KIND) do { size_t z_ = 0; int L_ = L; asm volatile("" : "+s"(z_), "+s"(L_)); const Params q_ = params_off(p, z_); run_kind<KIND>(q_, L_, lds, bid, nblk); } while (0)
__global__ void __launch_bounds__(NTHREADS, 2) mk_fwd(Params p) {
    extern __shared__ __attribute__((aligned(16))) unsigned char lds[];
    const int bid = (int)blockIdx.x, nblk = (int)gridDim.x;
    volatile LAS unsigned* misc = (volatile LAS unsigned*)((LAS unsigned char*)lds + LDS_MISC_OFF);
    if (threadIdx.x < 64) misc[threadIdx.x] = 0u;
    __syncthreads();
    XcdBarrier bar = xcd_barrier_post((unsigned*)(p.ws + WS_CTL) + CW_BAR, misc + 8);
    { int L = 0; RUN(K_PROLOGUE); }
    cg::this_grid().sync();
#pragma nounroll
    for (int L = 0; L < DEPTH; ++L) {
        RUN(0); xcd_barrier(bar);
        RUN(1); xcd_barrier(bar);
        RUN(2); xcd_barrier(bar);
        RUN(3); xcd_barrier(bar);
        RUN(4); xcd_barrier(bar);
        RUN(5); xcd_barrier(bar);
        RUN(6); xcd_barrier(bar);
        RUN(7); xcd_barrier(bar);
        RUN(9); xcd_barrier(bar);
        RUN(10); xcd_barrier(bar);
    }
    { int L = 0; RUN(K_FINAL); }
}

extern "C" void kernel_launch(void* const* d_in, const int* in_sizes, int n_in, void* d_out, int out_size, void* d_ws, size_t ws_size, hipStream_t stream) {
    static int grid = 0;
    if (grid == 0) {
        if (n_in != 20 || out_size != M * D || ws_size < WS_END) { fprintf(stderr, "kernel_launch: unexpected shapes (n_in %d, out %d, ws %zu < %zu)\n", n_in, out_size, ws_size, (size_t)WS_END); grid = -1; return; }
        int dev = 0, cus = 0, per_cu = 0;
        (void)hipGetDevice(&dev); (void)hipDeviceGetAttribute(&cus, hipDeviceAttributeMultiprocessorCount, dev);
        if (hipFuncSetAttribute((const void*)mk_fwd, hipFuncAttributeMaxDynamicSharedMemorySize, LDS_BYTES) != hipSuccess) { fprintf(stderr, "kernel_launch: hipFuncSetAttribute failed\n"); grid = -1; return; }
        if (hipOccupancyMaxActiveBlocksPerMultiprocessor(&per_cu, (const void*)mk_fwd, NTHREADS, LDS_BYTES) != hipSuccess || per_cu < 1) { fprintf(stderr, "kernel_launch: occupancy query says %d blocks per CU\n", per_cu); (void)hipGetLastError(); grid = -1; return; }
        grid = (cus > 0 ? cus : 256);
    }
    if (grid < 0) return;
    (void)hipMemsetAsync((char*)d_ws + WS_CTL, 0, CTL_ZERO_BYTES, stream);
    Params p{};
    const float** pp = (const float**)&p;
    for (int i = 0; i < 20; ++i) pp[i] = (const float*)d_in[i];
    p.out = (float*)d_out; p.ws = (unsigned char*)d_ws;
    void* args[] = {&p};
    hipError_t e = hipLaunchCooperativeKernel((const void*)mk_fwd, dim3(grid), dim3(NTHREADS), args, LDS_BYTES, stream);
    if (e != hipSuccess) fprintf(stderr, "kernel_launch: cooperative launch failed: %s (grid %d)\n", hipGetErrorString(e), grid);
}
```

```cpp
#include <hip/hip_runtime.h>
#include <hip/hip_cooperative_groups.h>
#include <cstdio>
#include <cstdint>
namespace cg = cooperative_groups;

typedef unsigned short bf16;
typedef float f32x4 __attribute__((ext_vector_type(4)));
typedef short bf16x8 __attribute__((ext_vector_type(8)));
typedef unsigned u32x4 __attribute__((ext_vector_type(4)));
typedef unsigned u32x2 __attribute__((ext_vector_type(2)));

constexpr int D = 1024, BATCH = 8, SEQ = 2048, DEPTH = 4, M = BATCH * SEQ;
constexpr int IN_COLS = 3592, IN_PAD = 3840, PROJ_W = 3584;
constexpr int NEXP = 16384;
constexpr float EPS = 1e-6f;
constexpr float QSCALE = 0.125f * 1.4426950408889634f;
constexpr int NWAVES = 8, NTHREADS = 512;
constexpr int LDS_BYTES = 147456;

constexpr size_t MiB = 1u << 20;
constexpr size_t WS_CTL = 0, CTL_ZERO_BYTES = 1 * MiB;
constexpr size_t WS_H = 1 * MiB;
constexpr size_t WS_HB0 = 65 * MiB;
constexpr size_t WS_HB1 = 97 * MiB;
constexpr size_t WS_HB2 = 129 * MiB;
constexpr size_t WS_PROJ = 161 * MiB;
constexpr size_t WS_BA = 273 * MiB;
constexpr size_t WS_OBUF = 274 * MiB;
constexpr size_t WS_Q2 = 306 * MiB;
constexpr size_t WS_EPRE = 370 * MiB;
constexpr size_t WS_IDX = 402 * MiB;
constexpr size_t WS_GATE = 410 * MiB;
constexpr size_t WS_STAT = 418 * MiB;
constexpr size_t WS_ORAW = 422 * MiB;
constexpr size_t WS_WIN = 550 * MiB;
constexpr size_t WS_WOUT = 582 * MiB;
constexpr size_t WS_WQ = 590 * MiB;
constexpr size_t WS_WG = 606 * MiB;
constexpr size_t WS_WP = 614 * MiB;
constexpr size_t WS_SK = 616 * MiB;
constexpr size_t WS_PB = 618 * MiB;
constexpr size_t WS_U = 650 * MiB;
constexpr size_t WS_V = 778 * MiB;
constexpr size_t WS_SU = WS_STAT + 1 * MiB, WS_SV = WS_STAT + 2 * MiB;
constexpr size_t WS_END = 906 * MiB;

struct Params {
    const float *x, *p, *ln_mix_g, *w_in, *conv_w, *a_log, *dt_bias, *gdn_norm_g, *diff_lambda, *subln_g, *w_out, *ln_ffn_g,
        *peer_wq, *subkeys, *peer_u, *peer_v, *ple_wp, *ple_wg, *ple_norm_g, *final_g;
    float* out;
    unsigned char* ws;
    int pad0, pad1;
};

__device__ __forceinline__ int tidx() { int t = (int)threadIdx.x; asm volatile("" : "+v"(t)); return t; }
#define LDS_BARRIER() asm volatile("s_waitcnt lgkmcnt(0)\n\ts_barrier" ::: "memory")
__device__ __forceinline__ float bf2f(bf16 v) { return __uint_as_float((unsigned)v << 16); }
__device__ __forceinline__ unsigned f2bf(float f) { unsigned u = __float_as_uint(f); return (u + 0x7fffu + ((u >> 16) & 1u)) >> 16; }
__device__ __forceinline__ unsigned pk2(float lo, float hi) { return f2bf(lo) | (f2bf(hi) << 16); }
__device__ __forceinline__ float lo16(unsigned w) { return __uint_as_float(w << 16); }
__device__ __forceinline__ float hi16(unsigned w) { return __uint_as_float(w & 0xffff0000u); }
template <int N> __device__ __forceinline__ float dpp_ror(float x) { return __builtin_bit_cast(float, __builtin_amdgcn_mov_dpp(__builtin_bit_cast(int, x), 0x120 + N, 0xf, 0xf, true)); }
template <int N> __device__ __forceinline__ unsigned dpp_ror_u(unsigned x) { return (unsigned)__builtin_amdgcn_mov_dpp((int)x, 0x120 + N, 0xf, 0xf, true); }
__device__ __forceinline__ float row16_sum(float x) { x += dpp_ror<8>(x); x += dpp_ror<4>(x); x += dpp_ror<2>(x); x += dpp_ror<1>(x); return x; }
__device__ __forceinline__ float row16_max(float x) { x = fmaxf(x, dpp_ror<8>(x)); x = fmaxf(x, dpp_ror<4>(x)); x = fmaxf(x, dpp_ror<2>(x)); x = fmaxf(x, dpp_ror<1>(x)); return x; }
__device__ __forceinline__ unsigned row16_umax(unsigned x) { unsigned y;
    y = dpp_ror_u<8>(x); x = x > y ? x : y; y = dpp_ror_u<4>(x); x = x > y ? x : y; y = dpp_ror_u<2>(x); x = x > y ? x : y; y = dpp_ror_u<1>(x); x = x > y ? x : y; return x; }
__device__ __forceinline__ float xrow16_max(float x) {
    auto s = __builtin_amdgcn_permlane16_swap(__float_as_uint(x), __float_as_uint(x), false, false);
    x = fmaxf(__uint_as_float(s[0]), __uint_as_float(s[1]));
    auto t = __builtin_amdgcn_permlane32_swap(__float_as_uint(x), __float_as_uint(x), false, false);
    return fmaxf(__uint_as_float(t[0]), __uint_as_float(t[1]));
}
__device__ __forceinline__ float xrow16_sum(float x) {
    auto s = __builtin_amdgcn_permlane16_swap(__float_as_uint(x), __float_as_uint(x), false, false);
    x = __uint_as_float(s[0]) + __uint_as_float(s[1]);
    auto t = __builtin_amdgcn_permlane32_swap(__float_as_uint(x), __float_as_uint(x), false, false);
    return __uint_as_float(t[0]) + __uint_as_float(t[1]);
}
__device__ __forceinline__ float wave_sum(float v) { return xrow16_sum(row16_sum(v)); }
__device__ __forceinline__ float wave_max(float v) {
#pragma unroll
    for (int o = 32; o; o >>= 1) v = fmaxf(v, __shfl_xor(v, o));
    return v;
}
__device__ __forceinline__ float sigmoidf_(float x) { return 1.f / (1.f + __expf(-x)); }
__device__ __forceinline__ float dot8(u32x4 a, u32x4 b, float s) {
#pragma unroll
    for (int i = 0; i < 4; ++i) { s += lo16(a[i]) * lo16(b[i]); s += hi16(a[i]) * hi16(b[i]); }
    return s;
}

#define LAS __attribute__((address_space(3)))
__host__ __device__ __forceinline__ int lds_byte(int r, int c) { const int st = (r >> 4) * 2 + (c >> 5), rr = r & 15, cc = c & 31, ob = rr * 64 + cc * 2; return st * 1024 + (ob ^ (((ob >> 9) & 1) << 5)); }
__host__ __device__ __forceinline__ void stage_rc(int b, int& R, int& C) { const int st = b / 1024, sb = b % 1024, swz = sb ^ (((sb >> 9) & 1) << 5); R = (st >> 1) * 16 + swz / 64; C = (st & 1) * 32 + (swz % 64) / 2; }
constexpr int HTB = 16384;
template <class F>
__device__ __forceinline__ void gemm_run(unsigned char* lds_, const bf16* A, const bf16* Bt, int Mm, int N, int K, const F& f, int bid, int nblk) {
    LAS unsigned char* lds = (LAS unsigned char*)lds_;
    const int tid = tidx(), wid = __builtin_amdgcn_readfirstlane(tid >> 6), lane = tid & 63, wr = wid >> 1, wc = wid & 1, fr = lane & 15, fq = lane >> 4;
    const int nt = K / 64, ntn = N / 128, nunits = (Mm / 256) * ntn;
    unsigned voff[2];
#pragma unroll
    for (int i = 0; i < 2; ++i) { int R, C; stage_rc(tid * 16 + i * 8192, R, C); voff[i] = (unsigned)(R * K + C) * 2u; }
    const unsigned ldsw = (unsigned)wid * 1024u;
    const int aoff = (wr >> 1) * HTB + lds_byte((wr & 1) * 64 + fr, fq * 8), boff = 2 * HTB + lds_byte(wc * 64 + fr, fq * 8);
#define G_STAGE(bufoff, gbase) do { _Pragma("unroll") for (int _i = 0; _i < 2; ++_i) \
        __builtin_amdgcn_global_load_lds((const unsigned*)((const char*)(gbase) + voff[_i]), (LAS unsigned*)(lds + (bufoff) + ldsw + _i * 8192), 16, 0, 0); } while (0)
    for (int u = bid; u < nunits; u += nblk) {
        const int pm = u % (Mm / 256), pn = u / (Mm / 256);
        const char* gA = (const char*)(A + (size_t)pm * 256 * K);
        const char* gB = (const char*)(Bt + (size_t)pn * 128 * K);
        const size_t hstep = (size_t)128 * K * 2;
        f32x4 acc[4][4];
#pragma unroll
        for (int a = 0; a < 4; ++a)
#pragma unroll
            for (int b = 0; b < 4; ++b) acc[a][b] = (f32x4){0.f, 0.f, 0.f, 0.f};
        G_STAGE(0, gA); G_STAGE(HTB, gA + hstep); G_STAGE(2 * HTB, gB);
        for (int t = 0; t < nt; ++t) {
            const int cur = (t & 1) * 3 * HTB, nxt = ((t + 1) & 1) * 3 * HTB;
            asm volatile("s_waitcnt vmcnt(0)" ::: "memory");
            __syncthreads();
            if (t + 1 < nt) { const size_t ko = (size_t)(t + 1) * 128; G_STAGE(nxt, gA + ko); G_STAGE(nxt + HTB, gA + hstep + ko); G_STAGE(nxt + 2 * HTB, gB + ko); }
            bf16x8 af[4][2], bfr[4][2];
#pragma unroll
            for (int m = 0; m < 4; ++m)
#pragma unroll
                for (int k = 0; k < 2; ++k) af[m][k] = *(const LAS bf16x8*)(lds + cur + aoff + m * 2048 + k * 1024);
#pragma unroll
            for (int n = 0; n < 4; ++n)
#pragma unroll
                for (int k = 0; k < 2; ++k) bfr[n][k] = *(const LAS bf16x8*)(lds + cur + boff + n * 2048 + k * 1024);
#pragma unroll
            for (int k = 0; k < 2; ++k)
#pragma unroll
                for (int m = 0; m < 4; ++m)
#pragma unroll
                    for (int n = 0; n < 4; ++n) acc[m][n] = __builtin_amdgcn_mfma_f32_16x16x32_bf16(bfr[n][k], af[m][k], acc[m][n], 0, 0, 0);
        }
#pragma unroll
        for (int m = 0; m < 4; ++m) {
            const int row = pm * 256 + wr * 64 + m * 16 + fr;
#pragma unroll
            for (int n = 0; n < 4; ++n) f(row, pn * 128 + wc * 64 + n * 16 + 4 * fq, acc[m][n]);
        }
        __syncthreads();
    }
#undef G_STAGE
}

__device__ __forceinline__ u32x2 pk4(f32x4 a) { u32x2 o; o.x = pk2(a[0], a[1]); o.y = pk2(a[2], a[3]); return o; }
struct EpiProj {
    bf16* proj; float* ba; const float* rstd;
    __device__ __forceinline__ void operator()(int row, int col, f32x4 v) const {
        v = v * rstd[row];
        if (col < PROJ_W) *(u32x2*)(proj + (size_t)row * PROJ_W + col) = pk4(v);
        else if (col < IN_COLS) *(f32x4*)(ba + (size_t)row * 8 + (col - PROJ_W)) = v;
    }
};
struct EpiRes {
    float* H; bf16* HB;
    __device__ __forceinline__ void operator()(int row, int col, f32x4 v) const {
        f32x4* hp = (f32x4*)(H + (size_t)row * D + col);
        const f32x4 h = *hp + v; *hp = h;
        *(u32x2*)(HB + (size_t)row * D + col) = pk4(h);
    }
};
struct EpiQ2 {
    bf16* Q2; const float* rstd;
    __device__ __forceinline__ void operator()(int row, int col, f32x4 v) const { *(u32x2*)(Q2 + (size_t)row * 2048 + col) = pk4(v * rstd[row]); }
};
struct EpiE {
    bf16* E;
    __device__ __forceinline__ void operator()(int row, int col, f32x4 v) const { *(u32x2*)(E + (size_t)row * D + col) = pk4(v); }
};
struct EpiPle {
    float* H; bf16* HB; const bf16* E; const float* rstde; const float* g;
    __device__ __forceinline__ void operator()(int row, int col, f32x4 v) const {
        f32x4* hp = (f32x4*)(H + (size_t)row * D + col);
        const u32x2 ev = *(const u32x2*)(E + (size_t)row * D + col);
        const f32x4 gv = *(const f32x4*)(g + col);
        const float r = rstde[row];
        f32x4 h = *hp;
        h[0] += sigmoidf_(v[0]) * (lo16(ev.x) * r * gv[0]); h[1] += sigmoidf_(v[1]) * (hi16(ev.x) * r * gv[1]);
        h[2] += sigmoidf_(v[2]) * (lo16(ev.y) * r * gv[2]); h[3] += sigmoidf_(v[3]) * (hi16(ev.y) * r * gv[3]);
        *hp = h;
        *(u32x2*)(HB + (size_t)row * D + col) = pk4(h);
    }
};

__device__ __forceinline__ void transpose_item(const float* W, int K, int N, int Npad, bf16* WT, const float* rowscale, int qcols, float* scr, int item, int lane) {
    const int nblk = Npad / 32, kb = item / nblk, nb = item % nblk, k0 = 64 * kb, n0 = 32 * nb;
    const int n = n0 + (lane & 31);
#pragma unroll 8
    for (int i = 0; i < 32; ++i) {
        const int kk = 2 * i + (lane >> 5);
        float v = (n < N) ? W[(size_t)(k0 + kk) * N + n] : 0.f;
        if (rowscale) v *= rowscale[k0 + kk];
        if (n < qcols) v *= QSCALE;
        scr[kk * 33 + (lane & 31)] = v;
    }
    asm volatile("s_waitcnt lgkmcnt(0)" ::: "memory");
    const int c = lane & 7;
#pragma unroll
    for (int j = 0; j < 4; ++j) {
        const int nn = (lane >> 3) + 8 * j; const float* s = scr + (8 * c) * 33 + nn;
        u32x4 o; o.x = pk2(s[0 * 33], s[1 * 33]); o.y = pk2(s[2 * 33], s[3 * 33]); o.z = pk2(s[4 * 33], s[5 * 33]); o.w = pk2(s[6 * 33], s[7 * 33]);
        *(u32x4*)(WT + (size_t)(n0 + nn) * K + k0 + 8 * c) = o;
    }
    asm volatile("s_waitcnt lgkmcnt(0)" ::: "memory");
}
__device__ __forceinline__ void convert_bulk(const float* src, bf16* dst, size_t n, size_t gtid, size_t nthr) {
    for (size_t i = gtid * 8; i < n; i += nthr * 8) {
        const f32x4 a = *(const f32x4*)(src + i), b = *(const f32x4*)(src + i + 4);
        u32x4 o; o.x = pk2(a[0], a[1]); o.y = pk2(a[2], a[3]); o.z = pk2(b[0], b[1]); o.w = pk2(b[2], b[3]);
        *(u32x4*)(dst + i) = o;
    }
}
__device__ void phase_prologue(const Params& p, unsigned char* lds, int bid, int nblk) {
    const int tid = tidx(), lane = tid & 63, w = tid >> 6;
    const int gw = bid * NWAVES + w, NGW = nblk * NWAVES;
    float* scr = (float*)(lds + w * 16384);
    constexpr int I_IN = 16 * (IN_PAD / 32), I_OUT = 16 * 32, I_Q = 16 * 64, I_G = 16 * 32, I_P = 4 * 32, I_L = I_IN + I_OUT + I_Q + I_G + I_P;
    for (int it = gw; it < DEPTH * I_L; it += NGW) {
        const int L = it / I_L; int r = it % I_L;
        if (r < I_IN) { transpose_item(p.w_in + (size_t)L * D * IN_COLS, D, IN_COLS, IN_PAD, (bf16*)(p.ws + WS_WIN) + (size_t)L * IN_PAD * D, p.ln_mix_g + L * D, 512, scr, r, lane); continue; } r -= I_IN;
        if (r < I_OUT) { transpose_item(p.w_out + (size_t)L * D * D, D, D, D, (bf16*)(p.ws + WS_WOUT) + (size_t)L * D * D, nullptr, 0, scr, r, lane); continue; } r -= I_OUT;
        if (r < I_Q) { transpose_item(p.peer_wq + (size_t)L * D * 2048, D, 2048, 2048, (bf16*)(p.ws + WS_WQ) + (size_t)L * 2048 * D, p.ln_ffn_g + L * D, 0, scr, r, lane); continue; } r -= I_Q;
        if (r < I_G) { transpose_item(p.ple_wg + (size_t)L * D * D, D, D, D, (bf16*)(p.ws + WS_WG) + (size_t)L * D * D, nullptr, 0, scr, r, lane); continue; } r -= I_G;
        transpose_item(p.ple_wp + (size_t)L * 256 * D, 256, D, D, (bf16*)(p.ws + WS_WP) + (size_t)L * D * 256, nullptr, 0, scr, r, lane);
    }
    const size_t gtid = (size_t)bid * NTHREADS + tid, nthr = (size_t)nblk * NTHREADS;
    for (int r = gw; r < 2 * DEPTH * NEXP; r += NGW) {
        const int which = r >= DEPTH * NEXP, rr = which ? r - DEPTH * NEXP : r;
        const float* srow = (which ? p.peer_v : p.peer_u) + (size_t)rr * D + 16 * lane;
        f32x4 v[4];
#pragma unroll
        for (int j = 0; j < 4; ++j) v[j] = *(const f32x4*)(srow + 4 * j);
        float mx = 0.f;
#pragma unroll
        for (int j = 0; j < 4; ++j) mx = fmaxf(mx, fmaxf(fmaxf(fabsf(v[j][0]), fabsf(v[j][1])), fmaxf(fabsf(v[j][2]), fabsf(v[j][3]))));
        mx = xrow16_max(row16_max(mx));
        const float inv = mx > 0.f ? 127.f / mx : 0.f;
        u32x4 o;
#pragma unroll
        for (int j = 0; j < 4; ++j) {
            const unsigned b0 = (unsigned)(__float2int_rn(v[j][0] * inv) + 128), b1 = (unsigned)(__float2int_rn(v[j][1] * inv) + 128), b2 = (unsigned)(__float2int_rn(v[j][2] * inv) + 128), b3 = (unsigned)(__float2int_rn(v[j][3] * inv) + 128);
            o[j] = b0 | (b1 << 8) | (b2 << 16) | (b3 << 24);
        }
        *(u32x4*)(p.ws + (which ? WS_V : WS_U) + (size_t)rr * D + 16 * lane) = o;
        if (lane == 0) ((float*)(p.ws + (which ? WS_SV : WS_SU)))[rr] = mx * (1.f / 127.f);
    }
    convert_bulk(p.p, (bf16*)(p.ws + WS_PB), (size_t)DEPTH * M * 256, gtid, nthr);
    convert_bulk(p.subkeys, (bf16*)(p.ws + WS_SK), (size_t)DEPTH * 8 * 2 * 128 * 128, gtid, nthr);
    float* H = (float*)(p.ws + WS_H); bf16* HB0 = (bf16*)(p.ws + WS_HB0); float* rstd0 = (float*)(p.ws + WS_STAT);
    for (int m = gw; m < M; m += NGW) {
        const f32x4* xr = (const f32x4*)(p.x + (size_t)m * D) + lane;
        float ss = 0.f;
#pragma unroll
        for (int j = 0; j < 4; ++j) {
            const f32x4 v = xr[64 * j];
            ss += v[0] * v[0] + v[1] * v[1] + v[2] * v[2] + v[3] * v[3];
            ((f32x4*)(H + (size_t)m * D))[lane + 64 * j] = v;
            u32x2 o; o.x = pk2(v[0], v[1]); o.y = pk2(v[2], v[3]);
            ((u32x2*)(HB0 + (size_t)m * D))[lane + 64 * j] = o;
        }
        ss = wave_sum(ss);
        if (lane == 0) rstd0[m] = rsqrtf(ss * (1.f / D) + EPS);
    }
}

__device__ void phase_rowstat_f32(const float* src, float* rstd, int bid, int nblk) {
    const int tid = tidx(), lane = tid & 63, gw = bid * NWAVES + (tid >> 6), NGW = nblk * NWAVES;
    for (int m = gw; m < M; m += NGW) {
        const f32x4* xr = (const f32x4*)(src + (size_t)m * D) + lane;
        float ss = 0.f;
#pragma unroll
        for (int j = 0; j < 4; ++j) { const f32x4 v = xr[64 * j]; ss += v[0] * v[0] + v[1] * v[1] + v[2] * v[2] + v[3] * v[3]; }
        ss = wave_sum(ss);
        if (lane == 0) rstd[m] = rsqrtf(ss * (1.f / D) + EPS);
    }
}
__device__ void phase_rowstat_bf16(const bf16* src, float* rstd, int bid, int nblk) {
    const int tid = tidx(), lane = tid & 63, gw = bid * NWAVES + (tid >> 6), NGW = nblk * NWAVES;
    for (int m = gw; m < M; m += NGW) {
        const u32x4* xr = (const u32x4*)(src + (size_t)m * D) + lane;
        float ss = 0.f;
#pragma unroll
        for (int j = 0; j < 2; ++j) { const u32x4 v = xr[64 * j];
#pragma unroll
            for (int i = 0; i < 4; ++i) { const float a = lo16(v[i]), b = hi16(v[i]); ss += a * a + b * b; } }
        ss = wave_sum(ss);
        if (lane == 0) rstd[m] = rsqrtf(ss * (1.f / D) + EPS);
    }
}

typedef short v4i16_t __attribute__((ext_vector_type(4)));
typedef __bf16 bf16x2_t __attribute__((ext_vector_type(2)));
typedef float f32x2_t __attribute__((ext_vector_type(2)));
__device__ __forceinline__ unsigned cvtpk(float lo, float hi) { f32x2_t v = {lo, hi}; bf16x2_t b = __builtin_convertvector(v, bf16x2_t); return __builtin_bit_cast(unsigned, b); }
constexpr int ATT_VOFF = 16384, ATT_VPITCH = 288;
__device__ void phase_att_mfma(const Params& p, int L, unsigned char* lds_, int bid, int nblk) {
    LAS unsigned char* lds = (LAS unsigned char*)lds_;
    const int tid = tidx(), lane = tid & 63, w = __builtin_amdgcn_readfirstlane(tid >> 6), fr = lane & 15, fq = lane >> 4;
    const bf16* proj = (const bf16*)(p.ws + WS_PROJ);
    bf16* obuf = (bf16*)(p.ws + WS_OBUF);
    const float* lp = p.diff_lambda + L * 256;
    const float d1 = wave_sum(lp[lane] * lp[64 + lane]), d2 = wave_sum(lp[128 + lane] * lp[192 + lane]);
    const float lam_init = 0.8f - 0.6f * expf(-0.3f * (float)L);
    const float lam = expf(d1) - expf(d2) + lam_init;
    for (int item = bid; item < 256; item += nblk) {
        const int bh = item >> 3, jj = item & 7, b = bh >> 2, hh = bh & 3;
        const float slope2 = exp2f(-2.f * (float)(hh + 1)) * 1.4426950408889634f;
        const bf16* kbase = proj + (size_t)b * SEQ * PROJ_W + 512 + hh * 128;
        const bf16* vbase = proj + (size_t)b * SEQ * PROJ_W + 1024 + hh * 128;
        for (int half = 0; half < 2; ++half) {
            const int qb = half == 0 ? 15 - jj : jj;
            const int qw0 = qb * 128 + w * 16, T = 2 * (qb + 1);
            bf16x8 qf[2][2];
#pragma unroll
            for (int mp = 0; mp < 2; ++mp)
#pragma unroll
                for (int ks = 0; ks < 2; ++ks) qf[mp][ks] = *(const bf16x8*)(proj + ((size_t)b * SEQ + qw0 + fr) * PROJ_W + hh * 128 + mp * 64 + ks * 32 + 8 * fq);
            f32x4 o[2][8];
#pragma unroll
            for (int mp = 0; mp < 2; ++mp)
#pragma unroll
                for (int dt = 0; dt < 8; ++dt) o[mp][dt] = (f32x4){0.f, 0.f, 0.f, 0.f};
            float mrun[2] = {-INFINITY, -INFINITY}, lrun[2] = {0.f, 0.f};
            u32x4 kreg[2], vreg[2];
#pragma unroll
            for (int i = 0; i < 2; ++i) { const int c = tid + 512 * i, key = c >> 4, ch = c & 15;
                kreg[i] = *(const u32x4*)(kbase + (size_t)key * PROJ_W + ch * 8); vreg[i] = *(const u32x4*)(vbase + (size_t)key * PROJ_W + ch * 8); }
            for (int t = 0; t < T; ++t) {
                const int k0 = t * 64;
#pragma unroll
                for (int i = 0; i < 2; ++i) { const int c = tid + 512 * i, key = c >> 4, ch = c & 15;
                    *(LAS u32x4*)(lds + key * 256 + ((ch ^ (key & 15)) << 4)) = kreg[i];
                    *(LAS u32x4*)(lds + ATT_VOFF + key * ATT_VPITCH + ch * 16) = vreg[i]; }
                LDS_BARRIER();
                if (t + 1 < T) {
#pragma unroll
                    for (int i = 0; i < 2; ++i) { const int c = tid + 512 * i, key = k0 + 64 + (c >> 4), ch = c & 15;
                        kreg[i] = *(const u32x4*)(kbase + (size_t)key * PROJ_W + ch * 8); vreg[i] = *(const u32x4*)(vbase + (size_t)key * PROJ_W + ch * 8); }
                }
                if (k0 <= qw0 + 15) {
                    f32x4 s[2][4];
                    const float base = -slope2 * (float)(qw0 + fr - k0 - 4 * fq);
#pragma unroll
                    for (int kt = 0; kt < 4; ++kt)
#pragma unroll
                        for (int r = 0; r < 4; ++r) { const float v = base + slope2 * (float)(16 * kt + r); s[0][kt][r] = v; s[1][kt][r] = v; }
#pragma unroll
                    for (int mp = 0; mp < 2; ++mp)
#pragma unroll
                        for (int kt = 0; kt < 4; ++kt)
#pragma unroll
                            for (int ks = 0; ks < 2; ++ks) {
                                const bf16x8 kf = *(const LAS bf16x8*)(lds + (16 * kt + fr) * 256 + (((mp * 8 + ks * 4 + fq) ^ fr) << 4));
                                s[mp][kt] = __builtin_amdgcn_mfma_f32_16x16x32_bf16(kf, qf[mp][ks], s[mp][kt], 0, 0, 0);
                            }
                    if (k0 + 63 > qw0) {
                        const int lim = qw0 + fr - k0 - 4 * fq;
#pragma unroll
                        for (int mp = 0; mp < 2; ++mp)
#pragma unroll
                            for (int kt = 0; kt < 4; ++kt)
#pragma unroll
                                for (int r = 0; r < 4; ++r) if (16 * kt + r > lim) s[mp][kt][r] = -INFINITY;
                    }
                    bf16x8 pb[2][2];
#pragma unroll
                    for (int mp = 0; mp < 2; ++mp) {
                        float mx = fmaxf(fmaxf(s[mp][0][0], s[mp][0][1]), fmaxf(s[mp][0][2], s[mp][0][3]));
#pragma unroll
                        for (int kt = 1; kt < 4; ++kt) mx = fmaxf(mx, fmaxf(fmaxf(s[mp][kt][0], s[mp][kt][1]), fmaxf(s[mp][kt][2], s[mp][kt][3])));
                        mx = xrow16_max(mx);
                        const float mnew = fmaxf(mrun[mp], mx);
                        const float alpha = __builtin_amdgcn_exp2f(mrun[mp] - mnew);
                        mrun[mp] = mnew;
                        float ps = 0.f;
#pragma unroll
                        for (int kt = 0; kt < 4; ++kt)
#pragma unroll
                            for (int r = 0; r < 4; ++r) { const float e = __builtin_amdgcn_exp2f(s[mp][kt][r] - mnew); s[mp][kt][r] = e; ps += e; }
                        lrun[mp] = lrun[mp] * alpha + ps;
#pragma unroll
                        for (int dt = 0; dt < 8; ++dt) o[mp][dt] = o[mp][dt] * alpha;
#pragma unroll
                        for (int ks = 0; ks < 2; ++ks) {
                            u32x4 pk; pk.x = cvtpk(s[mp][2 * ks][0], s[mp][2 * ks][1]); pk.y = cvtpk(s[mp][2 * ks][2], s[mp][2 * ks][3]);
                            pk.z = cvtpk(s[mp][2 * ks + 1][0], s[mp][2 * ks + 1][1]); pk.w = cvtpk(s[mp][2 * ks + 1][2], s[mp][2 * ks + 1][3]);
                            pb[mp][ks] = __builtin_bit_cast(bf16x8, pk);
                        }
                    }
                    const int gl = lane & 15;
                    LAS unsigned char* vrd = lds + ATT_VOFF + (4 * fq + (gl >> 2)) * ATT_VPITCH + (gl & 3) * 8;
#pragma unroll
                    for (int dt = 0; dt < 8; ++dt)
#pragma unroll
                        for (int ks = 0; ks < 2; ++ks) {
                            const v4i16_t v0 = __builtin_amdgcn_ds_read_tr16_b64_v4i16((LAS v4i16_t*)(vrd + (32 * ks) * ATT_VPITCH + dt * 32));
                            const v4i16_t v1 = __builtin_amdgcn_ds_read_tr16_b64_v4i16((LAS v4i16_t*)(vrd + (32 * ks + 16) * ATT_VPITCH + dt * 32));
                            bf16x8 vf; vf[0] = v0[0]; vf[1] = v0[1]; vf[2] = v0[2]; vf[3] = v0[3]; vf[4] = v1[0]; vf[5] = v1[1]; vf[6] = v1[2]; vf[7] = v1[3];
                            o[0][dt] = __builtin_amdgcn_mfma_f32_16x16x32_bf16(vf, pb[0][ks], o[0][dt], 0, 0, 0);
                            o[1][dt] = __builtin_amdgcn_mfma_f32_16x16x32_bf16(vf, pb[1][ks], o[1][dt], 0, 0, 0);
                        }
                }
                LDS_BARRIER();
            }
            const float i1 = 1.f / xrow16_sum(lrun[0]), i2 = lam / xrow16_sum(lrun[1]);
            float ss = 0.f;
#pragma unroll
            for (int dt = 0; dt < 8; ++dt)
#pragma unroll
                for (int r = 0; r < 4; ++r) { const float v = o[0][dt][r] * i1 - o[1][dt][r] * i2; o[0][dt][r] = v; ss += v * v; }
            ss = xrow16_sum(ss);
            const float rn = rsqrtf(ss * (1.f / 128.f) + EPS) * (1.f - lam_init);
            const float* g = p.subln_g + L * 128;
            bf16* orow = obuf + ((size_t)b * SEQ + qw0 + fr) * D + hh * 128;
#pragma unroll
            for (int dt = 0; dt < 8; ++dt) {
                const f32x4 gv = *(const f32x4*)(g + 16 * dt + 4 * fq);
                u32x2 ov; ov.x = pk2(o[0][dt][0] * rn * gv[0], o[0][dt][1] * rn * gv[1]); ov.y = pk2(o[0][dt][2] * rn * gv[2], o[0][dt][3] * rn * gv[3]);
                *(u32x2*)(orow + 16 * dt + 4 * fq) = ov;
            }
        }
    }
}

constexpr size_t GD_WP = WS_ORAW, GD_QD = WS_ORAW + 16 * MiB, GD_AIP = WS_ORAW + 32 * MiB, GD_KDT = WS_ORAW + 40 * MiB, GD_UT = WS_ORAW + 56 * MiB, GD_GL = WS_ORAW + 72 * MiB;
__device__ __forceinline__ int perm_pos(int k) { return (k & ~31) + 8 * ((k >> 2) & 3) + 4 * ((k >> 4) & 1) + (k & 3); }
__device__ __forceinline__ float softplusf_(float x) { return x > 20.f ? x : log1pf(expf(x)); }

constexpr int GP_KN = 0, GP_QN = 17408, GP_RT = 34816, GP_LM = 71680, GP_TB = 89088, GP_GT = 98304;
constexpr int GP_KP = 272, GP_RP = 144, GP_LP = 68, GP_TP = 144;
__device__ void phase_gdn_prep(const Params& p, int L, unsigned char* lds_, int bid, int nblk) {
    LAS unsigned char* lds = (LAS unsigned char*)lds_;
    const int tid = tidx(), lane = tid & 63, w = __builtin_amdgcn_readfirstlane(tid >> 6), fr = lane & 15, fq = lane >> 4;
    const bf16* proj = (const bf16*)(p.ws + WS_PROJ);
    const float* BA = (const float*)(p.ws + WS_BA);
    bf16* WP = (bf16*)(p.ws + GD_WP); bf16* QD = (bf16*)(p.ws + GD_QD); bf16* AIP = (bf16*)(p.ws + GD_AIP); bf16* KDT = (bf16*)(p.ws + GD_KDT); bf16* UT = (bf16*)(p.ws + GD_UT);
    float* GL = (float*)(p.ws + GD_GL);
    const float* cw = p.conv_w + (size_t)L * 4 * 1536;
    LAS float* beta_s = (LAS float*)(lds + GP_GT); LAS float* gc_s = beta_s + 64; LAS float* egc_s = gc_s + 64; LAS float* edl_s = egc_s + 64;
    LAS float* Lm = (LAS float*)(lds + GP_LM);
    for (int item = bid; item < 1024; item += nblk) {
        const int n = item & 31, bh = item >> 5, hh = bh & 3, b = bh >> 2, t0 = n * 64;
        const size_t row0 = (size_t)b * SEQ + t0;
        __syncthreads();
        if (w == 0) {
            const float negA = -expf(p.a_log[L * 4 + hh]), dtb = p.dt_bias[L * 4 + hh];
            const float bb = BA[(row0 + lane) * 8 + hh], aa = BA[(row0 + lane) * 8 + 4 + hh] + dtb;
            float c = negA * softplusf_(aa);
#pragma unroll
            for (int o = 1; o < 64; o <<= 1) { const float t = __shfl_up(c, o); if (lane >= o) c += t; }
            const float glast = __shfl(c, 63);
            beta_s[lane] = sigmoidf_(bb); gc_s[lane] = c; egc_s[lane] = expf(c); edl_s[lane] = expf(glast - c);
            if (lane == 0) GL[item] = expf(glast);
        }
        __syncthreads();
        {
            const int colq = hh * 128 + 2 * lane;
            {
                float wq[4][2]; unsigned xq[11];
#pragma unroll
                for (int j = 0; j < 4; ++j) { wq[j][0] = cw[j * 1536 + colq]; wq[j][1] = cw[j * 1536 + colq + 1]; }
#pragma unroll
                for (int r = 0; r < 11; ++r) { const int tt = t0 + 8 * w - 3 + r; xq[r] = (tt >= 0) ? *(const unsigned*)(proj + ((size_t)b * SEQ + tt) * PROJ_W + 1536 + colq) : 0u; }
#pragma unroll
                for (int i = 0; i < 8; ++i) {
                    const int c = 8 * w + i;
                    float q0 = 0.f, q1 = 0.f;
#pragma unroll
                    for (int j = 0; j < 4; ++j) { q0 += wq[j][0] * lo16(xq[i + j]); q1 += wq[j][1] * hi16(xq[i + j]); }
                    q0 *= sigmoidf_(q0); q1 *= sigmoidf_(q1);
                    const float sq = rsqrtf(wave_sum(q0 * q0 + q1 * q1) + EPS) * 0.08838834764831845f;
                    q0 *= sq; q1 *= sq;
                    const float eg = egc_s[c];
                    *(LAS unsigned*)(lds + GP_QN + c * GP_KP + lane * 4) = pk2(q0, q1);
                    *(unsigned*)(QD + ((size_t)item * 64 + c) * 128 + perm_pos(2 * lane)) = pk2(q0 * eg, q1 * eg);
                }
            }
            __builtin_amdgcn_sched_barrier(0);
            {
                float wk[4][2]; unsigned xk[11];
#pragma unroll
                for (int j = 0; j < 4; ++j) { wk[j][0] = cw[j * 1536 + 512 + colq]; wk[j][1] = cw[j * 1536 + 512 + colq + 1]; }
#pragma unroll
                for (int r = 0; r < 11; ++r) { const int tt = t0 + 8 * w - 3 + r; xk[r] = (tt >= 0) ? *(const unsigned*)(proj + ((size_t)b * SEQ + tt) * PROJ_W + 1536 + 512 + colq) : 0u; }
                unsigned kd0[8], kd1[8], rk0[8], rk1[8];
#pragma unroll
                for (int i = 0; i < 8; ++i) {
                    const int c = 8 * w + i;
                    float k0 = 0.f, k1 = 0.f;
#pragma unroll
                    for (int j = 0; j < 4; ++j) { k0 += wk[j][0] * lo16(xk[i + j]); k1 += wk[j][1] * hi16(xk[i + j]); }
                    k0 *= sigmoidf_(k0); k1 *= sigmoidf_(k1);
                    const float sk = rsqrtf(wave_sum(k0 * k0 + k1 * k1) + EPS);
                    k0 *= sk; k1 *= sk;
                    const float be = beta_s[c], eg = egc_s[c], ed = edl_s[c];
                    *(LAS unsigned*)(lds + GP_KN + c * GP_KP + lane * 4) = pk2(k0, k1);
                    kd0[i] = f2bf(k0 * ed); kd1[i] = f2bf(k1 * ed);
                    rk0[i] = f2bf(k0 * be * eg); rk1[i] = f2bf(k1 * be * eg);
                }
                u32x4 o;
                o.x = rk0[0] | (rk0[1] << 16); o.y = rk0[2] | (rk0[3] << 16); o.z = rk0[4] | (rk0[5] << 16); o.w = rk0[6] | (rk0[7] << 16); *(LAS u32x4*)(lds + GP_RT + (128 + 2 * lane) * GP_RP + 16 * w) = o;
                o.x = rk1[0] | (rk1[1] << 16); o.y = rk1[2] | (rk1[3] << 16); o.z = rk1[4] | (rk1[5] << 16); o.w = rk1[6] | (rk1[7] << 16); *(LAS u32x4*)(lds + GP_RT + (128 + 2 * lane + 1) * GP_RP + 16 * w) = o;
                const int pa = perm_pos(8 * w), pb = perm_pos(8 * w + 4);
                bf16* kr0 = KDT + ((size_t)item * 128 + 2 * lane) * 64; bf16* kr1 = kr0 + 64;
                u32x2 h2;
                h2.x = kd0[0] | (kd0[1] << 16); h2.y = kd0[2] | (kd0[3] << 16); *(u32x2*)(kr0 + pa) = h2;
                h2.x = kd0[4] | (kd0[5] << 16); h2.y = kd0[6] | (kd0[7] << 16); *(u32x2*)(kr0 + pb) = h2;
                h2.x = kd1[0] | (kd1[1] << 16); h2.y = kd1[2] | (kd1[3] << 16); *(u32x2*)(kr1 + pa) = h2;
                h2.x = kd1[4] | (kd1[5] << 16); h2.y = kd1[6] | (kd1[7] << 16); *(u32x2*)(kr1 + pb) = h2;
            }
            __builtin_amdgcn_sched_barrier(0);
            {
                float wv[4][2]; unsigned xv[11];
#pragma unroll
                for (int j = 0; j < 4; ++j) { wv[j][0] = cw[j * 1536 + 1024 + colq]; wv[j][1] = cw[j * 1536 + 1024 + colq + 1]; }
#pragma unroll
                for (int r = 0; r < 11; ++r) { const int tt = t0 + 8 * w - 3 + r; xv[r] = (tt >= 0) ? *(const unsigned*)(proj + ((size_t)b * SEQ + tt) * PROJ_W + 1536 + 1024 + colq) : 0u; }
                unsigned rv0[8], rv1[8];
#pragma unroll
                for (int i = 0; i < 8; ++i) {
                    float v0 = 0.f, v1 = 0.f;
#pragma unroll
                    for (int j = 0; j < 4; ++j) { v0 += wv[j][0] * lo16(xv[i + j]); v1 += wv[j][1] * hi16(xv[i + j]); }
                    v0 *= sigmoidf_(v0); v1 *= sigmoidf_(v1);
                    const float be = beta_s[8 * w + i];
                    rv0[i] = f2bf(v0 * be); rv1[i] = f2bf(v1 * be);
                }
                u32x4 o;
                o.x = rv0[0] | (rv0[1] << 16); o.y = rv0[2] | (rv0[3] << 16); o.z = rv0[4] | (rv0[5] << 16); o.w = rv0[6] | (rv0[7] << 16); *(LAS u32x4*)(lds + GP_RT + (2 * lane) * GP_RP + 16 * w) = o;
                o.x = rv1[0] | (rv1[1] << 16); o.y = rv1[2] | (rv1[3] << 16); o.z = rv1[4] | (rv1[5] << 16); o.w = rv1[6] | (rv1[7] << 16); *(LAS u32x4*)(lds + GP_RT + (2 * lane + 1) * GP_RP + 16 * w) = o;
            }
        }
        __syncthreads();
#pragma unroll
        for (int q = 0; q < 2; ++q) {
            const int id = 2 * w + q, ct = id >> 2, st = id & 3;
            if (st <= ct) {
                f32x4 acc = (f32x4){0.f, 0.f, 0.f, 0.f};
#pragma unroll
                for (int ks = 0; ks < 4; ++ks) {
                    const bf16x8 a = *(const LAS bf16x8*)(lds + GP_KN + (16 * ct + fr) * GP_KP + (32 * ks + 8 * fq) * 2);
                    const bf16x8 bb = *(const LAS bf16x8*)(lds + GP_KN + (16 * st + fr) * GP_KP + (32 * ks + 8 * fq) * 2);
                    acc = __builtin_amdgcn_mfma_f32_16x16x32_bf16(a, bb, acc, 0, 0, 0);
                }
                const int s = 16 * st + fr; const float gs = gc_s[s];
#pragma unroll
                for (int r = 0; r < 4; ++r) { const int c = 16 * ct + 4 * fq + r;
                    Lm[c * GP_LP + s] = (s < c) ? beta_s[c] * acc[r] * expf(fminf(gc_s[c] - gs, 0.f)) : 0.f; }
            }
        }
        __syncthreads();
        if (w == 0) {
            float t[64];
            int zoff = 0; asm volatile("" : "+v"(zoff));
            const LAS float* Lz = Lm + zoff;
#pragma unroll
            for (int i = 0; i < 64; ++i) {
                float a0 = (i == lane) ? 1.f : 0.f, a1 = 0.f, a2 = 0.f, a3 = 0.f;
#pragma unroll
                for (int s4 = 0; s4 + 4 <= i; s4 += 4) { const f32x4 lv = *(const LAS f32x4*)(Lz + i * GP_LP + s4);
                    a0 -= lv[0] * t[s4]; a1 -= lv[1] * t[s4 + 1]; a2 -= lv[2] * t[s4 + 2]; a3 -= lv[3] * t[s4 + 3]; }
#pragma unroll
                for (int s = i & ~3; s < i; ++s) a0 -= Lz[i * GP_LP + s] * t[s];
                t[i] = (a0 + a1) + (a2 + a3);
                *(LAS bf16*)(lds + GP_TB + i * GP_TP + lane * 2) = (bf16)f2bf(t[i]);
                if ((i & 3) == 3) __builtin_amdgcn_sched_barrier(0);
            }
        } else {
            for (int id = w - 1; id < 16; id += 7) {
                const int ct = id >> 2, st = id & 3;
                f32x4 acc = (f32x4){0.f, 0.f, 0.f, 0.f};
                if (st <= ct) {
#pragma unroll
                    for (int ks = 0; ks < 4; ++ks) {
                        const bf16x8 a = *(const LAS bf16x8*)(lds + GP_QN + (16 * ct + fr) * GP_KP + (32 * ks + 8 * fq) * 2);
                        const bf16x8 bb = *(const LAS bf16x8*)(lds + GP_KN + (16 * st + fr) * GP_KP + (32 * ks + 8 * fq) * 2);
                        acc = __builtin_amdgcn_mfma_f32_16x16x32_bf16(a, bb, acc, 0, 0, 0);
                    }
                }
                const int s = 16 * st + fr; const float gs = gc_s[s]; const int ps = perm_pos(s);
#pragma unroll
                for (int r = 0; r < 4; ++r) { const int c = 16 * ct + 4 * fq + r;
                    const float v = (s <= c) ? acc[r] * expf(fminf(gc_s[c] - gs, 0.f)) : 0.f;
                    AIP[((size_t)item * 64 + c) * 64 + ps] = (bf16)f2bf(v); }
            }
        }
        __syncthreads();
#pragma unroll
        for (int q = 0; q < 2; ++q) {
            const int colt = 2 * w + q;
            bf16x8 af[2];
#pragma unroll
            for (int ks = 0; ks < 2; ++ks) af[ks] = *(const LAS bf16x8*)(lds + GP_RT + (16 * colt + fr) * GP_RP + (32 * ks + 8 * fq) * 2);
#pragma unroll
            for (int ct = 0; ct < 4; ++ct) {
                f32x4 acc = (f32x4){0.f, 0.f, 0.f, 0.f};
#pragma unroll
                for (int ks = 0; ks < 2; ++ks) {
                    const bf16x8 bb = *(const LAS bf16x8*)(lds + GP_TB + (16 * ct + fr) * GP_TP + (32 * ks + 8 * fq) * 2);
                    acc = __builtin_amdgcn_mfma_f32_16x16x32_bf16(af[ks], bb, acc, 0, 0, 0);
                }
                const int c = 16 * ct + fr;
                if (colt < 8) {
#pragma unroll
                    for (int r = 0; r < 4; ++r) UT[((size_t)item * 128 + 16 * colt + 4 * fq + r) * 64 + c] = (bf16)f2bf(acc[r]);
                } else {
                    const int kt = colt - 8;
                    u32x2 h2; h2.x = pk2(-acc[0], -acc[1]); h2.y = pk2(-acc[2], -acc[3]);
                    *(u32x2*)(WP + ((size_t)item * 64 + c) * 128 + 32 * (kt >> 1) + 8 * fq + 4 * (kt & 1)) = h2;
                }
            }
        }
    }
    __syncthreads();
}

constexpr int GS_WP = 0, GS_QD = 17408, GS_AIP = 34816, GS_KDT = 44032, GS_BUF = 62464, GS_SSX = 2 * GS_BUF;
__device__ void phase_gdn_scan(const Params& p, int L, unsigned char* lds_, int bid, int nblk) {
    LAS unsigned char* lds = (LAS unsigned char*)lds_;
    const int tid = tidx(), lane = tid & 63, w = __builtin_amdgcn_readfirstlane(tid >> 6), fr = lane & 15, fq = lane >> 4;
    const bf16* proj = (const bf16*)(p.ws + WS_PROJ);
    const bf16* WP = (const bf16*)(p.ws + GD_WP); const bf16* QD = (const bf16*)(p.ws + GD_QD); const bf16* AIP = (const bf16*)(p.ws + GD_AIP);
    const bf16* KDT = (const bf16*)(p.ws + GD_KDT); const bf16* UT = (const bf16*)(p.ws + GD_UT); const float* GL = (const float*)(p.ws + GD_GL);
    bf16* obuf = (bf16*)(p.ws + WS_OBUF);
    LAS float* ssx = (LAS float*)(lds + GS_SSX);
    for (int item = bid; item < 32; item += nblk) {
        const int hh = item & 3, b = item >> 2;
        const float gn = p.gdn_norm_g[L * 128 + 16 * w + fr];
        f32x4 S[8];
#pragma unroll
        for (int kt = 0; kt < 8; ++kt) S[kt] = (f32x4){0.f, 0.f, 0.f, 0.f};
        f32x4 oprev[4];
#pragma unroll
        for (int ct = 0; ct < 4; ++ct) oprev[ct] = (f32x4){0.f, 0.f, 0.f, 0.f};
        u32x4 st[7];
        auto gload = [&](int ci) {
#pragma unroll
            for (int i = 0; i < 7; ++i) {
                const int pc = tid + 512 * i;
                const bf16* src;
                if (i < 2) src = WP + (size_t)ci * 8192 + pc * 8;
                else if (i < 4) src = QD + (size_t)ci * 8192 + (pc - 1024) * 8;
                else if (i < 5) src = AIP + (size_t)ci * 4096 + (pc - 2048) * 8;
                else src = KDT + (size_t)ci * 8192 + (pc - 2560) * 8;
                st[i] = *(const u32x4*)src;
            }
        };
        auto lstore = [&](int buf) {
#pragma unroll
            for (int i = 0; i < 7; ++i) {
                const int pc = tid + 512 * i;
                int off;
                if (i < 2) off = GS_WP + (pc >> 4) * 272 + (pc & 15) * 16;
                else if (i < 4) { const int q = pc - 1024; off = GS_QD + (q >> 4) * 272 + (q & 15) * 16; }
                else if (i < 5) { const int q = pc - 2048; off = GS_AIP + (q >> 3) * 144 + (q & 7) * 16; }
                else { const int q = pc - 2560; off = GS_KDT + (q >> 3) * 144 + (q & 7) * 16; }
                *(LAS u32x4*)(lds + buf * GS_BUF + off) = st[i];
            }
        };
        __syncthreads();
        gload(item * 32); lstore(0);
        u32x2 ut[4]; float gl;
        {
            const int ci = item * 32;
#pragma unroll
            for (int ct = 0; ct < 4; ++ct) ut[ct] = *(const u32x2*)(UT + ((size_t)ci * 128 + 16 * w + fr) * 64 + 16 * ct + 4 * fq);
            gl = GL[ci];
        }
        unsigned zr[8];
        __syncthreads();
        for (int n = 0; n <= 32; ++n) {
            const int ci = item * 32 + n, buf = n & 1;
            f32x4 oacc[4];
            u32x2 utn[4]; float gln = 0.f;
            unsigned zn[8];
            if (n < 32) {
                if (n + 1 < 32) {
                    gload(ci + 1);
#pragma unroll
                    for (int ct = 0; ct < 4; ++ct) utn[ct] = *(const u32x2*)(UT + ((size_t)(ci + 1) * 128 + 16 * w + fr) * 64 + 16 * ct + 4 * fq);
                    gln = GL[ci + 1];
                }
                {
                    const size_t rowc = (size_t)b * SEQ + n * 64;
#pragma unroll
                    for (int ct = 0; ct < 4; ++ct)
#pragma unroll
                        for (int r = 0; r < 4; r += 2) {
                            const bf16* zp = proj + (rowc + 16 * ct + 4 * fq + r) * PROJ_W + 3072 + hh * 128 + 16 * w + fr;
                            zn[2 * ct + (r >> 1)] = (unsigned)zp[0] | ((unsigned)zp[PROJ_W] << 16);
                        }
                }
                f32x4 vn[4];
#pragma unroll
                for (int ct = 0; ct < 4; ++ct) vn[ct] = (f32x4){lo16(ut[ct].x), hi16(ut[ct].x), lo16(ut[ct].y), hi16(ut[ct].y)};
                bf16x8 sb[4];
#pragma unroll
                for (int ks = 0; ks < 4; ++ks) { u32x4 pk; pk.x = cvtpk(S[2 * ks][0], S[2 * ks][1]); pk.y = cvtpk(S[2 * ks][2], S[2 * ks][3]); pk.z = cvtpk(S[2 * ks + 1][0], S[2 * ks + 1][1]); pk.w = cvtpk(S[2 * ks + 1][2], S[2 * ks + 1][3]);
                    sb[ks] = __builtin_bit_cast(bf16x8, pk); }
                LAS unsigned char* bb = lds + buf * GS_BUF;
#pragma unroll
                for (int ct = 0; ct < 4; ++ct) {
                    oacc[ct] = (f32x4){0.f, 0.f, 0.f, 0.f};
#pragma unroll
                    for (int ks = 0; ks < 4; ++ks) {
                        const bf16x8 aw = *(const LAS bf16x8*)(bb + GS_WP + (16 * ct + fr) * 272 + (32 * ks + 8 * fq) * 2);
                        const bf16x8 aq = *(const LAS bf16x8*)(bb + GS_QD + (16 * ct + fr) * 272 + (32 * ks + 8 * fq) * 2);
                        vn[ct] = __builtin_amdgcn_mfma_f32_16x16x32_bf16(aw, sb[ks], vn[ct], 0, 0, 0);
                        oacc[ct] = __builtin_amdgcn_mfma_f32_16x16x32_bf16(aq, sb[ks], oacc[ct], 0, 0, 0);
                    }
                }
                bf16x8 vb[2];
#pragma unroll
                for (int ss = 0; ss < 2; ++ss) { u32x4 pk; pk.x = cvtpk(vn[2 * ss][0], vn[2 * ss][1]); pk.y = cvtpk(vn[2 * ss][2], vn[2 * ss][3]); pk.z = cvtpk(vn[2 * ss + 1][0], vn[2 * ss + 1][1]); pk.w = cvtpk(vn[2 * ss + 1][2], vn[2 * ss + 1][3]);
                    vb[ss] = __builtin_bit_cast(bf16x8, pk); }
#pragma unroll
                for (int ct = 0; ct < 4; ++ct)
#pragma unroll
                    for (int ss = 0; ss < 2; ++ss) {
                        const bf16x8 aa = *(const LAS bf16x8*)(bb + GS_AIP + (16 * ct + fr) * 144 + (32 * ss + 8 * fq) * 2);
                        oacc[ct] = __builtin_amdgcn_mfma_f32_16x16x32_bf16(aa, vb[ss], oacc[ct], 0, 0, 0);
                    }
#pragma unroll
                for (int kt = 0; kt < 8; ++kt) {
                    S[kt] = S[kt] * gl;
#pragma unroll
                    for (int ss = 0; ss < 2; ++ss) {
                        const bf16x8 ak = *(const LAS bf16x8*)(bb + GS_KDT + (16 * kt + fr) * 144 + (32 * ss + 8 * fq) * 2);
                        S[kt] = __builtin_amdgcn_mfma_f32_16x16x32_bf16(ak, vb[ss], S[kt], 0, 0, 0);
                    }
                }
#pragma unroll
                for (int ct = 0; ct < 4; ++ct)
#pragma unroll
                    for (int r = 0; r < 4; ++r) { const float sq = row16_sum(oacc[ct][r] * oacc[ct][r]); if (fr == 0) ssx[(buf * 64 + 16 * ct + 4 * fq + r) * 8 + w] = sq; }
            }
            if (n > 0) {
                const int pb = (n - 1) & 1; const size_t rowp = (size_t)b * SEQ + (n - 1) * 64;
#pragma unroll
                for (int ct = 0; ct < 4; ++ct)
#pragma unroll
                    for (int r = 0; r < 4; ++r) {
                        const int c = 16 * ct + 4 * fq + r;
                        const f32x4 s0 = *(const LAS f32x4*)(ssx + (pb * 64 + c) * 8), s1 = *(const LAS f32x4*)(ssx + (pb * 64 + c) * 8 + 4);
                        const float tot = ((s0[0] + s0[1]) + (s0[2] + s0[3])) + ((s1[0] + s1[1]) + (s1[2] + s1[3]));
                        const float rn = rsqrtf(tot * (1.f / 128.f) + EPS);
                        const float z = (r & 1) ? hi16(zr[2 * ct + (r >> 1)]) : lo16(zr[2 * ct + (r >> 1)]);
                        obuf[(rowp + c) * D + 512 + hh * 128 + 16 * w + fr] = (bf16)f2bf(oprev[ct][r] * rn * gn * (z * sigmoidf_(z)));
                    }
            }
            if (n < 32) {
#pragma unroll
                for (int ct = 0; ct < 4; ++ct) oprev[ct] = oacc[ct];
#pragma unroll
                for (int i = 0; i < 8; ++i) zr[i] = zn[i];
                if (n + 1 < 32) {
                    lstore(buf ^ 1);
#pragma unroll
                    for (int ct = 0; ct < 4; ++ct) ut[ct] = utn[ct];
                    gl = gln;
                }
            }
            LDS_BARRIER();
        }
    }
}

__device__ __forceinline__ unsigned sortable(float f) { const unsigned u = __float_as_uint(f); return u ^ ((unsigned)((int)u >> 31) | 0x80000000u); }
__device__ __forceinline__ float unsortable(unsigned s) { return __uint_as_float((s & 0x80000000u) ? (s ^ 0x80000000u) : ~s); }
#define CE(a, b) do { const unsigned _x = k[a], _y = k[b]; k[a] = _x > _y ? _x : _y; k[b] = _x > _y ? _y : _x; } while (0)
constexpr int PE_TK = 0, PE_TAB = 8192, PE_ID = 8448, PE_GT = PE_ID + 32768;
__device__ void phase_peer(const Params& p, int L, unsigned char* lds_, int bid, int nblk) {
    LAS unsigned char* lds = (LAS unsigned char*)lds_;
    const int tid = tidx(), lane = tid & 63, w = __builtin_amdgcn_readfirstlane(tid >> 6), fr = lane & 15, fq = lane >> 4;
    const bf16* Q2 = (const bf16*)(p.ws + WS_Q2);
    const bf16* SK = (const bf16*)(p.ws + WS_SK) + (size_t)L * 8 * 2 * 128 * 128;
    float* H = (float*)(p.ws + WS_H); bf16* HB2 = (bf16*)(p.ws + WS_HB2);
    const unsigned char* U = p.ws + WS_U + (size_t)L * NEXP * D;
    const unsigned char* V = p.ws + WS_V + (size_t)L * NEXP * D;
    const float* SU = (const float*)(p.ws + WS_SU) + (size_t)L * NEXP; const float* SV = (const float*)(p.ws + WS_SV) + (size_t)L * NEXP;
    const float* g = p.ln_ffn_g + L * D;
    LAS unsigned* TK = (LAS unsigned*)(lds + PE_TK);
    LAS unsigned short* TAB = (LAS unsigned short*)(lds + PE_TAB);
    LAS int* IDL = (LAS int*)(lds + PE_ID); LAS float* GTL = (LAS float*)(lds + PE_GT);
    if (tid < 64) {
        int a = 0, base = 0, q = tid; unsigned short v = 0xffff;
        if (q < 50) { for (;;) { const int cnt = 16 / (a + 1); if (q < base + cnt) break; base += cnt; ++a; } v = (unsigned short)((a << 8) | (q - base)); }
        TAB[tid] = v;
    }
    for (int item = bid; item < M / 64; item += nblk) {
        const int tok0 = item * 64;
        __syncthreads();
        const int tg = w & 3, cc = w >> 2;
        for (int hh = 0; hh < 8; ++hh) {
            {
                f32x4 acc[8];
#pragma unroll
                for (int nt = 0; nt < 8; ++nt) acc[nt] = (f32x4){0.f, 0.f, 0.f, 0.f};
                bf16x8 qa[4];
#pragma unroll
                for (int ks = 0; ks < 4; ++ks) qa[ks] = *(const bf16x8*)(Q2 + (size_t)(tok0 + 16 * tg + fr) * 2048 + hh * 256 + cc * 128 + 32 * ks + 8 * fq);
                const bf16* skb = SK + ((size_t)(hh * 2 + cc) * 128 + fr) * 128 + 8 * fq;
#pragma unroll
                for (int nt = 0; nt < 8; ++nt)
#pragma unroll
                    for (int ks = 0; ks < 4; ++ks) {
                        const bf16x8 kb = *(const bf16x8*)(skb + (size_t)nt * 16 * 128 + 32 * ks);
                        acc[nt] = __builtin_amdgcn_mfma_f32_16x16x32_bf16(qa[ks], kb, acc[nt], 0, 0, 0);
                    }
#pragma unroll
                for (int r = 0; r < 4; ++r) {
                    unsigned k[8];
#pragma unroll
                    for (int nt = 0; nt < 8; ++nt) k[nt] = (sortable(acc[nt][r]) & ~0x7Fu) | (unsigned)(127 - (16 * nt + fr));
                    CE(0, 1); CE(2, 3); CE(4, 5); CE(6, 7); CE(0, 2); CE(1, 3); CE(4, 6); CE(5, 7); CE(1, 2); CE(5, 6); CE(0, 4); CE(3, 7);
                    CE(1, 5); CE(2, 6); CE(1, 4); CE(3, 6); CE(2, 4); CE(3, 5); CE(3, 4);
                    unsigned res = 0u;
#pragma unroll
                    for (int rd = 0; rd < 16; ++rd) {
                        const unsigned m = row16_umax(k[0]);
                        const bool win = k[0] == m;
#pragma unroll
                        for (int i = 0; i < 7; ++i) k[i] = win ? k[i + 1] : k[i];
                        k[7] = win ? 0u : k[7];
                        res = (fr == rd) ? m : res;
                    }
                    TK[(cc * 64 + 16 * tg + 4 * fq + r) * 16 + fr] = res;
                }
            }
            __syncthreads();
#pragma unroll
            for (int ps = 0; ps < 2; ++ps) {
                const int tl = 8 * w + 4 * ps + fq;
                unsigned k[4];
#pragma unroll
                for (int sl = 0; sl < 4; ++sl) {
                    const int q = sl * 16 + fr;
                    const unsigned ab = TAB[q];
                    const unsigned k1 = TK[tl * 16 + ((ab >> 8) & 15)], k2 = TK[(64 + tl) * 16 + (ab & 15)];
                    const float v = unsortable(k1 & ~0x7Fu) + unsortable(k2 & ~0x7Fu);
                    k[sl] = (q < 50) ? ((sortable(v) & ~0x3Fu) | (unsigned)(63 - q)) : 0u;
                }
                CE(0, 1); CE(2, 3); CE(0, 2); CE(1, 3); CE(1, 2);
                unsigned res = 0u;
#pragma unroll
                for (int rd = 0; rd < 16; ++rd) {
                    const unsigned m = row16_umax(k[0]);
                    const bool win = k[0] == m;
                    k[0] = win ? k[1] : k[0]; k[1] = win ? k[2] : k[1]; k[2] = win ? k[3] : k[2]; k[3] = win ? 0u : k[3];
                    res = (fr == rd) ? m : res;
                }
                const unsigned ab = TAB[63 - (res & 0x3Fu)];
                const unsigned k1 = TK[tl * 16 + ((ab >> 8) & 15)], k2 = TK[(64 + tl) * 16 + (ab & 15)];
                const float v = unsortable(k1 & ~0x7Fu) + unsortable(k2 & ~0x7Fu);
                const float e = __expf(v - row16_max(v));
                const float sum = row16_sum(e);
                IDL[tl * 128 + hh * 16 + fr] = (int)((127u - (k1 & 0x7Fu)) * 128u + (127u - (k2 & 0x7Fu)));
                GTL[tl * 128 + hh * 16 + fr] = e / sum;
            }
            __syncthreads();
        }
        for (int ti = 0; ti < 8; ++ti) {
            const int tl = 8 * w + ti, tok = tok0 + tl;
            float* hrow = H + (size_t)tok * D + 16 * lane;
            float xv[16];
#pragma unroll
            for (int j = 0; j < 4; ++j) { const f32x4 a = *(const f32x4*)(hrow + 4 * j); xv[4 * j] = a[0]; xv[4 * j + 1] = a[1]; xv[4 * j + 2] = a[2]; xv[4 * j + 3] = a[3]; }
            float ss = 0.f;
#pragma unroll
            for (int i = 0; i < 16; ++i) ss += xv[i] * xv[i];
            const float rstd = rsqrtf(wave_sum(ss) * (1.f / D) + EPS);
            float xn[16], xs = 0.f;
#pragma unroll
            for (int i = 0; i < 16; ++i) { xn[i] = xv[i] * rstd * g[16 * lane + i]; xs += xn[i]; }
            const float xoff = 128.f * wave_sum(xs);
            const int id0 = IDL[tl * 128 + lane], id1 = IDL[tl * 128 + 64 + lane];
            const float su0 = SU[id0], su1 = SU[id1], sv0 = SV[id0], sv1 = SV[id1];
            float h0 = 0.f, h1 = 0.f;
            u32x4 ring[16];
#pragma unroll
            for (int j = 0; j < 16; ++j) ring[j] = *(const u32x4*)(U + (size_t)IDL[tl * 128 + j] * D + 16 * lane);
#pragma unroll 1
            for (int k = 0; k < 8; ++k) {
#pragma unroll
                for (int j = 0; j < 16; ++j) {
                    const u32x4 a = ring[j];
                    if (k < 7) ring[j] = *(const u32x4*)(U + (size_t)IDL[tl * 128 + 16 * (k + 1) + j] * D + 16 * lane);
                    float d = 0.f;
#pragma unroll
                    for (int q = 0; q < 4; ++q) { d += xn[4 * q] * (float)(a[q] & 0xffu) + xn[4 * q + 1] * (float)((a[q] >> 8) & 0xffu) + xn[4 * q + 2] * (float)((a[q] >> 16) & 0xffu) + xn[4 * q + 3] * (float)(a[q] >> 24); }
                    d = wave_sum(d);
                    const int e = 16 * k + j;
                    if (lane == (e & 63)) { if (k < 4) h0 = d; else h1 = d; }
                }
            }
            h0 = su0 * (h0 - xoff); h1 = su1 * (h1 - xoff);
            const float w0 = sv0 * GTL[tl * 128 + lane] * 0.5f * h0 * (1.f + erff(h0 * 0.70710678118654752f));
            const float w1 = sv1 * GTL[tl * 128 + 64 + lane] * 0.5f * h1 * (1.f + erff(h1 * 0.70710678118654752f));
            const float woff = 128.f * wave_sum(w0 + w1);
            float y[16];
#pragma unroll
            for (int i = 0; i < 16; ++i) y[i] = 0.f;
#pragma unroll
            for (int j = 0; j < 16; ++j) ring[j] = *(const u32x4*)(V + (size_t)IDL[tl * 128 + j] * D + 16 * lane);
#pragma unroll 1
            for (int k = 0; k < 8; ++k) {
#pragma unroll
                for (int j = 0; j < 16; ++j) {
                    const u32x4 a = ring[j];
                    if (k < 7) ring[j] = *(const u32x4*)(V + (size_t)IDL[tl * 128 + 16 * (k + 1) + j] * D + 16 * lane);
                    const int e = 16 * k + j;
                    const float ww = __uint_as_float((unsigned)__builtin_amdgcn_readlane((int)__float_as_uint(k < 4 ? w0 : w1), e & 63));
#pragma unroll
                    for (int q = 0; q < 4; ++q) { y[4 * q] += ww * (float)(a[q] & 0xffu); y[4 * q + 1] += ww * (float)((a[q] >> 8) & 0xffu); y[4 * q + 2] += ww * (float)((a[q] >> 16) & 0xffu); y[4 * q + 3] += ww * (float)(a[q] >> 24); }
                }
            }
#pragma unroll
            for (int i = 0; i < 16; ++i) y[i] += xv[i] - woff;
#pragma unroll
            for (int j = 0; j < 4; ++j) *(f32x4*)(hrow + 4 * j) = (f32x4){y[4 * j], y[4 * j + 1], y[4 * j + 2], y[4 * j + 3]};
            bf16* hb = HB2 + (size_t)tok * D + 16 * lane;
            u32x4 o; o.x = pk2(y[0], y[1]); o.y = pk2(y[2], y[3]); o.z = pk2(y[4], y[5]); o.w = pk2(y[6], y[7]);
            *(u32x4*)hb = o;
            o.x = pk2(y[8], y[9]); o.y = pk2(y[10], y[11]); o.z = pk2(y[12], y[13]); o.w = pk2(y[14], y[15]);
            *(u32x4*)(hb + 8) = o;
        }
    }
    __syncthreads();
}
#undef CE

__device__ void phase_final(const Params& p, int bid, int nblk) {
    const int tid = tidx(), lane = tid & 63, gw = bid * NWAVES + (tid >> 6), NGW = nblk * NWAVES;
    const float* H = (const float*)(p.ws + WS_H); const float* rstd0 = (const float*)(p.ws + WS_STAT);
    for (int m = gw; m < M; m += NGW) {
        const float r = rstd0[m];
#pragma unroll
        for (int j = 0; j < 4; ++j) {
            const f32x4 v = ((const f32x4*)(H + (size_t)m * D))[lane + 64 * j];
            const f32x4 gv = ((const f32x4*)p.final_g)[lane + 64 * j];
            ((f32x4*)(p.out + (size_t)m * D))[lane + 64 * j] = v * r * gv;
        }
    }
}

#define XB_TMO      128
#define XB_XCNT(j)  (256  + 64 * (j))
#define XB_XSUB(j)  (1280 + 64 * (j))
#define XB_XGEN(j)  (2304 + 64 * (j))
#define XB_TOP      3328
#define XB_TOPGEN   3392
#define XCD_BAR_WORDS 3456
#define XB_SPIN_CAP (1u << 22)
__device__ __forceinline__ unsigned xb_ld(unsigned* p)              { return __hip_atomic_load(p, __ATOMIC_RELAXED, __HIP_MEMORY_SCOPE_AGENT); }
__device__ __forceinline__ unsigned xb_add(unsigned* p, unsigned v) { return __hip_atomic_fetch_add(p, v, __ATOMIC_RELAXED, __HIP_MEMORY_SCOPE_AGENT); }
__device__ __forceinline__ unsigned xb_xcc_id() { return (unsigned)__builtin_amdgcn_s_getreg((3 << 11) | 20) & 0xFu; }
#define XB_SPIN(cond, bar) do { unsigned _sp = 0; while (cond) { __builtin_amdgcn_s_sleep(1); \
    if ((++_sp & 255u) == 0u) { if (xb_ld(&(bar)[XB_TMO])) break; if (_sp > XB_SPIN_CAP) { atomicAdd(&(bar)[XB_TMO], 1u); break; } } } } while (0)
struct XcdBarrier { unsigned* bar; unsigned x; volatile LAS unsigned* st; };
__device__ __forceinline__ XcdBarrier xcd_barrier_post(unsigned* bar, volatile LAS unsigned* st) {
    XcdBarrier b; b.bar = bar; b.x = xb_xcc_id(); b.st = st;
    if (threadIdx.x == 0) (void)xb_add(&bar[XB_XCNT(b.x)], 1u);
    return b;
}
__device__ __forceinline__ void xcd_barrier_complete(unsigned* bar, unsigned x, unsigned& nloc, unsigned& nx) {
    const unsigned G = gridDim.x * gridDim.y * gridDim.z;
    unsigned sum, cnt, mine, sp = 0u;
    for (;;) {
        sum = 0u; cnt = 0u; mine = 0u;
#pragma unroll
        for (unsigned j = 0; j < 16; ++j) { const unsigned c = xb_ld(&bar[XB_XCNT(j)]); sum += c; cnt += (c > 0u) ? 1u : 0u; mine = (j == x) ? c : mine; }
        if (sum == G) break;
        __builtin_amdgcn_s_sleep(1);
        if ((++sp & 255u) == 0u) { if (xb_ld(&bar[XB_TMO])) break; if (sp > XB_SPIN_CAP) { atomicAdd(&bar[XB_TMO], 1u); break; } }
    }
    nloc = mine > 0u ? mine : 1u; nx = cnt > 0u ? cnt : 1u;
}
__device__ __forceinline__ void xcd_barrier(const XcdBarrier& b) {
    asm volatile("s_waitcnt vmcnt(0)" ::: "memory");
    __syncthreads();
    if (threadIdx.x == 0) {
        unsigned* bar = b.bar;
        __builtin_amdgcn_s_waitcnt(0);
        unsigned nloc = b.st[0], nx = b.st[1];
        if (nloc == 0u) { xcd_barrier_complete(bar, b.x, nloc, nx); b.st[0] = nloc; b.st[1] = nx; }
        const unsigned old = xb_add(&bar[XB_XSUB(b.x)], 1u);
        const unsigned gen = old / nloc;
        if (old + 1u == (gen + 1u) * nloc) {
            __builtin_amdgcn_fence(__ATOMIC_RELEASE, "agent");
            asm volatile("s_waitcnt vmcnt(0)" ::: "memory");
            const unsigned og = xb_add(&bar[XB_TOP], 1u);
            const unsigned tg = og / nx;
            if (og + 1u == (tg + 1u) * nx) xb_add(&bar[XB_TOPGEN], 1u);
            else XB_SPIN(xb_ld(&bar[XB_TOPGEN]) == tg, bar);
            __builtin_amdgcn_fence(__ATOMIC_ACQUIRE, "agent");
            xb_add(&bar[XB_XGEN(b.x)], 1u);
            asm volatile("s_waitcnt vmcnt(0)" ::: "memory");
        } else {
            XB_SPIN(xb_ld(&bar[XB_XGEN(b.x)]) == gen, bar);
            __builtin_amdgcn_fence(__ATOMIC_ACQUIRE, "agent");
            asm volatile("s_waitcnt vmcnt(0)" ::: "memory");
        }
    }
    __syncthreads();
}
constexpr int CW_BAR = 4096;
constexpr int LDS_MISC_OFF = LDS_BYTES - 256;

constexpr int NS = 11;
constexpr int K_PROLOGUE = 11, K_FINAL = 12;
template <int KIND>
__device__ __forceinline__ void run_kind(const Params& p, int L, unsigned char* lds, int bid, int nblk) {
    unsigned char* ws = p.ws;
    float* H = (float*)(ws + WS_H);
    float* rstd0 = (float*)(ws + WS_STAT); float* rstd1 = rstd0 + M; float* rstde = rstd1 + M;
    if constexpr (KIND == K_PROLOGUE) phase_prologue(p, lds, bid, nblk);
    if constexpr (KIND == K_FINAL) phase_final(p, bid, nblk);
    if constexpr (KIND == 0) { EpiProj E{(bf16*)(ws + WS_PROJ), (float*)(ws + WS_BA), rstd0};
        gemm_run(lds, (const bf16*)(ws + WS_HB0), (const bf16*)(ws + WS_WIN) + (size_t)L * IN_PAD * D, M, IN_PAD, D, E, bid, nblk); }
    if constexpr (KIND == 1) phase_att_mfma(p, L, lds, bid, nblk);
    if constexpr (KIND == 2) phase_gdn_prep(p, L, lds, bid, nblk);
    if constexpr (KIND == 3) phase_gdn_scan(p, L, lds, bid, nblk);
    if constexpr (KIND == 4) { EpiRes E{H, (bf16*)(ws + WS_HB1)};
        gemm_run(lds, (const bf16*)(ws + WS_OBUF), (const bf16*)(ws + WS_WOUT) + (size_t)L * D * D, M, D, D, E, bid, nblk); }
    if constexpr (KIND == 5) phase_rowstat_f32(H, rstd1, bid, nblk);
    if constexpr (KIND == 6) { EpiQ2 E{(bf16*)(ws + WS_Q2), rstd1};
        gemm_run(lds, (const bf16*)(ws + WS_HB1), (const bf16*)(ws + WS_WQ) + (size_t)L * 2048 * D, M, 2048, D, E, bid, nblk);
        EpiE E2{(bf16*)(ws + WS_EPRE)};
        gemm_run(lds, (const bf16*)(ws + WS_PB) + (size_t)L * M * 256, (const bf16*)(ws + WS_WP) + (size_t)L * D * 256, M, D, 256, E2, bid, nblk); }
    if constexpr (KIND == 7) { phase_rowstat_bf16((const bf16*)(ws + WS_EPRE), rstde, bid, nblk); phase_peer(p, L, lds, bid, nblk); }
    if constexpr (KIND == 9) { EpiPle E{H, (bf16*)(ws + WS_HB0), (const bf16*)(ws + WS_EPRE), rstde, p.ple_norm_g + L * D};
        gemm_run(lds, (const bf16*)(ws + WS_HB2), (const bf16*)(ws + WS_WG) + (size_t)L * D * D, M, D, D, E, bid, nblk); }
    if constexpr (KIND == 10) phase_rowstat_f32(H, rstd0, bid, nblk);
}

__device__ __forceinline__ Params params_off(const Params& s, size_t z) {
    Params q;
    q.x = s.x + z; q.p = s.p + z; q.ln_mix_g = s.ln_mix_g + z; q.w_in = s.w_in + z; q.conv_w = s.conv_w + z; q.a_log = s.a_log + z; q.dt_bias = s.dt_bias + z;
    q.gdn_norm_g = s.gdn_norm_g + z; q.diff_lambda = s.diff_lambda + z; q.subln_g = s.subln_g + z; q.w_out = s.w_out + z; q.ln_ffn_g = s.ln_ffn_g + z;
    q.peer_wq = s.peer_wq + z; q.subkeys = s.subkeys + z; q.peer_u = s.peer_u + z; q.peer_v = s.peer_v + z; q.ple_wp = s.ple_wp + z; q.ple_wg = s.ple_wg + z;
    q.ple_norm_g = s.ple_norm_g + z; q.final_g = s.final_g + z; q.out = s.out + z; q.ws = s.ws + z; q.pad0 = 0; q.pad1 = 0;
    return q;
}
#define RUN(KIND) do { size_t z_ = 0; int L_ = L; asm volatile("" : "+s"(z_), "+s"(L_)); const Params q_ = params_off(p, z_); run_kind<KIND>(q_, L_, lds, bid, nblk); } while (0)
__global__ void __launch_bounds__(NTHREADS, 2) mk_fwd(Params p) {
    extern __shared__ __attribute__((aligned(16))) unsigned char lds[];
    const int bid = (int)blockIdx.x, nblk = (int)gridDim.x;
    volatile LAS unsigned* misc = (volatile LAS unsigned*)((LAS unsigned char*)lds + LDS_MISC_OFF);
    if (threadIdx.x < 64) misc[threadIdx.x] = 0u;
    __syncthreads();
    XcdBarrier bar = xcd_barrier_post((unsigned*)(p.ws + WS_CTL) + CW_BAR, misc + 8);
    { int L = 0; RUN(K_PROLOGUE); }
    cg::this_grid().sync();
#pragma nounroll
    for (int L = 0; L < DEPTH; ++L) {
        RUN(0); xcd_barrier(bar);
        RUN(1); xcd_barrier(bar);
        RUN(2); xcd_barrier(bar);
        RUN(3); xcd_barrier(bar);
        RUN(4); xcd_barrier(bar);
        RUN(5); xcd_barrier(bar);
        RUN(6); xcd_barrier(bar);
        RUN(7); xcd_barrier(bar);
        RUN(9); xcd_barrier(bar);
        RUN(10); xcd_barrier(bar);
    }
    { int L = 0; RUN(K_FINAL); }
}

extern "C" void kernel_launch(void* const* d_in, const int* in_sizes, int n_in, void* d_out, int out_size, void* d_ws, size_t ws_size, hipStream_t stream) {
    static int grid = 0;
    if (grid == 0) {
        if (n_in != 20 || out_size != M * D || ws_size < WS_END) { fprintf(stderr, "kernel_launch: unexpected shapes (n_in %d, out %d, ws %zu < %zu)\n", n_in, out_size, ws_size, (size_t)WS_END); grid = -1; return; }
        int dev = 0, cus = 0, per_cu = 0;
        (void)hipGetDevice(&dev); (void)hipDeviceGetAttribute(&cus, hipDeviceAttributeMultiprocessorCount, dev);
        if (hipFuncSetAttribute((const void*)mk_fwd, hipFuncAttributeMaxDynamicSharedMemorySize, LDS_BYTES) != hipSuccess) { fprintf(stderr, "kernel_launch: hipFuncSetAttribute failed\n"); grid = -1; return; }
        if (hipOccupancyMaxActiveBlocksPerMultiprocessor(&per_cu, (const void*)mk_fwd, NTHREADS, LDS_BYTES) != hipSuccess || per_cu < 1) { fprintf(stderr, "kernel_launch: occupancy query says %d blocks per CU\n", per_cu); (void)hipGetLastError(); grid = -1; return; }
        grid = (cus > 0 ? cus : 256);
    }
    if (grid < 0) return;
    (void)hipMemsetAsync((char*)d_ws + WS_CTL, 0, CTL_ZERO_BYTES, stream);
    Params p{};
    const float** pp = (const float**)&p;
    for (int i = 0; i < 20; ++i) pp[i] = (const float*)d_in[i];
    p.out = (float*)d_out; p.ws = (unsigned char*)d_ws;
    void* args[] = {&p};
    hipError_t e = hipLaunchCooperativeKernel((const void*)mk_fwd, dim3(grid), dim3(NTHREADS), args, LDS_BYTES, stream);
    if (e != hipSuccess) fprintf(stderr, "kernel_launch: cooperative launch failed: %s (grid %d)\n", hipGetErrorString(e), grid);
}
```

```cpp
#include <hip/hip_runtime.h>
#include <hip/hip_cooperative_groups.h>
#include <cstdio>
#include <cstdint>
namespace cg = cooperative_groups;

typedef unsigned short bf16;
typedef float f32x4 __attribute__((ext_vector_type(4)));
typedef short bf16x8 __attribute__((ext_vector_type(8)));
typedef unsigned u32x4 __attribute__((ext_vector_type(4)));
typedef unsigned u32x2 __attribute__((ext_vector_type(2)));

constexpr int D = 1024, BATCH = 8, SEQ = 2048, DEPTH = 4, M = BATCH * SEQ;
constexpr int IN_COLS = 3592, IN_PAD = 3840, PROJ_W = 3584;
constexpr int NEXP = 16384;
constexpr float EPS = 1e-6f;
constexpr float QSCALE = 0.125f * 1.4426950408889634f;
constexpr int NWAVES = 8, NTHREADS = 512;
constexpr int LDS_BYTES = 163840;
constexpr int LDS_MISC_OFF = LDS_BYTES - 256;
constexpr int RS_OFF = 147456;
constexpr int CW_QUEUE = 1024;

constexpr size_t MiB = 1u << 20;
constexpr size_t WS_CTL = 0, CTL_ZERO_BYTES = 1 * MiB;
constexpr size_t WS_H = 1 * MiB;
constexpr size_t WS_HB0 = 65 * MiB;
constexpr size_t WS_HB1 = 97 * MiB;
constexpr size_t WS_HB2 = 129 * MiB;
constexpr size_t WS_PROJ = 161 * MiB;
constexpr size_t WS_BA = 273 * MiB;
constexpr size_t WS_OBUF = 274 * MiB;
constexpr size_t WS_Q2 = 306 * MiB;
constexpr size_t WS_EPRE = 370 * MiB;
constexpr size_t WS_IDX = 402 * MiB;
constexpr size_t WS_GATE = 410 * MiB;
constexpr size_t WS_STAT = 418 * MiB;
constexpr size_t WS_SS1 = WS_IDX + 1 * MiB, WS_SSE = WS_IDX;
constexpr size_t WS_ORAW = 422 * MiB;
constexpr size_t WS_WIN = 550 * MiB;
constexpr size_t WS_WOUT = 582 * MiB;
constexpr size_t WS_WQ = 590 * MiB;
constexpr size_t WS_WG = 606 * MiB;
constexpr size_t WS_WP = 614 * MiB;
constexpr size_t WS_SK = 616 * MiB;
constexpr size_t WS_PB = 618 * MiB;
constexpr size_t WS_U = 650 * MiB;
constexpr size_t WS_V = 778 * MiB;
constexpr size_t WS_SU = WS_STAT + 1 * MiB, WS_SV = WS_STAT + 2 * MiB;
constexpr size_t WS_END = 906 * MiB;

struct Params {
    const float *x, *p, *ln_mix_g, *w_in, *conv_w, *a_log, *dt_bias, *gdn_norm_g, *diff_lambda, *subln_g, *w_out, *ln_ffn_g,
        *peer_wq, *subkeys, *peer_u, *peer_v, *ple_wp, *ple_wg, *ple_norm_g, *final_g;
    float* out;
    unsigned char* ws;
    int pad0, pad1;
};

__device__ __forceinline__ int tidx() { int t = (int)threadIdx.x; asm volatile("" : "+v"(t)); return t; }
#define LDS_BARRIER() asm volatile("s_waitcnt lgkmcnt(0)\n\ts_barrier" ::: "memory")
__device__ __forceinline__ float bf2f(bf16 v) { return __uint_as_float((unsigned)v << 16); }
__device__ __forceinline__ unsigned f2bf(float f) { unsigned u = __float_as_uint(f); return (u + 0x7fffu + ((u >> 16) & 1u)) >> 16; }
__device__ __forceinline__ unsigned pk2(float lo, float hi) { return f2bf(lo) | (f2bf(hi) << 16); }
__device__ __forceinline__ float lo16(unsigned w) { return __uint_as_float(w << 16); }
__device__ __forceinline__ float hi16(unsigned w) { return __uint_as_float(w & 0xffff0000u); }
template <int N> __device__ __forceinline__ float dpp_ror(float x) { return __builtin_bit_cast(float, __builtin_amdgcn_mov_dpp(__builtin_bit_cast(int, x), 0x120 + N, 0xf, 0xf, true)); }
template <int N> __device__ __forceinline__ unsigned dpp_ror_u(unsigned x) { return (unsigned)__builtin_amdgcn_mov_dpp((int)x, 0x120 + N, 0xf, 0xf, true); }
__device__ __forceinline__ float row16_sum(float x) { x += dpp_ror<8>(x); x += dpp_ror<4>(x); x += dpp_ror<2>(x); x += dpp_ror<1>(x); return x; }
__device__ __forceinline__ float row16_max(float x) { x = fmaxf(x, dpp_ror<8>(x)); x = fmaxf(x, dpp_ror<4>(x)); x = fmaxf(x, dpp_ror<2>(x)); x = fmaxf(x, dpp_ror<1>(x)); return x; }
__device__ __forceinline__ unsigned row16_umax(unsigned x) { unsigned y;
    y = dpp_ror_u<8>(x); x = x > y ? x : y; y = dpp_ror_u<4>(x); x = x > y ? x : y; y = dpp_ror_u<2>(x); x = x > y ? x : y; y = dpp_ror_u<1>(x); x = x > y ? x : y; return x; }
__device__ __forceinline__ float xrow16_max(float x) {
    auto s = __builtin_amdgcn_permlane16_swap(__float_as_uint(x), __float_as_uint(x), false, false);
    x = fmaxf(__uint_as_float(s[0]), __uint_as_float(s[1]));
    auto t = __builtin_amdgcn_permlane32_swap(__float_as_uint(x), __float_as_uint(x), false, false);
    return fmaxf(__uint_as_float(t[0]), __uint_as_float(t[1]));
}
__device__ __forceinline__ float xrow16_sum(float x) {
    auto s = __builtin_amdgcn_permlane16_swap(__float_as_uint(x), __float_as_uint(x), false, false);
    x = __uint_as_float(s[0]) + __uint_as_float(s[1]);
    auto t = __builtin_amdgcn_permlane32_swap(__float_as_uint(x), __float_as_uint(x), false, false);
    return __uint_as_float(t[0]) + __uint_as_float(t[1]);
}
__device__ __forceinline__ float wave_sum(float v) { return xrow16_sum(row16_sum(v)); }
__device__ __forceinline__ float wave_max(float v) {
#pragma unroll
    for (int o = 32; o; o >>= 1) v = fmaxf(v, __shfl_xor(v, o));
    return v;
}
__device__ __forceinline__ float sigmoidf_(float x) { return 1.f / (1.f + __expf(-x)); }
__device__ __forceinline__ float dot8(u32x4 a, u32x4 b, float s) {
#pragma unroll
    for (int i = 0; i < 4; ++i) { s += lo16(a[i]) * lo16(b[i]); s += hi16(a[i]) * hi16(b[i]); }
    return s;
}

#define LAS __attribute__((address_space(3)))
__host__ __device__ __forceinline__ int lds_byte(int r, int c) { const int st = (r >> 4) * 2 + (c >> 5), rr = r & 15, cc = c & 31, ob = rr * 64 + cc * 2; return st * 1024 + (ob ^ (((ob >> 9) & 1) << 5)); }
__host__ __device__ __forceinline__ void stage_rc(int b, int& R, int& C) { const int st = b / 1024, sb = b % 1024, swz = sb ^ (((sb >> 9) & 1) << 5); R = (st >> 1) * 16 + swz / 64; C = (st & 1) * 32 + (swz % 64) / 2; }
constexpr int HTB = 16384;
template <class F>
__device__ __forceinline__ void gemm_run(unsigned char* lds_, const bf16* A, const bf16* Bt, int Mm, int N, int K, const F& f, int bid, int nblk, const float* slots_in = nullptr) {
    LAS unsigned char* lds = (LAS unsigned char*)lds_;
    LAS float* RS = (LAS float*)(lds + RS_OFF);
    if (slots_in) {
        const int t = tidx();
        if (t < 256) { const f32x4* sp = (const f32x4*)(slots_in + ((size_t)(bid % (Mm / 256)) * 256 + t) * 16);
            const f32x4 a = sp[0], b = sp[1], c = sp[2], d = sp[3];
            const float s = (((a[0] + a[1]) + (a[2] + a[3])) + ((b[0] + b[1]) + (b[2] + b[3]))) + (((c[0] + c[1]) + (c[2] + c[3])) + ((d[0] + d[1]) + (d[2] + d[3])));
            RS[t] = rsqrtf(s * (1.f / D) + EPS); }
        __syncthreads();
    }
    const int tid = tidx(), wid = __builtin_amdgcn_readfirstlane(tid >> 6), lane = tid & 63, wr = wid >> 1, wc = wid & 1, fr = lane & 15, fq = lane >> 4;
    const int nt = K / 64, ntn = N / 128, nunits = (Mm / 256) * ntn;
    unsigned voff[2];
#pragma unroll
    for (int i = 0; i < 2; ++i) { int R, C; stage_rc(tid * 16 + i * 8192, R, C); voff[i] = (unsigned)(R * K + C) * 2u; }
    const unsigned ldsw = (unsigned)wid * 1024u;
    const int aoff = (wr >> 1) * HTB + lds_byte((wr & 1) * 64 + fr, fq * 8), boff = 2 * HTB + lds_byte(wc * 64 + fr, fq * 8);
#define G_STAGE(bufoff, gbase) do { _Pragma("unroll") for (int _i = 0; _i < 2; ++_i) \
        __builtin_amdgcn_global_load_lds((const unsigned*)((const char*)(gbase) + voff[_i]), (LAS unsigned*)(lds + (bufoff) + ldsw + _i * 8192), 16, 0, 0); } while (0)
    for (int u = bid; u < nunits; u += nblk) {
        const int pm = u % (Mm / 256), pn = u / (Mm / 256);
        const char* gA = (const char*)(A + (size_t)pm * 256 * K);
        const char* gB = (const char*)(Bt + (size_t)pn * 128 * K);
        const size_t hstep = (size_t)128 * K * 2;
        f32x4 acc[4][4];
#pragma unroll
        for (int a = 0; a < 4; ++a)
#pragma unroll
            for (int b = 0; b < 4; ++b) acc[a][b] = (f32x4){0.f, 0.f, 0.f, 0.f};
        G_STAGE(0, gA); G_STAGE(HTB, gA + hstep); G_STAGE(2 * HTB, gB);
        G_STAGE(3 * HTB, gA + 128); G_STAGE(4 * HTB, gA + hstep + 128); G_STAGE(5 * HTB, gB + 128);
        int cur = 0;
        for (int t = 0; t < nt; ++t) {
            if (t + 1 < nt) asm volatile("s_waitcnt vmcnt(6)" ::: "memory"); else asm volatile("s_waitcnt vmcnt(0)" ::: "memory");
            __builtin_amdgcn_s_barrier();
            asm volatile("" ::: "memory");
            if (t + 2 < nt) { const int nx = (cur == 0 ? 2 : cur - 1) * 3 * HTB; const size_t ko = (size_t)(t + 2) * 128;
                G_STAGE(nx, gA + ko); G_STAGE(nx + HTB, gA + hstep + ko); G_STAGE(nx + 2 * HTB, gB + ko); }
            const int cb = cur * 3 * HTB;
            bf16x8 af[4][2], bfr[4][2];
#pragma unroll
            for (int m = 0; m < 4; ++m)
#pragma unroll
                for (int k = 0; k < 2; ++k) af[m][k] = *(const LAS bf16x8*)(lds + cb + aoff + m * 2048 + k * 1024);
#pragma unroll
            for (int n = 0; n < 4; ++n)
#pragma unroll
                for (int k = 0; k < 2; ++k) bfr[n][k] = *(const LAS bf16x8*)(lds + cb + boff + n * 2048 + k * 1024);
#pragma unroll
            for (int k = 0; k < 2; ++k)
#pragma unroll
                for (int m = 0; m < 4; ++m)
#pragma unroll
                    for (int n = 0; n < 4; ++n) acc[m][n] = __builtin_amdgcn_mfma_f32_16x16x32_bf16(bfr[n][k], af[m][k], acc[m][n], 0, 0, 0);
            asm volatile("s_waitcnt lgkmcnt(0)" ::: "memory");
            cur = (cur == 2) ? 0 : cur + 1;
        }
#pragma unroll
        for (int m = 0; m < 4; ++m) {
            const int lrow = wr * 64 + m * 16 + fr, row = pm * 256 + lrow;
            float ssq = 0.f;
#pragma unroll
            for (int n = 0; n < 4; ++n) { const f32x4 r = f(row, RS[lrow], pn * 128 + wc * 64 + n * 16 + 4 * fq, acc[m][n]); ssq += (r[0] * r[0] + r[1] * r[1]) + (r[2] * r[2] + r[3] * r[3]); }
            if constexpr (F::STATS) { ssq = xrow16_sum(ssq); if (fq == 0) f.slots[(size_t)row * 16 + pn * 2 + wc] = ssq; }
        }
        __syncthreads();
    }
#undef G_STAGE
}

__device__ __forceinline__ u32x2 pk4(f32x4 a) { u32x2 o; o.x = pk2(a[0], a[1]); o.y = pk2(a[2], a[3]); return o; }
struct EpiProj {
    static constexpr bool STATS = false; float* slots;
    bf16* proj; float* ba;
    __device__ __forceinline__ f32x4 operator()(int row, float rstd, int col, f32x4 v) const {
        v = v * rstd;
        if (col < PROJ_W) *(u32x2*)(proj + (size_t)row * PROJ_W + col) = pk4(v);
        else if (col < IN_COLS) *(f32x4*)(ba + (size_t)row * 8 + (col - PROJ_W)) = v;
        return v;
    }
};
struct EpiRes {
    static constexpr bool STATS = true; float* slots;
    float* H; bf16* HB;
    __device__ __forceinline__ f32x4 operator()(int row, float, int col, f32x4 v) const {
        f32x4* hp = (f32x4*)(H + (size_t)row * D + col);
        const f32x4 h = *hp + v; *hp = h;
        *(u32x2*)(HB + (size_t)row * D + col) = pk4(h);
        return h;
    }
};
struct EpiQ2 {
    static constexpr bool STATS = false; float* slots;
    bf16* Q2;
    __device__ __forceinline__ f32x4 operator()(int row, float rstd, int col, f32x4 v) const { v = v * rstd; *(u32x2*)(Q2 + (size_t)row * 2048 + col) = pk4(v); return v; }
};
struct EpiE {
    static constexpr bool STATS = true; float* slots;
    bf16* E;
    __device__ __forceinline__ f32x4 operator()(int row, float, int col, f32x4 v) const { *(u32x2*)(E + (size_t)row * D + col) = pk4(v); return v; }
};
struct EpiPle {
    static constexpr bool STATS = true; float* slots;
    float* H; bf16* HB; const bf16* E; const float* g;
    __device__ __forceinline__ f32x4 operator()(int row, float rstde, int col, f32x4 v) const {
        f32x4* hp = (f32x4*)(H + (size_t)row * D + col);
        const u32x2 ev = *(const u32x2*)(E + (size_t)row * D + col);
        const f32x4 gv = *(const f32x4*)(g + col);
        f32x4 h = *hp;
        h[0] += sigmoidf_(v[0]) * (lo16(ev.x) * rstde * gv[0]); h[1] += sigmoidf_(v[1]) * (hi16(ev.x) * rstde * gv[1]);
        h[2] += sigmoidf_(v[2]) * (lo16(ev.y) * rstde * gv[2]); h[3] += sigmoidf_(v[3]) * (hi16(ev.y) * rstde * gv[3]);
        *hp = h;
        *(u32x2*)(HB + (size_t)row * D + col) = pk4(h);
        return h;
    }
};

__device__ __forceinline__ void transpose_item(const float* W, int K, int N, int Npad, bf16* WT, const float* rowscale, int qcols, float* scr, int item, int lane) {
    const int nblk = Npad / 32, kb = item / nblk, nb = item % nblk, k0 = 64 * kb, n0 = 32 * nb;
    const int n = n0 + (lane & 31);
#pragma unroll 8
    for (int i = 0; i < 32; ++i) {
        const int kk = 2 * i + (lane >> 5);
        float v = (n < N) ? W[(size_t)(k0 + kk) * N + n] : 0.f;
        if (rowscale) v *= rowscale[k0 + kk];
        if (n < qcols) v *= QSCALE;
        scr[kk * 33 + (lane & 31)] = v;
    }
    asm volatile("s_waitcnt lgkmcnt(0)" ::: "memory");
    const int c = lane & 7;
#pragma unroll
    for (int j = 0; j < 4; ++j) {
        const int nn = (lane >> 3) + 8 * j; const float* s = scr + (8 * c) * 33 + nn;
        u32x4 o; o.x = pk2(s[0 * 33], s[1 * 33]); o.y = pk2(s[2 * 33], s[3 * 33]); o.z = pk2(s[4 * 33], s[5 * 33]); o.w = pk2(s[6 * 33], s[7 * 33]);
        *(u32x4*)(WT + (size_t)(n0 + nn) * K + k0 + 8 * c) = o;
    }
    asm volatile("s_waitcnt lgkmcnt(0)" ::: "memory");
}
__device__ __forceinline__ void convert_bulk(const float* src, bf16* dst, size_t n, size_t gtid, size_t nthr) {
    for (size_t i = gtid * 8; i < n; i += nthr * 8) {
        const f32x4 a = *(const f32x4*)(src + i), b = *(const f32x4*)(src + i + 4);
        u32x4 o; o.x = pk2(a[0], a[1]); o.y = pk2(a[2], a[3]); o.z = pk2(b[0], b[1]); o.w = pk2(b[2], b[3]);
        *(u32x4*)(dst + i) = o;
    }
}
__device__ void phase_prologue(const Params& p, unsigned char* lds, int bid, int nblk) {
    const int tid = tidx(), lane = tid & 63, w = tid >> 6;
    const int gw = bid * NWAVES + w, NGW = nblk * NWAVES;
    float* scr = (float*)(lds + w * 16384);
    constexpr int I_IN = 16 * (IN_PAD / 32), I_OUT = 16 * 32, I_Q = 16 * 64, I_G = 16 * 32, I_P = 4 * 32, I_L = I_IN + I_OUT + I_Q + I_G + I_P;
    for (int it = gw; it < DEPTH * I_L; it += NGW) {
        const int L = it / I_L; int r = it % I_L;
        if (r < I_IN) { transpose_item(p.w_in + (size_t)L * D * IN_COLS, D, IN_COLS, IN_PAD, (bf16*)(p.ws + WS_WIN) + (size_t)L * IN_PAD * D, p.ln_mix_g + L * D, 512, scr, r, lane); continue; } r -= I_IN;
        if (r < I_OUT) { transpose_item(p.w_out + (size_t)L * D * D, D, D, D, (bf16*)(p.ws + WS_WOUT) + (size_t)L * D * D, nullptr, 0, scr, r, lane); continue; } r -= I_OUT;
        if (r < I_Q) { transpose_item(p.peer_wq + (size_t)L * D * 2048, D, 2048, 2048, (bf16*)(p.ws + WS_WQ) + (size_t)L * 2048 * D, p.ln_ffn_g + L * D, 0, scr, r, lane); continue; } r -= I_Q;
        if (r < I_G) { transpose_item(p.ple_wg + (size_t)L * D * D, D, D, D, (bf16*)(p.ws + WS_WG) + (size_t)L * D * D, nullptr, 0, scr, r, lane); continue; } r -= I_G;
        transpose_item(p.ple_wp + (size_t)L * 256 * D, 256, D, D, (bf16*)(p.ws + WS_WP) + (size_t)L * D * 256, nullptr, 0, scr, r, lane);
    }
    const size_t gtid = (size_t)bid * NTHREADS + tid, nthr = (size_t)nblk * NTHREADS;
    for (int r = gw; r < 2 * DEPTH * NEXP; r += NGW) {
        const int which = r >= DEPTH * NEXP, rr = which ? r - DEPTH * NEXP : r;
        const float* srow = (which ? p.peer_v : p.peer_u) + (size_t)rr * D + 16 * lane;
        f32x4 v[4];
#pragma unroll
        for (int j = 0; j < 4; ++j) v[j] = *(const f32x4*)(srow + 4 * j);
        float mx = 0.f;
#pragma unroll
        for (int j = 0; j < 4; ++j) mx = fmaxf(mx, fmaxf(fmaxf(fabsf(v[j][0]), fabsf(v[j][1])), fmaxf(fabsf(v[j][2]), fabsf(v[j][3]))));
        mx = xrow16_max(row16_max(mx));
        const float inv = mx > 0.f ? 127.f / mx : 0.f;
        u32x4 o;
#pragma unroll
        for (int j = 0; j < 4; ++j) {
            const unsigned b0 = (unsigned)(__float2int_rn(v[j][0] * inv) + 128), b1 = (unsigned)(__float2int_rn(v[j][1] * inv) + 128), b2 = (unsigned)(__float2int_rn(v[j][2] * inv) + 128), b3 = (unsigned)(__float2int_rn(v[j][3] * inv) + 128);
            o[j] = b0 | (b1 << 8) | (b2 << 16) | (b3 << 24);
        }
        *(u32x4*)(p.ws + (which ? WS_V : WS_U) + (size_t)rr * D + 16 * lane) = o;
        if (lane == 0) ((float*)(p.ws + (which ? WS_SV : WS_SU)))[rr] = mx * (1.f / 127.f);
    }
    convert_bulk(p.p, (bf16*)(p.ws + WS_PB), (size_t)DEPTH * M * 256, gtid, nthr);
    convert_bulk(p.subkeys, (bf16*)(p.ws + WS_SK), (size_t)DEPTH * 8 * 2 * 128 * 128, gtid, nthr);
    float* H = (float*)(p.ws + WS_H); bf16* HB0 = (bf16*)(p.ws + WS_HB0); float* ss0 = (float*)(p.ws + WS_STAT);
    for (int m = gw; m < M; m += NGW) {
        const f32x4* xr = (const f32x4*)(p.x + (size_t)m * D) + lane;
        float ss = 0.f;
#pragma unroll
        for (int j = 0; j < 4; ++j) {
            const f32x4 v = xr[64 * j];
            ss += v[0] * v[0] + v[1] * v[1] + v[2] * v[2] + v[3] * v[3];
            ((f32x4*)(H + (size_t)m * D))[lane + 64 * j] = v;
            u32x2 o; o.x = pk2(v[0], v[1]); o.y = pk2(v[2], v[3]);
            ((u32x2*)(HB0 + (size_t)m * D))[lane + 64 * j] = o;
        }
        ss = wave_sum(ss);
        if (lane < 16) ss0[(size_t)m * 16 + lane] = lane == 0 ? ss : 0.f;
    }
}

typedef short v4i16_t __attribute__((ext_vector_type(4)));
typedef __bf16 bf16x2_t __attribute__((ext_vector_type(2)));
typedef float f32x2_t __attribute__((ext_vector_type(2)));
__device__ __forceinline__ unsigned cvtpk(float lo, float hi) { f32x2_t v = {lo, hi}; bf16x2_t b = __builtin_convertvector(v, bf16x2_t); return __builtin_bit_cast(unsigned, b); }
constexpr int ATT_VOFF = 16384, ATT_VPITCH = 288;
__device__ __forceinline__ void att_unit(const Params& p, int L, LAS unsigned char* lds, int tid, int b, int hh, int qb, float lam, float lam_init) {
    const int lane = tid & 63, w = __builtin_amdgcn_readfirstlane(tid >> 6), fr = lane & 15, fq = lane >> 4;
    const bf16* proj = (const bf16*)(p.ws + WS_PROJ);
    bf16* obuf = (bf16*)(p.ws + WS_OBUF);
    {
        const float slope2 = exp2f(-2.f * (float)(hh + 1)) * 1.4426950408889634f;
        const bf16* kbase = proj + (size_t)b * SEQ * PROJ_W + 512 + hh * 128;
        const bf16* vbase = proj + (size_t)b * SEQ * PROJ_W + 1024 + hh * 128;
        {
            const int qw0 = qb * 128 + w * 16, T = 2 * (qb + 1);
            bf16x8 qf[2][2];
#pragma unroll
            for (int mp = 0; mp < 2; ++mp)
#pragma unroll
                for (int ks = 0; ks < 2; ++ks) qf[mp][ks] = *(const bf16x8*)(proj + ((size_t)b * SEQ + qw0 + fr) * PROJ_W + hh * 128 + mp * 64 + ks * 32 + 8 * fq);
            f32x4 o[2][8];
#pragma unroll
            for (int mp = 0; mp < 2; ++mp)
#pragma unroll
                for (int dt = 0; dt < 8; ++dt) o[mp][dt] = (f32x4){0.f, 0.f, 0.f, 0.f};
            float mrun[2] = {-INFINITY, -INFINITY}, lrun[2] = {0.f, 0.f};
            u32x4 kreg[2], vreg[2];
#pragma unroll
            for (int i = 0; i < 2; ++i) { const int c = tid + 512 * i, key = c >> 4, ch = c & 15;
                kreg[i] = *(const u32x4*)(kbase + (size_t)key * PROJ_W + ch * 8); vreg[i] = *(const u32x4*)(vbase + (size_t)key * PROJ_W + ch * 8); }
            for (int t = 0; t < T; ++t) {
                const int k0 = t * 64;
#pragma unroll
                for (int i = 0; i < 2; ++i) { const int c = tid + 512 * i, key = c >> 4, ch = c & 15;
                    *(LAS u32x4*)(lds + key * 256 + ((ch ^ (key & 15)) << 4)) = kreg[i];
                    *(LAS u32x4*)(lds + ATT_VOFF + key * ATT_VPITCH + ch * 16) = vreg[i]; }
                LDS_BARRIER();
                if (t + 1 < T) {
#pragma unroll
                    for (int i = 0; i < 2; ++i) { const int c = tid + 512 * i, key = k0 + 64 + (c >> 4), ch = c & 15;
                        kreg[i] = *(const u32x4*)(kbase + (size_t)key * PROJ_W + ch * 8); vreg[i] = *(const u32x4*)(vbase + (size_t)key * PROJ_W + ch * 8); }
                }
                if (k0 <= qw0 + 15) {
                    f32x4 s[2][4];
                    const float base = -slope2 * (float)(qw0 + fr - k0 - 4 * fq);
#pragma unroll
                    for (int kt = 0; kt < 4; ++kt)
#pragma unroll
                        for (int r = 0; r < 4; ++r) { const float v = base + slope2 * (float)(16 * kt + r); s[0][kt][r] = v; s[1][kt][r] = v; }
#pragma unroll
                    for (int mp = 0; mp < 2; ++mp)
#pragma unroll
                        for (int kt = 0; kt < 4; ++kt)
#pragma unroll
                            for (int ks = 0; ks < 2; ++ks) {
                                const bf16x8 kf = *(const LAS bf16x8*)(lds + (16 * kt + fr) * 256 + (((mp * 8 + ks * 4 + fq) ^ fr) << 4));
                                s[mp][kt] = __builtin_amdgcn_mfma_f32_16x16x32_bf16(kf, qf[mp][ks], s[mp][kt], 0, 0, 0);
                            }
                    if (k0 + 63 > qw0) {
                        const int lim = qw0 + fr - k0 - 4 * fq;
#pragma unroll
                        for (int mp = 0; mp < 2; ++mp)
#pragma unroll
                            for (int kt = 0; kt < 4; ++kt)
#pragma unroll
                                for (int r = 0; r < 4; ++r) if (16 * kt + r > lim) s[mp][kt][r] = -INFINITY;
                    }
                    bf16x8 pb[2][2];
#pragma unroll
                    for (int mp = 0; mp < 2; ++mp) {
                        float mx = fmaxf(fmaxf(s[mp][0][0], s[mp][0][1]), fmaxf(s[mp][0][2], s[mp][0][3]));
#pragma unroll
                        for (int kt = 1; kt < 4; ++kt) mx = fmaxf(mx, fmaxf(fmaxf(s[mp][kt][0], s[mp][kt][1]), fmaxf(s[mp][kt][2], s[mp][kt][3])));
                        mx = xrow16_max(mx);
                        const float mnew = fmaxf(mrun[mp], mx);
                        const float alpha = __builtin_amdgcn_exp2f(mrun[mp] - mnew);
                        mrun[mp] = mnew;
                        float ps = 0.f;
#pragma unroll
                        for (int kt = 0; kt < 4; ++kt)
#pragma unroll
                            for (int r = 0; r < 4; ++r) { const float e = __builtin_amdgcn_exp2f(s[mp][kt][r] - mnew); s[mp][kt][r] = e; ps += e; }
                        lrun[mp] = lrun[mp] * alpha + ps;
#pragma unroll
                        for (int dt = 0; dt < 8; ++dt) o[mp][dt] = o[mp][dt] * alpha;
#pragma unroll
                        for (int ks = 0; ks < 2; ++ks) {
                            u32x4 pk; pk.x = cvtpk(s[mp][2 * ks][0], s[mp][2 * ks][1]); pk.y = cvtpk(s[mp][2 * ks][2], s[mp][2 * ks][3]);
                            pk.z = cvtpk(s[mp][2 * ks + 1][0], s[mp][2 * ks + 1][1]); pk.w = cvtpk(s[mp][2 * ks + 1][2], s[mp][2 * ks + 1][3]);
                            pb[mp][ks] = __builtin_bit_cast(bf16x8, pk);
                        }
                    }
                    const int gl = lane & 15;
                    LAS unsigned char* vrd = lds + ATT_VOFF + (4 * fq + (gl >> 2)) * ATT_VPITCH + (gl & 3) * 8;
#pragma unroll
                    for (int dt = 0; dt < 8; ++dt)
#pragma unroll
                        for (int ks = 0; ks < 2; ++ks) {
                            const v4i16_t v0 = __builtin_amdgcn_ds_read_tr16_b64_v4i16((LAS v4i16_t*)(vrd + (32 * ks) * ATT_VPITCH + dt * 32));
                            const v4i16_t v1 = __builtin_amdgcn_ds_read_tr16_b64_v4i16((LAS v4i16_t*)(vrd + (32 * ks + 16) * ATT_VPITCH + dt * 32));
                            bf16x8 vf; vf[0] = v0[0]; vf[1] = v0[1]; vf[2] = v0[2]; vf[3] = v0[3]; vf[4] = v1[0]; vf[5] = v1[1]; vf[6] = v1[2]; vf[7] = v1[3];
                            o[0][dt] = __builtin_amdgcn_mfma_f32_16x16x32_bf16(vf, pb[0][ks], o[0][dt], 0, 0, 0);
                            o[1][dt] = __builtin_amdgcn_mfma_f32_16x16x32_bf16(vf, pb[1][ks], o[1][dt], 0, 0, 0);
                        }
                }
                LDS_BARRIER();
            }
            const float i1 = 1.f / xrow16_sum(lrun[0]), i2 = lam / xrow16_sum(lrun[1]);
            float ss = 0.f;
#pragma unroll
            for (int dt = 0; dt < 8; ++dt)
#pragma unroll
                for (int r = 0; r < 4; ++r) { const float v = o[0][dt][r] * i1 - o[1][dt][r] * i2; o[0][dt][r] = v; ss += v * v; }
            ss = xrow16_sum(ss);
            const float rn = rsqrtf(ss * (1.f / 128.f) + EPS) * (1.f - lam_init);
            const float* g = p.subln_g + L * 128;
            bf16* orow = obuf + ((size_t)b * SEQ + qw0 + fr) * D + hh * 128;
#pragma unroll
            for (int dt = 0; dt < 8; ++dt) {
                const f32x4 gv = *(const f32x4*)(g + 16 * dt + 4 * fq);
                u32x2 ov; ov.x = pk2(o[0][dt][0] * rn * gv[0], o[0][dt][1] * rn * gv[1]); ov.y = pk2(o[0][dt][2] * rn * gv[2], o[0][dt][3] * rn * gv[3]);
                *(u32x2*)(orow + 16 * dt + 4 * fq) = ov;
            }
        }
    }
}

__device__ void phase_att_queue(const Params& p, int L, unsigned char* lds_, int bid, int nblk) {
    LAS unsigned char* lds = (LAS unsigned char*)lds_;
    const int tid = tidx(), lane = tid & 63;
    const float* lp = p.diff_lambda + L * 256;
    const float d1 = wave_sum(lp[lane] * lp[64 + lane]), d2 = wave_sum(lp[128 + lane] * lp[192 + lane]);
    const float lam_init = 0.8f - 0.6f * expf(-0.3f * (float)L);
    const float lam = expf(d1) - expf(d2) + lam_init;
    unsigned* head = (unsigned*)(p.ws + WS_CTL) + CW_QUEUE + L;
    volatile LAS int* slot = (volatile LAS int*)(lds + LDS_MISC_OFF + 64);
    for (;;) {
        __syncthreads();
        if (tid == 0) *slot = (int)__hip_atomic_fetch_add(head, 1u, __ATOMIC_RELAXED, __HIP_MEMORY_SCOPE_AGENT);
        __syncthreads();
        const int u = *slot;
        if (u >= 512) break;
        att_unit(p, L, lds, tid, (u & 31) >> 2, u & 3, 15 - (u >> 5), lam, lam_init);
    }
}

constexpr size_t GD_WP = WS_ORAW, GD_QD = WS_ORAW + 16 * MiB, GD_AIP = WS_ORAW + 32 * MiB, GD_KDT = WS_ORAW + 40 * MiB, GD_UT = WS_ORAW + 56 * MiB, GD_GL = WS_ORAW + 72 * MiB;
__device__ __forceinline__ int perm_pos(int k) { return (k & ~31) + 8 * ((k >> 2) & 3) + 4 * ((k >> 4) & 1) + (k & 3); }
__device__ __forceinline__ float softplusf_(float x) { return x > 20.f ? x : log1pf(expf(x)); }

constexpr int GP_KN = 0, GP_QN = 17408, GP_RT = 34816, GP_LM = 71680, GP_TB = 89088, GP_GT = 98304;
constexpr int GP_KP = 272, GP_RP = 144, GP_LP = 68, GP_TP = 144;
__device__ void phase_gdn_prep(const Params& p, int L, unsigned char* lds_, int bid, int nblk) {
    LAS unsigned char* lds = (LAS unsigned char*)lds_;
    const int tid = tidx(), lane = tid & 63, w = __builtin_amdgcn_readfirstlane(tid >> 6), fr = lane & 15, fq = lane >> 4;
    const bf16* proj = (const bf16*)(p.ws + WS_PROJ);
    const float* BA = (const float*)(p.ws + WS_BA);
    bf16* WP = (bf16*)(p.ws + GD_WP); bf16* QD = (bf16*)(p.ws + GD_QD); bf16* AIP = (bf16*)(p.ws + GD_AIP); bf16* KDT = (bf16*)(p.ws + GD_KDT); bf16* UT = (bf16*)(p.ws + GD_UT);
    float* GL = (float*)(p.ws + GD_GL);
    const float* cw = p.conv_w + (size_t)L * 4 * 1536;
    LAS float* beta_s = (LAS float*)(lds + GP_GT); LAS float* gc_s = beta_s + 64; LAS float* egc_s = gc_s + 64; LAS float* edl_s = egc_s + 64;
    LAS float* Lm = (LAS float*)(lds + GP_LM);
    for (int item = bid; item < 1024; item += nblk) {
        const int n = item & 31, bh = item >> 5, hh = bh & 3, b = bh >> 2, t0 = n * 64;
        const size_t row0 = (size_t)b * SEQ + t0;
        __syncthreads();
        if (w == 0) {
            const float negA = -expf(p.a_log[L * 4 + hh]), dtb = p.dt_bias[L * 4 + hh];
            const float bb = BA[(row0 + lane) * 8 + hh], aa = BA[(row0 + lane) * 8 + 4 + hh] + dtb;
            float c = negA * softplusf_(aa);
#pragma unroll
            for (int o = 1; o < 64; o <<= 1) { const float t = __shfl_up(c, o); if (lane >= o) c += t; }
            const float glast = __shfl(c, 63);
            beta_s[lane] = sigmoidf_(bb); gc_s[lane] = c; egc_s[lane] = expf(c); edl_s[lane] = expf(glast - c);
            if (lane == 0) GL[item] = expf(glast);
        }
        __syncthreads();
        {
            const int colq = hh * 128 + 2 * lane;
            {
                float wq[4][2]; unsigned xq[11];
#pragma unroll
                for (int j = 0; j < 4; ++j) { wq[j][0] = cw[j * 1536 + colq]; wq[j][1] = cw[j * 1536 + colq + 1]; }
#pragma unroll
                for (int r = 0; r < 11; ++r) { const int tt = t0 + 8 * w - 3 + r; xq[r] = (tt >= 0) ? *(const unsigned*)(proj + ((size_t)b * SEQ + tt) * PROJ_W + 1536 + colq) : 0u; }
#pragma unroll
                for (int i = 0; i < 8; ++i) {
                    const int c = 8 * w + i;
                    float q0 = 0.f, q1 = 0.f;
#pragma unroll
                    for (int j = 0; j < 4; ++j) { q0 += wq[j][0] * lo16(xq[i + j]); q1 += wq[j][1] * hi16(xq[i + j]); }
                    q0 *= sigmoidf_(q0); q1 *= sigmoidf_(q1);
                    const float sq = rsqrtf(wave_sum(q0 * q0 + q1 * q1) + EPS) * 0.08838834764831845f;
                    q0 *= sq; q1 *= sq;
                    const float eg = egc_s[c];
                    *(LAS unsigned*)(lds + GP_QN + c * GP_KP + lane * 4) = pk2(q0, q1);
                    *(unsigned*)(QD + ((size_t)item * 64 + c) * 128 + perm_pos(2 * lane)) = pk2(q0 * eg, q1 * eg);
                }
            }
            __builtin_amdgcn_sched_barrier(0);
            {
                float wk[4][2]; unsigned xk[11];
#pragma unroll
                for (int j = 0; j < 4; ++j) { wk[j][0] = cw[j * 1536 + 512 + colq]; wk[j][1] = cw[j * 1536 + 512 + colq + 1]; }
#pragma unroll
                for (int r = 0; r < 11; ++r) { const int tt = t0 + 8 * w - 3 + r; xk[r] = (tt >= 0) ? *(const unsigned*)(proj + ((size_t)b * SEQ + tt) * PROJ_W + 1536 + 512 + colq) : 0u; }
                unsigned kd0[8], kd1[8], rk0[8], rk1[8];
#pragma unroll
                for (int i = 0; i < 8; ++i) {
                    const int c = 8 * w + i;
                    float k0 = 0.f, k1 = 0.f;
#pragma unroll
                    for (int j = 0; j < 4; ++j) { k0 += wk[j][0] * lo16(xk[i + j]); k1 += wk[j][1] * hi16(xk[i + j]); }
                    k0 *= sigmoidf_(k0); k1 *= sigmoidf_(k1);
                    const float sk = rsqrtf(wave_sum(k0 * k0 + k1 * k1) + EPS);
                    k0 *= sk; k1 *= sk;
                    const float be = beta_s[c], eg = egc_s[c], ed = edl_s[c];
                    *(LAS unsigned*)(lds + GP_KN + c * GP_KP + lane * 4) = pk2(k0, k1);
                    kd0[i] = f2bf(k0 * ed); kd1[i] = f2bf(k1 * ed);
                    rk0[i] = f2bf(k0 * be * eg); rk1[i] = f2bf(k1 * be * eg);
                }
                u32x4 o;
                o.x = rk0[0] | (rk0[1] << 16); o.y = rk0[2] | (rk0[3] << 16); o.z = rk0[4] | (rk0[5] << 16); o.w = rk0[6] | (rk0[7] << 16); *(LAS u32x4*)(lds + GP_RT + (128 + 2 * lane) * GP_RP + 16 * w) = o;
                o.x = rk1[0] | (rk1[1] << 16); o.y = rk1[2] | (rk1[3] << 16); o.z = rk1[4] | (rk1[5] << 16); o.w = rk1[6] | (rk1[7] << 16); *(LAS u32x4*)(lds + GP_RT + (128 + 2 * lane + 1) * GP_RP + 16 * w) = o;
                const int pa = perm_pos(8 * w), pb = perm_pos(8 * w + 4);
                bf16* kr0 = KDT + ((size_t)item * 128 + 2 * lane) * 64; bf16* kr1 = kr0 + 64;
                u32x2 h2;
                h2.x = kd0[0] | (kd0[1] << 16); h2.y = kd0[2] | (kd0[3] << 16); *(u32x2*)(kr0 + pa) = h2;
                h2.x = kd0[4] | (kd0[5] << 16); h2.y = kd0[6] | (kd0[7] << 16); *(u32x2*)(kr0 + pb) = h2;
                h2.x = kd1[0] | (kd1[1] << 16); h2.y = kd1[2] | (kd1[3] << 16); *(u32x2*)(kr1 + pa) = h2;
                h2.x = kd1[4] | (kd1[5] << 16); h2.y = kd1[6] | (kd1[7] << 16); *(u32x2*)(kr1 + pb) = h2;
            }
            __builtin_amdgcn_sched_barrier(0);
            {
                float wv[4][2]; unsigned xv[11];
#pragma unroll
                for (int j = 0; j < 4; ++j) { wv[j][0] = cw[j * 1536 + 1024 + colq]; wv[j][1] = cw[j * 1536 + 1024 + colq + 1]; }
#pragma unroll
                for (int r = 0; r < 11; ++r) { const int tt = t0 + 8 * w - 3 + r; xv[r] = (tt >= 0) ? *(const unsigned*)(proj + ((size_t)b * SEQ + tt) * PROJ_W + 1536 + 1024 + colq) : 0u; }
                unsigned rv0[8], rv1[8];
#pragma unroll
                for (int i = 0; i < 8; ++i) {
                    float v0 = 0.f, v1 = 0.f;
#pragma unroll
                    for (int j = 0; j < 4; ++j) { v0 += wv[j][0] * lo16(xv[i + j]); v1 += wv[j][1] * hi16(xv[i + j]); }
                    v0 *= sigmoidf_(v0); v1 *= sigmoidf_(v1);
                    const float be = beta_s[8 * w + i];
                    rv0[i] = f2bf(v0 * be); rv1[i] = f2bf(v1 * be);
                }
                u32x4 o;
                o.x = rv0[0] | (rv0[1] << 16); o.y = rv0[2] | (rv0[3] << 16); o.z = rv0[4] | (rv0[5] << 16); o.w = rv0[6] | (rv0[7] << 16); *(LAS u32x4*)(lds + GP_RT + (2 * lane) * GP_RP + 16 * w) = o;
                o.x = rv1[0] | (rv1[1] << 16); o.y = rv1[2] | (rv1[3] << 16); o.z = rv1[4] | (rv1[5] << 16); o.w = rv1[6] | (rv1[7] << 16); *(LAS u32x4*)(lds + GP_RT + (2 * lane + 1) * GP_RP + 16 * w) = o;
            }
        }
        __syncthreads();
#pragma unroll
        for (int q = 0; q < 2; ++q) {
            const int id = 2 * w + q, ct = id >> 2, st = id & 3;
            if (st <= ct) {
                f32x4 acc = (f32x4){0.f, 0.f, 0.f, 0.f};
#pragma unroll
                for (int ks = 0; ks < 4; ++ks) {
                    const bf16x8 a = *(const LAS bf16x8*)(lds + GP_KN + (16 * ct + fr) * GP_KP + (32 * ks + 8 * fq) * 2);
                    const bf16x8 bb = *(const LAS bf16x8*)(lds + GP_KN + (16 * st + fr) * GP_KP + (32 * ks + 8 * fq) * 2);
                    acc = __builtin_amdgcn_mfma_f32_16x16x32_bf16(a, bb, acc, 0, 0, 0);
                }
                const int s = 16 * st + fr; const float gs = gc_s[s];
#pragma unroll
                for (int r = 0; r < 4; ++r) { const int c = 16 * ct + 4 * fq + r;
                    Lm[c * GP_LP + s] = (s < c) ? beta_s[c] * acc[r] * expf(fminf(gc_s[c] - gs, 0.f)) : 0.f; }
            }
        }
        __syncthreads();
        if (w == 0) {
            float t[64];
            int zoff = 0; asm volatile("" : "+v"(zoff));
            const LAS float* Lz = Lm + zoff;
#pragma unroll
            for (int i = 0; i < 64; ++i) {
                float a0 = (i == lane) ? 1.f : 0.f, a1 = 0.f, a2 = 0.f, a3 = 0.f;
#pragma unroll
                for (int s4 = 0; s4 + 4 <= i; s4 += 4) { const f32x4 lv = *(const LAS f32x4*)(Lz + i * GP_LP + s4);
                    a0 -= lv[0] * t[s4]; a1 -= lv[1] * t[s4 + 1]; a2 -= lv[2] * t[s4 + 2]; a3 -= lv[3] * t[s4 + 3]; }
#pragma unroll
                for (int s = i & ~3; s < i; ++s) a0 -= Lz[i * GP_LP + s] * t[s];
                t[i] = (a0 + a1) + (a2 + a3);
                *(LAS bf16*)(lds + GP_TB + i * GP_TP + lane * 2) = (bf16)f2bf(t[i]);
                if ((i & 3) == 3) __builtin_amdgcn_sched_barrier(0);
            }
        } else {
            for (int id = w - 1; id < 16; id += 7) {
                const int ct = id >> 2, st = id & 3;
                f32x4 acc = (f32x4){0.f, 0.f, 0.f, 0.f};
                if (st <= ct) {
#pragma unroll
                    for (int ks = 0; ks < 4; ++ks) {
                        const bf16x8 a = *(const LAS bf16x8*)(lds + GP_QN + (16 * ct + fr) * GP_KP + (32 * ks + 8 * fq) * 2);
                        const bf16x8 bb = *(const LAS bf16x8*)(lds + GP_KN + (16 * st + fr) * GP_KP + (32 * ks + 8 * fq) * 2);
                        acc = __builtin_amdgcn_mfma_f32_16x16x32_bf16(a, bb, acc, 0, 0, 0);
                    }
                }
                const int s = 16 * st + fr; const float gs = gc_s[s]; const int ps = perm_pos(s);
#pragma unroll
                for (int r = 0; r < 4; ++r) { const int c = 16 * ct + 4 * fq + r;
                    const float v = (s <= c) ? acc[r] * expf(fminf(gc_s[c] - gs, 0.f)) : 0.f;
                    AIP[((size_t)item * 64 + c) * 64 + ps] = (bf16)f2bf(v); }
            }
        }
        __syncthreads();
#pragma unroll
        for (int q = 0; q < 2; ++q) {
            const int colt = 2 * w + q;
            bf16x8 af[2];
#pragma unroll
            for (int ks = 0; ks < 2; ++ks) af[ks] = *(const LAS bf16x8*)(lds + GP_RT + (16 * colt + fr) * GP_RP + (32 * ks + 8 * fq) * 2);
#pragma unroll
            for (int ct = 0; ct < 4; ++ct) {
                f32x4 acc = (f32x4){0.f, 0.f, 0.f, 0.f};
#pragma unroll
                for (int ks = 0; ks < 2; ++ks) {
                    const bf16x8 bb = *(const LAS bf16x8*)(lds + GP_TB + (16 * ct + fr) * GP_TP + (32 * ks + 8 * fq) * 2);
                    acc = __builtin_amdgcn_mfma_f32_16x16x32_bf16(af[ks], bb, acc, 0, 0, 0);
                }
                const int c = 16 * ct + fr;
                if (colt < 8) {
#pragma unroll
                    for (int r = 0; r < 4; ++r) UT[((size_t)item * 128 + 16 * colt + 4 * fq + r) * 64 + c] = (bf16)f2bf(acc[r]);
                } else {
                    const int kt = colt - 8;
                    u32x2 h2; h2.x = pk2(-acc[0], -acc[1]); h2.y = pk2(-acc[2], -acc[3]);
                    *(u32x2*)(WP + ((size_t)item * 64 + c) * 128 + 32 * (kt >> 1) + 8 * fq + 4 * (kt & 1)) = h2;
                }
            }
        }
    }
    __syncthreads();
}

constexpr int GS_WP = 0, GS_QD = 17408, GS_AIP = 34816, GS_KDT = 44032, GS_BUF = 62464, GS_OB = 2 * GS_BUF, GS_OBP = 272;
__device__ void phase_gdn_scan(const Params& p, int L, unsigned char* lds_, int bid, int nblk) {
    LAS unsigned char* lds = (LAS unsigned char*)lds_;
    const int tid = tidx(), lane = tid & 63, w = __builtin_amdgcn_readfirstlane(tid >> 6), fr = lane & 15, fq = lane >> 4;
    const bf16* proj = (const bf16*)(p.ws + WS_PROJ);
    const bf16* WP = (const bf16*)(p.ws + GD_WP); const bf16* QD = (const bf16*)(p.ws + GD_QD); const bf16* AIP = (const bf16*)(p.ws + GD_AIP);
    const bf16* KDT = (const bf16*)(p.ws + GD_KDT); const bf16* UT = (const bf16*)(p.ws + GD_UT); const float* GL = (const float*)(p.ws + GD_GL);
    bf16* obuf = (bf16*)(p.ws + WS_OBUF);
    for (int item = bid; item < 32; item += nblk) {
        const int hh = item & 3, b = item >> 2;
        const int fc = tid >> 4, fv = tid & 15;
        float gn[8];
#pragma unroll
        for (int i = 0; i < 8; ++i) gn[i] = p.gdn_norm_g[L * 128 + 8 * fv + i];
        f32x4 S[8];
#pragma unroll
        for (int kt = 0; kt < 8; ++kt) S[kt] = (f32x4){0.f, 0.f, 0.f, 0.f};
        u32x4 st[7];
        auto gload = [&](int ci) {
#pragma unroll
            for (int i = 0; i < 7; ++i) {
                const int pc = tid + 512 * i;
                const bf16* src;
                if (i < 2) src = WP + (size_t)ci * 8192 + pc * 8;
                else if (i < 4) src = QD + (size_t)ci * 8192 + (pc - 1024) * 8;
                else if (i < 5) src = AIP + (size_t)ci * 4096 + (pc - 2048) * 8;
                else src = KDT + (size_t)ci * 8192 + (pc - 2560) * 8;
                st[i] = *(const u32x4*)src;
            }
        };
        auto lstore = [&](int buf) {
#pragma unroll
            for (int i = 0; i < 7; ++i) {
                const int pc = tid + 512 * i;
                int off;
                if (i < 2) off = GS_WP + (pc >> 4) * 272 + (pc & 15) * 16;
                else if (i < 4) { const int q = pc - 1024; off = GS_QD + (q >> 4) * 272 + (q & 15) * 16; }
                else if (i < 5) { const int q = pc - 2048; off = GS_AIP + (q >> 3) * 144 + (q & 7) * 16; }
                else { const int q = pc - 2560; off = GS_KDT + (q >> 3) * 144 + (q & 7) * 16; }
                *(LAS u32x4*)(lds + buf * GS_BUF + off) = st[i];
            }
        };
        __syncthreads();
        gload(item * 32); lstore(0);
        u32x2 ut[4]; float gl;
        {
            const int ci = item * 32;
#pragma unroll
            for (int ct = 0; ct < 4; ++ct) ut[ct] = *(const u32x2*)(UT + ((size_t)ci * 128 + 16 * w + fr) * 64 + 16 * ct + 4 * fq);
            gl = GL[ci];
        }
        __syncthreads();
        for (int n = 0; n < 32; ++n) {
            const int ci = item * 32 + n, buf = n & 1;
            const size_t rowc = (size_t)b * SEQ + n * 64;
            u32x2 utn[4]; float gln = 0.f;
            if (n + 1 < 32) {
                gload(ci + 1);
#pragma unroll
                for (int ct = 0; ct < 4; ++ct) utn[ct] = *(const u32x2*)(UT + ((size_t)(ci + 1) * 128 + 16 * w + fr) * 64 + 16 * ct + 4 * fq);
                gln = GL[ci + 1];
            }
            u32x4 zq[2];
#pragma unroll
            for (int ps = 0; ps < 2; ++ps) zq[ps] = *(const u32x4*)(proj + (rowc + 32 * ps + fc) * PROJ_W + 3072 + hh * 128 + 8 * fv);
            f32x4 vn[4], oacc[4];
#pragma unroll
            for (int ct = 0; ct < 4; ++ct) { vn[ct] = (f32x4){lo16(ut[ct].x), hi16(ut[ct].x), lo16(ut[ct].y), hi16(ut[ct].y)}; oacc[ct] = (f32x4){0.f, 0.f, 0.f, 0.f}; }
            bf16x8 sb[4];
#pragma unroll
            for (int ks = 0; ks < 4; ++ks) { u32x4 pk; pk.x = cvtpk(S[2 * ks][0], S[2 * ks][1]); pk.y = cvtpk(S[2 * ks][2], S[2 * ks][3]); pk.z = cvtpk(S[2 * ks + 1][0], S[2 * ks + 1][1]); pk.w = cvtpk(S[2 * ks + 1][2], S[2 * ks + 1][3]);
                sb[ks] = __builtin_bit_cast(bf16x8, pk); }
            LAS unsigned char* bb = lds + buf * GS_BUF;
            bf16x8 f0[8], f1[8];
#define LD_A(F, ct) do { _Pragma("unroll") for (int ks = 0; ks < 4; ++ks) { F[ks] = *(const LAS bf16x8*)(bb + GS_WP + (16 * (ct) + fr) * 272 + (32 * ks + 8 * fq) * 2); \
                    F[4 + ks] = *(const LAS bf16x8*)(bb + GS_QD + (16 * (ct) + fr) * 272 + (32 * ks + 8 * fq) * 2); } } while (0)
#define MM_A(F, ct) do { _Pragma("unroll") for (int ks = 0; ks < 4; ++ks) { vn[ct] = __builtin_amdgcn_mfma_f32_16x16x32_bf16(F[ks], sb[ks], vn[ct], 0, 0, 0); \
                    oacc[ct] = __builtin_amdgcn_mfma_f32_16x16x32_bf16(F[4 + ks], sb[ks], oacc[ct], 0, 0, 0); } } while (0)
#define SBAR() __builtin_amdgcn_sched_barrier(0)
            LD_A(f0, 0); SBAR();
            LD_A(f1, 1); MM_A(f0, 0); SBAR();
            LD_A(f0, 2); MM_A(f1, 1); SBAR();
            LD_A(f1, 3); MM_A(f0, 2); SBAR();
#pragma unroll
            for (int ct = 0; ct < 4; ++ct)
#pragma unroll
                for (int ss = 0; ss < 2; ++ss) f0[2 * ct + ss] = *(const LAS bf16x8*)(bb + GS_AIP + (16 * ct + fr) * 144 + (32 * ss + 8 * fq) * 2);
            MM_A(f1, 3); SBAR();
            bf16x8 vb[2];
#pragma unroll
            for (int ss = 0; ss < 2; ++ss) { u32x4 pk; pk.x = cvtpk(vn[2 * ss][0], vn[2 * ss][1]); pk.y = cvtpk(vn[2 * ss][2], vn[2 * ss][3]); pk.z = cvtpk(vn[2 * ss + 1][0], vn[2 * ss + 1][1]); pk.w = cvtpk(vn[2 * ss + 1][2], vn[2 * ss + 1][3]);
                vb[ss] = __builtin_bit_cast(bf16x8, pk); }
#pragma unroll
            for (int kt = 0; kt < 4; ++kt)
#pragma unroll
                for (int ss = 0; ss < 2; ++ss) f1[2 * kt + ss] = *(const LAS bf16x8*)(bb + GS_KDT + (16 * kt + fr) * 144 + (32 * ss + 8 * fq) * 2);
#pragma unroll
            for (int ct = 0; ct < 4; ++ct)
#pragma unroll
                for (int ss = 0; ss < 2; ++ss) oacc[ct] = __builtin_amdgcn_mfma_f32_16x16x32_bf16(f0[2 * ct + ss], vb[ss], oacc[ct], 0, 0, 0);
            SBAR();
#pragma unroll
            for (int kt = 4; kt < 8; ++kt)
#pragma unroll
                for (int ss = 0; ss < 2; ++ss) f0[2 * (kt - 4) + ss] = *(const LAS bf16x8*)(bb + GS_KDT + (16 * kt + fr) * 144 + (32 * ss + 8 * fq) * 2);
#pragma unroll
            for (int kt = 0; kt < 4; ++kt) {
                S[kt] = S[kt] * gl;
#pragma unroll
                for (int ss = 0; ss < 2; ++ss) S[kt] = __builtin_amdgcn_mfma_f32_16x16x32_bf16(f1[2 * kt + ss], vb[ss], S[kt], 0, 0, 0);
            }
            SBAR();
#pragma unroll
            for (int kt = 4; kt < 8; ++kt) {
                S[kt] = S[kt] * gl;
#pragma unroll
                for (int ss = 0; ss < 2; ++ss) S[kt] = __builtin_amdgcn_mfma_f32_16x16x32_bf16(f0[2 * (kt - 4) + ss], vb[ss], S[kt], 0, 0, 0);
            }
#undef LD_A
#undef MM_A
#undef SBAR
            LDS_BARRIER();
#pragma unroll
            for (int ct = 0; ct < 4; ++ct)
#pragma unroll
                for (int r = 0; r < 4; r += 2) {
                    const unsigned pk = cvtpk(oacc[ct][r], oacc[ct][r + 1]);
                    *(LAS bf16*)(lds + GS_OB + (16 * ct + 4 * fq + r) * GS_OBP + (16 * w + fr) * 2) = (bf16)(pk & 0xffffu);
                    *(LAS bf16*)(lds + GS_OB + (16 * ct + 4 * fq + r + 1) * GS_OBP + (16 * w + fr) * 2) = (bf16)(pk >> 16);
                }
            if (n + 1 < 32) {
                lstore(buf ^ 1);
#pragma unroll
                for (int ct = 0; ct < 4; ++ct) ut[ct] = utn[ct];
                gl = gln;
            }
            LDS_BARRIER();
#pragma unroll
            for (int ps = 0; ps < 2; ++ps) {
                const int c = 32 * ps + fc;
                const u32x4 ov = *(const LAS u32x4*)(lds + GS_OB + c * GS_OBP + fv * 16);
                float o8[8];
#pragma unroll
                for (int i = 0; i < 4; ++i) { o8[2 * i] = lo16(ov[i]); o8[2 * i + 1] = hi16(ov[i]); }
                float ss = 0.f;
#pragma unroll
                for (int i = 0; i < 8; ++i) ss += o8[i] * o8[i];
                const float rn = rsqrtf(row16_sum(ss) * (1.f / 128.f) + EPS);
                u32x4 res;
#pragma unroll
                for (int i = 0; i < 4; ++i) {
                    const float z0 = lo16(zq[ps][i]), z1 = hi16(zq[ps][i]);
                    res[i] = cvtpk(o8[2 * i] * rn * gn[2 * i] * (z0 * sigmoidf_(z0)), o8[2 * i + 1] * rn * gn[2 * i + 1] * (z1 * sigmoidf_(z1)));
                }
                *(u32x4*)(obuf + (rowc + c) * D + 512 + hh * 128 + 8 * fv) = res;
            }
        }
        __syncthreads();
    }
}

__device__ __forceinline__ unsigned sortable(float f) { const unsigned u = __float_as_uint(f); return u ^ ((unsigned)((int)u >> 31) | 0x80000000u); }
__device__ __forceinline__ float unsortable(unsigned s) { return __uint_as_float((s & 0x80000000u) ? (s ^ 0x80000000u) : ~s); }
#define CE(a, b) do { const unsigned _x = k[a], _y = k[b]; k[a] = _x > _y ? _x : _y; k[b] = _x > _y ? _y : _x; } while (0)
constexpr int PE_TK = 0, PE_TAB = 8192, PE_ID = 8448, PE_GT = PE_ID + 32768;
__device__ void phase_peer(const Params& p, int L, unsigned char* lds_, int bid, int nblk) {
    LAS unsigned char* lds = (LAS unsigned char*)lds_;
    const int tid = tidx(), lane = tid & 63, w = __builtin_amdgcn_readfirstlane(tid >> 6), fr = lane & 15, fq = lane >> 4;
    const bf16* Q2 = (const bf16*)(p.ws + WS_Q2);
    const bf16* SK = (const bf16*)(p.ws + WS_SK) + (size_t)L * 8 * 2 * 128 * 128;
    float* H = (float*)(p.ws + WS_H); bf16* HB2 = (bf16*)(p.ws + WS_HB2);
    const unsigned char* U = p.ws + WS_U + (size_t)L * NEXP * D;
    const unsigned char* V = p.ws + WS_V + (size_t)L * NEXP * D;
    const float* SU = (const float*)(p.ws + WS_SU) + (size_t)L * NEXP; const float* SV = (const float*)(p.ws + WS_SV) + (size_t)L * NEXP;
    const float* g = p.ln_ffn_g + L * D;
    LAS unsigned* TK = (LAS unsigned*)(lds + PE_TK);
    LAS unsigned short* TAB = (LAS unsigned short*)(lds + PE_TAB);
    LAS int* IDL = (LAS int*)(lds + PE_ID); LAS float* GTL = (LAS float*)(lds + PE_GT);
    if (tid < 64) {
        int a = 0, base = 0, q = tid; unsigned short v = 0xffff;
        if (q < 50) { for (;;) { const int cnt = 16 / (a + 1); if (q < base + cnt) break; base += cnt; ++a; } v = (unsigned short)((a << 8) | (q - base)); }
        TAB[tid] = v;
    }
    for (int item = bid; item < M / 64; item += nblk) {
        const int tok0 = item * 64;
        __syncthreads();
        const int tg = w & 3, cc = w >> 2;
        for (int hh = 0; hh < 8; ++hh) {
            {
                f32x4 acc[8];
#pragma unroll
                for (int nt = 0; nt < 8; ++nt) acc[nt] = (f32x4){0.f, 0.f, 0.f, 0.f};
                bf16x8 qa[4];
#pragma unroll
                for (int ks = 0; ks < 4; ++ks) qa[ks] = *(const bf16x8*)(Q2 + (size_t)(tok0 + 16 * tg + fr) * 2048 + hh * 256 + cc * 128 + 32 * ks + 8 * fq);
                const bf16* skb = SK + ((size_t)(hh * 2 + cc) * 128 + fr) * 128 + 8 * fq;
#pragma unroll
                for (int nt = 0; nt < 8; ++nt)
#pragma unroll
                    for (int ks = 0; ks < 4; ++ks) {
                        const bf16x8 kb = *(const bf16x8*)(skb + (size_t)nt * 16 * 128 + 32 * ks);
                        acc[nt] = __builtin_amdgcn_mfma_f32_16x16x32_bf16(qa[ks], kb, acc[nt], 0, 0, 0);
                    }
#pragma unroll
                for (int r = 0; r < 4; ++r) {
                    unsigned k[8];
#pragma unroll
                    for (int nt = 0; nt < 8; ++nt) k[nt] = (sortable(acc[nt][r]) & ~0x7Fu) | (unsigned)(127 - (16 * nt + fr));
                    CE(0, 1); CE(2, 3); CE(4, 5); CE(6, 7); CE(0, 2); CE(1, 3); CE(4, 6); CE(5, 7); CE(1, 2); CE(5, 6); CE(0, 4); CE(3, 7);
                    CE(1, 5); CE(2, 6); CE(1, 4); CE(3, 6); CE(2, 4); CE(3, 5); CE(3, 4);
                    unsigned res = 0u;
#pragma unroll
                    for (int rd = 0; rd < 16; ++rd) {
                        const unsigned m = row16_umax(k[0]);
                        const bool win = k[0] == m;
#pragma unroll
                        for (int i = 0; i < 7; ++i) k[i] = win ? k[i + 1] : k[i];
                        k[7] = win ? 0u : k[7];
                        res = (fr == rd) ? m : res;
                    }
                    TK[(cc * 64 + 16 * tg + 4 * fq + r) * 16 + fr] = res;
                }
            }
            __syncthreads();
#pragma unroll
            for (int ps = 0; ps < 2; ++ps) {
                const int tl = 8 * w + 4 * ps + fq;
                unsigned k[4];
#pragma unroll
                for (int sl = 0; sl < 4; ++sl) {
                    const int q = sl * 16 + fr;
                    const unsigned ab = TAB[q];
                    const unsigned k1 = TK[tl * 16 + ((ab >> 8) & 15)], k2 = TK[(64 + tl) * 16 + (ab & 15)];
                    const float v = unsortable(k1 & ~0x7Fu) + unsortable(k2 & ~0x7Fu);
                    k[sl] = (q < 50) ? ((sortable(v) & ~0x3Fu) | (unsigned)(63 - q)) : 0u;
                }
                CE(0, 1); CE(2, 3); CE(0, 2); CE(1, 3); CE(1, 2);
                unsigned res = 0u;
#pragma unroll
                for (int rd = 0; rd < 16; ++rd) {
                    const unsigned m = row16_umax(k[0]);
                    const bool win = k[0] == m;
                    k[0] = win ? k[1] : k[0]; k[1] = win ? k[2] : k[1]; k[2] = win ? k[3] : k[2]; k[3] = win ? 0u : k[3];
                    res = (fr == rd) ? m : res;
                }
                const unsigned ab = TAB[63 - (res & 0x3Fu)];
                const unsigned k1 = TK[tl * 16 + ((ab >> 8) & 15)], k2 = TK[(64 + tl) * 16 + (ab & 15)];
                const float v = unsortable(k1 & ~0x7Fu) + unsortable(k2 & ~0x7Fu);
                const float e = __expf(v - row16_max(v));
                const float sum = row16_sum(e);
                IDL[tl * 128 + hh * 16 + fr] = (int)((127u - (k1 & 0x7Fu)) * 128u + (127u - (k2 & 0x7Fu)));
                GTL[tl * 128 + hh * 16 + fr] = e / sum;
            }
            __syncthreads();
        }
        for (int ti = 0; ti < 8; ++ti) {
            const int tl = 8 * w + ti, tok = tok0 + tl;
            float* hrow = H + (size_t)tok * D + 16 * lane;
            float xv[16];
#pragma unroll
            for (int j = 0; j < 4; ++j) { const f32x4 a = *(const f32x4*)(hrow + 4 * j); xv[4 * j] = a[0]; xv[4 * j + 1] = a[1]; xv[4 * j + 2] = a[2]; xv[4 * j + 3] = a[3]; }
            float ss = 0.f;
#pragma unroll
            for (int i = 0; i < 16; ++i) ss += xv[i] * xv[i];
            const float rstd = rsqrtf(wave_sum(ss) * (1.f / D) + EPS);
            float xn[16], xs = 0.f;
#pragma unroll
            for (int i = 0; i < 16; ++i) { xn[i] = xv[i] * rstd * g[16 * lane + i]; xs += xn[i]; }
            const float xoff = 128.f * wave_sum(xs);
            const int id0 = IDL[tl * 128 + lane], id1 = IDL[tl * 128 + 64 + lane];
            const float su0 = SU[id0], su1 = SU[id1], sv0 = SV[id0], sv1 = SV[id1];
            float h0 = 0.f, h1 = 0.f;
            u32x4 ring[16];
#pragma unroll
            for (int j = 0; j < 16; ++j) ring[j] = *(const u32x4*)(U + (size_t)IDL[tl * 128 + j] * D + 16 * lane);
#pragma unroll 1
            for (int k = 0; k < 8; ++k) {
#pragma unroll
                for (int j = 0; j < 16; ++j) {
                    const u32x4 a = ring[j];
                    if (k < 7) ring[j] = *(const u32x4*)(U + (size_t)IDL[tl * 128 + 16 * (k + 1) + j] * D + 16 * lane);
                    float d = 0.f;
#pragma unroll
                    for (int q = 0; q < 4; ++q) { d += xn[4 * q] * (float)(a[q] & 0xffu) + xn[4 * q + 1] * (float)((a[q] >> 8) & 0xffu) + xn[4 * q + 2] * (float)((a[q] >> 16) & 0xffu) + xn[4 * q + 3] * (float)(a[q] >> 24); }
                    d = wave_sum(d);
                    const int e = 16 * k + j;
                    if (lane == (e & 63)) { if (k < 4) h0 = d; else h1 = d; }
                }
            }
            h0 = su0 * (h0 - xoff); h1 = su1 * (h1 - xoff);
            const float w0 = sv0 * GTL[tl * 128 + lane] * 0.5f * h0 * (1.f + erff(h0 * 0.70710678118654752f));
            const float w1 = sv1 * GTL[tl * 128 + 64 + lane] * 0.5f * h1 * (1.f + erff(h1 * 0.70710678118654752f));
            const float woff = 128.f * wave_sum(w0 + w1);
            float y[16];
#pragma unroll
            for (int i = 0; i < 16; ++i) y[i] = 0.f;
#pragma unroll
            for (int j = 0; j < 16; ++j) ring[j] = *(const u32x4*)(V + (size_t)IDL[tl * 128 + j] * D + 16 * lane);
#pragma unroll 1
            for (int k = 0; k < 8; ++k) {
#pragma unroll
                for (int j = 0; j < 16; ++j) {
                    const u32x4 a = ring[j];
                    if (k < 7) ring[j] = *(const u32x4*)(V + (size_t)IDL[tl * 128 + 16 * (k + 1) + j] * D + 16 * lane);
                    const int e = 16 * k + j;
                    const float ww = __uint_as_float((unsigned)__builtin_amdgcn_readlane((int)__float_as_uint(k < 4 ? w0 : w1), e & 63));
#pragma unroll
                    for (int q = 0; q < 4; ++q) { y[4 * q] += ww * (float)(a[q] & 0xffu); y[4 * q + 1] += ww * (float)((a[q] >> 8) & 0xffu); y[4 * q + 2] += ww * (float)((a[q] >> 16) & 0xffu); y[4 * q + 3] += ww * (float)(a[q] >> 24); }
                }
            }
#pragma unroll
            for (int i = 0; i < 16; ++i) y[i] += xv[i] - woff;
#pragma unroll
            for (int j = 0; j < 4; ++j) *(f32x4*)(hrow + 4 * j) = (f32x4){y[4 * j], y[4 * j + 1], y[4 * j + 2], y[4 * j + 3]};
            bf16* hb = HB2 + (size_t)tok * D + 16 * lane;
            u32x4 o; o.x = pk2(y[0], y[1]); o.y = pk2(y[2], y[3]); o.z = pk2(y[4], y[5]); o.w = pk2(y[6], y[7]);
            *(u32x4*)hb = o;
            o.x = pk2(y[8], y[9]); o.y = pk2(y[10], y[11]); o.z = pk2(y[12], y[13]); o.w = pk2(y[14], y[15]);
            *(u32x4*)(hb + 8) = o;
        }
    }
    __syncthreads();
}
#undef CE

__device__ void phase_final(const Params& p, int bid, int nblk) {
    const int tid = tidx(), lane = tid & 63, gw = bid * NWAVES + (tid >> 6), NGW = nblk * NWAVES;
    const float* H = (const float*)(p.ws + WS_H);
    for (int m = gw; m < M; m += NGW) {
        f32x4 v[4]; float ss = 0.f;
#pragma unroll
        for (int j = 0; j < 4; ++j) { v[j] = ((const f32x4*)(H + (size_t)m * D))[lane + 64 * j]; ss += (v[j][0] * v[j][0] + v[j][1] * v[j][1]) + (v[j][2] * v[j][2] + v[j][3] * v[j][3]); }
        const float r = rsqrtf(wave_sum(ss) * (1.f / D) + EPS);
#pragma unroll
        for (int j = 0; j < 4; ++j) { const f32x4 gv = ((const f32x4*)p.final_g)[lane + 64 * j]; ((f32x4*)(p.out + (size_t)m * D))[lane + 64 * j] = v[j] * r * gv; }
    }
}

#define XB_TMO      128
#define XB_XCNT(j)  (256  + 64 * (j))
#define XB_XSUB(j)  (1280 + 64 * (j))
#define XB_XGEN(j)  (2304 + 64 * (j))
#define XB_TOP      3328
#define XB_TOPGEN   3392
#define XCD_BAR_WORDS 3456
#define XB_SPIN_CAP (1u << 22)
__device__ __forceinline__ unsigned xb_ld(unsigned* p)              { return __hip_atomic_load(p, __ATOMIC_RELAXED, __HIP_MEMORY_SCOPE_AGENT); }
__device__ __forceinline__ unsigned xb_add(unsigned* p, unsigned v) { return __hip_atomic_fetch_add(p, v, __ATOMIC_RELAXED, __HIP_MEMORY_SCOPE_AGENT); }
__device__ __forceinline__ unsigned xb_xcc_id() { return (unsigned)__builtin_amdgcn_s_getreg((3 << 11) | 20) & 0xFu; }
#define XB_SPIN(cond, bar) do { unsigned _sp = 0; while (cond) { __builtin_amdgcn_s_sleep(1); \
    if ((++_sp & 255u) == 0u) { if (xb_ld(&(bar)[XB_TMO])) break; if (_sp > XB_SPIN_CAP) { atomicAdd(&(bar)[XB_TMO], 1u); break; } } } } while (0)
struct XcdBarrier { unsigned* bar; unsigned x; volatile LAS unsigned* st; };
__device__ __forceinline__ XcdBarrier xcd_barrier_post(unsigned* bar, volatile LAS unsigned* st) {
    XcdBarrier b; b.bar = bar; b.x = xb_xcc_id(); b.st = st;
    if (threadIdx.x == 0) (void)xb_add(&bar[XB_XCNT(b.x)], 1u);
    return b;
}
__device__ __forceinline__ void xcd_barrier_complete(unsigned* bar, unsigned x, unsigned& nloc, unsigned& nx) {
    const unsigned G = gridDim.x * gridDim.y * gridDim.z;
    unsigned sum, cnt, mine, sp = 0u;
    for (;;) {
        sum = 0u; cnt = 0u; mine = 0u;
#pragma unroll
        for (unsigned j = 0; j < 16; ++j) { const unsigned c = xb_ld(&bar[XB_XCNT(j)]); sum += c; cnt += (c > 0u) ? 1u : 0u; mine = (j == x) ? c : mine; }
        if (sum == G) break;
        __builtin_amdgcn_s_sleep(1);
        if ((++sp & 255u) == 0u) { if (xb_ld(&bar[XB_TMO])) break; if (sp > XB_SPIN_CAP) { atomicAdd(&bar[XB_TMO], 1u); break; } }
    }
    nloc = mine > 0u ? mine : 1u; nx = cnt > 0u ? cnt : 1u;
}
__device__ __forceinline__ void xcd_barrier(const XcdBarrier& b) {
    asm volatile("s_waitcnt vmcnt(0)" ::: "memory");
    __syncthreads();
    if (threadIdx.x == 0) {
        unsigned* bar = b.bar;
        __builtin_amdgcn_s_waitcnt(0);
        unsigned nloc = b.st[0], nx = b.st[1];
        if (nloc == 0u) { xcd_barrier_complete(bar, b.x, nloc, nx); b.st[0] = nloc; b.st[1] = nx; }
        const unsigned old = xb_add(&bar[XB_XSUB(b.x)], 1u);
        const unsigned gen = old / nloc;
        if (old + 1u == (gen + 1u) * nloc) {
            __builtin_amdgcn_fence(__ATOMIC_RELEASE, "agent");
            asm volatile("s_waitcnt vmcnt(0)" ::: "memory");
            const unsigned og = xb_add(&bar[XB_TOP], 1u);
            const unsigned tg = og / nx;
            if (og + 1u == (tg + 1u) * nx) xb_add(&bar[XB_TOPGEN], 1u);
            else XB_SPIN(xb_ld(&bar[XB_TOPGEN]) == tg, bar);
            __builtin_amdgcn_fence(__ATOMIC_ACQUIRE, "agent");
            xb_add(&bar[XB_XGEN(b.x)], 1u);
            asm volatile("s_waitcnt vmcnt(0)" ::: "memory");
        } else {
            XB_SPIN(xb_ld(&bar[XB_XGEN(b.x)]) == gen, bar);
            __builtin_amdgcn_fence(__ATOMIC_ACQUIRE, "agent");
            asm volatile("s_waitcnt vmcnt(0)" ::: "memory");
        }
    }
    __syncthreads();
}
constexpr int CW_BAR = 4096;

constexpr int K_PROLOGUE = 11, K_FINAL = 12;
template <int KIND>
__device__ __forceinline__ void run_kind(const Params& p, int L, unsigned char* lds, int bid, int nblk) {
    unsigned char* ws = p.ws;
    float* H = (float*)(ws + WS_H);
    float* ss0 = (float*)(ws + WS_STAT); float* ss1 = (float*)(ws + WS_SS1); float* sse = (float*)(ws + WS_SSE);
    if constexpr (KIND == K_PROLOGUE) phase_prologue(p, lds, bid, nblk);
    if constexpr (KIND == K_FINAL) phase_final(p, bid, nblk);
    if constexpr (KIND == 0) { EpiProj E{nullptr, (bf16*)(ws + WS_PROJ), (float*)(ws + WS_BA)};
        gemm_run(lds, (const bf16*)(ws + WS_HB0), (const bf16*)(ws + WS_WIN) + (size_t)L * IN_PAD * D, M, IN_PAD, D, E, bid, nblk, ss0); }
    if constexpr (KIND == 1) phase_gdn_prep(p, L, lds, bid, nblk);
    if constexpr (KIND == 2) { phase_gdn_scan(p, L, lds, bid, nblk); phase_att_queue(p, L, lds, bid, nblk); }
    if constexpr (KIND == 3) { EpiRes E{ss1, H, (bf16*)(ws + WS_HB1)};
        gemm_run(lds, (const bf16*)(ws + WS_OBUF), (const bf16*)(ws + WS_WOUT) + (size_t)L * D * D, M, D, D, E, bid, nblk); }
    if constexpr (KIND == 4) { EpiQ2 E{nullptr, (bf16*)(ws + WS_Q2)};
        gemm_run(lds, (const bf16*)(ws + WS_HB1), (const bf16*)(ws + WS_WQ) + (size_t)L * 2048 * D, M, 2048, D, E, bid, nblk, ss1);
        EpiE E2{sse, (bf16*)(ws + WS_EPRE)};
        gemm_run(lds, (const bf16*)(ws + WS_PB) + (size_t)L * M * 256, (const bf16*)(ws + WS_WP) + (size_t)L * D * 256, M, D, 256, E2, bid, nblk); }
    if constexpr (KIND == 5) phase_peer(p, L, lds, bid, nblk);
    if constexpr (KIND == 6) { EpiPle E{ss0, H, (bf16*)(ws + WS_HB0), (const bf16*)(ws + WS_EPRE), p.ple_norm_g + L * D};
        gemm_run(lds, (const bf16*)(ws + WS_HB2), (const bf16*)(ws + WS_WG) + (size_t)L * D * D, M, D, D, E, bid, nblk, sse); }
}

__device__ __forceinline__ Params params_off(const Params& s, size_t z) {
    Params q;
    q.x = s.x + z; q.p = s.p + z; q.ln_mix_g = s.ln_mix_g + z; q.w_in = s.w_in + z; q.conv_w = s.conv_w + z; q.a_log = s.a_log + z; q.dt_bias = s.dt_bias + z;
    q.gdn_norm_g = s.gdn_norm_g + z; q.diff_lambda = s.diff_lambda + z; q.subln_g = s.subln_g + z; q.w_out = s.w_out + z; q.ln_ffn_g = s.ln_ffn_g + z;
    q.peer_wq = s.peer_wq + z; q.subkeys = s.subkeys + z; q.peer_u = s.peer_u + z; q.peer_v = s.peer_v + z; q.ple_wp = s.ple_wp + z; q.ple_wg = s.ple_wg + z;
    q.ple_norm_g = s.ple_norm_g + z; q.final_g = s.final_g + z; q.out = s.out + z; q.ws = s.ws + z; q.pad0 = 0; q.pad1 = 0;
    return q;
}
#define RUN(KIND) do { size_t z_ = 0; int L_ = L; asm volatile("" : "+s"(z_), "+s"(L_)); const Params q_ = params_off(p, z_); run_kind<KIND>(q_, L_, lds, bid, nblk); } while (0)
__global__ void __launch_bounds__(NTHREADS, 2) mk_fwd(Params p) {
    extern __shared__ __attribute__((aligned(16))) unsigned char lds[];
    const int bid = (int)blockIdx.x, nblk = (int)gridDim.x;
    volatile LAS unsigned* misc = (volatile LAS unsigned*)((LAS unsigned char*)lds + LDS_MISC_OFF);
    if (threadIdx.x < 64) misc[threadIdx.x] = 0u;
    __syncthreads();
    XcdBarrier bar = xcd_barrier_post((unsigned*)(p.ws + WS_CTL) + CW_BAR, misc + 8);
    { int L = 0; RUN(K_PROLOGUE); }
    cg::this_grid().sync();
#pragma nounroll
    for (int L = 0; L < DEPTH; ++L) {
        RUN(0); xcd_barrier(bar);
        RUN(1); xcd_barrier(bar);
        RUN(2); xcd_barrier(bar);
        RUN(3); xcd_barrier(bar);
        RUN(4); xcd_barrier(bar);
        RUN(5); xcd_barrier(bar);
        RUN(6); xcd_barrier(bar);
    }
    { int L = 0; RUN(K_FINAL); }
}

extern "C" void kernel_launch(void* const* d_in, const int* in_sizes, int n_in, void* d_out, int out_size, void* d_ws, size_t ws_size, hipStream_t stream) {
    static int grid = 0;
    if (grid == 0) {
        if (n_in != 20 || out_size != M * D || ws_size < WS_END) { fprintf(stderr, "kernel_launch: unexpected shapes (n_in %d, out %d, ws %zu < %zu)\n", n_in, out_size, ws_size, (size_t)WS_END); grid = -1; return; }
        int dev = 0, cus = 0, per_cu = 0;
        (void)hipGetDevice(&dev); (void)hipDeviceGetAttribute(&cus, hipDeviceAttributeMultiprocessorCount, dev);
        if (hipFuncSetAttribute((const void*)mk_fwd, hipFuncAttributeMaxDynamicSharedMemorySize, LDS_BYTES) != hipSuccess) { fprintf(stderr, "kernel_launch: hipFuncSetAttribute failed\n"); grid = -1; return; }
        if (hipOccupancyMaxActiveBlocksPerMultiprocessor(&per_cu, (const void*)mk_fwd, NTHREADS, LDS_BYTES) != hipSuccess || per_cu < 1) { fprintf(stderr, "kernel_launch: occupancy query says %d blocks per CU\n", per_cu); (void)hipGetLastError(); grid = -1; return; }
        grid = (cus > 0 ? cus : 256);
    }
    if (grid < 0) return;
    (void)hipMemsetAsync((char*)d_ws + WS_CTL, 0, CTL_ZERO_BYTES, stream);
    Params p{};
    const float** pp = (const float**)&p;
    for (int i = 0; i < 20; ++i) pp[i] = (const float*)d_in[i];
    p.out = (float*)d_out; p.ws = (unsigned char*)d_ws;
    void* args[] = {&p};
    hipError_t e = hipLaunchCooperativeKernel((const void*)mk_fwd, dim3(grid), dim3(NTHREADS), args, LDS_BYTES, stream);
    if (e != hipSuccess) fprintf(stderr, "kernel_launch: cooperative launch failed: %s (grid %d)\n", hipGetErrorString(e), grid);
}
```

```cpp
#include <hip/hip_runtime.h>
#include <hip/hip_cooperative_groups.h>
#include <cstdio>
#include <cstdint>
namespace cg = cooperative_groups;

typedef unsigned short bf16;
typedef float f32x4 __attribute__((ext_vector_type(4)));
typedef short bf16x8 __attribute__((ext_vector_type(8)));
typedef unsigned u32x4 __attribute__((ext_vector_type(4)));
typedef unsigned u32x2 __attribute__((ext_vector_type(2)));

constexpr int D = 1024, BATCH = 8, SEQ = 2048, DEPTH = 4, M = BATCH * SEQ;
constexpr int IN_COLS = 3592, IN_PAD = 3840, PROJ_W = 3584;
constexpr int NEXP = 16384;
constexpr float EPS = 1e-6f;
constexpr float QSCALE = 0.125f * 1.4426950408889634f;
constexpr int NWAVES = 8, NTHREADS = 512;
constexpr int LDS_BYTES = 163840;
constexpr int LDS_MISC_OFF = LDS_BYTES - 256;
constexpr int RS_OFF = 147456;
constexpr int CW_QUEUE = 1024;

constexpr size_t MiB = 1u << 20;
constexpr size_t WS_CTL = 0, CTL_ZERO_BYTES = 1 * MiB;
constexpr size_t WS_H = 1 * MiB;
constexpr size_t WS_HB0 = 65 * MiB;
constexpr size_t WS_HB1 = 97 * MiB;
constexpr size_t WS_HB2 = 129 * MiB;
constexpr size_t WS_PROJ = 161 * MiB;
constexpr size_t WS_BA = 273 * MiB;
constexpr size_t WS_OBUF = 274 * MiB;
constexpr size_t WS_Q2 = 306 * MiB;
constexpr size_t WS_EPRE = 370 * MiB;
constexpr size_t WS_IDX = 402 * MiB;
constexpr size_t WS_GATE = 410 * MiB;
constexpr size_t WS_STAT = 418 * MiB;
constexpr size_t WS_SS1 = WS_IDX + 1 * MiB, WS_SSE = WS_IDX;
constexpr size_t WS_ORAW = 422 * MiB;
constexpr size_t WS_WIN = 550 * MiB;
constexpr size_t WS_WOUT = 582 * MiB;
constexpr size_t WS_WQ = 590 * MiB;
constexpr size_t WS_WG = 606 * MiB;
constexpr size_t WS_WP = 614 * MiB;
constexpr size_t WS_SK = 616 * MiB;
constexpr size_t WS_PB = 618 * MiB;
constexpr size_t WS_U = 650 * MiB;
constexpr size_t WS_V = 778 * MiB;
constexpr size_t WS_SU = WS_STAT + 1 * MiB, WS_SV = WS_STAT + 2 * MiB;
constexpr size_t WS_END = 906 * MiB;

struct Params {
    const float *x, *p, *ln_mix_g, *w_in, *conv_w, *a_log, *dt_bias, *gdn_norm_g, *diff_lambda, *subln_g, *w_out, *ln_ffn_g,
        *peer_wq, *subkeys, *peer_u, *peer_v, *ple_wp, *ple_wg, *ple_norm_g, *final_g;
    float* out;
    unsigned char* ws;
    int pad0, pad1;
};

__device__ __forceinline__ int tidx() { int t = (int)threadIdx.x; asm volatile("" : "+v"(t)); return t; }
#define LDS_BARRIER() asm volatile("s_waitcnt lgkmcnt(0)\n\ts_barrier" ::: "memory")
__device__ __forceinline__ float bf2f(bf16 v) { return __uint_as_float((unsigned)v << 16); }
__device__ __forceinline__ unsigned f2bf(float f) { unsigned u = __float_as_uint(f); return (u + 0x7fffu + ((u >> 16) & 1u)) >> 16; }
__device__ __forceinline__ unsigned pk2(float lo, float hi) { return f2bf(lo) | (f2bf(hi) << 16); }
__device__ __forceinline__ float lo16(unsigned w) { return __uint_as_float(w << 16); }
__device__ __forceinline__ float hi16(unsigned w) { return __uint_as_float(w & 0xffff0000u); }
template <int N> __device__ __forceinline__ float dpp_ror(float x) { return __builtin_bit_cast(float, __builtin_amdgcn_mov_dpp(__builtin_bit_cast(int, x), 0x120 + N, 0xf, 0xf, true)); }
template <int N> __device__ __forceinline__ unsigned dpp_ror_u(unsigned x) { return (unsigned)__builtin_amdgcn_mov_dpp((int)x, 0x120 + N, 0xf, 0xf, true); }
__device__ __forceinline__ float row16_sum(float x) { x += dpp_ror<8>(x); x += dpp_ror<4>(x); x += dpp_ror<2>(x); x += dpp_ror<1>(x); return x; }
__device__ __forceinline__ float row16_max(float x) { x = fmaxf(x, dpp_ror<8>(x)); x = fmaxf(x, dpp_ror<4>(x)); x = fmaxf(x, dpp_ror<2>(x)); x = fmaxf(x, dpp_ror<1>(x)); return x; }
__device__ __forceinline__ unsigned row16_umax(unsigned x) { unsigned y;
    y = dpp_ror_u<8>(x); x = x > y ? x : y; y = dpp_ror_u<4>(x); x = x > y ? x : y; y = dpp_ror_u<2>(x); x = x > y ? x : y; y = dpp_ror_u<1>(x); x = x > y ? x : y; return x; }
__device__ __forceinline__ float xrow16_max(float x) {
    auto s = __builtin_amdgcn_permlane16_swap(__float_as_uint(x), __float_as_uint(x), false, false);
    x = fmaxf(__uint_as_float(s[0]), __uint_as_float(s[1]));
    auto t = __builtin_amdgcn_permlane32_swap(__float_as_uint(x), __float_as_uint(x), false, false);
    return fmaxf(__uint_as_float(t[0]), __uint_as_float(t[1]));
}
__device__ __forceinline__ float xrow16_sum(float x) {
    auto s = __builtin_amdgcn_permlane16_swap(__float_as_uint(x), __float_as_uint(x), false, false);
    x = __uint_as_float(s[0]) + __uint_as_float(s[1]);
    auto t = __builtin_amdgcn_permlane32_swap(__float_as_uint(x), __float_as_uint(x), false, false);
    return __uint_as_float(t[0]) + __uint_as_float(t[1]);
}
__device__ __forceinline__ float wave_sum(float v) { return xrow16_sum(row16_sum(v)); }
__device__ __forceinline__ float wave_max(float v) {
#pragma unroll
    for (int o = 32; o; o >>= 1) v = fmaxf(v, __shfl_xor(v, o));
    return v;
}
__device__ __forceinline__ float sigmoidf_(float x) { return 1.f / (1.f + __expf(-x)); }
__device__ __forceinline__ float dot8(u32x4 a, u32x4 b, float s) {
#pragma unroll
    for (int i = 0; i < 4; ++i) { s += lo16(a[i]) * lo16(b[i]); s += hi16(a[i]) * hi16(b[i]); }
    return s;
}

#define LAS __attribute__((address_space(3)))
__host__ __device__ __forceinline__ int lds_byte(int r, int c) { const int st = (r >> 4) * 2 + (c >> 5), rr = r & 15, cc = c & 31, ob = rr * 64 + cc * 2; return st * 1024 + (ob ^ (((ob >> 9) & 1) << 5)); }
__host__ __device__ __forceinline__ void stage_rc(int b, int& R, int& C) { const int st = b / 1024, sb = b % 1024, swz = sb ^ (((sb >> 9) & 1) << 5); R = (st >> 1) * 16 + swz / 64; C = (st & 1) * 32 + (swz % 64) / 2; }
constexpr int HTB = 16384;
template <class F>
__device__ __forceinline__ void gemm_run(unsigned char* lds_, const bf16* A, const bf16* Bt, int Mm, int N, int K, const F& f, int bid, int nblk, const float* slots_in = nullptr) {
    LAS unsigned char* lds = (LAS unsigned char*)lds_;
    LAS float* RS = (LAS float*)(lds + RS_OFF);
    if (slots_in) {
        const int t = tidx();
        if (t < 256) { const f32x4* sp = (const f32x4*)(slots_in + ((size_t)(bid % (Mm / 256)) * 256 + t) * 16);
            const f32x4 a = sp[0], b = sp[1], c = sp[2], d = sp[3];
            const float s = (((a[0] + a[1]) + (a[2] + a[3])) + ((b[0] + b[1]) + (b[2] + b[3]))) + (((c[0] + c[1]) + (c[2] + c[3])) + ((d[0] + d[1]) + (d[2] + d[3])));
            RS[t] = rsqrtf(s * (1.f / D) + EPS); }
        __syncthreads();
    }
    const int tid = tidx(), wid = __builtin_amdgcn_readfirstlane(tid >> 6), lane = tid & 63, wr = wid >> 2, wc = wid & 3, fr = lane & 15, fq = lane >> 4;
    const int nt = K / 64, ntn = N / 256, nunits = (Mm / 256) * ntn;
    unsigned voff[2];
#pragma unroll
    for (int i = 0; i < 2; ++i) { int R, C; stage_rc(tid * 16 + i * 8192, R, C); voff[i] = (unsigned)(R * K + C) * 2u; }
    const unsigned ldsw = (unsigned)wid * 1024u;
    const int aoff = wr * HTB + lds_byte(fr, fq * 8), boff = (2 + (wc >> 1)) * HTB + lds_byte((wc & 1) * 64 + fr, fq * 8);
#define G_STAGE(bufoff, gbase) do { _Pragma("unroll") for (int _i = 0; _i < 2; ++_i) \
        __builtin_amdgcn_global_load_lds((const unsigned*)((const char*)(gbase) + voff[_i]), (LAS unsigned*)(lds + (bufoff) + ldsw + _i * 8192), 16, 0, 0); } while (0)
    for (int u = bid; u < nunits; u += nblk) {
        const int pm = u % (Mm / 256), pn = u / (Mm / 256);
        const char* gA = (const char*)(A + (size_t)pm * 256 * K);
        const char* gB = (const char*)(Bt + (size_t)pn * 256 * K);
        const size_t hstep = (size_t)128 * K * 2;
        f32x4 acc[8][4];
#pragma unroll
        for (int a = 0; a < 8; ++a)
#pragma unroll
            for (int b = 0; b < 4; ++b) acc[a][b] = (f32x4){0.f, 0.f, 0.f, 0.f};
        G_STAGE(0, gA); G_STAGE(HTB, gA + hstep); G_STAGE(2 * HTB, gB); G_STAGE(3 * HTB, gB + hstep);
        for (int t = 0; t < nt; ++t) {
            const int cb = (t & 1) * 4 * HTB, nb = ((t + 1) & 1) * 4 * HTB;
            asm volatile("s_waitcnt vmcnt(0)" ::: "memory");
            __builtin_amdgcn_s_barrier();
            asm volatile("" ::: "memory");
            if (t + 1 < nt) { const size_t ko = (size_t)(t + 1) * 128; G_STAGE(nb, gA + ko); G_STAGE(nb + HTB, gA + hstep + ko); G_STAGE(nb + 2 * HTB, gB + ko); G_STAGE(nb + 3 * HTB, gB + hstep + ko); }
#pragma unroll
            for (int k = 0; k < 2; ++k) {
                bf16x8 af[8], bfr[4];
#pragma unroll
                for (int n = 0; n < 4; ++n) bfr[n] = *(const LAS bf16x8*)(lds + cb + boff + n * 2048 + k * 1024);
#pragma unroll
                for (int m = 0; m < 8; ++m) af[m] = *(const LAS bf16x8*)(lds + cb + aoff + m * 2048 + k * 1024);
#pragma unroll
                for (int m = 0; m < 8; ++m)
#pragma unroll
                    for (int n = 0; n < 4; ++n) acc[m][n] = __builtin_amdgcn_mfma_f32_16x16x32_bf16(bfr[n], af[m], acc[m][n], 0, 0, 0);
                __builtin_amdgcn_sched_barrier(0);
            }
            asm volatile("s_waitcnt lgkmcnt(0)" ::: "memory");
        }
#pragma unroll
        for (int m = 0; m < 8; ++m) {
            const int lrow = wr * 128 + m * 16 + fr, row = pm * 256 + lrow;
            float ssq = 0.f;
#pragma unroll
            for (int n = 0; n < 4; ++n) { const f32x4 r = f(row, RS[lrow], pn * 256 + wc * 64 + n * 16 + 4 * fq, acc[m][n]); ssq += (r[0] * r[0] + r[1] * r[1]) + (r[2] * r[2] + r[3] * r[3]); }
            if constexpr (F::STATS) { ssq = xrow16_sum(ssq); if (fq == 0) f.slots[(size_t)row * 16 + pn * 4 + wc] = ssq; }
        }
        __syncthreads();
    }
#undef G_STAGE
}

__device__ __forceinline__ u32x2 pk4(f32x4 a) { u32x2 o; o.x = pk2(a[0], a[1]); o.y = pk2(a[2], a[3]); return o; }
struct EpiProj {
    static constexpr bool STATS = false; float* slots;
    bf16* proj; float* ba;
    __device__ __forceinline__ f32x4 operator()(int row, float rstd, int col, f32x4 v) const {
        v = v * rstd;
        if (col < PROJ_W) *(u32x2*)(proj + (size_t)row * PROJ_W + col) = pk4(v);
        else if (col < IN_COLS) *(f32x4*)(ba + (size_t)row * 8 + (col - PROJ_W)) = v;
        return v;
    }
};
struct EpiRes {
    static constexpr bool STATS = true; float* slots;
    float* H; bf16* HB;
    __device__ __forceinline__ f32x4 operator()(int row, float, int col, f32x4 v) const {
        f32x4* hp = (f32x4*)(H + (size_t)row * D + col);
        const f32x4 h = *hp + v; *hp = h;
        *(u32x2*)(HB + (size_t)row * D + col) = pk4(h);
        return h;
    }
};
struct EpiQ2 {
    static constexpr bool STATS = false; float* slots;
    bf16* Q2;
    __device__ __forceinline__ f32x4 operator()(int row, float rstd, int col, f32x4 v) const { v = v * rstd; *(u32x2*)(Q2 + (size_t)row * 2048 + col) = pk4(v); return v; }
};
struct EpiE {
    static constexpr bool STATS = true; float* slots;
    bf16* E;
    __device__ __forceinline__ f32x4 operator()(int row, float, int col, f32x4 v) const { *(u32x2*)(E + (size_t)row * D + col) = pk4(v); return v; }
};
struct EpiPle {
    static constexpr bool STATS = true; float* slots;
    float* H; bf16* HB; const bf16* E; const float* g;
    __device__ __forceinline__ f32x4 operator()(int row, float rstde, int col, f32x4 v) const {
        f32x4* hp = (f32x4*)(H + (size_t)row * D + col);
        const u32x2 ev = *(const u32x2*)(E + (size_t)row * D + col);
        const f32x4 gv = *(const f32x4*)(g + col);
        f32x4 h = *hp;
        h[0] += sigmoidf_(v[0]) * (lo16(ev.x) * rstde * gv[0]); h[1] += sigmoidf_(v[1]) * (hi16(ev.x) * rstde * gv[1]);
        h[2] += sigmoidf_(v[2]) * (lo16(ev.y) * rstde * gv[2]); h[3] += sigmoidf_(v[3]) * (hi16(ev.y) * rstde * gv[3]);
        *hp = h;
        *(u32x2*)(HB + (size_t)row * D + col) = pk4(h);
        return h;
    }
};

__device__ __forceinline__ void transpose_item(const float* W, int K, int N, int Npad, bf16* WT, const float* rowscale, int qcols, float* scr, int item, int lane) {
    const int nblk = Npad / 32, kb = item / nblk, nb = item % nblk, k0 = 64 * kb, n0 = 32 * nb;
    const int n = n0 + (lane & 31);
#pragma unroll 8
    for (int i = 0; i < 32; ++i) {
        const int kk = 2 * i + (lane >> 5);
        float v = (n < N) ? W[(size_t)(k0 + kk) * N + n] : 0.f;
        if (rowscale) v *= rowscale[k0 + kk];
        if (n < qcols) v *= QSCALE;
        scr[kk * 33 + (lane & 31)] = v;
    }
    asm volatile("s_waitcnt lgkmcnt(0)" ::: "memory");
    const int c = lane & 7;
#pragma unroll
    for (int j = 0; j < 4; ++j) {
        const int nn = (lane >> 3) + 8 * j; const float* s = scr + (8 * c) * 33 + nn;
        u32x4 o; o.x = pk2(s[0 * 33], s[1 * 33]); o.y = pk2(s[2 * 33], s[3 * 33]); o.z = pk2(s[4 * 33], s[5 * 33]); o.w = pk2(s[6 * 33], s[7 * 33]);
        *(u32x4*)(WT + (size_t)(n0 + nn) * K + k0 + 8 * c) = o;
    }
    asm volatile("s_waitcnt lgkmcnt(0)" ::: "memory");
}
__device__ __forceinline__ void convert_bulk(const float* src, bf16* dst, size_t n, size_t gtid, size_t nthr) {
    for (size_t i = gtid * 8; i < n; i += nthr * 8) {
        const f32x4 a = *(const f32x4*)(src + i), b = *(const f32x4*)(src + i + 4);
        u32x4 o; o.x = pk2(a[0], a[1]); o.y = pk2(a[2], a[3]); o.z = pk2(b[0], b[1]); o.w = pk2(b[2], b[3]);
        *(u32x4*)(dst + i) = o;
    }
}
__device__ void phase_prologue(const Params& p, unsigned char* lds, int bid, int nblk) {
    const int tid = tidx(), lane = tid & 63, w = tid >> 6;
    const int gw = bid * NWAVES + w, NGW = nblk * NWAVES;
    float* scr = (float*)(lds + w * 16384);
    constexpr int I_IN = 16 * (IN_PAD / 32), I_OUT = 16 * 32, I_Q = 16 * 64, I_G = 16 * 32, I_P = 4 * 32, I_L = I_IN + I_OUT + I_Q + I_G + I_P;
    for (int it = gw; it < DEPTH * I_L; it += NGW) {
        const int L = it / I_L; int r = it % I_L;
        if (r < I_IN) { transpose_item(p.w_in + (size_t)L * D * IN_COLS, D, IN_COLS, IN_PAD, (bf16*)(p.ws + WS_WIN) + (size_t)L * IN_PAD * D, p.ln_mix_g + L * D, 512, scr, r, lane); continue; } r -= I_IN;
        if (r < I_OUT) { transpose_item(p.w_out + (size_t)L * D * D, D, D, D, (bf16*)(p.ws + WS_WOUT) + (size_t)L * D * D, nullptr, 0, scr, r, lane); continue; } r -= I_OUT;
        if (r < I_Q) { transpose_item(p.peer_wq + (size_t)L * D * 2048, D, 2048, 2048, (bf16*)(p.ws + WS_WQ) + (size_t)L * 2048 * D, p.ln_ffn_g + L * D, 0, scr, r, lane); continue; } r -= I_Q;
        if (r < I_G) { transpose_item(p.ple_wg + (size_t)L * D * D, D, D, D, (bf16*)(p.ws + WS_WG) + (size_t)L * D * D, nullptr, 0, scr, r, lane); continue; } r -= I_G;
        transpose_item(p.ple_wp + (size_t)L * 256 * D, 256, D, D, (bf16*)(p.ws + WS_WP) + (size_t)L * D * 256, nullptr, 0, scr, r, lane);
    }
    const size_t gtid = (size_t)bid * NTHREADS + tid, nthr = (size_t)nblk * NTHREADS;
    for (int r = gw; r < 2 * DEPTH * NEXP; r += NGW) {
        const int which = r >= DEPTH * NEXP, rr = which ? r - DEPTH * NEXP : r;
        const float* srow = (which ? p.peer_v : p.peer_u) + (size_t)rr * D + 16 * lane;
        f32x4 v[4];
#pragma unroll
        for (int j = 0; j < 4; ++j) v[j] = *(const f32x4*)(srow + 4 * j);
        float mx = 0.f;
#pragma unroll
        for (int j = 0; j < 4; ++j) mx = fmaxf(mx, fmaxf(fmaxf(fabsf(v[j][0]), fabsf(v[j][1])), fmaxf(fabsf(v[j][2]), fabsf(v[j][3]))));
        mx = xrow16_max(row16_max(mx));
        const float inv = mx > 0.f ? 127.f / mx : 0.f;
        u32x4 o;
#pragma unroll
        for (int j = 0; j < 4; ++j) {
            const unsigned b0 = (unsigned)(__float2int_rn(v[j][0] * inv) + 128), b1 = (unsigned)(__float2int_rn(v[j][1] * inv) + 128), b2 = (unsigned)(__float2int_rn(v[j][2] * inv) + 128), b3 = (unsigned)(__float2int_rn(v[j][3] * inv) + 128);
            o[j] = b0 | (b1 << 8) | (b2 << 16) | (b3 << 24);
        }
        *(u32x4*)(p.ws + (which ? WS_V : WS_U) + (size_t)rr * D + 16 * lane) = o;
        if (lane == 0) ((float*)(p.ws + (which ? WS_SV : WS_SU)))[rr] = mx * (1.f / 127.f);
    }
    convert_bulk(p.p, (bf16*)(p.ws + WS_PB), (size_t)DEPTH * M * 256, gtid, nthr);
    convert_bulk(p.subkeys, (bf16*)(p.ws + WS_SK), (size_t)DEPTH * 8 * 2 * 128 * 128, gtid, nthr);
    float* H = (float*)(p.ws + WS_H); bf16* HB0 = (bf16*)(p.ws + WS_HB0); float* ss0 = (float*)(p.ws + WS_STAT);
    for (int m = gw; m < M; m += NGW) {
        const f32x4* xr = (const f32x4*)(p.x + (size_t)m * D) + lane;
        float ss = 0.f;
#pragma unroll
        for (int j = 0; j < 4; ++j) {
            const f32x4 v = xr[64 * j];
            ss += v[0] * v[0] + v[1] * v[1] + v[2] * v[2] + v[3] * v[3];
            ((f32x4*)(H + (size_t)m * D))[lane + 64 * j] = v;
            u32x2 o; o.x = pk2(v[0], v[1]); o.y = pk2(v[2], v[3]);
            ((u32x2*)(HB0 + (size_t)m * D))[lane + 64 * j] = o;
        }
        ss = wave_sum(ss);
        if (lane < 16) ss0[(size_t)m * 16 + lane] = lane == 0 ? ss : 0.f;
    }
}

typedef short v4i16_t __attribute__((ext_vector_type(4)));
typedef __bf16 bf16x2_t __attribute__((ext_vector_type(2)));
typedef float f32x2_t __attribute__((ext_vector_type(2)));
__device__ __forceinline__ unsigned cvtpk(float lo, float hi) { f32x2_t v = {lo, hi}; bf16x2_t b = __builtin_convertvector(v, bf16x2_t); return __builtin_bit_cast(unsigned, b); }
constexpr int ATT_VOFF = 16384, ATT_VPITCH = 288;
__device__ __forceinline__ void att_unit(const Params& p, int L, LAS unsigned char* lds, int tid, int b, int hh, int qb, float lam, float lam_init) {
    const int lane = tid & 63, w = __builtin_amdgcn_readfirstlane(tid >> 6), fr = lane & 15, fq = lane >> 4;
    const bf16* proj = (const bf16*)(p.ws + WS_PROJ);
    bf16* obuf = (bf16*)(p.ws + WS_OBUF);
    {
        const float slope2 = exp2f(-2.f * (float)(hh + 1)) * 1.4426950408889634f;
        const bf16* kbase = proj + (size_t)b * SEQ * PROJ_W + 512 + hh * 128;
        const bf16* vbase = proj + (size_t)b * SEQ * PROJ_W + 1024 + hh * 128;
        {
            const int qw0 = qb * 128 + w * 16, T = 2 * (qb + 1);
            bf16x8 qf[2][2];
#pragma unroll
            for (int mp = 0; mp < 2; ++mp)
#pragma unroll
                for (int ks = 0; ks < 2; ++ks) qf[mp][ks] = *(const bf16x8*)(proj + ((size_t)b * SEQ + qw0 + fr) * PROJ_W + hh * 128 + mp * 64 + ks * 32 + 8 * fq);
            f32x4 o[2][8];
#pragma unroll
            for (int mp = 0; mp < 2; ++mp)
#pragma unroll
                for (int dt = 0; dt < 8; ++dt) o[mp][dt] = (f32x4){0.f, 0.f, 0.f, 0.f};
            float mrun[2] = {-INFINITY, -INFINITY}, lrun[2] = {0.f, 0.f};
            u32x4 kreg[2], vreg[2];
#pragma unroll
            for (int i = 0; i < 2; ++i) { const int c = tid + 512 * i, key = c >> 4, ch = c & 15;
                kreg[i] = *(const u32x4*)(kbase + (size_t)key * PROJ_W + ch * 8); vreg[i] = *(const u32x4*)(vbase + (size_t)key * PROJ_W + ch * 8); }
            for (int t = 0; t < T; ++t) {
                const int k0 = t * 64;
#pragma unroll
                for (int i = 0; i < 2; ++i) { const int c = tid + 512 * i, key = c >> 4, ch = c & 15;
                    *(LAS u32x4*)(lds + key * 256 + ((ch ^ (key & 15)) << 4)) = kreg[i];
                    *(LAS u32x4*)(lds + ATT_VOFF + key * ATT_VPITCH + ch * 16) = vreg[i]; }
                LDS_BARRIER();
                if (t + 1 < T) {
#pragma unroll
                    for (int i = 0; i < 2; ++i) { const int c = tid + 512 * i, key = k0 + 64 + (c >> 4), ch = c & 15;
                        kreg[i] = *(const u32x4*)(kbase + (size_t)key * PROJ_W + ch * 8); vreg[i] = *(const u32x4*)(vbase + (size_t)key * PROJ_W + ch * 8); }
                }
                if (k0 <= qw0 + 15) {
                    f32x4 s[2][4];
                    const float base = -slope2 * (float)(qw0 + fr - k0 - 4 * fq);
#pragma unroll
                    for (int kt = 0; kt < 4; ++kt)
#pragma unroll
                        for (int r = 0; r < 4; ++r) { const float v = base + slope2 * (float)(16 * kt + r); s[0][kt][r] = v; s[1][kt][r] = v; }
#pragma unroll
                    for (int mp = 0; mp < 2; ++mp)
#pragma unroll
                        for (int kt = 0; kt < 4; ++kt)
#pragma unroll
                            for (int ks = 0; ks < 2; ++ks) {
                                const bf16x8 kf = *(const LAS bf16x8*)(lds + (16 * kt + fr) * 256 + (((mp * 8 + ks * 4 + fq) ^ fr) << 4));
                                s[mp][kt] = __builtin_amdgcn_mfma_f32_16x16x32_bf16(kf, qf[mp][ks], s[mp][kt], 0, 0, 0);
                            }
                    if (k0 + 63 > qw0) {
                        const int lim = qw0 + fr - k0 - 4 * fq;
#pragma unroll
                        for (int mp = 0; mp < 2; ++mp)
#pragma unroll
                            for (int kt = 0; kt < 4; ++kt)
#pragma unroll
                                for (int r = 0; r < 4; ++r) if (16 * kt + r > lim) s[mp][kt][r] = -INFINITY;
                    }
                    bf16x8 pb[2][2];
#pragma unroll
                    for (int mp = 0; mp < 2; ++mp) {
                        float mx = fmaxf(fmaxf(s[mp][0][0], s[mp][0][1]), fmaxf(s[mp][0][2], s[mp][0][3]));
#pragma unroll
                        for (int kt = 1; kt < 4; ++kt) mx = fmaxf(mx, fmaxf(fmaxf(s[mp][kt][0], s[mp][kt][1]), fmaxf(s[mp][kt][2], s[mp][kt][3])));
                        mx = xrow16_max(mx);
                        const float mnew = fmaxf(mrun[mp], mx);
                        const float alpha = __builtin_amdgcn_exp2f(mrun[mp] - mnew);
                        mrun[mp] = mnew;
                        float ps = 0.f;
#pragma unroll
                        for (int kt = 0; kt < 4; ++kt)
#pragma unroll
                            for (int r = 0; r < 4; ++r) { const float e = __builtin_amdgcn_exp2f(s[mp][kt][r] - mnew); s[mp][kt][r] = e; ps += e; }
                        lrun[mp] = lrun[mp] * alpha + ps;
#pragma unroll
                        for (int dt = 0; dt < 8; ++dt) o[mp][dt] = o[mp][dt] * alpha;
#pragma unroll
                        for (int ks = 0; ks < 2; ++ks) {
                            u32x4 pk; pk.x = cvtpk(s[mp][2 * ks][0], s[mp][2 * ks][1]); pk.y = cvtpk(s[mp][2 * ks][2], s[mp][2 * ks][3]);
                            pk.z = cvtpk(s[mp][2 * ks + 1][0], s[mp][2 * ks + 1][1]); pk.w = cvtpk(s[mp][2 * ks + 1][2], s[mp][2 * ks + 1][3]);
                            pb[mp][ks] = __builtin_bit_cast(bf16x8, pk);
                        }
                    }
                    const int gl = lane & 15;
                    LAS unsigned char* vrd = lds + ATT_VOFF + (4 * fq + (gl >> 2)) * ATT_VPITCH + (gl & 3) * 8;
#pragma unroll
                    for (int dt = 0; dt < 8; ++dt)
#pragma unroll
                        for (int ks = 0; ks < 2; ++ks) {
                            const v4i16_t v0 = __builtin_amdgcn_ds_read_tr16_b64_v4i16((LAS v4i16_t*)(vrd + (32 * ks) * ATT_VPITCH + dt * 32));
                            const v4i16_t v1 = __builtin_amdgcn_ds_read_tr16_b64_v4i16((LAS v4i16_t*)(vrd + (32 * ks + 16) * ATT_VPITCH + dt * 32));
                            bf16x8 vf; vf[0] = v0[0]; vf[1] = v0[1]; vf[2] = v0[2]; vf[3] = v0[3]; vf[4] = v1[0]; vf[5] = v1[1]; vf[6] = v1[2]; vf[7] = v1[3];
                            o[0][dt] = __builtin_amdgcn_mfma_f32_16x16x32_bf16(vf, pb[0][ks], o[0][dt], 0, 0, 0);
                            o[1][dt] = __builtin_amdgcn_mfma_f32_16x16x32_bf16(vf, pb[1][ks], o[1][dt], 0, 0, 0);
                        }
                }
                LDS_BARRIER();
            }
            const float i1 = 1.f / xrow16_sum(lrun[0]), i2 = lam / xrow16_sum(lrun[1]);
            float ss = 0.f;
#pragma unroll
            for (int dt = 0; dt < 8; ++dt)
#pragma unroll
                for (int r = 0; r < 4; ++r) { const float v = o[0][dt][r] * i1 - o[1][dt][r] * i2; o[0][dt][r] = v; ss += v * v; }
            ss = xrow16_sum(ss);
            const float rn = rsqrtf(ss * (1.f / 128.f) + EPS) * (1.f - lam_init);
            const float* g = p.subln_g + L * 128;
            bf16* orow = obuf + ((size_t)b * SEQ + qw0 + fr) * D + hh * 128;
#pragma unroll
            for (int dt = 0; dt < 8; ++dt) {
                const f32x4 gv = *(const f32x4*)(g + 16 * dt + 4 * fq);
                u32x2 ov; ov.x = pk2(o[0][dt][0] * rn * gv[0], o[0][dt][1] * rn * gv[1]); ov.y = pk2(o[0][dt][2] * rn * gv[2], o[0][dt][3] * rn * gv[3]);
                *(u32x2*)(orow + 16 * dt + 4 * fq) = ov;
            }
        }
    }
}

__device__ void phase_att_queue(const Params& p, int L, unsigned char* lds_, int bid, int nblk) {
    LAS unsigned char* lds = (LAS unsigned char*)lds_;
    const int tid = tidx(), lane = tid & 63;
    const float* lp = p.diff_lambda + L * 256;
    const float d1 = wave_sum(lp[lane] * lp[64 + lane]), d2 = wave_sum(lp[128 + lane] * lp[192 + lane]);
    const float lam_init = 0.8f - 0.6f * expf(-0.3f * (float)L);
    const float lam = expf(d1) - expf(d2) + lam_init;
    unsigned* head = (unsigned*)(p.ws + WS_CTL) + CW_QUEUE + L;
    volatile LAS int* slot = (volatile LAS int*)(lds + LDS_MISC_OFF + 64);
    for (;;) {
        __syncthreads();
        if (tid == 0) *slot = (int)__hip_atomic_fetch_add(head, 1u, __ATOMIC_RELAXED, __HIP_MEMORY_SCOPE_AGENT);
        __syncthreads();
        const int u = *slot;
        if (u >= 512) break;
        att_unit(p, L, lds, tid, (u & 31) >> 2, u & 3, 15 - (u >> 5), lam, lam_init);
    }
}

constexpr size_t GD_WP = WS_ORAW, GD_QD = WS_ORAW + 16 * MiB, GD_AIP = WS_ORAW + 32 * MiB, GD_KDT = WS_ORAW + 40 * MiB, GD_UT = WS_ORAW + 56 * MiB, GD_GL = WS_ORAW + 72 * MiB;
__device__ __forceinline__ int perm_pos(int k) { return (k & ~31) + 8 * ((k >> 2) & 3) + 4 * ((k >> 4) & 1) + (k & 3); }
__device__ __forceinline__ float softplusf_(float x) { return x > 20.f ? x : log1pf(expf(x)); }

constexpr int GP_KN = 0, GP_QN = 17408, GP_RT = 34816, GP_LM = 71680, GP_TB = 89088, GP_GT = 98304;
constexpr int GP_KP = 272, GP_RP = 144, GP_LP = 68, GP_TP = 144;
__device__ void phase_gdn_prep(const Params& p, int L, unsigned char* lds_, int bid, int nblk) {
    LAS unsigned char* lds = (LAS unsigned char*)lds_;
    const int tid = tidx(), lane = tid & 63, w = __builtin_amdgcn_readfirstlane(tid >> 6), fr = lane & 15, fq = lane >> 4;
    const bf16* proj = (const bf16*)(p.ws + WS_PROJ);
    const float* BA = (const float*)(p.ws + WS_BA);
    bf16* WP = (bf16*)(p.ws + GD_WP); bf16* QD = (bf16*)(p.ws + GD_QD); bf16* AIP = (bf16*)(p.ws + GD_AIP); bf16* KDT = (bf16*)(p.ws + GD_KDT); bf16* UT = (bf16*)(p.ws + GD_UT);
    float* GL = (float*)(p.ws + GD_GL);
    const float* cw = p.conv_w + (size_t)L * 4 * 1536;
    LAS float* beta_s = (LAS float*)(lds + GP_GT); LAS float* gc_s = beta_s + 64; LAS float* egc_s = gc_s + 64; LAS float* edl_s = egc_s + 64;
    LAS float* Lm = (LAS float*)(lds + GP_LM);
    for (int item = bid; item < 1024; item += nblk) {
        const int n = item & 31, bh = item >> 5, hh = bh & 3, b = bh >> 2, t0 = n * 64;
        const size_t row0 = (size_t)b * SEQ + t0;
        __syncthreads();
        if (w == 0) {
            const float negA = -expf(p.a_log[L * 4 + hh]), dtb = p.dt_bias[L * 4 + hh];
            const float bb = BA[(row0 + lane) * 8 + hh], aa = BA[(row0 + lane) * 8 + 4 + hh] + dtb;
            float c = negA * softplusf_(aa);
#pragma unroll
            for (int o = 1; o < 64; o <<= 1) { const float t = __shfl_up(c, o); if (lane >= o) c += t; }
            const float glast = __shfl(c, 63);
            beta_s[lane] = sigmoidf_(bb); gc_s[lane] = c; egc_s[lane] = expf(c); edl_s[lane] = expf(glast - c);
            if (lane == 0) GL[item] = expf(glast);
        }
        __syncthreads();
        {
            const int colq = hh * 128 + 2 * lane;
            {
                float wq[4][2]; unsigned xq[11];
#pragma unroll
                for (int j = 0; j < 4; ++j) { wq[j][0] = cw[j * 1536 + colq]; wq[j][1] = cw[j * 1536 + colq + 1]; }
#pragma unroll
                for (int r = 0; r < 11; ++r) { const int tt = t0 + 8 * w - 3 + r; xq[r] = (tt >= 0) ? *(const unsigned*)(proj + ((size_t)b * SEQ + tt) * PROJ_W + 1536 + colq) : 0u; }
#pragma unroll
                for (int i = 0; i < 8; ++i) {
                    const int c = 8 * w + i;
                    float q0 = 0.f, q1 = 0.f;
#pragma unroll
                    for (int j = 0; j < 4; ++j) { q0 += wq[j][0] * lo16(xq[i + j]); q1 += wq[j][1] * hi16(xq[i + j]); }
                    q0 *= sigmoidf_(q0); q1 *= sigmoidf_(q1);
                    const float sq = rsqrtf(wave_sum(q0 * q0 + q1 * q1) + EPS) * 0.08838834764831845f;
                    q0 *= sq; q1 *= sq;
                    const float eg = egc_s[c];
                    *(LAS unsigned*)(lds + GP_QN + c * GP_KP + lane * 4) = pk2(q0, q1);
                    *(unsigned*)(QD + ((size_t)item * 64 + c) * 128 + perm_pos(2 * lane)) = pk2(q0 * eg, q1 * eg);
                }
            }
            __builtin_amdgcn_sched_barrier(0);
            {
                float wk[4][2]; unsigned xk[11];
#pragma unroll
                for (int j = 0; j < 4; ++j) { wk[j][0] = cw[j * 1536 + 512 + colq]; wk[j][1] = cw[j * 1536 + 512 + colq + 1]; }
#pragma unroll
                for (int r = 0; r < 11; ++r) { const int tt = t0 + 8 * w - 3 + r; xk[r] = (tt >= 0) ? *(const unsigned*)(proj + ((size_t)b * SEQ + tt) * PROJ_W + 1536 + 512 + colq) : 0u; }
                unsigned kd0[8], kd1[8], rk0[8], rk1[8];
#pragma unroll
                for (int i = 0; i < 8; ++i) {
                    const int c = 8 * w + i;
                    float k0 = 0.f, k1 = 0.f;
#pragma unroll
                    for (int j = 0; j < 4; ++j) { k0 += wk[j][0] * lo16(xk[i + j]); k1 += wk[j][1] * hi16(xk[i + j]); }
                    k0 *= sigmoidf_(k0); k1 *= sigmoidf_(k1);
                    const float sk = rsqrtf(wave_sum(k0 * k0 + k1 * k1) + EPS);
                    k0 *= sk; k1 *= sk;
                    const float be = beta_s[c], eg = egc_s[c], ed = edl_s[c];
                    *(LAS unsigned*)(lds + GP_KN + c * GP_KP + lane * 4) = pk2(k0, k1);
                    kd0[i] = f2bf(k0 * ed); kd1[i] = f2bf(k1 * ed);
                    rk0[i] = f2bf(k0 * be * eg); rk1[i] = f2bf(k1 * be * eg);
                }
                u32x4 o;
                o.x = rk0[0] | (rk0[1] << 16); o.y = rk0[2] | (rk0[3] << 16); o.z = rk0[4] | (rk0[5] << 16); o.w = rk0[6] | (rk0[7] << 16); *(LAS u32x4*)(lds + GP_RT + (128 + 2 * lane) * GP_RP + 16 * w) = o;
                o.x = rk1[0] | (rk1[1] << 16); o.y = rk1[2] | (rk1[3] << 16); o.z = rk1[4] | (rk1[5] << 16); o.w = rk1[6] | (rk1[7] << 16); *(LAS u32x4*)(lds + GP_RT + (128 + 2 * lane + 1) * GP_RP + 16 * w) = o;
                const int pa = perm_pos(8 * w), pb = perm_pos(8 * w + 4);
                bf16* kr0 = KDT + ((size_t)item * 128 + 2 * lane) * 64; bf16* kr1 = kr0 + 64;
                u32x2 h2;
                h2.x = kd0[0] | (kd0[1] << 16); h2.y = kd0[2] | (kd0[3] << 16); *(u32x2*)(kr0 + pa) = h2;
                h2.x = kd0[4] | (kd0[5] << 16); h2.y = kd0[6] | (kd0[7] << 16); *(u32x2*)(kr0 + pb) = h2;
                h2.x = kd1[0] | (kd1[1] << 16); h2.y = kd1[2] | (kd1[3] << 16); *(u32x2*)(kr1 + pa) = h2;
                h2.x = kd1[4] | (kd1[5] << 16); h2.y = kd1[6] | (kd1[7] << 16); *(u32x2*)(kr1 + pb) = h2;
            }
            __builtin_amdgcn_sched_barrier(0);
            {
                float wv[4][2]; unsigned xv[11];
#pragma unroll
                for (int j = 0; j < 4; ++j) { wv[j][0] = cw[j * 1536 + 1024 + colq]; wv[j][1] = cw[j * 1536 + 1024 + colq + 1]; }
#pragma unroll
                for (int r = 0; r < 11; ++r) { const int tt = t0 + 8 * w - 3 + r; xv[r] = (tt >= 0) ? *(const unsigned*)(proj + ((size_t)b * SEQ + tt) * PROJ_W + 1536 + 1024 + colq) : 0u; }
                unsigned rv0[8], rv1[8];
#pragma unroll
                for (int i = 0; i < 8; ++i) {
                    float v0 = 0.f, v1 = 0.f;
#pragma unroll
                    for (int j = 0; j < 4; ++j) { v0 += wv[j][0] * lo16(xv[i + j]); v1 += wv[j][1] * hi16(xv[i + j]); }
                    v0 *= sigmoidf_(v0); v1 *= sigmoidf_(v1);
                    const float be = beta_s[8 * w + i];
                    rv0[i] = f2bf(v0 * be); rv1[i] = f2bf(v1 * be);
                }
                u32x4 o;
                o.x = rv0[0] | (rv0[1] << 16); o.y = rv0[2] | (rv0[3] << 16); o.z = rv0[4] | (rv0[5] << 16); o.w = rv0[6] | (rv0[7] << 16); *(LAS u32x4*)(lds + GP_RT + (2 * lane) * GP_RP + 16 * w) = o;
                o.x = rv1[0] | (rv1[1] << 16); o.y = rv1[2] | (rv1[3] << 16); o.z = rv1[4] | (rv1[5] << 16); o.w = rv1[6] | (rv1[7] << 16); *(LAS u32x4*)(lds + GP_RT + (2 * lane + 1) * GP_RP + 16 * w) = o;
            }
        }
        __syncthreads();
#pragma unroll
        for (int q = 0; q < 2; ++q) {
            const int id = 2 * w + q, ct = id >> 2, st = id & 3;
            if (st <= ct) {
                f32x4 acc = (f32x4){0.f, 0.f, 0.f, 0.f};
#pragma unroll
                for (int ks = 0; ks < 4; ++ks) {
                    const bf16x8 a = *(const LAS bf16x8*)(lds + GP_KN + (16 * ct + fr) * GP_KP + (32 * ks + 8 * fq) * 2);
                    const bf16x8 bb = *(const LAS bf16x8*)(lds + GP_KN + (16 * st + fr) * GP_KP + (32 * ks + 8 * fq) * 2);
                    acc = __builtin_amdgcn_mfma_f32_16x16x32_bf16(a, bb, acc, 0, 0, 0);
                }
                const int s = 16 * st + fr; const float gs = gc_s[s];
#pragma unroll
                for (int r = 0; r < 4; ++r) { const int c = 16 * ct + 4 * fq + r;
                    Lm[c * GP_LP + s] = (s < c) ? beta_s[c] * acc[r] * expf(fminf(gc_s[c] - gs, 0.f)) : 0.f; }
            }
        }
        __syncthreads();
        if (w == 0) {
            float t[64];
            int zoff = 0; asm volatile("" : "+v"(zoff));
            const LAS float* Lz = Lm + zoff;
#pragma unroll
            for (int i = 0; i < 64; ++i) {
                float a0 = (i == lane) ? 1.f : 0.f, a1 = 0.f, a2 = 0.f, a3 = 0.f;
#pragma unroll
                for (int s4 = 0; s4 + 4 <= i; s4 += 4) { const f32x4 lv = *(const LAS f32x4*)(Lz + i * GP_LP + s4);
                    a0 -= lv[0] * t[s4]; a1 -= lv[1] * t[s4 + 1]; a2 -= lv[2] * t[s4 + 2]; a3 -= lv[3] * t[s4 + 3]; }
#pragma unroll
                for (int s = i & ~3; s < i; ++s) a0 -= Lz[i * GP_LP + s] * t[s];
                t[i] = (a0 + a1) + (a2 + a3);
                *(LAS bf16*)(lds + GP_TB + i * GP_TP + lane * 2) = (bf16)f2bf(t[i]);
                if ((i & 3) == 3) __builtin_amdgcn_sched_barrier(0);
            }
        } else {
            for (int id = w - 1; id < 16; id += 7) {
                const int ct = id >> 2, st = id & 3;
                f32x4 acc = (f32x4){0.f, 0.f, 0.f, 0.f};
                if (st <= ct) {
#pragma unroll
                    for (int ks = 0; ks < 4; ++ks) {
                        const bf16x8 a = *(const LAS bf16x8*)(lds + GP_QN + (16 * ct + fr) * GP_KP + (32 * ks + 8 * fq) * 2);
                        const bf16x8 bb = *(const LAS bf16x8*)(lds + GP_KN + (16 * st + fr) * GP_KP + (32 * ks + 8 * fq) * 2);
                        acc = __builtin_amdgcn_mfma_f32_16x16x32_bf16(a, bb, acc, 0, 0, 0);
                    }
                }
                const int s = 16 * st + fr; const float gs = gc_s[s]; const int ps = perm_pos(s);
#pragma unroll
                for (int r = 0; r < 4; ++r) { const int c = 16 * ct + 4 * fq + r;
                    const float v = (s <= c) ? acc[r] * expf(fminf(gc_s[c] - gs, 0.f)) : 0.f;
                    AIP[((size_t)item * 64 + c) * 64 + ps] = (bf16)f2bf(v); }
            }
        }
        __syncthreads();
#pragma unroll
        for (int q = 0; q < 2; ++q) {
            const int colt = 2 * w + q;
            bf16x8 af[2];
#pragma unroll
            for (int ks = 0; ks < 2; ++ks) af[ks] = *(const LAS bf16x8*)(lds + GP_RT + (16 * colt + fr) * GP_RP + (32 * ks + 8 * fq) * 2);
#pragma unroll
            for (int ct = 0; ct < 4; ++ct) {
                f32x4 acc = (f32x4){0.f, 0.f, 0.f, 0.f};
#pragma unroll
                for (int ks = 0; ks < 2; ++ks) {
                    const bf16x8 bb = *(const LAS bf16x8*)(lds + GP_TB + (16 * ct + fr) * GP_TP + (32 * ks + 8 * fq) * 2);
                    acc = __builtin_amdgcn_mfma_f32_16x16x32_bf16(af[ks], bb, acc, 0, 0, 0);
                }
                const int c = 16 * ct + fr;
                if (colt < 8) {
#pragma unroll
                    for (int r = 0; r < 4; ++r) UT[((size_t)item * 128 + 16 * colt + 4 * fq + r) * 64 + c] = (bf16)f2bf(acc[r]);
                } else {
                    const int kt = colt - 8;
                    u32x2 h2; h2.x = pk2(-acc[0], -acc[1]); h2.y = pk2(-acc[2], -acc[3]);
                    *(u32x2*)(WP + ((size_t)item * 64 + c) * 128 + 32 * (kt >> 1) + 8 * fq + 4 * (kt & 1)) = h2;
                }
            }
        }
    }
    __syncthreads();
}

constexpr int GS_WP = 0, GS_QD = 17408, GS_AIP = 34816, GS_KDT = 44032, GS_BUF = 62464, GS_OB = 2 * GS_BUF, GS_OBP = 272;
__device__ void phase_gdn_scan(const Params& p, int L, unsigned char* lds_, int bid, int nblk) {
    LAS unsigned char* lds = (LAS unsigned char*)lds_;
    const int tid = tidx(), lane = tid & 63, w = __builtin_amdgcn_readfirstlane(tid >> 6), fr = lane & 15, fq = lane >> 4;
    const bf16* proj = (const bf16*)(p.ws + WS_PROJ);
    const bf16* WP = (const bf16*)(p.ws + GD_WP); const bf16* QD = (const bf16*)(p.ws + GD_QD); const bf16* AIP = (const bf16*)(p.ws + GD_AIP);
    const bf16* KDT = (const bf16*)(p.ws + GD_KDT); const bf16* UT = (const bf16*)(p.ws + GD_UT); const float* GL = (const float*)(p.ws + GD_GL);
    bf16* obuf = (bf16*)(p.ws + WS_OBUF);
    for (int item = bid; item < 32; item += nblk) {
        const int hh = item & 3, b = item >> 2;
        const int fc = tid >> 4, fv = tid & 15;
        float gn[8];
#pragma unroll
        for (int i = 0; i < 8; ++i) gn[i] = p.gdn_norm_g[L * 128 + 8 * fv + i];
        f32x4 S[8];
#pragma unroll
        for (int kt = 0; kt < 8; ++kt) S[kt] = (f32x4){0.f, 0.f, 0.f, 0.f};
        u32x4 st[7];
        auto gload = [&](int ci) {
#pragma unroll
            for (int i = 0; i < 7; ++i) {
                const int pc = tid + 512 * i;
                const bf16* src;
                if (i < 2) src = WP + (size_t)ci * 8192 + pc * 8;
                else if (i < 4) src = QD + (size_t)ci * 8192 + (pc - 1024) * 8;
                else if (i < 5) src = AIP + (size_t)ci * 4096 + (pc - 2048) * 8;
                else src = KDT + (size_t)ci * 8192 + (pc - 2560) * 8;
                st[i] = *(const u32x4*)src;
            }
        };
        auto lstore = [&](int buf) {
#pragma unroll
            for (int i = 0; i < 7; ++i) {
                const int pc = tid + 512 * i;
                int off;
                if (i < 2) off = GS_WP + (pc >> 4) * 272 + (pc & 15) * 16;
                else if (i < 4) { const int q = pc - 1024; off = GS_QD + (q >> 4) * 272 + (q & 15) * 16; }
                else if (i < 5) { const int q = pc - 2048; off = GS_AIP + (q >> 3) * 144 + (q & 7) * 16; }
                else { const int q = pc - 2560; off = GS_KDT + (q >> 3) * 144 + (q & 7) * 16; }
                *(LAS u32x4*)(lds + buf * GS_BUF + off) = st[i];
            }
        };
        __syncthreads();
        gload(item * 32); lstore(0);
        u32x2 ut[4]; float gl;
        {
            const int ci = item * 32;
#pragma unroll
            for (int ct = 0; ct < 4; ++ct) ut[ct] = *(const u32x2*)(UT + ((size_t)ci * 128 + 16 * w + fr) * 64 + 16 * ct + 4 * fq);
            gl = GL[ci];
        }
        __syncthreads();
        for (int n = 0; n < 32; ++n) {
            const int ci = item * 32 + n, buf = n & 1;
            const size_t rowc = (size_t)b * SEQ + n * 64;
            u32x2 utn[4]; float gln = 0.f;
            if (n + 1 < 32) {
                gload(ci + 1);
#pragma unroll
                for (int ct = 0; ct < 4; ++ct) utn[ct] = *(const u32x2*)(UT + ((size_t)(ci + 1) * 128 + 16 * w + fr) * 64 + 16 * ct + 4 * fq);
                gln = GL[ci + 1];
            }
            u32x4 zq[2];
#pragma unroll
            for (int ps = 0; ps < 2; ++ps) zq[ps] = *(const u32x4*)(proj + (rowc + 32 * ps + fc) * PROJ_W + 3072 + hh * 128 + 8 * fv);
            f32x4 vn[4], oacc[4];
#pragma unroll
            for (int ct = 0; ct < 4; ++ct) { vn[ct] = (f32x4){lo16(ut[ct].x), hi16(ut[ct].x), lo16(ut[ct].y), hi16(ut[ct].y)}; oacc[ct] = (f32x4){0.f, 0.f, 0.f, 0.f}; }
            bf16x8 sb[4];
#pragma unroll
            for (int ks = 0; ks < 4; ++ks) { u32x4 pk; pk.x = cvtpk(S[2 * ks][0], S[2 * ks][1]); pk.y = cvtpk(S[2 * ks][2], S[2 * ks][3]); pk.z = cvtpk(S[2 * ks + 1][0], S[2 * ks + 1][1]); pk.w = cvtpk(S[2 * ks + 1][2], S[2 * ks + 1][3]);
                sb[ks] = __builtin_bit_cast(bf16x8, pk); }
            LAS unsigned char* bb = lds + buf * GS_BUF;
            bf16x8 f0[8], f1[8];
#define LD_A(F, ct) do { _Pragma("unroll") for (int ks = 0; ks < 4; ++ks) { F[ks] = *(const LAS bf16x8*)(bb + GS_WP + (16 * (ct) + fr) * 272 + (32 * ks + 8 * fq) * 2); \
                    F[4 + ks] = *(const LAS bf16x8*)(bb + GS_QD + (16 * (ct) + fr) * 272 + (32 * ks + 8 * fq) * 2); } } while (0)
#define MM_A(F, ct) do { _Pragma("unroll") for (int ks = 0; ks < 4; ++ks) { vn[ct] = __builtin_amdgcn_mfma_f32_16x16x32_bf16(F[ks], sb[ks], vn[ct], 0, 0, 0); \
                    oacc[ct] = __builtin_amdgcn_mfma_f32_16x16x32_bf16(F[4 + ks], sb[ks], oacc[ct], 0, 0, 0); } } while (0)
#define SBAR() __builtin_amdgcn_sched_barrier(0)
            LD_A(f0, 0); SBAR();
            LD_A(f1, 1); MM_A(f0, 0); SBAR();
            LD_A(f0, 2); MM_A(f1, 1); SBAR();
            LD_A(f1, 3); MM_A(f0, 2); SBAR();
#pragma unroll
            for (int ct = 0; ct < 4; ++ct)
#pragma unroll
                for (int ss = 0; ss < 2; ++ss) f0[2 * ct + ss] = *(const LAS bf16x8*)(bb + GS_AIP + (16 * ct + fr) * 144 + (32 * ss + 8 * fq) * 2);
            MM_A(f1, 3); SBAR();
            bf16x8 vb[2];
#pragma unroll
            for (int ss = 0; ss < 2; ++ss) { u32x4 pk; pk.x = cvtpk(vn[2 * ss][0], vn[2 * ss][1]); pk.y = cvtpk(vn[2 * ss][2], vn[2 * ss][3]); pk.z = cvtpk(vn[2 * ss + 1][0], vn[2 * ss + 1][1]); pk.w = cvtpk(vn[2 * ss + 1][2], vn[2 * ss + 1][3]);
                vb[ss] = __builtin_bit_cast(bf16x8, pk); }
#pragma unroll
            for (int kt = 0; kt < 4; ++kt)
#pragma unroll
                for (int ss = 0; ss < 2; ++ss) f1[2 * kt + ss] = *(const LAS bf16x8*)(bb + GS_KDT + (16 * kt + fr) * 144 + (32 * ss + 8 * fq) * 2);
#pragma unroll
            for (int ct = 0; ct < 4; ++ct)
#pragma unroll
                for (int ss = 0; ss < 2; ++ss) oacc[ct] = __builtin_amdgcn_mfma_f32_16x16x32_bf16(f0[2 * ct + ss], vb[ss], oacc[ct], 0, 0, 0);
            SBAR();
#pragma unroll
            for (int kt = 4; kt < 8; ++kt)
#pragma unroll
                for (int ss = 0; ss < 2; ++ss) f0[2 * (kt - 4) + ss] = *(const LAS bf16x8*)(bb + GS_KDT + (16 * kt + fr) * 144 + (32 * ss + 8 * fq) * 2);
#pragma unroll
            for (int kt = 0; kt < 4; ++kt) {
                S[kt] = S[kt] * gl;
#pragma unroll
                for (int ss = 0; ss < 2; ++ss) S[kt] = __builtin_amdgcn_mfma_f32_16x16x32_bf16(f1[2 * kt + ss], vb[ss], S[kt], 0, 0, 0);
            }
            SBAR();
#pragma unroll
            for (int kt = 4; kt < 8; ++kt) {
                S[kt] = S[kt] * gl;
#pragma unroll
                for (int ss = 0; ss < 2; ++ss) S[kt] = __builtin_amdgcn_mfma_f32_16x16x32_bf16(f0[2 * (kt - 4) + ss], vb[ss], S[kt], 0, 0, 0);
            }
#undef LD_A
#undef MM_A
#undef SBAR
            LDS_BARRIER();
#pragma unroll
            for (int ct = 0; ct < 4; ++ct)
#pragma unroll
                for (int r = 0; r < 4; r += 2) {
                    const unsigned pk = cvtpk(oacc[ct][r], oacc[ct][r + 1]);
                    *(LAS bf16*)(lds + GS_OB + (16 * ct + 4 * fq + r) * GS_OBP + (16 * w + fr) * 2) = (bf16)(pk & 0xffffu);
                    *(LAS bf16*)(lds + GS_OB + (16 * ct + 4 * fq + r + 1) * GS_OBP + (16 * w + fr) * 2) = (bf16)(pk >> 16);
                }
            if (n + 1 < 32) {
                lstore(buf ^ 1);
#pragma unroll
                for (int ct = 0; ct < 4; ++ct) ut[ct] = utn[ct];
                gl = gln;
            }
            LDS_BARRIER();
#pragma unroll
            for (int ps = 0; ps < 2; ++ps) {
                const int c = 32 * ps + fc;
                const u32x4 ov = *(const LAS u32x4*)(lds + GS_OB + c * GS_OBP + fv * 16);
                float o8[8];
#pragma unroll
                for (int i = 0; i < 4; ++i) { o8[2 * i] = lo16(ov[i]); o8[2 * i + 1] = hi16(ov[i]); }
                float ss = 0.f;
#pragma unroll
                for (int i = 0; i < 8; ++i) ss += o8[i] * o8[i];
                const float rn = rsqrtf(row16_sum(ss) * (1.f / 128.f) + EPS);
                u32x4 res;
#pragma unroll
                for (int i = 0; i < 4; ++i) {
                    const float z0 = lo16(zq[ps][i]), z1 = hi16(zq[ps][i]);
                    res[i] = cvtpk(o8[2 * i] * rn * gn[2 * i] * (z0 * sigmoidf_(z0)), o8[2 * i + 1] * rn * gn[2 * i + 1] * (z1 * sigmoidf_(z1)));
                }
                *(u32x4*)(obuf + (rowc + c) * D + 512 + hh * 128 + 8 * fv) = res;
            }
        }
        __syncthreads();
    }
}

__device__ __forceinline__ unsigned sortable(float f) { const unsigned u = __float_as_uint(f); return u ^ ((unsigned)((int)u >> 31) | 0x80000000u); }
__device__ __forceinline__ float unsortable(unsigned s) { return __uint_as_float((s & 0x80000000u) ? (s ^ 0x80000000u) : ~s); }
#define CE(a, b) do { const unsigned _x = k[a], _y = k[b]; k[a] = _x > _y ? _x : _y; k[b] = _x > _y ? _y : _x; } while (0)
constexpr int PE_TK = 0, PE_TAB = 8192, PE_ID = 8448, PE_GT = PE_ID + 32768;
__device__ void phase_peer(const Params& p, int L, unsigned char* lds_, int bid, int nblk) {
    LAS unsigned char* lds = (LAS unsigned char*)lds_;
    const int tid = tidx(), lane = tid & 63, w = __builtin_amdgcn_readfirstlane(tid >> 6), fr = lane & 15, fq = lane >> 4;
    const bf16* Q2 = (const bf16*)(p.ws + WS_Q2);
    const bf16* SK = (const bf16*)(p.ws + WS_SK) + (size_t)L * 8 * 2 * 128 * 128;
    float* H = (float*)(p.ws + WS_H); bf16* HB2 = (bf16*)(p.ws + WS_HB2);
    const unsigned char* U = p.ws + WS_U + (size_t)L * NEXP * D;
    const unsigned char* V = p.ws + WS_V + (size_t)L * NEXP * D;
    const float* SU = (const float*)(p.ws + WS_SU) + (size_t)L * NEXP; const float* SV = (const float*)(p.ws + WS_SV) + (size_t)L * NEXP;
    const float* g = p.ln_ffn_g + L * D;
    LAS unsigned* TK = (LAS unsigned*)(lds + PE_TK);
    LAS unsigned short* TAB = (LAS unsigned short*)(lds + PE_TAB);
    LAS int* IDL = (LAS int*)(lds + PE_ID); LAS float* GTL = (LAS float*)(lds + PE_GT);
    if (tid < 64) {
        int a = 0, base = 0, q = tid; unsigned short v = 0xffff;
        if (q < 50) { for (;;) { const int cnt = 16 / (a + 1); if (q < base + cnt) break; base += cnt; ++a; } v = (unsigned short)((a << 8) | (q - base)); }
        TAB[tid] = v;
    }
    for (int item = bid; item < M / 64; item += nblk) {
        const int tok0 = item * 64;
        __syncthreads();
        const int tg = w & 3, cc = w >> 2;
        for (int hh = 0; hh < 8; ++hh) {
            {
                f32x4 acc[8];
#pragma unroll
                for (int nt = 0; nt < 8; ++nt) acc[nt] = (f32x4){0.f, 0.f, 0.f, 0.f};
                bf16x8 qa[4];
#pragma unroll
                for (int ks = 0; ks < 4; ++ks) qa[ks] = *(const bf16x8*)(Q2 + (size_t)(tok0 + 16 * tg + fr) * 2048 + hh * 256 + cc * 128 + 32 * ks + 8 * fq);
                const bf16* skb = SK + ((size_t)(hh * 2 + cc) * 128 + fr) * 128 + 8 * fq;
#pragma unroll
                for (int nt = 0; nt < 8; ++nt)
#pragma unroll
                    for (int ks = 0; ks < 4; ++ks) {
                        const bf16x8 kb = *(const bf16x8*)(skb + (size_t)nt * 16 * 128 + 32 * ks);
                        acc[nt] = __builtin_amdgcn_mfma_f32_16x16x32_bf16(qa[ks], kb, acc[nt], 0, 0, 0);
                    }
#pragma unroll
                for (int r = 0; r < 4; ++r) {
                    unsigned k[8];
#pragma unroll
                    for (int nt = 0; nt < 8; ++nt) k[nt] = (sortable(acc[nt][r]) & ~0x7Fu) | (unsigned)(127 - (16 * nt + fr));
                    CE(0, 1); CE(2, 3); CE(4, 5); CE(6, 7); CE(0, 2); CE(1, 3); CE(4, 6); CE(5, 7); CE(1, 2); CE(5, 6); CE(0, 4); CE(3, 7);
                    CE(1, 5); CE(2, 6); CE(1, 4); CE(3, 6); CE(2, 4); CE(3, 5); CE(3, 4);
                    unsigned res = 0u;
#pragma unroll
                    for (int rd = 0; rd < 16; ++rd) {
                        const unsigned m = row16_umax(k[0]);
                        const bool win = k[0] == m;
#pragma unroll
                        for (int i = 0; i < 7; ++i) k[i] = win ? k[i + 1] : k[i];
                        k[7] = win ? 0u : k[7];
                        res = (fr == rd) ? m : res;
                    }
                    TK[(cc * 64 + 16 * tg + 4 * fq + r) * 16 + fr] = res;
                }
            }
            __syncthreads();
#pragma unroll
            for (int ps = 0; ps < 2; ++ps) {
                const int tl = 8 * w + 4 * ps + fq;
                unsigned k[4];
#pragma unroll
                for (int sl = 0; sl < 4; ++sl) {
                    const int q = sl * 16 + fr;
                    const unsigned ab = TAB[q];
                    const unsigned k1 = TK[tl * 16 + ((ab >> 8) & 15)], k2 = TK[(64 + tl) * 16 + (ab & 15)];
                    const float v = unsortable(k1 & ~0x7Fu) + unsortable(k2 & ~0x7Fu);
                    k[sl] = (q < 50) ? ((sortable(v) & ~0x3Fu) | (unsigned)(63 - q)) : 0u;
                }
                CE(0, 1); CE(2, 3); CE(0, 2); CE(1, 3); CE(1, 2);
                unsigned res = 0u;
#pragma unroll
                for (int rd = 0; rd < 16; ++rd) {
                    const unsigned m = row16_umax(k[0]);
                    const bool win = k[0] == m;
                    k[0] = win ? k[1] : k[0]; k[1] = win ? k[2] : k[1]; k[2] = win ? k[3] : k[2]; k[3] = win ? 0u : k[3];
                    res = (fr == rd) ? m : res;
                }
                const unsigned ab = TAB[63 - (res & 0x3Fu)];
                const unsigned k1 = TK[tl * 16 + ((ab >> 8) & 15)], k2 = TK[(64 + tl) * 16 + (ab & 15)];
                const float v = unsortable(k1 & ~0x7Fu) + unsortable(k2 & ~0x7Fu);
                const float e = __expf(v - row16_max(v));
                const float sum = row16_sum(e);
                IDL[tl * 128 + hh * 16 + fr] = (int)((127u - (k1 & 0x7Fu)) * 128u + (127u - (k2 & 0x7Fu)));
                GTL[tl * 128 + hh * 16 + fr] = e / sum;
            }
            __syncthreads();
        }
        for (int ti = 0; ti < 8; ++ti) {
            const int tl = 8 * w + ti, tok = tok0 + tl;
            float* hrow = H + (size_t)tok * D + 16 * lane;
            float xv[16];
#pragma unroll
            for (int j = 0; j < 4; ++j) { const f32x4 a = *(const f32x4*)(hrow + 4 * j); xv[4 * j] = a[0]; xv[4 * j + 1] = a[1]; xv[4 * j + 2] = a[2]; xv[4 * j + 3] = a[3]; }
            float ss = 0.f;
#pragma unroll
            for (int i = 0; i < 16; ++i) ss += xv[i] * xv[i];
            const float rstd = rsqrtf(wave_sum(ss) * (1.f / D) + EPS);
            float xn[16], xs = 0.f;
#pragma unroll
            for (int i = 0; i < 16; ++i) { xn[i] = xv[i] * rstd * g[16 * lane + i]; xs += xn[i]; }
            const float xoff = 128.f * wave_sum(xs);
            const int id0 = IDL[tl * 128 + lane], id1 = IDL[tl * 128 + 64 + lane];
            const float su0 = SU[id0], su1 = SU[id1], sv0 = SV[id0], sv1 = SV[id1];
            float h0 = 0.f, h1 = 0.f;
            u32x4 ring[16];
#pragma unroll
            for (int j = 0; j < 16; ++j) ring[j] = *(const u32x4*)(U + (size_t)IDL[tl * 128 + j] * D + 16 * lane);
#pragma unroll 1
            for (int k = 0; k < 8; ++k) {
#pragma unroll
                for (int j = 0; j < 16; ++j) {
                    const u32x4 a = ring[j];
                    if (k < 7) ring[j] = *(const u32x4*)(U + (size_t)IDL[tl * 128 + 16 * (k + 1) + j] * D + 16 * lane);
                    float d = 0.f;
#pragma unroll
                    for (int q = 0; q < 4; ++q) { d += xn[4 * q] * (float)(a[q] & 0xffu) + xn[4 * q + 1] * (float)((a[q] >> 8) & 0xffu) + xn[4 * q + 2] * (float)((a[q] >> 16) & 0xffu) + xn[4 * q + 3] * (float)(a[q] >> 24); }
                    d = wave_sum(d);
                    const int e = 16 * k + j;
                    if (lane == (e & 63)) { if (k < 4) h0 = d; else h1 = d; }
                }
            }
            h0 = su0 * (h0 - xoff); h1 = su1 * (h1 - xoff);
            const float w0 = sv0 * GTL[tl * 128 + lane] * 0.5f * h0 * (1.f + erff(h0 * 0.70710678118654752f));
            const float w1 = sv1 * GTL[tl * 128 + 64 + lane] * 0.5f * h1 * (1.f + erff(h1 * 0.70710678118654752f));
            const float woff = 128.f * wave_sum(w0 + w1);
            float y[16];
#pragma unroll
            for (int i = 0; i < 16; ++i) y[i] = 0.f;
#pragma unroll
            for (int j = 0; j < 16; ++j) ring[j] = *(const u32x4*)(V + (size_t)IDL[tl * 128 + j] * D + 16 * lane);
#pragma unroll 1
            for (int k = 0; k < 8; ++k) {
#pragma unroll
                for (int j = 0; j < 16; ++j) {
                    const u32x4 a = ring[j];
                    if (k < 7) ring[j] = *(const u32x4*)(V + (size_t)IDL[tl * 128 + 16 * (k + 1) + j] * D + 16 * lane);
                    const int e = 16 * k + j;
                    const float ww = __uint_as_float((unsigned)__builtin_amdgcn_readlane((int)__float_as_uint(k < 4 ? w0 : w1), e & 63));
#pragma unroll
                    for (int q = 0; q < 4; ++q) { y[4 * q] += ww * (float)(a[q] & 0xffu); y[4 * q + 1] += ww * (float)((a[q] >> 8) & 0xffu); y[4 * q + 2] += ww * (float)((a[q] >> 16) & 0xffu); y[4 * q + 3] += ww * (float)(a[q] >> 24); }
                }
            }
#pragma unroll
            for (int i = 0; i < 16; ++i) y[i] += xv[i] - woff;
#pragma unroll
            for (int j = 0; j < 4; ++j) *(f32x4*)(hrow + 4 * j) = (f32x4){y[4 * j], y[4 * j + 1], y[4 * j + 2], y[4 * j + 3]};
            bf16* hb = HB2 + (size_t)tok * D + 16 * lane;
            u32x4 o; o.x = pk2(y[0], y[1]); o.y = pk2(y[2], y[3]); o.z = pk2(y[4], y[5]); o.w = pk2(y[6], y[7]);
            *(u32x4*)hb = o;
            o.x = pk2(y[8], y[9]); o.y = pk2(y[10], y[11]); o.z = pk2(y[12], y[13]); o.w = pk2(y[14], y[15]);
            *(u32x4*)(hb + 8) = o;
        }
    }
    __syncthreads();
}
#undef CE

__device__ void phase_final(const Params& p, int bid, int nblk) {
    const int tid = tidx(), lane = tid & 63, gw = bid * NWAVES + (tid >> 6), NGW = nblk * NWAVES;
    const float* H = (const float*)(p.ws + WS_H);
    for (int m = gw; m < M; m += NGW) {
        f32x4 v[4]; float ss = 0.f;
#pragma unroll
        for (int j = 0; j < 4; ++j) { v[j] = ((const f32x4*)(H + (size_t)m * D))[lane + 64 * j]; ss += (v[j][0] * v[j][0] + v[j][1] * v[j][1]) + (v[j][2] * v[j][2] + v[j][3] * v[j][3]); }
        const float r = rsqrtf(wave_sum(ss) * (1.f / D) + EPS);
#pragma unroll
        for (int j = 0; j < 4; ++j) { const f32x4 gv = ((const f32x4*)p.final_g)[lane + 64 * j]; ((f32x4*)(p.out + (size_t)m * D))[lane + 64 * j] = v[j] * r * gv; }
    }
}

#define XB_TMO      128
#define XB_XCNT(j)  (256  + 64 * (j))
#define XB_XSUB(j)  (1280 + 64 * (j))
#define XB_XGEN(j)  (2304 + 64 * (j))
#define XB_TOP      3328
#define XB_TOPGEN   3392
#define XCD_BAR_WORDS 3456
#define XB_SPIN_CAP (1u << 22)
__device__ __forceinline__ unsigned xb_ld(unsigned* p)              { return __hip_atomic_load(p, __ATOMIC_RELAXED, __HIP_MEMORY_SCOPE_AGENT); }
__device__ __forceinline__ unsigned xb_add(unsigned* p, unsigned v) { return __hip_atomic_fetch_add(p, v, __ATOMIC_RELAXED, __HIP_MEMORY_SCOPE_AGENT); }
__device__ __forceinline__ unsigned xb_xcc_id() { return (unsigned)__builtin_amdgcn_s_getreg((3 << 11) | 20) & 0xFu; }
#define XB_SPIN(cond, bar) do { unsigned _sp = 0; while (cond) { __builtin_amdgcn_s_sleep(1); \
    if ((++_sp & 255u) == 0u) { if (xb_ld(&(bar)[XB_TMO])) break; if (_sp > XB_SPIN_CAP) { atomicAdd(&(bar)[XB_TMO], 1u); break; } } } } while (0)
struct XcdBarrier { unsigned* bar; unsigned x; volatile LAS unsigned* st; };
__device__ __forceinline__ XcdBarrier xcd_barrier_post(unsigned* bar, volatile LAS unsigned* st) {
    XcdBarrier b; b.bar = bar; b.x = xb_xcc_id(); b.st = st;
    if (threadIdx.x == 0) (void)xb_add(&bar[XB_XCNT(b.x)], 1u);
    return b;
}
__device__ __forceinline__ void xcd_barrier_complete(unsigned* bar, unsigned x, unsigned& nloc, unsigned& nx) {
    const unsigned G = gridDim.x * gridDim.y * gridDim.z;
    unsigned sum, cnt, mine, sp = 0u;
    for (;;) {
        sum = 0u; cnt = 0u; mine = 0u;
#pragma unroll
        for (unsigned j = 0; j < 16; ++j) { const unsigned c = xb_ld(&bar[XB_XCNT(j)]); sum += c; cnt += (c > 0u) ? 1u : 0u; mine = (j == x) ? c : mine; }
        if (sum == G) break;
        __builtin_amdgcn_s_sleep(1);
        if ((++sp & 255u) == 0u) { if (xb_ld(&bar[XB_TMO])) break; if (sp > XB_SPIN_CAP) { atomicAdd(&bar[XB_TMO], 1u); break; } }
    }
    nloc = mine > 0u ? mine : 1u; nx = cnt > 0u ? cnt : 1u;
}
__device__ __forceinline__ void xcd_barrier(const XcdBarrier& b) {
    asm volatile("s_waitcnt vmcnt(0)" ::: "memory");
    __syncthreads();
    if (threadIdx.x == 0) {
        unsigned* bar = b.bar;
        __builtin_amdgcn_s_waitcnt(0);
        unsigned nloc = b.st[0], nx = b.st[1];
        if (nloc == 0u) { xcd_barrier_complete(bar, b.x, nloc, nx); b.st[0] = nloc; b.st[1] = nx; }
        const unsigned old = xb_add(&bar[XB_XSUB(b.x)], 1u);
        const unsigned gen = old / nloc;
        if (old + 1u == (gen + 1u) * nloc) {
            __builtin_amdgcn_fence(__ATOMIC_RELEASE, "agent");
            asm volatile("s_waitcnt vmcnt(0)" ::: "memory");
            const unsigned og = xb_add(&bar[XB_TOP], 1u);
            const unsigned tg = og / nx;
            if (og + 1u == (tg + 1u) * nx) xb_add(&bar[XB_TOPGEN], 1u);
            else XB_SPIN(xb_ld(&bar[XB_TOPGEN]) == tg, bar);
            __builtin_amdgcn_fence(__ATOMIC_ACQUIRE, "agent");
            xb_add(&bar[XB_XGEN(b.x)], 1u);
            asm volatile("s_waitcnt vmcnt(0)" ::: "memory");
        } else {
            XB_SPIN(xb_ld(&bar[XB_XGEN(b.x)]) == gen, bar);
            __builtin_amdgcn_fence(__ATOMIC_ACQUIRE, "agent");
            asm volatile("s_waitcnt vmcnt(0)" ::: "memory");
        }
    }
    __syncthreads();
}
constexpr int CW_BAR = 4096;

constexpr int K_PROLOGUE = 11, K_FINAL = 12;
template <int KIND>
__device__ __forceinline__ void run_kind(const Params& p, int L, unsigned char* lds, int bid, int nblk) {
    unsigned char* ws = p.ws;
    float* H = (float*)(ws + WS_H);
    float* ss0 = (float*)(ws + WS_STAT); float* ss1 = (float*)(ws + WS_SS1); float* sse = (float*)(ws + WS_SSE);
    if constexpr (KIND == K_PROLOGUE) phase_prologue(p, lds, bid, nblk);
    if constexpr (KIND == K_FINAL) phase_final(p, bid, nblk);
    if constexpr (KIND == 0) { EpiProj E{nullptr, (bf16*)(ws + WS_PROJ), (float*)(ws + WS_BA)};
        gemm_run(lds, (const bf16*)(ws + WS_HB0), (const bf16*)(ws + WS_WIN) + (size_t)L * IN_PAD * D, M, IN_PAD, D, E, bid, nblk, ss0); }
    if constexpr (KIND == 1) phase_gdn_prep(p, L, lds, bid, nblk);
    if constexpr (KIND == 2) { phase_gdn_scan(p, L, lds, bid, nblk); phase_att_queue(p, L, lds, bid, nblk); }
    if constexpr (KIND == 3) { EpiRes E{ss1, H, (bf16*)(ws + WS_HB1)};
        gemm_run(lds, (const bf16*)(ws + WS_OBUF), (const bf16*)(ws + WS_WOUT) + (size_t)L * D * D, M, D, D, E, bid, nblk); }
    if constexpr (KIND == 4) { EpiQ2 E{nullptr, (bf16*)(ws + WS_Q2)};
        gemm_run(lds, (const bf16*)(ws + WS_HB1), (const bf16*)(ws + WS_WQ) + (size_t)L * 2048 * D, M, 2048, D, E, bid, nblk, ss1);
        EpiE E2{sse, (bf16*)(ws + WS_EPRE)};
        gemm_run(lds, (const bf16*)(ws + WS_PB) + (size_t)L * M * 256, (const bf16*)(ws + WS_WP) + (size_t)L * D * 256, M, D, 256, E2, bid, nblk); }
    if constexpr (KIND == 5) phase_peer(p, L, lds, bid, nblk);
    if constexpr (KIND == 6) { EpiPle E{ss0, H, (bf16*)(ws + WS_HB0), (const bf16*)(ws + WS_EPRE), p.ple_norm_g + L * D};
        gemm_run(lds, (const bf16*)(ws + WS_HB2), (const bf16*)(ws + WS_WG) + (size_t)L * D * D, M, D, D, E, bid, nblk, sse); }
}

__device__ __forceinline__ Params params_off(const Params& s, size_t z) {
    Params q;
    q.x = s.x + z; q.p = s.p + z; q.ln_mix_g = s.ln_mix_g + z; q.w_in = s.w_in + z; q.conv_w = s.conv_w + z; q.a_log = s.a_log + z; q.dt_bias = s.dt_bias + z;
    q.gdn_norm_g = s.gdn_norm_g + z; q.diff_lambda = s.diff_lambda + z; q.subln_g = s.subln_g + z; q.w_out = s.w_out + z; q.ln_ffn_g = s.ln_ffn_g + z;
    q.peer_wq = s.peer_wq + z; q.subkeys = s.subkeys + z; q.peer_u = s.peer_u + z; q.peer_v = s.peer_v + z; q.ple_wp = s.ple_wp + z; q.ple_wg = s.ple_wg + z;
    q.ple_norm_g = s.ple_norm_g + z; q.final_g = s.final_g + z; q.out = s.out + z; q.ws = s.ws + z; q.pad0 = 0; q.pad1 = 0;
    return q;
}
#define RUN(KIND) do { size_t z_ = 0; int L_ = L; asm volatile("" : "+s"(z_), "+s"(L_)); const Params q_ = params_off(p, z_); run_kind<KIND>(q_, L_, lds, bid, nblk); } while (0)
__global__ void __launch_bounds__(NTHREADS, 2) mk_fwd(Params p) {
    extern __shared__ __attribute__((aligned(16))) unsigned char lds[];
    const int bid = (int)blockIdx.x, nblk = (int)gridDim.x;
    volatile LAS unsigned* misc = (volatile LAS unsigned*)((LAS unsigned char*)lds + LDS_MISC_OFF);
    if (threadIdx.x < 64) misc[threadIdx.x] = 0u;
    __syncthreads();
    XcdBarrier bar = xcd_barrier_post((unsigned*)(p.ws + WS_CTL) + CW_BAR, misc + 8);
    { int L = 0; RUN(K_PROLOGUE); }
    cg::this_grid().sync();
#pragma nounroll
    for (int L = 0; L < DEPTH; ++L) {
        RUN(0); xcd_barrier(bar);
        RUN(1); xcd_barrier(bar);
        RUN(2); xcd_barrier(bar);
        RUN(3); xcd_barrier(bar);
        RUN(4); xcd_barrier(bar);
        RUN(5); xcd_barrier(bar);
        RUN(6); xcd_barrier(bar);
    }
    { int L = 0; RUN(K_FINAL); }
}

extern "C" void kernel_launch(void* const* d_in, const int* in_sizes, int n_in, void* d_out, int out_size, void* d_ws, size_t ws_size, hipStream_t stream) {
    static int grid = 0;
    if (grid == 0) {
        if (n_in != 20 || out_size != M * D || ws_size < WS_END) { fprintf(stderr, "kernel_launch: unexpected shapes (n_in %d, out %d, ws %zu < %zu)\n", n_in, out_size, ws_size, (size_t)WS_END); grid = -1; return; }
        int dev = 0, cus = 0, per_cu = 0;
        (void)hipGetDevice(&dev); (void)hipDeviceGetAttribute(&cus, hipDeviceAttributeMultiprocessorCount, dev);
        if (hipFuncSetAttribute((const void*)mk_fwd, hipFuncAttributeMaxDynamicSharedMemorySize, LDS_BYTES) != hipSuccess) { fprintf(stderr, "kernel_launch: hipFuncSetAttribute failed\n"); grid = -1; return; }
        if (hipOccupancyMaxActiveBlocksPerMultiprocessor(&per_cu, (const void*)mk_fwd, NTHREADS, LDS_BYTES) != hipSuccess || per_cu < 1) { fprintf(stderr, "kernel_launch: occupancy query says %d blocks per CU\n", per_cu); (void)hipGetLastError(); grid = -1; return; }
        grid = (cus > 0 ? cus : 256);
    }
    if (grid < 0) return;
    (void)hipMemsetAsync((char*)d_ws + WS_CTL, 0, CTL_ZERO_BYTES, stream);
    Params p{};
    const float** pp = (const float**)&p;
    for (int i = 0; i < 20; ++i) pp[i] = (const float*)d_in[i];
    p.out = (float*)d_out; p.ws = (unsigned char*)d_ws;
    void* args[] = {&p};
    hipError_t e = hipLaunchCooperativeKernel((const void*)mk_fwd, dim3(grid), dim3(NTHREADS), args, LDS_BYTES, stream);
    if (e != hipSuccess) fprintf(stderr, "kernel_launch: cooperative launch failed: %s (grid %d)\n", hipGetErrorString(e), grid);
}
```

```cpp
#include <hip/hip_runtime.h>
#include <hip/hip_cooperative_groups.h>
#include <cstdio>
#include <cstdint>
namespace cg = cooperative_groups;

typedef unsigned short bf16;
typedef float f32x4 __attribute__((ext_vector_type(4)));
typedef short bf16x8 __attribute__((ext_vector_type(8)));
typedef unsigned u32x4 __attribute__((ext_vector_type(4)));
typedef unsigned u32x2 __attribute__((ext_vector_type(2)));

constexpr int D = 1024, BATCH = 8, SEQ = 2048, DEPTH = 4, M = BATCH * SEQ;
constexpr int IN_COLS = 3592, IN_PAD = 3840, PROJ_W = 3584;
constexpr int NEXP = 16384;
constexpr float EPS = 1e-6f;
constexpr float QSCALE = 0.125f * 1.4426950408889634f;
constexpr int NWAVES = 8, NTHREADS = 512;
constexpr int LDS_BYTES = 163840;
constexpr int LDS_MISC_OFF = LDS_BYTES - 256;
constexpr int RS_OFF = 147456;
constexpr int CW_QUEUE = 1024;

constexpr size_t MiB = 1u << 20;
constexpr size_t WS_CTL = 0, CTL_ZERO_BYTES = 1 * MiB;
constexpr size_t WS_H = 1 * MiB;
constexpr size_t WS_HB0 = 65 * MiB;
constexpr size_t WS_HB1 = 97 * MiB;
constexpr size_t WS_HB2 = 129 * MiB;
constexpr size_t WS_PROJ = 161 * MiB;
constexpr size_t WS_BA = 273 * MiB;
constexpr size_t WS_OBUF = 274 * MiB;
constexpr size_t WS_Q2 = 306 * MiB;
constexpr size_t WS_EPRE = 370 * MiB;
constexpr size_t WS_IDX = 402 * MiB;
constexpr size_t WS_GATE = 410 * MiB;
constexpr size_t WS_STAT = 418 * MiB;
constexpr size_t WS_SS1 = WS_IDX + 1 * MiB, WS_SSE = WS_IDX;
constexpr size_t WS_ORAW = 422 * MiB;
constexpr size_t WS_WIN = 550 * MiB;
constexpr size_t WS_WOUT = 582 * MiB;
constexpr size_t WS_WQ = 590 * MiB;
constexpr size_t WS_WG = 606 * MiB;
constexpr size_t WS_WP = 614 * MiB;
constexpr size_t WS_SK = 616 * MiB;
constexpr size_t WS_PB = 618 * MiB;
constexpr size_t WS_U = 650 * MiB;
constexpr size_t WS_V = 778 * MiB;
constexpr size_t WS_SU = WS_STAT + 1 * MiB, WS_SV = WS_STAT + 2 * MiB;
constexpr size_t WS_END = 906 * MiB;

struct Params {
    const float *x, *p, *ln_mix_g, *w_in, *conv_w, *a_log, *dt_bias, *gdn_norm_g, *diff_lambda, *subln_g, *w_out, *ln_ffn_g,
        *peer_wq, *subkeys, *peer_u, *peer_v, *ple_wp, *ple_wg, *ple_norm_g, *final_g;
    float* out;
    unsigned char* ws;
    int pad0, pad1;
};

__device__ __forceinline__ int tidx() { int t = (int)threadIdx.x; asm volatile("" : "+v"(t)); return t; }
#define LDS_BARRIER() asm volatile("s_waitcnt lgkmcnt(0)\n\ts_barrier" ::: "memory")
__device__ __forceinline__ float bf2f(bf16 v) { return __uint_as_float((unsigned)v << 16); }
__device__ __forceinline__ unsigned f2bf(float f) { unsigned u = __float_as_uint(f); return (u + 0x7fffu + ((u >> 16) & 1u)) >> 16; }
__device__ __forceinline__ unsigned pk2(float lo, float hi) { return f2bf(lo) | (f2bf(hi) << 16); }
__device__ __forceinline__ float lo16(unsigned w) { return __uint_as_float(w << 16); }
__device__ __forceinline__ float hi16(unsigned w) { return __uint_as_float(w & 0xffff0000u); }
template <int N> __device__ __forceinline__ float dpp_ror(float x) { return __builtin_bit_cast(float, __builtin_amdgcn_mov_dpp(__builtin_bit_cast(int, x), 0x120 + N, 0xf, 0xf, true)); }
template <int N> __device__ __forceinline__ unsigned dpp_ror_u(unsigned x) { return (unsigned)__builtin_amdgcn_mov_dpp((int)x, 0x120 + N, 0xf, 0xf, true); }
__device__ __forceinline__ float row16_sum(float x) { x += dpp_ror<8>(x); x += dpp_ror<4>(x); x += dpp_ror<2>(x); x += dpp_ror<1>(x); return x; }
__device__ __forceinline__ float row16_max(float x) { x = fmaxf(x, dpp_ror<8>(x)); x = fmaxf(x, dpp_ror<4>(x)); x = fmaxf(x, dpp_ror<2>(x)); x = fmaxf(x, dpp_ror<1>(x)); return x; }
__device__ __forceinline__ unsigned row16_umax(unsigned x) { unsigned y;
    y = dpp_ror_u<8>(x); x = x > y ? x : y; y = dpp_ror_u<4>(x); x = x > y ? x : y; y = dpp_ror_u<2>(x); x = x > y ? x : y; y = dpp_ror_u<1>(x); x = x > y ? x : y; return x; }
__device__ __forceinline__ float xrow16_max(float x) {
    auto s = __builtin_amdgcn_permlane16_swap(__float_as_uint(x), __float_as_uint(x), false, false);
    x = fmaxf(__uint_as_float(s[0]), __uint_as_float(s[1]));
    auto t = __builtin_amdgcn_permlane32_swap(__float_as_uint(x), __float_as_uint(x), false, false);
    return fmaxf(__uint_as_float(t[0]), __uint_as_float(t[1]));
}
__device__ __forceinline__ float xrow16_sum(float x) {
    auto s = __builtin_amdgcn_permlane16_swap(__float_as_uint(x), __float_as_uint(x), false, false);
    x = __uint_as_float(s[0]) + __uint_as_float(s[1]);
    auto t = __builtin_amdgcn_permlane32_swap(__float_as_uint(x), __float_as_uint(x), false, false);
    return __uint_as_float(t[0]) + __uint_as_float(t[1]);
}
__device__ __forceinline__ float wave_sum(float v) { return xrow16_sum(row16_sum(v)); }
__device__ __forceinline__ float wave_max(float v) {
#pragma unroll
    for (int o = 32; o; o >>= 1) v = fmaxf(v, __shfl_xor(v, o));
    return v;
}
__device__ __forceinline__ float sigmoidf_(float x) { return 1.f / (1.f + __expf(-x)); }
__device__ __forceinline__ float dot8(u32x4 a, u32x4 b, float s) {
#pragma unroll
    for (int i = 0; i < 4; ++i) { s += lo16(a[i]) * lo16(b[i]); s += hi16(a[i]) * hi16(b[i]); }
    return s;
}

#define LAS __attribute__((address_space(3)))
__host__ __device__ __forceinline__ int lds_byte(int r, int c) { const int st = (r >> 4) * 2 + (c >> 5), rr = r & 15, cc = c & 31, ob = rr * 64 + cc * 2; return st * 1024 + (ob ^ (((ob >> 9) & 1) << 5)); }
__host__ __device__ __forceinline__ void stage_rc(int b, int& R, int& C) { const int st = b / 1024, sb = b % 1024, swz = sb ^ (((sb >> 9) & 1) << 5); R = (st >> 1) * 16 + swz / 64; C = (st & 1) * 32 + (swz % 64) / 2; }
constexpr int HTB = 16384;
template <class F>
__device__ __forceinline__ void gemm_run(unsigned char* lds_, const bf16* A, const bf16* Bt, int Mm, int N, int K, const F& f, int bid, int nblk, const float* slots_in = nullptr) {
    LAS unsigned char* lds = (LAS unsigned char*)lds_;
    LAS float* RS = (LAS float*)(lds + RS_OFF);
    if (slots_in) {
        const int t = tidx();
        if (t < 256) { const f32x4* sp = (const f32x4*)(slots_in + ((size_t)(bid % (Mm / 256)) * 256 + t) * 16);
            const f32x4 a = sp[0], b = sp[1], c = sp[2], d = sp[3];
            const float s = (((a[0] + a[1]) + (a[2] + a[3])) + ((b[0] + b[1]) + (b[2] + b[3]))) + (((c[0] + c[1]) + (c[2] + c[3])) + ((d[0] + d[1]) + (d[2] + d[3])));
            RS[t] = rsqrtf(s * (1.f / D) + EPS); }
        __syncthreads();
    }
    const int tid = tidx(), wid = __builtin_amdgcn_readfirstlane(tid >> 6), lane = tid & 63, wr = wid >> 2, wc = wid & 3, fr = lane & 15, fq = lane >> 4;
    const int nt = K / 64, ntn = N / 256, nunits = (Mm / 256) * ntn;
    unsigned voff[2];
#pragma unroll
    for (int i = 0; i < 2; ++i) { int R, C; stage_rc(tid * 16 + i * 8192, R, C); voff[i] = (unsigned)(R * K + C) * 2u; }
    const unsigned ldsw = (unsigned)wid * 1024u;
    const int aoff = wr * HTB + lds_byte(fr, fq * 8), boff = (2 + (wc >> 1)) * HTB + lds_byte((wc & 1) * 64 + fr, fq * 8);
#define G_STAGE(bufoff, gbase) do { _Pragma("unroll") for (int _i = 0; _i < 2; ++_i) \
        __builtin_amdgcn_global_load_lds((const unsigned*)((const char*)(gbase) + voff[_i]), (LAS unsigned*)(lds + (bufoff) + ldsw + _i * 8192), 16, 0, 0); } while (0)
    for (int u = bid; u < nunits; u += nblk) {
        const int pm = u % (Mm / 256), pn = u / (Mm / 256);
        const char* gA = (const char*)(A + (size_t)pm * 256 * K);
        const char* gB = (const char*)(Bt + (size_t)pn * 256 * K);
        const size_t hstep = (size_t)128 * K * 2;
        f32x4 acc[8][4];
#pragma unroll
        for (int a = 0; a < 8; ++a)
#pragma unroll
            for (int b = 0; b < 4; ++b) acc[a][b] = (f32x4){0.f, 0.f, 0.f, 0.f};
        G_STAGE(0, gA); G_STAGE(HTB, gA + hstep); G_STAGE(2 * HTB, gB); G_STAGE(3 * HTB, gB + hstep);
        for (int t = 0; t < nt; ++t) {
            const int cb = (t & 1) * 4 * HTB, nb = ((t + 1) & 1) * 4 * HTB;
            asm volatile("s_waitcnt vmcnt(0)" ::: "memory");
            __builtin_amdgcn_s_barrier();
            asm volatile("" ::: "memory");
            if (t + 1 < nt) { const size_t ko = (size_t)(t + 1) * 128; G_STAGE(nb, gA + ko); G_STAGE(nb + HTB, gA + hstep + ko); G_STAGE(nb + 2 * HTB, gB + ko); G_STAGE(nb + 3 * HTB, gB + hstep + ko); }
#pragma unroll
            for (int k = 0; k < 2; ++k) {
                bf16x8 af[8], bfr[4];
#pragma unroll
                for (int n = 0; n < 4; ++n) bfr[n] = *(const LAS bf16x8*)(lds + cb + boff + n * 2048 + k * 1024);
#pragma unroll
                for (int m = 0; m < 8; ++m) af[m] = *(const LAS bf16x8*)(lds + cb + aoff + m * 2048 + k * 1024);
#pragma unroll
                for (int m = 0; m < 8; ++m)
#pragma unroll
                    for (int n = 0; n < 4; ++n) acc[m][n] = __builtin_amdgcn_mfma_f32_16x16x32_bf16(bfr[n], af[m], acc[m][n], 0, 0, 0);
                __builtin_amdgcn_sched_barrier(0);
            }
            asm volatile("s_waitcnt lgkmcnt(0)" ::: "memory");
        }
#pragma unroll
        for (int m = 0; m < 8; ++m) {
            const int lrow = wr * 128 + m * 16 + fr, row = pm * 256 + lrow;
            float ssq = 0.f;
#pragma unroll
            for (int n = 0; n < 4; ++n) { const f32x4 r = f(row, RS[lrow], pn * 256 + wc * 64 + n * 16 + 4 * fq, acc[m][n]); ssq += (r[0] * r[0] + r[1] * r[1]) + (r[2] * r[2] + r[3] * r[3]); }
            if constexpr (F::STATS) { ssq = xrow16_sum(ssq); if (fq == 0) f.slots[(size_t)row * 16 + pn * 4 + wc] = ssq; }
        }
        __syncthreads();
    }
#undef G_STAGE
}

__device__ __forceinline__ u32x2 pk4(f32x4 a) { u32x2 o; o.x = pk2(a[0], a[1]); o.y = pk2(a[2], a[3]); return o; }
struct EpiProj {
    static constexpr bool STATS = false; float* slots;
    bf16* proj; float* ba;
    __device__ __forceinline__ f32x4 operator()(int row, float rstd, int col, f32x4 v) const {
        v = v * rstd;
        if (col < PROJ_W) *(u32x2*)(proj + (size_t)row * PROJ_W + col) = pk4(v);
        else if (col < IN_COLS) *(f32x4*)(ba + (size_t)row * 8 + (col - PROJ_W)) = v;
        return v;
    }
};
struct EpiRes {
    static constexpr bool STATS = true; float* slots;
    float* H; bf16* HB;
    __device__ __forceinline__ f32x4 operator()(int row, float, int col, f32x4 v) const {
        f32x4* hp = (f32x4*)(H + (size_t)row * D + col);
        const f32x4 h = *hp + v; *hp = h;
        *(u32x2*)(HB + (size_t)row * D + col) = pk4(h);
        return h;
    }
};
struct EpiQ2 {
    static constexpr bool STATS = false; float* slots;
    bf16* Q2;
    __device__ __forceinline__ f32x4 operator()(int row, float rstd, int col, f32x4 v) const { v = v * rstd; *(u32x2*)(Q2 + (size_t)row * 2048 + col) = pk4(v); return v; }
};
struct EpiE {
    static constexpr bool STATS = true; float* slots;
    bf16* E;
    __device__ __forceinline__ f32x4 operator()(int row, float, int col, f32x4 v) const { *(u32x2*)(E + (size_t)row * D + col) = pk4(v); return v; }
};
struct EpiPle {
    static constexpr bool STATS = true; float* slots;
    float* H; bf16* HB; const bf16* E; const float* g;
    __device__ __forceinline__ f32x4 operator()(int row, float rstde, int col, f32x4 v) const {
        f32x4* hp = (f32x4*)(H + (size_t)row * D + col);
        const u32x2 ev = *(const u32x2*)(E + (size_t)row * D + col);
        const f32x4 gv = *(const f32x4*)(g + col);
        f32x4 h = *hp;
        h[0] += sigmoidf_(v[0]) * (lo16(ev.x) * rstde * gv[0]); h[1] += sigmoidf_(v[1]) * (hi16(ev.x) * rstde * gv[1]);
        h[2] += sigmoidf_(v[2]) * (lo16(ev.y) * rstde * gv[2]); h[3] += sigmoidf_(v[3]) * (hi16(ev.y) * rstde * gv[3]);
        *hp = h;
        *(u32x2*)(HB + (size_t)row * D + col) = pk4(h);
        return h;
    }
};

__device__ __forceinline__ void transpose_item(const float* W, int K, int N, int Npad, bf16* WT, const float* rowscale, int qcols, float* scr, int item, int lane) {
    const int nblk = Npad / 32, kb = item / nblk, nb = item % nblk, k0 = 64 * kb, n0 = 32 * nb;
    const int n = n0 + (lane & 31);
#pragma unroll 8
    for (int i = 0; i < 32; ++i) {
        const int kk = 2 * i + (lane >> 5);
        float v = (n < N) ? W[(size_t)(k0 + kk) * N + n] : 0.f;
        if (rowscale) v *= rowscale[k0 + kk];
        if (n < qcols) v *= QSCALE;
        scr[kk * 33 + (lane & 31)] = v;
    }
    asm volatile("s_waitcnt lgkmcnt(0)" ::: "memory");
    const int c = lane & 7;
#pragma unroll
    for (int j = 0; j < 4; ++j) {
        const int nn = (lane >> 3) + 8 * j; const float* s = scr + (8 * c) * 33 + nn;
        u32x4 o; o.x = pk2(s[0 * 33], s[1 * 33]); o.y = pk2(s[2 * 33], s[3 * 33]); o.z = pk2(s[4 * 33], s[5 * 33]); o.w = pk2(s[6 * 33], s[7 * 33]);
        *(u32x4*)(WT + (size_t)(n0 + nn) * K + k0 + 8 * c) = o;
    }
    asm volatile("s_waitcnt lgkmcnt(0)" ::: "memory");
}
__device__ __forceinline__ void convert_bulk(const float* src, bf16* dst, size_t n, size_t gtid, size_t nthr) {
    for (size_t i = gtid * 8; i < n; i += nthr * 8) {
        const f32x4 a = *(const f32x4*)(src + i), b = *(const f32x4*)(src + i + 4);
        u32x4 o; o.x = pk2(a[0], a[1]); o.y = pk2(a[2], a[3]); o.z = pk2(b[0], b[1]); o.w = pk2(b[2], b[3]);
        *(u32x4*)(dst + i) = o;
    }
}
__device__ void phase_prologue(const Params& p, unsigned char* lds, int bid, int nblk) {
    const int tid = tidx(), lane = tid & 63, w = tid >> 6;
    const int gw = bid * NWAVES + w, NGW = nblk * NWAVES;
    float* scr = (float*)(lds + w * 16384);
    constexpr int I_IN = 16 * (IN_PAD / 32), I_OUT = 16 * 32, I_Q = 16 * 64, I_G = 16 * 32, I_P = 4 * 32, I_L = I_IN + I_OUT + I_Q + I_G + I_P;
    for (int it = gw; it < DEPTH * I_L; it += NGW) {
        const int L = it / I_L; int r = it % I_L;
        if (r < I_IN) { transpose_item(p.w_in + (size_t)L * D * IN_COLS, D, IN_COLS, IN_PAD, (bf16*)(p.ws + WS_WIN) + (size_t)L * IN_PAD * D, p.ln_mix_g + L * D, 512, scr, r, lane); continue; } r -= I_IN;
        if (r < I_OUT) { transpose_item(p.w_out + (size_t)L * D * D, D, D, D, (bf16*)(p.ws + WS_WOUT) + (size_t)L * D * D, nullptr, 0, scr, r, lane); continue; } r -= I_OUT;
        if (r < I_Q) { transpose_item(p.peer_wq + (size_t)L * D * 2048, D, 2048, 2048, (bf16*)(p.ws + WS_WQ) + (size_t)L * 2048 * D, p.ln_ffn_g + L * D, 0, scr, r, lane); continue; } r -= I_Q;
        if (r < I_G) { transpose_item(p.ple_wg + (size_t)L * D * D, D, D, D, (bf16*)(p.ws + WS_WG) + (size_t)L * D * D, nullptr, 0, scr, r, lane); continue; } r -= I_G;
        transpose_item(p.ple_wp + (size_t)L * 256 * D, 256, D, D, (bf16*)(p.ws + WS_WP) + (size_t)L * D * 256, nullptr, 0, scr, r, lane);
    }
    const size_t gtid = (size_t)bid * NTHREADS + tid, nthr = (size_t)nblk * NTHREADS;
    for (int r = gw; r < 2 * DEPTH * NEXP; r += NGW) {
        const int which = r >= DEPTH * NEXP, rr = which ? r - DEPTH * NEXP : r;
        const float* srow = (which ? p.peer_v : p.peer_u) + (size_t)rr * D + 16 * lane;
        f32x4 v[4];
#pragma unroll
        for (int j = 0; j < 4; ++j) v[j] = *(const f32x4*)(srow + 4 * j);
        float mx = 0.f;
#pragma unroll
        for (int j = 0; j < 4; ++j) mx = fmaxf(mx, fmaxf(fmaxf(fabsf(v[j][0]), fabsf(v[j][1])), fmaxf(fabsf(v[j][2]), fabsf(v[j][3]))));
        mx = xrow16_max(row16_max(mx));
        const float inv = mx > 0.f ? 127.f / mx : 0.f;
        u32x4 o;
#pragma unroll
        for (int j = 0; j < 4; ++j) {
            const unsigned b0 = (unsigned)(__float2int_rn(v[j][0] * inv) + 128), b1 = (unsigned)(__float2int_rn(v[j][1] * inv) + 128), b2 = (unsigned)(__float2int_rn(v[j][2] * inv) + 128), b3 = (unsigned)(__float2int_rn(v[j][3] * inv) + 128);
            o[j] = b0 | (b1 << 8) | (b2 << 16) | (b3 << 24);
        }
        *(u32x4*)(p.ws + (which ? WS_V : WS_U) + (size_t)rr * D + 16 * lane) = o;
        if (lane == 0) ((float*)(p.ws + (which ? WS_SV : WS_SU)))[rr] = mx * (1.f / 127.f);
    }
    convert_bulk(p.p, (bf16*)(p.ws + WS_PB), (size_t)DEPTH * M * 256, gtid, nthr);
    convert_bulk(p.subkeys, (bf16*)(p.ws + WS_SK), (size_t)DEPTH * 8 * 2 * 128 * 128, gtid, nthr);
    float* H = (float*)(p.ws + WS_H); bf16* HB0 = (bf16*)(p.ws + WS_HB0); float* ss0 = (float*)(p.ws + WS_STAT);
    for (int m = gw; m < M; m += NGW) {
        const f32x4* xr = (const f32x4*)(p.x + (size_t)m * D) + lane;
        float ss = 0.f;
#pragma unroll
        for (int j = 0; j < 4; ++j) {
            const f32x4 v = xr[64 * j];
            ss += v[0] * v[0] + v[1] * v[1] + v[2] * v[2] + v[3] * v[3];
            ((f32x4*)(H + (size_t)m * D))[lane + 64 * j] = v;
            u32x2 o; o.x = pk2(v[0], v[1]); o.y = pk2(v[2], v[3]);
            ((u32x2*)(HB0 + (size_t)m * D))[lane + 64 * j] = o;
        }
        ss = wave_sum(ss);
        if (lane < 16) ss0[(size_t)m * 16 + lane] = lane == 0 ? ss : 0.f;
    }
}

typedef short v4i16_t __attribute__((ext_vector_type(4)));
typedef __bf16 bf16x2_t __attribute__((ext_vector_type(2)));
typedef float f32x2_t __attribute__((ext_vector_type(2)));
__device__ __forceinline__ unsigned cvtpk(float lo, float hi) { f32x2_t v = {lo, hi}; bf16x2_t b = __builtin_convertvector(v, bf16x2_t); return __builtin_bit_cast(unsigned, b); }
constexpr int ATT_VOFF = 16384, ATT_VPITCH = 288;
__device__ __forceinline__ void att_unit(const Params& p, int L, LAS unsigned char* lds, int tid, int b, int hh, int qb, float lam, float lam_init) {
    const int lane = tid & 63, w = __builtin_amdgcn_readfirstlane(tid >> 6), fr = lane & 15, fq = lane >> 4;
    const bf16* proj = (const bf16*)(p.ws + WS_PROJ);
    bf16* obuf = (bf16*)(p.ws + WS_OBUF);
    {
        const float slope2 = exp2f(-2.f * (float)(hh + 1)) * 1.4426950408889634f;
        const bf16* kbase = proj + (size_t)b * SEQ * PROJ_W + 512 + hh * 128;
        const bf16* vbase = proj + (size_t)b * SEQ * PROJ_W + 1024 + hh * 128;
        {
            const int qw0 = qb * 128 + w * 16, T = 2 * (qb + 1);
            bf16x8 qf[2][2];
#pragma unroll
            for (int mp = 0; mp < 2; ++mp)
#pragma unroll
                for (int ks = 0; ks < 2; ++ks) qf[mp][ks] = *(const bf16x8*)(proj + ((size_t)b * SEQ + qw0 + fr) * PROJ_W + hh * 128 + mp * 64 + ks * 32 + 8 * fq);
            f32x4 o[2][8];
#pragma unroll
            for (int mp = 0; mp < 2; ++mp)
#pragma unroll
                for (int dt = 0; dt < 8; ++dt) o[mp][dt] = (f32x4){0.f, 0.f, 0.f, 0.f};
            float mrun[2] = {-INFINITY, -INFINITY}, lrun[2] = {0.f, 0.f};
            u32x4 kreg[2], vreg[2];
#pragma unroll
            for (int i = 0; i < 2; ++i) { const int c = tid + 512 * i, key = c >> 4, ch = c & 15;
                kreg[i] = *(const u32x4*)(kbase + (size_t)key * PROJ_W + ch * 8); vreg[i] = *(const u32x4*)(vbase + (size_t)key * PROJ_W + ch * 8); }
            for (int t = 0; t < T; ++t) {
                const int k0 = t * 64;
#pragma unroll
                for (int i = 0; i < 2; ++i) { const int c = tid + 512 * i, key = c >> 4, ch = c & 15;
                    *(LAS u32x4*)(lds + key * 256 + ((ch ^ (key & 15)) << 4)) = kreg[i];
                    *(LAS u32x4*)(lds + ATT_VOFF + key * ATT_VPITCH + ch * 16) = vreg[i]; }
                LDS_BARRIER();
                if (t + 1 < T) {
#pragma unroll
                    for (int i = 0; i < 2; ++i) { const int c = tid + 512 * i, key = k0 + 64 + (c >> 4), ch = c & 15;
                        kreg[i] = *(const u32x4*)(kbase + (size_t)key * PROJ_W + ch * 8); vreg[i] = *(const u32x4*)(vbase + (size_t)key * PROJ_W + ch * 8); }
                }
                if (k0 <= qw0 + 15) {
                    f32x4 s[2][4];
                    const float base = -slope2 * (float)(qw0 + fr - k0 - 4 * fq);
#pragma unroll
                    for (int kt = 0; kt < 4; ++kt)
#pragma unroll
                        for (int r = 0; r < 4; ++r) { const float v = base + slope2 * (float)(16 * kt + r); s[0][kt][r] = v; s[1][kt][r] = v; }
#pragma unroll
                    for (int mp = 0; mp < 2; ++mp)
#pragma unroll
                        for (int kt = 0; kt < 4; ++kt)
#pragma unroll
                            for (int ks = 0; ks < 2; ++ks) {
                                const bf16x8 kf = *(const LAS bf16x8*)(lds + (16 * kt + fr) * 256 + (((mp * 8 + ks * 4 + fq) ^ fr) << 4));
                                s[mp][kt] = __builtin_amdgcn_mfma_f32_16x16x32_bf16(kf, qf[mp][ks], s[mp][kt], 0, 0, 0);
                            }
                    if (k0 + 63 > qw0) {
                        const int lim = qw0 + fr - k0 - 4 * fq;
#pragma unroll
                        for (int mp = 0; mp < 2; ++mp)
#pragma unroll
                            for (int kt = 0; kt < 4; ++kt)
#pragma unroll
                                for (int r = 0; r < 4; ++r) if (16 * kt + r > lim) s[mp][kt][r] = -INFINITY;
                    }
                    bf16x8 pb[2][2];
#pragma unroll
                    for (int mp = 0; mp < 2; ++mp) {
                        float mx = fmaxf(fmaxf(s[mp][0][0], s[mp][0][1]), fmaxf(s[mp][0][2], s[mp][0][3]));
#pragma unroll
                        for (int kt = 1; kt < 4; ++kt) mx = fmaxf(mx, fmaxf(fmaxf(s[mp][kt][0], s[mp][kt][1]), fmaxf(s[mp][kt][2], s[mp][kt][3])));
                        mx = xrow16_max(mx);
                        const float mnew = fmaxf(mrun[mp], mx);
                        const float alpha = __builtin_amdgcn_exp2f(mrun[mp] - mnew);
                        mrun[mp] = mnew;
                        float ps = 0.f;
#pragma unroll
                        for (int kt = 0; kt < 4; ++kt)
#pragma unroll
                            for (int r = 0; r < 4; ++r) { const float e = __builtin_amdgcn_exp2f(s[mp][kt][r] - mnew); s[mp][kt][r] = e; ps += e; }
                        lrun[mp] = lrun[mp] * alpha + ps;
#pragma unroll
                        for (int dt = 0; dt < 8; ++dt) o[mp][dt] = o[mp][dt] * alpha;
#pragma unroll
                        for (int ks = 0; ks < 2; ++ks) {
                            u32x4 pk; pk.x = cvtpk(s[mp][2 * ks][0], s[mp][2 * ks][1]); pk.y = cvtpk(s[mp][2 * ks][2], s[mp][2 * ks][3]);
                            pk.z = cvtpk(s[mp][2 * ks + 1][0], s[mp][2 * ks + 1][1]); pk.w = cvtpk(s[mp][2 * ks + 1][2], s[mp][2 * ks + 1][3]);
                            pb[mp][ks] = __builtin_bit_cast(bf16x8, pk);
                        }
                    }
                    const int gl = lane & 15;
                    LAS unsigned char* vrd = lds + ATT_VOFF + (4 * fq + (gl >> 2)) * ATT_VPITCH + (gl & 3) * 8;
#pragma unroll
                    for (int dt = 0; dt < 8; ++dt)
#pragma unroll
                        for (int ks = 0; ks < 2; ++ks) {
                            const v4i16_t v0 = __builtin_amdgcn_ds_read_tr16_b64_v4i16((LAS v4i16_t*)(vrd + (32 * ks) * ATT_VPITCH + dt * 32));
                            const v4i16_t v1 = __builtin_amdgcn_ds_read_tr16_b64_v4i16((LAS v4i16_t*)(vrd + (32 * ks + 16) * ATT_VPITCH + dt * 32));
                            bf16x8 vf; vf[0] = v0[0]; vf[1] = v0[1]; vf[2] = v0[2]; vf[3] = v0[3]; vf[4] = v1[0]; vf[5] = v1[1]; vf[6] = v1[2]; vf[7] = v1[3];
                            o[0][dt] = __builtin_amdgcn_mfma_f32_16x16x32_bf16(vf, pb[0][ks], o[0][dt], 0, 0, 0);
                            o[1][dt] = __builtin_amdgcn_mfma_f32_16x16x32_bf16(vf, pb[1][ks], o[1][dt], 0, 0, 0);
                        }
                }
                LDS_BARRIER();
            }
            const float i1 = 1.f / xrow16_sum(lrun[0]), i2 = lam / xrow16_sum(lrun[1]);
            float ss = 0.f;
#pragma unroll
            for (int dt = 0; dt < 8; ++dt)
#pragma unroll
                for (int r = 0; r < 4; ++r) { const float v = o[0][dt][r] * i1 - o[1][dt][r] * i2; o[0][dt][r] = v; ss += v * v; }
            ss = xrow16_sum(ss);
            const float rn = rsqrtf(ss * (1.f / 128.f) + EPS) * (1.f - lam_init);
            const float* g = p.subln_g + L * 128;
            bf16* orow = obuf + ((size_t)b * SEQ + qw0 + fr) * D + hh * 128;
#pragma unroll
            for (int dt = 0; dt < 8; ++dt) {
                const f32x4 gv = *(const f32x4*)(g + 16 * dt + 4 * fq);
                u32x2 ov; ov.x = pk2(o[0][dt][0] * rn * gv[0], o[0][dt][1] * rn * gv[1]); ov.y = pk2(o[0][dt][2] * rn * gv[2], o[0][dt][3] * rn * gv[3]);
                *(u32x2*)(orow + 16 * dt + 4 * fq) = ov;
            }
        }
    }
}

__device__ void phase_att_queue(const Params& p, int L, unsigned char* lds_, int bid, int nblk) {
    LAS unsigned char* lds = (LAS unsigned char*)lds_;
    const int tid = tidx(), lane = tid & 63;
    const float* lp = p.diff_lambda + L * 256;
    const float d1 = wave_sum(lp[lane] * lp[64 + lane]), d2 = wave_sum(lp[128 + lane] * lp[192 + lane]);
    const float lam_init = 0.8f - 0.6f * expf(-0.3f * (float)L);
    const float lam = expf(d1) - expf(d2) + lam_init;
    unsigned* head = (unsigned*)(p.ws + WS_CTL) + CW_QUEUE + L;
    volatile LAS int* slot = (volatile LAS int*)(lds + LDS_MISC_OFF + 64);
    for (;;) {
        __syncthreads();
        if (tid == 0) *slot = (int)__hip_atomic_fetch_add(head, 1u, __ATOMIC_RELAXED, __HIP_MEMORY_SCOPE_AGENT);
        __syncthreads();
        const int u = *slot;
        if (u >= 512) break;
        att_unit(p, L, lds, tid, (u & 31) >> 2, u & 3, 15 - (u >> 5), lam, lam_init);
    }
}

constexpr size_t GD_WP = WS_ORAW, GD_QD = WS_ORAW + 16 * MiB, GD_AIP = WS_ORAW + 32 * MiB, GD_KDT = WS_ORAW + 40 * MiB, GD_UT = WS_ORAW + 56 * MiB, GD_GL = WS_ORAW + 72 * MiB;
__device__ __forceinline__ int perm_pos(int k) { return (k & ~31) + 8 * ((k >> 2) & 3) + 4 * ((k >> 4) & 1) + (k & 3); }
__device__ __forceinline__ float softplusf_(float x) { return x > 20.f ? x : log1pf(expf(x)); }

constexpr int GP_KN = 0, GP_QN = 17408, GP_RT = 34816, GP_LM = 71680, GP_TB = 89088, GP_GT = 98304, GP_T0T = 99328;
constexpr int GP_KP = 272, GP_RP = 144, GP_LP = 68, GP_TP = 144;
__device__ void phase_gdn_prep(const Params& p, int L, unsigned char* lds_, int bid, int nblk) {
    LAS unsigned char* lds = (LAS unsigned char*)lds_;
    const int tid = tidx(), lane = tid & 63, w = __builtin_amdgcn_readfirstlane(tid >> 6), fr = lane & 15, fq = lane >> 4;
    const bf16* proj = (const bf16*)(p.ws + WS_PROJ);
    const float* BA = (const float*)(p.ws + WS_BA);
    bf16* WP = (bf16*)(p.ws + GD_WP); bf16* QD = (bf16*)(p.ws + GD_QD); bf16* AIP = (bf16*)(p.ws + GD_AIP); bf16* KDT = (bf16*)(p.ws + GD_KDT); bf16* UT = (bf16*)(p.ws + GD_UT);
    float* GL = (float*)(p.ws + GD_GL);
    const float* cw = p.conv_w + (size_t)L * 4 * 1536;
    LAS float* beta_s = (LAS float*)(lds + GP_GT); LAS float* gc_s = beta_s + 64; LAS float* egc_s = gc_s + 64; LAS float* edl_s = egc_s + 64;
    LAS float* Lm = (LAS float*)(lds + GP_LM);
    for (int item = bid; item < 1024; item += nblk) {
        const int n = item & 31, bh = item >> 5, hh = bh & 3, b = bh >> 2, t0 = n * 64;
        const size_t row0 = (size_t)b * SEQ + t0;
        __syncthreads();
        if (w == 0) {
            const float negA = -expf(p.a_log[L * 4 + hh]), dtb = p.dt_bias[L * 4 + hh];
            const float bb = BA[(row0 + lane) * 8 + hh], aa = BA[(row0 + lane) * 8 + 4 + hh] + dtb;
            float c = negA * softplusf_(aa);
#pragma unroll
            for (int o = 1; o < 64; o <<= 1) { const float t = __shfl_up(c, o); if (lane >= o) c += t; }
            const float glast = __shfl(c, 63);
            beta_s[lane] = sigmoidf_(bb); gc_s[lane] = c; egc_s[lane] = expf(c); edl_s[lane] = expf(glast - c);
            if (lane == 0) GL[item] = expf(glast);
        }
        __syncthreads();
        {
            const int colq = hh * 128 + 2 * lane;
            unsigned xk[11], xv[11];
#pragma unroll
            for (int r = 0; r < 11; ++r) { const int tt = t0 + 8 * w - 3 + r;
                xk[r] = (tt >= 0) ? *(const unsigned*)(proj + ((size_t)b * SEQ + tt) * PROJ_W + 1536 + 512 + colq) : 0u;
                xv[r] = (tt >= 0) ? *(const unsigned*)(proj + ((size_t)b * SEQ + tt) * PROJ_W + 1536 + 1024 + colq) : 0u; }
            {
                float wq[4][2]; unsigned xq[11];
#pragma unroll
                for (int j = 0; j < 4; ++j) { wq[j][0] = cw[j * 1536 + colq]; wq[j][1] = cw[j * 1536 + colq + 1]; }
#pragma unroll
                for (int r = 0; r < 11; ++r) { const int tt = t0 + 8 * w - 3 + r; xq[r] = (tt >= 0) ? *(const unsigned*)(proj + ((size_t)b * SEQ + tt) * PROJ_W + 1536 + colq) : 0u; }
#pragma unroll
                for (int i = 0; i < 8; ++i) {
                    const int c = 8 * w + i;
                    float q0 = 0.f, q1 = 0.f;
#pragma unroll
                    for (int j = 0; j < 4; ++j) { q0 += wq[j][0] * lo16(xq[i + j]); q1 += wq[j][1] * hi16(xq[i + j]); }
                    q0 *= sigmoidf_(q0); q1 *= sigmoidf_(q1);
                    const float sq = rsqrtf(wave_sum(q0 * q0 + q1 * q1) + EPS) * 0.08838834764831845f;
                    q0 *= sq; q1 *= sq;
                    const float eg = egc_s[c];
                    *(LAS unsigned*)(lds + GP_QN + c * GP_KP + lane * 4) = pk2(q0, q1);
                    *(unsigned*)(QD + ((size_t)item * 64 + c) * 128 + perm_pos(2 * lane)) = pk2(q0 * eg, q1 * eg);
                }
            }
            __builtin_amdgcn_sched_barrier(0);
            {
                float wk[4][2];
#pragma unroll
                for (int j = 0; j < 4; ++j) { wk[j][0] = cw[j * 1536 + 512 + colq]; wk[j][1] = cw[j * 1536 + 512 + colq + 1]; }
                unsigned kd0[8], kd1[8], rk0[8], rk1[8];
#pragma unroll
                for (int i = 0; i < 8; ++i) {
                    const int c = 8 * w + i;
                    float k0 = 0.f, k1 = 0.f;
#pragma unroll
                    for (int j = 0; j < 4; ++j) { k0 += wk[j][0] * lo16(xk[i + j]); k1 += wk[j][1] * hi16(xk[i + j]); }
                    k0 *= sigmoidf_(k0); k1 *= sigmoidf_(k1);
                    const float sk = rsqrtf(wave_sum(k0 * k0 + k1 * k1) + EPS);
                    k0 *= sk; k1 *= sk;
                    const float be = beta_s[c], eg = egc_s[c], ed = edl_s[c];
                    *(LAS unsigned*)(lds + GP_KN + c * GP_KP + lane * 4) = pk2(k0, k1);
                    kd0[i] = f2bf(k0 * ed); kd1[i] = f2bf(k1 * ed);
                    rk0[i] = f2bf(k0 * be * eg); rk1[i] = f2bf(k1 * be * eg);
                }
                u32x4 o;
                o.x = rk0[0] | (rk0[1] << 16); o.y = rk0[2] | (rk0[3] << 16); o.z = rk0[4] | (rk0[5] << 16); o.w = rk0[6] | (rk0[7] << 16); *(LAS u32x4*)(lds + GP_RT + (128 + 2 * lane) * GP_RP + 16 * w) = o;
                o.x = rk1[0] | (rk1[1] << 16); o.y = rk1[2] | (rk1[3] << 16); o.z = rk1[4] | (rk1[5] << 16); o.w = rk1[6] | (rk1[7] << 16); *(LAS u32x4*)(lds + GP_RT + (128 + 2 * lane + 1) * GP_RP + 16 * w) = o;
                const int pa = perm_pos(8 * w), pb = perm_pos(8 * w + 4);
                bf16* kr0 = KDT + ((size_t)item * 128 + 2 * lane) * 64; bf16* kr1 = kr0 + 64;
                u32x2 h2;
                h2.x = kd0[0] | (kd0[1] << 16); h2.y = kd0[2] | (kd0[3] << 16); *(u32x2*)(kr0 + pa) = h2;
                h2.x = kd0[4] | (kd0[5] << 16); h2.y = kd0[6] | (kd0[7] << 16); *(u32x2*)(kr0 + pb) = h2;
                h2.x = kd1[0] | (kd1[1] << 16); h2.y = kd1[2] | (kd1[3] << 16); *(u32x2*)(kr1 + pa) = h2;
                h2.x = kd1[4] | (kd1[5] << 16); h2.y = kd1[6] | (kd1[7] << 16); *(u32x2*)(kr1 + pb) = h2;
            }
            __builtin_amdgcn_sched_barrier(0);
            {
                float wv[4][2];
#pragma unroll
                for (int j = 0; j < 4; ++j) { wv[j][0] = cw[j * 1536 + 1024 + colq]; wv[j][1] = cw[j * 1536 + 1024 + colq + 1]; }
                unsigned rv0[8], rv1[8];
#pragma unroll
                for (int i = 0; i < 8; ++i) {
                    float v0 = 0.f, v1 = 0.f;
#pragma unroll
                    for (int j = 0; j < 4; ++j) { v0 += wv[j][0] * lo16(xv[i + j]); v1 += wv[j][1] * hi16(xv[i + j]); }
                    v0 *= sigmoidf_(v0); v1 *= sigmoidf_(v1);
                    const float be = beta_s[8 * w + i];
                    rv0[i] = f2bf(v0 * be); rv1[i] = f2bf(v1 * be);
                }
                u32x4 o;
                o.x = rv0[0] | (rv0[1] << 16); o.y = rv0[2] | (rv0[3] << 16); o.z = rv0[4] | (rv0[5] << 16); o.w = rv0[6] | (rv0[7] << 16); *(LAS u32x4*)(lds + GP_RT + (2 * lane) * GP_RP + 16 * w) = o;
                o.x = rv1[0] | (rv1[1] << 16); o.y = rv1[2] | (rv1[3] << 16); o.z = rv1[4] | (rv1[5] << 16); o.w = rv1[6] | (rv1[7] << 16); *(LAS u32x4*)(lds + GP_RT + (2 * lane + 1) * GP_RP + 16 * w) = o;
            }
        }
        __syncthreads();
#pragma unroll
        for (int q = 0; q < 2; ++q) {
            const int id = 2 * w + q, ct = id >> 2, st = id & 3;
            if (st <= ct) {
                f32x4 acc = (f32x4){0.f, 0.f, 0.f, 0.f};
#pragma unroll
                for (int ks = 0; ks < 4; ++ks) {
                    const bf16x8 a = *(const LAS bf16x8*)(lds + GP_KN + (16 * ct + fr) * GP_KP + (32 * ks + 8 * fq) * 2);
                    const bf16x8 bb = *(const LAS bf16x8*)(lds + GP_KN + (16 * st + fr) * GP_KP + (32 * ks + 8 * fq) * 2);
                    acc = __builtin_amdgcn_mfma_f32_16x16x32_bf16(a, bb, acc, 0, 0, 0);
                }
                const int s = 16 * st + fr; const float gs = gc_s[s];
#pragma unroll
                for (int r = 0; r < 4; ++r) { const int c = 16 * ct + 4 * fq + r;
                    Lm[c * GP_LP + s] = (s < c) ? beta_s[c] * acc[r] * expf(fminf(gc_s[c] - gs, 0.f)) : 0.f; }
            }
        }
        __syncthreads();
        if (w < 2) {
            const int o = 32 * w;
            float t[32];
            int zoff = 0; asm volatile("" : "+v"(zoff));
            const LAS float* Lz = Lm + zoff + o * GP_LP + o;
            const int col = lane & 31;
#pragma unroll
            for (int i = 0; i < 32; ++i) {
                float a0 = (i == lane) ? 1.f : 0.f, a1 = 0.f, a2 = 0.f, a3 = 0.f;
#pragma unroll
                for (int s4 = 0; s4 + 4 <= i; s4 += 4) { const f32x4 lv = *(const LAS f32x4*)(Lz + i * GP_LP + s4);
                    a0 -= lv[0] * t[s4]; a1 -= lv[1] * t[s4 + 1]; a2 -= lv[2] * t[s4 + 2]; a3 -= lv[3] * t[s4 + 3]; }
#pragma unroll
                for (int s = i & ~3; s < i; ++s) a0 -= Lz[i * GP_LP + s] * t[s];
                t[i] = (lane < 32) ? (a0 + a1) + (a2 + a3) : 0.f;
                const bf16 tb = (bf16)f2bf(t[i]);
                if (w == 0) { *(LAS bf16*)(lds + GP_TB + i * GP_TP + lane * 2) = tb;
                              if (lane < 32) *(LAS bf16*)(lds + GP_T0T + lane * 80 + i * 2) = tb; }
                else if (lane < 32) *(LAS bf16*)(lds + GP_TB + (32 + i) * GP_TP + (32 + col) * 2) = tb;
                if ((i & 3) == 3) __builtin_amdgcn_sched_barrier(0);
            }
        } else {
            for (int id = w - 2; id < 16; id += 6) {
                const int ct = id >> 2, st = id & 3;
                f32x4 acc = (f32x4){0.f, 0.f, 0.f, 0.f};
                if (st <= ct) {
#pragma unroll
                    for (int ks = 0; ks < 4; ++ks) {
                        const bf16x8 a = *(const LAS bf16x8*)(lds + GP_QN + (16 * ct + fr) * GP_KP + (32 * ks + 8 * fq) * 2);
                        const bf16x8 bb = *(const LAS bf16x8*)(lds + GP_KN + (16 * st + fr) * GP_KP + (32 * ks + 8 * fq) * 2);
                        acc = __builtin_amdgcn_mfma_f32_16x16x32_bf16(a, bb, acc, 0, 0, 0);
                    }
                }
                const int s = 16 * st + fr; const float gs = gc_s[s]; const int ps = perm_pos(s);
#pragma unroll
                for (int r = 0; r < 4; ++r) { const int c = 16 * ct + 4 * fq + r;
                    const float v = (s <= c) ? acc[r] * expf(fminf(gc_s[c] - gs, 0.f)) : 0.f;
                    AIP[((size_t)item * 64 + c) * 64 + ps] = (bf16)f2bf(v); }
            }
        }
        __syncthreads();
        if (w == 0) {
            f32x4 P[2][2];
#pragma unroll
            for (int it = 0; it < 2; ++it) {
                const LAS float* lr = Lm + (32 + 16 * it + fr) * GP_LP + 8 * fq;
                const f32x4 l0 = *(const LAS f32x4*)lr, l1 = *(const LAS f32x4*)(lr + 4);
                u32x4 pk; pk.x = cvtpk(l0[0], l0[1]); pk.y = cvtpk(l0[2], l0[3]); pk.z = cvtpk(l1[0], l1[1]); pk.w = cvtpk(l1[2], l1[3]);
                const bf16x8 a = __builtin_bit_cast(bf16x8, pk);
#pragma unroll
                for (int jt = 0; jt < 2; ++jt) {
                    const bf16x8 bb = *(const LAS bf16x8*)(lds + GP_T0T + (16 * jt + fr) * 80 + 16 * fq);
                    P[it][jt] = __builtin_amdgcn_mfma_f32_16x16x32_bf16(a, bb, (f32x4){0.f, 0.f, 0.f, 0.f}, 0, 0, 0);
                }
            }
#pragma unroll
            for (int jt = 0; jt < 2; ++jt) {
                u32x4 pk; pk.x = cvtpk(P[0][jt][0], P[0][jt][1]); pk.y = cvtpk(P[0][jt][2], P[0][jt][3]); pk.z = cvtpk(P[1][jt][0], P[1][jt][1]); pk.w = cvtpk(P[1][jt][2], P[1][jt][3]);
                const bf16x8 pb = __builtin_bit_cast(bf16x8, pk);
#pragma unroll
                for (int i2 = 0; i2 < 2; ++i2) {
                    const LAS unsigned char* tr = lds + GP_TB + (32 + 16 * i2 + fr) * GP_TP + (32 + 4 * fq) * 2;
                    const u32x2 ta = *(const LAS u32x2*)tr, tb2 = *(const LAS u32x2*)(tr + 32);
                    u32x4 ak; ak.x = ta.x; ak.y = ta.y; ak.z = tb2.x; ak.w = tb2.y;
                    const f32x4 r = __builtin_amdgcn_mfma_f32_16x16x32_bf16(__builtin_bit_cast(bf16x8, ak), pb, (f32x4){0.f, 0.f, 0.f, 0.f}, 0, 0, 0);
#pragma unroll
                    for (int q = 0; q < 4; ++q) *(LAS bf16*)(lds + GP_TB + (32 + 16 * i2 + 4 * fq + q) * GP_TP + (16 * jt + fr) * 2) = (bf16)f2bf(-r[q]);
                }
            }
        }
        __syncthreads();
#pragma unroll
        for (int q = 0; q < 2; ++q) {
            const int colt = 2 * w + q;
            bf16x8 af[2];
#pragma unroll
            for (int ks = 0; ks < 2; ++ks) af[ks] = *(const LAS bf16x8*)(lds + GP_RT + (16 * colt + fr) * GP_RP + (32 * ks + 8 * fq) * 2);
#pragma unroll
            for (int ct = 0; ct < 4; ++ct) {
                f32x4 acc = (f32x4){0.f, 0.f, 0.f, 0.f};
#pragma unroll
                for (int ks = 0; ks < 2; ++ks) {
                    const bf16x8 bb = *(const LAS bf16x8*)(lds + GP_TB + (16 * ct + fr) * GP_TP + (32 * ks + 8 * fq) * 2);
                    acc = __builtin_amdgcn_mfma_f32_16x16x32_bf16(af[ks], bb, acc, 0, 0, 0);
                }
                const int c = 16 * ct + fr;
                if (colt < 8) {
#pragma unroll
                    for (int r = 0; r < 4; ++r) UT[((size_t)item * 128 + 16 * colt + 4 * fq + r) * 64 + c] = (bf16)f2bf(acc[r]);
                } else {
                    const int kt = colt - 8;
                    u32x2 h2; h2.x = pk2(-acc[0], -acc[1]); h2.y = pk2(-acc[2], -acc[3]);
                    *(u32x2*)(WP + ((size_t)item * 64 + c) * 128 + 32 * (kt >> 1) + 8 * fq + 4 * (kt & 1)) = h2;
                }
            }
        }
    }
    __syncthreads();
}

constexpr int GS_WP = 0, GS_QD = 17408, GS_AIP = 34816, GS_KDT = 44032, GS_BUF = 62464, GS_OB = 2 * GS_BUF, GS_OBP = 272;
__device__ void phase_gdn_scan(const Params& p, int L, unsigned char* lds_, int bid, int nblk) {
    LAS unsigned char* lds = (LAS unsigned char*)lds_;
    const int tid = tidx(), lane = tid & 63, w = __builtin_amdgcn_readfirstlane(tid >> 6), fr = lane & 15, fq = lane >> 4;
    const bf16* proj = (const bf16*)(p.ws + WS_PROJ);
    const bf16* WP = (const bf16*)(p.ws + GD_WP); const bf16* QD = (const bf16*)(p.ws + GD_QD); const bf16* AIP = (const bf16*)(p.ws + GD_AIP);
    const bf16* KDT = (const bf16*)(p.ws + GD_KDT); const bf16* UT = (const bf16*)(p.ws + GD_UT); const float* GL = (const float*)(p.ws + GD_GL);
    bf16* obuf = (bf16*)(p.ws + WS_OBUF);
    for (int item = bid; item < 32; item += nblk) {
        const int hh = item & 3, b = item >> 2;
        const int fc = tid >> 4, fv = tid & 15;
        float gn[8];
#pragma unroll
        for (int i = 0; i < 8; ++i) gn[i] = p.gdn_norm_g[L * 128 + 8 * fv + i];
        f32x4 S[8];
#pragma unroll
        for (int kt = 0; kt < 8; ++kt) S[kt] = (f32x4){0.f, 0.f, 0.f, 0.f};
        u32x4 st[7];
        auto gload = [&](int ci) {
#pragma unroll
            for (int i = 0; i < 7; ++i) {
                const int pc = tid + 512 * i;
                const bf16* src;
                if (i < 2) src = WP + (size_t)ci * 8192 + pc * 8;
                else if (i < 4) src = QD + (size_t)ci * 8192 + (pc - 1024) * 8;
                else if (i < 5) src = AIP + (size_t)ci * 4096 + (pc - 2048) * 8;
                else src = KDT + (size_t)ci * 8192 + (pc - 2560) * 8;
                st[i] = *(const u32x4*)src;
            }
        };
        auto lstore = [&](int buf) {
#pragma unroll
            for (int i = 0; i < 7; ++i) {
                const int pc = tid + 512 * i;
                int off;
                if (i < 2) off = GS_WP + (pc >> 4) * 272 + (pc & 15) * 16;
                else if (i < 4) { const int q = pc - 1024; off = GS_QD + (q >> 4) * 272 + (q & 15) * 16; }
                else if (i < 5) { const int q = pc - 2048; off = GS_AIP + (q >> 3) * 144 + (q & 7) * 16; }
                else { const int q = pc - 2560; off = GS_KDT + (q >> 3) * 144 + (q & 7) * 16; }
                *(LAS u32x4*)(lds + buf * GS_BUF + off) = st[i];
            }
        };
        __syncthreads();
        gload(item * 32); lstore(0);
        u32x2 ut[4]; float gl;
        {
            const int ci = item * 32;
#pragma unroll
            for (int ct = 0; ct < 4; ++ct) ut[ct] = *(const u32x2*)(UT + ((size_t)ci * 128 + 16 * w + fr) * 64 + 16 * ct + 4 * fq);
            gl = GL[ci];
        }
        __syncthreads();
        for (int n = 0; n < 32; ++n) {
            const int ci = item * 32 + n, buf = n & 1;
            const size_t rowc = (size_t)b * SEQ + n * 64;
            u32x2 utn[4]; float gln = 0.f;
            if (n + 1 < 32) {
                gload(ci + 1);
#pragma unroll
                for (int ct = 0; ct < 4; ++ct) utn[ct] = *(const u32x2*)(UT + ((size_t)(ci + 1) * 128 + 16 * w + fr) * 64 + 16 * ct + 4 * fq);
                gln = GL[ci + 1];
            }
            u32x4 zq[2];
#pragma unroll
            for (int ps = 0; ps < 2; ++ps) zq[ps] = *(const u32x4*)(proj + (rowc + 32 * ps + fc) * PROJ_W + 3072 + hh * 128 + 8 * fv);
            f32x4 vn[4], oacc[4];
#pragma unroll
            for (int ct = 0; ct < 4; ++ct) { vn[ct] = (f32x4){lo16(ut[ct].x), hi16(ut[ct].x), lo16(ut[ct].y), hi16(ut[ct].y)}; oacc[ct] = (f32x4){0.f, 0.f, 0.f, 0.f}; }
            bf16x8 sb[4];
#pragma unroll
            for (int ks = 0; ks < 4; ++ks) { u32x4 pk; pk.x = cvtpk(S[2 * ks][0], S[2 * ks][1]); pk.y = cvtpk(S[2 * ks][2], S[2 * ks][3]); pk.z = cvtpk(S[2 * ks + 1][0], S[2 * ks + 1][1]); pk.w = cvtpk(S[2 * ks + 1][2], S[2 * ks + 1][3]);
                sb[ks] = __builtin_bit_cast(bf16x8, pk); }
            LAS unsigned char* bb = lds + buf * GS_BUF;
            bf16x8 f0[8], f1[8];
#define LD_A(F, ct) do { _Pragma("unroll") for (int ks = 0; ks < 4; ++ks) { F[ks] = *(const LAS bf16x8*)(bb + GS_WP + (16 * (ct) + fr) * 272 + (32 * ks + 8 * fq) * 2); \
                    F[4 + ks] = *(const LAS bf16x8*)(bb + GS_QD + (16 * (ct) + fr) * 272 + (32 * ks + 8 * fq) * 2); } } while (0)
#define MM_A(F, ct) do { _Pragma("unroll") for (int ks = 0; ks < 4; ++ks) { vn[ct] = __builtin_amdgcn_mfma_f32_16x16x32_bf16(F[ks], sb[ks], vn[ct], 0, 0, 0); \
                    oacc[ct] = __builtin_amdgcn_mfma_f32_16x16x32_bf16(F[4 + ks], sb[ks], oacc[ct], 0, 0, 0); } } while (0)
#define SBAR() __builtin_amdgcn_sched_barrier(0)
            LD_A(f0, 0); SBAR();
            LD_A(f1, 1); MM_A(f0, 0); SBAR();
            LD_A(f0, 2); MM_A(f1, 1); SBAR();
            LD_A(f1, 3); MM_A(f0, 2); SBAR();
#pragma unroll
            for (int ct = 0; ct < 4; ++ct)
#pragma unroll
                for (int ss = 0; ss < 2; ++ss) f0[2 * ct + ss] = *(const LAS bf16x8*)(bb + GS_AIP + (16 * ct + fr) * 144 + (32 * ss + 8 * fq) * 2);
            MM_A(f1, 3); SBAR();
            bf16x8 vb[2];
#pragma unroll
            for (int ss = 0; ss < 2; ++ss) { u32x4 pk; pk.x = cvtpk(vn[2 * ss][0], vn[2 * ss][1]); pk.y = cvtpk(vn[2 * ss][2], vn[2 * ss][3]); pk.z = cvtpk(vn[2 * ss + 1][0], vn[2 * ss + 1][1]); pk.w = cvtpk(vn[2 * ss + 1][2], vn[2 * ss + 1][3]);
                vb[ss] = __builtin_bit_cast(bf16x8, pk); }
#pragma unroll
            for (int kt = 0; kt < 4; ++kt)
#pragma unroll
                for (int ss = 0; ss < 2; ++ss) f1[2 * kt + ss] = *(const LAS bf16x8*)(bb + GS_KDT + (16 * kt + fr) * 144 + (32 * ss + 8 * fq) * 2);
#pragma unroll
            for (int ct = 0; ct < 4; ++ct)
#pragma unroll
                for (int ss = 0; ss < 2; ++ss) oacc[ct] = __builtin_amdgcn_mfma_f32_16x16x32_bf16(f0[2 * ct + ss], vb[ss], oacc[ct], 0, 0, 0);
            SBAR();
#pragma unroll
            for (int kt = 4; kt < 8; ++kt)
#pragma unroll
                for (int ss = 0; ss < 2; ++ss) f0[2 * (kt - 4) + ss] = *(const LAS bf16x8*)(bb + GS_KDT + (16 * kt + fr) * 144 + (32 * ss + 8 * fq) * 2);
#pragma unroll
            for (int kt = 0; kt < 4; ++kt) {
                S[kt] = S[kt] * gl;
#pragma unroll
                for (int ss = 0; ss < 2; ++ss) S[kt] = __builtin_amdgcn_mfma_f32_16x16x32_bf16(f1[2 * kt + ss], vb[ss], S[kt], 0, 0, 0);
            }
            SBAR();
#pragma unroll
            for (int kt = 4; kt < 8; ++kt) {
                S[kt] = S[kt] * gl;
#pragma unroll
                for (int ss = 0; ss < 2; ++ss) S[kt] = __builtin_amdgcn_mfma_f32_16x16x32_bf16(f0[2 * (kt - 4) + ss], vb[ss], S[kt], 0, 0, 0);
            }
#undef LD_A
#undef MM_A
#undef SBAR
            LDS_BARRIER();
#pragma unroll
            for (int ct = 0; ct < 4; ++ct)
#pragma unroll
                for (int r = 0; r < 4; r += 2) {
                    const unsigned pk = cvtpk(oacc[ct][r], oacc[ct][r + 1]);
                    *(LAS bf16*)(lds + GS_OB + (16 * ct + 4 * fq + r) * GS_OBP + (16 * w + fr) * 2) = (bf16)(pk & 0xffffu);
                    *(LAS bf16*)(lds + GS_OB + (16 * ct + 4 * fq + r + 1) * GS_OBP + (16 * w + fr) * 2) = (bf16)(pk >> 16);
                }
            if (n + 1 < 32) {
                lstore(buf ^ 1);
#pragma unroll
                for (int ct = 0; ct < 4; ++ct) ut[ct] = utn[ct];
                gl = gln;
            }
            LDS_BARRIER();
#pragma unroll
            for (int ps = 0; ps < 2; ++ps) {
                const int c = 32 * ps + fc;
                const u32x4 ov = *(const LAS u32x4*)(lds + GS_OB + c * GS_OBP + fv * 16);
                float o8[8];
#pragma unroll
                for (int i = 0; i < 4; ++i) { o8[2 * i] = lo16(ov[i]); o8[2 * i + 1] = hi16(ov[i]); }
                float ss = 0.f;
#pragma unroll
                for (int i = 0; i < 8; ++i) ss += o8[i] * o8[i];
                const float rn = rsqrtf(row16_sum(ss) * (1.f / 128.f) + EPS);
                u32x4 res;
#pragma unroll
                for (int i = 0; i < 4; ++i) {
                    const float z0 = lo16(zq[ps][i]), z1 = hi16(zq[ps][i]);
                    res[i] = cvtpk(o8[2 * i] * rn * gn[2 * i] * (z0 * sigmoidf_(z0)), o8[2 * i + 1] * rn * gn[2 * i + 1] * (z1 * sigmoidf_(z1)));
                }
                *(u32x4*)(obuf + (rowc + c) * D + 512 + hh * 128 + 8 * fv) = res;
            }
        }
        __syncthreads();
    }
}

__device__ __forceinline__ unsigned sortable(float f) { const unsigned u = __float_as_uint(f); return u ^ ((unsigned)((int)u >> 31) | 0x80000000u); }
__device__ __forceinline__ float unsortable(unsigned s) { return __uint_as_float((s & 0x80000000u) ? (s ^ 0x80000000u) : ~s); }
#define CE(a, b) do { const unsigned _x = k[a], _y = k[b]; k[a] = _x > _y ? _x : _y; k[b] = _x > _y ? _y : _x; } while (0)
constexpr int PE_TK = 0, PE_TAB = 8192, PE_ID = 8448, PE_GT = PE_ID + 32768;
__device__ void phase_peer(const Params& p, int L, unsigned char* lds_, int bid, int nblk) {
    LAS unsigned char* lds = (LAS unsigned char*)lds_;
    const int tid = tidx(), lane = tid & 63, w = __builtin_amdgcn_readfirstlane(tid >> 6), fr = lane & 15, fq = lane >> 4;
    const bf16* Q2 = (const bf16*)(p.ws + WS_Q2);
    const bf16* SK = (const bf16*)(p.ws + WS_SK) + (size_t)L * 8 * 2 * 128 * 128;
    float* H = (float*)(p.ws + WS_H); bf16* HB2 = (bf16*)(p.ws + WS_HB2);
    const unsigned char* U = p.ws + WS_U + (size_t)L * NEXP * D;
    const unsigned char* V = p.ws + WS_V + (size_t)L * NEXP * D;
    const float* SU = (const float*)(p.ws + WS_SU) + (size_t)L * NEXP; const float* SV = (const float*)(p.ws + WS_SV) + (size_t)L * NEXP;
    const float* g = p.ln_ffn_g + L * D;
    LAS unsigned* TK = (LAS unsigned*)(lds + PE_TK);
    LAS unsigned short* TAB = (LAS unsigned short*)(lds + PE_TAB);
    LAS int* IDL = (LAS int*)(lds + PE_ID); LAS float* GTL = (LAS float*)(lds + PE_GT);
    if (tid < 64) {
        int a = 0, base = 0, q = tid; unsigned short v = 0xffff;
        if (q < 50) { for (;;) { const int cnt = 16 / (a + 1); if (q < base + cnt) break; base += cnt; ++a; } v = (unsigned short)((a << 8) | (q - base)); }
        TAB[tid] = v;
    }
    for (int item = bid; item < M / 64; item += nblk) {
        const int tok0 = item * 64;
        __syncthreads();
        const int tg = w & 3, cc = w >> 2;
        for (int hh = 0; hh < 8; ++hh) {
            {
                f32x4 acc[8];
#pragma unroll
                for (int nt = 0; nt < 8; ++nt) acc[nt] = (f32x4){0.f, 0.f, 0.f, 0.f};
                bf16x8 qa[4];
#pragma unroll
                for (int ks = 0; ks < 4; ++ks) qa[ks] = *(const bf16x8*)(Q2 + (size_t)(tok0 + 16 * tg + fr) * 2048 + hh * 256 + cc * 128 + 32 * ks + 8 * fq);
                const bf16* skb = SK + ((size_t)(hh * 2 + cc) * 128 + fr) * 128 + 8 * fq;
#pragma unroll
                for (int nt = 0; nt < 8; ++nt)
#pragma unroll
                    for (int ks = 0; ks < 4; ++ks) {
                        const bf16x8 kb = *(const bf16x8*)(skb + (size_t)nt * 16 * 128 + 32 * ks);
                        acc[nt] = __builtin_amdgcn_mfma_f32_16x16x32_bf16(qa[ks], kb, acc[nt], 0, 0, 0);
                    }
#pragma unroll
                for (int r = 0; r < 4; ++r) {
                    unsigned k[8];
#pragma unroll
                    for (int nt = 0; nt < 8; ++nt) k[nt] = (sortable(acc[nt][r]) & ~0x7Fu) | (unsigned)(127 - (16 * nt + fr));
                    CE(0, 1); CE(2, 3); CE(4, 5); CE(6, 7); CE(0, 2); CE(1, 3); CE(4, 6); CE(5, 7); CE(1, 2); CE(5, 6); CE(0, 4); CE(3, 7);
                    CE(1, 5); CE(2, 6); CE(1, 4); CE(3, 6); CE(2, 4); CE(3, 5); CE(3, 4);
                    unsigned res = 0u;
#pragma unroll
                    for (int rd = 0; rd < 16; ++rd) {
                        const unsigned m = row16_umax(k[0]);
                        const bool win = k[0] == m;
#pragma unroll
                        for (int i = 0; i < 7; ++i) k[i] = win ? k[i + 1] : k[i];
                        k[7] = win ? 0u : k[7];
                        res = (fr == rd) ? m : res;
                    }
                    TK[(cc * 64 + 16 * tg + 4 * fq + r) * 16 + fr] = res;
                }
            }
            __syncthreads();
#pragma unroll
            for (int ps = 0; ps < 2; ++ps) {
                const int tl = 8 * w + 4 * ps + fq;
                unsigned k[4];
#pragma unroll
                for (int sl = 0; sl < 4; ++sl) {
                    const int q = sl * 16 + fr;
                    const unsigned ab = TAB[q];
                    const unsigned k1 = TK[tl * 16 + ((ab >> 8) & 15)], k2 = TK[(64 + tl) * 16 + (ab & 15)];
                    const float v = unsortable(k1 & ~0x7Fu) + unsortable(k2 & ~0x7Fu);
                    k[sl] = (q < 50) ? ((sortable(v) & ~0x3Fu) | (unsigned)(63 - q)) : 0u;
                }
                CE(0, 1); CE(2, 3); CE(0, 2); CE(1, 3); CE(1, 2);
                unsigned res = 0u;
#pragma unroll
                for (int rd = 0; rd < 16; ++rd) {
                    const unsigned m = row16_umax(k[0]);
                    const bool win = k[0] == m;
                    k[0] = win ? k[1] : k[0]; k[1] = win ? k[2] : k[1]; k[2] = win ? k[3] : k[2]; k[3] = win ? 0u : k[3];
                    res = (fr == rd) ? m : res;
                }
                const unsigned ab = TAB[63 - (res & 0x3Fu)];
                const unsigned k1 = TK[tl * 16 + ((ab >> 8) & 15)], k2 = TK[(64 + tl) * 16 + (ab & 15)];
                const float v = unsortable(k1 & ~0x7Fu) + unsortable(k2 & ~0x7Fu);
                const float e = __expf(v - row16_max(v));
                const float sum = row16_sum(e);
                IDL[tl * 128 + hh * 16 + fr] = (int)((127u - (k1 & 0x7Fu)) * 128u + (127u - (k2 & 0x7Fu)));
                GTL[tl * 128 + hh * 16 + fr] = e / sum;
            }
            __syncthreads();
        }
        for (int ti = 0; ti < 8; ++ti) {
            const int tl = 8 * w + ti, tok = tok0 + tl;
            float* hrow = H + (size_t)tok * D + 16 * lane;
            float xv[16];
#pragma unroll
            for (int j = 0; j < 4; ++j) { const f32x4 a = *(const f32x4*)(hrow + 4 * j); xv[4 * j] = a[0]; xv[4 * j + 1] = a[1]; xv[4 * j + 2] = a[2]; xv[4 * j + 3] = a[3]; }
            float ss = 0.f;
#pragma unroll
            for (int i = 0; i < 16; ++i) ss += xv[i] * xv[i];
            const float rstd = rsqrtf(wave_sum(ss) * (1.f / D) + EPS);
            float xn[16], xs = 0.f;
#pragma unroll
            for (int i = 0; i < 16; ++i) { xn[i] = xv[i] * rstd * g[16 * lane + i]; xs += xn[i]; }
            const float xoff = 128.f * wave_sum(xs);
            const int id0 = IDL[tl * 128 + lane], id1 = IDL[tl * 128 + 64 + lane];
            const float su0 = SU[id0], su1 = SU[id1], sv0 = SV[id0], sv1 = SV[id1];
            float h0 = 0.f, h1 = 0.f;
            u32x4 ring[16];
#pragma unroll
            for (int j = 0; j < 16; ++j) ring[j] = *(const u32x4*)(U + (size_t)IDL[tl * 128 + j] * D + 16 * lane);
#pragma unroll 1
            for (int k = 0; k < 8; ++k) {
#pragma unroll
                for (int j = 0; j < 16; ++j) {
                    const u32x4 a = ring[j];
                    if (k < 7) ring[j] = *(const u32x4*)(U + (size_t)IDL[tl * 128 + 16 * (k + 1) + j] * D + 16 * lane);
                    float d = 0.f;
#pragma unroll
                    for (int q = 0; q < 4; ++q) { d += xn[4 * q] * (float)(a[q] & 0xffu) + xn[4 * q + 1] * (float)((a[q] >> 8) & 0xffu) + xn[4 * q + 2] * (float)((a[q] >> 16) & 0xffu) + xn[4 * q + 3] * (float)(a[q] >> 24); }
                    d = wave_sum(d);
                    const int e = 16 * k + j;
                    if (lane == (e & 63)) { if (k < 4) h0 = d; else h1 = d; }
                }
            }
            h0 = su0 * (h0 - xoff); h1 = su1 * (h1 - xoff);
            const float w0 = sv0 * GTL[tl * 128 + lane] * 0.5f * h0 * (1.f + erff(h0 * 0.70710678118654752f));
            const float w1 = sv1 * GTL[tl * 128 + 64 + lane] * 0.5f * h1 * (1.f + erff(h1 * 0.70710678118654752f));
            const float woff = 128.f * wave_sum(w0 + w1);
            float y[16];
#pragma unroll
            for (int i = 0; i < 16; ++i) y[i] = 0.f;
#pragma unroll
            for (int j = 0; j < 16; ++j) ring[j] = *(const u32x4*)(V + (size_t)IDL[tl * 128 + j] * D + 16 * lane);
#pragma unroll 1
            for (int k = 0; k < 8; ++k) {
#pragma unroll
                for (int j = 0; j < 16; ++j) {
                    const u32x4 a = ring[j];
                    if (k < 7) ring[j] = *(const u32x4*)(V + (size_t)IDL[tl * 128 + 16 * (k + 1) + j] * D + 16 * lane);
                    const int e = 16 * k + j;
                    const float ww = __uint_as_float((unsigned)__builtin_amdgcn_readlane((int)__float_as_uint(k < 4 ? w0 : w1), e & 63));
#pragma unroll
                    for (int q = 0; q < 4; ++q) { y[4 * q] += ww * (float)(a[q] & 0xffu); y[4 * q + 1] += ww * (float)((a[q] >> 8) & 0xffu); y[4 * q + 2] += ww * (float)((a[q] >> 16) & 0xffu); y[4 * q + 3] += ww * (float)(a[q] >> 24); }
                }
            }
#pragma unroll
            for (int i = 0; i < 16; ++i) y[i] += xv[i] - woff;
#pragma unroll
            for (int j = 0; j < 4; ++j) *(f32x4*)(hrow + 4 * j) = (f32x4){y[4 * j], y[4 * j + 1], y[4 * j + 2], y[4 * j + 3]};
            bf16* hb = HB2 + (size_t)tok * D + 16 * lane;
            u32x4 o; o.x = pk2(y[0], y[1]); o.y = pk2(y[2], y[3]); o.z = pk2(y[4], y[5]); o.w = pk2(y[6], y[7]);
            *(u32x4*)hb = o;
            o.x = pk2(y[8], y[9]); o.y = pk2(y[10], y[11]); o.z = pk2(y[12], y[13]); o.w = pk2(y[14], y[15]);
            *(u32x4*)(hb + 8) = o;
        }
    }
    __syncthreads();
}
#undef CE

__device__ void phase_final(const Params& p, int bid, int nblk) {
    const int tid = tidx(), lane = tid & 63, gw = bid * NWAVES + (tid >> 6), NGW = nblk * NWAVES;
    const float* H = (const float*)(p.ws + WS_H);
    for (int m = gw; m < M; m += NGW) {
        f32x4 v[4]; float ss = 0.f;
#pragma unroll
        for (int j = 0; j < 4; ++j) { v[j] = ((const f32x4*)(H + (size_t)m * D))[lane + 64 * j]; ss += (v[j][0] * v[j][0] + v[j][1] * v[j][1]) + (v[j][2] * v[j][2] + v[j][3] * v[j][3]); }
        const float r = rsqrtf(wave_sum(ss) * (1.f / D) + EPS);
#pragma unroll
        for (int j = 0; j < 4; ++j) { const f32x4 gv = ((const f32x4*)p.final_g)[lane + 64 * j]; ((f32x4*)(p.out + (size_t)m * D))[lane + 64 * j] = v[j] * r * gv; }
    }
}

#define XB_TMO      128
#define XB_XCNT(j)  (256  + 64 * (j))
#define XB_XSUB(j)  (1280 + 64 * (j))
#define XB_XGEN(j)  (2304 + 64 * (j))
#define XB_TOP      3328
#define XB_TOPGEN   3392
#define XCD_BAR_WORDS 3456
#define XB_SPIN_CAP (1u << 22)
__device__ __forceinline__ unsigned xb_ld(unsigned* p)              { return __hip_atomic_load(p, __ATOMIC_RELAXED, __HIP_MEMORY_SCOPE_AGENT); }
__device__ __forceinline__ unsigned xb_add(unsigned* p, unsigned v) { return __hip_atomic_fetch_add(p, v, __ATOMIC_RELAXED, __HIP_MEMORY_SCOPE_AGENT); }
__device__ __forceinline__ unsigned xb_xcc_id() { return (unsigned)__builtin_amdgcn_s_getreg((3 << 11) | 20) & 0xFu; }
#define XB_SPIN(cond, bar) do { unsigned _sp = 0; while (cond) { __builtin_amdgcn_s_sleep(1); \
    if ((++_sp & 255u) == 0u) { if (xb_ld(&(bar)[XB_TMO])) break; if (_sp > XB_SPIN_CAP) { atomicAdd(&(bar)[XB_TMO], 1u); break; } } } } while (0)
struct XcdBarrier { unsigned* bar; unsigned x; volatile LAS unsigned* st; };
__device__ __forceinline__ XcdBarrier xcd_barrier_post(unsigned* bar, volatile LAS unsigned* st) {
    XcdBarrier b; b.bar = bar; b.x = xb_xcc_id(); b.st = st;
    if (threadIdx.x == 0) (void)xb_add(&bar[XB_XCNT(b.x)], 1u);
    return b;
}
__device__ __forceinline__ void xcd_barrier_complete(unsigned* bar, unsigned x, unsigned& nloc, unsigned& nx) {
    const unsigned G = gridDim.x * gridDim.y * gridDim.z;
    unsigned sum, cnt, mine, sp = 0u;
    for (;;) {
        sum = 0u; cnt = 0u; mine = 0u;
#pragma unroll
        for (unsigned j = 0; j < 16; ++j) { const unsigned c = xb_ld(&bar[XB_XCNT(j)]); sum += c; cnt += (c > 0u) ? 1u : 0u; mine = (j == x) ? c : mine; }
        if (sum == G) break;
        __builtin_amdgcn_s_sleep(1);
        if ((++sp & 255u) == 0u) { if (xb_ld(&bar[XB_TMO])) break; if (sp > XB_SPIN_CAP) { atomicAdd(&bar[XB_TMO], 1u); break; } }
    }
    nloc = mine > 0u ? mine : 1u; nx = cnt > 0u ? cnt : 1u;
}
__device__ __forceinline__ void xcd_barrier(const XcdBarrier& b) {
    asm volatile("s_waitcnt vmcnt(0)" ::: "memory");
    __syncthreads();
    if (threadIdx.x == 0) {
        unsigned* bar = b.bar;
        __builtin_amdgcn_s_waitcnt(0);
        unsigned nloc = b.st[0], nx = b.st[1];
        if (nloc == 0u) { xcd_barrier_complete(bar, b.x, nloc, nx); b.st[0] = nloc; b.st[1] = nx; }
        const unsigned old = xb_add(&bar[XB_XSUB(b.x)], 1u);
        const unsigned gen = old / nloc;
        if (old + 1u == (gen + 1u) * nloc) {
            __builtin_amdgcn_fence(__ATOMIC_RELEASE, "agent");
            asm volatile("s_waitcnt vmcnt(0)" ::: "memory");
            const unsigned og = xb_add(&bar[XB_TOP], 1u);
            const unsigned tg = og / nx;
            if (og + 1u == (tg + 1u) * nx) xb_add(&bar[XB_TOPGEN], 1u);
            else XB_SPIN(xb_ld(&bar[XB_TOPGEN]) == tg, bar);
            __builtin_amdgcn_fence(__ATOMIC_ACQUIRE, "agent");
            xb_add(&bar[XB_XGEN(b.x)], 1u);
            asm volatile("s_waitcnt vmcnt(0)" ::: "memory");
        } else {
            XB_SPIN(xb_ld(&bar[XB_XGEN(b.x)]) == gen, bar);
            __builtin_amdgcn_fence(__ATOMIC_ACQUIRE, "agent");
            asm volatile("s_waitcnt vmcnt(0)" ::: "memory");
        }
    }
    __syncthreads();
}
constexpr int CW_BAR = 4096;

constexpr int K_PROLOGUE = 11, K_FINAL = 12;
template <int KIND>
__device__ __forceinline__ void run_kind(const Params& p, int L, unsigned char* lds, int bid, int nblk) {
    unsigned char* ws = p.ws;
    float* H = (float*)(ws + WS_H);
    float* ss0 = (float*)(ws + WS_STAT); float* ss1 = (float*)(ws + WS_SS1); float* sse = (float*)(ws + WS_SSE);
    if constexpr (KIND == K_PROLOGUE) phase_prologue(p, lds, bid, nblk);
    if constexpr (KIND == K_FINAL) phase_final(p, bid, nblk);
    if constexpr (KIND == 0) { EpiProj E{nullptr, (bf16*)(ws + WS_PROJ), (float*)(ws + WS_BA)};
        gemm_run(lds, (const bf16*)(ws + WS_HB0), (const bf16*)(ws + WS_WIN) + (size_t)L * IN_PAD * D, M, IN_PAD, D, E, bid, nblk, ss0); }
    if constexpr (KIND == 1) phase_gdn_prep(p, L, lds, bid, nblk);
    if constexpr (KIND == 2) { phase_gdn_scan(p, L, lds, bid, nblk); phase_att_queue(p, L, lds, bid, nblk); }
    if constexpr (KIND == 3) { EpiRes E{ss1, H, (bf16*)(ws + WS_HB1)};
        gemm_run(lds, (const bf16*)(ws + WS_OBUF), (const bf16*)(ws + WS_WOUT) + (size_t)L * D * D, M, D, D, E, bid, nblk); }
    if constexpr (KIND == 4) { EpiQ2 E{nullptr, (bf16*)(ws + WS_Q2)};
        gemm_run(lds, (const bf16*)(ws + WS_HB1), (const bf16*)(ws + WS_WQ) + (size_t)L * 2048 * D, M, 2048, D, E, bid, nblk, ss1);
        EpiE E2{sse, (bf16*)(ws + WS_EPRE)};
        gemm_run(lds, (const bf16*)(ws + WS_PB) + (size_t)L * M * 256, (const bf16*)(ws + WS_WP) + (size_t)L * D * 256, M, D, 256, E2, bid, nblk); }
    if constexpr (KIND == 5) phase_peer(p, L, lds, bid, nblk);
    if constexpr (KIND == 6) { EpiPle E{ss0, H, (bf16*)(ws + WS_HB0), (const bf16*)(ws + WS_EPRE), p.ple_norm_g + L * D};
        gemm_run(lds, (const bf16*)(ws + WS_HB2), (const bf16*)(ws + WS_WG) + (size_t)L * D * D, M, D, D, E, bid, nblk, sse); }
}

__device__ __forceinline__ Params params_off(const Params& s, size_t z) {
    Params q;
    q.x = s.x + z; q.p = s.p + z; q.ln_mix_g = s.ln_mix_g + z; q.w_in = s.w_in + z; q.conv_w = s.conv_w + z; q.a_log = s.a_log + z; q.dt_bias = s.dt_bias + z;
    q.gdn_norm_g = s.gdn_norm_g + z; q.diff_lambda = s.diff_lambda + z; q.subln_g = s.subln_g + z; q.w_out = s.w_out + z; q.ln_ffn_g = s.ln_ffn_g + z;
    q.peer_wq = s.peer_wq + z; q.subkeys = s.subkeys + z; q.peer_u = s.peer_u + z; q.peer_v = s.peer_v + z; q.ple_wp = s.ple_wp + z; q.ple_wg = s.ple_wg + z;
    q.ple_norm_g = s.ple_norm_g + z; q.final_g = s.final_g + z; q.out = s.out + z; q.ws = s.ws + z; q.pad0 = 0; q.pad1 = 0;
    return q;
}
#define RUN(KIND) do { size_t z_ = 0; int L_ = L; asm volatile("" : "+s"(z_), "+s"(L_)); const Params q_ = params_off(p, z_); run_kind<KIND>(q_, L_, lds, bid, nblk); } while (0)
__global__ void __launch_bounds__(NTHREADS, 2) mk_fwd(Params p) {
    extern __shared__ __attribute__((aligned(16))) unsigned char lds[];
    const int bid = (int)blockIdx.x, nblk = (int)gridDim.x;
    volatile LAS unsigned* misc = (volatile LAS unsigned*)((LAS unsigned char*)lds + LDS_MISC_OFF);
    if (threadIdx.x < 64) misc[threadIdx.x] = 0u;
    __syncthreads();
    XcdBarrier bar = xcd_barrier_post((unsigned*)(p.ws + WS_CTL) + CW_BAR, misc + 8);
    { int L = 0; RUN(K_PROLOGUE); }
    cg::this_grid().sync();
#pragma nounroll
    for (int L = 0; L < DEPTH; ++L) {
        RUN(0); xcd_barrier(bar);
        RUN(1); xcd_barrier(bar);
        RUN(2); xcd_barrier(bar);
        RUN(3); xcd_barrier(bar);
        RUN(4); xcd_barrier(bar);
        RUN(5); xcd_barrier(bar);
        RUN(6); xcd_barrier(bar);
    }
    { int L = 0; RUN(K_FINAL); }
}

extern "C" void kernel_launch(void* const* d_in, const int* in_sizes, int n_in, void* d_out, int out_size, void* d_ws, size_t ws_size, hipStream_t stream) {
    static int grid = 0;
    if (grid == 0) {
        if (n_in != 20 || out_size != M * D || ws_size < WS_END) { fprintf(stderr, "kernel_launch: unexpected shapes (n_in %d, out %d, ws %zu < %zu)\n", n_in, out_size, ws_size, (size_t)WS_END); grid = -1; return; }
        int dev = 0, cus = 0, per_cu = 0;
        (void)hipGetDevice(&dev); (void)hipDeviceGetAttribute(&cus, hipDeviceAttributeMultiprocessorCount, dev);
        if (hipFuncSetAttribute((const void*)mk_fwd, hipFuncAttributeMaxDynamicSharedMemorySize, LDS_BYTES) != hipSuccess) { fprintf(stderr, "kernel_launch: hipFuncSetAttribute failed\n"); grid = -1; return; }
        if (hipOccupancyMaxActiveBlocksPerMultiprocessor(&per_cu, (const void*)mk_fwd, NTHREADS, LDS_BYTES) != hipSuccess || per_cu < 1) { fprintf(stderr, "kernel_launch: occupancy query says %d blocks per CU\n", per_cu); (void)hipGetLastError(); grid = -1; return; }
        grid = (cus > 0 ? cus : 256);
    }
    if (grid < 0) return;
    (void)hipMemsetAsync((char*)d_ws + WS_CTL, 0, CTL_ZERO_BYTES, stream);
    Params p{};
    const float** pp = (const float**)&p;
    for (int i = 0; i < 20; ++i) pp[i] = (const float*)d_in[i];
    p.out = (float*)d_out; p.ws = (unsigned char*)d_ws;
    void* args[] = {&p};
    hipError_t e = hipLaunchCooperativeKernel((const void*)mk_fwd, dim3(grid), dim3(NTHREADS), args, LDS_BYTES, stream);
    if (e != hipSuccess) fprintf(stderr, "kernel_launch: cooperative launch failed: %s (grid %d)\n", hipGetErrorString(e), grid);
}
```

```cpp
#include <hip/hip_runtime.h>
#include <hip/hip_cooperative_groups.h>
#include <cstdio>
#include <cstdint>
namespace cg = cooperative_groups;

typedef unsigned short bf16;
typedef float f32x4 __attribute__((ext_vector_type(4)));
typedef short bf16x8 __attribute__((ext_vector_type(8)));
typedef unsigned u32x4 __attribute__((ext_vector_type(4)));
typedef unsigned u32x2 __attribute__((ext_vector_type(2)));

constexpr int D = 1024, BATCH = 8, SEQ = 2048, DEPTH = 4, M = BATCH * SEQ;
constexpr int IN_COLS = 3592, IN_PAD = 3840, PROJ_W = 3584;
constexpr int NEXP = 16384;
constexpr float EPS = 1e-6f;
constexpr float QSCALE = 0.125f * 1.4426950408889634f;
constexpr int NWAVES = 8, NTHREADS = 512;
constexpr int LDS_BYTES = 163840;
constexpr int LDS_MISC_OFF = LDS_BYTES - 256;
constexpr int RS_OFF = 147456;
constexpr int CW_QUEUE = 1024;

constexpr size_t MiB = 1u << 20;
constexpr size_t WS_CTL = 0, CTL_ZERO_BYTES = 1 * MiB;
constexpr size_t WS_H = 1 * MiB;
constexpr size_t WS_HB0 = 65 * MiB;
constexpr size_t WS_HB1 = 97 * MiB;
constexpr size_t WS_HB2 = 129 * MiB;
constexpr size_t WS_PROJ = 161 * MiB;
constexpr size_t WS_BA = 273 * MiB;
constexpr size_t WS_OBUF = 274 * MiB;
constexpr size_t WS_Q2 = 306 * MiB;
constexpr size_t WS_EPRE = 370 * MiB;
constexpr size_t WS_IDX = 402 * MiB;
constexpr size_t WS_GATE = 410 * MiB;
constexpr size_t WS_STAT = 418 * MiB;
constexpr size_t WS_SS1 = WS_IDX + 1 * MiB, WS_SSE = WS_IDX;
constexpr size_t WS_ORAW = 422 * MiB;
constexpr size_t WS_WIN = 550 * MiB;
constexpr size_t WS_WOUT = 582 * MiB;
constexpr size_t WS_WQ = 590 * MiB;
constexpr size_t WS_WG = 606 * MiB;
constexpr size_t WS_WP = 614 * MiB;
constexpr size_t WS_SK = 616 * MiB;
constexpr size_t WS_PB = 618 * MiB;
constexpr size_t WS_U = 650 * MiB;
constexpr size_t WS_V = 778 * MiB;
constexpr size_t WS_SU = WS_STAT + 1 * MiB, WS_SV = WS_STAT + 2 * MiB;
constexpr size_t WS_END = 906 * MiB;

struct Params {
    const float *x, *p, *ln_mix_g, *w_in, *conv_w, *a_log, *dt_bias, *gdn_norm_g, *diff_lambda, *subln_g, *w_out, *ln_ffn_g,
        *peer_wq, *subkeys, *peer_u, *peer_v, *ple_wp, *ple_wg, *ple_norm_g, *final_g;
    float* out;
    unsigned char* ws;
    int pad0, pad1;
};

__device__ __forceinline__ int tidx() { int t = (int)threadIdx.x; asm volatile("" : "+v"(t)); return t; }
#define LDS_BARRIER() asm volatile("s_waitcnt lgkmcnt(0)\n\ts_barrier" ::: "memory")
__device__ __forceinline__ float bf2f(bf16 v) { return __uint_as_float((unsigned)v << 16); }
__device__ __forceinline__ unsigned f2bf(float f) { unsigned u = __float_as_uint(f); return (u + 0x7fffu + ((u >> 16) & 1u)) >> 16; }
__device__ __forceinline__ unsigned pk2(float lo, float hi) { return f2bf(lo) | (f2bf(hi) << 16); }
__device__ __forceinline__ float lo16(unsigned w) { return __uint_as_float(w << 16); }
__device__ __forceinline__ float hi16(unsigned w) { return __uint_as_float(w & 0xffff0000u); }
template <int N> __device__ __forceinline__ float dpp_ror(float x) { return __builtin_bit_cast(float, __builtin_amdgcn_mov_dpp(__builtin_bit_cast(int, x), 0x120 + N, 0xf, 0xf, true)); }
template <int N> __device__ __forceinline__ unsigned dpp_ror_u(unsigned x) { return (unsigned)__builtin_amdgcn_mov_dpp((int)x, 0x120 + N, 0xf, 0xf, true); }
__device__ __forceinline__ float row16_sum(float x) { x += dpp_ror<8>(x); x += dpp_ror<4>(x); x += dpp_ror<2>(x); x += dpp_ror<1>(x); return x; }
__device__ __forceinline__ float row16_max(float x) { x = fmaxf(x, dpp_ror<8>(x)); x = fmaxf(x, dpp_ror<4>(x)); x = fmaxf(x, dpp_ror<2>(x)); x = fmaxf(x, dpp_ror<1>(x)); return x; }
__device__ __forceinline__ unsigned row16_umax(unsigned x) { unsigned y;
    y = dpp_ror_u<8>(x); x = x > y ? x : y; y = dpp_ror_u<4>(x); x = x > y ? x : y; y = dpp_ror_u<2>(x); x = x > y ? x : y; y = dpp_ror_u<1>(x); x = x > y ? x : y; return x; }
__device__ __forceinline__ float xrow16_max(float x) {
    auto s = __builtin_amdgcn_permlane16_swap(__float_as_uint(x), __float_as_uint(x), false, false);
    x = fmaxf(__uint_as_float(s[0]), __uint_as_float(s[1]));
    auto t = __builtin_amdgcn_permlane32_swap(__float_as_uint(x), __float_as_uint(x), false, false);
    return fmaxf(__uint_as_float(t[0]), __uint_as_float(t[1]));
}
__device__ __forceinline__ float xrow16_sum(float x) {
    auto s = __builtin_amdgcn_permlane16_swap(__float_as_uint(x), __float_as_uint(x), false, false);
    x = __uint_as_float(s[0]) + __uint_as_float(s[1]);
    auto t = __builtin_amdgcn_permlane32_swap(__float_as_uint(x), __float_as_uint(x), false, false);
    return __uint_as_float(t[0]) + __uint_as_float(t[1]);
}
__device__ __forceinline__ float wave_sum(float v) { return xrow16_sum(row16_sum(v)); }
template <int N> __device__ __forceinline__ int dpp_ror_i(int x) { return __builtin_amdgcn_mov_dpp(x, 0x120 + N, 0xf, 0xf, true); }
__device__ __forceinline__ int wave_isum(int x) {
    x += dpp_ror_i<8>(x); x += dpp_ror_i<4>(x); x += dpp_ror_i<2>(x); x += dpp_ror_i<1>(x);
    auto s = __builtin_amdgcn_permlane16_swap((unsigned)x, (unsigned)x, false, false); x = (int)(s[0] + s[1]);
    auto t = __builtin_amdgcn_permlane32_swap((unsigned)x, (unsigned)x, false, false); return (int)(t[0] + t[1]);
}
__device__ __forceinline__ float wave_max(float v) {
#pragma unroll
    for (int o = 32; o; o >>= 1) v = fmaxf(v, __shfl_xor(v, o));
    return v;
}
__device__ __forceinline__ float sigmoidf_(float x) { return 1.f / (1.f + __expf(-x)); }
__device__ __forceinline__ float dot8(u32x4 a, u32x4 b, float s) {
#pragma unroll
    for (int i = 0; i < 4; ++i) { s += lo16(a[i]) * lo16(b[i]); s += hi16(a[i]) * hi16(b[i]); }
    return s;
}

#define LAS __attribute__((address_space(3)))
__host__ __device__ __forceinline__ int lds_byte(int r, int c) { const int st = (r >> 4) * 2 + (c >> 5), rr = r & 15, cc = c & 31, ob = rr * 64 + cc * 2; return st * 1024 + (ob ^ (((ob >> 9) & 1) << 5)); }
__host__ __device__ __forceinline__ void stage_rc(int b, int& R, int& C) { const int st = b / 1024, sb = b % 1024, swz = sb ^ (((sb >> 9) & 1) << 5); R = (st >> 1) * 16 + swz / 64; C = (st & 1) * 32 + (swz % 64) / 2; }
constexpr int HTB = 16384;
template <class F>
__device__ __forceinline__ void gemm_run(unsigned char* lds_, const bf16* A, const bf16* Bt, int Mm, int N, int K, const F& f, int bid, int nblk, const float* slots_in = nullptr) {
    LAS unsigned char* lds = (LAS unsigned char*)lds_;
    LAS float* RS = (LAS float*)(lds + RS_OFF);
    if (slots_in) {
        const int t = tidx();
        if (t < 256) { const f32x4* sp = (const f32x4*)(slots_in + ((size_t)(bid % (Mm / 256)) * 256 + t) * 16);
            const f32x4 a = sp[0], b = sp[1], c = sp[2], d = sp[3];
            const float s = (((a[0] + a[1]) + (a[2] + a[3])) + ((b[0] + b[1]) + (b[2] + b[3]))) + (((c[0] + c[1]) + (c[2] + c[3])) + ((d[0] + d[1]) + (d[2] + d[3])));
            RS[t] = rsqrtf(s * (1.f / D) + EPS); }
        __syncthreads();
    }
    const int tid = tidx(), wid = __builtin_amdgcn_readfirstlane(tid >> 6), lane = tid & 63, wr = wid >> 2, wc = wid & 3, fr = lane & 15, fq = lane >> 4;
    const int nt = K / 64, ntn = N / 256, nunits = (Mm / 256) * ntn;
    unsigned voff[2];
#pragma unroll
    for (int i = 0; i < 2; ++i) { int R, C; stage_rc(tid * 16 + i * 8192, R, C); voff[i] = (unsigned)(R * K + C) * 2u; }
    const unsigned ldsw = (unsigned)wid * 1024u;
    const int aoff = wr * HTB + lds_byte(fr, fq * 8), boff = (2 + (wc >> 1)) * HTB + lds_byte((wc & 1) * 64 + fr, fq * 8);
#define G_STAGE(bufoff, gbase) do { _Pragma("unroll") for (int _i = 0; _i < 2; ++_i) \
        __builtin_amdgcn_global_load_lds((const unsigned*)((const char*)(gbase) + voff[_i]), (LAS unsigned*)(lds + (bufoff) + ldsw + _i * 8192), 16, 0, 0); } while (0)
    for (int u = bid; u < nunits; u += nblk) {
        const int pm = u % (Mm / 256), pn = u / (Mm / 256);
        const char* gA = (const char*)(A + (size_t)pm * 256 * K);
        const char* gB = (const char*)(Bt + (size_t)pn * 256 * K);
        const size_t hstep = (size_t)128 * K * 2;
        f32x4 acc[8][4];
#pragma unroll
        for (int a = 0; a < 8; ++a)
#pragma unroll
            for (int b = 0; b < 4; ++b) acc[a][b] = (f32x4){0.f, 0.f, 0.f, 0.f};
        G_STAGE(0, gA); G_STAGE(HTB, gA + hstep); G_STAGE(2 * HTB, gB); G_STAGE(3 * HTB, gB + hstep);
        for (int t = 0; t < nt; ++t) {
            const int cb = (t & 1) * 4 * HTB, nb = ((t + 1) & 1) * 4 * HTB;
            asm volatile("s_waitcnt vmcnt(0)" ::: "memory");
            __builtin_amdgcn_s_barrier();
            asm volatile("" ::: "memory");
            const size_t ko = (size_t)(t + 1) * 128; const bool more = t + 1 < nt;
#pragma unroll
            for (int k = 0; k < 2; ++k) {
                if (more) { if (k == 0) { G_STAGE(nb, gA + ko); G_STAGE(nb + 2 * HTB, gB + ko); } else { G_STAGE(nb + HTB, gA + hstep + ko); G_STAGE(nb + 3 * HTB, gB + hstep + ko); } }
                bf16x8 bfr[4], acur, anxt;
#pragma unroll
                for (int n = 0; n < 4; ++n) bfr[n] = *(const LAS bf16x8*)(lds + cb + boff + n * 2048 + k * 1024);
                acur = *(const LAS bf16x8*)(lds + cb + aoff + k * 1024);
#pragma unroll
                for (int m = 0; m < 8; ++m) {
                    if (m < 7) anxt = *(const LAS bf16x8*)(lds + cb + aoff + (m + 1) * 2048 + k * 1024);
#pragma unroll
                    for (int n = 0; n < 4; ++n) acc[m][n] = __builtin_amdgcn_mfma_f32_16x16x32_bf16(bfr[n], acur, acc[m][n], 0, 0, 0);
                    acur = anxt;
                }
                __builtin_amdgcn_sched_barrier(0);
            }
            asm volatile("s_waitcnt lgkmcnt(0)" ::: "memory");
        }
#pragma unroll
        for (int m = 0; m < 8; ++m) {
            const int lrow = wr * 128 + m * 16 + fr, row = pm * 256 + lrow;
            float ssq = 0.f;
#pragma unroll
            for (int n = 0; n < 4; ++n) { const f32x4 r = f(row, RS[lrow], pn * 256 + wc * 64 + n * 16 + 4 * fq, acc[m][n]); ssq += (r[0] * r[0] + r[1] * r[1]) + (r[2] * r[2] + r[3] * r[3]); }
            if constexpr (F::STATS) { ssq = xrow16_sum(ssq); if (fq == 0) f.slots[(size_t)row * 16 + pn * 4 + wc] = ssq; }
        }
        __syncthreads();
    }
#undef G_STAGE
}

__device__ __forceinline__ u32x2 pk4(f32x4 a) { u32x2 o; o.x = pk2(a[0], a[1]); o.y = pk2(a[2], a[3]); return o; }
struct EpiProj {
    static constexpr bool STATS = false; float* slots;
    bf16* proj; float* ba;
    __device__ __forceinline__ f32x4 operator()(int row, float rstd, int col, f32x4 v) const {
        v = v * rstd;
        if (col < PROJ_W) *(u32x2*)(proj + (size_t)row * PROJ_W + col) = pk4(v);
        else if (col < IN_COLS) *(f32x4*)(ba + (size_t)row * 8 + (col - PROJ_W)) = v;
        return v;
    }
};
struct EpiRes {
    static constexpr bool STATS = true; float* slots;
    float* H; bf16* HB;
    __device__ __forceinline__ f32x4 operator()(int row, float, int col, f32x4 v) const {
        f32x4* hp = (f32x4*)(H + (size_t)row * D + col);
        const f32x4 h = *hp + v; *hp = h;
        *(u32x2*)(HB + (size_t)row * D + col) = pk4(h);
        return h;
    }
};
struct EpiQ2 {
    static constexpr bool STATS = false; float* slots;
    bf16* Q2;
    __device__ __forceinline__ f32x4 operator()(int row, float rstd, int col, f32x4 v) const { v = v * rstd; *(u32x2*)(Q2 + (size_t)row * 2048 + col) = pk4(v); return v; }
};
struct EpiE {
    static constexpr bool STATS = true; float* slots;
    bf16* E;
    __device__ __forceinline__ f32x4 operator()(int row, float, int col, f32x4 v) const { *(u32x2*)(E + (size_t)row * D + col) = pk4(v); return v; }
};
struct EpiPle {
    static constexpr bool STATS = true; float* slots;
    float* H; bf16* HB; const bf16* E; const float* g;
    __device__ __forceinline__ f32x4 operator()(int row, float rstde, int col, f32x4 v) const {
        f32x4* hp = (f32x4*)(H + (size_t)row * D + col);
        const u32x2 ev = *(const u32x2*)(E + (size_t)row * D + col);
        const f32x4 gv = *(const f32x4*)(g + col);
        f32x4 h = *hp;
        h[0] += sigmoidf_(v[0]) * (lo16(ev.x) * rstde * gv[0]); h[1] += sigmoidf_(v[1]) * (hi16(ev.x) * rstde * gv[1]);
        h[2] += sigmoidf_(v[2]) * (lo16(ev.y) * rstde * gv[2]); h[3] += sigmoidf_(v[3]) * (hi16(ev.y) * rstde * gv[3]);
        *hp = h;
        *(u32x2*)(HB + (size_t)row * D + col) = pk4(h);
        return h;
    }
};

__device__ __forceinline__ void transpose_item(const float* W, int K, int N, int Npad, bf16* WT, const float* rowscale, int qcols, float* scr, int item, int lane) {
    const int nblk = Npad / 32, kb = item / nblk, nb = item % nblk, k0 = 64 * kb, n0 = 32 * nb;
    const int n = n0 + (lane & 31);
#pragma unroll 8
    for (int i = 0; i < 32; ++i) {
        const int kk = 2 * i + (lane >> 5);
        float v = (n < N) ? W[(size_t)(k0 + kk) * N + n] : 0.f;
        if (rowscale) v *= rowscale[k0 + kk];
        if (n < qcols) v *= QSCALE;
        scr[kk * 33 + (lane & 31)] = v;
    }
    asm volatile("s_waitcnt lgkmcnt(0)" ::: "memory");
    const int c = lane & 7;
#pragma unroll
    for (int j = 0; j < 4; ++j) {
        const int nn = (lane >> 3) + 8 * j; const float* s = scr + (8 * c) * 33 + nn;
        u32x4 o; o.x = pk2(s[0 * 33], s[1 * 33]); o.y = pk2(s[2 * 33], s[3 * 33]); o.z = pk2(s[4 * 33], s[5 * 33]); o.w = pk2(s[6 * 33], s[7 * 33]);
        *(u32x4*)(WT + (size_t)(n0 + nn) * K + k0 + 8 * c) = o;
    }
    asm volatile("s_waitcnt lgkmcnt(0)" ::: "memory");
}
__device__ __forceinline__ void convert_bulk(const float* src, bf16* dst, size_t n, size_t gtid, size_t nthr) {
    for (size_t i = gtid * 8; i < n; i += nthr * 8) {
        const f32x4 a = *(const f32x4*)(src + i), b = *(const f32x4*)(src + i + 4);
        u32x4 o; o.x = pk2(a[0], a[1]); o.y = pk2(a[2], a[3]); o.z = pk2(b[0], b[1]); o.w = pk2(b[2], b[3]);
        *(u32x4*)(dst + i) = o;
    }
}
__device__ void phase_prologue(const Params& p, unsigned char* lds, int bid, int nblk) {
    const int tid = tidx(), lane = tid & 63, w = tid >> 6;
    const int gw = bid * NWAVES + w, NGW = nblk * NWAVES;
    float* scr = (float*)(lds + w * 16384);
    constexpr int I_IN = 16 * (IN_PAD / 32), I_OUT = 16 * 32, I_Q = 16 * 64, I_G = 16 * 32, I_P = 4 * 32, I_L = I_IN + I_OUT + I_Q + I_G + I_P;
    for (int it = gw; it < DEPTH * I_L; it += NGW) {
        const int L = it / I_L; int r = it % I_L;
        if (r < I_IN) { transpose_item(p.w_in + (size_t)L * D * IN_COLS, D, IN_COLS, IN_PAD, (bf16*)(p.ws + WS_WIN) + (size_t)L * IN_PAD * D, p.ln_mix_g + L * D, 512, scr, r, lane); continue; } r -= I_IN;
        if (r < I_OUT) { transpose_item(p.w_out + (size_t)L * D * D, D, D, D, (bf16*)(p.ws + WS_WOUT) + (size_t)L * D * D, nullptr, 0, scr, r, lane); continue; } r -= I_OUT;
        if (r < I_Q) { transpose_item(p.peer_wq + (size_t)L * D * 2048, D, 2048, 2048, (bf16*)(p.ws + WS_WQ) + (size_t)L * 2048 * D, p.ln_ffn_g + L * D, 0, scr, r, lane); continue; } r -= I_Q;
        if (r < I_G) { transpose_item(p.ple_wg + (size_t)L * D * D, D, D, D, (bf16*)(p.ws + WS_WG) + (size_t)L * D * D, nullptr, 0, scr, r, lane); continue; } r -= I_G;
        transpose_item(p.ple_wp + (size_t)L * 256 * D, 256, D, D, (bf16*)(p.ws + WS_WP) + (size_t)L * D * 256, nullptr, 0, scr, r, lane);
    }
    const size_t gtid = (size_t)bid * NTHREADS + tid, nthr = (size_t)nblk * NTHREADS;
    for (int r = gw; r < 2 * DEPTH * NEXP; r += NGW) {
        const int which = r >= DEPTH * NEXP, rr = which ? r - DEPTH * NEXP : r;
        const float* srow = (which ? p.peer_v : p.peer_u) + (size_t)rr * D + 16 * lane;
        f32x4 v[4];
#pragma unroll
        for (int j = 0; j < 4; ++j) v[j] = *(const f32x4*)(srow + 4 * j);
        float mx = 0.f;
#pragma unroll
        for (int j = 0; j < 4; ++j) mx = fmaxf(mx, fmaxf(fmaxf(fabsf(v[j][0]), fabsf(v[j][1])), fmaxf(fabsf(v[j][2]), fabsf(v[j][3]))));
        mx = xrow16_max(row16_max(mx));
        const float inv = mx > 0.f ? 127.f / mx : 0.f;
        u32x4 o;
#pragma unroll
        for (int j = 0; j < 4; ++j) {
            const unsigned b0 = (unsigned)__float2int_rn(v[j][0] * inv) & 0xffu, b1 = (unsigned)__float2int_rn(v[j][1] * inv) & 0xffu, b2 = (unsigned)__float2int_rn(v[j][2] * inv) & 0xffu, b3 = (unsigned)__float2int_rn(v[j][3] * inv) & 0xffu;
            o[j] = b0 | (b1 << 8) | (b2 << 16) | (b3 << 24);
        }
        *(u32x4*)(p.ws + (which ? WS_V : WS_U) + (size_t)rr * D + 16 * lane) = o;
        if (lane == 0) ((float*)(p.ws + (which ? WS_SV : WS_SU)))[rr] = mx * (1.f / 127.f);
    }
    convert_bulk(p.p, (bf16*)(p.ws + WS_PB), (size_t)DEPTH * M * 256, gtid, nthr);
    convert_bulk(p.subkeys, (bf16*)(p.ws + WS_SK), (size_t)DEPTH * 8 * 2 * 128 * 128, gtid, nthr);
    float* H = (float*)(p.ws + WS_H); bf16* HB0 = (bf16*)(p.ws + WS_HB0); float* ss0 = (float*)(p.ws + WS_STAT);
    for (int m = gw; m < M; m += NGW) {
        const f32x4* xr = (const f32x4*)(p.x + (size_t)m * D) + lane;
        float ss = 0.f;
#pragma unroll
        for (int j = 0; j < 4; ++j) {
            const f32x4 v = xr[64 * j];
            ss += v[0] * v[0] + v[1] * v[1] + v[2] * v[2] + v[3] * v[3];
            ((f32x4*)(H + (size_t)m * D))[lane + 64 * j] = v;
            u32x2 o; o.x = pk2(v[0], v[1]); o.y = pk2(v[2], v[3]);
            ((u32x2*)(HB0 + (size_t)m * D))[lane + 64 * j] = o;
        }
        ss = wave_sum(ss);
        if (lane < 16) ss0[(size_t)m * 16 + lane] = lane == 0 ? ss : 0.f;
    }
}

typedef short v4i16_t __attribute__((ext_vector_type(4)));
typedef __bf16 bf16x2_t __attribute__((ext_vector_type(2)));
typedef float f32x2_t __attribute__((ext_vector_type(2)));
__device__ __forceinline__ unsigned cvtpk(float lo, float hi) { f32x2_t v = {lo, hi}; bf16x2_t b = __builtin_convertvector(v, bf16x2_t); return __builtin_bit_cast(unsigned, b); }
constexpr int ATT_VOFF = 16384, ATT_VPITCH = 288;
__device__ __forceinline__ void att_unit(const Params& p, int L, LAS unsigned char* lds, int tid, int b, int hh, int qb, float lam, float lam_init) {
    const int lane = tid & 63, w = __builtin_amdgcn_readfirstlane(tid >> 6), fr = lane & 15, fq = lane >> 4;
    const bf16* proj = (const bf16*)(p.ws + WS_PROJ);
    bf16* obuf = (bf16*)(p.ws + WS_OBUF);
    {
        const float slope2 = exp2f(-2.f * (float)(hh + 1)) * 1.4426950408889634f;
        const bf16* kbase = proj + (size_t)b * SEQ * PROJ_W + 512 + hh * 128;
        const bf16* vbase = proj + (size_t)b * SEQ * PROJ_W + 1024 + hh * 128;
        {
            const int qw0 = qb * 128 + w * 16, T = 2 * (qb + 1);
            bf16x8 qf[2][2];
#pragma unroll
            for (int mp = 0; mp < 2; ++mp)
#pragma unroll
                for (int ks = 0; ks < 2; ++ks) qf[mp][ks] = *(const bf16x8*)(proj + ((size_t)b * SEQ + qw0 + fr) * PROJ_W + hh * 128 + mp * 64 + ks * 32 + 8 * fq);
            f32x4 o[2][8];
#pragma unroll
            for (int mp = 0; mp < 2; ++mp)
#pragma unroll
                for (int dt = 0; dt < 8; ++dt) o[mp][dt] = (f32x4){0.f, 0.f, 0.f, 0.f};
            float mrun[2] = {-INFINITY, -INFINITY}, lrun[2] = {0.f, 0.f};
            u32x4 kreg[2], vreg[2];
#pragma unroll
            for (int i = 0; i < 2; ++i) { const int c = tid + 512 * i, key = c >> 4, ch = c & 15;
                kreg[i] = *(const u32x4*)(kbase + (size_t)key * PROJ_W + ch * 8); vreg[i] = *(const u32x4*)(vbase + (size_t)key * PROJ_W + ch * 8); }
            for (int t = 0; t < T; ++t) {
                const int k0 = t * 64;
#pragma unroll
                for (int i = 0; i < 2; ++i) { const int c = tid + 512 * i, key = c >> 4, ch = c & 15;
                    *(LAS u32x4*)(lds + key * 256 + ((ch ^ (key & 15)) << 4)) = kreg[i];
                    *(LAS u32x4*)(lds + ATT_VOFF + key * ATT_VPITCH + ch * 16) = vreg[i]; }
                LDS_BARRIER();
                if (t + 1 < T) {
#pragma unroll
                    for (int i = 0; i < 2; ++i) { const int c = tid + 512 * i, key = k0 + 64 + (c >> 4), ch = c & 15;
                        kreg[i] = *(const u32x4*)(kbase + (size_t)key * PROJ_W + ch * 8); vreg[i] = *(const u32x4*)(vbase + (size_t)key * PROJ_W + ch * 8); }
                }
                if (k0 <= qw0 + 15) {
                    f32x4 s[2][4];
                    const float base = -slope2 * (float)(qw0 + fr - k0 - 4 * fq);
#pragma unroll
                    for (int kt = 0; kt < 4; ++kt)
#pragma unroll
                        for (int r = 0; r < 4; ++r) { const float v = base + slope2 * (float)(16 * kt + r); s[0][kt][r] = v; s[1][kt][r] = v; }
#pragma unroll
                    for (int mp = 0; mp < 2; ++mp)
#pragma unroll
                        for (int kt = 0; kt < 4; ++kt)
#pragma unroll
                            for (int ks = 0; ks < 2; ++ks) {
                                const bf16x8 kf = *(const LAS bf16x8*)(lds + (16 * kt + fr) * 256 + (((mp * 8 + ks * 4 + fq) ^ fr) << 4));
                                s[mp][kt] = __builtin_amdgcn_mfma_f32_16x16x32_bf16(kf, qf[mp][ks], s[mp][kt], 0, 0, 0);
                            }
                    if (k0 + 63 > qw0) {
                        const int lim = qw0 + fr - k0 - 4 * fq;
#pragma unroll
                        for (int mp = 0; mp < 2; ++mp)
#pragma unroll
                            for (int kt = 0; kt < 4; ++kt)
#pragma unroll
                                for (int r = 0; r < 4; ++r) if (16 * kt + r > lim) s[mp][kt][r] = -INFINITY;
                    }
                    bf16x8 pb[2][2];
#pragma unroll
                    for (int mp = 0; mp < 2; ++mp) {
                        float mx = fmaxf(fmaxf(s[mp][0][0], s[mp][0][1]), fmaxf(s[mp][0][2], s[mp][0][3]));
#pragma unroll
                        for (int kt = 1; kt < 4; ++kt) mx = fmaxf(mx, fmaxf(fmaxf(s[mp][kt][0], s[mp][kt][1]), fmaxf(s[mp][kt][2], s[mp][kt][3])));
                        mx = xrow16_max(mx);
                        const float mnew = fmaxf(mrun[mp], mx);
                        const float alpha = __builtin_amdgcn_exp2f(mrun[mp] - mnew);
                        mrun[mp] = mnew;
                        float ps = 0.f;
#pragma unroll
                        for (int kt = 0; kt < 4; ++kt)
#pragma unroll
                            for (int r = 0; r < 4; ++r) { const float e = __builtin_amdgcn_exp2f(s[mp][kt][r] - mnew); s[mp][kt][r] = e; ps += e; }
                        lrun[mp] = lrun[mp] * alpha + ps;
#pragma unroll
                        for (int dt = 0; dt < 8; ++dt) o[mp][dt] = o[mp][dt] * alpha;
#pragma unroll
                        for (int ks = 0; ks < 2; ++ks) {
                            u32x4 pk; pk.x = cvtpk(s[mp][2 * ks][0], s[mp][2 * ks][1]); pk.y = cvtpk(s[mp][2 * ks][2], s[mp][2 * ks][3]);
                            pk.z = cvtpk(s[mp][2 * ks + 1][0], s[mp][2 * ks + 1][1]); pk.w = cvtpk(s[mp][2 * ks + 1][2], s[mp][2 * ks + 1][3]);
                            pb[mp][ks] = __builtin_bit_cast(bf16x8, pk);
                        }
                    }
                    const int gl = lane & 15;
                    LAS unsigned char* vrd = lds + ATT_VOFF + (4 * fq + (gl >> 2)) * ATT_VPITCH + (gl & 3) * 8;
#pragma unroll
                    for (int dt = 0; dt < 8; ++dt)
#pragma unroll
                        for (int ks = 0; ks < 2; ++ks) {
                            const v4i16_t v0 = __builtin_amdgcn_ds_read_tr16_b64_v4i16((LAS v4i16_t*)(vrd + (32 * ks) * ATT_VPITCH + dt * 32));
                            const v4i16_t v1 = __builtin_amdgcn_ds_read_tr16_b64_v4i16((LAS v4i16_t*)(vrd + (32 * ks + 16) * ATT_VPITCH + dt * 32));
                            bf16x8 vf; vf[0] = v0[0]; vf[1] = v0[1]; vf[2] = v0[2]; vf[3] = v0[3]; vf[4] = v1[0]; vf[5] = v1[1]; vf[6] = v1[2]; vf[7] = v1[3];
                            o[0][dt] = __builtin_amdgcn_mfma_f32_16x16x32_bf16(vf, pb[0][ks], o[0][dt], 0, 0, 0);
                            o[1][dt] = __builtin_amdgcn_mfma_f32_16x16x32_bf16(vf, pb[1][ks], o[1][dt], 0, 0, 0);
                        }
                }
                LDS_BARRIER();
            }
            const float i1 = 1.f / xrow16_sum(lrun[0]), i2 = lam / xrow16_sum(lrun[1]);
            float ss = 0.f;
#pragma unroll
            for (int dt = 0; dt < 8; ++dt)
#pragma unroll
                for (int r = 0; r < 4; ++r) { const float v = o[0][dt][r] * i1 - o[1][dt][r] * i2; o[0][dt][r] = v; ss += v * v; }
            ss = xrow16_sum(ss);
            const float rn = rsqrtf(ss * (1.f / 128.f) + EPS) * (1.f - lam_init);
            const float* g = p.subln_g + L * 128;
            bf16* orow = obuf + ((size_t)b * SEQ + qw0 + fr) * D + hh * 128;
#pragma unroll
            for (int dt = 0; dt < 8; ++dt) {
                const f32x4 gv = *(const f32x4*)(g + 16 * dt + 4 * fq);
                u32x2 ov; ov.x = pk2(o[0][dt][0] * rn * gv[0], o[0][dt][1] * rn * gv[1]); ov.y = pk2(o[0][dt][2] * rn * gv[2], o[0][dt][3] * rn * gv[3]);
                *(u32x2*)(orow + 16 * dt + 4 * fq) = ov;
            }
        }
    }
}

__device__ void phase_att_queue(const Params& p, int L, unsigned char* lds_, int bid, int nblk) {
    LAS unsigned char* lds = (LAS unsigned char*)lds_;
    const int tid = tidx(), lane = tid & 63;
    const float* lp = p.diff_lambda + L * 256;
    const float d1 = wave_sum(lp[lane] * lp[64 + lane]), d2 = wave_sum(lp[128 + lane] * lp[192 + lane]);
    const float lam_init = 0.8f - 0.6f * expf(-0.3f * (float)L);
    const float lam = expf(d1) - expf(d2) + lam_init;
    unsigned* head = (unsigned*)(p.ws + WS_CTL) + CW_QUEUE + L;
    volatile LAS int* slot = (volatile LAS int*)(lds + LDS_MISC_OFF + 64);
    for (;;) {
        __syncthreads();
        if (tid == 0) *slot = (int)__hip_atomic_fetch_add(head, 1u, __ATOMIC_RELAXED, __HIP_MEMORY_SCOPE_AGENT);
        __syncthreads();
        const int u = *slot;
        if (u >= 512) break;
        att_unit(p, L, lds, tid, (u & 31) >> 2, u & 3, 15 - (u >> 5), lam, lam_init);
    }
}

constexpr size_t GD_WP = WS_ORAW, GD_QD = WS_ORAW + 16 * MiB, GD_AIP = WS_ORAW + 32 * MiB, GD_KDT = WS_ORAW + 40 * MiB, GD_UT = WS_ORAW + 56 * MiB, GD_GL = WS_ORAW + 72 * MiB;
__device__ __forceinline__ int perm_pos(int k) { return (k & ~31) + 8 * ((k >> 2) & 3) + 4 * ((k >> 4) & 1) + (k & 3); }
__device__ __forceinline__ float softplusf_(float x) { return x > 20.f ? x : log1pf(expf(x)); }

constexpr int GP_KN = 0, GP_QN = 17408, GP_RT = 34816, GP_LM = 71680, GP_TB = 89088, GP_GT = 98304, GP_T0T = 99328;
constexpr int GP_KP = 272, GP_RP = 144, GP_LP = 68, GP_TP = 144;
__device__ void phase_gdn_prep(const Params& p, int L, unsigned char* lds_, int bid, int nblk) {
    LAS unsigned char* lds = (LAS unsigned char*)lds_;
    const int tid = tidx(), lane = tid & 63, w = __builtin_amdgcn_readfirstlane(tid >> 6), fr = lane & 15, fq = lane >> 4;
    const bf16* proj = (const bf16*)(p.ws + WS_PROJ);
    const float* BA = (const float*)(p.ws + WS_BA);
    bf16* WP = (bf16*)(p.ws + GD_WP); bf16* QD = (bf16*)(p.ws + GD_QD); bf16* AIP = (bf16*)(p.ws + GD_AIP); bf16* KDT = (bf16*)(p.ws + GD_KDT); bf16* UT = (bf16*)(p.ws + GD_UT);
    float* GL = (float*)(p.ws + GD_GL);
    const float* cw = p.conv_w + (size_t)L * 4 * 1536;
    LAS float* beta_s = (LAS float*)(lds + GP_GT); LAS float* gc_s = beta_s + 64; LAS float* egc_s = gc_s + 64; LAS float* edl_s = egc_s + 64;
    LAS float* Lm = (LAS float*)(lds + GP_LM);
    for (int item = bid; item < 1024; item += nblk) {
        const int n = item & 31, bh = item >> 5, hh = bh & 3, b = bh >> 2, t0 = n * 64;
        const size_t row0 = (size_t)b * SEQ + t0;
        __syncthreads();
        if (w == 0) {
            const float negA = -expf(p.a_log[L * 4 + hh]), dtb = p.dt_bias[L * 4 + hh];
            const float bb = BA[(row0 + lane) * 8 + hh], aa = BA[(row0 + lane) * 8 + 4 + hh] + dtb;
            float c = negA * softplusf_(aa);
#pragma unroll
            for (int o = 1; o < 64; o <<= 1) { const float t = __shfl_up(c, o); if (lane >= o) c += t; }
            const float glast = __shfl(c, 63);
            beta_s[lane] = sigmoidf_(bb); gc_s[lane] = c; egc_s[lane] = expf(c); edl_s[lane] = expf(glast - c);
            if (lane == 0) GL[item] = expf(glast);
        }
        __syncthreads();
        {
            const int colq = hh * 128 + 2 * lane;
            unsigned xk[11], xv[11];
#pragma unroll
            for (int r = 0; r < 11; ++r) { const int tt = t0 + 8 * w - 3 + r;
                xk[r] = (tt >= 0) ? *(const unsigned*)(proj + ((size_t)b * SEQ + tt) * PROJ_W + 1536 + 512 + colq) : 0u;
                xv[r] = (tt >= 0) ? *(const unsigned*)(proj + ((size_t)b * SEQ + tt) * PROJ_W + 1536 + 1024 + colq) : 0u; }
            {
                float wq[4][2]; unsigned xq[11];
#pragma unroll
                for (int j = 0; j < 4; ++j) { wq[j][0] = cw[j * 1536 + colq]; wq[j][1] = cw[j * 1536 + colq + 1]; }
#pragma unroll
                for (int r = 0; r < 11; ++r) { const int tt = t0 + 8 * w - 3 + r; xq[r] = (tt >= 0) ? *(const unsigned*)(proj + ((size_t)b * SEQ + tt) * PROJ_W + 1536 + colq) : 0u; }
#pragma unroll
                for (int i = 0; i < 8; ++i) {
                    const int c = 8 * w + i;
                    float q0 = 0.f, q1 = 0.f;
#pragma unroll
                    for (int j = 0; j < 4; ++j) { q0 += wq[j][0] * lo16(xq[i + j]); q1 += wq[j][1] * hi16(xq[i + j]); }
                    q0 *= sigmoidf_(q0); q1 *= sigmoidf_(q1);
                    const float sq = rsqrtf(wave_sum(q0 * q0 + q1 * q1) + EPS) * 0.08838834764831845f;
                    q0 *= sq; q1 *= sq;
                    const float eg = egc_s[c];
                    *(LAS unsigned*)(lds + GP_QN + c * GP_KP + lane * 4) = pk2(q0, q1);
                    *(unsigned*)(QD + ((size_t)item * 64 + c) * 128 + perm_pos(2 * lane)) = pk2(q0 * eg, q1 * eg);
                }
            }
            __builtin_amdgcn_sched_barrier(0);
            {
                float wk[4][2];
#pragma unroll
                for (int j = 0; j < 4; ++j) { wk[j][0] = cw[j * 1536 + 512 + colq]; wk[j][1] = cw[j * 1536 + 512 + colq + 1]; }
                unsigned kd0[8], kd1[8], rk0[8], rk1[8];
#pragma unroll
                for (int i = 0; i < 8; ++i) {
                    const int c = 8 * w + i;
                    float k0 = 0.f, k1 = 0.f;
#pragma unroll
                    for (int j = 0; j < 4; ++j) { k0 += wk[j][0] * lo16(xk[i + j]); k1 += wk[j][1] * hi16(xk[i + j]); }
                    k0 *= sigmoidf_(k0); k1 *= sigmoidf_(k1);
                    const float sk = rsqrtf(wave_sum(k0 * k0 + k1 * k1) + EPS);
                    k0 *= sk; k1 *= sk;
                    const float be = beta_s[c], eg = egc_s[c], ed = edl_s[c];
                    *(LAS unsigned*)(lds + GP_KN + c * GP_KP + lane * 4) = pk2(k0, k1);
                    kd0[i] = f2bf(k0 * ed); kd1[i] = f2bf(k1 * ed);
                    rk0[i] = f2bf(k0 * be * eg); rk1[i] = f2bf(k1 * be * eg);
                }
                u32x4 o;
                o.x = rk0[0] | (rk0[1] << 16); o.y = rk0[2] | (rk0[3] << 16); o.z = rk0[4] | (rk0[5] << 16); o.w = rk0[6] | (rk0[7] << 16); *(LAS u32x4*)(lds + GP_RT + (128 + 2 * lane) * GP_RP + 16 * w) = o;
                o.x = rk1[0] | (rk1[1] << 16); o.y = rk1[2] | (rk1[3] << 16); o.z = rk1[4] | (rk1[5] << 16); o.w = rk1[6] | (rk1[7] << 16); *(LAS u32x4*)(lds + GP_RT + (128 + 2 * lane + 1) * GP_RP + 16 * w) = o;
                const int pa = perm_pos(8 * w), pb = perm_pos(8 * w + 4);
                bf16* kr0 = KDT + ((size_t)item * 128 + 2 * lane) * 64; bf16* kr1 = kr0 + 64;
                u32x2 h2;
                h2.x = kd0[0] | (kd0[1] << 16); h2.y = kd0[2] | (kd0[3] << 16); *(u32x2*)(kr0 + pa) = h2;
                h2.x = kd0[4] | (kd0[5] << 16); h2.y = kd0[6] | (kd0[7] << 16); *(u32x2*)(kr0 + pb) = h2;
                h2.x = kd1[0] | (kd1[1] << 16); h2.y = kd1[2] | (kd1[3] << 16); *(u32x2*)(kr1 + pa) = h2;
                h2.x = kd1[4] | (kd1[5] << 16); h2.y = kd1[6] | (kd1[7] << 16); *(u32x2*)(kr1 + pb) = h2;
            }
            __builtin_amdgcn_sched_barrier(0);
            {
                float wv[4][2];
#pragma unroll
                for (int j = 0; j < 4; ++j) { wv[j][0] = cw[j * 1536 + 1024 + colq]; wv[j][1] = cw[j * 1536 + 1024 + colq + 1]; }
                unsigned rv0[8], rv1[8];
#pragma unroll
                for (int i = 0; i < 8; ++i) {
                    float v0 = 0.f, v1 = 0.f;
#pragma unroll
                    for (int j = 0; j < 4; ++j) { v0 += wv[j][0] * lo16(xv[i + j]); v1 += wv[j][1] * hi16(xv[i + j]); }
                    v0 *= sigmoidf_(v0); v1 *= sigmoidf_(v1);
                    const float be = beta_s[8 * w + i];
                    rv0[i] = f2bf(v0 * be); rv1[i] = f2bf(v1 * be);
                }
                u32x4 o;
                o.x = rv0[0] | (rv0[1] << 16); o.y = rv0[2] | (rv0[3] << 16); o.z = rv0[4] | (rv0[5] << 16); o.w = rv0[6] | (rv0[7] << 16); *(LAS u32x4*)(lds + GP_RT + (2 * lane) * GP_RP + 16 * w) = o;
                o.x = rv1[0] | (rv1[1] << 16); o.y = rv1[2] | (rv1[3] << 16); o.z = rv1[4] | (rv1[5] << 16); o.w = rv1[6] | (rv1[7] << 16); *(LAS u32x4*)(lds + GP_RT + (2 * lane + 1) * GP_RP + 16 * w) = o;
            }
        }
        __syncthreads();
#pragma unroll
        for (int q = 0; q < 2; ++q) {
            const int id = 2 * w + q, ct = id >> 2, st = id & 3;
            if (st <= ct) {
                f32x4 acc = (f32x4){0.f, 0.f, 0.f, 0.f};
#pragma unroll
                for (int ks = 0; ks < 4; ++ks) {
                    const bf16x8 a = *(const LAS bf16x8*)(lds + GP_KN + (16 * ct + fr) * GP_KP + (32 * ks + 8 * fq) * 2);
                    const bf16x8 bb = *(const LAS bf16x8*)(lds + GP_KN + (16 * st + fr) * GP_KP + (32 * ks + 8 * fq) * 2);
                    acc = __builtin_amdgcn_mfma_f32_16x16x32_bf16(a, bb, acc, 0, 0, 0);
                }
                const int s = 16 * st + fr; const float gs = gc_s[s];
#pragma unroll
                for (int r = 0; r < 4; ++r) { const int c = 16 * ct + 4 * fq + r;
                    Lm[c * GP_LP + s] = (s < c) ? beta_s[c] * acc[r] * expf(fminf(gc_s[c] - gs, 0.f)) : 0.f; }
            }
        }
        __syncthreads();
        if (w < 2) {
            const int o = 32 * w;
            float t[32];
            int zoff = 0; asm volatile("" : "+v"(zoff));
            const LAS float* Lz = Lm + zoff + o * GP_LP + o;
            const int col = lane & 31;
#pragma unroll
            for (int i = 0; i < 32; ++i) {
                float a0 = (i == lane) ? 1.f : 0.f, a1 = 0.f, a2 = 0.f, a3 = 0.f;
#pragma unroll
                for (int s4 = 0; s4 + 4 <= i; s4 += 4) { const f32x4 lv = *(const LAS f32x4*)(Lz + i * GP_LP + s4);
                    a0 -= lv[0] * t[s4]; a1 -= lv[1] * t[s4 + 1]; a2 -= lv[2] * t[s4 + 2]; a3 -= lv[3] * t[s4 + 3]; }
#pragma unroll
                for (int s = i & ~3; s < i; ++s) a0 -= Lz[i * GP_LP + s] * t[s];
                t[i] = (lane < 32) ? (a0 + a1) + (a2 + a3) : 0.f;
                const bf16 tb = (bf16)f2bf(t[i]);
                if (w == 0) { *(LAS bf16*)(lds + GP_TB + i * GP_TP + lane * 2) = tb;
                              if (lane < 32) *(LAS bf16*)(lds + GP_T0T + lane * 80 + i * 2) = tb; }
                else if (lane < 32) *(LAS bf16*)(lds + GP_TB + (32 + i) * GP_TP + (32 + col) * 2) = tb;
                if ((i & 3) == 3) __builtin_amdgcn_sched_barrier(0);
            }
        } else {
            for (int id = w - 2; id < 16; id += 6) {
                const int ct = id >> 2, st = id & 3;
                f32x4 acc = (f32x4){0.f, 0.f, 0.f, 0.f};
                if (st <= ct) {
#pragma unroll
                    for (int ks = 0; ks < 4; ++ks) {
                        const bf16x8 a = *(const LAS bf16x8*)(lds + GP_QN + (16 * ct + fr) * GP_KP + (32 * ks + 8 * fq) * 2);
                        const bf16x8 bb = *(const LAS bf16x8*)(lds + GP_KN + (16 * st + fr) * GP_KP + (32 * ks + 8 * fq) * 2);
                        acc = __builtin_amdgcn_mfma_f32_16x16x32_bf16(a, bb, acc, 0, 0, 0);
                    }
                }
                const int s = 16 * st + fr; const float gs = gc_s[s]; const int ps = perm_pos(s);
#pragma unroll
                for (int r = 0; r < 4; ++r) { const int c = 16 * ct + 4 * fq + r;
                    const float v = (s <= c) ? acc[r] * expf(fminf(gc_s[c] - gs, 0.f)) : 0.f;
                    AIP[((size_t)item * 64 + c) * 64 + ps] = (bf16)f2bf(v); }
            }
        }
        __syncthreads();
        if (w == 0) {
            f32x4 P[2][2];
#pragma unroll
            for (int it = 0; it < 2; ++it) {
                const LAS float* lr = Lm + (32 + 16 * it + fr) * GP_LP + 8 * fq;
                const f32x4 l0 = *(const LAS f32x4*)lr, l1 = *(const LAS f32x4*)(lr + 4);
                u32x4 pk; pk.x = cvtpk(l0[0], l0[1]); pk.y = cvtpk(l0[2], l0[3]); pk.z = cvtpk(l1[0], l1[1]); pk.w = cvtpk(l1[2], l1[3]);
                const bf16x8 a = __builtin_bit_cast(bf16x8, pk);
#pragma unroll
                for (int jt = 0; jt < 2; ++jt) {
                    const bf16x8 bb = *(const LAS bf16x8*)(lds + GP_T0T + (16 * jt + fr) * 80 + 16 * fq);
                    P[it][jt] = __builtin_amdgcn_mfma_f32_16x16x32_bf16(a, bb, (f32x4){0.f, 0.f, 0.f, 0.f}, 0, 0, 0);
                }
            }
#pragma unroll
            for (int jt = 0; jt < 2; ++jt) {
                u32x4 pk; pk.x = cvtpk(P[0][jt][0], P[0][jt][1]); pk.y = cvtpk(P[0][jt][2], P[0][jt][3]); pk.z = cvtpk(P[1][jt][0], P[1][jt][1]); pk.w = cvtpk(P[1][jt][2], P[1][jt][3]);
                const bf16x8 pb = __builtin_bit_cast(bf16x8, pk);
#pragma unroll
                for (int i2 = 0; i2 < 2; ++i2) {
                    const LAS unsigned char* tr = lds + GP_TB + (32 + 16 * i2 + fr) * GP_TP + (32 + 4 * fq) * 2;
                    const u32x2 ta = *(const LAS u32x2*)tr, tb2 = *(const LAS u32x2*)(tr + 32);
                    u32x4 ak; ak.x = ta.x; ak.y = ta.y; ak.z = tb2.x; ak.w = tb2.y;
                    const f32x4 r = __builtin_amdgcn_mfma_f32_16x16x32_bf16(__builtin_bit_cast(bf16x8, ak), pb, (f32x4){0.f, 0.f, 0.f, 0.f}, 0, 0, 0);
#pragma unroll
                    for (int q = 0; q < 4; ++q) *(LAS bf16*)(lds + GP_TB + (32 + 16 * i2 + 4 * fq + q) * GP_TP + (16 * jt + fr) * 2) = (bf16)f2bf(-r[q]);
                }
            }
        }
        __syncthreads();
#pragma unroll
        for (int q = 0; q < 2; ++q) {
            const int colt = 2 * w + q;
            bf16x8 af[2];
#pragma unroll
            for (int ks = 0; ks < 2; ++ks) af[ks] = *(const LAS bf16x8*)(lds + GP_RT + (16 * colt + fr) * GP_RP + (32 * ks + 8 * fq) * 2);
#pragma unroll
            for (int ct = 0; ct < 4; ++ct) {
                f32x4 acc = (f32x4){0.f, 0.f, 0.f, 0.f};
#pragma unroll
                for (int ks = 0; ks < 2; ++ks) {
                    const bf16x8 bb = *(const LAS bf16x8*)(lds + GP_TB + (16 * ct + fr) * GP_TP + (32 * ks + 8 * fq) * 2);
                    acc = __builtin_amdgcn_mfma_f32_16x16x32_bf16(af[ks], bb, acc, 0, 0, 0);
                }
                const int c = 16 * ct + fr;
                if (colt < 8) {
#pragma unroll
                    for (int r = 0; r < 4; ++r) UT[((size_t)item * 128 + 16 * colt + 4 * fq + r) * 64 + c] = (bf16)f2bf(acc[r]);
                } else {
                    const int kt = colt - 8;
                    u32x2 h2; h2.x = pk2(-acc[0], -acc[1]); h2.y = pk2(-acc[2], -acc[3]);
                    *(u32x2*)(WP + ((size_t)item * 64 + c) * 128 + 32 * (kt >> 1) + 8 * fq + 4 * (kt & 1)) = h2;
                }
            }
        }
    }
    __syncthreads();
}

constexpr int GS_WP = 0, GS_QD = 17408, GS_AIP = 34816, GS_KDT = 44032, GS_BUF = 62464, GS_OB = 2 * GS_BUF, GS_OBP = 272;
__device__ void phase_gdn_scan(const Params& p, int L, unsigned char* lds_, int bid, int nblk) {
    LAS unsigned char* lds = (LAS unsigned char*)lds_;
    const int tid = tidx(), lane = tid & 63, w = __builtin_amdgcn_readfirstlane(tid >> 6), fr = lane & 15, fq = lane >> 4;
    const bf16* proj = (const bf16*)(p.ws + WS_PROJ);
    const bf16* WP = (const bf16*)(p.ws + GD_WP); const bf16* QD = (const bf16*)(p.ws + GD_QD); const bf16* AIP = (const bf16*)(p.ws + GD_AIP);
    const bf16* KDT = (const bf16*)(p.ws + GD_KDT); const bf16* UT = (const bf16*)(p.ws + GD_UT); const float* GL = (const float*)(p.ws + GD_GL);
    bf16* obuf = (bf16*)(p.ws + WS_OBUF);
    for (int item = bid; item < 32; item += nblk) {
        const int hh = item & 3, b = item >> 2;
        const int fc = tid >> 4, fv = tid & 15;
        float gn[8];
#pragma unroll
        for (int i = 0; i < 8; ++i) gn[i] = p.gdn_norm_g[L * 128 + 8 * fv + i];
        f32x4 S[8];
#pragma unroll
        for (int kt = 0; kt < 8; ++kt) S[kt] = (f32x4){0.f, 0.f, 0.f, 0.f};
        u32x4 st[7];
        auto gload = [&](int ci) {
#pragma unroll
            for (int i = 0; i < 7; ++i) {
                const int pc = tid + 512 * i;
                const bf16* src;
                if (i < 2) src = WP + (size_t)ci * 8192 + pc * 8;
                else if (i < 4) src = QD + (size_t)ci * 8192 + (pc - 1024) * 8;
                else if (i < 5) src = AIP + (size_t)ci * 4096 + (pc - 2048) * 8;
                else src = KDT + (size_t)ci * 8192 + (pc - 2560) * 8;
                st[i] = *(const u32x4*)src;
            }
        };
        auto lstore = [&](int buf) {
#pragma unroll
            for (int i = 0; i < 7; ++i) {
                const int pc = tid + 512 * i;
                int off;
                if (i < 2) off = GS_WP + (pc >> 4) * 272 + (pc & 15) * 16;
                else if (i < 4) { const int q = pc - 1024; off = GS_QD + (q >> 4) * 272 + (q & 15) * 16; }
                else if (i < 5) { const int q = pc - 2048; off = GS_AIP + (q >> 3) * 144 + (q & 7) * 16; }
                else { const int q = pc - 2560; off = GS_KDT + (q >> 3) * 144 + (q & 7) * 16; }
                *(LAS u32x4*)(lds + buf * GS_BUF + off) = st[i];
            }
        };
        __syncthreads();
        gload(item * 32); lstore(0);
        u32x2 ut[4]; float gl;
        {
            const int ci = item * 32;
#pragma unroll
            for (int ct = 0; ct < 4; ++ct) ut[ct] = *(const u32x2*)(UT + ((size_t)ci * 128 + 16 * w + fr) * 64 + 16 * ct + 4 * fq);
            gl = GL[ci];
        }
        __syncthreads();
        for (int n = 0; n < 32; ++n) {
            const int ci = item * 32 + n, buf = n & 1;
            const size_t rowc = (size_t)b * SEQ + n * 64;
            u32x2 utn[4]; float gln = 0.f;
            if (n + 1 < 32) {
                gload(ci + 1);
#pragma unroll
                for (int ct = 0; ct < 4; ++ct) utn[ct] = *(const u32x2*)(UT + ((size_t)(ci + 1) * 128 + 16 * w + fr) * 64 + 16 * ct + 4 * fq);
                gln = GL[ci + 1];
            }
            u32x4 zq[2];
#pragma unroll
            for (int ps = 0; ps < 2; ++ps) zq[ps] = *(const u32x4*)(proj + (rowc + 32 * ps + fc) * PROJ_W + 3072 + hh * 128 + 8 * fv);
            f32x4 vn[4], oacc[4];
#pragma unroll
            for (int ct = 0; ct < 4; ++ct) { vn[ct] = (f32x4){lo16(ut[ct].x), hi16(ut[ct].x), lo16(ut[ct].y), hi16(ut[ct].y)}; oacc[ct] = (f32x4){0.f, 0.f, 0.f, 0.f}; }
            bf16x8 sb[4];
#pragma unroll
            for (int ks = 0; ks < 4; ++ks) { u32x4 pk; pk.x = cvtpk(S[2 * ks][0], S[2 * ks][1]); pk.y = cvtpk(S[2 * ks][2], S[2 * ks][3]); pk.z = cvtpk(S[2 * ks + 1][0], S[2 * ks + 1][1]); pk.w = cvtpk(S[2 * ks + 1][2], S[2 * ks + 1][3]);
                sb[ks] = __builtin_bit_cast(bf16x8, pk); }
            LAS unsigned char* bb = lds + buf * GS_BUF;
            bf16x8 f0[8], f1[8];
#define LD_A(F, ct) do { _Pragma("unroll") for (int ks = 0; ks < 4; ++ks) { F[ks] = *(const LAS bf16x8*)(bb + GS_WP + (16 * (ct) + fr) * 272 + (32 * ks + 8 * fq) * 2); \
                    F[4 + ks] = *(const LAS bf16x8*)(bb + GS_QD + (16 * (ct) + fr) * 272 + (32 * ks + 8 * fq) * 2); } } while (0)
#define MM_A(F, ct) do { _Pragma("unroll") for (int ks = 0; ks < 4; ++ks) { vn[ct] = __builtin_amdgcn_mfma_f32_16x16x32_bf16(F[ks], sb[ks], vn[ct], 0, 0, 0); \
                    oacc[ct] = __builtin_amdgcn_mfma_f32_16x16x32_bf16(F[4 + ks], sb[ks], oacc[ct], 0, 0, 0); } } while (0)
#define SBAR() __builtin_amdgcn_sched_barrier(0)
            LD_A(f0, 0); SBAR();
            LD_A(f1, 1); MM_A(f0, 0); SBAR();
            LD_A(f0, 2); MM_A(f1, 1); SBAR();
            LD_A(f1, 3); MM_A(f0, 2); SBAR();
#pragma unroll
            for (int ct = 0; ct < 4; ++ct)
#pragma unroll
                for (int ss = 0; ss < 2; ++ss) f0[2 * ct + ss] = *(const LAS bf16x8*)(bb + GS_AIP + (16 * ct + fr) * 144 + (32 * ss + 8 * fq) * 2);
            MM_A(f1, 3); SBAR();
            bf16x8 vb[2];
#pragma unroll
            for (int ss = 0; ss < 2; ++ss) { u32x4 pk; pk.x = cvtpk(vn[2 * ss][0], vn[2 * ss][1]); pk.y = cvtpk(vn[2 * ss][2], vn[2 * ss][3]); pk.z = cvtpk(vn[2 * ss + 1][0], vn[2 * ss + 1][1]); pk.w = cvtpk(vn[2 * ss + 1][2], vn[2 * ss + 1][3]);
                vb[ss] = __builtin_bit_cast(bf16x8, pk); }
#pragma unroll
            for (int kt = 0; kt < 4; ++kt)
#pragma unroll
                for (int ss = 0; ss < 2; ++ss) f1[2 * kt + ss] = *(const LAS bf16x8*)(bb + GS_KDT + (16 * kt + fr) * 144 + (32 * ss + 8 * fq) * 2);
#pragma unroll
            for (int ct = 0; ct < 4; ++ct)
#pragma unroll
                for (int ss = 0; ss < 2; ++ss) oacc[ct] = __builtin_amdgcn_mfma_f32_16x16x32_bf16(f0[2 * ct + ss], vb[ss], oacc[ct], 0, 0, 0);
            SBAR();
#pragma unroll
            for (int kt = 4; kt < 8; ++kt)
#pragma unroll
                for (int ss = 0; ss < 2; ++ss) f0[2 * (kt - 4) + ss] = *(const LAS bf16x8*)(bb + GS_KDT + (16 * kt + fr) * 144 + (32 * ss + 8 * fq) * 2);
#pragma unroll
            for (int kt = 0; kt < 4; ++kt) {
                S[kt] = S[kt] * gl;
#pragma unroll
                for (int ss = 0; ss < 2; ++ss) S[kt] = __builtin_amdgcn_mfma_f32_16x16x32_bf16(f1[2 * kt + ss], vb[ss], S[kt], 0, 0, 0);
            }
            SBAR();
#pragma unroll
            for (int kt = 4; kt < 8; ++kt) {
                S[kt] = S[kt] * gl;
#pragma unroll
                for (int ss = 0; ss < 2; ++ss) S[kt] = __builtin_amdgcn_mfma_f32_16x16x32_bf16(f0[2 * (kt - 4) + ss], vb[ss], S[kt], 0, 0, 0);
            }
#undef LD_A
#undef MM_A
#undef SBAR
            LDS_BARRIER();
#pragma unroll
            for (int ct = 0; ct < 4; ++ct)
#pragma unroll
                for (int r = 0; r < 4; r += 2) {
                    const unsigned pk = cvtpk(oacc[ct][r], oacc[ct][r + 1]);
                    *(LAS bf16*)(lds + GS_OB + (16 * ct + 4 * fq + r) * GS_OBP + (16 * w + fr) * 2) = (bf16)(pk & 0xffffu);
                    *(LAS bf16*)(lds + GS_OB + (16 * ct + 4 * fq + r + 1) * GS_OBP + (16 * w + fr) * 2) = (bf16)(pk >> 16);
                }
            if (n + 1 < 32) {
                lstore(buf ^ 1);
#pragma unroll
                for (int ct = 0; ct < 4; ++ct) ut[ct] = utn[ct];
                gl = gln;
            }
            LDS_BARRIER();
#pragma unroll
            for (int ps = 0; ps < 2; ++ps) {
                const int c = 32 * ps + fc;
                const u32x4 ov = *(const LAS u32x4*)(lds + GS_OB + c * GS_OBP + fv * 16);
                float o8[8];
#pragma unroll
                for (int i = 0; i < 4; ++i) { o8[2 * i] = lo16(ov[i]); o8[2 * i + 1] = hi16(ov[i]); }
                float ss = 0.f;
#pragma unroll
                for (int i = 0; i < 8; ++i) ss += o8[i] * o8[i];
                const float rn = rsqrtf(row16_sum(ss) * (1.f / 128.f) + EPS);
                u32x4 res;
#pragma unroll
                for (int i = 0; i < 4; ++i) {
                    const float z0 = lo16(zq[ps][i]), z1 = hi16(zq[ps][i]);
                    res[i] = cvtpk(o8[2 * i] * rn * gn[2 * i] * (z0 * sigmoidf_(z0)), o8[2 * i + 1] * rn * gn[2 * i + 1] * (z1 * sigmoidf_(z1)));
                }
                *(u32x4*)(obuf + (rowc + c) * D + 512 + hh * 128 + 8 * fv) = res;
            }
        }
        __syncthreads();
    }
}

__device__ __forceinline__ unsigned sortable(float f) { const unsigned u = __float_as_uint(f); return u ^ ((unsigned)((int)u >> 31) | 0x80000000u); }
__device__ __forceinline__ float unsortable(unsigned s) { return __uint_as_float((s & 0x80000000u) ? (s ^ 0x80000000u) : ~s); }
#define CE(a, b) do { const unsigned _x = k[a], _y = k[b]; k[a] = _x > _y ? _x : _y; k[b] = _x > _y ? _y : _x; } while (0)
constexpr int PE_TK = 0, PE_TAB = 8192, PE_ID = 8448, PE_GT = PE_ID + 32768;
__device__ void phase_peer(const Params& p, int L, unsigned char* lds_, int bid, int nblk) {
    LAS unsigned char* lds = (LAS unsigned char*)lds_;
    const int tid = tidx(), lane = tid & 63, w = __builtin_amdgcn_readfirstlane(tid >> 6), fr = lane & 15, fq = lane >> 4;
    const bf16* Q2 = (const bf16*)(p.ws + WS_Q2);
    const bf16* SK = (const bf16*)(p.ws + WS_SK) + (size_t)L * 8 * 2 * 128 * 128;
    float* H = (float*)(p.ws + WS_H); bf16* HB2 = (bf16*)(p.ws + WS_HB2);
    const unsigned char* U = p.ws + WS_U + (size_t)L * NEXP * D;
    const unsigned char* V = p.ws + WS_V + (size_t)L * NEXP * D;
    const float* SU = (const float*)(p.ws + WS_SU) + (size_t)L * NEXP; const float* SV = (const float*)(p.ws + WS_SV) + (size_t)L * NEXP;
    const float* g = p.ln_ffn_g + L * D;
    LAS unsigned* TK = (LAS unsigned*)(lds + PE_TK);
    LAS unsigned short* TAB = (LAS unsigned short*)(lds + PE_TAB);
    LAS int* IDL = (LAS int*)(lds + PE_ID); LAS float* GTL = (LAS float*)(lds + PE_GT);
    if (tid < 64) {
        int a = 0, base = 0, q = tid; unsigned short v = 0xffff;
        if (q < 50) { for (;;) { const int cnt = 16 / (a + 1); if (q < base + cnt) break; base += cnt; ++a; } v = (unsigned short)((a << 8) | (q - base)); }
        TAB[tid] = v;
    }
    for (int item = bid; item < M / 64; item += nblk) {
        const int tok0 = item * 64;
        __syncthreads();
        const int tg = w & 3, cc = w >> 2;
        for (int hh = 0; hh < 8; ++hh) {
            {
                f32x4 acc[8];
#pragma unroll
                for (int nt = 0; nt < 8; ++nt) acc[nt] = (f32x4){0.f, 0.f, 0.f, 0.f};
                bf16x8 qa[4];
#pragma unroll
                for (int ks = 0; ks < 4; ++ks) qa[ks] = *(const bf16x8*)(Q2 + (size_t)(tok0 + 16 * tg + fr) * 2048 + hh * 256 + cc * 128 + 32 * ks + 8 * fq);
                const bf16* skb = SK + ((size_t)(hh * 2 + cc) * 128 + fr) * 128 + 8 * fq;
#pragma unroll
                for (int nt = 0; nt < 8; ++nt)
#pragma unroll
                    for (int ks = 0; ks < 4; ++ks) {
                        const bf16x8 kb = *(const bf16x8*)(skb + (size_t)nt * 16 * 128 + 32 * ks);
                        acc[nt] = __builtin_amdgcn_mfma_f32_16x16x32_bf16(qa[ks], kb, acc[nt], 0, 0, 0);
                    }
#pragma unroll
                for (int r = 0; r < 4; ++r) {
                    unsigned k[8];
#pragma unroll
                    for (int nt = 0; nt < 8; ++nt) k[nt] = (sortable(acc[nt][r]) & ~0x7Fu) | (unsigned)(127 - (16 * nt + fr));
                    CE(0, 1); CE(2, 3); CE(4, 5); CE(6, 7); CE(0, 2); CE(1, 3); CE(4, 6); CE(5, 7); CE(1, 2); CE(5, 6); CE(0, 4); CE(3, 7);
                    CE(1, 5); CE(2, 6); CE(1, 4); CE(3, 6); CE(2, 4); CE(3, 5); CE(3, 4);
                    unsigned res = 0u;
#pragma unroll
                    for (int rd = 0; rd < 16; ++rd) {
                        const unsigned m = row16_umax(k[0]);
                        const bool win = k[0] == m;
#pragma unroll
                        for (int i = 0; i < 7; ++i) k[i] = win ? k[i + 1] : k[i];
                        k[7] = win ? 0u : k[7];
                        res = (fr == rd) ? m : res;
                    }
                    TK[(cc * 64 + 16 * tg + 4 * fq + r) * 16 + fr] = res;
                }
            }
            __syncthreads();
#pragma unroll
            for (int ps = 0; ps < 2; ++ps) {
                const int tl = 8 * w + 4 * ps + fq;
                unsigned k[4];
#pragma unroll
                for (int sl = 0; sl < 4; ++sl) {
                    const int q = sl * 16 + fr;
                    const unsigned ab = TAB[q];
                    const unsigned k1 = TK[tl * 16 + ((ab >> 8) & 15)], k2 = TK[(64 + tl) * 16 + (ab & 15)];
                    const float v = unsortable(k1 & ~0x7Fu) + unsortable(k2 & ~0x7Fu);
                    k[sl] = (q < 50) ? ((sortable(v) & ~0x3Fu) | (unsigned)(63 - q)) : 0u;
                }
                CE(0, 1); CE(2, 3); CE(0, 2); CE(1, 3); CE(1, 2);
                unsigned res = 0u;
#pragma unroll
                for (int rd = 0; rd < 16; ++rd) {
                    const unsigned m = row16_umax(k[0]);
                    const bool win = k[0] == m;
                    k[0] = win ? k[1] : k[0]; k[1] = win ? k[2] : k[1]; k[2] = win ? k[3] : k[2]; k[3] = win ? 0u : k[3];
                    res = (fr == rd) ? m : res;
                }
                const unsigned ab = TAB[63 - (res & 0x3Fu)];
                const unsigned k1 = TK[tl * 16 + ((ab >> 8) & 15)], k2 = TK[(64 + tl) * 16 + (ab & 15)];
                const float v = unsortable(k1 & ~0x7Fu) + unsortable(k2 & ~0x7Fu);
                const float e = __expf(v - row16_max(v));
                const float sum = row16_sum(e);
                IDL[tl * 128 + hh * 16 + fr] = (int)((127u - (k1 & 0x7Fu)) * 128u + (127u - (k2 & 0x7Fu)));
                GTL[tl * 128 + hh * 16 + fr] = e / sum;
            }
            __syncthreads();
        }
        for (int ti = 0; ti < 8; ++ti) {
            const int tl = 8 * w + ti, tok = tok0 + tl;
            const float* hrow = H + (size_t)tok * D + 16 * lane;
            float xn[16];
#pragma unroll
            for (int j = 0; j < 4; ++j) { const f32x4 a = *(const f32x4*)(hrow + 4 * j); xn[4 * j] = a[0]; xn[4 * j + 1] = a[1]; xn[4 * j + 2] = a[2]; xn[4 * j + 3] = a[3]; }
            float ss = 0.f;
#pragma unroll
            for (int i = 0; i < 16; ++i) ss += xn[i] * xn[i];
            const float rstd = rsqrtf(wave_sum(ss) * (1.f / D) + EPS);
            float mx = 0.f;
#pragma unroll
            for (int i = 0; i < 16; ++i) { xn[i] = xn[i] * rstd * g[16 * lane + i]; mx = fmaxf(mx, fabsf(xn[i])); }
            mx = xrow16_max(row16_max(mx));
            const float xinv = mx > 0.f ? 127.f / mx : 0.f, sx = mx * (1.f / 127.f);
            int xq[4];
#pragma unroll
            for (int j = 0; j < 4; ++j) xq[j] = (int)(((unsigned)__float2int_rn(xn[4 * j] * xinv) & 0xffu) | (((unsigned)__float2int_rn(xn[4 * j + 1] * xinv) & 0xffu) << 8) |
                                                      (((unsigned)__float2int_rn(xn[4 * j + 2] * xinv) & 0xffu) << 16) | ((unsigned)__float2int_rn(xn[4 * j + 3] * xinv) << 24));
            const int id0 = IDL[tl * 128 + lane], id1 = IDL[tl * 128 + 64 + lane];
            const float su0 = SU[id0], su1 = SU[id1], sv0 = SV[id0], sv1 = SV[id1];
            int h0i = 0, h1i = 0;
            u32x4 ring[16];
#pragma unroll
            for (int j = 0; j < 16; ++j) ring[j] = *(const u32x4*)(U + (size_t)IDL[tl * 128 + j] * D + 16 * lane);
#pragma unroll 1
            for (int k = 0; k < 8; ++k) {
#pragma unroll
                for (int j = 0; j < 16; ++j) {
                    const u32x4 a = ring[j];
                    if (k < 7) ring[j] = *(const u32x4*)(U + (size_t)IDL[tl * 128 + 16 * (k + 1) + j] * D + 16 * lane);
                    int d = __builtin_amdgcn_sdot4((int)a[0], xq[0], 0, false);
                    d = __builtin_amdgcn_sdot4((int)a[1], xq[1], d, false); d = __builtin_amdgcn_sdot4((int)a[2], xq[2], d, false); d = __builtin_amdgcn_sdot4((int)a[3], xq[3], d, false);
                    d = wave_isum(d);
                    const int e = 16 * k + j;
                    if (lane == (e & 63)) { if (k < 4) h0i = d; else h1i = d; }
                }
            }
            const float h0 = su0 * sx * (float)h0i, h1 = su1 * sx * (float)h1i;
            GTL[tl * 128 + lane] = sv0 * GTL[tl * 128 + lane] * 0.5f * h0 * (1.f + erff(h0 * 0.70710678118654752f));
            GTL[tl * 128 + 64 + lane] = sv1 * GTL[tl * 128 + 64 + lane] * 0.5f * h1 * (1.f + erff(h1 * 0.70710678118654752f));
        }
        for (int ti = 0; ti < 8; ++ti) {
            const int tl = 8 * w + ti, tok = tok0 + tl;
            float* hrow = H + (size_t)tok * D + 16 * lane;
            float xv[16];
#pragma unroll
            for (int j = 0; j < 4; ++j) { const f32x4 a = *(const f32x4*)(hrow + 4 * j); xv[4 * j] = a[0]; xv[4 * j + 1] = a[1]; xv[4 * j + 2] = a[2]; xv[4 * j + 3] = a[3]; }
            const float w0 = GTL[tl * 128 + lane], w1 = GTL[tl * 128 + 64 + lane];
            const float wmx = xrow16_max(row16_max(fmaxf(fabsf(w0), fabsf(w1))));
            const float winv = wmx > 0.f ? 127.f / wmx : 0.f, sw = wmx * (1.f / 127.f);
            const f32x4 wv = *(const LAS f32x4*)(GTL + tl * 128 + 4 * (lane & 31));
            const int wq = (int)(((unsigned)__float2int_rn(wv[0] * winv) & 0xffu) | (((unsigned)__float2int_rn(wv[1] * winv) & 0xffu) << 8) |
                                 (((unsigned)__float2int_rn(wv[2] * winv) & 0xffu) << 16) | ((unsigned)__float2int_rn(wv[3] * winv) << 24));
            int yi[16];
#pragma unroll
            for (int i = 0; i < 16; ++i) yi[i] = 0;
            u32x4 ring[16];
#pragma unroll
            for (int j = 0; j < 16; ++j) ring[j] = *(const u32x4*)(V + (size_t)IDL[tl * 128 + j] * D + 16 * lane);
#pragma unroll 1
            for (int k = 0; k < 8; ++k) {
#pragma unroll
                for (int g4 = 0; g4 < 4; ++g4) {
                    const u32x4 a0 = ring[4 * g4], a1 = ring[4 * g4 + 1], a2 = ring[4 * g4 + 2], a3 = ring[4 * g4 + 3];
                    if (k < 7) {
#pragma unroll
                        for (int q = 0; q < 4; ++q) ring[4 * g4 + q] = *(const u32x4*)(V + (size_t)IDL[tl * 128 + 16 * (k + 1) + 4 * g4 + q] * D + 16 * lane);
                    }
                    const int wg = __builtin_amdgcn_readlane(wq, 4 * k + g4);
#pragma unroll
                    for (int q = 0; q < 4; ++q) {
                        const unsigned p0 = __builtin_amdgcn_perm(a1[q], a0[q], 0x05010400u), p1 = __builtin_amdgcn_perm(a1[q], a0[q], 0x07030602u);
                        const unsigned p2 = __builtin_amdgcn_perm(a3[q], a2[q], 0x05010400u), p3 = __builtin_amdgcn_perm(a3[q], a2[q], 0x07030602u);
                        yi[4 * q] = __builtin_amdgcn_sdot4((int)__builtin_amdgcn_perm(p2, p0, 0x05040100u), wg, yi[4 * q], false);
                        yi[4 * q + 1] = __builtin_amdgcn_sdot4((int)__builtin_amdgcn_perm(p2, p0, 0x07060302u), wg, yi[4 * q + 1], false);
                        yi[4 * q + 2] = __builtin_amdgcn_sdot4((int)__builtin_amdgcn_perm(p3, p1, 0x05040100u), wg, yi[4 * q + 2], false);
                        yi[4 * q + 3] = __builtin_amdgcn_sdot4((int)__builtin_amdgcn_perm(p3, p1, 0x07060302u), wg, yi[4 * q + 3], false);
                    }
                }
            }
            float y[16];
#pragma unroll
            for (int i = 0; i < 16; ++i) y[i] = xv[i] + sw * (float)yi[i];
#pragma unroll
            for (int j = 0; j < 4; ++j) *(f32x4*)(hrow + 4 * j) = (f32x4){y[4 * j], y[4 * j + 1], y[4 * j + 2], y[4 * j + 3]};
            bf16* hb = HB2 + (size_t)tok * D + 16 * lane;
            u32x4 o; o.x = pk2(y[0], y[1]); o.y = pk2(y[2], y[3]); o.z = pk2(y[4], y[5]); o.w = pk2(y[6], y[7]);
            *(u32x4*)hb = o;
            o.x = pk2(y[8], y[9]); o.y = pk2(y[10], y[11]); o.z = pk2(y[12], y[13]); o.w = pk2(y[14], y[15]);
            *(u32x4*)(hb + 8) = o;
        }
    }
    __syncthreads();
}
#undef CE

__device__ void phase_final(const Params& p, int bid, int nblk) {
    const int tid = tidx(), lane = tid & 63, gw = bid * NWAVES + (tid >> 6), NGW = nblk * NWAVES;
    const float* H = (const float*)(p.ws + WS_H);
    for (int m = gw; m < M; m += NGW) {
        f32x4 v[4]; float ss = 0.f;
#pragma unroll
        for (int j = 0; j < 4; ++j) { v[j] = ((const f32x4*)(H + (size_t)m * D))[lane + 64 * j]; ss += (v[j][0] * v[j][0] + v[j][1] * v[j][1]) + (v[j][2] * v[j][2] + v[j][3] * v[j][3]); }
        const float r = rsqrtf(wave_sum(ss) * (1.f / D) + EPS);
#pragma unroll
        for (int j = 0; j < 4; ++j) { const f32x4 gv = ((const f32x4*)p.final_g)[lane + 64 * j]; ((f32x4*)(p.out + (size_t)m * D))[lane + 64 * j] = v[j] * r * gv; }
    }
}

#define XB_TMO      128
#define XB_XCNT(j)  (256  + 64 * (j))
#define XB_XSUB(j)  (1280 + 64 * (j))
#define XB_XGEN(j)  (2304 + 64 * (j))
#define XB_TOP      3328
#define XB_TOPGEN   3392
#define XCD_BAR_WORDS 3456
#define XB_SPIN_CAP (1u << 22)
__device__ __forceinline__ unsigned xb_ld(unsigned* p)              { return __hip_atomic_load(p, __ATOMIC_RELAXED, __HIP_MEMORY_SCOPE_AGENT); }
__device__ __forceinline__ unsigned xb_add(unsigned* p, unsigned v) { return __hip_atomic_fetch_add(p, v, __ATOMIC_RELAXED, __HIP_MEMORY_SCOPE_AGENT); }
__device__ __forceinline__ unsigned xb_xcc_id() { return (unsigned)__builtin_amdgcn_s_getreg((3 << 11) | 20) & 0xFu; }
#define XB_SPIN(cond, bar) do { unsigned _sp = 0; while (cond) { __builtin_amdgcn_s_sleep(1); \
    if ((++_sp & 255u) == 0u) { if (xb_ld(&(bar)[XB_TMO])) break; if (_sp > XB_SPIN_CAP) { atomicAdd(&(bar)[XB_TMO], 1u); break; } } } } while (0)
struct XcdBarrier { unsigned* bar; unsigned x; volatile LAS unsigned* st; };
__device__ __forceinline__ XcdBarrier xcd_barrier_post(unsigned* bar, volatile LAS unsigned* st) {
    XcdBarrier b; b.bar = bar; b.x = xb_xcc_id(); b.st = st;
    if (threadIdx.x == 0) (void)xb_add(&bar[XB_XCNT(b.x)], 1u);
    return b;
}
__device__ __forceinline__ void xcd_barrier_complete(unsigned* bar, unsigned x, unsigned& nloc, unsigned& nx) {
    const unsigned G = gridDim.x * gridDim.y * gridDim.z;
    unsigned sum, cnt, mine, sp = 0u;
    for (;;) {
        sum = 0u; cnt = 0u; mine = 0u;
#pragma unroll
        for (unsigned j = 0; j < 16; ++j) { const unsigned c = xb_ld(&bar[XB_XCNT(j)]); sum += c; cnt += (c > 0u) ? 1u : 0u; mine = (j == x) ? c : mine; }
        if (sum == G) break;
        __builtin_amdgcn_s_sleep(1);
        if ((++sp & 255u) == 0u) { if (xb_ld(&bar[XB_TMO])) break; if (sp > XB_SPIN_CAP) { atomicAdd(&bar[XB_TMO], 1u); break; } }
    }
    nloc = mine > 0u ? mine : 1u; nx = cnt > 0u ? cnt : 1u;
}
__device__ __forceinline__ void xcd_barrier(const XcdBarrier& b) {
    asm volatile("s_waitcnt vmcnt(0)" ::: "memory");
    __syncthreads();
    if (threadIdx.x == 0) {
        unsigned* bar = b.bar;
        __builtin_amdgcn_s_waitcnt(0);
        unsigned nloc = b.st[0], nx = b.st[1];
        if (nloc == 0u) { xcd_barrier_complete(bar, b.x, nloc, nx); b.st[0] = nloc; b.st[1] = nx; }
        const unsigned old = xb_add(&bar[XB_XSUB(b.x)], 1u);
        const unsigned gen = old / nloc;
        if (old + 1u == (gen + 1u) * nloc) {
            __builtin_amdgcn_fence(__ATOMIC_RELEASE, "agent");
            asm volatile("s_waitcnt vmcnt(0)" ::: "memory");
            const unsigned og = xb_add(&bar[XB_TOP], 1u);
            const unsigned tg = og / nx;
            if (og + 1u == (tg + 1u) * nx) xb_add(&bar[XB_TOPGEN], 1u);
            else XB_SPIN(xb_ld(&bar[XB_TOPGEN]) == tg, bar);
            __builtin_amdgcn_fence(__ATOMIC_ACQUIRE, "agent");
            xb_add(&bar[XB_XGEN(b.x)], 1u);
            asm volatile("s_waitcnt vmcnt(0)" ::: "memory");
        } else {
            XB_SPIN(xb_ld(&bar[XB_XGEN(b.x)]) == gen, bar);
            __builtin_amdgcn_fence(__ATOMIC_ACQUIRE, "agent");
            asm volatile("s_waitcnt vmcnt(0)" ::: "memory");
        }
    }
    __syncthreads();
}
constexpr int CW_BAR = 4096;

constexpr int K_PROLOGUE = 11, K_FINAL = 12;
template <int KIND>
__device__ __forceinline__ void run_kind(const Params& p, int L, unsigned char* lds, int bid, int nblk) {
    unsigned char* ws = p.ws;
    float* H = (float*)(ws + WS_H);
    float* ss0 = (float*)(ws + WS_STAT); float* ss1 = (float*)(ws + WS_SS1); float* sse = (float*)(ws + WS_SSE);
    if constexpr (KIND == K_PROLOGUE) phase_prologue(p, lds, bid, nblk);
    if constexpr (KIND == K_FINAL) phase_final(p, bid, nblk);
    if constexpr (KIND == 0) { EpiProj E{nullptr, (bf16*)(ws + WS_PROJ), (float*)(ws + WS_BA)};
        gemm_run(lds, (const bf16*)(ws + WS_HB0), (const bf16*)(ws + WS_WIN) + (size_t)L * IN_PAD * D, M, IN_PAD, D, E, bid, nblk, ss0); }
    if constexpr (KIND == 1) phase_gdn_prep(p, L, lds, bid, nblk);
    if constexpr (KIND == 2) { phase_gdn_scan(p, L, lds, bid, nblk); phase_att_queue(p, L, lds, bid, nblk); }
    if constexpr (KIND == 3) { EpiRes E{ss1, H, (bf16*)(ws + WS_HB1)};
        gemm_run(lds, (const bf16*)(ws + WS_OBUF), (const bf16*)(ws + WS_WOUT) + (size_t)L * D * D, M, D, D, E, bid, nblk); }
    if constexpr (KIND == 4) { EpiQ2 E{nullptr, (bf16*)(ws + WS_Q2)};
        gemm_run(lds, (const bf16*)(ws + WS_HB1), (const bf16*)(ws + WS_WQ) + (size_t)L * 2048 * D, M, 2048, D, E, bid, nblk, ss1); }
    if constexpr (KIND == 5) phase_peer(p, L, lds, bid, nblk);
    if constexpr (KIND == 7) { EpiE E2{sse, (bf16*)(ws + WS_EPRE)};
        gemm_run(lds, (const bf16*)(ws + WS_PB) + (size_t)L * M * 256, (const bf16*)(ws + WS_WP) + (size_t)L * D * 256, M, D, 256, E2, bid, nblk); }
    if constexpr (KIND == 6) { EpiPle E{ss0, H, (bf16*)(ws + WS_HB0), (const bf16*)(ws + WS_EPRE), p.ple_norm_g + L * D};
        gemm_run(lds, (const bf16*)(ws + WS_HB2), (const bf16*)(ws + WS_WG) + (size_t)L * D * D, M, D, D, E, bid, nblk, sse); }
}

__device__ __forceinline__ Params params_off(const Params& s, size_t z) {
    Params q;
    q.x = s.x + z; q.p = s.p + z; q.ln_mix_g = s.ln_mix_g + z; q.w_in = s.w_in + z; q.conv_w = s.conv_w + z; q.a_log = s.a_log + z; q.dt_bias = s.dt_bias + z;
    q.gdn_norm_g = s.gdn_norm_g + z; q.diff_lambda = s.diff_lambda + z; q.subln_g = s.subln_g + z; q.w_out = s.w_out + z; q.ln_ffn_g = s.ln_ffn_g + z;
    q.peer_wq = s.peer_wq + z; q.subkeys = s.subkeys + z; q.peer_u = s.peer_u + z; q.peer_v = s.peer_v + z; q.ple_wp = s.ple_wp + z; q.ple_wg = s.ple_wg + z;
    q.ple_norm_g = s.ple_norm_g + z; q.final_g = s.final_g + z; q.out = s.out + z; q.ws = s.ws + z; q.pad0 = 0; q.pad1 = 0;
    return q;
}
#define RUN(KIND) do { size_t z_ = 0; int L_ = L; asm volatile("" : "+s"(z_), "+s"(L_)); const Params q_ = params_off(p, z_); run_kind<KIND>(q_, L_, lds, bid, nblk); } while (0)
__global__ void __launch_bounds__(NTHREADS, 2) mk_fwd(Params p) {
    extern __shared__ __attribute__((aligned(16))) unsigned char lds[];
    const int bid = (int)blockIdx.x, nblk = (int)gridDim.x;
    volatile LAS unsigned* misc = (volatile LAS unsigned*)((LAS unsigned char*)lds + LDS_MISC_OFF);
    if (threadIdx.x < 64) misc[threadIdx.x] = 0u;
    __syncthreads();
    XcdBarrier bar = xcd_barrier_post((unsigned*)(p.ws + WS_CTL) + CW_BAR, misc + 8);
    { int L = 0; RUN(K_PROLOGUE); }
    cg::this_grid().sync();
#pragma nounroll
    for (int L = 0; L < DEPTH; ++L) {
        RUN(0); xcd_barrier(bar);
        RUN(1); xcd_barrier(bar);
        RUN(2); xcd_barrier(bar);
        RUN(3); xcd_barrier(bar);
        RUN(4); xcd_barrier(bar);
        RUN(5); RUN(7); xcd_barrier(bar);
        RUN(6); xcd_barrier(bar);
    }
    { int L = 0; RUN(K_FINAL); }
}

extern "C" void kernel_launch(void* const* d_in, const int* in_sizes, int n_in, void* d_out, int out_size, void* d_ws, size_t ws_size, hipStream_t stream) {
    static int grid = 0;
    if (grid == 0) {
        if (n_in != 20 || out_size != M * D || ws_size < WS_END) { fprintf(stderr, "kernel_launch: unexpected shapes (n_in %d, out %d, ws %zu < %zu)\n", n_in, out_size, ws_size, (size_t)WS_END); grid = -1; return; }
        int dev = 0, cus = 0, per_cu = 0;
        (void)hipGetDevice(&dev); (void)hipDeviceGetAttribute(&cus, hipDeviceAttributeMultiprocessorCount, dev);
        if (hipFuncSetAttribute((const void*)mk_fwd, hipFuncAttributeMaxDynamicSharedMemorySize, LDS_BYTES) != hipSuccess) { fprintf(stderr, "kernel_launch: hipFuncSetAttribute failed\n"); grid = -1; return; }
        if (hipOccupancyMaxActiveBlocksPerMultiprocessor(&per_cu, (const void*)mk_fwd, NTHREADS, LDS_BYTES) != hipSuccess || per_cu < 1) { fprintf(stderr, "kernel_launch: occupancy query says %d blocks per CU\n", per_cu); (void)hipGetLastError(); grid = -1; return; }
        grid = (cus > 0 ? cus : 256);
    }
    if (grid < 0) return;
    (void)hipMemsetAsync((char*)d_ws + WS_CTL, 0, CTL_ZERO_BYTES, stream);
    Params p{};
    const float** pp = (const float**)&p;
    for (int i = 0; i < 20; ++i) pp[i] = (const float*)d_in[i];
    p.out = (float*)d_out; p.ws = (unsigned char*)d_ws;
    void* args[] = {&p};
    hipError_t e = hipLaunchCooperativeKernel((const void*)mk_fwd, dim3(grid), dim3(NTHREADS), args, LDS_BYTES, stream);
    if (e != hipSuccess) fprintf(stderr, "kernel_launch: cooperative launch failed: %s (grid %d)\n", hipGetErrorString(e), grid);
}
```

```cpp
#include <hip/hip_runtime.h>
#include <hip/hip_cooperative_groups.h>
#include <cstdio>
#include <cstdint>
namespace cg = cooperative_groups;

#define LAS __attribute__((address_space(3)))
typedef unsigned short bf16;
typedef float f32x4 __attribute__((ext_vector_type(4)));
typedef short bf16x8 __attribute__((ext_vector_type(8)));
typedef unsigned u32x4 __attribute__((ext_vector_type(4)));
typedef unsigned u32x2 __attribute__((ext_vector_type(2)));

constexpr int D = 1024, BATCH = 8, SEQ = 2048, DEPTH = 4, M = BATCH * SEQ;
constexpr int IN_COLS = 3592, IN_PAD = 3840, PROJ_W = 3584;
constexpr int NEXP = 16384;
constexpr float EPS = 1e-6f;
constexpr float QSCALE = 0.125f * 1.4426950408889634f;
constexpr int NWAVES = 8, NTHREADS = 512;
constexpr int LDS_BYTES = 163840;
constexpr int LDS_MISC_OFF = LDS_BYTES - 256;
constexpr int RS_OFF = 147456;
constexpr int CW_QUEUE = 1024;

constexpr size_t MiB = 1u << 20;
constexpr size_t WS_CTL = 0, CTL_ZERO_BYTES = 1 * MiB;
constexpr size_t WS_H = 1 * MiB;
constexpr size_t WS_HB0 = 65 * MiB;
constexpr size_t WS_HB1 = 97 * MiB;
constexpr size_t WS_HB2 = 129 * MiB;
constexpr size_t WS_PROJ = 161 * MiB;
constexpr size_t WS_BA = 273 * MiB;
constexpr size_t WS_OBUF = 274 * MiB;
constexpr size_t WS_Q2 = 306 * MiB;
constexpr size_t WS_EPRE = 370 * MiB;
constexpr size_t WS_IDX = 402 * MiB;
constexpr size_t WS_GATE = 410 * MiB;
constexpr size_t WS_STAT = 418 * MiB;
constexpr size_t WS_SS1 = WS_IDX + 1 * MiB, WS_SSE = WS_IDX;
constexpr size_t WS_ORAW = 422 * MiB;
constexpr size_t WS_WIN = 550 * MiB;
constexpr size_t WS_WOUT = 582 * MiB;
constexpr size_t WS_WQ = 590 * MiB;
constexpr size_t WS_WG = 606 * MiB;
constexpr size_t WS_WP = 614 * MiB;
constexpr size_t WS_SK = 616 * MiB;
constexpr size_t WS_PB = 618 * MiB;
constexpr size_t WS_U = 650 * MiB;
constexpr size_t WS_V = 778 * MiB;
constexpr size_t WS_SU = WS_STAT + 1 * MiB, WS_SV = WS_STAT + 2 * MiB;
constexpr size_t WS_END = 906 * MiB;

struct Params {
    const float *x, *p, *ln_mix_g, *w_in, *conv_w, *a_log, *dt_bias, *gdn_norm_g, *diff_lambda, *subln_g, *w_out, *ln_ffn_g,
        *peer_wq, *subkeys, *peer_u, *peer_v, *ple_wp, *ple_wg, *ple_norm_g, *final_g;
    float* out;
    unsigned char* ws;
    int pad0, pad1;
};

__device__ __forceinline__ int tidx() { int t = (int)threadIdx.x; asm volatile("" : "+v"(t)); return t; }
#define LDS_BARRIER() asm volatile("s_waitcnt lgkmcnt(0)\n\ts_barrier" ::: "memory")
__device__ __forceinline__ float bf2f(bf16 v) { return __uint_as_float((unsigned)v << 16); }
__device__ __forceinline__ unsigned f2bf(float f) { unsigned u = __float_as_uint(f); return (u + 0x7fffu + ((u >> 16) & 1u)) >> 16; }
__device__ __forceinline__ unsigned pk2(float lo, float hi) { return f2bf(lo) | (f2bf(hi) << 16); }
__device__ __forceinline__ float lo16(unsigned w) { return __uint_as_float(w << 16); }
__device__ __forceinline__ float hi16(unsigned w) { return __uint_as_float(w & 0xffff0000u); }
template <int N> __device__ __forceinline__ float dpp_ror(float x) { return __builtin_bit_cast(float, __builtin_amdgcn_mov_dpp(__builtin_bit_cast(int, x), 0x120 + N, 0xf, 0xf, true)); }
template <int N> __device__ __forceinline__ unsigned dpp_ror_u(unsigned x) { return (unsigned)__builtin_amdgcn_mov_dpp((int)x, 0x120 + N, 0xf, 0xf, true); }
__device__ __forceinline__ float row16_sum(float x) { x += dpp_ror<8>(x); x += dpp_ror<4>(x); x += dpp_ror<2>(x); x += dpp_ror<1>(x); return x; }
__device__ __forceinline__ float row16_max(float x) { x = fmaxf(x, dpp_ror<8>(x)); x = fmaxf(x, dpp_ror<4>(x)); x = fmaxf(x, dpp_ror<2>(x)); x = fmaxf(x, dpp_ror<1>(x)); return x; }
__device__ __forceinline__ unsigned row16_umax(unsigned x) { unsigned y;
    y = dpp_ror_u<8>(x); x = x > y ? x : y; y = dpp_ror_u<4>(x); x = x > y ? x : y; y = dpp_ror_u<2>(x); x = x > y ? x : y; y = dpp_ror_u<1>(x); x = x > y ? x : y; return x; }
__device__ __forceinline__ float xrow16_max(float x) {
    auto s = __builtin_amdgcn_permlane16_swap(__float_as_uint(x), __float_as_uint(x), false, false);
    x = fmaxf(__uint_as_float(s[0]), __uint_as_float(s[1]));
    auto t = __builtin_amdgcn_permlane32_swap(__float_as_uint(x), __float_as_uint(x), false, false);
    return fmaxf(__uint_as_float(t[0]), __uint_as_float(t[1]));
}
__device__ __forceinline__ float xrow16_sum(float x) {
    auto s = __builtin_amdgcn_permlane16_swap(__float_as_uint(x), __float_as_uint(x), false, false);
    x = __uint_as_float(s[0]) + __uint_as_float(s[1]);
    auto t = __builtin_amdgcn_permlane32_swap(__float_as_uint(x), __float_as_uint(x), false, false);
    return __uint_as_float(t[0]) + __uint_as_float(t[1]);
}
__device__ __forceinline__ float wave_sum(float v) { return xrow16_sum(row16_sum(v)); }
template <int N> __device__ __forceinline__ int dpp_ror_i(int x) { return __builtin_amdgcn_mov_dpp(x, 0x120 + N, 0xf, 0xf, true); }
__device__ __forceinline__ int wave_isum(int x) {
    x += dpp_ror_i<8>(x); x += dpp_ror_i<4>(x); x += dpp_ror_i<2>(x); x += dpp_ror_i<1>(x);
    auto s = __builtin_amdgcn_permlane16_swap((unsigned)x, (unsigned)x, false, false); x = (int)(s[0] + s[1]);
    auto t = __builtin_amdgcn_permlane32_swap((unsigned)x, (unsigned)x, false, false); return (int)(t[0] + t[1]);
}
__device__ __forceinline__ float wave_max(float v) {
#pragma unroll
    for (int o = 32; o; o >>= 1) v = fmaxf(v, __shfl_xor(v, o));
    return v;
}
__device__ __forceinline__ float sigmoidf_(float x) { return 1.f / (1.f + __expf(-x)); }
__device__ __forceinline__ float dot8(u32x4 a, u32x4 b, float s) {
#pragma unroll
    for (int i = 0; i < 4; ++i) { s += lo16(a[i]) * lo16(b[i]); s += hi16(a[i]) * hi16(b[i]); }
    return s;
}

__host__ __device__ __forceinline__ int lds_byte(int r, int c) { const int st = (r >> 4) * 2 + (c >> 5), rr = r & 15, cc = c & 31, ob = rr * 64 + cc * 2; return st * 1024 + (ob ^ (((ob >> 9) & 1) << 5)); }
__host__ __device__ __forceinline__ void stage_rc(int b, int& R, int& C) { const int st = b / 1024, sb = b % 1024, swz = sb ^ (((sb >> 9) & 1) << 5); R = (st >> 1) * 16 + swz / 64; C = (st & 1) * 32 + (swz % 64) / 2; }
constexpr int HTB = 16384;
template <class F>
__device__ __forceinline__ void gemm_run(LAS unsigned char* lds, const bf16* A, const bf16* Bt, int Mm, int N, int K, const F& f, int bid, int nblk, const float* slots_in = nullptr) {
    LAS float* RS = (LAS float*)(lds + RS_OFF);
    if (slots_in) {
        const int t = tidx();
        if (t < 256) { const f32x4* sp = (const f32x4*)(slots_in + ((size_t)(bid % (Mm / 256)) * 256 + t) * 16);
            const f32x4 a = sp[0], b = sp[1], c = sp[2], d = sp[3];
            const float s = (((a[0] + a[1]) + (a[2] + a[3])) + ((b[0] + b[1]) + (b[2] + b[3]))) + (((c[0] + c[1]) + (c[2] + c[3])) + ((d[0] + d[1]) + (d[2] + d[3])));
            RS[t] = rsqrtf(s * (1.f / D) + EPS); }
        __syncthreads();
    }
    const int tid = tidx(), wid = __builtin_amdgcn_readfirstlane(tid >> 6), lane = tid & 63, wr = wid >> 2, wc = wid & 3, fr = lane & 15, fq = lane >> 4;
    const int nt = K / 64, ntn = N / 256, nunits = (Mm / 256) * ntn;
    unsigned voff[2];
#pragma unroll
    for (int i = 0; i < 2; ++i) { int R, C; stage_rc(tid * 16 + i * 8192, R, C); voff[i] = (unsigned)(R * K + C) * 2u; }
    const unsigned ldsw = (unsigned)wid * 1024u;
    const int aoff = wr * HTB + lds_byte(fr, fq * 8), boff = (2 + (wc >> 1)) * HTB + lds_byte((wc & 1) * 64 + fr, fq * 8);
#define G_STAGE(bufoff, gbase) do { _Pragma("unroll") for (int _i = 0; _i < 2; ++_i) \
        __builtin_amdgcn_global_load_lds((const unsigned*)((const char*)(gbase) + voff[_i]), (LAS unsigned*)(lds + (bufoff) + ldsw + _i * 8192), 16, 0, 0); } while (0)
    for (int u = bid; u < nunits; u += nblk) {
        const int pm = u % (Mm / 256), pn = u / (Mm / 256);
        const char* gA = (const char*)(A + (size_t)pm * 256 * K);
        const char* gB = (const char*)(Bt + (size_t)pn * 256 * K);
        const size_t hstep = (size_t)128 * K * 2;
        f32x4 acc[8][4];
#pragma unroll
        for (int a = 0; a < 8; ++a)
#pragma unroll
            for (int b = 0; b < 4; ++b) acc[a][b] = (f32x4){0.f, 0.f, 0.f, 0.f};
        G_STAGE(0, gA); G_STAGE(HTB, gA + hstep); G_STAGE(2 * HTB, gB); G_STAGE(3 * HTB, gB + hstep);
        for (int t = 0; t < nt; ++t) {
            const int cb = (t & 1) * 4 * HTB, nb = ((t + 1) & 1) * 4 * HTB;
            asm volatile("s_waitcnt vmcnt(0)" ::: "memory");
            __builtin_amdgcn_s_barrier();
            asm volatile("" ::: "memory");
            const size_t ko = (size_t)(t + 1) * 128; const bool more = t + 1 < nt;
#pragma unroll
            for (int k = 0; k < 2; ++k) {
                if (more) { if (k == 0) { G_STAGE(nb, gA + ko); G_STAGE(nb + 2 * HTB, gB + ko); } else { G_STAGE(nb + HTB, gA + hstep + ko); G_STAGE(nb + 3 * HTB, gB + hstep + ko); } }
                bf16x8 bfr[4], acur, anxt;
#pragma unroll
                for (int n = 0; n < 4; ++n) bfr[n] = *(const LAS bf16x8*)(lds + cb + boff + n * 2048 + k * 1024);
                acur = *(const LAS bf16x8*)(lds + cb + aoff + k * 1024);
#pragma unroll
                for (int m = 0; m < 8; ++m) {
                    if (m < 7) anxt = *(const LAS bf16x8*)(lds + cb + aoff + (m + 1) * 2048 + k * 1024);
#pragma unroll
                    for (int n = 0; n < 4; ++n) acc[m][n] = __builtin_amdgcn_mfma_f32_16x16x32_bf16(bfr[n], acur, acc[m][n], 0, 0, 0);
                    acur = anxt;
                }
                __builtin_amdgcn_sched_barrier(0);
            }
            asm volatile("s_waitcnt lgkmcnt(0)" ::: "memory");
        }
#pragma unroll
        for (int m = 0; m < 8; ++m) {
            const int lrow = wr * 128 + m * 16 + fr, row = pm * 256 + lrow;
            float ssq = 0.f;
#pragma unroll
            for (int n = 0; n < 4; ++n) { const f32x4 r = f(row, RS[lrow], pn * 256 + wc * 64 + n * 16 + 4 * fq, acc[m][n]); ssq += (r[0] * r[0] + r[1] * r[1]) + (r[2] * r[2] + r[3] * r[3]); }
            if constexpr (F::STATS) { ssq = xrow16_sum(ssq); if (fq == 0) f.slots[(size_t)row * 16 + pn * 4 + wc] = ssq; }
        }
        __syncthreads();
    }
#undef G_STAGE
}

__device__ __forceinline__ u32x2 pk4(f32x4 a) { u32x2 o; o.x = pk2(a[0], a[1]); o.y = pk2(a[2], a[3]); return o; }
struct EpiProj {
    static constexpr bool STATS = false; float* slots;
    bf16* proj; float* ba;
    __device__ __forceinline__ f32x4 operator()(int row, float rstd, int col, f32x4 v) const {
        v = v * rstd;
        if (col < PROJ_W) *(u32x2*)(proj + (size_t)row * PROJ_W + col) = pk4(v);
        else if (col < IN_COLS) *(f32x4*)(ba + (size_t)row * 8 + (col - PROJ_W)) = v;
        return v;
    }
};
struct EpiRes {
    static constexpr bool STATS = true; float* slots;
    float* H; bf16* HB;
    __device__ __forceinline__ f32x4 operator()(int row, float, int col, f32x4 v) const {
        f32x4* hp = (f32x4*)(H + (size_t)row * D + col);
        const f32x4 h = *hp + v; *hp = h;
        *(u32x2*)(HB + (size_t)row * D + col) = pk4(h);
        return h;
    }
};
struct EpiQ2 {
    static constexpr bool STATS = false; float* slots;
    bf16* Q2;
    __device__ __forceinline__ f32x4 operator()(int row, float rstd, int col, f32x4 v) const { v = v * rstd; *(u32x2*)(Q2 + (size_t)row * 2048 + col) = pk4(v); return v; }
};
struct EpiE {
    static constexpr bool STATS = true; float* slots;
    bf16* E;
    __device__ __forceinline__ f32x4 operator()(int row, float, int col, f32x4 v) const { *(u32x2*)(E + (size_t)row * D + col) = pk4(v); return v; }
};
struct EpiPle {
    static constexpr bool STATS = true; float* slots;
    float* H; bf16* HB; const bf16* E; const float* g;
    __device__ __forceinline__ f32x4 operator()(int row, float rstde, int col, f32x4 v) const {
        f32x4* hp = (f32x4*)(H + (size_t)row * D + col);
        const u32x2 ev = *(const u32x2*)(E + (size_t)row * D + col);
        const f32x4 gv = *(const f32x4*)(g + col);
        f32x4 h = *hp;
        h[0] += sigmoidf_(v[0]) * (lo16(ev.x) * rstde * gv[0]); h[1] += sigmoidf_(v[1]) * (hi16(ev.x) * rstde * gv[1]);
        h[2] += sigmoidf_(v[2]) * (lo16(ev.y) * rstde * gv[2]); h[3] += sigmoidf_(v[3]) * (hi16(ev.y) * rstde * gv[3]);
        *hp = h;
        *(u32x2*)(HB + (size_t)row * D + col) = pk4(h);
        return h;
    }
};

__device__ __forceinline__ void transpose_item(const float* W, int K, int N, int Npad, bf16* WT, const float* rowscale, int qcols, float* scr, int item, int lane) {
    const int nblk = Npad / 32, kb = item / nblk, nb = item % nblk, k0 = 64 * kb, n0 = 32 * nb;
    const int n = n0 + (lane & 31);
#pragma unroll 8
    for (int i = 0; i < 32; ++i) {
        const int kk = 2 * i + (lane >> 5);
        float v = (n < N) ? W[(size_t)(k0 + kk) * N + n] : 0.f;
        if (rowscale) v *= rowscale[k0 + kk];
        if (n < qcols) v *= QSCALE;
        scr[kk * 33 + (lane & 31)] = v;
    }
    asm volatile("s_waitcnt lgkmcnt(0)" ::: "memory");
    const int c = lane & 7;
#pragma unroll
    for (int j = 0; j < 4; ++j) {
        const int nn = (lane >> 3) + 8 * j; const float* s = scr + (8 * c) * 33 + nn;
        u32x4 o; o.x = pk2(s[0 * 33], s[1 * 33]); o.y = pk2(s[2 * 33], s[3 * 33]); o.z = pk2(s[4 * 33], s[5 * 33]); o.w = pk2(s[6 * 33], s[7 * 33]);
        *(u32x4*)(WT + (size_t)(n0 + nn) * K + k0 + 8 * c) = o;
    }
    asm volatile("s_waitcnt lgkmcnt(0)" ::: "memory");
}
__device__ __forceinline__ void convert_bulk(const float* src, bf16* dst, size_t n, size_t gtid, size_t nthr) {
    for (size_t i = gtid * 8; i < n; i += nthr * 8) {
        const f32x4 a = *(const f32x4*)(src + i), b = *(const f32x4*)(src + i + 4);
        u32x4 o; o.x = pk2(a[0], a[1]); o.y = pk2(a[2], a[3]); o.z = pk2(b[0], b[1]); o.w = pk2(b[2], b[3]);
        *(u32x4*)(dst + i) = o;
    }
}
__device__ void phase_prologue(const Params& p, LAS unsigned char* lds_, int bid, int nblk) {
    unsigned char* lds = (unsigned char*)lds_;
    const int tid = tidx(), lane = tid & 63, w = tid >> 6;
    const int gw = bid * NWAVES + w, NGW = nblk * NWAVES;
    float* scr = (float*)(lds + w * 16384);
    constexpr int I_IN = 16 * (IN_PAD / 32), I_OUT = 16 * 32, I_Q = 16 * 64, I_G = 16 * 32, I_P = 4 * 32, I_L = I_IN + I_OUT + I_Q + I_G + I_P;
    for (int it = gw; it < DEPTH * I_L; it += NGW) {
        const int L = it / I_L; int r = it % I_L;
        if (r < I_IN) { transpose_item(p.w_in + (size_t)L * D * IN_COLS, D, IN_COLS, IN_PAD, (bf16*)(p.ws + WS_WIN) + (size_t)L * IN_PAD * D, p.ln_mix_g + L * D, 512, scr, r, lane); continue; } r -= I_IN;
        if (r < I_OUT) { transpose_item(p.w_out + (size_t)L * D * D, D, D, D, (bf16*)(p.ws + WS_WOUT) + (size_t)L * D * D, nullptr, 0, scr, r, lane); continue; } r -= I_OUT;
        if (r < I_Q) { transpose_item(p.peer_wq + (size_t)L * D * 2048, D, 2048, 2048, (bf16*)(p.ws + WS_WQ) + (size_t)L * 2048 * D, p.ln_ffn_g + L * D, 0, scr, r, lane); continue; } r -= I_Q;
        if (r < I_G) { transpose_item(p.ple_wg + (size_t)L * D * D, D, D, D, (bf16*)(p.ws + WS_WG) + (size_t)L * D * D, nullptr, 0, scr, r, lane); continue; } r -= I_G;
        transpose_item(p.ple_wp + (size_t)L * 256 * D, 256, D, D, (bf16*)(p.ws + WS_WP) + (size_t)L * D * 256, nullptr, 0, scr, r, lane);
    }
    const size_t gtid = (size_t)bid * NTHREADS + tid, nthr = (size_t)nblk * NTHREADS;
    for (int r = gw; r < 2 * DEPTH * NEXP; r += NGW) {
        const int which = r >= DEPTH * NEXP, rr = which ? r - DEPTH * NEXP : r;
        const float* srow = (which ? p.peer_v : p.peer_u) + (size_t)rr * D + 16 * lane;
        f32x4 v[4];
#pragma unroll
        for (int j = 0; j < 4; ++j) v[j] = *(const f32x4*)(srow + 4 * j);
        float mx = 0.f;
#pragma unroll
        for (int j = 0; j < 4; ++j) mx = fmaxf(mx, fmaxf(fmaxf(fabsf(v[j][0]), fabsf(v[j][1])), fmaxf(fabsf(v[j][2]), fabsf(v[j][3]))));
        mx = xrow16_max(row16_max(mx));
        const float inv = mx > 0.f ? 127.f / mx : 0.f;
        u32x4 o;
#pragma unroll
        for (int j = 0; j < 4; ++j) {
            const unsigned b0 = (unsigned)__float2int_rn(v[j][0] * inv) & 0xffu, b1 = (unsigned)__float2int_rn(v[j][1] * inv) & 0xffu, b2 = (unsigned)__float2int_rn(v[j][2] * inv) & 0xffu, b3 = (unsigned)__float2int_rn(v[j][3] * inv) & 0xffu;
            o[j] = b0 | (b1 << 8) | (b2 << 16) | (b3 << 24);
        }
        *(u32x4*)(p.ws + (which ? WS_V : WS_U) + (size_t)rr * D + 16 * lane) = o;
        if (lane == 0) ((float*)(p.ws + (which ? WS_SV : WS_SU)))[rr] = mx * (1.f / 127.f);
    }
    convert_bulk(p.p, (bf16*)(p.ws + WS_PB), (size_t)DEPTH * M * 256, gtid, nthr);
    convert_bulk(p.subkeys, (bf16*)(p.ws + WS_SK), (size_t)DEPTH * 8 * 2 * 128 * 128, gtid, nthr);
    float* H = (float*)(p.ws + WS_H); bf16* HB0 = (bf16*)(p.ws + WS_HB0); float* ss0 = (float*)(p.ws + WS_STAT);
    for (int m = gw; m < M; m += NGW) {
        const f32x4* xr = (const f32x4*)(p.x + (size_t)m * D) + lane;
        float ss = 0.f;
#pragma unroll
        for (int j = 0; j < 4; ++j) {
            const f32x4 v = xr[64 * j];
            ss += v[0] * v[0] + v[1] * v[1] + v[2] * v[2] + v[3] * v[3];
            ((f32x4*)(H + (size_t)m * D))[lane + 64 * j] = v;
            u32x2 o; o.x = pk2(v[0], v[1]); o.y = pk2(v[2], v[3]);
            ((u32x2*)(HB0 + (size_t)m * D))[lane + 64 * j] = o;
        }
        ss = wave_sum(ss);
        if (lane < 16) ss0[(size_t)m * 16 + lane] = lane == 0 ? ss : 0.f;
    }
}

typedef short v4i16_t __attribute__((ext_vector_type(4)));
typedef __bf16 bf16x2_t __attribute__((ext_vector_type(2)));
typedef float f32x2_t __attribute__((ext_vector_type(2)));
__device__ __forceinline__ unsigned cvtpk(float lo, float hi) { f32x2_t v = {lo, hi}; bf16x2_t b = __builtin_convertvector(v, bf16x2_t); return __builtin_bit_cast(unsigned, b); }
constexpr int ATT_VOFF = 16384, ATT_VPITCH = 288;
__device__ __forceinline__ void att_unit(const Params& p, int L, LAS unsigned char* lds, int tid, int b, int hh, int qb, float lam, float lam_init) {
    const int lane = tid & 63, w = __builtin_amdgcn_readfirstlane(tid >> 6), fr = lane & 15, fq = lane >> 4;
    const bf16* proj = (const bf16*)(p.ws + WS_PROJ);
    bf16* obuf = (bf16*)(p.ws + WS_OBUF);
    {
        const float slope2 = 1.4426950408889634f / (float)(1 << (2 * (hh + 1)));
        const bf16* kbase = proj + (size_t)b * SEQ * PROJ_W + 512 + hh * 128;
        const bf16* vbase = proj + (size_t)b * SEQ * PROJ_W + 1024 + hh * 128;
        {
            const int qw0 = qb * 128 + w * 16, T = 2 * (qb + 1);
            bf16x8 qf[2][2];
#pragma unroll
            for (int mp = 0; mp < 2; ++mp)
#pragma unroll
                for (int ks = 0; ks < 2; ++ks) qf[mp][ks] = *(const bf16x8*)(proj + ((size_t)b * SEQ + qw0 + fr) * PROJ_W + hh * 128 + mp * 64 + ks * 32 + 8 * fq);
            f32x4 o[2][8];
#pragma unroll
            for (int mp = 0; mp < 2; ++mp)
#pragma unroll
                for (int dt = 0; dt < 8; ++dt) o[mp][dt] = (f32x4){0.f, 0.f, 0.f, 0.f};
            float mrun[2] = {-INFINITY, -INFINITY}, lrun[2] = {0.f, 0.f};
            u32x4 kreg[2], vreg[2];
#pragma unroll
            for (int i = 0; i < 2; ++i) { const int c = tid + 512 * i, key = c >> 4, ch = c & 15;
                kreg[i] = *(const u32x4*)(kbase + (size_t)key * PROJ_W + ch * 8); vreg[i] = *(const u32x4*)(vbase + (size_t)key * PROJ_W + ch * 8); }
            for (int t = 0; t < T; ++t) {
                const int k0 = t * 64;
#pragma unroll
                for (int i = 0; i < 2; ++i) { const int c = tid + 512 * i, key = c >> 4, ch = c & 15;
                    *(LAS u32x4*)(lds + key * 256 + ((ch ^ (key & 15)) << 4)) = kreg[i];
                    *(LAS u32x4*)(lds + ATT_VOFF + key * ATT_VPITCH + ch * 16) = vreg[i]; }
                LDS_BARRIER();
                if (t + 1 < T) {
#pragma unroll
                    for (int i = 0; i < 2; ++i) { const int c = tid + 512 * i, key = k0 + 64 + (c >> 4), ch = c & 15;
                        kreg[i] = *(const u32x4*)(kbase + (size_t)key * PROJ_W + ch * 8); vreg[i] = *(const u32x4*)(vbase + (size_t)key * PROJ_W + ch * 8); }
                }
                if (k0 <= qw0 + 15) {
                    f32x4 s[2][4];
                    const float base = -slope2 * (float)(qw0 + fr - k0 - 4 * fq);
#pragma unroll
                    for (int kt = 0; kt < 4; ++kt)
#pragma unroll
                        for (int r = 0; r < 4; ++r) { const float v = base + slope2 * (float)(16 * kt + r); s[0][kt][r] = v; s[1][kt][r] = v; }
#pragma unroll
                    for (int mp = 0; mp < 2; ++mp)
#pragma unroll
                        for (int kt = 0; kt < 4; ++kt)
#pragma unroll
                            for (int ks = 0; ks < 2; ++ks) {
                                const bf16x8 kf = *(const LAS bf16x8*)(lds + (16 * kt + fr) * 256 + (((mp * 8 + ks * 4 + fq) ^ fr) << 4));
                                s[mp][kt] = __builtin_amdgcn_mfma_f32_16x16x32_bf16(kf, qf[mp][ks], s[mp][kt], 0, 0, 0);
                            }
                    if (k0 + 63 > qw0) {
                        const int lim = qw0 + fr - k0 - 4 * fq;
#pragma unroll
                        for (int mp = 0; mp < 2; ++mp)
#pragma unroll
                            for (int kt = 0; kt < 4; ++kt)
#pragma unroll
                                for (int r = 0; r < 4; ++r) if (16 * kt + r > lim) s[mp][kt][r] = -INFINITY;
                    }
                    bf16x8 pb[2][2];
#pragma unroll
                    for (int mp = 0; mp < 2; ++mp) {
                        float mx = fmaxf(fmaxf(s[mp][0][0], s[mp][0][1]), fmaxf(s[mp][0][2], s[mp][0][3]));
#pragma unroll
                        for (int kt = 1; kt < 4; ++kt) mx = fmaxf(mx, fmaxf(fmaxf(s[mp][kt][0], s[mp][kt][1]), fmaxf(s[mp][kt][2], s[mp][kt][3])));
                        mx = xrow16_max(mx);
                        const float mnew = fmaxf(mrun[mp], mx);
                        const float alpha = __builtin_amdgcn_exp2f(mrun[mp] - mnew);
                        mrun[mp] = mnew;
                        float ps = 0.f;
#pragma unroll
                        for (int kt = 0; kt < 4; ++kt)
#pragma unroll
                            for (int r = 0; r < 4; ++r) { const float e = __builtin_amdgcn_exp2f(s[mp][kt][r] - mnew); s[mp][kt][r] = e; ps += e; }
                        lrun[mp] = lrun[mp] * alpha + ps;
#pragma unroll
                        for (int dt = 0; dt < 8; ++dt) o[mp][dt] = o[mp][dt] * alpha;
#pragma unroll
                        for (int ks = 0; ks < 2; ++ks) {
                            u32x4 pk; pk.x = cvtpk(s[mp][2 * ks][0], s[mp][2 * ks][1]); pk.y = cvtpk(s[mp][2 * ks][2], s[mp][2 * ks][3]);
                            pk.z = cvtpk(s[mp][2 * ks + 1][0], s[mp][2 * ks + 1][1]); pk.w = cvtpk(s[mp][2 * ks + 1][2], s[mp][2 * ks + 1][3]);
                            pb[mp][ks] = __builtin_bit_cast(bf16x8, pk);
                        }
                    }
                    const int gl = lane & 15;
                    LAS unsigned char* vrd = lds + ATT_VOFF + (4 * fq + (gl >> 2)) * ATT_VPITCH + (gl & 3) * 8;
#pragma unroll
                    for (int dt = 0; dt < 8; ++dt)
#pragma unroll
                        for (int ks = 0; ks < 2; ++ks) {
                            const v4i16_t v0 = __builtin_amdgcn_ds_read_tr16_b64_v4i16((LAS v4i16_t*)(vrd + (32 * ks) * ATT_VPITCH + dt * 32));
                            const v4i16_t v1 = __builtin_amdgcn_ds_read_tr16_b64_v4i16((LAS v4i16_t*)(vrd + (32 * ks + 16) * ATT_VPITCH + dt * 32));
                            bf16x8 vf; vf[0] = v0[0]; vf[1] = v0[1]; vf[2] = v0[2]; vf[3] = v0[3]; vf[4] = v1[0]; vf[5] = v1[1]; vf[6] = v1[2]; vf[7] = v1[3];
                            o[0][dt] = __builtin_amdgcn_mfma_f32_16x16x32_bf16(vf, pb[0][ks], o[0][dt], 0, 0, 0);
                            o[1][dt] = __builtin_amdgcn_mfma_f32_16x16x32_bf16(vf, pb[1][ks], o[1][dt], 0, 0, 0);
                        }
                }
                LDS_BARRIER();
            }
            const float i1 = 1.f / xrow16_sum(lrun[0]), i2 = lam / xrow16_sum(lrun[1]);
            float ss = 0.f;
#pragma unroll
            for (int dt = 0; dt < 8; ++dt)
#pragma unroll
                for (int r = 0; r < 4; ++r) { const float v = o[0][dt][r] * i1 - o[1][dt][r] * i2; o[0][dt][r] = v; ss += v * v; }
            ss = xrow16_sum(ss);
            const float rn = rsqrtf(ss * (1.f / 128.f) + EPS) * (1.f - lam_init);
            const float* g = p.subln_g + L * 128;
            bf16* orow = obuf + ((size_t)b * SEQ + qw0 + fr) * D + hh * 128;
#pragma unroll
            for (int dt = 0; dt < 8; ++dt) {
                const f32x4 gv = *(const f32x4*)(g + 16 * dt + 4 * fq);
                u32x2 ov; ov.x = pk2(o[0][dt][0] * rn * gv[0], o[0][dt][1] * rn * gv[1]); ov.y = pk2(o[0][dt][2] * rn * gv[2], o[0][dt][3] * rn * gv[3]);
                *(u32x2*)(orow + 16 * dt + 4 * fq) = ov;
            }
        }
    }
}

__device__ void phase_att_queue(const Params& p, int L, LAS unsigned char* lds, int bid, int nblk) {
    const int tid = tidx(), lane = tid & 63;
    const float* lp = p.diff_lambda + L * 256;
    const float d1 = wave_sum(lp[lane] * lp[64 + lane]), d2 = wave_sum(lp[128 + lane] * lp[192 + lane]);
    const float lam_init = 0.8f - 0.6f * __expf(-0.3f * (float)L);
    const float lam = __expf(d1) - __expf(d2) + lam_init;
    unsigned* head = (unsigned*)(p.ws + WS_CTL) + CW_QUEUE + L;
    volatile LAS int* slot = (volatile LAS int*)(lds + LDS_MISC_OFF + 64);
    for (;;) {
        __syncthreads();
        if (tid == 0) *slot = (int)__hip_atomic_fetch_add(head, 1u, __ATOMIC_RELAXED, __HIP_MEMORY_SCOPE_AGENT);
        __syncthreads();
        const int u = *slot;
        if (u >= 512) break;
        att_unit(p, L, lds, tid, (u & 31) >> 2, u & 3, 15 - (u >> 5), lam, lam_init);
    }
}

constexpr size_t GD_WP = WS_ORAW, GD_QD = WS_ORAW + 16 * MiB, GD_AIP = WS_ORAW + 32 * MiB, GD_KDT = WS_ORAW + 40 * MiB, GD_UT = WS_ORAW + 56 * MiB, GD_GL = WS_ORAW + 72 * MiB;
__device__ __forceinline__ int perm_pos(int k) { return (k & ~31) + 8 * ((k >> 2) & 3) + 4 * ((k >> 4) & 1) + (k & 3); }
__device__ __forceinline__ float softplusf_(float x) { if (x > 20.f) return x; const float e = __expf(x); return e < 0.06f ? e * (1.f - e * (0.5f - e * (0.33333334f - 0.25f * e))) : __logf(1.f + e); }
__device__ __forceinline__ float gelu_erf(float v) {
    const float z = fabsf(v) * 0.70710678118654752f, t = 1.f / (1.f + 0.3275911f * z);
    const float pl = t * (0.254829592f + t * (-0.284496736f + t * (1.421413741f + t * (-1.453152027f + t * 1.061405429f))));
    const float er = 1.f - pl * __expf(-z * z);
    return 0.5f * v * (1.f + (v < 0.f ? -er : er));
}

constexpr int GP_KN = 0, GP_QN = 17408, GP_RT = 34816, GP_LM = 71680, GP_TB = 89088, GP_GT = 98304, GP_T0T = 99328;
constexpr int GP_KP = 272, GP_RP = 144, GP_LP = 68, GP_TP = 144;
__device__ void phase_gdn_prep(const Params& p, int L, LAS unsigned char* lds, int bid, int nblk) {
    const int tid = tidx(), lane = tid & 63, w = __builtin_amdgcn_readfirstlane(tid >> 6), fr = lane & 15, fq = lane >> 4;
    const bf16* proj = (const bf16*)(p.ws + WS_PROJ);
    const float* BA = (const float*)(p.ws + WS_BA);
    bf16* WP = (bf16*)(p.ws + GD_WP); bf16* QD = (bf16*)(p.ws + GD_QD); bf16* AIP = (bf16*)(p.ws + GD_AIP); bf16* KDT = (bf16*)(p.ws + GD_KDT); bf16* UT = (bf16*)(p.ws + GD_UT);
    float* GL = (float*)(p.ws + GD_GL);
    const float* cw = p.conv_w + (size_t)L * 4 * 1536;
    LAS float* beta_s = (LAS float*)(lds + GP_GT); LAS float* gc_s = beta_s + 64; LAS float* egc_s = gc_s + 64; LAS float* edl_s = egc_s + 64;
    LAS float* Lm = (LAS float*)(lds + GP_LM);
    for (int item = bid; item < 1024; item += nblk) {
        const int n = item & 31, bh = item >> 5, hh = bh & 3, b = bh >> 2, t0 = n * 64;
        const size_t row0 = (size_t)b * SEQ + t0;
        __syncthreads();
        if (w == 0) {
            const float negA = -__expf(p.a_log[L * 4 + hh]), dtb = p.dt_bias[L * 4 + hh];
            const float bb = BA[(row0 + lane) * 8 + hh], aa = BA[(row0 + lane) * 8 + 4 + hh] + dtb;
            float c = negA * softplusf_(aa);
#pragma unroll
            for (int o = 1; o < 64; o <<= 1) { const float t = __shfl_up(c, o); if (lane >= o) c += t; }
            const float glast = __shfl(c, 63);
            beta_s[lane] = sigmoidf_(bb); gc_s[lane] = c; egc_s[lane] = __expf(c); edl_s[lane] = __expf(glast - c);
            if (lane == 0) GL[item] = __expf(glast);
        }
        __syncthreads();
        {
            const int colq = hh * 128 + 2 * lane;
            unsigned xk[11], xv[11];
#pragma unroll
            for (int r = 0; r < 11; ++r) { const int tt = t0 + 8 * w - 3 + r;
                xk[r] = (tt >= 0) ? *(const unsigned*)(proj + ((size_t)b * SEQ + tt) * PROJ_W + 1536 + 512 + colq) : 0u;
                xv[r] = (tt >= 0) ? *(const unsigned*)(proj + ((size_t)b * SEQ + tt) * PROJ_W + 1536 + 1024 + colq) : 0u; }
            {
                float wq[4][2]; unsigned xq[11];
#pragma unroll
                for (int j = 0; j < 4; ++j) { wq[j][0] = cw[j * 1536 + colq]; wq[j][1] = cw[j * 1536 + colq + 1]; }
#pragma unroll
                for (int r = 0; r < 11; ++r) { const int tt = t0 + 8 * w - 3 + r; xq[r] = (tt >= 0) ? *(const unsigned*)(proj + ((size_t)b * SEQ + tt) * PROJ_W + 1536 + colq) : 0u; }
#pragma unroll
                for (int i = 0; i < 8; ++i) {
                    const int c = 8 * w + i;
                    float q0 = 0.f, q1 = 0.f;
#pragma unroll
                    for (int j = 0; j < 4; ++j) { q0 += wq[j][0] * lo16(xq[i + j]); q1 += wq[j][1] * hi16(xq[i + j]); }
                    q0 *= sigmoidf_(q0); q1 *= sigmoidf_(q1);
                    const float sq = rsqrtf(wave_sum(q0 * q0 + q1 * q1) + EPS) * 0.08838834764831845f;
                    q0 *= sq; q1 *= sq;
                    const float eg = egc_s[c];
                    *(LAS unsigned*)(lds + GP_QN + c * GP_KP + lane * 4) = pk2(q0, q1);
                    *(unsigned*)(QD + ((size_t)item * 64 + c) * 128 + perm_pos(2 * lane)) = pk2(q0 * eg, q1 * eg);
                }
            }
            __builtin_amdgcn_sched_barrier(0);
            {
                float wk[4][2];
#pragma unroll
                for (int j = 0; j < 4; ++j) { wk[j][0] = cw[j * 1536 + 512 + colq]; wk[j][1] = cw[j * 1536 + 512 + colq + 1]; }
                unsigned kd0[8], kd1[8], rk0[8], rk1[8];
#pragma unroll
                for (int i = 0; i < 8; ++i) {
                    const int c = 8 * w + i;
                    float k0 = 0.f, k1 = 0.f;
#pragma unroll
                    for (int j = 0; j < 4; ++j) { k0 += wk[j][0] * lo16(xk[i + j]); k1 += wk[j][1] * hi16(xk[i + j]); }
                    k0 *= sigmoidf_(k0); k1 *= sigmoidf_(k1);
                    const float sk = rsqrtf(wave_sum(k0 * k0 + k1 * k1) + EPS);
                    k0 *= sk; k1 *= sk;
                    const float be = beta_s[c], eg = egc_s[c], ed = edl_s[c];
                    *(LAS unsigned*)(lds + GP_KN + c * GP_KP + lane * 4) = pk2(k0, k1);
                    kd0[i] = f2bf(k0 * ed); kd1[i] = f2bf(k1 * ed);
                    rk0[i] = f2bf(k0 * be * eg); rk1[i] = f2bf(k1 * be * eg);
                }
                u32x4 o;
                o.x = rk0[0] | (rk0[1] << 16); o.y = rk0[2] | (rk0[3] << 16); o.z = rk0[4] | (rk0[5] << 16); o.w = rk0[6] | (rk0[7] << 16); *(LAS u32x4*)(lds + GP_RT + (128 + 2 * lane) * GP_RP + 16 * w) = o;
                o.x = rk1[0] | (rk1[1] << 16); o.y = rk1[2] | (rk1[3] << 16); o.z = rk1[4] | (rk1[5] << 16); o.w = rk1[6] | (rk1[7] << 16); *(LAS u32x4*)(lds + GP_RT + (128 + 2 * lane + 1) * GP_RP + 16 * w) = o;
                const int pa = perm_pos(8 * w), pb = perm_pos(8 * w + 4);
                bf16* kr0 = KDT + ((size_t)item * 128 + 2 * lane) * 64; bf16* kr1 = kr0 + 64;
                u32x2 h2;
                h2.x = kd0[0] | (kd0[1] << 16); h2.y = kd0[2] | (kd0[3] << 16); *(u32x2*)(kr0 + pa) = h2;
                h2.x = kd0[4] | (kd0[5] << 16); h2.y = kd0[6] | (kd0[7] << 16); *(u32x2*)(kr0 + pb) = h2;
                h2.x = kd1[0] | (kd1[1] << 16); h2.y = kd1[2] | (kd1[3] << 16); *(u32x2*)(kr1 + pa) = h2;
                h2.x = kd1[4] | (kd1[5] << 16); h2.y = kd1[6] | (kd1[7] << 16); *(u32x2*)(kr1 + pb) = h2;
            }
            __builtin_amdgcn_sched_barrier(0);
            {
                float wv[4][2];
#pragma unroll
                for (int j = 0; j < 4; ++j) { wv[j][0] = cw[j * 1536 + 1024 + colq]; wv[j][1] = cw[j * 1536 + 1024 + colq + 1]; }
                unsigned rv0[8], rv1[8];
#pragma unroll
                for (int i = 0; i < 8; ++i) {
                    float v0 = 0.f, v1 = 0.f;
#pragma unroll
                    for (int j = 0; j < 4; ++j) { v0 += wv[j][0] * lo16(xv[i + j]); v1 += wv[j][1] * hi16(xv[i + j]); }
                    v0 *= sigmoidf_(v0); v1 *= sigmoidf_(v1);
                    const float be = beta_s[8 * w + i];
                    rv0[i] = f2bf(v0 * be); rv1[i] = f2bf(v1 * be);
                }
                u32x4 o;
                o.x = rv0[0] | (rv0[1] << 16); o.y = rv0[2] | (rv0[3] << 16); o.z = rv0[4] | (rv0[5] << 16); o.w = rv0[6] | (rv0[7] << 16); *(LAS u32x4*)(lds + GP_RT + (2 * lane) * GP_RP + 16 * w) = o;
                o.x = rv1[0] | (rv1[1] << 16); o.y = rv1[2] | (rv1[3] << 16); o.z = rv1[4] | (rv1[5] << 16); o.w = rv1[6] | (rv1[7] << 16); *(LAS u32x4*)(lds + GP_RT + (2 * lane + 1) * GP_RP + 16 * w) = o;
            }
        }
        __syncthreads();
#pragma unroll
        for (int q = 0; q < 2; ++q) {
            const int id = 2 * w + q, ct = id >> 2, st = id & 3;
            if (st <= ct) {
                f32x4 acc = (f32x4){0.f, 0.f, 0.f, 0.f};
#pragma unroll
                for (int ks = 0; ks < 4; ++ks) {
                    const bf16x8 a = *(const LAS bf16x8*)(lds + GP_KN + (16 * ct + fr) * GP_KP + (32 * ks + 8 * fq) * 2);
                    const bf16x8 bb = *(const LAS bf16x8*)(lds + GP_KN + (16 * st + fr) * GP_KP + (32 * ks + 8 * fq) * 2);
                    acc = __builtin_amdgcn_mfma_f32_16x16x32_bf16(a, bb, acc, 0, 0, 0);
                }
                const int s = 16 * st + fr; const float gs = gc_s[s];
#pragma unroll
                for (int r = 0; r < 4; ++r) { const int c = 16 * ct + 4 * fq + r;
                    Lm[c * GP_LP + s] = (s < c) ? beta_s[c] * acc[r] * __expf(fminf(gc_s[c] - gs, 0.f)) : 0.f; }
            }
        }
        __syncthreads();
        if (w < 2) {
            const int o = 32 * w;
            float t[32];
            int zoff = 0; asm volatile("" : "+v"(zoff));
            const LAS float* Lz = Lm + zoff + o * GP_LP + o;
            const int col = lane & 31;
#pragma unroll
            for (int i = 0; i < 32; ++i) {
                float a0 = (i == lane) ? 1.f : 0.f, a1 = 0.f, a2 = 0.f, a3 = 0.f;
#pragma unroll
                for (int s4 = 0; s4 + 4 <= i; s4 += 4) { const f32x4 lv = *(const LAS f32x4*)(Lz + i * GP_LP + s4);
                    a0 -= lv[0] * t[s4]; a1 -= lv[1] * t[s4 + 1]; a2 -= lv[2] * t[s4 + 2]; a3 -= lv[3] * t[s4 + 3]; }
#pragma unroll
                for (int s = i & ~3; s < i; ++s) a0 -= Lz[i * GP_LP + s] * t[s];
                t[i] = (lane < 32) ? (a0 + a1) + (a2 + a3) : 0.f;
                const bf16 tb = (bf16)f2bf(t[i]);
                if (w == 0) { *(LAS bf16*)(lds + GP_TB + i * GP_TP + lane * 2) = tb;
                              if (lane < 32) *(LAS bf16*)(lds + GP_T0T + lane * 80 + i * 2) = tb; }
                else if (lane < 32) *(LAS bf16*)(lds + GP_TB + (32 + i) * GP_TP + (32 + col) * 2) = tb;
                if ((i & 3) == 3) __builtin_amdgcn_sched_barrier(0);
            }
        } else {
            for (int id = w - 2; id < 16; id += 6) {
                const int ct = id >> 2, st = id & 3;
                f32x4 acc = (f32x4){0.f, 0.f, 0.f, 0.f};
                if (st <= ct) {
#pragma unroll
                    for (int ks = 0; ks < 4; ++ks) {
                        const bf16x8 a = *(const LAS bf16x8*)(lds + GP_QN + (16 * ct + fr) * GP_KP + (32 * ks + 8 * fq) * 2);
                        const bf16x8 bb = *(const LAS bf16x8*)(lds + GP_KN + (16 * st + fr) * GP_KP + (32 * ks + 8 * fq) * 2);
                        acc = __builtin_amdgcn_mfma_f32_16x16x32_bf16(a, bb, acc, 0, 0, 0);
                    }
                }
                const int s = 16 * st + fr; const float gs = gc_s[s]; const int ps = perm_pos(s);
#pragma unroll
                for (int r = 0; r < 4; ++r) { const int c = 16 * ct + 4 * fq + r;
                    const float v = (s <= c) ? acc[r] * __expf(fminf(gc_s[c] - gs, 0.f)) : 0.f;
                    AIP[((size_t)item * 64 + c) * 64 + ps] = (bf16)f2bf(v); }
            }
        }
        __syncthreads();
        if (w == 0) {
            f32x4 P[2][2];
#pragma unroll
            for (int it = 0; it < 2; ++it) {
                const LAS float* lr = Lm + (32 + 16 * it + fr) * GP_LP + 8 * fq;
                const f32x4 l0 = *(const LAS f32x4*)lr, l1 = *(const LAS f32x4*)(lr + 4);
                u32x4 pk; pk.x = cvtpk(l0[0], l0[1]); pk.y = cvtpk(l0[2], l0[3]); pk.z = cvtpk(l1[0], l1[1]); pk.w = cvtpk(l1[2], l1[3]);
                const bf16x8 a = __builtin_bit_cast(bf16x8, pk);
#pragma unroll
                for (int jt = 0; jt < 2; ++jt) {
                    const bf16x8 bb = *(const LAS bf16x8*)(lds + GP_T0T + (16 * jt + fr) * 80 + 16 * fq);
                    P[it][jt] = __builtin_amdgcn_mfma_f32_16x16x32_bf16(a, bb, (f32x4){0.f, 0.f, 0.f, 0.f}, 0, 0, 0);
                }
            }
#pragma unroll
            for (int jt = 0; jt < 2; ++jt) {
                u32x4 pk; pk.x = cvtpk(P[0][jt][0], P[0][jt][1]); pk.y = cvtpk(P[0][jt][2], P[0][jt][3]); pk.z = cvtpk(P[1][jt][0], P[1][jt][1]); pk.w = cvtpk(P[1][jt][2], P[1][jt][3]);
                const bf16x8 pb = __builtin_bit_cast(bf16x8, pk);
#pragma unroll
                for (int i2 = 0; i2 < 2; ++i2) {
                    const LAS unsigned char* tr = lds + GP_TB + (32 + 16 * i2 + fr) * GP_TP + (32 + 4 * fq) * 2;
                    const u32x2 ta = *(const LAS u32x2*)tr, tb2 = *(const LAS u32x2*)(tr + 32);
                    u32x4 ak; ak.x = ta.x; ak.y = ta.y; ak.z = tb2.x; ak.w = tb2.y;
                    const f32x4 r = __builtin_amdgcn_mfma_f32_16x16x32_bf16(__builtin_bit_cast(bf16x8, ak), pb, (f32x4){0.f, 0.f, 0.f, 0.f}, 0, 0, 0);
#pragma unroll
                    for (int q = 0; q < 4; ++q) *(LAS bf16*)(lds + GP_TB + (32 + 16 * i2 + 4 * fq + q) * GP_TP + (16 * jt + fr) * 2) = (bf16)f2bf(-r[q]);
                }
            }
        }
        __syncthreads();
#pragma unroll
        for (int q = 0; q < 2; ++q) {
            const int colt = 2 * w + q;
            bf16x8 af[2];
#pragma unroll
            for (int ks = 0; ks < 2; ++ks) af[ks] = *(const LAS bf16x8*)(lds + GP_RT + (16 * colt + fr) * GP_RP + (32 * ks + 8 * fq) * 2);
#pragma unroll
            for (int ct = 0; ct < 4; ++ct) {
                f32x4 acc = (f32x4){0.f, 0.f, 0.f, 0.f};
#pragma unroll
                for (int ks = 0; ks < 2; ++ks) {
                    const bf16x8 bb = *(const LAS bf16x8*)(lds + GP_TB + (16 * ct + fr) * GP_TP + (32 * ks + 8 * fq) * 2);
                    acc = __builtin_amdgcn_mfma_f32_16x16x32_bf16(af[ks], bb, acc, 0, 0, 0);
                }
                const int c = 16 * ct + fr;
                if (colt < 8) {
#pragma unroll
                    for (int r = 0; r < 4; ++r) UT[((size_t)item * 128 + 16 * colt + 4 * fq + r) * 64 + c] = (bf16)f2bf(acc[r]);
                } else {
                    const int kt = colt - 8;
                    u32x2 h2; h2.x = pk2(-acc[0], -acc[1]); h2.y = pk2(-acc[2], -acc[3]);
                    *(u32x2*)(WP + ((size_t)item * 64 + c) * 128 + 32 * (kt >> 1) + 8 * fq + 4 * (kt & 1)) = h2;
                }
            }
        }
    }
    __syncthreads();
}

constexpr int GS_WP = 0, GS_QD = 17408, GS_AIP = 34816, GS_KDT = 44032, GS_BUF = 62464, GS_OB = 2 * GS_BUF, GS_OBP = 272;
__device__ void phase_gdn_scan(const Params& p, int L, LAS unsigned char* lds, int bid, int nblk) {
    const int tid = tidx(), lane = tid & 63, w = __builtin_amdgcn_readfirstlane(tid >> 6), fr = lane & 15, fq = lane >> 4;
    const bf16* proj = (const bf16*)(p.ws + WS_PROJ);
    const bf16* WP = (const bf16*)(p.ws + GD_WP); const bf16* QD = (const bf16*)(p.ws + GD_QD); const bf16* AIP = (const bf16*)(p.ws + GD_AIP);
    const bf16* KDT = (const bf16*)(p.ws + GD_KDT); const bf16* UT = (const bf16*)(p.ws + GD_UT); const float* GL = (const float*)(p.ws + GD_GL);
    bf16* obuf = (bf16*)(p.ws + WS_OBUF);
    for (int item = bid; item < 32; item += nblk) {
        const int hh = item & 3, b = item >> 2;
        const int fc = tid >> 4, fv = tid & 15;
        float gn[8];
#pragma unroll
        for (int i = 0; i < 8; ++i) gn[i] = p.gdn_norm_g[L * 128 + 8 * fv + i];
        f32x4 S[8];
#pragma unroll
        for (int kt = 0; kt < 8; ++kt) S[kt] = (f32x4){0.f, 0.f, 0.f, 0.f};
        u32x4 st[7];
        auto gload = [&](int ci) {
#pragma unroll
            for (int i = 0; i < 7; ++i) {
                const int pc = tid + 512 * i;
                const bf16* src;
                if (i < 2) src = WP + (size_t)ci * 8192 + pc * 8;
                else if (i < 4) src = QD + (size_t)ci * 8192 + (pc - 1024) * 8;
                else if (i < 5) src = AIP + (size_t)ci * 4096 + (pc - 2048) * 8;
                else src = KDT + (size_t)ci * 8192 + (pc - 2560) * 8;
                st[i] = *(const u32x4*)src;
            }
        };
        auto lstore = [&](int buf) {
#pragma unroll
            for (int i = 0; i < 7; ++i) {
                const int pc = tid + 512 * i;
                int off;
                if (i < 2) off = GS_WP + (pc >> 4) * 272 + (pc & 15) * 16;
                else if (i < 4) { const int q = pc - 1024; off = GS_QD + (q >> 4) * 272 + (q & 15) * 16; }
                else if (i < 5) { const int q = pc - 2048; off = GS_AIP + (q >> 3) * 144 + (q & 7) * 16; }
                else { const int q = pc - 2560; off = GS_KDT + (q >> 3) * 144 + (q & 7) * 16; }
                *(LAS u32x4*)(lds + buf * GS_BUF + off) = st[i];
            }
        };
        __syncthreads();
        gload(item * 32); lstore(0);
        u32x2 ut[4]; float gl;
        {
            const int ci = item * 32;
#pragma unroll
            for (int ct = 0; ct < 4; ++ct) ut[ct] = *(const u32x2*)(UT + ((size_t)ci * 128 + 16 * w + fr) * 64 + 16 * ct + 4 * fq);
            gl = GL[ci];
        }
        __syncthreads();
        for (int n = 0; n < 32; ++n) {
            const int ci = item * 32 + n, buf = n & 1;
            const size_t rowc = (size_t)b * SEQ + n * 64;
            u32x2 utn[4]; float gln = 0.f;
            if (n + 1 < 32) {
                gload(ci + 1);
#pragma unroll
                for (int ct = 0; ct < 4; ++ct) utn[ct] = *(const u32x2*)(UT + ((size_t)(ci + 1) * 128 + 16 * w + fr) * 64 + 16 * ct + 4 * fq);
                gln = GL[ci + 1];
            }
            u32x4 zq[2];
#pragma unroll
            for (int ps = 0; ps < 2; ++ps) zq[ps] = *(const u32x4*)(proj + (rowc + 32 * ps + fc) * PROJ_W + 3072 + hh * 128 + 8 * fv);
            f32x4 vn[4], oacc[4];
#pragma unroll
            for (int ct = 0; ct < 4; ++ct) { vn[ct] = (f32x4){lo16(ut[ct].x), hi16(ut[ct].x), lo16(ut[ct].y), hi16(ut[ct].y)}; oacc[ct] = (f32x4){0.f, 0.f, 0.f, 0.f}; }
            bf16x8 sb[4];
#pragma unroll
            for (int ks = 0; ks < 4; ++ks) { u32x4 pk; pk.x = cvtpk(S[2 * ks][0], S[2 * ks][1]); pk.y = cvtpk(S[2 * ks][2], S[2 * ks][3]); pk.z = cvtpk(S[2 * ks + 1][0], S[2 * ks + 1][1]); pk.w = cvtpk(S[2 * ks + 1][2], S[2 * ks + 1][3]);
                sb[ks] = __builtin_bit_cast(bf16x8, pk); }
            LAS unsigned char* bb = lds + buf * GS_BUF;
            bf16x8 f0[8], f1[8];
#define LD_A(F, ct) do { _Pragma("unroll") for (int ks = 0; ks < 4; ++ks) { F[ks] = *(const LAS bf16x8*)(bb + GS_WP + (16 * (ct) + fr) * 272 + (32 * ks + 8 * fq) * 2); \
                    F[4 + ks] = *(const LAS bf16x8*)(bb + GS_QD + (16 * (ct) + fr) * 272 + (32 * ks + 8 * fq) * 2); } } while (0)
#define MM_A(F, ct) do { _Pragma("unroll") for (int ks = 0; ks < 4; ++ks) { vn[ct] = __builtin_amdgcn_mfma_f32_16x16x32_bf16(F[ks], sb[ks], vn[ct], 0, 0, 0); \
                    oacc[ct] = __builtin_amdgcn_mfma_f32_16x16x32_bf16(F[4 + ks], sb[ks], oacc[ct], 0, 0, 0); } } while (0)
#define SBAR() __builtin_amdgcn_sched_barrier(0)
            LD_A(f0, 0); SBAR();
            LD_A(f1, 1); MM_A(f0, 0); SBAR();
            LD_A(f0, 2); MM_A(f1, 1); SBAR();
            LD_A(f1, 3); MM_A(f0, 2); SBAR();
#pragma unroll
            for (int ct = 0; ct < 4; ++ct)
#pragma unroll
                for (int ss = 0; ss < 2; ++ss) f0[2 * ct + ss] = *(const LAS bf16x8*)(bb + GS_AIP + (16 * ct + fr) * 144 + (32 * ss + 8 * fq) * 2);
            MM_A(f1, 3); SBAR();
            bf16x8 vb[2];
#pragma unroll
            for (int ss = 0; ss < 2; ++ss) { u32x4 pk; pk.x = cvtpk(vn[2 * ss][0], vn[2 * ss][1]); pk.y = cvtpk(vn[2 * ss][2], vn[2 * ss][3]); pk.z = cvtpk(vn[2 * ss + 1][0], vn[2 * ss + 1][1]); pk.w = cvtpk(vn[2 * ss + 1][2], vn[2 * ss + 1][3]);
                vb[ss] = __builtin_bit_cast(bf16x8, pk); }
#pragma unroll
            for (int kt = 0; kt < 4; ++kt)
#pragma unroll
                for (int ss = 0; ss < 2; ++ss) f1[2 * kt + ss] = *(const LAS bf16x8*)(bb + GS_KDT + (16 * kt + fr) * 144 + (32 * ss + 8 * fq) * 2);
#pragma unroll
            for (int ct = 0; ct < 4; ++ct)
#pragma unroll
                for (int ss = 0; ss < 2; ++ss) oacc[ct] = __builtin_amdgcn_mfma_f32_16x16x32_bf16(f0[2 * ct + ss], vb[ss], oacc[ct], 0, 0, 0);
            SBAR();
#pragma unroll
            for (int kt = 4; kt < 8; ++kt)
#pragma unroll
                for (int ss = 0; ss < 2; ++ss) f0[2 * (kt - 4) + ss] = *(const LAS bf16x8*)(bb + GS_KDT + (16 * kt + fr) * 144 + (32 * ss + 8 * fq) * 2);
#pragma unroll
            for (int kt = 0; kt < 4; ++kt) {
                S[kt] = S[kt] * gl;
#pragma unroll
                for (int ss = 0; ss < 2; ++ss) S[kt] = __builtin_amdgcn_mfma_f32_16x16x32_bf16(f1[2 * kt + ss], vb[ss], S[kt], 0, 0, 0);
            }
            SBAR();
#pragma unroll
            for (int kt = 4; kt < 8; ++kt) {
                S[kt] = S[kt] * gl;
#pragma unroll
                for (int ss = 0; ss < 2; ++ss) S[kt] = __builtin_amdgcn_mfma_f32_16x16x32_bf16(f0[2 * (kt - 4) + ss], vb[ss], S[kt], 0, 0, 0);
            }
#undef LD_A
#undef MM_A
#undef SBAR
            LDS_BARRIER();
#pragma unroll
            for (int ct = 0; ct < 4; ++ct)
#pragma unroll
                for (int r = 0; r < 4; r += 2) {
                    const unsigned pk = cvtpk(oacc[ct][r], oacc[ct][r + 1]);
                    *(LAS bf16*)(lds + GS_OB + (16 * ct + 4 * fq + r) * GS_OBP + (16 * w + fr) * 2) = (bf16)(pk & 0xffffu);
                    *(LAS bf16*)(lds + GS_OB + (16 * ct + 4 * fq + r + 1) * GS_OBP + (16 * w + fr) * 2) = (bf16)(pk >> 16);
                }
            if (n + 1 < 32) {
                lstore(buf ^ 1);
#pragma unroll
                for (int ct = 0; ct < 4; ++ct) ut[ct] = utn[ct];
                gl = gln;
            }
            LDS_BARRIER();
#pragma unroll
            for (int ps = 0; ps < 2; ++ps) {
                const int c = 32 * ps + fc;
                const u32x4 ov = *(const LAS u32x4*)(lds + GS_OB + c * GS_OBP + fv * 16);
                float o8[8];
#pragma unroll
                for (int i = 0; i < 4; ++i) { o8[2 * i] = lo16(ov[i]); o8[2 * i + 1] = hi16(ov[i]); }
                float ss = 0.f;
#pragma unroll
                for (int i = 0; i < 8; ++i) ss += o8[i] * o8[i];
                const float rn = rsqrtf(row16_sum(ss) * (1.f / 128.f) + EPS);
                u32x4 res;
#pragma unroll
                for (int i = 0; i < 4; ++i) {
                    const float z0 = lo16(zq[ps][i]), z1 = hi16(zq[ps][i]);
                    res[i] = cvtpk(o8[2 * i] * rn * gn[2 * i] * (z0 * sigmoidf_(z0)), o8[2 * i + 1] * rn * gn[2 * i + 1] * (z1 * sigmoidf_(z1)));
                }
                *(u32x4*)(obuf + (rowc + c) * D + 512 + hh * 128 + 8 * fv) = res;
            }
        }
        __syncthreads();
    }
}

__device__ __forceinline__ unsigned sortable(float f) { const unsigned u = __float_as_uint(f); return u ^ ((unsigned)((int)u >> 31) | 0x80000000u); }
__device__ __forceinline__ float unsortable(unsigned s) { return __uint_as_float((s & 0x80000000u) ? (s ^ 0x80000000u) : ~s); }
#define CE(a, b) do { const unsigned _x = k[a], _y = k[b]; k[a] = _x > _y ? _x : _y; k[b] = _x > _y ? _y : _x; } while (0)
constexpr int PE_TK = 0, PE_TAB = 8192, PE_ID = 8448, PE_GT = PE_ID + 32768, PE_SK = PE_GT + 32768;
__device__ void phase_peer(const Params& p, int L, LAS unsigned char* lds, int bid, int nblk) {
    const int tid = tidx(), lane = tid & 63, w = __builtin_amdgcn_readfirstlane(tid >> 6), fr = lane & 15, fq = lane >> 4;
    const bf16* Q2 = (const bf16*)(p.ws + WS_Q2);
    const bf16* SK = (const bf16*)(p.ws + WS_SK) + (size_t)L * 8 * 2 * 128 * 128;
    float* H = (float*)(p.ws + WS_H); bf16* HB2 = (bf16*)(p.ws + WS_HB2);
    const unsigned char* U = p.ws + WS_U + (size_t)L * NEXP * D;
    const unsigned char* V = p.ws + WS_V + (size_t)L * NEXP * D;
    const float* SU = (const float*)(p.ws + WS_SU) + (size_t)L * NEXP; const float* SV = (const float*)(p.ws + WS_SV) + (size_t)L * NEXP;
    const float* g = p.ln_ffn_g + L * D;
    LAS unsigned* TK = (LAS unsigned*)(lds + PE_TK);
    LAS unsigned short* TAB = (LAS unsigned short*)(lds + PE_TAB);
    LAS int* IDL = (LAS int*)(lds + PE_ID); LAS float* GTL = (LAS float*)(lds + PE_GT);
    if (tid < 64) {
        int a = 0, base = 0, q = tid; unsigned short v = 0xffff;
        if (q < 50) { for (;;) { const int cnt = 16 / (a + 1); if (q < base + cnt) break; base += cnt; ++a; } v = (unsigned short)((a << 8) | (q - base)); }
        TAB[tid] = v;
    }
    for (int item = bid; item < M / 64; item += nblk) {
        const int tok0 = item * 64;
        __syncthreads();
        const int tg = w & 3, cc = w >> 2;
#define SK_FETCH(hd) do { _Pragma("unroll") for (int i = 0; i < 8; ++i) { const int pc = tid + 512 * i, nn = (pc >> 4) & 127; \
            __builtin_amdgcn_global_load_lds((const unsigned*)(SK + ((size_t)((hd) * 2 + (pc >> 11)) * 128 + nn) * 128 + (((pc & 15) ^ (nn & 15)) * 8)), \
                                             (LAS unsigned*)(lds + PE_SK + (w * 64 + 512 * i) * 16), 16, 0, 0); } } while (0)
        SK_FETCH(0);
        asm volatile("s_waitcnt vmcnt(0)" ::: "memory");
        __syncthreads();
        for (int hh = 0; hh < 8; ++hh) {
            {
                f32x4 acc[8];
#pragma unroll
                for (int nt = 0; nt < 8; ++nt) acc[nt] = (f32x4){0.f, 0.f, 0.f, 0.f};
                bf16x8 qa[4];
#pragma unroll
                for (int ks = 0; ks < 4; ++ks) qa[ks] = *(const bf16x8*)(Q2 + (size_t)(tok0 + 16 * tg + fr) * 2048 + hh * 256 + cc * 128 + 32 * ks + 8 * fq);
                const LAS unsigned char* skb = lds + PE_SK + cc * 32768 + fr * 256;
#pragma unroll
                for (int nt = 0; nt < 8; ++nt)
#pragma unroll
                    for (int ks = 0; ks < 4; ++ks) {
                        const bf16x8 kb = *(const LAS bf16x8*)(skb + nt * 4096 + (((4 * ks + fq) ^ fr) << 4));
                        acc[nt] = __builtin_amdgcn_mfma_f32_16x16x32_bf16(qa[ks], kb, acc[nt], 0, 0, 0);
                    }
#pragma unroll
                for (int r = 0; r < 4; ++r) {
                    unsigned k[8];
#pragma unroll
                    for (int nt = 0; nt < 8; ++nt) k[nt] = (sortable(acc[nt][r]) & ~0x7Fu) | (unsigned)(127 - (16 * nt + fr));
                    CE(0, 1); CE(2, 3); CE(4, 5); CE(6, 7); CE(0, 2); CE(1, 3); CE(4, 6); CE(5, 7); CE(1, 2); CE(5, 6); CE(0, 4); CE(3, 7);
                    CE(1, 5); CE(2, 6); CE(1, 4); CE(3, 6); CE(2, 4); CE(3, 5); CE(3, 4);
                    unsigned res = 0u;
#pragma unroll
                    for (int rd = 0; rd < 16; ++rd) {
                        const unsigned m = row16_umax(k[0]);
                        const bool win = k[0] == m;
#pragma unroll
                        for (int i = 0; i < 7; ++i) k[i] = win ? k[i + 1] : k[i];
                        k[7] = win ? 0u : k[7];
                        res = (fr == rd) ? m : res;
                    }
                    TK[(cc * 64 + 16 * tg + 4 * fq + r) * 16 + fr] = res;
                }
            }
            __syncthreads();
            if (hh + 1 < 8) SK_FETCH(hh + 1);
#pragma unroll
            for (int ps = 0; ps < 2; ++ps) {
                const int tl = 8 * w + 4 * ps + fq;
                unsigned k[4];
#pragma unroll
                for (int sl = 0; sl < 4; ++sl) {
                    const int q = sl * 16 + fr;
                    const unsigned ab = TAB[q];
                    const unsigned k1 = TK[tl * 16 + ((ab >> 8) & 15)], k2 = TK[(64 + tl) * 16 + (ab & 15)];
                    const float v = unsortable(k1 & ~0x7Fu) + unsortable(k2 & ~0x7Fu);
                    k[sl] = (q < 50) ? ((sortable(v) & ~0x3Fu) | (unsigned)(63 - q)) : 0u;
                }
                CE(0, 1); CE(2, 3); CE(0, 2); CE(1, 3); CE(1, 2);
                unsigned res = 0u;
#pragma unroll
                for (int rd = 0; rd < 16; ++rd) {
                    const unsigned m = row16_umax(k[0]);
                    const bool win = k[0] == m;
                    k[0] = win ? k[1] : k[0]; k[1] = win ? k[2] : k[1]; k[2] = win ? k[3] : k[2]; k[3] = win ? 0u : k[3];
                    res = (fr == rd) ? m : res;
                }
                const unsigned ab = TAB[63 - (res & 0x3Fu)];
                const unsigned k1 = TK[tl * 16 + ((ab >> 8) & 15)], k2 = TK[(64 + tl) * 16 + (ab & 15)];
                const float v = unsortable(k1 & ~0x7Fu) + unsortable(k2 & ~0x7Fu);
                const float e = __expf(v - row16_max(v));
                const float sum = row16_sum(e);
                IDL[tl * 128 + hh * 16 + fr] = (int)((127u - (k1 & 0x7Fu)) * 128u + (127u - (k2 & 0x7Fu)));
                GTL[tl * 128 + hh * 16 + fr] = e / sum;
            }
            asm volatile("s_waitcnt vmcnt(0)" ::: "memory");
            __syncthreads();
        }
#undef SK_FETCH
        for (int ti = 0; ti < 8; ++ti) {
            const int tl = 8 * w + ti, tok = tok0 + tl;
            const float* hrow = H + (size_t)tok * D + 16 * lane;
            float xn[16];
#pragma unroll
            for (int j = 0; j < 4; ++j) { const f32x4 a = *(const f32x4*)(hrow + 4 * j); xn[4 * j] = a[0]; xn[4 * j + 1] = a[1]; xn[4 * j + 2] = a[2]; xn[4 * j + 3] = a[3]; }
            float ss = 0.f;
#pragma unroll
            for (int i = 0; i < 16; ++i) ss += xn[i] * xn[i];
            const float rstd = rsqrtf(wave_sum(ss) * (1.f / D) + EPS);
            float mx = 0.f;
#pragma unroll
            for (int i = 0; i < 16; ++i) { xn[i] = xn[i] * rstd * g[16 * lane + i]; mx = fmaxf(mx, fabsf(xn[i])); }
            mx = xrow16_max(row16_max(mx));
            const float xinv = mx > 0.f ? 127.f / mx : 0.f, sx = mx * (1.f / 127.f);
            int xq[4];
#pragma unroll
            for (int j = 0; j < 4; ++j) xq[j] = (int)(((unsigned)__float2int_rn(xn[4 * j] * xinv) & 0xffu) | (((unsigned)__float2int_rn(xn[4 * j + 1] * xinv) & 0xffu) << 8) |
                                                      (((unsigned)__float2int_rn(xn[4 * j + 2] * xinv) & 0xffu) << 16) | ((unsigned)__float2int_rn(xn[4 * j + 3] * xinv) << 24));
            const int id0 = IDL[tl * 128 + lane], id1 = IDL[tl * 128 + 64 + lane];
            const float su0 = SU[id0], su1 = SU[id1], sv0 = SV[id0], sv1 = SV[id1];
            int h0i = 0, h1i = 0;
            u32x4 ring[16];
#pragma unroll
            for (int j = 0; j < 16; ++j) ring[j] = *(const u32x4*)(U + (size_t)IDL[tl * 128 + j] * D + 16 * lane);
#pragma unroll 1
            for (int k = 0; k < 8; ++k) {
#pragma unroll
                for (int j = 0; j < 16; ++j) {
                    const u32x4 a = ring[j];
                    if (k < 7) ring[j] = *(const u32x4*)(U + (size_t)IDL[tl * 128 + 16 * (k + 1) + j] * D + 16 * lane);
                    int d = __builtin_amdgcn_sdot4((int)a[0], xq[0], 0, false);
                    d = __builtin_amdgcn_sdot4((int)a[1], xq[1], d, false); d = __builtin_amdgcn_sdot4((int)a[2], xq[2], d, false); d = __builtin_amdgcn_sdot4((int)a[3], xq[3], d, false);
                    d = wave_isum(d);
                    const int e = 16 * k + j;
                    if (lane == (e & 63)) { if (k < 4) h0i = d; else h1i = d; }
                }
            }
            const float h0 = su0 * sx * (float)h0i, h1 = su1 * sx * (float)h1i;
            GTL[tl * 128 + lane] = sv0 * GTL[tl * 128 + lane] * gelu_erf(h0);
            GTL[tl * 128 + 64 + lane] = sv1 * GTL[tl * 128 + 64 + lane] * gelu_erf(h1);
        }
        for (int ti = 0; ti < 8; ++ti) {
            const int tl = 8 * w + ti, tok = tok0 + tl;
            float* hrow = H + (size_t)tok * D + 16 * lane;
            float xv[16];
#pragma unroll
            for (int j = 0; j < 4; ++j) { const f32x4 a = *(const f32x4*)(hrow + 4 * j); xv[4 * j] = a[0]; xv[4 * j + 1] = a[1]; xv[4 * j + 2] = a[2]; xv[4 * j + 3] = a[3]; }
            const float w0 = GTL[tl * 128 + lane], w1 = GTL[tl * 128 + 64 + lane];
            const float wmx = xrow16_max(row16_max(fmaxf(fabsf(w0), fabsf(w1))));
            const float winv = wmx > 0.f ? 127.f / wmx : 0.f, sw = wmx * (1.f / 127.f);
            const f32x4 wv = *(const LAS f32x4*)(GTL + tl * 128 + 4 * (lane & 31));
            const int wq = (int)(((unsigned)__float2int_rn(wv[0] * winv) & 0xffu) | (((unsigned)__float2int_rn(wv[1] * winv) & 0xffu) << 8) |
                                 (((unsigned)__float2int_rn(wv[2] * winv) & 0xffu) << 16) | ((unsigned)__float2int_rn(wv[3] * winv) << 24));
            int yi[16];
#pragma unroll
            for (int i = 0; i < 16; ++i) yi[i] = 0;
            u32x4 ring[16];
#pragma unroll
            for (int j = 0; j < 16; ++j) ring[j] = *(const u32x4*)(V + (size_t)IDL[tl * 128 + j] * D + 16 * lane);
#pragma unroll 1
            for (int k = 0; k < 8; ++k) {
#pragma unroll
                for (int g4 = 0; g4 < 4; ++g4) {
                    const u32x4 a0 = ring[4 * g4], a1 = ring[4 * g4 + 1], a2 = ring[4 * g4 + 2], a3 = ring[4 * g4 + 3];
                    if (k < 7) {
#pragma unroll
                        for (int q = 0; q < 4; ++q) ring[4 * g4 + q] = *(const u32x4*)(V + (size_t)IDL[tl * 128 + 16 * (k + 1) + 4 * g4 + q] * D + 16 * lane);
                    }
                    const int wg = __builtin_amdgcn_readlane(wq, 4 * k + g4);
#pragma unroll
                    for (int q = 0; q < 4; ++q) {
                        const unsigned p0 = __builtin_amdgcn_perm(a1[q], a0[q], 0x05010400u), p1 = __builtin_amdgcn_perm(a1[q], a0[q], 0x07030602u);
                        const unsigned p2 = __builtin_amdgcn_perm(a3[q], a2[q], 0x05010400u), p3 = __builtin_amdgcn_perm(a3[q], a2[q], 0x07030602u);
                        yi[4 * q] = __builtin_amdgcn_sdot4((int)__builtin_amdgcn_perm(p2, p0, 0x05040100u), wg, yi[4 * q], false);
                        yi[4 * q + 1] = __builtin_amdgcn_sdot4((int)__builtin_amdgcn_perm(p2, p0, 0x07060302u), wg, yi[4 * q + 1], false);
                        yi[4 * q + 2] = __builtin_amdgcn_sdot4((int)__builtin_amdgcn_perm(p3, p1, 0x05040100u), wg, yi[4 * q + 2], false);
                        yi[4 * q + 3] = __builtin_amdgcn_sdot4((int)__builtin_amdgcn_perm(p3, p1, 0x07060302u), wg, yi[4 * q + 3], false);
                    }
                }
            }
            float y[16];
#pragma unroll
            for (int i = 0; i < 16; ++i) y[i] = xv[i] + sw * (float)yi[i];
#pragma unroll
            for (int j = 0; j < 4; ++j) *(f32x4*)(hrow + 4 * j) = (f32x4){y[4 * j], y[4 * j + 1], y[4 * j + 2], y[4 * j + 3]};
            bf16* hb = HB2 + (size_t)tok * D + 16 * lane;
            u32x4 o; o.x = pk2(y[0], y[1]); o.y = pk2(y[2], y[3]); o.z = pk2(y[4], y[5]); o.w = pk2(y[6], y[7]);
            *(u32x4*)hb = o;
            o.x = pk2(y[8], y[9]); o.y = pk2(y[10], y[11]); o.z = pk2(y[12], y[13]); o.w = pk2(y[14], y[15]);
            *(u32x4*)(hb + 8) = o;
        }
    }
    __syncthreads();
}
#undef CE

__device__ void phase_final(const Params& p, int bid, int nblk) {
    const int tid = tidx(), lane = tid & 63, gw = bid * NWAVES + (tid >> 6), NGW = nblk * NWAVES;
    const float* H = (const float*)(p.ws + WS_H);
    for (int m = gw; m < M; m += NGW) {
        f32x4 v[4]; float ss = 0.f;
#pragma unroll
        for (int j = 0; j < 4; ++j) { v[j] = ((const f32x4*)(H + (size_t)m * D))[lane + 64 * j]; ss += (v[j][0] * v[j][0] + v[j][1] * v[j][1]) + (v[j][2] * v[j][2] + v[j][3] * v[j][3]); }
        const float r = rsqrtf(wave_sum(ss) * (1.f / D) + EPS);
#pragma unroll
        for (int j = 0; j < 4; ++j) { const f32x4 gv = ((const f32x4*)p.final_g)[lane + 64 * j]; ((f32x4*)(p.out + (size_t)m * D))[lane + 64 * j] = v[j] * r * gv; }
    }
}

#define XB_TMO      128
#define XB_XCNT(j)  (256  + 64 * (j))
#define XB_XSUB(j)  (1280 + 64 * (j))
#define XB_XGEN(j)  (2304 + 64 * (j))
#define XB_TOP      3328
#define XB_TOPGEN   3392
#define XCD_BAR_WORDS 3456
#define XB_SPIN_CAP (1u << 22)
__device__ __forceinline__ unsigned xb_ld(unsigned* p)              { return __hip_atomic_load(p, __ATOMIC_RELAXED, __HIP_MEMORY_SCOPE_AGENT); }
__device__ __forceinline__ unsigned xb_add(unsigned* p, unsigned v) { return __hip_atomic_fetch_add(p, v, __ATOMIC_RELAXED, __HIP_MEMORY_SCOPE_AGENT); }
__device__ __forceinline__ unsigned xb_xcc_id() { return (unsigned)__builtin_amdgcn_s_getreg((3 << 11) | 20) & 0xFu; }
#define XB_SPIN(cond, bar) do { unsigned _sp = 0; while (cond) { __builtin_amdgcn_s_sleep(1); \
    if ((++_sp & 255u) == 0u) { if (xb_ld(&(bar)[XB_TMO])) break; if (_sp > XB_SPIN_CAP) { atomicAdd(&(bar)[XB_TMO], 1u); break; } } } } while (0)
struct XcdBarrier { unsigned* bar; unsigned x; volatile LAS unsigned* st; };
__device__ __forceinline__ XcdBarrier xcd_barrier_post(unsigned* bar, volatile LAS unsigned* st) {
    XcdBarrier b; b.bar = bar; b.x = xb_xcc_id(); b.st = st;
    if (threadIdx.x == 0) (void)xb_add(&bar[XB_XCNT(b.x)], 1u);
    return b;
}
__device__ __forceinline__ void xcd_barrier_complete(unsigned* bar, unsigned x, unsigned& nloc, unsigned& nx) {
    const unsigned G = gridDim.x * gridDim.y * gridDim.z;
    unsigned sum, cnt, mine, sp = 0u;
    for (;;) {
        sum = 0u; cnt = 0u; mine = 0u;
#pragma unroll
        for (unsigned j = 0; j < 16; ++j) { const unsigned c = xb_ld(&bar[XB_XCNT(j)]); sum += c; cnt += (c > 0u) ? 1u : 0u; mine = (j == x) ? c : mine; }
        if (sum == G) break;
        __builtin_amdgcn_s_sleep(1);
        if ((++sp & 255u) == 0u) { if (xb_ld(&bar[XB_TMO])) break; if (sp > XB_SPIN_CAP) { atomicAdd(&bar[XB_TMO], 1u); break; } }
    }
    nloc = mine > 0u ? mine : 1u; nx = cnt > 0u ? cnt : 1u;
}
__device__ __forceinline__ void xcd_barrier(const XcdBarrier& b) {
    asm volatile("s_waitcnt vmcnt(0)" ::: "memory");
    __syncthreads();
    if (threadIdx.x == 0) {
        unsigned* bar = b.bar;
        __builtin_amdgcn_s_waitcnt(0);
        unsigned nloc = b.st[0], nx = b.st[1];
        if (nloc == 0u) { xcd_barrier_complete(bar, b.x, nloc, nx); b.st[0] = nloc; b.st[1] = nx; }
        const unsigned old = xb_add(&bar[XB_XSUB(b.x)], 1u);
        const unsigned gen = old / nloc;
        if (old + 1u == (gen + 1u) * nloc) {
            __builtin_amdgcn_fence(__ATOMIC_RELEASE, "agent");
            asm volatile("s_waitcnt vmcnt(0)" ::: "memory");
            const unsigned og = xb_add(&bar[XB_TOP], 1u);
            const unsigned tg = og / nx;
            if (og + 1u == (tg + 1u) * nx) xb_add(&bar[XB_TOPGEN], 1u);
            else XB_SPIN(xb_ld(&bar[XB_TOPGEN]) == tg, bar);
            __builtin_amdgcn_fence(__ATOMIC_ACQUIRE, "agent");
            xb_add(&bar[XB_XGEN(b.x)], 1u);
            asm volatile("s_waitcnt vmcnt(0)" ::: "memory");
        } else {
            XB_SPIN(xb_ld(&bar[XB_XGEN(b.x)]) == gen, bar);
            __builtin_amdgcn_fence(__ATOMIC_ACQUIRE, "agent");
            asm volatile("s_waitcnt vmcnt(0)" ::: "memory");
        }
    }
    __syncthreads();
}
constexpr int CW_BAR = 4096;

constexpr int K_PROLOGUE = 11, K_FINAL = 12;
template <int KIND>
__device__ __forceinline__ void run_kind(const Params& p, int L, LAS unsigned char* lds, int bid, int nblk) {
    unsigned char* ws = p.ws;
    float* H = (float*)(ws + WS_H);
    float* ss0 = (float*)(ws + WS_STAT); float* ss1 = (float*)(ws + WS_SS1); float* sse = (float*)(ws + WS_SSE);
    if constexpr (KIND == K_PROLOGUE) phase_prologue(p, lds, bid, nblk);
    if constexpr (KIND == K_FINAL) phase_final(p, bid, nblk);
    if constexpr (KIND == 0) { EpiProj E{nullptr, (bf16*)(ws + WS_PROJ), (float*)(ws + WS_BA)};
        gemm_run(lds, (const bf16*)(ws + WS_HB0), (const bf16*)(ws + WS_WIN) + (size_t)L * IN_PAD * D, M, IN_PAD, D, E, bid, nblk, ss0); }
    if constexpr (KIND == 1) phase_gdn_prep(p, L, lds, bid, nblk);
    if constexpr (KIND == 2) { phase_gdn_scan(p, L, lds, bid, nblk); phase_att_queue(p, L, lds, bid, nblk); }
    if constexpr (KIND == 3) { EpiRes E{ss1, H, (bf16*)(ws + WS_HB1)};
        gemm_run(lds, (const bf16*)(ws + WS_OBUF), (const bf16*)(ws + WS_WOUT) + (size_t)L * D * D, M, D, D, E, bid, nblk); }
    if constexpr (KIND == 4) { EpiQ2 E{nullptr, (bf16*)(ws + WS_Q2)};
        gemm_run(lds, (const bf16*)(ws + WS_HB1), (const bf16*)(ws + WS_WQ) + (size_t)L * 2048 * D, M, 2048, D, E, bid, nblk, ss1); }
    if constexpr (KIND == 5) phase_peer(p, L, lds, bid, nblk);
    if constexpr (KIND == 7) { EpiE E2{sse, (bf16*)(ws + WS_EPRE)};
        gemm_run(lds, (const bf16*)(ws + WS_PB) + (size_t)L * M * 256, (const bf16*)(ws + WS_WP) + (size_t)L * D * 256, M, D, 256, E2, bid, nblk); }
    if constexpr (KIND == 6) { EpiPle E{ss0, H, (bf16*)(ws + WS_HB0), (const bf16*)(ws + WS_EPRE), p.ple_norm_g + L * D};
        gemm_run(lds, (const bf16*)(ws + WS_HB2), (const bf16*)(ws + WS_WG) + (size_t)L * D * D, M, D, D, E, bid, nblk, sse); }
}

__device__ __forceinline__ Params params_off(const Params& s, size_t z) {
    Params q;
    q.x = s.x + z; q.p = s.p + z; q.ln_mix_g = s.ln_mix_g + z; q.w_in = s.w_in + z; q.conv_w = s.conv_w + z; q.a_log = s.a_log + z; q.dt_bias = s.dt_bias + z;
    q.gdn_norm_g = s.gdn_norm_g + z; q.diff_lambda = s.diff_lambda + z; q.subln_g = s.subln_g + z; q.w_out = s.w_out + z; q.ln_ffn_g = s.ln_ffn_g + z;
    q.peer_wq = s.peer_wq + z; q.subkeys = s.subkeys + z; q.peer_u = s.peer_u + z; q.peer_v = s.peer_v + z; q.ple_wp = s.ple_wp + z; q.ple_wg = s.ple_wg + z;
    q.ple_norm_g = s.ple_norm_g + z; q.final_g = s.final_g + z; q.out = s.out + z; q.ws = s.ws + z; q.pad0 = 0; q.pad1 = 0;
    return q;
}
#define RUN(KIND) do { size_t z_ = 0; int L_ = L; asm volatile("" : "+s"(z_), "+s"(L_)); const Params q_ = params_off(p, z_); run_kind<KIND>(q_, L_, (LAS unsigned char*)lds, (int)blockIdx.x, (int)gridDim.x); } while (0)
#define GRID_BARRIER() do { XcdBarrier b_; b_.bar = (unsigned*)(p.ws + WS_CTL) + CW_BAR; b_.x = xb_xcc_id(); b_.st = (volatile LAS unsigned*)((LAS unsigned char*)lds + LDS_MISC_OFF) + 8; xcd_barrier(b_); } while (0)
__global__ void __launch_bounds__(NTHREADS, 2) mk_fwd(Params p) {
    extern __shared__ __attribute__((aligned(16))) unsigned char lds[];
    {
        volatile LAS unsigned* misc = (volatile LAS unsigned*)((LAS unsigned char*)lds + LDS_MISC_OFF);
        if (threadIdx.x < 64) misc[threadIdx.x] = 0u;
        __syncthreads();
        (void)xcd_barrier_post((unsigned*)(p.ws + WS_CTL) + CW_BAR, misc + 8);
    }
    { int L = 0; RUN(K_PROLOGUE); }
    cg::this_grid().sync();
#define LAYER(LL) do { const int L = (LL); RUN(0); GRID_BARRIER(); RUN(1); GRID_BARRIER(); RUN(2); GRID_BARRIER(); RUN(3); GRID_BARRIER(); RUN(4); GRID_BARRIER(); RUN(5); RUN(7); GRID_BARRIER(); RUN(6); GRID_BARRIER(); } while (0)
    LAYER(0); LAYER(1); LAYER(2); LAYER(3);
#undef LAYER
    { int L = 0; RUN(K_FINAL); }
}

extern "C" void kernel_launch(void* const* d_in, const int* in_sizes, int n_in, void* d_out, int out_size, void* d_ws, size_t ws_size, hipStream_t stream) {
    static int grid = 0;
    if (grid == 0) {
        if (n_in != 20 || out_size != M * D || ws_size < WS_END) { fprintf(stderr, "kernel_launch: unexpected shapes (n_in %d, out %d, ws %zu < %zu)\n", n_in, out_size, ws_size, (size_t)WS_END); grid = -1; return; }
        int dev = 0, cus = 0, per_cu = 0;
        (void)hipGetDevice(&dev); (void)hipDeviceGetAttribute(&cus, hipDeviceAttributeMultiprocessorCount, dev);
        if (hipFuncSetAttribute((const void*)mk_fwd, hipFuncAttributeMaxDynamicSharedMemorySize, LDS_BYTES) != hipSuccess) { fprintf(stderr, "kernel_launch: hipFuncSetAttribute failed\n"); grid = -1; return; }
        if (hipOccupancyMaxActiveBlocksPerMultiprocessor(&per_cu, (const void*)mk_fwd, NTHREADS, LDS_BYTES) != hipSuccess || per_cu < 1) { fprintf(stderr, "kernel_launch: occupancy query says %d blocks per CU\n", per_cu); (void)hipGetLastError(); grid = -1; return; }
        grid = (cus > 0 ? cus : 256);
    }
    if (grid < 0) return;
    (void)hipMemsetAsync((char*)d_ws + WS_CTL, 0, CTL_ZERO_BYTES, stream);
    Params p{};
    const float** pp = (const float**)&p;
    for (int i = 0; i < 20; ++i) pp[i] = (const float*)d_in[i];
    p.out = (float*)d_out; p.ws = (unsigned char*)d_ws;
    void* args[] = {&p};
    hipError_t e = hipLaunchCooperativeKernel((const void*)mk_fwd, dim3(grid), dim3(NTHREADS), args, LDS_BYTES, stream);
    if (e != hipSuccess) fprintf(stderr, "kernel_launch: cooperative launch failed: %s (grid %d)\n", hipGetErrorString(e), grid);
}
```

```cpp
#include <hip/hip_runtime.h>
#include <hip/hip_cooperative_groups.h>
#include <cstdio>
#include <cstdint>
namespace cg = cooperative_groups;

#define LAS __attribute__((address_space(3)))
typedef unsigned short bf16;
typedef float f32x4 __attribute__((ext_vector_type(4)));
typedef short bf16x8 __attribute__((ext_vector_type(8)));
typedef unsigned u32x4 __attribute__((ext_vector_type(4)));
typedef unsigned u32x2 __attribute__((ext_vector_type(2)));

constexpr int D = 1024, BATCH = 8, SEQ = 2048, DEPTH = 4, M = BATCH * SEQ;
constexpr int IN_COLS = 3592, IN_PAD = 3840, PROJ_W = 3584;
constexpr int NEXP = 16384;
constexpr float EPS = 1e-6f;
constexpr float QSCALE = 0.125f * 1.4426950408889634f;
constexpr int NWAVES = 8, NTHREADS = 512;
constexpr int LDS_BYTES = 163840;
constexpr int LDS_MISC_OFF = LDS_BYTES - 256;
constexpr int RS_OFF = 147456;
constexpr int CW_QUEUE = 1024;

constexpr size_t MiB = 1u << 20;
constexpr size_t WS_CTL = 0, CTL_ZERO_BYTES = 1 * MiB;
constexpr size_t WS_H = 1 * MiB;
constexpr size_t WS_HB0 = 65 * MiB;
constexpr size_t WS_HB1 = 97 * MiB;
constexpr size_t WS_HB2 = 129 * MiB;
constexpr size_t WS_PROJ = 161 * MiB;
constexpr size_t WS_BA = 273 * MiB;
constexpr size_t WS_OBUF = 274 * MiB;
constexpr size_t WS_Q2 = 306 * MiB;
constexpr size_t WS_EPRE = 370 * MiB;
constexpr size_t WS_IDX = 402 * MiB;
constexpr size_t WS_GATE = 410 * MiB;
constexpr size_t WS_STAT = 418 * MiB;
constexpr size_t WS_SS1 = WS_IDX + 1 * MiB, WS_SSE = WS_IDX;
constexpr size_t WS_ORAW = 422 * MiB;
constexpr size_t WS_WIN = 550 * MiB;
constexpr size_t WS_WOUT = 582 * MiB;
constexpr size_t WS_WQ = 590 * MiB;
constexpr size_t WS_WG = 606 * MiB;
constexpr size_t WS_WP = 614 * MiB;
constexpr size_t WS_SK = 616 * MiB;
constexpr size_t WS_PB = 618 * MiB;
constexpr size_t WS_U = 650 * MiB;
constexpr size_t WS_V = 778 * MiB;
constexpr size_t WS_SU = WS_STAT + 1 * MiB, WS_SV = WS_STAT + 2 * MiB;
constexpr size_t WS_END = 906 * MiB;

struct Params {
    const float *x, *p, *ln_mix_g, *w_in, *conv_w, *a_log, *dt_bias, *gdn_norm_g, *diff_lambda, *subln_g, *w_out, *ln_ffn_g,
        *peer_wq, *subkeys, *peer_u, *peer_v, *ple_wp, *ple_wg, *ple_norm_g, *final_g;
    float* out;
    unsigned char* ws;
    int pad0, pad1;
};

__device__ __forceinline__ int tidx() { int t = (int)threadIdx.x; asm volatile("" : "+v"(t)); return t; }
#define LDS_BARRIER() asm volatile("s_waitcnt lgkmcnt(0)\n\ts_barrier" ::: "memory")
__device__ __forceinline__ float bf2f(bf16 v) { return __uint_as_float((unsigned)v << 16); }
__device__ __forceinline__ unsigned f2bf(float f) { unsigned u = __float_as_uint(f); return (u + 0x7fffu + ((u >> 16) & 1u)) >> 16; }
__device__ __forceinline__ unsigned pk2(float lo, float hi) { return f2bf(lo) | (f2bf(hi) << 16); }
__device__ __forceinline__ float lo16(unsigned w) { return __uint_as_float(w << 16); }
__device__ __forceinline__ float hi16(unsigned w) { return __uint_as_float(w & 0xffff0000u); }
template <int N> __device__ __forceinline__ float dpp_ror(float x) { return __builtin_bit_cast(float, __builtin_amdgcn_mov_dpp(__builtin_bit_cast(int, x), 0x120 + N, 0xf, 0xf, true)); }
template <int N> __device__ __forceinline__ unsigned dpp_ror_u(unsigned x) { return (unsigned)__builtin_amdgcn_mov_dpp((int)x, 0x120 + N, 0xf, 0xf, true); }
__device__ __forceinline__ float row16_sum(float x) { x += dpp_ror<8>(x); x += dpp_ror<4>(x); x += dpp_ror<2>(x); x += dpp_ror<1>(x); return x; }
__device__ __forceinline__ float row16_max(float x) { x = fmaxf(x, dpp_ror<8>(x)); x = fmaxf(x, dpp_ror<4>(x)); x = fmaxf(x, dpp_ror<2>(x)); x = fmaxf(x, dpp_ror<1>(x)); return x; }
__device__ __forceinline__ unsigned row16_umax(unsigned x) { unsigned y;
    y = dpp_ror_u<8>(x); x = x > y ? x : y; y = dpp_ror_u<4>(x); x = x > y ? x : y; y = dpp_ror_u<2>(x); x = x > y ? x : y; y = dpp_ror_u<1>(x); x = x > y ? x : y; return x; }
__device__ __forceinline__ float xrow16_max(float x) {
    auto s = __builtin_amdgcn_permlane16_swap(__float_as_uint(x), __float_as_uint(x), false, false);
    x = fmaxf(__uint_as_float(s[0]), __uint_as_float(s[1]));
    auto t = __builtin_amdgcn_permlane32_swap(__float_as_uint(x), __float_as_uint(x), false, false);
    return fmaxf(__uint_as_float(t[0]), __uint_as_float(t[1]));
}
__device__ __forceinline__ float xrow16_sum(float x) {
    auto s = __builtin_amdgcn_permlane16_swap(__float_as_uint(x), __float_as_uint(x), false, false);
    x = __uint_as_float(s[0]) + __uint_as_float(s[1]);
    auto t = __builtin_amdgcn_permlane32_swap(__float_as_uint(x), __float_as_uint(x), false, false);
    return __uint_as_float(t[0]) + __uint_as_float(t[1]);
}
__device__ __forceinline__ float wave_sum(float v) { return xrow16_sum(row16_sum(v)); }
template <int N> __device__ __forceinline__ int dpp_ror_i(int x) { return __builtin_amdgcn_mov_dpp(x, 0x120 + N, 0xf, 0xf, true); }
__device__ __forceinline__ int wave_isum(int x) {
    x += dpp_ror_i<8>(x); x += dpp_ror_i<4>(x); x += dpp_ror_i<2>(x); x += dpp_ror_i<1>(x);
    auto s = __builtin_amdgcn_permlane16_swap((unsigned)x, (unsigned)x, false, false); x = (int)(s[0] + s[1]);
    auto t = __builtin_amdgcn_permlane32_swap((unsigned)x, (unsigned)x, false, false); return (int)(t[0] + t[1]);
}
__device__ __forceinline__ float wave_max(float v) {
#pragma unroll
    for (int o = 32; o; o >>= 1) v = fmaxf(v, __shfl_xor(v, o));
    return v;
}
__device__ __forceinline__ float sigmoidf_(float x) { return 1.f / (1.f + __expf(-x)); }
__device__ __forceinline__ float dot8(u32x4 a, u32x4 b, float s) {
#pragma unroll
    for (int i = 0; i < 4; ++i) { s += lo16(a[i]) * lo16(b[i]); s += hi16(a[i]) * hi16(b[i]); }
    return s;
}

__host__ __device__ __forceinline__ int lds_byte(int r, int c) { const int st = (r >> 4) * 2 + (c >> 5), rr = r & 15, cc = c & 31, ob = rr * 64 + cc * 2; return st * 1024 + (ob ^ (((ob >> 9) & 1) << 5)); }
__host__ __device__ __forceinline__ void stage_rc(int b, int& R, int& C) { const int st = b / 1024, sb = b % 1024, swz = sb ^ (((sb >> 9) & 1) << 5); R = (st >> 1) * 16 + swz / 64; C = (st & 1) * 32 + (swz % 64) / 2; }
constexpr int HTB = 16384;
template <class F>
__device__ __forceinline__ void gemm_run(LAS unsigned char* lds, const bf16* A, const bf16* Bt, int Mm, int N, int K, const F& f, int bid, int nblk, const float* slots_in = nullptr) {
    LAS float* RS = (LAS float*)(lds + RS_OFF);
    if (slots_in) {
        const int t = tidx();
        if (t < 256) { const f32x4* sp = (const f32x4*)(slots_in + ((size_t)(bid % (Mm / 256)) * 256 + t) * 16);
            const f32x4 a = sp[0], b = sp[1], c = sp[2], d = sp[3];
            const float s = (((a[0] + a[1]) + (a[2] + a[3])) + ((b[0] + b[1]) + (b[2] + b[3]))) + (((c[0] + c[1]) + (c[2] + c[3])) + ((d[0] + d[1]) + (d[2] + d[3])));
            RS[t] = rsqrtf(s * (1.f / D) + EPS); }
        __syncthreads();
    }
    const int tid = tidx(), wid = __builtin_amdgcn_readfirstlane(tid >> 6), lane = tid & 63, wr = wid >> 2, wc = wid & 3, fr = lane & 15, fq = lane >> 4;
    const int nt = K / 64, ntn = N / 256, nunits = (Mm / 256) * ntn;
    unsigned voff[2];
#pragma unroll
    for (int i = 0; i < 2; ++i) { const int uu = tid + 512 * i, r = uu >> 3, c = (uu & 7) ^ ((r >> 1) & 7); voff[i] = (unsigned)(r * K + c * 8) * 2u; }
    const unsigned ldsw = (unsigned)wid * 1024u;
    const int sw7 = (fr >> 1) & 7;
    const int aoff0 = wr * HTB + fr * 128 + ((fq ^ sw7) << 4), aoff1 = wr * HTB + fr * 128 + (((4 + fq) ^ sw7) << 4);
    const int bbase = (2 + (wc >> 1)) * HTB + (wc & 1) * 8192 + fr * 128;
    const int boff0 = bbase + ((fq ^ sw7) << 4), boff1 = bbase + (((4 + fq) ^ sw7) << 4);
#define G_STAGE(bufoff, gbase) do { _Pragma("unroll") for (int _i = 0; _i < 2; ++_i) \
        __builtin_amdgcn_global_load_lds((const unsigned*)((const char*)(gbase) + voff[_i]), (LAS unsigned*)(lds + (bufoff) + ldsw + _i * 8192), 16, 0, 0); } while (0)
    for (int u = bid; u < nunits; u += nblk) {
        const int pm = u % (Mm / 256), pn = u / (Mm / 256);
        const char* gA = (const char*)(A + (size_t)pm * 256 * K);
        const char* gB = (const char*)(Bt + (size_t)pn * 256 * K);
        const size_t hstep = (size_t)128 * K * 2;
        f32x4 acc[8][4];
#pragma unroll
        for (int a = 0; a < 8; ++a)
#pragma unroll
            for (int b = 0; b < 4; ++b) acc[a][b] = (f32x4){0.f, 0.f, 0.f, 0.f};
        G_STAGE(0, gA); G_STAGE(HTB, gA + hstep); G_STAGE(2 * HTB, gB); G_STAGE(3 * HTB, gB + hstep);
        for (int t = 0; t < nt; ++t) {
            const int cb = (t & 1) * 4 * HTB, nb = ((t + 1) & 1) * 4 * HTB;
            asm volatile("s_waitcnt vmcnt(0)" ::: "memory");
            __builtin_amdgcn_s_barrier();
            asm volatile("" ::: "memory");
            const size_t ko = (size_t)(t + 1) * 128; const bool more = t + 1 < nt;
#pragma unroll
            for (int k = 0; k < 2; ++k) {
                if (more) { if (k == 0) { G_STAGE(nb, gA + ko); G_STAGE(nb + 2 * HTB, gB + ko); } else { G_STAGE(nb + HTB, gA + hstep + ko); G_STAGE(nb + 3 * HTB, gB + hstep + ko); } }
                bf16x8 bfr[4], acur, anxt;
#pragma unroll
                for (int n = 0; n < 4; ++n) bfr[n] = *(const LAS bf16x8*)(lds + cb + (k ? boff1 : boff0) + n * 2048);
                acur = *(const LAS bf16x8*)(lds + cb + (k ? aoff1 : aoff0));
#pragma unroll
                for (int m = 0; m < 8; ++m) {
                    if (m < 7) anxt = *(const LAS bf16x8*)(lds + cb + (k ? aoff1 : aoff0) + (m + 1) * 2048);
#pragma unroll
                    for (int n = 0; n < 4; ++n) acc[m][n] = __builtin_amdgcn_mfma_f32_16x16x32_bf16(bfr[n], acur, acc[m][n], 0, 0, 0);
                    acur = anxt;
                }
                __builtin_amdgcn_sched_barrier(0);
            }
            asm volatile("s_waitcnt lgkmcnt(0)" ::: "memory");
        }
#pragma unroll
        for (int m = 0; m < 8; ++m) {
            const int lrow = wr * 128 + m * 16 + fr, row = pm * 256 + lrow;
            float ssq = 0.f;
#pragma unroll
            for (int n = 0; n < 4; ++n) { const f32x4 r = f(row, RS[lrow], pn * 256 + wc * 64 + n * 16 + 4 * fq, acc[m][n]); ssq += (r[0] * r[0] + r[1] * r[1]) + (r[2] * r[2] + r[3] * r[3]); }
            if constexpr (F::STATS) { ssq = xrow16_sum(ssq); if (fq == 0) f.slots[(size_t)row * 16 + pn * 4 + wc] = ssq; }
        }
        __syncthreads();
    }
#undef G_STAGE
}

__device__ __forceinline__ u32x2 pk4(f32x4 a) { u32x2 o; o.x = pk2(a[0], a[1]); o.y = pk2(a[2], a[3]); return o; }
struct EpiProj {
    static constexpr bool STATS = false; float* slots;
    bf16* proj; float* ba;
    __device__ __forceinline__ f32x4 operator()(int row, float rstd, int col, f32x4 v) const {
        v = v * rstd;
        if (col < PROJ_W) *(u32x2*)(proj + (size_t)row * PROJ_W + col) = pk4(v);
        else if (col < IN_COLS) *(f32x4*)(ba + (size_t)row * 8 + (col - PROJ_W)) = v;
        return v;
    }
};
struct EpiRes {
    static constexpr bool STATS = true; float* slots;
    float* H; bf16* HB;
    __device__ __forceinline__ f32x4 operator()(int row, float, int col, f32x4 v) const {
        f32x4* hp = (f32x4*)(H + (size_t)row * D + col);
        const f32x4 h = *hp + v; *hp = h;
        *(u32x2*)(HB + (size_t)row * D + col) = pk4(h);
        return h;
    }
};
struct EpiQ2 {
    static constexpr bool STATS = false; float* slots;
    bf16* Q2;
    __device__ __forceinline__ f32x4 operator()(int row, float rstd, int col, f32x4 v) const { v = v * rstd; *(u32x2*)(Q2 + (size_t)row * 2048 + col) = pk4(v); return v; }
};
struct EpiE {
    static constexpr bool STATS = true; float* slots;
    bf16* E;
    __device__ __forceinline__ f32x4 operator()(int row, float, int col, f32x4 v) const { *(u32x2*)(E + (size_t)row * D + col) = pk4(v); return v; }
};
struct EpiPle {
    static constexpr bool STATS = true; float* slots;
    float* H; bf16* HB; const bf16* E; const float* g;
    __device__ __forceinline__ f32x4 operator()(int row, float rstde, int col, f32x4 v) const {
        f32x4* hp = (f32x4*)(H + (size_t)row * D + col);
        const u32x2 ev = *(const u32x2*)(E + (size_t)row * D + col);
        const f32x4 gv = *(const f32x4*)(g + col);
        f32x4 h = *hp;
        h[0] += sigmoidf_(v[0]) * (lo16(ev.x) * rstde * gv[0]); h[1] += sigmoidf_(v[1]) * (hi16(ev.x) * rstde * gv[1]);
        h[2] += sigmoidf_(v[2]) * (lo16(ev.y) * rstde * gv[2]); h[3] += sigmoidf_(v[3]) * (hi16(ev.y) * rstde * gv[3]);
        *hp = h;
        *(u32x2*)(HB + (size_t)row * D + col) = pk4(h);
        return h;
    }
};

__device__ __forceinline__ void transpose_item(const float* W, int K, int N, int Npad, bf16* WT, const float* rowscale, int qcols, float* scr, int item, int lane) {
    const int nblk = Npad / 32, kb = item / nblk, nb = item % nblk, k0 = 64 * kb, n0 = 32 * nb;
    const int n = n0 + (lane & 31);
#pragma unroll 8
    for (int i = 0; i < 32; ++i) {
        const int kk = 2 * i + (lane >> 5);
        float v = (n < N) ? W[(size_t)(k0 + kk) * N + n] : 0.f;
        if (rowscale) v *= rowscale[k0 + kk];
        if (n < qcols) v *= QSCALE;
        scr[kk * 33 + (lane & 31)] = v;
    }
    asm volatile("s_waitcnt lgkmcnt(0)" ::: "memory");
    const int c = lane & 7;
#pragma unroll
    for (int j = 0; j < 4; ++j) {
        const int nn = (lane >> 3) + 8 * j; const float* s = scr + (8 * c) * 33 + nn;
        u32x4 o; o.x = pk2(s[0 * 33], s[1 * 33]); o.y = pk2(s[2 * 33], s[3 * 33]); o.z = pk2(s[4 * 33], s[5 * 33]); o.w = pk2(s[6 * 33], s[7 * 33]);
        *(u32x4*)(WT + (size_t)(n0 + nn) * K + k0 + 8 * c) = o;
    }
    asm volatile("s_waitcnt lgkmcnt(0)" ::: "memory");
}
__device__ __forceinline__ void convert_bulk(const float* src, bf16* dst, size_t n, size_t gtid, size_t nthr) {
    for (size_t i = gtid * 8; i < n; i += nthr * 8) {
        const f32x4 a = *(const f32x4*)(src + i), b = *(const f32x4*)(src + i + 4);
        u32x4 o; o.x = pk2(a[0], a[1]); o.y = pk2(a[2], a[3]); o.z = pk2(b[0], b[1]); o.w = pk2(b[2], b[3]);
        *(u32x4*)(dst + i) = o;
    }
}
__device__ void phase_prologue(const Params& p, LAS unsigned char* lds_, int bid, int nblk) {
    unsigned char* lds = (unsigned char*)lds_;
    const int tid = tidx(), lane = tid & 63, w = tid >> 6;
    const int gw = bid * NWAVES + w, NGW = nblk * NWAVES;
    float* scr = (float*)(lds + w * 16384);
    constexpr int I_IN = 16 * (IN_PAD / 32), I_OUT = 16 * 32, I_Q = 16 * 64, I_G = 16 * 32, I_P = 4 * 32, I_L = I_IN + I_OUT + I_Q + I_G + I_P;
    for (int it = gw; it < DEPTH * I_L; it += NGW) {
        const int L = it / I_L; int r = it % I_L;
        if (r < I_IN) { transpose_item(p.w_in + (size_t)L * D * IN_COLS, D, IN_COLS, IN_PAD, (bf16*)(p.ws + WS_WIN) + (size_t)L * IN_PAD * D, p.ln_mix_g + L * D, 512, scr, r, lane); continue; } r -= I_IN;
        if (r < I_OUT) { transpose_item(p.w_out + (size_t)L * D * D, D, D, D, (bf16*)(p.ws + WS_WOUT) + (size_t)L * D * D, nullptr, 0, scr, r, lane); continue; } r -= I_OUT;
        if (r < I_Q) { transpose_item(p.peer_wq + (size_t)L * D * 2048, D, 2048, 2048, (bf16*)(p.ws + WS_WQ) + (size_t)L * 2048 * D, p.ln_ffn_g + L * D, 0, scr, r, lane); continue; } r -= I_Q;
        if (r < I_G) { transpose_item(p.ple_wg + (size_t)L * D * D, D, D, D, (bf16*)(p.ws + WS_WG) + (size_t)L * D * D, nullptr, 0, scr, r, lane); continue; } r -= I_G;
        transpose_item(p.ple_wp + (size_t)L * 256 * D, 256, D, D, (bf16*)(p.ws + WS_WP) + (size_t)L * D * 256, nullptr, 0, scr, r, lane);
    }
    const size_t gtid = (size_t)bid * NTHREADS + tid, nthr = (size_t)nblk * NTHREADS;
    for (int r = gw; r < 2 * DEPTH * NEXP; r += NGW) {
        const int which = r >= DEPTH * NEXP, rr = which ? r - DEPTH * NEXP : r;
        const float* srow = (which ? p.peer_v : p.peer_u) + (size_t)rr * D + 16 * lane;
        f32x4 v[4];
#pragma unroll
        for (int j = 0; j < 4; ++j) v[j] = *(const f32x4*)(srow + 4 * j);
        float mx = 0.f;
#pragma unroll
        for (int j = 0; j < 4; ++j) mx = fmaxf(mx, fmaxf(fmaxf(fabsf(v[j][0]), fabsf(v[j][1])), fmaxf(fabsf(v[j][2]), fabsf(v[j][3]))));
        mx = xrow16_max(row16_max(mx));
        const float inv = mx > 0.f ? 127.f / mx : 0.f;
        u32x4 o;
#pragma unroll
        for (int j = 0; j < 4; ++j) {
            const unsigned b0 = (unsigned)__float2int_rn(v[j][0] * inv) & 0xffu, b1 = (unsigned)__float2int_rn(v[j][1] * inv) & 0xffu, b2 = (unsigned)__float2int_rn(v[j][2] * inv) & 0xffu, b3 = (unsigned)__float2int_rn(v[j][3] * inv) & 0xffu;
            o[j] = b0 | (b1 << 8) | (b2 << 16) | (b3 << 24);
        }
        *(u32x4*)(p.ws + (which ? WS_V : WS_U) + (size_t)rr * D + 16 * lane) = o;
        if (lane == 0) ((float*)(p.ws + (which ? WS_SV : WS_SU)))[rr] = mx * (1.f / 127.f);
    }
    convert_bulk(p.p, (bf16*)(p.ws + WS_PB), (size_t)DEPTH * M * 256, gtid, nthr);
    convert_bulk(p.subkeys, (bf16*)(p.ws + WS_SK), (size_t)DEPTH * 8 * 2 * 128 * 128, gtid, nthr);
    float* H = (float*)(p.ws + WS_H); bf16* HB0 = (bf16*)(p.ws + WS_HB0); float* ss0 = (float*)(p.ws + WS_STAT);
    for (int m = gw; m < M; m += NGW) {
        const f32x4* xr = (const f32x4*)(p.x + (size_t)m * D) + lane;
        float ss = 0.f;
#pragma unroll
        for (int j = 0; j < 4; ++j) {
            const f32x4 v = xr[64 * j];
            ss += v[0] * v[0] + v[1] * v[1] + v[2] * v[2] + v[3] * v[3];
            ((f32x4*)(H + (size_t)m * D))[lane + 64 * j] = v;
            u32x2 o; o.x = pk2(v[0], v[1]); o.y = pk2(v[2], v[3]);
            ((u32x2*)(HB0 + (size_t)m * D))[lane + 64 * j] = o;
        }
        ss = wave_sum(ss);
        if (lane < 16) ss0[(size_t)m * 16 + lane] = lane == 0 ? ss : 0.f;
    }
}

typedef short v4i16_t __attribute__((ext_vector_type(4)));
typedef __bf16 bf16x2_t __attribute__((ext_vector_type(2)));
typedef float f32x2_t __attribute__((ext_vector_type(2)));
__device__ __forceinline__ unsigned cvtpk(float lo, float hi) { f32x2_t v = {lo, hi}; bf16x2_t b = __builtin_convertvector(v, bf16x2_t); return __builtin_bit_cast(unsigned, b); }
constexpr int ATT_VOFF = 16384, ATT_VPITCH = 288;
__device__ __forceinline__ void att_unit(const Params& p, int L, LAS unsigned char* lds, int tid, int b, int hh, int qb, float lam, float lam_init) {
    const int lane = tid & 63, w = __builtin_amdgcn_readfirstlane(tid >> 6), fr = lane & 15, fq = lane >> 4;
    const bf16* proj = (const bf16*)(p.ws + WS_PROJ);
    bf16* obuf = (bf16*)(p.ws + WS_OBUF);
    {
        const float slope2 = 1.4426950408889634f / (float)(1 << (2 * (hh + 1)));
        const bf16* kbase = proj + (size_t)b * SEQ * PROJ_W + 512 + hh * 128;
        const bf16* vbase = proj + (size_t)b * SEQ * PROJ_W + 1024 + hh * 128;
        {
            const int qw0 = qb * 128 + w * 16, T = 2 * (qb + 1);
            bf16x8 qf[2][2];
#pragma unroll
            for (int mp = 0; mp < 2; ++mp)
#pragma unroll
                for (int ks = 0; ks < 2; ++ks) qf[mp][ks] = *(const bf16x8*)(proj + ((size_t)b * SEQ + qw0 + fr) * PROJ_W + hh * 128 + mp * 64 + ks * 32 + 8 * fq);
            f32x4 o[2][8];
#pragma unroll
            for (int mp = 0; mp < 2; ++mp)
#pragma unroll
                for (int dt = 0; dt < 8; ++dt) o[mp][dt] = (f32x4){0.f, 0.f, 0.f, 0.f};
            float mrun[2] = {-INFINITY, -INFINITY}, lrun[2] = {0.f, 0.f};
            u32x4 kreg[2], vreg[2];
#pragma unroll
            for (int i = 0; i < 2; ++i) { const int c = tid + 512 * i, key = c >> 4, ch = c & 15;
                kreg[i] = *(const u32x4*)(kbase + (size_t)key * PROJ_W + ch * 8); vreg[i] = *(const u32x4*)(vbase + (size_t)key * PROJ_W + ch * 8); }
            for (int t = 0; t < T; ++t) {
                const int k0 = t * 64;
#pragma unroll
                for (int i = 0; i < 2; ++i) { const int c = tid + 512 * i, key = c >> 4, ch = c & 15;
                    *(LAS u32x4*)(lds + key * 256 + ((ch ^ (key & 15)) << 4)) = kreg[i];
                    *(LAS u32x4*)(lds + ATT_VOFF + key * ATT_VPITCH + ch * 16) = vreg[i]; }
                LDS_BARRIER();
                if (t + 1 < T) {
#pragma unroll
                    for (int i = 0; i < 2; ++i) { const int c = tid + 512 * i, key = k0 + 64 + (c >> 4), ch = c & 15;
                        kreg[i] = *(const u32x4*)(kbase + (size_t)key * PROJ_W + ch * 8); vreg[i] = *(const u32x4*)(vbase + (size_t)key * PROJ_W + ch * 8); }
                }
                if (k0 <= qw0 + 15) {
                    f32x4 s[2][4];
                    const float base = -slope2 * (float)(qw0 + fr - k0 - 4 * fq);
#pragma unroll
                    for (int kt = 0; kt < 4; ++kt)
#pragma unroll
                        for (int r = 0; r < 4; ++r) { const float v = base + slope2 * (float)(16 * kt + r); s[0][kt][r] = v; s[1][kt][r] = v; }
#pragma unroll
                    for (int mp = 0; mp < 2; ++mp)
#pragma unroll
                        for (int kt = 0; kt < 4; ++kt)
#pragma unroll
                            for (int ks = 0; ks < 2; ++ks) {
                                const bf16x8 kf = *(const LAS bf16x8*)(lds + (16 * kt + fr) * 256 + (((mp * 8 + ks * 4 + fq) ^ fr) << 4));
                                s[mp][kt] = __builtin_amdgcn_mfma_f32_16x16x32_bf16(kf, qf[mp][ks], s[mp][kt], 0, 0, 0);
                            }
                    if (k0 + 63 > qw0) {
                        const int lim = qw0 + fr - k0 - 4 * fq;
#pragma unroll
                        for (int mp = 0; mp < 2; ++mp)
#pragma unroll
                            for (int kt = 0; kt < 4; ++kt)
#pragma unroll
                                for (int r = 0; r < 4; ++r) if (16 * kt + r > lim) s[mp][kt][r] = -INFINITY;
                    }
                    bf16x8 pb[2][2];
#pragma unroll
                    for (int mp = 0; mp < 2; ++mp) {
                        float mx = fmaxf(fmaxf(s[mp][0][0], s[mp][0][1]), fmaxf(s[mp][0][2], s[mp][0][3]));
#pragma unroll
                        for (int kt = 1; kt < 4; ++kt) mx = fmaxf(mx, fmaxf(fmaxf(s[mp][kt][0], s[mp][kt][1]), fmaxf(s[mp][kt][2], s[mp][kt][3])));
                        mx = xrow16_max(mx);
                        const float mnew = fmaxf(mrun[mp], mx);
                        const float alpha = __builtin_amdgcn_exp2f(mrun[mp] - mnew);
                        mrun[mp] = mnew;
                        float ps = 0.f;
#pragma unroll
                        for (int kt = 0; kt < 4; ++kt)
#pragma unroll
                            for (int r = 0; r < 4; ++r) { const float e = __builtin_amdgcn_exp2f(s[mp][kt][r] - mnew); s[mp][kt][r] = e; ps += e; }
                        lrun[mp] = lrun[mp] * alpha + ps;
#pragma unroll
                        for (int dt = 0; dt < 8; ++dt) o[mp][dt] = o[mp][dt] * alpha;
#pragma unroll
                        for (int ks = 0; ks < 2; ++ks) {
                            u32x4 pk; pk.x = cvtpk(s[mp][2 * ks][0], s[mp][2 * ks][1]); pk.y = cvtpk(s[mp][2 * ks][2], s[mp][2 * ks][3]);
                            pk.z = cvtpk(s[mp][2 * ks + 1][0], s[mp][2 * ks + 1][1]); pk.w = cvtpk(s[mp][2 * ks + 1][2], s[mp][2 * ks + 1][3]);
                            pb[mp][ks] = __builtin_bit_cast(bf16x8, pk);
                        }
                    }
                    const int gl = lane & 15;
                    LAS unsigned char* vrd = lds + ATT_VOFF + (4 * fq + (gl >> 2)) * ATT_VPITCH + (gl & 3) * 8;
#pragma unroll
                    for (int dt = 0; dt < 8; ++dt)
#pragma unroll
                        for (int ks = 0; ks < 2; ++ks) {
                            const v4i16_t v0 = __builtin_amdgcn_ds_read_tr16_b64_v4i16((LAS v4i16_t*)(vrd + (32 * ks) * ATT_VPITCH + dt * 32));
                            const v4i16_t v1 = __builtin_amdgcn_ds_read_tr16_b64_v4i16((LAS v4i16_t*)(vrd + (32 * ks + 16) * ATT_VPITCH + dt * 32));
                            bf16x8 vf; vf[0] = v0[0]; vf[1] = v0[1]; vf[2] = v0[2]; vf[3] = v0[3]; vf[4] = v1[0]; vf[5] = v1[1]; vf[6] = v1[2]; vf[7] = v1[3];
                            o[0][dt] = __builtin_amdgcn_mfma_f32_16x16x32_bf16(vf, pb[0][ks], o[0][dt], 0, 0, 0);
                            o[1][dt] = __builtin_amdgcn_mfma_f32_16x16x32_bf16(vf, pb[1][ks], o[1][dt], 0, 0, 0);
                        }
                }
                LDS_BARRIER();
            }
            const float i1 = 1.f / xrow16_sum(lrun[0]), i2 = lam / xrow16_sum(lrun[1]);
            float ss = 0.f;
#pragma unroll
            for (int dt = 0; dt < 8; ++dt)
#pragma unroll
                for (int r = 0; r < 4; ++r) { const float v = o[0][dt][r] * i1 - o[1][dt][r] * i2; o[0][dt][r] = v; ss += v * v; }
            ss = xrow16_sum(ss);
            const float rn = rsqrtf(ss * (1.f / 128.f) + EPS) * (1.f - lam_init);
            const float* g = p.subln_g + L * 128;
            bf16* orow = obuf + ((size_t)b * SEQ + qw0 + fr) * D + hh * 128;
#pragma unroll
            for (int dt = 0; dt < 8; ++dt) {
                const f32x4 gv = *(const f32x4*)(g + 16 * dt + 4 * fq);
                u32x2 ov; ov.x = pk2(o[0][dt][0] * rn * gv[0], o[0][dt][1] * rn * gv[1]); ov.y = pk2(o[0][dt][2] * rn * gv[2], o[0][dt][3] * rn * gv[3]);
                *(u32x2*)(orow + 16 * dt + 4 * fq) = ov;
            }
        }
    }
}

__device__ void phase_att_queue(const Params& p, int L, LAS unsigned char* lds, int bid, int nblk) {
    const int tid = tidx(), lane = tid & 63;
    const float* lp = p.diff_lambda + L * 256;
    const float d1 = wave_sum(lp[lane] * lp[64 + lane]), d2 = wave_sum(lp[128 + lane] * lp[192 + lane]);
    const float lam_init = 0.8f - 0.6f * __expf(-0.3f * (float)L);
    const float lam = __expf(d1) - __expf(d2) + lam_init;
    unsigned* head = (unsigned*)(p.ws + WS_CTL) + CW_QUEUE + L;
    volatile LAS int* slot = (volatile LAS int*)(lds + LDS_MISC_OFF + 64);
    for (;;) {
        __syncthreads();
        if (tid == 0) *slot = (int)__hip_atomic_fetch_add(head, 1u, __ATOMIC_RELAXED, __HIP_MEMORY_SCOPE_AGENT);
        __syncthreads();
        const int u = *slot;
        if (u >= 512) break;
        att_unit(p, L, lds, tid, (u & 31) >> 2, u & 3, 15 - (u >> 5), lam, lam_init);
    }
}

constexpr size_t GD_WP = WS_ORAW, GD_QD = WS_ORAW + 16 * MiB, GD_AIP = WS_ORAW + 32 * MiB, GD_KDT = WS_ORAW + 40 * MiB, GD_UT = WS_ORAW + 56 * MiB, GD_GL = WS_ORAW + 72 * MiB;
__device__ __forceinline__ int perm_pos(int k) { return (k & ~31) + 8 * ((k >> 2) & 3) + 4 * ((k >> 4) & 1) + (k & 3); }
__device__ __forceinline__ float softplusf_(float x) { if (x > 20.f) return x; const float e = __expf(x); return e < 0.06f ? e * (1.f - e * (0.5f - e * (0.33333334f - 0.25f * e))) : __logf(1.f + e); }
__device__ __forceinline__ float gelu_erf(float v) {
    const float z = fabsf(v) * 0.70710678118654752f, t = 1.f / (1.f + 0.3275911f * z);
    const float pl = t * (0.254829592f + t * (-0.284496736f + t * (1.421413741f + t * (-1.453152027f + t * 1.061405429f))));
    const float er = 1.f - pl * __expf(-z * z);
    return 0.5f * v * (1.f + (v < 0.f ? -er : er));
}

constexpr int GP_KN = 0, GP_QN = 17408, GP_RT = 34816, GP_LM = 71680, GP_TB = 89088, GP_GT = 98304, GP_T0T = 99328;
constexpr int GP_KP = 272, GP_RP = 144, GP_LP = 68, GP_TP = 144;
__device__ void phase_gdn_prep(const Params& p, int L, LAS unsigned char* lds, int bid, int nblk) {
    const int tid = tidx(), lane = tid & 63, w = __builtin_amdgcn_readfirstlane(tid >> 6), fr = lane & 15, fq = lane >> 4;
    const bf16* proj = (const bf16*)(p.ws + WS_PROJ);
    const float* BA = (const float*)(p.ws + WS_BA);
    bf16* WP = (bf16*)(p.ws + GD_WP); bf16* QD = (bf16*)(p.ws + GD_QD); bf16* AIP = (bf16*)(p.ws + GD_AIP); bf16* KDT = (bf16*)(p.ws + GD_KDT); bf16* UT = (bf16*)(p.ws + GD_UT);
    float* GL = (float*)(p.ws + GD_GL);
    const float* cw = p.conv_w + (size_t)L * 4 * 1536;
    LAS float* beta_s = (LAS float*)(lds + GP_GT); LAS float* gc_s = beta_s + 64; LAS float* egc_s = gc_s + 64; LAS float* edl_s = egc_s + 64;
    LAS float* Lm = (LAS float*)(lds + GP_LM);
    for (int item = bid; item < 1024; item += nblk) {
        const int n = item & 31, bh = item >> 5, hh = bh & 3, b = bh >> 2, t0 = n * 64;
        const size_t row0 = (size_t)b * SEQ + t0;
        __syncthreads();
        if (w == 0) {
            const float negA = -__expf(p.a_log[L * 4 + hh]), dtb = p.dt_bias[L * 4 + hh];
            const float bb = BA[(row0 + lane) * 8 + hh], aa = BA[(row0 + lane) * 8 + 4 + hh] + dtb;
            float c = negA * softplusf_(aa);
#pragma unroll
            for (int o = 1; o < 64; o <<= 1) { const float t = __shfl_up(c, o); if (lane >= o) c += t; }
            const float glast = __shfl(c, 63);
            beta_s[lane] = sigmoidf_(bb); gc_s[lane] = c; egc_s[lane] = __expf(c); edl_s[lane] = __expf(glast - c);
            if (lane == 0) GL[item] = __expf(glast);
        }
        __syncthreads();
        {
            const int colq = hh * 128 + 2 * lane;
            unsigned xk[11], xv[11];
#pragma unroll
            for (int r = 0; r < 11; ++r) { const int tt = t0 + 8 * w - 3 + r;
                xk[r] = (tt >= 0) ? *(const unsigned*)(proj + ((size_t)b * SEQ + tt) * PROJ_W + 1536 + 512 + colq) : 0u;
                xv[r] = (tt >= 0) ? *(const unsigned*)(proj + ((size_t)b * SEQ + tt) * PROJ_W + 1536 + 1024 + colq) : 0u; }
            {
                float wq[4][2]; unsigned xq[11];
#pragma unroll
                for (int j = 0; j < 4; ++j) { wq[j][0] = cw[j * 1536 + colq]; wq[j][1] = cw[j * 1536 + colq + 1]; }
#pragma unroll
                for (int r = 0; r < 11; ++r) { const int tt = t0 + 8 * w - 3 + r; xq[r] = (tt >= 0) ? *(const unsigned*)(proj + ((size_t)b * SEQ + tt) * PROJ_W + 1536 + colq) : 0u; }
#pragma unroll
                for (int i = 0; i < 8; ++i) {
                    const int c = 8 * w + i;
                    float q0 = 0.f, q1 = 0.f;
#pragma unroll
                    for (int j = 0; j < 4; ++j) { q0 += wq[j][0] * lo16(xq[i + j]); q1 += wq[j][1] * hi16(xq[i + j]); }
                    q0 *= sigmoidf_(q0); q1 *= sigmoidf_(q1);
                    const float sq = rsqrtf(wave_sum(q0 * q0 + q1 * q1) + EPS) * 0.08838834764831845f;
                    q0 *= sq; q1 *= sq;
                    const float eg = egc_s[c];
                    *(LAS unsigned*)(lds + GP_QN + c * GP_KP + lane * 4) = pk2(q0, q1);
                    *(unsigned*)(QD + ((size_t)item * 64 + c) * 128 + perm_pos(2 * lane)) = pk2(q0 * eg, q1 * eg);
                }
            }
            __builtin_amdgcn_sched_barrier(0);
            {
                float wk[4][2];
#pragma unroll
                for (int j = 0; j < 4; ++j) { wk[j][0] = cw[j * 1536 + 512 + colq]; wk[j][1] = cw[j * 1536 + 512 + colq + 1]; }
                unsigned kd0[8], kd1[8], rk0[8], rk1[8];
#pragma unroll
                for (int i = 0; i < 8; ++i) {
                    const int c = 8 * w + i;
                    float k0 = 0.f, k1 = 0.f;
#pragma unroll
                    for (int j = 0; j < 4; ++j) { k0 += wk[j][0] * lo16(xk[i + j]); k1 += wk[j][1] * hi16(xk[i + j]); }
                    k0 *= sigmoidf_(k0); k1 *= sigmoidf_(k1);
                    const float sk = rsqrtf(wave_sum(k0 * k0 + k1 * k1) + EPS);
                    k0 *= sk; k1 *= sk;
                    const float be = beta_s[c], eg = egc_s[c], ed = edl_s[c];
                    *(LAS unsigned*)(lds + GP_KN + c * GP_KP + lane * 4) = pk2(k0, k1);
                    kd0[i] = f2bf(k0 * ed); kd1[i] = f2bf(k1 * ed);
                    rk0[i] = f2bf(k0 * be * eg); rk1[i] = f2bf(k1 * be * eg);
                }
                u32x4 o;
                o.x = rk0[0] | (rk0[1] << 16); o.y = rk0[2] | (rk0[3] << 16); o.z = rk0[4] | (rk0[5] << 16); o.w = rk0[6] | (rk0[7] << 16); *(LAS u32x4*)(lds + GP_RT + (128 + 2 * lane) * GP_RP + 16 * w) = o;
                o.x = rk1[0] | (rk1[1] << 16); o.y = rk1[2] | (rk1[3] << 16); o.z = rk1[4] | (rk1[5] << 16); o.w = rk1[6] | (rk1[7] << 16); *(LAS u32x4*)(lds + GP_RT + (128 + 2 * lane + 1) * GP_RP + 16 * w) = o;
                const int pa = perm_pos(8 * w), pb = perm_pos(8 * w + 4);
                bf16* kr0 = KDT + ((size_t)item * 128 + 2 * lane) * 64; bf16* kr1 = kr0 + 64;
                u32x2 h2;
                h2.x = kd0[0] | (kd0[1] << 16); h2.y = kd0[2] | (kd0[3] << 16); *(u32x2*)(kr0 + pa) = h2;
                h2.x = kd0[4] | (kd0[5] << 16); h2.y = kd0[6] | (kd0[7] << 16); *(u32x2*)(kr0 + pb) = h2;
                h2.x = kd1[0] | (kd1[1] << 16); h2.y = kd1[2] | (kd1[3] << 16); *(u32x2*)(kr1 + pa) = h2;
                h2.x = kd1[4] | (kd1[5] << 16); h2.y = kd1[6] | (kd1[7] << 16); *(u32x2*)(kr1 + pb) = h2;
            }
            __builtin_amdgcn_sched_barrier(0);
            {
                float wv[4][2];
#pragma unroll
                for (int j = 0; j < 4; ++j) { wv[j][0] = cw[j * 1536 + 1024 + colq]; wv[j][1] = cw[j * 1536 + 1024 + colq + 1]; }
                unsigned rv0[8], rv1[8];
#pragma unroll
                for (int i = 0; i < 8; ++i) {
                    float v0 = 0.f, v1 = 0.f;
#pragma unroll
                    for (int j = 0; j < 4; ++j) { v0 += wv[j][0] * lo16(xv[i + j]); v1 += wv[j][1] * hi16(xv[i + j]); }
                    v0 *= sigmoidf_(v0); v1 *= sigmoidf_(v1);
                    const float be = beta_s[8 * w + i];
                    rv0[i] = f2bf(v0 * be); rv1[i] = f2bf(v1 * be);
                }
                u32x4 o;
                o.x = rv0[0] | (rv0[1] << 16); o.y = rv0[2] | (rv0[3] << 16); o.z = rv0[4] | (rv0[5] << 16); o.w = rv0[6] | (rv0[7] << 16); *(LAS u32x4*)(lds + GP_RT + (2 * lane) * GP_RP + 16 * w) = o;
                o.x = rv1[0] | (rv1[1] << 16); o.y = rv1[2] | (rv1[3] << 16); o.z = rv1[4] | (rv1[5] << 16); o.w = rv1[6] | (rv1[7] << 16); *(LAS u32x4*)(lds + GP_RT + (2 * lane + 1) * GP_RP + 16 * w) = o;
            }
        }
        __syncthreads();
#pragma unroll
        for (int q = 0; q < 2; ++q) {
            const int id = 2 * w + q, ct = id >> 2, st = id & 3;
            if (st <= ct) {
                f32x4 acc = (f32x4){0.f, 0.f, 0.f, 0.f};
#pragma unroll
                for (int ks = 0; ks < 4; ++ks) {
                    const bf16x8 a = *(const LAS bf16x8*)(lds + GP_KN + (16 * ct + fr) * GP_KP + (32 * ks + 8 * fq) * 2);
                    const bf16x8 bb = *(const LAS bf16x8*)(lds + GP_KN + (16 * st + fr) * GP_KP + (32 * ks + 8 * fq) * 2);
                    acc = __builtin_amdgcn_mfma_f32_16x16x32_bf16(a, bb, acc, 0, 0, 0);
                }
                const int s = 16 * st + fr; const float gs = gc_s[s];
#pragma unroll
                for (int r = 0; r < 4; ++r) { const int c = 16 * ct + 4 * fq + r;
                    Lm[c * GP_LP + s] = (s < c) ? beta_s[c] * acc[r] * __expf(fminf(gc_s[c] - gs, 0.f)) : 0.f; }
            }
        }
        __syncthreads();
        if (w < 2) {
            const int o = 32 * w;
            float t[32];
            int zoff = 0; asm volatile("" : "+v"(zoff));
            const LAS float* Lz = Lm + zoff + o * GP_LP + o;
            const int col = lane & 31;
#pragma unroll
            for (int i = 0; i < 32; ++i) {
                float a0 = (i == lane) ? 1.f : 0.f, a1 = 0.f, a2 = 0.f, a3 = 0.f;
#pragma unroll
                for (int s4 = 0; s4 + 4 <= i; s4 += 4) { const f32x4 lv = *(const LAS f32x4*)(Lz + i * GP_LP + s4);
                    a0 -= lv[0] * t[s4]; a1 -= lv[1] * t[s4 + 1]; a2 -= lv[2] * t[s4 + 2]; a3 -= lv[3] * t[s4 + 3]; }
#pragma unroll
                for (int s = i & ~3; s < i; ++s) a0 -= Lz[i * GP_LP + s] * t[s];
                t[i] = (lane < 32) ? (a0 + a1) + (a2 + a3) : 0.f;
                const bf16 tb = (bf16)f2bf(t[i]);
                if (w == 0) { *(LAS bf16*)(lds + GP_TB + i * GP_TP + lane * 2) = tb;
                              if (lane < 32) *(LAS bf16*)(lds + GP_T0T + lane * 80 + i * 2) = tb; }
                else if (lane < 32) *(LAS bf16*)(lds + GP_TB + (32 + i) * GP_TP + (32 + col) * 2) = tb;
                if ((i & 3) == 3) __builtin_amdgcn_sched_barrier(0);
            }
        } else {
            for (int id = w - 2; id < 16; id += 6) {
                const int ct = id >> 2, st = id & 3;
                f32x4 acc = (f32x4){0.f, 0.f, 0.f, 0.f};
                if (st <= ct) {
#pragma unroll
                    for (int ks = 0; ks < 4; ++ks) {
                        const bf16x8 a = *(const LAS bf16x8*)(lds + GP_QN + (16 * ct + fr) * GP_KP + (32 * ks + 8 * fq) * 2);
                        const bf16x8 bb = *(const LAS bf16x8*)(lds + GP_KN + (16 * st + fr) * GP_KP + (32 * ks + 8 * fq) * 2);
                        acc = __builtin_amdgcn_mfma_f32_16x16x32_bf16(a, bb, acc, 0, 0, 0);
                    }
                }
                const int s = 16 * st + fr; const float gs = gc_s[s]; const int ps = perm_pos(s);
#pragma unroll
                for (int r = 0; r < 4; ++r) { const int c = 16 * ct + 4 * fq + r;
                    const float v = (s <= c) ? acc[r] * __expf(fminf(gc_s[c] - gs, 0.f)) : 0.f;
                    AIP[((size_t)item * 64 + c) * 64 + ps] = (bf16)f2bf(v); }
            }
        }
        __syncthreads();
        if (w == 0) {
            f32x4 P[2][2];
#pragma unroll
            for (int it = 0; it < 2; ++it) {
                const LAS float* lr = Lm + (32 + 16 * it + fr) * GP_LP + 8 * fq;
                const f32x4 l0 = *(const LAS f32x4*)lr, l1 = *(const LAS f32x4*)(lr + 4);
                u32x4 pk; pk.x = cvtpk(l0[0], l0[1]); pk.y = cvtpk(l0[2], l0[3]); pk.z = cvtpk(l1[0], l1[1]); pk.w = cvtpk(l1[2], l1[3]);
                const bf16x8 a = __builtin_bit_cast(bf16x8, pk);
#pragma unroll
                for (int jt = 0; jt < 2; ++jt) {
                    const bf16x8 bb = *(const LAS bf16x8*)(lds + GP_T0T + (16 * jt + fr) * 80 + 16 * fq);
                    P[it][jt] = __builtin_amdgcn_mfma_f32_16x16x32_bf16(a, bb, (f32x4){0.f, 0.f, 0.f, 0.f}, 0, 0, 0);
                }
            }
#pragma unroll
            for (int jt = 0; jt < 2; ++jt) {
                u32x4 pk; pk.x = cvtpk(P[0][jt][0], P[0][jt][1]); pk.y = cvtpk(P[0][jt][2], P[0][jt][3]); pk.z = cvtpk(P[1][jt][0], P[1][jt][1]); pk.w = cvtpk(P[1][jt][2], P[1][jt][3]);
                const bf16x8 pb = __builtin_bit_cast(bf16x8, pk);
#pragma unroll
                for (int i2 = 0; i2 < 2; ++i2) {
                    const LAS unsigned char* tr = lds + GP_TB + (32 + 16 * i2 + fr) * GP_TP + (32 + 4 * fq) * 2;
                    const u32x2 ta = *(const LAS u32x2*)tr, tb2 = *(const LAS u32x2*)(tr + 32);
                    u32x4 ak; ak.x = ta.x; ak.y = ta.y; ak.z = tb2.x; ak.w = tb2.y;
                    const f32x4 r = __builtin_amdgcn_mfma_f32_16x16x32_bf16(__builtin_bit_cast(bf16x8, ak), pb, (f32x4){0.f, 0.f, 0.f, 0.f}, 0, 0, 0);
#pragma unroll
                    for (int q = 0; q < 4; ++q) *(LAS bf16*)(lds + GP_TB + (32 + 16 * i2 + 4 * fq + q) * GP_TP + (16 * jt + fr) * 2) = (bf16)f2bf(-r[q]);
                }
            }
        }
        __syncthreads();
#pragma unroll
        for (int q = 0; q < 2; ++q) {
            const int colt = 2 * w + q;
            bf16x8 af[2];
#pragma unroll
            for (int ks = 0; ks < 2; ++ks) af[ks] = *(const LAS bf16x8*)(lds + GP_RT + (16 * colt + fr) * GP_RP + (32 * ks + 8 * fq) * 2);
#pragma unroll
            for (int ct = 0; ct < 4; ++ct) {
                f32x4 acc = (f32x4){0.f, 0.f, 0.f, 0.f};
#pragma unroll
                for (int ks = 0; ks < 2; ++ks) {
                    const bf16x8 bb = *(const LAS bf16x8*)(lds + GP_TB + (16 * ct + fr) * GP_TP + (32 * ks + 8 * fq) * 2);
                    acc = __builtin_amdgcn_mfma_f32_16x16x32_bf16(af[ks], bb, acc, 0, 0, 0);
                }
                const int c = 16 * ct + fr;
                if (colt < 8) {
#pragma unroll
                    for (int r = 0; r < 4; ++r) UT[((size_t)item * 128 + 16 * colt + 4 * fq + r) * 64 + c] = (bf16)f2bf(acc[r]);
                } else {
                    const int kt = colt - 8;
                    u32x2 h2; h2.x = pk2(-acc[0], -acc[1]); h2.y = pk2(-acc[2], -acc[3]);
                    *(u32x2*)(WP + ((size_t)item * 64 + c) * 128 + 32 * (kt >> 1) + 8 * fq + 4 * (kt & 1)) = h2;
                }
            }
        }
    }
    __syncthreads();
}

constexpr int GS_WP = 0, GS_QD = 17408, GS_AIP = 34816, GS_KDT = 44032, GS_BUF = 62464, GS_OB = 2 * GS_BUF, GS_OBP = 272;
__device__ void phase_gdn_scan(const Params& p, int L, LAS unsigned char* lds, int bid, int nblk) {
    const int tid = tidx(), lane = tid & 63, w = __builtin_amdgcn_readfirstlane(tid >> 6), fr = lane & 15, fq = lane >> 4;
    const bf16* proj = (const bf16*)(p.ws + WS_PROJ);
    const bf16* WP = (const bf16*)(p.ws + GD_WP); const bf16* QD = (const bf16*)(p.ws + GD_QD); const bf16* AIP = (const bf16*)(p.ws + GD_AIP);
    const bf16* KDT = (const bf16*)(p.ws + GD_KDT); const bf16* UT = (const bf16*)(p.ws + GD_UT); const float* GL = (const float*)(p.ws + GD_GL);
    bf16* obuf = (bf16*)(p.ws + WS_OBUF);
    for (int item = bid; item < 32; item += nblk) {
        const int hh = item & 3, b = item >> 2;
        const int fc = tid >> 4, fv = tid & 15;
        float gn[8];
#pragma unroll
        for (int i = 0; i < 8; ++i) gn[i] = p.gdn_norm_g[L * 128 + 8 * fv + i];
        f32x4 S[8];
#pragma unroll
        for (int kt = 0; kt < 8; ++kt) S[kt] = (f32x4){0.f, 0.f, 0.f, 0.f};
        u32x4 st[7];
        auto gload = [&](int ci) {
#pragma unroll
            for (int i = 0; i < 7; ++i) {
                const int pc = tid + 512 * i;
                const bf16* src;
                if (i < 2) src = WP + (size_t)ci * 8192 + pc * 8;
                else if (i < 4) src = QD + (size_t)ci * 8192 + (pc - 1024) * 8;
                else if (i < 5) src = AIP + (size_t)ci * 4096 + (pc - 2048) * 8;
                else src = KDT + (size_t)ci * 8192 + (pc - 2560) * 8;
                st[i] = *(const u32x4*)src;
            }
        };
        auto lstore = [&](int buf) {
#pragma unroll
            for (int i = 0; i < 7; ++i) {
                const int pc = tid + 512 * i;
                int off;
                if (i < 2) off = GS_WP + (pc >> 4) * 272 + (pc & 15) * 16;
                else if (i < 4) { const int q = pc - 1024; off = GS_QD + (q >> 4) * 272 + (q & 15) * 16; }
                else if (i < 5) { const int q = pc - 2048; off = GS_AIP + (q >> 3) * 144 + (q & 7) * 16; }
                else { const int q = pc - 2560; off = GS_KDT + (q >> 3) * 144 + (q & 7) * 16; }
                *(LAS u32x4*)(lds + buf * GS_BUF + off) = st[i];
            }
        };
        __syncthreads();
        gload(item * 32); lstore(0);
        u32x2 ut[4]; float gl;
        {
            const int ci = item * 32;
#pragma unroll
            for (int ct = 0; ct < 4; ++ct) ut[ct] = *(const u32x2*)(UT + ((size_t)ci * 128 + 16 * w + fr) * 64 + 16 * ct + 4 * fq);
            gl = GL[ci];
        }
        __syncthreads();
        for (int n = 0; n < 32; ++n) {
            const int ci = item * 32 + n, buf = n & 1;
            const size_t rowc = (size_t)b * SEQ + n * 64;
            u32x2 utn[4]; float gln = 0.f;
            if (n + 1 < 32) {
                gload(ci + 1);
#pragma unroll
                for (int ct = 0; ct < 4; ++ct) utn[ct] = *(const u32x2*)(UT + ((size_t)(ci + 1) * 128 + 16 * w + fr) * 64 + 16 * ct + 4 * fq);
                gln = GL[ci + 1];
            }
            u32x4 zq[2];
#pragma unroll
            for (int ps = 0; ps < 2; ++ps) zq[ps] = *(const u32x4*)(proj + (rowc + 32 * ps + fc) * PROJ_W + 3072 + hh * 128 + 8 * fv);
            f32x4 vn[4], oacc[4];
#pragma unroll
            for (int ct = 0; ct < 4; ++ct) { vn[ct] = (f32x4){lo16(ut[ct].x), hi16(ut[ct].x), lo16(ut[ct].y), hi16(ut[ct].y)}; oacc[ct] = (f32x4){0.f, 0.f, 0.f, 0.f}; }
            bf16x8 sb[4];
#pragma unroll
            for (int ks = 0; ks < 4; ++ks) { u32x4 pk; pk.x = cvtpk(S[2 * ks][0], S[2 * ks][1]); pk.y = cvtpk(S[2 * ks][2], S[2 * ks][3]); pk.z = cvtpk(S[2 * ks + 1][0], S[2 * ks + 1][1]); pk.w = cvtpk(S[2 * ks + 1][2], S[2 * ks + 1][3]);
                sb[ks] = __builtin_bit_cast(bf16x8, pk); }
            LAS unsigned char* bb = lds + buf * GS_BUF;
            bf16x8 f0[8], f1[8];
#define LD_A(F, ct) do { _Pragma("unroll") for (int ks = 0; ks < 4; ++ks) { F[ks] = *(const LAS bf16x8*)(bb + GS_WP + (16 * (ct) + fr) * 272 + (32 * ks + 8 * fq) * 2); \
                    F[4 + ks] = *(const LAS bf16x8*)(bb + GS_QD + (16 * (ct) + fr) * 272 + (32 * ks + 8 * fq) * 2); } } while (0)
#define MM_A(F, ct) do { _Pragma("unroll") for (int ks = 0; ks < 4; ++ks) { vn[ct] = __builtin_amdgcn_mfma_f32_16x16x32_bf16(F[ks], sb[ks], vn[ct], 0, 0, 0); \
                    oacc[ct] = __builtin_amdgcn_mfma_f32_16x16x32_bf16(F[4 + ks], sb[ks], oacc[ct], 0, 0, 0); } } while (0)
#define SBAR() __builtin_amdgcn_sched_barrier(0)
            LD_A(f0, 0); SBAR();
            LD_A(f1, 1); MM_A(f0, 0); SBAR();
            LD_A(f0, 2); MM_A(f1, 1); SBAR();
            LD_A(f1, 3); MM_A(f0, 2); SBAR();
#pragma unroll
            for (int ct = 0; ct < 4; ++ct)
#pragma unroll
                for (int ss = 0; ss < 2; ++ss) f0[2 * ct + ss] = *(const LAS bf16x8*)(bb + GS_AIP + (16 * ct + fr) * 144 + (32 * ss + 8 * fq) * 2);
            MM_A(f1, 3); SBAR();
            bf16x8 vb[2];
#pragma unroll
            for (int ss = 0; ss < 2; ++ss) { u32x4 pk; pk.x = cvtpk(vn[2 * ss][0], vn[2 * ss][1]); pk.y = cvtpk(vn[2 * ss][2], vn[2 * ss][3]); pk.z = cvtpk(vn[2 * ss + 1][0], vn[2 * ss + 1][1]); pk.w = cvtpk(vn[2 * ss + 1][2], vn[2 * ss + 1][3]);
                vb[ss] = __builtin_bit_cast(bf16x8, pk); }
#pragma unroll
            for (int kt = 0; kt < 4; ++kt)
#pragma unroll
                for (int ss = 0; ss < 2; ++ss) f1[2 * kt + ss] = *(const LAS bf16x8*)(bb + GS_KDT + (16 * kt + fr) * 144 + (32 * ss + 8 * fq) * 2);
#pragma unroll
            for (int ct = 0; ct < 4; ++ct)
#pragma unroll
                for (int ss = 0; ss < 2; ++ss) oacc[ct] = __builtin_amdgcn_mfma_f32_16x16x32_bf16(f0[2 * ct + ss], vb[ss], oacc[ct], 0, 0, 0);
            SBAR();
#pragma unroll
            for (int kt = 4; kt < 8; ++kt)
#pragma unroll
                for (int ss = 0; ss < 2; ++ss) f0[2 * (kt - 4) + ss] = *(const LAS bf16x8*)(bb + GS_KDT + (16 * kt + fr) * 144 + (32 * ss + 8 * fq) * 2);
#pragma unroll
            for (int kt = 0; kt < 4; ++kt) {
                S[kt] = S[kt] * gl;
#pragma unroll
                for (int ss = 0; ss < 2; ++ss) S[kt] = __builtin_amdgcn_mfma_f32_16x16x32_bf16(f1[2 * kt + ss], vb[ss], S[kt], 0, 0, 0);
            }
            SBAR();
#pragma unroll
            for (int kt = 4; kt < 8; ++kt) {
                S[kt] = S[kt] * gl;
#pragma unroll
                for (int ss = 0; ss < 2; ++ss) S[kt] = __builtin_amdgcn_mfma_f32_16x16x32_bf16(f0[2 * (kt - 4) + ss], vb[ss], S[kt], 0, 0, 0);
            }
#undef LD_A
#undef MM_A
#undef SBAR
            LDS_BARRIER();
#pragma unroll
            for (int ct = 0; ct < 4; ++ct)
#pragma unroll
                for (int r = 0; r < 4; r += 2) {
                    const unsigned pk = cvtpk(oacc[ct][r], oacc[ct][r + 1]);
                    *(LAS bf16*)(lds + GS_OB + (16 * ct + 4 * fq + r) * GS_OBP + (16 * w + fr) * 2) = (bf16)(pk & 0xffffu);
                    *(LAS bf16*)(lds + GS_OB + (16 * ct + 4 * fq + r + 1) * GS_OBP + (16 * w + fr) * 2) = (bf16)(pk >> 16);
                }
            if (n + 1 < 32) {
                lstore(buf ^ 1);
#pragma unroll
                for (int ct = 0; ct < 4; ++ct) ut[ct] = utn[ct];
                gl = gln;
            }
            LDS_BARRIER();
#pragma unroll
            for (int ps = 0; ps < 2; ++ps) {
                const int c = 32 * ps + fc;
                const u32x4 ov = *(const LAS u32x4*)(lds + GS_OB + c * GS_OBP + fv * 16);
                float o8[8];
#pragma unroll
                for (int i = 0; i < 4; ++i) { o8[2 * i] = lo16(ov[i]); o8[2 * i + 1] = hi16(ov[i]); }
                float ss = 0.f;
#pragma unroll
                for (int i = 0; i < 8; ++i) ss += o8[i] * o8[i];
                const float rn = rsqrtf(row16_sum(ss) * (1.f / 128.f) + EPS);
                u32x4 res;
#pragma unroll
                for (int i = 0; i < 4; ++i) {
                    const float z0 = lo16(zq[ps][i]), z1 = hi16(zq[ps][i]);
                    res[i] = cvtpk(o8[2 * i] * rn * gn[2 * i] * (z0 * sigmoidf_(z0)), o8[2 * i + 1] * rn * gn[2 * i + 1] * (z1 * sigmoidf_(z1)));
                }
                *(u32x4*)(obuf + (rowc + c) * D + 512 + hh * 128 + 8 * fv) = res;
            }
        }
        __syncthreads();
    }
}

__device__ __forceinline__ unsigned sortable(float f) { const unsigned u = __float_as_uint(f); return u ^ ((unsigned)((int)u >> 31) | 0x80000000u); }
__device__ __forceinline__ float unsortable(unsigned s) { return __uint_as_float((s & 0x80000000u) ? (s ^ 0x80000000u) : ~s); }
#define CE(a, b) do { const unsigned _x = k[a], _y = k[b]; k[a] = _x > _y ? _x : _y; k[b] = _x > _y ? _y : _x; } while (0)
constexpr int PE_TK = 0, PE_TAB = 8192, PE_ID = 8448, PE_GT = PE_ID + 32768, PE_SK = PE_GT + 32768;
__device__ void phase_peer(const Params& p, int L, LAS unsigned char* lds, int bid, int nblk) {
    const int tid = tidx(), lane = tid & 63, w = __builtin_amdgcn_readfirstlane(tid >> 6), fr = lane & 15, fq = lane >> 4;
    const bf16* Q2 = (const bf16*)(p.ws + WS_Q2);
    const bf16* SK = (const bf16*)(p.ws + WS_SK) + (size_t)L * 8 * 2 * 128 * 128;
    float* H = (float*)(p.ws + WS_H); bf16* HB2 = (bf16*)(p.ws + WS_HB2);
    const unsigned char* U = p.ws + WS_U + (size_t)L * NEXP * D;
    const unsigned char* V = p.ws + WS_V + (size_t)L * NEXP * D;
    const float* SU = (const float*)(p.ws + WS_SU) + (size_t)L * NEXP; const float* SV = (const float*)(p.ws + WS_SV) + (size_t)L * NEXP;
    const float* g = p.ln_ffn_g + L * D;
    LAS unsigned* TK = (LAS unsigned*)(lds + PE_TK);
    LAS unsigned short* TAB = (LAS unsigned short*)(lds + PE_TAB);
    LAS int* IDL = (LAS int*)(lds + PE_ID); LAS float* GTL = (LAS float*)(lds + PE_GT);
    if (tid < 64) {
        int a = 0, base = 0, q = tid; unsigned short v = 0xffff;
        if (q < 50) { for (;;) { const int cnt = 16 / (a + 1); if (q < base + cnt) break; base += cnt; ++a; } v = (unsigned short)((a << 8) | (q - base)); }
        TAB[tid] = v;
    }
    for (int item = bid; item < M / 64; item += nblk) {
        const int tok0 = item * 64;
        __syncthreads();
        const int tg = w & 3, cc = w >> 2;
#define SK_FETCH(hd) do { _Pragma("unroll") for (int i = 0; i < 8; ++i) { const int pc = tid + 512 * i, nn = (pc >> 4) & 127; \
            __builtin_amdgcn_global_load_lds((const unsigned*)(SK + ((size_t)((hd) * 2 + (pc >> 11)) * 128 + nn) * 128 + (((pc & 15) ^ (nn & 15)) * 8)), \
                                             (LAS unsigned*)(lds + PE_SK + (w * 64 + 512 * i) * 16), 16, 0, 0); } } while (0)
        SK_FETCH(0);
        asm volatile("s_waitcnt vmcnt(0)" ::: "memory");
        __syncthreads();
        for (int hh = 0; hh < 8; ++hh) {
            {
                f32x4 acc[8];
#pragma unroll
                for (int nt = 0; nt < 8; ++nt) acc[nt] = (f32x4){0.f, 0.f, 0.f, 0.f};
                bf16x8 qa[4];
#pragma unroll
                for (int ks = 0; ks < 4; ++ks) qa[ks] = *(const bf16x8*)(Q2 + (size_t)(tok0 + 16 * tg + fr) * 2048 + hh * 256 + cc * 128 + 32 * ks + 8 * fq);
                const LAS unsigned char* skb = lds + PE_SK + cc * 32768 + fr * 256;
#pragma unroll
                for (int nt = 0; nt < 8; ++nt)
#pragma unroll
                    for (int ks = 0; ks < 4; ++ks) {
                        const bf16x8 kb = *(const LAS bf16x8*)(skb + nt * 4096 + (((4 * ks + fq) ^ fr) << 4));
                        acc[nt] = __builtin_amdgcn_mfma_f32_16x16x32_bf16(qa[ks], kb, acc[nt], 0, 0, 0);
                    }
#pragma unroll
                for (int r = 0; r < 4; ++r) {
                    unsigned k[8];
#pragma unroll
                    for (int nt = 0; nt < 8; ++nt) k[nt] = (sortable(acc[nt][r]) & ~0x7Fu) | (unsigned)(127 - (16 * nt + fr));
                    CE(0, 1); CE(2, 3); CE(4, 5); CE(6, 7); CE(0, 2); CE(1, 3); CE(4, 6); CE(5, 7); CE(1, 2); CE(5, 6); CE(0, 4); CE(3, 7);
                    CE(1, 5); CE(2, 6); CE(1, 4); CE(3, 6); CE(2, 4); CE(3, 5); CE(3, 4);
                    unsigned res = 0u;
#pragma unroll
                    for (int rd = 0; rd < 16; ++rd) {
                        const unsigned m = row16_umax(k[0]);
                        const bool win = k[0] == m;
#pragma unroll
                        for (int i = 0; i < 7; ++i) k[i] = win ? k[i + 1] : k[i];
                        k[7] = win ? 0u : k[7];
                        res = (fr == rd) ? m : res;
                    }
                    TK[(cc * 64 + 16 * tg + 4 * fq + r) * 16 + fr] = res;
                }
            }
            __syncthreads();
            if (hh + 1 < 8) SK_FETCH(hh + 1);
#pragma unroll
            for (int ps = 0; ps < 2; ++ps) {
                const int tl = 8 * w + 4 * ps + fq;
                unsigned k[4];
#pragma unroll
                for (int sl = 0; sl < 4; ++sl) {
                    const int q = sl * 16 + fr;
                    const unsigned ab = TAB[q];
                    const unsigned k1 = TK[tl * 16 + ((ab >> 8) & 15)], k2 = TK[(64 + tl) * 16 + (ab & 15)];
                    const float v = unsortable(k1 & ~0x7Fu) + unsortable(k2 & ~0x7Fu);
                    k[sl] = (q < 50) ? ((sortable(v) & ~0x3Fu) | (unsigned)(63 - q)) : 0u;
                }
                CE(0, 1); CE(2, 3); CE(0, 2); CE(1, 3); CE(1, 2);
                unsigned res = 0u;
#pragma unroll
                for (int rd = 0; rd < 16; ++rd) {
                    const unsigned m = row16_umax(k[0]);
                    const bool win = k[0] == m;
                    k[0] = win ? k[1] : k[0]; k[1] = win ? k[2] : k[1]; k[2] = win ? k[3] : k[2]; k[3] = win ? 0u : k[3];
                    res = (fr == rd) ? m : res;
                }
                const unsigned ab = TAB[63 - (res & 0x3Fu)];
                const unsigned k1 = TK[tl * 16 + ((ab >> 8) & 15)], k2 = TK[(64 + tl) * 16 + (ab & 15)];
                const float v = unsortable(k1 & ~0x7Fu) + unsortable(k2 & ~0x7Fu);
                const float e = __expf(v - row16_max(v));
                const float sum = row16_sum(e);
                IDL[tl * 128 + hh * 16 + fr] = (int)((127u - (k1 & 0x7Fu)) * 128u + (127u - (k2 & 0x7Fu)));
                GTL[tl * 128 + hh * 16 + fr] = e / sum;
            }
            asm volatile("s_waitcnt vmcnt(0)" ::: "memory");
            __syncthreads();
        }
#undef SK_FETCH
        for (int ti = 0; ti < 8; ++ti) {
            const int tl = 8 * w + ti, tok = tok0 + tl;
            const float* hrow = H + (size_t)tok * D + 16 * lane;
            float xn[16];
#pragma unroll
            for (int j = 0; j < 4; ++j) { const f32x4 a = *(const f32x4*)(hrow + 4 * j); xn[4 * j] = a[0]; xn[4 * j + 1] = a[1]; xn[4 * j + 2] = a[2]; xn[4 * j + 3] = a[3]; }
            float ss = 0.f;
#pragma unroll
            for (int i = 0; i < 16; ++i) ss += xn[i] * xn[i];
            const float rstd = rsqrtf(wave_sum(ss) * (1.f / D) + EPS);
            float mx = 0.f;
#pragma unroll
            for (int i = 0; i < 16; ++i) { xn[i] = xn[i] * rstd * g[16 * lane + i]; mx = fmaxf(mx, fabsf(xn[i])); }
            mx = xrow16_max(row16_max(mx));
            const float xinv = mx > 0.f ? 127.f / mx : 0.f, sx = mx * (1.f / 127.f);
            int xq[4];
#pragma unroll
            for (int j = 0; j < 4; ++j) xq[j] = (int)(((unsigned)__float2int_rn(xn[4 * j] * xinv) & 0xffu) | (((unsigned)__float2int_rn(xn[4 * j + 1] * xinv) & 0xffu) << 8) |
                                                      (((unsigned)__float2int_rn(xn[4 * j + 2] * xinv) & 0xffu) << 16) | ((unsigned)__float2int_rn(xn[4 * j + 3] * xinv) << 24));
            const int id0 = IDL[tl * 128 + lane], id1 = IDL[tl * 128 + 64 + lane];
            const float su0 = SU[id0], su1 = SU[id1], sv0 = SV[id0], sv1 = SV[id1];
            int h0i = 0, h1i = 0;
            u32x4 ring[16];
#pragma unroll
            for (int j = 0; j < 16; ++j) ring[j] = *(const u32x4*)(U + (size_t)IDL[tl * 128 + j] * D + 16 * lane);
#pragma unroll 1
            for (int k = 0; k < 8; ++k) {
#pragma unroll
                for (int j = 0; j < 16; ++j) {
                    const u32x4 a = ring[j];
                    if (k < 7) ring[j] = *(const u32x4*)(U + (size_t)IDL[tl * 128 + 16 * (k + 1) + j] * D + 16 * lane);
                    int d = __builtin_amdgcn_sdot4((int)a[0], xq[0], 0, false);
                    d = __builtin_amdgcn_sdot4((int)a[1], xq[1], d, false); d = __builtin_amdgcn_sdot4((int)a[2], xq[2], d, false); d = __builtin_amdgcn_sdot4((int)a[3], xq[3], d, false);
                    d = wave_isum(d);
                    const int e = 16 * k + j;
                    if (lane == (e & 63)) { if (k < 4) h0i = d; else h1i = d; }
                }
            }
            const float h0 = su0 * sx * (float)h0i, h1 = su1 * sx * (float)h1i;
            GTL[tl * 128 + lane] = sv0 * GTL[tl * 128 + lane] * gelu_erf(h0);
            GTL[tl * 128 + 64 + lane] = sv1 * GTL[tl * 128 + 64 + lane] * gelu_erf(h1);
        }
        for (int ti = 0; ti < 8; ++ti) {
            const int tl = 8 * w + ti, tok = tok0 + tl;
            float* hrow = H + (size_t)tok * D + 16 * lane;
            float xv[16];
#pragma unroll
            for (int j = 0; j < 4; ++j) { const f32x4 a = *(const f32x4*)(hrow + 4 * j); xv[4 * j] = a[0]; xv[4 * j + 1] = a[1]; xv[4 * j + 2] = a[2]; xv[4 * j + 3] = a[3]; }
            const float w0 = GTL[tl * 128 + lane], w1 = GTL[tl * 128 + 64 + lane];
            const float wmx = xrow16_max(row16_max(fmaxf(fabsf(w0), fabsf(w1))));
            const float winv = wmx > 0.f ? 127.f / wmx : 0.f, sw = wmx * (1.f / 127.f);
            const f32x4 wv = *(const LAS f32x4*)(GTL + tl * 128 + 4 * (lane & 31));
            const int wq = (int)(((unsigned)__float2int_rn(wv[0] * winv) & 0xffu) | (((unsigned)__float2int_rn(wv[1] * winv) & 0xffu) << 8) |
                                 (((unsigned)__float2int_rn(wv[2] * winv) & 0xffu) << 16) | ((unsigned)__float2int_rn(wv[3] * winv) << 24));
            int yi[16];
#pragma unroll
            for (int i = 0; i < 16; ++i) yi[i] = 0;
            u32x4 ring[16];
#pragma unroll
            for (int j = 0; j < 16; ++j) ring[j] = *(const u32x4*)(V + (size_t)IDL[tl * 128 + j] * D + 16 * lane);
#pragma unroll 1
            for (int k = 0; k < 8; ++k) {
#pragma unroll
                for (int g4 = 0; g4 < 4; ++g4) {
                    const u32x4 a0 = ring[4 * g4], a1 = ring[4 * g4 + 1], a2 = ring[4 * g4 + 2], a3 = ring[4 * g4 + 3];
                    if (k < 7) {
#pragma unroll
                        for (int q = 0; q < 4; ++q) ring[4 * g4 + q] = *(const u32x4*)(V + (size_t)IDL[tl * 128 + 16 * (k + 1) + 4 * g4 + q] * D + 16 * lane);
                    }
                    const int wg = __builtin_amdgcn_readlane(wq, 4 * k + g4);
#pragma unroll
                    for (int q = 0; q < 4; ++q) {
                        const unsigned p0 = __builtin_amdgcn_perm(a1[q], a0[q], 0x05010400u), p1 = __builtin_amdgcn_perm(a1[q], a0[q], 0x07030602u);
                        const unsigned p2 = __builtin_amdgcn_perm(a3[q], a2[q], 0x05010400u), p3 = __builtin_amdgcn_perm(a3[q], a2[q], 0x07030602u);
                        yi[4 * q] = __builtin_amdgcn_sdot4((int)__builtin_amdgcn_perm(p2, p0, 0x05040100u), wg, yi[4 * q], false);
                        yi[4 * q + 1] = __builtin_amdgcn_sdot4((int)__builtin_amdgcn_perm(p2, p0, 0x07060302u), wg, yi[4 * q + 1], false);
                        yi[4 * q + 2] = __builtin_amdgcn_sdot4((int)__builtin_amdgcn_perm(p3, p1, 0x05040100u), wg, yi[4 * q + 2], false);
                        yi[4 * q + 3] = __builtin_amdgcn_sdot4((int)__builtin_amdgcn_perm(p3, p1, 0x07060302u), wg, yi[4 * q + 3], false);
                    }
                }
            }
            float y[16];
#pragma unroll
            for (int i = 0; i < 16; ++i) y[i] = xv[i] + sw * (float)yi[i];
#pragma unroll
            for (int j = 0; j < 4; ++j) *(f32x4*)(hrow + 4 * j) = (f32x4){y[4 * j], y[4 * j + 1], y[4 * j + 2], y[4 * j + 3]};
            bf16* hb = HB2 + (size_t)tok * D + 16 * lane;
            u32x4 o; o.x = pk2(y[0], y[1]); o.y = pk2(y[2], y[3]); o.z = pk2(y[4], y[5]); o.w = pk2(y[6], y[7]);
            *(u32x4*)hb = o;
            o.x = pk2(y[8], y[9]); o.y = pk2(y[10], y[11]); o.z = pk2(y[12], y[13]); o.w = pk2(y[14], y[15]);
            *(u32x4*)(hb + 8) = o;
        }
    }
    __syncthreads();
}
#undef CE

__device__ void phase_final(const Params& p, int bid, int nblk) {
    const int tid = tidx(), lane = tid & 63, gw = bid * NWAVES + (tid >> 6), NGW = nblk * NWAVES;
    const float* H = (const float*)(p.ws + WS_H);
    for (int m = gw; m < M; m += NGW) {
        f32x4 v[4]; float ss = 0.f;
#pragma unroll
        for (int j = 0; j < 4; ++j) { v[j] = ((const f32x4*)(H + (size_t)m * D))[lane + 64 * j]; ss += (v[j][0] * v[j][0] + v[j][1] * v[j][1]) + (v[j][2] * v[j][2] + v[j][3] * v[j][3]); }
        const float r = rsqrtf(wave_sum(ss) * (1.f / D) + EPS);
#pragma unroll
        for (int j = 0; j < 4; ++j) { const f32x4 gv = ((const f32x4*)p.final_g)[lane + 64 * j]; ((f32x4*)(p.out + (size_t)m * D))[lane + 64 * j] = v[j] * r * gv; }
    }
}

#define XB_TMO      128
#define XB_XCNT(j)  (256  + 64 * (j))
#define XB_XSUB(j)  (1280 + 64 * (j))
#define XB_XGEN(j)  (2304 + 64 * (j))
#define XB_TOP      3328
#define XB_TOPGEN   3392
#define XCD_BAR_WORDS 3456
#define XB_SPIN_CAP (1u << 22)
__device__ __forceinline__ unsigned xb_ld(unsigned* p)              { return __hip_atomic_load(p, __ATOMIC_RELAXED, __HIP_MEMORY_SCOPE_AGENT); }
__device__ __forceinline__ unsigned xb_add(unsigned* p, unsigned v) { return __hip_atomic_fetch_add(p, v, __ATOMIC_RELAXED, __HIP_MEMORY_SCOPE_AGENT); }
__device__ __forceinline__ unsigned xb_xcc_id() { return (unsigned)__builtin_amdgcn_s_getreg((3 << 11) | 20) & 0xFu; }
#define XB_SPIN(cond, bar) do { unsigned _sp = 0; while (cond) { __builtin_amdgcn_s_sleep(1); \
    if ((++_sp & 255u) == 0u) { if (xb_ld(&(bar)[XB_TMO])) break; if (_sp > XB_SPIN_CAP) { atomicAdd(&(bar)[XB_TMO], 1u); break; } } } } while (0)
struct XcdBarrier { unsigned* bar; unsigned x; volatile LAS unsigned* st; };
__device__ __forceinline__ XcdBarrier xcd_barrier_post(unsigned* bar, volatile LAS unsigned* st) {
    XcdBarrier b; b.bar = bar; b.x = xb_xcc_id(); b.st = st;
    if (threadIdx.x == 0) (void)xb_add(&bar[XB_XCNT(b.x)], 1u);
    return b;
}
__device__ __forceinline__ void xcd_barrier_complete(unsigned* bar, unsigned x, unsigned& nloc, unsigned& nx) {
    const unsigned G = gridDim.x * gridDim.y * gridDim.z;
    unsigned sum, cnt, mine, sp = 0u;
    for (;;) {
        sum = 0u; cnt = 0u; mine = 0u;
#pragma unroll
        for (unsigned j = 0; j < 16; ++j) { const unsigned c = xb_ld(&bar[XB_XCNT(j)]); sum += c; cnt += (c > 0u) ? 1u : 0u; mine = (j == x) ? c : mine; }
        if (sum == G) break;
        __builtin_amdgcn_s_sleep(1);
        if ((++sp & 255u) == 0u) { if (xb_ld(&bar[XB_TMO])) break; if (sp > XB_SPIN_CAP) { atomicAdd(&bar[XB_TMO], 1u); break; } }
    }
    nloc = mine > 0u ? mine : 1u; nx = cnt > 0u ? cnt : 1u;
}
__device__ __forceinline__ void xcd_barrier(const XcdBarrier& b) {
    asm volatile("s_waitcnt vmcnt(0)" ::: "memory");
    __syncthreads();
    if (threadIdx.x == 0) {
        unsigned* bar = b.bar;
        __builtin_amdgcn_s_waitcnt(0);
        unsigned nloc = b.st[0], nx = b.st[1];
        if (nloc == 0u) { xcd_barrier_complete(bar, b.x, nloc, nx); b.st[0] = nloc; b.st[1] = nx; }
        const unsigned old = xb_add(&bar[XB_XSUB(b.x)], 1u);
        const unsigned gen = old / nloc;
        if (old + 1u == (gen + 1u) * nloc) {
            __builtin_amdgcn_fence(__ATOMIC_RELEASE, "agent");
            asm volatile("s_waitcnt vmcnt(0)" ::: "memory");
            const unsigned og = xb_add(&bar[XB_TOP], 1u);
            const unsigned tg = og / nx;
            if (og + 1u == (tg + 1u) * nx) xb_add(&bar[XB_TOPGEN], 1u);
            else XB_SPIN(xb_ld(&bar[XB_TOPGEN]) == tg, bar);
            __builtin_amdgcn_fence(__ATOMIC_ACQUIRE, "agent");
            xb_add(&bar[XB_XGEN(b.x)], 1u);
            asm volatile("s_waitcnt vmcnt(0)" ::: "memory");
        } else {
            XB_SPIN(xb_ld(&bar[XB_XGEN(b.x)]) == gen, bar);
            __builtin_amdgcn_fence(__ATOMIC_ACQUIRE, "agent");
            asm volatile("s_waitcnt vmcnt(0)" ::: "memory");
        }
    }
    __syncthreads();
}
constexpr int CW_BAR = 4096;

constexpr int K_PROLOGUE = 11, K_FINAL = 12;
template <int KIND>
__device__ __forceinline__ void run_kind(const Params& p, int L, LAS unsigned char* lds, int bid, int nblk) {
    unsigned char* ws = p.ws;
    float* H = (float*)(ws + WS_H);
    float* ss0 = (float*)(ws + WS_STAT); float* ss1 = (float*)(ws + WS_SS1); float* sse = (float*)(ws + WS_SSE);
    if constexpr (KIND == K_PROLOGUE) phase_prologue(p, lds, bid, nblk);
    if constexpr (KIND == K_FINAL) phase_final(p, bid, nblk);
    if constexpr (KIND == 0) { EpiProj E{nullptr, (bf16*)(ws + WS_PROJ), (float*)(ws + WS_BA)};
        gemm_run(lds, (const bf16*)(ws + WS_HB0), (const bf16*)(ws + WS_WIN) + (size_t)L * IN_PAD * D, M, IN_PAD, D, E, bid, nblk, ss0); }
    if constexpr (KIND == 1) phase_gdn_prep(p, L, lds, bid, nblk);
    if constexpr (KIND == 2) { phase_gdn_scan(p, L, lds, bid, nblk); phase_att_queue(p, L, lds, bid, nblk); }
    if constexpr (KIND == 3) { EpiRes E{ss1, H, (bf16*)(ws + WS_HB1)};
        gemm_run(lds, (const bf16*)(ws + WS_OBUF), (const bf16*)(ws + WS_WOUT) + (size_t)L * D * D, M, D, D, E, bid, nblk); }
    if constexpr (KIND == 4) { EpiQ2 E{nullptr, (bf16*)(ws + WS_Q2)};
        gemm_run(lds, (const bf16*)(ws + WS_HB1), (const bf16*)(ws + WS_WQ) + (size_t)L * 2048 * D, M, 2048, D, E, bid, nblk, ss1); }
    if constexpr (KIND == 5) phase_peer(p, L, lds, bid, nblk);
    if constexpr (KIND == 7) { EpiE E2{sse, (bf16*)(ws + WS_EPRE)};
        gemm_run(lds, (const bf16*)(ws + WS_PB) + (size_t)L * M * 256, (const bf16*)(ws + WS_WP) + (size_t)L * D * 256, M, D, 256, E2, bid, nblk); }
    if constexpr (KIND == 6) { EpiPle E{ss0, H, (bf16*)(ws + WS_HB0), (const bf16*)(ws + WS_EPRE), p.ple_norm_g + L * D};
        gemm_run(lds, (const bf16*)(ws + WS_HB2), (const bf16*)(ws + WS_WG) + (size_t)L * D * D, M, D, D, E, bid, nblk, sse); }
}

__device__ __forceinline__ Params params_off(const Params& s, size_t z) {
    Params q;
    q.x = s.x + z; q.p = s.p + z; q.ln_mix_g = s.ln_mix_g + z; q.w_in = s.w_in + z; q.conv_w = s.conv_w + z; q.a_log = s.a_log + z; q.dt_bias = s.dt_bias + z;
    q.gdn_norm_g = s.gdn_norm_g + z; q.diff_lambda = s.diff_lambda + z; q.subln_g = s.subln_g + z; q.w_out = s.w_out + z; q.ln_ffn_g = s.ln_ffn_g + z;
    q.peer_wq = s.peer_wq + z; q.subkeys = s.subkeys + z; q.peer_u = s.peer_u + z; q.peer_v = s.peer_v + z; q.ple_wp = s.ple_wp + z; q.ple_wg = s.ple_wg + z;
    q.ple_norm_g = s.ple_norm_g + z; q.final_g = s.final_g + z; q.out = s.out + z; q.ws = s.ws + z; q.pad0 = 0; q.pad1 = 0;
    return q;
}
#define RUN(KIND) do { size_t z_ = 0; int L_ = L; asm volatile("" : "+s"(z_), "+s"(L_)); const Params q_ = params_off(p, z_); run_kind<KIND>(q_, L_, (LAS unsigned char*)lds, (int)blockIdx.x, (int)gridDim.x); } while (0)
#define GRID_BARRIER() do { XcdBarrier b_; b_.bar = (unsigned*)(p.ws + WS_CTL) + CW_BAR; b_.x = xb_xcc_id(); b_.st = (volatile LAS unsigned*)((LAS unsigned char*)lds + LDS_MISC_OFF) + 8; xcd_barrier(b_); } while (0)
__global__ void __launch_bounds__(NTHREADS, 2) mk_fwd(Params p) {
    extern __shared__ __attribute__((aligned(16))) unsigned char lds[];
    {
        volatile LAS unsigned* misc = (volatile LAS unsigned*)((LAS unsigned char*)lds + LDS_MISC_OFF);
        if (threadIdx.x < 64) misc[threadIdx.x] = 0u;
        __syncthreads();
        (void)xcd_barrier_post((unsigned*)(p.ws + WS_CTL) + CW_BAR, misc + 8);
    }
    { int L = 0; RUN(K_PROLOGUE); }
    cg::this_grid().sync();
#define LAYER(LL) do { const int L = (LL); RUN(0); GRID_BARRIER(); RUN(1); GRID_BARRIER(); RUN(2); GRID_BARRIER(); RUN(3); GRID_BARRIER(); RUN(4); GRID_BARRIER(); RUN(5); RUN(7); GRID_BARRIER(); RUN(6); GRID_BARRIER(); } while (0)
    LAYER(0); LAYER(1); LAYER(2); LAYER(3);
#undef LAYER
    { int L = 0; RUN(K_FINAL); }
}

extern "C" void kernel_launch(void* const* d_in, const int* in_sizes, int n_in, void* d_out, int out_size, void* d_ws, size_t ws_size, hipStream_t stream) {
    static int grid = 0;
    if (grid == 0) {
        if (n_in != 20 || out_size != M * D || ws_size < WS_END) { fprintf(stderr, "kernel_launch: unexpected shapes (n_in %d, out %d, ws %zu < %zu)\n", n_in, out_size, ws_size, (size_t)WS_END); grid = -1; return; }
        int dev = 0, cus = 0, per_cu = 0;
        (void)hipGetDevice(&dev); (void)hipDeviceGetAttribute(&cus, hipDeviceAttributeMultiprocessorCount, dev);
        if (hipFuncSetAttribute((const void*)mk_fwd, hipFuncAttributeMaxDynamicSharedMemorySize, LDS_BYTES) != hipSuccess) { fprintf(stderr, "kernel_launch: hipFuncSetAttribute failed\n"); grid = -1; return; }
        if (hipOccupancyMaxActiveBlocksPerMultiprocessor(&per_cu, (const void*)mk_fwd, NTHREADS, LDS_BYTES) != hipSuccess || per_cu < 1) { fprintf(stderr, "kernel_launch: occupancy query says %d blocks per CU\n", per_cu); (void)hipGetLastError(); grid = -1; return; }
        grid = (cus > 0 ? cus : 256);
    }
    if (grid < 0) return;
    (void)hipMemsetAsync((char*)d_ws + WS_CTL, 0, CTL_ZERO_BYTES, stream);
    Params p{};
    const float** pp = (const float**)&p;
    for (int i = 0; i < 20; ++i) pp[i] = (const float*)d_in[i];
    p.out = (float*)d_out; p.ws = (unsigned char*)d_ws;
    void* args[] = {&p};
    hipError_t e = hipLaunchCooperativeKernel((const void*)mk_fwd, dim3(grid), dim3(NTHREADS), args, LDS_BYTES, stream);
    if (e != hipSuccess) fprintf(stderr, "kernel_launch: cooperative launch failed: %s (grid %d)\n", hipGetErrorString(e), grid);
}
```

```cpp
#include <hip/hip_runtime.h>
#include <hip/hip_cooperative_groups.h>
#include <cstdio>
#include <cstdint>
namespace cg = cooperative_groups;

#define LAS __attribute__((address_space(3)))
typedef unsigned short bf16;
typedef float f32x4 __attribute__((ext_vector_type(4)));
typedef short bf16x8 __attribute__((ext_vector_type(8)));
typedef unsigned u32x4 __attribute__((ext_vector_type(4)));
typedef unsigned u32x2 __attribute__((ext_vector_type(2)));

constexpr int D = 1024, BATCH = 8, SEQ = 2048, DEPTH = 4, M = BATCH * SEQ;
constexpr int IN_COLS = 3592, IN_PAD = 3840, PROJ_W = 3584;
constexpr int NEXP = 16384;
constexpr float EPS = 1e-6f;
constexpr float QSCALE = 0.125f * 1.4426950408889634f;
constexpr int NWAVES = 8, NTHREADS = 512;
constexpr int LDS_BYTES = 163840;
constexpr int LDS_MISC_OFF = LDS_BYTES - 256;
constexpr int RS_OFF = 147456;
constexpr int CW_QUEUE = 1024;

constexpr size_t MiB = 1u << 20;
constexpr size_t WS_CTL = 0, CTL_ZERO_BYTES = 1 * MiB;
constexpr size_t WS_H = 1 * MiB;
constexpr size_t WS_HB0 = 65 * MiB;
constexpr size_t WS_HB1 = 97 * MiB;
constexpr size_t WS_HB2 = 129 * MiB;
constexpr size_t WS_PROJ = 161 * MiB;
constexpr size_t WS_BA = 273 * MiB;
constexpr size_t WS_OBUF = 274 * MiB;
constexpr size_t WS_Q2 = 306 * MiB;
constexpr size_t WS_EPRE = 370 * MiB;
constexpr size_t WS_IDX = 402 * MiB;
constexpr size_t WS_GATE = 410 * MiB;
constexpr size_t WS_STAT = 418 * MiB;
constexpr size_t WS_SS1 = WS_IDX + 1 * MiB, WS_SSE = WS_IDX;
constexpr size_t WS_ORAW = 422 * MiB;
constexpr size_t WS_WIN = 550 * MiB;
constexpr size_t WS_WOUT = 582 * MiB;
constexpr size_t WS_WQ = 590 * MiB;
constexpr size_t WS_WG = 606 * MiB;
constexpr size_t WS_WP = 614 * MiB;
constexpr size_t WS_SK = 616 * MiB;
constexpr size_t WS_PB = 618 * MiB;
constexpr size_t WS_U = 650 * MiB;
constexpr size_t WS_V = 778 * MiB;
constexpr size_t WS_SU = WS_STAT + 1 * MiB, WS_SV = WS_STAT + 2 * MiB;
constexpr size_t WS_END = 906 * MiB;

struct Params {
    const float *x, *p, *ln_mix_g, *w_in, *conv_w, *a_log, *dt_bias, *gdn_norm_g, *diff_lambda, *subln_g, *w_out, *ln_ffn_g,
        *peer_wq, *subkeys, *peer_u, *peer_v, *ple_wp, *ple_wg, *ple_norm_g, *final_g;
    float* out;
    unsigned char* ws;
    int pad0, pad1;
};

__device__ __forceinline__ int tidx() { int t = (int)threadIdx.x; asm volatile("" : "+v"(t)); return t; }
#define LDS_BARRIER() asm volatile("s_waitcnt lgkmcnt(0)\n\ts_barrier" ::: "memory")
__device__ __forceinline__ float bf2f(bf16 v) { return __uint_as_float((unsigned)v << 16); }
__device__ __forceinline__ unsigned f2bf(float f) { unsigned u = __float_as_uint(f); return (u + 0x7fffu + ((u >> 16) & 1u)) >> 16; }
__device__ __forceinline__ unsigned pk2(float lo, float hi) { return f2bf(lo) | (f2bf(hi) << 16); }
__device__ __forceinline__ float lo16(unsigned w) { return __uint_as_float(w << 16); }
__device__ __forceinline__ float hi16(unsigned w) { return __uint_as_float(w & 0xffff0000u); }
template <int N> __device__ __forceinline__ float dpp_ror(float x) { return __builtin_bit_cast(float, __builtin_amdgcn_mov_dpp(__builtin_bit_cast(int, x), 0x120 + N, 0xf, 0xf, true)); }
template <int N> __device__ __forceinline__ unsigned dpp_ror_u(unsigned x) { return (unsigned)__builtin_amdgcn_mov_dpp((int)x, 0x120 + N, 0xf, 0xf, true); }
__device__ __forceinline__ float row16_sum(float x) { x += dpp_ror<8>(x); x += dpp_ror<4>(x); x += dpp_ror<2>(x); x += dpp_ror<1>(x); return x; }
__device__ __forceinline__ float row16_max(float x) { x = fmaxf(x, dpp_ror<8>(x)); x = fmaxf(x, dpp_ror<4>(x)); x = fmaxf(x, dpp_ror<2>(x)); x = fmaxf(x, dpp_ror<1>(x)); return x; }
__device__ __forceinline__ unsigned row16_umax(unsigned x) { unsigned y;
    y = dpp_ror_u<8>(x); x = x > y ? x : y; y = dpp_ror_u<4>(x); x = x > y ? x : y; y = dpp_ror_u<2>(x); x = x > y ? x : y; y = dpp_ror_u<1>(x); x = x > y ? x : y; return x; }
__device__ __forceinline__ float xrow16_max(float x) {
    auto s = __builtin_amdgcn_permlane16_swap(__float_as_uint(x), __float_as_uint(x), false, false);
    x = fmaxf(__uint_as_float(s[0]), __uint_as_float(s[1]));
    auto t = __builtin_amdgcn_permlane32_swap(__float_as_uint(x), __float_as_uint(x), false, false);
    return fmaxf(__uint_as_float(t[0]), __uint_as_float(t[1]));
}
__device__ __forceinline__ float xrow16_sum(float x) {
    auto s = __builtin_amdgcn_permlane16_swap(__float_as_uint(x), __float_as_uint(x), false, false);
    x = __uint_as_float(s[0]) + __uint_as_float(s[1]);
    auto t = __builtin_amdgcn_permlane32_swap(__float_as_uint(x), __float_as_uint(x), false, false);
    return __uint_as_float(t[0]) + __uint_as_float(t[1]);
}
__device__ __forceinline__ float wave_sum(float v) { return xrow16_sum(row16_sum(v)); }
template <int N> __device__ __forceinline__ int dpp_ror_i(int x) { return __builtin_amdgcn_mov_dpp(x, 0x120 + N, 0xf, 0xf, true); }
__device__ __forceinline__ int wave_isum(int x) {
    x += dpp_ror_i<8>(x); x += dpp_ror_i<4>(x); x += dpp_ror_i<2>(x); x += dpp_ror_i<1>(x);
    auto s = __builtin_amdgcn_permlane16_swap((unsigned)x, (unsigned)x, false, false); x = (int)(s[0] + s[1]);
    auto t = __builtin_amdgcn_permlane32_swap((unsigned)x, (unsigned)x, false, false); return (int)(t[0] + t[1]);
}
__device__ __forceinline__ float wave_max(float v) {
#pragma unroll
    for (int o = 32; o; o >>= 1) v = fmaxf(v, __shfl_xor(v, o));
    return v;
}
__device__ __forceinline__ float sigmoidf_(float x) { return 1.f / (1.f + __expf(-x)); }
__device__ __forceinline__ float dot8(u32x4 a, u32x4 b, float s) {
#pragma unroll
    for (int i = 0; i < 4; ++i) { s += lo16(a[i]) * lo16(b[i]); s += hi16(a[i]) * hi16(b[i]); }
    return s;
}

__host__ __device__ __forceinline__ int lds_byte(int r, int c) { const int st = (r >> 4) * 2 + (c >> 5), rr = r & 15, cc = c & 31, ob = rr * 64 + cc * 2; return st * 1024 + (ob ^ (((ob >> 9) & 1) << 5)); }
__host__ __device__ __forceinline__ void stage_rc(int b, int& R, int& C) { const int st = b / 1024, sb = b % 1024, swz = sb ^ (((sb >> 9) & 1) << 5); R = (st >> 1) * 16 + swz / 64; C = (st & 1) * 32 + (swz % 64) / 2; }
constexpr int HTB = 16384;
template <class F>
__device__ __forceinline__ void gemm_run(LAS unsigned char* lds, const bf16* A, const bf16* Bt, int Mm, int N, int K, const F& f, int bid, int nblk, const float* slots_in = nullptr) {
    LAS float* RS = (LAS float*)(lds + RS_OFF);
    int rs_pm = -1;
    const int tid = tidx(), wid = __builtin_amdgcn_readfirstlane(tid >> 6), lane = tid & 63, wr = wid >> 2, wc = wid & 3, fr = lane & 15, fq = lane >> 4;
    const int nt = K / 64, ntn = N / 256, nunits = (Mm / 256) * ntn;
    unsigned voff[2];
#pragma unroll
    for (int i = 0; i < 2; ++i) { const int uu = tid + 512 * i, r = uu >> 3, c = (uu & 7) ^ ((r >> 1) & 7); voff[i] = (unsigned)(r * K + c * 8) * 2u; }
    const unsigned ldsw = (unsigned)wid * 1024u;
    const int sw7 = (fr >> 1) & 7;
    const int aoff0 = wr * HTB + fr * 128 + ((fq ^ sw7) << 4), aoff1 = wr * HTB + fr * 128 + (((4 + fq) ^ sw7) << 4);
    const int bbase = (2 + (wc >> 1)) * HTB + (wc & 1) * 8192 + fr * 128;
    const int boff0 = bbase + ((fq ^ sw7) << 4), boff1 = bbase + (((4 + fq) ^ sw7) << 4);
#define G_STAGE(bufoff, gbase) do { _Pragma("unroll") for (int _i = 0; _i < 2; ++_i) \
        __builtin_amdgcn_global_load_lds((const unsigned*)((const char*)(gbase) + voff[_i]), (LAS unsigned*)(lds + (bufoff) + ldsw + _i * 8192), 16, 0, 0); } while (0)
    for (int u = bid; u < nunits; u += nblk) {
        const int pm = u % (Mm / 256), pn = u / (Mm / 256);
        if (slots_in && pm != rs_pm) {
            __syncthreads();
            if (tid < 256) { const f32x4* sp = (const f32x4*)(slots_in + ((size_t)pm * 256 + tid) * 16);
                const f32x4 a = sp[0], b = sp[1], c = sp[2], d = sp[3];
                const float s = (((a[0] + a[1]) + (a[2] + a[3])) + ((b[0] + b[1]) + (b[2] + b[3]))) + (((c[0] + c[1]) + (c[2] + c[3])) + ((d[0] + d[1]) + (d[2] + d[3])));
                RS[tid] = rsqrtf(s * (1.f / D) + EPS); }
            __syncthreads();
            rs_pm = pm;
        }
        const char* gA = (const char*)(A + (size_t)pm * 256 * K);
        const char* gB = (const char*)(Bt + (size_t)pn * 256 * K);
        const size_t hstep = (size_t)128 * K * 2;
        f32x4 acc[8][4];
#pragma unroll
        for (int a = 0; a < 8; ++a)
#pragma unroll
            for (int b = 0; b < 4; ++b) acc[a][b] = (f32x4){0.f, 0.f, 0.f, 0.f};
        G_STAGE(0, gA); G_STAGE(HTB, gA + hstep); G_STAGE(2 * HTB, gB); G_STAGE(3 * HTB, gB + hstep);
        for (int t = 0; t < nt; ++t) {
            const int cb = (t & 1) * 4 * HTB, nb = ((t + 1) & 1) * 4 * HTB;
            asm volatile("s_waitcnt vmcnt(0)" ::: "memory");
            __builtin_amdgcn_s_barrier();
            asm volatile("" ::: "memory");
            const size_t ko = (size_t)(t + 1) * 128; const bool more = t + 1 < nt;
#pragma unroll
            for (int k = 0; k < 2; ++k) {
                if (more) { if (k == 0) { G_STAGE(nb, gA + ko); G_STAGE(nb + 2 * HTB, gB + ko); } else { G_STAGE(nb + HTB, gA + hstep + ko); G_STAGE(nb + 3 * HTB, gB + hstep + ko); } }
                bf16x8 bfr[4], acur, anxt;
#pragma unroll
                for (int n = 0; n < 4; ++n) bfr[n] = *(const LAS bf16x8*)(lds + cb + (k ? boff1 : boff0) + n * 2048);
                acur = *(const LAS bf16x8*)(lds + cb + (k ? aoff1 : aoff0));
#pragma unroll
                for (int m = 0; m < 8; ++m) {
                    if (m < 7) anxt = *(const LAS bf16x8*)(lds + cb + (k ? aoff1 : aoff0) + (m + 1) * 2048);
#pragma unroll
                    for (int n = 0; n < 4; ++n) acc[m][n] = __builtin_amdgcn_mfma_f32_16x16x32_bf16(bfr[n], acur, acc[m][n], 0, 0, 0);
                    acur = anxt;
                }
                __builtin_amdgcn_sched_barrier(0);
            }
            asm volatile("s_waitcnt lgkmcnt(0)" ::: "memory");
        }
#pragma unroll
        for (int m = 0; m < 8; ++m) {
            const int lrow = wr * 128 + m * 16 + fr, row = pm * 256 + lrow;
            float ssq = 0.f;
#pragma unroll
            for (int n = 0; n < 4; ++n) { const f32x4 r = f(row, RS[lrow], pn * 256 + wc * 64 + n * 16 + 4 * fq, acc[m][n]); ssq += (r[0] * r[0] + r[1] * r[1]) + (r[2] * r[2] + r[3] * r[3]); }
            if constexpr (F::STATS) { ssq = xrow16_sum(ssq); if (fq == 0) f.slots[(size_t)row * 16 + pn * 4 + wc] = ssq; }
        }
        __syncthreads();
    }
#undef G_STAGE
}

__device__ __forceinline__ u32x2 pk4(f32x4 a) { u32x2 o; o.x = pk2(a[0], a[1]); o.y = pk2(a[2], a[3]); return o; }
struct EpiProj {
    static constexpr bool STATS = false; float* slots;
    bf16* proj; float* ba;
    __device__ __forceinline__ f32x4 operator()(int row, float rstd, int col, f32x4 v) const {
        v = v * rstd;
        if (col < PROJ_W) *(u32x2*)(proj + (size_t)row * PROJ_W + col) = pk4(v);
        else if (col < IN_COLS) *(f32x4*)(ba + (size_t)row * 8 + (col - PROJ_W)) = v;
        return v;
    }
};
struct EpiRes {
    static constexpr bool STATS = true; float* slots;
    float* H; bf16* HB;
    __device__ __forceinline__ f32x4 operator()(int row, float, int col, f32x4 v) const {
        f32x4* hp = (f32x4*)(H + (size_t)row * D + col);
        const f32x4 h = *hp + v; *hp = h;
        *(u32x2*)(HB + (size_t)row * D + col) = pk4(h);
        return h;
    }
};
struct EpiQ2 {
    static constexpr bool STATS = false; float* slots;
    bf16* Q2;
    __device__ __forceinline__ f32x4 operator()(int row, float rstd, int col, f32x4 v) const { v = v * rstd; *(u32x2*)(Q2 + (size_t)row * 2048 + col) = pk4(v); return v; }
};
struct EpiE {
    static constexpr bool STATS = true; float* slots;
    bf16* E;
    __device__ __forceinline__ f32x4 operator()(int row, float, int col, f32x4 v) const { *(u32x2*)(E + (size_t)row * D + col) = pk4(v); return v; }
};
struct EpiPle {
    static constexpr bool STATS = true; float* slots;
    float* H; bf16* HB; const bf16* E; const float* g;
    __device__ __forceinline__ f32x4 operator()(int row, float rstde, int col, f32x4 v) const {
        f32x4* hp = (f32x4*)(H + (size_t)row * D + col);
        const u32x2 ev = *(const u32x2*)(E + (size_t)row * D + col);
        const f32x4 gv = *(const f32x4*)(g + col);
        f32x4 h = *hp;
        h[0] += sigmoidf_(v[0]) * (lo16(ev.x) * rstde * gv[0]); h[1] += sigmoidf_(v[1]) * (hi16(ev.x) * rstde * gv[1]);
        h[2] += sigmoidf_(v[2]) * (lo16(ev.y) * rstde * gv[2]); h[3] += sigmoidf_(v[3]) * (hi16(ev.y) * rstde * gv[3]);
        *hp = h;
        *(u32x2*)(HB + (size_t)row * D + col) = pk4(h);
        return h;
    }
};

__device__ __forceinline__ void transpose_item(const float* W, int K, int N, int Npad, bf16* WT, const float* rowscale, int qcols, float* scr, int item, int lane) {
    const int nblk = Npad / 32, kb = item / nblk, nb = item % nblk, k0 = 64 * kb, n0 = 32 * nb;
    const int n = n0 + (lane & 31);
#pragma unroll 8
    for (int i = 0; i < 32; ++i) {
        const int kk = 2 * i + (lane >> 5);
        float v = (n < N) ? W[(size_t)(k0 + kk) * N + n] : 0.f;
        if (rowscale) v *= rowscale[k0 + kk];
        if (n < qcols) v *= QSCALE;
        scr[kk * 33 + (lane & 31)] = v;
    }
    asm volatile("s_waitcnt lgkmcnt(0)" ::: "memory");
    const int c = lane & 7;
#pragma unroll
    for (int j = 0; j < 4; ++j) {
        const int nn = (lane >> 3) + 8 * j; const float* s = scr + (8 * c) * 33 + nn;
        u32x4 o; o.x = pk2(s[0 * 33], s[1 * 33]); o.y = pk2(s[2 * 33], s[3 * 33]); o.z = pk2(s[4 * 33], s[5 * 33]); o.w = pk2(s[6 * 33], s[7 * 33]);
        *(u32x4*)(WT + (size_t)(n0 + nn) * K + k0 + 8 * c) = o;
    }
    asm volatile("s_waitcnt lgkmcnt(0)" ::: "memory");
}
__device__ __forceinline__ void convert_bulk(const float* src, bf16* dst, size_t n, size_t gtid, size_t nthr) {
    for (size_t i = gtid * 8; i < n; i += nthr * 8) {
        const f32x4 a = *(const f32x4*)(src + i), b = *(const f32x4*)(src + i + 4);
        u32x4 o; o.x = pk2(a[0], a[1]); o.y = pk2(a[2], a[3]); o.z = pk2(b[0], b[1]); o.w = pk2(b[2], b[3]);
        *(u32x4*)(dst + i) = o;
    }
}
__device__ void phase_prologue(const Params& p, LAS unsigned char* lds_, int bid, int nblk) {
    unsigned char* lds = (unsigned char*)lds_;
    const int tid = tidx(), lane = tid & 63, w = tid >> 6;
    const int gw = bid * NWAVES + w, NGW = nblk * NWAVES;
    float* scr = (float*)(lds + w * 16384);
    constexpr int I_IN = 16 * (IN_PAD / 32), I_OUT = 16 * 32, I_Q = 16 * 64, I_G = 16 * 32, I_P = 4 * 32, I_L = I_IN + I_OUT + I_Q + I_G + I_P;
    for (int it = gw; it < DEPTH * I_L; it += NGW) {
        const int L = it / I_L; int r = it % I_L;
        if (r < I_IN) { transpose_item(p.w_in + (size_t)L * D * IN_COLS, D, IN_COLS, IN_PAD, (bf16*)(p.ws + WS_WIN) + (size_t)L * IN_PAD * D, p.ln_mix_g + L * D, 512, scr, r, lane); continue; } r -= I_IN;
        if (r < I_OUT) { transpose_item(p.w_out + (size_t)L * D * D, D, D, D, (bf16*)(p.ws + WS_WOUT) + (size_t)L * D * D, nullptr, 0, scr, r, lane); continue; } r -= I_OUT;
        if (r < I_Q) { transpose_item(p.peer_wq + (size_t)L * D * 2048, D, 2048, 2048, (bf16*)(p.ws + WS_WQ) + (size_t)L * 2048 * D, p.ln_ffn_g + L * D, 0, scr, r, lane); continue; } r -= I_Q;
        if (r < I_G) { transpose_item(p.ple_wg + (size_t)L * D * D, D, D, D, (bf16*)(p.ws + WS_WG) + (size_t)L * D * D, nullptr, 0, scr, r, lane); continue; } r -= I_G;
        transpose_item(p.ple_wp + (size_t)L * 256 * D, 256, D, D, (bf16*)(p.ws + WS_WP) + (size_t)L * D * 256, nullptr, 0, scr, r, lane);
    }
    const size_t gtid = (size_t)bid * NTHREADS + tid, nthr = (size_t)nblk * NTHREADS;
    for (int r = gw; r < 2 * DEPTH * NEXP; r += NGW) {
        const int which = r >= DEPTH * NEXP, rr = which ? r - DEPTH * NEXP : r;
        const float* srow = (which ? p.peer_v : p.peer_u) + (size_t)rr * D + 16 * lane;
        f32x4 v[4];
#pragma unroll
        for (int j = 0; j < 4; ++j) v[j] = *(const f32x4*)(srow + 4 * j);
        float mx = 0.f;
#pragma unroll
        for (int j = 0; j < 4; ++j) mx = fmaxf(mx, fmaxf(fmaxf(fabsf(v[j][0]), fabsf(v[j][1])), fmaxf(fabsf(v[j][2]), fabsf(v[j][3]))));
        mx = xrow16_max(row16_max(mx));
        const float inv = mx > 0.f ? 127.f / mx : 0.f;
        u32x4 o;
#pragma unroll
        for (int j = 0; j < 4; ++j) {
            const unsigned b0 = (unsigned)__float2int_rn(v[j][0] * inv) & 0xffu, b1 = (unsigned)__float2int_rn(v[j][1] * inv) & 0xffu, b2 = (unsigned)__float2int_rn(v[j][2] * inv) & 0xffu, b3 = (unsigned)__float2int_rn(v[j][3] * inv) & 0xffu;
            o[j] = b0 | (b1 << 8) | (b2 << 16) | (b3 << 24);
        }
        *(u32x4*)(p.ws + (which ? WS_V : WS_U) + (size_t)rr * D + 16 * lane) = o;
        if (lane == 0) ((float*)(p.ws + (which ? WS_SV : WS_SU)))[rr] = mx * (1.f / 127.f);
    }
    convert_bulk(p.p, (bf16*)(p.ws + WS_PB), (size_t)DEPTH * M * 256, gtid, nthr);
    convert_bulk(p.subkeys, (bf16*)(p.ws + WS_SK), (size_t)DEPTH * 8 * 2 * 128 * 128, gtid, nthr);
    float* H = (float*)(p.ws + WS_H); bf16* HB0 = (bf16*)(p.ws + WS_HB0); float* ss0 = (float*)(p.ws + WS_STAT);
    for (int m = gw; m < M; m += NGW) {
        const f32x4* xr = (const f32x4*)(p.x + (size_t)m * D) + lane;
        float ss = 0.f;
#pragma unroll
        for (int j = 0; j < 4; ++j) {
            const f32x4 v = xr[64 * j];
            ss += v[0] * v[0] + v[1] * v[1] + v[2] * v[2] + v[3] * v[3];
            ((f32x4*)(H + (size_t)m * D))[lane + 64 * j] = v;
            u32x2 o; o.x = pk2(v[0], v[1]); o.y = pk2(v[2], v[3]);
            ((u32x2*)(HB0 + (size_t)m * D))[lane + 64 * j] = o;
        }
        ss = wave_sum(ss);
        if (lane < 16) ss0[(size_t)m * 16 + lane] = lane == 0 ? ss : 0.f;
    }
}

typedef short v4i16_t __attribute__((ext_vector_type(4)));
typedef __bf16 bf16x2_t __attribute__((ext_vector_type(2)));
typedef float f32x2_t __attribute__((ext_vector_type(2)));
__device__ __forceinline__ unsigned cvtpk(float lo, float hi) { f32x2_t v = {lo, hi}; bf16x2_t b = __builtin_convertvector(v, bf16x2_t); return __builtin_bit_cast(unsigned, b); }
constexpr int ATT_VOFF = 16384, ATT_VPITCH = 288;
__device__ __forceinline__ void att_unit(const Params& p, int L, LAS unsigned char* lds, int tid, int b, int hh, int qb, float lam, float lam_init) {
    const int lane = tid & 63, w = __builtin_amdgcn_readfirstlane(tid >> 6), fr = lane & 15, fq = lane >> 4;
    const bf16* proj = (const bf16*)(p.ws + WS_PROJ);
    bf16* obuf = (bf16*)(p.ws + WS_OBUF);
    {
        const float slope2 = 1.4426950408889634f / (float)(1 << (2 * (hh + 1)));
        const bf16* kbase = proj + (size_t)b * SEQ * PROJ_W + 512 + hh * 128;
        const bf16* vbase = proj + (size_t)b * SEQ * PROJ_W + 1024 + hh * 128;
        {
            const int qw0 = qb * 128 + w * 16, T = 2 * (qb + 1);
            bf16x8 qf[2][2];
#pragma unroll
            for (int mp = 0; mp < 2; ++mp)
#pragma unroll
                for (int ks = 0; ks < 2; ++ks) qf[mp][ks] = *(const bf16x8*)(proj + ((size_t)b * SEQ + qw0 + fr) * PROJ_W + hh * 128 + mp * 64 + ks * 32 + 8 * fq);
            f32x4 o[2][8];
#pragma unroll
            for (int mp = 0; mp < 2; ++mp)
#pragma unroll
                for (int dt = 0; dt < 8; ++dt) o[mp][dt] = (f32x4){0.f, 0.f, 0.f, 0.f};
            float mrun[2] = {-INFINITY, -INFINITY}, lrun[2] = {0.f, 0.f};
            u32x4 kreg[2], vreg[2];
#pragma unroll
            for (int i = 0; i < 2; ++i) { const int c = tid + 512 * i, key = c >> 4, ch = c & 15;
                kreg[i] = *(const u32x4*)(kbase + (size_t)key * PROJ_W + ch * 8); vreg[i] = *(const u32x4*)(vbase + (size_t)key * PROJ_W + ch * 8); }
            for (int t = 0; t < T; ++t) {
                const int k0 = t * 64;
#pragma unroll
                for (int i = 0; i < 2; ++i) { const int c = tid + 512 * i, key = c >> 4, ch = c & 15;
                    *(LAS u32x4*)(lds + key * 256 + ((ch ^ (key & 15)) << 4)) = kreg[i];
                    *(LAS u32x4*)(lds + ATT_VOFF + key * ATT_VPITCH + ch * 16) = vreg[i]; }
                LDS_BARRIER();
                if (t + 1 < T) {
#pragma unroll
                    for (int i = 0; i < 2; ++i) { const int c = tid + 512 * i, key = k0 + 64 + (c >> 4), ch = c & 15;
                        kreg[i] = *(const u32x4*)(kbase + (size_t)key * PROJ_W + ch * 8); vreg[i] = *(const u32x4*)(vbase + (size_t)key * PROJ_W + ch * 8); }
                }
                if (k0 <= qw0 + 15) {
                    f32x4 s[2][4];
                    const float base = -slope2 * (float)(qw0 + fr - k0 - 4 * fq);
#pragma unroll
                    for (int kt = 0; kt < 4; ++kt)
#pragma unroll
                        for (int r = 0; r < 4; ++r) { const float v = base + slope2 * (float)(16 * kt + r); s[0][kt][r] = v; s[1][kt][r] = v; }
#pragma unroll
                    for (int mp = 0; mp < 2; ++mp)
#pragma unroll
                        for (int kt = 0; kt < 4; ++kt)
#pragma unroll
                            for (int ks = 0; ks < 2; ++ks) {
                                const bf16x8 kf = *(const LAS bf16x8*)(lds + (16 * kt + fr) * 256 + (((mp * 8 + ks * 4 + fq) ^ fr) << 4));
                                s[mp][kt] = __builtin_amdgcn_mfma_f32_16x16x32_bf16(kf, qf[mp][ks], s[mp][kt], 0, 0, 0);
                            }
                    if (k0 + 63 > qw0) {
                        const int lim = qw0 + fr - k0 - 4 * fq;
#pragma unroll
                        for (int mp = 0; mp < 2; ++mp)
#pragma unroll
                            for (int kt = 0; kt < 4; ++kt)
#pragma unroll
                                for (int r = 0; r < 4; ++r) if (16 * kt + r > lim) s[mp][kt][r] = -INFINITY;
                    }
                    bf16x8 pb[2][2];
#pragma unroll
                    for (int mp = 0; mp < 2; ++mp) {
                        float mx = fmaxf(fmaxf(s[mp][0][0], s[mp][0][1]), fmaxf(s[mp][0][2], s[mp][0][3]));
#pragma unroll
                        for (int kt = 1; kt < 4; ++kt) mx = fmaxf(mx, fmaxf(fmaxf(s[mp][kt][0], s[mp][kt][1]), fmaxf(s[mp][kt][2], s[mp][kt][3])));
                        mx = xrow16_max(mx);
                        const float mnew = fmaxf(mrun[mp], mx);
                        const float alpha = __builtin_amdgcn_exp2f(mrun[mp] - mnew);
                        mrun[mp] = mnew;
                        float ps = 0.f;
#pragma unroll
                        for (int kt = 0; kt < 4; ++kt)
#pragma unroll
                            for (int r = 0; r < 4; ++r) { const float e = __builtin_amdgcn_exp2f(s[mp][kt][r] - mnew); s[mp][kt][r] = e; ps += e; }
                        lrun[mp] = lrun[mp] * alpha + ps;
#pragma unroll
                        for (int dt = 0; dt < 8; ++dt) o[mp][dt] = o[mp][dt] * alpha;
#pragma unroll
                        for (int ks = 0; ks < 2; ++ks) {
                            u32x4 pk; pk.x = cvtpk(s[mp][2 * ks][0], s[mp][2 * ks][1]); pk.y = cvtpk(s[mp][2 * ks][2], s[mp][2 * ks][3]);
                            pk.z = cvtpk(s[mp][2 * ks + 1][0], s[mp][2 * ks + 1][1]); pk.w = cvtpk(s[mp][2 * ks + 1][2], s[mp][2 * ks + 1][3]);
                            pb[mp][ks] = __builtin_bit_cast(bf16x8, pk);
                        }
                    }
                    const int gl = lane & 15;
                    LAS unsigned char* vrd = lds + ATT_VOFF + (4 * fq + (gl >> 2)) * ATT_VPITCH + (gl & 3) * 8;
#pragma unroll
                    for (int dt = 0; dt < 8; ++dt)
#pragma unroll
                        for (int ks = 0; ks < 2; ++ks) {
                            const v4i16_t v0 = __builtin_amdgcn_ds_read_tr16_b64_v4i16((LAS v4i16_t*)(vrd + (32 * ks) * ATT_VPITCH + dt * 32));
                            const v4i16_t v1 = __builtin_amdgcn_ds_read_tr16_b64_v4i16((LAS v4i16_t*)(vrd + (32 * ks + 16) * ATT_VPITCH + dt * 32));
                            bf16x8 vf; vf[0] = v0[0]; vf[1] = v0[1]; vf[2] = v0[2]; vf[3] = v0[3]; vf[4] = v1[0]; vf[5] = v1[1]; vf[6] = v1[2]; vf[7] = v1[3];
                            o[0][dt] = __builtin_amdgcn_mfma_f32_16x16x32_bf16(vf, pb[0][ks], o[0][dt], 0, 0, 0);
                            o[1][dt] = __builtin_amdgcn_mfma_f32_16x16x32_bf16(vf, pb[1][ks], o[1][dt], 0, 0, 0);
                        }
                }
                LDS_BARRIER();
            }
            const float i1 = 1.f / xrow16_sum(lrun[0]), i2 = lam / xrow16_sum(lrun[1]);
            float ss = 0.f;
#pragma unroll
            for (int dt = 0; dt < 8; ++dt)
#pragma unroll
                for (int r = 0; r < 4; ++r) { const float v = o[0][dt][r] * i1 - o[1][dt][r] * i2; o[0][dt][r] = v; ss += v * v; }
            ss = xrow16_sum(ss);
            const float rn = rsqrtf(ss * (1.f / 128.f) + EPS) * (1.f - lam_init);
            const float* g = p.subln_g + L * 128;
            bf16* orow = obuf + ((size_t)b * SEQ + qw0 + fr) * D + hh * 128;
#pragma unroll
            for (int dt = 0; dt < 8; ++dt) {
                const f32x4 gv = *(const f32x4*)(g + 16 * dt + 4 * fq);
                u32x2 ov; ov.x = pk2(o[0][dt][0] * rn * gv[0], o[0][dt][1] * rn * gv[1]); ov.y = pk2(o[0][dt][2] * rn * gv[2], o[0][dt][3] * rn * gv[3]);
                *(u32x2*)(orow + 16 * dt + 4 * fq) = ov;
            }
        }
    }
}

__device__ void phase_att_queue(const Params& p, int L, LAS unsigned char* lds, int bid, int nblk) {
    const int tid = tidx(), lane = tid & 63;
    const float* lp = p.diff_lambda + L * 256;
    const float d1 = wave_sum(lp[lane] * lp[64 + lane]), d2 = wave_sum(lp[128 + lane] * lp[192 + lane]);
    const float lam_init = 0.8f - 0.6f * __expf(-0.3f * (float)L);
    const float lam = __expf(d1) - __expf(d2) + lam_init;
    unsigned* head = (unsigned*)(p.ws + WS_CTL) + CW_QUEUE + L;
    volatile LAS int* slot = (volatile LAS int*)(lds + LDS_MISC_OFF + 64);
    for (;;) {
        __syncthreads();
        if (tid == 0) *slot = (int)__hip_atomic_fetch_add(head, 1u, __ATOMIC_RELAXED, __HIP_MEMORY_SCOPE_AGENT);
        __syncthreads();
        const int u = *slot;
        if (u >= 512) break;
        att_unit(p, L, lds, tid, (u & 31) >> 2, u & 3, 15 - (u >> 5), lam, lam_init);
    }
}

constexpr size_t GD_WP = WS_ORAW, GD_QD = WS_ORAW + 16 * MiB, GD_AIP = WS_ORAW + 32 * MiB, GD_KDT = WS_ORAW + 40 * MiB, GD_UT = WS_ORAW + 56 * MiB, GD_GL = WS_ORAW + 72 * MiB;
__device__ __forceinline__ int perm_pos(int k) { return (k & ~31) + 8 * ((k >> 2) & 3) + 4 * ((k >> 4) & 1) + (k & 3); }
__device__ __forceinline__ float softplusf_(float x) { if (x > 20.f) return x; const float e = __expf(x); return e < 0.06f ? e * (1.f - e * (0.5f - e * (0.33333334f - 0.25f * e))) : __logf(1.f + e); }
__device__ __forceinline__ float gelu_erf(float v) {
    const float z = fabsf(v) * 0.70710678118654752f, t = 1.f / (1.f + 0.3275911f * z);
    const float pl = t * (0.254829592f + t * (-0.284496736f + t * (1.421413741f + t * (-1.453152027f + t * 1.061405429f))));
    const float er = 1.f - pl * __expf(-z * z);
    return 0.5f * v * (1.f + (v < 0.f ? -er : er));
}

constexpr int GP_KN = 0, GP_QN = 17408, GP_RT = 34816, GP_LM = 71680, GP_TB = 89088, GP_GT = 98304, GP_T0T = 99328;
constexpr int GP_KP = 272, GP_RP = 144, GP_LP = 68, GP_TP = 144;
__device__ void phase_gdn_prep(const Params& p, int L, LAS unsigned char* lds, int bid, int nblk) {
    const int tid = tidx(), lane = tid & 63, w = __builtin_amdgcn_readfirstlane(tid >> 6), fr = lane & 15, fq = lane >> 4;
    const bf16* proj = (const bf16*)(p.ws + WS_PROJ);
    const float* BA = (const float*)(p.ws + WS_BA);
    bf16* WP = (bf16*)(p.ws + GD_WP); bf16* QD = (bf16*)(p.ws + GD_QD); bf16* AIP = (bf16*)(p.ws + GD_AIP); bf16* KDT = (bf16*)(p.ws + GD_KDT); bf16* UT = (bf16*)(p.ws + GD_UT);
    float* GL = (float*)(p.ws + GD_GL);
    const float* cw = p.conv_w + (size_t)L * 4 * 1536;
    LAS float* beta_s = (LAS float*)(lds + GP_GT); LAS float* gc_s = beta_s + 64; LAS float* egc_s = gc_s + 64; LAS float* edl_s = egc_s + 64;
    LAS float* Lm = (LAS float*)(lds + GP_LM);
    for (int item = bid; item < 1024; item += nblk) {
        const int n = item & 31, bh = item >> 5, hh = bh & 3, b = bh >> 2, t0 = n * 64;
        const size_t row0 = (size_t)b * SEQ + t0;
        __syncthreads();
        if (w == 0) {
            const float negA = -__expf(p.a_log[L * 4 + hh]), dtb = p.dt_bias[L * 4 + hh];
            const float bb = BA[(row0 + lane) * 8 + hh], aa = BA[(row0 + lane) * 8 + 4 + hh] + dtb;
            float c = negA * softplusf_(aa);
#pragma unroll
            for (int o = 1; o < 64; o <<= 1) { const float t = __shfl_up(c, o); if (lane >= o) c += t; }
            const float glast = __shfl(c, 63);
            beta_s[lane] = sigmoidf_(bb); gc_s[lane] = c; egc_s[lane] = __expf(c); edl_s[lane] = __expf(glast - c);
            if (lane == 0) GL[item] = __expf(glast);
        }
        __syncthreads();
        {
            const int colq = hh * 128 + 2 * lane;
            unsigned xk[11], xv[11];
#pragma unroll
            for (int r = 0; r < 11; ++r) { const int tt = t0 + 8 * w - 3 + r;
                xk[r] = (tt >= 0) ? *(const unsigned*)(proj + ((size_t)b * SEQ + tt) * PROJ_W + 1536 + 512 + colq) : 0u;
                xv[r] = (tt >= 0) ? *(const unsigned*)(proj + ((size_t)b * SEQ + tt) * PROJ_W + 1536 + 1024 + colq) : 0u; }
            {
                float wq[4][2]; unsigned xq[11];
#pragma unroll
                for (int j = 0; j < 4; ++j) { wq[j][0] = cw[j * 1536 + colq]; wq[j][1] = cw[j * 1536 + colq + 1]; }
#pragma unroll
                for (int r = 0; r < 11; ++r) { const int tt = t0 + 8 * w - 3 + r; xq[r] = (tt >= 0) ? *(const unsigned*)(proj + ((size_t)b * SEQ + tt) * PROJ_W + 1536 + colq) : 0u; }
#pragma unroll
                for (int i = 0; i < 8; ++i) {
                    const int c = 8 * w + i;
                    float q0 = 0.f, q1 = 0.f;
#pragma unroll
                    for (int j = 0; j < 4; ++j) { q0 += wq[j][0] * lo16(xq[i + j]); q1 += wq[j][1] * hi16(xq[i + j]); }
                    q0 *= sigmoidf_(q0); q1 *= sigmoidf_(q1);
                    const float sq = rsqrtf(wave_sum(q0 * q0 + q1 * q1) + EPS) * 0.08838834764831845f;
                    q0 *= sq; q1 *= sq;
                    const float eg = egc_s[c];
                    *(LAS unsigned*)(lds + GP_QN + c * GP_KP + lane * 4) = pk2(q0, q1);
                    *(unsigned*)(QD + ((size_t)item * 64 + c) * 128 + perm_pos(2 * lane)) = pk2(q0 * eg, q1 * eg);
                }
            }
            __builtin_amdgcn_sched_barrier(0);
            {
                float wk[4][2];
#pragma unroll
                for (int j = 0; j < 4; ++j) { wk[j][0] = cw[j * 1536 + 512 + colq]; wk[j][1] = cw[j * 1536 + 512 + colq + 1]; }
                unsigned kd0[8], kd1[8], rk0[8], rk1[8];
#pragma unroll
                for (int i = 0; i < 8; ++i) {
                    const int c = 8 * w + i;
                    float k0 = 0.f, k1 = 0.f;
#pragma unroll
                    for (int j = 0; j < 4; ++j) { k0 += wk[j][0] * lo16(xk[i + j]); k1 += wk[j][1] * hi16(xk[i + j]); }
                    k0 *= sigmoidf_(k0); k1 *= sigmoidf_(k1);
                    const float sk = rsqrtf(wave_sum(k0 * k0 + k1 * k1) + EPS);
                    k0 *= sk; k1 *= sk;
                    const float be = beta_s[c], eg = egc_s[c], ed = edl_s[c];
                    *(LAS unsigned*)(lds + GP_KN + c * GP_KP + lane * 4) = pk2(k0, k1);
                    kd0[i] = f2bf(k0 * ed); kd1[i] = f2bf(k1 * ed);
                    rk0[i] = f2bf(k0 * be * eg); rk1[i] = f2bf(k1 * be * eg);
                }
                u32x4 o;
                o.x = rk0[0] | (rk0[1] << 16); o.y = rk0[2] | (rk0[3] << 16); o.z = rk0[4] | (rk0[5] << 16); o.w = rk0[6] | (rk0[7] << 16); *(LAS u32x4*)(lds + GP_RT + (128 + 2 * lane) * GP_RP + 16 * w) = o;
                o.x = rk1[0] | (rk1[1] << 16); o.y = rk1[2] | (rk1[3] << 16); o.z = rk1[4] | (rk1[5] << 16); o.w = rk1[6] | (rk1[7] << 16); *(LAS u32x4*)(lds + GP_RT + (128 + 2 * lane + 1) * GP_RP + 16 * w) = o;
                const int pa = perm_pos(8 * w), pb = perm_pos(8 * w + 4);
                bf16* kr0 = KDT + ((size_t)item * 128 + 2 * lane) * 64; bf16* kr1 = kr0 + 64;
                u32x2 h2;
                h2.x = kd0[0] | (kd0[1] << 16); h2.y = kd0[2] | (kd0[3] << 16); *(u32x2*)(kr0 + pa) = h2;
                h2.x = kd0[4] | (kd0[5] << 16); h2.y = kd0[6] | (kd0[7] << 16); *(u32x2*)(kr0 + pb) = h2;
                h2.x = kd1[0] | (kd1[1] << 16); h2.y = kd1[2] | (kd1[3] << 16); *(u32x2*)(kr1 + pa) = h2;
                h2.x = kd1[4] | (kd1[5] << 16); h2.y = kd1[6] | (kd1[7] << 16); *(u32x2*)(kr1 + pb) = h2;
            }
            __builtin_amdgcn_sched_barrier(0);
            {
                float wv[4][2];
#pragma unroll
                for (int j = 0; j < 4; ++j) { wv[j][0] = cw[j * 1536 + 1024 + colq]; wv[j][1] = cw[j * 1536 + 1024 + colq + 1]; }
                unsigned rv0[8], rv1[8];
#pragma unroll
                for (int i = 0; i < 8; ++i) {
                    float v0 = 0.f, v1 = 0.f;
#pragma unroll
                    for (int j = 0; j < 4; ++j) { v0 += wv[j][0] * lo16(xv[i + j]); v1 += wv[j][1] * hi16(xv[i + j]); }
                    v0 *= sigmoidf_(v0); v1 *= sigmoidf_(v1);
                    const float be = beta_s[8 * w + i];
                    rv0[i] = f2bf(v0 * be); rv1[i] = f2bf(v1 * be);
                }
                u32x4 o;
                o.x = rv0[0] | (rv0[1] << 16); o.y = rv0[2] | (rv0[3] << 16); o.z = rv0[4] | (rv0[5] << 16); o.w = rv0[6] | (rv0[7] << 16); *(LAS u32x4*)(lds + GP_RT + (2 * lane) * GP_RP + 16 * w) = o;
                o.x = rv1[0] | (rv1[1] << 16); o.y = rv1[2] | (rv1[3] << 16); o.z = rv1[4] | (rv1[5] << 16); o.w = rv1[6] | (rv1[7] << 16); *(LAS u32x4*)(lds + GP_RT + (2 * lane + 1) * GP_RP + 16 * w) = o;
            }
        }
        __syncthreads();
#pragma unroll
        for (int q = 0; q < 2; ++q) {
            const int id = 2 * w + q, ct = id >> 2, st = id & 3;
            if (st <= ct) {
                f32x4 acc = (f32x4){0.f, 0.f, 0.f, 0.f};
#pragma unroll
                for (int ks = 0; ks < 4; ++ks) {
                    const bf16x8 a = *(const LAS bf16x8*)(lds + GP_KN + (16 * ct + fr) * GP_KP + (32 * ks + 8 * fq) * 2);
                    const bf16x8 bb = *(const LAS bf16x8*)(lds + GP_KN + (16 * st + fr) * GP_KP + (32 * ks + 8 * fq) * 2);
                    acc = __builtin_amdgcn_mfma_f32_16x16x32_bf16(a, bb, acc, 0, 0, 0);
                }
                const int s = 16 * st + fr; const float gs = gc_s[s];
#pragma unroll
                for (int r = 0; r < 4; ++r) { const int c = 16 * ct + 4 * fq + r;
                    Lm[c * GP_LP + s] = (s < c) ? beta_s[c] * acc[r] * __expf(fminf(gc_s[c] - gs, 0.f)) : 0.f; }
            }
        }
        __syncthreads();
        if (w < 2) {
            const int o = 32 * w;
            float t[32];
            int zoff = 0; asm volatile("" : "+v"(zoff));
            const LAS float* Lz = Lm + zoff + o * GP_LP + o;
            const int col = lane & 31;
#pragma unroll
            for (int i = 0; i < 32; ++i) {
                float a0 = (i == lane) ? 1.f : 0.f, a1 = 0.f, a2 = 0.f, a3 = 0.f;
#pragma unroll
                for (int s4 = 0; s4 + 4 <= i; s4 += 4) { const f32x4 lv = *(const LAS f32x4*)(Lz + i * GP_LP + s4);
                    a0 -= lv[0] * t[s4]; a1 -= lv[1] * t[s4 + 1]; a2 -= lv[2] * t[s4 + 2]; a3 -= lv[3] * t[s4 + 3]; }
#pragma unroll
                for (int s = i & ~3; s < i; ++s) a0 -= Lz[i * GP_LP + s] * t[s];
                t[i] = (lane < 32) ? (a0 + a1) + (a2 + a3) : 0.f;
                const bf16 tb = (bf16)f2bf(t[i]);
                if (w == 0) { *(LAS bf16*)(lds + GP_TB + i * GP_TP + lane * 2) = tb;
                              if (lane < 32) *(LAS bf16*)(lds + GP_T0T + lane * 80 + i * 2) = tb; }
                else if (lane < 32) *(LAS bf16*)(lds + GP_TB + (32 + i) * GP_TP + (32 + col) * 2) = tb;
                if ((i & 3) == 3) __builtin_amdgcn_sched_barrier(0);
            }
        } else {
            for (int id = w - 2; id < 16; id += 6) {
                const int ct = id >> 2, st = id & 3;
                f32x4 acc = (f32x4){0.f, 0.f, 0.f, 0.f};
                if (st <= ct) {
#pragma unroll
                    for (int ks = 0; ks < 4; ++ks) {
                        const bf16x8 a = *(const LAS bf16x8*)(lds + GP_QN + (16 * ct + fr) * GP_KP + (32 * ks + 8 * fq) * 2);
                        const bf16x8 bb = *(const LAS bf16x8*)(lds + GP_KN + (16 * st + fr) * GP_KP + (32 * ks + 8 * fq) * 2);
                        acc = __builtin_amdgcn_mfma_f32_16x16x32_bf16(a, bb, acc, 0, 0, 0);
                    }
                }
                const int s = 16 * st + fr; const float gs = gc_s[s]; const int ps = perm_pos(s);
#pragma unroll
                for (int r = 0; r < 4; ++r) { const int c = 16 * ct + 4 * fq + r;
                    const float v = (s <= c) ? acc[r] * __expf(fminf(gc_s[c] - gs, 0.f)) : 0.f;
                    AIP[((size_t)item * 64 + c) * 64 + ps] = (bf16)f2bf(v); }
            }
        }
        __syncthreads();
        if (w == 0) {
            f32x4 P[2][2];
#pragma unroll
            for (int it = 0; it < 2; ++it) {
                const LAS float* lr = Lm + (32 + 16 * it + fr) * GP_LP + 8 * fq;
                const f32x4 l0 = *(const LAS f32x4*)lr, l1 = *(const LAS f32x4*)(lr + 4);
                u32x4 pk; pk.x = cvtpk(l0[0], l0[1]); pk.y = cvtpk(l0[2], l0[3]); pk.z = cvtpk(l1[0], l1[1]); pk.w = cvtpk(l1[2], l1[3]);
                const bf16x8 a = __builtin_bit_cast(bf16x8, pk);
#pragma unroll
                for (int jt = 0; jt < 2; ++jt) {
                    const bf16x8 bb = *(const LAS bf16x8*)(lds + GP_T0T + (16 * jt + fr) * 80 + 16 * fq);
                    P[it][jt] = __builtin_amdgcn_mfma_f32_16x16x32_bf16(a, bb, (f32x4){0.f, 0.f, 0.f, 0.f}, 0, 0, 0);
                }
            }
#pragma unroll
            for (int jt = 0; jt < 2; ++jt) {
                u32x4 pk; pk.x = cvtpk(P[0][jt][0], P[0][jt][1]); pk.y = cvtpk(P[0][jt][2], P[0][jt][3]); pk.z = cvtpk(P[1][jt][0], P[1][jt][1]); pk.w = cvtpk(P[1][jt][2], P[1][jt][3]);
                const bf16x8 pb = __builtin_bit_cast(bf16x8, pk);
#pragma unroll
                for (int i2 = 0; i2 < 2; ++i2) {
                    const LAS unsigned char* tr = lds + GP_TB + (32 + 16 * i2 + fr) * GP_TP + (32 + 4 * fq) * 2;
                    const u32x2 ta = *(const LAS u32x2*)tr, tb2 = *(const LAS u32x2*)(tr + 32);
                    u32x4 ak; ak.x = ta.x; ak.y = ta.y; ak.z = tb2.x; ak.w = tb2.y;
                    const f32x4 r = __builtin_amdgcn_mfma_f32_16x16x32_bf16(__builtin_bit_cast(bf16x8, ak), pb, (f32x4){0.f, 0.f, 0.f, 0.f}, 0, 0, 0);
#pragma unroll
                    for (int q = 0; q < 4; ++q) *(LAS bf16*)(lds + GP_TB + (32 + 16 * i2 + 4 * fq + q) * GP_TP + (16 * jt + fr) * 2) = (bf16)f2bf(-r[q]);
                }
            }
        }
        __syncthreads();
#pragma unroll
        for (int q = 0; q < 2; ++q) {
            const int colt = 2 * w + q;
            bf16x8 af[2];
#pragma unroll
            for (int ks = 0; ks < 2; ++ks) af[ks] = *(const LAS bf16x8*)(lds + GP_RT + (16 * colt + fr) * GP_RP + (32 * ks + 8 * fq) * 2);
#pragma unroll
            for (int ct = 0; ct < 4; ++ct) {
                f32x4 acc = (f32x4){0.f, 0.f, 0.f, 0.f};
#pragma unroll
                for (int ks = 0; ks < 2; ++ks) {
                    const bf16x8 bb = *(const LAS bf16x8*)(lds + GP_TB + (16 * ct + fr) * GP_TP + (32 * ks + 8 * fq) * 2);
                    acc = __builtin_amdgcn_mfma_f32_16x16x32_bf16(af[ks], bb, acc, 0, 0, 0);
                }
                const int c = 16 * ct + fr;
                if (colt < 8) {
#pragma unroll
                    for (int r = 0; r < 4; ++r) UT[((size_t)item * 128 + 16 * colt + 4 * fq + r) * 64 + c] = (bf16)f2bf(acc[r]);
                } else {
                    const int kt = colt - 8;
                    u32x2 h2; h2.x = pk2(-acc[0], -acc[1]); h2.y = pk2(-acc[2], -acc[3]);
                    *(u32x2*)(WP + ((size_t)item * 64 + c) * 128 + 32 * (kt >> 1) + 8 * fq + 4 * (kt & 1)) = h2;
                }
            }
        }
    }
    __syncthreads();
}

constexpr int GS_WP = 0, GS_QD = 17408, GS_AIP = 34816, GS_KDT = 44032, GS_BUF = 62464, GS_OB = 2 * GS_BUF, GS_OBP = 272;
__device__ void phase_gdn_scan(const Params& p, int L, LAS unsigned char* lds, int bid, int nblk) {
    const int tid = tidx(), lane = tid & 63, w = __builtin_amdgcn_readfirstlane(tid >> 6), fr = lane & 15, fq = lane >> 4;
    const bf16* proj = (const bf16*)(p.ws + WS_PROJ);
    const bf16* WP = (const bf16*)(p.ws + GD_WP); const bf16* QD = (const bf16*)(p.ws + GD_QD); const bf16* AIP = (const bf16*)(p.ws + GD_AIP);
    const bf16* KDT = (const bf16*)(p.ws + GD_KDT); const bf16* UT = (const bf16*)(p.ws + GD_UT); const float* GL = (const float*)(p.ws + GD_GL);
    bf16* obuf = (bf16*)(p.ws + WS_OBUF);
    for (int item = bid; item < 32; item += nblk) {
        const int hh = item & 3, b = item >> 2;
        const int fc = tid >> 4, fv = tid & 15;
        float gn[8];
#pragma unroll
        for (int i = 0; i < 8; ++i) gn[i] = p.gdn_norm_g[L * 128 + 8 * fv + i];
        f32x4 S[8];
#pragma unroll
        for (int kt = 0; kt < 8; ++kt) S[kt] = (f32x4){0.f, 0.f, 0.f, 0.f};
        u32x4 st[7];
        auto gload = [&](int ci) {
#pragma unroll
            for (int i = 0; i < 7; ++i) {
                const int pc = tid + 512 * i;
                const bf16* src;
                if (i < 2) src = WP + (size_t)ci * 8192 + pc * 8;
                else if (i < 4) src = QD + (size_t)ci * 8192 + (pc - 1024) * 8;
                else if (i < 5) src = AIP + (size_t)ci * 4096 + (pc - 2048) * 8;
                else src = KDT + (size_t)ci * 8192 + (pc - 2560) * 8;
                st[i] = *(const u32x4*)src;
            }
        };
        auto lstore = [&](int buf) {
#pragma unroll
            for (int i = 0; i < 7; ++i) {
                const int pc = tid + 512 * i;
                int off;
                if (i < 2) off = GS_WP + (pc >> 4) * 272 + (pc & 15) * 16;
                else if (i < 4) { const int q = pc - 1024; off = GS_QD + (q >> 4) * 272 + (q & 15) * 16; }
                else if (i < 5) { const int q = pc - 2048; off = GS_AIP + (q >> 3) * 144 + (q & 7) * 16; }
                else { const int q = pc - 2560; off = GS_KDT + (q >> 3) * 144 + (q & 7) * 16; }
                *(LAS u32x4*)(lds + buf * GS_BUF + off) = st[i];
            }
        };
        __syncthreads();
        gload(item * 32); lstore(0);
        u32x2 ut[4]; float gl;
        {
            const int ci = item * 32;
#pragma unroll
            for (int ct = 0; ct < 4; ++ct) ut[ct] = *(const u32x2*)(UT + ((size_t)ci * 128 + 16 * w + fr) * 64 + 16 * ct + 4 * fq);
            gl = GL[ci];
        }
        __syncthreads();
        for (int n = 0; n < 32; ++n) {
            const int ci = item * 32 + n, buf = n & 1;
            const size_t rowc = (size_t)b * SEQ + n * 64;
            u32x2 utn[4]; float gln = 0.f;
            if (n + 1 < 32) {
                gload(ci + 1);
#pragma unroll
                for (int ct = 0; ct < 4; ++ct) utn[ct] = *(const u32x2*)(UT + ((size_t)(ci + 1) * 128 + 16 * w + fr) * 64 + 16 * ct + 4 * fq);
                gln = GL[ci + 1];
            }
            u32x4 zq[2];
#pragma unroll
            for (int ps = 0; ps < 2; ++ps) zq[ps] = *(const u32x4*)(proj + (rowc + 32 * ps + fc) * PROJ_W + 3072 + hh * 128 + 8 * fv);
            f32x4 vn[4], oacc[4];
#pragma unroll
            for (int ct = 0; ct < 4; ++ct) { vn[ct] = (f32x4){lo16(ut[ct].x), hi16(ut[ct].x), lo16(ut[ct].y), hi16(ut[ct].y)}; oacc[ct] = (f32x4){0.f, 0.f, 0.f, 0.f}; }
            bf16x8 sb[4];
#pragma unroll
            for (int ks = 0; ks < 4; ++ks) { u32x4 pk; pk.x = cvtpk(S[2 * ks][0], S[2 * ks][1]); pk.y = cvtpk(S[2 * ks][2], S[2 * ks][3]); pk.z = cvtpk(S[2 * ks + 1][0], S[2 * ks + 1][1]); pk.w = cvtpk(S[2 * ks + 1][2], S[2 * ks + 1][3]);
                sb[ks] = __builtin_bit_cast(bf16x8, pk); }
            LAS unsigned char* bb = lds + buf * GS_BUF;
            bf16x8 f0[8], f1[8];
#define LD_A(F, ct) do { _Pragma("unroll") for (int ks = 0; ks < 4; ++ks) { F[ks] = *(const LAS bf16x8*)(bb + GS_WP + (16 * (ct) + fr) * 272 + (32 * ks + 8 * fq) * 2); \
                    F[4 + ks] = *(const LAS bf16x8*)(bb + GS_QD + (16 * (ct) + fr) * 272 + (32 * ks + 8 * fq) * 2); } } while (0)
#define MM_A(F, ct) do { _Pragma("unroll") for (int ks = 0; ks < 4; ++ks) { vn[ct] = __builtin_amdgcn_mfma_f32_16x16x32_bf16(F[ks], sb[ks], vn[ct], 0, 0, 0); \
                    oacc[ct] = __builtin_amdgcn_mfma_f32_16x16x32_bf16(F[4 + ks], sb[ks], oacc[ct], 0, 0, 0); } } while (0)
#define SBAR() __builtin_amdgcn_sched_barrier(0)
            LD_A(f0, 0); SBAR();
            LD_A(f1, 1); MM_A(f0, 0); SBAR();
            LD_A(f0, 2); MM_A(f1, 1); SBAR();
            LD_A(f1, 3); MM_A(f0, 2); SBAR();
#pragma unroll
            for (int ct = 0; ct < 4; ++ct)
#pragma unroll
                for (int ss = 0; ss < 2; ++ss) f0[2 * ct + ss] = *(const LAS bf16x8*)(bb + GS_AIP + (16 * ct + fr) * 144 + (32 * ss + 8 * fq) * 2);
            MM_A(f1, 3); SBAR();
            bf16x8 vb[2];
#pragma unroll
            for (int ss = 0; ss < 2; ++ss) { u32x4 pk; pk.x = cvtpk(vn[2 * ss][0], vn[2 * ss][1]); pk.y = cvtpk(vn[2 * ss][2], vn[2 * ss][3]); pk.z = cvtpk(vn[2 * ss + 1][0], vn[2 * ss + 1][1]); pk.w = cvtpk(vn[2 * ss + 1][2], vn[2 * ss + 1][3]);
                vb[ss] = __builtin_bit_cast(bf16x8, pk); }
#pragma unroll
            for (int kt = 0; kt < 4; ++kt)
#pragma unroll
                for (int ss = 0; ss < 2; ++ss) f1[2 * kt + ss] = *(const LAS bf16x8*)(bb + GS_KDT + (16 * kt + fr) * 144 + (32 * ss + 8 * fq) * 2);
#pragma unroll
            for (int ct = 0; ct < 4; ++ct)
#pragma unroll
                for (int ss = 0; ss < 2; ++ss) oacc[ct] = __builtin_amdgcn_mfma_f32_16x16x32_bf16(f0[2 * ct + ss], vb[ss], oacc[ct], 0, 0, 0);
            SBAR();
#pragma unroll
            for (int kt = 4; kt < 8; ++kt)
#pragma unroll
                for (int ss = 0; ss < 2; ++ss) f0[2 * (kt - 4) + ss] = *(const LAS bf16x8*)(bb + GS_KDT + (16 * kt + fr) * 144 + (32 * ss + 8 * fq) * 2);
#pragma unroll
            for (int kt = 0; kt < 4; ++kt) {
                S[kt] = S[kt] * gl;
#pragma unroll
                for (int ss = 0; ss < 2; ++ss) S[kt] = __builtin_amdgcn_mfma_f32_16x16x32_bf16(f1[2 * kt + ss], vb[ss], S[kt], 0, 0, 0);
            }
            SBAR();
#pragma unroll
            for (int kt = 4; kt < 8; ++kt) {
                S[kt] = S[kt] * gl;
#pragma unroll
                for (int ss = 0; ss < 2; ++ss) S[kt] = __builtin_amdgcn_mfma_f32_16x16x32_bf16(f0[2 * (kt - 4) + ss], vb[ss], S[kt], 0, 0, 0);
            }
#undef LD_A
#undef MM_A
#undef SBAR
            LDS_BARRIER();
#pragma unroll
            for (int ct = 0; ct < 4; ++ct)
#pragma unroll
                for (int r = 0; r < 4; r += 2) {
                    const unsigned pk = cvtpk(oacc[ct][r], oacc[ct][r + 1]);
                    *(LAS bf16*)(lds + GS_OB + (16 * ct + 4 * fq + r) * GS_OBP + (16 * w + fr) * 2) = (bf16)(pk & 0xffffu);
                    *(LAS bf16*)(lds + GS_OB + (16 * ct + 4 * fq + r + 1) * GS_OBP + (16 * w + fr) * 2) = (bf16)(pk >> 16);
                }
            if (n + 1 < 32) {
                lstore(buf ^ 1);
#pragma unroll
                for (int ct = 0; ct < 4; ++ct) ut[ct] = utn[ct];
                gl = gln;
            }
            LDS_BARRIER();
#pragma unroll
            for (int ps = 0; ps < 2; ++ps) {
                const int c = 32 * ps + fc;
                const u32x4 ov = *(const LAS u32x4*)(lds + GS_OB + c * GS_OBP + fv * 16);
                float o8[8];
#pragma unroll
                for (int i = 0; i < 4; ++i) { o8[2 * i] = lo16(ov[i]); o8[2 * i + 1] = hi16(ov[i]); }
                float ss = 0.f;
#pragma unroll
                for (int i = 0; i < 8; ++i) ss += o8[i] * o8[i];
                const float rn = rsqrtf(row16_sum(ss) * (1.f / 128.f) + EPS);
                u32x4 res;
#pragma unroll
                for (int i = 0; i < 4; ++i) {
                    const float z0 = lo16(zq[ps][i]), z1 = hi16(zq[ps][i]);
                    res[i] = cvtpk(o8[2 * i] * rn * gn[2 * i] * (z0 * sigmoidf_(z0)), o8[2 * i + 1] * rn * gn[2 * i + 1] * (z1 * sigmoidf_(z1)));
                }
                *(u32x4*)(obuf + (rowc + c) * D + 512 + hh * 128 + 8 * fv) = res;
            }
        }
        __syncthreads();
    }
}

__device__ __forceinline__ unsigned sortable(float f) { const unsigned u = __float_as_uint(f); return u ^ ((unsigned)((int)u >> 31) | 0x80000000u); }
__device__ __forceinline__ float unsortable(unsigned s) { return __uint_as_float((s & 0x80000000u) ? (s ^ 0x80000000u) : ~s); }
#define CE(a, b) do { const unsigned _x = k[a], _y = k[b]; k[a] = _x > _y ? _x : _y; k[b] = _x > _y ? _y : _x; } while (0)
constexpr int PE_TK = 0, PE_TAB = 8192, PE_ID = 8448, PE_GT = PE_ID + 32768, PE_SK = PE_GT + 32768;
__device__ void phase_peer(const Params& p, int L, LAS unsigned char* lds, int bid, int nblk) {
    const int tid = tidx(), lane = tid & 63, w = __builtin_amdgcn_readfirstlane(tid >> 6), fr = lane & 15, fq = lane >> 4;
    const bf16* Q2 = (const bf16*)(p.ws + WS_Q2);
    const bf16* SK = (const bf16*)(p.ws + WS_SK) + (size_t)L * 8 * 2 * 128 * 128;
    float* H = (float*)(p.ws + WS_H); bf16* HB2 = (bf16*)(p.ws + WS_HB2);
    const unsigned char* U = p.ws + WS_U + (size_t)L * NEXP * D;
    const unsigned char* V = p.ws + WS_V + (size_t)L * NEXP * D;
    const float* SU = (const float*)(p.ws + WS_SU) + (size_t)L * NEXP; const float* SV = (const float*)(p.ws + WS_SV) + (size_t)L * NEXP;
    const float* g = p.ln_ffn_g + L * D;
    LAS unsigned* TK = (LAS unsigned*)(lds + PE_TK);
    LAS unsigned short* TAB = (LAS unsigned short*)(lds + PE_TAB);
    LAS int* IDL = (LAS int*)(lds + PE_ID); LAS float* GTL = (LAS float*)(lds + PE_GT);
    if (tid < 64) {
        int a = 0, base = 0, q = tid; unsigned short v = 0xffff;
        if (q < 50) { for (;;) { const int cnt = 16 / (a + 1); if (q < base + cnt) break; base += cnt; ++a; } v = (unsigned short)((a << 8) | (q - base)); }
        TAB[tid] = v;
    }
    for (int item = bid; item < M / 64; item += nblk) {
        const int tok0 = item * 64;
        __syncthreads();
        const int tg = w & 3, cc = w >> 2;
#define SK_FETCH(hd) do { _Pragma("unroll") for (int i = 0; i < 8; ++i) { const int pc = tid + 512 * i, nn = (pc >> 4) & 127; \
            __builtin_amdgcn_global_load_lds((const unsigned*)(SK + ((size_t)((hd) * 2 + (pc >> 11)) * 128 + nn) * 128 + (((pc & 15) ^ (nn & 15)) * 8)), \
                                             (LAS unsigned*)(lds + PE_SK + (w * 64 + 512 * i) * 16), 16, 0, 0); } } while (0)
        SK_FETCH(0);
        asm volatile("s_waitcnt vmcnt(0)" ::: "memory");
        __syncthreads();
        for (int hh = 0; hh < 8; ++hh) {
            {
                f32x4 acc[8];
#pragma unroll
                for (int nt = 0; nt < 8; ++nt) acc[nt] = (f32x4){0.f, 0.f, 0.f, 0.f};
                bf16x8 qa[4];
#pragma unroll
                for (int ks = 0; ks < 4; ++ks) qa[ks] = *(const bf16x8*)(Q2 + (size_t)(tok0 + 16 * tg + fr) * 2048 + hh * 256 + cc * 128 + 32 * ks + 8 * fq);
                const LAS unsigned char* skb = lds + PE_SK + cc * 32768 + fr * 256;
#pragma unroll
                for (int nt = 0; nt < 8; ++nt)
#pragma unroll
                    for (int ks = 0; ks < 4; ++ks) {
                        const bf16x8 kb = *(const LAS bf16x8*)(skb + nt * 4096 + (((4 * ks + fq) ^ fr) << 4));
                        acc[nt] = __builtin_amdgcn_mfma_f32_16x16x32_bf16(qa[ks], kb, acc[nt], 0, 0, 0);
                    }
#pragma unroll
                for (int r = 0; r < 4; ++r) {
                    unsigned k[8];
#pragma unroll
                    for (int nt = 0; nt < 8; ++nt) k[nt] = (sortable(acc[nt][r]) & ~0x7Fu) | (unsigned)(127 - (16 * nt + fr));
                    CE(0, 1); CE(2, 3); CE(4, 5); CE(6, 7); CE(0, 2); CE(1, 3); CE(4, 6); CE(5, 7); CE(1, 2); CE(5, 6); CE(0, 4); CE(3, 7);
                    CE(1, 5); CE(2, 6); CE(1, 4); CE(3, 6); CE(2, 4); CE(3, 5); CE(3, 4);
                    unsigned res = 0u;
#pragma unroll
                    for (int rd = 0; rd < 16; ++rd) {
                        const unsigned m = row16_umax(k[0]);
                        const bool win = k[0] == m;
#pragma unroll
                        for (int i = 0; i < 7; ++i) k[i] = win ? k[i + 1] : k[i];
                        k[7] = win ? 0u : k[7];
                        res = (fr == rd) ? m : res;
                    }
                    TK[(cc * 64 + 16 * tg + 4 * fq + r) * 16 + fr] = res;
                }
            }
            __syncthreads();
            if (hh + 1 < 8) SK_FETCH(hh + 1);
#pragma unroll
            for (int ps = 0; ps < 2; ++ps) {
                const int tl = 8 * w + 4 * ps + fq;
                unsigned k[4];
#pragma unroll
                for (int sl = 0; sl < 4; ++sl) {
                    const int q = sl * 16 + fr;
                    const unsigned ab = TAB[q];
                    const unsigned k1 = TK[tl * 16 + ((ab >> 8) & 15)], k2 = TK[(64 + tl) * 16 + (ab & 15)];
                    const float v = unsortable(k1 & ~0x7Fu) + unsortable(k2 & ~0x7Fu);
                    k[sl] = (q < 50) ? ((sortable(v) & ~0x3Fu) | (unsigned)(63 - q)) : 0u;
                }
                CE(0, 1); CE(2, 3); CE(0, 2); CE(1, 3); CE(1, 2);
                unsigned res = 0u;
#pragma unroll
                for (int rd = 0; rd < 16; ++rd) {
                    const unsigned m = row16_umax(k[0]);
                    const bool win = k[0] == m;
                    k[0] = win ? k[1] : k[0]; k[1] = win ? k[2] : k[1]; k[2] = win ? k[3] : k[2]; k[3] = win ? 0u : k[3];
                    res = (fr == rd) ? m : res;
                }
                const unsigned ab = TAB[63 - (res & 0x3Fu)];
                const unsigned k1 = TK[tl * 16 + ((ab >> 8) & 15)], k2 = TK[(64 + tl) * 16 + (ab & 15)];
                const float v = unsortable(k1 & ~0x7Fu) + unsortable(k2 & ~0x7Fu);
                const float e = __expf(v - row16_max(v));
                const float sum = row16_sum(e);
                IDL[tl * 128 + hh * 16 + fr] = (int)((127u - (k1 & 0x7Fu)) * 128u + (127u - (k2 & 0x7Fu)));
                GTL[tl * 128 + hh * 16 + fr] = e / sum;
            }
            asm volatile("s_waitcnt vmcnt(0)" ::: "memory");
            __syncthreads();
        }
#undef SK_FETCH
        for (int ti = 0; ti < 8; ++ti) {
            const int tl = 8 * w + ti;
            unsigned k0 = ((unsigned)IDL[tl * 128 + lane] << 7) | (unsigned)lane, k1 = ((unsigned)IDL[tl * 128 + 64 + lane] << 7) | (unsigned)(64 + lane);
#pragma unroll
            for (int kk = 2; kk <= 128; kk <<= 1) {
#pragma unroll
                for (int j = kk >> 1; j >= 1; j >>= 1) {
                    if (j == 64) { const unsigned lo = k0 < k1 ? k0 : k1, hi = k0 < k1 ? k1 : k0; k0 = lo; k1 = hi; }
                    else {
                        const unsigned p0 = (unsigned)__shfl_xor((int)k0, j), p1 = (unsigned)__shfl_xor((int)k1, j);
                        const bool up0 = ((lane & kk) == 0) || kk == 128, up1 = (((lane + 64) & kk) == 0);
                        const bool low = (lane & j) == 0;
                        k0 = (low == up0) ? (k0 < p0 ? k0 : p0) : (k0 > p0 ? k0 : p0);
                        k1 = (low == (kk == 128 ? true : up1)) ? (k1 < p1 ? k1 : p1) : (k1 > p1 ? k1 : p1);
                    }
                }
            }
            const float g0 = GTL[tl * 128 + (k0 & 127u)], g1 = GTL[tl * 128 + (k1 & 127u)];
            asm volatile("s_waitcnt lgkmcnt(0)" ::: "memory");
            IDL[tl * 128 + lane] = (int)(k0 >> 7); IDL[tl * 128 + 64 + lane] = (int)(k1 >> 7);
            GTL[tl * 128 + lane] = g0; GTL[tl * 128 + 64 + lane] = g1;
        }
        __syncthreads();
        for (int ti = 0; ti < 8; ++ti) {
            const int tl = 8 * w + ti, tok = tok0 + tl;
            const float* hrow = H + (size_t)tok * D + 16 * lane;
            float xn[16];
#pragma unroll
            for (int j = 0; j < 4; ++j) { const f32x4 a = *(const f32x4*)(hrow + 4 * j); xn[4 * j] = a[0]; xn[4 * j + 1] = a[1]; xn[4 * j + 2] = a[2]; xn[4 * j + 3] = a[3]; }
            float ss = 0.f;
#pragma unroll
            for (int i = 0; i < 16; ++i) ss += xn[i] * xn[i];
            const float rstd = rsqrtf(wave_sum(ss) * (1.f / D) + EPS);
            float mx = 0.f;
#pragma unroll
            for (int i = 0; i < 16; ++i) { xn[i] = xn[i] * rstd * g[16 * lane + i]; mx = fmaxf(mx, fabsf(xn[i])); }
            mx = xrow16_max(row16_max(mx));
            const float xinv = mx > 0.f ? 127.f / mx : 0.f, sx = mx * (1.f / 127.f);
            int xq[4];
#pragma unroll
            for (int j = 0; j < 4; ++j) xq[j] = (int)(((unsigned)__float2int_rn(xn[4 * j] * xinv) & 0xffu) | (((unsigned)__float2int_rn(xn[4 * j + 1] * xinv) & 0xffu) << 8) |
                                                      (((unsigned)__float2int_rn(xn[4 * j + 2] * xinv) & 0xffu) << 16) | ((unsigned)__float2int_rn(xn[4 * j + 3] * xinv) << 24));
            const int id0 = IDL[tl * 128 + lane], id1 = IDL[tl * 128 + 64 + lane];
            const float su0 = SU[id0], su1 = SU[id1], sv0 = SV[id0], sv1 = SV[id1];
            int h0i = 0, h1i = 0;
            u32x4 ring[16];
#pragma unroll
            for (int j = 0; j < 16; ++j) ring[j] = *(const u32x4*)(U + (size_t)IDL[tl * 128 + j] * D + 16 * lane);
#pragma unroll 1
            for (int k = 0; k < 8; ++k) {
#pragma unroll
                for (int j = 0; j < 16; ++j) {
                    const u32x4 a = ring[j];
                    if (k < 7) ring[j] = *(const u32x4*)(U + (size_t)IDL[tl * 128 + 16 * (k + 1) + j] * D + 16 * lane);
                    int d = __builtin_amdgcn_sdot4((int)a[0], xq[0], 0, false);
                    d = __builtin_amdgcn_sdot4((int)a[1], xq[1], d, false); d = __builtin_amdgcn_sdot4((int)a[2], xq[2], d, false); d = __builtin_amdgcn_sdot4((int)a[3], xq[3], d, false);
                    d = wave_isum(d);
                    const int e = 16 * k + j;
                    if (lane == (e & 63)) { if (k < 4) h0i = d; else h1i = d; }
                }
            }
            const float h0 = su0 * sx * (float)h0i, h1 = su1 * sx * (float)h1i;
            GTL[tl * 128 + lane] = sv0 * GTL[tl * 128 + lane] * gelu_erf(h0);
            GTL[tl * 128 + 64 + lane] = sv1 * GTL[tl * 128 + 64 + lane] * gelu_erf(h1);
        }
        for (int ti = 0; ti < 8; ++ti) {
            const int tl = 8 * w + ti, tok = tok0 + tl;
            float* hrow = H + (size_t)tok * D + 16 * lane;
            float xv[16];
#pragma unroll
            for (int j = 0; j < 4; ++j) { const f32x4 a = *(const f32x4*)(hrow + 4 * j); xv[4 * j] = a[0]; xv[4 * j + 1] = a[1]; xv[4 * j + 2] = a[2]; xv[4 * j + 3] = a[3]; }
            const float w0 = GTL[tl * 128 + lane], w1 = GTL[tl * 128 + 64 + lane];
            const float wmx = xrow16_max(row16_max(fmaxf(fabsf(w0), fabsf(w1))));
            const float winv = wmx > 0.f ? 127.f / wmx : 0.f, sw = wmx * (1.f / 127.f);
            const f32x4 wv = *(const LAS f32x4*)(GTL + tl * 128 + 4 * (lane & 31));
            const int wq = (int)(((unsigned)__float2int_rn(wv[0] * winv) & 0xffu) | (((unsigned)__float2int_rn(wv[1] * winv) & 0xffu) << 8) |
                                 (((unsigned)__float2int_rn(wv[2] * winv) & 0xffu) << 16) | ((unsigned)__float2int_rn(wv[3] * winv) << 24));
            int yi[16];
#pragma unroll
            for (int i = 0; i < 16; ++i) yi[i] = 0;
            u32x4 ring[16];
#pragma unroll
            for (int j = 0; j < 16; ++j) ring[j] = *(const u32x4*)(V + (size_t)IDL[tl * 128 + j] * D + 16 * lane);
#pragma unroll 1
            for (int k = 0; k < 8; ++k) {
#pragma unroll
                for (int g4 = 0; g4 < 4; ++g4) {
                    const u32x4 a0 = ring[4 * g4], a1 = ring[4 * g4 + 1], a2 = ring[4 * g4 + 2], a3 = ring[4 * g4 + 3];
                    if (k < 7) {
#pragma unroll
                        for (int q = 0; q < 4; ++q) ring[4 * g4 + q] = *(const u32x4*)(V + (size_t)IDL[tl * 128 + 16 * (k + 1) + 4 * g4 + q] * D + 16 * lane);
                    }
                    const int wg = __builtin_amdgcn_readlane(wq, 4 * k + g4);
#pragma unroll
                    for (int q = 0; q < 4; ++q) {
                        const unsigned p0 = __builtin_amdgcn_perm(a1[q], a0[q], 0x05010400u), p1 = __builtin_amdgcn_perm(a1[q], a0[q], 0x07030602u);
                        const unsigned p2 = __builtin_amdgcn_perm(a3[q], a2[q], 0x05010400u), p3 = __builtin_amdgcn_perm(a3[q], a2[q], 0x07030602u);
                        yi[4 * q] = __builtin_amdgcn_sdot4((int)__builtin_amdgcn_perm(p2, p0, 0x05040100u), wg, yi[4 * q], false);
                        yi[4 * q + 1] = __builtin_amdgcn_sdot4((int)__builtin_amdgcn_perm(p2, p0, 0x07060302u), wg, yi[4 * q + 1], false);
                        yi[4 * q + 2] = __builtin_amdgcn_sdot4((int)__builtin_amdgcn_perm(p3, p1, 0x05040100u), wg, yi[4 * q + 2], false);
                        yi[4 * q + 3] = __builtin_amdgcn_sdot4((int)__builtin_amdgcn_perm(p3, p1, 0x07060302u), wg, yi[4 * q + 3], false);
                    }
                }
            }
            float y[16];
#pragma unroll
            for (int i = 0; i < 16; ++i) y[i] = xv[i] + sw * (float)yi[i];
#pragma unroll
            for (int j = 0; j < 4; ++j) *(f32x4*)(hrow + 4 * j) = (f32x4){y[4 * j], y[4 * j + 1], y[4 * j + 2], y[4 * j + 3]};
            bf16* hb = HB2 + (size_t)tok * D + 16 * lane;
            u32x4 o; o.x = pk2(y[0], y[1]); o.y = pk2(y[2], y[3]); o.z = pk2(y[4], y[5]); o.w = pk2(y[6], y[7]);
            *(u32x4*)hb = o;
            o.x = pk2(y[8], y[9]); o.y = pk2(y[10], y[11]); o.z = pk2(y[12], y[13]); o.w = pk2(y[14], y[15]);
            *(u32x4*)(hb + 8) = o;
        }
    }
    __syncthreads();
}
#undef CE

__device__ void phase_final(const Params& p, int bid, int nblk) {
    const int tid = tidx(), lane = tid & 63, gw = bid * NWAVES + (tid >> 6), NGW = nblk * NWAVES;
    const float* H = (const float*)(p.ws + WS_H);
    for (int m = gw; m < M; m += NGW) {
        f32x4 v[4]; float ss = 0.f;
#pragma unroll
        for (int j = 0; j < 4; ++j) { v[j] = ((const f32x4*)(H + (size_t)m * D))[lane + 64 * j]; ss += (v[j][0] * v[j][0] + v[j][1] * v[j][1]) + (v[j][2] * v[j][2] + v[j][3] * v[j][3]); }
        const float r = rsqrtf(wave_sum(ss) * (1.f / D) + EPS);
#pragma unroll
        for (int j = 0; j < 4; ++j) { const f32x4 gv = ((const f32x4*)p.final_g)[lane + 64 * j]; ((f32x4*)(p.out + (size_t)m * D))[lane + 64 * j] = v[j] * r * gv; }
    }
}

#define XB_TMO      128
#define XB_XCNT(j)  (256  + 64 * (j))
#define XB_XSUB(j)  (1280 + 64 * (j))
#define XB_XGEN(j)  (2304 + 64 * (j))
#define XB_TOP      3328
#define XB_TOPGEN   3392
#define XCD_BAR_WORDS 3456
#define XB_SPIN_CAP (1u << 22)
__device__ __forceinline__ unsigned xb_ld(unsigned* p)              { return __hip_atomic_load(p, __ATOMIC_RELAXED, __HIP_MEMORY_SCOPE_AGENT); }
__device__ __forceinline__ unsigned xb_add(unsigned* p, unsigned v) { return __hip_atomic_fetch_add(p, v, __ATOMIC_RELAXED, __HIP_MEMORY_SCOPE_AGENT); }
__device__ __forceinline__ unsigned xb_xcc_id() { return (unsigned)__builtin_amdgcn_s_getreg((3 << 11) | 20) & 0xFu; }
#define XB_SPIN(cond, bar) do { unsigned _sp = 0; while (cond) { __builtin_amdgcn_s_sleep(1); \
    if ((++_sp & 255u) == 0u) { if (xb_ld(&(bar)[XB_TMO])) break; if (_sp > XB_SPIN_CAP) { atomicAdd(&(bar)[XB_TMO], 1u); break; } } } } while (0)
struct XcdBarrier { unsigned* bar; unsigned x; volatile LAS unsigned* st; };
__device__ __forceinline__ XcdBarrier xcd_barrier_post(unsigned* bar, volatile LAS unsigned* st) {
    XcdBarrier b; b.bar = bar; b.x = xb_xcc_id(); b.st = st;
    if (threadIdx.x == 0) (void)xb_add(&bar[XB_XCNT(b.x)], 1u);
    return b;
}
__device__ __forceinline__ void xcd_barrier_complete(unsigned* bar, unsigned x, unsigned& nloc, unsigned& nx) {
    const unsigned G = gridDim.x * gridDim.y * gridDim.z;
    unsigned sum, cnt, mine, sp = 0u;
    for (;;) {
        sum = 0u; cnt = 0u; mine = 0u;
#pragma unroll
        for (unsigned j = 0; j < 16; ++j) { const unsigned c = xb_ld(&bar[XB_XCNT(j)]); sum += c; cnt += (c > 0u) ? 1u : 0u; mine = (j == x) ? c : mine; }
        if (sum == G) break;
        __builtin_amdgcn_s_sleep(1);
        if ((++sp & 255u) == 0u) { if (xb_ld(&bar[XB_TMO])) break; if (sp > XB_SPIN_CAP) { atomicAdd(&bar[XB_TMO], 1u); break; } }
    }
    nloc = mine > 0u ? mine : 1u; nx = cnt > 0u ? cnt : 1u;
}
__device__ __forceinline__ void xcd_barrier(const XcdBarrier& b) {
    asm volatile("s_waitcnt vmcnt(0)" ::: "memory");
    __syncthreads();
    if (threadIdx.x == 0) {
        unsigned* bar = b.bar;
        __builtin_amdgcn_s_waitcnt(0);
        unsigned nloc = b.st[0], nx = b.st[1];
        if (nloc == 0u) { xcd_barrier_complete(bar, b.x, nloc, nx); b.st[0] = nloc; b.st[1] = nx; }
        const unsigned old = xb_add(&bar[XB_XSUB(b.x)], 1u);
        const unsigned gen = old / nloc;
        if (old + 1u == (gen + 1u) * nloc) {
            __builtin_amdgcn_fence(__ATOMIC_RELEASE, "agent");
            asm volatile("s_waitcnt vmcnt(0)" ::: "memory");
            const unsigned og = xb_add(&bar[XB_TOP], 1u);
            const unsigned tg = og / nx;
            if (og + 1u == (tg + 1u) * nx) xb_add(&bar[XB_TOPGEN], 1u);
            else XB_SPIN(xb_ld(&bar[XB_TOPGEN]) == tg, bar);
            __builtin_amdgcn_fence(__ATOMIC_ACQUIRE, "agent");
            xb_add(&bar[XB_XGEN(b.x)], 1u);
            asm volatile("s_waitcnt vmcnt(0)" ::: "memory");
        } else {
            XB_SPIN(xb_ld(&bar[XB_XGEN(b.x)]) == gen, bar);
            __builtin_amdgcn_fence(__ATOMIC_ACQUIRE, "agent");
            asm volatile("s_waitcnt vmcnt(0)" ::: "memory");
        }
    }
    __syncthreads();
}
constexpr int CW_BAR = 4096;

constexpr int K_PROLOGUE = 11, K_FINAL = 12;
template <int KIND>
__device__ __forceinline__ void run_kind(const Params& p, int L, LAS unsigned char* lds, int bid, int nblk) {
    unsigned char* ws = p.ws;
    float* H = (float*)(ws + WS_H);
    float* ss0 = (float*)(ws + WS_STAT); float* ss1 = (float*)(ws + WS_SS1); float* sse = (float*)(ws + WS_SSE);
    if constexpr (KIND == K_PROLOGUE) phase_prologue(p, lds, bid, nblk);
    if constexpr (KIND == K_FINAL) phase_final(p, bid, nblk);
    if constexpr (KIND == 0) { EpiProj E{nullptr, (bf16*)(ws + WS_PROJ), (float*)(ws + WS_BA)};
        gemm_run(lds, (const bf16*)(ws + WS_HB0), (const bf16*)(ws + WS_WIN) + (size_t)L * IN_PAD * D, M, IN_PAD, D, E, bid, nblk, ss0); }
    if constexpr (KIND == 1) phase_gdn_prep(p, L, lds, bid, nblk);
    if constexpr (KIND == 2) { phase_gdn_scan(p, L, lds, bid, nblk); phase_att_queue(p, L, lds, bid, nblk); }
    if constexpr (KIND == 3) { EpiRes E{ss1, H, (bf16*)(ws + WS_HB1)};
        gemm_run(lds, (const bf16*)(ws + WS_OBUF), (const bf16*)(ws + WS_WOUT) + (size_t)L * D * D, M, D, D, E, bid, nblk); }
    if constexpr (KIND == 4) { EpiQ2 E{nullptr, (bf16*)(ws + WS_Q2)};
        gemm_run(lds, (const bf16*)(ws + WS_HB1), (const bf16*)(ws + WS_WQ) + (size_t)L * 2048 * D, M, 2048, D, E, bid, nblk, ss1); }
    if constexpr (KIND == 5) phase_peer(p, L, lds, bid, nblk);
    if constexpr (KIND == 7) { EpiE E2{sse, (bf16*)(ws + WS_EPRE)};
        gemm_run(lds, (const bf16*)(ws + WS_PB) + (size_t)L * M * 256, (const bf16*)(ws + WS_WP) + (size_t)L * D * 256, M, D, 256, E2, bid, nblk); }
    if constexpr (KIND == 6) { EpiPle E{ss0, H, (bf16*)(ws + WS_HB0), (const bf16*)(ws + WS_EPRE), p.ple_norm_g + L * D};
        gemm_run(lds, (const bf16*)(ws + WS_HB2), (const bf16*)(ws + WS_WG) + (size_t)L * D * D, M, D, D, E, bid, nblk, sse); }
}

__device__ __forceinline__ Params params_off(const Params& s, size_t z) {
    Params q;
    q.x = s.x + z; q.p = s.p + z; q.ln_mix_g = s.ln_mix_g + z; q.w_in = s.w_in + z; q.conv_w = s.conv_w + z; q.a_log = s.a_log + z; q.dt_bias = s.dt_bias + z;
    q.gdn_norm_g = s.gdn_norm_g + z; q.diff_lambda = s.diff_lambda + z; q.subln_g = s.subln_g + z; q.w_out = s.w_out + z; q.ln_ffn_g = s.ln_ffn_g + z;
    q.peer_wq = s.peer_wq + z; q.subkeys = s.subkeys + z; q.peer_u = s.peer_u + z; q.peer_v = s.peer_v + z; q.ple_wp = s.ple_wp + z; q.ple_wg = s.ple_wg + z;
    q.ple_norm_g = s.ple_norm_g + z; q.final_g = s.final_g + z; q.out = s.out + z; q.ws = s.ws + z; q.pad0 = 0; q.pad1 = 0;
    return q;
}
#define RUN(KIND) do { size_t z_ = 0; int L_ = L; asm volatile("" : "+s"(z_), "+s"(L_)); const Params q_ = params_off(p, z_); run_kind<KIND>(q_, L_, (LAS unsigned char*)lds, (int)blockIdx.x, (int)gridDim.x); } while (0)
#define GRID_BARRIER() do { XcdBarrier b_; b_.bar = (unsigned*)(p.ws + WS_CTL) + CW_BAR; b_.x = xb_xcc_id(); b_.st = (volatile LAS unsigned*)((LAS unsigned char*)lds + LDS_MISC_OFF) + 8; xcd_barrier(b_); } while (0)
__global__ void __launch_bounds__(NTHREADS, 2) mk_fwd(Params p) {
    extern __shared__ __attribute__((aligned(16))) unsigned char lds[];
    {
        volatile LAS unsigned* misc = (volatile LAS unsigned*)((LAS unsigned char*)lds + LDS_MISC_OFF);
        if (threadIdx.x < 64) misc[threadIdx.x] = 0u;
        __syncthreads();
        (void)xcd_barrier_post((unsigned*)(p.ws + WS_CTL) + CW_BAR, misc + 8);
    }
    { int L = 0; RUN(K_PROLOGUE); }
    cg::this_grid().sync();
#define LAYER(LL) do { const int L = (LL); RUN(0); GRID_BARRIER(); RUN(1); GRID_BARRIER(); RUN(2); GRID_BARRIER(); RUN(3); GRID_BARRIER(); RUN(4); GRID_BARRIER(); RUN(5); RUN(7); GRID_BARRIER(); RUN(6); GRID_BARRIER(); } while (0)
    LAYER(0); LAYER(1); LAYER(2); LAYER(3);
#undef LAYER
    { int L = 0; RUN(K_FINAL); }
}

extern "C" void kernel_launch(void* const* d_in, const int* in_sizes, int n_in, void* d_out, int out_size, void* d_ws, size_t ws_size, hipStream_t stream) {
    static int grid = 0;
    if (grid == 0) {
        if (n_in != 20 || out_size != M * D || ws_size < WS_END) { fprintf(stderr, "kernel_launch: unexpected shapes (n_in %d, out %d, ws %zu < %zu)\n", n_in, out_size, ws_size, (size_t)WS_END); grid = -1; return; }
        int dev = 0, cus = 0, per_cu = 0;
        (void)hipGetDevice(&dev); (void)hipDeviceGetAttribute(&cus, hipDeviceAttributeMultiprocessorCount, dev);
        if (hipFuncSetAttribute((const void*)mk_fwd, hipFuncAttributeMaxDynamicSharedMemorySize, LDS_BYTES) != hipSuccess) { fprintf(stderr, "kernel_launch: hipFuncSetAttribute failed\n"); grid = -1; return; }
        if (hipOccupancyMaxActiveBlocksPerMultiprocessor(&per_cu, (const void*)mk_fwd, NTHREADS, LDS_BYTES) != hipSuccess || per_cu < 1) { fprintf(stderr, "kernel_launch: occupancy query says %d blocks per CU\n", per_cu); (void)hipGetLastError(); grid = -1; return; }
        grid = (cus > 0 ? cus : 256);
    }
    if (grid < 0) return;
    (void)hipMemsetAsync((char*)d_ws + WS_CTL, 0, CTL_ZERO_BYTES, stream);
    Params p{};
    const float** pp = (const float**)&p;
    for (int i = 0; i < 20; ++i) pp[i] = (const float*)d_in[i];
    p.out = (float*)d_out; p.ws = (unsigned char*)d_ws;
    void* args[] = {&p};
    hipError_t e = hipLaunchCooperativeKernel((const void*)mk_fwd, dim3(grid), dim3(NTHREADS), args, LDS_BYTES, stream);
    if (e != hipSuccess) fprintf(stderr, "kernel_launch: cooperative launch failed: %s (grid %d)\n", hipGetErrorString(e), grid);
}
```

```cpp
#include <hip/hip_runtime.h>
#include <hip/hip_cooperative_groups.h>
#include <cstdio>
#include <cstdint>
namespace cg = cooperative_groups;

#define LAS __attribute__((address_space(3)))
typedef unsigned short bf16;
typedef float f32x4 __attribute__((ext_vector_type(4)));
typedef short bf16x8 __attribute__((ext_vector_type(8)));
typedef unsigned u32x4 __attribute__((ext_vector_type(4)));
typedef unsigned u32x2 __attribute__((ext_vector_type(2)));

constexpr int D = 1024, BATCH = 8, SEQ = 2048, DEPTH = 4, M = BATCH * SEQ;
constexpr int IN_COLS = 3592, IN_PAD = 3840, PROJ_W = 3584;
constexpr int NEXP = 16384;
constexpr float EPS = 1e-6f;
constexpr float QSCALE = 0.125f * 1.4426950408889634f;
constexpr int NWAVES = 8, NTHREADS = 512;
constexpr int LDS_BYTES = 163840;
constexpr int LDS_MISC_OFF = LDS_BYTES - 256;
constexpr int RS_OFF = 147456;
constexpr int CW_QUEUE = 1024;

constexpr size_t MiB = 1u << 20;
constexpr size_t WS_CTL = 0, CTL_ZERO_BYTES = 1 * MiB;
constexpr size_t WS_H = 1 * MiB;
constexpr size_t WS_HB0 = 65 * MiB;
constexpr size_t WS_HB1 = 97 * MiB;
constexpr size_t WS_HB2 = 129 * MiB;
constexpr size_t WS_PROJ = 161 * MiB;
constexpr size_t WS_BA = 273 * MiB;
constexpr size_t WS_OBUF = 274 * MiB;
constexpr size_t WS_Q2 = 306 * MiB;
constexpr size_t WS_EPRE = 370 * MiB;
constexpr size_t WS_IDX = 402 * MiB;
constexpr size_t WS_GATE = 410 * MiB;
constexpr size_t WS_STAT = 418 * MiB;
constexpr size_t WS_SS1 = WS_IDX + 1 * MiB, WS_SSE = WS_IDX;
constexpr size_t WS_ORAW = 422 * MiB;
constexpr size_t WS_WIN = 550 * MiB;
constexpr size_t WS_WOUT = 582 * MiB;
constexpr size_t WS_WQ = 590 * MiB;
constexpr size_t WS_WG = 606 * MiB;
constexpr size_t WS_WP = 614 * MiB;
constexpr size_t WS_SK = 616 * MiB;
constexpr size_t WS_PB = 618 * MiB;
constexpr size_t WS_U = 650 * MiB;
constexpr size_t WS_V = 778 * MiB;
constexpr size_t WS_SU = WS_STAT + 1 * MiB, WS_SV = WS_STAT + 2 * MiB;
constexpr size_t WS_END = 906 * MiB;

struct Params {
    const float *x, *p, *ln_mix_g, *w_in, *conv_w, *a_log, *dt_bias, *gdn_norm_g, *diff_lambda, *subln_g, *w_out, *ln_ffn_g,
        *peer_wq, *subkeys, *peer_u, *peer_v, *ple_wp, *ple_wg, *ple_norm_g, *final_g;
    float* out;
    unsigned char* ws;
    int pad0, pad1;
};

__device__ __forceinline__ int tidx() { int t = (int)threadIdx.x; asm volatile("" : "+v"(t)); return t; }
#define LDS_BARRIER() asm volatile("s_waitcnt lgkmcnt(0)\n\ts_barrier" ::: "memory")
__device__ __forceinline__ float bf2f(bf16 v) { return __uint_as_float((unsigned)v << 16); }
__device__ __forceinline__ unsigned f2bf(float f) { unsigned u = __float_as_uint(f); return (u + 0x7fffu + ((u >> 16) & 1u)) >> 16; }
__device__ __forceinline__ unsigned pk2(float lo, float hi) { return f2bf(lo) | (f2bf(hi) << 16); }
__device__ __forceinline__ float lo16(unsigned w) { return __uint_as_float(w << 16); }
__device__ __forceinline__ float hi16(unsigned w) { return __uint_as_float(w & 0xffff0000u); }
template <int N> __device__ __forceinline__ float dpp_ror(float x) { return __builtin_bit_cast(float, __builtin_amdgcn_mov_dpp(__builtin_bit_cast(int, x), 0x120 + N, 0xf, 0xf, true)); }
template <int N> __device__ __forceinline__ unsigned dpp_ror_u(unsigned x) { return (unsigned)__builtin_amdgcn_mov_dpp((int)x, 0x120 + N, 0xf, 0xf, true); }
__device__ __forceinline__ float row16_sum(float x) { x += dpp_ror<8>(x); x += dpp_ror<4>(x); x += dpp_ror<2>(x); x += dpp_ror<1>(x); return x; }
__device__ __forceinline__ float row16_max(float x) { x = fmaxf(x, dpp_ror<8>(x)); x = fmaxf(x, dpp_ror<4>(x)); x = fmaxf(x, dpp_ror<2>(x)); x = fmaxf(x, dpp_ror<1>(x)); return x; }
__device__ __forceinline__ unsigned row16_umax(unsigned x) { unsigned y;
    y = dpp_ror_u<8>(x); x = x > y ? x : y; y = dpp_ror_u<4>(x); x = x > y ? x : y; y = dpp_ror_u<2>(x); x = x > y ? x : y; y = dpp_ror_u<1>(x); x = x > y ? x : y; return x; }
__device__ __forceinline__ float xrow16_max(float x) {
    auto s = __builtin_amdgcn_permlane16_swap(__float_as_uint(x), __float_as_uint(x), false, false);
    x = fmaxf(__uint_as_float(s[0]), __uint_as_float(s[1]));
    auto t = __builtin_amdgcn_permlane32_swap(__float_as_uint(x), __float_as_uint(x), false, false);
    return fmaxf(__uint_as_float(t[0]), __uint_as_float(t[1]));
}
__device__ __forceinline__ float xrow16_sum(float x) {
    auto s = __builtin_amdgcn_permlane16_swap(__float_as_uint(x), __float_as_uint(x), false, false);
    x = __uint_as_float(s[0]) + __uint_as_float(s[1]);
    auto t = __builtin_amdgcn_permlane32_swap(__float_as_uint(x), __float_as_uint(x), false, false);
    return __uint_as_float(t[0]) + __uint_as_float(t[1]);
}
__device__ __forceinline__ float wave_sum(float v) { return xrow16_sum(row16_sum(v)); }
template <int N> __device__ __forceinline__ int dpp_ror_i(int x) { return __builtin_amdgcn_mov_dpp(x, 0x120 + N, 0xf, 0xf, true); }
__device__ __forceinline__ int wave_isum(int x) {
    x += dpp_ror_i<8>(x); x += dpp_ror_i<4>(x); x += dpp_ror_i<2>(x); x += dpp_ror_i<1>(x);
    auto s = __builtin_amdgcn_permlane16_swap((unsigned)x, (unsigned)x, false, false); x = (int)(s[0] + s[1]);
    auto t = __builtin_amdgcn_permlane32_swap((unsigned)x, (unsigned)x, false, false); return (int)(t[0] + t[1]);
}
__device__ __forceinline__ float wave_max(float v) {
#pragma unroll
    for (int o = 32; o; o >>= 1) v = fmaxf(v, __shfl_xor(v, o));
    return v;
}
__device__ __forceinline__ float sigmoidf_(float x) { return 1.f / (1.f + __expf(-x)); }
__device__ __forceinline__ float dot8(u32x4 a, u32x4 b, float s) {
#pragma unroll
    for (int i = 0; i < 4; ++i) { s += lo16(a[i]) * lo16(b[i]); s += hi16(a[i]) * hi16(b[i]); }
    return s;
}

__host__ __device__ __forceinline__ int lds_byte(int r, int c) { const int st = (r >> 4) * 2 + (c >> 5), rr = r & 15, cc = c & 31, ob = rr * 64 + cc * 2; return st * 1024 + (ob ^ (((ob >> 9) & 1) << 5)); }
__host__ __device__ __forceinline__ void stage_rc(int b, int& R, int& C) { const int st = b / 1024, sb = b % 1024, swz = sb ^ (((sb >> 9) & 1) << 5); R = (st >> 1) * 16 + swz / 64; C = (st & 1) * 32 + (swz % 64) / 2; }
constexpr int HTB = 16384;
template <class F>
__device__ __forceinline__ void gemm_run(LAS unsigned char* lds, const bf16* A, const bf16* Bt, int Mm, int N, int K, const F& f, int bid, int nblk, const float* slots_in = nullptr) {
    LAS float* RS = (LAS float*)(lds + RS_OFF);
    int rs_pm = -1;
    const int tid = tidx(), wid = __builtin_amdgcn_readfirstlane(tid >> 6), lane = tid & 63, wr = wid >> 2, wc = wid & 3, fr = lane & 15, fq = lane >> 4;
    const int nt = K / 64, ntn = N / 256, nunits = (Mm / 256) * ntn;
    unsigned voff[2];
#pragma unroll
    for (int i = 0; i < 2; ++i) { const int uu = tid + 512 * i, r = uu >> 3, c = (uu & 7) ^ ((r >> 1) & 7); voff[i] = (unsigned)(r * K + c * 8) * 2u; }
    const unsigned ldsw = (unsigned)wid * 1024u;
    const int sw7 = (fr >> 1) & 7;
    const int aoff0 = wr * HTB + fr * 128 + ((fq ^ sw7) << 4), aoff1 = wr * HTB + fr * 128 + (((4 + fq) ^ sw7) << 4);
    const int bbase = (2 + (wc >> 1)) * HTB + (wc & 1) * 8192 + fr * 128;
    const int boff0 = bbase + ((fq ^ sw7) << 4), boff1 = bbase + (((4 + fq) ^ sw7) << 4);
#define G_STAGE(bufoff, gbase) do { _Pragma("unroll") for (int _i = 0; _i < 2; ++_i) \
        __builtin_amdgcn_global_load_lds((const unsigned*)((const char*)(gbase) + voff[_i]), (LAS unsigned*)(lds + (bufoff) + ldsw + _i * 8192), 16, 0, 0); } while (0)
    for (int u = bid; u < nunits; u += nblk) {
        const int pm = u % (Mm / 256), pn = u / (Mm / 256);
        if (slots_in && pm != rs_pm) {
            __syncthreads();
            if (tid < 256) { const f32x4* sp = (const f32x4*)(slots_in + ((size_t)pm * 256 + tid) * 16);
                const f32x4 a = sp[0], b = sp[1], c = sp[2], d = sp[3];
                const float s = (((a[0] + a[1]) + (a[2] + a[3])) + ((b[0] + b[1]) + (b[2] + b[3]))) + (((c[0] + c[1]) + (c[2] + c[3])) + ((d[0] + d[1]) + (d[2] + d[3])));
                RS[tid] = rsqrtf(s * (1.f / D) + EPS); }
            __syncthreads();
            rs_pm = pm;
        }
        const char* gA = (const char*)(A + (size_t)pm * 256 * K);
        const char* gB = (const char*)(Bt + (size_t)pn * 256 * K);
        const size_t hstep = (size_t)128 * K * 2;
        f32x4 acc[8][4];
#pragma unroll
        for (int a = 0; a < 8; ++a)
#pragma unroll
            for (int b = 0; b < 4; ++b) acc[a][b] = (f32x4){0.f, 0.f, 0.f, 0.f};
        G_STAGE(0, gA); G_STAGE(HTB, gA + hstep); G_STAGE(2 * HTB, gB); G_STAGE(3 * HTB, gB + hstep);
        for (int t = 0; t < nt; ++t) {
            const int cb = (t & 1) * 4 * HTB, nb = ((t + 1) & 1) * 4 * HTB;
            asm volatile("s_waitcnt vmcnt(0)" ::: "memory");
            __builtin_amdgcn_s_barrier();
            asm volatile("" ::: "memory");
            const size_t ko = (size_t)(t + 1) * 128; const bool more = t + 1 < nt;
#pragma unroll
            for (int k = 0; k < 2; ++k) {
                if (more) { if (k == 0) { G_STAGE(nb, gA + ko); G_STAGE(nb + 2 * HTB, gB + ko); } else { G_STAGE(nb + HTB, gA + hstep + ko); G_STAGE(nb + 3 * HTB, gB + hstep + ko); } }
                bf16x8 bfr[4], acur, anxt;
#pragma unroll
                for (int n = 0; n < 4; ++n) bfr[n] = *(const LAS bf16x8*)(lds + cb + (k ? boff1 : boff0) + n * 2048);
                acur = *(const LAS bf16x8*)(lds + cb + (k ? aoff1 : aoff0));
#pragma unroll
                for (int m = 0; m < 8; ++m) {
                    if (m < 7) anxt = *(const LAS bf16x8*)(lds + cb + (k ? aoff1 : aoff0) + (m + 1) * 2048);
#pragma unroll
                    for (int n = 0; n < 4; ++n) acc[m][n] = __builtin_amdgcn_mfma_f32_16x16x32_bf16(bfr[n], acur, acc[m][n], 0, 0, 0);
                    acur = anxt;
                }
                __builtin_amdgcn_sched_barrier(0);
            }
            asm volatile("s_waitcnt lgkmcnt(0)" ::: "memory");
        }
        {
            int el = lane; asm volatile("" : "+v"(el));
            const int efr = el & 15, efq = el >> 4;
            LAS float* et = (LAS float*)(lds + wid * 4352);
#pragma unroll
            for (int m = 0; m < 8; ++m) {
#pragma unroll
                for (int n = 0; n < 4; ++n) *(LAS f32x4*)(et + efr * 68 + n * 16 + 4 * efq) = acc[m][n];
                asm volatile("s_waitcnt lgkmcnt(0)" ::: "memory");
#pragma unroll
                for (int i = 0; i < 4; ++i) {
                    const int lrow = wr * 128 + m * 16 + 4 * i + efq, row = pm * 256 + lrow;
                    const f32x4 v = *(const LAS f32x4*)(et + (4 * i + efq) * 68 + 4 * efr);
                    const f32x4 r = f(row, RS[lrow], pn * 256 + wc * 64 + 4 * efr, v);
                    if constexpr (F::STATS) { const float ssq = row16_sum((r[0] * r[0] + r[1] * r[1]) + (r[2] * r[2] + r[3] * r[3])); if (efr == 0) f.slots[(size_t)row * 16 + pn * 4 + wc] = ssq; }
                }
                asm volatile("s_waitcnt lgkmcnt(0)" ::: "memory");
                __builtin_amdgcn_sched_barrier(0);
            }
        }
        __syncthreads();
    }
#undef G_STAGE
}

__device__ __forceinline__ u32x2 pk4(f32x4 a) { u32x2 o; o.x = pk2(a[0], a[1]); o.y = pk2(a[2], a[3]); return o; }
struct EpiProj {
    static constexpr bool STATS = false; float* slots;
    bf16* proj; float* ba;
    __device__ __forceinline__ f32x4 operator()(int row, float rstd, int col, f32x4 v) const {
        v = v * rstd;
        if (col < PROJ_W) *(u32x2*)(proj + (size_t)row * PROJ_W + col) = pk4(v);
        else if (col < IN_COLS) *(f32x4*)(ba + (size_t)row * 8 + (col - PROJ_W)) = v;
        return v;
    }
};
struct EpiRes {
    static constexpr bool STATS = true; float* slots;
    float* H; bf16* HB;
    __device__ __forceinline__ f32x4 operator()(int row, float, int col, f32x4 v) const {
        f32x4* hp = (f32x4*)(H + (size_t)row * D + col);
        const f32x4 h = *hp + v; *hp = h;
        *(u32x2*)(HB + (size_t)row * D + col) = pk4(h);
        return h;
    }
};
struct EpiQ2 {
    static constexpr bool STATS = false; float* slots;
    bf16* Q2;
    __device__ __forceinline__ f32x4 operator()(int row, float rstd, int col, f32x4 v) const { v = v * rstd; *(u32x2*)(Q2 + (size_t)row * 2048 + col) = pk4(v); return v; }
};
struct EpiE {
    static constexpr bool STATS = true; float* slots;
    bf16* E;
    __device__ __forceinline__ f32x4 operator()(int row, float, int col, f32x4 v) const { *(u32x2*)(E + (size_t)row * D + col) = pk4(v); return v; }
};
struct EpiPle {
    static constexpr bool STATS = true; float* slots;
    float* H; bf16* HB; const bf16* E; const float* g;
    __device__ __forceinline__ f32x4 operator()(int row, float rstde, int col, f32x4 v) const {
        f32x4* hp = (f32x4*)(H + (size_t)row * D + col);
        const u32x2 ev = *(const u32x2*)(E + (size_t)row * D + col);
        const f32x4 gv = *(const f32x4*)(g + col);
        f32x4 h = *hp;
        h[0] += sigmoidf_(v[0]) * (lo16(ev.x) * rstde * gv[0]); h[1] += sigmoidf_(v[1]) * (hi16(ev.x) * rstde * gv[1]);
        h[2] += sigmoidf_(v[2]) * (lo16(ev.y) * rstde * gv[2]); h[3] += sigmoidf_(v[3]) * (hi16(ev.y) * rstde * gv[3]);
        *hp = h;
        *(u32x2*)(HB + (size_t)row * D + col) = pk4(h);
        return h;
    }
};

__device__ __forceinline__ void transpose_item(const float* W, int K, int N, int Npad, bf16* WT, const float* rowscale, int qcols, float* scr, int item, int lane) {
    const int nblk = Npad / 32, kb = item / nblk, nb = item % nblk, k0 = 64 * kb, n0 = 32 * nb;
    const int n = n0 + (lane & 31);
#pragma unroll 8
    for (int i = 0; i < 32; ++i) {
        const int kk = 2 * i + (lane >> 5);
        float v = (n < N) ? W[(size_t)(k0 + kk) * N + n] : 0.f;
        if (rowscale) v *= rowscale[k0 + kk];
        if (n < qcols) v *= QSCALE;
        scr[kk * 33 + (lane & 31)] = v;
    }
    asm volatile("s_waitcnt lgkmcnt(0)" ::: "memory");
    const int c = lane & 7;
#pragma unroll
    for (int j = 0; j < 4; ++j) {
        const int nn = (lane >> 3) + 8 * j; const float* s = scr + (8 * c) * 33 + nn;
        u32x4 o; o.x = pk2(s[0 * 33], s[1 * 33]); o.y = pk2(s[2 * 33], s[3 * 33]); o.z = pk2(s[4 * 33], s[5 * 33]); o.w = pk2(s[6 * 33], s[7 * 33]);
        *(u32x4*)(WT + (size_t)(n0 + nn) * K + k0 + 8 * c) = o;
    }
    asm volatile("s_waitcnt lgkmcnt(0)" ::: "memory");
}
__device__ __forceinline__ void convert_bulk(const float* src, bf16* dst, size_t n, size_t gtid, size_t nthr) {
    for (size_t i = gtid * 8; i < n; i += nthr * 8) {
        const f32x4 a = *(const f32x4*)(src + i), b = *(const f32x4*)(src + i + 4);
        u32x4 o; o.x = pk2(a[0], a[1]); o.y = pk2(a[2], a[3]); o.z = pk2(b[0], b[1]); o.w = pk2(b[2], b[3]);
        *(u32x4*)(dst + i) = o;
    }
}
__device__ void phase_prologue(const Params& p, LAS unsigned char* lds_, int bid, int nblk) {
    unsigned char* lds = (unsigned char*)lds_;
    const int tid = tidx(), lane = tid & 63, w = tid >> 6;
    const int gw = bid * NWAVES + w, NGW = nblk * NWAVES;
    float* scr = (float*)(lds + w * 16384);
    constexpr int I_IN = 16 * (IN_PAD / 32), I_OUT = 16 * 32, I_Q = 16 * 64, I_G = 16 * 32, I_P = 4 * 32, I_L = I_IN + I_OUT + I_Q + I_G + I_P;
    for (int it = gw; it < DEPTH * I_L; it += NGW) {
        const int L = it / I_L; int r = it % I_L;
        if (r < I_IN) { transpose_item(p.w_in + (size_t)L * D * IN_COLS, D, IN_COLS, IN_PAD, (bf16*)(p.ws + WS_WIN) + (size_t)L * IN_PAD * D, p.ln_mix_g + L * D, 512, scr, r, lane); continue; } r -= I_IN;
        if (r < I_OUT) { transpose_item(p.w_out + (size_t)L * D * D, D, D, D, (bf16*)(p.ws + WS_WOUT) + (size_t)L * D * D, nullptr, 0, scr, r, lane); continue; } r -= I_OUT;
        if (r < I_Q) { transpose_item(p.peer_wq + (size_t)L * D * 2048, D, 2048, 2048, (bf16*)(p.ws + WS_WQ) + (size_t)L * 2048 * D, p.ln_ffn_g + L * D, 0, scr, r, lane); continue; } r -= I_Q;
        if (r < I_G) { transpose_item(p.ple_wg + (size_t)L * D * D, D, D, D, (bf16*)(p.ws + WS_WG) + (size_t)L * D * D, nullptr, 0, scr, r, lane); continue; } r -= I_G;
        transpose_item(p.ple_wp + (size_t)L * 256 * D, 256, D, D, (bf16*)(p.ws + WS_WP) + (size_t)L * D * 256, nullptr, 0, scr, r, lane);
    }
    const size_t gtid = (size_t)bid * NTHREADS + tid, nthr = (size_t)nblk * NTHREADS;
    for (int r = gw; r < 2 * DEPTH * NEXP; r += NGW) {
        const int which = r >= DEPTH * NEXP, rr = which ? r - DEPTH * NEXP : r;
        const float* srow = (which ? p.peer_v : p.peer_u) + (size_t)rr * D + 16 * lane;
        f32x4 v[4];
#pragma unroll
        for (int j = 0; j < 4; ++j) v[j] = *(const f32x4*)(srow + 4 * j);
        float mx = 0.f;
#pragma unroll
        for (int j = 0; j < 4; ++j) mx = fmaxf(mx, fmaxf(fmaxf(fabsf(v[j][0]), fabsf(v[j][1])), fmaxf(fabsf(v[j][2]), fabsf(v[j][3]))));
        mx = xrow16_max(row16_max(mx));
        const float inv = mx > 0.f ? 127.f / mx : 0.f;
        u32x4 o;
#pragma unroll
        for (int j = 0; j < 4; ++j) {
            const unsigned b0 = (unsigned)__float2int_rn(v[j][0] * inv) & 0xffu, b1 = (unsigned)__float2int_rn(v[j][1] * inv) & 0xffu, b2 = (unsigned)__float2int_rn(v[j][2] * inv) & 0xffu, b3 = (unsigned)__float2int_rn(v[j][3] * inv) & 0xffu;
            o[j] = b0 | (b1 << 8) | (b2 << 16) | (b3 << 24);
        }
        *(u32x4*)(p.ws + (which ? WS_V : WS_U) + (size_t)rr * D + 16 * lane) = o;
        if (lane == 0) ((float*)(p.ws + (which ? WS_SV : WS_SU)))[rr] = mx * (1.f / 127.f);
    }
    convert_bulk(p.p, (bf16*)(p.ws + WS_PB), (size_t)DEPTH * M * 256, gtid, nthr);
    convert_bulk(p.subkeys, (bf16*)(p.ws + WS_SK), (size_t)DEPTH * 8 * 2 * 128 * 128, gtid, nthr);
    float* H = (float*)(p.ws + WS_H); bf16* HB0 = (bf16*)(p.ws + WS_HB0); float* ss0 = (float*)(p.ws + WS_STAT);
    for (int m = gw; m < M; m += NGW) {
        const f32x4* xr = (const f32x4*)(p.x + (size_t)m * D) + lane;
        float ss = 0.f;
#pragma unroll
        for (int j = 0; j < 4; ++j) {
            const f32x4 v = xr[64 * j];
            ss += v[0] * v[0] + v[1] * v[1] + v[2] * v[2] + v[3] * v[3];
            ((f32x4*)(H + (size_t)m * D))[lane + 64 * j] = v;
            u32x2 o; o.x = pk2(v[0], v[1]); o.y = pk2(v[2], v[3]);
            ((u32x2*)(HB0 + (size_t)m * D))[lane + 64 * j] = o;
        }
        ss = wave_sum(ss);
        if (lane < 16) ss0[(size_t)m * 16 + lane] = lane == 0 ? ss : 0.f;
    }
}

typedef short v4i16_t __attribute__((ext_vector_type(4)));
typedef __bf16 bf16x2_t __attribute__((ext_vector_type(2)));
typedef float f32x2_t __attribute__((ext_vector_type(2)));
__device__ __forceinline__ unsigned cvtpk(float lo, float hi) { f32x2_t v = {lo, hi}; bf16x2_t b = __builtin_convertvector(v, bf16x2_t); return __builtin_bit_cast(unsigned, b); }
constexpr int ATT_VOFF = 16384, ATT_VPITCH = 288;
__device__ __forceinline__ void att_unit(const Params& p, int L, LAS unsigned char* lds, int tid, int b, int hh, int qb, float lam, float lam_init) {
    const int lane = tid & 63, w = __builtin_amdgcn_readfirstlane(tid >> 6), fr = lane & 15, fq = lane >> 4;
    const bf16* proj = (const bf16*)(p.ws + WS_PROJ);
    bf16* obuf = (bf16*)(p.ws + WS_OBUF);
    {
        const float slope2 = 1.4426950408889634f / (float)(1 << (2 * (hh + 1)));
        const bf16* kbase = proj + (size_t)b * SEQ * PROJ_W + 512 + hh * 128;
        const bf16* vbase = proj + (size_t)b * SEQ * PROJ_W + 1024 + hh * 128;
        {
            const int qw0 = qb * 128 + w * 16, T = 2 * (qb + 1);
            bf16x8 qf[2][2];
#pragma unroll
            for (int mp = 0; mp < 2; ++mp)
#pragma unroll
                for (int ks = 0; ks < 2; ++ks) qf[mp][ks] = *(const bf16x8*)(proj + ((size_t)b * SEQ + qw0 + fr) * PROJ_W + hh * 128 + mp * 64 + ks * 32 + 8 * fq);
            f32x4 o[2][8];
#pragma unroll
            for (int mp = 0; mp < 2; ++mp)
#pragma unroll
                for (int dt = 0; dt < 8; ++dt) o[mp][dt] = (f32x4){0.f, 0.f, 0.f, 0.f};
            float mrun[2] = {-INFINITY, -INFINITY}, lrun[2] = {0.f, 0.f};
            u32x4 kreg[2], vreg[2];
#pragma unroll
            for (int i = 0; i < 2; ++i) { const int c = tid + 512 * i, key = c >> 4, ch = c & 15;
                kreg[i] = *(const u32x4*)(kbase + (size_t)key * PROJ_W + ch * 8); vreg[i] = *(const u32x4*)(vbase + (size_t)key * PROJ_W + ch * 8); }
            for (int t = 0; t < T; ++t) {
                const int k0 = t * 64;
#pragma unroll
                for (int i = 0; i < 2; ++i) { const int c = tid + 512 * i, key = c >> 4, ch = c & 15;
                    *(LAS u32x4*)(lds + key * 256 + ((ch ^ (key & 15)) << 4)) = kreg[i];
                    *(LAS u32x4*)(lds + ATT_VOFF + key * ATT_VPITCH + ch * 16) = vreg[i]; }
                LDS_BARRIER();
                if (t + 1 < T) {
#pragma unroll
                    for (int i = 0; i < 2; ++i) { const int c = tid + 512 * i, key = k0 + 64 + (c >> 4), ch = c & 15;
                        kreg[i] = *(const u32x4*)(kbase + (size_t)key * PROJ_W + ch * 8); vreg[i] = *(const u32x4*)(vbase + (size_t)key * PROJ_W + ch * 8); }
                }
                if (k0 <= qw0 + 15) {
                    f32x4 s[2][4];
                    const float base = -slope2 * (float)(qw0 + fr - k0 - 4 * fq);
#pragma unroll
                    for (int kt = 0; kt < 4; ++kt)
#pragma unroll
                        for (int r = 0; r < 4; ++r) { const float v = base + slope2 * (float)(16 * kt + r); s[0][kt][r] = v; s[1][kt][r] = v; }
#pragma unroll
                    for (int mp = 0; mp < 2; ++mp)
#pragma unroll
                        for (int kt = 0; kt < 4; ++kt)
#pragma unroll
                            for (int ks = 0; ks < 2; ++ks) {
                                const bf16x8 kf = *(const LAS bf16x8*)(lds + (16 * kt + fr) * 256 + (((mp * 8 + ks * 4 + fq) ^ fr) << 4));
                                s[mp][kt] = __builtin_amdgcn_mfma_f32_16x16x32_bf16(kf, qf[mp][ks], s[mp][kt], 0, 0, 0);
                            }
                    if (k0 + 63 > qw0) {
                        const int lim = qw0 + fr - k0 - 4 * fq;
#pragma unroll
                        for (int mp = 0; mp < 2; ++mp)
#pragma unroll
                            for (int kt = 0; kt < 4; ++kt)
#pragma unroll
                                for (int r = 0; r < 4; ++r) if (16 * kt + r > lim) s[mp][kt][r] = -INFINITY;
                    }
                    bf16x8 pb[2][2];
#pragma unroll
                    for (int mp = 0; mp < 2; ++mp) {
                        float mx = fmaxf(fmaxf(s[mp][0][0], s[mp][0][1]), fmaxf(s[mp][0][2], s[mp][0][3]));
#pragma unroll
                        for (int kt = 1; kt < 4; ++kt) mx = fmaxf(mx, fmaxf(fmaxf(s[mp][kt][0], s[mp][kt][1]), fmaxf(s[mp][kt][2], s[mp][kt][3])));
                        mx = xrow16_max(mx);
                        const float mnew = fmaxf(mrun[mp], mx);
                        const float alpha = __builtin_amdgcn_exp2f(mrun[mp] - mnew);
                        mrun[mp] = mnew;
                        float ps = 0.f;
#pragma unroll
                        for (int kt = 0; kt < 4; ++kt)
#pragma unroll
                            for (int r = 0; r < 4; ++r) { const float e = __builtin_amdgcn_exp2f(s[mp][kt][r] - mnew); s[mp][kt][r] = e; ps += e; }
                        lrun[mp] = lrun[mp] * alpha + ps;
#pragma unroll
                        for (int dt = 0; dt < 8; ++dt) o[mp][dt] = o[mp][dt] * alpha;
#pragma unroll
                        for (int ks = 0; ks < 2; ++ks) {
                            u32x4 pk; pk.x = cvtpk(s[mp][2 * ks][0], s[mp][2 * ks][1]); pk.y = cvtpk(s[mp][2 * ks][2], s[mp][2 * ks][3]);
                            pk.z = cvtpk(s[mp][2 * ks + 1][0], s[mp][2 * ks + 1][1]); pk.w = cvtpk(s[mp][2 * ks + 1][2], s[mp][2 * ks + 1][3]);
                            pb[mp][ks] = __builtin_bit_cast(bf16x8, pk);
                        }
                    }
                    const int gl = lane & 15;
                    LAS unsigned char* vrd = lds + ATT_VOFF + (4 * fq + (gl >> 2)) * ATT_VPITCH + (gl & 3) * 8;
#pragma unroll
                    for (int dt = 0; dt < 8; ++dt)
#pragma unroll
                        for (int ks = 0; ks < 2; ++ks) {
                            const v4i16_t v0 = __builtin_amdgcn_ds_read_tr16_b64_v4i16((LAS v4i16_t*)(vrd + (32 * ks) * ATT_VPITCH + dt * 32));
                            const v4i16_t v1 = __builtin_amdgcn_ds_read_tr16_b64_v4i16((LAS v4i16_t*)(vrd + (32 * ks + 16) * ATT_VPITCH + dt * 32));
                            bf16x8 vf; vf[0] = v0[0]; vf[1] = v0[1]; vf[2] = v0[2]; vf[3] = v0[3]; vf[4] = v1[0]; vf[5] = v1[1]; vf[6] = v1[2]; vf[7] = v1[3];
                            o[0][dt] = __builtin_amdgcn_mfma_f32_16x16x32_bf16(vf, pb[0][ks], o[0][dt], 0, 0, 0);
                            o[1][dt] = __builtin_amdgcn_mfma_f32_16x16x32_bf16(vf, pb[1][ks], o[1][dt], 0, 0, 0);
                        }
                }
                LDS_BARRIER();
            }
            const float i1 = 1.f / xrow16_sum(lrun[0]), i2 = lam / xrow16_sum(lrun[1]);
            float ss = 0.f;
#pragma unroll
            for (int dt = 0; dt < 8; ++dt)
#pragma unroll
                for (int r = 0; r < 4; ++r) { const float v = o[0][dt][r] * i1 - o[1][dt][r] * i2; o[0][dt][r] = v; ss += v * v; }
            ss = xrow16_sum(ss);
            const float rn = rsqrtf(ss * (1.f / 128.f) + EPS) * (1.f - lam_init);
            const float* g = p.subln_g + L * 128;
            bf16* orow = obuf + ((size_t)b * SEQ + qw0 + fr) * D + hh * 128;
#pragma unroll
            for (int dt = 0; dt < 8; ++dt) {
                const f32x4 gv = *(const f32x4*)(g + 16 * dt + 4 * fq);
                u32x2 ov; ov.x = pk2(o[0][dt][0] * rn * gv[0], o[0][dt][1] * rn * gv[1]); ov.y = pk2(o[0][dt][2] * rn * gv[2], o[0][dt][3] * rn * gv[3]);
                *(u32x2*)(orow + 16 * dt + 4 * fq) = ov;
            }
        }
    }
}

__device__ void phase_att_queue(const Params& p, int L, LAS unsigned char* lds, int bid, int nblk) {
    const int tid = tidx(), lane = tid & 63;
    const float* lp = p.diff_lambda + L * 256;
    const float d1 = wave_sum(lp[lane] * lp[64 + lane]), d2 = wave_sum(lp[128 + lane] * lp[192 + lane]);
    const float lam_init = 0.8f - 0.6f * __expf(-0.3f * (float)L);
    const float lam = __expf(d1) - __expf(d2) + lam_init;
    unsigned* head = (unsigned*)(p.ws + WS_CTL) + CW_QUEUE + L;
    volatile LAS int* slot = (volatile LAS int*)(lds + LDS_MISC_OFF + 64);
    for (;;) {
        __syncthreads();
        if (tid == 0) *slot = (int)__hip_atomic_fetch_add(head, 1u, __ATOMIC_RELAXED, __HIP_MEMORY_SCOPE_AGENT);
        __syncthreads();
        const int u = *slot;
        if (u >= 512) break;
        att_unit(p, L, lds, tid, (u & 31) >> 2, u & 3, 15 - (u >> 5), lam, lam_init);
    }
}

constexpr size_t GD_WP = WS_ORAW, GD_QD = WS_ORAW + 16 * MiB, GD_AIP = WS_ORAW + 32 * MiB, GD_KDT = WS_ORAW + 40 * MiB, GD_UT = WS_ORAW + 56 * MiB, GD_GL = WS_ORAW + 72 * MiB;
__device__ __forceinline__ int perm_pos(int k) { return (k & ~31) + 8 * ((k >> 2) & 3) + 4 * ((k >> 4) & 1) + (k & 3); }
__device__ __forceinline__ float softplusf_(float x) { if (x > 20.f) return x; const float e = __expf(x); return e < 0.06f ? e * (1.f - e * (0.5f - e * (0.33333334f - 0.25f * e))) : __logf(1.f + e); }
__device__ __forceinline__ float gelu_erf(float v) {
    const float z = fabsf(v) * 0.70710678118654752f, t = 1.f / (1.f + 0.3275911f * z);
    const float pl = t * (0.254829592f + t * (-0.284496736f + t * (1.421413741f + t * (-1.453152027f + t * 1.061405429f))));
    const float er = 1.f - pl * __expf(-z * z);
    return 0.5f * v * (1.f + (v < 0.f ? -er : er));
}

constexpr int GP_KN = 0, GP_QN = 17408, GP_RT = 34816, GP_LM = 71680, GP_TB = 89088, GP_GT = 98304, GP_T0T = 99328;
constexpr int GP_KP = 272, GP_RP = 144, GP_LP = 68, GP_TP = 144;
__device__ void phase_gdn_prep(const Params& p, int L, LAS unsigned char* lds, int bid, int nblk) {
    const int tid = tidx(), lane = tid & 63, w = __builtin_amdgcn_readfirstlane(tid >> 6), fr = lane & 15, fq = lane >> 4;
    const bf16* proj = (const bf16*)(p.ws + WS_PROJ);
    const float* BA = (const float*)(p.ws + WS_BA);
    bf16* WP = (bf16*)(p.ws + GD_WP); bf16* QD = (bf16*)(p.ws + GD_QD); bf16* AIP = (bf16*)(p.ws + GD_AIP); bf16* KDT = (bf16*)(p.ws + GD_KDT); bf16* UT = (bf16*)(p.ws + GD_UT);
    float* GL = (float*)(p.ws + GD_GL);
    const float* cw = p.conv_w + (size_t)L * 4 * 1536;
    LAS float* beta_s = (LAS float*)(lds + GP_GT); LAS float* gc_s = beta_s + 64; LAS float* egc_s = gc_s + 64; LAS float* edl_s = egc_s + 64;
    LAS float* Lm = (LAS float*)(lds + GP_LM);
    for (int item = bid; item < 1024; item += nblk) {
        const int n = item & 31, bh = item >> 5, hh = bh & 3, b = bh >> 2, t0 = n * 64;
        const size_t row0 = (size_t)b * SEQ + t0;
        __syncthreads();
        if (w == 0) {
            const float negA = -__expf(p.a_log[L * 4 + hh]), dtb = p.dt_bias[L * 4 + hh];
            const float bb = BA[(row0 + lane) * 8 + hh], aa = BA[(row0 + lane) * 8 + 4 + hh] + dtb;
            float c = negA * softplusf_(aa);
#pragma unroll
            for (int o = 1; o < 64; o <<= 1) { const float t = __shfl_up(c, o); if (lane >= o) c += t; }
            const float glast = __shfl(c, 63);
            beta_s[lane] = sigmoidf_(bb); gc_s[lane] = c; egc_s[lane] = __expf(c); edl_s[lane] = __expf(glast - c);
            if (lane == 0) GL[item] = __expf(glast);
        }
        __syncthreads();
        {
            const int colq = hh * 128 + 2 * lane;
            unsigned xk[11], xv[11];
#pragma unroll
            for (int r = 0; r < 11; ++r) { const int tt = t0 + 8 * w - 3 + r;
                xk[r] = (tt >= 0) ? *(const unsigned*)(proj + ((size_t)b * SEQ + tt) * PROJ_W + 1536 + 512 + colq) : 0u;
                xv[r] = (tt >= 0) ? *(const unsigned*)(proj + ((size_t)b * SEQ + tt) * PROJ_W + 1536 + 1024 + colq) : 0u; }
            {
                float wq[4][2]; unsigned xq[11];
#pragma unroll
                for (int j = 0; j < 4; ++j) { wq[j][0] = cw[j * 1536 + colq]; wq[j][1] = cw[j * 1536 + colq + 1]; }
#pragma unroll
                for (int r = 0; r < 11; ++r) { const int tt = t0 + 8 * w - 3 + r; xq[r] = (tt >= 0) ? *(const unsigned*)(proj + ((size_t)b * SEQ + tt) * PROJ_W + 1536 + colq) : 0u; }
#pragma unroll
                for (int i = 0; i < 8; ++i) {
                    const int c = 8 * w + i;
                    float q0 = 0.f, q1 = 0.f;
#pragma unroll
                    for (int j = 0; j < 4; ++j) { q0 += wq[j][0] * lo16(xq[i + j]); q1 += wq[j][1] * hi16(xq[i + j]); }
                    q0 *= sigmoidf_(q0); q1 *= sigmoidf_(q1);
                    const float sq = rsqrtf(wave_sum(q0 * q0 + q1 * q1) + EPS) * 0.08838834764831845f;
                    q0 *= sq; q1 *= sq;
                    const float eg = egc_s[c];
                    *(LAS unsigned*)(lds + GP_QN + c * GP_KP + lane * 4) = pk2(q0, q1);
                    *(unsigned*)(QD + ((size_t)item * 64 + c) * 128 + perm_pos(2 * lane)) = pk2(q0 * eg, q1 * eg);
                }
            }
            __builtin_amdgcn_sched_barrier(0);
            {
                float wk[4][2];
#pragma unroll
                for (int j = 0; j < 4; ++j) { wk[j][0] = cw[j * 1536 + 512 + colq]; wk[j][1] = cw[j * 1536 + 512 + colq + 1]; }
                unsigned kd0[8], kd1[8], rk0[8], rk1[8];
#pragma unroll
                for (int i = 0; i < 8; ++i) {
                    const int c = 8 * w + i;
                    float k0 = 0.f, k1 = 0.f;
#pragma unroll
                    for (int j = 0; j < 4; ++j) { k0 += wk[j][0] * lo16(xk[i + j]); k1 += wk[j][1] * hi16(xk[i + j]); }
                    k0 *= sigmoidf_(k0); k1 *= sigmoidf_(k1);
                    const float sk = rsqrtf(wave_sum(k0 * k0 + k1 * k1) + EPS);
                    k0 *= sk; k1 *= sk;
                    const float be = beta_s[c], eg = egc_s[c], ed = edl_s[c];
                    *(LAS unsigned*)(lds + GP_KN + c * GP_KP + lane * 4) = pk2(k0, k1);
                    kd0[i] = f2bf(k0 * ed); kd1[i] = f2bf(k1 * ed);
                    rk0[i] = f2bf(k0 * be * eg); rk1[i] = f2bf(k1 * be * eg);
                }
                u32x4 o;
                o.x = rk0[0] | (rk0[1] << 16); o.y = rk0[2] | (rk0[3] << 16); o.z = rk0[4] | (rk0[5] << 16); o.w = rk0[6] | (rk0[7] << 16); *(LAS u32x4*)(lds + GP_RT + (128 + 2 * lane) * GP_RP + 16 * w) = o;
                o.x = rk1[0] | (rk1[1] << 16); o.y = rk1[2] | (rk1[3] << 16); o.z = rk1[4] | (rk1[5] << 16); o.w = rk1[6] | (rk1[7] << 16); *(LAS u32x4*)(lds + GP_RT + (128 + 2 * lane + 1) * GP_RP + 16 * w) = o;
                const int pa = perm_pos(8 * w), pb = perm_pos(8 * w + 4);
                bf16* kr0 = KDT + ((size_t)item * 128 + 2 * lane) * 64; bf16* kr1 = kr0 + 64;
                u32x2 h2;
                h2.x = kd0[0] | (kd0[1] << 16); h2.y = kd0[2] | (kd0[3] << 16); *(u32x2*)(kr0 + pa) = h2;
                h2.x = kd0[4] | (kd0[5] << 16); h2.y = kd0[6] | (kd0[7] << 16); *(u32x2*)(kr0 + pb) = h2;
                h2.x = kd1[0] | (kd1[1] << 16); h2.y = kd1[2] | (kd1[3] << 16); *(u32x2*)(kr1 + pa) = h2;
                h2.x = kd1[4] | (kd1[5] << 16); h2.y = kd1[6] | (kd1[7] << 16); *(u32x2*)(kr1 + pb) = h2;
            }
            __builtin_amdgcn_sched_barrier(0);
            {
                float wv[4][2];
#pragma unroll
                for (int j = 0; j < 4; ++j) { wv[j][0] = cw[j * 1536 + 1024 + colq]; wv[j][1] = cw[j * 1536 + 1024 + colq + 1]; }
                unsigned rv0[8], rv1[8];
#pragma unroll
                for (int i = 0; i < 8; ++i) {
                    float v0 = 0.f, v1 = 0.f;
#pragma unroll
                    for (int j = 0; j < 4; ++j) { v0 += wv[j][0] * lo16(xv[i + j]); v1 += wv[j][1] * hi16(xv[i + j]); }
                    v0 *= sigmoidf_(v0); v1 *= sigmoidf_(v1);
                    const float be = beta_s[8 * w + i];
                    rv0[i] = f2bf(v0 * be); rv1[i] = f2bf(v1 * be);
                }
                u32x4 o;
                o.x = rv0[0] | (rv0[1] << 16); o.y = rv0[2] | (rv0[3] << 16); o.z = rv0[4] | (rv0[5] << 16); o.w = rv0[6] | (rv0[7] << 16); *(LAS u32x4*)(lds + GP_RT + (2 * lane) * GP_RP + 16 * w) = o;
                o.x = rv1[0] | (rv1[1] << 16); o.y = rv1[2] | (rv1[3] << 16); o.z = rv1[4] | (rv1[5] << 16); o.w = rv1[6] | (rv1[7] << 16); *(LAS u32x4*)(lds + GP_RT + (2 * lane + 1) * GP_RP + 16 * w) = o;
            }
        }
        __syncthreads();
#pragma unroll
        for (int q = 0; q < 2; ++q) {
            const int id = 2 * w + q, ct = id >> 2, st = id & 3;
            if (st <= ct) {
                f32x4 acc = (f32x4){0.f, 0.f, 0.f, 0.f};
#pragma unroll
                for (int ks = 0; ks < 4; ++ks) {
                    const bf16x8 a = *(const LAS bf16x8*)(lds + GP_KN + (16 * ct + fr) * GP_KP + (32 * ks + 8 * fq) * 2);
                    const bf16x8 bb = *(const LAS bf16x8*)(lds + GP_KN + (16 * st + fr) * GP_KP + (32 * ks + 8 * fq) * 2);
                    acc = __builtin_amdgcn_mfma_f32_16x16x32_bf16(a, bb, acc, 0, 0, 0);
                }
                const int s = 16 * st + fr; const float gs = gc_s[s];
#pragma unroll
                for (int r = 0; r < 4; ++r) { const int c = 16 * ct + 4 * fq + r;
                    Lm[c * GP_LP + s] = (s < c) ? beta_s[c] * acc[r] * __expf(fminf(gc_s[c] - gs, 0.f)) : 0.f; }
            }
        }
        __syncthreads();
        if (w < 2) {
            const int o = 32 * w;
            float t[32];
            int zoff = 0; asm volatile("" : "+v"(zoff));
            const LAS float* Lz = Lm + zoff + o * GP_LP + o;
            const int col = lane & 31;
#pragma unroll
            for (int i = 0; i < 32; ++i) {
                float a0 = (i == lane) ? 1.f : 0.f, a1 = 0.f, a2 = 0.f, a3 = 0.f;
#pragma unroll
                for (int s4 = 0; s4 + 4 <= i; s4 += 4) { const f32x4 lv = *(const LAS f32x4*)(Lz + i * GP_LP + s4);
                    a0 -= lv[0] * t[s4]; a1 -= lv[1] * t[s4 + 1]; a2 -= lv[2] * t[s4 + 2]; a3 -= lv[3] * t[s4 + 3]; }
#pragma unroll
                for (int s = i & ~3; s < i; ++s) a0 -= Lz[i * GP_LP + s] * t[s];
                t[i] = (lane < 32) ? (a0 + a1) + (a2 + a3) : 0.f;
                const bf16 tb = (bf16)f2bf(t[i]);
                if (w == 0) { *(LAS bf16*)(lds + GP_TB + i * GP_TP + lane * 2) = tb;
                              if (lane < 32) *(LAS bf16*)(lds + GP_T0T + lane * 80 + i * 2) = tb; }
                else if (lane < 32) *(LAS bf16*)(lds + GP_TB + (32 + i) * GP_TP + (32 + col) * 2) = tb;
                if ((i & 3) == 3) __builtin_amdgcn_sched_barrier(0);
            }
        } else {
            for (int id = w - 2; id < 16; id += 6) {
                const int ct = id >> 2, st = id & 3;
                f32x4 acc = (f32x4){0.f, 0.f, 0.f, 0.f};
                if (st <= ct) {
#pragma unroll
                    for (int ks = 0; ks < 4; ++ks) {
                        const bf16x8 a = *(const LAS bf16x8*)(lds + GP_QN + (16 * ct + fr) * GP_KP + (32 * ks + 8 * fq) * 2);
                        const bf16x8 bb = *(const LAS bf16x8*)(lds + GP_KN + (16 * st + fr) * GP_KP + (32 * ks + 8 * fq) * 2);
                        acc = __builtin_amdgcn_mfma_f32_16x16x32_bf16(a, bb, acc, 0, 0, 0);
                    }
                }
                const int s = 16 * st + fr; const float gs = gc_s[s]; const int ps = perm_pos(s);
#pragma unroll
                for (int r = 0; r < 4; ++r) { const int c = 16 * ct + 4 * fq + r;
                    const float v = (s <= c) ? acc[r] * __expf(fminf(gc_s[c] - gs, 0.f)) : 0.f;
                    AIP[((size_t)item * 64 + c) * 64 + ps] = (bf16)f2bf(v); }
            }
        }
        __syncthreads();
        if (w == 0) {
            f32x4 P[2][2];
#pragma unroll
            for (int it = 0; it < 2; ++it) {
                const LAS float* lr = Lm + (32 + 16 * it + fr) * GP_LP + 8 * fq;
                const f32x4 l0 = *(const LAS f32x4*)lr, l1 = *(const LAS f32x4*)(lr + 4);
                u32x4 pk; pk.x = cvtpk(l0[0], l0[1]); pk.y = cvtpk(l0[2], l0[3]); pk.z = cvtpk(l1[0], l1[1]); pk.w = cvtpk(l1[2], l1[3]);
                const bf16x8 a = __builtin_bit_cast(bf16x8, pk);
#pragma unroll
                for (int jt = 0; jt < 2; ++jt) {
                    const bf16x8 bb = *(const LAS bf16x8*)(lds + GP_T0T + (16 * jt + fr) * 80 + 16 * fq);
                    P[it][jt] = __builtin_amdgcn_mfma_f32_16x16x32_bf16(a, bb, (f32x4){0.f, 0.f, 0.f, 0.f}, 0, 0, 0);
                }
            }
#pragma unroll
            for (int jt = 0; jt < 2; ++jt) {
                u32x4 pk; pk.x = cvtpk(P[0][jt][0], P[0][jt][1]); pk.y = cvtpk(P[0][jt][2], P[0][jt][3]); pk.z = cvtpk(P[1][jt][0], P[1][jt][1]); pk.w = cvtpk(P[1][jt][2], P[1][jt][3]);
                const bf16x8 pb = __builtin_bit_cast(bf16x8, pk);
#pragma unroll
                for (int i2 = 0; i2 < 2; ++i2) {
                    const LAS unsigned char* tr = lds + GP_TB + (32 + 16 * i2 + fr) * GP_TP + (32 + 4 * fq) * 2;
                    const u32x2 ta = *(const LAS u32x2*)tr, tb2 = *(const LAS u32x2*)(tr + 32);
                    u32x4 ak; ak.x = ta.x; ak.y = ta.y; ak.z = tb2.x; ak.w = tb2.y;
                    const f32x4 r = __builtin_amdgcn_mfma_f32_16x16x32_bf16(__builtin_bit_cast(bf16x8, ak), pb, (f32x4){0.f, 0.f, 0.f, 0.f}, 0, 0, 0);
#pragma unroll
                    for (int q = 0; q < 4; ++q) *(LAS bf16*)(lds + GP_TB + (32 + 16 * i2 + 4 * fq + q) * GP_TP + (16 * jt + fr) * 2) = (bf16)f2bf(-r[q]);
                }
            }
        }
        __syncthreads();
#pragma unroll
        for (int q = 0; q < 2; ++q) {
            const int colt = 2 * w + q;
            bf16x8 af[2];
#pragma unroll
            for (int ks = 0; ks < 2; ++ks) af[ks] = *(const LAS bf16x8*)(lds + GP_RT + (16 * colt + fr) * GP_RP + (32 * ks + 8 * fq) * 2);
#pragma unroll
            for (int ct = 0; ct < 4; ++ct) {
                f32x4 acc = (f32x4){0.f, 0.f, 0.f, 0.f};
#pragma unroll
                for (int ks = 0; ks < 2; ++ks) {
                    const bf16x8 bb = *(const LAS bf16x8*)(lds + GP_TB + (16 * ct + fr) * GP_TP + (32 * ks + 8 * fq) * 2);
                    acc = __builtin_amdgcn_mfma_f32_16x16x32_bf16(af[ks], bb, acc, 0, 0, 0);
                }
                const int c = 16 * ct + fr;
                if (colt < 8) {
#pragma unroll
                    for (int r = 0; r < 4; ++r) UT[((size_t)item * 128 + 16 * colt + 4 * fq + r) * 64 + c] = (bf16)f2bf(acc[r]);
                } else {
                    const int kt = colt - 8;
                    u32x2 h2; h2.x = pk2(-acc[0], -acc[1]); h2.y = pk2(-acc[2], -acc[3]);
                    *(u32x2*)(WP + ((size_t)item * 64 + c) * 128 + 32 * (kt >> 1) + 8 * fq + 4 * (kt & 1)) = h2;
                }
            }
        }
    }
    __syncthreads();
}

constexpr int GS_WP = 0, GS_QD = 17408, GS_AIP = 34816, GS_KDT = 44032, GS_BUF = 62464, GS_OB = 2 * GS_BUF, GS_OBP = 272;
__device__ void phase_gdn_scan(const Params& p, int L, LAS unsigned char* lds, int bid, int nblk) {
    const int tid = tidx(), lane = tid & 63, w = __builtin_amdgcn_readfirstlane(tid >> 6), fr = lane & 15, fq = lane >> 4;
    const bf16* proj = (const bf16*)(p.ws + WS_PROJ);
    const bf16* WP = (const bf16*)(p.ws + GD_WP); const bf16* QD = (const bf16*)(p.ws + GD_QD); const bf16* AIP = (const bf16*)(p.ws + GD_AIP);
    const bf16* KDT = (const bf16*)(p.ws + GD_KDT); const bf16* UT = (const bf16*)(p.ws + GD_UT); const float* GL = (const float*)(p.ws + GD_GL);
    bf16* obuf = (bf16*)(p.ws + WS_OBUF);
    for (int item = bid; item < 32; item += nblk) {
        const int hh = item & 3, b = item >> 2;
        const int fc = tid >> 4, fv = tid & 15;
        float gn[8];
#pragma unroll
        for (int i = 0; i < 8; ++i) gn[i] = p.gdn_norm_g[L * 128 + 8 * fv + i];
        f32x4 S[8];
#pragma unroll
        for (int kt = 0; kt < 8; ++kt) S[kt] = (f32x4){0.f, 0.f, 0.f, 0.f};
        u32x4 st[7];
        auto gload = [&](int ci) {
#pragma unroll
            for (int i = 0; i < 7; ++i) {
                const int pc = tid + 512 * i;
                const bf16* src;
                if (i < 2) src = WP + (size_t)ci * 8192 + pc * 8;
                else if (i < 4) src = QD + (size_t)ci * 8192 + (pc - 1024) * 8;
                else if (i < 5) src = AIP + (size_t)ci * 4096 + (pc - 2048) * 8;
                else src = KDT + (size_t)ci * 8192 + (pc - 2560) * 8;
                st[i] = *(const u32x4*)src;
            }
        };
        auto lstore = [&](int buf) {
#pragma unroll
            for (int i = 0; i < 7; ++i) {
                const int pc = tid + 512 * i;
                int off;
                if (i < 2) off = GS_WP + (pc >> 4) * 272 + (pc & 15) * 16;
                else if (i < 4) { const int q = pc - 1024; off = GS_QD + (q >> 4) * 272 + (q & 15) * 16; }
                else if (i < 5) { const int q = pc - 2048; off = GS_AIP + (q >> 3) * 144 + (q & 7) * 16; }
                else { const int q = pc - 2560; off = GS_KDT + (q >> 3) * 144 + (q & 7) * 16; }
                *(LAS u32x4*)(lds + buf * GS_BUF + off) = st[i];
            }
        };
        __syncthreads();
        gload(item * 32); lstore(0);
        u32x2 ut[4]; float gl;
        {
            const int ci = item * 32;
#pragma unroll
            for (int ct = 0; ct < 4; ++ct) ut[ct] = *(const u32x2*)(UT + ((size_t)ci * 128 + 16 * w + fr) * 64 + 16 * ct + 4 * fq);
            gl = GL[ci];
        }
        __syncthreads();
        for (int n = 0; n < 32; ++n) {
            const int ci = item * 32 + n, buf = n & 1;
            const size_t rowc = (size_t)b * SEQ + n * 64;
            u32x2 utn[4]; float gln = 0.f;
            if (n + 1 < 32) {
                gload(ci + 1);
#pragma unroll
                for (int ct = 0; ct < 4; ++ct) utn[ct] = *(const u32x2*)(UT + ((size_t)(ci + 1) * 128 + 16 * w + fr) * 64 + 16 * ct + 4 * fq);
                gln = GL[ci + 1];
            }
            u32x4 zq[2];
#pragma unroll
            for (int ps = 0; ps < 2; ++ps) zq[ps] = *(const u32x4*)(proj + (rowc + 32 * ps + fc) * PROJ_W + 3072 + hh * 128 + 8 * fv);
            f32x4 vn[4], oacc[4];
#pragma unroll
            for (int ct = 0; ct < 4; ++ct) { vn[ct] = (f32x4){lo16(ut[ct].x), hi16(ut[ct].x), lo16(ut[ct].y), hi16(ut[ct].y)}; oacc[ct] = (f32x4){0.f, 0.f, 0.f, 0.f}; }
            bf16x8 sb[4];
#pragma unroll
            for (int ks = 0; ks < 4; ++ks) { u32x4 pk; pk.x = cvtpk(S[2 * ks][0], S[2 * ks][1]); pk.y = cvtpk(S[2 * ks][2], S[2 * ks][3]); pk.z = cvtpk(S[2 * ks + 1][0], S[2 * ks + 1][1]); pk.w = cvtpk(S[2 * ks + 1][2], S[2 * ks + 1][3]);
                sb[ks] = __builtin_bit_cast(bf16x8, pk); }
            LAS unsigned char* bb = lds + buf * GS_BUF;
            bf16x8 f0[8], f1[8];
#define LD_A(F, ct) do { _Pragma("unroll") for (int ks = 0; ks < 4; ++ks) { F[ks] = *(const LAS bf16x8*)(bb + GS_WP + (16 * (ct) + fr) * 272 + (32 * ks + 8 * fq) * 2); \
                    F[4 + ks] = *(const LAS bf16x8*)(bb + GS_QD + (16 * (ct) + fr) * 272 + (32 * ks + 8 * fq) * 2); } } while (0)
#define MM_A(F, ct) do { _Pragma("unroll") for (int ks = 0; ks < 4; ++ks) { vn[ct] = __builtin_amdgcn_mfma_f32_16x16x32_bf16(F[ks], sb[ks], vn[ct], 0, 0, 0); \
                    oacc[ct] = __builtin_amdgcn_mfma_f32_16x16x32_bf16(F[4 + ks], sb[ks], oacc[ct], 0, 0, 0); } } while (0)
#define SBAR() __builtin_amdgcn_sched_barrier(0)
            LD_A(f0, 0); SBAR();
            LD_A(f1, 1); MM_A(f0, 0); SBAR();
            LD_A(f0, 2); MM_A(f1, 1); SBAR();
            LD_A(f1, 3); MM_A(f0, 2); SBAR();
#pragma unroll
            for (int ct = 0; ct < 4; ++ct)
#pragma unroll
                for (int ss = 0; ss < 2; ++ss) f0[2 * ct + ss] = *(const LAS bf16x8*)(bb + GS_AIP + (16 * ct + fr) * 144 + (32 * ss + 8 * fq) * 2);
            MM_A(f1, 3); SBAR();
            bf16x8 vb[2];
#pragma unroll
            for (int ss = 0; ss < 2; ++ss) { u32x4 pk; pk.x = cvtpk(vn[2 * ss][0], vn[2 * ss][1]); pk.y = cvtpk(vn[2 * ss][2], vn[2 * ss][3]); pk.z = cvtpk(vn[2 * ss + 1][0], vn[2 * ss + 1][1]); pk.w = cvtpk(vn[2 * ss + 1][2], vn[2 * ss + 1][3]);
                vb[ss] = __builtin_bit_cast(bf16x8, pk); }
#pragma unroll
            for (int kt = 0; kt < 4; ++kt)
#pragma unroll
                for (int ss = 0; ss < 2; ++ss) f1[2 * kt + ss] = *(const LAS bf16x8*)(bb + GS_KDT + (16 * kt + fr) * 144 + (32 * ss + 8 * fq) * 2);
#pragma unroll
            for (int ct = 0; ct < 4; ++ct)
#pragma unroll
                for (int ss = 0; ss < 2; ++ss) oacc[ct] = __builtin_amdgcn_mfma_f32_16x16x32_bf16(f0[2 * ct + ss], vb[ss], oacc[ct], 0, 0, 0);
            SBAR();
#pragma unroll
            for (int kt = 4; kt < 8; ++kt)
#pragma unroll
                for (int ss = 0; ss < 2; ++ss) f0[2 * (kt - 4) + ss] = *(const LAS bf16x8*)(bb + GS_KDT + (16 * kt + fr) * 144 + (32 * ss + 8 * fq) * 2);
#pragma unroll
            for (int kt = 0; kt < 4; ++kt) {
                S[kt] = S[kt] * gl;
#pragma unroll
                for (int ss = 0; ss < 2; ++ss) S[kt] = __builtin_amdgcn_mfma_f32_16x16x32_bf16(f1[2 * kt + ss], vb[ss], S[kt], 0, 0, 0);
            }
            SBAR();
#pragma unroll
            for (int kt = 4; kt < 8; ++kt) {
                S[kt] = S[kt] * gl;
#pragma unroll
                for (int ss = 0; ss < 2; ++ss) S[kt] = __builtin_amdgcn_mfma_f32_16x16x32_bf16(f0[2 * (kt - 4) + ss], vb[ss], S[kt], 0, 0, 0);
            }
#undef LD_A
#undef MM_A
#undef SBAR
            LDS_BARRIER();
#pragma unroll
            for (int ct = 0; ct < 4; ++ct)
#pragma unroll
                for (int r = 0; r < 4; r += 2) {
                    const unsigned pk = cvtpk(oacc[ct][r], oacc[ct][r + 1]);
                    *(LAS bf16*)(lds + GS_OB + (16 * ct + 4 * fq + r) * GS_OBP + (16 * w + fr) * 2) = (bf16)(pk & 0xffffu);
                    *(LAS bf16*)(lds + GS_OB + (16 * ct + 4 * fq + r + 1) * GS_OBP + (16 * w + fr) * 2) = (bf16)(pk >> 16);
                }
            if (n + 1 < 32) {
                lstore(buf ^ 1);
#pragma unroll
                for (int ct = 0; ct < 4; ++ct) ut[ct] = utn[ct];
                gl = gln;
            }
            LDS_BARRIER();
#pragma unroll
            for (int ps = 0; ps < 2; ++ps) {
                const int c = 32 * ps + fc;
                const u32x4 ov = *(const LAS u32x4*)(lds + GS_OB + c * GS_OBP + fv * 16);
                float o8[8];
#pragma unroll
                for (int i = 0; i < 4; ++i) { o8[2 * i] = lo16(ov[i]); o8[2 * i + 1] = hi16(ov[i]); }
                float ss = 0.f;
#pragma unroll
                for (int i = 0; i < 8; ++i) ss += o8[i] * o8[i];
                const float rn = rsqrtf(row16_sum(ss) * (1.f / 128.f) + EPS);
                u32x4 res;
#pragma unroll
                for (int i = 0; i < 4; ++i) {
                    const float z0 = lo16(zq[ps][i]), z1 = hi16(zq[ps][i]);
                    res[i] = cvtpk(o8[2 * i] * rn * gn[2 * i] * (z0 * sigmoidf_(z0)), o8[2 * i + 1] * rn * gn[2 * i + 1] * (z1 * sigmoidf_(z1)));
                }
                *(u32x4*)(obuf + (rowc + c) * D + 512 + hh * 128 + 8 * fv) = res;
            }
        }
        __syncthreads();
    }
}

__device__ __forceinline__ unsigned sortable(float f) { const unsigned u = __float_as_uint(f); return u ^ ((unsigned)((int)u >> 31) | 0x80000000u); }
__device__ __forceinline__ float unsortable(unsigned s) { return __uint_as_float((s & 0x80000000u) ? (s ^ 0x80000000u) : ~s); }
#define CE(a, b) do { const unsigned _x = k[a], _y = k[b]; k[a] = _x > _y ? _x : _y; k[b] = _x > _y ? _y : _x; } while (0)
constexpr int PE_TK = 0, PE_TAB = 8192, PE_ID = 8448, PE_GT = PE_ID + 32768, PE_SK = PE_GT + 32768;
__device__ void phase_peer(const Params& p, int L, LAS unsigned char* lds, int bid, int nblk) {
    const int tid = tidx(), lane = tid & 63, w = __builtin_amdgcn_readfirstlane(tid >> 6), fr = lane & 15, fq = lane >> 4;
    const bf16* Q2 = (const bf16*)(p.ws + WS_Q2);
    const bf16* SK = (const bf16*)(p.ws + WS_SK) + (size_t)L * 8 * 2 * 128 * 128;
    float* H = (float*)(p.ws + WS_H); bf16* HB2 = (bf16*)(p.ws + WS_HB2);
    const unsigned char* U = p.ws + WS_U + (size_t)L * NEXP * D;
    const unsigned char* V = p.ws + WS_V + (size_t)L * NEXP * D;
    const float* SU = (const float*)(p.ws + WS_SU) + (size_t)L * NEXP; const float* SV = (const float*)(p.ws + WS_SV) + (size_t)L * NEXP;
    const float* g = p.ln_ffn_g + L * D;
    LAS unsigned* TK = (LAS unsigned*)(lds + PE_TK);
    LAS unsigned short* TAB = (LAS unsigned short*)(lds + PE_TAB);
    LAS int* IDL = (LAS int*)(lds + PE_ID); LAS float* GTL = (LAS float*)(lds + PE_GT);
    if (tid < 64) {
        int a = 0, base = 0, q = tid; unsigned short v = 0xffff;
        if (q < 50) { for (;;) { const int cnt = 16 / (a + 1); if (q < base + cnt) break; base += cnt; ++a; } v = (unsigned short)((a << 8) | (q - base)); }
        TAB[tid] = v;
    }
    for (int item = bid; item < M / 64; item += nblk) {
        const int tok0 = item * 64;
        __syncthreads();
        const int tg = w & 3, cc = w >> 2;
#define SK_FETCH(hd) do { _Pragma("unroll") for (int i = 0; i < 8; ++i) { const int pc = tid + 512 * i, nn = (pc >> 4) & 127; \
            __builtin_amdgcn_global_load_lds((const unsigned*)(SK + ((size_t)((hd) * 2 + (pc >> 11)) * 128 + nn) * 128 + (((pc & 15) ^ (nn & 15)) * 8)), \
                                             (LAS unsigned*)(lds + PE_SK + (w * 64 + 512 * i) * 16), 16, 0, 0); } } while (0)
        SK_FETCH(0);
        asm volatile("s_waitcnt vmcnt(0)" ::: "memory");
        __syncthreads();
        for (int hh = 0; hh < 8; ++hh) {
            {
                f32x4 acc[8];
#pragma unroll
                for (int nt = 0; nt < 8; ++nt) acc[nt] = (f32x4){0.f, 0.f, 0.f, 0.f};
                bf16x8 qa[4];
#pragma unroll
                for (int ks = 0; ks < 4; ++ks) qa[ks] = *(const bf16x8*)(Q2 + (size_t)(tok0 + 16 * tg + fr) * 2048 + hh * 256 + cc * 128 + 32 * ks + 8 * fq);
                const LAS unsigned char* skb = lds + PE_SK + cc * 32768 + fr * 256;
#pragma unroll
                for (int nt = 0; nt < 8; ++nt)
#pragma unroll
                    for (int ks = 0; ks < 4; ++ks) {
                        const bf16x8 kb = *(const LAS bf16x8*)(skb + nt * 4096 + (((4 * ks + fq) ^ fr) << 4));
                        acc[nt] = __builtin_amdgcn_mfma_f32_16x16x32_bf16(qa[ks], kb, acc[nt], 0, 0, 0);
                    }
#pragma unroll
                for (int r = 0; r < 4; ++r) {
                    unsigned k[8];
#pragma unroll
                    for (int nt = 0; nt < 8; ++nt) k[nt] = (sortable(acc[nt][r]) & ~0x7Fu) | (unsigned)(127 - (16 * nt + fr));
                    CE(0, 1); CE(2, 3); CE(4, 5); CE(6, 7); CE(0, 2); CE(1, 3); CE(4, 6); CE(5, 7); CE(1, 2); CE(5, 6); CE(0, 4); CE(3, 7);
                    CE(1, 5); CE(2, 6); CE(1, 4); CE(3, 6); CE(2, 4); CE(3, 5); CE(3, 4);
                    unsigned res = 0u;
#pragma unroll
                    for (int rd = 0; rd < 16; ++rd) {
                        const unsigned m = row16_umax(k[0]);
                        const bool win = k[0] == m;
#pragma unroll
                        for (int i = 0; i < 7; ++i) k[i] = win ? k[i + 1] : k[i];
                        k[7] = win ? 0u : k[7];
                        res = (fr == rd) ? m : res;
                    }
                    TK[(cc * 64 + 16 * tg + 4 * fq + r) * 16 + fr] = res;
                }
            }
            __syncthreads();
            if (hh + 1 < 8) SK_FETCH(hh + 1);
#pragma unroll
            for (int ps = 0; ps < 2; ++ps) {
                const int tl = 8 * w + 4 * ps + fq;
                unsigned k[4];
#pragma unroll
                for (int sl = 0; sl < 4; ++sl) {
                    const int q = sl * 16 + fr;
                    const unsigned ab = TAB[q];
                    const unsigned k1 = TK[tl * 16 + ((ab >> 8) & 15)], k2 = TK[(64 + tl) * 16 + (ab & 15)];
                    const float v = unsortable(k1 & ~0x7Fu) + unsortable(k2 & ~0x7Fu);
                    k[sl] = (q < 50) ? ((sortable(v) & ~0x3Fu) | (unsigned)(63 - q)) : 0u;
                }
                CE(0, 1); CE(2, 3); CE(0, 2); CE(1, 3); CE(1, 2);
                unsigned res = 0u;
#pragma unroll
                for (int rd = 0; rd < 16; ++rd) {
                    const unsigned m = row16_umax(k[0]);
                    const bool win = k[0] == m;
                    k[0] = win ? k[1] : k[0]; k[1] = win ? k[2] : k[1]; k[2] = win ? k[3] : k[2]; k[3] = win ? 0u : k[3];
                    res = (fr == rd) ? m : res;
                }
                const unsigned ab = TAB[63 - (res & 0x3Fu)];
                const unsigned k1 = TK[tl * 16 + ((ab >> 8) & 15)], k2 = TK[(64 + tl) * 16 + (ab & 15)];
                const float v = unsortable(k1 & ~0x7Fu) + unsortable(k2 & ~0x7Fu);
                const float e = __expf(v - row16_max(v));
                const float sum = row16_sum(e);
                IDL[tl * 128 + hh * 16 + fr] = (int)((127u - (k1 & 0x7Fu)) * 128u + (127u - (k2 & 0x7Fu)));
                GTL[tl * 128 + hh * 16 + fr] = e / sum;
            }
            asm volatile("s_waitcnt vmcnt(0)" ::: "memory");
            __syncthreads();
        }
#undef SK_FETCH
        for (int ti = 0; ti < 8; ++ti) {
            const int tl = 8 * w + ti;
            unsigned k0 = ((unsigned)IDL[tl * 128 + lane] << 7) | (unsigned)lane, k1 = ((unsigned)IDL[tl * 128 + 64 + lane] << 7) | (unsigned)(64 + lane);
#pragma unroll
            for (int kk = 2; kk <= 128; kk <<= 1) {
#pragma unroll
                for (int j = kk >> 1; j >= 1; j >>= 1) {
                    if (j == 64) { const unsigned lo = k0 < k1 ? k0 : k1, hi = k0 < k1 ? k1 : k0; k0 = lo; k1 = hi; }
                    else {
                        const unsigned p0 = (unsigned)__shfl_xor((int)k0, j), p1 = (unsigned)__shfl_xor((int)k1, j);
                        const bool up0 = ((lane & kk) == 0) || kk == 128, up1 = (((lane + 64) & kk) == 0);
                        const bool low = (lane & j) == 0;
                        k0 = (low == up0) ? (k0 < p0 ? k0 : p0) : (k0 > p0 ? k0 : p0);
                        k1 = (low == (kk == 128 ? true : up1)) ? (k1 < p1 ? k1 : p1) : (k1 > p1 ? k1 : p1);
                    }
                }
            }
            const float g0 = GTL[tl * 128 + (k0 & 127u)], g1 = GTL[tl * 128 + (k1 & 127u)];
            asm volatile("s_waitcnt lgkmcnt(0)" ::: "memory");
            IDL[tl * 128 + lane] = (int)(k0 >> 7); IDL[tl * 128 + 64 + lane] = (int)(k1 >> 7);
            GTL[tl * 128 + lane] = g0; GTL[tl * 128 + 64 + lane] = g1;
        }
        __syncthreads();
        for (int ti = 0; ti < 8; ++ti) {
            const int tl = 8 * w + ti, tok = tok0 + tl;
            const float* hrow = H + (size_t)tok * D + 16 * lane;
            float xn[16];
#pragma unroll
            for (int j = 0; j < 4; ++j) { const f32x4 a = *(const f32x4*)(hrow + 4 * j); xn[4 * j] = a[0]; xn[4 * j + 1] = a[1]; xn[4 * j + 2] = a[2]; xn[4 * j + 3] = a[3]; }
            float ss = 0.f;
#pragma unroll
            for (int i = 0; i < 16; ++i) ss += xn[i] * xn[i];
            const float rstd = rsqrtf(wave_sum(ss) * (1.f / D) + EPS);
            float mx = 0.f;
#pragma unroll
            for (int i = 0; i < 16; ++i) { xn[i] = xn[i] * rstd * g[16 * lane + i]; mx = fmaxf(mx, fabsf(xn[i])); }
            mx = xrow16_max(row16_max(mx));
            const float xinv = mx > 0.f ? 127.f / mx : 0.f, sx = mx * (1.f / 127.f);
            int xq[4];
#pragma unroll
            for (int j = 0; j < 4; ++j) xq[j] = (int)(((unsigned)__float2int_rn(xn[4 * j] * xinv) & 0xffu) | (((unsigned)__float2int_rn(xn[4 * j + 1] * xinv) & 0xffu) << 8) |
                                                      (((unsigned)__float2int_rn(xn[4 * j + 2] * xinv) & 0xffu) << 16) | ((unsigned)__float2int_rn(xn[4 * j + 3] * xinv) << 24));
            const int id0 = IDL[tl * 128 + lane], id1 = IDL[tl * 128 + 64 + lane];
            const float su0 = SU[id0], su1 = SU[id1], sv0 = SV[id0], sv1 = SV[id1];
            int h0i = 0, h1i = 0;
            u32x4 ring[16];
#pragma unroll
            for (int j = 0; j < 16; ++j) ring[j] = *(const u32x4*)(U + (size_t)IDL[tl * 128 + j] * D + 16 * lane);
#pragma unroll 1
            for (int k = 0; k < 8; ++k) {
#pragma unroll
                for (int j = 0; j < 16; ++j) {
                    const u32x4 a = ring[j];
                    if (k < 7) ring[j] = *(const u32x4*)(U + (size_t)IDL[tl * 128 + 16 * (k + 1) + j] * D + 16 * lane);
                    int d = __builtin_amdgcn_sdot4((int)a[0], xq[0], 0, false);
                    d = __builtin_amdgcn_sdot4((int)a[1], xq[1], d, false); d = __builtin_amdgcn_sdot4((int)a[2], xq[2], d, false); d = __builtin_amdgcn_sdot4((int)a[3], xq[3], d, false);
                    d = wave_isum(d);
                    const int e = 16 * k + j;
                    if (lane == (e & 63)) { if (k < 4) h0i = d; else h1i = d; }
                }
            }
            const float h0 = su0 * sx * (float)h0i, h1 = su1 * sx * (float)h1i;
            GTL[tl * 128 + lane] = sv0 * GTL[tl * 128 + lane] * gelu_erf(h0);
            GTL[tl * 128 + 64 + lane] = sv1 * GTL[tl * 128 + 64 + lane] * gelu_erf(h1);
        }
        for (int ti = 0; ti < 8; ++ti) {
            const int tl = 8 * w + ti, tok = tok0 + tl;
            float* hrow = H + (size_t)tok * D + 16 * lane;
            float xv[16];
#pragma unroll
            for (int j = 0; j < 4; ++j) { const f32x4 a = *(const f32x4*)(hrow + 4 * j); xv[4 * j] = a[0]; xv[4 * j + 1] = a[1]; xv[4 * j + 2] = a[2]; xv[4 * j + 3] = a[3]; }
            const float w0 = GTL[tl * 128 + lane], w1 = GTL[tl * 128 + 64 + lane];
            const float wmx = xrow16_max(row16_max(fmaxf(fabsf(w0), fabsf(w1))));
            const float winv = wmx > 0.f ? 127.f / wmx : 0.f, sw = wmx * (1.f / 127.f);
            const f32x4 wv = *(const LAS f32x4*)(GTL + tl * 128 + 4 * (lane & 31));
            const int wq = (int)(((unsigned)__float2int_rn(wv[0] * winv) & 0xffu) | (((unsigned)__float2int_rn(wv[1] * winv) & 0xffu) << 8) |
                                 (((unsigned)__float2int_rn(wv[2] * winv) & 0xffu) << 16) | ((unsigned)__float2int_rn(wv[3] * winv) << 24));
            int yi[16];
#pragma unroll
            for (int i = 0; i < 16; ++i) yi[i] = 0;
            u32x4 ring[16];
#pragma unroll
            for (int j = 0; j < 16; ++j) ring[j] = *(const u32x4*)(V + (size_t)IDL[tl * 128 + j] * D + 16 * lane);
#pragma unroll 1
            for (int k = 0; k < 8; ++k) {
#pragma unroll
                for (int g4 = 0; g4 < 4; ++g4) {
                    const u32x4 a0 = ring[4 * g4], a1 = ring[4 * g4 + 1], a2 = ring[4 * g4 + 2], a3 = ring[4 * g4 + 3];
                    if (k < 7) {
#pragma unroll
                        for (int q = 0; q < 4; ++q) ring[4 * g4 + q] = *(const u32x4*)(V + (size_t)IDL[tl * 128 + 16 * (k + 1) + 4 * g4 + q] * D + 16 * lane);
                    }
                    const int wg = __builtin_amdgcn_readlane(wq, 4 * k + g4);
#pragma unroll
                    for (int q = 0; q < 4; ++q) {
                        const unsigned p0 = __builtin_amdgcn_perm(a1[q], a0[q], 0x05010400u), p1 = __builtin_amdgcn_perm(a1[q], a0[q], 0x07030602u);
                        const unsigned p2 = __builtin_amdgcn_perm(a3[q], a2[q], 0x05010400u), p3 = __builtin_amdgcn_perm(a3[q], a2[q], 0x07030602u);
                        yi[4 * q] = __builtin_amdgcn_sdot4((int)__builtin_amdgcn_perm(p2, p0, 0x05040100u), wg, yi[4 * q], false);
                        yi[4 * q + 1] = __builtin_amdgcn_sdot4((int)__builtin_amdgcn_perm(p2, p0, 0x07060302u), wg, yi[4 * q + 1], false);
                        yi[4 * q + 2] = __builtin_amdgcn_sdot4((int)__builtin_amdgcn_perm(p3, p1, 0x05040100u), wg, yi[4 * q + 2], false);
                        yi[4 * q + 3] = __builtin_amdgcn_sdot4((int)__builtin_amdgcn_perm(p3, p1, 0x07060302u), wg, yi[4 * q + 3], false);
                    }
                }
            }
            float y[16];
#pragma unroll
            for (int i = 0; i < 16; ++i) y[i] = xv[i] + sw * (float)yi[i];
#pragma unroll
            for (int j = 0; j < 4; ++j) *(f32x4*)(hrow + 4 * j) = (f32x4){y[4 * j], y[4 * j + 1], y[4 * j + 2], y[4 * j + 3]};
            bf16* hb = HB2 + (size_t)tok * D + 16 * lane;
            u32x4 o; o.x = pk2(y[0], y[1]); o.y = pk2(y[2], y[3]); o.z = pk2(y[4], y[5]); o.w = pk2(y[6], y[7]);
            *(u32x4*)hb = o;
            o.x = pk2(y[8], y[9]); o.y = pk2(y[10], y[11]); o.z = pk2(y[12], y[13]); o.w = pk2(y[14], y[15]);
            *(u32x4*)(hb + 8) = o;
        }
    }
    __syncthreads();
}
#undef CE

__device__ void phase_final(const Params& p, int bid, int nblk) {
    const int tid = tidx(), lane = tid & 63, gw = bid * NWAVES + (tid >> 6), NGW = nblk * NWAVES;
    const float* H = (const float*)(p.ws + WS_H);
    for (int m = gw; m < M; m += NGW) {
        f32x4 v[4]; float ss = 0.f;
#pragma unroll
        for (int j = 0; j < 4; ++j) { v[j] = ((const f32x4*)(H + (size_t)m * D))[lane + 64 * j]; ss += (v[j][0] * v[j][0] + v[j][1] * v[j][1]) + (v[j][2] * v[j][2] + v[j][3] * v[j][3]); }
        const float r = rsqrtf(wave_sum(ss) * (1.f / D) + EPS);
#pragma unroll
        for (int j = 0; j < 4; ++j) { const f32x4 gv = ((const f32x4*)p.final_g)[lane + 64 * j]; ((f32x4*)(p.out + (size_t)m * D))[lane + 64 * j] = v[j] * r * gv; }
    }
}

#define XB_TMO      128
#define XB_XCNT(j)  (256  + 64 * (j))
#define XB_XSUB(j)  (1280 + 64 * (j))
#define XB_XGEN(j)  (2304 + 64 * (j))
#define XB_TOP      3328
#define XB_TOPGEN   3392
#define XCD_BAR_WORDS 3456
#define XB_SPIN_CAP (1u << 22)
__device__ __forceinline__ unsigned xb_ld(unsigned* p)              { return __hip_atomic_load(p, __ATOMIC_RELAXED, __HIP_MEMORY_SCOPE_AGENT); }
__device__ __forceinline__ unsigned xb_add(unsigned* p, unsigned v) { return __hip_atomic_fetch_add(p, v, __ATOMIC_RELAXED, __HIP_MEMORY_SCOPE_AGENT); }
__device__ __forceinline__ unsigned xb_xcc_id() { return (unsigned)__builtin_amdgcn_s_getreg((3 << 11) | 20) & 0xFu; }
#define XB_SPIN(cond, bar) do { unsigned _sp = 0; while (cond) { __builtin_amdgcn_s_sleep(1); \
    if ((++_sp & 255u) == 0u) { if (xb_ld(&(bar)[XB_TMO])) break; if (_sp > XB_SPIN_CAP) { atomicAdd(&(bar)[XB_TMO], 1u); break; } } } } while (0)
struct XcdBarrier { unsigned* bar; unsigned x; volatile LAS unsigned* st; };
__device__ __forceinline__ XcdBarrier xcd_barrier_post(unsigned* bar, volatile LAS unsigned* st) {
    XcdBarrier b; b.bar = bar; b.x = xb_xcc_id(); b.st = st;
    if (threadIdx.x == 0) (void)xb_add(&bar[XB_XCNT(b.x)], 1u);
    return b;
}
__device__ __forceinline__ void xcd_barrier_complete(unsigned* bar, unsigned x, unsigned& nloc, unsigned& nx) {
    const unsigned G = gridDim.x * gridDim.y * gridDim.z;
    unsigned sum, cnt, mine, sp = 0u;
    for (;;) {
        sum = 0u; cnt = 0u; mine = 0u;
#pragma unroll
        for (unsigned j = 0; j < 16; ++j) { const unsigned c = xb_ld(&bar[XB_XCNT(j)]); sum += c; cnt += (c > 0u) ? 1u : 0u; mine = (j == x) ? c : mine; }
        if (sum == G) break;
        __builtin_amdgcn_s_sleep(1);
        if ((++sp & 255u) == 0u) { if (xb_ld(&bar[XB_TMO])) break; if (sp > XB_SPIN_CAP) { atomicAdd(&bar[XB_TMO], 1u); break; } }
    }
    nloc = mine > 0u ? mine : 1u; nx = cnt > 0u ? cnt : 1u;
}
__device__ __forceinline__ void xcd_barrier(const XcdBarrier& b) {
    asm volatile("s_waitcnt vmcnt(0)" ::: "memory");
    __syncthreads();
    if (threadIdx.x == 0) {
        unsigned* bar = b.bar;
        __builtin_amdgcn_s_waitcnt(0);
        unsigned nloc = b.st[0], nx = b.st[1];
        if (nloc == 0u) { xcd_barrier_complete(bar, b.x, nloc, nx); b.st[0] = nloc; b.st[1] = nx; }
        const unsigned old = xb_add(&bar[XB_XSUB(b.x)], 1u);
        const unsigned gen = old / nloc;
        if (old + 1u == (gen + 1u) * nloc) {
            __builtin_amdgcn_fence(__ATOMIC_RELEASE, "agent");
            asm volatile("s_waitcnt vmcnt(0)" ::: "memory");
            const unsigned og = xb_add(&bar[XB_TOP], 1u);
            const unsigned tg = og / nx;
            if (og + 1u == (tg + 1u) * nx) xb_add(&bar[XB_TOPGEN], 1u);
            else XB_SPIN(xb_ld(&bar[XB_TOPGEN]) == tg, bar);
            __builtin_amdgcn_fence(__ATOMIC_ACQUIRE, "agent");
            xb_add(&bar[XB_XGEN(b.x)], 1u);
            asm volatile("s_waitcnt vmcnt(0)" ::: "memory");
        } else {
            XB_SPIN(xb_ld(&bar[XB_XGEN(b.x)]) == gen, bar);
            __builtin_amdgcn_fence(__ATOMIC_ACQUIRE, "agent");
            asm volatile("s_waitcnt vmcnt(0)" ::: "memory");
        }
    }
    __syncthreads();
}
constexpr int CW_BAR = 4096;

constexpr int K_PROLOGUE = 11, K_FINAL = 12;
template <int KIND>
__device__ __forceinline__ void run_kind(const Params& p, int L, LAS unsigned char* lds, int bid, int nblk) {
    unsigned char* ws = p.ws;
    float* H = (float*)(ws + WS_H);
    float* ss0 = (float*)(ws + WS_STAT); float* ss1 = (float*)(ws + WS_SS1); float* sse = (float*)(ws + WS_SSE);
    if constexpr (KIND == K_PROLOGUE) phase_prologue(p, lds, bid, nblk);
    if constexpr (KIND == K_FINAL) phase_final(p, bid, nblk);
    if constexpr (KIND == 0) { EpiProj E{nullptr, (bf16*)(ws + WS_PROJ), (float*)(ws + WS_BA)};
        gemm_run(lds, (const bf16*)(ws + WS_HB0), (const bf16*)(ws + WS_WIN) + (size_t)L * IN_PAD * D, M, IN_PAD, D, E, bid, nblk, ss0); }
    if constexpr (KIND == 1) phase_gdn_prep(p, L, lds, bid, nblk);
    if constexpr (KIND == 2) { phase_gdn_scan(p, L, lds, bid, nblk); phase_att_queue(p, L, lds, bid, nblk); }
    if constexpr (KIND == 3) { EpiRes E{ss1, H, (bf16*)(ws + WS_HB1)};
        gemm_run(lds, (const bf16*)(ws + WS_OBUF), (const bf16*)(ws + WS_WOUT) + (size_t)L * D * D, M, D, D, E, bid, nblk); }
    if constexpr (KIND == 4) { EpiQ2 E{nullptr, (bf16*)(ws + WS_Q2)};
        gemm_run(lds, (const bf16*)(ws + WS_HB1), (const bf16*)(ws + WS_WQ) + (size_t)L * 2048 * D, M, 2048, D, E, bid, nblk, ss1); }
    if constexpr (KIND == 5) phase_peer(p, L, lds, bid, nblk);
    if constexpr (KIND == 7) { EpiE E2{sse, (bf16*)(ws + WS_EPRE)};
        gemm_run(lds, (const bf16*)(ws + WS_PB) + (size_t)L * M * 256, (const bf16*)(ws + WS_WP) + (size_t)L * D * 256, M, D, 256, E2, bid, nblk); }
    if constexpr (KIND == 6) { EpiPle E{ss0, H, (bf16*)(ws + WS_HB0), (const bf16*)(ws + WS_EPRE), p.ple_norm_g + L * D};
        gemm_run(lds, (const bf16*)(ws + WS_HB2), (const bf16*)(ws + WS_WG) + (size_t)L * D * D, M, D, D, E, bid, nblk, sse); }
}

__device__ __forceinline__ Params params_off(const Params& s, size_t z) {
    Params q;
    q.x = s.x + z; q.p = s.p + z; q.ln_mix_g = s.ln_mix_g + z; q.w_in = s.w_in + z; q.conv_w = s.conv_w + z; q.a_log = s.a_log + z; q.dt_bias = s.dt_bias + z;
    q.gdn_norm_g = s.gdn_norm_g + z; q.diff_lambda = s.diff_lambda + z; q.subln_g = s.subln_g + z; q.w_out = s.w_out + z; q.ln_ffn_g = s.ln_ffn_g + z;
    q.peer_wq = s.peer_wq + z; q.subkeys = s.subkeys + z; q.peer_u = s.peer_u + z; q.peer_v = s.peer_v + z; q.ple_wp = s.ple_wp + z; q.ple_wg = s.ple_wg + z;
    q.ple_norm_g = s.ple_norm_g + z; q.final_g = s.final_g + z; q.out = s.out + z; q.ws = s.ws + z; q.pad0 = 0; q.pad1 = 0;
    return q;
}
#define RUN(KIND) do { size_t z_ = 0; int L_ = L; asm volatile("" : "+s"(z_), "+s"(L_)); const Params q_ = params_off(p, z_); run_kind<KIND>(q_, L_, (LAS unsigned char*)lds, (int)blockIdx.x, (int)gridDim.x); } while (0)
#define GRID_BARRIER() do { XcdBarrier b_; b_.bar = (unsigned*)(p.ws + WS_CTL) + CW_BAR; b_.x = xb_xcc_id(); b_.st = (volatile LAS unsigned*)((LAS unsigned char*)lds + LDS_MISC_OFF) + 8; xcd_barrier(b_); } while (0)
__global__ void __launch_bounds__(NTHREADS, 2) mk_fwd(Params p) {
    extern __shared__ __attribute__((aligned(16))) unsigned char lds[];
    {
        volatile LAS unsigned* misc = (volatile LAS unsigned*)((LAS unsigned char*)lds + LDS_MISC_OFF);
        if (threadIdx.x < 64) misc[threadIdx.x] = 0u;
        __syncthreads();
        (void)xcd_barrier_post((unsigned*)(p.ws + WS_CTL) + CW_BAR, misc + 8);
    }
    { int L = 0; RUN(K_PROLOGUE); }
    cg::this_grid().sync();
#define LAYER(LL) do { const int L = (LL); RUN(0); GRID_BARRIER(); RUN(1); GRID_BARRIER(); RUN(2); GRID_BARRIER(); RUN(3); GRID_BARRIER(); RUN(4); GRID_BARRIER(); RUN(5); RUN(7); GRID_BARRIER(); RUN(6); GRID_BARRIER(); } while (0)
    LAYER(0); LAYER(1); LAYER(2); LAYER(3);
#undef LAYER
    { int L = 0; RUN(K_FINAL); }
}

extern "C" void kernel_launch(void* const* d_in, const int* in_sizes, int n_in, void* d_out, int out_size, void* d_ws, size_t ws_size, hipStream_t stream) {
    static int grid = 0;
    if (grid == 0) {
        if (n_in != 20 || out_size != M * D || ws_size < WS_END) { fprintf(stderr, "kernel_launch: unexpected shapes (n_in %d, out %d, ws %zu < %zu)\n", n_in, out_size, ws_size, (size_t)WS_END); grid = -1; return; }
        int dev = 0, cus = 0, per_cu = 0;
        (void)hipGetDevice(&dev); (void)hipDeviceGetAttribute(&cus, hipDeviceAttributeMultiprocessorCount, dev);
        if (hipFuncSetAttribute((const void*)mk_fwd, hipFuncAttributeMaxDynamicSharedMemorySize, LDS_BYTES) != hipSuccess) { fprintf(stderr, "kernel_launch: hipFuncSetAttribute failed\n"); grid = -1; return; }
        if (hipOccupancyMaxActiveBlocksPerMultiprocessor(&per_cu, (const void*)mk_fwd, NTHREADS, LDS_BYTES) != hipSuccess || per_cu < 1) { fprintf(stderr, "kernel_launch: occupancy query says %d blocks per CU\n", per_cu); (void)hipGetLastError(); grid = -1; return; }
        grid = (cus > 0 ? cus : 256);
    }
    if (grid < 0) return;
    (void)hipMemsetAsync((char*)d_ws + WS_CTL, 0, CTL_ZERO_BYTES, stream);
    Params p{};
    const float** pp = (const float**)&p;
    for (int i = 0; i < 20; ++i) pp[i] = (const float*)d_in[i];
    p.out = (float*)d_out; p.ws = (unsigned char*)d_ws;
    void* args[] = {&p};
    hipError_t e = hipLaunchCooperativeKernel((const void*)mk_fwd, dim3(grid), dim3(NTHREADS), args, LDS_BYTES, stream);
    if (e != hipSuccess) fprintf(stderr, "kernel_launch: cooperative launch failed: %s (grid %d)\n", hipGetErrorString(e), grid);
}
```

```cpp
#include <hip/hip_runtime.h>
#include <hip/hip_cooperative_groups.h>
#include <cstdio>
#include <cstdint>
namespace cg = cooperative_groups;

#define LAS __attribute__((address_space(3)))
typedef unsigned short bf16;
typedef float f32x4 __attribute__((ext_vector_type(4)));
typedef short bf16x8 __attribute__((ext_vector_type(8)));
typedef unsigned u32x4 __attribute__((ext_vector_type(4)));
typedef unsigned u32x2 __attribute__((ext_vector_type(2)));

constexpr int D = 1024, BATCH = 8, SEQ = 2048, DEPTH = 4, M = BATCH * SEQ;
constexpr int IN_COLS = 3592, IN_PAD = 3840, PROJ_W = 3584;
constexpr int NEXP = 16384;
constexpr float EPS = 1e-6f;
constexpr float QSCALE = 0.125f * 1.4426950408889634f;
constexpr int NWAVES = 8, NTHREADS = 512;
constexpr int LDS_BYTES = 163840;
constexpr int LDS_MISC_OFF = LDS_BYTES - 256;
constexpr int RS_OFF = 147456;
constexpr int CW_QUEUE = 1024;

constexpr size_t MiB = 1u << 20;
constexpr size_t WS_CTL = 0, CTL_ZERO_BYTES = 1 * MiB;
constexpr size_t WS_H = 1 * MiB;
constexpr size_t WS_HB0 = 65 * MiB;
constexpr size_t WS_HB1 = 97 * MiB;
constexpr size_t WS_HB2 = 129 * MiB;
constexpr size_t WS_PROJ = 161 * MiB;
constexpr size_t WS_BA = 273 * MiB;
constexpr size_t WS_OBUF = 274 * MiB;
constexpr size_t WS_Q2 = 306 * MiB;
constexpr size_t WS_EPRE = 370 * MiB;
constexpr size_t WS_IDX = 402 * MiB;
constexpr size_t WS_GATE = 410 * MiB;
constexpr size_t WS_STAT = 418 * MiB;
constexpr size_t WS_SS1 = WS_IDX + 1 * MiB, WS_SSE = WS_IDX;
constexpr size_t WS_ORAW = 422 * MiB;
constexpr size_t WS_WIN = 550 * MiB;
constexpr size_t WS_WOUT = 582 * MiB;
constexpr size_t WS_WQ = 590 * MiB;
constexpr size_t WS_WG = 606 * MiB;
constexpr size_t WS_WP = 614 * MiB;
constexpr size_t WS_SK = 616 * MiB;
constexpr size_t WS_PB = 618 * MiB;
constexpr size_t WS_U = 650 * MiB;
constexpr size_t WS_V = 778 * MiB;
constexpr size_t WS_SU = WS_STAT + 1 * MiB, WS_SV = WS_STAT + 2 * MiB;
constexpr size_t WS_END = 906 * MiB;

struct Params {
    const float *x, *p, *ln_mix_g, *w_in, *conv_w, *a_log, *dt_bias, *gdn_norm_g, *diff_lambda, *subln_g, *w_out, *ln_ffn_g,
        *peer_wq, *subkeys, *peer_u, *peer_v, *ple_wp, *ple_wg, *ple_norm_g, *final_g;
    float* out;
    unsigned char* ws;
    int pad0, pad1;
};

__device__ __forceinline__ int tidx() { int t = (int)threadIdx.x; asm volatile("" : "+v"(t)); return t; }
#define LDS_BARRIER() asm volatile("s_waitcnt lgkmcnt(0)\n\ts_barrier" ::: "memory")
__device__ __forceinline__ float bf2f(bf16 v) { return __uint_as_float((unsigned)v << 16); }
__device__ __forceinline__ unsigned f2bf(float f);
typedef __bf16 bf16x2_t __attribute__((ext_vector_type(2)));
typedef float f32x2_t __attribute__((ext_vector_type(2)));
__device__ __forceinline__ unsigned cvtpk(float lo, float hi) { f32x2_t v = {lo, hi}; bf16x2_t b = __builtin_convertvector(v, bf16x2_t); return __builtin_bit_cast(unsigned, b); }
__device__ __forceinline__ unsigned pk2(float lo, float hi) { return cvtpk(lo, hi); }
__device__ __forceinline__ unsigned f2bf(float f) { return cvtpk(f, 0.f) & 0xffffu; }
__device__ __forceinline__ float lo16(unsigned w) { return __uint_as_float(w << 16); }
__device__ __forceinline__ float hi16(unsigned w) { return __uint_as_float(w & 0xffff0000u); }
template <int N> __device__ __forceinline__ float dpp_ror(float x) { return __builtin_bit_cast(float, __builtin_amdgcn_mov_dpp(__builtin_bit_cast(int, x), 0x120 + N, 0xf, 0xf, true)); }
template <int N> __device__ __forceinline__ unsigned dpp_ror_u(unsigned x) { return (unsigned)__builtin_amdgcn_mov_dpp((int)x, 0x120 + N, 0xf, 0xf, true); }
__device__ __forceinline__ float row16_sum(float x) { x += dpp_ror<8>(x); x += dpp_ror<4>(x); x += dpp_ror<2>(x); x += dpp_ror<1>(x); return x; }
__device__ __forceinline__ float row16_max(float x) { x = fmaxf(x, dpp_ror<8>(x)); x = fmaxf(x, dpp_ror<4>(x)); x = fmaxf(x, dpp_ror<2>(x)); x = fmaxf(x, dpp_ror<1>(x)); return x; }
__device__ __forceinline__ unsigned row16_umax(unsigned x) { unsigned y;
    y = dpp_ror_u<8>(x); x = x > y ? x : y; y = dpp_ror_u<4>(x); x = x > y ? x : y; y = dpp_ror_u<2>(x); x = x > y ? x : y; y = dpp_ror_u<1>(x); x = x > y ? x : y; return x; }
__device__ __forceinline__ float xrow16_max(float x) {
    auto s = __builtin_amdgcn_permlane16_swap(__float_as_uint(x), __float_as_uint(x), false, false);
    x = fmaxf(__uint_as_float(s[0]), __uint_as_float(s[1]));
    auto t = __builtin_amdgcn_permlane32_swap(__float_as_uint(x), __float_as_uint(x), false, false);
    return fmaxf(__uint_as_float(t[0]), __uint_as_float(t[1]));
}
__device__ __forceinline__ float xrow16_sum(float x) {
    auto s = __builtin_amdgcn_permlane16_swap(__float_as_uint(x), __float_as_uint(x), false, false);
    x = __uint_as_float(s[0]) + __uint_as_float(s[1]);
    auto t = __builtin_amdgcn_permlane32_swap(__float_as_uint(x), __float_as_uint(x), false, false);
    return __uint_as_float(t[0]) + __uint_as_float(t[1]);
}
__device__ __forceinline__ float wave_sum(float v) { return xrow16_sum(row16_sum(v)); }
template <int N> __device__ __forceinline__ int dpp_ror_i(int x) { return __builtin_amdgcn_mov_dpp(x, 0x120 + N, 0xf, 0xf, true); }
__device__ __forceinline__ int wave_isum(int x) {
    x += dpp_ror_i<8>(x); x += dpp_ror_i<4>(x); x += dpp_ror_i<2>(x); x += dpp_ror_i<1>(x);
    auto s = __builtin_amdgcn_permlane16_swap((unsigned)x, (unsigned)x, false, false); x = (int)(s[0] + s[1]);
    auto t = __builtin_amdgcn_permlane32_swap((unsigned)x, (unsigned)x, false, false); return (int)(t[0] + t[1]);
}
__device__ __forceinline__ float wave_max(float v) {
#pragma unroll
    for (int o = 32; o; o >>= 1) v = fmaxf(v, __shfl_xor(v, o));
    return v;
}
__device__ __forceinline__ float sigmoidf_(float x) { return __builtin_amdgcn_rcpf(1.f + __expf(-x)); }
__device__ __forceinline__ float dot8(u32x4 a, u32x4 b, float s) {
#pragma unroll
    for (int i = 0; i < 4; ++i) { s += lo16(a[i]) * lo16(b[i]); s += hi16(a[i]) * hi16(b[i]); }
    return s;
}

__host__ __device__ __forceinline__ int lds_byte(int r, int c) { const int st = (r >> 4) * 2 + (c >> 5), rr = r & 15, cc = c & 31, ob = rr * 64 + cc * 2; return st * 1024 + (ob ^ (((ob >> 9) & 1) << 5)); }
__host__ __device__ __forceinline__ void stage_rc(int b, int& R, int& C) { const int st = b / 1024, sb = b % 1024, swz = sb ^ (((sb >> 9) & 1) << 5); R = (st >> 1) * 16 + swz / 64; C = (st & 1) * 32 + (swz % 64) / 2; }
constexpr int HTB = 16384;
template <class F>
__device__ __forceinline__ void gemm_run(LAS unsigned char* lds, const bf16* A, const bf16* Bt, int Mm, int N, int K, const F& f, int bid, int nblk, const float* slots_in = nullptr) {
    LAS float* RS = (LAS float*)(lds + RS_OFF);
    int rs_pm = -1;
    const int tid = tidx(), wid = __builtin_amdgcn_readfirstlane(tid >> 6), lane = tid & 63, wr = wid >> 2, wc = wid & 3, fr = lane & 15, fq = lane >> 4;
    const int nt = K / 64, ntn = N / 256, nunits = (Mm / 256) * ntn;
    unsigned voff[2];
#pragma unroll
    for (int i = 0; i < 2; ++i) { const int uu = tid + 512 * i, r = uu >> 3, c = (uu & 7) ^ ((r >> 1) & 7); voff[i] = (unsigned)(r * K + c * 8) * 2u; }
    const unsigned ldsw = (unsigned)wid * 1024u;
    const int sw7 = (fr >> 1) & 7;
    const int aoff0 = wr * HTB + fr * 128 + ((fq ^ sw7) << 4), aoff1 = wr * HTB + fr * 128 + (((4 + fq) ^ sw7) << 4);
    const int bbase = (2 + (wc >> 1)) * HTB + (wc & 1) * 8192 + fr * 128;
    const int boff0 = bbase + ((fq ^ sw7) << 4), boff1 = bbase + (((4 + fq) ^ sw7) << 4);
#define G_STAGE(bufoff, gbase) do { _Pragma("unroll") for (int _i = 0; _i < 2; ++_i) \
        __builtin_amdgcn_global_load_lds((const unsigned*)((const char*)(gbase) + voff[_i]), (LAS unsigned*)(lds + (bufoff) + ldsw + _i * 8192), 16, 0, 0); } while (0)
    for (int u = bid; u < nunits; u += nblk) {
        const int pm = u % (Mm / 256), pn = u / (Mm / 256);
        if (slots_in && pm != rs_pm) {
            __syncthreads();
            if (tid < 256) { const f32x4* sp = (const f32x4*)(slots_in + ((size_t)pm * 256 + tid) * 16);
                const f32x4 a = sp[0], b = sp[1], c = sp[2], d = sp[3];
                const float s = (((a[0] + a[1]) + (a[2] + a[3])) + ((b[0] + b[1]) + (b[2] + b[3]))) + (((c[0] + c[1]) + (c[2] + c[3])) + ((d[0] + d[1]) + (d[2] + d[3])));
                RS[tid] = rsqrtf(s * (1.f / D) + EPS); }
            __syncthreads();
            rs_pm = pm;
        }
        const char* gA = (const char*)(A + (size_t)pm * 256 * K);
        const char* gB = (const char*)(Bt + (size_t)pn * 256 * K);
        const size_t hstep = (size_t)128 * K * 2;
        f32x4 acc[8][4];
#pragma unroll
        for (int a = 0; a < 8; ++a)
#pragma unroll
            for (int b = 0; b < 4; ++b) acc[a][b] = (f32x4){0.f, 0.f, 0.f, 0.f};
        G_STAGE(0, gA); G_STAGE(HTB, gA + hstep); G_STAGE(2 * HTB, gB); G_STAGE(3 * HTB, gB + hstep);
        for (int t = 0; t < nt; ++t) {
            const int cb = (t & 1) * 4 * HTB, nb = ((t + 1) & 1) * 4 * HTB;
            asm volatile("s_waitcnt vmcnt(0)" ::: "memory");
            __builtin_amdgcn_s_barrier();
            asm volatile("" ::: "memory");
            const size_t ko = (size_t)(t + 1) * 128; const bool more = t + 1 < nt;
#pragma unroll
            for (int k = 0; k < 2; ++k) {
                if (more) { if (k == 0) { G_STAGE(nb, gA + ko); G_STAGE(nb + 2 * HTB, gB + ko); } else { G_STAGE(nb + HTB, gA + hstep + ko); G_STAGE(nb + 3 * HTB, gB + hstep + ko); } }
                bf16x8 bfr[4], acur, anxt;
#pragma unroll
                for (int n = 0; n < 4; ++n) bfr[n] = *(const LAS bf16x8*)(lds + cb + (k ? boff1 : boff0) + n * 2048);
                acur = *(const LAS bf16x8*)(lds + cb + (k ? aoff1 : aoff0));
#pragma unroll
                for (int m = 0; m < 8; ++m) {
                    if (m < 7) anxt = *(const LAS bf16x8*)(lds + cb + (k ? aoff1 : aoff0) + (m + 1) * 2048);
#pragma unroll
                    for (int n = 0; n < 4; ++n) acc[m][n] = __builtin_amdgcn_mfma_f32_16x16x32_bf16(bfr[n], acur, acc[m][n], 0, 0, 0);
                    acur = anxt;
                }
                __builtin_amdgcn_sched_barrier(0);
            }
            asm volatile("s_waitcnt lgkmcnt(0)" ::: "memory");
        }
        {
            int el = lane; asm volatile("" : "+v"(el));
            const int efr = el & 15, efq = el >> 4;
            LAS float* et = (LAS float*)(lds + wid * 4352);
#pragma unroll
            for (int m = 0; m < 8; ++m) {
#pragma unroll
                for (int n = 0; n < 4; ++n) *(LAS f32x4*)(et + efr * 68 + n * 16 + 4 * efq) = acc[m][n];
                asm volatile("s_waitcnt lgkmcnt(0)" ::: "memory");
#pragma unroll
                for (int i = 0; i < 4; ++i) {
                    const int lrow = wr * 128 + m * 16 + 4 * i + efq, row = pm * 256 + lrow;
                    const f32x4 v = *(const LAS f32x4*)(et + (4 * i + efq) * 68 + 4 * efr);
                    const f32x4 r = f(row, RS[lrow], pn * 256 + wc * 64 + 4 * efr, v);
                    if constexpr (F::STATS) { const float ssq = row16_sum((r[0] * r[0] + r[1] * r[1]) + (r[2] * r[2] + r[3] * r[3])); if (efr == 0) f.slots[(size_t)row * 16 + pn * 4 + wc] = ssq; }
                }
                asm volatile("s_waitcnt lgkmcnt(0)" ::: "memory");
                __builtin_amdgcn_sched_barrier(0);
            }
        }
        __syncthreads();
    }
#undef G_STAGE
}

__device__ __forceinline__ u32x2 pk4(f32x4 a) { u32x2 o; o.x = pk2(a[0], a[1]); o.y = pk2(a[2], a[3]); return o; }
struct EpiProj {
    static constexpr bool STATS = false; float* slots;
    bf16* proj; float* ba;
    __device__ __forceinline__ f32x4 operator()(int row, float rstd, int col, f32x4 v) const {
        v = v * rstd;
        if (col < PROJ_W) *(u32x2*)(proj + (size_t)row * PROJ_W + col) = pk4(v);
        else if (col < IN_COLS) *(f32x4*)(ba + (size_t)row * 8 + (col - PROJ_W)) = v;
        return v;
    }
};
struct EpiRes {
    static constexpr bool STATS = true; float* slots;
    float* H; bf16* HB;
    __device__ __forceinline__ f32x4 operator()(int row, float, int col, f32x4 v) const {
        f32x4* hp = (f32x4*)(H + (size_t)row * D + col);
        const f32x4 h = *hp + v; *hp = h;
        *(u32x2*)(HB + (size_t)row * D + col) = pk4(h);
        return h;
    }
};
struct EpiQ2 {
    static constexpr bool STATS = false; float* slots;
    bf16* Q2;
    __device__ __forceinline__ f32x4 operator()(int row, float rstd, int col, f32x4 v) const { v = v * rstd; *(u32x2*)(Q2 + (size_t)row * 2048 + col) = pk4(v); return v; }
};
struct EpiE {
    static constexpr bool STATS = true; float* slots;
    bf16* E;
    __device__ __forceinline__ f32x4 operator()(int row, float, int col, f32x4 v) const { *(u32x2*)(E + (size_t)row * D + col) = pk4(v); return v; }
};
struct EpiPle {
    static constexpr bool STATS = true; float* slots;
    float* H; bf16* HB; const bf16* E; const float* g;
    __device__ __forceinline__ f32x4 operator()(int row, float rstde, int col, f32x4 v) const {
        f32x4* hp = (f32x4*)(H + (size_t)row * D + col);
        const u32x2 ev = *(const u32x2*)(E + (size_t)row * D + col);
        const f32x4 gv = *(const f32x4*)(g + col);
        f32x4 h = *hp;
        h[0] += sigmoidf_(v[0]) * (lo16(ev.x) * rstde * gv[0]); h[1] += sigmoidf_(v[1]) * (hi16(ev.x) * rstde * gv[1]);
        h[2] += sigmoidf_(v[2]) * (lo16(ev.y) * rstde * gv[2]); h[3] += sigmoidf_(v[3]) * (hi16(ev.y) * rstde * gv[3]);
        *hp = h;
        *(u32x2*)(HB + (size_t)row * D + col) = pk4(h);
        return h;
    }
};

__device__ __forceinline__ void transpose_item(const float* W, int K, int N, int Npad, bf16* WT, const float* rowscale, int qcols, float* scr, int item, int lane) {
    const int nblk = Npad / 32, kb = item / nblk, nb = item % nblk, k0 = 64 * kb, n0 = 32 * nb;
    const int nq = n0 + 4 * (lane & 7);
#pragma unroll
    for (int i = 0; i < 8; ++i) {
        const int kk = 8 * i + (lane >> 3);
        f32x4 v = (nq < N) ? *(const f32x4*)(W + (size_t)(k0 + kk) * N + nq) : (f32x4){0.f, 0.f, 0.f, 0.f};
        if (rowscale) v = v * rowscale[k0 + kk];
        if (nq < qcols) v = v * QSCALE;
        scr[kk * 33 + 4 * (lane & 7)] = v[0]; scr[kk * 33 + 4 * (lane & 7) + 1] = v[1]; scr[kk * 33 + 4 * (lane & 7) + 2] = v[2]; scr[kk * 33 + 4 * (lane & 7) + 3] = v[3];
    }
    asm volatile("s_waitcnt lgkmcnt(0)" ::: "memory");
    const int c = lane & 7;
#pragma unroll
    for (int j = 0; j < 4; ++j) {
        const int nn = (lane >> 3) + 8 * j; const float* s = scr + (8 * c) * 33 + nn;
        u32x4 o; o.x = pk2(s[0 * 33], s[1 * 33]); o.y = pk2(s[2 * 33], s[3 * 33]); o.z = pk2(s[4 * 33], s[5 * 33]); o.w = pk2(s[6 * 33], s[7 * 33]);
        *(u32x4*)(WT + (size_t)(n0 + nn) * K + k0 + 8 * c) = o;
    }
    asm volatile("s_waitcnt lgkmcnt(0)" ::: "memory");
}
__device__ __forceinline__ void convert_bulk(const float* src, bf16* dst, size_t n, size_t gtid, size_t nthr) {
    for (size_t i = gtid * 8; i < n; i += nthr * 8) {
        const f32x4 a = *(const f32x4*)(src + i), b = *(const f32x4*)(src + i + 4);
        u32x4 o; o.x = pk2(a[0], a[1]); o.y = pk2(a[2], a[3]); o.z = pk2(b[0], b[1]); o.w = pk2(b[2], b[3]);
        *(u32x4*)(dst + i) = o;
    }
}
__device__ void phase_prologue(const Params& p, LAS unsigned char* lds_, int bid, int nblk) {
    unsigned char* lds = (unsigned char*)lds_;
    const int tid = tidx(), lane = tid & 63, w = tid >> 6;
    const int gw = bid * NWAVES + w, NGW = nblk * NWAVES;
    float* scr = (float*)(lds + w * 16384);
    constexpr int I_IN = 16 * (IN_PAD / 32), I_OUT = 16 * 32, I_Q = 16 * 64, I_G = 16 * 32, I_P = 4 * 32, I_L = I_IN + I_OUT + I_Q + I_G + I_P;
    for (int it = gw; it < DEPTH * I_L; it += NGW) {
        const int L = it / I_L; int r = it % I_L;
        if (r < I_IN) { transpose_item(p.w_in + (size_t)L * D * IN_COLS, D, IN_COLS, IN_PAD, (bf16*)(p.ws + WS_WIN) + (size_t)L * IN_PAD * D, p.ln_mix_g + L * D, 512, scr, r, lane); continue; } r -= I_IN;
        if (r < I_OUT) { transpose_item(p.w_out + (size_t)L * D * D, D, D, D, (bf16*)(p.ws + WS_WOUT) + (size_t)L * D * D, nullptr, 0, scr, r, lane); continue; } r -= I_OUT;
        if (r < I_Q) { transpose_item(p.peer_wq + (size_t)L * D * 2048, D, 2048, 2048, (bf16*)(p.ws + WS_WQ) + (size_t)L * 2048 * D, p.ln_ffn_g + L * D, 0, scr, r, lane); continue; } r -= I_Q;
        if (r < I_G) { transpose_item(p.ple_wg + (size_t)L * D * D, D, D, D, (bf16*)(p.ws + WS_WG) + (size_t)L * D * D, nullptr, 0, scr, r, lane); continue; } r -= I_G;
        transpose_item(p.ple_wp + (size_t)L * 256 * D, 256, D, D, (bf16*)(p.ws + WS_WP) + (size_t)L * D * 256, nullptr, 0, scr, r, lane);
    }
    const size_t gtid = (size_t)bid * NTHREADS + tid, nthr = (size_t)nblk * NTHREADS;
    for (int r = gw; r < 2 * DEPTH * NEXP; r += NGW) {
        const int which = r >= DEPTH * NEXP, rr = which ? r - DEPTH * NEXP : r;
        const float* srow = (which ? p.peer_v : p.peer_u) + (size_t)rr * D + 4 * lane;
        f32x4 v[4];
#pragma unroll
        for (int j = 0; j < 4; ++j) v[j] = *(const f32x4*)(srow + 256 * j);
        float mx = 0.f;
#pragma unroll
        for (int j = 0; j < 4; ++j) mx = fmaxf(mx, fmaxf(fmaxf(fabsf(v[j][0]), fabsf(v[j][1])), fmaxf(fabsf(v[j][2]), fabsf(v[j][3]))));
        mx = xrow16_max(row16_max(mx));
        const float inv = mx > 0.f ? 127.f / mx : 0.f;
        u32x4 o;
#pragma unroll
        for (int j = 0; j < 4; ++j) {
            const unsigned b0 = (unsigned)__float2int_rn(v[j][0] * inv) & 0xffu, b1 = (unsigned)__float2int_rn(v[j][1] * inv) & 0xffu, b2 = (unsigned)__float2int_rn(v[j][2] * inv) & 0xffu, b3 = (unsigned)__float2int_rn(v[j][3] * inv) & 0xffu;
            o[j] = b0 | (b1 << 8) | (b2 << 16) | (b3 << 24);
        }
        *(u32x4*)(p.ws + (which ? WS_V : WS_U) + (size_t)rr * D + 16 * lane) = o;
        if (lane == 0) ((float*)(p.ws + (which ? WS_SV : WS_SU)))[rr] = mx * (1.f / 127.f);
    }
    convert_bulk(p.p, (bf16*)(p.ws + WS_PB), (size_t)DEPTH * M * 256, gtid, nthr);
    convert_bulk(p.subkeys, (bf16*)(p.ws + WS_SK), (size_t)DEPTH * 8 * 2 * 128 * 128, gtid, nthr);
    float* H = (float*)(p.ws + WS_H); bf16* HB0 = (bf16*)(p.ws + WS_HB0); float* ss0 = (float*)(p.ws + WS_STAT);
    for (int m = gw; m < M; m += NGW) {
        const f32x4* xr = (const f32x4*)(p.x + (size_t)m * D) + lane;
        float ss = 0.f;
#pragma unroll
        for (int j = 0; j < 4; ++j) {
            const f32x4 v = xr[64 * j];
            ss += v[0] * v[0] + v[1] * v[1] + v[2] * v[2] + v[3] * v[3];
            ((f32x4*)(H + (size_t)m * D))[lane + 64 * j] = v;
            u32x2 o; o.x = pk2(v[0], v[1]); o.y = pk2(v[2], v[3]);
            ((u32x2*)(HB0 + (size_t)m * D))[lane + 64 * j] = o;
        }
        ss = wave_sum(ss);
        if (lane < 16) ss0[(size_t)m * 16 + lane] = lane == 0 ? ss : 0.f;
    }
}

typedef short v4i16_t __attribute__((ext_vector_type(4)));
constexpr int ATT_VOFF = 16384, ATT_VPITCH = 288;
__device__ __forceinline__ void att_unit(const Params& p, int L, LAS unsigned char* lds, int tid, int b, int hh, int qb, float lam, float lam_init) {
    const int lane = tid & 63, w = __builtin_amdgcn_readfirstlane(tid >> 6), fr = lane & 15, fq = lane >> 4;
    const bf16* proj = (const bf16*)(p.ws + WS_PROJ);
    bf16* obuf = (bf16*)(p.ws + WS_OBUF);
    {
        const float slope2 = 1.4426950408889634f / (float)(1 << (2 * (hh + 1)));
        const bf16* kbase = proj + (size_t)b * SEQ * PROJ_W + 512 + hh * 128;
        const bf16* vbase = proj + (size_t)b * SEQ * PROJ_W + 1024 + hh * 128;
        {
            const int qw0 = qb * 128 + w * 16, T = 2 * (qb + 1);
            bf16x8 qf[2][2];
#pragma unroll
            for (int mp = 0; mp < 2; ++mp)
#pragma unroll
                for (int ks = 0; ks < 2; ++ks) qf[mp][ks] = *(const bf16x8*)(proj + ((size_t)b * SEQ + qw0 + fr) * PROJ_W + hh * 128 + mp * 64 + ks * 32 + 8 * fq);
            f32x4 o[2][8];
#pragma unroll
            for (int mp = 0; mp < 2; ++mp)
#pragma unroll
                for (int dt = 0; dt < 8; ++dt) o[mp][dt] = (f32x4){0.f, 0.f, 0.f, 0.f};
            float mrun[2] = {-INFINITY, -INFINITY}, lrun[2] = {0.f, 0.f};
            u32x4 kreg[2], vreg[2];
#pragma unroll
            for (int i = 0; i < 2; ++i) { const int c = tid + 512 * i, key = c >> 4, ch = c & 15;
                kreg[i] = *(const u32x4*)(kbase + (size_t)key * PROJ_W + ch * 8); vreg[i] = *(const u32x4*)(vbase + (size_t)key * PROJ_W + ch * 8); }
            for (int t = 0; t < T; ++t) {
                const int k0 = t * 64;
#pragma unroll
                for (int i = 0; i < 2; ++i) { const int c = tid + 512 * i, key = c >> 4, ch = c & 15;
                    *(LAS u32x4*)(lds + key * 256 + ((ch ^ (key & 15)) << 4)) = kreg[i];
                    *(LAS u32x4*)(lds + ATT_VOFF + key * ATT_VPITCH + ch * 16) = vreg[i]; }
                LDS_BARRIER();
                if (t + 1 < T) {
#pragma unroll
                    for (int i = 0; i < 2; ++i) { const int c = tid + 512 * i, key = k0 + 64 + (c >> 4), ch = c & 15;
                        kreg[i] = *(const u32x4*)(kbase + (size_t)key * PROJ_W + ch * 8); vreg[i] = *(const u32x4*)(vbase + (size_t)key * PROJ_W + ch * 8); }
                }
                if (k0 <= qw0 + 15) {
                    f32x4 s[2][4];
                    const float base = -slope2 * (float)(qw0 + fr - k0 - 4 * fq);
#pragma unroll
                    for (int kt = 0; kt < 4; ++kt)
#pragma unroll
                        for (int r = 0; r < 4; ++r) { const float v = base + slope2 * (float)(16 * kt + r); s[0][kt][r] = v; s[1][kt][r] = v; }
#pragma unroll
                    for (int mp = 0; mp < 2; ++mp)
#pragma unroll
                        for (int kt = 0; kt < 4; ++kt)
#pragma unroll
                            for (int ks = 0; ks < 2; ++ks) {
                                const bf16x8 kf = *(const LAS bf16x8*)(lds + (16 * kt + fr) * 256 + (((mp * 8 + ks * 4 + fq) ^ fr) << 4));
                                s[mp][kt] = __builtin_amdgcn_mfma_f32_16x16x32_bf16(kf, qf[mp][ks], s[mp][kt], 0, 0, 0);
                            }
                    if (k0 + 63 > qw0) {
                        const int lim = qw0 + fr - k0 - 4 * fq;
#pragma unroll
                        for (int mp = 0; mp < 2; ++mp)
#pragma unroll
                            for (int kt = 0; kt < 4; ++kt)
#pragma unroll
                                for (int r = 0; r < 4; ++r) if (16 * kt + r > lim) s[mp][kt][r] = -INFINITY;
                    }
                    bf16x8 pb[2][2];
#pragma unroll
                    for (int mp = 0; mp < 2; ++mp) {
                        float mx = fmaxf(fmaxf(s[mp][0][0], s[mp][0][1]), fmaxf(s[mp][0][2], s[mp][0][3]));
#pragma unroll
                        for (int kt = 1; kt < 4; ++kt) mx = fmaxf(mx, fmaxf(fmaxf(s[mp][kt][0], s[mp][kt][1]), fmaxf(s[mp][kt][2], s[mp][kt][3])));
                        mx = xrow16_max(mx);
                        const float mnew = fmaxf(mrun[mp], mx);
                        const float alpha = __builtin_amdgcn_exp2f(mrun[mp] - mnew);
                        mrun[mp] = mnew;
                        float ps = 0.f;
#pragma unroll
                        for (int kt = 0; kt < 4; ++kt)
#pragma unroll
                            for (int r = 0; r < 4; ++r) { const float e = __builtin_amdgcn_exp2f(s[mp][kt][r] - mnew); s[mp][kt][r] = e; ps += e; }
                        lrun[mp] = lrun[mp] * alpha + ps;
#pragma unroll
                        for (int dt = 0; dt < 8; ++dt) o[mp][dt] = o[mp][dt] * alpha;
#pragma unroll
                        for (int ks = 0; ks < 2; ++ks) {
                            u32x4 pk; pk.x = cvtpk(s[mp][2 * ks][0], s[mp][2 * ks][1]); pk.y = cvtpk(s[mp][2 * ks][2], s[mp][2 * ks][3]);
                            pk.z = cvtpk(s[mp][2 * ks + 1][0], s[mp][2 * ks + 1][1]); pk.w = cvtpk(s[mp][2 * ks + 1][2], s[mp][2 * ks + 1][3]);
                            pb[mp][ks] = __builtin_bit_cast(bf16x8, pk);
                        }
                    }
                    const int gl = lane & 15;
                    LAS unsigned char* vrd = lds + ATT_VOFF + (4 * fq + (gl >> 2)) * ATT_VPITCH + (gl & 3) * 8;
#pragma unroll
                    for (int dt = 0; dt < 8; ++dt)
#pragma unroll
                        for (int ks = 0; ks < 2; ++ks) {
                            const v4i16_t v0 = __builtin_amdgcn_ds_read_tr16_b64_v4i16((LAS v4i16_t*)(vrd + (32 * ks) * ATT_VPITCH + dt * 32));
                            const v4i16_t v1 = __builtin_amdgcn_ds_read_tr16_b64_v4i16((LAS v4i16_t*)(vrd + (32 * ks + 16) * ATT_VPITCH + dt * 32));
                            bf16x8 vf; vf[0] = v0[0]; vf[1] = v0[1]; vf[2] = v0[2]; vf[3] = v0[3]; vf[4] = v1[0]; vf[5] = v1[1]; vf[6] = v1[2]; vf[7] = v1[3];
                            o[0][dt] = __builtin_amdgcn_mfma_f32_16x16x32_bf16(vf, pb[0][ks], o[0][dt], 0, 0, 0);
                            o[1][dt] = __builtin_amdgcn_mfma_f32_16x16x32_bf16(vf, pb[1][ks], o[1][dt], 0, 0, 0);
                        }
                }
                LDS_BARRIER();
            }
            const float i1 = __builtin_amdgcn_rcpf(xrow16_sum(lrun[0])), i2 = lam * __builtin_amdgcn_rcpf(xrow16_sum(lrun[1]));
            float ss = 0.f;
#pragma unroll
            for (int dt = 0; dt < 8; ++dt)
#pragma unroll
                for (int r = 0; r < 4; ++r) { const float v = o[0][dt][r] * i1 - o[1][dt][r] * i2; o[0][dt][r] = v; ss += v * v; }
            ss = xrow16_sum(ss);
            const float rn = rsqrtf(ss * (1.f / 128.f) + EPS) * (1.f - lam_init);
            const float* g = p.subln_g + L * 128;
            bf16* orow = obuf + ((size_t)b * SEQ + qw0 + fr) * D + hh * 128;
#pragma unroll
            for (int dt = 0; dt < 8; ++dt) {
                const f32x4 gv = *(const f32x4*)(g + 16 * dt + 4 * fq);
                u32x2 ov; ov.x = pk2(o[0][dt][0] * rn * gv[0], o[0][dt][1] * rn * gv[1]); ov.y = pk2(o[0][dt][2] * rn * gv[2], o[0][dt][3] * rn * gv[3]);
                *(u32x2*)(orow + 16 * dt + 4 * fq) = ov;
            }
        }
    }
}

__device__ void phase_att_queue(const Params& p, int L, LAS unsigned char* lds, int bid, int nblk) {
    const int tid = tidx(), lane = tid & 63;
    const float* lp = p.diff_lambda + L * 256;
    const float d1 = wave_sum(lp[lane] * lp[64 + lane]), d2 = wave_sum(lp[128 + lane] * lp[192 + lane]);
    const float lam_init = 0.8f - 0.6f * __expf(-0.3f * (float)L);
    const float lam = __expf(d1) - __expf(d2) + lam_init;
    unsigned* head = (unsigned*)(p.ws + WS_CTL) + CW_QUEUE + L;
    volatile LAS int* slot = (volatile LAS int*)(lds + LDS_MISC_OFF + 64);
    for (;;) {
        __syncthreads();
        if (tid == 0) *slot = (int)__hip_atomic_fetch_add(head, 1u, __ATOMIC_RELAXED, __HIP_MEMORY_SCOPE_AGENT);
        __syncthreads();
        const int u = *slot;
        if (u >= 512) break;
        att_unit(p, L, lds, tid, (u & 31) >> 2, u & 3, 15 - (u >> 5), lam, lam_init);
    }
}

constexpr size_t GD_WP = WS_ORAW, GD_QD = WS_ORAW + 16 * MiB, GD_AIP = WS_ORAW + 32 * MiB, GD_KDT = WS_ORAW + 40 * MiB, GD_UT = WS_ORAW + 56 * MiB, GD_GL = WS_ORAW + 72 * MiB;
__device__ __forceinline__ int perm_pos(int k) { return (k & ~31) + 8 * ((k >> 2) & 3) + 4 * ((k >> 4) & 1) + (k & 3); }
__device__ __forceinline__ float softplusf_(float x) { if (x > 20.f) return x; const float e = __expf(x); return e < 0.06f ? e * (1.f - e * (0.5f - e * (0.33333334f - 0.25f * e))) : __logf(1.f + e); }
__device__ __forceinline__ float gelu_erf(float v) {
    const float z = fabsf(v) * 0.70710678118654752f, t = __builtin_amdgcn_rcpf(1.f + 0.3275911f * z);
    const float pl = t * (0.254829592f + t * (-0.284496736f + t * (1.421413741f + t * (-1.453152027f + t * 1.061405429f))));
    const float er = 1.f - pl * __expf(-z * z);
    return 0.5f * v * (1.f + (v < 0.f ? -er : er));
}

constexpr int GP_KN = 0, GP_QN = 17408, GP_RT = 34816, GP_LM = 71680, GP_TB = 89088, GP_GT = 98304, GP_T0T = 99328;
constexpr int GP_KP = 272, GP_RP = 144, GP_LP = 68, GP_TP = 144;
__device__ void phase_gdn_prep(const Params& p, int L, LAS unsigned char* lds, int bid, int nblk) {
    const int tid = tidx(), lane = tid & 63, w = __builtin_amdgcn_readfirstlane(tid >> 6), fr = lane & 15, fq = lane >> 4;
    const bf16* proj = (const bf16*)(p.ws + WS_PROJ);
    const float* BA = (const float*)(p.ws + WS_BA);
    bf16* WP = (bf16*)(p.ws + GD_WP); bf16* QD = (bf16*)(p.ws + GD_QD); bf16* AIP = (bf16*)(p.ws + GD_AIP); bf16* KDT = (bf16*)(p.ws + GD_KDT); bf16* UT = (bf16*)(p.ws + GD_UT);
    float* GL = (float*)(p.ws + GD_GL);
    const float* cw = p.conv_w + (size_t)L * 4 * 1536;
    LAS float* beta_s = (LAS float*)(lds + GP_GT); LAS float* gc_s = beta_s + 64; LAS float* egc_s = gc_s + 64; LAS float* edl_s = egc_s + 64;
    LAS float* Lm = (LAS float*)(lds + GP_LM);
    for (int item = bid; item < 1024; item += nblk) {
        const int n = item & 31, bh = item >> 5, hh = bh & 3, b = bh >> 2, t0 = n * 64;
        const size_t row0 = (size_t)b * SEQ + t0;
        __syncthreads();
        if (w == 0) {
            const float negA = -__expf(p.a_log[L * 4 + hh]), dtb = p.dt_bias[L * 4 + hh];
            const float bb = BA[(row0 + lane) * 8 + hh], aa = BA[(row0 + lane) * 8 + 4 + hh] + dtb;
            float c = negA * softplusf_(aa);
#pragma unroll
            for (int o = 1; o < 64; o <<= 1) { const float t = __shfl_up(c, o); if (lane >= o) c += t; }
            const float glast = __shfl(c, 63);
            beta_s[lane] = sigmoidf_(bb); gc_s[lane] = c; egc_s[lane] = __expf(c); edl_s[lane] = __expf(glast - c);
            if (lane == 0) GL[item] = __expf(glast);
        }
        __syncthreads();
        {
            const int colq = hh * 128 + 2 * lane;
            unsigned xk[11], xv[11];
#pragma unroll
            for (int r = 0; r < 11; ++r) { const int tt = t0 + 8 * w - 3 + r;
                xk[r] = (tt >= 0) ? *(const unsigned*)(proj + ((size_t)b * SEQ + tt) * PROJ_W + 1536 + 512 + colq) : 0u;
                xv[r] = (tt >= 0) ? *(const unsigned*)(proj + ((size_t)b * SEQ + tt) * PROJ_W + 1536 + 1024 + colq) : 0u; }
            {
                float wq[4][2]; unsigned xq[11];
#pragma unroll
                for (int j = 0; j < 4; ++j) { wq[j][0] = cw[j * 1536 + colq]; wq[j][1] = cw[j * 1536 + colq + 1]; }
#pragma unroll
                for (int r = 0; r < 11; ++r) { const int tt = t0 + 8 * w - 3 + r; xq[r] = (tt >= 0) ? *(const unsigned*)(proj + ((size_t)b * SEQ + tt) * PROJ_W + 1536 + colq) : 0u; }
#pragma unroll
                for (int i = 0; i < 8; ++i) {
                    const int c = 8 * w + i;
                    float q0 = 0.f, q1 = 0.f;
#pragma unroll
                    for (int j = 0; j < 4; ++j) { q0 += wq[j][0] * lo16(xq[i + j]); q1 += wq[j][1] * hi16(xq[i + j]); }
                    q0 *= sigmoidf_(q0); q1 *= sigmoidf_(q1);
                    const float sq = rsqrtf(wave_sum(q0 * q0 + q1 * q1) + EPS) * 0.08838834764831845f;
                    q0 *= sq; q1 *= sq;
                    const float eg = egc_s[c];
                    *(LAS unsigned*)(lds + GP_QN + c * GP_KP + lane * 4) = pk2(q0, q1);
                    *(unsigned*)(QD + ((size_t)item * 64 + c) * 128 + perm_pos(2 * lane)) = pk2(q0 * eg, q1 * eg);
                }
            }
            __builtin_amdgcn_sched_barrier(0);
            {
                float wk[4][2];
#pragma unroll
                for (int j = 0; j < 4; ++j) { wk[j][0] = cw[j * 1536 + 512 + colq]; wk[j][1] = cw[j * 1536 + 512 + colq + 1]; }
                unsigned kd0[8], kd1[8], rk0[8], rk1[8];
#pragma unroll
                for (int i = 0; i < 8; ++i) {
                    const int c = 8 * w + i;
                    float k0 = 0.f, k1 = 0.f;
#pragma unroll
                    for (int j = 0; j < 4; ++j) { k0 += wk[j][0] * lo16(xk[i + j]); k1 += wk[j][1] * hi16(xk[i + j]); }
                    k0 *= sigmoidf_(k0); k1 *= sigmoidf_(k1);
                    const float sk = rsqrtf(wave_sum(k0 * k0 + k1 * k1) + EPS);
                    k0 *= sk; k1 *= sk;
                    const float be = beta_s[c], eg = egc_s[c], ed = edl_s[c];
                    *(LAS unsigned*)(lds + GP_KN + c * GP_KP + lane * 4) = pk2(k0, k1);
                    kd0[i] = f2bf(k0 * ed); kd1[i] = f2bf(k1 * ed);
                    rk0[i] = f2bf(k0 * be * eg); rk1[i] = f2bf(k1 * be * eg);
                }
                u32x4 o;
                o.x = rk0[0] | (rk0[1] << 16); o.y = rk0[2] | (rk0[3] << 16); o.z = rk0[4] | (rk0[5] << 16); o.w = rk0[6] | (rk0[7] << 16); *(LAS u32x4*)(lds + GP_RT + (128 + 2 * lane) * GP_RP + 16 * w) = o;
                o.x = rk1[0] | (rk1[1] << 16); o.y = rk1[2] | (rk1[3] << 16); o.z = rk1[4] | (rk1[5] << 16); o.w = rk1[6] | (rk1[7] << 16); *(LAS u32x4*)(lds + GP_RT + (128 + 2 * lane + 1) * GP_RP + 16 * w) = o;
                const int pa = perm_pos(8 * w), pb = perm_pos(8 * w + 4);
                bf16* kr0 = KDT + ((size_t)item * 128 + 2 * lane) * 64; bf16* kr1 = kr0 + 64;
                u32x2 h2;
                h2.x = kd0[0] | (kd0[1] << 16); h2.y = kd0[2] | (kd0[3] << 16); *(u32x2*)(kr0 + pa) = h2;
                h2.x = kd0[4] | (kd0[5] << 16); h2.y = kd0[6] | (kd0[7] << 16); *(u32x2*)(kr0 + pb) = h2;
                h2.x = kd1[0] | (kd1[1] << 16); h2.y = kd1[2] | (kd1[3] << 16); *(u32x2*)(kr1 + pa) = h2;
                h2.x = kd1[4] | (kd1[5] << 16); h2.y = kd1[6] | (kd1[7] << 16); *(u32x2*)(kr1 + pb) = h2;
            }
            __builtin_amdgcn_sched_barrier(0);
            {
                float wv[4][2];
#pragma unroll
                for (int j = 0; j < 4; ++j) { wv[j][0] = cw[j * 1536 + 1024 + colq]; wv[j][1] = cw[j * 1536 + 1024 + colq + 1]; }
                unsigned rv0[8], rv1[8];
#pragma unroll
                for (int i = 0; i < 8; ++i) {
                    float v0 = 0.f, v1 = 0.f;
#pragma unroll
                    for (int j = 0; j < 4; ++j) { v0 += wv[j][0] * lo16(xv[i + j]); v1 += wv[j][1] * hi16(xv[i + j]); }
                    v0 *= sigmoidf_(v0); v1 *= sigmoidf_(v1);
                    const float be = beta_s[8 * w + i];
                    rv0[i] = f2bf(v0 * be); rv1[i] = f2bf(v1 * be);
                }
                u32x4 o;
                o.x = rv0[0] | (rv0[1] << 16); o.y = rv0[2] | (rv0[3] << 16); o.z = rv0[4] | (rv0[5] << 16); o.w = rv0[6] | (rv0[7] << 16); *(LAS u32x4*)(lds + GP_RT + (2 * lane) * GP_RP + 16 * w) = o;
                o.x = rv1[0] | (rv1[1] << 16); o.y = rv1[2] | (rv1[3] << 16); o.z = rv1[4] | (rv1[5] << 16); o.w = rv1[6] | (rv1[7] << 16); *(LAS u32x4*)(lds + GP_RT + (2 * lane + 1) * GP_RP + 16 * w) = o;
            }
        }
        __syncthreads();
#pragma unroll
        for (int q = 0; q < 2; ++q) {
            const int id = 2 * w + q, ct = id >> 2, st = id & 3;
            if (st <= ct) {
                f32x4 acc = (f32x4){0.f, 0.f, 0.f, 0.f};
#pragma unroll
                for (int ks = 0; ks < 4; ++ks) {
                    const bf16x8 a = *(const LAS bf16x8*)(lds + GP_KN + (16 * ct + fr) * GP_KP + (32 * ks + 8 * fq) * 2);
                    const bf16x8 bb = *(const LAS bf16x8*)(lds + GP_KN + (16 * st + fr) * GP_KP + (32 * ks + 8 * fq) * 2);
                    acc = __builtin_amdgcn_mfma_f32_16x16x32_bf16(a, bb, acc, 0, 0, 0);
                }
                const int s = 16 * st + fr; const float gs = gc_s[s];
#pragma unroll
                for (int r = 0; r < 4; ++r) { const int c = 16 * ct + 4 * fq + r;
                    Lm[c * GP_LP + s] = (s < c) ? beta_s[c] * acc[r] * __expf(fminf(gc_s[c] - gs, 0.f)) : 0.f; }
            }
        }
        __syncthreads();
        if (w < 2) {
            const int o = 32 * w;
            float t[32];
            int zoff = 0; asm volatile("" : "+v"(zoff));
            const LAS float* Lz = Lm + zoff + o * GP_LP + o;
            const int col = lane & 31;
#pragma unroll
            for (int i = 0; i < 32; ++i) {
                float a0 = (i == lane) ? 1.f : 0.f, a1 = 0.f, a2 = 0.f, a3 = 0.f;
#pragma unroll
                for (int s4 = 0; s4 + 4 <= i; s4 += 4) { const f32x4 lv = *(const LAS f32x4*)(Lz + i * GP_LP + s4);
                    a0 -= lv[0] * t[s4]; a1 -= lv[1] * t[s4 + 1]; a2 -= lv[2] * t[s4 + 2]; a3 -= lv[3] * t[s4 + 3]; }
#pragma unroll
                for (int s = i & ~3; s < i; ++s) a0 -= Lz[i * GP_LP + s] * t[s];
                t[i] = (lane < 32) ? (a0 + a1) + (a2 + a3) : 0.f;
                const bf16 tb = (bf16)f2bf(t[i]);
                if (w == 0) { *(LAS bf16*)(lds + GP_TB + i * GP_TP + lane * 2) = tb;
                              if (lane < 32) *(LAS bf16*)(lds + GP_T0T + lane * 80 + i * 2) = tb; }
                else if (lane < 32) *(LAS bf16*)(lds + GP_TB + (32 + i) * GP_TP + (32 + col) * 2) = tb;
                if ((i & 3) == 3) __builtin_amdgcn_sched_barrier(0);
            }
        } else {
            for (int id = w - 2; id < 16; id += 6) {
                const int ct = id >> 2, st = id & 3;
                f32x4 acc = (f32x4){0.f, 0.f, 0.f, 0.f};
                if (st <= ct) {
#pragma unroll
                    for (int ks = 0; ks < 4; ++ks) {
                        const bf16x8 a = *(const LAS bf16x8*)(lds + GP_QN + (16 * ct + fr) * GP_KP + (32 * ks + 8 * fq) * 2);
                        const bf16x8 bb = *(const LAS bf16x8*)(lds + GP_KN + (16 * st + fr) * GP_KP + (32 * ks + 8 * fq) * 2);
                        acc = __builtin_amdgcn_mfma_f32_16x16x32_bf16(a, bb, acc, 0, 0, 0);
                    }
                }
                const int s = 16 * st + fr; const float gs = gc_s[s]; const int ps = perm_pos(s);
#pragma unroll
                for (int r = 0; r < 4; ++r) { const int c = 16 * ct + 4 * fq + r;
                    const float v = (s <= c) ? acc[r] * __expf(fminf(gc_s[c] - gs, 0.f)) : 0.f;
                    AIP[((size_t)item * 64 + c) * 64 + ps] = (bf16)f2bf(v); }
            }
        }
        __syncthreads();
        if (w == 0) {
            f32x4 P[2][2];
#pragma unroll
            for (int it = 0; it < 2; ++it) {
                const LAS float* lr = Lm + (32 + 16 * it + fr) * GP_LP + 8 * fq;
                const f32x4 l0 = *(const LAS f32x4*)lr, l1 = *(const LAS f32x4*)(lr + 4);
                u32x4 pk; pk.x = cvtpk(l0[0], l0[1]); pk.y = cvtpk(l0[2], l0[3]); pk.z = cvtpk(l1[0], l1[1]); pk.w = cvtpk(l1[2], l1[3]);
                const bf16x8 a = __builtin_bit_cast(bf16x8, pk);
#pragma unroll
                for (int jt = 0; jt < 2; ++jt) {
                    const bf16x8 bb = *(const LAS bf16x8*)(lds + GP_T0T + (16 * jt + fr) * 80 + 16 * fq);
                    P[it][jt] = __builtin_amdgcn_mfma_f32_16x16x32_bf16(a, bb, (f32x4){0.f, 0.f, 0.f, 0.f}, 0, 0, 0);
                }
            }
#pragma unroll
            for (int jt = 0; jt < 2; ++jt) {
                u32x4 pk; pk.x = cvtpk(P[0][jt][0], P[0][jt][1]); pk.y = cvtpk(P[0][jt][2], P[0][jt][3]); pk.z = cvtpk(P[1][jt][0], P[1][jt][1]); pk.w = cvtpk(P[1][jt][2], P[1][jt][3]);
                const bf16x8 pb = __builtin_bit_cast(bf16x8, pk);
#pragma unroll
                for (int i2 = 0; i2 < 2; ++i2) {
                    const LAS unsigned char* tr = lds + GP_TB + (32 + 16 * i2 + fr) * GP_TP + (32 + 4 * fq) * 2;
                    const u32x2 ta = *(const LAS u32x2*)tr, tb2 = *(const LAS u32x2*)(tr + 32);
                    u32x4 ak; ak.x = ta.x; ak.y = ta.y; ak.z = tb2.x; ak.w = tb2.y;
                    const f32x4 r = __builtin_amdgcn_mfma_f32_16x16x32_bf16(__builtin_bit_cast(bf16x8, ak), pb, (f32x4){0.f, 0.f, 0.f, 0.f}, 0, 0, 0);
#pragma unroll
                    for (int q = 0; q < 4; ++q) *(LAS bf16*)(lds + GP_TB + (32 + 16 * i2 + 4 * fq + q) * GP_TP + (16 * jt + fr) * 2) = (bf16)f2bf(-r[q]);
                }
            }
        }
        __syncthreads();
#pragma unroll
        for (int q = 0; q < 2; ++q) {
            const int colt = 2 * w + q;
            bf16x8 af[2];
#pragma unroll
            for (int ks = 0; ks < 2; ++ks) af[ks] = *(const LAS bf16x8*)(lds + GP_RT + (16 * colt + fr) * GP_RP + (32 * ks + 8 * fq) * 2);
#pragma unroll
            for (int ct = 0; ct < 4; ++ct) {
                f32x4 acc = (f32x4){0.f, 0.f, 0.f, 0.f};
#pragma unroll
                for (int ks = 0; ks < 2; ++ks) {
                    const bf16x8 bb = *(const LAS bf16x8*)(lds + GP_TB + (16 * ct + fr) * GP_TP + (32 * ks + 8 * fq) * 2);
                    acc = __builtin_amdgcn_mfma_f32_16x16x32_bf16(af[ks], bb, acc, 0, 0, 0);
                }
                const int c = 16 * ct + fr;
                if (colt < 8) {
#pragma unroll
                    for (int r = 0; r < 4; ++r) UT[((size_t)item * 128 + 16 * colt + 4 * fq + r) * 64 + c] = (bf16)f2bf(acc[r]);
                } else {
                    const int kt = colt - 8;
                    u32x2 h2; h2.x = pk2(-acc[0], -acc[1]); h2.y = pk2(-acc[2], -acc[3]);
                    *(u32x2*)(WP + ((size_t)item * 64 + c) * 128 + 32 * (kt >> 1) + 8 * fq + 4 * (kt & 1)) = h2;
                }
            }
        }
    }
    __syncthreads();
}

constexpr int GS_WP = 0, GS_QD = 17408, GS_AIP = 34816, GS_KDT = 44032, GS_BUF = 62464, GS_OB = 2 * GS_BUF, GS_OBP = 272;
__device__ void phase_gdn_scan(const Params& p, int L, LAS unsigned char* lds, int bid, int nblk) {
    const int tid = tidx(), lane = tid & 63, w = __builtin_amdgcn_readfirstlane(tid >> 6), fr = lane & 15, fq = lane >> 4;
    const bf16* proj = (const bf16*)(p.ws + WS_PROJ);
    const bf16* WP = (const bf16*)(p.ws + GD_WP); const bf16* QD = (const bf16*)(p.ws + GD_QD); const bf16* AIP = (const bf16*)(p.ws + GD_AIP);
    const bf16* KDT = (const bf16*)(p.ws + GD_KDT); const bf16* UT = (const bf16*)(p.ws + GD_UT); const float* GL = (const float*)(p.ws + GD_GL);
    bf16* obuf = (bf16*)(p.ws + WS_OBUF);
    for (int item = bid; item < 32; item += nblk) {
        const int hh = item & 3, b = item >> 2;
        const int fc = tid >> 4, fv = tid & 15;
        float gn[8];
#pragma unroll
        for (int i = 0; i < 8; ++i) gn[i] = p.gdn_norm_g[L * 128 + 8 * fv + i];
        f32x4 S[8];
#pragma unroll
        for (int kt = 0; kt < 8; ++kt) S[kt] = (f32x4){0.f, 0.f, 0.f, 0.f};
        u32x4 st[7];
        auto gload = [&](int ci) {
#pragma unroll
            for (int i = 0; i < 7; ++i) {
                const int pc = tid + 512 * i;
                const bf16* src;
                if (i < 2) src = WP + (size_t)ci * 8192 + pc * 8;
                else if (i < 4) src = QD + (size_t)ci * 8192 + (pc - 1024) * 8;
                else if (i < 5) src = AIP + (size_t)ci * 4096 + (pc - 2048) * 8;
                else src = KDT + (size_t)ci * 8192 + (pc - 2560) * 8;
                st[i] = *(const u32x4*)src;
            }
        };
        auto lstore = [&](int buf) {
#pragma unroll
            for (int i = 0; i < 7; ++i) {
                const int pc = tid + 512 * i;
                int off;
                if (i < 2) off = GS_WP + (pc >> 4) * 272 + (pc & 15) * 16;
                else if (i < 4) { const int q = pc - 1024; off = GS_QD + (q >> 4) * 272 + (q & 15) * 16; }
                else if (i < 5) { const int q = pc - 2048; off = GS_AIP + (q >> 3) * 144 + (q & 7) * 16; }
                else { const int q = pc - 2560; off = GS_KDT + (q >> 3) * 144 + (q & 7) * 16; }
                *(LAS u32x4*)(lds + buf * GS_BUF + off) = st[i];
            }
        };
        __syncthreads();
        gload(item * 32); lstore(0);
        u32x2 ut[4]; float gl;
        {
            const int ci = item * 32;
#pragma unroll
            for (int ct = 0; ct < 4; ++ct) ut[ct] = *(const u32x2*)(UT + ((size_t)ci * 128 + 16 * w + fr) * 64 + 16 * ct + 4 * fq);
            gl = GL[ci];
        }
        __syncthreads();
        for (int n = 0; n < 32; ++n) {
            const int ci = item * 32 + n, buf = n & 1;
            const size_t rowc = (size_t)b * SEQ + n * 64;
            u32x2 utn[4]; float gln = 0.f;
            if (n + 1 < 32) {
                gload(ci + 1);
#pragma unroll
                for (int ct = 0; ct < 4; ++ct) utn[ct] = *(const u32x2*)(UT + ((size_t)(ci + 1) * 128 + 16 * w + fr) * 64 + 16 * ct + 4 * fq);
                gln = GL[ci + 1];
            }
            u32x4 zq[2];
#pragma unroll
            for (int ps = 0; ps < 2; ++ps) zq[ps] = *(const u32x4*)(proj + (rowc + 32 * ps + fc) * PROJ_W + 3072 + hh * 128 + 8 * fv);
            f32x4 vn[4], oacc[4];
#pragma unroll
            for (int ct = 0; ct < 4; ++ct) { vn[ct] = (f32x4){lo16(ut[ct].x), hi16(ut[ct].x), lo16(ut[ct].y), hi16(ut[ct].y)}; oacc[ct] = (f32x4){0.f, 0.f, 0.f, 0.f}; }
            bf16x8 sb[4];
#pragma unroll
            for (int ks = 0; ks < 4; ++ks) { u32x4 pk; pk.x = cvtpk(S[2 * ks][0], S[2 * ks][1]); pk.y = cvtpk(S[2 * ks][2], S[2 * ks][3]); pk.z = cvtpk(S[2 * ks + 1][0], S[2 * ks + 1][1]); pk.w = cvtpk(S[2 * ks + 1][2], S[2 * ks + 1][3]);
                sb[ks] = __builtin_bit_cast(bf16x8, pk); }
            LAS unsigned char* bb = lds + buf * GS_BUF;
            bf16x8 f0[8], f1[8];
#define LD_A(F, ct) do { _Pragma("unroll") for (int ks = 0; ks < 4; ++ks) { F[ks] = *(const LAS bf16x8*)(bb + GS_WP + (16 * (ct) + fr) * 272 + (32 * ks + 8 * fq) * 2); \
                    F[4 + ks] = *(const LAS bf16x8*)(bb + GS_QD + (16 * (ct) + fr) * 272 + (32 * ks + 8 * fq) * 2); } } while (0)
#define MM_A(F, ct) do { _Pragma("unroll") for (int ks = 0; ks < 4; ++ks) { vn[ct] = __builtin_amdgcn_mfma_f32_16x16x32_bf16(F[ks], sb[ks], vn[ct], 0, 0, 0); \
                    oacc[ct] = __builtin_amdgcn_mfma_f32_16x16x32_bf16(F[4 + ks], sb[ks], oacc[ct], 0, 0, 0); } } while (0)
#define SBAR() __builtin_amdgcn_sched_barrier(0)
            LD_A(f0, 0); SBAR();
            LD_A(f1, 1); MM_A(f0, 0); SBAR();
            LD_A(f0, 2); MM_A(f1, 1); SBAR();
            LD_A(f1, 3); MM_A(f0, 2); SBAR();
#pragma unroll
            for (int ct = 0; ct < 4; ++ct)
#pragma unroll
                for (int ss = 0; ss < 2; ++ss) f0[2 * ct + ss] = *(const LAS bf16x8*)(bb + GS_AIP + (16 * ct + fr) * 144 + (32 * ss + 8 * fq) * 2);
            MM_A(f1, 3); SBAR();
            bf16x8 vb[2];
#pragma unroll
            for (int ss = 0; ss < 2; ++ss) { u32x4 pk; pk.x = cvtpk(vn[2 * ss][0], vn[2 * ss][1]); pk.y = cvtpk(vn[2 * ss][2], vn[2 * ss][3]); pk.z = cvtpk(vn[2 * ss + 1][0], vn[2 * ss + 1][1]); pk.w = cvtpk(vn[2 * ss + 1][2], vn[2 * ss + 1][3]);
                vb[ss] = __builtin_bit_cast(bf16x8, pk); }
#pragma unroll
            for (int kt = 0; kt < 4; ++kt)
#pragma unroll
                for (int ss = 0; ss < 2; ++ss) f1[2 * kt + ss] = *(const LAS bf16x8*)(bb + GS_KDT + (16 * kt + fr) * 144 + (32 * ss + 8 * fq) * 2);
#pragma unroll
            for (int ct = 0; ct < 4; ++ct)
#pragma unroll
                for (int ss = 0; ss < 2; ++ss) oacc[ct] = __builtin_amdgcn_mfma_f32_16x16x32_bf16(f0[2 * ct + ss], vb[ss], oacc[ct], 0, 0, 0);
            SBAR();
#pragma unroll
            for (int kt = 4; kt < 8; ++kt)
#pragma unroll
                for (int ss = 0; ss < 2; ++ss) f0[2 * (kt - 4) + ss] = *(const LAS bf16x8*)(bb + GS_KDT + (16 * kt + fr) * 144 + (32 * ss + 8 * fq) * 2);
#pragma unroll
            for (int kt = 0; kt < 4; ++kt) {
                S[kt] = S[kt] * gl;
#pragma unroll
                for (int ss = 0; ss < 2; ++ss) S[kt] = __builtin_amdgcn_mfma_f32_16x16x32_bf16(f1[2 * kt + ss], vb[ss], S[kt], 0, 0, 0);
            }
            SBAR();
#pragma unroll
            for (int kt = 4; kt < 8; ++kt) {
                S[kt] = S[kt] * gl;
#pragma unroll
                for (int ss = 0; ss < 2; ++ss) S[kt] = __builtin_amdgcn_mfma_f32_16x16x32_bf16(f0[2 * (kt - 4) + ss], vb[ss], S[kt], 0, 0, 0);
            }
#undef LD_A
#undef MM_A
#undef SBAR
            LDS_BARRIER();
#pragma unroll
            for (int ct = 0; ct < 4; ++ct)
#pragma unroll
                for (int r = 0; r < 4; r += 2) {
                    const unsigned pk = cvtpk(oacc[ct][r], oacc[ct][r + 1]);
                    *(LAS bf16*)(lds + GS_OB + (16 * ct + 4 * fq + r) * GS_OBP + (16 * w + fr) * 2) = (bf16)(pk & 0xffffu);
                    *(LAS bf16*)(lds + GS_OB + (16 * ct + 4 * fq + r + 1) * GS_OBP + (16 * w + fr) * 2) = (bf16)(pk >> 16);
                }
            if (n + 1 < 32) {
                lstore(buf ^ 1);
#pragma unroll
                for (int ct = 0; ct < 4; ++ct) ut[ct] = utn[ct];
                gl = gln;
            }
            LDS_BARRIER();
#pragma unroll
            for (int ps = 0; ps < 2; ++ps) {
                const int c = 32 * ps + fc;
                const u32x4 ov = *(const LAS u32x4*)(lds + GS_OB + c * GS_OBP + fv * 16);
                float o8[8];
#pragma unroll
                for (int i = 0; i < 4; ++i) { o8[2 * i] = lo16(ov[i]); o8[2 * i + 1] = hi16(ov[i]); }
                float ss = 0.f;
#pragma unroll
                for (int i = 0; i < 8; ++i) ss += o8[i] * o8[i];
                const float rn = rsqrtf(row16_sum(ss) * (1.f / 128.f) + EPS);
                u32x4 res;
#pragma unroll
                for (int i = 0; i < 4; ++i) {
                    const float z0 = lo16(zq[ps][i]), z1 = hi16(zq[ps][i]);
                    res[i] = cvtpk(o8[2 * i] * rn * gn[2 * i] * (z0 * sigmoidf_(z0)), o8[2 * i + 1] * rn * gn[2 * i + 1] * (z1 * sigmoidf_(z1)));
                }
                *(u32x4*)(obuf + (rowc + c) * D + 512 + hh * 128 + 8 * fv) = res;
            }
        }
        __syncthreads();
    }
}

__device__ __forceinline__ unsigned sortable(float f) { const unsigned u = __float_as_uint(f); return u ^ ((unsigned)((int)u >> 31) | 0x80000000u); }
__device__ __forceinline__ float unsortable(unsigned s) { return __uint_as_float((s & 0x80000000u) ? (s ^ 0x80000000u) : ~s); }
#define CE(a, b) do { const unsigned _x = k[a], _y = k[b]; k[a] = _x > _y ? _x : _y; k[b] = _x > _y ? _y : _x; } while (0)
constexpr int PE_TK = 0, PE_TAB = 8192, PE_ID = 8448, PE_GT = PE_ID + 32768, PE_SK = PE_GT + 32768;
__device__ void phase_peer(const Params& p, int L, LAS unsigned char* lds, int bid, int nblk) {
    const int tid = tidx(), lane = tid & 63, w = __builtin_amdgcn_readfirstlane(tid >> 6), fr = lane & 15, fq = lane >> 4;
    const bf16* Q2 = (const bf16*)(p.ws + WS_Q2);
    const bf16* SK = (const bf16*)(p.ws + WS_SK) + (size_t)L * 8 * 2 * 128 * 128;
    float* H = (float*)(p.ws + WS_H); bf16* HB2 = (bf16*)(p.ws + WS_HB2);
    const unsigned char* U = p.ws + WS_U + (size_t)L * NEXP * D;
    const unsigned char* V = p.ws + WS_V + (size_t)L * NEXP * D;
    const float* SU = (const float*)(p.ws + WS_SU) + (size_t)L * NEXP; const float* SV = (const float*)(p.ws + WS_SV) + (size_t)L * NEXP;
    const float* g = p.ln_ffn_g + L * D;
    LAS unsigned* TK = (LAS unsigned*)(lds + PE_TK);
    LAS unsigned short* TAB = (LAS unsigned short*)(lds + PE_TAB);
    LAS int* IDL = (LAS int*)(lds + PE_ID); LAS float* GTL = (LAS float*)(lds + PE_GT);
    if (tid < 64) {
        int a = 0, base = 0, q = tid; unsigned short v = 0xffff;
        if (q < 50) { for (;;) { const int cnt = 16 / (a + 1); if (q < base + cnt) break; base += cnt; ++a; } v = (unsigned short)((a << 8) | (q - base)); }
        TAB[tid] = v;
    }
    for (int item = bid; item < M / 64; item += nblk) {
        const int tok0 = item * 64;
        __syncthreads();
        const int tg = w & 3, cc = w >> 2;
#define SK_FETCH(hd) do { _Pragma("unroll") for (int i = 0; i < 8; ++i) { const int pc = tid + 512 * i, nn = (pc >> 4) & 127; \
            __builtin_amdgcn_global_load_lds((const unsigned*)(SK + ((size_t)((hd) * 2 + (pc >> 11)) * 128 + nn) * 128 + (((pc & 15) ^ (nn & 15)) * 8)), \
                                             (LAS unsigned*)(lds + PE_SK + (w * 64 + 512 * i) * 16), 16, 0, 0); } } while (0)
        SK_FETCH(0);
        asm volatile("s_waitcnt vmcnt(0)" ::: "memory");
        __syncthreads();
        for (int hh = 0; hh < 8; ++hh) {
            {
                f32x4 acc[8];
#pragma unroll
                for (int nt = 0; nt < 8; ++nt) acc[nt] = (f32x4){0.f, 0.f, 0.f, 0.f};
                bf16x8 qa[4];
#pragma unroll
                for (int ks = 0; ks < 4; ++ks) qa[ks] = *(const bf16x8*)(Q2 + (size_t)(tok0 + 16 * tg + fr) * 2048 + hh * 256 + cc * 128 + 32 * ks + 8 * fq);
                const LAS unsigned char* skb = lds + PE_SK + cc * 32768 + fr * 256;
#pragma unroll
                for (int nt = 0; nt < 8; ++nt)
#pragma unroll
                    for (int ks = 0; ks < 4; ++ks) {
                        const bf16x8 kb = *(const LAS bf16x8*)(skb + nt * 4096 + (((4 * ks + fq) ^ fr) << 4));
                        acc[nt] = __builtin_amdgcn_mfma_f32_16x16x32_bf16(qa[ks], kb, acc[nt], 0, 0, 0);
                    }
#pragma unroll
                for (int r = 0; r < 4; ++r) {
                    unsigned k[8];
#pragma unroll
                    for (int nt = 0; nt < 8; ++nt) k[nt] = (sortable(acc[nt][r]) & ~0x7Fu) | (unsigned)(127 - (16 * nt + fr));
                    CE(0, 1); CE(2, 3); CE(4, 5); CE(6, 7); CE(0, 2); CE(1, 3); CE(4, 6); CE(5, 7); CE(1, 2); CE(5, 6); CE(0, 4); CE(3, 7);
                    CE(1, 5); CE(2, 6); CE(1, 4); CE(3, 6); CE(2, 4); CE(3, 5); CE(3, 4);
                    unsigned res = 0u;
#pragma unroll
                    for (int rd = 0; rd < 16; ++rd) {
                        const unsigned m = row16_umax(k[0]);
                        const bool win = k[0] == m;
#pragma unroll
                        for (int i = 0; i < 7; ++i) k[i] = win ? k[i + 1] : k[i];
                        k[7] = win ? 0u : k[7];
                        res = (fr == rd) ? m : res;
                    }
                    TK[(cc * 64 + 16 * tg + 4 * fq + r) * 16 + fr] = res;
                }
            }
            __syncthreads();
            if (hh + 1 < 8) SK_FETCH(hh + 1);
#pragma unroll
            for (int ps = 0; ps < 2; ++ps) {
                const int tl = 8 * w + 4 * ps + fq;
                unsigned k[4];
#pragma unroll
                for (int sl = 0; sl < 4; ++sl) {
                    const int q = sl * 16 + fr;
                    const unsigned ab = TAB[q];
                    const unsigned k1 = TK[tl * 16 + ((ab >> 8) & 15)], k2 = TK[(64 + tl) * 16 + (ab & 15)];
                    const float v = unsortable(k1 & ~0x7Fu) + unsortable(k2 & ~0x7Fu);
                    k[sl] = (q < 50) ? ((sortable(v) & ~0x3Fu) | (unsigned)(63 - q)) : 0u;
                }
                CE(0, 1); CE(2, 3); CE(0, 2); CE(1, 3); CE(1, 2);
                unsigned res = 0u;
#pragma unroll
                for (int rd = 0; rd < 16; ++rd) {
                    const unsigned m = row16_umax(k[0]);
                    const bool win = k[0] == m;
                    k[0] = win ? k[1] : k[0]; k[1] = win ? k[2] : k[1]; k[2] = win ? k[3] : k[2]; k[3] = win ? 0u : k[3];
                    res = (fr == rd) ? m : res;
                }
                const unsigned ab = TAB[63 - (res & 0x3Fu)];
                const unsigned k1 = TK[tl * 16 + ((ab >> 8) & 15)], k2 = TK[(64 + tl) * 16 + (ab & 15)];
                const float v = unsortable(k1 & ~0x7Fu) + unsortable(k2 & ~0x7Fu);
                const float e = __expf(v - row16_max(v));
                const float sum = row16_sum(e);
                IDL[tl * 128 + hh * 16 + fr] = (int)((127u - (k1 & 0x7Fu)) * 128u + (127u - (k2 & 0x7Fu)));
                GTL[tl * 128 + hh * 16 + fr] = e * __builtin_amdgcn_rcpf(sum);
            }
            asm volatile("s_waitcnt vmcnt(0)" ::: "memory");
            __syncthreads();
        }
#undef SK_FETCH
        for (int ti = 0; ti < 8; ++ti) {
            const int tl = 8 * w + ti;
            unsigned k0 = ((unsigned)IDL[tl * 128 + lane] << 7) | (unsigned)lane, k1 = ((unsigned)IDL[tl * 128 + 64 + lane] << 7) | (unsigned)(64 + lane);
#pragma unroll
            for (int kk = 2; kk <= 128; kk <<= 1) {
#pragma unroll
                for (int j = kk >> 1; j >= 1; j >>= 1) {
                    if (j == 64) { const unsigned lo = k0 < k1 ? k0 : k1, hi = k0 < k1 ? k1 : k0; k0 = lo; k1 = hi; }
                    else {
                        const unsigned p0 = (unsigned)__shfl_xor((int)k0, j), p1 = (unsigned)__shfl_xor((int)k1, j);
                        const bool up0 = ((lane & kk) == 0) || kk == 128, up1 = (((lane + 64) & kk) == 0);
                        const bool low = (lane & j) == 0;
                        k0 = (low == up0) ? (k0 < p0 ? k0 : p0) : (k0 > p0 ? k0 : p0);
                        k1 = (low == (kk == 128 ? true : up1)) ? (k1 < p1 ? k1 : p1) : (k1 > p1 ? k1 : p1);
                    }
                }
            }
            const float g0 = GTL[tl * 128 + (k0 & 127u)], g1 = GTL[tl * 128 + (k1 & 127u)];
            asm volatile("s_waitcnt lgkmcnt(0)" ::: "memory");
            IDL[tl * 128 + lane] = (int)(k0 >> 7); IDL[tl * 128 + 64 + lane] = (int)(k1 >> 7);
            GTL[tl * 128 + lane] = g0; GTL[tl * 128 + 64 + lane] = g1;
        }
        __syncthreads();
        for (int ti = 0; ti < 8; ++ti) {
            const int tl = 8 * w + ti, tok = tok0 + tl;
            const float* hrow = H + (size_t)tok * D + 4 * lane;
            float xn[16];
#pragma unroll
            for (int j = 0; j < 4; ++j) { const f32x4 a = *(const f32x4*)(hrow + 256 * j); xn[4 * j] = a[0]; xn[4 * j + 1] = a[1]; xn[4 * j + 2] = a[2]; xn[4 * j + 3] = a[3]; }
            float ss = 0.f;
#pragma unroll
            for (int i = 0; i < 16; ++i) ss += xn[i] * xn[i];
            const float rstd = rsqrtf(wave_sum(ss) * (1.f / D) + EPS);
            float mx = 0.f;
#pragma unroll
            for (int i = 0; i < 16; ++i) { xn[i] = xn[i] * rstd * g[256 * (i >> 2) + 4 * lane + (i & 3)]; mx = fmaxf(mx, fabsf(xn[i])); }
            mx = xrow16_max(row16_max(mx));
            const float xinv = mx > 0.f ? 127.f / mx : 0.f, sx = mx * (1.f / 127.f);
            int xq[4];
#pragma unroll
            for (int j = 0; j < 4; ++j) xq[j] = (int)(((unsigned)__float2int_rn(xn[4 * j] * xinv) & 0xffu) | (((unsigned)__float2int_rn(xn[4 * j + 1] * xinv) & 0xffu) << 8) |
                                                      (((unsigned)__float2int_rn(xn[4 * j + 2] * xinv) & 0xffu) << 16) | ((unsigned)__float2int_rn(xn[4 * j + 3] * xinv) << 24));
            const int id0 = IDL[tl * 128 + lane], id1 = IDL[tl * 128 + 64 + lane];
            const float su0 = SU[id0], su1 = SU[id1], sv0 = SV[id0], sv1 = SV[id1];
            int h0i = 0, h1i = 0;
            u32x4 ring[16];
#pragma unroll
            for (int j = 0; j < 16; ++j) ring[j] = *(const u32x4*)(U + (size_t)IDL[tl * 128 + j] * D + 16 * lane);
#pragma unroll 1
            for (int k = 0; k < 8; ++k) {
#pragma unroll
                for (int j = 0; j < 16; ++j) {
                    const u32x4 a = ring[j];
                    if (k < 7) ring[j] = *(const u32x4*)(U + (size_t)IDL[tl * 128 + 16 * (k + 1) + j] * D + 16 * lane);
                    int d = __builtin_amdgcn_sdot4((int)a[0], xq[0], 0, false);
                    d = __builtin_amdgcn_sdot4((int)a[1], xq[1], d, false); d = __builtin_amdgcn_sdot4((int)a[2], xq[2], d, false); d = __builtin_amdgcn_sdot4((int)a[3], xq[3], d, false);
                    d = wave_isum(d);
                    const int e = 16 * k + j;
                    if (lane == (e & 63)) { if (k < 4) h0i = d; else h1i = d; }
                }
            }
            const float h0 = su0 * sx * (float)h0i, h1 = su1 * sx * (float)h1i;
            GTL[tl * 128 + lane] = sv0 * GTL[tl * 128 + lane] * gelu_erf(h0);
            GTL[tl * 128 + 64 + lane] = sv1 * GTL[tl * 128 + 64 + lane] * gelu_erf(h1);
        }
        for (int ti = 0; ti < 8; ++ti) {
            const int tl = 8 * w + ti, tok = tok0 + tl;
            float* hrow = H + (size_t)tok * D + 4 * lane;
            float xv[16];
#pragma unroll
            for (int j = 0; j < 4; ++j) { const f32x4 a = *(const f32x4*)(hrow + 256 * j); xv[4 * j] = a[0]; xv[4 * j + 1] = a[1]; xv[4 * j + 2] = a[2]; xv[4 * j + 3] = a[3]; }
            const float w0 = GTL[tl * 128 + lane], w1 = GTL[tl * 128 + 64 + lane];
            const float wmx = xrow16_max(row16_max(fmaxf(fabsf(w0), fabsf(w1))));
            const float winv = wmx > 0.f ? 127.f / wmx : 0.f, sw = wmx * (1.f / 127.f);
            const f32x4 wv = *(const LAS f32x4*)(GTL + tl * 128 + 4 * (lane & 31));
            const int wq = (int)(((unsigned)__float2int_rn(wv[0] * winv) & 0xffu) | (((unsigned)__float2int_rn(wv[1] * winv) & 0xffu) << 8) |
                                 (((unsigned)__float2int_rn(wv[2] * winv) & 0xffu) << 16) | ((unsigned)__float2int_rn(wv[3] * winv) << 24));
            int yi[16];
#pragma unroll
            for (int i = 0; i < 16; ++i) yi[i] = 0;
            u32x4 ring[16];
#pragma unroll
            for (int j = 0; j < 16; ++j) ring[j] = *(const u32x4*)(V + (size_t)IDL[tl * 128 + j] * D + 16 * lane);
#pragma unroll 1
            for (int k = 0; k < 8; ++k) {
#pragma unroll
                for (int g4 = 0; g4 < 4; ++g4) {
                    const u32x4 a0 = ring[4 * g4], a1 = ring[4 * g4 + 1], a2 = ring[4 * g4 + 2], a3 = ring[4 * g4 + 3];
                    if (k < 7) {
#pragma unroll
                        for (int q = 0; q < 4; ++q) ring[4 * g4 + q] = *(const u32x4*)(V + (size_t)IDL[tl * 128 + 16 * (k + 1) + 4 * g4 + q] * D + 16 * lane);
                    }
                    const int wg = __builtin_amdgcn_readlane(wq, 4 * k + g4);
#pragma unroll
                    for (int q = 0; q < 4; ++q) {
                        const unsigned p0 = __builtin_amdgcn_perm(a1[q], a0[q], 0x05010400u), p1 = __builtin_amdgcn_perm(a1[q], a0[q], 0x07030602u);
                        const unsigned p2 = __builtin_amdgcn_perm(a3[q], a2[q], 0x05010400u), p3 = __builtin_amdgcn_perm(a3[q], a2[q], 0x07030602u);
                        yi[4 * q] = __builtin_amdgcn_sdot4((int)__builtin_amdgcn_perm(p2, p0, 0x05040100u), wg, yi[4 * q], false);
                        yi[4 * q + 1] = __builtin_amdgcn_sdot4((int)__builtin_amdgcn_perm(p2, p0, 0x07060302u), wg, yi[4 * q + 1], false);
                        yi[4 * q + 2] = __builtin_amdgcn_sdot4((int)__builtin_amdgcn_perm(p3, p1, 0x05040100u), wg, yi[4 * q + 2], false);
                        yi[4 * q + 3] = __builtin_amdgcn_sdot4((int)__builtin_amdgcn_perm(p3, p1, 0x07060302u), wg, yi[4 * q + 3], false);
                    }
                }
            }
            float y[16];
#pragma unroll
            for (int i = 0; i < 16; ++i) y[i] = xv[i] + sw * (float)yi[i];
#pragma unroll
            for (int j = 0; j < 4; ++j) *(f32x4*)(hrow + 256 * j) = (f32x4){y[4 * j], y[4 * j + 1], y[4 * j + 2], y[4 * j + 3]};
            bf16* hb = HB2 + (size_t)tok * D + 4 * lane;
#pragma unroll
            for (int j = 0; j < 4; ++j) { u32x2 o2; o2.x = pk2(y[4 * j], y[4 * j + 1]); o2.y = pk2(y[4 * j + 2], y[4 * j + 3]); *(u32x2*)(hb + 256 * j) = o2; }
        }
    }
    __syncthreads();
}
#undef CE

__device__ void phase_final(const Params& p, int bid, int nblk) {
    const int tid = tidx(), lane = tid & 63, gw = bid * NWAVES + (tid >> 6), NGW = nblk * NWAVES;
    const float* H = (const float*)(p.ws + WS_H);
    for (int m = gw; m < M; m += NGW) {
        f32x4 v[4]; float ss = 0.f;
#pragma unroll
        for (int j = 0; j < 4; ++j) { v[j] = ((const f32x4*)(H + (size_t)m * D))[lane + 64 * j]; ss += (v[j][0] * v[j][0] + v[j][1] * v[j][1]) + (v[j][2] * v[j][2] + v[j][3] * v[j][3]); }
        const float r = rsqrtf(wave_sum(ss) * (1.f / D) + EPS);
#pragma unroll
        for (int j = 0; j < 4; ++j) { const f32x4 gv = ((const f32x4*)p.final_g)[lane + 64 * j]; ((f32x4*)(p.out + (size_t)m * D))[lane + 64 * j] = v[j] * r * gv; }
    }
}

#define XB_TMO      128
#define XB_XCNT(j)  (256  + 64 * (j))
#define XB_XSUB(j)  (1280 + 64 * (j))
#define XB_XGEN(j)  (2304 + 64 * (j))
#define XB_TOP      3328
#define XB_TOPGEN   3392
#define XCD_BAR_WORDS 3456
#define XB_SPIN_CAP (1u << 22)
__device__ __forceinline__ unsigned xb_ld(unsigned* p)              { return __hip_atomic_load(p, __ATOMIC_RELAXED, __HIP_MEMORY_SCOPE_AGENT); }
__device__ __forceinline__ unsigned xb_add(unsigned* p, unsigned v) { return __hip_atomic_fetch_add(p, v, __ATOMIC_RELAXED, __HIP_MEMORY_SCOPE_AGENT); }
__device__ __forceinline__ unsigned xb_xcc_id() { return (unsigned)__builtin_amdgcn_s_getreg((3 << 11) | 20) & 0xFu; }
#define XB_SPIN(cond, bar) do { unsigned _sp = 0; while (cond) { __builtin_amdgcn_s_sleep(1); \
    if ((++_sp & 255u) == 0u) { if (xb_ld(&(bar)[XB_TMO])) break; if (_sp > XB_SPIN_CAP) { atomicAdd(&(bar)[XB_TMO], 1u); break; } } } } while (0)
struct XcdBarrier { unsigned* bar; unsigned x; volatile LAS unsigned* st; };
__device__ __forceinline__ XcdBarrier xcd_barrier_post(unsigned* bar, volatile LAS unsigned* st) {
    XcdBarrier b; b.bar = bar; b.x = xb_xcc_id(); b.st = st;
    if (threadIdx.x == 0) (void)xb_add(&bar[XB_XCNT(b.x)], 1u);
    return b;
}
__device__ __forceinline__ void xcd_barrier_complete(unsigned* bar, unsigned x, unsigned& nloc, unsigned& nx) {
    const unsigned G = gridDim.x * gridDim.y * gridDim.z;
    unsigned sum, cnt, mine, sp = 0u;
    for (;;) {
        sum = 0u; cnt = 0u; mine = 0u;
#pragma unroll
        for (unsigned j = 0; j < 16; ++j) { const unsigned c = xb_ld(&bar[XB_XCNT(j)]); sum += c; cnt += (c > 0u) ? 1u : 0u; mine = (j == x) ? c : mine; }
        if (sum == G) break;
        __builtin_amdgcn_s_sleep(1);
        if ((++sp & 255u) == 0u) { if (xb_ld(&bar[XB_TMO])) break; if (sp > XB_SPIN_CAP) { atomicAdd(&bar[XB_TMO], 1u); break; } }
    }
    nloc = mine > 0u ? mine : 1u; nx = cnt > 0u ? cnt : 1u;
}
__device__ __forceinline__ void xcd_barrier(const XcdBarrier& b) {
    asm volatile("s_waitcnt vmcnt(0)" ::: "memory");
    __syncthreads();
    if (threadIdx.x == 0) {
        unsigned* bar = b.bar;
        __builtin_amdgcn_s_waitcnt(0);
        unsigned nloc = b.st[0], nx = b.st[1];
        if (nloc == 0u) { xcd_barrier_complete(bar, b.x, nloc, nx); b.st[0] = nloc; b.st[1] = nx; }
        const unsigned old = xb_add(&bar[XB_XSUB(b.x)], 1u);
        const unsigned gen = old / nloc;
        if (old + 1u == (gen + 1u) * nloc) {
            __builtin_amdgcn_fence(__ATOMIC_RELEASE, "agent");
            asm volatile("s_waitcnt vmcnt(0)" ::: "memory");
            const unsigned og = xb_add(&bar[XB_TOP], 1u);
            const unsigned tg = og / nx;
            if (og + 1u == (tg + 1u) * nx) xb_add(&bar[XB_TOPGEN], 1u);
            else XB_SPIN(xb_ld(&bar[XB_TOPGEN]) == tg, bar);
            __builtin_amdgcn_fence(__ATOMIC_ACQUIRE, "agent");
            xb_add(&bar[XB_XGEN(b.x)], 1u);
            asm volatile("s_waitcnt vmcnt(0)" ::: "memory");
        } else {
            XB_SPIN(xb_ld(&bar[XB_XGEN(b.x)]) == gen, bar);
            __builtin_amdgcn_fence(__ATOMIC_ACQUIRE, "agent");
            asm volatile("s_waitcnt vmcnt(0)" ::: "memory");
        }
    }
    __syncthreads();
}
constexpr int CW_BAR = 4096;

constexpr int K_PROLOGUE = 11, K_FINAL = 12;
template <int KIND>
__device__ __forceinline__ void run_kind(const Params& p, int L, LAS unsigned char* lds, int bid, int nblk) {
    unsigned char* ws = p.ws;
    float* H = (float*)(ws + WS_H);
    float* ss0 = (float*)(ws + WS_STAT); float* ss1 = (float*)(ws + WS_SS1); float* sse = (float*)(ws + WS_SSE);
    if constexpr (KIND == K_PROLOGUE) phase_prologue(p, lds, bid, nblk);
    if constexpr (KIND == K_FINAL) phase_final(p, bid, nblk);
    if constexpr (KIND == 0) { EpiProj E{nullptr, (bf16*)(ws + WS_PROJ), (float*)(ws + WS_BA)};
        gemm_run(lds, (const bf16*)(ws + WS_HB0), (const bf16*)(ws + WS_WIN) + (size_t)L * IN_PAD * D, M, IN_PAD, D, E, bid, nblk, ss0); }
    if constexpr (KIND == 1) phase_gdn_prep(p, L, lds, bid, nblk);
    if constexpr (KIND == 2) { phase_gdn_scan(p, L, lds, bid, nblk); phase_att_queue(p, L, lds, bid, nblk); }
    if constexpr (KIND == 3) { EpiRes E{ss1, H, (bf16*)(ws + WS_HB1)};
        gemm_run(lds, (const bf16*)(ws + WS_OBUF), (const bf16*)(ws + WS_WOUT) + (size_t)L * D * D, M, D, D, E, bid, nblk); }
    if constexpr (KIND == 4) { EpiQ2 E{nullptr, (bf16*)(ws + WS_Q2)};
        gemm_run(lds, (const bf16*)(ws + WS_HB1), (const bf16*)(ws + WS_WQ) + (size_t)L * 2048 * D, M, 2048, D, E, bid, nblk, ss1); }
    if constexpr (KIND == 5) phase_peer(p, L, lds, bid, nblk);
    if constexpr (KIND == 7) { EpiE E2{sse, (bf16*)(ws + WS_EPRE)};
        gemm_run(lds, (const bf16*)(ws + WS_PB) + (size_t)L * M * 256, (const bf16*)(ws + WS_WP) + (size_t)L * D * 256, M, D, 256, E2, bid, nblk); }
    if constexpr (KIND == 6) { EpiPle E{ss0, H, (bf16*)(ws + WS_HB0), (const bf16*)(ws + WS_EPRE), p.ple_norm_g + L * D};
        gemm_run(lds, (const bf16*)(ws + WS_HB2), (const bf16*)(ws + WS_WG) + (size_t)L * D * D, M, D, D, E, bid, nblk, sse); }
}

__device__ __forceinline__ Params params_off(const Params& s, size_t z) {
    Params q;
    q.x = s.x + z; q.p = s.p + z; q.ln_mix_g = s.ln_mix_g + z; q.w_in = s.w_in + z; q.conv_w = s.conv_w + z; q.a_log = s.a_log + z; q.dt_bias = s.dt_bias + z;
    q.gdn_norm_g = s.gdn_norm_g + z; q.diff_lambda = s.diff_lambda + z; q.subln_g = s.subln_g + z; q.w_out = s.w_out + z; q.ln_ffn_g = s.ln_ffn_g + z;
    q.peer_wq = s.peer_wq + z; q.subkeys = s.subkeys + z; q.peer_u = s.peer_u + z; q.peer_v = s.peer_v + z; q.ple_wp = s.ple_wp + z; q.ple_wg = s.ple_wg + z;
    q.ple_norm_g = s.ple_norm_g + z; q.final_g = s.final_g + z; q.out = s.out + z; q.ws = s.ws + z; q.pad0 = 0; q.pad1 = 0;
    return q;
}
#define RUN(KIND) do { size_t z_ = 0; int L_ = L; asm volatile("" : "+s"(z_), "+s"(L_)); const Params q_ = params_off(p, z_); run_kind<KIND>(q_, L_, (LAS unsigned char*)lds, (int)blockIdx.x, (int)gridDim.x); } while (0)
#define GRID_BARRIER() do { XcdBarrier b_; b_.bar = (unsigned*)(p.ws + WS_CTL) + CW_BAR; b_.x = xb_xcc_id(); b_.st = (volatile LAS unsigned*)((LAS unsigned char*)lds + LDS_MISC_OFF) + 8; xcd_barrier(b_); } while (0)
__global__ void __launch_bounds__(NTHREADS, 2) mk_fwd(Params p) {
    extern __shared__ __attribute__((aligned(16))) unsigned char lds[];
    {
        volatile LAS unsigned* misc = (volatile LAS unsigned*)((LAS unsigned char*)lds + LDS_MISC_OFF);
        if (threadIdx.x < 64) misc[threadIdx.x] = 0u;
        __syncthreads();
        (void)xcd_barrier_post((unsigned*)(p.ws + WS_CTL) + CW_BAR, misc + 8);
    }
    { int L = 0; RUN(K_PROLOGUE); }
    cg::this_grid().sync();
#define LAYER(LL) do { const int L = (LL); RUN(0); GRID_BARRIER(); RUN(1); GRID_BARRIER(); RUN(2); GRID_BARRIER(); RUN(3); GRID_BARRIER(); RUN(4); GRID_BARRIER(); RUN(5); RUN(7); GRID_BARRIER(); RUN(6); GRID_BARRIER(); } while (0)
    LAYER(0); LAYER(1); LAYER(2); LAYER(3);
#undef LAYER
    { int L = 0; RUN(K_FINAL); }
}

extern "C" void kernel_launch(void* const* d_in, const int* in_sizes, int n_in, void* d_out, int out_size, void* d_ws, size_t ws_size, hipStream_t stream) {
    static int grid = 0;
    if (grid == 0) {
        if (n_in != 20 || out_size != M * D || ws_size < WS_END) { fprintf(stderr, "kernel_launch: unexpected shapes (n_in %d, out %d, ws %zu < %zu)\n", n_in, out_size, ws_size, (size_t)WS_END); grid = -1; return; }
        int dev = 0, cus = 0, per_cu = 0;
        (void)hipGetDevice(&dev); (void)hipDeviceGetAttribute(&cus, hipDeviceAttributeMultiprocessorCount, dev);
        if (hipFuncSetAttribute((const void*)mk_fwd, hipFuncAttributeMaxDynamicSharedMemorySize, LDS_BYTES) != hipSuccess) { fprintf(stderr, "kernel_launch: hipFuncSetAttribute failed\n"); grid = -1; return; }
        if (hipOccupancyMaxActiveBlocksPerMultiprocessor(&per_cu, (const void*)mk_fwd, NTHREADS, LDS_BYTES) != hipSuccess || per_cu < 1) { fprintf(stderr, "kernel_launch: occupancy query says %d blocks per CU\n", per_cu); (void)hipGetLastError(); grid = -1; return; }
        grid = (cus > 0 ? cus : 256);
    }
    if (grid < 0) return;
    (void)hipMemsetAsync((char*)d_ws + WS_CTL, 0, CTL_ZERO_BYTES, stream);
    Params p{};
    const float** pp = (const float**)&p;
    for (int i = 0; i < 20; ++i) pp[i] = (const float*)d_in[i];
    p.out = (float*)d_out; p.ws = (unsigned char*)d_ws;
    void* args[] = {&p};
    hipError_t e = hipLaunchCooperativeKernel((const void*)mk_fwd, dim3(grid), dim3(NTHREADS), args, LDS_BYTES, stream);
    if (e != hipSuccess) fprintf(stderr, "kernel_launch: cooperative launch failed: %s (grid %d)\n", hipGetErrorString(e), grid);
}
```

```cpp
#include <hip/hip_runtime.h>
#include <hip/hip_cooperative_groups.h>
#include <cstdio>
#include <cstdint>
namespace cg = cooperative_groups;

#define LAS __attribute__((address_space(3)))
typedef unsigned short bf16;
typedef float f32x4 __attribute__((ext_vector_type(4)));
typedef short bf16x8 __attribute__((ext_vector_type(8)));
typedef unsigned u32x4 __attribute__((ext_vector_type(4)));
typedef unsigned u32x2 __attribute__((ext_vector_type(2)));

constexpr int D = 1024, BATCH = 8, SEQ = 2048, DEPTH = 4, M = BATCH * SEQ;
constexpr int IN_COLS = 3592, IN_PAD = 3840, PROJ_W = 3584;
constexpr int NEXP = 16384;
constexpr float EPS = 1e-6f;
constexpr float QSCALE = 0.125f * 1.4426950408889634f;
constexpr int NWAVES = 8, NTHREADS = 512;
constexpr int LDS_BYTES = 163840;
constexpr int LDS_MISC_OFF = LDS_BYTES - 256;
constexpr int RS_OFF = 147456;
constexpr int CW_QUEUE = 1024;

constexpr size_t MiB = 1u << 20;
constexpr size_t WS_CTL = 0, CTL_ZERO_BYTES = 1 * MiB;
constexpr size_t WS_H = 1 * MiB;
constexpr size_t WS_HB0 = 65 * MiB;
constexpr size_t WS_HB1 = 97 * MiB;
constexpr size_t WS_HB2 = 129 * MiB;
constexpr size_t WS_PROJ = 161 * MiB;
constexpr size_t WS_BA = 273 * MiB;
constexpr size_t WS_OBUF = 274 * MiB;
constexpr size_t WS_Q2 = 306 * MiB;
constexpr size_t WS_EPRE = 370 * MiB;
constexpr size_t WS_IDX = 402 * MiB;
constexpr size_t WS_GATE = 410 * MiB;
constexpr size_t WS_STAT = 418 * MiB;
constexpr size_t WS_SS1 = WS_IDX + 1 * MiB, WS_SSE = WS_IDX;
constexpr size_t WS_ORAW = 422 * MiB;
constexpr size_t WS_WIN = 550 * MiB;
constexpr size_t WS_WOUT = 582 * MiB;
constexpr size_t WS_WQ = 590 * MiB;
constexpr size_t WS_WG = 606 * MiB;
constexpr size_t WS_WP = 614 * MiB;
constexpr size_t WS_SK = 616 * MiB;
constexpr size_t WS_PB = 618 * MiB;
constexpr size_t WS_U = 650 * MiB;
constexpr size_t WS_V = 778 * MiB;
constexpr size_t WS_SU = WS_STAT + 1 * MiB, WS_SV = WS_STAT + 2 * MiB;
constexpr size_t WS_END = 906 * MiB;

struct Params {
    const float *x, *p, *ln_mix_g, *w_in, *conv_w, *a_log, *dt_bias, *gdn_norm_g, *diff_lambda, *subln_g, *w_out, *ln_ffn_g,
        *peer_wq, *subkeys, *peer_u, *peer_v, *ple_wp, *ple_wg, *ple_norm_g, *final_g;
    float* out;
    unsigned char* ws;
    int pad0, pad1;
};

__device__ __forceinline__ int tidx() { int t = (int)threadIdx.x; asm volatile("" : "+v"(t)); return t; }
#define LDS_BARRIER() asm volatile("s_waitcnt lgkmcnt(0)\n\ts_barrier" ::: "memory")
__device__ __forceinline__ float bf2f(bf16 v) { return __uint_as_float((unsigned)v << 16); }
__device__ __forceinline__ unsigned f2bf(float f);
typedef __bf16 bf16x2_t __attribute__((ext_vector_type(2)));
typedef float f32x2_t __attribute__((ext_vector_type(2)));
__device__ __forceinline__ unsigned cvtpk(float lo, float hi) { f32x2_t v = {lo, hi}; bf16x2_t b = __builtin_convertvector(v, bf16x2_t); return __builtin_bit_cast(unsigned, b); }
__device__ __forceinline__ unsigned pk2(float lo, float hi) { return cvtpk(lo, hi); }
__device__ __forceinline__ unsigned f2bf(float f) { return cvtpk(f, 0.f) & 0xffffu; }
__device__ __forceinline__ float lo16(unsigned w) { return __uint_as_float(w << 16); }
__device__ __forceinline__ float hi16(unsigned w) { return __uint_as_float(w & 0xffff0000u); }
template <int N> __device__ __forceinline__ float dpp_ror(float x) { return __builtin_bit_cast(float, __builtin_amdgcn_mov_dpp(__builtin_bit_cast(int, x), 0x120 + N, 0xf, 0xf, true)); }
template <int N> __device__ __forceinline__ unsigned dpp_ror_u(unsigned x) { return (unsigned)__builtin_amdgcn_mov_dpp((int)x, 0x120 + N, 0xf, 0xf, true); }
__device__ __forceinline__ float row16_sum(float x) { x += dpp_ror<8>(x); x += dpp_ror<4>(x); x += dpp_ror<2>(x); x += dpp_ror<1>(x); return x; }
__device__ __forceinline__ float row16_max(float x) { x = fmaxf(x, dpp_ror<8>(x)); x = fmaxf(x, dpp_ror<4>(x)); x = fmaxf(x, dpp_ror<2>(x)); x = fmaxf(x, dpp_ror<1>(x)); return x; }
__device__ __forceinline__ unsigned row16_umax(unsigned x) { unsigned y;
    y = dpp_ror_u<8>(x); x = x > y ? x : y; y = dpp_ror_u<4>(x); x = x > y ? x : y; y = dpp_ror_u<2>(x); x = x > y ? x : y; y = dpp_ror_u<1>(x); x = x > y ? x : y; return x; }
__device__ __forceinline__ float xrow16_max(float x) {
    auto s = __builtin_amdgcn_permlane16_swap(__float_as_uint(x), __float_as_uint(x), false, false);
    x = fmaxf(__uint_as_float(s[0]), __uint_as_float(s[1]));
    auto t = __builtin_amdgcn_permlane32_swap(__float_as_uint(x), __float_as_uint(x), false, false);
    return fmaxf(__uint_as_float(t[0]), __uint_as_float(t[1]));
}
__device__ __forceinline__ float xrow16_sum(float x) {
    auto s = __builtin_amdgcn_permlane16_swap(__float_as_uint(x), __float_as_uint(x), false, false);
    x = __uint_as_float(s[0]) + __uint_as_float(s[1]);
    auto t = __builtin_amdgcn_permlane32_swap(__float_as_uint(x), __float_as_uint(x), false, false);
    return __uint_as_float(t[0]) + __uint_as_float(t[1]);
}
__device__ __forceinline__ float wave_sum(float v) { return xrow16_sum(row16_sum(v)); }
template <int N> __device__ __forceinline__ int dpp_ror_i(int x) { return __builtin_amdgcn_mov_dpp(x, 0x120 + N, 0xf, 0xf, true); }
__device__ __forceinline__ int wave_isum(int x) {
    x += dpp_ror_i<8>(x); x += dpp_ror_i<4>(x); x += dpp_ror_i<2>(x); x += dpp_ror_i<1>(x);
    auto s = __builtin_amdgcn_permlane16_swap((unsigned)x, (unsigned)x, false, false); x = (int)(s[0] + s[1]);
    auto t = __builtin_amdgcn_permlane32_swap((unsigned)x, (unsigned)x, false, false); return (int)(t[0] + t[1]);
}
__device__ __forceinline__ float wave_max(float v) {
#pragma unroll
    for (int o = 32; o; o >>= 1) v = fmaxf(v, __shfl_xor(v, o));
    return v;
}
__device__ __forceinline__ float sigmoidf_(float x) { return __builtin_amdgcn_rcpf(1.f + __expf(-x)); }
__device__ __forceinline__ float dot8(u32x4 a, u32x4 b, float s) {
#pragma unroll
    for (int i = 0; i < 4; ++i) { s += lo16(a[i]) * lo16(b[i]); s += hi16(a[i]) * hi16(b[i]); }
    return s;
}

__host__ __device__ __forceinline__ int lds_byte(int r, int c) { const int st = (r >> 4) * 2 + (c >> 5), rr = r & 15, cc = c & 31, ob = rr * 64 + cc * 2; return st * 1024 + (ob ^ (((ob >> 9) & 1) << 5)); }
__host__ __device__ __forceinline__ void stage_rc(int b, int& R, int& C) { const int st = b / 1024, sb = b % 1024, swz = sb ^ (((sb >> 9) & 1) << 5); R = (st >> 1) * 16 + swz / 64; C = (st & 1) * 32 + (swz % 64) / 2; }
constexpr int HTB = 16384;
template <class F>
__device__ __forceinline__ void gemm_run(LAS unsigned char* lds, const bf16* A, const bf16* Bt, int Mm, int N, int K, const F& f, int bid, int nblk, const float* slots_in = nullptr) {
    LAS float* RS = (LAS float*)(lds + RS_OFF);
    int rs_pm = -1;
    const int tid = tidx(), wid = __builtin_amdgcn_readfirstlane(tid >> 6), lane = tid & 63, wr = wid >> 2, wc = wid & 3, fr = lane & 15, fq = lane >> 4;
    const int nt = K / 64, ntn = N / 256, nunits = (Mm / 256) * ntn;
    unsigned voff[2];
#pragma unroll
    for (int i = 0; i < 2; ++i) { const int uu = tid + 512 * i, r = uu >> 3, c = (uu & 7) ^ ((r >> 1) & 7); voff[i] = (unsigned)(r * K + c * 8) * 2u; }
    const unsigned ldsw = (unsigned)wid * 1024u;
    const int sw7 = (fr >> 1) & 7;
    const int aoff0 = wr * HTB + fr * 128 + ((fq ^ sw7) << 4), aoff1 = wr * HTB + fr * 128 + (((4 + fq) ^ sw7) << 4);
    const int bbase = (2 + (wc >> 1)) * HTB + (wc & 1) * 8192 + fr * 128;
    const int boff0 = bbase + ((fq ^ sw7) << 4), boff1 = bbase + (((4 + fq) ^ sw7) << 4);
#define G_STAGE(bufoff, gbase) do { _Pragma("unroll") for (int _i = 0; _i < 2; ++_i) \
        __builtin_amdgcn_global_load_lds((const unsigned*)((const char*)(gbase) + voff[_i]), (LAS unsigned*)(lds + (bufoff) + ldsw + _i * 8192), 16, 0, 0); } while (0)
    for (int u = bid; u < nunits; u += nblk) {
        const int pm = u % (Mm / 256), pn = u / (Mm / 256);
        if (slots_in && pm != rs_pm) {
            __syncthreads();
            if (tid < 256) { const f32x4* sp = (const f32x4*)(slots_in + ((size_t)pm * 256 + tid) * 16);
                const f32x4 a = sp[0], b = sp[1], c = sp[2], d = sp[3];
                const float s = (((a[0] + a[1]) + (a[2] + a[3])) + ((b[0] + b[1]) + (b[2] + b[3]))) + (((c[0] + c[1]) + (c[2] + c[3])) + ((d[0] + d[1]) + (d[2] + d[3])));
                RS[tid] = rsqrtf(s * (1.f / D) + EPS); }
            __syncthreads();
            rs_pm = pm;
        }
        const char* gA = (const char*)(A + (size_t)pm * 256 * K);
        const char* gB = (const char*)(Bt + (size_t)pn * 256 * K);
        const size_t hstep = (size_t)128 * K * 2;
        f32x4 acc[8][4];
#pragma unroll
        for (int a = 0; a < 8; ++a)
#pragma unroll
            for (int b = 0; b < 4; ++b) acc[a][b] = (f32x4){0.f, 0.f, 0.f, 0.f};
        G_STAGE(0, gA); G_STAGE(HTB, gA + hstep); G_STAGE(2 * HTB, gB); G_STAGE(3 * HTB, gB + hstep);
        for (int t = 0; t < nt; ++t) {
            const int cb = (t & 1) * 4 * HTB, nb = ((t + 1) & 1) * 4 * HTB;
            asm volatile("s_waitcnt vmcnt(0)" ::: "memory");
            __builtin_amdgcn_s_barrier();
            asm volatile("" ::: "memory");
            const size_t ko = (size_t)(t + 1) * 128; const bool more = t + 1 < nt;
#pragma unroll
            for (int k = 0; k < 2; ++k) {
                if (more) { if (k == 0) { G_STAGE(nb, gA + ko); G_STAGE(nb + 2 * HTB, gB + ko); } else { G_STAGE(nb + HTB, gA + hstep + ko); G_STAGE(nb + 3 * HTB, gB + hstep + ko); } }
                bf16x8 bfr[4], acur, anxt;
#pragma unroll
                for (int n = 0; n < 4; ++n) bfr[n] = *(const LAS bf16x8*)(lds + cb + (k ? boff1 : boff0) + n * 2048);
                acur = *(const LAS bf16x8*)(lds + cb + (k ? aoff1 : aoff0));
#pragma unroll
                for (int m = 0; m < 8; ++m) {
                    if (m < 7) anxt = *(const LAS bf16x8*)(lds + cb + (k ? aoff1 : aoff0) + (m + 1) * 2048);
#pragma unroll
                    for (int n = 0; n < 4; ++n) acc[m][n] = __builtin_amdgcn_mfma_f32_16x16x32_bf16(bfr[n], acur, acc[m][n], 0, 0, 0);
                    acur = anxt;
                }
                __builtin_amdgcn_sched_barrier(0);
            }
            asm volatile("s_waitcnt lgkmcnt(0)" ::: "memory");
        }
        {
            int el = lane; asm volatile("" : "+v"(el));
            const int efr = el & 15, efq = el >> 4;
            LAS float* et = (LAS float*)(lds + wid * 4352);
#pragma unroll
            for (int m = 0; m < 8; ++m) {
#pragma unroll
                for (int n = 0; n < 4; ++n) *(LAS f32x4*)(et + efr * 68 + n * 16 + 4 * efq) = acc[m][n];
                asm volatile("s_waitcnt lgkmcnt(0)" ::: "memory");
#pragma unroll
                for (int i = 0; i < 4; ++i) {
                    const int lrow = wr * 128 + m * 16 + 4 * i + efq, row = pm * 256 + lrow;
                    const f32x4 v = *(const LAS f32x4*)(et + (4 * i + efq) * 68 + 4 * efr);
                    const f32x4 r = f(row, RS[lrow], pn * 256 + wc * 64 + 4 * efr, v);
                    if constexpr (F::STATS) { const float ssq = row16_sum((r[0] * r[0] + r[1] * r[1]) + (r[2] * r[2] + r[3] * r[3])); if (efr == 0) f.slots[(size_t)row * 16 + pn * 4 + wc] = ssq; }
                }
                asm volatile("s_waitcnt lgkmcnt(0)" ::: "memory");
                __builtin_amdgcn_sched_barrier(0);
            }
        }
        __syncthreads();
    }
#undef G_STAGE
}

__device__ __forceinline__ u32x2 pk4(f32x4 a) { u32x2 o; o.x = pk2(a[0], a[1]); o.y = pk2(a[2], a[3]); return o; }
struct EpiProj {
    static constexpr bool STATS = false; float* slots;
    bf16* proj; float* ba;
    __device__ __forceinline__ f32x4 operator()(int row, float rstd, int col, f32x4 v) const {
        v = v * rstd;
        if (col < PROJ_W) *(u32x2*)(proj + (size_t)row * PROJ_W + col) = pk4(v);
        else if (col < IN_COLS) *(f32x4*)(ba + (size_t)row * 8 + (col - PROJ_W)) = v;
        return v;
    }
};
struct EpiRes {
    static constexpr bool STATS = true; float* slots;
    float* H; bf16* HB;
    __device__ __forceinline__ f32x4 operator()(int row, float, int col, f32x4 v) const {
        f32x4* hp = (f32x4*)(H + (size_t)row * D + col);
        const f32x4 h = *hp + v; *hp = h;
        *(u32x2*)(HB + (size_t)row * D + col) = pk4(h);
        return h;
    }
};
struct EpiQ2 {
    static constexpr bool STATS = false; float* slots;
    bf16* Q2;
    __device__ __forceinline__ f32x4 operator()(int row, float rstd, int col, f32x4 v) const { v = v * rstd; *(u32x2*)(Q2 + (size_t)row * 2048 + col) = pk4(v); return v; }
};
struct EpiE {
    static constexpr bool STATS = true; float* slots;
    bf16* E;
    __device__ __forceinline__ f32x4 operator()(int row, float, int col, f32x4 v) const { *(u32x2*)(E + (size_t)row * D + col) = pk4(v); return v; }
};
struct EpiPle {
    static constexpr bool STATS = true; float* slots;
    float* H; bf16* HB; const bf16* E; const float* g;
    __device__ __forceinline__ f32x4 operator()(int row, float rstde, int col, f32x4 v) const {
        f32x4* hp = (f32x4*)(H + (size_t)row * D + col);
        const u32x2 ev = *(const u32x2*)(E + (size_t)row * D + col);
        const f32x4 gv = *(const f32x4*)(g + col);
        f32x4 h = *hp;
        h[0] += sigmoidf_(v[0]) * (lo16(ev.x) * rstde * gv[0]); h[1] += sigmoidf_(v[1]) * (hi16(ev.x) * rstde * gv[1]);
        h[2] += sigmoidf_(v[2]) * (lo16(ev.y) * rstde * gv[2]); h[3] += sigmoidf_(v[3]) * (hi16(ev.y) * rstde * gv[3]);
        *hp = h;
        *(u32x2*)(HB + (size_t)row * D + col) = pk4(h);
        return h;
    }
};

__device__ __forceinline__ void transpose_item(const float* W, int K, int N, int Npad, bf16* WT, const float* rowscale, int qcols, float* scr, int item, int lane) {
    const int nblk = Npad / 32, kb = item / nblk, nb = item % nblk, k0 = 64 * kb, n0 = 32 * nb;
    const int nq = n0 + 4 * (lane & 7);
#pragma unroll
    for (int i = 0; i < 8; ++i) {
        const int kk = 8 * i + (lane >> 3);
        f32x4 v = (nq < N) ? *(const f32x4*)(W + (size_t)(k0 + kk) * N + nq) : (f32x4){0.f, 0.f, 0.f, 0.f};
        if (rowscale) v = v * rowscale[k0 + kk];
        if (nq < qcols) v = v * QSCALE;
        scr[kk * 33 + 4 * (lane & 7)] = v[0]; scr[kk * 33 + 4 * (lane & 7) + 1] = v[1]; scr[kk * 33 + 4 * (lane & 7) + 2] = v[2]; scr[kk * 33 + 4 * (lane & 7) + 3] = v[3];
    }
    asm volatile("s_waitcnt lgkmcnt(0)" ::: "memory");
    const int c = lane & 7;
#pragma unroll
    for (int j = 0; j < 4; ++j) {
        const int nn = (lane >> 3) + 8 * j; const float* s = scr + (8 * c) * 33 + nn;
        u32x4 o; o.x = pk2(s[0 * 33], s[1 * 33]); o.y = pk2(s[2 * 33], s[3 * 33]); o.z = pk2(s[4 * 33], s[5 * 33]); o.w = pk2(s[6 * 33], s[7 * 33]);
        *(u32x4*)(WT + (size_t)(n0 + nn) * K + k0 + 8 * c) = o;
    }
    asm volatile("s_waitcnt lgkmcnt(0)" ::: "memory");
}
__device__ __forceinline__ void convert_bulk(const float* src, bf16* dst, size_t n, size_t gtid, size_t nthr) {
    for (size_t i = gtid * 8; i < n; i += nthr * 8) {
        const f32x4 a = *(const f32x4*)(src + i), b = *(const f32x4*)(src + i + 4);
        u32x4 o; o.x = pk2(a[0], a[1]); o.y = pk2(a[2], a[3]); o.z = pk2(b[0], b[1]); o.w = pk2(b[2], b[3]);
        *(u32x4*)(dst + i) = o;
    }
}
__device__ void phase_prologue(const Params& p, LAS unsigned char* lds_, int bid, int nblk) {
    unsigned char* lds = (unsigned char*)lds_;
    const int tid = tidx(), lane = tid & 63, w = tid >> 6;
    const int gw = bid * NWAVES + w, NGW = nblk * NWAVES;
    float* scr = (float*)(lds + w * 16384);
    constexpr int I_IN = 16 * (IN_PAD / 32), I_OUT = 16 * 32, I_Q = 16 * 64, I_G = 16 * 32, I_P = 4 * 32, I_L = I_IN + I_OUT + I_Q + I_G + I_P;
    for (int it = gw; it < DEPTH * I_L; it += NGW) {
        const int L = it / I_L; int r = it % I_L;
        if (r < I_IN) { transpose_item(p.w_in + (size_t)L * D * IN_COLS, D, IN_COLS, IN_PAD, (bf16*)(p.ws + WS_WIN) + (size_t)L * IN_PAD * D, p.ln_mix_g + L * D, 512, scr, r, lane); continue; } r -= I_IN;
        if (r < I_OUT) { transpose_item(p.w_out + (size_t)L * D * D, D, D, D, (bf16*)(p.ws + WS_WOUT) + (size_t)L * D * D, nullptr, 0, scr, r, lane); continue; } r -= I_OUT;
        if (r < I_Q) { transpose_item(p.peer_wq + (size_t)L * D * 2048, D, 2048, 2048, (bf16*)(p.ws + WS_WQ) + (size_t)L * 2048 * D, p.ln_ffn_g + L * D, 0, scr, r, lane); continue; } r -= I_Q;
        if (r < I_G) { transpose_item(p.ple_wg + (size_t)L * D * D, D, D, D, (bf16*)(p.ws + WS_WG) + (size_t)L * D * D, nullptr, 0, scr, r, lane); continue; } r -= I_G;
        transpose_item(p.ple_wp + (size_t)L * 256 * D, 256, D, D, (bf16*)(p.ws + WS_WP) + (size_t)L * D * 256, nullptr, 0, scr, r, lane);
    }
    const size_t gtid = (size_t)bid * NTHREADS + tid, nthr = (size_t)nblk * NTHREADS;
    for (int r = gw; r < 2 * DEPTH * NEXP; r += NGW) {
        const int which = r >= DEPTH * NEXP, rr = which ? r - DEPTH * NEXP : r;
        const float* srow = (which ? p.peer_v : p.peer_u) + (size_t)rr * D + 4 * lane;
        f32x4 v[4];
#pragma unroll
        for (int j = 0; j < 4; ++j) v[j] = *(const f32x4*)(srow + 256 * j);
        float mx = 0.f;
#pragma unroll
        for (int j = 0; j < 4; ++j) mx = fmaxf(mx, fmaxf(fmaxf(fabsf(v[j][0]), fabsf(v[j][1])), fmaxf(fabsf(v[j][2]), fabsf(v[j][3]))));
        mx = xrow16_max(row16_max(mx));
        const float inv = mx > 0.f ? 127.f / mx : 0.f;
        u32x4 o;
#pragma unroll
        for (int j = 0; j < 4; ++j) {
            const unsigned b0 = (unsigned)__float2int_rn(v[j][0] * inv) & 0xffu, b1 = (unsigned)__float2int_rn(v[j][1] * inv) & 0xffu, b2 = (unsigned)__float2int_rn(v[j][2] * inv) & 0xffu, b3 = (unsigned)__float2int_rn(v[j][3] * inv) & 0xffu;
            o[j] = b0 | (b1 << 8) | (b2 << 16) | (b3 << 24);
        }
        *(u32x4*)(p.ws + (which ? WS_V : WS_U) + (size_t)rr * D + 16 * lane) = o;
        if (lane == 0) ((float*)(p.ws + (which ? WS_SV : WS_SU)))[rr] = mx * (1.f / 127.f);
    }
    convert_bulk(p.p, (bf16*)(p.ws + WS_PB), (size_t)DEPTH * M * 256, gtid, nthr);
    convert_bulk(p.subkeys, (bf16*)(p.ws + WS_SK), (size_t)DEPTH * 8 * 2 * 128 * 128, gtid, nthr);
    float* H = (float*)(p.ws + WS_H); bf16* HB0 = (bf16*)(p.ws + WS_HB0); float* ss0 = (float*)(p.ws + WS_STAT);
    for (int m = gw; m < M; m += NGW) {
        const f32x4* xr = (const f32x4*)(p.x + (size_t)m * D) + lane;
        float ss = 0.f;
#pragma unroll
        for (int j = 0; j < 4; ++j) {
            const f32x4 v = xr[64 * j];
            ss += v[0] * v[0] + v[1] * v[1] + v[2] * v[2] + v[3] * v[3];
            ((f32x4*)(H + (size_t)m * D))[lane + 64 * j] = v;
            u32x2 o; o.x = pk2(v[0], v[1]); o.y = pk2(v[2], v[3]);
            ((u32x2*)(HB0 + (size_t)m * D))[lane + 64 * j] = o;
        }
        ss = wave_sum(ss);
        if (lane < 16) ss0[(size_t)m * 16 + lane] = lane == 0 ? ss : 0.f;
    }
}

typedef short v4i16_t __attribute__((ext_vector_type(4)));
constexpr int ATT_VOFF = 16384, ATT_VPITCH = 288;
__device__ __forceinline__ void att_unit(const Params& p, int L, LAS unsigned char* lds, int tid, int b, int hh, int qb, float lam, float lam_init) {
    const int lane = tid & 63, w = __builtin_amdgcn_readfirstlane(tid >> 6), fr = lane & 15, fq = lane >> 4;
    const bf16* proj = (const bf16*)(p.ws + WS_PROJ);
    bf16* obuf = (bf16*)(p.ws + WS_OBUF);
    {
        const float slope2 = 1.4426950408889634f / (float)(1 << (2 * (hh + 1)));
        const bf16* kbase = proj + (size_t)b * SEQ * PROJ_W + 512 + hh * 128;
        const bf16* vbase = proj + (size_t)b * SEQ * PROJ_W + 1024 + hh * 128;
        {
            const int qw0 = qb * 128 + w * 16, T = 2 * (qb + 1);
            bf16x8 qf[2][2];
#pragma unroll
            for (int mp = 0; mp < 2; ++mp)
#pragma unroll
                for (int ks = 0; ks < 2; ++ks) qf[mp][ks] = *(const bf16x8*)(proj + ((size_t)b * SEQ + qw0 + fr) * PROJ_W + hh * 128 + mp * 64 + ks * 32 + 8 * fq);
            f32x4 o[2][8];
#pragma unroll
            for (int mp = 0; mp < 2; ++mp)
#pragma unroll
                for (int dt = 0; dt < 8; ++dt) o[mp][dt] = (f32x4){0.f, 0.f, 0.f, 0.f};
            float mrun[2] = {-INFINITY, -INFINITY}, lrun[2] = {0.f, 0.f};
            u32x4 kreg[2], vreg[2];
#pragma unroll
            for (int i = 0; i < 2; ++i) { const int c = tid + 512 * i, key = c >> 4, ch = c & 15;
                kreg[i] = *(const u32x4*)(kbase + (size_t)key * PROJ_W + ch * 8); vreg[i] = *(const u32x4*)(vbase + (size_t)key * PROJ_W + ch * 8); }
            for (int t = 0; t < T; ++t) {
                const int k0 = t * 64;
#pragma unroll
                for (int i = 0; i < 2; ++i) { const int c = tid + 512 * i, key = c >> 4, ch = c & 15;
                    *(LAS u32x4*)(lds + key * 256 + ((ch ^ (key & 15)) << 4)) = kreg[i];
                    *(LAS u32x4*)(lds + ATT_VOFF + key * ATT_VPITCH + ch * 16) = vreg[i]; }
                LDS_BARRIER();
                if (t + 1 < T) {
#pragma unroll
                    for (int i = 0; i < 2; ++i) { const int c = tid + 512 * i, key = k0 + 64 + (c >> 4), ch = c & 15;
                        kreg[i] = *(const u32x4*)(kbase + (size_t)key * PROJ_W + ch * 8); vreg[i] = *(const u32x4*)(vbase + (size_t)key * PROJ_W + ch * 8); }
                }
                if (k0 <= qw0 + 15) {
                    f32x4 s[2][4];
                    const float base = -slope2 * (float)(qw0 + fr - k0 - 4 * fq);
#pragma unroll
                    for (int kt = 0; kt < 4; ++kt)
#pragma unroll
                        for (int r = 0; r < 4; ++r) { const float v = base + slope2 * (float)(16 * kt + r); s[0][kt][r] = v; s[1][kt][r] = v; }
#pragma unroll
                    for (int mp = 0; mp < 2; ++mp)
#pragma unroll
                        for (int kt = 0; kt < 4; ++kt)
#pragma unroll
                            for (int ks = 0; ks < 2; ++ks) {
                                const bf16x8 kf = *(const LAS bf16x8*)(lds + (16 * kt + fr) * 256 + (((mp * 8 + ks * 4 + fq) ^ fr) << 4));
                                s[mp][kt] = __builtin_amdgcn_mfma_f32_16x16x32_bf16(kf, qf[mp][ks], s[mp][kt], 0, 0, 0);
                            }
                    if (k0 + 63 > qw0) {
                        const int lim = qw0 + fr - k0 - 4 * fq;
#pragma unroll
                        for (int mp = 0; mp < 2; ++mp)
#pragma unroll
                            for (int kt = 0; kt < 4; ++kt)
#pragma unroll
                                for (int r = 0; r < 4; ++r) if (16 * kt + r > lim) s[mp][kt][r] = -INFINITY;
                    }
                    bf16x8 pb[2][2];
#pragma unroll
                    for (int mp = 0; mp < 2; ++mp) {
                        float mx = fmaxf(fmaxf(s[mp][0][0], s[mp][0][1]), fmaxf(s[mp][0][2], s[mp][0][3]));
#pragma unroll
                        for (int kt = 1; kt < 4; ++kt) mx = fmaxf(mx, fmaxf(fmaxf(s[mp][kt][0], s[mp][kt][1]), fmaxf(s[mp][kt][2], s[mp][kt][3])));
                        mx = xrow16_max(mx);
                        const float mnew = fmaxf(mrun[mp], mx);
                        const float alpha = __builtin_amdgcn_exp2f(mrun[mp] - mnew);
                        mrun[mp] = mnew;
                        float ps = 0.f;
#pragma unroll
                        for (int kt = 0; kt < 4; ++kt)
#pragma unroll
                            for (int r = 0; r < 4; ++r) { const float e = __builtin_amdgcn_exp2f(s[mp][kt][r] - mnew); s[mp][kt][r] = e; ps += e; }
                        lrun[mp] = lrun[mp] * alpha + ps;
#pragma unroll
                        for (int dt = 0; dt < 8; ++dt) o[mp][dt] = o[mp][dt] * alpha;
#pragma unroll
                        for (int ks = 0; ks < 2; ++ks) {
                            u32x4 pk; pk.x = cvtpk(s[mp][2 * ks][0], s[mp][2 * ks][1]); pk.y = cvtpk(s[mp][2 * ks][2], s[mp][2 * ks][3]);
                            pk.z = cvtpk(s[mp][2 * ks + 1][0], s[mp][2 * ks + 1][1]); pk.w = cvtpk(s[mp][2 * ks + 1][2], s[mp][2 * ks + 1][3]);
                            pb[mp][ks] = __builtin_bit_cast(bf16x8, pk);
                        }
                    }
                    const int gl = lane & 15;
                    LAS unsigned char* vrd = lds + ATT_VOFF + (4 * fq + (gl >> 2)) * ATT_VPITCH + (gl & 3) * 8;
#pragma unroll
                    for (int dt = 0; dt < 8; ++dt)
#pragma unroll
                        for (int ks = 0; ks < 2; ++ks) {
                            const v4i16_t v0 = __builtin_amdgcn_ds_read_tr16_b64_v4i16((LAS v4i16_t*)(vrd + (32 * ks) * ATT_VPITCH + dt * 32));
                            const v4i16_t v1 = __builtin_amdgcn_ds_read_tr16_b64_v4i16((LAS v4i16_t*)(vrd + (32 * ks + 16) * ATT_VPITCH + dt * 32));
                            bf16x8 vf; vf[0] = v0[0]; vf[1] = v0[1]; vf[2] = v0[2]; vf[3] = v0[3]; vf[4] = v1[0]; vf[5] = v1[1]; vf[6] = v1[2]; vf[7] = v1[3];
                            o[0][dt] = __builtin_amdgcn_mfma_f32_16x16x32_bf16(vf, pb[0][ks], o[0][dt], 0, 0, 0);
                            o[1][dt] = __builtin_amdgcn_mfma_f32_16x16x32_bf16(vf, pb[1][ks], o[1][dt], 0, 0, 0);
                        }
                }
                LDS_BARRIER();
            }
            const float i1 = __builtin_amdgcn_rcpf(xrow16_sum(lrun[0])), i2 = lam * __builtin_amdgcn_rcpf(xrow16_sum(lrun[1]));
            float ss = 0.f;
#pragma unroll
            for (int dt = 0; dt < 8; ++dt)
#pragma unroll
                for (int r = 0; r < 4; ++r) { const float v = o[0][dt][r] * i1 - o[1][dt][r] * i2; o[0][dt][r] = v; ss += v * v; }
            ss = xrow16_sum(ss);
            const float rn = rsqrtf(ss * (1.f / 128.f) + EPS) * (1.f - lam_init);
            const float* g = p.subln_g + L * 128;
            bf16* orow = obuf + ((size_t)b * SEQ + qw0 + fr) * D + hh * 128;
#pragma unroll
            for (int dt = 0; dt < 8; ++dt) {
                const f32x4 gv = *(const f32x4*)(g + 16 * dt + 4 * fq);
                u32x2 ov; ov.x = pk2(o[0][dt][0] * rn * gv[0], o[0][dt][1] * rn * gv[1]); ov.y = pk2(o[0][dt][2] * rn * gv[2], o[0][dt][3] * rn * gv[3]);
                *(u32x2*)(orow + 16 * dt + 4 * fq) = ov;
            }
        }
    }
}

__device__ void phase_att_queue(const Params& p, int L, LAS unsigned char* lds, int bid, int nblk) {
    const int tid = tidx(), lane = tid & 63;
    const float* lp = p.diff_lambda + L * 256;
    const float d1 = wave_sum(lp[lane] * lp[64 + lane]), d2 = wave_sum(lp[128 + lane] * lp[192 + lane]);
    const float lam_init = 0.8f - 0.6f * __expf(-0.3f * (float)L);
    const float lam = __expf(d1) - __expf(d2) + lam_init;
    unsigned* head = (unsigned*)(p.ws + WS_CTL) + CW_QUEUE + L;
    volatile LAS int* slot = (volatile LAS int*)(lds + LDS_MISC_OFF + 64);
    for (;;) {
        __syncthreads();
        if (tid == 0) *slot = (int)__hip_atomic_fetch_add(head, 1u, __ATOMIC_RELAXED, __HIP_MEMORY_SCOPE_AGENT);
        __syncthreads();
        const int u = *slot;
        if (u >= 512) break;
        att_unit(p, L, lds, tid, (u & 31) >> 2, u & 3, 15 - (u >> 5), lam, lam_init);
    }
}

constexpr size_t GD_WP = WS_ORAW, GD_QD = WS_ORAW + 16 * MiB, GD_AIP = WS_ORAW + 32 * MiB, GD_KDT = WS_ORAW + 40 * MiB, GD_UT = WS_ORAW + 56 * MiB, GD_GL = WS_ORAW + 72 * MiB;
__device__ __forceinline__ int perm_pos(int k) { return (k & ~31) + 8 * ((k >> 2) & 3) + 4 * ((k >> 4) & 1) + (k & 3); }
__device__ __forceinline__ float softplusf_(float x) { if (x > 20.f) return x; const float e = __expf(x); return e < 0.06f ? e * (1.f - e * (0.5f - e * (0.33333334f - 0.25f * e))) : __logf(1.f + e); }
__device__ __forceinline__ float gelu_erf(float v) {
    const float z = fabsf(v) * 0.70710678118654752f, t = __builtin_amdgcn_rcpf(1.f + 0.3275911f * z);
    const float pl = t * (0.254829592f + t * (-0.284496736f + t * (1.421413741f + t * (-1.453152027f + t * 1.061405429f))));
    const float er = 1.f - pl * __expf(-z * z);
    return 0.5f * v * (1.f + (v < 0.f ? -er : er));
}

constexpr int GP_KN = 0, GP_QN = 17408, GP_RT = 34816, GP_LM = 71680, GP_TB = 89088, GP_GT = 98304, GP_T0T = 99328;
constexpr int GP_KP = 272, GP_RP = 144, GP_LP = 68, GP_TP = 144;
__device__ void phase_gdn_prep(const Params& p, int L, LAS unsigned char* lds, int bid, int nblk) {
    const int tid = tidx(), lane = tid & 63, w = __builtin_amdgcn_readfirstlane(tid >> 6), fr = lane & 15, fq = lane >> 4;
    const bf16* proj = (const bf16*)(p.ws + WS_PROJ);
    const float* BA = (const float*)(p.ws + WS_BA);
    bf16* WP = (bf16*)(p.ws + GD_WP); bf16* QD = (bf16*)(p.ws + GD_QD); bf16* AIP = (bf16*)(p.ws + GD_AIP); bf16* KDT = (bf16*)(p.ws + GD_KDT); bf16* UT = (bf16*)(p.ws + GD_UT);
    float* GL = (float*)(p.ws + GD_GL);
    const float* cw = p.conv_w + (size_t)L * 4 * 1536;
    LAS float* beta_s = (LAS float*)(lds + GP_GT); LAS float* gc_s = beta_s + 64; LAS float* egc_s = gc_s + 64; LAS float* edl_s = egc_s + 64;
    LAS float* Lm = (LAS float*)(lds + GP_LM);
    for (int item = bid; item < 1024; item += nblk) {
        const int n = item & 31, bh = item >> 5, hh = bh & 3, b = bh >> 2, t0 = n * 64;
        const size_t row0 = (size_t)b * SEQ + t0;
        __syncthreads();
        if (w == 0) {
            const float negA = -__expf(p.a_log[L * 4 + hh]), dtb = p.dt_bias[L * 4 + hh];
            const float bb = BA[(row0 + lane) * 8 + hh], aa = BA[(row0 + lane) * 8 + 4 + hh] + dtb;
            float c = negA * softplusf_(aa);
#pragma unroll
            for (int o = 1; o < 64; o <<= 1) { const float t = __shfl_up(c, o); if (lane >= o) c += t; }
            const float glast = __shfl(c, 63);
            beta_s[lane] = sigmoidf_(bb); gc_s[lane] = c; egc_s[lane] = __expf(c); edl_s[lane] = __expf(glast - c);
            if (lane == 0) GL[item] = __expf(glast);
        }
        __syncthreads();
        {
            const int colq = hh * 128 + 2 * lane;
            unsigned xk[11], xv[11];
#pragma unroll
            for (int r = 0; r < 11; ++r) { const int tt = t0 + 8 * w - 3 + r;
                xk[r] = (tt >= 0) ? *(const unsigned*)(proj + ((size_t)b * SEQ + tt) * PROJ_W + 1536 + 512 + colq) : 0u;
                xv[r] = (tt >= 0) ? *(const unsigned*)(proj + ((size_t)b * SEQ + tt) * PROJ_W + 1536 + 1024 + colq) : 0u; }
            {
                float wq[4][2]; unsigned xq[11];
#pragma unroll
                for (int j = 0; j < 4; ++j) { wq[j][0] = cw[j * 1536 + colq]; wq[j][1] = cw[j * 1536 + colq + 1]; }
#pragma unroll
                for (int r = 0; r < 11; ++r) { const int tt = t0 + 8 * w - 3 + r; xq[r] = (tt >= 0) ? *(const unsigned*)(proj + ((size_t)b * SEQ + tt) * PROJ_W + 1536 + colq) : 0u; }
#pragma unroll
                for (int i = 0; i < 8; ++i) {
                    const int c = 8 * w + i;
                    float q0 = 0.f, q1 = 0.f;
#pragma unroll
                    for (int j = 0; j < 4; ++j) { q0 += wq[j][0] * lo16(xq[i + j]); q1 += wq[j][1] * hi16(xq[i + j]); }
                    q0 *= sigmoidf_(q0); q1 *= sigmoidf_(q1);
                    const float sq = rsqrtf(wave_sum(q0 * q0 + q1 * q1) + EPS) * 0.08838834764831845f;
                    q0 *= sq; q1 *= sq;
                    const float eg = egc_s[c];
                    *(LAS unsigned*)(lds + GP_QN + c * GP_KP + lane * 4) = pk2(q0, q1);
                    *(unsigned*)(QD + ((size_t)item * 64 + c) * 128 + perm_pos(2 * lane)) = pk2(q0 * eg, q1 * eg);
                }
            }
            __builtin_amdgcn_sched_barrier(0);
            {
                float wk[4][2];
#pragma unroll
                for (int j = 0; j < 4; ++j) { wk[j][0] = cw[j * 1536 + 512 + colq]; wk[j][1] = cw[j * 1536 + 512 + colq + 1]; }
                unsigned kd0[8], kd1[8], rk0[8], rk1[8];
#pragma unroll
                for (int i = 0; i < 8; ++i) {
                    const int c = 8 * w + i;
                    float k0 = 0.f, k1 = 0.f;
#pragma unroll
                    for (int j = 0; j < 4; ++j) { k0 += wk[j][0] * lo16(xk[i + j]); k1 += wk[j][1] * hi16(xk[i + j]); }
                    k0 *= sigmoidf_(k0); k1 *= sigmoidf_(k1);
                    const float sk = rsqrtf(wave_sum(k0 * k0 + k1 * k1) + EPS);
                    k0 *= sk; k1 *= sk;
                    const float be = beta_s[c], eg = egc_s[c], ed = edl_s[c];
                    *(LAS unsigned*)(lds + GP_KN + c * GP_KP + lane * 4) = pk2(k0, k1);
                    kd0[i] = f2bf(k0 * ed); kd1[i] = f2bf(k1 * ed);
                    rk0[i] = f2bf(k0 * be * eg); rk1[i] = f2bf(k1 * be * eg);
                }
                u32x4 o;
                o.x = rk0[0] | (rk0[1] << 16); o.y = rk0[2] | (rk0[3] << 16); o.z = rk0[4] | (rk0[5] << 16); o.w = rk0[6] | (rk0[7] << 16); *(LAS u32x4*)(lds + GP_RT + (128 + 2 * lane) * GP_RP + 16 * w) = o;
                o.x = rk1[0] | (rk1[1] << 16); o.y = rk1[2] | (rk1[3] << 16); o.z = rk1[4] | (rk1[5] << 16); o.w = rk1[6] | (rk1[7] << 16); *(LAS u32x4*)(lds + GP_RT + (128 + 2 * lane + 1) * GP_RP + 16 * w) = o;
                const int pa = perm_pos(8 * w), pb = perm_pos(8 * w + 4);
                bf16* kr0 = KDT + ((size_t)item * 128 + 2 * lane) * 64; bf16* kr1 = kr0 + 64;
                u32x2 h2;
                h2.x = kd0[0] | (kd0[1] << 16); h2.y = kd0[2] | (kd0[3] << 16); *(u32x2*)(kr0 + pa) = h2;
                h2.x = kd0[4] | (kd0[5] << 16); h2.y = kd0[6] | (kd0[7] << 16); *(u32x2*)(kr0 + pb) = h2;
                h2.x = kd1[0] | (kd1[1] << 16); h2.y = kd1[2] | (kd1[3] << 16); *(u32x2*)(kr1 + pa) = h2;
                h2.x = kd1[4] | (kd1[5] << 16); h2.y = kd1[6] | (kd1[7] << 16); *(u32x2*)(kr1 + pb) = h2;
            }
            __builtin_amdgcn_sched_barrier(0);
            {
                float wv[4][2];
#pragma unroll
                for (int j = 0; j < 4; ++j) { wv[j][0] = cw[j * 1536 + 1024 + colq]; wv[j][1] = cw[j * 1536 + 1024 + colq + 1]; }
                unsigned rv0[8], rv1[8];
#pragma unroll
                for (int i = 0; i < 8; ++i) {
                    float v0 = 0.f, v1 = 0.f;
#pragma unroll
                    for (int j = 0; j < 4; ++j) { v0 += wv[j][0] * lo16(xv[i + j]); v1 += wv[j][1] * hi16(xv[i + j]); }
                    v0 *= sigmoidf_(v0); v1 *= sigmoidf_(v1);
                    const float be = beta_s[8 * w + i];
                    rv0[i] = f2bf(v0 * be); rv1[i] = f2bf(v1 * be);
                }
                u32x4 o;
                o.x = rv0[0] | (rv0[1] << 16); o.y = rv0[2] | (rv0[3] << 16); o.z = rv0[4] | (rv0[5] << 16); o.w = rv0[6] | (rv0[7] << 16); *(LAS u32x4*)(lds + GP_RT + (2 * lane) * GP_RP + 16 * w) = o;
                o.x = rv1[0] | (rv1[1] << 16); o.y = rv1[2] | (rv1[3] << 16); o.z = rv1[4] | (rv1[5] << 16); o.w = rv1[6] | (rv1[7] << 16); *(LAS u32x4*)(lds + GP_RT + (2 * lane + 1) * GP_RP + 16 * w) = o;
            }
        }
        __syncthreads();
#pragma unroll
        for (int q = 0; q < 2; ++q) {
            const int id = 2 * w + q, ct = id >> 2, st = id & 3;
            if (st <= ct) {
                f32x4 acc = (f32x4){0.f, 0.f, 0.f, 0.f};
#pragma unroll
                for (int ks = 0; ks < 4; ++ks) {
                    const bf16x8 a = *(const LAS bf16x8*)(lds + GP_KN + (16 * ct + fr) * GP_KP + (32 * ks + 8 * fq) * 2);
                    const bf16x8 bb = *(const LAS bf16x8*)(lds + GP_KN + (16 * st + fr) * GP_KP + (32 * ks + 8 * fq) * 2);
                    acc = __builtin_amdgcn_mfma_f32_16x16x32_bf16(a, bb, acc, 0, 0, 0);
                }
                const int s = 16 * st + fr; const float gs = gc_s[s];
#pragma unroll
                for (int r = 0; r < 4; ++r) { const int c = 16 * ct + 4 * fq + r;
                    Lm[c * GP_LP + s] = (s < c) ? beta_s[c] * acc[r] * __expf(fminf(gc_s[c] - gs, 0.f)) : 0.f; }
            }
        }
        __syncthreads();
        if (w < 2) {
            const int o = 32 * w;
            float t[32];
            int zoff = 0; asm volatile("" : "+v"(zoff));
            const LAS float* Lz = Lm + zoff + o * GP_LP + o;
            const int col = lane & 31;
#pragma unroll
            for (int i = 0; i < 32; ++i) {
                float a0 = (i == lane) ? 1.f : 0.f, a1 = 0.f, a2 = 0.f, a3 = 0.f;
#pragma unroll
                for (int s4 = 0; s4 + 4 <= i; s4 += 4) { const f32x4 lv = *(const LAS f32x4*)(Lz + i * GP_LP + s4);
                    a0 -= lv[0] * t[s4]; a1 -= lv[1] * t[s4 + 1]; a2 -= lv[2] * t[s4 + 2]; a3 -= lv[3] * t[s4 + 3]; }
#pragma unroll
                for (int s = i & ~3; s < i; ++s) a0 -= Lz[i * GP_LP + s] * t[s];
                t[i] = (lane < 32) ? (a0 + a1) + (a2 + a3) : 0.f;
                const bf16 tb = (bf16)f2bf(t[i]);
                if (w == 0) { *(LAS bf16*)(lds + GP_TB + i * GP_TP + lane * 2) = tb;
                              if (lane < 32) *(LAS bf16*)(lds + GP_T0T + lane * 80 + i * 2) = tb; }
                else if (lane < 32) *(LAS bf16*)(lds + GP_TB + (32 + i) * GP_TP + (32 + col) * 2) = tb;
                if ((i & 3) == 3) __builtin_amdgcn_sched_barrier(0);
            }
        } else {
            for (int id = w - 2; id < 16; id += 6) {
                const int ct = id >> 2, st = id & 3;
                f32x4 acc = (f32x4){0.f, 0.f, 0.f, 0.f};
                if (st <= ct) {
#pragma unroll
                    for (int ks = 0; ks < 4; ++ks) {
                        const bf16x8 a = *(const LAS bf16x8*)(lds + GP_QN + (16 * ct + fr) * GP_KP + (32 * ks + 8 * fq) * 2);
                        const bf16x8 bb = *(const LAS bf16x8*)(lds + GP_KN + (16 * st + fr) * GP_KP + (32 * ks + 8 * fq) * 2);
                        acc = __builtin_amdgcn_mfma_f32_16x16x32_bf16(a, bb, acc, 0, 0, 0);
                    }
                }
                const int s = 16 * st + fr; const float gs = gc_s[s]; const int ps = perm_pos(s);
#pragma unroll
                for (int r = 0; r < 4; ++r) { const int c = 16 * ct + 4 * fq + r;
                    const float v = (s <= c) ? acc[r] * __expf(fminf(gc_s[c] - gs, 0.f)) : 0.f;
                    AIP[((size_t)item * 64 + c) * 64 + ps] = (bf16)f2bf(v); }
            }
        }
        __syncthreads();
        if (w == 0) {
            f32x4 P[2][2];
#pragma unroll
            for (int it = 0; it < 2; ++it) {
                const LAS float* lr = Lm + (32 + 16 * it + fr) * GP_LP + 8 * fq;
                const f32x4 l0 = *(const LAS f32x4*)lr, l1 = *(const LAS f32x4*)(lr + 4);
                u32x4 pk; pk.x = cvtpk(l0[0], l0[1]); pk.y = cvtpk(l0[2], l0[3]); pk.z = cvtpk(l1[0], l1[1]); pk.w = cvtpk(l1[2], l1[3]);
                const bf16x8 a = __builtin_bit_cast(bf16x8, pk);
#pragma unroll
                for (int jt = 0; jt < 2; ++jt) {
                    const bf16x8 bb = *(const LAS bf16x8*)(lds + GP_T0T + (16 * jt + fr) * 80 + 16 * fq);
                    P[it][jt] = __builtin_amdgcn_mfma_f32_16x16x32_bf16(a, bb, (f32x4){0.f, 0.f, 0.f, 0.f}, 0, 0, 0);
                }
            }
#pragma unroll
            for (int jt = 0; jt < 2; ++jt) {
                u32x4 pk; pk.x = cvtpk(P[0][jt][0], P[0][jt][1]); pk.y = cvtpk(P[0][jt][2], P[0][jt][3]); pk.z = cvtpk(P[1][jt][0], P[1][jt][1]); pk.w = cvtpk(P[1][jt][2], P[1][jt][3]);
                const bf16x8 pb = __builtin_bit_cast(bf16x8, pk);
#pragma unroll
                for (int i2 = 0; i2 < 2; ++i2) {
                    const LAS unsigned char* tr = lds + GP_TB + (32 + 16 * i2 + fr) * GP_TP + (32 + 4 * fq) * 2;
                    const u32x2 ta = *(const LAS u32x2*)tr, tb2 = *(const LAS u32x2*)(tr + 32);
                    u32x4 ak; ak.x = ta.x; ak.y = ta.y; ak.z = tb2.x; ak.w = tb2.y;
                    const f32x4 r = __builtin_amdgcn_mfma_f32_16x16x32_bf16(__builtin_bit_cast(bf16x8, ak), pb, (f32x4){0.f, 0.f, 0.f, 0.f}, 0, 0, 0);
#pragma unroll
                    for (int q = 0; q < 4; ++q) *(LAS bf16*)(lds + GP_TB + (32 + 16 * i2 + 4 * fq + q) * GP_TP + (16 * jt + fr) * 2) = (bf16)f2bf(-r[q]);
                }
            }
        }
        __syncthreads();
#pragma unroll
        for (int q = 0; q < 2; ++q) {
            const int colt = 2 * w + q;
            bf16x8 af[2];
#pragma unroll
            for (int ks = 0; ks < 2; ++ks) af[ks] = *(const LAS bf16x8*)(lds + GP_RT + (16 * colt + fr) * GP_RP + (32 * ks + 8 * fq) * 2);
#pragma unroll
            for (int ct = 0; ct < 4; ++ct) {
                f32x4 acc = (f32x4){0.f, 0.f, 0.f, 0.f};
#pragma unroll
                for (int ks = 0; ks < 2; ++ks) {
                    const bf16x8 bb = *(const LAS bf16x8*)(lds + GP_TB + (16 * ct + fr) * GP_TP + (32 * ks + 8 * fq) * 2);
                    acc = __builtin_amdgcn_mfma_f32_16x16x32_bf16(af[ks], bb, acc, 0, 0, 0);
                }
                const int c = 16 * ct + fr;
                if (colt < 8) {
#pragma unroll
                    for (int r = 0; r < 4; ++r) UT[((size_t)item * 128 + 16 * colt + 4 * fq + r) * 64 + c] = (bf16)f2bf(acc[r]);
                } else {
                    const int kt = colt - 8;
                    u32x2 h2; h2.x = pk2(-acc[0], -acc[1]); h2.y = pk2(-acc[2], -acc[3]);
                    *(u32x2*)(WP + ((size_t)item * 64 + c) * 128 + 32 * (kt >> 1) + 8 * fq + 4 * (kt & 1)) = h2;
                }
            }
        }
    }
    __syncthreads();
}

constexpr int GS_WP = 0, GS_QD = 16384, GS_AIP = 32768, GS_KDT = 40960, GS_BUF = 57344, GS_OB = 2 * GS_BUF, GS_OBP = 272;
__device__ void phase_gdn_scan(const Params& p, int L, LAS unsigned char* lds, int bid, int nblk) {
    const int tid = tidx(), lane = tid & 63, w = __builtin_amdgcn_readfirstlane(tid >> 6), fr = lane & 15, fq = lane >> 4;
    const bf16* proj = (const bf16*)(p.ws + WS_PROJ);
    const bf16* WP = (const bf16*)(p.ws + GD_WP); const bf16* QD = (const bf16*)(p.ws + GD_QD); const bf16* AIP = (const bf16*)(p.ws + GD_AIP);
    const bf16* KDT = (const bf16*)(p.ws + GD_KDT); const bf16* UT = (const bf16*)(p.ws + GD_UT); const float* GL = (const float*)(p.ws + GD_GL);
    bf16* obuf = (bf16*)(p.ws + WS_OBUF);
    for (int item = bid; item < 32; item += nblk) {
        const int hh = item & 3, b = item >> 2;
        const int fc = tid >> 4, fv = tid & 15;
        float gn[8];
#pragma unroll
        for (int i = 0; i < 8; ++i) gn[i] = p.gdn_norm_g[L * 128 + 8 * fv + i];
        f32x4 S[8];
#pragma unroll
        for (int kt = 0; kt < 8; ++kt) S[kt] = (f32x4){0.f, 0.f, 0.f, 0.f};
        auto dma = [&](int ci, int buf) {
#pragma unroll
            for (int i = 0; i < 7; ++i) {
                const int pc = tid + 512 * i;
                const bf16* src;
                if (i < 2) { const int r = pc >> 4; src = WP + (size_t)ci * 8192 + r * 128 + (((pc & 15) ^ (r & 15)) * 8); }
                else if (i < 4) { const int q = pc - 1024, r = q >> 4; src = QD + (size_t)ci * 8192 + r * 128 + (((q & 15) ^ (r & 15)) * 8); }
                else if (i < 5) { const int q = pc - 2048, r = q >> 3; src = AIP + (size_t)ci * 4096 + r * 64 + (((q & 7) ^ ((r >> 1) & 7)) * 8); }
                else { const int q = pc - 2560, r = q >> 3; src = KDT + (size_t)ci * 8192 + r * 64 + (((q & 7) ^ ((r >> 1) & 7)) * 8); }
                __builtin_amdgcn_global_load_lds((const unsigned*)src, (LAS unsigned*)(lds + buf * GS_BUF + (w * 64 + 512 * i) * 16), 16, 0, 0);
            }
        };
        int offk[4], offa[2];
#pragma unroll
        for (int ks = 0; ks < 4; ++ks) offk[ks] = fr * 256 + (((4 * ks + fq) ^ fr) * 16);
#pragma unroll
        for (int ss = 0; ss < 2; ++ss) offa[ss] = fr * 128 + (((4 * ss + fq) ^ ((fr >> 1) & 7)) * 16);
        __syncthreads();
        dma(item * 32, 0); dma(item * 32 + 1, 1);
        u32x2 ut[4]; float gl;
        {
            const int ci = item * 32;
#pragma unroll
            for (int ct = 0; ct < 4; ++ct) ut[ct] = *(const u32x2*)(UT + ((size_t)ci * 128 + 16 * w + fr) * 64 + 16 * ct + 4 * fq);
            gl = GL[ci];
        }
        asm volatile("s_waitcnt vmcnt(0)" ::: "memory");
        __syncthreads();
        for (int n = 0; n < 32; ++n) {
            const int ci = item * 32 + n, buf = n & 1;
            const size_t rowc = (size_t)b * SEQ + n * 64;
            u32x2 utn[4]; float gln = 0.f;
            if (n + 1 < 32) {
#pragma unroll
                for (int ct = 0; ct < 4; ++ct) utn[ct] = *(const u32x2*)(UT + ((size_t)(ci + 1) * 128 + 16 * w + fr) * 64 + 16 * ct + 4 * fq);
                gln = GL[ci + 1];
            }
            u32x4 zq[2];
#pragma unroll
            for (int ps = 0; ps < 2; ++ps) zq[ps] = *(const u32x4*)(proj + (rowc + 32 * ps + fc) * PROJ_W + 3072 + hh * 128 + 8 * fv);
            f32x4 vn[4], oacc[4];
#pragma unroll
            for (int ct = 0; ct < 4; ++ct) { vn[ct] = (f32x4){lo16(ut[ct].x), hi16(ut[ct].x), lo16(ut[ct].y), hi16(ut[ct].y)}; oacc[ct] = (f32x4){0.f, 0.f, 0.f, 0.f}; }
            bf16x8 sb[4];
#pragma unroll
            for (int ks = 0; ks < 4; ++ks) { u32x4 pk; pk.x = cvtpk(S[2 * ks][0], S[2 * ks][1]); pk.y = cvtpk(S[2 * ks][2], S[2 * ks][3]); pk.z = cvtpk(S[2 * ks + 1][0], S[2 * ks + 1][1]); pk.w = cvtpk(S[2 * ks + 1][2], S[2 * ks + 1][3]);
                sb[ks] = __builtin_bit_cast(bf16x8, pk); }
            LAS unsigned char* bb = lds + buf * GS_BUF;
            bf16x8 f0[8], f1[8];
#define LD_A(F, ct) do { _Pragma("unroll") for (int ks = 0; ks < 4; ++ks) { F[ks] = *(const LAS bf16x8*)(bb + GS_WP + (ct) * 4096 + offk[ks]); \
                    F[4 + ks] = *(const LAS bf16x8*)(bb + GS_QD + (ct) * 4096 + offk[ks]); } } while (0)
#define MM_A(F, ct) do { _Pragma("unroll") for (int ks = 0; ks < 4; ++ks) { vn[ct] = __builtin_amdgcn_mfma_f32_16x16x32_bf16(F[ks], sb[ks], vn[ct], 0, 0, 0); \
                    oacc[ct] = __builtin_amdgcn_mfma_f32_16x16x32_bf16(sb[ks], F[4 + ks], oacc[ct], 0, 0, 0); } } while (0)
#define SBAR() __builtin_amdgcn_sched_barrier(0)
            LD_A(f0, 0); SBAR();
            LD_A(f1, 1); MM_A(f0, 0); SBAR();
            LD_A(f0, 2); MM_A(f1, 1); SBAR();
            LD_A(f1, 3); MM_A(f0, 2); SBAR();
#pragma unroll
            for (int ct = 0; ct < 4; ++ct)
#pragma unroll
                for (int ss = 0; ss < 2; ++ss) f0[2 * ct + ss] = *(const LAS bf16x8*)(bb + GS_AIP + ct * 2048 + offa[ss]);
            MM_A(f1, 3); SBAR();
            bf16x8 vb[2];
#pragma unroll
            for (int ss = 0; ss < 2; ++ss) { u32x4 pk; pk.x = cvtpk(vn[2 * ss][0], vn[2 * ss][1]); pk.y = cvtpk(vn[2 * ss][2], vn[2 * ss][3]); pk.z = cvtpk(vn[2 * ss + 1][0], vn[2 * ss + 1][1]); pk.w = cvtpk(vn[2 * ss + 1][2], vn[2 * ss + 1][3]);
                vb[ss] = __builtin_bit_cast(bf16x8, pk); }
#pragma unroll
            for (int kt = 0; kt < 4; ++kt)
#pragma unroll
                for (int ss = 0; ss < 2; ++ss) f1[2 * kt + ss] = *(const LAS bf16x8*)(bb + GS_KDT + kt * 2048 + offa[ss]);
#pragma unroll
            for (int ct = 0; ct < 4; ++ct)
#pragma unroll
                for (int ss = 0; ss < 2; ++ss) oacc[ct] = __builtin_amdgcn_mfma_f32_16x16x32_bf16(vb[ss], f0[2 * ct + ss], oacc[ct], 0, 0, 0);
            SBAR();
#pragma unroll
            for (int kt = 4; kt < 8; ++kt)
#pragma unroll
                for (int ss = 0; ss < 2; ++ss) f0[2 * (kt - 4) + ss] = *(const LAS bf16x8*)(bb + GS_KDT + kt * 2048 + offa[ss]);
#pragma unroll
            for (int kt = 0; kt < 4; ++kt) {
                S[kt] = S[kt] * gl;
#pragma unroll
                for (int ss = 0; ss < 2; ++ss) S[kt] = __builtin_amdgcn_mfma_f32_16x16x32_bf16(f1[2 * kt + ss], vb[ss], S[kt], 0, 0, 0);
            }
            SBAR();
#pragma unroll
            for (int kt = 4; kt < 8; ++kt) {
                S[kt] = S[kt] * gl;
#pragma unroll
                for (int ss = 0; ss < 2; ++ss) S[kt] = __builtin_amdgcn_mfma_f32_16x16x32_bf16(f0[2 * (kt - 4) + ss], vb[ss], S[kt], 0, 0, 0);
            }
#undef LD_A
#undef MM_A
#undef SBAR
            LDS_BARRIER();
            asm volatile("s_waitcnt vmcnt(0)" ::: "memory");
            if (n + 2 < 32) dma(ci + 2, buf);
#pragma unroll
            for (int ct = 0; ct < 4; ++ct) {
                u32x2 pk; pk.x = cvtpk(oacc[ct][0], oacc[ct][1]); pk.y = cvtpk(oacc[ct][2], oacc[ct][3]);
                *(LAS u32x2*)(lds + GS_OB + (16 * ct + fr) * GS_OBP + (16 * w + 4 * fq) * 2) = pk;
            }
            if (n + 1 < 32) {
#pragma unroll
                for (int ct = 0; ct < 4; ++ct) ut[ct] = utn[ct];
                gl = gln;
            }
            LDS_BARRIER();
#pragma unroll
            for (int ps = 0; ps < 2; ++ps) {
                const int c = 32 * ps + fc;
                const u32x4 ov = *(const LAS u32x4*)(lds + GS_OB + c * GS_OBP + fv * 16);
                float o8[8];
#pragma unroll
                for (int i = 0; i < 4; ++i) { o8[2 * i] = lo16(ov[i]); o8[2 * i + 1] = hi16(ov[i]); }
                float ss = 0.f;
#pragma unroll
                for (int i = 0; i < 8; ++i) ss += o8[i] * o8[i];
                const float rn = rsqrtf(row16_sum(ss) * (1.f / 128.f) + EPS);
                u32x4 res;
#pragma unroll
                for (int i = 0; i < 4; ++i) {
                    const float z0 = lo16(zq[ps][i]), z1 = hi16(zq[ps][i]);
                    res[i] = cvtpk(o8[2 * i] * rn * gn[2 * i] * (z0 * sigmoidf_(z0)), o8[2 * i + 1] * rn * gn[2 * i + 1] * (z1 * sigmoidf_(z1)));
                }
                *(u32x4*)(obuf + (rowc + c) * D + 512 + hh * 128 + 8 * fv) = res;
            }
        }
        __syncthreads();
    }
}

__device__ __forceinline__ unsigned sortable(float f) { const unsigned u = __float_as_uint(f); return u ^ ((unsigned)((int)u >> 31) | 0x80000000u); }
__device__ __forceinline__ float unsortable(unsigned s) { return __uint_as_float((s & 0x80000000u) ? (s ^ 0x80000000u) : ~s); }
#define CE(a, b) do { const unsigned _x = k[a], _y = k[b]; k[a] = _x > _y ? _x : _y; k[b] = _x > _y ? _y : _x; } while (0)
constexpr int PE_TK = 0, PE_TAB = 8192, PE_ID = 8448, PE_GT = PE_ID + 32768, PE_SK = PE_GT + 32768;
__device__ void phase_peer(const Params& p, int L, LAS unsigned char* lds, int bid, int nblk) {
    const int tid = tidx(), lane = tid & 63, w = __builtin_amdgcn_readfirstlane(tid >> 6), fr = lane & 15, fq = lane >> 4;
    const bf16* Q2 = (const bf16*)(p.ws + WS_Q2);
    const bf16* SK = (const bf16*)(p.ws + WS_SK) + (size_t)L * 8 * 2 * 128 * 128;
    float* H = (float*)(p.ws + WS_H); bf16* HB2 = (bf16*)(p.ws + WS_HB2);
    const unsigned char* U = p.ws + WS_U + (size_t)L * NEXP * D;
    const unsigned char* V = p.ws + WS_V + (size_t)L * NEXP * D;
    const float* SU = (const float*)(p.ws + WS_SU) + (size_t)L * NEXP; const float* SV = (const float*)(p.ws + WS_SV) + (size_t)L * NEXP;
    const float* g = p.ln_ffn_g + L * D;
    LAS unsigned* TK = (LAS unsigned*)(lds + PE_TK);
    LAS unsigned short* TAB = (LAS unsigned short*)(lds + PE_TAB);
    LAS int* IDL = (LAS int*)(lds + PE_ID); LAS float* GTL = (LAS float*)(lds + PE_GT);
    if (tid < 64) {
        int a = 0, base = 0, q = tid; unsigned short v = 0xffff;
        if (q < 50) { for (;;) { const int cnt = 16 / (a + 1); if (q < base + cnt) break; base += cnt; ++a; } v = (unsigned short)((a << 8) | (q - base)); }
        TAB[tid] = v;
    }
    for (int item = bid; item < M / 64; item += nblk) {
        const int tok0 = item * 64;
        __syncthreads();
        const int tg = w & 3, cc = w >> 2;
#define SK_FETCH(hd) do { _Pragma("unroll") for (int i = 0; i < 8; ++i) { const int pc = tid + 512 * i, nn = (pc >> 4) & 127; \
            __builtin_amdgcn_global_load_lds((const unsigned*)(SK + ((size_t)((hd) * 2 + (pc >> 11)) * 128 + nn) * 128 + (((pc & 15) ^ (nn & 15)) * 8)), \
                                             (LAS unsigned*)(lds + PE_SK + (w * 64 + 512 * i) * 16), 16, 0, 0); } } while (0)
        SK_FETCH(0);
        asm volatile("s_waitcnt vmcnt(0)" ::: "memory");
        __syncthreads();
        for (int hh = 0; hh < 8; ++hh) {
            {
                f32x4 acc[8];
#pragma unroll
                for (int nt = 0; nt < 8; ++nt) acc[nt] = (f32x4){0.f, 0.f, 0.f, 0.f};
                bf16x8 qa[4];
#pragma unroll
                for (int ks = 0; ks < 4; ++ks) qa[ks] = *(const bf16x8*)(Q2 + (size_t)(tok0 + 16 * tg + fr) * 2048 + hh * 256 + cc * 128 + 32 * ks + 8 * fq);
                const LAS unsigned char* skb = lds + PE_SK + cc * 32768 + fr * 256;
#pragma unroll
                for (int nt = 0; nt < 8; ++nt)
#pragma unroll
                    for (int ks = 0; ks < 4; ++ks) {
                        const bf16x8 kb = *(const LAS bf16x8*)(skb + nt * 4096 + (((4 * ks + fq) ^ fr) << 4));
                        acc[nt] = __builtin_amdgcn_mfma_f32_16x16x32_bf16(qa[ks], kb, acc[nt], 0, 0, 0);
                    }
#pragma unroll
                for (int r = 0; r < 4; ++r) {
                    unsigned k[8];
#pragma unroll
                    for (int nt = 0; nt < 8; ++nt) k[nt] = (sortable(acc[nt][r]) & ~0x7Fu) | (unsigned)(127 - (16 * nt + fr));
                    CE(0, 1); CE(2, 3); CE(4, 5); CE(6, 7); CE(0, 2); CE(1, 3); CE(4, 6); CE(5, 7); CE(1, 2); CE(5, 6); CE(0, 4); CE(3, 7);
                    CE(1, 5); CE(2, 6); CE(1, 4); CE(3, 6); CE(2, 4); CE(3, 5); CE(3, 4);
                    unsigned res = 0u;
#pragma unroll
                    for (int rd = 0; rd < 16; ++rd) {
                        const unsigned m = row16_umax(k[0]);
                        const bool win = k[0] == m;
#pragma unroll
                        for (int i = 0; i < 7; ++i) k[i] = win ? k[i + 1] : k[i];
                        k[7] = win ? 0u : k[7];
                        res = (fr == rd) ? m : res;
                    }
                    TK[(cc * 64 + 16 * tg + 4 * fq + r) * 16 + fr] = res;
                }
            }
            __syncthreads();
            if (hh + 1 < 8) SK_FETCH(hh + 1);
#pragma unroll
            for (int ps = 0; ps < 2; ++ps) {
                const int tl = 8 * w + 4 * ps + fq;
                unsigned k[4];
#pragma unroll
                for (int sl = 0; sl < 4; ++sl) {
                    const int q = sl * 16 + fr;
                    const unsigned ab = TAB[q];
                    const unsigned k1 = TK[tl * 16 + ((ab >> 8) & 15)], k2 = TK[(64 + tl) * 16 + (ab & 15)];
                    const float v = unsortable(k1 & ~0x7Fu) + unsortable(k2 & ~0x7Fu);
                    k[sl] = (q < 50) ? ((sortable(v) & ~0x3Fu) | (unsigned)(63 - q)) : 0u;
                }
                CE(0, 1); CE(2, 3); CE(0, 2); CE(1, 3); CE(1, 2);
                unsigned res = 0u;
#pragma unroll
                for (int rd = 0; rd < 16; ++rd) {
                    const unsigned m = row16_umax(k[0]);
                    const bool win = k[0] == m;
                    k[0] = win ? k[1] : k[0]; k[1] = win ? k[2] : k[1]; k[2] = win ? k[3] : k[2]; k[3] = win ? 0u : k[3];
                    res = (fr == rd) ? m : res;
                }
                const unsigned ab = TAB[63 - (res & 0x3Fu)];
                const unsigned k1 = TK[tl * 16 + ((ab >> 8) & 15)], k2 = TK[(64 + tl) * 16 + (ab & 15)];
                const float v = unsortable(k1 & ~0x7Fu) + unsortable(k2 & ~0x7Fu);
                const float e = __expf(v - row16_max(v));
                const float sum = row16_sum(e);
                IDL[tl * 128 + hh * 16 + fr] = (int)((127u - (k1 & 0x7Fu)) * 128u + (127u - (k2 & 0x7Fu)));
                GTL[tl * 128 + hh * 16 + fr] = e * __builtin_amdgcn_rcpf(sum);
            }
            asm volatile("s_waitcnt vmcnt(0)" ::: "memory");
            __syncthreads();
        }
#undef SK_FETCH
        for (int ti = 0; ti < 8; ++ti) {
            const int tl = 8 * w + ti;
            unsigned k0 = ((unsigned)IDL[tl * 128 + lane] << 7) | (unsigned)lane, k1 = ((unsigned)IDL[tl * 128 + 64 + lane] << 7) | (unsigned)(64 + lane);
#pragma unroll
            for (int kk = 2; kk <= 128; kk <<= 1) {
#pragma unroll
                for (int j = kk >> 1; j >= 1; j >>= 1) {
                    if (j == 64) { const unsigned lo = k0 < k1 ? k0 : k1, hi = k0 < k1 ? k1 : k0; k0 = lo; k1 = hi; }
                    else {
                        const unsigned p0 = (unsigned)__shfl_xor((int)k0, j), p1 = (unsigned)__shfl_xor((int)k1, j);
                        const bool up0 = ((lane & kk) == 0) || kk == 128, up1 = (((lane + 64) & kk) == 0);
                        const bool low = (lane & j) == 0;
                        k0 = (low == up0) ? (k0 < p0 ? k0 : p0) : (k0 > p0 ? k0 : p0);
                        k1 = (low == (kk == 128 ? true : up1)) ? (k1 < p1 ? k1 : p1) : (k1 > p1 ? k1 : p1);
                    }
                }
            }
            const float g0 = GTL[tl * 128 + (k0 & 127u)], g1 = GTL[tl * 128 + (k1 & 127u)];
            asm volatile("s_waitcnt lgkmcnt(0)" ::: "memory");
            IDL[tl * 128 + lane] = (int)(k0 >> 7); IDL[tl * 128 + 64 + lane] = (int)(k1 >> 7);
            GTL[tl * 128 + lane] = g0; GTL[tl * 128 + 64 + lane] = g1;
        }
        __syncthreads();
        for (int ti = 0; ti < 8; ++ti) {
            const int tl = 8 * w + ti, tok = tok0 + tl;
            const float* hrow = H + (size_t)tok * D + 4 * lane;
            float xn[16];
#pragma unroll
            for (int j = 0; j < 4; ++j) { const f32x4 a = *(const f32x4*)(hrow + 256 * j); xn[4 * j] = a[0]; xn[4 * j + 1] = a[1]; xn[4 * j + 2] = a[2]; xn[4 * j + 3] = a[3]; }
            float ss = 0.f;
#pragma unroll
            for (int i = 0; i < 16; ++i) ss += xn[i] * xn[i];
            const float rstd = rsqrtf(wave_sum(ss) * (1.f / D) + EPS);
            float mx = 0.f;
#pragma unroll
            for (int i = 0; i < 16; ++i) { xn[i] = xn[i] * rstd * g[256 * (i >> 2) + 4 * lane + (i & 3)]; mx = fmaxf(mx, fabsf(xn[i])); }
            mx = xrow16_max(row16_max(mx));
            const float xinv = mx > 0.f ? 127.f / mx : 0.f, sx = mx * (1.f / 127.f);
            int xq[4];
#pragma unroll
            for (int j = 0; j < 4; ++j) xq[j] = (int)(((unsigned)__float2int_rn(xn[4 * j] * xinv) & 0xffu) | (((unsigned)__float2int_rn(xn[4 * j + 1] * xinv) & 0xffu) << 8) |
                                                      (((unsigned)__float2int_rn(xn[4 * j + 2] * xinv) & 0xffu) << 16) | ((unsigned)__float2int_rn(xn[4 * j + 3] * xinv) << 24));
            const int id0 = IDL[tl * 128 + lane], id1 = IDL[tl * 128 + 64 + lane];
            const float su0 = SU[id0], su1 = SU[id1], sv0 = SV[id0], sv1 = SV[id1];
            int h0i = 0, h1i = 0;
            u32x4 ring[16];
#pragma unroll
            for (int j = 0; j < 16; ++j) ring[j] = *(const u32x4*)(U + (size_t)IDL[tl * 128 + j] * D + 16 * lane);
#pragma unroll 1
            for (int k = 0; k < 8; ++k) {
#pragma unroll
                for (int j = 0; j < 16; ++j) {
                    const u32x4 a = ring[j];
                    if (k < 7) ring[j] = *(const u32x4*)(U + (size_t)IDL[tl * 128 + 16 * (k + 1) + j] * D + 16 * lane);
                    int d = __builtin_amdgcn_sdot4((int)a[0], xq[0], 0, false);
                    d = __builtin_amdgcn_sdot4((int)a[1], xq[1], d, false); d = __builtin_amdgcn_sdot4((int)a[2], xq[2], d, false); d = __builtin_amdgcn_sdot4((int)a[3], xq[3], d, false);
                    d = wave_isum(d);
                    const int e = 16 * k + j;
                    if (lane == (e & 63)) { if (k < 4) h0i = d; else h1i = d; }
                }
            }
            const float h0 = su0 * sx * (float)h0i, h1 = su1 * sx * (float)h1i;
            GTL[tl * 128 + lane] = sv0 * GTL[tl * 128 + lane] * gelu_erf(h0);
            GTL[tl * 128 + 64 + lane] = sv1 * GTL[tl * 128 + 64 + lane] * gelu_erf(h1);
        }
        for (int ti = 0; ti < 8; ++ti) {
            const int tl = 8 * w + ti, tok = tok0 + tl;
            float* hrow = H + (size_t)tok * D + 4 * lane;
            float xv[16];
#pragma unroll
            for (int j = 0; j < 4; ++j) { const f32x4 a = *(const f32x4*)(hrow + 256 * j); xv[4 * j] = a[0]; xv[4 * j + 1] = a[1]; xv[4 * j + 2] = a[2]; xv[4 * j + 3] = a[3]; }
            const float w0 = GTL[tl * 128 + lane], w1 = GTL[tl * 128 + 64 + lane];
            const float wmx = xrow16_max(row16_max(fmaxf(fabsf(w0), fabsf(w1))));
            const float winv = wmx > 0.f ? 127.f / wmx : 0.f, sw = wmx * (1.f / 127.f);
            const f32x4 wv = *(const LAS f32x4*)(GTL + tl * 128 + 4 * (lane & 31));
            const int wq = (int)(((unsigned)__float2int_rn(wv[0] * winv) & 0xffu) | (((unsigned)__float2int_rn(wv[1] * winv) & 0xffu) << 8) |
                                 (((unsigned)__float2int_rn(wv[2] * winv) & 0xffu) << 16) | ((unsigned)__float2int_rn(wv[3] * winv) << 24));
            int yi[16];
#pragma unroll
            for (int i = 0; i < 16; ++i) yi[i] = 0;
            u32x4 ring[16];
#pragma unroll
            for (int j = 0; j < 16; ++j) ring[j] = *(const u32x4*)(V + (size_t)IDL[tl * 128 + j] * D + 16 * lane);
#pragma unroll 1
            for (int k = 0; k < 8; ++k) {
#pragma unroll
                for (int g4 = 0; g4 < 4; ++g4) {
                    const u32x4 a0 = ring[4 * g4], a1 = ring[4 * g4 + 1], a2 = ring[4 * g4 + 2], a3 = ring[4 * g4 + 3];
                    if (k < 7) {
#pragma unroll
                        for (int q = 0; q < 4; ++q) ring[4 * g4 + q] = *(const u32x4*)(V + (size_t)IDL[tl * 128 + 16 * (k + 1) + 4 * g4 + q] * D + 16 * lane);
                    }
                    const int wg = __builtin_amdgcn_readlane(wq, 4 * k + g4);
#pragma unroll
                    for (int q = 0; q < 4; ++q) {
                        const unsigned p0 = __builtin_amdgcn_perm(a1[q], a0[q], 0x05010400u), p1 = __builtin_amdgcn_perm(a1[q], a0[q], 0x07030602u);
                        const unsigned p2 = __builtin_amdgcn_perm(a3[q], a2[q], 0x05010400u), p3 = __builtin_amdgcn_perm(a3[q], a2[q], 0x07030602u);
                        yi[4 * q] = __builtin_amdgcn_sdot4((int)__builtin_amdgcn_perm(p2, p0, 0x05040100u), wg, yi[4 * q], false);
                        yi[4 * q + 1] = __builtin_amdgcn_sdot4((int)__builtin_amdgcn_perm(p2, p0, 0x07060302u), wg, yi[4 * q + 1], false);
                        yi[4 * q + 2] = __builtin_amdgcn_sdot4((int)__builtin_amdgcn_perm(p3, p1, 0x05040100u), wg, yi[4 * q + 2], false);
                        yi[4 * q + 3] = __builtin_amdgcn_sdot4((int)__builtin_amdgcn_perm(p3, p1, 0x07060302u), wg, yi[4 * q + 3], false);
                    }
                }
            }
            float y[16];
#pragma unroll
            for (int i = 0; i < 16; ++i) y[i] = xv[i] + sw * (float)yi[i];
#pragma unroll
            for (int j = 0; j < 4; ++j) *(f32x4*)(hrow + 256 * j) = (f32x4){y[4 * j], y[4 * j + 1], y[4 * j + 2], y[4 * j + 3]};
            bf16* hb = HB2 + (size_t)tok * D + 4 * lane;
#pragma unroll
            for (int j = 0; j < 4; ++j) { u32x2 o2; o2.x = pk2(y[4 * j], y[4 * j + 1]); o2.y = pk2(y[4 * j + 2], y[4 * j + 3]); *(u32x2*)(hb + 256 * j) = o2; }
        }
    }
    __syncthreads();
}
#undef CE

__device__ void phase_final(const Params& p, int bid, int nblk) {
    const int tid = tidx(), lane = tid & 63, gw = bid * NWAVES + (tid >> 6), NGW = nblk * NWAVES;
    const float* H = (const float*)(p.ws + WS_H);
    for (int m = gw; m < M; m += NGW) {
        f32x4 v[4]; float ss = 0.f;
#pragma unroll
        for (int j = 0; j < 4; ++j) { v[j] = ((const f32x4*)(H + (size_t)m * D))[lane + 64 * j]; ss += (v[j][0] * v[j][0] + v[j][1] * v[j][1]) + (v[j][2] * v[j][2] + v[j][3] * v[j][3]); }
        const float r = rsqrtf(wave_sum(ss) * (1.f / D) + EPS);
#pragma unroll
        for (int j = 0; j < 4; ++j) { const f32x4 gv = ((const f32x4*)p.final_g)[lane + 64 * j]; ((f32x4*)(p.out + (size_t)m * D))[lane + 64 * j] = v[j] * r * gv; }
    }
}

#define XB_TMO      128
#define XB_XCNT(j)  (256  + 64 * (j))
#define XB_XSUB(j)  (1280 + 64 * (j))
#define XB_XGEN(j)  (2304 + 64 * (j))
#define XB_TOP      3328
#define XB_TOPGEN   3392
#define XCD_BAR_WORDS 3456
#define XB_SPIN_CAP (1u << 22)
__device__ __forceinline__ unsigned xb_ld(unsigned* p)              { return __hip_atomic_load(p, __ATOMIC_RELAXED, __HIP_MEMORY_SCOPE_AGENT); }
__device__ __forceinline__ unsigned xb_add(unsigned* p, unsigned v) { return __hip_atomic_fetch_add(p, v, __ATOMIC_RELAXED, __HIP_MEMORY_SCOPE_AGENT); }
__device__ __forceinline__ unsigned xb_xcc_id() { return (unsigned)__builtin_amdgcn_s_getreg((3 << 11) | 20) & 0xFu; }
#define XB_SPIN(cond, bar) do { unsigned _sp = 0; while (cond) { __builtin_amdgcn_s_sleep(1); \
    if ((++_sp & 255u) == 0u) { if (xb_ld(&(bar)[XB_TMO])) break; if (_sp > XB_SPIN_CAP) { atomicAdd(&(bar)[XB_TMO], 1u); break; } } } } while (0)
struct XcdBarrier { unsigned* bar; unsigned x; volatile LAS unsigned* st; };
__device__ __forceinline__ XcdBarrier xcd_barrier_post(unsigned* bar, volatile LAS unsigned* st) {
    XcdBarrier b; b.bar = bar; b.x = xb_xcc_id(); b.st = st;
    if (threadIdx.x == 0) (void)xb_add(&bar[XB_XCNT(b.x)], 1u);
    return b;
}
__device__ __forceinline__ void xcd_barrier_complete(unsigned* bar, unsigned x, unsigned& nloc, unsigned& nx) {
    const unsigned G = gridDim.x * gridDim.y * gridDim.z;
    unsigned sum, cnt, mine, sp = 0u;
    for (;;) {
        sum = 0u; cnt = 0u; mine = 0u;
#pragma unroll
        for (unsigned j = 0; j < 16; ++j) { const unsigned c = xb_ld(&bar[XB_XCNT(j)]); sum += c; cnt += (c > 0u) ? 1u : 0u; mine = (j == x) ? c : mine; }
        if (sum == G) break;
        __builtin_amdgcn_s_sleep(1);
        if ((++sp & 255u) == 0u) { if (xb_ld(&bar[XB_TMO])) break; if (sp > XB_SPIN_CAP) { atomicAdd(&bar[XB_TMO], 1u); break; } }
    }
    nloc = mine > 0u ? mine : 1u; nx = cnt > 0u ? cnt : 1u;
}
__device__ __forceinline__ void xcd_barrier(const XcdBarrier& b) {
    asm volatile("s_waitcnt vmcnt(0)" ::: "memory");
    __syncthreads();
    if (threadIdx.x == 0) {
        unsigned* bar = b.bar;
        __builtin_amdgcn_s_waitcnt(0);
        unsigned nloc = b.st[0], nx = b.st[1];
        if (nloc == 0u) { xcd_barrier_complete(bar, b.x, nloc, nx); b.st[0] = nloc; b.st[1] = nx; }
        const unsigned old = xb_add(&bar[XB_XSUB(b.x)], 1u);
        const unsigned gen = old / nloc;
        if (old + 1u == (gen + 1u) * nloc) {
            __builtin_amdgcn_fence(__ATOMIC_RELEASE, "agent");
            asm volatile("s_waitcnt vmcnt(0)" ::: "memory");
            const unsigned og = xb_add(&bar[XB_TOP], 1u);
            const unsigned tg = og / nx;
            if (og + 1u == (tg + 1u) * nx) xb_add(&bar[XB_TOPGEN], 1u);
            else XB_SPIN(xb_ld(&bar[XB_TOPGEN]) == tg, bar);
            __builtin_amdgcn_fence(__ATOMIC_ACQUIRE, "agent");
            xb_add(&bar[XB_XGEN(b.x)], 1u);
            asm volatile("s_waitcnt vmcnt(0)" ::: "memory");
        } else {
            XB_SPIN(xb_ld(&bar[XB_XGEN(b.x)]) == gen, bar);
            __builtin_amdgcn_fence(__ATOMIC_ACQUIRE, "agent");
            asm volatile("s_waitcnt vmcnt(0)" ::: "memory");
        }
    }
    __syncthreads();
}
constexpr int CW_BAR = 4096;

constexpr int K_PROLOGUE = 11, K_FINAL = 12;
template <int KIND>
__device__ __forceinline__ void run_kind(const Params& p, int L, LAS unsigned char* lds, int bid, int nblk) {
    unsigned char* ws = p.ws;
    float* H = (float*)(ws + WS_H);
    float* ss0 = (float*)(ws + WS_STAT); float* ss1 = (float*)(ws + WS_SS1); float* sse = (float*)(ws + WS_SSE);
    if constexpr (KIND == K_PROLOGUE) phase_prologue(p, lds, bid, nblk);
    if constexpr (KIND == K_FINAL) phase_final(p, bid, nblk);
    if constexpr (KIND == 0) { EpiProj E{nullptr, (bf16*)(ws + WS_PROJ), (float*)(ws + WS_BA)};
        gemm_run(lds, (const bf16*)(ws + WS_HB0), (const bf16*)(ws + WS_WIN) + (size_t)L * IN_PAD * D, M, IN_PAD, D, E, bid, nblk, ss0); }
    if constexpr (KIND == 1) phase_gdn_prep(p, L, lds, bid, nblk);
    if constexpr (KIND == 2) { phase_gdn_scan(p, L, lds, bid, nblk); phase_att_queue(p, L, lds, bid, nblk); }
    if constexpr (KIND == 3) { EpiRes E{ss1, H, (bf16*)(ws + WS_HB1)};
        gemm_run(lds, (const bf16*)(ws + WS_OBUF), (const bf16*)(ws + WS_WOUT) + (size_t)L * D * D, M, D, D, E, bid, nblk); }
    if constexpr (KIND == 4) { EpiQ2 E{nullptr, (bf16*)(ws + WS_Q2)};
        gemm_run(lds, (const bf16*)(ws + WS_HB1), (const bf16*)(ws + WS_WQ) + (size_t)L * 2048 * D, M, 2048, D, E, bid, nblk, ss1); }
    if constexpr (KIND == 5) phase_peer(p, L, lds, bid, nblk);
    if constexpr (KIND == 7) { EpiE E2{sse, (bf16*)(ws + WS_EPRE)};
        gemm_run(lds, (const bf16*)(ws + WS_PB) + (size_t)L * M * 256, (const bf16*)(ws + WS_WP) + (size_t)L * D * 256, M, D, 256, E2, bid, nblk); }
    if constexpr (KIND == 6) { EpiPle E{ss0, H, (bf16*)(ws + WS_HB0), (const bf16*)(ws + WS_EPRE), p.ple_norm_g + L * D};
        gemm_run(lds, (const bf16*)(ws + WS_HB2), (const bf16*)(ws + WS_WG) + (size_t)L * D * D, M, D, D, E, bid, nblk, sse); }
}

__device__ __forceinline__ Params params_off(const Params& s, size_t z) {
    Params q;
    q.x = s.x + z; q.p = s.p + z; q.ln_mix_g = s.ln_mix_g + z; q.w_in = s.w_in + z; q.conv_w = s.conv_w + z; q.a_log = s.a_log + z; q.dt_bias = s.dt_bias + z;
    q.gdn_norm_g = s.gdn_norm_g + z; q.diff_lambda = s.diff_lambda + z; q.subln_g = s.subln_g + z; q.w_out = s.w_out + z; q.ln_ffn_g = s.ln_ffn_g + z;
    q.peer_wq = s.peer_wq + z; q.subkeys = s.subkeys + z; q.peer_u = s.peer_u + z; q.peer_v = s.peer_v + z; q.ple_wp = s.ple_wp + z; q.ple_wg = s.ple_wg + z;
    q.ple_norm_g = s.ple_norm_g + z; q.final_g = s.final_g + z; q.out = s.out + z; q.ws = s.ws + z; q.pad0 = 0; q.pad1 = 0;
    return q;
}
#define RUN(KIND) do { size_t z_ = 0; int L_ = L; asm volatile("" : "+s"(z_), "+s"(L_)); const Params q_ = params_off(p, z_); run_kind<KIND>(q_, L_, (LAS unsigned char*)lds, (int)blockIdx.x, (int)gridDim.x); } while (0)
#define GRID_BARRIER() do { XcdBarrier b_; b_.bar = (unsigned*)(p.ws + WS_CTL) + CW_BAR; b_.x = xb_xcc_id(); b_.st = (volatile LAS unsigned*)((LAS unsigned char*)lds + LDS_MISC_OFF) + 8; xcd_barrier(b_); } while (0)
__global__ void __launch_bounds__(NTHREADS, 2) mk_fwd(Params p) {
    extern __shared__ __attribute__((aligned(16))) unsigned char lds[];
    {
        volatile LAS unsigned* misc = (volatile LAS unsigned*)((LAS unsigned char*)lds + LDS_MISC_OFF);
        if (threadIdx.x < 64) misc[threadIdx.x] = 0u;
        __syncthreads();
        (void)xcd_barrier_post((unsigned*)(p.ws + WS_CTL) + CW_BAR, misc + 8);
    }
    { int L = 0; RUN(K_PROLOGUE); }
    cg::this_grid().sync();
#define LAYER(LL) do { const int L = (LL); RUN(0); GRID_BARRIER(); RUN(1); GRID_BARRIER(); RUN(2); GRID_BARRIER(); RUN(3); GRID_BARRIER(); RUN(4); GRID_BARRIER(); RUN(5); RUN(7); GRID_BARRIER(); RUN(6); GRID_BARRIER(); } while (0)
    LAYER(0); LAYER(1); LAYER(2); LAYER(3);
#undef LAYER
    { int L = 0; RUN(K_FINAL); }
}

extern "C" void kernel_launch(void* const* d_in, const int* in_sizes, int n_in, void* d_out, int out_size, void* d_ws, size_t ws_size, hipStream_t stream) {
    static int grid = 0;
    if (grid == 0) {
        if (n_in != 20 || out_size != M * D || ws_size < WS_END) { fprintf(stderr, "kernel_launch: unexpected shapes (n_in %d, out %d, ws %zu < %zu)\n", n_in, out_size, ws_size, (size_t)WS_END); grid = -1; return; }
        int dev = 0, cus = 0, per_cu = 0;
        (void)hipGetDevice(&dev); (void)hipDeviceGetAttribute(&cus, hipDeviceAttributeMultiprocessorCount, dev);
        if (hipFuncSetAttribute((const void*)mk_fwd, hipFuncAttributeMaxDynamicSharedMemorySize, LDS_BYTES) != hipSuccess) { fprintf(stderr, "kernel_launch: hipFuncSetAttribute failed\n"); grid = -1; return; }
        if (hipOccupancyMaxActiveBlocksPerMultiprocessor(&per_cu, (const void*)mk_fwd, NTHREADS, LDS_BYTES) != hipSuccess || per_cu < 1) { fprintf(stderr, "kernel_launch: occupancy query says %d blocks per CU\n", per_cu); (void)hipGetLastError(); grid = -1; return; }
        grid = (cus > 0 ? cus : 256);
    }
    if (grid < 0) return;
    (void)hipMemsetAsync((char*)d_ws + WS_CTL, 0, CTL_ZERO_BYTES, stream);
    Params p{};
    const float** pp = (const float**)&p;
    for (int i = 0; i < 20; ++i) pp[i] = (const float*)d_in[i];
    p.out = (float*)d_out; p.ws = (unsigned char*)d_ws;
    void* args[] = {&p};
    hipError_t e = hipLaunchCooperativeKernel((const void*)mk_fwd, dim3(grid), dim3(NTHREADS), args, LDS_BYTES, stream);
    if (e != hipSuccess) fprintf(stderr, "kernel_launch: cooperative launch failed: %s (grid %d)\n", hipGetErrorString(e), grid);
}
```

```cpp
#include <hip/hip_runtime.h>
#include <hip/hip_cooperative_groups.h>
#include <cstdio>
#include <cstdint>
namespace cg = cooperative_groups;

#define LAS __attribute__((address_space(3)))
typedef unsigned short bf16;
typedef float f32x4 __attribute__((ext_vector_type(4)));
typedef short bf16x8 __attribute__((ext_vector_type(8)));
typedef unsigned u32x4 __attribute__((ext_vector_type(4)));
typedef unsigned u32x2 __attribute__((ext_vector_type(2)));

constexpr int D = 1024, BATCH = 8, SEQ = 2048, DEPTH = 4, M = BATCH * SEQ;
constexpr int IN_COLS = 3592, IN_PAD = 3840, PROJ_W = 3584;
constexpr int NEXP = 16384;
constexpr float EPS = 1e-6f;
constexpr float QSCALE = 0.125f * 1.4426950408889634f;
constexpr int NWAVES = 8, NTHREADS = 512;
constexpr int LDS_BYTES = 163840;
constexpr int LDS_MISC_OFF = LDS_BYTES - 256;
constexpr int RS_OFF = 147456;
constexpr int CW_QUEUE = 1024;

constexpr size_t MiB = 1u << 20;
constexpr size_t WS_CTL = 0, CTL_ZERO_BYTES = 1 * MiB;
constexpr size_t WS_H = 1 * MiB;
constexpr size_t WS_HB0 = 65 * MiB;
constexpr size_t WS_HB1 = 97 * MiB;
constexpr size_t WS_HB2 = 129 * MiB;
constexpr size_t WS_PROJ = 161 * MiB;
constexpr size_t WS_BA = 273 * MiB;
constexpr size_t WS_OBUF = 274 * MiB;
constexpr size_t WS_Q2 = 306 * MiB;
constexpr size_t WS_EPRE = 370 * MiB;
constexpr size_t WS_IDX = 402 * MiB;
constexpr size_t WS_GATE = 410 * MiB;
constexpr size_t WS_STAT = 418 * MiB;
constexpr size_t WS_SS1 = WS_IDX + 1 * MiB, WS_SSE = WS_IDX;
constexpr size_t WS_ORAW = 422 * MiB;
constexpr size_t WS_WIN = 550 * MiB;
constexpr size_t WS_WOUT = 582 * MiB;
constexpr size_t WS_WQ = 590 * MiB;
constexpr size_t WS_WG = 606 * MiB;
constexpr size_t WS_WP = 614 * MiB;
constexpr size_t WS_SK = 616 * MiB;
constexpr size_t WS_PB = 618 * MiB;
constexpr size_t WS_U = 650 * MiB;
constexpr size_t WS_V = 778 * MiB;
constexpr size_t WS_SU = WS_STAT + 1 * MiB, WS_SV = WS_STAT + 2 * MiB;
constexpr size_t WS_END = 906 * MiB;

struct Params {
    const float *x, *p, *ln_mix_g, *w_in, *conv_w, *a_log, *dt_bias, *gdn_norm_g, *diff_lambda, *subln_g, *w_out, *ln_ffn_g,
        *peer_wq, *subkeys, *peer_u, *peer_v, *ple_wp, *ple_wg, *ple_norm_g, *final_g;
    float* out;
    unsigned char* ws;
    int pad0, pad1;
};

__device__ __forceinline__ int tidx() { int t = (int)threadIdx.x; asm volatile("" : "+v"(t)); return t; }
#define LDS_BARRIER() asm volatile("s_waitcnt lgkmcnt(0)\n\ts_barrier" ::: "memory")
__device__ __forceinline__ float bf2f(bf16 v) { return __uint_as_float((unsigned)v << 16); }
__device__ __forceinline__ unsigned f2bf(float f);
typedef __bf16 bf16x2_t __attribute__((ext_vector_type(2)));
typedef float f32x2_t __attribute__((ext_vector_type(2)));
__device__ __forceinline__ unsigned cvtpk(float lo, float hi) { f32x2_t v = {lo, hi}; bf16x2_t b = __builtin_convertvector(v, bf16x2_t); return __builtin_bit_cast(unsigned, b); }
__device__ __forceinline__ unsigned pk2(float lo, float hi) { return cvtpk(lo, hi); }
__device__ __forceinline__ unsigned f2bf(float f) { return cvtpk(f, 0.f) & 0xffffu; }
__device__ __forceinline__ float lo16(unsigned w) { return __uint_as_float(w << 16); }
__device__ __forceinline__ float hi16(unsigned w) { return __uint_as_float(w & 0xffff0000u); }
template <int N> __device__ __forceinline__ float dpp_ror(float x) { return __builtin_bit_cast(float, __builtin_amdgcn_mov_dpp(__builtin_bit_cast(int, x), 0x120 + N, 0xf, 0xf, true)); }
template <int N> __device__ __forceinline__ unsigned dpp_ror_u(unsigned x) { return (unsigned)__builtin_amdgcn_mov_dpp((int)x, 0x120 + N, 0xf, 0xf, true); }
__device__ __forceinline__ float row16_sum(float x) { x += dpp_ror<8>(x); x += dpp_ror<4>(x); x += dpp_ror<2>(x); x += dpp_ror<1>(x); return x; }
__device__ __forceinline__ float row16_max(float x) { x = fmaxf(x, dpp_ror<8>(x)); x = fmaxf(x, dpp_ror<4>(x)); x = fmaxf(x, dpp_ror<2>(x)); x = fmaxf(x, dpp_ror<1>(x)); return x; }
__device__ __forceinline__ unsigned row16_umax(unsigned x) { unsigned y;
    y = dpp_ror_u<8>(x); x = x > y ? x : y; y = dpp_ror_u<4>(x); x = x > y ? x : y; y = dpp_ror_u<2>(x); x = x > y ? x : y; y = dpp_ror_u<1>(x); x = x > y ? x : y; return x; }
__device__ __forceinline__ float xrow16_max(float x) {
    auto s = __builtin_amdgcn_permlane16_swap(__float_as_uint(x), __float_as_uint(x), false, false);
    x = fmaxf(__uint_as_float(s[0]), __uint_as_float(s[1]));
    auto t = __builtin_amdgcn_permlane32_swap(__float_as_uint(x), __float_as_uint(x), false, false);
    return fmaxf(__uint_as_float(t[0]), __uint_as_float(t[1]));
}
__device__ __forceinline__ float xrow16_sum(float x) {
    auto s = __builtin_amdgcn_permlane16_swap(__float_as_uint(x), __float_as_uint(x), false, false);
    x = __uint_as_float(s[0]) + __uint_as_float(s[1]);
    auto t = __builtin_amdgcn_permlane32_swap(__float_as_uint(x), __float_as_uint(x), false, false);
    return __uint_as_float(t[0]) + __uint_as_float(t[1]);
}
__device__ __forceinline__ float wave_sum(float v) { return xrow16_sum(row16_sum(v)); }
template <int N> __device__ __forceinline__ int dpp_ror_i(int x) { return __builtin_amdgcn_mov_dpp(x, 0x120 + N, 0xf, 0xf, true); }
__device__ __forceinline__ int wave_isum(int x) {
    x += dpp_ror_i<8>(x); x += dpp_ror_i<4>(x); x += dpp_ror_i<2>(x); x += dpp_ror_i<1>(x);
    auto s = __builtin_amdgcn_permlane16_swap((unsigned)x, (unsigned)x, false, false); x = (int)(s[0] + s[1]);
    auto t = __builtin_amdgcn_permlane32_swap((unsigned)x, (unsigned)x, false, false); return (int)(t[0] + t[1]);
}
__device__ __forceinline__ float wave_max(float v) {
#pragma unroll
    for (int o = 32; o; o >>= 1) v = fmaxf(v, __shfl_xor(v, o));
    return v;
}
__device__ __forceinline__ float sigmoidf_(float x) { return __builtin_amdgcn_rcpf(1.f + __expf(-x)); }
__device__ __forceinline__ float dot8(u32x4 a, u32x4 b, float s) {
#pragma unroll
    for (int i = 0; i < 4; ++i) { s += lo16(a[i]) * lo16(b[i]); s += hi16(a[i]) * hi16(b[i]); }
    return s;
}

__host__ __device__ __forceinline__ int lds_byte(int r, int c) { const int st = (r >> 4) * 2 + (c >> 5), rr = r & 15, cc = c & 31, ob = rr * 64 + cc * 2; return st * 1024 + (ob ^ (((ob >> 9) & 1) << 5)); }
__host__ __device__ __forceinline__ void stage_rc(int b, int& R, int& C) { const int st = b / 1024, sb = b % 1024, swz = sb ^ (((sb >> 9) & 1) << 5); R = (st >> 1) * 16 + swz / 64; C = (st & 1) * 32 + (swz % 64) / 2; }
constexpr int HTB = 16384;
template <class F>
__device__ __forceinline__ void gemm_run(LAS unsigned char* lds, const bf16* A, const bf16* Bt, int Mm, int N, int K, const F& f, int bid, int nblk, const float* slots_in = nullptr) {
    LAS float* RS = (LAS float*)(lds + RS_OFF);
    int rs_pm = -1;
    const int tid = tidx(), wid = __builtin_amdgcn_readfirstlane(tid >> 6), lane = tid & 63, wr = wid >> 2, wc = wid & 3, fr = lane & 15, fq = lane >> 4;
    const int nt = K / 64, ntn = N / 256, nunits = (Mm / 256) * ntn;
    unsigned voff[2];
#pragma unroll
    for (int i = 0; i < 2; ++i) { const int uu = tid + 512 * i, r = uu >> 3, c = (uu & 7) ^ ((r >> 1) & 7); voff[i] = (unsigned)(r * K + c * 8) * 2u; }
    const unsigned ldsw = (unsigned)wid * 1024u;
    const int sw7 = (fr >> 1) & 7;
    const int aoff0 = wr * HTB + fr * 128 + ((fq ^ sw7) << 4), aoff1 = wr * HTB + fr * 128 + (((4 + fq) ^ sw7) << 4);
    const int bbase = (2 + (wc >> 1)) * HTB + (wc & 1) * 8192 + fr * 128;
    const int boff0 = bbase + ((fq ^ sw7) << 4), boff1 = bbase + (((4 + fq) ^ sw7) << 4);
#define G_STAGE(bufoff, gbase) do { _Pragma("unroll") for (int _i = 0; _i < 2; ++_i) \
        __builtin_amdgcn_global_load_lds((const unsigned*)((const char*)(gbase) + voff[_i]), (LAS unsigned*)(lds + (bufoff) + ldsw + _i * 8192), 16, 0, 0); } while (0)
    for (int u = bid; u < nunits; u += nblk) {
        const int pm = u % (Mm / 256), pn = u / (Mm / 256);
        if (slots_in && pm != rs_pm) {
            __syncthreads();
            if (tid < 256) { const f32x4* sp = (const f32x4*)(slots_in + ((size_t)pm * 256 + tid) * 16);
                const f32x4 a = sp[0], b = sp[1], c = sp[2], d = sp[3];
                const float s = (((a[0] + a[1]) + (a[2] + a[3])) + ((b[0] + b[1]) + (b[2] + b[3]))) + (((c[0] + c[1]) + (c[2] + c[3])) + ((d[0] + d[1]) + (d[2] + d[3])));
                RS[tid] = rsqrtf(s * (1.f / D) + EPS); }
            __syncthreads();
            rs_pm = pm;
        }
        const char* gA = (const char*)(A + (size_t)pm * 256 * K);
        const char* gB = (const char*)(Bt + (size_t)pn * 256 * K);
        const size_t hstep = (size_t)128 * K * 2;
        f32x4 acc[8][4];
#pragma unroll
        for (int a = 0; a < 8; ++a)
#pragma unroll
            for (int b = 0; b < 4; ++b) acc[a][b] = (f32x4){0.f, 0.f, 0.f, 0.f};
        G_STAGE(0, gA); G_STAGE(HTB, gA + hstep); G_STAGE(2 * HTB, gB); G_STAGE(3 * HTB, gB + hstep);
        for (int t = 0; t < nt; ++t) {
            const int cb = (t & 1) * 4 * HTB, nb = ((t + 1) & 1) * 4 * HTB;
            asm volatile("s_waitcnt vmcnt(0)" ::: "memory");
            __builtin_amdgcn_s_barrier();
            asm volatile("" ::: "memory");
            const size_t ko = (size_t)(t + 1) * 128; const bool more = t + 1 < nt;
#pragma unroll
            for (int k = 0; k < 2; ++k) {
                if (more) { if (k == 0) { G_STAGE(nb, gA + ko); G_STAGE(nb + 2 * HTB, gB + ko); } else { G_STAGE(nb + HTB, gA + hstep + ko); G_STAGE(nb + 3 * HTB, gB + hstep + ko); } }
                bf16x8 bfr[4], acur, anxt;
#pragma unroll
                for (int n = 0; n < 4; ++n) bfr[n] = *(const LAS bf16x8*)(lds + cb + (k ? boff1 : boff0) + n * 2048);
                acur = *(const LAS bf16x8*)(lds + cb + (k ? aoff1 : aoff0));
#pragma unroll
                for (int m = 0; m < 8; ++m) {
                    if (m < 7) anxt = *(const LAS bf16x8*)(lds + cb + (k ? aoff1 : aoff0) + (m + 1) * 2048);
#pragma unroll
                    for (int n = 0; n < 4; ++n) acc[m][n] = __builtin_amdgcn_mfma_f32_16x16x32_bf16(bfr[n], acur, acc[m][n], 0, 0, 0);
                    acur = anxt;
                }
                __builtin_amdgcn_sched_barrier(0);
            }
            asm volatile("s_waitcnt lgkmcnt(0)" ::: "memory");
        }
        {
            int el = lane; asm volatile("" : "+v"(el));
            const int efr = el & 15, efq = el >> 4;
            LAS float* et = (LAS float*)(lds + wid * 4352);
#pragma unroll
            for (int m = 0; m < 8; ++m) {
#pragma unroll
                for (int n = 0; n < 4; ++n) *(LAS f32x4*)(et + efr * 68 + n * 16 + 4 * efq) = acc[m][n];
                asm volatile("s_waitcnt lgkmcnt(0)" ::: "memory");
#pragma unroll
                for (int i = 0; i < 4; ++i) {
                    const int lrow = wr * 128 + m * 16 + 4 * i + efq, row = pm * 256 + lrow;
                    const f32x4 v = *(const LAS f32x4*)(et + (4 * i + efq) * 68 + 4 * efr);
                    const f32x4 r = f(row, RS[lrow], pn * 256 + wc * 64 + 4 * efr, v);
                    if constexpr (F::STATS) { const float ssq = row16_sum((r[0] * r[0] + r[1] * r[1]) + (r[2] * r[2] + r[3] * r[3])); if (efr == 0) f.slots[(size_t)row * 16 + pn * 4 + wc] = ssq; }
                }
                asm volatile("s_waitcnt lgkmcnt(0)" ::: "memory");
                __builtin_amdgcn_sched_barrier(0);
            }
        }
        __syncthreads();
    }
#undef G_STAGE
}

__device__ __forceinline__ u32x2 pk4(f32x4 a) { u32x2 o; o.x = pk2(a[0], a[1]); o.y = pk2(a[2], a[3]); return o; }
struct EpiProj {
    static constexpr bool STATS = false; float* slots;
    bf16* proj; float* ba;
    __device__ __forceinline__ f32x4 operator()(int row, float rstd, int col, f32x4 v) const {
        v = v * rstd;
        if (col < PROJ_W) *(u32x2*)(proj + (size_t)row * PROJ_W + col) = pk4(v);
        else if (col < IN_COLS) *(f32x4*)(ba + (size_t)row * 8 + (col - PROJ_W)) = v;
        return v;
    }
};
struct EpiRes {
    static constexpr bool STATS = true; float* slots;
    float* H; bf16* HB;
    __device__ __forceinline__ f32x4 operator()(int row, float, int col, f32x4 v) const {
        f32x4* hp = (f32x4*)(H + (size_t)row * D + col);
        const f32x4 h = *hp + v; *hp = h;
        *(u32x2*)(HB + (size_t)row * D + col) = pk4(h);
        return h;
    }
};
struct EpiQ2 {
    static constexpr bool STATS = false; float* slots;
    bf16* Q2;
    __device__ __forceinline__ f32x4 operator()(int row, float rstd, int col, f32x4 v) const { v = v * rstd; *(u32x2*)(Q2 + (size_t)row * 2048 + col) = pk4(v); return v; }
};
struct EpiE {
    static constexpr bool STATS = true; float* slots;
    bf16* E;
    __device__ __forceinline__ f32x4 operator()(int row, float, int col, f32x4 v) const { *(u32x2*)(E + (size_t)row * D + col) = pk4(v); return v; }
};
struct EpiPle {
    static constexpr bool STATS = true; float* slots;
    float* H; bf16* HB; const bf16* E; const float* g;
    __device__ __forceinline__ f32x4 operator()(int row, float rstde, int col, f32x4 v) const {
        f32x4* hp = (f32x4*)(H + (size_t)row * D + col);
        const u32x2 ev = *(const u32x2*)(E + (size_t)row * D + col);
        const f32x4 gv = *(const f32x4*)(g + col);
        f32x4 h = *hp;
        h[0] += sigmoidf_(v[0]) * (lo16(ev.x) * rstde * gv[0]); h[1] += sigmoidf_(v[1]) * (hi16(ev.x) * rstde * gv[1]);
        h[2] += sigmoidf_(v[2]) * (lo16(ev.y) * rstde * gv[2]); h[3] += sigmoidf_(v[3]) * (hi16(ev.y) * rstde * gv[3]);
        *hp = h;
        *(u32x2*)(HB + (size_t)row * D + col) = pk4(h);
        return h;
    }
};

__device__ __forceinline__ void transpose_item(const float* W, int K, int N, int Npad, bf16* WT, const float* rowscale, int qcols, float* scr, int item, int lane) {
    const int nblk = Npad / 32, kb = item / nblk, nb = item % nblk, k0 = 64 * kb, n0 = 32 * nb;
    const int nq = n0 + 4 * (lane & 7);
#pragma unroll
    for (int i = 0; i < 8; ++i) {
        const int kk = 8 * i + (lane >> 3);
        f32x4 v = (nq < N) ? *(const f32x4*)(W + (size_t)(k0 + kk) * N + nq) : (f32x4){0.f, 0.f, 0.f, 0.f};
        if (rowscale) v = v * rowscale[k0 + kk];
        if (nq < qcols) v = v * QSCALE;
        scr[kk * 33 + 4 * (lane & 7)] = v[0]; scr[kk * 33 + 4 * (lane & 7) + 1] = v[1]; scr[kk * 33 + 4 * (lane & 7) + 2] = v[2]; scr[kk * 33 + 4 * (lane & 7) + 3] = v[3];
    }
    asm volatile("s_waitcnt lgkmcnt(0)" ::: "memory");
    const int c = lane & 7;
#pragma unroll
    for (int j = 0; j < 4; ++j) {
        const int nn = (lane >> 3) + 8 * j; const float* s = scr + (8 * c) * 33 + nn;
        u32x4 o; o.x = pk2(s[0 * 33], s[1 * 33]); o.y = pk2(s[2 * 33], s[3 * 33]); o.z = pk2(s[4 * 33], s[5 * 33]); o.w = pk2(s[6 * 33], s[7 * 33]);
        *(u32x4*)(WT + (size_t)(n0 + nn) * K + k0 + 8 * c) = o;
    }
    asm volatile("s_waitcnt lgkmcnt(0)" ::: "memory");
}
__device__ __forceinline__ void convert_bulk(const float* src, bf16* dst, size_t n, size_t gtid, size_t nthr) {
    for (size_t i = gtid * 8; i < n; i += nthr * 8) {
        const f32x4 a = *(const f32x4*)(src + i), b = *(const f32x4*)(src + i + 4);
        u32x4 o; o.x = pk2(a[0], a[1]); o.y = pk2(a[2], a[3]); o.z = pk2(b[0], b[1]); o.w = pk2(b[2], b[3]);
        *(u32x4*)(dst + i) = o;
    }
}
__device__ void phase_prologue(const Params& p, LAS unsigned char* lds_, int bid, int nblk) {
    unsigned char* lds = (unsigned char*)lds_;
    const int tid = tidx(), lane = tid & 63, w = tid >> 6;
    const int gw = bid * NWAVES + w, NGW = nblk * NWAVES;
    float* scr = (float*)(lds + w * 16384);
    constexpr int I_IN = 16 * (IN_PAD / 32), I_OUT = 16 * 32, I_Q = 16 * 64, I_G = 16 * 32, I_P = 4 * 32, I_L = I_IN + I_OUT + I_Q + I_G + I_P;
    for (int it = gw; it < DEPTH * I_L; it += NGW) {
        const int L = it / I_L; int r = it % I_L;
        if (r < I_IN) { transpose_item(p.w_in + (size_t)L * D * IN_COLS, D, IN_COLS, IN_PAD, (bf16*)(p.ws + WS_WIN) + (size_t)L * IN_PAD * D, p.ln_mix_g + L * D, 512, scr, r, lane); continue; } r -= I_IN;
        if (r < I_OUT) { transpose_item(p.w_out + (size_t)L * D * D, D, D, D, (bf16*)(p.ws + WS_WOUT) + (size_t)L * D * D, nullptr, 0, scr, r, lane); continue; } r -= I_OUT;
        if (r < I_Q) { transpose_item(p.peer_wq + (size_t)L * D * 2048, D, 2048, 2048, (bf16*)(p.ws + WS_WQ) + (size_t)L * 2048 * D, p.ln_ffn_g + L * D, 0, scr, r, lane); continue; } r -= I_Q;
        if (r < I_G) { transpose_item(p.ple_wg + (size_t)L * D * D, D, D, D, (bf16*)(p.ws + WS_WG) + (size_t)L * D * D, nullptr, 0, scr, r, lane); continue; } r -= I_G;
        transpose_item(p.ple_wp + (size_t)L * 256 * D, 256, D, D, (bf16*)(p.ws + WS_WP) + (size_t)L * D * 256, nullptr, 0, scr, r, lane);
    }
    const size_t gtid = (size_t)bid * NTHREADS + tid, nthr = (size_t)nblk * NTHREADS;
    for (int r = gw; r < 2 * DEPTH * NEXP; r += NGW) {
        const int which = r >= DEPTH * NEXP, rr = which ? r - DEPTH * NEXP : r;
        const float* srow = (which ? p.peer_v : p.peer_u) + (size_t)rr * D + 4 * lane;
        f32x4 v[4];
#pragma unroll
        for (int j = 0; j < 4; ++j) v[j] = *(const f32x4*)(srow + 256 * j);
        float mx = 0.f;
#pragma unroll
        for (int j = 0; j < 4; ++j) mx = fmaxf(mx, fmaxf(fmaxf(fabsf(v[j][0]), fabsf(v[j][1])), fmaxf(fabsf(v[j][2]), fabsf(v[j][3]))));
        mx = xrow16_max(row16_max(mx));
        const float inv = mx > 0.f ? 127.f / mx : 0.f;
        u32x4 o;
#pragma unroll
        for (int j = 0; j < 4; ++j) {
            const unsigned b0 = (unsigned)__float2int_rn(v[j][0] * inv) & 0xffu, b1 = (unsigned)__float2int_rn(v[j][1] * inv) & 0xffu, b2 = (unsigned)__float2int_rn(v[j][2] * inv) & 0xffu, b3 = (unsigned)__float2int_rn(v[j][3] * inv) & 0xffu;
            o[j] = b0 | (b1 << 8) | (b2 << 16) | (b3 << 24);
        }
        *(u32x4*)(p.ws + (which ? WS_V : WS_U) + (size_t)rr * D + 16 * lane) = o;
        if (lane == 0) ((float*)(p.ws + (which ? WS_SV : WS_SU)))[rr] = mx * (1.f / 127.f);
    }
    convert_bulk(p.p, (bf16*)(p.ws + WS_PB), (size_t)DEPTH * M * 256, gtid, nthr);
    convert_bulk(p.subkeys, (bf16*)(p.ws + WS_SK), (size_t)DEPTH * 8 * 2 * 128 * 128, gtid, nthr);
    float* H = (float*)(p.ws + WS_H); bf16* HB0 = (bf16*)(p.ws + WS_HB0); float* ss0 = (float*)(p.ws + WS_STAT);
    for (int m = gw; m < M; m += NGW) {
        const f32x4* xr = (const f32x4*)(p.x + (size_t)m * D) + lane;
        float ss = 0.f;
#pragma unroll
        for (int j = 0; j < 4; ++j) {
            const f32x4 v = xr[64 * j];
            ss += v[0] * v[0] + v[1] * v[1] + v[2] * v[2] + v[3] * v[3];
            ((f32x4*)(H + (size_t)m * D))[lane + 64 * j] = v;
            u32x2 o; o.x = pk2(v[0], v[1]); o.y = pk2(v[2], v[3]);
            ((u32x2*)(HB0 + (size_t)m * D))[lane + 64 * j] = o;
        }
        ss = wave_sum(ss);
        if (lane < 16) ss0[(size_t)m * 16 + lane] = lane == 0 ? ss : 0.f;
    }
}

typedef short v4i16_t __attribute__((ext_vector_type(4)));
__device__ __forceinline__ void glds16_asm(const void* gsrc, unsigned lds_dst) {
    unsigned keep;
    asm volatile("s_mov_b32 %0, m0\n\ts_mov_b32 m0, %2\n\ts_nop 0\n\tglobal_load_lds_dwordx4 %1, off\n\ts_mov_b32 m0, %0" : "=&s"(keep) : "v"(gsrc), "s"(lds_dst) : "memory");
}
__device__ __forceinline__ float max3_(float a, float b, float c) { float r; asm("v_max3_f32 %0, %1, %2, %3" : "=v"(r) : "v"(a), "v"(b), "v"(c)); return r; }
constexpr int ATT_BUF = 32768, ATT_VOFF = 16384;
__device__ __forceinline__ void att_unit(const Params& p, int L, LAS unsigned char* lds, int tid, int b, int hh, int qb, float lam, float lam_init) {
    const int lane = tid & 63, w = __builtin_amdgcn_readfirstlane(tid >> 6), fr = lane & 15, fq = lane >> 4;
    const bool grpB = w >= 4;
    const bf16* proj = (const bf16*)(p.ws + WS_PROJ);
    bf16* obuf = (bf16*)(p.ws + WS_OBUF);
    const float slope2 = 1.4426950408889634f / (float)(1 << (2 * (hh + 1)));
    const bf16* kbase = proj + (size_t)b * SEQ * PROJ_W + 512 + hh * 128;
    const bf16* vbase = proj + (size_t)b * SEQ * PROJ_W + 1024 + hh * 128;
    const int qw0 = qb * 128 + w * 16, T = 2 * (qb + 1);
    const int S_w = ((qw0 + 15) >> 6) + 1;
    bf16x8 qf[2][2];
#pragma unroll
    for (int mp = 0; mp < 2; ++mp)
#pragma unroll
        for (int ks = 0; ks < 2; ++ks) qf[mp][ks] = *(const bf16x8*)(proj + ((size_t)b * SEQ + qw0 + fr) * PROJ_W + hh * 128 + mp * 64 + ks * 32 + 8 * fq);
    f32x4 o[2][8];
#pragma unroll
    for (int mp = 0; mp < 2; ++mp)
#pragma unroll
        for (int dt = 0; dt < 8; ++dt) o[mp][dt] = (f32x4){0.f, 0.f, 0.f, 0.f};
    float mrun[2] = {-INFINITY, -INFINITY}, lrun[2] = {0.f, 0.f};
    int ksrc[2], vsrc[2];
#pragma unroll
    for (int i = 0; i < 2; ++i) { const int pc = tid + 512 * i, key = pc >> 4, ph = pc & 15;
        ksrc[i] = key * PROJ_W + ((ph ^ (key & 15)) * 8); vsrc[i] = key * PROJ_W + ((ph ^ ((key & 7) << 1)) * 8); }
    const unsigned ldsb = (unsigned)(size_t)lds;
    auto dma = [&](int t, int bo) {
#pragma unroll
        for (int i = 0; i < 2; ++i) {
            glds16_asm(kbase + (size_t)t * 64 * PROJ_W + ksrc[i], ldsb + bo + (w * 64 + 512 * i) * 16);
            glds16_asm(vbase + (size_t)t * 64 * PROJ_W + vsrc[i], ldsb + bo + ATT_VOFF + (w * 64 + 512 * i) * 16);
        }
    };
    int koff[2][2];
#pragma unroll
    for (int mp = 0; mp < 2; ++mp)
#pragma unroll
        for (int ks = 0; ks < 2; ++ks) koff[mp][ks] = fr * 256 + (((mp * 8 + ks * 4 + fq) ^ fr) << 4);
    const int gl = lane & 15;
    const int vrd0 = ATT_VOFF + (4 * fq + (gl >> 2)) * 256 + (gl & 3) * 8 + ((4 * (fq & 1) + (gl >> 2)) << 5);
    bf16x8 pb[2][2];
#pragma unroll
    for (int mp = 0; mp < 2; ++mp)
#pragma unroll
        for (int ks = 0; ks < 2; ++ks) pb[mp][ks] = qf[0][0];
#define ATT_SB() __builtin_amdgcn_sched_barrier(0)
#define ATT_VRD(dt) do { _Pragma("unroll") for (int q_ = 0; q_ < 4; ++q_) vf_[dt][q_] = __builtin_amdgcn_ds_read_tr16_b64_v4i16((LAS v4i16_t*)(lds + ((vb_ ^ ((dt) << 5)) + q_ * 4096))); } while (0)
#define ATT_VMM(PB, dt) do { _Pragma("unroll") for (int ks = 0; ks < 2; ++ks) { const v4i16_t v0 = vf_[dt][2 * ks], v1 = vf_[dt][2 * ks + 1]; \
            bf16x8 vf; vf[0] = v0[0]; vf[1] = v0[1]; vf[2] = v0[2]; vf[3] = v0[3]; vf[4] = v1[0]; vf[5] = v1[1]; vf[6] = v1[2]; vf[7] = v1[3]; \
            o[0][dt] = __builtin_amdgcn_mfma_f32_16x16x32_bf16(vf, PB[0][ks], o[0][dt], 0, 0, 0); \
            o[1][dt] = __builtin_amdgcn_mfma_f32_16x16x32_bf16(vf, PB[1][ks], o[1][dt], 0, 0, 0); } } while (0)
#define ATT_PV(PB, BO) do { const int vb_ = (BO) + vrd0; v4i16_t vf_[8][4]; \
        ATT_VRD(0); ATT_VRD(1); ATT_VRD(2); ATT_VRD(3); ATT_SB(); \
        ATT_VMM(PB, 0); ATT_VRD(4); ATT_SB(); ATT_VMM(PB, 1); ATT_VRD(5); ATT_SB(); ATT_VMM(PB, 2); ATT_VRD(6); ATT_SB(); ATT_VMM(PB, 3); ATT_VRD(7); ATT_SB(); \
        ATT_VMM(PB, 4); ATT_VMM(PB, 5); ATT_VMM(PB, 6); ATT_VMM(PB, 7); ATT_SB(); } while (0)
    dma(0, 0);
    asm volatile("" :: "v"(qf[0][0]), "v"(qf[0][1]), "v"(qf[1][0]), "v"(qf[1][1]));
    int bo_prev = 2 * ATT_BUF, bo_cur = 0, bo_next = ATT_BUF;
    for (int s = 0; s < T; ++s) {
        const int k0 = s * 64;
        asm volatile("s_waitcnt vmcnt(0)" ::: "memory");
        LDS_BARRIER();
        if (s + 1 < T) dma(s + 1, bo_next);
        if (grpB && s > 0 && s <= S_w) ATT_PV(pb, bo_prev);
        if (s < S_w) {
            f32x4 sc[2][4];
            const float base = -slope2 * (float)(qw0 + fr - k0 - 4 * fq);
#pragma unroll
            for (int kt = 0; kt < 4; ++kt)
#pragma unroll
                for (int r = 0; r < 4; ++r) { const float v = base + slope2 * (float)(16 * kt + r); sc[0][kt][r] = v; sc[1][kt][r] = v; }
            {
                bf16x8 kf[4][2][2];
#define ATT_KRD(kt) do { _Pragma("unroll") for (int mp = 0; mp < 2; ++mp) _Pragma("unroll") for (int ks = 0; ks < 2; ++ks) kf[kt][mp][ks] = *(const LAS bf16x8*)(lds + bo_cur + (kt) * 4096 + koff[mp][ks]); } while (0)
#define ATT_KMM(kt) do { _Pragma("unroll") for (int ks = 0; ks < 2; ++ks) _Pragma("unroll") for (int mp = 0; mp < 2; ++mp) sc[mp][kt] = __builtin_amdgcn_mfma_f32_16x16x32_bf16(kf[kt][mp][ks], qf[mp][ks], sc[mp][kt], 0, 0, 0); } while (0)
                ATT_KRD(0); ATT_KRD(1); ATT_SB();
                ATT_KMM(0); ATT_KRD(2); ATT_SB();
                ATT_KMM(1); ATT_KRD(3); ATT_SB();
                ATT_KMM(2); ATT_KMM(3); ATT_SB();
#undef ATT_KRD
#undef ATT_KMM
            }
            if (k0 + 63 > qw0) {
                const int lim = qw0 + fr - k0 - 4 * fq;
#pragma unroll
                for (int mp = 0; mp < 2; ++mp)
#pragma unroll
                    for (int kt = 0; kt < 4; ++kt)
#pragma unroll
                        for (int r = 0; r < 4; ++r) if (16 * kt + r > lim) sc[mp][kt][r] = -INFINITY;
            }
#pragma unroll
            for (int mp = 0; mp < 2; ++mp) {
                float mx = max3_(sc[mp][0][0], sc[mp][0][1], sc[mp][0][2]);
                mx = max3_(mx, sc[mp][0][3], sc[mp][1][0]);
#pragma unroll
                for (int kt = 1; kt < 4; ++kt) { mx = max3_(mx, sc[mp][kt][1], sc[mp][kt][2]); if (kt < 3) mx = max3_(mx, sc[mp][kt][3], sc[mp][kt + 1][0]); else mx = max3_(mx, sc[mp][kt][3], mx); }
                mx = xrow16_max(mx);
                const float mnew = fmaxf(mrun[mp], mx);
                const float alpha = __builtin_amdgcn_exp2f(mrun[mp] - mnew);
                mrun[mp] = mnew;
                float ps = 0.f;
#pragma unroll
                for (int kt = 0; kt < 4; ++kt)
#pragma unroll
                    for (int r = 0; r < 4; ++r) { const float e = __builtin_amdgcn_exp2f(sc[mp][kt][r] - mnew); sc[mp][kt][r] = e; ps += e; }
                lrun[mp] = lrun[mp] * alpha + ps;
#pragma unroll
                for (int ks = 0; ks < 2; ++ks) {
                    u32x4 pk; pk.x = cvtpk(sc[mp][2 * ks][0], sc[mp][2 * ks][1]); pk.y = cvtpk(sc[mp][2 * ks][2], sc[mp][2 * ks][3]);
                    pk.z = cvtpk(sc[mp][2 * ks + 1][0], sc[mp][2 * ks + 1][1]); pk.w = cvtpk(sc[mp][2 * ks + 1][2], sc[mp][2 * ks + 1][3]);
                    pb[mp][ks] = __builtin_bit_cast(bf16x8, pk);
                }
#pragma unroll
                for (int dt = 0; dt < 8; ++dt) o[mp][dt] = o[mp][dt] * alpha;
            }
            if (!grpB) ATT_PV(pb, bo_cur);
        }
        const int tb = bo_prev; bo_prev = bo_cur; bo_cur = bo_next; bo_next = tb;
    }
    if (grpB && S_w == T) ATT_PV(pb, bo_prev);
#undef ATT_PV
#undef ATT_VRD
#undef ATT_VMM
#undef ATT_SB
    const float i1 = __builtin_amdgcn_rcpf(xrow16_sum(lrun[0])), i2 = lam * __builtin_amdgcn_rcpf(xrow16_sum(lrun[1]));
    float ss = 0.f;
#pragma unroll
    for (int dt = 0; dt < 8; ++dt)
#pragma unroll
        for (int r = 0; r < 4; ++r) { const float v = o[0][dt][r] * i1 - o[1][dt][r] * i2; o[0][dt][r] = v; ss += v * v; }
    ss = xrow16_sum(ss);
    const float rn = rsqrtf(ss * (1.f / 128.f) + EPS) * (1.f - lam_init);
    const float* g = p.subln_g + L * 128;
    bf16* orow = obuf + ((size_t)b * SEQ + qw0 + fr) * D + hh * 128;
#pragma unroll
    for (int dt = 0; dt < 8; ++dt) {
        const f32x4 gv = *(const f32x4*)(g + 16 * dt + 4 * fq);
        u32x2 ov; ov.x = pk2(o[0][dt][0] * rn * gv[0], o[0][dt][1] * rn * gv[1]); ov.y = pk2(o[0][dt][2] * rn * gv[2], o[0][dt][3] * rn * gv[3]);
        *(u32x2*)(orow + 16 * dt + 4 * fq) = ov;
    }
}

__device__ void phase_att_queue(const Params& p, int L, LAS unsigned char* lds, int bid, int nblk) {
    const int tid = tidx(), lane = tid & 63;
    const float* lp = p.diff_lambda + L * 256;
    const float d1 = wave_sum(lp[lane] * lp[64 + lane]), d2 = wave_sum(lp[128 + lane] * lp[192 + lane]);
    const float lam_init = 0.8f - 0.6f * __expf(-0.3f * (float)L);
    const float lam = __expf(d1) - __expf(d2) + lam_init;
    unsigned* head = (unsigned*)(p.ws + WS_CTL) + CW_QUEUE + L;
    volatile LAS int* slot = (volatile LAS int*)(lds + LDS_MISC_OFF + 64);
    for (;;) {
        __syncthreads();
        if (tid == 0) *slot = (int)__hip_atomic_fetch_add(head, 1u, __ATOMIC_RELAXED, __HIP_MEMORY_SCOPE_AGENT);
        __syncthreads();
        const int u = *slot;
        if (u >= 512) break;
        att_unit(p, L, lds, tid, (u & 31) >> 2, u & 3, 15 - (u >> 5), lam, lam_init);
    }
}

constexpr size_t GD_WP = WS_ORAW, GD_QD = WS_ORAW + 16 * MiB, GD_AIP = WS_ORAW + 32 * MiB, GD_KDT = WS_ORAW + 40 * MiB, GD_UT = WS_ORAW + 56 * MiB, GD_GL = WS_ORAW + 72 * MiB;
__device__ __forceinline__ int perm_pos(int k) { return (k & ~31) + 8 * ((k >> 2) & 3) + 4 * ((k >> 4) & 1) + (k & 3); }
__device__ __forceinline__ float softplusf_(float x) { if (x > 20.f) return x; const float e = __expf(x); return e < 0.06f ? e * (1.f - e * (0.5f - e * (0.33333334f - 0.25f * e))) : __logf(1.f + e); }
__device__ __forceinline__ float gelu_erf(float v) {
    const float z = fabsf(v) * 0.70710678118654752f, t = __builtin_amdgcn_rcpf(1.f + 0.3275911f * z);
    const float pl = t * (0.254829592f + t * (-0.284496736f + t * (1.421413741f + t * (-1.453152027f + t * 1.061405429f))));
    const float er = 1.f - pl * __expf(-z * z);
    return 0.5f * v * (1.f + (v < 0.f ? -er : er));
}

constexpr int GP_KN = 0, GP_QN = 17408, GP_RT = 34816, GP_LM = 71680, GP_TB = 89088, GP_GT = 98304, GP_T0T = 99328;
constexpr int GP_KP = 272, GP_RP = 144, GP_LP = 68, GP_TP = 144;
__device__ void phase_gdn_prep(const Params& p, int L, LAS unsigned char* lds, int bid, int nblk) {
    const int tid = tidx(), lane = tid & 63, w = __builtin_amdgcn_readfirstlane(tid >> 6), fr = lane & 15, fq = lane >> 4;
    const bf16* proj = (const bf16*)(p.ws + WS_PROJ);
    const float* BA = (const float*)(p.ws + WS_BA);
    bf16* WP = (bf16*)(p.ws + GD_WP); bf16* QD = (bf16*)(p.ws + GD_QD); bf16* AIP = (bf16*)(p.ws + GD_AIP); bf16* KDT = (bf16*)(p.ws + GD_KDT); bf16* UT = (bf16*)(p.ws + GD_UT);
    float* GL = (float*)(p.ws + GD_GL);
    const float* cw = p.conv_w + (size_t)L * 4 * 1536;
    LAS float* beta_s = (LAS float*)(lds + GP_GT); LAS float* gc_s = beta_s + 64; LAS float* egc_s = gc_s + 64; LAS float* edl_s = egc_s + 64;
    LAS float* Lm = (LAS float*)(lds + GP_LM);
    for (int item = bid; item < 1024; item += nblk) {
        const int n = item & 31, bh = item >> 5, hh = bh & 3, b = bh >> 2, t0 = n * 64;
        const size_t row0 = (size_t)b * SEQ + t0;
        __syncthreads();
        const int colq = hh * 128 + 2 * lane;
        unsigned xq[11], xk[11], xv[11];
#pragma unroll
        for (int r = 0; r < 11; ++r) { const int tt = t0 + 8 * w - 3 + r;
            xq[r] = (tt >= 0) ? *(const unsigned*)(proj + ((size_t)b * SEQ + tt) * PROJ_W + 1536 + colq) : 0u;
            xk[r] = (tt >= 0) ? *(const unsigned*)(proj + ((size_t)b * SEQ + tt) * PROJ_W + 1536 + 512 + colq) : 0u;
            xv[r] = (tt >= 0) ? *(const unsigned*)(proj + ((size_t)b * SEQ + tt) * PROJ_W + 1536 + 1024 + colq) : 0u; }
        if (w == 0) {
            const float negA = -__expf(p.a_log[L * 4 + hh]), dtb = p.dt_bias[L * 4 + hh];
            const float bb = BA[(row0 + lane) * 8 + hh], aa = BA[(row0 + lane) * 8 + 4 + hh] + dtb;
            float c = negA * softplusf_(aa);
#pragma unroll
            for (int o = 1; o < 64; o <<= 1) { const float t = __shfl_up(c, o); if (lane >= o) c += t; }
            const float glast = __shfl(c, 63);
            beta_s[lane] = sigmoidf_(bb); gc_s[lane] = c; egc_s[lane] = __expf(c); edl_s[lane] = __expf(glast - c);
            if (lane == 0) GL[item] = __expf(glast);
        }
        __syncthreads();
        {
            {
                float wq[4][2];
#pragma unroll
                for (int j = 0; j < 4; ++j) { wq[j][0] = cw[j * 1536 + colq]; wq[j][1] = cw[j * 1536 + colq + 1]; }
#pragma unroll
                for (int i = 0; i < 8; ++i) {
                    const int c = 8 * w + i;
                    float q0 = 0.f, q1 = 0.f;
#pragma unroll
                    for (int j = 0; j < 4; ++j) { q0 += wq[j][0] * lo16(xq[i + j]); q1 += wq[j][1] * hi16(xq[i + j]); }
                    q0 *= sigmoidf_(q0); q1 *= sigmoidf_(q1);
                    const float sq = rsqrtf(wave_sum(q0 * q0 + q1 * q1) + EPS) * 0.08838834764831845f;
                    q0 *= sq; q1 *= sq;
                    const float eg = egc_s[c];
                    *(LAS unsigned*)(lds + GP_QN + c * GP_KP + lane * 4) = pk2(q0, q1);
                    *(unsigned*)(QD + ((size_t)item * 64 + c) * 128 + perm_pos(2 * lane)) = pk2(q0 * eg, q1 * eg);
                }
            }
            __builtin_amdgcn_sched_barrier(0);
            {
                float wk[4][2];
#pragma unroll
                for (int j = 0; j < 4; ++j) { wk[j][0] = cw[j * 1536 + 512 + colq]; wk[j][1] = cw[j * 1536 + 512 + colq + 1]; }
                unsigned kd0[8], kd1[8], rk0[8], rk1[8];
#pragma unroll
                for (int i = 0; i < 8; ++i) {
                    const int c = 8 * w + i;
                    float k0 = 0.f, k1 = 0.f;
#pragma unroll
                    for (int j = 0; j < 4; ++j) { k0 += wk[j][0] * lo16(xk[i + j]); k1 += wk[j][1] * hi16(xk[i + j]); }
                    k0 *= sigmoidf_(k0); k1 *= sigmoidf_(k1);
                    const float sk = rsqrtf(wave_sum(k0 * k0 + k1 * k1) + EPS);
                    k0 *= sk; k1 *= sk;
                    const float be = beta_s[c], eg = egc_s[c], ed = edl_s[c];
                    *(LAS unsigned*)(lds + GP_KN + c * GP_KP + lane * 4) = pk2(k0, k1);
                    kd0[i] = f2bf(k0 * ed); kd1[i] = f2bf(k1 * ed);
                    rk0[i] = f2bf(k0 * be * eg); rk1[i] = f2bf(k1 * be * eg);
                }
                u32x4 o;
                o.x = rk0[0] | (rk0[1] << 16); o.y = rk0[2] | (rk0[3] << 16); o.z = rk0[4] | (rk0[5] << 16); o.w = rk0[6] | (rk0[7] << 16); *(LAS u32x4*)(lds + GP_RT + (128 + 2 * lane) * GP_RP + 16 * w) = o;
                o.x = rk1[0] | (rk1[1] << 16); o.y = rk1[2] | (rk1[3] << 16); o.z = rk1[4] | (rk1[5] << 16); o.w = rk1[6] | (rk1[7] << 16); *(LAS u32x4*)(lds + GP_RT + (128 + 2 * lane + 1) * GP_RP + 16 * w) = o;
                const int pa = perm_pos(8 * w), pb = perm_pos(8 * w + 4);
                bf16* kr0 = KDT + ((size_t)item * 128 + 2 * lane) * 64; bf16* kr1 = kr0 + 64;
                u32x2 h2;
                h2.x = kd0[0] | (kd0[1] << 16); h2.y = kd0[2] | (kd0[3] << 16); *(u32x2*)(kr0 + pa) = h2;
                h2.x = kd0[4] | (kd0[5] << 16); h2.y = kd0[6] | (kd0[7] << 16); *(u32x2*)(kr0 + pb) = h2;
                h2.x = kd1[0] | (kd1[1] << 16); h2.y = kd1[2] | (kd1[3] << 16); *(u32x2*)(kr1 + pa) = h2;
                h2.x = kd1[4] | (kd1[5] << 16); h2.y = kd1[6] | (kd1[7] << 16); *(u32x2*)(kr1 + pb) = h2;
            }
            __builtin_amdgcn_sched_barrier(0);
            {
                float wv[4][2];
#pragma unroll
                for (int j = 0; j < 4; ++j) { wv[j][0] = cw[j * 1536 + 1024 + colq]; wv[j][1] = cw[j * 1536 + 1024 + colq + 1]; }
                unsigned rv0[8], rv1[8];
#pragma unroll
                for (int i = 0; i < 8; ++i) {
                    float v0 = 0.f, v1 = 0.f;
#pragma unroll
                    for (int j = 0; j < 4; ++j) { v0 += wv[j][0] * lo16(xv[i + j]); v1 += wv[j][1] * hi16(xv[i + j]); }
                    v0 *= sigmoidf_(v0); v1 *= sigmoidf_(v1);
                    const float be = beta_s[8 * w + i];
                    rv0[i] = f2bf(v0 * be); rv1[i] = f2bf(v1 * be);
                }
                u32x4 o;
                o.x = rv0[0] | (rv0[1] << 16); o.y = rv0[2] | (rv0[3] << 16); o.z = rv0[4] | (rv0[5] << 16); o.w = rv0[6] | (rv0[7] << 16); *(LAS u32x4*)(lds + GP_RT + (2 * lane) * GP_RP + 16 * w) = o;
                o.x = rv1[0] | (rv1[1] << 16); o.y = rv1[2] | (rv1[3] << 16); o.z = rv1[4] | (rv1[5] << 16); o.w = rv1[6] | (rv1[7] << 16); *(LAS u32x4*)(lds + GP_RT + (2 * lane + 1) * GP_RP + 16 * w) = o;
            }
        }
        __syncthreads();
#pragma unroll
        for (int q = 0; q < 2; ++q) {
            const int id = 2 * w + q, ct = id >> 2, st = id & 3;
            if (st <= ct) {
                f32x4 acc = (f32x4){0.f, 0.f, 0.f, 0.f};
#pragma unroll
                for (int ks = 0; ks < 4; ++ks) {
                    const bf16x8 a = *(const LAS bf16x8*)(lds + GP_KN + (16 * ct + fr) * GP_KP + (32 * ks + 8 * fq) * 2);
                    const bf16x8 bb = *(const LAS bf16x8*)(lds + GP_KN + (16 * st + fr) * GP_KP + (32 * ks + 8 * fq) * 2);
                    acc = __builtin_amdgcn_mfma_f32_16x16x32_bf16(a, bb, acc, 0, 0, 0);
                }
                const int s = 16 * st + fr; const float gs = gc_s[s];
#pragma unroll
                for (int r = 0; r < 4; ++r) { const int c = 16 * ct + 4 * fq + r;
                    Lm[c * GP_LP + s] = (s < c) ? beta_s[c] * acc[r] * __expf(fminf(gc_s[c] - gs, 0.f)) : 0.f; }
            }
        }
        __syncthreads();
        if (w < 2) {
            const int o = 32 * w;
            float t[32];
            int zoff = 0; asm volatile("" : "+v"(zoff));
            const LAS float* Lz = Lm + zoff + o * GP_LP + o;
            const int col = lane & 31;
#pragma unroll
            for (int i = 0; i < 32; ++i) {
                float a0 = (i == lane) ? 1.f : 0.f, a1 = 0.f, a2 = 0.f, a3 = 0.f;
#pragma unroll
                for (int s4 = 0; s4 + 4 <= i; s4 += 4) { const f32x4 lv = *(const LAS f32x4*)(Lz + i * GP_LP + s4);
                    a0 -= lv[0] * t[s4]; a1 -= lv[1] * t[s4 + 1]; a2 -= lv[2] * t[s4 + 2]; a3 -= lv[3] * t[s4 + 3]; }
#pragma unroll
                for (int s = i & ~3; s < i; ++s) a0 -= Lz[i * GP_LP + s] * t[s];
                t[i] = (lane < 32) ? (a0 + a1) + (a2 + a3) : 0.f;
                const bf16 tb = (bf16)f2bf(t[i]);
                if (w == 0) { *(LAS bf16*)(lds + GP_TB + i * GP_TP + lane * 2) = tb;
                              if (lane < 32) *(LAS bf16*)(lds + GP_T0T + lane * 80 + i * 2) = tb; }
                else if (lane < 32) *(LAS bf16*)(lds + GP_TB + (32 + i) * GP_TP + (32 + col) * 2) = tb;
                if ((i & 3) == 3) __builtin_amdgcn_sched_barrier(0);
            }
        } else {
            for (int id = w - 2; id < 16; id += 6) {
                const int ct = id >> 2, st = id & 3;
                f32x4 acc = (f32x4){0.f, 0.f, 0.f, 0.f};
                if (st <= ct) {
#pragma unroll
                    for (int ks = 0; ks < 4; ++ks) {
                        const bf16x8 a = *(const LAS bf16x8*)(lds + GP_QN + (16 * ct + fr) * GP_KP + (32 * ks + 8 * fq) * 2);
                        const bf16x8 bb = *(const LAS bf16x8*)(lds + GP_KN + (16 * st + fr) * GP_KP + (32 * ks + 8 * fq) * 2);
                        acc = __builtin_amdgcn_mfma_f32_16x16x32_bf16(a, bb, acc, 0, 0, 0);
                    }
                }
                const int s = 16 * st + fr; const float gs = gc_s[s]; const int ps = perm_pos(s);
#pragma unroll
                for (int r = 0; r < 4; ++r) { const int c = 16 * ct + 4 * fq + r;
                    const float v = (s <= c) ? acc[r] * __expf(fminf(gc_s[c] - gs, 0.f)) : 0.f;
                    AIP[((size_t)item * 64 + c) * 64 + ps] = (bf16)f2bf(v); }
            }
        }
        __syncthreads();
        if (w == 0) {
            f32x4 P[2][2];
#pragma unroll
            for (int it = 0; it < 2; ++it) {
                const LAS float* lr = Lm + (32 + 16 * it + fr) * GP_LP + 8 * fq;
                const f32x4 l0 = *(const LAS f32x4*)lr, l1 = *(const LAS f32x4*)(lr + 4);
                u32x4 pk; pk.x = cvtpk(l0[0], l0[1]); pk.y = cvtpk(l0[2], l0[3]); pk.z = cvtpk(l1[0], l1[1]); pk.w = cvtpk(l1[2], l1[3]);
                const bf16x8 a = __builtin_bit_cast(bf16x8, pk);
#pragma unroll
                for (int jt = 0; jt < 2; ++jt) {
                    const bf16x8 bb = *(const LAS bf16x8*)(lds + GP_T0T + (16 * jt + fr) * 80 + 16 * fq);
                    P[it][jt] = __builtin_amdgcn_mfma_f32_16x16x32_bf16(a, bb, (f32x4){0.f, 0.f, 0.f, 0.f}, 0, 0, 0);
                }
            }
#pragma unroll
            for (int jt = 0; jt < 2; ++jt) {
                u32x4 pk; pk.x = cvtpk(P[0][jt][0], P[0][jt][1]); pk.y = cvtpk(P[0][jt][2], P[0][jt][3]); pk.z = cvtpk(P[1][jt][0], P[1][jt][1]); pk.w = cvtpk(P[1][jt][2], P[1][jt][3]);
                const bf16x8 pb = __builtin_bit_cast(bf16x8, pk);
#pragma unroll
                for (int i2 = 0; i2 < 2; ++i2) {
                    const LAS unsigned char* tr = lds + GP_TB + (32 + 16 * i2 + fr) * GP_TP + (32 + 4 * fq) * 2;
                    const u32x2 ta = *(const LAS u32x2*)tr, tb2 = *(const LAS u32x2*)(tr + 32);
                    u32x4 ak; ak.x = ta.x; ak.y = ta.y; ak.z = tb2.x; ak.w = tb2.y;
                    const f32x4 r = __builtin_amdgcn_mfma_f32_16x16x32_bf16(__builtin_bit_cast(bf16x8, ak), pb, (f32x4){0.f, 0.f, 0.f, 0.f}, 0, 0, 0);
#pragma unroll
                    for (int q = 0; q < 4; ++q) *(LAS bf16*)(lds + GP_TB + (32 + 16 * i2 + 4 * fq + q) * GP_TP + (16 * jt + fr) * 2) = (bf16)f2bf(-r[q]);
                }
            }
        }
        __syncthreads();
#pragma unroll
        for (int q = 0; q < 2; ++q) {
            const int colt = 2 * w + q;
            bf16x8 af[2];
#pragma unroll
            for (int ks = 0; ks < 2; ++ks) af[ks] = *(const LAS bf16x8*)(lds + GP_RT + (16 * colt + fr) * GP_RP + (32 * ks + 8 * fq) * 2);
#pragma unroll
            for (int ct = 0; ct < 4; ++ct) {
                f32x4 acc = (f32x4){0.f, 0.f, 0.f, 0.f};
#pragma unroll
                for (int ks = 0; ks < 2; ++ks) {
                    const bf16x8 bb = *(const LAS bf16x8*)(lds + GP_TB + (16 * ct + fr) * GP_TP + (32 * ks + 8 * fq) * 2);
                    acc = __builtin_amdgcn_mfma_f32_16x16x32_bf16(af[ks], bb, acc, 0, 0, 0);
                }
                const int c = 16 * ct + fr;
                if (colt < 8) {
#pragma unroll
                    for (int r = 0; r < 4; ++r) UT[((size_t)item * 128 + 16 * colt + 4 * fq + r) * 64 + c] = (bf16)f2bf(acc[r]);
                } else {
                    const int kt = colt - 8;
                    u32x2 h2; h2.x = pk2(-acc[0], -acc[1]); h2.y = pk2(-acc[2], -acc[3]);
                    *(u32x2*)(WP + ((size_t)item * 64 + c) * 128 + 32 * (kt >> 1) + 8 * fq + 4 * (kt & 1)) = h2;
                }
            }
        }
    }
    __syncthreads();
}

constexpr int GS_WP = 0, GS_QD = 16384, GS_AIP = 32768, GS_KDT = 40960, GS_BUF = 57344, GS_OB = 2 * GS_BUF, GS_OBP = 272, GS_OBT = 64 * GS_OBP;
__device__ void phase_gdn_scan(const Params& p, int L, LAS unsigned char* lds, int bid, int nblk) {
    const int tid = tidx(), lane = tid & 63, w = __builtin_amdgcn_readfirstlane(tid >> 6), fr = lane & 15, fq = lane >> 4;
    const bf16* proj = (const bf16*)(p.ws + WS_PROJ);
    const bf16* WP = (const bf16*)(p.ws + GD_WP); const bf16* QD = (const bf16*)(p.ws + GD_QD); const bf16* AIP = (const bf16*)(p.ws + GD_AIP);
    const bf16* KDT = (const bf16*)(p.ws + GD_KDT); const bf16* UT = (const bf16*)(p.ws + GD_UT); const float* GL = (const float*)(p.ws + GD_GL);
    bf16* obuf = (bf16*)(p.ws + WS_OBUF);
    for (int item = bid; item < 32; item += nblk) {
        const int hh = item & 3, b = item >> 2;
        const int fc = tid >> 4, fv = tid & 15;
        float gn[8];
#pragma unroll
        for (int i = 0; i < 8; ++i) gn[i] = p.gdn_norm_g[L * 128 + 8 * fv + i];
        f32x4 S[8];
#pragma unroll
        for (int kt = 0; kt < 8; ++kt) S[kt] = (f32x4){0.f, 0.f, 0.f, 0.f};
        auto dma = [&](int ci, int buf) {
#pragma unroll
            for (int i = 0; i < 7; ++i) {
                const int pc = tid + 512 * i;
                const bf16* src;
                if (i < 2) { const int r = pc >> 4; src = WP + (size_t)ci * 8192 + r * 128 + (((pc & 15) ^ (r & 15)) * 8); }
                else if (i < 4) { const int q = pc - 1024, r = q >> 4; src = QD + (size_t)ci * 8192 + r * 128 + (((q & 15) ^ (r & 15)) * 8); }
                else if (i < 5) { const int q = pc - 2048, r = q >> 3; src = AIP + (size_t)ci * 4096 + r * 64 + (((q & 7) ^ ((r >> 1) & 7)) * 8); }
                else { const int q = pc - 2560, r = q >> 3; src = KDT + (size_t)ci * 8192 + r * 64 + (((q & 7) ^ ((r >> 1) & 7)) * 8); }
                __builtin_amdgcn_global_load_lds((const unsigned*)src, (LAS unsigned*)(lds + buf * GS_BUF + (w * 64 + 512 * i) * 16), 16, 0, 0);
            }
        };
        int offk[4], offa[2];
#pragma unroll
        for (int ks = 0; ks < 4; ++ks) offk[ks] = fr * 256 + (((4 * ks + fq) ^ fr) * 16);
#pragma unroll
        for (int ss = 0; ss < 2; ++ss) offa[ss] = fr * 128 + (((4 * ss + fq) ^ ((fr >> 1) & 7)) * 16);
        __syncthreads();
        dma(item * 32, 0);
        u32x2 ut[4]; float gl;
        {
            const int ci = item * 32;
#pragma unroll
            for (int ct = 0; ct < 4; ++ct) ut[ct] = *(const u32x2*)(UT + ((size_t)ci * 128 + 16 * w + fr) * 64 + 16 * ct + 4 * fq);
            gl = GL[ci];
        }
        u32x4 zp[2];
        zp[0] = (u32x4){0u, 0u, 0u, 0u}; zp[1] = zp[0];
        asm volatile("s_waitcnt vmcnt(0)" ::: "memory");
        __syncthreads();
#define GS_FINISH(ps, TILE, DST) do { const int c = 32 * (ps) + fc; \
            const u32x4 ov = *(const LAS u32x4*)(lds + (TILE) + c * GS_OBP + fv * 16); \
            float o8[8]; \
            _Pragma("unroll") for (int i = 0; i < 4; ++i) { o8[2 * i] = lo16(ov[i]); o8[2 * i + 1] = hi16(ov[i]); } \
            float ss = 0.f; \
            _Pragma("unroll") for (int i = 0; i < 8; ++i) ss += o8[i] * o8[i]; \
            const float rn = rsqrtf(row16_sum(ss) * (1.f / 128.f) + EPS); \
            u32x4 res; \
            _Pragma("unroll") for (int i = 0; i < 4; ++i) { \
                const float z0 = lo16(zp[ps][i]), z1 = hi16(zp[ps][i]); \
                res[i] = cvtpk(o8[2 * i] * rn * gn[2 * i] * (z0 * sigmoidf_(z0)), o8[2 * i + 1] * rn * gn[2 * i + 1] * (z1 * sigmoidf_(z1))); } \
            *(u32x4*)((DST) + (size_t)c * D) = res; } while (0)
        bf16* const dummy = (bf16*)(p.ws + WS_Q2) + tid * 8;
        for (int n = 0; n < 32; ++n) {
            const int ci = item * 32 + n, buf = n & 1;
            const size_t rowc = (size_t)b * SEQ + n * 64;
            if (n + 1 < 32) dma(ci + 1, buf ^ 1);
            u32x2 utn[4]; float gln = 0.f;
            {
                const int cn = ci + (n + 1 < 32 ? 1 : 0);
#pragma unroll
                for (int ct = 0; ct < 4; ++ct) utn[ct] = *(const u32x2*)(UT + ((size_t)cn * 128 + 16 * w + fr) * 64 + 16 * ct + 4 * fq);
                gln = GL[cn];
            }
            u32x4 zq[2];
#pragma unroll
            for (int ps = 0; ps < 2; ++ps) zq[ps] = *(const u32x4*)(proj + (rowc + 32 * ps + fc) * PROJ_W + 3072 + hh * 128 + 8 * fv);
            bf16* const fdst = n > 0 ? obuf + (rowc - 64) * D + 512 + hh * 128 + 8 * fv : dummy;
            const int tprev = GS_OB + (buf ^ 1) * GS_OBT, tcur = GS_OB + buf * GS_OBT;
            f32x4 vn[4], oacc[4];
#pragma unroll
            for (int ct = 0; ct < 4; ++ct) { vn[ct] = (f32x4){lo16(ut[ct].x), hi16(ut[ct].x), lo16(ut[ct].y), hi16(ut[ct].y)}; oacc[ct] = (f32x4){0.f, 0.f, 0.f, 0.f}; }
            bf16x8 sb[4];
#pragma unroll
            for (int ks = 0; ks < 4; ++ks) { u32x4 pk; pk.x = cvtpk(S[2 * ks][0], S[2 * ks][1]); pk.y = cvtpk(S[2 * ks][2], S[2 * ks][3]); pk.z = cvtpk(S[2 * ks + 1][0], S[2 * ks + 1][1]); pk.w = cvtpk(S[2 * ks + 1][2], S[2 * ks + 1][3]);
                sb[ks] = __builtin_bit_cast(bf16x8, pk); }
            LAS unsigned char* bb = lds + buf * GS_BUF;
            bf16x8 f0[8], f1[8];
#define LD_A(F, ct) do { _Pragma("unroll") for (int ks = 0; ks < 4; ++ks) { F[ks] = *(const LAS bf16x8*)(bb + GS_WP + (ct) * 4096 + offk[ks]); \
                    F[4 + ks] = *(const LAS bf16x8*)(bb + GS_QD + (ct) * 4096 + offk[ks]); } } while (0)
#define MM_A(F, ct) do { _Pragma("unroll") for (int ks = 0; ks < 4; ++ks) { vn[ct] = __builtin_amdgcn_mfma_f32_16x16x32_bf16(F[ks], sb[ks], vn[ct], 0, 0, 0); \
                    oacc[ct] = __builtin_amdgcn_mfma_f32_16x16x32_bf16(sb[ks], F[4 + ks], oacc[ct], 0, 0, 0); } } while (0)
#define SBAR() __builtin_amdgcn_sched_barrier(0)
            LD_A(f0, 0); SBAR();
            LD_A(f1, 1); MM_A(f0, 0); SBAR();
            LD_A(f0, 2); MM_A(f1, 1); GS_FINISH(0, tprev, fdst); SBAR();
            LD_A(f1, 3); MM_A(f0, 2); SBAR();
#pragma unroll
            for (int ct = 0; ct < 4; ++ct)
#pragma unroll
                for (int ss = 0; ss < 2; ++ss) f0[2 * ct + ss] = *(const LAS bf16x8*)(bb + GS_AIP + ct * 2048 + offa[ss]);
            MM_A(f1, 3); GS_FINISH(1, tprev, fdst); SBAR();
            bf16x8 vb[2];
#pragma unroll
            for (int ss = 0; ss < 2; ++ss) { u32x4 pk; pk.x = cvtpk(vn[2 * ss][0], vn[2 * ss][1]); pk.y = cvtpk(vn[2 * ss][2], vn[2 * ss][3]); pk.z = cvtpk(vn[2 * ss + 1][0], vn[2 * ss + 1][1]); pk.w = cvtpk(vn[2 * ss + 1][2], vn[2 * ss + 1][3]);
                vb[ss] = __builtin_bit_cast(bf16x8, pk); }
#pragma unroll
            for (int kt = 0; kt < 4; ++kt)
#pragma unroll
                for (int ss = 0; ss < 2; ++ss) f1[2 * kt + ss] = *(const LAS bf16x8*)(bb + GS_KDT + kt * 2048 + offa[ss]);
#pragma unroll
            for (int ct = 0; ct < 4; ++ct)
#pragma unroll
                for (int ss = 0; ss < 2; ++ss) oacc[ct] = __builtin_amdgcn_mfma_f32_16x16x32_bf16(vb[ss], f0[2 * ct + ss], oacc[ct], 0, 0, 0);
            SBAR();
#pragma unroll
            for (int kt = 4; kt < 8; ++kt)
#pragma unroll
                for (int ss = 0; ss < 2; ++ss) f0[2 * (kt - 4) + ss] = *(const LAS bf16x8*)(bb + GS_KDT + kt * 2048 + offa[ss]);
#pragma unroll
            for (int kt = 0; kt < 4; ++kt) {
                S[kt] = S[kt] * gl;
#pragma unroll
                for (int ss = 0; ss < 2; ++ss) S[kt] = __builtin_amdgcn_mfma_f32_16x16x32_bf16(f1[2 * kt + ss], vb[ss], S[kt], 0, 0, 0);
            }
#pragma unroll
            for (int ct = 0; ct < 4; ++ct) {
                u32x2 pk; pk.x = cvtpk(oacc[ct][0], oacc[ct][1]); pk.y = cvtpk(oacc[ct][2], oacc[ct][3]);
                *(LAS u32x2*)(lds + tcur + (16 * ct + fr) * GS_OBP + (16 * w + 4 * fq) * 2) = pk;
            }
            SBAR();
#pragma unroll
            for (int kt = 4; kt < 8; ++kt) {
                S[kt] = S[kt] * gl;
#pragma unroll
                for (int ss = 0; ss < 2; ++ss) S[kt] = __builtin_amdgcn_mfma_f32_16x16x32_bf16(f0[2 * (kt - 4) + ss], vb[ss], S[kt], 0, 0, 0);
            }
#undef LD_A
#undef MM_A
#undef SBAR
#pragma unroll
            for (int ct = 0; ct < 4; ++ct) ut[ct] = utn[ct];
            gl = gln; zp[0] = zq[0]; zp[1] = zq[1];
            asm volatile("s_waitcnt vmcnt(0)" ::: "memory");
            LDS_BARRIER();
        }
        {
            bf16* const fdst = obuf + ((size_t)b * SEQ + 31 * 64) * D + 512 + hh * 128 + 8 * fv;
            GS_FINISH(0, GS_OB + GS_OBT, fdst); GS_FINISH(1, GS_OB + GS_OBT, fdst);
        }
#undef GS_FINISH
        __syncthreads();
    }
}

__device__ __forceinline__ unsigned sortable(float f) { const unsigned u = __float_as_uint(f); return u ^ ((unsigned)((int)u >> 31) | 0x80000000u); }
__device__ __forceinline__ float unsortable(unsigned s) { return __uint_as_float((s & 0x80000000u) ? (s ^ 0x80000000u) : ~s); }
#define CE(a, b) do { const unsigned _x = k[a], _y = k[b]; k[a] = _x > _y ? _x : _y; k[b] = _x > _y ? _y : _x; } while (0)
constexpr int PE_TK = 0, PE_TAB = 8192, PE_ID = 8448, PE_GT = PE_ID + 32768, PE_SK = PE_GT + 32768;
__device__ void phase_peer(const Params& p, int L, LAS unsigned char* lds, int bid, int nblk) {
    const int tid = tidx(), lane = tid & 63, w = __builtin_amdgcn_readfirstlane(tid >> 6), fr = lane & 15, fq = lane >> 4;
    const bf16* Q2 = (const bf16*)(p.ws + WS_Q2);
    const bf16* SK = (const bf16*)(p.ws + WS_SK) + (size_t)L * 8 * 2 * 128 * 128;
    float* H = (float*)(p.ws + WS_H); bf16* HB2 = (bf16*)(p.ws + WS_HB2);
    const unsigned char* U = p.ws + WS_U + (size_t)L * NEXP * D;
    const unsigned char* V = p.ws + WS_V + (size_t)L * NEXP * D;
    const float* SU = (const float*)(p.ws + WS_SU) + (size_t)L * NEXP; const float* SV = (const float*)(p.ws + WS_SV) + (size_t)L * NEXP;
    const float* g = p.ln_ffn_g + L * D;
    LAS unsigned* TK = (LAS unsigned*)(lds + PE_TK);
    LAS unsigned short* TAB = (LAS unsigned short*)(lds + PE_TAB);
    LAS int* IDL = (LAS int*)(lds + PE_ID); LAS float* GTL = (LAS float*)(lds + PE_GT);
    if (tid < 64) {
        int a = 0, base = 0, q = tid; unsigned short v = 0xffff;
        if (q < 50) { for (;;) { const int cnt = 16 / (a + 1); if (q < base + cnt) break; base += cnt; ++a; } v = (unsigned short)((a << 8) | (q - base)); }
        TAB[tid] = v;
    }
    for (int item = bid; item < M / 64; item += nblk) {
        const int tok0 = item * 64;
        __syncthreads();
        const int tg = w & 3, cc = w >> 2;
#define SK_FETCH(hd) do { _Pragma("unroll") for (int i = 0; i < 8; ++i) { const int pc = tid + 512 * i, nn = (pc >> 4) & 127; \
            __builtin_amdgcn_global_load_lds((const unsigned*)(SK + ((size_t)((hd) * 2 + (pc >> 11)) * 128 + nn) * 128 + (((pc & 15) ^ (nn & 15)) * 8)), \
                                             (LAS unsigned*)(lds + PE_SK + (w * 64 + 512 * i) * 16), 16, 0, 0); } } while (0)
        SK_FETCH(0);
        asm volatile("s_waitcnt vmcnt(0)" ::: "memory");
        __syncthreads();
        for (int hh = 0; hh < 8; ++hh) {
            {
                f32x4 acc[8];
#pragma unroll
                for (int nt = 0; nt < 8; ++nt) acc[nt] = (f32x4){0.f, 0.f, 0.f, 0.f};
                bf16x8 qa[4];
#pragma unroll
                for (int ks = 0; ks < 4; ++ks) qa[ks] = *(const bf16x8*)(Q2 + (size_t)(tok0 + 16 * tg + fr) * 2048 + hh * 256 + cc * 128 + 32 * ks + 8 * fq);
                const LAS unsigned char* skb = lds + PE_SK + cc * 32768 + fr * 256;
#pragma unroll
                for (int nt = 0; nt < 8; ++nt)
#pragma unroll
                    for (int ks = 0; ks < 4; ++ks) {
                        const bf16x8 kb = *(const LAS bf16x8*)(skb + nt * 4096 + (((4 * ks + fq) ^ fr) << 4));
                        acc[nt] = __builtin_amdgcn_mfma_f32_16x16x32_bf16(qa[ks], kb, acc[nt], 0, 0, 0);
                    }
#pragma unroll
                for (int r = 0; r < 4; ++r) {
                    unsigned k[8];
#pragma unroll
                    for (int nt = 0; nt < 8; ++nt) k[nt] = (sortable(acc[nt][r]) & ~0x7Fu) | (unsigned)(127 - (16 * nt + fr));
                    CE(0, 1); CE(2, 3); CE(4, 5); CE(6, 7); CE(0, 2); CE(1, 3); CE(4, 6); CE(5, 7); CE(1, 2); CE(5, 6); CE(0, 4); CE(3, 7);
                    CE(1, 5); CE(2, 6); CE(1, 4); CE(3, 6); CE(2, 4); CE(3, 5); CE(3, 4);
                    unsigned res = 0u;
#pragma unroll
                    for (int rd = 0; rd < 16; ++rd) {
                        const unsigned m = row16_umax(k[0]);
                        const bool win = k[0] == m;
#pragma unroll
                        for (int i = 0; i < 7; ++i) k[i] = win ? k[i + 1] : k[i];
                        k[7] = win ? 0u : k[7];
                        res = (fr == rd) ? m : res;
                    }
                    TK[(cc * 64 + 16 * tg + 4 * fq + r) * 16 + fr] = res;
                }
            }
            __syncthreads();
            if (hh + 1 < 8) SK_FETCH(hh + 1);
#pragma unroll
            for (int ps = 0; ps < 2; ++ps) {
                const int tl = 8 * w + 4 * ps + fq;
                unsigned k[4];
#pragma unroll
                for (int sl = 0; sl < 4; ++sl) {
                    const int q = sl * 16 + fr;
                    const unsigned ab = TAB[q];
                    const unsigned k1 = TK[tl * 16 + ((ab >> 8) & 15)], k2 = TK[(64 + tl) * 16 + (ab & 15)];
                    const float v = unsortable(k1 & ~0x7Fu) + unsortable(k2 & ~0x7Fu);
                    k[sl] = (q < 50) ? ((sortable(v) & ~0x3Fu) | (unsigned)(63 - q)) : 0u;
                }
                CE(0, 1); CE(2, 3); CE(0, 2); CE(1, 3); CE(1, 2);
                unsigned res = 0u;
#pragma unroll
                for (int rd = 0; rd < 16; ++rd) {
                    const unsigned m = row16_umax(k[0]);
                    const bool win = k[0] == m;
                    k[0] = win ? k[1] : k[0]; k[1] = win ? k[2] : k[1]; k[2] = win ? k[3] : k[2]; k[3] = win ? 0u : k[3];
                    res = (fr == rd) ? m : res;
                }
                const unsigned ab = TAB[63 - (res & 0x3Fu)];
                const unsigned k1 = TK[tl * 16 + ((ab >> 8) & 15)], k2 = TK[(64 + tl) * 16 + (ab & 15)];
                const float v = unsortable(k1 & ~0x7Fu) + unsortable(k2 & ~0x7Fu);
                const float e = __expf(v - row16_max(v));
                const float sum = row16_sum(e);
                IDL[tl * 128 + hh * 16 + fr] = (int)((127u - (k1 & 0x7Fu)) * 128u + (127u - (k2 & 0x7Fu)));
                GTL[tl * 128 + hh * 16 + fr] = e * __builtin_amdgcn_rcpf(sum);
            }
            asm volatile("s_waitcnt vmcnt(0)" ::: "memory");
            __syncthreads();
        }
#undef SK_FETCH
        for (int ti = 0; ti < 8; ++ti) {
            const int tl = 8 * w + ti;
            unsigned k0 = ((unsigned)IDL[tl * 128 + lane] << 7) | (unsigned)lane, k1 = ((unsigned)IDL[tl * 128 + 64 + lane] << 7) | (unsigned)(64 + lane);
#pragma unroll
            for (int kk = 2; kk <= 128; kk <<= 1) {
#pragma unroll
                for (int j = kk >> 1; j >= 1; j >>= 1) {
                    if (j == 64) { const unsigned lo = k0 < k1 ? k0 : k1, hi = k0 < k1 ? k1 : k0; k0 = lo; k1 = hi; }
                    else {
                        const unsigned p0 = (unsigned)__shfl_xor((int)k0, j), p1 = (unsigned)__shfl_xor((int)k1, j);
                        const bool up0 = ((lane & kk) == 0) || kk == 128, up1 = (((lane + 64) & kk) == 0);
                        const bool low = (lane & j) == 0;
                        k0 = (low == up0) ? (k0 < p0 ? k0 : p0) : (k0 > p0 ? k0 : p0);
                        k1 = (low == (kk == 128 ? true : up1)) ? (k1 < p1 ? k1 : p1) : (k1 > p1 ? k1 : p1);
                    }
                }
            }
            const float g0 = GTL[tl * 128 + (k0 & 127u)], g1 = GTL[tl * 128 + (k1 & 127u)];
            asm volatile("s_waitcnt lgkmcnt(0)" ::: "memory");
            IDL[tl * 128 + lane] = (int)(k0 >> 7); IDL[tl * 128 + 64 + lane] = (int)(k1 >> 7);
            GTL[tl * 128 + lane] = g0; GTL[tl * 128 + 64 + lane] = g1;
        }
        __syncthreads();
        {
            int xq[8][4]; float sx[8];
#pragma unroll
            for (int t = 0; t < 8; ++t) {
                const float* hrow = H + (size_t)(tok0 + 8 * w + t) * D + 4 * lane;
                float xn[16];
#pragma unroll
                for (int j = 0; j < 4; ++j) { const f32x4 a = *(const f32x4*)(hrow + 256 * j); xn[4 * j] = a[0]; xn[4 * j + 1] = a[1]; xn[4 * j + 2] = a[2]; xn[4 * j + 3] = a[3]; }
                float ss = 0.f;
#pragma unroll
                for (int i = 0; i < 16; ++i) ss += xn[i] * xn[i];
                const float rstd = rsqrtf(wave_sum(ss) * (1.f / D) + EPS);
                float mx = 0.f;
#pragma unroll
                for (int i = 0; i < 16; ++i) { xn[i] = xn[i] * rstd * g[256 * (i >> 2) + 4 * lane + (i & 3)]; mx = fmaxf(mx, fabsf(xn[i])); }
                mx = xrow16_max(row16_max(mx));
                const float xinv = mx > 0.f ? 127.f / mx : 0.f; sx[t] = mx * (1.f / 127.f);
#pragma unroll
                for (int j = 0; j < 4; ++j) xq[t][j] = (int)(((unsigned)__float2int_rn(xn[4 * j] * xinv) & 0xffu) | (((unsigned)__float2int_rn(xn[4 * j + 1] * xinv) & 0xffu) << 8) |
                                                             (((unsigned)__float2int_rn(xn[4 * j + 2] * xinv) & 0xffu) << 16) | ((unsigned)__float2int_rn(xn[4 * j + 3] * xinv) << 24));
                asm volatile("" ::: "memory"); __builtin_amdgcn_sched_barrier(0);
            }
            int hi[8][2];
#pragma unroll
            for (int t = 0; t < 8; ++t) { hi[t][0] = 0; hi[t][1] = 0; }
            const LAS int* idw = IDL + 8 * w * 128;
            u32x4 ring[16];
#pragma unroll
            for (int j = 0; j < 16; ++j) ring[j] = *(const u32x4*)(U + (size_t)idw[(j & 7) * 128 + (j >> 3)] * D + 16 * lane);
#pragma unroll 1
            for (int k = 0; k < 64; ++k) {
#pragma unroll
                for (int j = 0; j < 16; ++j) {
                    const int t = j & 7, pos = 2 * k + (j >> 3);
                    const u32x4 a = ring[j];
                    if (k < 63) ring[j] = *(const u32x4*)(U + (size_t)idw[t * 128 + pos + 2] * D + 16 * lane);
                    int d = __builtin_amdgcn_sdot4((int)a[0], xq[t][0], 0, false);
                    d = __builtin_amdgcn_sdot4((int)a[1], xq[t][1], d, false); d = __builtin_amdgcn_sdot4((int)a[2], xq[t][2], d, false); d = __builtin_amdgcn_sdot4((int)a[3], xq[t][3], d, false);
                    d = wave_isum(d);
                    if (lane == (pos & 63)) { if (k < 32) hi[t][0] = d; else hi[t][1] = d; }
                }
            }
#pragma unroll
            for (int t = 0; t < 8; ++t) {
                const int tl = 8 * w + t;
                const int id0 = IDL[tl * 128 + lane], id1 = IDL[tl * 128 + 64 + lane];
                const float su0 = SU[id0], su1 = SU[id1], sv0 = SV[id0], sv1 = SV[id1];
                const float h0 = su0 * sx[t] * (float)hi[t][0], h1 = su1 * sx[t] * (float)hi[t][1];
                GTL[tl * 128 + lane] = sv0 * GTL[tl * 128 + lane] * gelu_erf(h0);
                GTL[tl * 128 + 64 + lane] = sv1 * GTL[tl * 128 + 64 + lane] * gelu_erf(h1);
                asm volatile("" ::: "memory"); __builtin_amdgcn_sched_barrier(0);
            }
        }
        for (int ti = 0; ti < 8; ++ti) {
            const int tl = 8 * w + ti, tok = tok0 + tl;
            float* hrow = H + (size_t)tok * D + 4 * lane;
            float xv[16];
#pragma unroll
            for (int j = 0; j < 4; ++j) { const f32x4 a = *(const f32x4*)(hrow + 256 * j); xv[4 * j] = a[0]; xv[4 * j + 1] = a[1]; xv[4 * j + 2] = a[2]; xv[4 * j + 3] = a[3]; }
            const float w0 = GTL[tl * 128 + lane], w1 = GTL[tl * 128 + 64 + lane];
            const float wmx = xrow16_max(row16_max(fmaxf(fabsf(w0), fabsf(w1))));
            const float winv = wmx > 0.f ? 127.f / wmx : 0.f, sw = wmx * (1.f / 127.f);
            const f32x4 wv = *(const LAS f32x4*)(GTL + tl * 128 + 4 * (lane & 31));
            const int wq = (int)(((unsigned)__float2int_rn(wv[0] * winv) & 0xffu) | (((unsigned)__float2int_rn(wv[1] * winv) & 0xffu) << 8) |
                                 (((unsigned)__float2int_rn(wv[2] * winv) & 0xffu) << 16) | ((unsigned)__float2int_rn(wv[3] * winv) << 24));
            int yi[16];
#pragma unroll
            for (int i = 0; i < 16; ++i) yi[i] = 0;
            u32x4 ring[16];
#pragma unroll
            for (int j = 0; j < 16; ++j) ring[j] = *(const u32x4*)(V + (size_t)IDL[tl * 128 + j] * D + 16 * lane);
#pragma unroll 1
            for (int k = 0; k < 8; ++k) {
#pragma unroll
                for (int g4 = 0; g4 < 4; ++g4) {
                    const u32x4 a0 = ring[4 * g4], a1 = ring[4 * g4 + 1], a2 = ring[4 * g4 + 2], a3 = ring[4 * g4 + 3];
                    if (k < 7) {
#pragma unroll
                        for (int q = 0; q < 4; ++q) ring[4 * g4 + q] = *(const u32x4*)(V + (size_t)IDL[tl * 128 + 16 * (k + 1) + 4 * g4 + q] * D + 16 * lane);
                    }
                    const int wg = __builtin_amdgcn_readlane(wq, 4 * k + g4);
#pragma unroll
                    for (int q = 0; q < 4; ++q) {
                        const unsigned p0 = __builtin_amdgcn_perm(a1[q], a0[q], 0x05010400u), p1 = __builtin_amdgcn_perm(a1[q], a0[q], 0x07030602u);
                        const unsigned p2 = __builtin_amdgcn_perm(a3[q], a2[q], 0x05010400u), p3 = __builtin_amdgcn_perm(a3[q], a2[q], 0x07030602u);
                        yi[4 * q] = __builtin_amdgcn_sdot4((int)__builtin_amdgcn_perm(p2, p0, 0x05040100u), wg, yi[4 * q], false);
                        yi[4 * q + 1] = __builtin_amdgcn_sdot4((int)__builtin_amdgcn_perm(p2, p0, 0x07060302u), wg, yi[4 * q + 1], false);
                        yi[4 * q + 2] = __builtin_amdgcn_sdot4((int)__builtin_amdgcn_perm(p3, p1, 0x05040100u), wg, yi[4 * q + 2], false);
                        yi[4 * q + 3] = __builtin_amdgcn_sdot4((int)__builtin_amdgcn_perm(p3, p1, 0x07060302u), wg, yi[4 * q + 3], false);
                    }
                }
            }
            float y[16];
#pragma unroll
            for (int i = 0; i < 16; ++i) y[i] = xv[i] + sw * (float)yi[i];
#pragma unroll
            for (int j = 0; j < 4; ++j) *(f32x4*)(hrow + 256 * j) = (f32x4){y[4 * j], y[4 * j + 1], y[4 * j + 2], y[4 * j + 3]};
            bf16* hb = HB2 + (size_t)tok * D + 4 * lane;
#pragma unroll
            for (int j = 0; j < 4; ++j) { u32x2 o2; o2.x = pk2(y[4 * j], y[4 * j + 1]); o2.y = pk2(y[4 * j + 2], y[4 * j + 3]); *(u32x2*)(hb + 256 * j) = o2; }
        }
    }
    __syncthreads();
}
#undef CE

__device__ void phase_final(const Params& p, int bid, int nblk) {
    const int tid = tidx(), lane = tid & 63, gw = bid * NWAVES + (tid >> 6), NGW = nblk * NWAVES;
    const float* H = (const float*)(p.ws + WS_H);
    for (int m = gw; m < M; m += NGW) {
        f32x4 v[4]; float ss = 0.f;
#pragma unroll
        for (int j = 0; j < 4; ++j) { v[j] = ((const f32x4*)(H + (size_t)m * D))[lane + 64 * j]; ss += (v[j][0] * v[j][0] + v[j][1] * v[j][1]) + (v[j][2] * v[j][2] + v[j][3] * v[j][3]); }
        const float r = rsqrtf(wave_sum(ss) * (1.f / D) + EPS);
#pragma unroll
        for (int j = 0; j < 4; ++j) { const f32x4 gv = ((const f32x4*)p.final_g)[lane + 64 * j]; ((f32x4*)(p.out + (size_t)m * D))[lane + 64 * j] = v[j] * r * gv; }
    }
}

#define XB_TMO      128
#define XB_XCNT(j)  (256  + 64 * (j))
#define XB_XSUB(j)  (1280 + 64 * (j))
#define XB_XGEN(j)  (2304 + 64 * (j))
#define XB_TOP      3328
#define XB_TOPGEN   3392
#define XCD_BAR_WORDS 3456
#define XB_SPIN_CAP (1u << 22)
__device__ __forceinline__ unsigned xb_ld(unsigned* p)              { return __hip_atomic_load(p, __ATOMIC_RELAXED, __HIP_MEMORY_SCOPE_AGENT); }
__device__ __forceinline__ unsigned xb_add(unsigned* p, unsigned v) { return __hip_atomic_fetch_add(p, v, __ATOMIC_RELAXED, __HIP_MEMORY_SCOPE_AGENT); }
__device__ __forceinline__ unsigned xb_xcc_id() { return (unsigned)__builtin_amdgcn_s_getreg((3 << 11) | 20) & 0xFu; }
#define XB_SPIN(cond, bar) do { unsigned _sp = 0; while (cond) { __builtin_amdgcn_s_sleep(1); \
    if ((++_sp & 255u) == 0u) { if (xb_ld(&(bar)[XB_TMO])) break; if (_sp > XB_SPIN_CAP) { atomicAdd(&(bar)[XB_TMO], 1u); break; } } } } while (0)
struct XcdBarrier { unsigned* bar; unsigned x; volatile LAS unsigned* st; };
__device__ __forceinline__ XcdBarrier xcd_barrier_post(unsigned* bar, volatile LAS unsigned* st) {
    XcdBarrier b; b.bar = bar; b.x = xb_xcc_id(); b.st = st;
    if (threadIdx.x == 0) (void)xb_add(&bar[XB_XCNT(b.x)], 1u);
    return b;
}
__device__ __forceinline__ void xcd_barrier_complete(unsigned* bar, unsigned x, unsigned& nloc, unsigned& nx) {
    const unsigned G = gridDim.x * gridDim.y * gridDim.z;
    unsigned sum, cnt, mine, sp = 0u;
    for (;;) {
        sum = 0u; cnt = 0u; mine = 0u;
#pragma unroll
        for (unsigned j = 0; j < 16; ++j) { const unsigned c = xb_ld(&bar[XB_XCNT(j)]); sum += c; cnt += (c > 0u) ? 1u : 0u; mine = (j == x) ? c : mine; }
        if (sum == G) break;
        __builtin_amdgcn_s_sleep(1);
        if ((++sp & 255u) == 0u) { if (xb_ld(&bar[XB_TMO])) break; if (sp > XB_SPIN_CAP) { atomicAdd(&bar[XB_TMO], 1u); break; } }
    }
    nloc = mine > 0u ? mine : 1u; nx = cnt > 0u ? cnt : 1u;
}
__device__ __forceinline__ void xcd_barrier(const XcdBarrier& b) {
    asm volatile("s_waitcnt vmcnt(0)" ::: "memory");
    __syncthreads();
    if (threadIdx.x == 0) {
        unsigned* bar = b.bar;
        __builtin_amdgcn_s_waitcnt(0);
        unsigned nloc = b.st[0], nx = b.st[1];
        if (nloc == 0u) { xcd_barrier_complete(bar, b.x, nloc, nx); b.st[0] = nloc; b.st[1] = nx; }
        const unsigned old = xb_add(&bar[XB_XSUB(b.x)], 1u);
        const unsigned gen = old / nloc;
        if (old + 1u == (gen + 1u) * nloc) {
            __builtin_amdgcn_fence(__ATOMIC_RELEASE, "agent");
            asm volatile("s_waitcnt vmcnt(0)" ::: "memory");
            const unsigned og = xb_add(&bar[XB_TOP], 1u);
            const unsigned tg = og / nx;
            if (og + 1u == (tg + 1u) * nx) xb_add(&bar[XB_TOPGEN], 1u);
            else XB_SPIN(xb_ld(&bar[XB_TOPGEN]) == tg, bar);
            __builtin_amdgcn_fence(__ATOMIC_ACQUIRE, "agent");
            xb_add(&bar[XB_XGEN(b.x)], 1u);
            asm volatile("s_waitcnt vmcnt(0)" ::: "memory");
        } else {
            XB_SPIN(xb_ld(&bar[XB_XGEN(b.x)]) == gen, bar);
            __builtin_amdgcn_fence(__ATOMIC_ACQUIRE, "agent");
            asm volatile("s_waitcnt vmcnt(0)" ::: "memory");
        }
    }
    __syncthreads();
}
constexpr int CW_BAR = 4096;

constexpr int K_PROLOGUE = 11, K_FINAL = 12;
template <int KIND>
__device__ __forceinline__ void run_kind(const Params& p, int L, LAS unsigned char* lds, int bid, int nblk) {
    unsigned char* ws = p.ws;
    float* H = (float*)(ws + WS_H);
    float* ss0 = (float*)(ws + WS_STAT); float* ss1 = (float*)(ws + WS_SS1); float* sse = (float*)(ws + WS_SSE);
    if constexpr (KIND == K_PROLOGUE) phase_prologue(p, lds, bid, nblk);
    if constexpr (KIND == K_FINAL) phase_final(p, bid, nblk);
    if constexpr (KIND == 0) { EpiProj E{nullptr, (bf16*)(ws + WS_PROJ), (float*)(ws + WS_BA)};
        gemm_run(lds, (const bf16*)(ws + WS_HB0), (const bf16*)(ws + WS_WIN) + (size_t)L * IN_PAD * D, M, IN_PAD, D, E, bid, nblk, ss0); }
    if constexpr (KIND == 1) phase_gdn_prep(p, L, lds, bid, nblk);
    if constexpr (KIND == 2) { phase_gdn_scan(p, L, lds, bid, nblk); phase_att_queue(p, L, lds, bid, nblk); }
    if constexpr (KIND == 3) { EpiRes E{ss1, H, (bf16*)(ws + WS_HB1)};
        gemm_run(lds, (const bf16*)(ws + WS_OBUF), (const bf16*)(ws + WS_WOUT) + (size_t)L * D * D, M, D, D, E, bid, nblk); }
    if constexpr (KIND == 4) { EpiQ2 E{nullptr, (bf16*)(ws + WS_Q2)};
        gemm_run(lds, (const bf16*)(ws + WS_HB1), (const bf16*)(ws + WS_WQ) + (size_t)L * 2048 * D, M, 2048, D, E, bid, nblk, ss1); }
    if constexpr (KIND == 5) phase_peer(p, L, lds, bid, nblk);
    if constexpr (KIND == 7) { EpiE E2{sse, (bf16*)(ws + WS_EPRE)};
        gemm_run(lds, (const bf16*)(ws + WS_PB) + (size_t)L * M * 256, (const bf16*)(ws + WS_WP) + (size_t)L * D * 256, M, D, 256, E2, bid, nblk); }
    if constexpr (KIND == 6) { EpiPle E{ss0, H, (bf16*)(ws + WS_HB0), (const bf16*)(ws + WS_EPRE), p.ple_norm_g + L * D};
        gemm_run(lds, (const bf16*)(ws + WS_HB2), (const bf16*)(ws + WS_WG) + (size_t)L * D * D, M, D, D, E, bid, nblk, sse); }
}

__device__ __forceinline__ Params params_off(const Params& s, size_t z) {
    Params q;
    q.x = s.x + z; q.p = s.p + z; q.ln_mix_g = s.ln_mix_g + z; q.w_in = s.w_in + z; q.conv_w = s.conv_w + z; q.a_log = s.a_log + z; q.dt_bias = s.dt_bias + z;
    q.gdn_norm_g = s.gdn_norm_g + z; q.diff_lambda = s.diff_lambda + z; q.subln_g = s.subln_g + z; q.w_out = s.w_out + z; q.ln_ffn_g = s.ln_ffn_g + z;
    q.peer_wq = s.peer_wq + z; q.subkeys = s.subkeys + z; q.peer_u = s.peer_u + z; q.peer_v = s.peer_v + z; q.ple_wp = s.ple_wp + z; q.ple_wg = s.ple_wg + z;
    q.ple_norm_g = s.ple_norm_g + z; q.final_g = s.final_g + z; q.out = s.out + z; q.ws = s.ws + z; q.pad0 = 0; q.pad1 = 0;
    return q;
}
#define RUN(KIND) do { size_t z_ = 0; int L_ = L; asm volatile("" : "+s"(z_), "+s"(L_)); const Params q_ = params_off(p, z_); run_kind<KIND>(q_, L_, (LAS unsigned char*)lds, (int)blockIdx.x, (int)gridDim.x); } while (0)
#define GRID_BARRIER() do { XcdBarrier b_; b_.bar = (unsigned*)(p.ws + WS_CTL) + CW_BAR; b_.x = xb_xcc_id(); b_.st = (volatile LAS unsigned*)((LAS unsigned char*)lds + LDS_MISC_OFF) + 8; xcd_barrier(b_); } while (0)
__global__ void __launch_bounds__(NTHREADS, 2) mk_fwd(Params p) {
    extern __shared__ __attribute__((aligned(16))) unsigned char lds[];
    {
        volatile LAS unsigned* misc = (volatile LAS unsigned*)((LAS unsigned char*)lds + LDS_MISC_OFF);
        if (threadIdx.x < 64) misc[threadIdx.x] = 0u;
        __syncthreads();
        (void)xcd_barrier_post((unsigned*)(p.ws + WS_CTL) + CW_BAR, misc + 8);
    }
    { int L = 0; RUN(K_PROLOGUE); }
    cg::this_grid().sync();
#define LAYER(LL) do { const int L = (LL); RUN(0); GRID_BARRIER(); RUN(1); GRID_BARRIER(); RUN(2); GRID_BARRIER(); RUN(3); GRID_BARRIER(); RUN(4); GRID_BARRIER(); RUN(5); RUN(7); GRID_BARRIER(); RUN(6); GRID_BARRIER(); } while (0)
    LAYER(0); LAYER(1); LAYER(2); LAYER(3);
#undef LAYER
    { int L = 0; RUN(K_FINAL); }
}

extern "C" void kernel_launch(void* const* d_in, const int* in_sizes, int n_in, void* d_out, int out_size, void* d_ws, size_t ws_size, hipStream_t stream) {
    static int grid = 0;
    if (grid == 0) {
        if (n_in != 20 || out_size != M * D || ws_size < WS_END) { fprintf(stderr, "kernel_launch: unexpected shapes (n_in %d, out %d, ws %zu < %zu)\n", n_in, out_size, ws_size, (size_t)WS_END); grid = -1; return; }
        int dev = 0, cus = 0, per_cu = 0;
        (void)hipGetDevice(&dev); (void)hipDeviceGetAttribute(&cus, hipDeviceAttributeMultiprocessorCount, dev);
        if (hipFuncSetAttribute((const void*)mk_fwd, hipFuncAttributeMaxDynamicSharedMemorySize, LDS_BYTES) != hipSuccess) { fprintf(stderr, "kernel_launch: hipFuncSetAttribute failed\n"); grid = -1; return; }
        if (hipOccupancyMaxActiveBlocksPerMultiprocessor(&per_cu, (const void*)mk_fwd, NTHREADS, LDS_BYTES) != hipSuccess || per_cu < 1) { fprintf(stderr, "kernel_launch: occupancy query says %d blocks per CU\n", per_cu); (void)hipGetLastError(); grid = -1; return; }
        grid = (cus > 0 ? cus : 256);
    }
    if (grid < 0) return;
    (void)hipMemsetAsync((char*)d_ws + WS_CTL, 0, CTL_ZERO_BYTES, stream);
    Params p{};
    const float** pp = (const float**)&p;
    for (int i = 0; i < 20; ++i) pp[i] = (const float*)d_in[i];
    p.out = (float*)d_out; p.ws = (unsigned char*)d_ws;
    void* args[] = {&p};
    hipError_t e = hipLaunchCooperativeKernel((const void*)mk_fwd, dim3(grid), dim3(NTHREADS), args, LDS_BYTES, stream);
    if (e != hipSuccess) fprintf(stderr, "kernel_launch: cooperative launch failed: %s (grid %d)\n", hipGetErrorString(e), grid);
}
```

```cpp
#include <hip/hip_runtime.h>
#include <hip/hip_cooperative_groups.h>
#include <cstdio>
#include <cstdint>
namespace cg = cooperative_groups;

#define LAS __attribute__((address_space(3)))
typedef unsigned short bf16;
typedef float f32x4 __attribute__((ext_vector_type(4)));
typedef short bf16x8 __attribute__((ext_vector_type(8)));
typedef unsigned u32x4 __attribute__((ext_vector_type(4)));
typedef unsigned u32x2 __attribute__((ext_vector_type(2)));

constexpr int D = 1024, BATCH = 8, SEQ = 2048, DEPTH = 4, M = BATCH * SEQ;
constexpr int IN_COLS = 3592, IN_PAD = 3840, PROJ_W = 3584;
constexpr int NEXP = 16384;
constexpr float EPS = 1e-6f;
constexpr float QSCALE = 0.125f * 1.4426950408889634f;
constexpr int NWAVES = 8, NTHREADS = 512;
constexpr int LDS_BYTES = 163840;
constexpr int LDS_MISC_OFF = LDS_BYTES - 256;
constexpr int RS_OFF = 147456;
constexpr int CW_QUEUE = 1024;

constexpr size_t MiB = 1u << 20;
constexpr size_t WS_CTL = 0, CTL_ZERO_BYTES = 1 * MiB;
constexpr size_t WS_H = 1 * MiB;
constexpr size_t WS_HB0 = 65 * MiB;
constexpr size_t WS_HB1 = 97 * MiB;
constexpr size_t WS_HB2 = 129 * MiB;
constexpr size_t WS_PROJ = 161 * MiB;
constexpr size_t WS_BA = 273 * MiB;
constexpr size_t WS_OBUF = 274 * MiB;
constexpr size_t WS_Q2 = 306 * MiB;
constexpr size_t WS_EPRE = 370 * MiB;
constexpr size_t WS_IDX = 402 * MiB;
constexpr size_t WS_GATE = 410 * MiB;
constexpr size_t WS_STAT = 418 * MiB;
constexpr size_t WS_SS1 = WS_IDX + 1 * MiB, WS_SSE = WS_IDX;
constexpr size_t WS_ORAW = 422 * MiB;
constexpr size_t WS_WIN = 550 * MiB;
constexpr size_t WS_WOUT = 582 * MiB;
constexpr size_t WS_WQ = 590 * MiB;
constexpr size_t WS_WG = 606 * MiB;
constexpr size_t WS_WP = 614 * MiB;
constexpr size_t WS_SK = 616 * MiB;
constexpr size_t WS_PB = 618 * MiB;
constexpr size_t WS_U = 650 * MiB;
constexpr size_t WS_V = 778 * MiB;
constexpr size_t WS_SU = WS_STAT + 1 * MiB, WS_SV = WS_STAT + 2 * MiB;
constexpr size_t WS_END = 906 * MiB;

struct Params {
    const float *x, *p, *ln_mix_g, *w_in, *conv_w, *a_log, *dt_bias, *gdn_norm_g, *diff_lambda, *subln_g, *w_out, *ln_ffn_g,
        *peer_wq, *subkeys, *peer_u, *peer_v, *ple_wp, *ple_wg, *ple_norm_g, *final_g;
    float* out;
    unsigned char* ws;
    int pad0, pad1;
};

__device__ __forceinline__ int tidx() { int t = (int)threadIdx.x; asm volatile("" : "+v"(t)); return t; }
#define LDS_BARRIER() asm volatile("s_waitcnt lgkmcnt(0)\n\ts_barrier" ::: "memory")
__device__ __forceinline__ float bf2f(bf16 v) { return __uint_as_float((unsigned)v << 16); }
__device__ __forceinline__ unsigned f2bf(float f);
typedef __bf16 bf16x2_t __attribute__((ext_vector_type(2)));
typedef float f32x2_t __attribute__((ext_vector_type(2)));
__device__ __forceinline__ unsigned cvtpk(float lo, float hi) { f32x2_t v = {lo, hi}; bf16x2_t b = __builtin_convertvector(v, bf16x2_t); return __builtin_bit_cast(unsigned, b); }
__device__ __forceinline__ unsigned pk2(float lo, float hi) { return cvtpk(lo, hi); }
__device__ __forceinline__ unsigned f2bf(float f) { return cvtpk(f, 0.f) & 0xffffu; }
__device__ __forceinline__ float lo16(unsigned w) { return __uint_as_float(w << 16); }
__device__ __forceinline__ float hi16(unsigned w) { return __uint_as_float(w & 0xffff0000u); }
template <int N> __device__ __forceinline__ float dpp_ror(float x) { return __builtin_bit_cast(float, __builtin_amdgcn_mov_dpp(__builtin_bit_cast(int, x), 0x120 + N, 0xf, 0xf, true)); }
template <int N> __device__ __forceinline__ unsigned dpp_ror_u(unsigned x) { return (unsigned)__builtin_amdgcn_mov_dpp((int)x, 0x120 + N, 0xf, 0xf, true); }
__device__ __forceinline__ float row16_sum(float x) { x += dpp_ror<8>(x); x += dpp_ror<4>(x); x += dpp_ror<2>(x); x += dpp_ror<1>(x); return x; }
__device__ __forceinline__ float row16_max(float x) { x = fmaxf(x, dpp_ror<8>(x)); x = fmaxf(x, dpp_ror<4>(x)); x = fmaxf(x, dpp_ror<2>(x)); x = fmaxf(x, dpp_ror<1>(x)); return x; }
__device__ __forceinline__ unsigned row16_umax(unsigned x) { unsigned y;
    y = dpp_ror_u<8>(x); x = x > y ? x : y; y = dpp_ror_u<4>(x); x = x > y ? x : y; y = dpp_ror_u<2>(x); x = x > y ? x : y; y = dpp_ror_u<1>(x); x = x > y ? x : y; return x; }
__device__ __forceinline__ float xrow16_max(float x) {
    auto s = __builtin_amdgcn_permlane16_swap(__float_as_uint(x), __float_as_uint(x), false, false);
    x = fmaxf(__uint_as_float(s[0]), __uint_as_float(s[1]));
    auto t = __builtin_amdgcn_permlane32_swap(__float_as_uint(x), __float_as_uint(x), false, false);
    return fmaxf(__uint_as_float(t[0]), __uint_as_float(t[1]));
}
__device__ __forceinline__ float xrow16_sum(float x) {
    auto s = __builtin_amdgcn_permlane16_swap(__float_as_uint(x), __float_as_uint(x), false, false);
    x = __uint_as_float(s[0]) + __uint_as_float(s[1]);
    auto t = __builtin_amdgcn_permlane32_swap(__float_as_uint(x), __float_as_uint(x), false, false);
    return __uint_as_float(t[0]) + __uint_as_float(t[1]);
}
__device__ __forceinline__ float wave_sum(float v) { return xrow16_sum(row16_sum(v)); }
template <int N> __device__ __forceinline__ int dpp_ror_i(int x) { return __builtin_amdgcn_mov_dpp(x, 0x120 + N, 0xf, 0xf, true); }
__device__ __forceinline__ int wave_isum(int x) {
    x += dpp_ror_i<8>(x); x += dpp_ror_i<4>(x); x += dpp_ror_i<2>(x); x += dpp_ror_i<1>(x);
    auto s = __builtin_amdgcn_permlane16_swap((unsigned)x, (unsigned)x, false, false); x = (int)(s[0] + s[1]);
    auto t = __builtin_amdgcn_permlane32_swap((unsigned)x, (unsigned)x, false, false); return (int)(t[0] + t[1]);
}
__device__ __forceinline__ float wave_max(float v) {
#pragma unroll
    for (int o = 32; o; o >>= 1) v = fmaxf(v, __shfl_xor(v, o));
    return v;
}
__device__ __forceinline__ float sigmoidf_(float x) { return __builtin_amdgcn_rcpf(1.f + __expf(-x)); }
__device__ __forceinline__ float dot8(u32x4 a, u32x4 b, float s) {
#pragma unroll
    for (int i = 0; i < 4; ++i) { s += lo16(a[i]) * lo16(b[i]); s += hi16(a[i]) * hi16(b[i]); }
    return s;
}

__host__ __device__ __forceinline__ int lds_byte(int r, int c) { const int st = (r >> 4) * 2 + (c >> 5), rr = r & 15, cc = c & 31, ob = rr * 64 + cc * 2; return st * 1024 + (ob ^ (((ob >> 9) & 1) << 5)); }
__host__ __device__ __forceinline__ void stage_rc(int b, int& R, int& C) { const int st = b / 1024, sb = b % 1024, swz = sb ^ (((sb >> 9) & 1) << 5); R = (st >> 1) * 16 + swz / 64; C = (st & 1) * 32 + (swz % 64) / 2; }
constexpr int HTB = 16384;
template <class F>
__device__ __forceinline__ void gemm_run(LAS unsigned char* lds, const bf16* A, const bf16* Bt, int Mm, int N, int K, const F& f, int bid, int nblk, const float* slots_in = nullptr) {
    LAS float* RS = (LAS float*)(lds + RS_OFF);
    int rs_pm = -1;
    const int tid = tidx(), wid = __builtin_amdgcn_readfirstlane(tid >> 6), lane = tid & 63, wr = wid >> 2, wc = wid & 3, fr = lane & 15, fq = lane >> 4;
    const int nt = K / 64, ntn = N / 256, nunits = (Mm / 256) * ntn;
    unsigned voff[2];
#pragma unroll
    for (int i = 0; i < 2; ++i) { const int uu = tid + 512 * i, r = uu >> 3, c = (uu & 7) ^ ((r >> 1) & 7); voff[i] = (unsigned)(r * K + c * 8) * 2u; }
    const unsigned ldsw = (unsigned)wid * 1024u;
    const int sw7 = (fr >> 1) & 7;
    const int aoff0 = wr * HTB + fr * 128 + ((fq ^ sw7) << 4), aoff1 = wr * HTB + fr * 128 + (((4 + fq) ^ sw7) << 4);
    const int bbase = (2 + (wc >> 1)) * HTB + (wc & 1) * 8192 + fr * 128;
    const int boff0 = bbase + ((fq ^ sw7) << 4), boff1 = bbase + (((4 + fq) ^ sw7) << 4);
#define G_STAGE(bufoff, gbase) do { _Pragma("unroll") for (int _i = 0; _i < 2; ++_i) \
        __builtin_amdgcn_global_load_lds((const unsigned*)((const char*)(gbase) + voff[_i]), (LAS unsigned*)(lds + (bufoff) + ldsw + _i * 8192), 16, 0, 0); } while (0)
    for (int u = bid; u < nunits; u += nblk) {
        const int pm = u % (Mm / 256), pn = u / (Mm / 256);
        if (slots_in && pm != rs_pm) {
            __syncthreads();
            if (tid < 256) { const f32x4* sp = (const f32x4*)(slots_in + ((size_t)pm * 256 + tid) * 16);
                const f32x4 a = sp[0], b = sp[1], c = sp[2], d = sp[3];
                const float s = (((a[0] + a[1]) + (a[2] + a[3])) + ((b[0] + b[1]) + (b[2] + b[3]))) + (((c[0] + c[1]) + (c[2] + c[3])) + ((d[0] + d[1]) + (d[2] + d[3])));
                RS[tid] = rsqrtf(s * (1.f / D) + EPS); }
            __syncthreads();
            rs_pm = pm;
        }
        const char* gA = (const char*)(A + (size_t)pm * 256 * K);
        const char* gB = (const char*)(Bt + (size_t)pn * 256 * K);
        const size_t hstep = (size_t)128 * K * 2;
        f32x4 acc[8][4];
#pragma unroll
        for (int a = 0; a < 8; ++a)
#pragma unroll
            for (int b = 0; b < 4; ++b) acc[a][b] = (f32x4){0.f, 0.f, 0.f, 0.f};
        G_STAGE(0, gA); G_STAGE(HTB, gA + hstep); G_STAGE(2 * HTB, gB); G_STAGE(3 * HTB, gB + hstep);
        for (int t = 0; t < nt; ++t) {
            const int cb = (t & 1) * 4 * HTB, nb = ((t + 1) & 1) * 4 * HTB;
            asm volatile("s_waitcnt vmcnt(0)" ::: "memory");
            __builtin_amdgcn_s_barrier();
            asm volatile("" ::: "memory");
            const size_t ko = (size_t)(t + 1) * 128; const bool more = t + 1 < nt;
#pragma unroll
            for (int k = 0; k < 2; ++k) {
                if (more) { if (k == 0) { G_STAGE(nb, gA + ko); G_STAGE(nb + 2 * HTB, gB + ko); } else { G_STAGE(nb + HTB, gA + hstep + ko); G_STAGE(nb + 3 * HTB, gB + hstep + ko); } }
                bf16x8 bfr[4], acur, anxt;
#pragma unroll
                for (int n = 0; n < 4; ++n) bfr[n] = *(const LAS bf16x8*)(lds + cb + (k ? boff1 : boff0) + n * 2048);
                acur = *(const LAS bf16x8*)(lds + cb + (k ? aoff1 : aoff0));
#pragma unroll
                for (int m = 0; m < 8; ++m) {
                    if (m < 7) anxt = *(const LAS bf16x8*)(lds + cb + (k ? aoff1 : aoff0) + (m + 1) * 2048);
#pragma unroll
                    for (int n = 0; n < 4; ++n) acc[m][n] = __builtin_amdgcn_mfma_f32_16x16x32_bf16(bfr[n], acur, acc[m][n], 0, 0, 0);
                    acur = anxt;
                }
                __builtin_amdgcn_sched_barrier(0);
            }
            asm volatile("s_waitcnt lgkmcnt(0)" ::: "memory");
        }
        {
            int el = lane; asm volatile("" : "+v"(el));
            const int efr = el & 15, efq = el >> 4;
            LAS float* et = (LAS float*)(lds + wid * 4352);
#pragma unroll
            for (int m = 0; m < 8; ++m) {
#pragma unroll
                for (int n = 0; n < 4; ++n) *(LAS f32x4*)(et + efr * 68 + n * 16 + 4 * efq) = acc[m][n];
                asm volatile("s_waitcnt lgkmcnt(0)" ::: "memory");
#pragma unroll
                for (int i = 0; i < 4; ++i) {
                    const int lrow = wr * 128 + m * 16 + 4 * i + efq, row = pm * 256 + lrow;
                    const f32x4 v = *(const LAS f32x4*)(et + (4 * i + efq) * 68 + 4 * efr);
                    const f32x4 r = f(row, RS[lrow], pn * 256 + wc * 64 + 4 * efr, v);
                    if constexpr (F::STATS) { const float ssq = row16_sum((r[0] * r[0] + r[1] * r[1]) + (r[2] * r[2] + r[3] * r[3])); if (efr == 0) f.slots[(size_t)row * 16 + pn * 4 + wc] = ssq; }
                }
                asm volatile("s_waitcnt lgkmcnt(0)" ::: "memory");
                __builtin_amdgcn_sched_barrier(0);
            }
        }
        __syncthreads();
    }
#undef G_STAGE
}

__device__ __forceinline__ u32x2 pk4(f32x4 a) { u32x2 o; o.x = pk2(a[0], a[1]); o.y = pk2(a[2], a[3]); return o; }
struct EpiProj {
    static constexpr bool STATS = false; float* slots;
    bf16* proj; float* ba;
    __device__ __forceinline__ f32x4 operator()(int row, float rstd, int col, f32x4 v) const {
        v = v * rstd;
        if (col < PROJ_W) *(u32x2*)(proj + (size_t)row * PROJ_W + col) = pk4(v);
        else if (col < IN_COLS) *(f32x4*)(ba + (size_t)row * 8 + (col - PROJ_W)) = v;
        return v;
    }
};
struct EpiRes {
    static constexpr bool STATS = true; float* slots;
    float* H; bf16* HB;
    __device__ __forceinline__ f32x4 operator()(int row, float, int col, f32x4 v) const {
        f32x4* hp = (f32x4*)(H + (size_t)row * D + col);
        const f32x4 h = *hp + v; *hp = h;
        *(u32x2*)(HB + (size_t)row * D + col) = pk4(h);
        return h;
    }
};
struct EpiQ2 {
    static constexpr bool STATS = false; float* slots;
    bf16* Q2;
    __device__ __forceinline__ f32x4 operator()(int row, float rstd, int col, f32x4 v) const { v = v * rstd; *(u32x2*)(Q2 + (size_t)row * 2048 + col) = pk4(v); return v; }
};
struct EpiE {
    static constexpr bool STATS = true; float* slots;
    bf16* E;
    __device__ __forceinline__ f32x4 operator()(int row, float, int col, f32x4 v) const { *(u32x2*)(E + (size_t)row * D + col) = pk4(v); return v; }
};
struct EpiPle {
    static constexpr bool STATS = true; float* slots;
    float* H; bf16* HB; const bf16* E; const float* g;
    __device__ __forceinline__ f32x4 operator()(int row, float rstde, int col, f32x4 v) const {
        f32x4* hp = (f32x4*)(H + (size_t)row * D + col);
        const u32x2 ev = *(const u32x2*)(E + (size_t)row * D + col);
        const f32x4 gv = *(const f32x4*)(g + col);
        f32x4 h = *hp;
        h[0] += sigmoidf_(v[0]) * (lo16(ev.x) * rstde * gv[0]); h[1] += sigmoidf_(v[1]) * (hi16(ev.x) * rstde * gv[1]);
        h[2] += sigmoidf_(v[2]) * (lo16(ev.y) * rstde * gv[2]); h[3] += sigmoidf_(v[3]) * (hi16(ev.y) * rstde * gv[3]);
        *hp = h;
        *(u32x2*)(HB + (size_t)row * D + col) = pk4(h);
        return h;
    }
};

__device__ __forceinline__ void transpose_item(const float* W, int K, int N, int Npad, bf16* WT, const float* rowscale, int qcols, float* scr, int item, int lane) {
    const int nblk = Npad / 32, kb = item / nblk, nb = item % nblk, k0 = 64 * kb, n0 = 32 * nb;
    const int nq = n0 + 4 * (lane & 7);
#pragma unroll
    for (int i = 0; i < 8; ++i) {
        const int kk = 8 * i + (lane >> 3);
        f32x4 v = (nq < N) ? *(const f32x4*)(W + (size_t)(k0 + kk) * N + nq) : (f32x4){0.f, 0.f, 0.f, 0.f};
        if (rowscale) v = v * rowscale[k0 + kk];
        if (nq < qcols) v = v * QSCALE;
        scr[kk * 33 + 4 * (lane & 7)] = v[0]; scr[kk * 33 + 4 * (lane & 7) + 1] = v[1]; scr[kk * 33 + 4 * (lane & 7) + 2] = v[2]; scr[kk * 33 + 4 * (lane & 7) + 3] = v[3];
    }
    asm volatile("s_waitcnt lgkmcnt(0)" ::: "memory");
    const int c = lane & 7;
#pragma unroll
    for (int j = 0; j < 4; ++j) {
        const int nn = (lane >> 3) + 8 * j; const float* s = scr + (8 * c) * 33 + nn;
        u32x4 o; o.x = pk2(s[0 * 33], s[1 * 33]); o.y = pk2(s[2 * 33], s[3 * 33]); o.z = pk2(s[4 * 33], s[5 * 33]); o.w = pk2(s[6 * 33], s[7 * 33]);
        *(u32x4*)(WT + (size_t)(n0 + nn) * K + k0 + 8 * c) = o;
    }
    asm volatile("s_waitcnt lgkmcnt(0)" ::: "memory");
}
__device__ __forceinline__ void convert_bulk(const float* src, bf16* dst, size_t n, size_t gtid, size_t nthr) {
    for (size_t i = gtid * 8; i < n; i += nthr * 8) {
        const f32x4 a = *(const f32x4*)(src + i), b = *(const f32x4*)(src + i + 4);
        u32x4 o; o.x = pk2(a[0], a[1]); o.y = pk2(a[2], a[3]); o.z = pk2(b[0], b[1]); o.w = pk2(b[2], b[3]);
        *(u32x4*)(dst + i) = o;
    }
}
__device__ void phase_prologue(const Params& p, LAS unsigned char* lds_, int bid, int nblk) {
    unsigned char* lds = (unsigned char*)lds_;
    const int tid = tidx(), lane = tid & 63, w = tid >> 6;
    const int gw = bid * NWAVES + w, NGW = nblk * NWAVES;
    float* scr = (float*)(lds + w * 16384);
    constexpr int I_IN = 16 * (IN_PAD / 32), I_OUT = 16 * 32, I_Q = 16 * 64, I_G = 16 * 32, I_P = 4 * 32, I_L = I_IN + I_OUT + I_Q + I_G + I_P;
    for (int it = gw; it < DEPTH * I_L; it += NGW) {
        const int L = it / I_L; int r = it % I_L;
        if (r < I_IN) { transpose_item(p.w_in + (size_t)L * D * IN_COLS, D, IN_COLS, IN_PAD, (bf16*)(p.ws + WS_WIN) + (size_t)L * IN_PAD * D, p.ln_mix_g + L * D, 512, scr, r, lane); continue; } r -= I_IN;
        if (r < I_OUT) { transpose_item(p.w_out + (size_t)L * D * D, D, D, D, (bf16*)(p.ws + WS_WOUT) + (size_t)L * D * D, nullptr, 0, scr, r, lane); continue; } r -= I_OUT;
        if (r < I_Q) { transpose_item(p.peer_wq + (size_t)L * D * 2048, D, 2048, 2048, (bf16*)(p.ws + WS_WQ) + (size_t)L * 2048 * D, p.ln_ffn_g + L * D, 0, scr, r, lane); continue; } r -= I_Q;
        if (r < I_G) { transpose_item(p.ple_wg + (size_t)L * D * D, D, D, D, (bf16*)(p.ws + WS_WG) + (size_t)L * D * D, nullptr, 0, scr, r, lane); continue; } r -= I_G;
        transpose_item(p.ple_wp + (size_t)L * 256 * D, 256, D, D, (bf16*)(p.ws + WS_WP) + (size_t)L * D * 256, nullptr, 0, scr, r, lane);
    }
    const size_t gtid = (size_t)bid * NTHREADS + tid, nthr = (size_t)nblk * NTHREADS;
    for (int r = gw; r < 2 * DEPTH * NEXP; r += NGW) {
        const int which = r >= DEPTH * NEXP, rr = which ? r - DEPTH * NEXP : r;
        const float* srow = (which ? p.peer_v : p.peer_u) + (size_t)rr * D + 4 * lane;
        f32x4 v[4];
#pragma unroll
        for (int j = 0; j < 4; ++j) v[j] = *(const f32x4*)(srow + 256 * j);
        float mx = 0.f;
#pragma unroll
        for (int j = 0; j < 4; ++j) mx = fmaxf(mx, fmaxf(fmaxf(fabsf(v[j][0]), fabsf(v[j][1])), fmaxf(fabsf(v[j][2]), fabsf(v[j][3]))));
        mx = xrow16_max(row16_max(mx));
        const float inv = mx > 0.f ? 127.f / mx : 0.f;
        u32x4 o;
#pragma unroll
        for (int j = 0; j < 4; ++j) {
            const unsigned b0 = (unsigned)__float2int_rn(v[j][0] * inv) & 0xffu, b1 = (unsigned)__float2int_rn(v[j][1] * inv) & 0xffu, b2 = (unsigned)__float2int_rn(v[j][2] * inv) & 0xffu, b3 = (unsigned)__float2int_rn(v[j][3] * inv) & 0xffu;
            o[j] = b0 | (b1 << 8) | (b2 << 16) | (b3 << 24);
        }
        *(u32x4*)(p.ws + (which ? WS_V : WS_U) + (size_t)rr * D + 16 * lane) = o;
        if (lane == 0) ((float*)(p.ws + (which ? WS_SV : WS_SU)))[rr] = mx * (1.f / 127.f);
    }
    convert_bulk(p.p, (bf16*)(p.ws + WS_PB), (size_t)DEPTH * M * 256, gtid, nthr);
    convert_bulk(p.subkeys, (bf16*)(p.ws + WS_SK), (size_t)DEPTH * 8 * 2 * 128 * 128, gtid, nthr);
    float* H = (float*)(p.ws + WS_H); bf16* HB0 = (bf16*)(p.ws + WS_HB0); float* ss0 = (float*)(p.ws + WS_STAT);
    for (int m = gw; m < M; m += NGW) {
        const f32x4* xr = (const f32x4*)(p.x + (size_t)m * D) + lane;
        float ss = 0.f;
#pragma unroll
        for (int j = 0; j < 4; ++j) {
            const f32x4 v = xr[64 * j];
            ss += v[0] * v[0] + v[1] * v[1] + v[2] * v[2] + v[3] * v[3];
            ((f32x4*)(H + (size_t)m * D))[lane + 64 * j] = v;
            u32x2 o; o.x = pk2(v[0], v[1]); o.y = pk2(v[2], v[3]);
            ((u32x2*)(HB0 + (size_t)m * D))[lane + 64 * j] = o;
        }
        ss = wave_sum(ss);
        if (lane < 16) ss0[(size_t)m * 16 + lane] = lane == 0 ? ss : 0.f;
    }
}

typedef short v4i16_t __attribute__((ext_vector_type(4)));
__device__ __forceinline__ void glds16_asm(const void* gsrc, unsigned lds_dst) {
    unsigned keep;
    asm volatile("s_mov_b32 %0, m0\n\ts_mov_b32 m0, %2\n\ts_nop 0\n\tglobal_load_lds_dwordx4 %1, off\n\ts_mov_b32 m0, %0" : "=&s"(keep) : "v"(gsrc), "s"(lds_dst) : "memory");
}
__device__ __forceinline__ float max3_(float a, float b, float c) { float r; asm("v_max3_f32 %0, %1, %2, %3" : "=v"(r) : "v"(a), "v"(b), "v"(c)); return r; }
constexpr int ATT_BUF = 32768, ATT_VOFF = 16384;
__device__ __forceinline__ void att_unit(const Params& p, int L, LAS unsigned char* lds, int tid, int b, int hh, int qb, float lam, float lam_init) {
    const int lane = tid & 63, w = __builtin_amdgcn_readfirstlane(tid >> 6), fr = lane & 15, fq = lane >> 4;
    const bool grpB = w >= 4;
    const bf16* proj = (const bf16*)(p.ws + WS_PROJ);
    bf16* obuf = (bf16*)(p.ws + WS_OBUF);
    const float slope2 = 1.4426950408889634f / (float)(1 << (2 * (hh + 1)));
    const bf16* kbase = proj + (size_t)b * SEQ * PROJ_W + 512 + hh * 128;
    const bf16* vbase = proj + (size_t)b * SEQ * PROJ_W + 1024 + hh * 128;
    const int qw0 = qb * 128 + w * 16, T = 2 * (qb + 1);
    const int S_w = ((qw0 + 15) >> 6) + 1;
    bf16x8 qf[2][2];
#pragma unroll
    for (int mp = 0; mp < 2; ++mp)
#pragma unroll
        for (int ks = 0; ks < 2; ++ks) qf[mp][ks] = *(const bf16x8*)(proj + ((size_t)b * SEQ + qw0 + fr) * PROJ_W + hh * 128 + mp * 64 + ks * 32 + 8 * fq);
    f32x4 o[2][8];
#pragma unroll
    for (int mp = 0; mp < 2; ++mp)
#pragma unroll
        for (int dt = 0; dt < 8; ++dt) o[mp][dt] = (f32x4){0.f, 0.f, 0.f, 0.f};
    float mrun[2] = {-INFINITY, -INFINITY}, lrun[2] = {0.f, 0.f};
    int ksrc[2], vsrc[2];
#pragma unroll
    for (int i = 0; i < 2; ++i) { const int pc = tid + 512 * i, key = pc >> 4, ph = pc & 15;
        ksrc[i] = key * PROJ_W + ((ph ^ (key & 15)) * 8); vsrc[i] = key * PROJ_W + ((ph ^ ((key & 7) << 1)) * 8); }
    const unsigned ldsb = (unsigned)(size_t)lds;
    auto dma = [&](int t, int bo) {
#pragma unroll
        for (int i = 0; i < 2; ++i) {
            glds16_asm(kbase + (size_t)t * 64 * PROJ_W + ksrc[i], ldsb + bo + (w * 64 + 512 * i) * 16);
            glds16_asm(vbase + (size_t)t * 64 * PROJ_W + vsrc[i], ldsb + bo + ATT_VOFF + (w * 64 + 512 * i) * 16);
        }
    };
    int koff[2][2];
#pragma unroll
    for (int mp = 0; mp < 2; ++mp)
#pragma unroll
        for (int ks = 0; ks < 2; ++ks) koff[mp][ks] = fr * 256 + (((mp * 8 + ks * 4 + fq) ^ fr) << 4);
    const int gl = lane & 15;
    const int vrd0 = ATT_VOFF + (4 * fq + (gl >> 2)) * 256 + (gl & 3) * 8 + ((4 * (fq & 1) + (gl >> 2)) << 5);
    bf16x8 pb[2][2];
#pragma unroll
    for (int mp = 0; mp < 2; ++mp)
#pragma unroll
        for (int ks = 0; ks < 2; ++ks) pb[mp][ks] = qf[0][0];
#define ATT_SB() __builtin_amdgcn_sched_barrier(0)
#define ATT_VRD(dt) do { _Pragma("unroll") for (int q_ = 0; q_ < 4; ++q_) vf_[dt][q_] = __builtin_amdgcn_ds_read_tr16_b64_v4i16((LAS v4i16_t*)(lds + ((vb_ ^ ((dt) << 5)) + q_ * 4096))); } while (0)
#define ATT_VMM(PB, dt) do { _Pragma("unroll") for (int ks = 0; ks < 2; ++ks) { const v4i16_t v0 = vf_[dt][2 * ks], v1 = vf_[dt][2 * ks + 1]; \
            bf16x8 vf; vf[0] = v0[0]; vf[1] = v0[1]; vf[2] = v0[2]; vf[3] = v0[3]; vf[4] = v1[0]; vf[5] = v1[1]; vf[6] = v1[2]; vf[7] = v1[3]; \
            o[0][dt] = __builtin_amdgcn_mfma_f32_16x16x32_bf16(vf, PB[0][ks], o[0][dt], 0, 0, 0); \
            o[1][dt] = __builtin_amdgcn_mfma_f32_16x16x32_bf16(vf, PB[1][ks], o[1][dt], 0, 0, 0); } } while (0)
#define ATT_PV(PB, BO) do { const int vb_ = (BO) + vrd0; v4i16_t vf_[8][4]; \
        ATT_VRD(0); ATT_VRD(1); ATT_VRD(2); ATT_VRD(3); ATT_SB(); \
        ATT_VMM(PB, 0); ATT_VRD(4); ATT_SB(); ATT_VMM(PB, 1); ATT_VRD(5); ATT_SB(); ATT_VMM(PB, 2); ATT_VRD(6); ATT_SB(); ATT_VMM(PB, 3); ATT_VRD(7); ATT_SB(); \
        ATT_VMM(PB, 4); ATT_VMM(PB, 5); ATT_VMM(PB, 6); ATT_VMM(PB, 7); ATT_SB(); } while (0)
    dma(0, 0);
    asm volatile("" :: "v"(qf[0][0]), "v"(qf[0][1]), "v"(qf[1][0]), "v"(qf[1][1]));
    int bo_prev = 2 * ATT_BUF, bo_cur = 0, bo_next = ATT_BUF;
    for (int s = 0; s < T; ++s) {
        const int k0 = s * 64;
        asm volatile("s_waitcnt vmcnt(0)" ::: "memory");
        LDS_BARRIER();
        if (s + 1 < T) dma(s + 1, bo_next);
        if (grpB && s > 0 && s <= S_w) ATT_PV(pb, bo_prev);
        if (s < S_w) {
            f32x4 sc[2][4];
            const float base = -slope2 * (float)(qw0 + fr - k0 - 4 * fq);
#pragma unroll
            for (int kt = 0; kt < 4; ++kt)
#pragma unroll
                for (int r = 0; r < 4; ++r) { const float v = base + slope2 * (float)(16 * kt + r); sc[0][kt][r] = v; sc[1][kt][r] = v; }
            {
                bf16x8 kf[4][2][2];
#define ATT_KRD(kt) do { _Pragma("unroll") for (int mp = 0; mp < 2; ++mp) _Pragma("unroll") for (int ks = 0; ks < 2; ++ks) kf[kt][mp][ks] = *(const LAS bf16x8*)(lds + bo_cur + (kt) * 4096 + koff[mp][ks]); } while (0)
#define ATT_KMM(kt) do { _Pragma("unroll") for (int ks = 0; ks < 2; ++ks) _Pragma("unroll") for (int mp = 0; mp < 2; ++mp) sc[mp][kt] = __builtin_amdgcn_mfma_f32_16x16x32_bf16(kf[kt][mp][ks], qf[mp][ks], sc[mp][kt], 0, 0, 0); } while (0)
                ATT_KRD(0); ATT_KRD(1); ATT_SB();
                ATT_KMM(0); ATT_KRD(2); ATT_SB();
                ATT_KMM(1); ATT_KRD(3); ATT_SB();
                ATT_KMM(2); ATT_KMM(3); ATT_SB();
#undef ATT_KRD
#undef ATT_KMM
            }
            if (k0 + 63 > qw0) {
                const int lim = qw0 + fr - k0 - 4 * fq;
#pragma unroll
                for (int mp = 0; mp < 2; ++mp)
#pragma unroll
                    for (int kt = 0; kt < 4; ++kt)
#pragma unroll
                        for (int r = 0; r < 4; ++r) if (16 * kt + r > lim) sc[mp][kt][r] = -INFINITY;
            }
#pragma unroll
            for (int mp = 0; mp < 2; ++mp) {
                float mx = max3_(sc[mp][0][0], sc[mp][0][1], sc[mp][0][2]);
                mx = max3_(mx, sc[mp][0][3], sc[mp][1][0]);
#pragma unroll
                for (int kt = 1; kt < 4; ++kt) { mx = max3_(mx, sc[mp][kt][1], sc[mp][kt][2]); if (kt < 3) mx = max3_(mx, sc[mp][kt][3], sc[mp][kt + 1][0]); else mx = max3_(mx, sc[mp][kt][3], mx); }
                mx = xrow16_max(mx);
                const float mnew = fmaxf(mrun[mp], mx);
                const float alpha = __builtin_amdgcn_exp2f(mrun[mp] - mnew);
                mrun[mp] = mnew;
                float ps = 0.f;
#pragma unroll
                for (int kt = 0; kt < 4; ++kt)
#pragma unroll
                    for (int r = 0; r < 4; ++r) { const float e = __builtin_amdgcn_exp2f(sc[mp][kt][r] - mnew); sc[mp][kt][r] = e; ps += e; }
                lrun[mp] = lrun[mp] * alpha + ps;
#pragma unroll
                for (int ks = 0; ks < 2; ++ks) {
                    u32x4 pk; pk.x = cvtpk(sc[mp][2 * ks][0], sc[mp][2 * ks][1]); pk.y = cvtpk(sc[mp][2 * ks][2], sc[mp][2 * ks][3]);
                    pk.z = cvtpk(sc[mp][2 * ks + 1][0], sc[mp][2 * ks + 1][1]); pk.w = cvtpk(sc[mp][2 * ks + 1][2], sc[mp][2 * ks + 1][3]);
                    pb[mp][ks] = __builtin_bit_cast(bf16x8, pk);
                }
#pragma unroll
                for (int dt = 0; dt < 8; ++dt) o[mp][dt] = o[mp][dt] * alpha;
            }
            if (!grpB) ATT_PV(pb, bo_cur);
        }
        const int tb = bo_prev; bo_prev = bo_cur; bo_cur = bo_next; bo_next = tb;
    }
    if (grpB && S_w == T) ATT_PV(pb, bo_prev);
#undef ATT_PV
#undef ATT_VRD
#undef ATT_VMM
#undef ATT_SB
    const float i1 = __builtin_amdgcn_rcpf(xrow16_sum(lrun[0])), i2 = lam * __builtin_amdgcn_rcpf(xrow16_sum(lrun[1]));
    float ss = 0.f;
#pragma unroll
    for (int dt = 0; dt < 8; ++dt)
#pragma unroll
        for (int r = 0; r < 4; ++r) { const float v = o[0][dt][r] * i1 - o[1][dt][r] * i2; o[0][dt][r] = v; ss += v * v; }
    ss = xrow16_sum(ss);
    const float rn = rsqrtf(ss * (1.f / 128.f) + EPS) * (1.f - lam_init);
    const float* g = p.subln_g + L * 128;
    bf16* orow = obuf + ((size_t)b * SEQ + qw0 + fr) * D + hh * 128;
#pragma unroll
    for (int dt = 0; dt < 8; ++dt) {
        const f32x4 gv = *(const f32x4*)(g + 16 * dt + 4 * fq);
        u32x2 ov; ov.x = pk2(o[0][dt][0] * rn * gv[0], o[0][dt][1] * rn * gv[1]); ov.y = pk2(o[0][dt][2] * rn * gv[2], o[0][dt][3] * rn * gv[3]);
        *(u32x2*)(orow + 16 * dt + 4 * fq) = ov;
    }
}

__device__ void phase_att_queue(const Params& p, int L, LAS unsigned char* lds, int bid, int nblk) {
    const int tid = tidx(), lane = tid & 63;
    const float* lp = p.diff_lambda + L * 256;
    const float d1 = wave_sum(lp[lane] * lp[64 + lane]), d2 = wave_sum(lp[128 + lane] * lp[192 + lane]);
    const float lam_init = 0.8f - 0.6f * __expf(-0.3f * (float)L);
    const float lam = __expf(d1) - __expf(d2) + lam_init;
    unsigned* head = (unsigned*)(p.ws + WS_CTL) + CW_QUEUE + L;
    volatile LAS int* slot = (volatile LAS int*)(lds + LDS_MISC_OFF + 64);
    for (;;) {
        __syncthreads();
        if (tid == 0) *slot = (int)__hip_atomic_fetch_add(head, 1u, __ATOMIC_RELAXED, __HIP_MEMORY_SCOPE_AGENT);
        __syncthreads();
        const int u = *slot;
        if (u >= 512) break;
        att_unit(p, L, lds, tid, (u & 31) >> 2, u & 3, 15 - (u >> 5), lam, lam_init);
    }
}

constexpr size_t GD_WP = WS_ORAW, GD_QD = WS_ORAW + 16 * MiB, GD_AIP = WS_ORAW + 32 * MiB, GD_KDT = WS_ORAW + 40 * MiB, GD_UT = WS_ORAW + 56 * MiB, GD_GL = WS_ORAW + 72 * MiB;
__device__ __forceinline__ int perm_pos(int k) { return (k & ~31) + 8 * ((k >> 2) & 3) + 4 * ((k >> 4) & 1) + (k & 3); }
__device__ __forceinline__ float softplusf_(float x) { if (x > 20.f) return x; const float e = __expf(x); return e < 0.06f ? e * (1.f - e * (0.5f - e * (0.33333334f - 0.25f * e))) : __logf(1.f + e); }
__device__ __forceinline__ float gelu_erf(float v) {
    const float z = fabsf(v) * 0.70710678118654752f, t = __builtin_amdgcn_rcpf(1.f + 0.3275911f * z);
    const float pl = t * (0.254829592f + t * (-0.284496736f + t * (1.421413741f + t * (-1.453152027f + t * 1.061405429f))));
    const float er = 1.f - pl * __expf(-z * z);
    return 0.5f * v * (1.f + (v < 0.f ? -er : er));
}

constexpr int GP_KN = 0, GP_QN = 17408, GP_RT = 34816, GP_LM = 71680, GP_TB = 89088, GP_GT = 98304, GP_T0T = 99328;
constexpr int GP_KP = 272, GP_RP = 144, GP_LP = 68, GP_TP = 144;
__device__ void phase_gdn_prep(const Params& p, int L, LAS unsigned char* lds, int bid, int nblk) {
    const int tid = tidx(), lane = tid & 63, w = __builtin_amdgcn_readfirstlane(tid >> 6), fr = lane & 15, fq = lane >> 4;
    const bf16* proj = (const bf16*)(p.ws + WS_PROJ);
    const float* BA = (const float*)(p.ws + WS_BA);
    bf16* WP = (bf16*)(p.ws + GD_WP); bf16* QD = (bf16*)(p.ws + GD_QD); bf16* AIP = (bf16*)(p.ws + GD_AIP); bf16* KDT = (bf16*)(p.ws + GD_KDT); bf16* UT = (bf16*)(p.ws + GD_UT);
    float* GL = (float*)(p.ws + GD_GL);
    const float* cw = p.conv_w + (size_t)L * 4 * 1536;
    LAS float* beta_s = (LAS float*)(lds + GP_GT); LAS float* gc_s = beta_s + 64; LAS float* egc_s = gc_s + 64; LAS float* edl_s = egc_s + 64;
    LAS float* Lm = (LAS float*)(lds + GP_LM);
    for (int item = bid; item < 1024; item += nblk) {
        const int n = item & 31, bh = item >> 5, hh = bh & 3, b = bh >> 2, t0 = n * 64;
        const size_t row0 = (size_t)b * SEQ + t0;
        __syncthreads();
        const int colq = hh * 128 + 2 * lane;
        unsigned xq[11], xk[11], xv[11];
#pragma unroll
        for (int r = 0; r < 11; ++r) { const int tt = t0 + 8 * w - 3 + r;
            xq[r] = (tt >= 0) ? *(const unsigned*)(proj + ((size_t)b * SEQ + tt) * PROJ_W + 1536 + colq) : 0u;
            xk[r] = (tt >= 0) ? *(const unsigned*)(proj + ((size_t)b * SEQ + tt) * PROJ_W + 1536 + 512 + colq) : 0u;
            xv[r] = (tt >= 0) ? *(const unsigned*)(proj + ((size_t)b * SEQ + tt) * PROJ_W + 1536 + 1024 + colq) : 0u; }
        if (w == 0) {
            const float negA = -__expf(p.a_log[L * 4 + hh]), dtb = p.dt_bias[L * 4 + hh];
            const float bb = BA[(row0 + lane) * 8 + hh], aa = BA[(row0 + lane) * 8 + 4 + hh] + dtb;
            float c = negA * softplusf_(aa);
#pragma unroll
            for (int o = 1; o < 64; o <<= 1) { const float t = __shfl_up(c, o); if (lane >= o) c += t; }
            const float glast = __shfl(c, 63);
            beta_s[lane] = sigmoidf_(bb); gc_s[lane] = c; egc_s[lane] = __expf(c); edl_s[lane] = __expf(glast - c);
            if (lane == 0) GL[item] = __expf(glast);
        }
        __syncthreads();
        {
            {
                float wq[4][2];
#pragma unroll
                for (int j = 0; j < 4; ++j) { wq[j][0] = cw[j * 1536 + colq]; wq[j][1] = cw[j * 1536 + colq + 1]; }
#pragma unroll
                for (int i = 0; i < 8; ++i) {
                    const int c = 8 * w + i;
                    float q0 = 0.f, q1 = 0.f;
#pragma unroll
                    for (int j = 0; j < 4; ++j) { q0 += wq[j][0] * lo16(xq[i + j]); q1 += wq[j][1] * hi16(xq[i + j]); }
                    q0 *= sigmoidf_(q0); q1 *= sigmoidf_(q1);
                    const float sq = rsqrtf(wave_sum(q0 * q0 + q1 * q1) + EPS) * 0.08838834764831845f;
                    q0 *= sq; q1 *= sq;
                    const float eg = egc_s[c];
                    *(LAS unsigned*)(lds + GP_QN + c * GP_KP + lane * 4) = pk2(q0, q1);
                    *(unsigned*)(QD + ((size_t)item * 64 + c) * 128 + perm_pos(2 * lane)) = pk2(q0 * eg, q1 * eg);
                }
            }
            __builtin_amdgcn_sched_barrier(0);
            {
                float wk[4][2];
#pragma unroll
                for (int j = 0; j < 4; ++j) { wk[j][0] = cw[j * 1536 + 512 + colq]; wk[j][1] = cw[j * 1536 + 512 + colq + 1]; }
                unsigned kd0[8], kd1[8], rk0[8], rk1[8];
#pragma unroll
                for (int i = 0; i < 8; ++i) {
                    const int c = 8 * w + i;
                    float k0 = 0.f, k1 = 0.f;
#pragma unroll
                    for (int j = 0; j < 4; ++j) { k0 += wk[j][0] * lo16(xk[i + j]); k1 += wk[j][1] * hi16(xk[i + j]); }
                    k0 *= sigmoidf_(k0); k1 *= sigmoidf_(k1);
                    const float sk = rsqrtf(wave_sum(k0 * k0 + k1 * k1) + EPS);
                    k0 *= sk; k1 *= sk;
                    const float be = beta_s[c], eg = egc_s[c], ed = edl_s[c];
                    *(LAS unsigned*)(lds + GP_KN + c * GP_KP + lane * 4) = pk2(k0, k1);
                    kd0[i] = f2bf(k0 * ed); kd1[i] = f2bf(k1 * ed);
                    rk0[i] = f2bf(k0 * be * eg); rk1[i] = f2bf(k1 * be * eg);
                }
                u32x4 o;
                o.x = rk0[0] | (rk0[1] << 16); o.y = rk0[2] | (rk0[3] << 16); o.z = rk0[4] | (rk0[5] << 16); o.w = rk0[6] | (rk0[7] << 16); *(LAS u32x4*)(lds + GP_RT + (128 + 2 * lane) * GP_RP + 16 * w) = o;
                o.x = rk1[0] | (rk1[1] << 16); o.y = rk1[2] | (rk1[3] << 16); o.z = rk1[4] | (rk1[5] << 16); o.w = rk1[6] | (rk1[7] << 16); *(LAS u32x4*)(lds + GP_RT + (128 + 2 * lane + 1) * GP_RP + 16 * w) = o;
                const int pa = perm_pos(8 * w), pb = perm_pos(8 * w + 4);
                bf16* kr0 = KDT + ((size_t)item * 128 + 2 * lane) * 64; bf16* kr1 = kr0 + 64;
                u32x2 h2;
                h2.x = kd0[0] | (kd0[1] << 16); h2.y = kd0[2] | (kd0[3] << 16); *(u32x2*)(kr0 + pa) = h2;
                h2.x = kd0[4] | (kd0[5] << 16); h2.y = kd0[6] | (kd0[7] << 16); *(u32x2*)(kr0 + pb) = h2;
                h2.x = kd1[0] | (kd1[1] << 16); h2.y = kd1[2] | (kd1[3] << 16); *(u32x2*)(kr1 + pa) = h2;
                h2.x = kd1[4] | (kd1[5] << 16); h2.y = kd1[6] | (kd1[7] << 16); *(u32x2*)(kr1 + pb) = h2;
            }
            __builtin_amdgcn_sched_barrier(0);
            {
                float wv[4][2];
#pragma unroll
                for (int j = 0; j < 4; ++j) { wv[j][0] = cw[j * 1536 + 1024 + colq]; wv[j][1] = cw[j * 1536 + 1024 + colq + 1]; }
                unsigned rv0[8], rv1[8];
#pragma unroll
                for (int i = 0; i < 8; ++i) {
                    float v0 = 0.f, v1 = 0.f;
#pragma unroll
                    for (int j = 0; j < 4; ++j) { v0 += wv[j][0] * lo16(xv[i + j]); v1 += wv[j][1] * hi16(xv[i + j]); }
                    v0 *= sigmoidf_(v0); v1 *= sigmoidf_(v1);
                    const float be = beta_s[8 * w + i];
                    rv0[i] = f2bf(v0 * be); rv1[i] = f2bf(v1 * be);
                }
                u32x4 o;
                o.x = rv0[0] | (rv0[1] << 16); o.y = rv0[2] | (rv0[3] << 16); o.z = rv0[4] | (rv0[5] << 16); o.w = rv0[6] | (rv0[7] << 16); *(LAS u32x4*)(lds + GP_RT + (2 * lane) * GP_RP + 16 * w) = o;
                o.x = rv1[0] | (rv1[1] << 16); o.y = rv1[2] | (rv1[3] << 16); o.z = rv1[4] | (rv1[5] << 16); o.w = rv1[6] | (rv1[7] << 16); *(LAS u32x4*)(lds + GP_RT + (2 * lane + 1) * GP_RP + 16 * w) = o;
            }
        }
        __syncthreads();
#pragma unroll
        for (int q = 0; q < 2; ++q) {
            const int id = 2 * w + q, ct = id >> 2, st = id & 3;
            if (st <= ct) {
                f32x4 acc = (f32x4){0.f, 0.f, 0.f, 0.f};
#pragma unroll
                for (int ks = 0; ks < 4; ++ks) {
                    const bf16x8 a = *(const LAS bf16x8*)(lds + GP_KN + (16 * ct + fr) * GP_KP + (32 * ks + 8 * fq) * 2);
                    const bf16x8 bb = *(const LAS bf16x8*)(lds + GP_KN + (16 * st + fr) * GP_KP + (32 * ks + 8 * fq) * 2);
                    acc = __builtin_amdgcn_mfma_f32_16x16x32_bf16(a, bb, acc, 0, 0, 0);
                }
                const int s = 16 * st + fr; const float gs = gc_s[s];
#pragma unroll
                for (int r = 0; r < 4; ++r) { const int c = 16 * ct + 4 * fq + r;
                    Lm[c * GP_LP + s] = (s < c) ? beta_s[c] * acc[r] * __expf(fminf(gc_s[c] - gs, 0.f)) : 0.f; }
            }
        }
        __syncthreads();
        if (w < 2) {
            const int o = 32 * w;
            float t[32];
            int zoff = 0; asm volatile("" : "+v"(zoff));
            const LAS float* Lz = Lm + zoff + o * GP_LP + o;
            const int col = lane & 31;
#pragma unroll
            for (int i = 0; i < 32; ++i) {
                float a0 = (i == lane) ? 1.f : 0.f, a1 = 0.f, a2 = 0.f, a3 = 0.f;
#pragma unroll
                for (int s4 = 0; s4 + 4 <= i; s4 += 4) { const f32x4 lv = *(const LAS f32x4*)(Lz + i * GP_LP + s4);
                    a0 -= lv[0] * t[s4]; a1 -= lv[1] * t[s4 + 1]; a2 -= lv[2] * t[s4 + 2]; a3 -= lv[3] * t[s4 + 3]; }
#pragma unroll
                for (int s = i & ~3; s < i; ++s) a0 -= Lz[i * GP_LP + s] * t[s];
                t[i] = (lane < 32) ? (a0 + a1) + (a2 + a3) : 0.f;
                const bf16 tb = (bf16)f2bf(t[i]);
                if (w == 0) { *(LAS bf16*)(lds + GP_TB + i * GP_TP + lane * 2) = tb;
                              if (lane < 32) *(LAS bf16*)(lds + GP_T0T + lane * 80 + i * 2) = tb; }
                else if (lane < 32) *(LAS bf16*)(lds + GP_TB + (32 + i) * GP_TP + (32 + col) * 2) = tb;
                if ((i & 3) == 3) __builtin_amdgcn_sched_barrier(0);
            }
        } else {
            for (int id = w - 2; id < 16; id += 6) {
                const int ct = id >> 2, st = id & 3;
                f32x4 acc = (f32x4){0.f, 0.f, 0.f, 0.f};
                if (st <= ct) {
#pragma unroll
                    for (int ks = 0; ks < 4; ++ks) {
                        const bf16x8 a = *(const LAS bf16x8*)(lds + GP_QN + (16 * ct + fr) * GP_KP + (32 * ks + 8 * fq) * 2);
                        const bf16x8 bb = *(const LAS bf16x8*)(lds + GP_KN + (16 * st + fr) * GP_KP + (32 * ks + 8 * fq) * 2);
                        acc = __builtin_amdgcn_mfma_f32_16x16x32_bf16(a, bb, acc, 0, 0, 0);
                    }
                }
                const int s = 16 * st + fr; const float gs = gc_s[s]; const int ps = perm_pos(s);
#pragma unroll
                for (int r = 0; r < 4; ++r) { const int c = 16 * ct + 4 * fq + r;
                    const float v = (s <= c) ? acc[r] * __expf(fminf(gc_s[c] - gs, 0.f)) : 0.f;
                    AIP[((size_t)item * 64 + c) * 64 + ps] = (bf16)f2bf(v); }
            }
        }
        __syncthreads();
        if (w == 0) {
            f32x4 P[2][2];
#pragma unroll
            for (int it = 0; it < 2; ++it) {
                const LAS float* lr = Lm + (32 + 16 * it + fr) * GP_LP + 8 * fq;
                const f32x4 l0 = *(const LAS f32x4*)lr, l1 = *(const LAS f32x4*)(lr + 4);
                u32x4 pk; pk.x = cvtpk(l0[0], l0[1]); pk.y = cvtpk(l0[2], l0[3]); pk.z = cvtpk(l1[0], l1[1]); pk.w = cvtpk(l1[2], l1[3]);
                const bf16x8 a = __builtin_bit_cast(bf16x8, pk);
#pragma unroll
                for (int jt = 0; jt < 2; ++jt) {
                    const bf16x8 bb = *(const LAS bf16x8*)(lds + GP_T0T + (16 * jt + fr) * 80 + 16 * fq);
                    P[it][jt] = __builtin_amdgcn_mfma_f32_16x16x32_bf16(a, bb, (f32x4){0.f, 0.f, 0.f, 0.f}, 0, 0, 0);
                }
            }
#pragma unroll
            for (int jt = 0; jt < 2; ++jt) {
                u32x4 pk; pk.x = cvtpk(P[0][jt][0], P[0][jt][1]); pk.y = cvtpk(P[0][jt][2], P[0][jt][3]); pk.z = cvtpk(P[1][jt][0], P[1][jt][1]); pk.w = cvtpk(P[1][jt][2], P[1][jt][3]);
                const bf16x8 pb = __builtin_bit_cast(bf16x8, pk);
#pragma unroll
                for (int i2 = 0; i2 < 2; ++i2) {
                    const LAS unsigned char* tr = lds + GP_TB + (32 + 16 * i2 + fr) * GP_TP + (32 + 4 * fq) * 2;
                    const u32x2 ta = *(const LAS u32x2*)tr, tb2 = *(const LAS u32x2*)(tr + 32);
                    u32x4 ak; ak.x = ta.x; ak.y = ta.y; ak.z = tb2.x; ak.w = tb2.y;
                    const f32x4 r = __builtin_amdgcn_mfma_f32_16x16x32_bf16(__builtin_bit_cast(bf16x8, ak), pb, (f32x4){0.f, 0.f, 0.f, 0.f}, 0, 0, 0);
#pragma unroll
                    for (int q = 0; q < 4; ++q) *(LAS bf16*)(lds + GP_TB + (32 + 16 * i2 + 4 * fq + q) * GP_TP + (16 * jt + fr) * 2) = (bf16)f2bf(-r[q]);
                }
            }
        }
        __syncthreads();
#pragma unroll
        for (int q = 0; q < 2; ++q) {
            const int colt = 2 * w + q;
            bf16x8 af[2];
#pragma unroll
            for (int ks = 0; ks < 2; ++ks) af[ks] = *(const LAS bf16x8*)(lds + GP_RT + (16 * colt + fr) * GP_RP + (32 * ks + 8 * fq) * 2);
#pragma unroll
            for (int ct = 0; ct < 4; ++ct) {
                f32x4 acc = (f32x4){0.f, 0.f, 0.f, 0.f};
#pragma unroll
                for (int ks = 0; ks < 2; ++ks) {
                    const bf16x8 bb = *(const LAS bf16x8*)(lds + GP_TB + (16 * ct + fr) * GP_TP + (32 * ks + 8 * fq) * 2);
                    acc = __builtin_amdgcn_mfma_f32_16x16x32_bf16(af[ks], bb, acc, 0, 0, 0);
                }
                const int c = 16 * ct + fr;
                if (colt < 8) {
#pragma unroll
                    for (int r = 0; r < 4; ++r) UT[((size_t)item * 128 + 16 * colt + 4 * fq + r) * 64 + c] = (bf16)f2bf(acc[r]);
                } else {
                    const int kt = colt - 8;
                    u32x2 h2; h2.x = pk2(-acc[0], -acc[1]); h2.y = pk2(-acc[2], -acc[3]);
                    *(u32x2*)(WP + ((size_t)item * 64 + c) * 128 + 32 * (kt >> 1) + 8 * fq + 4 * (kt & 1)) = h2;
                }
            }
        }
    }
    __syncthreads();
}

constexpr int GS_WP = 0, GS_QD = 16384, GS_AIP = 32768, GS_KDT = 40960, GS_BUF = 57344, GS_OB = 2 * GS_BUF, GS_OBP = 272, GS_OBT = 64 * GS_OBP;
__device__ void phase_gdn_scan(const Params& p, int L, LAS unsigned char* lds, int bid, int nblk) {
    const int tid = tidx(), lane = tid & 63, w = __builtin_amdgcn_readfirstlane(tid >> 6), fr = lane & 15, fq = lane >> 4;
    const bf16* proj = (const bf16*)(p.ws + WS_PROJ);
    const bf16* WP = (const bf16*)(p.ws + GD_WP); const bf16* QD = (const bf16*)(p.ws + GD_QD); const bf16* AIP = (const bf16*)(p.ws + GD_AIP);
    const bf16* KDT = (const bf16*)(p.ws + GD_KDT); const bf16* UT = (const bf16*)(p.ws + GD_UT); const float* GL = (const float*)(p.ws + GD_GL);
    bf16* obuf = (bf16*)(p.ws + WS_OBUF);
    for (int item = bid; item < 32; item += nblk) {
        const int hh = item & 3, b = item >> 2;
        const int fc = tid >> 4, fv = tid & 15;
        float gn[8];
#pragma unroll
        for (int i = 0; i < 8; ++i) gn[i] = p.gdn_norm_g[L * 128 + 8 * fv + i];
        f32x4 S[8];
#pragma unroll
        for (int kt = 0; kt < 8; ++kt) S[kt] = (f32x4){0.f, 0.f, 0.f, 0.f};
        auto dma = [&](int ci, int buf) {
#pragma unroll
            for (int i = 0; i < 7; ++i) {
                const int pc = tid + 512 * i;
                const bf16* src;
                if (i < 2) { const int r = pc >> 4; src = WP + (size_t)ci * 8192 + r * 128 + (((pc & 15) ^ (r & 15)) * 8); }
                else if (i < 4) { const int q = pc - 1024, r = q >> 4; src = QD + (size_t)ci * 8192 + r * 128 + (((q & 15) ^ (r & 15)) * 8); }
                else if (i < 5) { const int q = pc - 2048, r = q >> 3; src = AIP + (size_t)ci * 4096 + r * 64 + (((q & 7) ^ ((r >> 1) & 7)) * 8); }
                else { const int q = pc - 2560, r = q >> 3; src = KDT + (size_t)ci * 8192 + r * 64 + (((q & 7) ^ ((r >> 1) & 7)) * 8); }
                __builtin_amdgcn_global_load_lds((const unsigned*)src, (LAS unsigned*)(lds + buf * GS_BUF + (w * 64 + 512 * i) * 16), 16, 0, 0);
            }
        };
        int offk[4], offa[2];
#pragma unroll
        for (int ks = 0; ks < 4; ++ks) offk[ks] = fr * 256 + (((4 * ks + fq) ^ fr) * 16);
#pragma unroll
        for (int ss = 0; ss < 2; ++ss) offa[ss] = fr * 128 + (((4 * ss + fq) ^ ((fr >> 1) & 7)) * 16);
        __syncthreads();
        dma(item * 32, 0);
        u32x2 ut[4]; float gl;
        {
            const int ci = item * 32;
#pragma unroll
            for (int ct = 0; ct < 4; ++ct) ut[ct] = *(const u32x2*)(UT + ((size_t)ci * 128 + 16 * w + fr) * 64 + 16 * ct + 4 * fq);
            gl = GL[ci];
        }
        u32x4 zp[2];
        zp[0] = (u32x4){0u, 0u, 0u, 0u}; zp[1] = zp[0];
        asm volatile("s_waitcnt vmcnt(0)" ::: "memory");
        __syncthreads();
#define GS_FINISH(ps, TILE, DST) do { const int c = 32 * (ps) + fc; \
            const u32x4 ov = *(const LAS u32x4*)(lds + (TILE) + c * GS_OBP + fv * 16); \
            float o8[8]; \
            _Pragma("unroll") for (int i = 0; i < 4; ++i) { o8[2 * i] = lo16(ov[i]); o8[2 * i + 1] = hi16(ov[i]); } \
            float ss = 0.f; \
            _Pragma("unroll") for (int i = 0; i < 8; ++i) ss += o8[i] * o8[i]; \
            const float rn = rsqrtf(row16_sum(ss) * (1.f / 128.f) + EPS); \
            u32x4 res; \
            _Pragma("unroll") for (int i = 0; i < 4; ++i) { \
                const float z0 = lo16(zp[ps][i]), z1 = hi16(zp[ps][i]); \
                res[i] = cvtpk(o8[2 * i] * rn * gn[2 * i] * (z0 * sigmoidf_(z0)), o8[2 * i + 1] * rn * gn[2 * i + 1] * (z1 * sigmoidf_(z1))); } \
            *(u32x4*)((DST) + (size_t)c * D) = res; } while (0)
        bf16* const dummy = (bf16*)(p.ws + WS_Q2) + tid * 8;
        for (int n = 0; n < 32; ++n) {
            const int ci = item * 32 + n, buf = n & 1;
            const size_t rowc = (size_t)b * SEQ + n * 64;
            if (n + 1 < 32) dma(ci + 1, buf ^ 1);
            u32x2 utn[4]; float gln = 0.f;
            {
                const int cn = ci + (n + 1 < 32 ? 1 : 0);
#pragma unroll
                for (int ct = 0; ct < 4; ++ct) utn[ct] = *(const u32x2*)(UT + ((size_t)cn * 128 + 16 * w + fr) * 64 + 16 * ct + 4 * fq);
                gln = GL[cn];
            }
            u32x4 zq[2];
#pragma unroll
            for (int ps = 0; ps < 2; ++ps) zq[ps] = *(const u32x4*)(proj + (rowc + 32 * ps + fc) * PROJ_W + 3072 + hh * 128 + 8 * fv);
            bf16* const fdst = n > 0 ? obuf + (rowc - 64) * D + 512 + hh * 128 + 8 * fv : dummy;
            const int tprev = GS_OB + (buf ^ 1) * GS_OBT, tcur = GS_OB + buf * GS_OBT;
            f32x4 vn[4], oacc[4];
#pragma unroll
            for (int ct = 0; ct < 4; ++ct) { vn[ct] = (f32x4){lo16(ut[ct].x), hi16(ut[ct].x), lo16(ut[ct].y), hi16(ut[ct].y)}; oacc[ct] = (f32x4){0.f, 0.f, 0.f, 0.f}; }
            bf16x8 sb[4];
#pragma unroll
            for (int ks = 0; ks < 4; ++ks) { u32x4 pk; pk.x = cvtpk(S[2 * ks][0], S[2 * ks][1]); pk.y = cvtpk(S[2 * ks][2], S[2 * ks][3]); pk.z = cvtpk(S[2 * ks + 1][0], S[2 * ks + 1][1]); pk.w = cvtpk(S[2 * ks + 1][2], S[2 * ks + 1][3]);
                sb[ks] = __builtin_bit_cast(bf16x8, pk); }
            LAS unsigned char* bb = lds + buf * GS_BUF;
            bf16x8 f0[8], f1[8];
#define LD_A(F, ct) do { _Pragma("unroll") for (int ks = 0; ks < 4; ++ks) { F[ks] = *(const LAS bf16x8*)(bb + GS_WP + (ct) * 4096 + offk[ks]); \
                    F[4 + ks] = *(const LAS bf16x8*)(bb + GS_QD + (ct) * 4096 + offk[ks]); } } while (0)
#define MM_A(F, ct) do { _Pragma("unroll") for (int ks = 0; ks < 4; ++ks) { vn[ct] = __builtin_amdgcn_mfma_f32_16x16x32_bf16(F[ks], sb[ks], vn[ct], 0, 0, 0); \
                    oacc[ct] = __builtin_amdgcn_mfma_f32_16x16x32_bf16(sb[ks], F[4 + ks], oacc[ct], 0, 0, 0); } } while (0)
#define SBAR() __builtin_amdgcn_sched_barrier(0)
            LD_A(f0, 0); SBAR();
            LD_A(f1, 1); MM_A(f0, 0); SBAR();
            LD_A(f0, 2); MM_A(f1, 1); GS_FINISH(0, tprev, fdst); SBAR();
            LD_A(f1, 3); MM_A(f0, 2); SBAR();
#pragma unroll
            for (int ct = 0; ct < 4; ++ct)
#pragma unroll
                for (int ss = 0; ss < 2; ++ss) f0[2 * ct + ss] = *(const LAS bf16x8*)(bb + GS_AIP + ct * 2048 + offa[ss]);
            MM_A(f1, 3); GS_FINISH(1, tprev, fdst); SBAR();
            bf16x8 vb[2];
#pragma unroll
            for (int ss = 0; ss < 2; ++ss) { u32x4 pk; pk.x = cvtpk(vn[2 * ss][0], vn[2 * ss][1]); pk.y = cvtpk(vn[2 * ss][2], vn[2 * ss][3]); pk.z = cvtpk(vn[2 * ss + 1][0], vn[2 * ss + 1][1]); pk.w = cvtpk(vn[2 * ss + 1][2], vn[2 * ss + 1][3]);
                vb[ss] = __builtin_bit_cast(bf16x8, pk); }
#pragma unroll
            for (int kt = 0; kt < 4; ++kt)
#pragma unroll
                for (int ss = 0; ss < 2; ++ss) f1[2 * kt + ss] = *(const LAS bf16x8*)(bb + GS_KDT + kt * 2048 + offa[ss]);
#pragma unroll
            for (int ct = 0; ct < 4; ++ct)
#pragma unroll
                for (int ss = 0; ss < 2; ++ss) oacc[ct] = __builtin_amdgcn_mfma_f32_16x16x32_bf16(vb[ss], f0[2 * ct + ss], oacc[ct], 0, 0, 0);
            SBAR();
#pragma unroll
            for (int kt = 4; kt < 8; ++kt)
#pragma unroll
                for (int ss = 0; ss < 2; ++ss) f0[2 * (kt - 4) + ss] = *(const LAS bf16x8*)(bb + GS_KDT + kt * 2048 + offa[ss]);
#pragma unroll
            for (int kt = 0; kt < 4; ++kt) {
                S[kt] = S[kt] * gl;
#pragma unroll
                for (int ss = 0; ss < 2; ++ss) S[kt] = __builtin_amdgcn_mfma_f32_16x16x32_bf16(f1[2 * kt + ss], vb[ss], S[kt], 0, 0, 0);
            }
#pragma unroll
            for (int ct = 0; ct < 4; ++ct) {
                u32x2 pk; pk.x = cvtpk(oacc[ct][0], oacc[ct][1]); pk.y = cvtpk(oacc[ct][2], oacc[ct][3]);
                *(LAS u32x2*)(lds + tcur + (16 * ct + fr) * GS_OBP + (16 * w + 4 * fq) * 2) = pk;
            }
            SBAR();
#pragma unroll
            for (int kt = 4; kt < 8; ++kt) {
                S[kt] = S[kt] * gl;
#pragma unroll
                for (int ss = 0; ss < 2; ++ss) S[kt] = __builtin_amdgcn_mfma_f32_16x16x32_bf16(f0[2 * (kt - 4) + ss], vb[ss], S[kt], 0, 0, 0);
            }
#undef LD_A
#undef MM_A
#undef SBAR
#pragma unroll
            for (int ct = 0; ct < 4; ++ct) ut[ct] = utn[ct];
            gl = gln; zp[0] = zq[0]; zp[1] = zq[1];
            asm volatile("s_waitcnt vmcnt(0)" ::: "memory");
            LDS_BARRIER();
        }
        {
            bf16* const fdst = obuf + ((size_t)b * SEQ + 31 * 64) * D + 512 + hh * 128 + 8 * fv;
            GS_FINISH(0, GS_OB + GS_OBT, fdst); GS_FINISH(1, GS_OB + GS_OBT, fdst);
        }
#undef GS_FINISH
        __syncthreads();
    }
}

__device__ __forceinline__ unsigned sortable(float f) { const unsigned u = __float_as_uint(f); return u ^ ((unsigned)((int)u >> 31) | 0x80000000u); }
__device__ __forceinline__ float unsortable(unsigned s) { return __uint_as_float((s & 0x80000000u) ? (s ^ 0x80000000u) : ~s); }
#define CE(a, b) do { const unsigned _x = k[a], _y = k[b]; k[a] = _x > _y ? _x : _y; k[b] = _x > _y ? _y : _x; } while (0)
constexpr int PE_TK = 0, PE_TAB = 8192, PE_ID = 8448, PE_GT = PE_ID + 32768, PE_SK = PE_GT + 32768;
__device__ void phase_peer(const Params& p, int L, LAS unsigned char* lds, int bid, int nblk) {
    const int tid = tidx(), lane = tid & 63, w = __builtin_amdgcn_readfirstlane(tid >> 6), fr = lane & 15, fq = lane >> 4;
    const bf16* Q2 = (const bf16*)(p.ws + WS_Q2);
    const bf16* SK = (const bf16*)(p.ws + WS_SK) + (size_t)L * 8 * 2 * 128 * 128;
    float* H = (float*)(p.ws + WS_H); bf16* HB2 = (bf16*)(p.ws + WS_HB2);
    const unsigned char* U = p.ws + WS_U + (size_t)L * NEXP * D;
    const unsigned char* V = p.ws + WS_V + (size_t)L * NEXP * D;
    const float* SU = (const float*)(p.ws + WS_SU) + (size_t)L * NEXP; const float* SV = (const float*)(p.ws + WS_SV) + (size_t)L * NEXP;
    const float* g = p.ln_ffn_g + L * D;
    LAS unsigned* TK = (LAS unsigned*)(lds + PE_TK);
    LAS unsigned short* TAB = (LAS unsigned short*)(lds + PE_TAB);
    LAS int* IDL = (LAS int*)(lds + PE_ID); LAS float* GTL = (LAS float*)(lds + PE_GT);
    if (tid < 64) {
        int a = 0, base = 0, q = tid; unsigned short v = 0xffff;
        if (q < 50) { for (;;) { const int cnt = 16 / (a + 1); if (q < base + cnt) break; base += cnt; ++a; } v = (unsigned short)((a << 8) | (q - base)); }
        TAB[tid] = v;
    }
    for (int item = bid; item < M / 64; item += nblk) {
        const int tok0 = item * 64;
        int tid_o = tid; asm volatile("" : "+v"(tid_o));
        const int tid = tid_o, lane = tid & 63, fr = lane & 15, fq = lane >> 4;
        __syncthreads();
        const int tg = w & 3, cc = w >> 2;
        int zs = 0; asm volatile("" : "+v"(zs));
        const bf16* SK_ = SK + zs;
#define SK_FETCH(hd) do { _Pragma("unroll") for (int i = 0; i < 8; ++i) { const int pc = tid + 512 * i, nn = (pc >> 4) & 127; \
            __builtin_amdgcn_global_load_lds((const unsigned*)(SK_ + ((size_t)((hd) * 2 + (pc >> 11)) * 128 + nn) * 128 + (((pc & 15) ^ (nn & 15)) * 8)), \
                                             (LAS unsigned*)(lds + PE_SK + (w * 64 + 512 * i) * 16), 16, 0, 0); } } while (0)
        SK_FETCH(0);
        asm volatile("s_waitcnt vmcnt(0)" ::: "memory");
        __syncthreads();
        for (int hh = 0; hh < 8; ++hh) {
            {
                f32x4 acc[8];
#pragma unroll
                for (int nt = 0; nt < 8; ++nt) acc[nt] = (f32x4){0.f, 0.f, 0.f, 0.f};
                bf16x8 qa[4];
#pragma unroll
                for (int ks = 0; ks < 4; ++ks) qa[ks] = *(const bf16x8*)(Q2 + (size_t)(tok0 + 16 * tg + fr) * 2048 + hh * 256 + cc * 128 + 32 * ks + 8 * fq);
                const LAS unsigned char* skb = lds + PE_SK + cc * 32768 + fr * 256;
#pragma unroll
                for (int nt = 0; nt < 8; ++nt)
#pragma unroll
                    for (int ks = 0; ks < 4; ++ks) {
                        const bf16x8 kb = *(const LAS bf16x8*)(skb + nt * 4096 + (((4 * ks + fq) ^ fr) << 4));
                        acc[nt] = __builtin_amdgcn_mfma_f32_16x16x32_bf16(qa[ks], kb, acc[nt], 0, 0, 0);
                    }
#pragma unroll
                for (int r = 0; r < 4; ++r) {
                    unsigned k[8];
#pragma unroll
                    for (int nt = 0; nt < 8; ++nt) k[nt] = (sortable(acc[nt][r]) & ~0x7Fu) | (unsigned)(127 - (16 * nt + fr));
                    CE(0, 1); CE(2, 3); CE(4, 5); CE(6, 7); CE(0, 2); CE(1, 3); CE(4, 6); CE(5, 7); CE(1, 2); CE(5, 6); CE(0, 4); CE(3, 7);
                    CE(1, 5); CE(2, 6); CE(1, 4); CE(3, 6); CE(2, 4); CE(3, 5); CE(3, 4);
                    unsigned res = 0u;
#pragma unroll
                    for (int rd = 0; rd < 16; ++rd) {
                        const unsigned m = row16_umax(k[0]);
                        const bool win = k[0] == m;
#pragma unroll
                        for (int i = 0; i < 7; ++i) k[i] = win ? k[i + 1] : k[i];
                        k[7] = win ? 0u : k[7];
                        res = (fr == rd) ? m : res;
                    }
                    TK[(cc * 64 + 16 * tg + 4 * fq + r) * 16 + fr] = res;
                }
            }
            __syncthreads();
            if (hh + 1 < 8) SK_FETCH(hh + 1);
#pragma unroll
            for (int ps = 0; ps < 2; ++ps) {
                const int tl = 8 * w + 4 * ps + fq;
                unsigned k[4];
#pragma unroll
                for (int sl = 0; sl < 4; ++sl) {
                    const int q = sl * 16 + fr;
                    const unsigned ab = TAB[q];
                    const unsigned k1 = TK[tl * 16 + ((ab >> 8) & 15)], k2 = TK[(64 + tl) * 16 + (ab & 15)];
                    const float v = unsortable(k1 & ~0x7Fu) + unsortable(k2 & ~0x7Fu);
                    k[sl] = (q < 50) ? ((sortable(v) & ~0x3Fu) | (unsigned)(63 - q)) : 0u;
                }
                CE(0, 1); CE(2, 3); CE(0, 2); CE(1, 3); CE(1, 2);
                unsigned res = 0u;
#pragma unroll
                for (int rd = 0; rd < 16; ++rd) {
                    const unsigned m = row16_umax(k[0]);
                    const bool win = k[0] == m;
                    k[0] = win ? k[1] : k[0]; k[1] = win ? k[2] : k[1]; k[2] = win ? k[3] : k[2]; k[3] = win ? 0u : k[3];
                    res = (fr == rd) ? m : res;
                }
                const unsigned ab = TAB[63 - (res & 0x3Fu)];
                const unsigned k1 = TK[tl * 16 + ((ab >> 8) & 15)], k2 = TK[(64 + tl) * 16 + (ab & 15)];
                const float v = unsortable(k1 & ~0x7Fu) + unsortable(k2 & ~0x7Fu);
                const float e = __expf(v - row16_max(v));
                const float sum = row16_sum(e);
                IDL[tl * 128 + hh * 16 + fr] = (int)((127u - (k1 & 0x7Fu)) * 128u + (127u - (k2 & 0x7Fu)));
                GTL[tl * 128 + hh * 16 + fr] = e * __builtin_amdgcn_rcpf(sum);
            }
            asm volatile("s_waitcnt vmcnt(0)" ::: "memory");
            __syncthreads();
        }
#undef SK_FETCH
        for (int ti = 0; ti < 8; ++ti) {
            const int tl = 8 * w + ti;
            unsigned k0 = ((unsigned)IDL[tl * 128 + lane] << 7) | (unsigned)lane, k1 = ((unsigned)IDL[tl * 128 + 64 + lane] << 7) | (unsigned)(64 + lane);
#pragma unroll
            for (int kk = 2; kk <= 128; kk <<= 1) {
#pragma unroll
                for (int j = kk >> 1; j >= 1; j >>= 1) {
                    if (j == 64) { const unsigned lo = k0 < k1 ? k0 : k1, hi = k0 < k1 ? k1 : k0; k0 = lo; k1 = hi; }
                    else {
                        const unsigned p0 = (unsigned)__shfl_xor((int)k0, j), p1 = (unsigned)__shfl_xor((int)k1, j);
                        const bool up0 = ((lane & kk) == 0) || kk == 128, up1 = (((lane + 64) & kk) == 0);
                        const bool low = (lane & j) == 0;
                        k0 = (low == up0) ? (k0 < p0 ? k0 : p0) : (k0 > p0 ? k0 : p0);
                        k1 = (low == (kk == 128 ? true : up1)) ? (k1 < p1 ? k1 : p1) : (k1 > p1 ? k1 : p1);
                    }
                }
            }
            const float g0 = GTL[tl * 128 + (k0 & 127u)], g1 = GTL[tl * 128 + (k1 & 127u)];
            asm volatile("s_waitcnt lgkmcnt(0)" ::: "memory");
            IDL[tl * 128 + lane] = (int)(k0 >> 7); IDL[tl * 128 + 64 + lane] = (int)(k1 >> 7);
            GTL[tl * 128 + lane] = g0; GTL[tl * 128 + 64 + lane] = g1;
        }
        __syncthreads();
        {
            int zo = 0; asm volatile("" : "+v"(zo));
            const float* g_ = g + zo; const unsigned char* U_ = U + zo; const float* H_ = H + zo;
            int xq[8][4]; float sx[8];
#pragma unroll
            for (int t = 0; t < 8; ++t) {
                const float* hrow = H_ + (size_t)(tok0 + 8 * w + t) * D + 4 * lane;
                float xn[16];
#pragma unroll
                for (int j = 0; j < 4; ++j) { const f32x4 a = *(const f32x4*)(hrow + 256 * j); xn[4 * j] = a[0]; xn[4 * j + 1] = a[1]; xn[4 * j + 2] = a[2]; xn[4 * j + 3] = a[3]; }
                float ss = 0.f;
#pragma unroll
                for (int i = 0; i < 16; ++i) ss += xn[i] * xn[i];
                const float rstd = rsqrtf(wave_sum(ss) * (1.f / D) + EPS);
                float mx = 0.f;
#pragma unroll
                for (int i = 0; i < 16; ++i) { xn[i] = xn[i] * rstd * g_[256 * (i >> 2) + 4 * lane + (i & 3)]; mx = fmaxf(mx, fabsf(xn[i])); }
                mx = xrow16_max(row16_max(mx));
                const float xinv = mx > 0.f ? 127.f / mx : 0.f; sx[t] = mx * (1.f / 127.f);
#pragma unroll
                for (int j = 0; j < 4; ++j) xq[t][j] = (int)(((unsigned)__float2int_rn(xn[4 * j] * xinv) & 0xffu) | (((unsigned)__float2int_rn(xn[4 * j + 1] * xinv) & 0xffu) << 8) |
                                                             (((unsigned)__float2int_rn(xn[4 * j + 2] * xinv) & 0xffu) << 16) | ((unsigned)__float2int_rn(xn[4 * j + 3] * xinv) << 24));
                asm volatile("" ::: "memory"); __builtin_amdgcn_sched_barrier(0);
            }
            int hi[8][2];
#pragma unroll
            for (int t = 0; t < 8; ++t) { hi[t][0] = 0; hi[t][1] = 0; }
            const LAS int* idw = IDL + 8 * w * 128;
            u32x4 ring[16];
#pragma unroll
            for (int j = 0; j < 16; ++j) ring[j] = *(const u32x4*)(U_ + (size_t)idw[(j & 7) * 128 + (j >> 3)] * D + 16 * lane);
#pragma unroll 1
            for (int k = 0; k < 64; ++k) {
#pragma unroll
                for (int j = 0; j < 16; ++j) {
                    const int t = j & 7, pos = 2 * k + (j >> 3);
                    const u32x4 a = ring[j];
                    if (k < 63) ring[j] = *(const u32x4*)(U_ + (size_t)idw[t * 128 + pos + 2] * D + 16 * lane);
                    int d = __builtin_amdgcn_sdot4((int)a[0], xq[t][0], 0, false);
                    d = __builtin_amdgcn_sdot4((int)a[1], xq[t][1], d, false); d = __builtin_amdgcn_sdot4((int)a[2], xq[t][2], d, false); d = __builtin_amdgcn_sdot4((int)a[3], xq[t][3], d, false);
                    d = wave_isum(d);
                    if (lane == (pos & 63)) { if (k < 32) hi[t][0] = d; else hi[t][1] = d; }
                }
            }
#pragma unroll
            for (int t = 0; t < 8; ++t) {
                const int tl = 8 * w + t;
                const int id0 = IDL[tl * 128 + lane], id1 = IDL[tl * 128 + 64 + lane];
                const float su0 = SU[id0], su1 = SU[id1], sv0 = SV[id0], sv1 = SV[id1];
                const float h0 = su0 * sx[t] * (float)hi[t][0], h1 = su1 * sx[t] * (float)hi[t][1];
                GTL[tl * 128 + lane] = sv0 * GTL[tl * 128 + lane] * gelu_erf(h0);
                GTL[tl * 128 + 64 + lane] = sv1 * GTL[tl * 128 + 64 + lane] * gelu_erf(h1);
                asm volatile("" ::: "memory"); __builtin_amdgcn_sched_barrier(0);
            }
        }
        {
            int zo = 0; asm volatile("" : "+v"(zo));
            const unsigned char* V_ = V + zo; float* H_ = H + zo; bf16* HB2_ = HB2 + zo;
            int wq[8]; float sw[8];
#pragma unroll
            for (int t = 0; t < 8; ++t) {
                const int tl = 8 * w + t;
                const float w0 = GTL[tl * 128 + lane], w1 = GTL[tl * 128 + 64 + lane];
                const float wmx = xrow16_max(row16_max(fmaxf(fabsf(w0), fabsf(w1))));
                const float winv = wmx > 0.f ? 127.f / wmx : 0.f; sw[t] = wmx * (1.f / 127.f);
                const f32x4 wv = *(const LAS f32x4*)(GTL + tl * 128 + 4 * (lane & 31));
                wq[t] = (int)(((unsigned)__float2int_rn(wv[0] * winv) & 0xffu) | (((unsigned)__float2int_rn(wv[1] * winv) & 0xffu) << 8) |
                              (((unsigned)__float2int_rn(wv[2] * winv) & 0xffu) << 16) | ((unsigned)__float2int_rn(wv[3] * winv) << 24));
                asm volatile("" ::: "memory"); __builtin_amdgcn_sched_barrier(0);
            }
            const LAS int* idw = IDL + 8 * w * 128;
#pragma unroll
            for (int hf = 0; hf < 2; ++hf) {
                int yi[4][16];
#pragma unroll
                for (int g4 = 0; g4 < 4; ++g4)
#pragma unroll
                    for (int i = 0; i < 16; ++i) yi[g4][i] = 0;
                u32x4 ring[16];
#pragma unroll
                for (int j = 0; j < 16; ++j) ring[j] = *(const u32x4*)(V_ + (size_t)idw[(4 * hf + (j >> 2)) * 128 + (j & 3)] * D + 16 * lane);
#pragma unroll 1
                for (int s4 = 0; s4 < 32; ++s4) {
#pragma unroll
                    for (int g4 = 0; g4 < 4; ++g4) {
                        const int t = 4 * hf + g4;
                        const int wg = __builtin_amdgcn_readlane(wq[t], s4);
#pragma unroll
                        for (int q = 0; q < 4; ++q) {
                            const unsigned a0 = ring[4 * g4][q], a1 = ring[4 * g4 + 1][q], a2 = ring[4 * g4 + 2][q], a3 = ring[4 * g4 + 3][q];
                            const unsigned p0 = __builtin_amdgcn_perm(a1, a0, 0x05010400u), p1 = __builtin_amdgcn_perm(a1, a0, 0x07030602u);
                            const unsigned p2 = __builtin_amdgcn_perm(a3, a2, 0x05010400u), p3 = __builtin_amdgcn_perm(a3, a2, 0x07030602u);
                            yi[g4][4 * q] = __builtin_amdgcn_sdot4((int)__builtin_amdgcn_perm(p2, p0, 0x05040100u), wg, yi[g4][4 * q], false);
                            yi[g4][4 * q + 1] = __builtin_amdgcn_sdot4((int)__builtin_amdgcn_perm(p2, p0, 0x07060302u), wg, yi[g4][4 * q + 1], false);
                            yi[g4][4 * q + 2] = __builtin_amdgcn_sdot4((int)__builtin_amdgcn_perm(p3, p1, 0x05040100u), wg, yi[g4][4 * q + 2], false);
                            yi[g4][4 * q + 3] = __builtin_amdgcn_sdot4((int)__builtin_amdgcn_perm(p3, p1, 0x07060302u), wg, yi[g4][4 * q + 3], false);
                        }
                        __builtin_amdgcn_sched_barrier(0);
                        if (s4 < 31) {
#pragma unroll
                            for (int q = 0; q < 4; ++q) ring[4 * g4 + q] = *(const u32x4*)(V_ + (size_t)idw[t * 128 + 4 * (s4 + 1) + q] * D + 16 * lane);
                        }
                        __builtin_amdgcn_sched_barrier(0);
                    }
                }
#pragma unroll
                for (int g4 = 0; g4 < 4; ++g4) {
                    const int t = 4 * hf + g4, tok = tok0 + 8 * w + t;
                    float* hrow = H_ + (size_t)tok * D + 4 * lane;
                    float y[16];
#pragma unroll
                    for (int j = 0; j < 4; ++j) { const f32x4 a = *(const f32x4*)(hrow + 256 * j); y[4 * j] = a[0]; y[4 * j + 1] = a[1]; y[4 * j + 2] = a[2]; y[4 * j + 3] = a[3]; }
#pragma unroll
                    for (int i = 0; i < 16; ++i) y[i] = y[i] + sw[t] * (float)yi[g4][i];
#pragma unroll
                    for (int j = 0; j < 4; ++j) *(f32x4*)(hrow + 256 * j) = (f32x4){y[4 * j], y[4 * j + 1], y[4 * j + 2], y[4 * j + 3]};
                    bf16* hb = HB2_ + (size_t)tok * D + 4 * lane;
#pragma unroll
                    for (int j = 0; j < 4; ++j) { u32x2 o2; o2.x = pk2(y[4 * j], y[4 * j + 1]); o2.y = pk2(y[4 * j + 2], y[4 * j + 3]); *(u32x2*)(hb + 256 * j) = o2; }
                    asm volatile("" ::: "memory"); __builtin_amdgcn_sched_barrier(0);
                }
            }
        }
    }
    __syncthreads();
}
#undef CE

__device__ void phase_final(const Params& p, int bid, int nblk) {
    const int tid = tidx(), lane = tid & 63, gw = bid * NWAVES + (tid >> 6), NGW = nblk * NWAVES;
    const float* H = (const float*)(p.ws + WS_H);
    for (int m = gw; m < M; m += NGW) {
        f32x4 v[4]; float ss = 0.f;
#pragma unroll
        for (int j = 0; j < 4; ++j) { v[j] = ((const f32x4*)(H + (size_t)m * D))[lane + 64 * j]; ss += (v[j][0] * v[j][0] + v[j][1] * v[j][1]) + (v[j][2] * v[j][2] + v[j][3] * v[j][3]); }
        const float r = rsqrtf(wave_sum(ss) * (1.f / D) + EPS);
#pragma unroll
        for (int j = 0; j < 4; ++j) { const f32x4 gv = ((const f32x4*)p.final_g)[lane + 64 * j]; ((f32x4*)(p.out + (size_t)m * D))[lane + 64 * j] = v[j] * r * gv; }
    }
}

#define XB_TMO      128
#define XB_XCNT(j)  (256  + 64 * (j))
#define XB_XSUB(j)  (1280 + 64 * (j))
#define XB_XGEN(j)  (2304 + 64 * (j))
#define XB_TOP      3328
#define XB_TOPGEN   3392
#define XCD_BAR_WORDS 3456
#define XB_SPIN_CAP (1u << 22)
__device__ __forceinline__ unsigned xb_ld(unsigned* p)              { return __hip_atomic_load(p, __ATOMIC_RELAXED, __HIP_MEMORY_SCOPE_AGENT); }
__device__ __forceinline__ unsigned xb_add(unsigned* p, unsigned v) { return __hip_atomic_fetch_add(p, v, __ATOMIC_RELAXED, __HIP_MEMORY_SCOPE_AGENT); }
__device__ __forceinline__ unsigned xb_xcc_id() { return (unsigned)__builtin_amdgcn_s_getreg((3 << 11) | 20) & 0xFu; }
#define XB_SPIN(cond, bar) do { unsigned _sp = 0; while (cond) { __builtin_amdgcn_s_sleep(1); \
    if ((++_sp & 255u) == 0u) { if (xb_ld(&(bar)[XB_TMO])) break; if (_sp > XB_SPIN_CAP) { atomicAdd(&(bar)[XB_TMO], 1u); break; } } } } while (0)
struct XcdBarrier { unsigned* bar; unsigned x; volatile LAS unsigned* st; };
__device__ __forceinline__ XcdBarrier xcd_barrier_post(unsigned* bar, volatile LAS unsigned* st) {
    XcdBarrier b; b.bar = bar; b.x = xb_xcc_id(); b.st = st;
    if (threadIdx.x == 0) (void)xb_add(&bar[XB_XCNT(b.x)], 1u);
    return b;
}
__device__ __forceinline__ void xcd_barrier_complete(unsigned* bar, unsigned x, unsigned& nloc, unsigned& nx) {
    const unsigned G = gridDim.x * gridDim.y * gridDim.z;
    unsigned sum, cnt, mine, sp = 0u;
    for (;;) {
        sum = 0u; cnt = 0u; mine = 0u;
#pragma unroll
        for (unsigned j = 0; j < 16; ++j) { const unsigned c = xb_ld(&bar[XB_XCNT(j)]); sum += c; cnt += (c > 0u) ? 1u : 0u; mine = (j == x) ? c : mine; }
        if (sum == G) break;
        __builtin_amdgcn_s_sleep(1);
        if ((++sp & 255u) == 0u) { if (xb_ld(&bar[XB_TMO])) break; if (sp > XB_SPIN_CAP) { atomicAdd(&bar[XB_TMO], 1u); break; } }
    }
    nloc = mine > 0u ? mine : 1u; nx = cnt > 0u ? cnt : 1u;
}
__device__ __forceinline__ void xcd_barrier(const XcdBarrier& b) {
    asm volatile("s_waitcnt vmcnt(0)" ::: "memory");
    __syncthreads();
    if (threadIdx.x == 0) {
        unsigned* bar = b.bar;
        __builtin_amdgcn_s_waitcnt(0);
        unsigned nloc = b.st[0], nx = b.st[1];
        if (nloc == 0u) { xcd_barrier_complete(bar, b.x, nloc, nx); b.st[0] = nloc; b.st[1] = nx; }
        const unsigned old = xb_add(&bar[XB_XSUB(b.x)], 1u);
        const unsigned gen = old / nloc;
        if (old + 1u == (gen + 1u) * nloc) {
            __builtin_amdgcn_fence(__ATOMIC_RELEASE, "agent");
            asm volatile("s_waitcnt vmcnt(0)" ::: "memory");
            const unsigned og = xb_add(&bar[XB_TOP], 1u);
            const unsigned tg = og / nx;
            if (og + 1u == (tg + 1u) * nx) xb_add(&bar[XB_TOPGEN], 1u);
            else XB_SPIN(xb_ld(&bar[XB_TOPGEN]) == tg, bar);
            __builtin_amdgcn_fence(__ATOMIC_ACQUIRE, "agent");
            xb_add(&bar[XB_XGEN(b.x)], 1u);
            asm volatile("s_waitcnt vmcnt(0)" ::: "memory");
        } else {
            XB_SPIN(xb_ld(&bar[XB_XGEN(b.x)]) == gen, bar);
            __builtin_amdgcn_fence(__ATOMIC_ACQUIRE, "agent");
            asm volatile("s_waitcnt vmcnt(0)" ::: "memory");
        }
    }
    __syncthreads();
}
constexpr int CW_BAR = 4096;

constexpr int K_PROLOGUE = 11, K_FINAL = 12;
template <int KIND>
__device__ __forceinline__ void run_kind(const Params& p, int L, LAS unsigned char* lds, int bid, int nblk) {
    unsigned char* ws = p.ws;
    float* H = (float*)(ws + WS_H);
    float* ss0 = (float*)(ws + WS_STAT); float* ss1 = (float*)(ws + WS_SS1); float* sse = (float*)(ws + WS_SSE);
    if constexpr (KIND == K_PROLOGUE) phase_prologue(p, lds, bid, nblk);
    if constexpr (KIND == K_FINAL) phase_final(p, bid, nblk);
    if constexpr (KIND == 0) { EpiProj E{nullptr, (bf16*)(ws + WS_PROJ), (float*)(ws + WS_BA)};
        gemm_run(lds, (const bf16*)(ws + WS_HB0), (const bf16*)(ws + WS_WIN) + (size_t)L * IN_PAD * D, M, IN_PAD, D, E, bid, nblk, ss0); }
    if constexpr (KIND == 1) phase_gdn_prep(p, L, lds, bid, nblk);
    if constexpr (KIND == 2) { phase_gdn_scan(p, L, lds, bid, nblk); phase_att_queue(p, L, lds, bid, nblk); }
    if constexpr (KIND == 3) { EpiRes E{ss1, H, (bf16*)(ws + WS_HB1)};
        gemm_run(lds, (const bf16*)(ws + WS_OBUF), (const bf16*)(ws + WS_WOUT) + (size_t)L * D * D, M, D, D, E, bid, nblk); }
    if constexpr (KIND == 4) { EpiQ2 E{nullptr, (bf16*)(ws + WS_Q2)};
        gemm_run(lds, (const bf16*)(ws + WS_HB1), (const bf16*)(ws + WS_WQ) + (size_t)L * 2048 * D, M, 2048, D, E, bid, nblk, ss1); }
    if constexpr (KIND == 5) phase_peer(p, L, lds, bid, nblk);
    if constexpr (KIND == 7) { EpiE E2{sse, (bf16*)(ws + WS_EPRE)};
        gemm_run(lds, (const bf16*)(ws + WS_PB) + (size_t)L * M * 256, (const bf16*)(ws + WS_WP) + (size_t)L * D * 256, M, D, 256, E2, bid, nblk); }
    if constexpr (KIND == 6) { EpiPle E{ss0, H, (bf16*)(ws + WS_HB0), (const bf16*)(ws + WS_EPRE), p.ple_norm_g + L * D};
        gemm_run(lds, (const bf16*)(ws + WS_HB2), (const bf16*)(ws + WS_WG) + (size_t)L * D * D, M, D, D, E, bid, nblk, sse); }
}

__device__ __forceinline__ Params params_off(const Params& s, size_t z) {
    Params q;
    q.x = s.x + z; q.p = s.p + z; q.ln_mix_g = s.ln_mix_g + z; q.w_in = s.w_in + z; q.conv_w = s.conv_w + z; q.a_log = s.a_log + z; q.dt_bias = s.dt_bias + z;
    q.gdn_norm_g = s.gdn_norm_g + z; q.diff_lambda = s.diff_lambda + z; q.subln_g = s.subln_g + z; q.w_out = s.w_out + z; q.ln_ffn_g = s.ln_ffn_g + z;
    q.peer_wq = s.peer_wq + z; q.subkeys = s.subkeys + z; q.peer_u = s.peer_u + z; q.peer_v = s.peer_v + z; q.ple_wp = s.ple_wp + z; q.ple_wg = s.ple_wg + z;
    q.ple_norm_g = s.ple_norm_g + z; q.final_g = s.final_g + z; q.out = s.out + z; q.ws = s.ws + z; q.pad0 = 0; q.pad1 = 0;
    return q;
}
#define RUN(KIND) do { size_t z_ = 0; int L_ = L; asm volatile("" : "+s"(z_), "+s"(L_)); const Params q_ = params_off(p, z_); run_kind<KIND>(q_, L_, (LAS unsigned char*)lds, (int)blockIdx.x, (int)gridDim.x); } while (0)
#define GRID_BARRIER() do { XcdBarrier b_; b_.bar = (unsigned*)(p.ws + WS_CTL) + CW_BAR; b_.x = xb_xcc_id(); b_.st = (volatile LAS unsigned*)((LAS unsigned char*)lds + LDS_MISC_OFF) + 8; xcd_barrier(b_); } while (0)
__global__ void __launch_bounds__(NTHREADS, 2) mk_fwd(Params p) {
    extern __shared__ __attribute__((aligned(16))) unsigned char lds[];
    {
        volatile LAS unsigned* misc = (volatile LAS unsigned*)((LAS unsigned char*)lds + LDS_MISC_OFF);
        if (threadIdx.x < 64) misc[threadIdx.x] = 0u;
        __syncthreads();
        (void)xcd_barrier_post((unsigned*)(p.ws + WS_CTL) + CW_BAR, misc + 8);
    }
    { int L = 0; RUN(K_PROLOGUE); }
    cg::this_grid().sync();
#define LAYER(LL) do { const int L = (LL); RUN(0); GRID_BARRIER(); RUN(1); GRID_BARRIER(); RUN(2); GRID_BARRIER(); RUN(3); GRID_BARRIER(); RUN(4); GRID_BARRIER(); RUN(5); RUN(7); GRID_BARRIER(); RUN(6); GRID_BARRIER(); } while (0)
    LAYER(0); LAYER(1); LAYER(2); LAYER(3);
#undef LAYER
    { int L = 0; RUN(K_FINAL); }
}

extern "C" void kernel_launch(void* const* d_in, const int* in_sizes, int n_in, void* d_out, int out_size, void* d_ws, size_t ws_size, hipStream_t stream) {
    static int grid = 0;
    if (grid == 0) {
        if (n_in != 20 || out_size != M * D || ws_size < WS_END) { fprintf(stderr, "kernel_launch: unexpected shapes (n_in %d, out %d, ws %zu < %zu)\n", n_in, out_size, ws_size, (size_t)WS_END); grid = -1; return; }
        int dev = 0, cus = 0, per_cu = 0;
        (void)hipGetDevice(&dev); (void)hipDeviceGetAttribute(&cus, hipDeviceAttributeMultiprocessorCount, dev);
        if (hipFuncSetAttribute((const void*)mk_fwd, hipFuncAttributeMaxDynamicSharedMemorySize, LDS_BYTES) != hipSuccess) { fprintf(stderr, "kernel_launch: hipFuncSetAttribute failed\n"); grid = -1; return; }
        if (hipOccupancyMaxActiveBlocksPerMultiprocessor(&per_cu, (const void*)mk_fwd, NTHREADS, LDS_BYTES) != hipSuccess || per_cu < 1) { fprintf(stderr, "kernel_launch: occupancy query says %d blocks per CU\n", per_cu); (void)hipGetLastError(); grid = -1; return; }
        grid = (cus > 0 ? cus : 256);
    }
    if (grid < 0) return;
    (void)hipMemsetAsync((char*)d_ws + WS_CTL, 0, CTL_ZERO_BYTES, stream);
    Params p{};
    const float** pp = (const float**)&p;
    for (int i = 0; i < 20; ++i) pp[i] = (const float*)d_in[i];
    p.out = (float*)d_out; p.ws = (unsigned char*)d_ws;
    void* args[] = {&p};
    hipError_t e = hipLaunchCooperativeKernel((const void*)mk_fwd, dim3(grid), dim3(NTHREADS), args, LDS_BYTES, stream);
    if (e != hipSuccess) fprintf(stderr, "kernel_launch: cooperative launch failed: %s (grid %d)\n", hipGetErrorString(e), grid);
}
```

```cpp
#include <hip/hip_runtime.h>
#include <hip/hip_cooperative_groups.h>
#include <cstdio>
#include <cstdint>
namespace cg = cooperative_groups;

#define LAS __attribute__((address_space(3)))
typedef unsigned short bf16;
typedef float f32x4 __attribute__((ext_vector_type(4)));
typedef short bf16x8 __attribute__((ext_vector_type(8)));
typedef unsigned u32x4 __attribute__((ext_vector_type(4)));
typedef unsigned u32x2 __attribute__((ext_vector_type(2)));

constexpr int D = 1024, BATCH = 8, SEQ = 2048, DEPTH = 4, M = BATCH * SEQ;
constexpr int IN_COLS = 3592, IN_PAD = 3840, PROJ_W = 3584;
constexpr int NEXP = 16384;
constexpr float EPS = 1e-6f;
constexpr float QSCALE = 0.125f * 1.4426950408889634f;
constexpr int NWAVES = 8, NTHREADS = 512;
constexpr int LDS_BYTES = 163840;
constexpr int LDS_MISC_OFF = LDS_BYTES - 256;
constexpr int RS_OFF = 147456;
constexpr int CW_QUEUE = 1024;

constexpr size_t MiB = 1u << 20;
constexpr size_t WS_CTL = 0, CTL_ZERO_BYTES = 1 * MiB;
constexpr size_t WS_H = 1 * MiB;
constexpr size_t WS_HB0 = 65 * MiB;
constexpr size_t WS_HB1 = 97 * MiB;
constexpr size_t WS_HB2 = 129 * MiB;
constexpr size_t WS_PROJ = 161 * MiB;
constexpr size_t WS_BA = 273 * MiB;
constexpr size_t WS_OBUF = 274 * MiB;
constexpr size_t WS_Q2 = 306 * MiB;
constexpr size_t WS_EPRE = 370 * MiB;
constexpr size_t WS_IDX = 402 * MiB;
constexpr size_t WS_GATE = 410 * MiB;
constexpr size_t WS_STAT = 418 * MiB;
constexpr size_t WS_SS1 = WS_IDX + 1 * MiB, WS_SSE = WS_IDX;
constexpr size_t WS_ORAW = 422 * MiB;
constexpr size_t WS_WIN = 550 * MiB;
constexpr size_t WS_WOUT = 582 * MiB;
constexpr size_t WS_WQ = 590 * MiB;
constexpr size_t WS_WG = 606 * MiB;
constexpr size_t WS_WP = 614 * MiB;
constexpr size_t WS_SK = 616 * MiB;
constexpr size_t WS_PB = 618 * MiB;
constexpr size_t WS_U = 650 * MiB;
constexpr size_t WS_V = 778 * MiB;
constexpr size_t WS_SU = WS_STAT + 1 * MiB, WS_SV = WS_STAT + 2 * MiB;
constexpr size_t WS_END = 906 * MiB;

struct Params {
    const float *x, *p, *ln_mix_g, *w_in, *conv_w, *a_log, *dt_bias, *gdn_norm_g, *diff_lambda, *subln_g, *w_out, *ln_ffn_g,
        *peer_wq, *subkeys, *peer_u, *peer_v, *ple_wp, *ple_wg, *ple_norm_g, *final_g;
    float* out;
    unsigned char* ws;
    int pad0, pad1;
};

__device__ __forceinline__ int tidx() { int t = (int)threadIdx.x; asm volatile("" : "+v"(t)); return t; }
#define LDS_BARRIER() asm volatile("s_waitcnt lgkmcnt(0)\n\ts_barrier" ::: "memory")
__device__ __forceinline__ float bf2f(bf16 v) { return __uint_as_float((unsigned)v << 16); }
__device__ __forceinline__ unsigned f2bf(float f);
typedef __bf16 bf16x2_t __attribute__((ext_vector_type(2)));
typedef float f32x2_t __attribute__((ext_vector_type(2)));
__device__ __forceinline__ unsigned cvtpk(float lo, float hi) { f32x2_t v = {lo, hi}; bf16x2_t b = __builtin_convertvector(v, bf16x2_t); return __builtin_bit_cast(unsigned, b); }
__device__ __forceinline__ unsigned pk2(float lo, float hi) { return cvtpk(lo, hi); }
__device__ __forceinline__ unsigned f2bf(float f) { return cvtpk(f, 0.f) & 0xffffu; }
__device__ __forceinline__ float lo16(unsigned w) { return __uint_as_float(w << 16); }
__device__ __forceinline__ float hi16(unsigned w) { return __uint_as_float(w & 0xffff0000u); }
template <int N> __device__ __forceinline__ float dpp_ror(float x) { return __builtin_bit_cast(float, __builtin_amdgcn_mov_dpp(__builtin_bit_cast(int, x), 0x120 + N, 0xf, 0xf, true)); }
template <int N> __device__ __forceinline__ unsigned dpp_ror_u(unsigned x) { return (unsigned)__builtin_amdgcn_mov_dpp((int)x, 0x120 + N, 0xf, 0xf, true); }
__device__ __forceinline__ float row16_sum(float x) { x += dpp_ror<8>(x); x += dpp_ror<4>(x); x += dpp_ror<2>(x); x += dpp_ror<1>(x); return x; }
__device__ __forceinline__ float row16_max(float x) { x = fmaxf(x, dpp_ror<8>(x)); x = fmaxf(x, dpp_ror<4>(x)); x = fmaxf(x, dpp_ror<2>(x)); x = fmaxf(x, dpp_ror<1>(x)); return x; }
__device__ __forceinline__ unsigned row16_umax(unsigned x) { unsigned y;
    y = dpp_ror_u<8>(x); x = x > y ? x : y; y = dpp_ror_u<4>(x); x = x > y ? x : y; y = dpp_ror_u<2>(x); x = x > y ? x : y; y = dpp_ror_u<1>(x); x = x > y ? x : y; return x; }
__device__ __forceinline__ float xrow16_max(float x) {
    auto s = __builtin_amdgcn_permlane16_swap(__float_as_uint(x), __float_as_uint(x), false, false);
    x = fmaxf(__uint_as_float(s[0]), __uint_as_float(s[1]));
    auto t = __builtin_amdgcn_permlane32_swap(__float_as_uint(x), __float_as_uint(x), false, false);
    return fmaxf(__uint_as_float(t[0]), __uint_as_float(t[1]));
}
__device__ __forceinline__ float xrow16_sum(float x) {
    auto s = __builtin_amdgcn_permlane16_swap(__float_as_uint(x), __float_as_uint(x), false, false);
    x = __uint_as_float(s[0]) + __uint_as_float(s[1]);
    auto t = __builtin_amdgcn_permlane32_swap(__float_as_uint(x), __float_as_uint(x), false, false);
    return __uint_as_float(t[0]) + __uint_as_float(t[1]);
}
__device__ __forceinline__ float wave_sum(float v) { return xrow16_sum(row16_sum(v)); }
template <int N> __device__ __forceinline__ int dpp_ror_i(int x) { return __builtin_amdgcn_mov_dpp(x, 0x120 + N, 0xf, 0xf, true); }
__device__ __forceinline__ int wave_isum(int x) {
    x += dpp_ror_i<8>(x); x += dpp_ror_i<4>(x); x += dpp_ror_i<2>(x); x += dpp_ror_i<1>(x);
    auto s = __builtin_amdgcn_permlane16_swap((unsigned)x, (unsigned)x, false, false); x = (int)(s[0] + s[1]);
    auto t = __builtin_amdgcn_permlane32_swap((unsigned)x, (unsigned)x, false, false); return (int)(t[0] + t[1]);
}
__device__ __forceinline__ float wave_max(float v) {
#pragma unroll
    for (int o = 32; o; o >>= 1) v = fmaxf(v, __shfl_xor(v, o));
    return v;
}
__device__ __forceinline__ float sigmoidf_(float x) { return __builtin_amdgcn_rcpf(1.f + __expf(-x)); }
__device__ __forceinline__ float dot8(u32x4 a, u32x4 b, float s) {
#pragma unroll
    for (int i = 0; i < 4; ++i) { s += lo16(a[i]) * lo16(b[i]); s += hi16(a[i]) * hi16(b[i]); }
    return s;
}

__host__ __device__ __forceinline__ int lds_byte(int r, int c) { const int st = (r >> 4) * 2 + (c >> 5), rr = r & 15, cc = c & 31, ob = rr * 64 + cc * 2; return st * 1024 + (ob ^ (((ob >> 9) & 1) << 5)); }
__host__ __device__ __forceinline__ void stage_rc(int b, int& R, int& C) { const int st = b / 1024, sb = b % 1024, swz = sb ^ (((sb >> 9) & 1) << 5); R = (st >> 1) * 16 + swz / 64; C = (st & 1) * 32 + (swz % 64) / 2; }
constexpr int HTB = 16384;
template <class F>
__device__ __forceinline__ void gemm_run(LAS unsigned char* lds, const bf16* A, const bf16* Bt, int Mm, int N, int K, const F& f, int bid, int nblk, const float* slots_in = nullptr) {
    LAS float* RS = (LAS float*)(lds + RS_OFF);
    int rs_pm = -1;
    const int tid = tidx(), wid = __builtin_amdgcn_readfirstlane(tid >> 6), lane = tid & 63, wr = wid >> 2, wc = wid & 3, fr = lane & 15, fq = lane >> 4;
    const int nt = K / 64, ntn = N / 256, nunits = (Mm / 256) * ntn;
    unsigned voff[2];
#pragma unroll
    for (int i = 0; i < 2; ++i) { const int uu = tid + 512 * i, r = uu >> 3, c = (uu & 7) ^ ((r >> 1) & 7); voff[i] = (unsigned)(r * K + c * 8) * 2u; }
    const unsigned ldsw = (unsigned)wid * 1024u;
    const int sw7 = (fr >> 1) & 7;
    const int aoff0 = wr * HTB + fr * 128 + ((fq ^ sw7) << 4), aoff1 = wr * HTB + fr * 128 + (((4 + fq) ^ sw7) << 4);
    const int bbase = (2 + (wc >> 1)) * HTB + (wc & 1) * 8192 + fr * 128;
    const int boff0 = bbase + ((fq ^ sw7) << 4), boff1 = bbase + (((4 + fq) ^ sw7) << 4);
#define G_STAGE(bufoff, gbase) do { _Pragma("unroll") for (int _i = 0; _i < 2; ++_i) \
        __builtin_amdgcn_global_load_lds((const unsigned*)((const char*)(gbase) + voff[_i]), (LAS unsigned*)(lds + (bufoff) + ldsw + _i * 8192), 16, 0, 0); } while (0)
    for (int u = bid; u < nunits; u += nblk) {
        const int pm = u % (Mm / 256), pn = u / (Mm / 256);
        if (slots_in && pm != rs_pm) {
            __syncthreads();
            if (tid < 256) { const f32x4* sp = (const f32x4*)(slots_in + ((size_t)pm * 256 + tid) * 16);
                const f32x4 a = sp[0], b = sp[1], c = sp[2], d = sp[3];
                const float s = (((a[0] + a[1]) + (a[2] + a[3])) + ((b[0] + b[1]) + (b[2] + b[3]))) + (((c[0] + c[1]) + (c[2] + c[3])) + ((d[0] + d[1]) + (d[2] + d[3])));
                RS[tid] = rsqrtf(s * (1.f / D) + EPS); }
            __syncthreads();
            rs_pm = pm;
        }
        const char* gA = (const char*)(A + (size_t)pm * 256 * K);
        const char* gB = (const char*)(Bt + (size_t)pn * 256 * K);
        const size_t hstep = (size_t)128 * K * 2;
        f32x4 acc[8][4];
#pragma unroll
        for (int a = 0; a < 8; ++a)
#pragma unroll
            for (int b = 0; b < 4; ++b) acc[a][b] = (f32x4){0.f, 0.f, 0.f, 0.f};
        G_STAGE(0, gA); G_STAGE(HTB, gA + hstep); G_STAGE(2 * HTB, gB); G_STAGE(3 * HTB, gB + hstep);
        for (int t = 0; t < nt; ++t) {
            const int cb = (t & 1) * 4 * HTB, nb = ((t + 1) & 1) * 4 * HTB;
            asm volatile("s_waitcnt vmcnt(0)" ::: "memory");
            __builtin_amdgcn_s_barrier();
            asm volatile("" ::: "memory");
            const size_t ko = (size_t)(t + 1) * 128; const bool more = t + 1 < nt;
#pragma unroll
            for (int k = 0; k < 2; ++k) {
                if (more) { if (k == 0) { G_STAGE(nb, gA + ko); G_STAGE(nb + 2 * HTB, gB + ko); } else { G_STAGE(nb + HTB, gA + hstep + ko); G_STAGE(nb + 3 * HTB, gB + hstep + ko); } }
                bf16x8 bfr[4], acur, anxt;
#pragma unroll
                for (int n = 0; n < 4; ++n) bfr[n] = *(const LAS bf16x8*)(lds + cb + (k ? boff1 : boff0) + n * 2048);
                acur = *(const LAS bf16x8*)(lds + cb + (k ? aoff1 : aoff0));
#pragma unroll
                for (int m = 0; m < 8; ++m) {
                    if (m < 7) anxt = *(const LAS bf16x8*)(lds + cb + (k ? aoff1 : aoff0) + (m + 1) * 2048);
#pragma unroll
                    for (int n = 0; n < 4; ++n) acc[m][n] = __builtin_amdgcn_mfma_f32_16x16x32_bf16(bfr[n], acur, acc[m][n], 0, 0, 0);
                    acur = anxt;
                }
                __builtin_amdgcn_sched_barrier(0);
            }
            asm volatile("s_waitcnt lgkmcnt(0)" ::: "memory");
        }
        {
            int el = lane; asm volatile("" : "+v"(el));
            const int efr = el & 15, efq = el >> 4;
            LAS float* et = (LAS float*)(lds + wid * 4352);
            const int ecol = pn * 256 + wc * 64 + 4 * efr;
            typename F::Pre pq[4];
            if constexpr (F::PRE) {
#pragma unroll
                for (int i = 0; i < 4; ++i) pq[i] = f.pre(pm * 256 + wr * 128 + 4 * i + efq, ecol);
            }
#pragma unroll
            for (int m = 0; m < 8; ++m) {
#pragma unroll
                for (int n = 0; n < 4; ++n) *(LAS f32x4*)(et + efr * 68 + n * 16 + 4 * efq) = acc[m][n];
                typename F::Pre pnx[4];
                if constexpr (F::PRE) {
                    if (m < 7) {
#pragma unroll
                        for (int i = 0; i < 4; ++i) pnx[i] = f.pre(pm * 256 + wr * 128 + (m + 1) * 16 + 4 * i + efq, ecol);
                    }
                }
                asm volatile("s_waitcnt lgkmcnt(0)" ::: "memory");
#pragma unroll
                for (int i = 0; i < 4; ++i) {
                    const int lrow = wr * 128 + m * 16 + 4 * i + efq, row = pm * 256 + lrow;
                    const f32x4 v = *(const LAS f32x4*)(et + (4 * i + efq) * 68 + 4 * efr);
                    f32x4 r;
                    if constexpr (F::PRE) r = f(row, RS[lrow], ecol, v, pq[i]); else r = f(row, RS[lrow], ecol, v);
                    if constexpr (F::STATS) { const float ssq = row16_sum((r[0] * r[0] + r[1] * r[1]) + (r[2] * r[2] + r[3] * r[3])); if (efr == 0) f.slots[(size_t)row * 16 + pn * 4 + wc] = ssq; }
                }
                if constexpr (F::PRE) {
                    if (m < 7) {
#pragma unroll
                        for (int i = 0; i < 4; ++i) pq[i] = pnx[i];
                    }
                }
                asm volatile("s_waitcnt lgkmcnt(0)" ::: "memory");
                __builtin_amdgcn_sched_barrier(0);
            }
        }
        __syncthreads();
    }
#undef G_STAGE
}

__device__ __forceinline__ u32x2 pk4(f32x4 a) { u32x2 o; o.x = pk2(a[0], a[1]); o.y = pk2(a[2], a[3]); return o; }
struct NoPre {};
struct EpiProj {
    static constexpr bool STATS = false, PRE = false; typedef NoPre Pre; float* slots;
    bf16* proj; float* ba;
    __device__ __forceinline__ f32x4 operator()(int row, float rstd, int col, f32x4 v) const {
        v = v * rstd;
        if (col < PROJ_W) *(u32x2*)(proj + (size_t)row * PROJ_W + col) = pk4(v);
        else if (col < IN_COLS) *(f32x4*)(ba + (size_t)row * 8 + (col - PROJ_W)) = v;
        return v;
    }
};
struct EpiRes {
    static constexpr bool STATS = true, PRE = true; float* slots;
    float* H; bf16* HB;
    struct Pre { f32x4 h; };
    __device__ __forceinline__ Pre pre(int row, int col) const { Pre q; q.h = *(const f32x4*)(H + (size_t)row * D + col); return q; }
    __device__ __forceinline__ f32x4 operator()(int row, float, int col, f32x4 v, const Pre& q) const {
        const f32x4 h = q.h + v; *(f32x4*)(H + (size_t)row * D + col) = h;
        *(u32x2*)(HB + (size_t)row * D + col) = pk4(h);
        return h;
    }
};
struct EpiQ2 {
    static constexpr bool STATS = false, PRE = false; typedef NoPre Pre; float* slots;
    bf16* Q2;
    __device__ __forceinline__ f32x4 operator()(int row, float rstd, int col, f32x4 v) const { v = v * rstd; *(u32x2*)(Q2 + (size_t)row * 2048 + col) = pk4(v); return v; }
};
struct EpiE {
    static constexpr bool STATS = true, PRE = false; typedef NoPre Pre; float* slots;
    bf16* E;
    __device__ __forceinline__ f32x4 operator()(int row, float, int col, f32x4 v) const { *(u32x2*)(E + (size_t)row * D + col) = pk4(v); return v; }
};
struct EpiPle {
    static constexpr bool STATS = true, PRE = true; float* slots;
    float* H; bf16* HB; const bf16* E; const float* g;
    struct Pre { f32x4 h; u32x2 ev; };
    __device__ __forceinline__ Pre pre(int row, int col) const { Pre q; q.h = *(const f32x4*)(H + (size_t)row * D + col); q.ev = *(const u32x2*)(E + (size_t)row * D + col); return q; }
    __device__ __forceinline__ f32x4 operator()(int row, float rstde, int col, f32x4 v, const Pre& q) const {
        const u32x2 ev = q.ev;
        const f32x4 gv = *(const f32x4*)(g + col);
        f32x4 h = q.h;
        h[0] += sigmoidf_(v[0]) * (lo16(ev.x) * rstde * gv[0]); h[1] += sigmoidf_(v[1]) * (hi16(ev.x) * rstde * gv[1]);
        h[2] += sigmoidf_(v[2]) * (lo16(ev.y) * rstde * gv[2]); h[3] += sigmoidf_(v[3]) * (hi16(ev.y) * rstde * gv[3]);
        *(f32x4*)(H + (size_t)row * D + col) = h;
        *(u32x2*)(HB + (size_t)row * D + col) = pk4(h);
        return h;
    }
};

__device__ __forceinline__ void transpose_item(const float* W, int K, int N, int Npad, bf16* WT, const float* rowscale, int qcols, float* scr, int item, int lane) {
    const int nblk = Npad / 32, kb = item / nblk, nb = item % nblk, k0 = 64 * kb, n0 = 32 * nb;
    const int nq = n0 + 4 * (lane & 7);
#pragma unroll
    for (int i = 0; i < 8; ++i) {
        const int kk = 8 * i + (lane >> 3);
        f32x4 v = (nq < N) ? *(const f32x4*)(W + (size_t)(k0 + kk) * N + nq) : (f32x4){0.f, 0.f, 0.f, 0.f};
        if (rowscale) v = v * rowscale[k0 + kk];
        if (nq < qcols) v = v * QSCALE;
        scr[kk * 33 + 4 * (lane & 7)] = v[0]; scr[kk * 33 + 4 * (lane & 7) + 1] = v[1]; scr[kk * 33 + 4 * (lane & 7) + 2] = v[2]; scr[kk * 33 + 4 * (lane & 7) + 3] = v[3];
    }
    asm volatile("s_waitcnt lgkmcnt(0)" ::: "memory");
    const int c = lane & 7;
#pragma unroll
    for (int j = 0; j < 4; ++j) {
        const int nn = (lane >> 3) + 8 * j; const float* s = scr + (8 * c) * 33 + nn;
        u32x4 o; o.x = pk2(s[0 * 33], s[1 * 33]); o.y = pk2(s[2 * 33], s[3 * 33]); o.z = pk2(s[4 * 33], s[5 * 33]); o.w = pk2(s[6 * 33], s[7 * 33]);
        *(u32x4*)(WT + (size_t)(n0 + nn) * K + k0 + 8 * c) = o;
    }
    asm volatile("s_waitcnt lgkmcnt(0)" ::: "memory");
}
__device__ __forceinline__ void convert_bulk(const float* src, bf16* dst, size_t n, size_t gtid, size_t nthr) {
    for (size_t i = gtid * 8; i < n; i += nthr * 8) {
        const f32x4 a = *(const f32x4*)(src + i), b = *(const f32x4*)(src + i + 4);
        u32x4 o; o.x = pk2(a[0], a[1]); o.y = pk2(a[2], a[3]); o.z = pk2(b[0], b[1]); o.w = pk2(b[2], b[3]);
        *(u32x4*)(dst + i) = o;
    }
}
__device__ void phase_prologue(const Params& p, LAS unsigned char* lds_, int bid, int nblk) {
    unsigned char* lds = (unsigned char*)lds_;
    const int tid = tidx(), lane = tid & 63, w = tid >> 6;
    const int gw = bid * NWAVES + w, NGW = nblk * NWAVES;
    float* scr = (float*)(lds + w * 16384);
    constexpr int I_IN = 16 * (IN_PAD / 32), I_OUT = 16 * 32, I_Q = 16 * 64, I_G = 16 * 32, I_P = 4 * 32, I_L = I_IN + I_OUT + I_Q + I_G + I_P;
    for (int it = gw; it < DEPTH * I_L; it += NGW) {
        const int L = it / I_L; int r = it % I_L;
        if (r < I_IN) { transpose_item(p.w_in + (size_t)L * D * IN_COLS, D, IN_COLS, IN_PAD, (bf16*)(p.ws + WS_WIN) + (size_t)L * IN_PAD * D, p.ln_mix_g + L * D, 512, scr, r, lane); continue; } r -= I_IN;
        if (r < I_OUT) { transpose_item(p.w_out + (size_t)L * D * D, D, D, D, (bf16*)(p.ws + WS_WOUT) + (size_t)L * D * D, nullptr, 0, scr, r, lane); continue; } r -= I_OUT;
        if (r < I_Q) { transpose_item(p.peer_wq + (size_t)L * D * 2048, D, 2048, 2048, (bf16*)(p.ws + WS_WQ) + (size_t)L * 2048 * D, p.ln_ffn_g + L * D, 0, scr, r, lane); continue; } r -= I_Q;
        if (r < I_G) { transpose_item(p.ple_wg + (size_t)L * D * D, D, D, D, (bf16*)(p.ws + WS_WG) + (size_t)L * D * D, nullptr, 0, scr, r, lane); continue; } r -= I_G;
        transpose_item(p.ple_wp + (size_t)L * 256 * D, 256, D, D, (bf16*)(p.ws + WS_WP) + (size_t)L * D * 256, nullptr, 0, scr, r, lane);
    }
    const size_t gtid = (size_t)bid * NTHREADS + tid, nthr = (size_t)nblk * NTHREADS;
    for (int r = gw; r < 2 * DEPTH * NEXP; r += NGW) {
        const int which = r >= DEPTH * NEXP, rr = which ? r - DEPTH * NEXP : r;
        const float* srow = (which ? p.peer_v : p.peer_u) + (size_t)rr * D + 4 * lane;
        f32x4 v[4];
#pragma unroll
        for (int j = 0; j < 4; ++j) v[j] = *(const f32x4*)(srow + 256 * j);
        float mx = 0.f;
#pragma unroll
        for (int j = 0; j < 4; ++j) mx = fmaxf(mx, fmaxf(fmaxf(fabsf(v[j][0]), fabsf(v[j][1])), fmaxf(fabsf(v[j][2]), fabsf(v[j][3]))));
        mx = xrow16_max(row16_max(mx));
        const float inv = mx > 0.f ? 127.f / mx : 0.f;
        u32x4 o;
#pragma unroll
        for (int j = 0; j < 4; ++j) {
            const unsigned b0 = (unsigned)__float2int_rn(v[j][0] * inv) & 0xffu, b1 = (unsigned)__float2int_rn(v[j][1] * inv) & 0xffu, b2 = (unsigned)__float2int_rn(v[j][2] * inv) & 0xffu, b3 = (unsigned)__float2int_rn(v[j][3] * inv) & 0xffu;
            o[j] = b0 | (b1 << 8) | (b2 << 16) | (b3 << 24);
        }
        *(u32x4*)(p.ws + (which ? WS_V : WS_U) + (size_t)rr * D + 16 * lane) = o;
        if (lane == 0) ((float*)(p.ws + (which ? WS_SV : WS_SU)))[rr] = mx * (1.f / 127.f);
    }
    convert_bulk(p.p, (bf16*)(p.ws + WS_PB), (size_t)DEPTH * M * 256, gtid, nthr);
    convert_bulk(p.subkeys, (bf16*)(p.ws + WS_SK), (size_t)DEPTH * 8 * 2 * 128 * 128, gtid, nthr);
    float* H = (float*)(p.ws + WS_H); bf16* HB0 = (bf16*)(p.ws + WS_HB0); float* ss0 = (float*)(p.ws + WS_STAT);
    for (int m = gw; m < M; m += NGW) {
        const f32x4* xr = (const f32x4*)(p.x + (size_t)m * D) + lane;
        float ss = 0.f;
#pragma unroll
        for (int j = 0; j < 4; ++j) {
            const f32x4 v = xr[64 * j];
            ss += v[0] * v[0] + v[1] * v[1] + v[2] * v[2] + v[3] * v[3];
            ((f32x4*)(H + (size_t)m * D))[lane + 64 * j] = v;
            u32x2 o; o.x = pk2(v[0], v[1]); o.y = pk2(v[2], v[3]);
            ((u32x2*)(HB0 + (size_t)m * D))[lane + 64 * j] = o;
        }
        ss = wave_sum(ss);
        if (lane < 16) ss0[(size_t)m * 16 + lane] = lane == 0 ? ss : 0.f;
    }
}

typedef short v4i16_t __attribute__((ext_vector_type(4)));
__device__ __forceinline__ void glds16_asm(const void* gsrc, unsigned lds_dst) {
    unsigned keep;
    asm volatile("s_mov_b32 %0, m0\n\ts_mov_b32 m0, %2\n\ts_nop 0\n\tglobal_load_lds_dwordx4 %1, off\n\ts_mov_b32 m0, %0" : "=&s"(keep) : "v"(gsrc), "s"(lds_dst) : "memory");
}
__device__ __forceinline__ float max3_(float a, float b, float c) { float r; asm("v_max3_f32 %0, %1, %2, %3" : "=v"(r) : "v"(a), "v"(b), "v"(c)); return r; }
constexpr int ATT_BUF = 32768, ATT_VOFF = 16384;
__device__ __forceinline__ void att_unit(const Params& p, int L, LAS unsigned char* lds, int tid, int b, int hh, int qb, float lam, float lam_init) {
    const int lane = tid & 63, w = __builtin_amdgcn_readfirstlane(tid >> 6), fr = lane & 15, fq = lane >> 4;
    const bool grpB = w >= 4;
    const bf16* proj = (const bf16*)(p.ws + WS_PROJ);
    bf16* obuf = (bf16*)(p.ws + WS_OBUF);
    const float slope2 = 1.4426950408889634f / (float)(1 << (2 * (hh + 1)));
    const bf16* kbase = proj + (size_t)b * SEQ * PROJ_W + 512 + hh * 128;
    const bf16* vbase = proj + (size_t)b * SEQ * PROJ_W + 1024 + hh * 128;
    const int qw0 = qb * 128 + w * 16, T = 2 * (qb + 1);
    const int S_w = ((qw0 + 15) >> 6) + 1;
    bf16x8 qf[2][2];
#pragma unroll
    for (int mp = 0; mp < 2; ++mp)
#pragma unroll
        for (int ks = 0; ks < 2; ++ks) qf[mp][ks] = *(const bf16x8*)(proj + ((size_t)b * SEQ + qw0 + fr) * PROJ_W + hh * 128 + mp * 64 + ks * 32 + 8 * fq);
    f32x4 o[2][8];
#pragma unroll
    for (int mp = 0; mp < 2; ++mp)
#pragma unroll
        for (int dt = 0; dt < 8; ++dt) o[mp][dt] = (f32x4){0.f, 0.f, 0.f, 0.f};
    float mrun[2] = {-INFINITY, -INFINITY}, lrun[2] = {0.f, 0.f};
    int ksrc[2], vsrc[2];
#pragma unroll
    for (int i = 0; i < 2; ++i) { const int pc = tid + 512 * i, key = pc >> 4, ph = pc & 15;
        ksrc[i] = key * PROJ_W + ((ph ^ (key & 15)) * 8); vsrc[i] = key * PROJ_W + ((ph ^ ((key & 7) << 1)) * 8); }
    const unsigned ldsb = (unsigned)(size_t)lds;
    auto dma = [&](int t, int bo) {
#pragma unroll
        for (int i = 0; i < 2; ++i) {
            glds16_asm(kbase + (size_t)t * 64 * PROJ_W + ksrc[i], ldsb + bo + (w * 64 + 512 * i) * 16);
            glds16_asm(vbase + (size_t)t * 64 * PROJ_W + vsrc[i], ldsb + bo + ATT_VOFF + (w * 64 + 512 * i) * 16);
        }
    };
    int koff[2][2];
#pragma unroll
    for (int mp = 0; mp < 2; ++mp)
#pragma unroll
        for (int ks = 0; ks < 2; ++ks) koff[mp][ks] = fr * 256 + (((mp * 8 + ks * 4 + fq) ^ fr) << 4);
    const int gl = lane & 15;
    const int vrd0 = ATT_VOFF + (4 * fq + (gl >> 2)) * 256 + (gl & 3) * 8 + ((4 * (fq & 1) + (gl >> 2)) << 5);
    bf16x8 pb[2][2];
#pragma unroll
    for (int mp = 0; mp < 2; ++mp)
#pragma unroll
        for (int ks = 0; ks < 2; ++ks) pb[mp][ks] = qf[0][0];
#define ATT_SB() __builtin_amdgcn_sched_barrier(0)
#define ATT_VRD(dt) do { _Pragma("unroll") for (int q_ = 0; q_ < 4; ++q_) vf_[dt][q_] = __builtin_amdgcn_ds_read_tr16_b64_v4i16((LAS v4i16_t*)(lds + ((vb_ ^ ((dt) << 5)) + q_ * 4096))); } while (0)
#define ATT_VMM(PB, dt) do { _Pragma("unroll") for (int ks = 0; ks < 2; ++ks) { const v4i16_t v0 = vf_[dt][2 * ks], v1 = vf_[dt][2 * ks + 1]; \
            bf16x8 vf; vf[0] = v0[0]; vf[1] = v0[1]; vf[2] = v0[2]; vf[3] = v0[3]; vf[4] = v1[0]; vf[5] = v1[1]; vf[6] = v1[2]; vf[7] = v1[3]; \
            o[0][dt] = __builtin_amdgcn_mfma_f32_16x16x32_bf16(vf, PB[0][ks], o[0][dt], 0, 0, 0); \
            o[1][dt] = __builtin_amdgcn_mfma_f32_16x16x32_bf16(vf, PB[1][ks], o[1][dt], 0, 0, 0); } } while (0)
#define ATT_PV(PB, BO) do { const int vb_ = (BO) + vrd0; v4i16_t vf_[8][4]; \
        ATT_VRD(0); ATT_VRD(1); ATT_VRD(2); ATT_VRD(3); ATT_SB(); \
        ATT_VMM(PB, 0); ATT_VRD(4); ATT_SB(); ATT_VMM(PB, 1); ATT_VRD(5); ATT_SB(); ATT_VMM(PB, 2); ATT_VRD(6); ATT_SB(); ATT_VMM(PB, 3); ATT_VRD(7); ATT_SB(); \
        ATT_VMM(PB, 4); ATT_VMM(PB, 5); ATT_VMM(PB, 6); ATT_VMM(PB, 7); ATT_SB(); } while (0)
    dma(0, 0);
    asm volatile("" :: "v"(qf[0][0]), "v"(qf[0][1]), "v"(qf[1][0]), "v"(qf[1][1]));
    int bo_prev = 2 * ATT_BUF, bo_cur = 0, bo_next = ATT_BUF;
    for (int s = 0; s < T; ++s) {
        const int k0 = s * 64;
        asm volatile("s_waitcnt vmcnt(0)" ::: "memory");
        LDS_BARRIER();
        if (s + 1 < T) dma(s + 1, bo_next);
        if (grpB && s > 0 && s <= S_w) ATT_PV(pb, bo_prev);
        if (s < S_w) {
            f32x4 sc[2][4];
            const float base = -slope2 * (float)(qw0 + fr - k0 - 4 * fq);
#pragma unroll
            for (int kt = 0; kt < 4; ++kt)
#pragma unroll
                for (int r = 0; r < 4; ++r) { const float v = base + slope2 * (float)(16 * kt + r); sc[0][kt][r] = v; sc[1][kt][r] = v; }
            {
                bf16x8 kf[4][2][2];
#define ATT_KRD(kt) do { _Pragma("unroll") for (int mp = 0; mp < 2; ++mp) _Pragma("unroll") for (int ks = 0; ks < 2; ++ks) kf[kt][mp][ks] = *(const LAS bf16x8*)(lds + bo_cur + (kt) * 4096 + koff[mp][ks]); } while (0)
#define ATT_KMM(kt) do { _Pragma("unroll") for (int ks = 0; ks < 2; ++ks) _Pragma("unroll") for (int mp = 0; mp < 2; ++mp) sc[mp][kt] = __builtin_amdgcn_mfma_f32_16x16x32_bf16(kf[kt][mp][ks], qf[mp][ks], sc[mp][kt], 0, 0, 0); } while (0)
                ATT_KRD(0); ATT_KRD(1); ATT_SB();
                ATT_KMM(0); ATT_KRD(2); ATT_SB();
                ATT_KMM(1); ATT_KRD(3); ATT_SB();
                ATT_KMM(2); ATT_KMM(3); ATT_SB();
#undef ATT_KRD
#undef ATT_KMM
            }
            if (k0 + 63 > qw0) {
                const int lim = qw0 + fr - k0 - 4 * fq;
#pragma unroll
                for (int mp = 0; mp < 2; ++mp)
#pragma unroll
                    for (int kt = 0; kt < 4; ++kt)
#pragma unroll
                        for (int r = 0; r < 4; ++r) if (16 * kt + r > lim) sc[mp][kt][r] = -INFINITY;
            }
#pragma unroll
            for (int mp = 0; mp < 2; ++mp) {
                float mx = max3_(sc[mp][0][0], sc[mp][0][1], sc[mp][0][2]);
                mx = max3_(mx, sc[mp][0][3], sc[mp][1][0]);
#pragma unroll
                for (int kt = 1; kt < 4; ++kt) { mx = max3_(mx, sc[mp][kt][1], sc[mp][kt][2]); if (kt < 3) mx = max3_(mx, sc[mp][kt][3], sc[mp][kt + 1][0]); else mx = max3_(mx, sc[mp][kt][3], mx); }
                mx = xrow16_max(mx);
                const float mnew = fmaxf(mrun[mp], mx);
                const float alpha = __builtin_amdgcn_exp2f(mrun[mp] - mnew);
                mrun[mp] = mnew;
                float ps = 0.f;
#pragma unroll
                for (int kt = 0; kt < 4; ++kt)
#pragma unroll
                    for (int r = 0; r < 4; ++r) { const float e = __builtin_amdgcn_exp2f(sc[mp][kt][r] - mnew); sc[mp][kt][r] = e; ps += e; }
                lrun[mp] = lrun[mp] * alpha + ps;
#pragma unroll
                for (int ks = 0; ks < 2; ++ks) {
                    u32x4 pk; pk.x = cvtpk(sc[mp][2 * ks][0], sc[mp][2 * ks][1]); pk.y = cvtpk(sc[mp][2 * ks][2], sc[mp][2 * ks][3]);
                    pk.z = cvtpk(sc[mp][2 * ks + 1][0], sc[mp][2 * ks + 1][1]); pk.w = cvtpk(sc[mp][2 * ks + 1][2], sc[mp][2 * ks + 1][3]);
                    pb[mp][ks] = __builtin_bit_cast(bf16x8, pk);
                }
#pragma unroll
                for (int dt = 0; dt < 8; ++dt) o[mp][dt] = o[mp][dt] * alpha;
            }
            if (!grpB) ATT_PV(pb, bo_cur);
        }
        const int tb = bo_prev; bo_prev = bo_cur; bo_cur = bo_next; bo_next = tb;
    }
    if (grpB && S_w == T) ATT_PV(pb, bo_prev);
#undef ATT_PV
#undef ATT_VRD
#undef ATT_VMM
#undef ATT_SB
    const float i1 = __builtin_amdgcn_rcpf(xrow16_sum(lrun[0])), i2 = lam * __builtin_amdgcn_rcpf(xrow16_sum(lrun[1]));
    float ss = 0.f;
#pragma unroll
    for (int dt = 0; dt < 8; ++dt)
#pragma unroll
        for (int r = 0; r < 4; ++r) { const float v = o[0][dt][r] * i1 - o[1][dt][r] * i2; o[0][dt][r] = v; ss += v * v; }
    ss = xrow16_sum(ss);
    const float rn = rsqrtf(ss * (1.f / 128.f) + EPS) * (1.f - lam_init);
    const float* g = p.subln_g + L * 128;
    bf16* orow = obuf + ((size_t)b * SEQ + qw0 + fr) * D + hh * 128;
#pragma unroll
    for (int dt = 0; dt < 8; ++dt) {
        const f32x4 gv = *(const f32x4*)(g + 16 * dt + 4 * fq);
        u32x2 ov; ov.x = pk2(o[0][dt][0] * rn * gv[0], o[0][dt][1] * rn * gv[1]); ov.y = pk2(o[0][dt][2] * rn * gv[2], o[0][dt][3] * rn * gv[3]);
        *(u32x2*)(orow + 16 * dt + 4 * fq) = ov;
    }
}

__device__ void phase_att_queue(const Params& p, int L, LAS unsigned char* lds, int bid, int nblk) {
    const int tid = tidx(), lane = tid & 63;
    const float* lp = p.diff_lambda + L * 256;
    const float d1 = wave_sum(lp[lane] * lp[64 + lane]), d2 = wave_sum(lp[128 + lane] * lp[192 + lane]);
    const float lam_init = 0.8f - 0.6f * __expf(-0.3f * (float)L);
    const float lam = __expf(d1) - __expf(d2) + lam_init;
    unsigned* head = (unsigned*)(p.ws + WS_CTL) + CW_QUEUE + L;
    volatile LAS int* slot = (volatile LAS int*)(lds + LDS_MISC_OFF + 64);
    for (;;) {
        __syncthreads();
        if (tid == 0) *slot = (int)__hip_atomic_fetch_add(head, 1u, __ATOMIC_RELAXED, __HIP_MEMORY_SCOPE_AGENT);
        __syncthreads();
        const int u = *slot;
        if (u >= 512) break;
        att_unit(p, L, lds, tid, (u & 31) >> 2, u & 3, 15 - (u >> 5), lam, lam_init);
    }
}

constexpr size_t GD_WP = WS_ORAW, GD_QD = WS_ORAW + 16 * MiB, GD_AIP = WS_ORAW + 32 * MiB, GD_KDT = WS_ORAW + 40 * MiB, GD_UT = WS_ORAW + 56 * MiB, GD_GL = WS_ORAW + 72 * MiB;
__device__ __forceinline__ int perm_pos(int k) { return (k & ~31) + 8 * ((k >> 2) & 3) + 4 * ((k >> 4) & 1) + (k & 3); }
__device__ __forceinline__ float softplusf_(float x) { if (x > 20.f) return x; const float e = __expf(x); return e < 0.06f ? e * (1.f - e * (0.5f - e * (0.33333334f - 0.25f * e))) : __logf(1.f + e); }
__device__ __forceinline__ float gelu_erf(float v) {
    const float z = fabsf(v) * 0.70710678118654752f, t = __builtin_amdgcn_rcpf(1.f + 0.3275911f * z);
    const float pl = t * (0.254829592f + t * (-0.284496736f + t * (1.421413741f + t * (-1.453152027f + t * 1.061405429f))));
    const float er = 1.f - pl * __expf(-z * z);
    return 0.5f * v * (1.f + (v < 0.f ? -er : er));
}

constexpr int GP_KN = 0, GP_QN = 17408, GP_RT = 34816, GP_LM = 71680, GP_TB = 89088, GP_GT = 98304, GP_T0T = 99328;
constexpr int GP_KP = 272, GP_RP = 144, GP_LP = 68, GP_TP = 144;
__device__ void phase_gdn_prep(const Params& p, int L, LAS unsigned char* lds, int bid, int nblk) {
    const int tid = tidx(), lane = tid & 63, w = __builtin_amdgcn_readfirstlane(tid >> 6), fr = lane & 15, fq = lane >> 4;
    const bf16* proj = (const bf16*)(p.ws + WS_PROJ);
    const float* BA = (const float*)(p.ws + WS_BA);
    bf16* WP = (bf16*)(p.ws + GD_WP); bf16* QD = (bf16*)(p.ws + GD_QD); bf16* AIP = (bf16*)(p.ws + GD_AIP); bf16* KDT = (bf16*)(p.ws + GD_KDT); bf16* UT = (bf16*)(p.ws + GD_UT);
    float* GL = (float*)(p.ws + GD_GL);
    const float* cw = p.conv_w + (size_t)L * 4 * 1536;
    LAS float* beta_s = (LAS float*)(lds + GP_GT); LAS float* gc_s = beta_s + 64; LAS float* egc_s = gc_s + 64; LAS float* edl_s = egc_s + 64;
    LAS float* Lm = (LAS float*)(lds + GP_LM);
    for (int item = bid; item < 1024; item += nblk) {
        const int n = item & 31, bh = item >> 5, hh = bh & 3, b = bh >> 2, t0 = n * 64;
        const size_t row0 = (size_t)b * SEQ + t0;
        __syncthreads();
        const int colq = hh * 128 + 2 * lane;
        unsigned xq[11], xk[11], xv[11];
#pragma unroll
        for (int r = 0; r < 11; ++r) { const int tt = t0 + 8 * w - 3 + r;
            xq[r] = (tt >= 0) ? *(const unsigned*)(proj + ((size_t)b * SEQ + tt) * PROJ_W + 1536 + colq) : 0u;
            xk[r] = (tt >= 0) ? *(const unsigned*)(proj + ((size_t)b * SEQ + tt) * PROJ_W + 1536 + 512 + colq) : 0u;
            xv[r] = (tt >= 0) ? *(const unsigned*)(proj + ((size_t)b * SEQ + tt) * PROJ_W + 1536 + 1024 + colq) : 0u; }
        if (w == 0) {
            const float negA = -__expf(p.a_log[L * 4 + hh]), dtb = p.dt_bias[L * 4 + hh];
            const float bb = BA[(row0 + lane) * 8 + hh], aa = BA[(row0 + lane) * 8 + 4 + hh] + dtb;
            float c = negA * softplusf_(aa);
#pragma unroll
            for (int o = 1; o < 64; o <<= 1) { const float t = __shfl_up(c, o); if (lane >= o) c += t; }
            const float glast = __shfl(c, 63);
            beta_s[lane] = sigmoidf_(bb); gc_s[lane] = c; egc_s[lane] = __expf(c); edl_s[lane] = __expf(glast - c);
            if (lane == 0) GL[item] = __expf(glast);
        }
        __syncthreads();
        {
            {
                float wq[4][2];
#pragma unroll
                for (int j = 0; j < 4; ++j) { wq[j][0] = cw[j * 1536 + colq]; wq[j][1] = cw[j * 1536 + colq + 1]; }
#pragma unroll
                for (int i = 0; i < 8; ++i) {
                    const int c = 8 * w + i;
                    float q0 = 0.f, q1 = 0.f;
#pragma unroll
                    for (int j = 0; j < 4; ++j) { q0 += wq[j][0] * lo16(xq[i + j]); q1 += wq[j][1] * hi16(xq[i + j]); }
                    q0 *= sigmoidf_(q0); q1 *= sigmoidf_(q1);
                    const float sq = rsqrtf(wave_sum(q0 * q0 + q1 * q1) + EPS) * 0.08838834764831845f;
                    q0 *= sq; q1 *= sq;
                    const float eg = egc_s[c];
                    *(LAS unsigned*)(lds + GP_QN + c * GP_KP + lane * 4) = pk2(q0, q1);
                    *(unsigned*)(QD + ((size_t)item * 64 + c) * 128 + perm_pos(2 * lane)) = pk2(q0 * eg, q1 * eg);
                }
            }
            __builtin_amdgcn_sched_barrier(0);
            {
                float wk[4][2];
#pragma unroll
                for (int j = 0; j < 4; ++j) { wk[j][0] = cw[j * 1536 + 512 + colq]; wk[j][1] = cw[j * 1536 + 512 + colq + 1]; }
                unsigned kd0[8], kd1[8], rk0[8], rk1[8];
#pragma unroll
                for (int i = 0; i < 8; ++i) {
                    const int c = 8 * w + i;
                    float k0 = 0.f, k1 = 0.f;
#pragma unroll
                    for (int j = 0; j < 4; ++j) { k0 += wk[j][0] * lo16(xk[i + j]); k1 += wk[j][1] * hi16(xk[i + j]); }
                    k0 *= sigmoidf_(k0); k1 *= sigmoidf_(k1);
                    const float sk = rsqrtf(wave_sum(k0 * k0 + k1 * k1) + EPS);
                    k0 *= sk; k1 *= sk;
                    const float be = beta_s[c], eg = egc_s[c], ed = edl_s[c];
                    *(LAS unsigned*)(lds + GP_KN + c * GP_KP + lane * 4) = pk2(k0, k1);
                    kd0[i] = f2bf(k0 * ed); kd1[i] = f2bf(k1 * ed);
                    rk0[i] = f2bf(k0 * be * eg); rk1[i] = f2bf(k1 * be * eg);
                }
                u32x4 o;
                o.x = rk0[0] | (rk0[1] << 16); o.y = rk0[2] | (rk0[3] << 16); o.z = rk0[4] | (rk0[5] << 16); o.w = rk0[6] | (rk0[7] << 16); *(LAS u32x4*)(lds + GP_RT + (128 + 2 * lane) * GP_RP + 16 * w) = o;
                o.x = rk1[0] | (rk1[1] << 16); o.y = rk1[2] | (rk1[3] << 16); o.z = rk1[4] | (rk1[5] << 16); o.w = rk1[6] | (rk1[7] << 16); *(LAS u32x4*)(lds + GP_RT + (128 + 2 * lane + 1) * GP_RP + 16 * w) = o;
                const int pa = perm_pos(8 * w), pb = perm_pos(8 * w + 4);
                bf16* kr0 = KDT + ((size_t)item * 128 + 2 * lane) * 64; bf16* kr1 = kr0 + 64;
                u32x2 h2;
                h2.x = kd0[0] | (kd0[1] << 16); h2.y = kd0[2] | (kd0[3] << 16); *(u32x2*)(kr0 + pa) = h2;
                h2.x = kd0[4] | (kd0[5] << 16); h2.y = kd0[6] | (kd0[7] << 16); *(u32x2*)(kr0 + pb) = h2;
                h2.x = kd1[0] | (kd1[1] << 16); h2.y = kd1[2] | (kd1[3] << 16); *(u32x2*)(kr1 + pa) = h2;
                h2.x = kd1[4] | (kd1[5] << 16); h2.y = kd1[6] | (kd1[7] << 16); *(u32x2*)(kr1 + pb) = h2;
            }
            __builtin_amdgcn_sched_barrier(0);
            {
                float wv[4][2];
#pragma unroll
                for (int j = 0; j < 4; ++j) { wv[j][0] = cw[j * 1536 + 1024 + colq]; wv[j][1] = cw[j * 1536 + 1024 + colq + 1]; }
                unsigned rv0[8], rv1[8];
#pragma unroll
                for (int i = 0; i < 8; ++i) {
                    float v0 = 0.f, v1 = 0.f;
#pragma unroll
                    for (int j = 0; j < 4; ++j) { v0 += wv[j][0] * lo16(xv[i + j]); v1 += wv[j][1] * hi16(xv[i + j]); }
                    v0 *= sigmoidf_(v0); v1 *= sigmoidf_(v1);
                    const float be = beta_s[8 * w + i];
                    rv0[i] = f2bf(v0 * be); rv1[i] = f2bf(v1 * be);
                }
                u32x4 o;
                o.x = rv0[0] | (rv0[1] << 16); o.y = rv0[2] | (rv0[3] << 16); o.z = rv0[4] | (rv0[5] << 16); o.w = rv0[6] | (rv0[7] << 16); *(LAS u32x4*)(lds + GP_RT + (2 * lane) * GP_RP + 16 * w) = o;
                o.x = rv1[0] | (rv1[1] << 16); o.y = rv1[2] | (rv1[3] << 16); o.z = rv1[4] | (rv1[5] << 16); o.w = rv1[6] | (rv1[7] << 16); *(LAS u32x4*)(lds + GP_RT + (2 * lane + 1) * GP_RP + 16 * w) = o;
            }
        }
        __syncthreads();
#pragma unroll
        for (int q = 0; q < 2; ++q) {
            const int id = 2 * w + q, ct = id >> 2, st = id & 3;
            if (st <= ct) {
                f32x4 acc = (f32x4){0.f, 0.f, 0.f, 0.f};
#pragma unroll
                for (int ks = 0; ks < 4; ++ks) {
                    const bf16x8 a = *(const LAS bf16x8*)(lds + GP_KN + (16 * ct + fr) * GP_KP + (32 * ks + 8 * fq) * 2);
                    const bf16x8 bb = *(const LAS bf16x8*)(lds + GP_KN + (16 * st + fr) * GP_KP + (32 * ks + 8 * fq) * 2);
                    acc = __builtin_amdgcn_mfma_f32_16x16x32_bf16(a, bb, acc, 0, 0, 0);
                }
                const int s = 16 * st + fr; const float gs = gc_s[s];
#pragma unroll
                for (int r = 0; r < 4; ++r) { const int c = 16 * ct + 4 * fq + r;
                    Lm[c * GP_LP + s] = (s < c) ? beta_s[c] * acc[r] * __expf(fminf(gc_s[c] - gs, 0.f)) : 0.f; }
            }
        }
        __syncthreads();
        if (w < 2) {
            const int o = 32 * w;
            float t[32];
            int zoff = 0; asm volatile("" : "+v"(zoff));
            const LAS float* Lz = Lm + zoff + o * GP_LP + o;
            const int col = lane & 31;
#pragma unroll
            for (int i = 0; i < 32; ++i) {
                float a0 = (i == lane) ? 1.f : 0.f, a1 = 0.f, a2 = 0.f, a3 = 0.f;
#pragma unroll
                for (int s4 = 0; s4 + 4 <= i; s4 += 4) { const f32x4 lv = *(const LAS f32x4*)(Lz + i * GP_LP + s4);
                    a0 -= lv[0] * t[s4]; a1 -= lv[1] * t[s4 + 1]; a2 -= lv[2] * t[s4 + 2]; a3 -= lv[3] * t[s4 + 3]; }
#pragma unroll
                for (int s = i & ~3; s < i; ++s) a0 -= Lz[i * GP_LP + s] * t[s];
                t[i] = (lane < 32) ? (a0 + a1) + (a2 + a3) : 0.f;
                const bf16 tb = (bf16)f2bf(t[i]);
                if (w == 0) { *(LAS bf16*)(lds + GP_TB + i * GP_TP + lane * 2) = tb;
                              if (lane < 32) *(LAS bf16*)(lds + GP_T0T + lane * 80 + i * 2) = tb; }
                else if (lane < 32) *(LAS bf16*)(lds + GP_TB + (32 + i) * GP_TP + (32 + col) * 2) = tb;
                if ((i & 3) == 3) __builtin_amdgcn_sched_barrier(0);
            }
        } else {
            for (int id = w - 2; id < 16; id += 6) {
                const int ct = id >> 2, st = id & 3;
                f32x4 acc = (f32x4){0.f, 0.f, 0.f, 0.f};
                if (st <= ct) {
#pragma unroll
                    for (int ks = 0; ks < 4; ++ks) {
                        const bf16x8 a = *(const LAS bf16x8*)(lds + GP_QN + (16 * ct + fr) * GP_KP + (32 * ks + 8 * fq) * 2);
                        const bf16x8 bb = *(const LAS bf16x8*)(lds + GP_KN + (16 * st + fr) * GP_KP + (32 * ks + 8 * fq) * 2);
                        acc = __builtin_amdgcn_mfma_f32_16x16x32_bf16(a, bb, acc, 0, 0, 0);
                    }
                }
                const int s = 16 * st + fr; const float gs = gc_s[s]; const int ps = perm_pos(s);
#pragma unroll
                for (int r = 0; r < 4; ++r) { const int c = 16 * ct + 4 * fq + r;
                    const float v = (s <= c) ? acc[r] * __expf(fminf(gc_s[c] - gs, 0.f)) : 0.f;
                    AIP[((size_t)item * 64 + c) * 64 + ps] = (bf16)f2bf(v); }
            }
        }
        __syncthreads();
        if (w == 0) {
            f32x4 P[2][2];
#pragma unroll
            for (int it = 0; it < 2; ++it) {
                const LAS float* lr = Lm + (32 + 16 * it + fr) * GP_LP + 8 * fq;
                const f32x4 l0 = *(const LAS f32x4*)lr, l1 = *(const LAS f32x4*)(lr + 4);
                u32x4 pk; pk.x = cvtpk(l0[0], l0[1]); pk.y = cvtpk(l0[2], l0[3]); pk.z = cvtpk(l1[0], l1[1]); pk.w = cvtpk(l1[2], l1[3]);
                const bf16x8 a = __builtin_bit_cast(bf16x8, pk);
#pragma unroll
                for (int jt = 0; jt < 2; ++jt) {
                    const bf16x8 bb = *(const LAS bf16x8*)(lds + GP_T0T + (16 * jt + fr) * 80 + 16 * fq);
                    P[it][jt] = __builtin_amdgcn_mfma_f32_16x16x32_bf16(a, bb, (f32x4){0.f, 0.f, 0.f, 0.f}, 0, 0, 0);
                }
            }
#pragma unroll
            for (int jt = 0; jt < 2; ++jt) {
                u32x4 pk; pk.x = cvtpk(P[0][jt][0], P[0][jt][1]); pk.y = cvtpk(P[0][jt][2], P[0][jt][3]); pk.z = cvtpk(P[1][jt][0], P[1][jt][1]); pk.w = cvtpk(P[1][jt][2], P[1][jt][3]);
                const bf16x8 pb = __builtin_bit_cast(bf16x8, pk);
#pragma unroll
                for (int i2 = 0; i2 < 2; ++i2) {
                    const LAS unsigned char* tr = lds + GP_TB + (32 + 16 * i2 + fr) * GP_TP + (32 + 4 * fq) * 2;
                    const u32x2 ta = *(const LAS u32x2*)tr, tb2 = *(const LAS u32x2*)(tr + 32);
                    u32x4 ak; ak.x = ta.x; ak.y = ta.y; ak.z = tb2.x; ak.w = tb2.y;
                    const f32x4 r = __builtin_amdgcn_mfma_f32_16x16x32_bf16(__builtin_bit_cast(bf16x8, ak), pb, (f32x4){0.f, 0.f, 0.f, 0.f}, 0, 0, 0);
#pragma unroll
                    for (int q = 0; q < 4; ++q) *(LAS bf16*)(lds + GP_TB + (32 + 16 * i2 + 4 * fq + q) * GP_TP + (16 * jt + fr) * 2) = (bf16)f2bf(-r[q]);
                }
            }
        }
        __syncthreads();
#pragma unroll
        for (int q = 0; q < 2; ++q) {
            const int colt = 2 * w + q;
            bf16x8 af[2];
#pragma unroll
            for (int ks = 0; ks < 2; ++ks) af[ks] = *(const LAS bf16x8*)(lds + GP_RT + (16 * colt + fr) * GP_RP + (32 * ks + 8 * fq) * 2);
#pragma unroll
            for (int ct = 0; ct < 4; ++ct) {
                f32x4 acc = (f32x4){0.f, 0.f, 0.f, 0.f};
#pragma unroll
                for (int ks = 0; ks < 2; ++ks) {
                    const bf16x8 bb = *(const LAS bf16x8*)(lds + GP_TB + (16 * ct + fr) * GP_TP + (32 * ks + 8 * fq) * 2);
                    acc = __builtin_amdgcn_mfma_f32_16x16x32_bf16(af[ks], bb, acc, 0, 0, 0);
                }
                const int c = 16 * ct + fr;
                if (colt < 8) {
#pragma unroll
                    for (int r = 0; r < 4; ++r) UT[((size_t)item * 128 + 16 * colt + 4 * fq + r) * 64 + c] = (bf16)f2bf(acc[r]);
                } else {
                    const int kt = colt - 8;
                    u32x2 h2; h2.x = pk2(-acc[0], -acc[1]); h2.y = pk2(-acc[2], -acc[3]);
                    *(u32x2*)(WP + ((size_t)item * 64 + c) * 128 + 32 * (kt >> 1) + 8 * fq + 4 * (kt & 1)) = h2;
                }
            }
        }
    }
    __syncthreads();
}

constexpr int GS_WP = 0, GS_QD = 16384, GS_AIP = 32768, GS_KDT = 40960, GS_BUF = 57344, GS_OB = 2 * GS_BUF, GS_OBP = 272, GS_OBT = 64 * GS_OBP;
__device__ void phase_gdn_scan(const Params& p, int L, LAS unsigned char* lds, int bid, int nblk) {
    const int tid = tidx(), lane = tid & 63, w = __builtin_amdgcn_readfirstlane(tid >> 6), fr = lane & 15, fq = lane >> 4;
    const bf16* proj = (const bf16*)(p.ws + WS_PROJ);
    const bf16* WP = (const bf16*)(p.ws + GD_WP); const bf16* QD = (const bf16*)(p.ws + GD_QD); const bf16* AIP = (const bf16*)(p.ws + GD_AIP);
    const bf16* KDT = (const bf16*)(p.ws + GD_KDT); const bf16* UT = (const bf16*)(p.ws + GD_UT); const float* GL = (const float*)(p.ws + GD_GL);
    bf16* obuf = (bf16*)(p.ws + WS_OBUF);
    for (int item = bid; item < 32; item += nblk) {
        const int hh = item & 3, b = item >> 2;
        const int fc = tid >> 4, fv = tid & 15;
        float gn[8];
#pragma unroll
        for (int i = 0; i < 8; ++i) gn[i] = p.gdn_norm_g[L * 128 + 8 * fv + i];
        f32x4 S[8];
#pragma unroll
        for (int kt = 0; kt < 8; ++kt) S[kt] = (f32x4){0.f, 0.f, 0.f, 0.f};
        auto dma = [&](int ci, int buf) {
#pragma unroll
            for (int i = 0; i < 7; ++i) {
                const int pc = tid + 512 * i;
                const bf16* src;
                if (i < 2) { const int r = pc >> 4; src = WP + (size_t)ci * 8192 + r * 128 + (((pc & 15) ^ (r & 15)) * 8); }
                else if (i < 4) { const int q = pc - 1024, r = q >> 4; src = QD + (size_t)ci * 8192 + r * 128 + (((q & 15) ^ (r & 15)) * 8); }
                else if (i < 5) { const int q = pc - 2048, r = q >> 3; src = AIP + (size_t)ci * 4096 + r * 64 + (((q & 7) ^ ((r >> 1) & 7)) * 8); }
                else { const int q = pc - 2560, r = q >> 3; src = KDT + (size_t)ci * 8192 + r * 64 + (((q & 7) ^ ((r >> 1) & 7)) * 8); }
                __builtin_amdgcn_global_load_lds((const unsigned*)src, (LAS unsigned*)(lds + buf * GS_BUF + (w * 64 + 512 * i) * 16), 16, 0, 0);
            }
        };
        int offk[4], offa[2];
#pragma unroll
        for (int ks = 0; ks < 4; ++ks) offk[ks] = fr * 256 + (((4 * ks + fq) ^ fr) * 16);
#pragma unroll
        for (int ss = 0; ss < 2; ++ss) offa[ss] = fr * 128 + (((4 * ss + fq) ^ ((fr >> 1) & 7)) * 16);
        __syncthreads();
        dma(item * 32, 0);
        u32x2 ut[4]; float gl;
        {
            const int ci = item * 32;
#pragma unroll
            for (int ct = 0; ct < 4; ++ct) ut[ct] = *(const u32x2*)(UT + ((size_t)ci * 128 + 16 * w + fr) * 64 + 16 * ct + 4 * fq);
            gl = GL[ci];
        }
        u32x4 zp[2];
        zp[0] = (u32x4){0u, 0u, 0u, 0u}; zp[1] = zp[0];
        asm volatile("s_waitcnt vmcnt(0)" ::: "memory");
        __syncthreads();
#define GS_FINISH(ps, TILE, DST) do { const int c = 32 * (ps) + fc; \
            const u32x4 ov = *(const LAS u32x4*)(lds + (TILE) + c * GS_OBP + fv * 16); \
            float o8[8]; \
            _Pragma("unroll") for (int i = 0; i < 4; ++i) { o8[2 * i] = lo16(ov[i]); o8[2 * i + 1] = hi16(ov[i]); } \
            float ss = 0.f; \
            _Pragma("unroll") for (int i = 0; i < 8; ++i) ss += o8[i] * o8[i]; \
            const float rn = rsqrtf(row16_sum(ss) * (1.f / 128.f) + EPS); \
            u32x4 res; \
            _Pragma("unroll") for (int i = 0; i < 4; ++i) { \
                const float z0 = lo16(zp[ps][i]), z1 = hi16(zp[ps][i]); \
                res[i] = cvtpk(o8[2 * i] * rn * gn[2 * i] * (z0 * sigmoidf_(z0)), o8[2 * i + 1] * rn * gn[2 * i + 1] * (z1 * sigmoidf_(z1))); } \
            *(u32x4*)((DST) + (size_t)c * D) = res; } while (0)
        bf16* const dummy = (bf16*)(p.ws + WS_Q2) + tid * 8;
        for (int n = 0; n < 32; ++n) {
            const int ci = item * 32 + n, buf = n & 1;
            const size_t rowc = (size_t)b * SEQ + n * 64;
            if (n + 1 < 32) dma(ci + 1, buf ^ 1);
            u32x2 utn[4]; float gln = 0.f;
            {
                const int cn = ci + (n + 1 < 32 ? 1 : 0);
#pragma unroll
                for (int ct = 0; ct < 4; ++ct) utn[ct] = *(const u32x2*)(UT + ((size_t)cn * 128 + 16 * w + fr) * 64 + 16 * ct + 4 * fq);
                gln = GL[cn];
            }
            u32x4 zq[2];
#pragma unroll
            for (int ps = 0; ps < 2; ++ps) zq[ps] = *(const u32x4*)(proj + (rowc + 32 * ps + fc) * PROJ_W + 3072 + hh * 128 + 8 * fv);
            bf16* const fdst = n > 0 ? obuf + (rowc - 64) * D + 512 + hh * 128 + 8 * fv : dummy;
            const int tprev = GS_OB + (buf ^ 1) * GS_OBT, tcur = GS_OB + buf * GS_OBT;
            f32x4 vn[4], oacc[4];
#pragma unroll
            for (int ct = 0; ct < 4; ++ct) { vn[ct] = (f32x4){lo16(ut[ct].x), hi16(ut[ct].x), lo16(ut[ct].y), hi16(ut[ct].y)}; oacc[ct] = (f32x4){0.f, 0.f, 0.f, 0.f}; }
            bf16x8 sb[4];
#pragma unroll
            for (int ks = 0; ks < 4; ++ks) { u32x4 pk; pk.x = cvtpk(S[2 * ks][0], S[2 * ks][1]); pk.y = cvtpk(S[2 * ks][2], S[2 * ks][3]); pk.z = cvtpk(S[2 * ks + 1][0], S[2 * ks + 1][1]); pk.w = cvtpk(S[2 * ks + 1][2], S[2 * ks + 1][3]);
                sb[ks] = __builtin_bit_cast(bf16x8, pk); }
            LAS unsigned char* bb = lds + buf * GS_BUF;
            bf16x8 f0[8], f1[8];
#define LD_A(F, ct) do { _Pragma("unroll") for (int ks = 0; ks < 4; ++ks) { F[ks] = *(const LAS bf16x8*)(bb + GS_WP + (ct) * 4096 + offk[ks]); \
                    F[4 + ks] = *(const LAS bf16x8*)(bb + GS_QD + (ct) * 4096 + offk[ks]); } } while (0)
#define MM_A(F, ct) do { _Pragma("unroll") for (int ks = 0; ks < 4; ++ks) { vn[ct] = __builtin_amdgcn_mfma_f32_16x16x32_bf16(F[ks], sb[ks], vn[ct], 0, 0, 0); \
                    oacc[ct] = __builtin_amdgcn_mfma_f32_16x16x32_bf16(sb[ks], F[4 + ks], oacc[ct], 0, 0, 0); } } while (0)
#define SBAR() __builtin_amdgcn_sched_barrier(0)
            LD_A(f0, 0); SBAR();
            LD_A(f1, 1); MM_A(f0, 0); SBAR();
            LD_A(f0, 2); MM_A(f1, 1); GS_FINISH(0, tprev, fdst); SBAR();
            LD_A(f1, 3); MM_A(f0, 2); SBAR();
#pragma unroll
            for (int ct = 0; ct < 4; ++ct)
#pragma unroll
                for (int ss = 0; ss < 2; ++ss) f0[2 * ct + ss] = *(const LAS bf16x8*)(bb + GS_AIP + ct * 2048 + offa[ss]);
            MM_A(f1, 3); GS_FINISH(1, tprev, fdst); SBAR();
            bf16x8 vb[2];
#pragma unroll
            for (int ss = 0; ss < 2; ++ss) { u32x4 pk; pk.x = cvtpk(vn[2 * ss][0], vn[2 * ss][1]); pk.y = cvtpk(vn[2 * ss][2], vn[2 * ss][3]); pk.z = cvtpk(vn[2 * ss + 1][0], vn[2 * ss + 1][1]); pk.w = cvtpk(vn[2 * ss + 1][2], vn[2 * ss + 1][3]);
                vb[ss] = __builtin_bit_cast(bf16x8, pk); }
#pragma unroll
            for (int kt = 0; kt < 4; ++kt)
#pragma unroll
                for (int ss = 0; ss < 2; ++ss) f1[2 * kt + ss] = *(const LAS bf16x8*)(bb + GS_KDT + kt * 2048 + offa[ss]);
#pragma unroll
            for (int ct = 0; ct < 4; ++ct)
#pragma unroll
                for (int ss = 0; ss < 2; ++ss) oacc[ct] = __builtin_amdgcn_mfma_f32_16x16x32_bf16(vb[ss], f0[2 * ct + ss], oacc[ct], 0, 0, 0);
            SBAR();
#pragma unroll
            for (int kt = 4; kt < 8; ++kt)
#pragma unroll
                for (int ss = 0; ss < 2; ++ss) f0[2 * (kt - 4) + ss] = *(const LAS bf16x8*)(bb + GS_KDT + kt * 2048 + offa[ss]);
#pragma unroll
            for (int kt = 0; kt < 4; ++kt) {
                S[kt] = S[kt] * gl;
#pragma unroll
                for (int ss = 0; ss < 2; ++ss) S[kt] = __builtin_amdgcn_mfma_f32_16x16x32_bf16(f1[2 * kt + ss], vb[ss], S[kt], 0, 0, 0);
            }
#pragma unroll
            for (int ct = 0; ct < 4; ++ct) {
                u32x2 pk; pk.x = cvtpk(oacc[ct][0], oacc[ct][1]); pk.y = cvtpk(oacc[ct][2], oacc[ct][3]);
                *(LAS u32x2*)(lds + tcur + (16 * ct + fr) * GS_OBP + (16 * w + 4 * fq) * 2) = pk;
            }
            SBAR();
#pragma unroll
            for (int kt = 4; kt < 8; ++kt) {
                S[kt] = S[kt] * gl;
#pragma unroll
                for (int ss = 0; ss < 2; ++ss) S[kt] = __builtin_amdgcn_mfma_f32_16x16x32_bf16(f0[2 * (kt - 4) + ss], vb[ss], S[kt], 0, 0, 0);
            }
#undef LD_A
#undef MM_A
#undef SBAR
#pragma unroll
            for (int ct = 0; ct < 4; ++ct) ut[ct] = utn[ct];
            gl = gln; zp[0] = zq[0]; zp[1] = zq[1];
            asm volatile("s_waitcnt vmcnt(0)" ::: "memory");
            LDS_BARRIER();
        }
        {
            bf16* const fdst = obuf + ((size_t)b * SEQ + 31 * 64) * D + 512 + hh * 128 + 8 * fv;
            GS_FINISH(0, GS_OB + GS_OBT, fdst); GS_FINISH(1, GS_OB + GS_OBT, fdst);
        }
#undef GS_FINISH
        __syncthreads();
    }
}

__device__ __forceinline__ unsigned sortable(float f) { const unsigned u = __float_as_uint(f); return u ^ ((unsigned)((int)u >> 31) | 0x80000000u); }
__device__ __forceinline__ float unsortable(unsigned s) { return __uint_as_float((s & 0x80000000u) ? (s ^ 0x80000000u) : ~s); }
#define CE(a, b) do { const unsigned _x = k[a], _y = k[b]; k[a] = _x > _y ? _x : _y; k[b] = _x > _y ? _y : _x; } while (0)
constexpr int PE_TK = 0, PE_TAB = 8192, PE_ID = 8448, PE_GT = PE_ID + 32768, PE_SK = PE_GT + 32768;
__device__ void phase_peer(const Params& p, int L, LAS unsigned char* lds, int bid, int nblk) {
    const int tid = tidx(), lane = tid & 63, w = __builtin_amdgcn_readfirstlane(tid >> 6), fr = lane & 15, fq = lane >> 4;
    const bf16* Q2 = (const bf16*)(p.ws + WS_Q2);
    const bf16* SK = (const bf16*)(p.ws + WS_SK) + (size_t)L * 8 * 2 * 128 * 128;
    float* H = (float*)(p.ws + WS_H); bf16* HB2 = (bf16*)(p.ws + WS_HB2);
    const unsigned char* U = p.ws + WS_U + (size_t)L * NEXP * D;
    const unsigned char* V = p.ws + WS_V + (size_t)L * NEXP * D;
    const float* SU = (const float*)(p.ws + WS_SU) + (size_t)L * NEXP; const float* SV = (const float*)(p.ws + WS_SV) + (size_t)L * NEXP;
    const float* g = p.ln_ffn_g + L * D;
    LAS unsigned* TK = (LAS unsigned*)(lds + PE_TK);
    LAS unsigned short* TAB = (LAS unsigned short*)(lds + PE_TAB);
    LAS int* IDL = (LAS int*)(lds + PE_ID); LAS float* GTL = (LAS float*)(lds + PE_GT);
    if (tid < 64) {
        int a = 0, base = 0, q = tid; unsigned short v = 0xffff;
        if (q < 50) { for (;;) { const int cnt = 16 / (a + 1); if (q < base + cnt) break; base += cnt; ++a; } v = (unsigned short)((a << 8) | (q - base)); }
        TAB[tid] = v;
    }
    for (int item = bid; item < M / 64; item += nblk) {
        const int tok0 = item * 64;
        int tid_o = tid; asm volatile("" : "+v"(tid_o));
        const int tid = tid_o, lane = tid & 63, fr = lane & 15, fq = lane >> 4;
        __syncthreads();
        const int tg = w & 3, cc = w >> 2;
        int zs = 0; asm volatile("" : "+v"(zs));
        const bf16* SK_ = SK + zs;
#define SK_FETCH(hd) do { _Pragma("unroll") for (int i = 0; i < 8; ++i) { const int pc = tid + 512 * i, nn = (pc >> 4) & 127; \
            __builtin_amdgcn_global_load_lds((const unsigned*)(SK_ + ((size_t)((hd) * 2 + (pc >> 11)) * 128 + nn) * 128 + (((pc & 15) ^ (nn & 15)) * 8)), \
                                             (LAS unsigned*)(lds + PE_SK + (w * 64 + 512 * i) * 16), 16, 0, 0); } } while (0)
        SK_FETCH(0);
        asm volatile("s_waitcnt vmcnt(0)" ::: "memory");
        __syncthreads();
        for (int hh = 0; hh < 8; ++hh) {
            {
                f32x4 acc[8];
#pragma unroll
                for (int nt = 0; nt < 8; ++nt) acc[nt] = (f32x4){0.f, 0.f, 0.f, 0.f};
                bf16x8 qa[4];
#pragma unroll
                for (int ks = 0; ks < 4; ++ks) qa[ks] = *(const bf16x8*)(Q2 + (size_t)(tok0 + 16 * tg + fr) * 2048 + hh * 256 + cc * 128 + 32 * ks + 8 * fq);
                const LAS unsigned char* skb = lds + PE_SK + cc * 32768 + fr * 256;
#pragma unroll
                for (int nt = 0; nt < 8; ++nt)
#pragma unroll
                    for (int ks = 0; ks < 4; ++ks) {
                        const bf16x8 kb = *(const LAS bf16x8*)(skb + nt * 4096 + (((4 * ks + fq) ^ fr) << 4));
                        acc[nt] = __builtin_amdgcn_mfma_f32_16x16x32_bf16(qa[ks], kb, acc[nt], 0, 0, 0);
                    }
#pragma unroll
                for (int r = 0; r < 4; ++r) {
                    unsigned k[8];
#pragma unroll
                    for (int nt = 0; nt < 8; ++nt) k[nt] = (sortable(acc[nt][r]) & ~0x7Fu) | (unsigned)(127 - (16 * nt + fr));
                    CE(0, 1); CE(2, 3); CE(4, 5); CE(6, 7); CE(0, 2); CE(1, 3); CE(4, 6); CE(5, 7); CE(1, 2); CE(5, 6); CE(0, 4); CE(3, 7);
                    CE(1, 5); CE(2, 6); CE(1, 4); CE(3, 6); CE(2, 4); CE(3, 5); CE(3, 4);
                    unsigned res = 0u;
#pragma unroll
                    for (int rd = 0; rd < 16; ++rd) {
                        const unsigned m = row16_umax(k[0]);
                        const bool win = k[0] == m;
#pragma unroll
                        for (int i = 0; i < 7; ++i) k[i] = win ? k[i + 1] : k[i];
                        k[7] = win ? 0u : k[7];
                        res = (fr == rd) ? m : res;
                    }
                    TK[(cc * 64 + 16 * tg + 4 * fq + r) * 16 + fr] = res;
                }
            }
            __syncthreads();
            if (hh + 1 < 8) SK_FETCH(hh + 1);
#pragma unroll
            for (int ps = 0; ps < 2; ++ps) {
                const int tl = 8 * w + 4 * ps + fq;
                unsigned k[4];
#pragma unroll
                for (int sl = 0; sl < 4; ++sl) {
                    const int q = sl * 16 + fr;
                    const unsigned ab = TAB[q];
                    const unsigned k1 = TK[tl * 16 + ((ab >> 8) & 15)], k2 = TK[(64 + tl) * 16 + (ab & 15)];
                    const float v = unsortable(k1 & ~0x7Fu) + unsortable(k2 & ~0x7Fu);
                    k[sl] = (q < 50) ? ((sortable(v) & ~0x3Fu) | (unsigned)(63 - q)) : 0u;
                }
                CE(0, 1); CE(2, 3); CE(0, 2); CE(1, 3); CE(1, 2);
                unsigned res = 0u;
#pragma unroll
                for (int rd = 0; rd < 16; ++rd) {
                    const unsigned m = row16_umax(k[0]);
                    const bool win = k[0] == m;
                    k[0] = win ? k[1] : k[0]; k[1] = win ? k[2] : k[1]; k[2] = win ? k[3] : k[2]; k[3] = win ? 0u : k[3];
                    res = (fr == rd) ? m : res;
                }
                const unsigned ab = TAB[63 - (res & 0x3Fu)];
                const unsigned k1 = TK[tl * 16 + ((ab >> 8) & 15)], k2 = TK[(64 + tl) * 16 + (ab & 15)];
                const float v = unsortable(k1 & ~0x7Fu) + unsortable(k2 & ~0x7Fu);
                const float e = __expf(v - row16_max(v));
                const float sum = row16_sum(e);
                IDL[tl * 128 + hh * 16 + fr] = (int)((127u - (k1 & 0x7Fu)) * 128u + (127u - (k2 & 0x7Fu)));
                GTL[tl * 128 + hh * 16 + fr] = e * __builtin_amdgcn_rcpf(sum);
            }
            asm volatile("s_waitcnt vmcnt(0)" ::: "memory");
            __syncthreads();
        }
#undef SK_FETCH
        for (int ti = 0; ti < 8; ++ti) {
            const int tl = 8 * w + ti;
            unsigned k0 = ((unsigned)IDL[tl * 128 + lane] << 7) | (unsigned)lane, k1 = ((unsigned)IDL[tl * 128 + 64 + lane] << 7) | (unsigned)(64 + lane);
#pragma unroll
            for (int kk = 2; kk <= 128; kk <<= 1) {
#pragma unroll
                for (int j = kk >> 1; j >= 1; j >>= 1) {
                    if (j == 64) { const unsigned lo = k0 < k1 ? k0 : k1, hi = k0 < k1 ? k1 : k0; k0 = lo; k1 = hi; }
                    else {
                        const unsigned p0 = (unsigned)__shfl_xor((int)k0, j), p1 = (unsigned)__shfl_xor((int)k1, j);
                        const bool up0 = ((lane & kk) == 0) || kk == 128, up1 = (((lane + 64) & kk) == 0);
                        const bool low = (lane & j) == 0;
                        k0 = (low == up0) ? (k0 < p0 ? k0 : p0) : (k0 > p0 ? k0 : p0);
                        k1 = (low == (kk == 128 ? true : up1)) ? (k1 < p1 ? k1 : p1) : (k1 > p1 ? k1 : p1);
                    }
                }
            }
            const float g0 = GTL[tl * 128 + (k0 & 127u)], g1 = GTL[tl * 128 + (k1 & 127u)];
            asm volatile("s_waitcnt lgkmcnt(0)" ::: "memory");
            IDL[tl * 128 + lane] = (int)(k0 >> 7); IDL[tl * 128 + 64 + lane] = (int)(k1 >> 7);
            GTL[tl * 128 + lane] = g0; GTL[tl * 128 + 64 + lane] = g1;
        }
        __syncthreads();
        {
            int zo = 0; asm volatile("" : "+v"(zo));
            const float* g_ = g + zo; const unsigned char* U_ = U + zo; const float* H_ = H + zo;
            int xq[8][4]; float sx[8];
#pragma unroll
            for (int t = 0; t < 8; ++t) {
                const float* hrow = H_ + (size_t)(tok0 + 8 * w + t) * D + 4 * lane;
                float xn[16];
#pragma unroll
                for (int j = 0; j < 4; ++j) { const f32x4 a = *(const f32x4*)(hrow + 256 * j); xn[4 * j] = a[0]; xn[4 * j + 1] = a[1]; xn[4 * j + 2] = a[2]; xn[4 * j + 3] = a[3]; }
                float ss = 0.f;
#pragma unroll
                for (int i = 0; i < 16; ++i) ss += xn[i] * xn[i];
                const float rstd = rsqrtf(wave_sum(ss) * (1.f / D) + EPS);
                float mx = 0.f;
#pragma unroll
                for (int i = 0; i < 16; ++i) { xn[i] = xn[i] * rstd * g_[256 * (i >> 2) + 4 * lane + (i & 3)]; mx = fmaxf(mx, fabsf(xn[i])); }
                mx = xrow16_max(row16_max(mx));
                const float xinv = mx > 0.f ? 127.f / mx : 0.f; sx[t] = mx * (1.f / 127.f);
#pragma unroll
                for (int j = 0; j < 4; ++j) xq[t][j] = (int)(((unsigned)__float2int_rn(xn[4 * j] * xinv) & 0xffu) | (((unsigned)__float2int_rn(xn[4 * j + 1] * xinv) & 0xffu) << 8) |
                                                             (((unsigned)__float2int_rn(xn[4 * j + 2] * xinv) & 0xffu) << 16) | ((unsigned)__float2int_rn(xn[4 * j + 3] * xinv) << 24));
                asm volatile("" ::: "memory"); __builtin_amdgcn_sched_barrier(0);
            }
            int hi[8][2];
#pragma unroll
            for (int t = 0; t < 8; ++t) { hi[t][0] = 0; hi[t][1] = 0; }
            const LAS int* idw = IDL + 8 * w * 128;
            u32x4 ring[16];
#pragma unroll
            for (int j = 0; j < 16; ++j) ring[j] = *(const u32x4*)(U_ + (size_t)idw[(j & 7) * 128 + (j >> 3)] * D + 16 * lane);
#pragma unroll 1
            for (int k = 0; k < 64; ++k) {
#pragma unroll
                for (int j = 0; j < 16; ++j) {
                    const int t = j & 7, pos = 2 * k + (j >> 3);
                    const u32x4 a = ring[j];
                    if (k < 63) ring[j] = *(const u32x4*)(U_ + (size_t)idw[t * 128 + pos + 2] * D + 16 * lane);
                    int d = __builtin_amdgcn_sdot4((int)a[0], xq[t][0], 0, false);
                    d = __builtin_amdgcn_sdot4((int)a[1], xq[t][1], d, false); d = __builtin_amdgcn_sdot4((int)a[2], xq[t][2], d, false); d = __builtin_amdgcn_sdot4((int)a[3], xq[t][3], d, false);
                    d = wave_isum(d);
                    if (lane == (pos & 63)) { if (k < 32) hi[t][0] = d; else hi[t][1] = d; }
                }
            }
#pragma unroll
            for (int t = 0; t < 8; ++t) {
                const int tl = 8 * w + t;
                const int id0 = IDL[tl * 128 + lane], id1 = IDL[tl * 128 + 64 + lane];
                const float su0 = SU[id0], su1 = SU[id1], sv0 = SV[id0], sv1 = SV[id1];
                const float h0 = su0 * sx[t] * (float)hi[t][0], h1 = su1 * sx[t] * (float)hi[t][1];
                GTL[tl * 128 + lane] = sv0 * GTL[tl * 128 + lane] * gelu_erf(h0);
                GTL[tl * 128 + 64 + lane] = sv1 * GTL[tl * 128 + 64 + lane] * gelu_erf(h1);
                asm volatile("" ::: "memory"); __builtin_amdgcn_sched_barrier(0);
            }
        }
        {
            int zo = 0; asm volatile("" : "+v"(zo));
            const unsigned char* V_ = V + zo; float* H_ = H + zo; bf16* HB2_ = HB2 + zo;
            int wq[8]; float sw[8];
#pragma unroll
            for (int t = 0; t < 8; ++t) {
                const int tl = 8 * w + t;
                const float w0 = GTL[tl * 128 + lane], w1 = GTL[tl * 128 + 64 + lane];
                const float wmx = xrow16_max(row16_max(fmaxf(fabsf(w0), fabsf(w1))));
                const float winv = wmx > 0.f ? 127.f / wmx : 0.f; sw[t] = wmx * (1.f / 127.f);
                const f32x4 wv = *(const LAS f32x4*)(GTL + tl * 128 + 4 * (lane & 31));
                wq[t] = (int)(((unsigned)__float2int_rn(wv[0] * winv) & 0xffu) | (((unsigned)__float2int_rn(wv[1] * winv) & 0xffu) << 8) |
                              (((unsigned)__float2int_rn(wv[2] * winv) & 0xffu) << 16) | ((unsigned)__float2int_rn(wv[3] * winv) << 24));
                asm volatile("" ::: "memory"); __builtin_amdgcn_sched_barrier(0);
            }
            const LAS int* idw = IDL + 8 * w * 128;
#pragma unroll
            for (int hf = 0; hf < 2; ++hf) {
                int yi[4][16];
#pragma unroll
                for (int g4 = 0; g4 < 4; ++g4)
#pragma unroll
                    for (int i = 0; i < 16; ++i) yi[g4][i] = 0;
                u32x4 ring[16];
#pragma unroll
                for (int j = 0; j < 16; ++j) ring[j] = *(const u32x4*)(V_ + (size_t)idw[(4 * hf + (j >> 2)) * 128 + (j & 3)] * D + 16 * lane);
#pragma unroll 1
                for (int s4 = 0; s4 < 32; ++s4) {
#pragma unroll
                    for (int g4 = 0; g4 < 4; ++g4) {
                        const int t = 4 * hf + g4;
                        const int wg = __builtin_amdgcn_readlane(wq[t], s4);
#pragma unroll
                        for (int q = 0; q < 4; ++q) {
                            const unsigned a0 = ring[4 * g4][q], a1 = ring[4 * g4 + 1][q], a2 = ring[4 * g4 + 2][q], a3 = ring[4 * g4 + 3][q];
                            const unsigned p0 = __builtin_amdgcn_perm(a1, a0, 0x05010400u), p1 = __builtin_amdgcn_perm(a1, a0, 0x07030602u);
                            const unsigned p2 = __builtin_amdgcn_perm(a3, a2, 0x05010400u), p3 = __builtin_amdgcn_perm(a3, a2, 0x07030602u);
                            yi[g4][4 * q] = __builtin_amdgcn_sdot4((int)__builtin_amdgcn_perm(p2, p0, 0x05040100u), wg, yi[g4][4 * q], false);
                            yi[g4][4 * q + 1] = __builtin_amdgcn_sdot4((int)__builtin_amdgcn_perm(p2, p0, 0x07060302u), wg, yi[g4][4 * q + 1], false);
                            yi[g4][4 * q + 2] = __builtin_amdgcn_sdot4((int)__builtin_amdgcn_perm(p3, p1, 0x05040100u), wg, yi[g4][4 * q + 2], false);
                            yi[g4][4 * q + 3] = __builtin_amdgcn_sdot4((int)__builtin_amdgcn_perm(p3, p1, 0x07060302u), wg, yi[g4][4 * q + 3], false);
                        }
                        __builtin_amdgcn_sched_barrier(0);
                        if (s4 < 31) {
#pragma unroll
                            for (int q = 0; q < 4; ++q) ring[4 * g4 + q] = *(const u32x4*)(V_ + (size_t)idw[t * 128 + 4 * (s4 + 1) + q] * D + 16 * lane);
                        }
                        __builtin_amdgcn_sched_barrier(0);
                    }
                }
#pragma unroll
                for (int g4 = 0; g4 < 4; ++g4) {
                    const int t = 4 * hf + g4, tok = tok0 + 8 * w + t;
                    float* hrow = H_ + (size_t)tok * D + 4 * lane;
                    float y[16];
#pragma unroll
                    for (int j = 0; j < 4; ++j) { const f32x4 a = *(const f32x4*)(hrow + 256 * j); y[4 * j] = a[0]; y[4 * j + 1] = a[1]; y[4 * j + 2] = a[2]; y[4 * j + 3] = a[3]; }
#pragma unroll
                    for (int i = 0; i < 16; ++i) y[i] = y[i] + sw[t] * (float)yi[g4][i];
#pragma unroll
                    for (int j = 0; j < 4; ++j) *(f32x4*)(hrow + 256 * j) = (f32x4){y[4 * j], y[4 * j + 1], y[4 * j + 2], y[4 * j + 3]};
                    bf16* hb = HB2_ + (size_t)tok * D + 4 * lane;
#pragma unroll
                    for (int j = 0; j < 4; ++j) { u32x2 o2; o2.x = pk2(y[4 * j], y[4 * j + 1]); o2.y = pk2(y[4 * j + 2], y[4 * j + 3]); *(u32x2*)(hb + 256 * j) = o2; }
                    asm volatile("" ::: "memory"); __builtin_amdgcn_sched_barrier(0);
                }
            }
        }
    }
    __syncthreads();
}
#undef CE

__device__ void phase_final(const Params& p, int bid, int nblk) {
    const int tid = tidx(), lane = tid & 63, gw = bid * NWAVES + (tid >> 6), NGW = nblk * NWAVES;
    const float* H = (const float*)(p.ws + WS_H);
    for (int m = gw; m < M; m += NGW) {
        f32x4 v[4]; float ss = 0.f;
#pragma unroll
        for (int j = 0; j < 4; ++j) { v[j] = ((const f32x4*)(H + (size_t)m * D))[lane + 64 * j]; ss += (v[j][0] * v[j][0] + v[j][1] * v[j][1]) + (v[j][2] * v[j][2] + v[j][3] * v[j][3]); }
        const float r = rsqrtf(wave_sum(ss) * (1.f / D) + EPS);
#pragma unroll
        for (int j = 0; j < 4; ++j) { const f32x4 gv = ((const f32x4*)p.final_g)[lane + 64 * j]; ((f32x4*)(p.out + (size_t)m * D))[lane + 64 * j] = v[j] * r * gv; }
    }
}

#define XB_TMO      128
#define XB_XCNT(j)  (256  + 64 * (j))
#define XB_XSUB(j)  (1280 + 64 * (j))
#define XB_XGEN(j)  (2304 + 64 * (j))
#define XB_TOP      3328
#define XB_TOPGEN   3392
#define XCD_BAR_WORDS 3456
#define XB_SPIN_CAP (1u << 22)
__device__ __forceinline__ unsigned xb_ld(unsigned* p)              { return __hip_atomic_load(p, __ATOMIC_RELAXED, __HIP_MEMORY_SCOPE_AGENT); }
__device__ __forceinline__ unsigned xb_add(unsigned* p, unsigned v) { return __hip_atomic_fetch_add(p, v, __ATOMIC_RELAXED, __HIP_MEMORY_SCOPE_AGENT); }
__device__ __forceinline__ unsigned xb_xcc_id() { return (unsigned)__builtin_amdgcn_s_getreg((3 << 11) | 20) & 0xFu; }
#define XB_SPIN(cond, bar) do { unsigned _sp = 0; while (cond) { __builtin_amdgcn_s_sleep(1); \
    if ((++_sp & 255u) == 0u) { if (xb_ld(&(bar)[XB_TMO])) break; if (_sp > XB_SPIN_CAP) { atomicAdd(&(bar)[XB_TMO], 1u); break; } } } } while (0)
struct XcdBarrier { unsigned* bar; unsigned x; volatile LAS unsigned* st; };
__device__ __forceinline__ XcdBarrier xcd_barrier_post(unsigned* bar, volatile LAS unsigned* st) {
    XcdBarrier b; b.bar = bar; b.x = xb_xcc_id(); b.st = st;
    if (threadIdx.x == 0) (void)xb_add(&bar[XB_XCNT(b.x)], 1u);
    return b;
}
__device__ __forceinline__ void xcd_barrier_complete(unsigned* bar, unsigned x, unsigned& nloc, unsigned& nx) {
    const unsigned G = gridDim.x * gridDim.y * gridDim.z;
    unsigned sum, cnt, mine, sp = 0u;
    for (;;) {
        sum = 0u; cnt = 0u; mine = 0u;
#pragma unroll
        for (unsigned j = 0; j < 16; ++j) { const unsigned c = xb_ld(&bar[XB_XCNT(j)]); sum += c; cnt += (c > 0u) ? 1u : 0u; mine = (j == x) ? c : mine; }
        if (sum == G) break;
        __builtin_amdgcn_s_sleep(1);
        if ((++sp & 255u) == 0u) { if (xb_ld(&bar[XB_TMO])) break; if (sp > XB_SPIN_CAP) { atomicAdd(&bar[XB_TMO], 1u); break; } }
    }
    nloc = mine > 0u ? mine : 1u; nx = cnt > 0u ? cnt : 1u;
}
__device__ __forceinline__ void xcd_barrier(const XcdBarrier& b) {
    asm volatile("s_waitcnt vmcnt(0)" ::: "memory");
    __syncthreads();
    if (threadIdx.x == 0) {
        unsigned* bar = b.bar;
        __builtin_amdgcn_s_waitcnt(0);
        unsigned nloc = b.st[0], nx = b.st[1];
        if (nloc == 0u) { xcd_barrier_complete(bar, b.x, nloc, nx); b.st[0] = nloc; b.st[1] = nx; }
        const unsigned old = xb_add(&bar[XB_XSUB(b.x)], 1u);
        const unsigned gen = old / nloc;
        if (old + 1u == (gen + 1u) * nloc) {
            __builtin_amdgcn_fence(__ATOMIC_RELEASE, "agent");
            asm volatile("s_waitcnt vmcnt(0)" ::: "memory");
            const unsigned og = xb_add(&bar[XB_TOP], 1u);
            const unsigned tg = og / nx;
            if (og + 1u == (tg + 1u) * nx) xb_add(&bar[XB_TOPGEN], 1u);
            else XB_SPIN(xb_ld(&bar[XB_TOPGEN]) == tg, bar);
            __builtin_amdgcn_fence(__ATOMIC_ACQUIRE, "agent");
            xb_add(&bar[XB_XGEN(b.x)], 1u);
            asm volatile("s_waitcnt vmcnt(0)" ::: "memory");
        } else {
            XB_SPIN(xb_ld(&bar[XB_XGEN(b.x)]) == gen, bar);
            __builtin_amdgcn_fence(__ATOMIC_ACQUIRE, "agent");
            asm volatile("s_waitcnt vmcnt(0)" ::: "memory");
        }
    }
    __syncthreads();
}
constexpr int CW_BAR = 4096;

constexpr int K_PROLOGUE = 11, K_FINAL = 12;
template <int KIND>
__device__ __forceinline__ void run_kind(const Params& p, int L, LAS unsigned char* lds, int bid, int nblk) {
    unsigned char* ws = p.ws;
    float* H = (float*)(ws + WS_H);
    float* ss0 = (float*)(ws + WS_STAT); float* ss1 = (float*)(ws + WS_SS1); float* sse = (float*)(ws + WS_SSE);
    if constexpr (KIND == K_PROLOGUE) phase_prologue(p, lds, bid, nblk);
    if constexpr (KIND == K_FINAL) phase_final(p, bid, nblk);
    if constexpr (KIND == 0) { EpiProj E{nullptr, (bf16*)(ws + WS_PROJ), (float*)(ws + WS_BA)};
        gemm_run(lds, (const bf16*)(ws + WS_HB0), (const bf16*)(ws + WS_WIN) + (size_t)L * IN_PAD * D, M, IN_PAD, D, E, bid, nblk, ss0); }
    if constexpr (KIND == 1) phase_gdn_prep(p, L, lds, bid, nblk);
    if constexpr (KIND == 2) { phase_gdn_scan(p, L, lds, bid, nblk); phase_att_queue(p, L, lds, bid, nblk); }
    if constexpr (KIND == 3) { EpiRes E{ss1, H, (bf16*)(ws + WS_HB1)};
        gemm_run(lds, (const bf16*)(ws + WS_OBUF), (const bf16*)(ws + WS_WOUT) + (size_t)L * D * D, M, D, D, E, bid, nblk); }
    if constexpr (KIND == 4) { EpiQ2 E{nullptr, (bf16*)(ws + WS_Q2)};
        gemm_run(lds, (const bf16*)(ws + WS_HB1), (const bf16*)(ws + WS_WQ) + (size_t)L * 2048 * D, M, 2048, D, E, bid, nblk, ss1); }
    if constexpr (KIND == 5) phase_peer(p, L, lds, bid, nblk);
    if constexpr (KIND == 7) { EpiE E2{sse, (bf16*)(ws + WS_EPRE)};
        gemm_run(lds, (const bf16*)(ws + WS_PB) + (size_t)L * M * 256, (const bf16*)(ws + WS_WP) + (size_t)L * D * 256, M, D, 256, E2, bid, nblk); }
    if constexpr (KIND == 6) { EpiPle E{ss0, H, (bf16*)(ws + WS_HB0), (const bf16*)(ws + WS_EPRE), p.ple_norm_g + L * D};
        gemm_run(lds, (const bf16*)(ws + WS_HB2), (const bf16*)(ws + WS_WG) + (size_t)L * D * D, M, D, D, E, bid, nblk, sse); }
}

__device__ __forceinline__ Params params_off(const Params& s, size_t z) {
    Params q;
    q.x = s.x + z; q.p = s.p + z; q.ln_mix_g = s.ln_mix_g + z; q.w_in = s.w_in + z; q.conv_w = s.conv_w + z; q.a_log = s.a_log + z; q.dt_bias = s.dt_bias + z;
    q.gdn_norm_g = s.gdn_norm_g + z; q.diff_lambda = s.diff_lambda + z; q.subln_g = s.subln_g + z; q.w_out = s.w_out + z; q.ln_ffn_g = s.ln_ffn_g + z;
    q.peer_wq = s.peer_wq + z; q.subkeys = s.subkeys + z; q.peer_u = s.peer_u + z; q.peer_v = s.peer_v + z; q.ple_wp = s.ple_wp + z; q.ple_wg = s.ple_wg + z;
    q.ple_norm_g = s.ple_norm_g + z; q.final_g = s.final_g + z; q.out = s.out + z; q.ws = s.ws + z; q.pad0 = 0; q.pad1 = 0;
    return q;
}
#define RUN(KIND) do { size_t z_ = 0; int L_ = L; asm volatile("" : "+s"(z_), "+s"(L_)); const Params q_ = params_off(p, z_); run_kind<KIND>(q_, L_, (LAS unsigned char*)lds, (int)blockIdx.x, (int)gridDim.x); } while (0)
#define GRID_BARRIER() do { XcdBarrier b_; b_.bar = (unsigned*)(p.ws + WS_CTL) + CW_BAR; b_.x = xb_xcc_id(); b_.st = (volatile LAS unsigned*)((LAS unsigned char*)lds + LDS_MISC_OFF) + 8; xcd_barrier(b_); } while (0)
__global__ void __launch_bounds__(NTHREADS, 2) mk_fwd(Params p) {
    extern __shared__ __attribute__((aligned(16))) unsigned char lds[];
    {
        volatile LAS unsigned* misc = (volatile LAS unsigned*)((LAS unsigned char*)lds + LDS_MISC_OFF);
        if (threadIdx.x < 64) misc[threadIdx.x] = 0u;
        __syncthreads();
        (void)xcd_barrier_post((unsigned*)(p.ws + WS_CTL) + CW_BAR, misc + 8);
    }
    { int L = 0; RUN(K_PROLOGUE); }
    cg::this_grid().sync();
#define LAYER(LL) do { const int L = (LL); RUN(0); GRID_BARRIER(); RUN(1); GRID_BARRIER(); RUN(2); GRID_BARRIER(); RUN(3); GRID_BARRIER(); RUN(4); GRID_BARRIER(); RUN(5); RUN(7); GRID_BARRIER(); RUN(6); GRID_BARRIER(); } while (0)
    LAYER(0); LAYER(1); LAYER(2); LAYER(3);
#undef LAYER
    { int L = 0; RUN(K_FINAL); }
}

extern "C" void kernel_launch(void* const* d_in, const int* in_sizes, int n_in, void* d_out, int out_size, void* d_ws, size_t ws_size, hipStream_t stream) {
    static int grid = 0;
    if (grid == 0) {
        if (n_in != 20 || out_size != M * D || ws_size < WS_END) { fprintf(stderr, "kernel_launch: unexpected shapes (n_in %d, out %d, ws %zu < %zu)\n", n_in, out_size, ws_size, (size_t)WS_END); grid = -1; return; }
        int dev = 0, cus = 0, per_cu = 0;
        (void)hipGetDevice(&dev); (void)hipDeviceGetAttribute(&cus, hipDeviceAttributeMultiprocessorCount, dev);
        if (hipFuncSetAttribute((const void*)mk_fwd, hipFuncAttributeMaxDynamicSharedMemorySize, LDS_BYTES) != hipSuccess) { fprintf(stderr, "kernel_launch: hipFuncSetAttribute failed\n"); grid = -1; return; }
        if (hipOccupancyMaxActiveBlocksPerMultiprocessor(&per_cu, (const void*)mk_fwd, NTHREADS, LDS_BYTES) != hipSuccess || per_cu < 1) { fprintf(stderr, "kernel_launch: occupancy query says %d blocks per CU\n", per_cu); (void)hipGetLastError(); grid = -1; return; }
        grid = (cus > 0 ? cus : 256);
    }
    if (grid < 0) return;
    (void)hipMemsetAsync((char*)d_ws + WS_CTL, 0, CTL_ZERO_BYTES, stream);
    Params p{};
    const float** pp = (const float**)&p;
    for (int i = 0; i < 20; ++i) pp[i] = (const float*)d_in[i];
    p.out = (float*)d_out; p.ws = (unsigned char*)d_ws;
    void* args[] = {&p};
    hipError_t e = hipLaunchCooperativeKernel((const void*)mk_fwd, dim3(grid), dim3(NTHREADS), args, LDS_BYTES, stream);
    if (e != hipSuccess) fprintf(stderr, "kernel_launch: cooperative launch failed: %s (grid %d)\n", hipGetErrorString(e), grid);
}
```

```cpp
#include <hip/hip_runtime.h>
#include <hip/hip_cooperative_groups.h>
#include <cstdio>
#include <cstdint>
namespace cg = cooperative_groups;

#define LAS __attribute__((address_space(3)))
typedef unsigned short bf16;
typedef float f32x4 __attribute__((ext_vector_type(4)));
typedef short bf16x8 __attribute__((ext_vector_type(8)));
typedef unsigned u32x4 __attribute__((ext_vector_type(4)));
typedef unsigned u32x2 __attribute__((ext_vector_type(2)));

constexpr int D = 1024, BATCH = 8, SEQ = 2048, DEPTH = 4, M = BATCH * SEQ;
constexpr int IN_COLS = 3592, IN_PAD = 3840, PROJ_W = 3584;
constexpr int NEXP = 16384;
constexpr float EPS = 1e-6f;
constexpr float QSCALE = 0.125f * 1.4426950408889634f;
constexpr int NWAVES = 8, NTHREADS = 512;
constexpr int LDS_BYTES = 163840;
constexpr int LDS_MISC_OFF = LDS_BYTES - 256;
constexpr int RS_OFF = 147456;
constexpr int CW_QUEUE = 1024;

constexpr size_t MiB = 1u << 20;
constexpr size_t WS_CTL = 0, CTL_ZERO_BYTES = 1 * MiB;
constexpr size_t WS_H = 1 * MiB;
constexpr size_t WS_HB0 = 65 * MiB;
constexpr size_t WS_HB1 = 97 * MiB;
constexpr size_t WS_HB2 = 129 * MiB;
constexpr size_t WS_PROJ = 161 * MiB;
constexpr size_t WS_BA = 273 * MiB;
constexpr size_t WS_OBUF = 274 * MiB;
constexpr size_t WS_Q2 = 306 * MiB;
constexpr size_t WS_EPRE = 370 * MiB;
constexpr size_t WS_IDX = 402 * MiB;
constexpr size_t WS_GATE = 410 * MiB;
constexpr size_t WS_STAT = 418 * MiB;
constexpr size_t WS_SS1 = WS_IDX + 1 * MiB, WS_SSE = WS_IDX;
constexpr size_t WS_ORAW = 422 * MiB;
constexpr size_t WS_WIN = 550 * MiB;
constexpr size_t WS_WOUT = 582 * MiB;
constexpr size_t WS_WQ = 590 * MiB;
constexpr size_t WS_WG = 606 * MiB;
constexpr size_t WS_WP = 614 * MiB;
constexpr size_t WS_SK = 616 * MiB;
constexpr size_t WS_PB = 618 * MiB;
constexpr size_t WS_U = 650 * MiB;
constexpr size_t WS_V = 778 * MiB;
constexpr size_t WS_SU = WS_STAT + 1 * MiB, WS_SV = WS_STAT + 2 * MiB;
constexpr size_t WS_END = 906 * MiB;

struct Params {
    const float *x, *p, *ln_mix_g, *w_in, *conv_w, *a_log, *dt_bias, *gdn_norm_g, *diff_lambda, *subln_g, *w_out, *ln_ffn_g,
        *peer_wq, *subkeys, *peer_u, *peer_v, *ple_wp, *ple_wg, *ple_norm_g, *final_g;
    float* out;
    unsigned char* ws;
    int pad0, pad1;
};

__device__ __forceinline__ int tidx() { int t = (int)threadIdx.x; asm volatile("" : "+v"(t)); return t; }
#define LDS_BARRIER() asm volatile("s_waitcnt lgkmcnt(0)\n\ts_barrier" ::: "memory")
__device__ __forceinline__ float bf2f(bf16 v) { return __uint_as_float((unsigned)v << 16); }
__device__ __forceinline__ unsigned f2bf(float f);
typedef __bf16 bf16x2_t __attribute__((ext_vector_type(2)));
typedef float f32x2_t __attribute__((ext_vector_type(2)));
__device__ __forceinline__ unsigned cvtpk(float lo, float hi) { f32x2_t v = {lo, hi}; bf16x2_t b = __builtin_convertvector(v, bf16x2_t); return __builtin_bit_cast(unsigned, b); }
__device__ __forceinline__ unsigned pk2(float lo, float hi) { return cvtpk(lo, hi); }
__device__ __forceinline__ unsigned f2bf(float f) { return cvtpk(f, 0.f) & 0xffffu; }
__device__ __forceinline__ float lo16(unsigned w) { return __uint_as_float(w << 16); }
__device__ __forceinline__ float hi16(unsigned w) { return __uint_as_float(w & 0xffff0000u); }
template <int N> __device__ __forceinline__ float dpp_ror(float x) { return __builtin_bit_cast(float, __builtin_amdgcn_mov_dpp(__builtin_bit_cast(int, x), 0x120 + N, 0xf, 0xf, true)); }
template <int N> __device__ __forceinline__ unsigned dpp_ror_u(unsigned x) { return (unsigned)__builtin_amdgcn_mov_dpp((int)x, 0x120 + N, 0xf, 0xf, true); }
__device__ __forceinline__ float row16_sum(float x) { x += dpp_ror<8>(x); x += dpp_ror<4>(x); x += dpp_ror<2>(x); x += dpp_ror<1>(x); return x; }
__device__ __forceinline__ float row16_max(float x) { x = fmaxf(x, dpp_ror<8>(x)); x = fmaxf(x, dpp_ror<4>(x)); x = fmaxf(x, dpp_ror<2>(x)); x = fmaxf(x, dpp_ror<1>(x)); return x; }
__device__ __forceinline__ unsigned row16_umax(unsigned x) { unsigned y;
    y = dpp_ror_u<8>(x); x = x > y ? x : y; y = dpp_ror_u<4>(x); x = x > y ? x : y; y = dpp_ror_u<2>(x); x = x > y ? x : y; y = dpp_ror_u<1>(x); x = x > y ? x : y; return x; }
__device__ __forceinline__ float xrow16_max(float x) {
    auto s = __builtin_amdgcn_permlane16_swap(__float_as_uint(x), __float_as_uint(x), false, false);
    x = fmaxf(__uint_as_float(s[0]), __uint_as_float(s[1]));
    auto t = __builtin_amdgcn_permlane32_swap(__float_as_uint(x), __float_as_uint(x), false, false);
    return fmaxf(__uint_as_float(t[0]), __uint_as_float(t[1]));
}
__device__ __forceinline__ float xrow16_sum(float x) {
    auto s = __builtin_amdgcn_permlane16_swap(__float_as_uint(x), __float_as_uint(x), false, false);
    x = __uint_as_float(s[0]) + __uint_as_float(s[1]);
    auto t = __builtin_amdgcn_permlane32_swap(__float_as_uint(x), __float_as_uint(x), false, false);
    return __uint_as_float(t[0]) + __uint_as_float(t[1]);
}
__device__ __forceinline__ float wave_sum(float v) { return xrow16_sum(row16_sum(v)); }
template <int N> __device__ __forceinline__ int dpp_ror_i(int x) { return __builtin_amdgcn_mov_dpp(x, 0x120 + N, 0xf, 0xf, true); }
__device__ __forceinline__ int wave_isum(int x) {
    x += dpp_ror_i<8>(x); x += dpp_ror_i<4>(x); x += dpp_ror_i<2>(x); x += dpp_ror_i<1>(x);
    auto s = __builtin_amdgcn_permlane16_swap((unsigned)x, (unsigned)x, false, false); x = (int)(s[0] + s[1]);
    auto t = __builtin_amdgcn_permlane32_swap((unsigned)x, (unsigned)x, false, false); return (int)(t[0] + t[1]);
}
__device__ __forceinline__ float wave_max(float v) {
#pragma unroll
    for (int o = 32; o; o >>= 1) v = fmaxf(v, __shfl_xor(v, o));
    return v;
}
__device__ __forceinline__ float sigmoidf_(float x) { return __builtin_amdgcn_rcpf(1.f + __expf(-x)); }
__device__ __forceinline__ float dot8(u32x4 a, u32x4 b, float s) {
#pragma unroll
    for (int i = 0; i < 4; ++i) { s += lo16(a[i]) * lo16(b[i]); s += hi16(a[i]) * hi16(b[i]); }
    return s;
}

__host__ __device__ __forceinline__ int lds_byte(int r, int c) { const int st = (r >> 4) * 2 + (c >> 5), rr = r & 15, cc = c & 31, ob = rr * 64 + cc * 2; return st * 1024 + (ob ^ (((ob >> 9) & 1) << 5)); }
__host__ __device__ __forceinline__ void stage_rc(int b, int& R, int& C) { const int st = b / 1024, sb = b % 1024, swz = sb ^ (((sb >> 9) & 1) << 5); R = (st >> 1) * 16 + swz / 64; C = (st & 1) * 32 + (swz % 64) / 2; }
constexpr int HTB = 16384;
template <class F>
__device__ __forceinline__ void gemm_run(LAS unsigned char* lds, const bf16* A, const bf16* Bt, int Mm, int N, int K, const F& f, int bid, int nblk, const float* slots_in = nullptr) {
    LAS float* RS = (LAS float*)(lds + RS_OFF);
    int rs_pm = -1;
    const int tid = tidx(), wid = __builtin_amdgcn_readfirstlane(tid >> 6), lane = tid & 63, wr = wid >> 2, wc = wid & 3, fr = lane & 15, fq = lane >> 4;
    const int nt = K / 64, ntn = N / 256, nunits = (Mm / 256) * ntn;
    unsigned voff[2];
#pragma unroll
    for (int i = 0; i < 2; ++i) { const int uu = tid + 512 * i, r = uu >> 3, c = (uu & 7) ^ ((r >> 1) & 7); voff[i] = (unsigned)(r * K + c * 8) * 2u; }
    const unsigned ldsw = (unsigned)wid * 1024u;
    const int sw7 = (fr >> 1) & 7;
    const int aoff0 = wr * HTB + fr * 128 + ((fq ^ sw7) << 4), aoff1 = wr * HTB + fr * 128 + (((4 + fq) ^ sw7) << 4);
    const int bbase = (2 + (wc >> 1)) * HTB + (wc & 1) * 8192 + fr * 128;
    const int boff0 = bbase + ((fq ^ sw7) << 4), boff1 = bbase + (((4 + fq) ^ sw7) << 4);
#define G_STAGE(bufoff, gbase) do { _Pragma("unroll") for (int _i = 0; _i < 2; ++_i) \
        __builtin_amdgcn_global_load_lds((const unsigned*)((const char*)(gbase) + voff[_i]), (LAS unsigned*)(lds + (bufoff) + ldsw + _i * 8192), 16, 0, 0); } while (0)
    for (int u = bid; u < nunits; u += nblk) {
        const int pm = u % (Mm / 256), pn = u / (Mm / 256);
        if (slots_in && pm != rs_pm) {
            __syncthreads();
            if (tid < 256) { const f32x4* sp = (const f32x4*)(slots_in + ((size_t)pm * 256 + tid) * 16);
                const f32x4 a = sp[0], b = sp[1], c = sp[2], d = sp[3];
                const float s = (((a[0] + a[1]) + (a[2] + a[3])) + ((b[0] + b[1]) + (b[2] + b[3]))) + (((c[0] + c[1]) + (c[2] + c[3])) + ((d[0] + d[1]) + (d[2] + d[3])));
                RS[tid] = rsqrtf(s * (1.f / D) + EPS); }
            __syncthreads();
            rs_pm = pm;
        }
        const char* gA = (const char*)(A + (size_t)pm * 256 * K);
        const char* gB = (const char*)(Bt + (size_t)pn * 256 * K);
        const size_t hstep = (size_t)128 * K * 2;
        f32x4 acc[8][4];
#pragma unroll
        for (int a = 0; a < 8; ++a)
#pragma unroll
            for (int b = 0; b < 4; ++b) acc[a][b] = (f32x4){0.f, 0.f, 0.f, 0.f};
        G_STAGE(0, gA); G_STAGE(HTB, gA + hstep); G_STAGE(2 * HTB, gB); G_STAGE(3 * HTB, gB + hstep);
        for (int t = 0; t < nt; ++t) {
            const int cb = (t & 1) * 4 * HTB, nb = ((t + 1) & 1) * 4 * HTB;
            asm volatile("s_waitcnt vmcnt(0)" ::: "memory");
            __builtin_amdgcn_s_barrier();
            asm volatile("" ::: "memory");
            const size_t ko = (size_t)(t + 1) * 128; const bool more = t + 1 < nt;
#pragma unroll
            for (int k = 0; k < 2; ++k) {
                if (more) { if (k == 0) { G_STAGE(nb, gA + ko); G_STAGE(nb + 2 * HTB, gB + ko); } else { G_STAGE(nb + HTB, gA + hstep + ko); G_STAGE(nb + 3 * HTB, gB + hstep + ko); } }
                bf16x8 bfr[4], acur, anxt;
#pragma unroll
                for (int n = 0; n < 4; ++n) bfr[n] = *(const LAS bf16x8*)(lds + cb + (k ? boff1 : boff0) + n * 2048);
                acur = *(const LAS bf16x8*)(lds + cb + (k ? aoff1 : aoff0));
#pragma unroll
                for (int m = 0; m < 8; ++m) {
                    if (m < 7) anxt = *(const LAS bf16x8*)(lds + cb + (k ? aoff1 : aoff0) + (m + 1) * 2048);
#pragma unroll
                    for (int n = 0; n < 4; ++n) acc[m][n] = __builtin_amdgcn_mfma_f32_16x16x32_bf16(bfr[n], acur, acc[m][n], 0, 0, 0);
                    acur = anxt;
                }
                __builtin_amdgcn_sched_barrier(0);
            }
            asm volatile("s_waitcnt lgkmcnt(0)" ::: "memory");
        }
        {
            int el = lane; asm volatile("" : "+v"(el));
            const int efr = el & 15, efq = el >> 4;
            LAS float* et = (LAS float*)(lds + wid * 4352);
            const int ecol = pn * 256 + wc * 64 + 4 * efr;
            typename F::Pre pq[4];
            if constexpr (F::PRE) {
#pragma unroll
                for (int i = 0; i < 4; ++i) pq[i] = f.pre(pm * 256 + wr * 128 + 4 * i + efq, ecol);
            }
#pragma unroll
            for (int m = 0; m < 8; ++m) {
#pragma unroll
                for (int n = 0; n < 4; ++n) *(LAS f32x4*)(et + efr * 68 + n * 16 + 4 * efq) = acc[m][n];
                typename F::Pre pnx[4];
                if constexpr (F::PRE) {
                    if (m < 7) {
#pragma unroll
                        for (int i = 0; i < 4; ++i) pnx[i] = f.pre(pm * 256 + wr * 128 + (m + 1) * 16 + 4 * i + efq, ecol);
                    }
                }
                asm volatile("s_waitcnt lgkmcnt(0)" ::: "memory");
#pragma unroll
                for (int i = 0; i < 4; ++i) {
                    const int lrow = wr * 128 + m * 16 + 4 * i + efq, row = pm * 256 + lrow;
                    const f32x4 v = *(const LAS f32x4*)(et + (4 * i + efq) * 68 + 4 * efr);
                    f32x4 r;
                    if constexpr (F::PRE) r = f(row, RS[lrow], ecol, v, pq[i]); else r = f(row, RS[lrow], ecol, v);
                    if constexpr (F::STATS) { const float ssq = row16_sum((r[0] * r[0] + r[1] * r[1]) + (r[2] * r[2] + r[3] * r[3])); if (efr == 0) f.slots[(size_t)row * 16 + pn * 4 + wc] = ssq; }
                }
                if constexpr (F::PRE) {
                    if (m < 7) {
#pragma unroll
                        for (int i = 0; i < 4; ++i) pq[i] = pnx[i];
                    }
                }
                asm volatile("s_waitcnt lgkmcnt(0)" ::: "memory");
                __builtin_amdgcn_sched_barrier(0);
            }
        }
        __syncthreads();
    }
#undef G_STAGE
}

__device__ __forceinline__ u32x2 pk4(f32x4 a) { u32x2 o; o.x = pk2(a[0], a[1]); o.y = pk2(a[2], a[3]); return o; }
struct NoPre {};
struct EpiProj {
    static constexpr bool STATS = false, PRE = false; typedef NoPre Pre; float* slots;
    bf16* proj; float* ba;
    __device__ __forceinline__ f32x4 operator()(int row, float rstd, int col, f32x4 v) const {
        v = v * rstd;
        if (col < PROJ_W) *(u32x2*)(proj + (size_t)row * PROJ_W + col) = pk4(v);
        else if (col < IN_COLS) *(f32x4*)(ba + (size_t)row * 8 + (col - PROJ_W)) = v;
        return v;
    }
};
struct EpiRes {
    static constexpr bool STATS = true, PRE = true; float* slots;
    float* H; bf16* HB; const float* Hin;
    struct Pre { f32x4 h; };
    __device__ __forceinline__ Pre pre(int row, int col) const { Pre q; q.h = *(const f32x4*)(Hin + (size_t)row * D + col); return q; }
    __device__ __forceinline__ f32x4 operator()(int row, float, int col, f32x4 v, const Pre& q) const {
        const f32x4 h = q.h + v; *(f32x4*)(H + (size_t)row * D + col) = h;
        *(u32x2*)(HB + (size_t)row * D + col) = pk4(h);
        return h;
    }
};
struct EpiQ2 {
    static constexpr bool STATS = false, PRE = false; typedef NoPre Pre; float* slots;
    bf16* Q2;
    __device__ __forceinline__ f32x4 operator()(int row, float rstd, int col, f32x4 v) const { v = v * rstd; *(u32x2*)(Q2 + (size_t)row * 2048 + col) = pk4(v); return v; }
};
struct EpiE {
    static constexpr bool STATS = true, PRE = false; typedef NoPre Pre; float* slots;
    bf16* E;
    __device__ __forceinline__ f32x4 operator()(int row, float, int col, f32x4 v) const { *(u32x2*)(E + (size_t)row * D + col) = pk4(v); return v; }
};
struct EpiPle {
    static constexpr bool STATS = true, PRE = true; float* slots;
    float* H; bf16* HB; const bf16* E; const float* g;
    struct Pre { f32x4 h; u32x2 ev; };
    __device__ __forceinline__ Pre pre(int row, int col) const { Pre q; q.h = *(const f32x4*)(H + (size_t)row * D + col); q.ev = *(const u32x2*)(E + (size_t)row * D + col); return q; }
    __device__ __forceinline__ f32x4 operator()(int row, float rstde, int col, f32x4 v, const Pre& q) const {
        const u32x2 ev = q.ev;
        const f32x4 gv = *(const f32x4*)(g + col);
        f32x4 h = q.h;
        h[0] += sigmoidf_(v[0]) * (lo16(ev.x) * rstde * gv[0]); h[1] += sigmoidf_(v[1]) * (hi16(ev.x) * rstde * gv[1]);
        h[2] += sigmoidf_(v[2]) * (lo16(ev.y) * rstde * gv[2]); h[3] += sigmoidf_(v[3]) * (hi16(ev.y) * rstde * gv[3]);
        *(f32x4*)(H + (size_t)row * D + col) = h;
        *(u32x2*)(HB + (size_t)row * D + col) = pk4(h);
        return h;
    }
};

__device__ __forceinline__ void transpose_item(const float* W, int K, int N, int Npad, bf16* WT, const float* rowscale, int qcols, float* scr, int item, int lane) {
    const int nblk = Npad / 32, kb = item / nblk, nb = item % nblk, k0 = 64 * kb, n0 = 32 * nb;
    const int nq = n0 + 4 * (lane & 7);
#pragma unroll
    for (int i = 0; i < 8; ++i) {
        const int kk = 8 * i + (lane >> 3);
        f32x4 v = (nq < N) ? *(const f32x4*)(W + (size_t)(k0 + kk) * N + nq) : (f32x4){0.f, 0.f, 0.f, 0.f};
        if (rowscale) v = v * rowscale[k0 + kk];
        if (nq < qcols) v = v * QSCALE;
        scr[kk * 33 + 4 * (lane & 7)] = v[0]; scr[kk * 33 + 4 * (lane & 7) + 1] = v[1]; scr[kk * 33 + 4 * (lane & 7) + 2] = v[2]; scr[kk * 33 + 4 * (lane & 7) + 3] = v[3];
    }
    asm volatile("s_waitcnt lgkmcnt(0)" ::: "memory");
    const int c = lane & 7;
#pragma unroll
    for (int j = 0; j < 4; ++j) {
        const int nn = (lane >> 3) + 8 * j; const float* s = scr + (8 * c) * 33 + nn;
        u32x4 o; o.x = pk2(s[0 * 33], s[1 * 33]); o.y = pk2(s[2 * 33], s[3 * 33]); o.z = pk2(s[4 * 33], s[5 * 33]); o.w = pk2(s[6 * 33], s[7 * 33]);
        *(u32x4*)(WT + (size_t)(n0 + nn) * K + k0 + 8 * c) = o;
    }
    asm volatile("s_waitcnt lgkmcnt(0)" ::: "memory");
}
__device__ __forceinline__ void convert_bulk(const float* src, bf16* dst, size_t n, size_t gtid, size_t nthr) {
    for (size_t i = gtid * 8; i < n; i += nthr * 8) {
        const f32x4 a = *(const f32x4*)(src + i), b = *(const f32x4*)(src + i + 4);
        u32x4 o; o.x = pk2(a[0], a[1]); o.y = pk2(a[2], a[3]); o.z = pk2(b[0], b[1]); o.w = pk2(b[2], b[3]);
        *(u32x4*)(dst + i) = o;
    }
}
__device__ void phase_prologue(const Params& p, LAS unsigned char* lds_, int bid, int nblk) {
    unsigned char* lds = (unsigned char*)lds_;
    const int tid = tidx(), lane = tid & 63, w = tid >> 6;
    const int gw = bid * NWAVES + w, NGW = nblk * NWAVES;
    float* scr = (float*)(lds + w * 16384);
    constexpr int I_IN = 16 * (IN_PAD / 32), I_OUT = 16 * 32, I_Q = 16 * 64, I_G = 16 * 32, I_P = 4 * 32, I_L = I_IN + I_OUT + I_Q + I_G + I_P;
    for (int it = gw; it < DEPTH * I_L; it += NGW) {
        const int L = it / I_L; int r = it % I_L;
        if (r < I_IN) { transpose_item(p.w_in + (size_t)L * D * IN_COLS, D, IN_COLS, IN_PAD, (bf16*)(p.ws + WS_WIN) + (size_t)L * IN_PAD * D, p.ln_mix_g + L * D, 512, scr, r, lane); continue; } r -= I_IN;
        if (r < I_OUT) { transpose_item(p.w_out + (size_t)L * D * D, D, D, D, (bf16*)(p.ws + WS_WOUT) + (size_t)L * D * D, nullptr, 0, scr, r, lane); continue; } r -= I_OUT;
        if (r < I_Q) { transpose_item(p.peer_wq + (size_t)L * D * 2048, D, 2048, 2048, (bf16*)(p.ws + WS_WQ) + (size_t)L * 2048 * D, p.ln_ffn_g + L * D, 0, scr, r, lane); continue; } r -= I_Q;
        if (r < I_G) { transpose_item(p.ple_wg + (size_t)L * D * D, D, D, D, (bf16*)(p.ws + WS_WG) + (size_t)L * D * D, nullptr, 0, scr, r, lane); continue; } r -= I_G;
        transpose_item(p.ple_wp + (size_t)L * 256 * D, 256, D, D, (bf16*)(p.ws + WS_WP) + (size_t)L * D * 256, nullptr, 0, scr, r, lane);
    }
    const size_t gtid = (size_t)bid * NTHREADS + tid, nthr = (size_t)nblk * NTHREADS;
    for (int r = gw; r < 2 * DEPTH * NEXP; r += NGW) {
        const int which = r >= DEPTH * NEXP, rr = which ? r - DEPTH * NEXP : r;
        const float* srow = (which ? p.peer_v : p.peer_u) + (size_t)rr * D + 4 * lane;
        f32x4 v[4];
#pragma unroll
        for (int j = 0; j < 4; ++j) v[j] = *(const f32x4*)(srow + 256 * j);
        float mx = 0.f;
#pragma unroll
        for (int j = 0; j < 4; ++j) mx = fmaxf(mx, fmaxf(fmaxf(fabsf(v[j][0]), fabsf(v[j][1])), fmaxf(fabsf(v[j][2]), fabsf(v[j][3]))));
        mx = xrow16_max(row16_max(mx));
        const float inv = mx > 0.f ? 127.f / mx : 0.f;
        u32x4 o;
#pragma unroll
        for (int j = 0; j < 4; ++j) {
            const unsigned b0 = (unsigned)__float2int_rn(v[j][0] * inv) & 0xffu, b1 = (unsigned)__float2int_rn(v[j][1] * inv) & 0xffu, b2 = (unsigned)__float2int_rn(v[j][2] * inv) & 0xffu, b3 = (unsigned)__float2int_rn(v[j][3] * inv) & 0xffu;
            o[j] = b0 | (b1 << 8) | (b2 << 16) | (b3 << 24);
        }
        *(u32x4*)(p.ws + (which ? WS_V : WS_U) + (size_t)rr * D + 16 * lane) = o;
        if (lane == 0) ((float*)(p.ws + (which ? WS_SV : WS_SU)))[rr] = mx * (1.f / 127.f);
    }
    convert_bulk(p.p, (bf16*)(p.ws + WS_PB), (size_t)DEPTH * M * 256, gtid, nthr);
    convert_bulk(p.subkeys, (bf16*)(p.ws + WS_SK), (size_t)DEPTH * 8 * 2 * 128 * 128, gtid, nthr);
    float* H = (float*)(p.ws + WS_H); bf16* HB0 = (bf16*)(p.ws + WS_HB0); float* ss0 = (float*)(p.ws + WS_STAT);
    for (int m = gw; m < M; m += NGW) {
        const f32x4* xr = (const f32x4*)(p.x + (size_t)m * D) + lane;
        float ss = 0.f;
#pragma unroll
        for (int j = 0; j < 4; ++j) {
            const f32x4 v = xr[64 * j];
            ss += v[0] * v[0] + v[1] * v[1] + v[2] * v[2] + v[3] * v[3];
            u32x2 o; o.x = pk2(v[0], v[1]); o.y = pk2(v[2], v[3]);
            ((u32x2*)(HB0 + (size_t)m * D))[lane + 64 * j] = o;
        }
        ss = wave_sum(ss);
        if (lane < 16) ss0[(size_t)m * 16 + lane] = lane == 0 ? ss : 0.f;
    }
}

typedef short v4i16_t __attribute__((ext_vector_type(4)));
__device__ __forceinline__ void glds16_asm(const void* gsrc, unsigned lds_dst) {
    unsigned keep;
    asm volatile("s_mov_b32 %0, m0\n\ts_mov_b32 m0, %2\n\ts_nop 0\n\tglobal_load_lds_dwordx4 %1, off\n\ts_mov_b32 m0, %0" : "=&s"(keep) : "v"(gsrc), "s"(lds_dst) : "memory");
}
__device__ __forceinline__ float max3_(float a, float b, float c) { float r; asm("v_max3_f32 %0, %1, %2, %3" : "=v"(r) : "v"(a), "v"(b), "v"(c)); return r; }
constexpr int ATT_BUF = 32768, ATT_VOFF = 16384;
__device__ __forceinline__ void att_unit(const Params& p, int L, LAS unsigned char* lds, int tid, int b, int hh, int qb, float lam, float lam_init) {
    const int lane = tid & 63, w = __builtin_amdgcn_readfirstlane(tid >> 6), fr = lane & 15, fq = lane >> 4;
    const bool grpB = w >= 4;
    const bf16* proj = (const bf16*)(p.ws + WS_PROJ);
    bf16* obuf = (bf16*)(p.ws + WS_OBUF);
    const float slope2 = 1.4426950408889634f / (float)(1 << (2 * (hh + 1)));
    const bf16* kbase = proj + (size_t)b * SEQ * PROJ_W + 512 + hh * 128;
    const bf16* vbase = proj + (size_t)b * SEQ * PROJ_W + 1024 + hh * 128;
    const int qw0 = qb * 128 + w * 16, T = 2 * (qb + 1);
    const int S_w = ((qw0 + 15) >> 6) + 1;
    bf16x8 qf[2][2];
#pragma unroll
    for (int mp = 0; mp < 2; ++mp)
#pragma unroll
        for (int ks = 0; ks < 2; ++ks) qf[mp][ks] = *(const bf16x8*)(proj + ((size_t)b * SEQ + qw0 + fr) * PROJ_W + hh * 128 + mp * 64 + ks * 32 + 8 * fq);
    f32x4 o[2][8];
#pragma unroll
    for (int mp = 0; mp < 2; ++mp)
#pragma unroll
        for (int dt = 0; dt < 8; ++dt) o[mp][dt] = (f32x4){0.f, 0.f, 0.f, 0.f};
    float mrun[2] = {-INFINITY, -INFINITY}, lrun[2] = {0.f, 0.f};
    int ksrc[2], vsrc[2];
#pragma unroll
    for (int i = 0; i < 2; ++i) { const int pc = tid + 512 * i, key = pc >> 4, ph = pc & 15;
        ksrc[i] = key * PROJ_W + ((ph ^ (key & 15)) * 8); vsrc[i] = key * PROJ_W + ((ph ^ ((key & 7) << 1)) * 8); }
    const unsigned ldsb = (unsigned)(size_t)lds;
    auto dma = [&](int t, int bo) {
#pragma unroll
        for (int i = 0; i < 2; ++i) {
            glds16_asm(kbase + (size_t)t * 64 * PROJ_W + ksrc[i], ldsb + bo + (w * 64 + 512 * i) * 16);
            glds16_asm(vbase + (size_t)t * 64 * PROJ_W + vsrc[i], ldsb + bo + ATT_VOFF + (w * 64 + 512 * i) * 16);
        }
    };
    int koff[2][2];
#pragma unroll
    for (int mp = 0; mp < 2; ++mp)
#pragma unroll
        for (int ks = 0; ks < 2; ++ks) koff[mp][ks] = fr * 256 + (((mp * 8 + ks * 4 + fq) ^ fr) << 4);
    const int gl = lane & 15;
    const int vrd0 = ATT_VOFF + (4 * fq + (gl >> 2)) * 256 + (gl & 3) * 8 + ((4 * (fq & 1) + (gl >> 2)) << 5);
    bf16x8 pb[2][2];
#pragma unroll
    for (int mp = 0; mp < 2; ++mp)
#pragma unroll
        for (int ks = 0; ks < 2; ++ks) pb[mp][ks] = qf[0][0];
#define ATT_SB() __builtin_amdgcn_sched_barrier(0)
#define ATT_VRD(dt) do { _Pragma("unroll") for (int q_ = 0; q_ < 4; ++q_) vf_[dt][q_] = __builtin_amdgcn_ds_read_tr16_b64_v4i16((LAS v4i16_t*)(lds + ((vb_ ^ ((dt) << 5)) + q_ * 4096))); } while (0)
#define ATT_VMM(PB, dt) do { _Pragma("unroll") for (int ks = 0; ks < 2; ++ks) { const v4i16_t v0 = vf_[dt][2 * ks], v1 = vf_[dt][2 * ks + 1]; \
            bf16x8 vf; vf[0] = v0[0]; vf[1] = v0[1]; vf[2] = v0[2]; vf[3] = v0[3]; vf[4] = v1[0]; vf[5] = v1[1]; vf[6] = v1[2]; vf[7] = v1[3]; \
            o[0][dt] = __builtin_amdgcn_mfma_f32_16x16x32_bf16(vf, PB[0][ks], o[0][dt], 0, 0, 0); \
            o[1][dt] = __builtin_amdgcn_mfma_f32_16x16x32_bf16(vf, PB[1][ks], o[1][dt], 0, 0, 0); } } while (0)
#define ATT_PV(PB, BO) do { const int vb_ = (BO) + vrd0; v4i16_t vf_[8][4]; \
        ATT_VRD(0); ATT_VRD(1); ATT_VRD(2); ATT_VRD(3); ATT_SB(); \
        ATT_VMM(PB, 0); ATT_VRD(4); ATT_SB(); ATT_VMM(PB, 1); ATT_VRD(5); ATT_SB(); ATT_VMM(PB, 2); ATT_VRD(6); ATT_SB(); ATT_VMM(PB, 3); ATT_VRD(7); ATT_SB(); \
        ATT_VMM(PB, 4); ATT_VMM(PB, 5); ATT_VMM(PB, 6); ATT_VMM(PB, 7); ATT_SB(); } while (0)
    dma(0, 0);
    asm volatile("" :: "v"(qf[0][0]), "v"(qf[0][1]), "v"(qf[1][0]), "v"(qf[1][1]));
    int bo_prev = 2 * ATT_BUF, bo_cur = 0, bo_next = ATT_BUF;
    for (int s = 0; s < T; ++s) {
        const int k0 = s * 64;
        asm volatile("s_waitcnt vmcnt(0)" ::: "memory");
        LDS_BARRIER();
        if (s + 1 < T) dma(s + 1, bo_next);
        if (grpB && s > 0 && s <= S_w) ATT_PV(pb, bo_prev);
        if (s < S_w) {
            f32x4 sc[2][4];
            const float base = -slope2 * (float)(qw0 + fr - k0 - 4 * fq);
#pragma unroll
            for (int kt = 0; kt < 4; ++kt)
#pragma unroll
                for (int r = 0; r < 4; ++r) { const float v = base + slope2 * (float)(16 * kt + r); sc[0][kt][r] = v; sc[1][kt][r] = v; }
            {
                bf16x8 kf[4][2][2];
#define ATT_KRD(kt) do { _Pragma("unroll") for (int mp = 0; mp < 2; ++mp) _Pragma("unroll") for (int ks = 0; ks < 2; ++ks) kf[kt][mp][ks] = *(const LAS bf16x8*)(lds + bo_cur + (kt) * 4096 + koff[mp][ks]); } while (0)
#define ATT_KMM(kt) do { _Pragma("unroll") for (int ks = 0; ks < 2; ++ks) _Pragma("unroll") for (int mp = 0; mp < 2; ++mp) sc[mp][kt] = __builtin_amdgcn_mfma_f32_16x16x32_bf16(kf[kt][mp][ks], qf[mp][ks], sc[mp][kt], 0, 0, 0); } while (0)
                ATT_KRD(0); ATT_KRD(1); ATT_SB();
                ATT_KMM(0); ATT_KRD(2); ATT_SB();
                ATT_KMM(1); ATT_KRD(3); ATT_SB();
                ATT_KMM(2); ATT_KMM(3); ATT_SB();
#undef ATT_KRD
#undef ATT_KMM
            }
            if (k0 + 63 > qw0) {
                const int lim = qw0 + fr - k0 - 4 * fq;
#pragma unroll
                for (int mp = 0; mp < 2; ++mp)
#pragma unroll
                    for (int kt = 0; kt < 4; ++kt)
#pragma unroll
                        for (int r = 0; r < 4; ++r) if (16 * kt + r > lim) sc[mp][kt][r] = -INFINITY;
            }
#pragma unroll
            for (int mp = 0; mp < 2; ++mp) {
                float mx = max3_(sc[mp][0][0], sc[mp][0][1], sc[mp][0][2]);
                mx = max3_(mx, sc[mp][0][3], sc[mp][1][0]);
#pragma unroll
                for (int kt = 1; kt < 4; ++kt) { mx = max3_(mx, sc[mp][kt][1], sc[mp][kt][2]); if (kt < 3) mx = max3_(mx, sc[mp][kt][3], sc[mp][kt + 1][0]); else mx = max3_(mx, sc[mp][kt][3], mx); }
                mx = xrow16_max(mx);
                const float mnew = fmaxf(mrun[mp], mx);
                const float alpha = __builtin_amdgcn_exp2f(mrun[mp] - mnew);
                mrun[mp] = mnew;
                float ps = 0.f;
#pragma unroll
                for (int kt = 0; kt < 4; ++kt)
#pragma unroll
                    for (int r = 0; r < 4; ++r) { const float e = __builtin_amdgcn_exp2f(sc[mp][kt][r] - mnew); sc[mp][kt][r] = e; ps += e; }
                lrun[mp] = lrun[mp] * alpha + ps;
#pragma unroll
                for (int ks = 0; ks < 2; ++ks) {
                    u32x4 pk; pk.x = cvtpk(sc[mp][2 * ks][0], sc[mp][2 * ks][1]); pk.y = cvtpk(sc[mp][2 * ks][2], sc[mp][2 * ks][3]);
                    pk.z = cvtpk(sc[mp][2 * ks + 1][0], sc[mp][2 * ks + 1][1]); pk.w = cvtpk(sc[mp][2 * ks + 1][2], sc[mp][2 * ks + 1][3]);
                    pb[mp][ks] = __builtin_bit_cast(bf16x8, pk);
                }
#pragma unroll
                for (int dt = 0; dt < 8; ++dt) o[mp][dt] = o[mp][dt] * alpha;
            }
            if (!grpB) ATT_PV(pb, bo_cur);
        }
        const int tb = bo_prev; bo_prev = bo_cur; bo_cur = bo_next; bo_next = tb;
    }
    if (grpB && S_w == T) ATT_PV(pb, bo_prev);
#undef ATT_PV
#undef ATT_VRD
#undef ATT_VMM
#undef ATT_SB
    const float i1 = __builtin_amdgcn_rcpf(xrow16_sum(lrun[0])), i2 = lam * __builtin_amdgcn_rcpf(xrow16_sum(lrun[1]));
    float ss = 0.f;
#pragma unroll
    for (int dt = 0; dt < 8; ++dt)
#pragma unroll
        for (int r = 0; r < 4; ++r) { const float v = o[0][dt][r] * i1 - o[1][dt][r] * i2; o[0][dt][r] = v; ss += v * v; }
    ss = xrow16_sum(ss);
    const float rn = rsqrtf(ss * (1.f / 128.f) + EPS) * (1.f - lam_init);
    const float* g = p.subln_g + L * 128;
    bf16* orow = obuf + ((size_t)b * SEQ + qw0 + fr) * D + hh * 128;
#pragma unroll
    for (int dt = 0; dt < 8; ++dt) {
        const f32x4 gv = *(const f32x4*)(g + 16 * dt + 4 * fq);
        u32x2 ov; ov.x = pk2(o[0][dt][0] * rn * gv[0], o[0][dt][1] * rn * gv[1]); ov.y = pk2(o[0][dt][2] * rn * gv[2], o[0][dt][3] * rn * gv[3]);
        *(u32x2*)(orow + 16 * dt + 4 * fq) = ov;
    }
}

__device__ void phase_att_queue(const Params& p, int L, LAS unsigned char* lds, int bid, int nblk) {
    const int tid = tidx(), lane = tid & 63;
    const float* lp = p.diff_lambda + L * 256;
    const float d1 = wave_sum(lp[lane] * lp[64 + lane]), d2 = wave_sum(lp[128 + lane] * lp[192 + lane]);
    const float lam_init = 0.8f - 0.6f * __expf(-0.3f * (float)L);
    const float lam = __expf(d1) - __expf(d2) + lam_init;
    unsigned* head = (unsigned*)(p.ws + WS_CTL) + CW_QUEUE + L;
    volatile LAS int* slot = (volatile LAS int*)(lds + LDS_MISC_OFF + 64);
    for (;;) {
        __syncthreads();
        if (tid == 0) *slot = (int)__hip_atomic_fetch_add(head, 1u, __ATOMIC_RELAXED, __HIP_MEMORY_SCOPE_AGENT);
        __syncthreads();
        const int u = *slot;
        if (u >= 512) break;
        att_unit(p, L, lds, tid, (u & 31) >> 2, u & 3, 15 - (u >> 5), lam, lam_init);
    }
}

constexpr size_t GD_WP = WS_ORAW, GD_QD = WS_ORAW + 16 * MiB, GD_AIP = WS_ORAW + 32 * MiB, GD_KDT = WS_ORAW + 40 * MiB, GD_UT = WS_ORAW + 56 * MiB, GD_GL = WS_ORAW + 72 * MiB;
__device__ __forceinline__ int perm_pos(int k) { return (k & ~31) + 8 * ((k >> 2) & 3) + 4 * ((k >> 4) & 1) + (k & 3); }
__device__ __forceinline__ float softplusf_(float x) { if (x > 20.f) return x; const float e = __expf(x); return e < 0.06f ? e * (1.f - e * (0.5f - e * (0.33333334f - 0.25f * e))) : __logf(1.f + e); }
__device__ __forceinline__ float gelu_erf(float v) {
    const float z = fabsf(v) * 0.70710678118654752f, t = __builtin_amdgcn_rcpf(1.f + 0.3275911f * z);
    const float pl = t * (0.254829592f + t * (-0.284496736f + t * (1.421413741f + t * (-1.453152027f + t * 1.061405429f))));
    const float er = 1.f - pl * __expf(-z * z);
    return 0.5f * v * (1.f + (v < 0.f ? -er : er));
}

constexpr int GP_KN = 0, GP_QN = 17408, GP_RT = 34816, GP_LM = 71680, GP_TB = 89088, GP_GT = 98304, GP_T0T = 99328;
constexpr int GP_KP = 272, GP_RP = 144, GP_LP = 68, GP_TP = 144;
__device__ void phase_gdn_prep(const Params& p, int L, LAS unsigned char* lds, int bid, int nblk) {
    const int tid = tidx(), lane = tid & 63, w = __builtin_amdgcn_readfirstlane(tid >> 6), fr = lane & 15, fq = lane >> 4;
    const bf16* proj = (const bf16*)(p.ws + WS_PROJ);
    const float* BA = (const float*)(p.ws + WS_BA);
    bf16* WP = (bf16*)(p.ws + GD_WP); bf16* QD = (bf16*)(p.ws + GD_QD); bf16* AIP = (bf16*)(p.ws + GD_AIP); bf16* KDT = (bf16*)(p.ws + GD_KDT); bf16* UT = (bf16*)(p.ws + GD_UT);
    float* GL = (float*)(p.ws + GD_GL);
    const float* cw = p.conv_w + (size_t)L * 4 * 1536;
    LAS float* beta_s = (LAS float*)(lds + GP_GT); LAS float* gc_s = beta_s + 64; LAS float* egc_s = gc_s + 64; LAS float* edl_s = egc_s + 64;
    LAS float* Lm = (LAS float*)(lds + GP_LM);
    for (int item = bid; item < 1024; item += nblk) {
        const int n = item & 31, bh = item >> 5, hh = bh & 3, b = bh >> 2, t0 = n * 64;
        const size_t row0 = (size_t)b * SEQ + t0;
        __syncthreads();
        const int colq = hh * 128 + 2 * lane;
        unsigned xq[11], xk[11], xv[11];
#pragma unroll
        for (int r = 0; r < 11; ++r) { const int tt = t0 + 8 * w - 3 + r;
            xq[r] = (tt >= 0) ? *(const unsigned*)(proj + ((size_t)b * SEQ + tt) * PROJ_W + 1536 + colq) : 0u;
            xk[r] = (tt >= 0) ? *(const unsigned*)(proj + ((size_t)b * SEQ + tt) * PROJ_W + 1536 + 512 + colq) : 0u;
            xv[r] = (tt >= 0) ? *(const unsigned*)(proj + ((size_t)b * SEQ + tt) * PROJ_W + 1536 + 1024 + colq) : 0u; }
        if (w == 0) {
            const float negA = -__expf(p.a_log[L * 4 + hh]), dtb = p.dt_bias[L * 4 + hh];
            const float bb = BA[(row0 + lane) * 8 + hh], aa = BA[(row0 + lane) * 8 + 4 + hh] + dtb;
            float c = negA * softplusf_(aa);
#pragma unroll
            for (int o = 1; o < 64; o <<= 1) { const float t = __shfl_up(c, o); if (lane >= o) c += t; }
            const float glast = __shfl(c, 63);
            beta_s[lane] = sigmoidf_(bb); gc_s[lane] = c; egc_s[lane] = __expf(c); edl_s[lane] = __expf(glast - c);
            if (lane == 0) GL[item] = __expf(glast);
        }
        __syncthreads();
        {
            {
                float wq[4][2];
#pragma unroll
                for (int j = 0; j < 4; ++j) { wq[j][0] = cw[j * 1536 + colq]; wq[j][1] = cw[j * 1536 + colq + 1]; }
#pragma unroll
                for (int i = 0; i < 8; ++i) {
                    const int c = 8 * w + i;
                    float q0 = 0.f, q1 = 0.f;
#pragma unroll
                    for (int j = 0; j < 4; ++j) { q0 += wq[j][0] * lo16(xq[i + j]); q1 += wq[j][1] * hi16(xq[i + j]); }
                    q0 *= sigmoidf_(q0); q1 *= sigmoidf_(q1);
                    const float sq = rsqrtf(wave_sum(q0 * q0 + q1 * q1) + EPS) * 0.08838834764831845f;
                    q0 *= sq; q1 *= sq;
                    const float eg = egc_s[c];
                    *(LAS unsigned*)(lds + GP_QN + c * GP_KP + lane * 4) = pk2(q0, q1);
                    *(unsigned*)(QD + ((size_t)item * 64 + c) * 128 + perm_pos(2 * lane)) = pk2(q0 * eg, q1 * eg);
                }
            }
            __builtin_amdgcn_sched_barrier(0);
            {
                float wk[4][2];
#pragma unroll
                for (int j = 0; j < 4; ++j) { wk[j][0] = cw[j * 1536 + 512 + colq]; wk[j][1] = cw[j * 1536 + 512 + colq + 1]; }
                unsigned kd0[8], kd1[8], rk0[8], rk1[8];
#pragma unroll
                for (int i = 0; i < 8; ++i) {
                    const int c = 8 * w + i;
                    float k0 = 0.f, k1 = 0.f;
#pragma unroll
                    for (int j = 0; j < 4; ++j) { k0 += wk[j][0] * lo16(xk[i + j]); k1 += wk[j][1] * hi16(xk[i + j]); }
                    k0 *= sigmoidf_(k0); k1 *= sigmoidf_(k1);
                    const float sk = rsqrtf(wave_sum(k0 * k0 + k1 * k1) + EPS);
                    k0 *= sk; k1 *= sk;
                    const float be = beta_s[c], eg = egc_s[c], ed = edl_s[c];
                    *(LAS unsigned*)(lds + GP_KN + c * GP_KP + lane * 4) = pk2(k0, k1);
                    kd0[i] = f2bf(k0 * ed); kd1[i] = f2bf(k1 * ed);
                    rk0[i] = f2bf(k0 * be * eg); rk1[i] = f2bf(k1 * be * eg);
                }
                u32x4 o;
                o.x = rk0[0] | (rk0[1] << 16); o.y = rk0[2] | (rk0[3] << 16); o.z = rk0[4] | (rk0[5] << 16); o.w = rk0[6] | (rk0[7] << 16); *(LAS u32x4*)(lds + GP_RT + (128 + 2 * lane) * GP_RP + 16 * w) = o;
                o.x = rk1[0] | (rk1[1] << 16); o.y = rk1[2] | (rk1[3] << 16); o.z = rk1[4] | (rk1[5] << 16); o.w = rk1[6] | (rk1[7] << 16); *(LAS u32x4*)(lds + GP_RT + (128 + 2 * lane + 1) * GP_RP + 16 * w) = o;
                const int pa = perm_pos(8 * w), pb = perm_pos(8 * w + 4);
                bf16* kr0 = KDT + ((size_t)item * 128 + 2 * lane) * 64; bf16* kr1 = kr0 + 64;
                u32x2 h2;
                h2.x = kd0[0] | (kd0[1] << 16); h2.y = kd0[2] | (kd0[3] << 16); *(u32x2*)(kr0 + pa) = h2;
                h2.x = kd0[4] | (kd0[5] << 16); h2.y = kd0[6] | (kd0[7] << 16); *(u32x2*)(kr0 + pb) = h2;
                h2.x = kd1[0] | (kd1[1] << 16); h2.y = kd1[2] | (kd1[3] << 16); *(u32x2*)(kr1 + pa) = h2;
                h2.x = kd1[4] | (kd1[5] << 16); h2.y = kd1[6] | (kd1[7] << 16); *(u32x2*)(kr1 + pb) = h2;
            }
            __builtin_amdgcn_sched_barrier(0);
            {
                float wv[4][2];
#pragma unroll
                for (int j = 0; j < 4; ++j) { wv[j][0] = cw[j * 1536 + 1024 + colq]; wv[j][1] = cw[j * 1536 + 1024 + colq + 1]; }
                unsigned rv0[8], rv1[8];
#pragma unroll
                for (int i = 0; i < 8; ++i) {
                    float v0 = 0.f, v1 = 0.f;
#pragma unroll
                    for (int j = 0; j < 4; ++j) { v0 += wv[j][0] * lo16(xv[i + j]); v1 += wv[j][1] * hi16(xv[i + j]); }
                    v0 *= sigmoidf_(v0); v1 *= sigmoidf_(v1);
                    const float be = beta_s[8 * w + i];
                    rv0[i] = f2bf(v0 * be); rv1[i] = f2bf(v1 * be);
                }
                u32x4 o;
                o.x = rv0[0] | (rv0[1] << 16); o.y = rv0[2] | (rv0[3] << 16); o.z = rv0[4] | (rv0[5] << 16); o.w = rv0[6] | (rv0[7] << 16); *(LAS u32x4*)(lds + GP_RT + (2 * lane) * GP_RP + 16 * w) = o;
                o.x = rv1[0] | (rv1[1] << 16); o.y = rv1[2] | (rv1[3] << 16); o.z = rv1[4] | (rv1[5] << 16); o.w = rv1[6] | (rv1[7] << 16); *(LAS u32x4*)(lds + GP_RT + (2 * lane + 1) * GP_RP + 16 * w) = o;
            }
        }
        __syncthreads();
#pragma unroll
        for (int q = 0; q < 2; ++q) {
            const int id = 2 * w + q, ct = id >> 2, st = id & 3;
            if (st <= ct) {
                f32x4 acc = (f32x4){0.f, 0.f, 0.f, 0.f};
#pragma unroll
                for (int ks = 0; ks < 4; ++ks) {
                    const bf16x8 a = *(const LAS bf16x8*)(lds + GP_KN + (16 * ct + fr) * GP_KP + (32 * ks + 8 * fq) * 2);
                    const bf16x8 bb = *(const LAS bf16x8*)(lds + GP_KN + (16 * st + fr) * GP_KP + (32 * ks + 8 * fq) * 2);
                    acc = __builtin_amdgcn_mfma_f32_16x16x32_bf16(a, bb, acc, 0, 0, 0);
                }
                const int s = 16 * st + fr; const float gs = gc_s[s];
#pragma unroll
                for (int r = 0; r < 4; ++r) { const int c = 16 * ct + 4 * fq + r;
                    Lm[c * GP_LP + s] = (s < c) ? beta_s[c] * acc[r] * __expf(fminf(gc_s[c] - gs, 0.f)) : 0.f; }
            }
        }
        __syncthreads();
        if (w < 2) {
            const int o = 32 * w;
            float t[32];
            int zoff = 0; asm volatile("" : "+v"(zoff));
            const LAS float* Lz = Lm + zoff + o * GP_LP + o;
            const int col = lane & 31;
#pragma unroll
            for (int i = 0; i < 32; ++i) {
                float a0 = (i == lane) ? 1.f : 0.f, a1 = 0.f, a2 = 0.f, a3 = 0.f;
#pragma unroll
                for (int s4 = 0; s4 + 4 <= i; s4 += 4) { const f32x4 lv = *(const LAS f32x4*)(Lz + i * GP_LP + s4);
                    a0 -= lv[0] * t[s4]; a1 -= lv[1] * t[s4 + 1]; a2 -= lv[2] * t[s4 + 2]; a3 -= lv[3] * t[s4 + 3]; }
#pragma unroll
                for (int s = i & ~3; s < i; ++s) a0 -= Lz[i * GP_LP + s] * t[s];
                t[i] = (lane < 32) ? (a0 + a1) + (a2 + a3) : 0.f;
                const bf16 tb = (bf16)f2bf(t[i]);
                if (w == 0) { *(LAS bf16*)(lds + GP_TB + i * GP_TP + lane * 2) = tb;
                              if (lane < 32) *(LAS bf16*)(lds + GP_T0T + lane * 80 + i * 2) = tb; }
                else if (lane < 32) *(LAS bf16*)(lds + GP_TB + (32 + i) * GP_TP + (32 + col) * 2) = tb;
                if ((i & 3) == 3) __builtin_amdgcn_sched_barrier(0);
            }
        } else {
            for (int id = w - 2; id < 16; id += 6) {
                const int ct = id >> 2, st = id & 3;
                f32x4 acc = (f32x4){0.f, 0.f, 0.f, 0.f};
                if (st <= ct) {
#pragma unroll
                    for (int ks = 0; ks < 4; ++ks) {
                        const bf16x8 a = *(const LAS bf16x8*)(lds + GP_QN + (16 * ct + fr) * GP_KP + (32 * ks + 8 * fq) * 2);
                        const bf16x8 bb = *(const LAS bf16x8*)(lds + GP_KN + (16 * st + fr) * GP_KP + (32 * ks + 8 * fq) * 2);
                        acc = __builtin_amdgcn_mfma_f32_16x16x32_bf16(a, bb, acc, 0, 0, 0);
                    }
                }
                const int s = 16 * st + fr; const float gs = gc_s[s]; const int ps = perm_pos(s);
#pragma unroll
                for (int r = 0; r < 4; ++r) { const int c = 16 * ct + 4 * fq + r;
                    const float v = (s <= c) ? acc[r] * __expf(fminf(gc_s[c] - gs, 0.f)) : 0.f;
                    AIP[((size_t)item * 64 + c) * 64 + ps] = (bf16)f2bf(v); }
            }
        }
        __syncthreads();
        if (w == 0) {
            f32x4 P[2][2];
#pragma unroll
            for (int it = 0; it < 2; ++it) {
                const LAS float* lr = Lm + (32 + 16 * it + fr) * GP_LP + 8 * fq;
                const f32x4 l0 = *(const LAS f32x4*)lr, l1 = *(const LAS f32x4*)(lr + 4);
                u32x4 pk; pk.x = cvtpk(l0[0], l0[1]); pk.y = cvtpk(l0[2], l0[3]); pk.z = cvtpk(l1[0], l1[1]); pk.w = cvtpk(l1[2], l1[3]);
                const bf16x8 a = __builtin_bit_cast(bf16x8, pk);
#pragma unroll
                for (int jt = 0; jt < 2; ++jt) {
                    const bf16x8 bb = *(const LAS bf16x8*)(lds + GP_T0T + (16 * jt + fr) * 80 + 16 * fq);
                    P[it][jt] = __builtin_amdgcn_mfma_f32_16x16x32_bf16(a, bb, (f32x4){0.f, 0.f, 0.f, 0.f}, 0, 0, 0);
                }
            }
#pragma unroll
            for (int jt = 0; jt < 2; ++jt) {
                u32x4 pk; pk.x = cvtpk(P[0][jt][0], P[0][jt][1]); pk.y = cvtpk(P[0][jt][2], P[0][jt][3]); pk.z = cvtpk(P[1][jt][0], P[1][jt][1]); pk.w = cvtpk(P[1][jt][2], P[1][jt][3]);
                const bf16x8 pb = __builtin_bit_cast(bf16x8, pk);
#pragma unroll
                for (int i2 = 0; i2 < 2; ++i2) {
                    const LAS unsigned char* tr = lds + GP_TB + (32 + 16 * i2 + fr) * GP_TP + (32 + 4 * fq) * 2;
                    const u32x2 ta = *(const LAS u32x2*)tr, tb2 = *(const LAS u32x2*)(tr + 32);
                    u32x4 ak; ak.x = ta.x; ak.y = ta.y; ak.z = tb2.x; ak.w = tb2.y;
                    const f32x4 r = __builtin_amdgcn_mfma_f32_16x16x32_bf16(__builtin_bit_cast(bf16x8, ak), pb, (f32x4){0.f, 0.f, 0.f, 0.f}, 0, 0, 0);
#pragma unroll
                    for (int q = 0; q < 4; ++q) *(LAS bf16*)(lds + GP_TB + (32 + 16 * i2 + 4 * fq + q) * GP_TP + (16 * jt + fr) * 2) = (bf16)f2bf(-r[q]);
                }
            }
        }
        __syncthreads();
#pragma unroll
        for (int q = 0; q < 2; ++q) {
            const int colt = 2 * w + q;
            bf16x8 af[2];
#pragma unroll
            for (int ks = 0; ks < 2; ++ks) af[ks] = *(const LAS bf16x8*)(lds + GP_RT + (16 * colt + fr) * GP_RP + (32 * ks + 8 * fq) * 2);
#pragma unroll
            for (int ct = 0; ct < 4; ++ct) {
                f32x4 acc = (f32x4){0.f, 0.f, 0.f, 0.f};
#pragma unroll
                for (int ks = 0; ks < 2; ++ks) {
                    const bf16x8 bb = *(const LAS bf16x8*)(lds + GP_TB + (16 * ct + fr) * GP_TP + (32 * ks + 8 * fq) * 2);
                    acc = __builtin_amdgcn_mfma_f32_16x16x32_bf16(af[ks], bb, acc, 0, 0, 0);
                }
                const int c = 16 * ct + fr;
                if (colt < 8) {
#pragma unroll
                    for (int r = 0; r < 4; ++r) UT[((size_t)item * 128 + 16 * colt + 4 * fq + r) * 64 + c] = (bf16)f2bf(acc[r]);
                } else {
                    const int kt = colt - 8;
                    u32x2 h2; h2.x = pk2(-acc[0], -acc[1]); h2.y = pk2(-acc[2], -acc[3]);
                    *(u32x2*)(WP + ((size_t)item * 64 + c) * 128 + 32 * (kt >> 1) + 8 * fq + 4 * (kt & 1)) = h2;
                }
            }
        }
    }
    __syncthreads();
}

constexpr int GS_WP = 0, GS_QD = 16384, GS_AIP = 32768, GS_KDT = 40960, GS_BUF = 57344, GS_OB = 2 * GS_BUF, GS_OBP = 272, GS_OBT = 64 * GS_OBP;
__device__ void phase_gdn_scan(const Params& p, int L, LAS unsigned char* lds, int bid, int nblk) {
    const int tid = tidx(), lane = tid & 63, w = __builtin_amdgcn_readfirstlane(tid >> 6), fr = lane & 15, fq = lane >> 4;
    const bf16* proj = (const bf16*)(p.ws + WS_PROJ);
    const bf16* WP = (const bf16*)(p.ws + GD_WP); const bf16* QD = (const bf16*)(p.ws + GD_QD); const bf16* AIP = (const bf16*)(p.ws + GD_AIP);
    const bf16* KDT = (const bf16*)(p.ws + GD_KDT); const bf16* UT = (const bf16*)(p.ws + GD_UT); const float* GL = (const float*)(p.ws + GD_GL);
    bf16* obuf = (bf16*)(p.ws + WS_OBUF);
    for (int item = bid; item < 32; item += nblk) {
        const int hh = item & 3, b = item >> 2;
        const int fc = tid >> 4, fv = tid & 15;
        float gn[8];
#pragma unroll
        for (int i = 0; i < 8; ++i) gn[i] = p.gdn_norm_g[L * 128 + 8 * fv + i];
        f32x4 S[8];
#pragma unroll
        for (int kt = 0; kt < 8; ++kt) S[kt] = (f32x4){0.f, 0.f, 0.f, 0.f};
        auto dma = [&](int ci, int buf) {
#pragma unroll
            for (int i = 0; i < 7; ++i) {
                const int pc = tid + 512 * i;
                const bf16* src;
                if (i < 2) { const int r = pc >> 4; src = WP + (size_t)ci * 8192 + r * 128 + (((pc & 15) ^ (r & 15)) * 8); }
                else if (i < 4) { const int q = pc - 1024, r = q >> 4; src = QD + (size_t)ci * 8192 + r * 128 + (((q & 15) ^ (r & 15)) * 8); }
                else if (i < 5) { const int q = pc - 2048, r = q >> 3; src = AIP + (size_t)ci * 4096 + r * 64 + (((q & 7) ^ ((r >> 1) & 7)) * 8); }
                else { const int q = pc - 2560, r = q >> 3; src = KDT + (size_t)ci * 8192 + r * 64 + (((q & 7) ^ ((r >> 1) & 7)) * 8); }
                __builtin_amdgcn_global_load_lds((const unsigned*)src, (LAS unsigned*)(lds + buf * GS_BUF + (w * 64 + 512 * i) * 16), 16, 0, 0);
            }
        };
        int offk[4], offa[2];
#pragma unroll
        for (int ks = 0; ks < 4; ++ks) offk[ks] = fr * 256 + (((4 * ks + fq) ^ fr) * 16);
#pragma unroll
        for (int ss = 0; ss < 2; ++ss) offa[ss] = fr * 128 + (((4 * ss + fq) ^ ((fr >> 1) & 7)) * 16);
        __syncthreads();
        dma(item * 32, 0);
        u32x2 ut[4]; float gl;
        {
            const int ci = item * 32;
#pragma unroll
            for (int ct = 0; ct < 4; ++ct) ut[ct] = *(const u32x2*)(UT + ((size_t)ci * 128 + 16 * w + fr) * 64 + 16 * ct + 4 * fq);
            gl = GL[ci];
        }
        u32x4 zp[2];
        zp[0] = (u32x4){0u, 0u, 0u, 0u}; zp[1] = zp[0];
        asm volatile("s_waitcnt vmcnt(0)" ::: "memory");
        __syncthreads();
#define GS_FINISH(ps, TILE, DST) do { const int c = 32 * (ps) + fc; \
            const u32x4 ov = *(const LAS u32x4*)(lds + (TILE) + c * GS_OBP + fv * 16); \
            float o8[8]; \
            _Pragma("unroll") for (int i = 0; i < 4; ++i) { o8[2 * i] = lo16(ov[i]); o8[2 * i + 1] = hi16(ov[i]); } \
            float ss = 0.f; \
            _Pragma("unroll") for (int i = 0; i < 8; ++i) ss += o8[i] * o8[i]; \
            const float rn = rsqrtf(row16_sum(ss) * (1.f / 128.f) + EPS); \
            u32x4 res; \
            _Pragma("unroll") for (int i = 0; i < 4; ++i) { \
                const float z0 = lo16(zp[ps][i]), z1 = hi16(zp[ps][i]); \
                res[i] = cvtpk(o8[2 * i] * rn * gn[2 * i] * (z0 * sigmoidf_(z0)), o8[2 * i + 1] * rn * gn[2 * i + 1] * (z1 * sigmoidf_(z1))); } \
            *(u32x4*)((DST) + (size_t)c * D) = res; } while (0)
        bf16* const dummy = (bf16*)(p.ws + WS_Q2) + tid * 8;
        for (int n = 0; n < 32; ++n) {
            const int ci = item * 32 + n, buf = n & 1;
            const size_t rowc = (size_t)b * SEQ + n * 64;
            if (n + 1 < 32) dma(ci + 1, buf ^ 1);
            u32x2 utn[4]; float gln = 0.f;
            {
                const int cn = ci + (n + 1 < 32 ? 1 : 0);
#pragma unroll
                for (int ct = 0; ct < 4; ++ct) utn[ct] = *(const u32x2*)(UT + ((size_t)cn * 128 + 16 * w + fr) * 64 + 16 * ct + 4 * fq);
                gln = GL[cn];
            }
            u32x4 zq[2];
#pragma unroll
            for (int ps = 0; ps < 2; ++ps) zq[ps] = *(const u32x4*)(proj + (rowc + 32 * ps + fc) * PROJ_W + 3072 + hh * 128 + 8 * fv);
            bf16* const fdst = n > 0 ? obuf + (rowc - 64) * D + 512 + hh * 128 + 8 * fv : dummy;
            const int tprev = GS_OB + (buf ^ 1) * GS_OBT, tcur = GS_OB + buf * GS_OBT;
            f32x4 vn[4], oacc[4];
#pragma unroll
            for (int ct = 0; ct < 4; ++ct) { vn[ct] = (f32x4){lo16(ut[ct].x), hi16(ut[ct].x), lo16(ut[ct].y), hi16(ut[ct].y)}; oacc[ct] = (f32x4){0.f, 0.f, 0.f, 0.f}; }
            bf16x8 sb[4];
#pragma unroll
            for (int ks = 0; ks < 4; ++ks) { u32x4 pk; pk.x = cvtpk(S[2 * ks][0], S[2 * ks][1]); pk.y = cvtpk(S[2 * ks][2], S[2 * ks][3]); pk.z = cvtpk(S[2 * ks + 1][0], S[2 * ks + 1][1]); pk.w = cvtpk(S[2 * ks + 1][2], S[2 * ks + 1][3]);
                sb[ks] = __builtin_bit_cast(bf16x8, pk); }
            LAS unsigned char* bb = lds + buf * GS_BUF;
            bf16x8 f0[8], f1[8];
#define LD_A(F, ct) do { _Pragma("unroll") for (int ks = 0; ks < 4; ++ks) { F[ks] = *(const LAS bf16x8*)(bb + GS_WP + (ct) * 4096 + offk[ks]); \
                    F[4 + ks] = *(const LAS bf16x8*)(bb + GS_QD + (ct) * 4096 + offk[ks]); } } while (0)
#define MM_A(F, ct) do { _Pragma("unroll") for (int ks = 0; ks < 4; ++ks) { vn[ct] = __builtin_amdgcn_mfma_f32_16x16x32_bf16(F[ks], sb[ks], vn[ct], 0, 0, 0); \
                    oacc[ct] = __builtin_amdgcn_mfma_f32_16x16x32_bf16(sb[ks], F[4 + ks], oacc[ct], 0, 0, 0); } } while (0)
#define SBAR() __builtin_amdgcn_sched_barrier(0)
            LD_A(f0, 0); SBAR();
            LD_A(f1, 1); MM_A(f0, 0); SBAR();
            LD_A(f0, 2); MM_A(f1, 1); GS_FINISH(0, tprev, fdst); SBAR();
            LD_A(f1, 3); MM_A(f0, 2); SBAR();
#pragma unroll
            for (int ct = 0; ct < 4; ++ct)
#pragma unroll
                for (int ss = 0; ss < 2; ++ss) f0[2 * ct + ss] = *(const LAS bf16x8*)(bb + GS_AIP + ct * 2048 + offa[ss]);
            MM_A(f1, 3); GS_FINISH(1, tprev, fdst); SBAR();
            bf16x8 vb[2];
#pragma unroll
            for (int ss = 0; ss < 2; ++ss) { u32x4 pk; pk.x = cvtpk(vn[2 * ss][0], vn[2 * ss][1]); pk.y = cvtpk(vn[2 * ss][2], vn[2 * ss][3]); pk.z = cvtpk(vn[2 * ss + 1][0], vn[2 * ss + 1][1]); pk.w = cvtpk(vn[2 * ss + 1][2], vn[2 * ss + 1][3]);
                vb[ss] = __builtin_bit_cast(bf16x8, pk); }
#pragma unroll
            for (int kt = 0; kt < 4; ++kt)
#pragma unroll
                for (int ss = 0; ss < 2; ++ss) f1[2 * kt + ss] = *(const LAS bf16x8*)(bb + GS_KDT + kt * 2048 + offa[ss]);
#pragma unroll
            for (int ct = 0; ct < 4; ++ct)
#pragma unroll
                for (int ss = 0; ss < 2; ++ss) oacc[ct] = __builtin_amdgcn_mfma_f32_16x16x32_bf16(vb[ss], f0[2 * ct + ss], oacc[ct], 0, 0, 0);
            SBAR();
#pragma unroll
            for (int kt = 4; kt < 8; ++kt)
#pragma unroll
                for (int ss = 0; ss < 2; ++ss) f0[2 * (kt - 4) + ss] = *(const LAS bf16x8*)(bb + GS_KDT + kt * 2048 + offa[ss]);
#pragma unroll
            for (int kt = 0; kt < 4; ++kt) {
                S[kt] = S[kt] * gl;
#pragma unroll
                for (int ss = 0; ss < 2; ++ss) S[kt] = __builtin_amdgcn_mfma_f32_16x16x32_bf16(f1[2 * kt + ss], vb[ss], S[kt], 0, 0, 0);
            }
#pragma unroll
            for (int ct = 0; ct < 4; ++ct) {
                u32x2 pk; pk.x = cvtpk(oacc[ct][0], oacc[ct][1]); pk.y = cvtpk(oacc[ct][2], oacc[ct][3]);
                *(LAS u32x2*)(lds + tcur + (16 * ct + fr) * GS_OBP + (16 * w + 4 * fq) * 2) = pk;
            }
            SBAR();
#pragma unroll
            for (int kt = 4; kt < 8; ++kt) {
                S[kt] = S[kt] * gl;
#pragma unroll
                for (int ss = 0; ss < 2; ++ss) S[kt] = __builtin_amdgcn_mfma_f32_16x16x32_bf16(f0[2 * (kt - 4) + ss], vb[ss], S[kt], 0, 0, 0);
            }
#undef LD_A
#undef MM_A
#undef SBAR
#pragma unroll
            for (int ct = 0; ct < 4; ++ct) ut[ct] = utn[ct];
            gl = gln; zp[0] = zq[0]; zp[1] = zq[1];
            asm volatile("s_waitcnt vmcnt(0)" ::: "memory");
            LDS_BARRIER();
        }
        {
            bf16* const fdst = obuf + ((size_t)b * SEQ + 31 * 64) * D + 512 + hh * 128 + 8 * fv;
            GS_FINISH(0, GS_OB + GS_OBT, fdst); GS_FINISH(1, GS_OB + GS_OBT, fdst);
        }
#undef GS_FINISH
        __syncthreads();
    }
}

__device__ __forceinline__ unsigned sortable(float f) { const unsigned u = __float_as_uint(f); return u ^ ((unsigned)((int)u >> 31) | 0x80000000u); }
__device__ __forceinline__ float unsortable(unsigned s) { return __uint_as_float((s & 0x80000000u) ? (s ^ 0x80000000u) : ~s); }
#define CE(a, b) do { const unsigned _x = k[a], _y = k[b]; k[a] = _x > _y ? _x : _y; k[b] = _x > _y ? _y : _x; } while (0)
constexpr int PE_TK = 0, PE_TAB = 8192, PE_ID = 8448, PE_GT = PE_ID + 32768, PE_SK = PE_GT + 32768;
__device__ void phase_peer(const Params& p, int L, LAS unsigned char* lds, int bid, int nblk) {
    const int tid = tidx(), lane = tid & 63, w = __builtin_amdgcn_readfirstlane(tid >> 6), fr = lane & 15, fq = lane >> 4;
    const bf16* Q2 = (const bf16*)(p.ws + WS_Q2);
    const bf16* SK = (const bf16*)(p.ws + WS_SK) + (size_t)L * 8 * 2 * 128 * 128;
    float* H = (float*)(p.ws + WS_H); bf16* HB2 = (bf16*)(p.ws + WS_HB2);
    const unsigned char* U = p.ws + WS_U + (size_t)L * NEXP * D;
    const unsigned char* V = p.ws + WS_V + (size_t)L * NEXP * D;
    const float* SU = (const float*)(p.ws + WS_SU) + (size_t)L * NEXP; const float* SV = (const float*)(p.ws + WS_SV) + (size_t)L * NEXP;
    const float* g = p.ln_ffn_g + L * D;
    LAS unsigned* TK = (LAS unsigned*)(lds + PE_TK);
    LAS unsigned short* TAB = (LAS unsigned short*)(lds + PE_TAB);
    LAS int* IDL = (LAS int*)(lds + PE_ID); LAS float* GTL = (LAS float*)(lds + PE_GT);
    if (tid < 64) {
        int a = 0, base = 0, q = tid; unsigned short v = 0xffff;
        if (q < 50) { for (;;) { const int cnt = 16 / (a + 1); if (q < base + cnt) break; base += cnt; ++a; } v = (unsigned short)((a << 8) | (q - base)); }
        TAB[tid] = v;
    }
    for (int item = bid; item < M / 64; item += nblk) {
        const int tok0 = item * 64;
        int tid_o = tid; asm volatile("" : "+v"(tid_o));
        const int tid = tid_o, lane = tid & 63, fr = lane & 15, fq = lane >> 4;
        __syncthreads();
        const int tg = w & 3, cc = w >> 2;
        int zs = 0; asm volatile("" : "+v"(zs));
        const bf16* SK_ = SK + zs;
#define SK_FETCH(hd) do { _Pragma("unroll") for (int i = 0; i < 8; ++i) { const int pc = tid + 512 * i, nn = (pc >> 4) & 127; \
            __builtin_amdgcn_global_load_lds((const unsigned*)(SK_ + ((size_t)((hd) * 2 + (pc >> 11)) * 128 + nn) * 128 + (((pc & 15) ^ (nn & 15)) * 8)), \
                                             (LAS unsigned*)(lds + PE_SK + (w * 64 + 512 * i) * 16), 16, 0, 0); } } while (0)
        SK_FETCH(0);
        asm volatile("s_waitcnt vmcnt(0)" ::: "memory");
        __syncthreads();
        for (int hh = 0; hh < 8; ++hh) {
            {
                f32x4 acc[8];
#pragma unroll
                for (int nt = 0; nt < 8; ++nt) acc[nt] = (f32x4){0.f, 0.f, 0.f, 0.f};
                bf16x8 qa[4];
#pragma unroll
                for (int ks = 0; ks < 4; ++ks) qa[ks] = *(const bf16x8*)(Q2 + (size_t)(tok0 + 16 * tg + fr) * 2048 + hh * 256 + cc * 128 + 32 * ks + 8 * fq);
                const LAS unsigned char* skb = lds + PE_SK + cc * 32768 + fr * 256;
#pragma unroll
                for (int nt = 0; nt < 8; ++nt)
#pragma unroll
                    for (int ks = 0; ks < 4; ++ks) {
                        const bf16x8 kb = *(const LAS bf16x8*)(skb + nt * 4096 + (((4 * ks + fq) ^ fr) << 4));
                        acc[nt] = __builtin_amdgcn_mfma_f32_16x16x32_bf16(qa[ks], kb, acc[nt], 0, 0, 0);
                    }
#pragma unroll
                for (int r = 0; r < 4; ++r) {
                    unsigned k[8];
#pragma unroll
                    for (int nt = 0; nt < 8; ++nt) k[nt] = (sortable(acc[nt][r]) & ~0x7Fu) | (unsigned)(127 - (16 * nt + fr));
                    CE(0, 1); CE(2, 3); CE(4, 5); CE(6, 7); CE(0, 2); CE(1, 3); CE(4, 6); CE(5, 7); CE(1, 2); CE(5, 6); CE(0, 4); CE(3, 7);
                    CE(1, 5); CE(2, 6); CE(1, 4); CE(3, 6); CE(2, 4); CE(3, 5); CE(3, 4);
                    unsigned res = 0u;
#pragma unroll
                    for (int rd = 0; rd < 16; ++rd) {
                        const unsigned m = row16_umax(k[0]);
                        const bool win = k[0] == m;
#pragma unroll
                        for (int i = 0; i < 7; ++i) k[i] = win ? k[i + 1] : k[i];
                        k[7] = win ? 0u : k[7];
                        res = (fr == rd) ? m : res;
                    }
                    TK[(cc * 64 + 16 * tg + 4 * fq + r) * 16 + fr] = res;
                }
            }
            __syncthreads();
            if (hh + 1 < 8) SK_FETCH(hh + 1);
#pragma unroll
            for (int ps = 0; ps < 2; ++ps) {
                const int tl = 8 * w + 4 * ps + fq;
                unsigned k[4];
#pragma unroll
                for (int sl = 0; sl < 4; ++sl) {
                    const int q = sl * 16 + fr;
                    const unsigned ab = TAB[q];
                    const unsigned k1 = TK[tl * 16 + ((ab >> 8) & 15)], k2 = TK[(64 + tl) * 16 + (ab & 15)];
                    const float v = unsortable(k1 & ~0x7Fu) + unsortable(k2 & ~0x7Fu);
                    k[sl] = (q < 50) ? ((sortable(v) & ~0x3Fu) | (unsigned)(63 - q)) : 0u;
                }
                CE(0, 1); CE(2, 3); CE(0, 2); CE(1, 3); CE(1, 2);
                unsigned res = 0u;
#pragma unroll
                for (int rd = 0; rd < 16; ++rd) {
                    const unsigned m = row16_umax(k[0]);
                    const bool win = k[0] == m;
                    k[0] = win ? k[1] : k[0]; k[1] = win ? k[2] : k[1]; k[2] = win ? k[3] : k[2]; k[3] = win ? 0u : k[3];
                    res = (fr == rd) ? m : res;
                }
                const unsigned ab = TAB[63 - (res & 0x3Fu)];
                const unsigned k1 = TK[tl * 16 + ((ab >> 8) & 15)], k2 = TK[(64 + tl) * 16 + (ab & 15)];
                const float v = unsortable(k1 & ~0x7Fu) + unsortable(k2 & ~0x7Fu);
                const float e = __expf(v - row16_max(v));
                const float sum = row16_sum(e);
                IDL[tl * 128 + hh * 16 + fr] = (int)((127u - (k1 & 0x7Fu)) * 128u + (127u - (k2 & 0x7Fu)));
                GTL[tl * 128 + hh * 16 + fr] = e * __builtin_amdgcn_rcpf(sum);
            }
            asm volatile("s_waitcnt vmcnt(0)" ::: "memory");
            __syncthreads();
        }
#undef SK_FETCH
        for (int ti = 0; ti < 8; ++ti) {
            const int tl = 8 * w + ti;
            unsigned k0 = ((unsigned)IDL[tl * 128 + lane] << 7) | (unsigned)lane, k1 = ((unsigned)IDL[tl * 128 + 64 + lane] << 7) | (unsigned)(64 + lane);
#pragma unroll
            for (int kk = 2; kk <= 128; kk <<= 1) {
#pragma unroll
                for (int j = kk >> 1; j >= 1; j >>= 1) {
                    if (j == 64) { const unsigned lo = k0 < k1 ? k0 : k1, hi = k0 < k1 ? k1 : k0; k0 = lo; k1 = hi; }
                    else {
                        const unsigned p0 = (unsigned)__shfl_xor((int)k0, j), p1 = (unsigned)__shfl_xor((int)k1, j);
                        const bool up0 = ((lane & kk) == 0) || kk == 128, up1 = (((lane + 64) & kk) == 0);
                        const bool low = (lane & j) == 0;
                        k0 = (low == up0) ? (k0 < p0 ? k0 : p0) : (k0 > p0 ? k0 : p0);
                        k1 = (low == (kk == 128 ? true : up1)) ? (k1 < p1 ? k1 : p1) : (k1 > p1 ? k1 : p1);
                    }
                }
            }
            const float g0 = GTL[tl * 128 + (k0 & 127u)], g1 = GTL[tl * 128 + (k1 & 127u)];
            asm volatile("s_waitcnt lgkmcnt(0)" ::: "memory");
            IDL[tl * 128 + lane] = (int)(k0 >> 7); IDL[tl * 128 + 64 + lane] = (int)(k1 >> 7);
            GTL[tl * 128 + lane] = g0; GTL[tl * 128 + 64 + lane] = g1;
        }
        __syncthreads();
        {
            int zo = 0; asm volatile("" : "+v"(zo));
            const float* g_ = g + zo; const unsigned char* U_ = U + zo; const float* H_ = H + zo;
            int xq[8][4]; float sx[8];
#pragma unroll
            for (int t = 0; t < 8; ++t) {
                const float* hrow = H_ + (size_t)(tok0 + 8 * w + t) * D + 4 * lane;
                float xn[16];
#pragma unroll
                for (int j = 0; j < 4; ++j) { const f32x4 a = *(const f32x4*)(hrow + 256 * j); xn[4 * j] = a[0]; xn[4 * j + 1] = a[1]; xn[4 * j + 2] = a[2]; xn[4 * j + 3] = a[3]; }
                float ss = 0.f;
#pragma unroll
                for (int i = 0; i < 16; ++i) ss += xn[i] * xn[i];
                const float rstd = rsqrtf(wave_sum(ss) * (1.f / D) + EPS);
                float mx = 0.f;
#pragma unroll
                for (int i = 0; i < 16; ++i) { xn[i] = xn[i] * rstd * g_[256 * (i >> 2) + 4 * lane + (i & 3)]; mx = fmaxf(mx, fabsf(xn[i])); }
                mx = xrow16_max(row16_max(mx));
                const float xinv = mx > 0.f ? 127.f / mx : 0.f; sx[t] = mx * (1.f / 127.f);
#pragma unroll
                for (int j = 0; j < 4; ++j) xq[t][j] = (int)(((unsigned)__float2int_rn(xn[4 * j] * xinv) & 0xffu) | (((unsigned)__float2int_rn(xn[4 * j + 1] * xinv) & 0xffu) << 8) |
                                                             (((unsigned)__float2int_rn(xn[4 * j + 2] * xinv) & 0xffu) << 16) | ((unsigned)__float2int_rn(xn[4 * j + 3] * xinv) << 24));
                if (t & 1) { asm volatile("" ::: "memory"); __builtin_amdgcn_sched_barrier(0); }
            }
            int hi[8][2];
#pragma unroll
            for (int t = 0; t < 8; ++t) { hi[t][0] = 0; hi[t][1] = 0; }
            const LAS int* idw = IDL + 8 * w * 128;
            u32x4 ring[16];
#pragma unroll
            for (int j = 0; j < 16; ++j) ring[j] = *(const u32x4*)(U_ + (size_t)idw[(j & 7) * 128 + (j >> 3)] * D + 16 * lane);
#pragma unroll 1
            for (int k = 0; k < 64; ++k) {
#pragma unroll
                for (int j = 0; j < 16; ++j) {
                    const int t = j & 7, pos = 2 * k + (j >> 3);
                    const u32x4 a = ring[j];
                    if (k < 63) ring[j] = *(const u32x4*)(U_ + (size_t)idw[t * 128 + pos + 2] * D + 16 * lane);
                    int d = __builtin_amdgcn_sdot4((int)a[0], xq[t][0], 0, false);
                    d = __builtin_amdgcn_sdot4((int)a[1], xq[t][1], d, false); d = __builtin_amdgcn_sdot4((int)a[2], xq[t][2], d, false); d = __builtin_amdgcn_sdot4((int)a[3], xq[t][3], d, false);
                    d = wave_isum(d);
                    if (lane == (pos & 63)) { if (k < 32) hi[t][0] = d; else hi[t][1] = d; }
                }
            }
#pragma unroll
            for (int t = 0; t < 8; ++t) {
                const int tl = 8 * w + t;
                const int id0 = IDL[tl * 128 + lane], id1 = IDL[tl * 128 + 64 + lane];
                const float su0 = SU[id0], su1 = SU[id1], sv0 = SV[id0], sv1 = SV[id1];
                const float h0 = su0 * sx[t] * (float)hi[t][0], h1 = su1 * sx[t] * (float)hi[t][1];
                GTL[tl * 128 + lane] = sv0 * GTL[tl * 128 + lane] * gelu_erf(h0);
                GTL[tl * 128 + 64 + lane] = sv1 * GTL[tl * 128 + 64 + lane] * gelu_erf(h1);

            }
        }
        {
            int zo = 0; asm volatile("" : "+v"(zo));
            const unsigned char* V_ = V + zo; float* H_ = H + zo; bf16* HB2_ = HB2 + zo;
            int wq[8]; float sw[8];
#pragma unroll
            for (int t = 0; t < 8; ++t) {
                const int tl = 8 * w + t;
                const float w0 = GTL[tl * 128 + lane], w1 = GTL[tl * 128 + 64 + lane];
                const float wmx = xrow16_max(row16_max(fmaxf(fabsf(w0), fabsf(w1))));
                const float winv = wmx > 0.f ? 127.f / wmx : 0.f; sw[t] = wmx * (1.f / 127.f);
                const f32x4 wv = *(const LAS f32x4*)(GTL + tl * 128 + 4 * (lane & 31));
                wq[t] = (int)(((unsigned)__float2int_rn(wv[0] * winv) & 0xffu) | (((unsigned)__float2int_rn(wv[1] * winv) & 0xffu) << 8) |
                              (((unsigned)__float2int_rn(wv[2] * winv) & 0xffu) << 16) | ((unsigned)__float2int_rn(wv[3] * winv) << 24));

            }
            const LAS int* idw = IDL + 8 * w * 128;
#pragma unroll
            for (int hf = 0; hf < 2; ++hf) {
                int yi[4][16];
#pragma unroll
                for (int g4 = 0; g4 < 4; ++g4)
#pragma unroll
                    for (int i = 0; i < 16; ++i) yi[g4][i] = 0;
                u32x4 ring[16];
#pragma unroll
                for (int j = 0; j < 16; ++j) ring[j] = *(const u32x4*)(V_ + (size_t)idw[(4 * hf + (j >> 2)) * 128 + (j & 3)] * D + 16 * lane);
#pragma unroll 1
                for (int s4 = 0; s4 < 32; ++s4) {
#pragma unroll
                    for (int g4 = 0; g4 < 4; ++g4) {
                        const int t = 4 * hf + g4;
                        const int wg = __builtin_amdgcn_readlane(wq[t], s4);
#pragma unroll
                        for (int q = 0; q < 4; ++q) {
                            const unsigned a0 = ring[4 * g4][q], a1 = ring[4 * g4 + 1][q], a2 = ring[4 * g4 + 2][q], a3 = ring[4 * g4 + 3][q];
                            const unsigned p0 = __builtin_amdgcn_perm(a1, a0, 0x05010400u), p1 = __builtin_amdgcn_perm(a1, a0, 0x07030602u);
                            const unsigned p2 = __builtin_amdgcn_perm(a3, a2, 0x05010400u), p3 = __builtin_amdgcn_perm(a3, a2, 0x07030602u);
                            yi[g4][4 * q] = __builtin_amdgcn_sdot4((int)__builtin_amdgcn_perm(p2, p0, 0x05040100u), wg, yi[g4][4 * q], false);
                            yi[g4][4 * q + 1] = __builtin_amdgcn_sdot4((int)__builtin_amdgcn_perm(p2, p0, 0x07060302u), wg, yi[g4][4 * q + 1], false);
                            yi[g4][4 * q + 2] = __builtin_amdgcn_sdot4((int)__builtin_amdgcn_perm(p3, p1, 0x05040100u), wg, yi[g4][4 * q + 2], false);
                            yi[g4][4 * q + 3] = __builtin_amdgcn_sdot4((int)__builtin_amdgcn_perm(p3, p1, 0x07060302u), wg, yi[g4][4 * q + 3], false);
                        }
                        __builtin_amdgcn_sched_barrier(0);
                        if (s4 < 31) {
#pragma unroll
                            for (int q = 0; q < 4; ++q) ring[4 * g4 + q] = *(const u32x4*)(V_ + (size_t)idw[t * 128 + 4 * (s4 + 1) + q] * D + 16 * lane);
                        }
                        __builtin_amdgcn_sched_barrier(0);
                    }
                }
#pragma unroll
                for (int g4 = 0; g4 < 4; ++g4) {
                    const int t = 4 * hf + g4, tok = tok0 + 8 * w + t;
                    float* hrow = H_ + (size_t)tok * D + 4 * lane;
                    float y[16];
#pragma unroll
                    for (int j = 0; j < 4; ++j) { const f32x4 a = *(const f32x4*)(hrow + 256 * j); y[4 * j] = a[0]; y[4 * j + 1] = a[1]; y[4 * j + 2] = a[2]; y[4 * j + 3] = a[3]; }
#pragma unroll
                    for (int i = 0; i < 16; ++i) y[i] = y[i] + sw[t] * (float)yi[g4][i];
#pragma unroll
                    for (int j = 0; j < 4; ++j) *(f32x4*)(hrow + 256 * j) = (f32x4){y[4 * j], y[4 * j + 1], y[4 * j + 2], y[4 * j + 3]};
                    bf16* hb = HB2_ + (size_t)tok * D + 4 * lane;
#pragma unroll
                    for (int j = 0; j < 4; ++j) { u32x2 o2; o2.x = pk2(y[4 * j], y[4 * j + 1]); o2.y = pk2(y[4 * j + 2], y[4 * j + 3]); *(u32x2*)(hb + 256 * j) = o2; }

                }
            }
        }
    }
    __syncthreads();
}
#undef CE

__device__ void phase_final(const Params& p, int bid, int nblk) {
    const int tid = tidx(), lane = tid & 63, gw = bid * NWAVES + (tid >> 6), NGW = nblk * NWAVES;
    const float* H = (const float*)(p.ws + WS_H);
    for (int m = gw; m < M; m += NGW) {
        f32x4 v[4]; float ss = 0.f;
#pragma unroll
        for (int j = 0; j < 4; ++j) { v[j] = ((const f32x4*)(H + (size_t)m * D))[lane + 64 * j]; ss += (v[j][0] * v[j][0] + v[j][1] * v[j][1]) + (v[j][2] * v[j][2] + v[j][3] * v[j][3]); }
        const float r = rsqrtf(wave_sum(ss) * (1.f / D) + EPS);
#pragma unroll
        for (int j = 0; j < 4; ++j) { const f32x4 gv = ((const f32x4*)p.final_g)[lane + 64 * j]; ((f32x4*)(p.out + (size_t)m * D))[lane + 64 * j] = v[j] * r * gv; }
    }
}

#define XB_TMO      128
#define XB_XCNT(j)  (256  + 64 * (j))
#define XB_XSUB(j)  (1280 + 64 * (j))
#define XB_XGEN(j)  (2304 + 64 * (j))
#define XB_TOP      3328
#define XB_TOPGEN   3392
#define XCD_BAR_WORDS 3456
#define XB_SPIN_CAP (1u << 22)
__device__ __forceinline__ unsigned xb_ld(unsigned* p)              { return __hip_atomic_load(p, __ATOMIC_RELAXED, __HIP_MEMORY_SCOPE_AGENT); }
__device__ __forceinline__ unsigned xb_add(unsigned* p, unsigned v) { return __hip_atomic_fetch_add(p, v, __ATOMIC_RELAXED, __HIP_MEMORY_SCOPE_AGENT); }
__device__ __forceinline__ unsigned xb_xcc_id() { return (unsigned)__builtin_amdgcn_s_getreg((3 << 11) | 20) & 0xFu; }
#define XB_SPIN(cond, bar) do { unsigned _sp = 0; while (cond) { __builtin_amdgcn_s_sleep(1); \
    if ((++_sp & 255u) == 0u) { if (xb_ld(&(bar)[XB_TMO])) break; if (_sp > XB_SPIN_CAP) { atomicAdd(&(bar)[XB_TMO], 1u); break; } } } } while (0)
struct XcdBarrier { unsigned* bar; unsigned x; volatile LAS unsigned* st; };
__device__ __forceinline__ XcdBarrier xcd_barrier_post(unsigned* bar, volatile LAS unsigned* st) {
    XcdBarrier b; b.bar = bar; b.x = xb_xcc_id(); b.st = st;
    if (threadIdx.x == 0) (void)xb_add(&bar[XB_XCNT(b.x)], 1u);
    return b;
}
__device__ __forceinline__ void xcd_barrier_complete(unsigned* bar, unsigned x, unsigned& nloc, unsigned& nx) {
    const unsigned G = gridDim.x * gridDim.y * gridDim.z;
    unsigned sum, cnt, mine, sp = 0u;
    for (;;) {
        sum = 0u; cnt = 0u; mine = 0u;
#pragma unroll
        for (unsigned j = 0; j < 16; ++j) { const unsigned c = xb_ld(&bar[XB_XCNT(j)]); sum += c; cnt += (c > 0u) ? 1u : 0u; mine = (j == x) ? c : mine; }
        if (sum == G) break;
        __builtin_amdgcn_s_sleep(1);
        if ((++sp & 255u) == 0u) { if (xb_ld(&bar[XB_TMO])) break; if (sp > XB_SPIN_CAP) { atomicAdd(&bar[XB_TMO], 1u); break; } }
    }
    nloc = mine > 0u ? mine : 1u; nx = cnt > 0u ? cnt : 1u;
}
__device__ __forceinline__ void xcd_barrier(const XcdBarrier& b) {
    asm volatile("s_waitcnt vmcnt(0)" ::: "memory");
    __syncthreads();
    if (threadIdx.x == 0) {
        unsigned* bar = b.bar;
        __builtin_amdgcn_s_waitcnt(0);
        unsigned nloc = b.st[0], nx = b.st[1];
        if (nloc == 0u) { xcd_barrier_complete(bar, b.x, nloc, nx); b.st[0] = nloc; b.st[1] = nx; }
        const unsigned old = xb_add(&bar[XB_XSUB(b.x)], 1u);
        const unsigned gen = old / nloc;
        if (old + 1u == (gen + 1u) * nloc) {
            __builtin_amdgcn_fence(__ATOMIC_RELEASE, "agent");
            asm volatile("s_waitcnt vmcnt(0)" ::: "memory");
            const unsigned og = xb_add(&bar[XB_TOP], 1u);
            const unsigned tg = og / nx;
            if (og + 1u == (tg + 1u) * nx) xb_add(&bar[XB_TOPGEN], 1u);
            else XB_SPIN(xb_ld(&bar[XB_TOPGEN]) == tg, bar);
            __builtin_amdgcn_fence(__ATOMIC_ACQUIRE, "agent");
            xb_add(&bar[XB_XGEN(b.x)], 1u);
            asm volatile("s_waitcnt vmcnt(0)" ::: "memory");
        } else {
            XB_SPIN(xb_ld(&bar[XB_XGEN(b.x)]) == gen, bar);
            __builtin_amdgcn_fence(__ATOMIC_ACQUIRE, "agent");
            asm volatile("s_waitcnt vmcnt(0)" ::: "memory");
        }
    }
    __syncthreads();
}
constexpr int CW_BAR = 4096;

constexpr int K_PROLOGUE = 11, K_FINAL = 12;
template <int KIND>
__device__ __forceinline__ void run_kind(const Params& p, int L, LAS unsigned char* lds, int bid, int nblk) {
    unsigned char* ws = p.ws;
    float* H = (float*)(ws + WS_H);
    float* ss0 = (float*)(ws + WS_STAT); float* ss1 = (float*)(ws + WS_SS1); float* sse = (float*)(ws + WS_SSE);
    if constexpr (KIND == K_PROLOGUE) phase_prologue(p, lds, bid, nblk);
    if constexpr (KIND == K_FINAL) phase_final(p, bid, nblk);
    if constexpr (KIND == 0) { EpiProj E{nullptr, (bf16*)(ws + WS_PROJ), (float*)(ws + WS_BA)};
        gemm_run(lds, (const bf16*)(ws + WS_HB0), (const bf16*)(ws + WS_WIN) + (size_t)L * IN_PAD * D, M, IN_PAD, D, E, bid, nblk, ss0); }
    if constexpr (KIND == 1) phase_gdn_prep(p, L, lds, bid, nblk);
    if constexpr (KIND == 2) { phase_gdn_scan(p, L, lds, bid, nblk); phase_att_queue(p, L, lds, bid, nblk); }
    if constexpr (KIND == 3) { EpiRes E{ss1, H, (bf16*)(ws + WS_HB1), L == 0 ? p.x : (const float*)H};
        gemm_run(lds, (const bf16*)(ws + WS_OBUF), (const bf16*)(ws + WS_WOUT) + (size_t)L * D * D, M, D, D, E, bid, nblk); }
    if constexpr (KIND == 4) { EpiQ2 E{nullptr, (bf16*)(ws + WS_Q2)};
        gemm_run(lds, (const bf16*)(ws + WS_HB1), (const bf16*)(ws + WS_WQ) + (size_t)L * 2048 * D, M, 2048, D, E, bid, nblk, ss1); }
    if constexpr (KIND == 5) phase_peer(p, L, lds, bid, nblk);
    if constexpr (KIND == 7) { EpiE E2{sse, (bf16*)(ws + WS_EPRE)};
        gemm_run(lds, (const bf16*)(ws + WS_PB) + (size_t)L * M * 256, (const bf16*)(ws + WS_WP) + (size_t)L * D * 256, M, D, 256, E2, bid, nblk); }
    if constexpr (KIND == 6) { EpiPle E{ss0, H, (bf16*)(ws + WS_HB0), (const bf16*)(ws + WS_EPRE), p.ple_norm_g + L * D};
        gemm_run(lds, (const bf16*)(ws + WS_HB2), (const bf16*)(ws + WS_WG) + (size_t)L * D * D, M, D, D, E, bid, nblk, sse); }
}

__device__ __forceinline__ Params params_off(const Params& s, size_t z) {
    Params q;
    q.x = s.x + z; q.p = s.p + z; q.ln_mix_g = s.ln_mix_g + z; q.w_in = s.w_in + z; q.conv_w = s.conv_w + z; q.a_log = s.a_log + z; q.dt_bias = s.dt_bias + z;
    q.gdn_norm_g = s.gdn_norm_g + z; q.diff_lambda = s.diff_lambda + z; q.subln_g = s.subln_g + z; q.w_out = s.w_out + z; q.ln_ffn_g = s.ln_ffn_g + z;
    q.peer_wq = s.peer_wq + z; q.subkeys = s.subkeys + z; q.peer_u = s.peer_u + z; q.peer_v = s.peer_v + z; q.ple_wp = s.ple_wp + z; q.ple_wg = s.ple_wg + z;
    q.ple_norm_g = s.ple_norm_g + z; q.final_g = s.final_g + z; q.out = s.out + z; q.ws = s.ws + z; q.pad0 = 0; q.pad1 = 0;
    return q;
}
#define RUN(KIND) do { size_t z_ = 0; int L_ = L; asm volatile("" : "+s"(z_), "+s"(L_)); const Params q_ = params_off(p, z_); run_kind<KIND>(q_, L_, (LAS unsigned char*)lds, (int)blockIdx.x, (int)gridDim.x); } while (0)
#define GRID_BARRIER() do { XcdBarrier b_; b_.bar = (unsigned*)(p.ws + WS_CTL) + CW_BAR; b_.x = xb_xcc_id(); b_.st = (volatile LAS unsigned*)((LAS unsigned char*)lds + LDS_MISC_OFF) + 8; xcd_barrier(b_); } while (0)
__global__ void __launch_bounds__(NTHREADS, 2) mk_fwd(Params p) {
    extern __shared__ __attribute__((aligned(16))) unsigned char lds[];
    {
        volatile LAS unsigned* misc = (volatile LAS unsigned*)((LAS unsigned char*)lds + LDS_MISC_OFF);
        if (threadIdx.x < 64) misc[threadIdx.x] = 0u;
        __syncthreads();
        (void)xcd_barrier_post((unsigned*)(p.ws + WS_CTL) + CW_BAR, misc + 8);
    }
    { int L = 0; RUN(K_PROLOGUE); }
    cg::this_grid().sync();
#define LAYER(LL) do { const int L = (LL); RUN(0); GRID_BARRIER(); RUN(1); GRID_BARRIER(); RUN(2); GRID_BARRIER(); RUN(3); GRID_BARRIER(); RUN(4); GRID_BARRIER(); RUN(5); RUN(7); GRID_BARRIER(); RUN(6); GRID_BARRIER(); } while (0)
    LAYER(0); LAYER(1); LAYER(2); LAYER(3);
#undef LAYER
    { int L = 0; RUN(K_FINAL); }
}

extern "C" void kernel_launch(void* const* d_in, const int* in_sizes, int n_in, void* d_out, int out_size, void* d_ws, size_t ws_size, hipStream_t stream) {
    static int grid = 0;
    if (grid == 0) {
        if (n_in != 20 || out_size != M * D || ws_size < WS_END) { fprintf(stderr, "kernel_launch: unexpected shapes (n_in %d, out %d, ws %zu < %zu)\n", n_in, out_size, ws_size, (size_t)WS_END); grid = -1; return; }
        int dev = 0, cus = 0, per_cu = 0;
        (void)hipGetDevice(&dev); (void)hipDeviceGetAttribute(&cus, hipDeviceAttributeMultiprocessorCount, dev);
        if (hipFuncSetAttribute((const void*)mk_fwd, hipFuncAttributeMaxDynamicSharedMemorySize, LDS_BYTES) != hipSuccess) { fprintf(stderr, "kernel_launch: hipFuncSetAttribute failed\n"); grid = -1; return; }
        if (hipOccupancyMaxActiveBlocksPerMultiprocessor(&per_cu, (const void*)mk_fwd, NTHREADS, LDS_BYTES) != hipSuccess || per_cu < 1) { fprintf(stderr, "kernel_launch: occupancy query says %d blocks per CU\n", per_cu); (void)hipGetLastError(); grid = -1; return; }
        grid = (cus > 0 ? cus : 256);
    }
    if (grid < 0) return;
    (void)hipMemsetAsync((char*)d_ws + WS_CTL, 0, CTL_ZERO_BYTES, stream);
    Params p{};
    const float** pp = (const float**)&p;
    for (int i = 0; i < 20; ++i) pp[i] = (const float*)d_in[i];
    p.out = (float*)d_out; p.ws = (unsigned char*)d_ws;
    void* args[] = {&p};
    hipError_t e = hipLaunchCooperativeKernel((const void*)mk_fwd, dim3(grid), dim3(NTHREADS), args, LDS_BYTES, stream);
    if (e != hipSuccess) fprintf(stderr, "kernel_launch: cooperative launch failed: %s (grid %d)\n", hipGetErrorString(e), grid);
}
```

```cpp
#include <hip/hip_runtime.h>
#include <hip/hip_cooperative_groups.h>
#include <cstdio>
#include <cstdint>
namespace cg = cooperative_groups;

#define LAS __attribute__((address_space(3)))
typedef unsigned short bf16;
typedef float f32x4 __attribute__((ext_vector_type(4)));
typedef short bf16x8 __attribute__((ext_vector_type(8)));
typedef unsigned u32x4 __attribute__((ext_vector_type(4)));
typedef unsigned u32x2 __attribute__((ext_vector_type(2)));

constexpr int D = 1024, BATCH = 8, SEQ = 2048, DEPTH = 4, M = BATCH * SEQ;
constexpr int IN_COLS = 3592, IN_PAD = 3840, PROJ_W = 3584;
constexpr int NEXP = 16384;
constexpr float EPS = 1e-6f;
constexpr float QSCALE = 0.125f * 1.4426950408889634f;
constexpr int NWAVES = 8, NTHREADS = 512;
constexpr int LDS_BYTES = 163840;
constexpr int LDS_MISC_OFF = LDS_BYTES - 256;
constexpr int RS_OFF = 147456;
constexpr int CW_QUEUE = 1024;

constexpr size_t MiB = 1u << 20;
constexpr size_t WS_CTL = 0, CTL_ZERO_BYTES = 1 * MiB;
constexpr size_t WS_H = 1 * MiB;
constexpr size_t WS_HB0 = 65 * MiB;
constexpr size_t WS_HB1 = 97 * MiB;
constexpr size_t WS_HB2 = 129 * MiB;
constexpr size_t WS_PROJ = 161 * MiB;
constexpr size_t WS_BA = 273 * MiB;
constexpr size_t WS_OBUF = 274 * MiB;
constexpr size_t WS_Q2 = 306 * MiB;
constexpr size_t WS_EPRE = 370 * MiB;
constexpr size_t WS_IDX = 402 * MiB;
constexpr size_t WS_GATE = 410 * MiB;
constexpr size_t WS_STAT = 418 * MiB;
constexpr size_t WS_SS1 = WS_IDX + 1 * MiB, WS_SSE = WS_IDX;
constexpr size_t WS_ORAW = 422 * MiB;
constexpr size_t WS_WIN = 550 * MiB;
constexpr size_t WS_WOUT = 582 * MiB;
constexpr size_t WS_WQ = 590 * MiB;
constexpr size_t WS_WG = 606 * MiB;
constexpr size_t WS_WP = 614 * MiB;
constexpr size_t WS_SK = 616 * MiB;
constexpr size_t WS_PB = 618 * MiB;
constexpr size_t WS_U = 650 * MiB;
constexpr size_t WS_V = 778 * MiB;
constexpr size_t WS_SU = WS_STAT + 1 * MiB, WS_SV = WS_STAT + 2 * MiB;
constexpr size_t WS_END = 906 * MiB;

struct Params {
    const float *x, *p, *ln_mix_g, *w_in, *conv_w, *a_log, *dt_bias, *gdn_norm_g, *diff_lambda, *subln_g, *w_out, *ln_ffn_g,
        *peer_wq, *subkeys, *peer_u, *peer_v, *ple_wp, *ple_wg, *ple_norm_g, *final_g;
    float* out;
    unsigned char* ws;
    int pad0, pad1;
};

__device__ __forceinline__ int tidx() { int t = (int)threadIdx.x; asm volatile("" : "+v"(t)); return t; }
#define LDS_BARRIER() asm volatile("s_waitcnt lgkmcnt(0)\n\ts_barrier" ::: "memory")
__device__ __forceinline__ float bf2f(bf16 v) { return __uint_as_float((unsigned)v << 16); }
__device__ __forceinline__ unsigned f2bf(float f);
typedef __bf16 bf16x2_t __attribute__((ext_vector_type(2)));
typedef float f32x2_t __attribute__((ext_vector_type(2)));
__device__ __forceinline__ unsigned cvtpk(float lo, float hi) { f32x2_t v = {lo, hi}; bf16x2_t b = __builtin_convertvector(v, bf16x2_t); return __builtin_bit_cast(unsigned, b); }
__device__ __forceinline__ unsigned pk2(float lo, float hi) { return cvtpk(lo, hi); }
__device__ __forceinline__ unsigned f2bf(float f) { return cvtpk(f, 0.f) & 0xffffu; }
__device__ __forceinline__ float lo16(unsigned w) { return __uint_as_float(w << 16); }
__device__ __forceinline__ float hi16(unsigned w) { return __uint_as_float(w & 0xffff0000u); }
template <int N> __device__ __forceinline__ float dpp_ror(float x) { return __builtin_bit_cast(float, __builtin_amdgcn_mov_dpp(__builtin_bit_cast(int, x), 0x120 + N, 0xf, 0xf, true)); }
template <int N> __device__ __forceinline__ unsigned dpp_ror_u(unsigned x) { return (unsigned)__builtin_amdgcn_mov_dpp((int)x, 0x120 + N, 0xf, 0xf, true); }
__device__ __forceinline__ float row16_sum(float x) { x += dpp_ror<8>(x); x += dpp_ror<4>(x); x += dpp_ror<2>(x); x += dpp_ror<1>(x); return x; }
__device__ __forceinline__ float row16_max(float x) { x = fmaxf(x, dpp_ror<8>(x)); x = fmaxf(x, dpp_ror<4>(x)); x = fmaxf(x, dpp_ror<2>(x)); x = fmaxf(x, dpp_ror<1>(x)); return x; }
__device__ __forceinline__ unsigned row16_umax(unsigned x) { unsigned y;
    y = dpp_ror_u<8>(x); x = x > y ? x : y; y = dpp_ror_u<4>(x); x = x > y ? x : y; y = dpp_ror_u<2>(x); x = x > y ? x : y; y = dpp_ror_u<1>(x); x = x > y ? x : y; return x; }
__device__ __forceinline__ float xrow16_max(float x) {
    auto s = __builtin_amdgcn_permlane16_swap(__float_as_uint(x), __float_as_uint(x), false, false);
    x = fmaxf(__uint_as_float(s[0]), __uint_as_float(s[1]));
    auto t = __builtin_amdgcn_permlane32_swap(__float_as_uint(x), __float_as_uint(x), false, false);
    return fmaxf(__uint_as_float(t[0]), __uint_as_float(t[1]));
}
__device__ __forceinline__ float xrow16_sum(float x) {
    auto s = __builtin_amdgcn_permlane16_swap(__float_as_uint(x), __float_as_uint(x), false, false);
    x = __uint_as_float(s[0]) + __uint_as_float(s[1]);
    auto t = __builtin_amdgcn_permlane32_swap(__float_as_uint(x), __float_as_uint(x), false, false);
    return __uint_as_float(t[0]) + __uint_as_float(t[1]);
}
__device__ __forceinline__ float wave_sum(float v) { return xrow16_sum(row16_sum(v)); }
template <int N> __device__ __forceinline__ int dpp_ror_i(int x) { return __builtin_amdgcn_mov_dpp(x, 0x120 + N, 0xf, 0xf, true); }
__device__ __forceinline__ int wave_isum(int x) {
    x += dpp_ror_i<8>(x); x += dpp_ror_i<4>(x); x += dpp_ror_i<2>(x); x += dpp_ror_i<1>(x);
    auto s = __builtin_amdgcn_permlane16_swap((unsigned)x, (unsigned)x, false, false); x = (int)(s[0] + s[1]);
    auto t = __builtin_amdgcn_permlane32_swap((unsigned)x, (unsigned)x, false, false); return (int)(t[0] + t[1]);
}
__device__ __forceinline__ float wave_max(float v) {
#pragma unroll
    for (int o = 32; o; o >>= 1) v = fmaxf(v, __shfl_xor(v, o));
    return v;
}
__device__ __forceinline__ float sigmoidf_(float x) { return __builtin_amdgcn_rcpf(1.f + __expf(-x)); }
__device__ __forceinline__ float dot8(u32x4 a, u32x4 b, float s) {
#pragma unroll
    for (int i = 0; i < 4; ++i) { s += lo16(a[i]) * lo16(b[i]); s += hi16(a[i]) * hi16(b[i]); }
    return s;
}

__host__ __device__ __forceinline__ int lds_byte(int r, int c) { const int st = (r >> 4) * 2 + (c >> 5), rr = r & 15, cc = c & 31, ob = rr * 64 + cc * 2; return st * 1024 + (ob ^ (((ob >> 9) & 1) << 5)); }
__host__ __device__ __forceinline__ void stage_rc(int b, int& R, int& C) { const int st = b / 1024, sb = b % 1024, swz = sb ^ (((sb >> 9) & 1) << 5); R = (st >> 1) * 16 + swz / 64; C = (st & 1) * 32 + (swz % 64) / 2; }
constexpr int HTB = 16384;
template <class F>
__device__ __forceinline__ void gemm_run(LAS unsigned char* lds, const bf16* A, const bf16* Bt, int Mm, int N, int K, const F& f, int bid, int nblk, const float* slots_in = nullptr) {
    LAS float* RS = (LAS float*)(lds + RS_OFF);
    int rs_pm = -1;
    const int tid = tidx(), wid = __builtin_amdgcn_readfirstlane(tid >> 6), lane = tid & 63, wr = wid >> 2, wc = wid & 3, fr = lane & 15, fq = lane >> 4;
    const int nt = K / 64, ntn = N / 256, nunits = (Mm / 256) * ntn;
    unsigned voff[2];
#pragma unroll
    for (int i = 0; i < 2; ++i) { const int uu = tid + 512 * i, r = uu >> 3, c = (uu & 7) ^ ((r >> 1) & 7); voff[i] = (unsigned)(r * K + c * 8) * 2u; }
    const unsigned ldsw = (unsigned)wid * 1024u;
    const int sw7 = (fr >> 1) & 7;
    const int aoff0 = wr * HTB + fr * 128 + ((fq ^ sw7) << 4), aoff1 = wr * HTB + fr * 128 + (((4 + fq) ^ sw7) << 4);
    const int bbase = (2 + (wc >> 1)) * HTB + (wc & 1) * 8192 + fr * 128;
    const int boff0 = bbase + ((fq ^ sw7) << 4), boff1 = bbase + (((4 + fq) ^ sw7) << 4);
#define G_STAGE(bufoff, gbase) do { _Pragma("unroll") for (int _i = 0; _i < 2; ++_i) \
        __builtin_amdgcn_global_load_lds((const unsigned*)((const char*)(gbase) + voff[_i]), (LAS unsigned*)(lds + (bufoff) + ldsw + _i * 8192), 16, 0, 0); } while (0)
    for (int u = bid; u < nunits; u += nblk) {
        const int pm = u % (Mm / 256), pn = u / (Mm / 256);
        if (slots_in && pm != rs_pm) {
            __syncthreads();
            if (tid < 256) { const f32x4* sp = (const f32x4*)(slots_in + ((size_t)pm * 256 + tid) * 16);
                const f32x4 a = sp[0], b = sp[1], c = sp[2], d = sp[3];
                const float s = (((a[0] + a[1]) + (a[2] + a[3])) + ((b[0] + b[1]) + (b[2] + b[3]))) + (((c[0] + c[1]) + (c[2] + c[3])) + ((d[0] + d[1]) + (d[2] + d[3])));
                RS[tid] = rsqrtf(s * (1.f / D) + EPS); }
            __syncthreads();
            rs_pm = pm;
        }
        const char* gA = (const char*)(A + (size_t)pm * 256 * K);
        const char* gB = (const char*)(Bt + (size_t)pn * 256 * K);
        const size_t hstep = (size_t)128 * K * 2;
        f32x4 acc[8][4];
#pragma unroll
        for (int a = 0; a < 8; ++a)
#pragma unroll
            for (int b = 0; b < 4; ++b) acc[a][b] = (f32x4){0.f, 0.f, 0.f, 0.f};
        G_STAGE(0, gA); G_STAGE(HTB, gA + hstep); G_STAGE(2 * HTB, gB); G_STAGE(3 * HTB, gB + hstep);
        for (int t = 0; t < nt; ++t) {
            const int cb = (t & 1) * 4 * HTB, nb = ((t + 1) & 1) * 4 * HTB;
            asm volatile("s_waitcnt vmcnt(0)" ::: "memory");
            __builtin_amdgcn_s_barrier();
            asm volatile("" ::: "memory");
            const size_t ko = (size_t)(t + 1) * 128; const bool more = t + 1 < nt;
#pragma unroll
            for (int k = 0; k < 2; ++k) {
                if (more) { if (k == 0) { G_STAGE(nb, gA + ko); G_STAGE(nb + 2 * HTB, gB + ko); } else { G_STAGE(nb + HTB, gA + hstep + ko); G_STAGE(nb + 3 * HTB, gB + hstep + ko); } }
                bf16x8 bfr[4], acur, anxt;
#pragma unroll
                for (int n = 0; n < 4; ++n) bfr[n] = *(const LAS bf16x8*)(lds + cb + (k ? boff1 : boff0) + n * 2048);
                acur = *(const LAS bf16x8*)(lds + cb + (k ? aoff1 : aoff0));
#pragma unroll
                for (int m = 0; m < 8; ++m) {
                    if (m < 7) anxt = *(const LAS bf16x8*)(lds + cb + (k ? aoff1 : aoff0) + (m + 1) * 2048);
#pragma unroll
                    for (int n = 0; n < 4; ++n) acc[m][n] = __builtin_amdgcn_mfma_f32_16x16x32_bf16(bfr[n], acur, acc[m][n], 0, 0, 0);
                    acur = anxt;
                }
                __builtin_amdgcn_sched_barrier(0);
            }
            asm volatile("s_waitcnt lgkmcnt(0)" ::: "memory");
        }
        {
            int el = lane; asm volatile("" : "+v"(el));
            const int efr = el & 15, efq = el >> 4;
            LAS float* et = (LAS float*)(lds + wid * 4352);
            const int ecol = pn * 256 + wc * 64 + 4 * efr;
            typename F::Pre pq[4];
            if constexpr (F::PRE) {
#pragma unroll
                for (int i = 0; i < 4; ++i) pq[i] = f.pre(pm * 256 + wr * 128 + 4 * i + efq, ecol);
            }
#pragma unroll
            for (int m = 0; m < 8; ++m) {
#pragma unroll
                for (int n = 0; n < 4; ++n) *(LAS f32x4*)(et + efr * 68 + n * 16 + 4 * efq) = acc[m][n];
                typename F::Pre pnx[4];
                if constexpr (F::PRE) {
                    if (m < 7) {
#pragma unroll
                        for (int i = 0; i < 4; ++i) pnx[i] = f.pre(pm * 256 + wr * 128 + (m + 1) * 16 + 4 * i + efq, ecol);
                    }
                }
                asm volatile("s_waitcnt lgkmcnt(0)" ::: "memory");
#pragma unroll
                for (int i = 0; i < 4; ++i) {
                    const int lrow = wr * 128 + m * 16 + 4 * i + efq, row = pm * 256 + lrow;
                    const f32x4 v = *(const LAS f32x4*)(et + (4 * i + efq) * 68 + 4 * efr);
                    f32x4 r;
                    if constexpr (F::PRE) r = f(row, RS[lrow], ecol, v, pq[i]); else r = f(row, RS[lrow], ecol, v);
                    if constexpr (F::STATS) { const float ssq = row16_sum((r[0] * r[0] + r[1] * r[1]) + (r[2] * r[2] + r[3] * r[3])); if (efr == 0) f.slots[(size_t)row * 16 + pn * 4 + wc] = ssq; }
                }
                if constexpr (F::PRE) {
                    if (m < 7) {
#pragma unroll
                        for (int i = 0; i < 4; ++i) pq[i] = pnx[i];
                    }
                }
                asm volatile("s_waitcnt lgkmcnt(0)" ::: "memory");
                __builtin_amdgcn_sched_barrier(0);
            }
        }
        __syncthreads();
    }
#undef G_STAGE
}

__device__ __forceinline__ u32x2 pk4(f32x4 a) { u32x2 o; o.x = pk2(a[0], a[1]); o.y = pk2(a[2], a[3]); return o; }
struct NoPre {};
struct EpiProj {
    static constexpr bool STATS = false, PRE = false; typedef NoPre Pre; float* slots;
    bf16* proj; float* ba;
    __device__ __forceinline__ f32x4 operator()(int row, float rstd, int col, f32x4 v) const {
        v = v * rstd;
        if (col < PROJ_W) *(u32x2*)(proj + (size_t)row * PROJ_W + col) = pk4(v);
        else if (col < IN_COLS) *(f32x4*)(ba + (size_t)row * 8 + (col - PROJ_W)) = v;
        return v;
    }
};
struct EpiRes {
    static constexpr bool STATS = true, PRE = true; float* slots;
    float* H; bf16* HB; const float* Hin;
    struct Pre { f32x4 h; };
    __device__ __forceinline__ Pre pre(int row, int col) const { Pre q; q.h = *(const f32x4*)(Hin + (size_t)row * D + col); return q; }
    __device__ __forceinline__ f32x4 operator()(int row, float, int col, f32x4 v, const Pre& q) const {
        const f32x4 h = q.h + v; *(f32x4*)(H + (size_t)row * D + col) = h;
        *(u32x2*)(HB + (size_t)row * D + col) = pk4(h);
        return h;
    }
};
struct EpiQ2 {
    static constexpr bool STATS = false, PRE = false; typedef NoPre Pre; float* slots;
    bf16* Q2;
    __device__ __forceinline__ f32x4 operator()(int row, float rstd, int col, f32x4 v) const { v = v * rstd; *(u32x2*)(Q2 + (size_t)row * 2048 + col) = pk4(v); return v; }
};
struct EpiE {
    static constexpr bool STATS = true, PRE = false; typedef NoPre Pre; float* slots;
    bf16* E;
    __device__ __forceinline__ f32x4 operator()(int row, float, int col, f32x4 v) const { *(u32x2*)(E + (size_t)row * D + col) = pk4(v); return v; }
};
struct EpiPle {
    static constexpr bool STATS = true, PRE = true; float* slots;
    float* H; bf16* HB; const bf16* E; const float* g;
    struct Pre { f32x4 h; u32x2 ev; };
    __device__ __forceinline__ Pre pre(int row, int col) const { Pre q; q.h = *(const f32x4*)(H + (size_t)row * D + col); q.ev = *(const u32x2*)(E + (size_t)row * D + col); return q; }
    __device__ __forceinline__ f32x4 operator()(int row, float rstde, int col, f32x4 v, const Pre& q) const {
        const u32x2 ev = q.ev;
        const f32x4 gv = *(const f32x4*)(g + col);
        f32x4 h = q.h;
        h[0] += sigmoidf_(v[0]) * (lo16(ev.x) * rstde * gv[0]); h[1] += sigmoidf_(v[1]) * (hi16(ev.x) * rstde * gv[1]);
        h[2] += sigmoidf_(v[2]) * (lo16(ev.y) * rstde * gv[2]); h[3] += sigmoidf_(v[3]) * (hi16(ev.y) * rstde * gv[3]);
        *(f32x4*)(H + (size_t)row * D + col) = h;
        *(u32x2*)(HB + (size_t)row * D + col) = pk4(h);
        return h;
    }
};

__device__ __forceinline__ void transpose_item(const float* W, int K, int N, int Npad, bf16* WT, const float* rowscale, int qcols, float* scr, int item, int lane) {
    const int nblk = Npad / 32, kb = item / nblk, nb = item % nblk, k0 = 64 * kb, n0 = 32 * nb;
    const int nq = n0 + 4 * (lane & 7);
#pragma unroll
    for (int i = 0; i < 8; ++i) {
        const int kk = 8 * i + (lane >> 3);
        f32x4 v = (nq < N) ? *(const f32x4*)(W + (size_t)(k0 + kk) * N + nq) : (f32x4){0.f, 0.f, 0.f, 0.f};
        if (rowscale) v = v * rowscale[k0 + kk];
        if (nq < qcols) v = v * QSCALE;
        scr[kk * 33 + 4 * (lane & 7)] = v[0]; scr[kk * 33 + 4 * (lane & 7) + 1] = v[1]; scr[kk * 33 + 4 * (lane & 7) + 2] = v[2]; scr[kk * 33 + 4 * (lane & 7) + 3] = v[3];
    }
    asm volatile("s_waitcnt lgkmcnt(0)" ::: "memory");
    const int c = lane & 7;
#pragma unroll
    for (int j = 0; j < 4; ++j) {
        const int nn = (lane >> 3) + 8 * j; const float* s = scr + (8 * c) * 33 + nn;
        u32x4 o; o.x = pk2(s[0 * 33], s[1 * 33]); o.y = pk2(s[2 * 33], s[3 * 33]); o.z = pk2(s[4 * 33], s[5 * 33]); o.w = pk2(s[6 * 33], s[7 * 33]);
        *(u32x4*)(WT + (size_t)(n0 + nn) * K + k0 + 8 * c) = o;
    }
    asm volatile("s_waitcnt lgkmcnt(0)" ::: "memory");
}
__device__ __forceinline__ void convert_bulk(const float* src, bf16* dst, size_t n, size_t gtid, size_t nthr) {
    for (size_t i = gtid * 8; i < n; i += nthr * 8) {
        const f32x4 a = *(const f32x4*)(src + i), b = *(const f32x4*)(src + i + 4);
        u32x4 o; o.x = pk2(a[0], a[1]); o.y = pk2(a[2], a[3]); o.z = pk2(b[0], b[1]); o.w = pk2(b[2], b[3]);
        *(u32x4*)(dst + i) = o;
    }
}
__device__ void phase_prologue(const Params& p, LAS unsigned char* lds_, int bid, int nblk) {
    unsigned char* lds = (unsigned char*)lds_;
    const int tid = tidx(), lane = tid & 63, w = tid >> 6;
    const int gw = bid * NWAVES + w, NGW = nblk * NWAVES;
    float* scr = (float*)(lds + w * 16384);
    constexpr int I_IN = 16 * (IN_PAD / 32), I_OUT = 16 * 32, I_Q = 16 * 64, I_G = 16 * 32, I_P = 4 * 32, I_L = I_IN + I_OUT + I_Q + I_G + I_P;
    for (int it = gw; it < DEPTH * I_L; it += NGW) {
        const int L = it / I_L; int r = it % I_L;
        if (r < I_IN) { transpose_item(p.w_in + (size_t)L * D * IN_COLS, D, IN_COLS, IN_PAD, (bf16*)(p.ws + WS_WIN) + (size_t)L * IN_PAD * D, p.ln_mix_g + L * D, 512, scr, r, lane); continue; } r -= I_IN;
        if (r < I_OUT) { transpose_item(p.w_out + (size_t)L * D * D, D, D, D, (bf16*)(p.ws + WS_WOUT) + (size_t)L * D * D, nullptr, 0, scr, r, lane); continue; } r -= I_OUT;
        if (r < I_Q) { transpose_item(p.peer_wq + (size_t)L * D * 2048, D, 2048, 2048, (bf16*)(p.ws + WS_WQ) + (size_t)L * 2048 * D, p.ln_ffn_g + L * D, 0, scr, r, lane); continue; } r -= I_Q;
        if (r < I_G) { transpose_item(p.ple_wg + (size_t)L * D * D, D, D, D, (bf16*)(p.ws + WS_WG) + (size_t)L * D * D, nullptr, 0, scr, r, lane); continue; } r -= I_G;
        transpose_item(p.ple_wp + (size_t)L * 256 * D, 256, D, D, (bf16*)(p.ws + WS_WP) + (size_t)L * D * 256, nullptr, 0, scr, r, lane);
    }
    const size_t gtid = (size_t)bid * NTHREADS + tid, nthr = (size_t)nblk * NTHREADS;
    for (int r = gw; r < 2 * DEPTH * NEXP; r += NGW) {
        const int which = r >= DEPTH * NEXP, rr = which ? r - DEPTH * NEXP : r;
        const float* srow = (which ? p.peer_v : p.peer_u) + (size_t)rr * D + 4 * lane;
        f32x4 v[4];
#pragma unroll
        for (int j = 0; j < 4; ++j) v[j] = *(const f32x4*)(srow + 256 * j);
        float mx = 0.f;
#pragma unroll
        for (int j = 0; j < 4; ++j) mx = fmaxf(mx, fmaxf(fmaxf(fabsf(v[j][0]), fabsf(v[j][1])), fmaxf(fabsf(v[j][2]), fabsf(v[j][3]))));
        mx = xrow16_max(row16_max(mx));
        const float inv = mx > 0.f ? 127.f / mx : 0.f;
        u32x4 o;
#pragma unroll
        for (int j = 0; j < 4; ++j) {
            const unsigned b0 = (unsigned)__float2int_rn(v[j][0] * inv) & 0xffu, b1 = (unsigned)__float2int_rn(v[j][1] * inv) & 0xffu, b2 = (unsigned)__float2int_rn(v[j][2] * inv) & 0xffu, b3 = (unsigned)__float2int_rn(v[j][3] * inv) & 0xffu;
            o[j] = b0 | (b1 << 8) | (b2 << 16) | (b3 << 24);
        }
        *(u32x4*)(p.ws + (which ? WS_V : WS_U) + (size_t)rr * D + 16 * lane) = o;
        if (lane == 0) ((float*)(p.ws + (which ? WS_SV : WS_SU)))[rr] = mx * (1.f / 127.f);
    }
    convert_bulk(p.p, (bf16*)(p.ws + WS_PB), (size_t)DEPTH * M * 256, gtid, nthr);
    convert_bulk(p.subkeys, (bf16*)(p.ws + WS_SK), (size_t)DEPTH * 8 * 2 * 128 * 128, gtid, nthr);
    float* H = (float*)(p.ws + WS_H); bf16* HB0 = (bf16*)(p.ws + WS_HB0); float* ss0 = (float*)(p.ws + WS_STAT);
    for (int m = gw; m < M; m += NGW) {
        const f32x4* xr = (const f32x4*)(p.x + (size_t)m * D) + lane;
        float ss = 0.f;
#pragma unroll
        for (int j = 0; j < 4; ++j) {
            const f32x4 v = xr[64 * j];
            ss += v[0] * v[0] + v[1] * v[1] + v[2] * v[2] + v[3] * v[3];
            u32x2 o; o.x = pk2(v[0], v[1]); o.y = pk2(v[2], v[3]);
            ((u32x2*)(HB0 + (size_t)m * D))[lane + 64 * j] = o;
        }
        ss = wave_sum(ss);
        if (lane < 16) ss0[(size_t)m * 16 + lane] = lane == 0 ? ss : 0.f;
    }
}

typedef short v4i16_t __attribute__((ext_vector_type(4)));
__device__ __forceinline__ void glds16_asm(const void* gsrc, unsigned lds_dst) {
    unsigned keep;
    asm volatile("s_mov_b32 %0, m0\n\ts_mov_b32 m0, %2\n\ts_nop 0\n\tglobal_load_lds_dwordx4 %1, off\n\ts_mov_b32 m0, %0" : "=&s"(keep) : "v"(gsrc), "s"(lds_dst) : "memory");
}
__device__ __forceinline__ float max3_(float a, float b, float c) { float r; asm("v_max3_f32 %0, %1, %2, %3" : "=v"(r) : "v"(a), "v"(b), "v"(c)); return r; }
constexpr int ATT_BUF = 32768, ATT_VOFF = 16384;
__device__ __forceinline__ void att_unit(const Params& p, int L, LAS unsigned char* lds, int tid, int b, int hh, int qb, float lam, float lam_init) {
    const int lane = tid & 63, w = __builtin_amdgcn_readfirstlane(tid >> 6), fr = lane & 15, fq = lane >> 4;
    const bool grpB = w >= 4;
    const bf16* proj = (const bf16*)(p.ws + WS_PROJ);
    bf16* obuf = (bf16*)(p.ws + WS_OBUF);
    const float slope2 = 1.4426950408889634f / (float)(1 << (2 * (hh + 1)));
    const bf16* kbase = proj + (size_t)b * SEQ * PROJ_W + 512 + hh * 128;
    const bf16* vbase = proj + (size_t)b * SEQ * PROJ_W + 1024 + hh * 128;
    const int qw0 = qb * 128 + w * 16, T = 2 * (qb + 1);
    const int S_w = ((qw0 + 15) >> 6) + 1;
    bf16x8 qf[2][2];
#pragma unroll
    for (int mp = 0; mp < 2; ++mp)
#pragma unroll
        for (int ks = 0; ks < 2; ++ks) qf[mp][ks] = *(const bf16x8*)(proj + ((size_t)b * SEQ + qw0 + fr) * PROJ_W + hh * 128 + mp * 64 + ks * 32 + 8 * fq);
    f32x4 o[2][8];
#pragma unroll
    for (int mp = 0; mp < 2; ++mp)
#pragma unroll
        for (int dt = 0; dt < 8; ++dt) o[mp][dt] = (f32x4){0.f, 0.f, 0.f, 0.f};
    float mrun[2] = {-INFINITY, -INFINITY}, lrun[2] = {0.f, 0.f};
    int ksrc[2], vsrc[2];
#pragma unroll
    for (int i = 0; i < 2; ++i) { const int pc = tid + 512 * i, key = pc >> 4, ph = pc & 15;
        ksrc[i] = key * PROJ_W + ((ph ^ (key & 15)) * 8); vsrc[i] = key * PROJ_W + ((ph ^ ((key & 7) << 1)) * 8); }
    const unsigned ldsb = (unsigned)(size_t)lds;
    auto dma = [&](int t, int bo) {
#pragma unroll
        for (int i = 0; i < 2; ++i) {
            glds16_asm(kbase + (size_t)t * 64 * PROJ_W + ksrc[i], ldsb + bo + (w * 64 + 512 * i) * 16);
            glds16_asm(vbase + (size_t)t * 64 * PROJ_W + vsrc[i], ldsb + bo + ATT_VOFF + (w * 64 + 512 * i) * 16);
        }
    };
    int koff[2][2];
#pragma unroll
    for (int mp = 0; mp < 2; ++mp)
#pragma unroll
        for (int ks = 0; ks < 2; ++ks) koff[mp][ks] = fr * 256 + (((mp * 8 + ks * 4 + fq) ^ fr) << 4);
    const int gl = lane & 15;
    const int vrd0 = ATT_VOFF + (4 * fq + (gl >> 2)) * 256 + (gl & 3) * 8 + ((4 * (fq & 1) + (gl >> 2)) << 5);
    bf16x8 pb[2][2];
#pragma unroll
    for (int mp = 0; mp < 2; ++mp)
#pragma unroll
        for (int ks = 0; ks < 2; ++ks) pb[mp][ks] = qf[0][0];
#define ATT_SB() __builtin_amdgcn_sched_barrier(0)
#define ATT_VRD(dt) do { _Pragma("unroll") for (int q_ = 0; q_ < 4; ++q_) vf_[dt][q_] = __builtin_amdgcn_ds_read_tr16_b64_v4i16((LAS v4i16_t*)(lds + ((vb_ ^ ((dt) << 5)) + q_ * 4096))); } while (0)
#define ATT_VMM(PB, dt) do { _Pragma("unroll") for (int ks = 0; ks < 2; ++ks) { const v4i16_t v0 = vf_[dt][2 * ks], v1 = vf_[dt][2 * ks + 1]; \
            bf16x8 vf; vf[0] = v0[0]; vf[1] = v0[1]; vf[2] = v0[2]; vf[3] = v0[3]; vf[4] = v1[0]; vf[5] = v1[1]; vf[6] = v1[2]; vf[7] = v1[3]; \
            o[0][dt] = __builtin_amdgcn_mfma_f32_16x16x32_bf16(vf, PB[0][ks], o[0][dt], 0, 0, 0); \
            o[1][dt] = __builtin_amdgcn_mfma_f32_16x16x32_bf16(vf, PB[1][ks], o[1][dt], 0, 0, 0); } } while (0)
#define ATT_PV(PB, BO) do { const int vb_ = (BO) + vrd0; v4i16_t vf_[8][4]; \
        ATT_VRD(0); ATT_VRD(1); ATT_VRD(2); ATT_VRD(3); ATT_SB(); \
        ATT_VMM(PB, 0); ATT_VRD(4); ATT_SB(); ATT_VMM(PB, 1); ATT_VRD(5); ATT_SB(); ATT_VMM(PB, 2); ATT_VRD(6); ATT_SB(); ATT_VMM(PB, 3); ATT_VRD(7); ATT_SB(); \
        ATT_VMM(PB, 4); ATT_VMM(PB, 5); ATT_VMM(PB, 6); ATT_VMM(PB, 7); ATT_SB(); } while (0)
    dma(0, 0);
    asm volatile("" :: "v"(qf[0][0]), "v"(qf[0][1]), "v"(qf[1][0]), "v"(qf[1][1]));
    int bo_prev = 2 * ATT_BUF, bo_cur = 0, bo_next = ATT_BUF;
    for (int s = 0; s < T; ++s) {
        const int k0 = s * 64;
        asm volatile("s_waitcnt vmcnt(0)" ::: "memory");
        LDS_BARRIER();
        if (s + 1 < T) dma(s + 1, bo_next);
        if (grpB && s > 0 && s <= S_w) ATT_PV(pb, bo_prev);
        if (s < S_w) {
            f32x4 sc[2][4];
            const float base = -slope2 * (float)(qw0 + fr - k0 - 4 * fq);
#pragma unroll
            for (int kt = 0; kt < 4; ++kt)
#pragma unroll
                for (int r = 0; r < 4; ++r) { const float v = base + slope2 * (float)(16 * kt + r); sc[0][kt][r] = v; sc[1][kt][r] = v; }
            {
                bf16x8 kf[4][2][2];
#define ATT_KRD(kt) do { _Pragma("unroll") for (int mp = 0; mp < 2; ++mp) _Pragma("unroll") for (int ks = 0; ks < 2; ++ks) kf[kt][mp][ks] = *(const LAS bf16x8*)(lds + bo_cur + (kt) * 4096 + koff[mp][ks]); } while (0)
#define ATT_KMM(kt) do { _Pragma("unroll") for (int ks = 0; ks < 2; ++ks) _Pragma("unroll") for (int mp = 0; mp < 2; ++mp) sc[mp][kt] = __builtin_amdgcn_mfma_f32_16x16x32_bf16(kf[kt][mp][ks], qf[mp][ks], sc[mp][kt], 0, 0, 0); } while (0)
                ATT_KRD(0); ATT_KRD(1); ATT_SB();
                ATT_KMM(0); ATT_KRD(2); ATT_SB();
                ATT_KMM(1); ATT_KRD(3); ATT_SB();
                ATT_KMM(2); ATT_KMM(3); ATT_SB();
#undef ATT_KRD
#undef ATT_KMM
            }
            if (k0 + 63 > qw0) {
                const int lim = qw0 + fr - k0 - 4 * fq;
#pragma unroll
                for (int mp = 0; mp < 2; ++mp)
#pragma unroll
                    for (int kt = 0; kt < 4; ++kt)
#pragma unroll
                        for (int r = 0; r < 4; ++r) if (16 * kt + r > lim) sc[mp][kt][r] = -INFINITY;
            }
#pragma unroll
            for (int mp = 0; mp < 2; ++mp) {
                float mx = max3_(sc[mp][0][0], sc[mp][0][1], sc[mp][0][2]);
                mx = max3_(mx, sc[mp][0][3], sc[mp][1][0]);
#pragma unroll
                for (int kt = 1; kt < 4; ++kt) { mx = max3_(mx, sc[mp][kt][1], sc[mp][kt][2]); if (kt < 3) mx = max3_(mx, sc[mp][kt][3], sc[mp][kt + 1][0]); else mx = max3_(mx, sc[mp][kt][3], mx); }
                mx = xrow16_max(mx);
                const float mnew = fmaxf(mrun[mp], mx);
                const float alpha = __builtin_amdgcn_exp2f(mrun[mp] - mnew);
                mrun[mp] = mnew;
                float ps = 0.f;
#pragma unroll
                for (int kt = 0; kt < 4; ++kt)
#pragma unroll
                    for (int r = 0; r < 4; ++r) { const float e = __builtin_amdgcn_exp2f(sc[mp][kt][r] - mnew); sc[mp][kt][r] = e; ps += e; }
                lrun[mp] = lrun[mp] * alpha + ps;
#pragma unroll
                for (int ks = 0; ks < 2; ++ks) {
                    u32x4 pk; pk.x = cvtpk(sc[mp][2 * ks][0], sc[mp][2 * ks][1]); pk.y = cvtpk(sc[mp][2 * ks][2], sc[mp][2 * ks][3]);
                    pk.z = cvtpk(sc[mp][2 * ks + 1][0], sc[mp][2 * ks + 1][1]); pk.w = cvtpk(sc[mp][2 * ks + 1][2], sc[mp][2 * ks + 1][3]);
                    pb[mp][ks] = __builtin_bit_cast(bf16x8, pk);
                }
#pragma unroll
                for (int dt = 0; dt < 8; ++dt) o[mp][dt] = o[mp][dt] * alpha;
            }
            if (!grpB) ATT_PV(pb, bo_cur);
        }
        const int tb = bo_prev; bo_prev = bo_cur; bo_cur = bo_next; bo_next = tb;
    }
    if (grpB && S_w == T) ATT_PV(pb, bo_prev);
#undef ATT_PV
#undef ATT_VRD
#undef ATT_VMM
#undef ATT_SB
    const float i1 = __builtin_amdgcn_rcpf(xrow16_sum(lrun[0])), i2 = lam * __builtin_amdgcn_rcpf(xrow16_sum(lrun[1]));
    float ss = 0.f;
#pragma unroll
    for (int dt = 0; dt < 8; ++dt)
#pragma unroll
        for (int r = 0; r < 4; ++r) { const float v = o[0][dt][r] * i1 - o[1][dt][r] * i2; o[0][dt][r] = v; ss += v * v; }
    ss = xrow16_sum(ss);
    const float rn = rsqrtf(ss * (1.f / 128.f) + EPS) * (1.f - lam_init);
    const float* g = p.subln_g + L * 128;
    bf16* orow = obuf + ((size_t)b * SEQ + qw0 + fr) * D + hh * 128;
#pragma unroll
    for (int dt = 0; dt < 8; ++dt) {
        const f32x4 gv = *(const f32x4*)(g + 16 * dt + 4 * fq);
        u32x2 ov; ov.x = pk2(o[0][dt][0] * rn * gv[0], o[0][dt][1] * rn * gv[1]); ov.y = pk2(o[0][dt][2] * rn * gv[2], o[0][dt][3] * rn * gv[3]);
        *(u32x2*)(orow + 16 * dt + 4 * fq) = ov;
    }
}

__device__ void phase_att_queue(const Params& p, int L, LAS unsigned char* lds, int bid, int nblk) {
    const int tid = tidx(), lane = tid & 63;
    const float* lp = p.diff_lambda + L * 256;
    const float d1 = wave_sum(lp[lane] * lp[64 + lane]), d2 = wave_sum(lp[128 + lane] * lp[192 + lane]);
    const float lam_init = 0.8f - 0.6f * __expf(-0.3f * (float)L);
    const float lam = __expf(d1) - __expf(d2) + lam_init;
    unsigned* head = (unsigned*)(p.ws + WS_CTL) + CW_QUEUE + L;
    volatile LAS int* slot = (volatile LAS int*)(lds + LDS_MISC_OFF + 64);
    for (;;) {
        __syncthreads();
        if (tid == 0) *slot = (int)__hip_atomic_fetch_add(head, 1u, __ATOMIC_RELAXED, __HIP_MEMORY_SCOPE_AGENT);
        __syncthreads();
        const int u = *slot;
        if (u >= 512) break;
        att_unit(p, L, lds, tid, (u & 31) >> 2, u & 3, 15 - (u >> 5), lam, lam_init);
    }
}

constexpr size_t GD_WP = WS_ORAW, GD_QD = WS_ORAW + 16 * MiB, GD_AIP = WS_ORAW + 32 * MiB, GD_KDT = WS_ORAW + 40 * MiB, GD_UT = WS_ORAW + 56 * MiB, GD_GL = WS_ORAW + 72 * MiB;
__device__ __forceinline__ int perm_pos(int k) { return (k & ~31) + 8 * ((k >> 2) & 3) + 4 * ((k >> 4) & 1) + (k & 3); }
__device__ __forceinline__ float softplusf_(float x) { if (x > 20.f) return x; const float e = __expf(x); return e < 0.06f ? e * (1.f - e * (0.5f - e * (0.33333334f - 0.25f * e))) : __logf(1.f + e); }
__device__ __forceinline__ float gelu_erf(float v) {
    const float z = fabsf(v) * 0.70710678118654752f, t = __builtin_amdgcn_rcpf(1.f + 0.3275911f * z);
    const float pl = t * (0.254829592f + t * (-0.284496736f + t * (1.421413741f + t * (-1.453152027f + t * 1.061405429f))));
    const float er = 1.f - pl * __expf(-z * z);
    return 0.5f * v * (1.f + (v < 0.f ? -er : er));
}

constexpr int GP_KN = 0, GP_QN = 17408, GP_RT = 34816, GP_LM = 71680, GP_TB = 89088, GP_GT = 98304, GP_T0T = 99328;
constexpr int GP_KP = 272, GP_RP = 144, GP_LP = 68, GP_TP = 144;
__device__ void phase_gdn_prep(const Params& p, int L, LAS unsigned char* lds, int bid, int nblk) {
    const int tid = tidx(), lane = tid & 63, w = __builtin_amdgcn_readfirstlane(tid >> 6), fr = lane & 15, fq = lane >> 4;
    const bf16* proj = (const bf16*)(p.ws + WS_PROJ);
    const float* BA = (const float*)(p.ws + WS_BA);
    bf16* WP = (bf16*)(p.ws + GD_WP); bf16* QD = (bf16*)(p.ws + GD_QD); bf16* AIP = (bf16*)(p.ws + GD_AIP); bf16* KDT = (bf16*)(p.ws + GD_KDT); bf16* UT = (bf16*)(p.ws + GD_UT);
    float* GL = (float*)(p.ws + GD_GL);
    const float* cw = p.conv_w + (size_t)L * 4 * 1536;
    LAS float* beta_s = (LAS float*)(lds + GP_GT); LAS float* gc_s = beta_s + 64; LAS float* egc_s = gc_s + 64; LAS float* edl_s = egc_s + 64;
    LAS float* Lm = (LAS float*)(lds + GP_LM);
    for (int item = bid; item < 1024; item += nblk) {
        const int n = item & 31, bh = item >> 5, hh = bh & 3, b = bh >> 2, t0 = n * 64;
        const size_t row0 = (size_t)b * SEQ + t0;
        __syncthreads();
        const int colq = hh * 128 + 2 * lane;
        unsigned xq[11], xk[11], xv[11];
#pragma unroll
        for (int r = 0; r < 11; ++r) { const int tt = t0 + 8 * w - 3 + r;
            xq[r] = (tt >= 0) ? *(const unsigned*)(proj + ((size_t)b * SEQ + tt) * PROJ_W + 1536 + colq) : 0u;
            xk[r] = (tt >= 0) ? *(const unsigned*)(proj + ((size_t)b * SEQ + tt) * PROJ_W + 1536 + 512 + colq) : 0u;
            xv[r] = (tt >= 0) ? *(const unsigned*)(proj + ((size_t)b * SEQ + tt) * PROJ_W + 1536 + 1024 + colq) : 0u; }
        if (w == 0) {
            const float negA = -__expf(p.a_log[L * 4 + hh]), dtb = p.dt_bias[L * 4 + hh];
            const float bb = BA[(row0 + lane) * 8 + hh], aa = BA[(row0 + lane) * 8 + 4 + hh] + dtb;
            float c = negA * softplusf_(aa);
#pragma unroll
            for (int o = 1; o < 64; o <<= 1) { const float t = __shfl_up(c, o); if (lane >= o) c += t; }
            const float glast = __shfl(c, 63);
            beta_s[lane] = sigmoidf_(bb); gc_s[lane] = c; egc_s[lane] = __expf(c); edl_s[lane] = __expf(glast - c);
            if (lane == 0) GL[item] = __expf(glast);
        }
        __syncthreads();
        {
            {
                float wq[4][2];
#pragma unroll
                for (int j = 0; j < 4; ++j) { wq[j][0] = cw[j * 1536 + colq]; wq[j][1] = cw[j * 1536 + colq + 1]; }
#pragma unroll
                for (int i = 0; i < 8; ++i) {
                    const int c = 8 * w + i;
                    float q0 = 0.f, q1 = 0.f;
#pragma unroll
                    for (int j = 0; j < 4; ++j) { q0 += wq[j][0] * lo16(xq[i + j]); q1 += wq[j][1] * hi16(xq[i + j]); }
                    q0 *= sigmoidf_(q0); q1 *= sigmoidf_(q1);
                    const float sq = rsqrtf(wave_sum(q0 * q0 + q1 * q1) + EPS) * 0.08838834764831845f;
                    q0 *= sq; q1 *= sq;
                    const float eg = egc_s[c];
                    *(LAS unsigned*)(lds + GP_QN + c * GP_KP + lane * 4) = pk2(q0, q1);
                    *(unsigned*)(QD + ((size_t)item * 64 + c) * 128 + perm_pos(2 * lane)) = pk2(q0 * eg, q1 * eg);
                }
            }
            __builtin_amdgcn_sched_barrier(0);
            {
                float wk[4][2];
#pragma unroll
                for (int j = 0; j < 4; ++j) { wk[j][0] = cw[j * 1536 + 512 + colq]; wk[j][1] = cw[j * 1536 + 512 + colq + 1]; }
                unsigned kd0[8], kd1[8], rk0[8], rk1[8];
#pragma unroll
                for (int i = 0; i < 8; ++i) {
                    const int c = 8 * w + i;
                    float k0 = 0.f, k1 = 0.f;
#pragma unroll
                    for (int j = 0; j < 4; ++j) { k0 += wk[j][0] * lo16(xk[i + j]); k1 += wk[j][1] * hi16(xk[i + j]); }
                    k0 *= sigmoidf_(k0); k1 *= sigmoidf_(k1);
                    const float sk = rsqrtf(wave_sum(k0 * k0 + k1 * k1) + EPS);
                    k0 *= sk; k1 *= sk;
                    const float be = beta_s[c], eg = egc_s[c], ed = edl_s[c];
                    *(LAS unsigned*)(lds + GP_KN + c * GP_KP + lane * 4) = pk2(k0, k1);
                    kd0[i] = f2bf(k0 * ed); kd1[i] = f2bf(k1 * ed);
                    rk0[i] = f2bf(k0 * be * eg); rk1[i] = f2bf(k1 * be * eg);
                }
                u32x4 o;
                o.x = rk0[0] | (rk0[1] << 16); o.y = rk0[2] | (rk0[3] << 16); o.z = rk0[4] | (rk0[5] << 16); o.w = rk0[6] | (rk0[7] << 16); *(LAS u32x4*)(lds + GP_RT + (128 + 2 * lane) * GP_RP + 16 * w) = o;
                o.x = rk1[0] | (rk1[1] << 16); o.y = rk1[2] | (rk1[3] << 16); o.z = rk1[4] | (rk1[5] << 16); o.w = rk1[6] | (rk1[7] << 16); *(LAS u32x4*)(lds + GP_RT + (128 + 2 * lane + 1) * GP_RP + 16 * w) = o;
                const int pa = perm_pos(8 * w), pb = perm_pos(8 * w + 4);
                bf16* kr0 = KDT + ((size_t)item * 128 + 2 * lane) * 64; bf16* kr1 = kr0 + 64;
                u32x2 h2;
                h2.x = kd0[0] | (kd0[1] << 16); h2.y = kd0[2] | (kd0[3] << 16); *(u32x2*)(kr0 + pa) = h2;
                h2.x = kd0[4] | (kd0[5] << 16); h2.y = kd0[6] | (kd0[7] << 16); *(u32x2*)(kr0 + pb) = h2;
                h2.x = kd1[0] | (kd1[1] << 16); h2.y = kd1[2] | (kd1[3] << 16); *(u32x2*)(kr1 + pa) = h2;
                h2.x = kd1[4] | (kd1[5] << 16); h2.y = kd1[6] | (kd1[7] << 16); *(u32x2*)(kr1 + pb) = h2;
            }
            __builtin_amdgcn_sched_barrier(0);
            {
                float wv[4][2];
#pragma unroll
                for (int j = 0; j < 4; ++j) { wv[j][0] = cw[j * 1536 + 1024 + colq]; wv[j][1] = cw[j * 1536 + 1024 + colq + 1]; }
                unsigned rv0[8], rv1[8];
#pragma unroll
                for (int i = 0; i < 8; ++i) {
                    float v0 = 0.f, v1 = 0.f;
#pragma unroll
                    for (int j = 0; j < 4; ++j) { v0 += wv[j][0] * lo16(xv[i + j]); v1 += wv[j][1] * hi16(xv[i + j]); }
                    v0 *= sigmoidf_(v0); v1 *= sigmoidf_(v1);
                    const float be = beta_s[8 * w + i];
                    rv0[i] = f2bf(v0 * be); rv1[i] = f2bf(v1 * be);
                }
                u32x4 o;
                o.x = rv0[0] | (rv0[1] << 16); o.y = rv0[2] | (rv0[3] << 16); o.z = rv0[4] | (rv0[5] << 16); o.w = rv0[6] | (rv0[7] << 16); *(LAS u32x4*)(lds + GP_RT + (2 * lane) * GP_RP + 16 * w) = o;
                o.x = rv1[0] | (rv1[1] << 16); o.y = rv1[2] | (rv1[3] << 16); o.z = rv1[4] | (rv1[5] << 16); o.w = rv1[6] | (rv1[7] << 16); *(LAS u32x4*)(lds + GP_RT + (2 * lane + 1) * GP_RP + 16 * w) = o;
            }
        }
        __syncthreads();
#pragma unroll
        for (int q = 0; q < 2; ++q) {
            const int id = 2 * w + q, ct = id >> 2, st = id & 3;
            if (st <= ct) {
                f32x4 acc = (f32x4){0.f, 0.f, 0.f, 0.f};
#pragma unroll
                for (int ks = 0; ks < 4; ++ks) {
                    const bf16x8 a = *(const LAS bf16x8*)(lds + GP_KN + (16 * ct + fr) * GP_KP + (32 * ks + 8 * fq) * 2);
                    const bf16x8 bb = *(const LAS bf16x8*)(lds + GP_KN + (16 * st + fr) * GP_KP + (32 * ks + 8 * fq) * 2);
                    acc = __builtin_amdgcn_mfma_f32_16x16x32_bf16(a, bb, acc, 0, 0, 0);
                }
                const int s = 16 * st + fr; const float gs = gc_s[s];
#pragma unroll
                for (int r = 0; r < 4; ++r) { const int c = 16 * ct + 4 * fq + r;
                    Lm[c * GP_LP + s] = (s < c) ? beta_s[c] * acc[r] * __expf(fminf(gc_s[c] - gs, 0.f)) : 0.f; }
            }
        }
        __syncthreads();
        if (w < 2) {
            const int o = 32 * w;
            float t[32];
            int zoff = 0; asm volatile("" : "+v"(zoff));
            const LAS float* Lz = Lm + zoff + o * GP_LP + o;
            const int col = lane & 31;
#pragma unroll
            for (int i = 0; i < 32; ++i) {
                float a0 = (i == lane) ? 1.f : 0.f, a1 = 0.f, a2 = 0.f, a3 = 0.f;
#pragma unroll
                for (int s4 = 0; s4 + 4 <= i; s4 += 4) { const f32x4 lv = *(const LAS f32x4*)(Lz + i * GP_LP + s4);
                    a0 -= lv[0] * t[s4]; a1 -= lv[1] * t[s4 + 1]; a2 -= lv[2] * t[s4 + 2]; a3 -= lv[3] * t[s4 + 3]; }
#pragma unroll
                for (int s = i & ~3; s < i; ++s) a0 -= Lz[i * GP_LP + s] * t[s];
                t[i] = (lane < 32) ? (a0 + a1) + (a2 + a3) : 0.f;
                const bf16 tb = (bf16)f2bf(t[i]);
                if (w == 0) { *(LAS bf16*)(lds + GP_TB + i * GP_TP + lane * 2) = tb;
                              if (lane < 32) *(LAS bf16*)(lds + GP_T0T + lane * 80 + i * 2) = tb; }
                else if (lane < 32) *(LAS bf16*)(lds + GP_TB + (32 + i) * GP_TP + (32 + col) * 2) = tb;
                if ((i & 3) == 3) __builtin_amdgcn_sched_barrier(0);
            }
        } else {
            for (int id = w - 2; id < 16; id += 6) {
                const int ct = id >> 2, st = id & 3;
                f32x4 acc = (f32x4){0.f, 0.f, 0.f, 0.f};
                if (st <= ct) {
#pragma unroll
                    for (int ks = 0; ks < 4; ++ks) {
                        const bf16x8 a = *(const LAS bf16x8*)(lds + GP_QN + (16 * ct + fr) * GP_KP + (32 * ks + 8 * fq) * 2);
                        const bf16x8 bb = *(const LAS bf16x8*)(lds + GP_KN + (16 * st + fr) * GP_KP + (32 * ks + 8 * fq) * 2);
                        acc = __builtin_amdgcn_mfma_f32_16x16x32_bf16(a, bb, acc, 0, 0, 0);
                    }
                }
                const int s = 16 * st + fr; const float gs = gc_s[s]; const int ps = perm_pos(s);
#pragma unroll
                for (int r = 0; r < 4; ++r) { const int c = 16 * ct + 4 * fq + r;
                    const float v = (s <= c) ? acc[r] * __expf(fminf(gc_s[c] - gs, 0.f)) : 0.f;
                    AIP[((size_t)item * 64 + c) * 64 + ps] = (bf16)f2bf(v); }
            }
        }
        __syncthreads();
        if (w == 0) {
            f32x4 P[2][2];
#pragma unroll
            for (int it = 0; it < 2; ++it) {
                const LAS float* lr = Lm + (32 + 16 * it + fr) * GP_LP + 8 * fq;
                const f32x4 l0 = *(const LAS f32x4*)lr, l1 = *(const LAS f32x4*)(lr + 4);
                u32x4 pk; pk.x = cvtpk(l0[0], l0[1]); pk.y = cvtpk(l0[2], l0[3]); pk.z = cvtpk(l1[0], l1[1]); pk.w = cvtpk(l1[2], l1[3]);
                const bf16x8 a = __builtin_bit_cast(bf16x8, pk);
#pragma unroll
                for (int jt = 0; jt < 2; ++jt) {
                    const bf16x8 bb = *(const LAS bf16x8*)(lds + GP_T0T + (16 * jt + fr) * 80 + 16 * fq);
                    P[it][jt] = __builtin_amdgcn_mfma_f32_16x16x32_bf16(a, bb, (f32x4){0.f, 0.f, 0.f, 0.f}, 0, 0, 0);
                }
            }
#pragma unroll
            for (int jt = 0; jt < 2; ++jt) {
                u32x4 pk; pk.x = cvtpk(P[0][jt][0], P[0][jt][1]); pk.y = cvtpk(P[0][jt][2], P[0][jt][3]); pk.z = cvtpk(P[1][jt][0], P[1][jt][1]); pk.w = cvtpk(P[1][jt][2], P[1][jt][3]);
                const bf16x8 pb = __builtin_bit_cast(bf16x8, pk);
#pragma unroll
                for (int i2 = 0; i2 < 2; ++i2) {
                    const LAS unsigned char* tr = lds + GP_TB + (32 + 16 * i2 + fr) * GP_TP + (32 + 4 * fq) * 2;
                    const u32x2 ta = *(const LAS u32x2*)tr, tb2 = *(const LAS u32x2*)(tr + 32);
                    u32x4 ak; ak.x = ta.x; ak.y = ta.y; ak.z = tb2.x; ak.w = tb2.y;
                    const f32x4 r = __builtin_amdgcn_mfma_f32_16x16x32_bf16(__builtin_bit_cast(bf16x8, ak), pb, (f32x4){0.f, 0.f, 0.f, 0.f}, 0, 0, 0);
#pragma unroll
                    for (int q = 0; q < 4; ++q) *(LAS bf16*)(lds + GP_TB + (32 + 16 * i2 + 4 * fq + q) * GP_TP + (16 * jt + fr) * 2) = (bf16)f2bf(-r[q]);
                }
            }
        }
        __syncthreads();
#pragma unroll
        for (int q = 0; q < 2; ++q) {
            const int colt = 2 * w + q;
            bf16x8 af[2];
#pragma unroll
            for (int ks = 0; ks < 2; ++ks) af[ks] = *(const LAS bf16x8*)(lds + GP_RT + (16 * colt + fr) * GP_RP + (32 * ks + 8 * fq) * 2);
#pragma unroll
            for (int ct = 0; ct < 4; ++ct) {
                f32x4 acc = (f32x4){0.f, 0.f, 0.f, 0.f};
#pragma unroll
                for (int ks = 0; ks < 2; ++ks) {
                    const bf16x8 bb = *(const LAS bf16x8*)(lds + GP_TB + (16 * ct + fr) * GP_TP + (32 * ks + 8 * fq) * 2);
                    acc = __builtin_amdgcn_mfma_f32_16x16x32_bf16(af[ks], bb, acc, 0, 0, 0);
                }
                const int c = 16 * ct + fr;
                if (colt < 8) {
#pragma unroll
                    for (int r = 0; r < 4; ++r) UT[((size_t)item * 128 + 16 * colt + 4 * fq + r) * 64 + c] = (bf16)f2bf(acc[r]);
                } else {
                    const int kt = colt - 8;
                    u32x2 h2; h2.x = pk2(-acc[0], -acc[1]); h2.y = pk2(-acc[2], -acc[3]);
                    *(u32x2*)(WP + ((size_t)item * 64 + c) * 128 + 32 * (kt >> 1) + 8 * fq + 4 * (kt & 1)) = h2;
                }
            }
        }
    }
    __syncthreads();
}

constexpr int GS_WP = 0, GS_QD = 16384, GS_AIP = 32768, GS_KDT = 40960, GS_BUF = 57344, GS_OB = 2 * GS_BUF, GS_OBP = 272, GS_OBT = 64 * GS_OBP;
__device__ void phase_gdn_scan(const Params& p, int L, LAS unsigned char* lds, int bid, int nblk) {
    const int tid = tidx(), lane = tid & 63, w = __builtin_amdgcn_readfirstlane(tid >> 6), fr = lane & 15, fq = lane >> 4;
    const bf16* proj = (const bf16*)(p.ws + WS_PROJ);
    const bf16* WP = (const bf16*)(p.ws + GD_WP); const bf16* QD = (const bf16*)(p.ws + GD_QD); const bf16* AIP = (const bf16*)(p.ws + GD_AIP);
    const bf16* KDT = (const bf16*)(p.ws + GD_KDT); const bf16* UT = (const bf16*)(p.ws + GD_UT); const float* GL = (const float*)(p.ws + GD_GL);
    bf16* obuf = (bf16*)(p.ws + WS_OBUF);
    for (int item = bid; item < 32; item += nblk) {
        const int hh = item & 3, b = item >> 2;
        const int fc = tid >> 4, fv = tid & 15;
        float gn[8];
#pragma unroll
        for (int i = 0; i < 8; ++i) gn[i] = p.gdn_norm_g[L * 128 + 8 * fv + i];
        f32x4 S[8];
#pragma unroll
        for (int kt = 0; kt < 8; ++kt) S[kt] = (f32x4){0.f, 0.f, 0.f, 0.f};
        auto dma = [&](int ci, int buf) {
#pragma unroll
            for (int i = 0; i < 7; ++i) {
                const int pc = tid + 512 * i;
                const bf16* src;
                if (i < 2) { const int r = pc >> 4; src = WP + (size_t)ci * 8192 + r * 128 + (((pc & 15) ^ (r & 15)) * 8); }
                else if (i < 4) { const int q = pc - 1024, r = q >> 4; src = QD + (size_t)ci * 8192 + r * 128 + (((q & 15) ^ (r & 15)) * 8); }
                else if (i < 5) { const int q = pc - 2048, r = q >> 3; src = AIP + (size_t)ci * 4096 + r * 64 + (((q & 7) ^ ((r >> 1) & 7)) * 8); }
                else { const int q = pc - 2560, r = q >> 3; src = KDT + (size_t)ci * 8192 + r * 64 + (((q & 7) ^ ((r >> 1) & 7)) * 8); }
                __builtin_amdgcn_global_load_lds((const unsigned*)src, (LAS unsigned*)(lds + buf * GS_BUF + (w * 64 + 512 * i) * 16), 16, 0, 0);
            }
        };
        int offk[4], offa[2];
#pragma unroll
        for (int ks = 0; ks < 4; ++ks) offk[ks] = fr * 256 + (((4 * ks + fq) ^ fr) * 16);
#pragma unroll
        for (int ss = 0; ss < 2; ++ss) offa[ss] = fr * 128 + (((4 * ss + fq) ^ ((fr >> 1) & 7)) * 16);
        __syncthreads();
        dma(item * 32, 0);
        u32x2 ut[4]; float gl;
        {
            const int ci = item * 32;
#pragma unroll
            for (int ct = 0; ct < 4; ++ct) ut[ct] = *(const u32x2*)(UT + ((size_t)ci * 128 + 16 * w + fr) * 64 + 16 * ct + 4 * fq);
            gl = GL[ci];
        }
        u32x4 zp[2];
        zp[0] = (u32x4){0u, 0u, 0u, 0u}; zp[1] = zp[0];
        asm volatile("s_waitcnt vmcnt(0)" ::: "memory");
        __syncthreads();
#define GS_FINISH(ps, TILE, DST) do { const int c = 32 * (ps) + fc; \
            const u32x4 ov = *(const LAS u32x4*)(lds + (TILE) + c * GS_OBP + fv * 16); \
            float o8[8]; \
            _Pragma("unroll") for (int i = 0; i < 4; ++i) { o8[2 * i] = lo16(ov[i]); o8[2 * i + 1] = hi16(ov[i]); } \
            float ss = 0.f; \
            _Pragma("unroll") for (int i = 0; i < 8; ++i) ss += o8[i] * o8[i]; \
            const float rn = rsqrtf(row16_sum(ss) * (1.f / 128.f) + EPS); \
            u32x4 res; \
            _Pragma("unroll") for (int i = 0; i < 4; ++i) { \
                const float z0 = lo16(zp[ps][i]), z1 = hi16(zp[ps][i]); \
                res[i] = cvtpk(o8[2 * i] * rn * gn[2 * i] * (z0 * sigmoidf_(z0)), o8[2 * i + 1] * rn * gn[2 * i + 1] * (z1 * sigmoidf_(z1))); } \
            *(u32x4*)((DST) + (size_t)c * D) = res; } while (0)
        bf16* const dummy = (bf16*)(p.ws + WS_Q2) + tid * 8;
        for (int n = 0; n < 32; ++n) {
            const int ci = item * 32 + n, buf = n & 1;
            const size_t rowc = (size_t)b * SEQ + n * 64;
            if (n + 1 < 32) dma(ci + 1, buf ^ 1);
            u32x2 utn[4]; float gln = 0.f;
            {
                const int cn = ci + (n + 1 < 32 ? 1 : 0);
#pragma unroll
                for (int ct = 0; ct < 4; ++ct) utn[ct] = *(const u32x2*)(UT + ((size_t)cn * 128 + 16 * w + fr) * 64 + 16 * ct + 4 * fq);
                gln = GL[cn];
            }
            u32x4 zq[2];
#pragma unroll
            for (int ps = 0; ps < 2; ++ps) zq[ps] = *(const u32x4*)(proj + (rowc + 32 * ps + fc) * PROJ_W + 3072 + hh * 128 + 8 * fv);
            bf16* const fdst = n > 0 ? obuf + (rowc - 64) * D + 512 + hh * 128 + 8 * fv : dummy;
            const int tprev = GS_OB + (buf ^ 1) * GS_OBT, tcur = GS_OB + buf * GS_OBT;
            f32x4 vn[4], oacc[4];
#pragma unroll
            for (int ct = 0; ct < 4; ++ct) { vn[ct] = (f32x4){lo16(ut[ct].x), hi16(ut[ct].x), lo16(ut[ct].y), hi16(ut[ct].y)}; oacc[ct] = (f32x4){0.f, 0.f, 0.f, 0.f}; }
            bf16x8 sb[4];
#pragma unroll
            for (int ks = 0; ks < 4; ++ks) { u32x4 pk; pk.x = cvtpk(S[2 * ks][0], S[2 * ks][1]); pk.y = cvtpk(S[2 * ks][2], S[2 * ks][3]); pk.z = cvtpk(S[2 * ks + 1][0], S[2 * ks + 1][1]); pk.w = cvtpk(S[2 * ks + 1][2], S[2 * ks + 1][3]);
                sb[ks] = __builtin_bit_cast(bf16x8, pk); }
            LAS unsigned char* bb = lds + buf * GS_BUF;
            bf16x8 f0[8], f1[8];
#define LD_A(F, ct) do { _Pragma("unroll") for (int ks = 0; ks < 4; ++ks) { F[ks] = *(const LAS bf16x8*)(bb + GS_WP + (ct) * 4096 + offk[ks]); \
                    F[4 + ks] = *(const LAS bf16x8*)(bb + GS_QD + (ct) * 4096 + offk[ks]); } } while (0)
#define MM_A(F, ct) do { _Pragma("unroll") for (int ks = 0; ks < 4; ++ks) { vn[ct] = __builtin_amdgcn_mfma_f32_16x16x32_bf16(F[ks], sb[ks], vn[ct], 0, 0, 0); \
                    oacc[ct] = __builtin_amdgcn_mfma_f32_16x16x32_bf16(sb[ks], F[4 + ks], oacc[ct], 0, 0, 0); } } while (0)
#define SBAR() __builtin_amdgcn_sched_barrier(0)
            LD_A(f0, 0); SBAR();
            LD_A(f1, 1); MM_A(f0, 0); SBAR();
            LD_A(f0, 2); MM_A(f1, 1); GS_FINISH(0, tprev, fdst); SBAR();
            LD_A(f1, 3); MM_A(f0, 2); SBAR();
#pragma unroll
            for (int ct = 0; ct < 4; ++ct)
#pragma unroll
                for (int ss = 0; ss < 2; ++ss) f0[2 * ct + ss] = *(const LAS bf16x8*)(bb + GS_AIP + ct * 2048 + offa[ss]);
            MM_A(f1, 3); GS_FINISH(1, tprev, fdst); SBAR();
            bf16x8 vb[2];
#pragma unroll
            for (int ss = 0; ss < 2; ++ss) { u32x4 pk; pk.x = cvtpk(vn[2 * ss][0], vn[2 * ss][1]); pk.y = cvtpk(vn[2 * ss][2], vn[2 * ss][3]); pk.z = cvtpk(vn[2 * ss + 1][0], vn[2 * ss + 1][1]); pk.w = cvtpk(vn[2 * ss + 1][2], vn[2 * ss + 1][3]);
                vb[ss] = __builtin_bit_cast(bf16x8, pk); }
#pragma unroll
            for (int kt = 0; kt < 4; ++kt)
#pragma unroll
                for (int ss = 0; ss < 2; ++ss) f1[2 * kt + ss] = *(const LAS bf16x8*)(bb + GS_KDT + kt * 2048 + offa[ss]);
#pragma unroll
            for (int ct = 0; ct < 4; ++ct)
#pragma unroll
                for (int ss = 0; ss < 2; ++ss) oacc[ct] = __builtin_amdgcn_mfma_f32_16x16x32_bf16(vb[ss], f0[2 * ct + ss], oacc[ct], 0, 0, 0);
            SBAR();
#pragma unroll
            for (int kt = 4; kt < 8; ++kt)
#pragma unroll
                for (int ss = 0; ss < 2; ++ss) f0[2 * (kt - 4) + ss] = *(const LAS bf16x8*)(bb + GS_KDT + kt * 2048 + offa[ss]);
#pragma unroll
            for (int kt = 0; kt < 4; ++kt) {
                S[kt] = S[kt] * gl;
#pragma unroll
                for (int ss = 0; ss < 2; ++ss) S[kt] = __builtin_amdgcn_mfma_f32_16x16x32_bf16(f1[2 * kt + ss], vb[ss], S[kt], 0, 0, 0);
            }
#pragma unroll
            for (int ct = 0; ct < 4; ++ct) {
                u32x2 pk; pk.x = cvtpk(oacc[ct][0], oacc[ct][1]); pk.y = cvtpk(oacc[ct][2], oacc[ct][3]);
                *(LAS u32x2*)(lds + tcur + (16 * ct + fr) * GS_OBP + (16 * w + 4 * fq) * 2) = pk;
            }
            SBAR();
#pragma unroll
            for (int kt = 4; kt < 8; ++kt) {
                S[kt] = S[kt] * gl;
#pragma unroll
                for (int ss = 0; ss < 2; ++ss) S[kt] = __builtin_amdgcn_mfma_f32_16x16x32_bf16(f0[2 * (kt - 4) + ss], vb[ss], S[kt], 0, 0, 0);
            }
#undef LD_A
#undef MM_A
#undef SBAR
#pragma unroll
            for (int ct = 0; ct < 4; ++ct) ut[ct] = utn[ct];
            gl = gln; zp[0] = zq[0]; zp[1] = zq[1];
            asm volatile("s_waitcnt vmcnt(0)" ::: "memory");
            LDS_BARRIER();
        }
        {
            bf16* const fdst = obuf + ((size_t)b * SEQ + 31 * 64) * D + 512 + hh * 128 + 8 * fv;
            GS_FINISH(0, GS_OB + GS_OBT, fdst); GS_FINISH(1, GS_OB + GS_OBT, fdst);
        }
#undef GS_FINISH
        __syncthreads();
    }
}

__device__ __forceinline__ unsigned sortable(float f) { const unsigned u = __float_as_uint(f); return u ^ ((unsigned)((int)u >> 31) | 0x80000000u); }
__device__ __forceinline__ float unsortable(unsigned s) { return __uint_as_float((s & 0x80000000u) ? (s ^ 0x80000000u) : ~s); }
#define CE(a, b) do { const unsigned _x = k[a], _y = k[b]; k[a] = _x > _y ? _x : _y; k[b] = _x > _y ? _y : _x; } while (0)
constexpr int PE_TK = 0, PE_TAB = 8192, PE_ID = 8448, PE_GT = PE_ID + 32768, PE_SK = PE_GT + 32768;
__device__ void phase_peer(const Params& p, int L, LAS unsigned char* lds, int bid, int nblk) {
    const int tid = tidx(), lane = tid & 63, w = __builtin_amdgcn_readfirstlane(tid >> 6), fr = lane & 15, fq = lane >> 4;
    const bf16* Q2 = (const bf16*)(p.ws + WS_Q2);
    const bf16* SK = (const bf16*)(p.ws + WS_SK) + (size_t)L * 8 * 2 * 128 * 128;
    float* H = (float*)(p.ws + WS_H); bf16* HB2 = (bf16*)(p.ws + WS_HB2);
    const unsigned char* U = p.ws + WS_U + (size_t)L * NEXP * D;
    const unsigned char* V = p.ws + WS_V + (size_t)L * NEXP * D;
    const float* SU = (const float*)(p.ws + WS_SU) + (size_t)L * NEXP; const float* SV = (const float*)(p.ws + WS_SV) + (size_t)L * NEXP;
    const float* g = p.ln_ffn_g + L * D;
    LAS unsigned* TK = (LAS unsigned*)(lds + PE_TK);
    LAS unsigned short* TAB = (LAS unsigned short*)(lds + PE_TAB);
    LAS int* IDL = (LAS int*)(lds + PE_ID); LAS float* GTL = (LAS float*)(lds + PE_GT);
    if (tid < 64) {
        int a = 0, base = 0, q = tid; unsigned short v = 0xffff;
        if (q < 50) { for (;;) { const int cnt = 16 / (a + 1); if (q < base + cnt) break; base += cnt; ++a; } v = (unsigned short)((a << 8) | (q - base)); }
        TAB[tid] = v;
    }
    for (int item = bid; item < M / 64; item += nblk) {
        const int tok0 = item * 64;
        int tid_o = tid; asm volatile("" : "+v"(tid_o));
        const int tid = tid_o, lane = tid & 63, fr = lane & 15, fq = lane >> 4;
        __syncthreads();
        const int tg = w & 3, cc = w >> 2;
        int zs = 0; asm volatile("" : "+v"(zs));
        const bf16* SK_ = SK + zs;
#define SK_FETCH(hd) do { _Pragma("unroll") for (int i = 0; i < 8; ++i) { const int pc = tid + 512 * i, nn = (pc >> 4) & 127; \
            __builtin_amdgcn_global_load_lds((const unsigned*)(SK_ + ((size_t)((hd) * 2 + (pc >> 11)) * 128 + nn) * 128 + (((pc & 15) ^ (nn & 15)) * 8)), \
                                             (LAS unsigned*)(lds + PE_SK + (w * 64 + 512 * i) * 16), 16, 0, 0); } } while (0)
        SK_FETCH(0);
        bf16x8 qn[4];
        const bf16* qrow = Q2 + (size_t)(tok0 + 16 * tg + fr) * 2048 + cc * 128 + 8 * fq;
#pragma unroll
        for (int ks = 0; ks < 4; ++ks) qn[ks] = *(const bf16x8*)(qrow + 32 * ks);
        asm volatile("s_waitcnt vmcnt(0)" ::: "memory");
        __syncthreads();
        for (int hh = 0; hh < 8; ++hh) {
            {
                f32x4 acc[8];
#pragma unroll
                for (int nt = 0; nt < 8; ++nt) acc[nt] = (f32x4){0.f, 0.f, 0.f, 0.f};
                bf16x8 qa[4];
#pragma unroll
                for (int ks = 0; ks < 4; ++ks) qa[ks] = qn[ks];
                {
                    const int hn = hh + 1 < 8 ? hh + 1 : hh;
#pragma unroll
                    for (int ks = 0; ks < 4; ++ks) qn[ks] = *(const bf16x8*)(qrow + hn * 256 + 32 * ks);
                }
                const LAS unsigned char* skb = lds + PE_SK + cc * 32768 + fr * 256;
#pragma unroll
                for (int nt = 0; nt < 8; ++nt)
#pragma unroll
                    for (int ks = 0; ks < 4; ++ks) {
                        const bf16x8 kb = *(const LAS bf16x8*)(skb + nt * 4096 + (((4 * ks + fq) ^ fr) << 4));
                        acc[nt] = __builtin_amdgcn_mfma_f32_16x16x32_bf16(qa[ks], kb, acc[nt], 0, 0, 0);
                    }
#pragma unroll
                for (int r = 0; r < 4; ++r) {
                    unsigned k[8];
#pragma unroll
                    for (int nt = 0; nt < 8; ++nt) k[nt] = (sortable(acc[nt][r]) & ~0x7Fu) | (unsigned)(127 - (16 * nt + fr));
                    CE(0, 1); CE(2, 3); CE(4, 5); CE(6, 7); CE(0, 2); CE(1, 3); CE(4, 6); CE(5, 7); CE(1, 2); CE(5, 6); CE(0, 4); CE(3, 7);
                    CE(1, 5); CE(2, 6); CE(1, 4); CE(3, 6); CE(2, 4); CE(3, 5); CE(3, 4);
                    unsigned res = 0u;
#pragma unroll
                    for (int rd = 0; rd < 16; ++rd) {
                        const unsigned m = row16_umax(k[0]);
                        const bool win = k[0] == m;
#pragma unroll
                        for (int i = 0; i < 7; ++i) k[i] = win ? k[i + 1] : k[i];
                        k[7] = win ? 0u : k[7];
                        res = (fr == rd) ? m : res;
                    }
                    TK[(cc * 64 + 16 * tg + 4 * fq + r) * 16 + fr] = res;
                }
            }
            __syncthreads();
            if (hh + 1 < 8) SK_FETCH(hh + 1);
#pragma unroll
            for (int ps = 0; ps < 2; ++ps) {
                const int tl = 8 * w + 4 * ps + fq;
                unsigned k[4];
#pragma unroll
                for (int sl = 0; sl < 4; ++sl) {
                    const int q = sl * 16 + fr;
                    const unsigned ab = TAB[q];
                    const unsigned k1 = TK[tl * 16 + ((ab >> 8) & 15)], k2 = TK[(64 + tl) * 16 + (ab & 15)];
                    const float v = unsortable(k1 & ~0x7Fu) + unsortable(k2 & ~0x7Fu);
                    k[sl] = (q < 50) ? ((sortable(v) & ~0x3Fu) | (unsigned)(63 - q)) : 0u;
                }
                CE(0, 1); CE(2, 3); CE(0, 2); CE(1, 3); CE(1, 2);
                unsigned res = 0u;
#pragma unroll
                for (int rd = 0; rd < 16; ++rd) {
                    const unsigned m = row16_umax(k[0]);
                    const bool win = k[0] == m;
                    k[0] = win ? k[1] : k[0]; k[1] = win ? k[2] : k[1]; k[2] = win ? k[3] : k[2]; k[3] = win ? 0u : k[3];
                    res = (fr == rd) ? m : res;
                }
                const unsigned ab = TAB[63 - (res & 0x3Fu)];
                const unsigned k1 = TK[tl * 16 + ((ab >> 8) & 15)], k2 = TK[(64 + tl) * 16 + (ab & 15)];
                const float v = unsortable(k1 & ~0x7Fu) + unsortable(k2 & ~0x7Fu);
                const float e = __expf(v - row16_max(v));
                const float sum = row16_sum(e);
                IDL[tl * 128 + hh * 16 + fr] = (int)((127u - (k1 & 0x7Fu)) * 128u + (127u - (k2 & 0x7Fu)));
                GTL[tl * 128 + hh * 16 + fr] = e * __builtin_amdgcn_rcpf(sum);
            }
            asm volatile("s_waitcnt vmcnt(0)" ::: "memory");
            __syncthreads();
        }
#undef SK_FETCH
        for (int ti = 0; ti < 8; ++ti) {
            const int tl = 8 * w + ti;
            unsigned k0 = ((unsigned)IDL[tl * 128 + lane] << 7) | (unsigned)lane, k1 = ((unsigned)IDL[tl * 128 + 64 + lane] << 7) | (unsigned)(64 + lane);
#pragma unroll
            for (int kk = 2; kk <= 128; kk <<= 1) {
#pragma unroll
                for (int j = kk >> 1; j >= 1; j >>= 1) {
                    if (j == 64) { const unsigned lo = k0 < k1 ? k0 : k1, hi = k0 < k1 ? k1 : k0; k0 = lo; k1 = hi; }
                    else {
                        const unsigned p0 = (unsigned)__shfl_xor((int)k0, j), p1 = (unsigned)__shfl_xor((int)k1, j);
                        const bool up0 = ((lane & kk) == 0) || kk == 128, up1 = (((lane + 64) & kk) == 0);
                        const bool low = (lane & j) == 0;
                        k0 = (low == up0) ? (k0 < p0 ? k0 : p0) : (k0 > p0 ? k0 : p0);
                        k1 = (low == (kk == 128 ? true : up1)) ? (k1 < p1 ? k1 : p1) : (k1 > p1 ? k1 : p1);
                    }
                }
            }
            const float g0 = GTL[tl * 128 + (k0 & 127u)], g1 = GTL[tl * 128 + (k1 & 127u)];
            asm volatile("s_waitcnt lgkmcnt(0)" ::: "memory");
            IDL[tl * 128 + lane] = (int)(k0 >> 7); IDL[tl * 128 + 64 + lane] = (int)(k1 >> 7);
            GTL[tl * 128 + lane] = g0; GTL[tl * 128 + 64 + lane] = g1;
        }
        __syncthreads();
        {
            int zo = 0; asm volatile("" : "+v"(zo));
            const float* g_ = g + zo; const unsigned char* U_ = U + zo; const float* H_ = H + zo;
            int xq[8][4]; float sx[8];
#pragma unroll
            for (int t = 0; t < 8; ++t) {
                const float* hrow = H_ + (size_t)(tok0 + 8 * w + t) * D + 4 * lane;
                float xn[16];
#pragma unroll
                for (int j = 0; j < 4; ++j) { const f32x4 a = *(const f32x4*)(hrow + 256 * j); xn[4 * j] = a[0]; xn[4 * j + 1] = a[1]; xn[4 * j + 2] = a[2]; xn[4 * j + 3] = a[3]; }
                float ss = 0.f;
#pragma unroll
                for (int i = 0; i < 16; ++i) ss += xn[i] * xn[i];
                const float rstd = rsqrtf(wave_sum(ss) * (1.f / D) + EPS);
                float mx = 0.f;
#pragma unroll
                for (int i = 0; i < 16; ++i) { xn[i] = xn[i] * rstd * g_[256 * (i >> 2) + 4 * lane + (i & 3)]; mx = fmaxf(mx, fabsf(xn[i])); }
                mx = xrow16_max(row16_max(mx));
                const float xinv = mx > 0.f ? 127.f / mx : 0.f; sx[t] = mx * (1.f / 127.f);
#pragma unroll
                for (int j = 0; j < 4; ++j) xq[t][j] = (int)(((unsigned)__float2int_rn(xn[4 * j] * xinv) & 0xffu) | (((unsigned)__float2int_rn(xn[4 * j + 1] * xinv) & 0xffu) << 8) |
                                                             (((unsigned)__float2int_rn(xn[4 * j + 2] * xinv) & 0xffu) << 16) | ((unsigned)__float2int_rn(xn[4 * j + 3] * xinv) << 24));
                if (t & 1) { asm volatile("" ::: "memory"); __builtin_amdgcn_sched_barrier(0); }
            }
            int hi[8][2];
#pragma unroll
            for (int t = 0; t < 8; ++t) { hi[t][0] = 0; hi[t][1] = 0; }
            const LAS int* idw = IDL + 8 * w * 128;
            u32x4 ring[16];
#pragma unroll
            for (int j = 0; j < 16; ++j) ring[j] = *(const u32x4*)(U_ + (size_t)idw[(j & 7) * 128 + (j >> 3)] * D + 16 * lane);
#pragma unroll 1
            for (int k = 0; k < 64; ++k) {
#pragma unroll
                for (int j = 0; j < 16; ++j) {
                    const int t = j & 7, pos = 2 * k + (j >> 3);
                    const u32x4 a = ring[j];
                    if (k < 63) ring[j] = *(const u32x4*)(U_ + (size_t)idw[t * 128 + pos + 2] * D + 16 * lane);
                    int d = __builtin_amdgcn_sdot4((int)a[0], xq[t][0], 0, false);
                    d = __builtin_amdgcn_sdot4((int)a[1], xq[t][1], d, false); d = __builtin_amdgcn_sdot4((int)a[2], xq[t][2], d, false); d = __builtin_amdgcn_sdot4((int)a[3], xq[t][3], d, false);
                    d = wave_isum(d);
                    if (lane == (pos & 63)) { if (k < 32) hi[t][0] = d; else hi[t][1] = d; }
                }
            }
#pragma unroll
            for (int t = 0; t < 8; ++t) {
                const int tl = 8 * w + t;
                const int id0 = IDL[tl * 128 + lane], id1 = IDL[tl * 128 + 64 + lane];
                const float su0 = SU[id0], su1 = SU[id1], sv0 = SV[id0], sv1 = SV[id1];
                const float h0 = su0 * sx[t] * (float)hi[t][0], h1 = su1 * sx[t] * (float)hi[t][1];
                GTL[tl * 128 + lane] = sv0 * GTL[tl * 128 + lane] * gelu_erf(h0);
                GTL[tl * 128 + 64 + lane] = sv1 * GTL[tl * 128 + 64 + lane] * gelu_erf(h1);

            }
        }
        {
            int zo = 0; asm volatile("" : "+v"(zo));
            const unsigned char* V_ = V + zo; float* H_ = H + zo; bf16* HB2_ = HB2 + zo;
            int wq[8]; float sw[8];
#pragma unroll
            for (int t = 0; t < 8; ++t) {
                const int tl = 8 * w + t;
                const float w0 = GTL[tl * 128 + lane], w1 = GTL[tl * 128 + 64 + lane];
                const float wmx = xrow16_max(row16_max(fmaxf(fabsf(w0), fabsf(w1))));
                const float winv = wmx > 0.f ? 127.f / wmx : 0.f; sw[t] = wmx * (1.f / 127.f);
                const f32x4 wv = *(const LAS f32x4*)(GTL + tl * 128 + 4 * (lane & 31));
                wq[t] = (int)(((unsigned)__float2int_rn(wv[0] * winv) & 0xffu) | (((unsigned)__float2int_rn(wv[1] * winv) & 0xffu) << 8) |
                              (((unsigned)__float2int_rn(wv[2] * winv) & 0xffu) << 16) | ((unsigned)__float2int_rn(wv[3] * winv) << 24));

            }
            const LAS int* idw = IDL + 8 * w * 128;
#pragma unroll
            for (int hf = 0; hf < 2; ++hf) {
                int yi[4][16];
#pragma unroll
                for (int g4 = 0; g4 < 4; ++g4)
#pragma unroll
                    for (int i = 0; i < 16; ++i) yi[g4][i] = 0;
                u32x4 ring[16];
#pragma unroll
                for (int j = 0; j < 16; ++j) ring[j] = *(const u32x4*)(V_ + (size_t)idw[(4 * hf + (j >> 2)) * 128 + (j & 3)] * D + 16 * lane);
#pragma unroll 1
                for (int s4 = 0; s4 < 32; ++s4) {
#pragma unroll
                    for (int g4 = 0; g4 < 4; ++g4) {
                        const int t = 4 * hf + g4;
                        const int wg = __builtin_amdgcn_readlane(wq[t], s4);
#pragma unroll
                        for (int q = 0; q < 4; ++q) {
                            const unsigned a0 = ring[4 * g4][q], a1 = ring[4 * g4 + 1][q], a2 = ring[4 * g4 + 2][q], a3 = ring[4 * g4 + 3][q];
                            const unsigned p0 = __builtin_amdgcn_perm(a1, a0, 0x05010400u), p1 = __builtin_amdgcn_perm(a1, a0, 0x07030602u);
                            const unsigned p2 = __builtin_amdgcn_perm(a3, a2, 0x05010400u), p3 = __builtin_amdgcn_perm(a3, a2, 0x07030602u);
                            yi[g4][4 * q] = __builtin_amdgcn_sdot4((int)__builtin_amdgcn_perm(p2, p0, 0x05040100u), wg, yi[g4][4 * q], false);
                            yi[g4][4 * q + 1] = __builtin_amdgcn_sdot4((int)__builtin_amdgcn_perm(p2, p0, 0x07060302u), wg, yi[g4][4 * q + 1], false);
                            yi[g4][4 * q + 2] = __builtin_amdgcn_sdot4((int)__builtin_amdgcn_perm(p3, p1, 0x05040100u), wg, yi[g4][4 * q + 2], false);
                            yi[g4][4 * q + 3] = __builtin_amdgcn_sdot4((int)__builtin_amdgcn_perm(p3, p1, 0x07060302u), wg, yi[g4][4 * q + 3], false);
                        }
                        __builtin_amdgcn_sched_barrier(0);
                        if (s4 < 31) {
#pragma unroll
                            for (int q = 0; q < 4; ++q) ring[4 * g4 + q] = *(const u32x4*)(V_ + (size_t)idw[t * 128 + 4 * (s4 + 1) + q] * D + 16 * lane);
                        }
                        __builtin_amdgcn_sched_barrier(0);
                    }
                }
#pragma unroll
                for (int g4 = 0; g4 < 4; ++g4) {
                    const int t = 4 * hf + g4, tok = tok0 + 8 * w + t;
                    float* hrow = H_ + (size_t)tok * D + 4 * lane;
                    float y[16];
#pragma unroll
                    for (int j = 0; j < 4; ++j) { const f32x4 a = *(const f32x4*)(hrow + 256 * j); y[4 * j] = a[0]; y[4 * j + 1] = a[1]; y[4 * j + 2] = a[2]; y[4 * j + 3] = a[3]; }
#pragma unroll
                    for (int i = 0; i < 16; ++i) y[i] = y[i] + sw[t] * (float)yi[g4][i];
#pragma unroll
                    for (int j = 0; j < 4; ++j) *(f32x4*)(hrow + 256 * j) = (f32x4){y[4 * j], y[4 * j + 1], y[4 * j + 2], y[4 * j + 3]};
                    bf16* hb = HB2_ + (size_t)tok * D + 4 * lane;
#pragma unroll
                    for (int j = 0; j < 4; ++j) { u32x2 o2; o2.x = pk2(y[4 * j], y[4 * j + 1]); o2.y = pk2(y[4 * j + 2], y[4 * j + 3]); *(u32x2*)(hb + 256 * j) = o2; }

                }
            }
        }
    }
    __syncthreads();
}
#undef CE

__device__ void phase_final(const Params& p, int bid, int nblk) {
    const int tid = tidx(), lane = tid & 63, gw = bid * NWAVES + (tid >> 6), NGW = nblk * NWAVES;
    const float* H = (const float*)(p.ws + WS_H);
    for (int m = gw; m < M; m += NGW) {
        f32x4 v[4]; float ss = 0.f;
#pragma unroll
        for (int j = 0; j < 4; ++j) { v[j] = ((const f32x4*)(H + (size_t)m * D))[lane + 64 * j]; ss += (v[j][0] * v[j][0] + v[j][1] * v[j][1]) + (v[j][2] * v[j][2] + v[j][3] * v[j][3]); }
        const float r = rsqrtf(wave_sum(ss) * (1.f / D) + EPS);
#pragma unroll
        for (int j = 0; j < 4; ++j) { const f32x4 gv = ((const f32x4*)p.final_g)[lane + 64 * j]; ((f32x4*)(p.out + (size_t)m * D))[lane + 64 * j] = v[j] * r * gv; }
    }
}

#define XB_TMO      128
#define XB_XCNT(j)  (256  + 64 * (j))
#define XB_XSUB(j)  (1280 + 64 * (j))
#define XB_XGEN(j)  (2304 + 64 * (j))
#define XB_TOP      3328
#define XB_TOPGEN   3392
#define XCD_BAR_WORDS 3456
#define XB_SPIN_CAP (1u << 22)
__device__ __forceinline__ unsigned xb_ld(unsigned* p)              { return __hip_atomic_load(p, __ATOMIC_RELAXED, __HIP_MEMORY_SCOPE_AGENT); }
__device__ __forceinline__ unsigned xb_add(unsigned* p, unsigned v) { return __hip_atomic_fetch_add(p, v, __ATOMIC_RELAXED, __HIP_MEMORY_SCOPE_AGENT); }
__device__ __forceinline__ unsigned xb_xcc_id() { return (unsigned)__builtin_amdgcn_s_getreg((3 << 11) | 20) & 0xFu; }
#define XB_SPIN(cond, bar) do { unsigned _sp = 0; while (cond) { __builtin_amdgcn_s_sleep(1); \
    if ((++_sp & 255u) == 0u) { if (xb_ld(&(bar)[XB_TMO])) break; if (_sp > XB_SPIN_CAP) { atomicAdd(&(bar)[XB_TMO], 1u); break; } } } } while (0)
struct XcdBarrier { unsigned* bar; unsigned x; volatile LAS unsigned* st; };
__device__ __forceinline__ XcdBarrier xcd_barrier_post(unsigned* bar, volatile LAS unsigned* st) {
    XcdBarrier b; b.bar = bar; b.x = xb_xcc_id(); b.st = st;
    if (threadIdx.x == 0) (void)xb_add(&bar[XB_XCNT(b.x)], 1u);
    return b;
}
__device__ __forceinline__ void xcd_barrier_complete(unsigned* bar, unsigned x, unsigned& nloc, unsigned& nx) {
    const unsigned G = gridDim.x * gridDim.y * gridDim.z;
    unsigned sum, cnt, mine, sp = 0u;
    for (;;) {
        sum = 0u; cnt = 0u; mine = 0u;
#pragma unroll
        for (unsigned j = 0; j < 16; ++j) { const unsigned c = xb_ld(&bar[XB_XCNT(j)]); sum += c; cnt += (c > 0u) ? 1u : 0u; mine = (j == x) ? c : mine; }
        if (sum == G) break;
        __builtin_amdgcn_s_sleep(1);
        if ((++sp & 255u) == 0u) { if (xb_ld(&bar[XB_TMO])) break; if (sp > XB_SPIN_CAP) { atomicAdd(&bar[XB_TMO], 1u); break; } }
    }
    nloc = mine > 0u ? mine : 1u; nx = cnt > 0u ? cnt : 1u;
}
__device__ __forceinline__ void xcd_barrier(const XcdBarrier& b) {
    asm volatile("s_waitcnt vmcnt(0)" ::: "memory");
    __syncthreads();
    if (threadIdx.x == 0) {
        unsigned* bar = b.bar;
        __builtin_amdgcn_s_waitcnt(0);
        unsigned nloc = b.st[0], nx = b.st[1];
        if (nloc == 0u) { xcd_barrier_complete(bar, b.x, nloc, nx); b.st[0] = nloc; b.st[1] = nx; }
        const unsigned old = xb_add(&bar[XB_XSUB(b.x)], 1u);
        const unsigned gen = old / nloc;
        if (old + 1u == (gen + 1u) * nloc) {
            __builtin_amdgcn_fence(__ATOMIC_RELEASE, "agent");
            asm volatile("s_waitcnt vmcnt(0)" ::: "memory");
            const unsigned og = xb_add(&bar[XB_TOP], 1u);
            const unsigned tg = og / nx;
            if (og + 1u == (tg + 1u) * nx) xb_add(&bar[XB_TOPGEN], 1u);
            else XB_SPIN(xb_ld(&bar[XB_TOPGEN]) == tg, bar);
            __builtin_amdgcn_fence(__ATOMIC_ACQUIRE, "agent");
            xb_add(&bar[XB_XGEN(b.x)], 1u);
            asm volatile("s_waitcnt vmcnt(0)" ::: "memory");
        } else {
            XB_SPIN(xb_ld(&bar[XB_XGEN(b.x)]) == gen, bar);
            __builtin_amdgcn_fence(__ATOMIC_ACQUIRE, "agent");
            asm volatile("s_waitcnt vmcnt(0)" ::: "memory");
        }
    }
    __syncthreads();
}
constexpr int CW_BAR = 4096;

constexpr int K_PROLOGUE = 11, K_FINAL = 12;
template <int KIND>
__device__ __forceinline__ void run_kind(const Params& p, int L, LAS unsigned char* lds, int bid, int nblk) {
    unsigned char* ws = p.ws;
    float* H = (float*)(ws + WS_H);
    float* ss0 = (float*)(ws + WS_STAT); float* ss1 = (float*)(ws + WS_SS1); float* sse = (float*)(ws + WS_SSE);
    if constexpr (KIND == K_PROLOGUE) phase_prologue(p, lds, bid, nblk);
    if constexpr (KIND == K_FINAL) phase_final(p, bid, nblk);
    if constexpr (KIND == 0) { EpiProj E{nullptr, (bf16*)(ws + WS_PROJ), (float*)(ws + WS_BA)};
        gemm_run(lds, (const bf16*)(ws + WS_HB0), (const bf16*)(ws + WS_WIN) + (size_t)L * IN_PAD * D, M, IN_PAD, D, E, bid, nblk, ss0); }
    if constexpr (KIND == 1) phase_gdn_prep(p, L, lds, bid, nblk);
    if constexpr (KIND == 2) { phase_gdn_scan(p, L, lds, bid, nblk); phase_att_queue(p, L, lds, bid, nblk); }
    if constexpr (KIND == 3) { EpiRes E{ss1, H, (bf16*)(ws + WS_HB1), L == 0 ? p.x : (const float*)H};
        gemm_run(lds, (const bf16*)(ws + WS_OBUF), (const bf16*)(ws + WS_WOUT) + (size_t)L * D * D, M, D, D, E, bid, nblk); }
    if constexpr (KIND == 4) { EpiQ2 E{nullptr, (bf16*)(ws + WS_Q2)};
        gemm_run(lds, (const bf16*)(ws + WS_HB1), (const bf16*)(ws + WS_WQ) + (size_t)L * 2048 * D, M, 2048, D, E, bid, nblk, ss1); }
    if constexpr (KIND == 5) phase_peer(p, L, lds, bid, nblk);
    if constexpr (KIND == 7) { EpiE E2{sse, (bf16*)(ws + WS_EPRE)};
        gemm_run(lds, (const bf16*)(ws + WS_PB) + (size_t)L * M * 256, (const bf16*)(ws + WS_WP) + (size_t)L * D * 256, M, D, 256, E2, bid, nblk); }
    if constexpr (KIND == 6) { EpiPle E{ss0, H, (bf16*)(ws + WS_HB0), (const bf16*)(ws + WS_EPRE), p.ple_norm_g + L * D};
        gemm_run(lds, (const bf16*)(ws + WS_HB2), (const bf16*)(ws + WS_WG) + (size_t)L * D * D, M, D, D, E, bid, nblk, sse); }
}

__device__ __forceinline__ Params params_off(const Params& s, size_t z) {
    Params q;
    q.x = s.x + z; q.p = s.p + z; q.ln_mix_g = s.ln_mix_g + z; q.w_in = s.w_in + z; q.conv_w = s.conv_w + z; q.a_log = s.a_log + z; q.dt_bias = s.dt_bias + z;
    q.gdn_norm_g = s.gdn_norm_g + z; q.diff_lambda = s.diff_lambda + z; q.subln_g = s.subln_g + z; q.w_out = s.w_out + z; q.ln_ffn_g = s.ln_ffn_g + z;
    q.peer_wq = s.peer_wq + z; q.subkeys = s.subkeys + z; q.peer_u = s.peer_u + z; q.peer_v = s.peer_v + z; q.ple_wp = s.ple_wp + z; q.ple_wg = s.ple_wg + z;
    q.ple_norm_g = s.ple_norm_g + z; q.final_g = s.final_g + z; q.out = s.out + z; q.ws = s.ws + z; q.pad0 = 0; q.pad1 = 0;
    return q;
}
#define RUN(KIND) do { size_t z_ = 0; int L_ = L; asm volatile("" : "+s"(z_), "+s"(L_)); const Params q_ = params_off(p, z_); run_kind<KIND>(q_, L_, (LAS unsigned char*)lds, (int)blockIdx.x, (int)gridDim.x); } while (0)
#define GRID_BARRIER() do { XcdBarrier b_; b_.bar = (unsigned*)(p.ws + WS_CTL) + CW_BAR; b_.x = xb_xcc_id(); b_.st = (volatile LAS unsigned*)((LAS unsigned char*)lds + LDS_MISC_OFF) + 8; xcd_barrier(b_); } while (0)
__global__ void __launch_bounds__(NTHREADS, 2) mk_fwd(Params p) {
    extern __shared__ __attribute__((aligned(16))) unsigned char lds[];
    {
        volatile LAS unsigned* misc = (volatile LAS unsigned*)((LAS unsigned char*)lds + LDS_MISC_OFF);
        if (threadIdx.x < 64) misc[threadIdx.x] = 0u;
        __syncthreads();
        (void)xcd_barrier_post((unsigned*)(p.ws + WS_CTL) + CW_BAR, misc + 8);
    }
    { int L = 0; RUN(K_PROLOGUE); }
    cg::this_grid().sync();
#define LAYER(LL) do { const int L = (LL); RUN(0); GRID_BARRIER(); RUN(1); GRID_BARRIER(); RUN(2); GRID_BARRIER(); RUN(3); GRID_BARRIER(); RUN(4); GRID_BARRIER(); RUN(5); RUN(7); GRID_BARRIER(); RUN(6); GRID_BARRIER(); } while (0)
    LAYER(0); LAYER(1); LAYER(2); LAYER(3);
#undef LAYER
    { int L = 0; RUN(K_FINAL); }
}

extern "C" void kernel_launch(void* const* d_in, const int* in_sizes, int n_in, void* d_out, int out_size, void* d_ws, size_t ws_size, hipStream_t stream) {
    static int grid = 0;
    if (grid == 0) {
        if (n_in != 20 || out_size != M * D || ws_size < WS_END) { fprintf(stderr, "kernel_launch: unexpected shapes (n_in %d, out %d, ws %zu < %zu)\n", n_in, out_size, ws_size, (size_t)WS_END); grid = -1; return; }
        int dev = 0, cus = 0, per_cu = 0;
        (void)hipGetDevice(&dev); (void)hipDeviceGetAttribute(&cus, hipDeviceAttributeMultiprocessorCount, dev);
        if (hipFuncSetAttribute((const void*)mk_fwd, hipFuncAttributeMaxDynamicSharedMemorySize, LDS_BYTES) != hipSuccess) { fprintf(stderr, "kernel_launch: hipFuncSetAttribute failed\n"); grid = -1; return; }
        if (hipOccupancyMaxActiveBlocksPerMultiprocessor(&per_cu, (const void*)mk_fwd, NTHREADS, LDS_BYTES) != hipSuccess || per_cu < 1) { fprintf(stderr, "kernel_launch: occupancy query says %d blocks per CU\n", per_cu); (void)hipGetLastError(); grid = -1; return; }
        grid = (cus > 0 ? cus : 256);
    }
    if (grid < 0) return;
    (void)hipMemsetAsync((char*)d_ws + WS_CTL, 0, CTL_ZERO_BYTES, stream);
    Params p{};
    const float** pp = (const float**)&p;
    for (int i = 0; i < 20; ++i) pp[i] = (const float*)d_in[i];
    p.out = (float*)d_out; p.ws = (unsigned char*)d_ws;
    void* args[] = {&p};
    hipError_t e = hipLaunchCooperativeKernel((const void*)mk_fwd, dim3(grid), dim3(NTHREADS), args, LDS_BYTES, stream);
    if (e != hipSuccess) fprintf(stderr, "kernel_launch: cooperative launch failed: %s (grid %d)\n", hipGetErrorString(e), grid);
}
```

```cpp
#include <hip/hip_runtime.h>
#include <hip/hip_cooperative_groups.h>
#include <cstdio>
#include <cstdint>
namespace cg = cooperative_groups;

#define LAS __attribute__((address_space(3)))
typedef unsigned short bf16;
typedef float f32x4 __attribute__((ext_vector_type(4)));
typedef short bf16x8 __attribute__((ext_vector_type(8)));
typedef unsigned u32x4 __attribute__((ext_vector_type(4)));
typedef unsigned u32x2 __attribute__((ext_vector_type(2)));

constexpr int D = 1024, BATCH = 8, SEQ = 2048, DEPTH = 4, M = BATCH * SEQ;
constexpr int IN_COLS = 3592, IN_PAD = 3840, PROJ_W = 3584;
constexpr int NEXP = 16384;
constexpr float EPS = 1e-6f;
constexpr float QSCALE = 0.125f * 1.4426950408889634f;
constexpr int NWAVES = 8, NTHREADS = 512;
constexpr int LDS_BYTES = 163840;
constexpr int LDS_MISC_OFF = LDS_BYTES - 256;
constexpr int RS_OFF = 147456;
constexpr int CW_QUEUE = 1024;

constexpr size_t MiB = 1u << 20;
constexpr size_t WS_CTL = 0, CTL_ZERO_BYTES = 1 * MiB;
constexpr size_t WS_H = 1 * MiB;
constexpr size_t WS_HB0 = 65 * MiB;
constexpr size_t WS_HB1 = 97 * MiB;
constexpr size_t WS_HB2 = 129 * MiB;
constexpr size_t WS_PROJ = 161 * MiB;
constexpr size_t WS_BA = 273 * MiB;
constexpr size_t WS_OBUF = 274 * MiB;
constexpr size_t WS_Q2 = 306 * MiB;
constexpr size_t WS_EPRE = 370 * MiB;
constexpr size_t WS_IDX = 402 * MiB;
constexpr size_t WS_GATE = 410 * MiB;
constexpr size_t WS_STAT = 418 * MiB;
constexpr size_t WS_SS1 = WS_IDX + 1 * MiB, WS_SSE = WS_IDX;
constexpr size_t WS_ORAW = 422 * MiB;
constexpr size_t WS_WIN = 550 * MiB;
constexpr size_t WS_WOUT = 582 * MiB;
constexpr size_t WS_WQ = 590 * MiB;
constexpr size_t WS_WG = 606 * MiB;
constexpr size_t WS_WP = 614 * MiB;
constexpr size_t WS_SK = 616 * MiB;
constexpr size_t WS_PB = 618 * MiB;
constexpr size_t WS_U = 650 * MiB;
constexpr size_t WS_V = 778 * MiB;
constexpr size_t WS_SU = WS_STAT + 1 * MiB, WS_SV = WS_STAT + 2 * MiB;
constexpr size_t WS_END = 906 * MiB;

struct Params {
    const float *x, *p, *ln_mix_g, *w_in, *conv_w, *a_log, *dt_bias, *gdn_norm_g, *diff_lambda, *subln_g, *w_out, *ln_ffn_g,
        *peer_wq, *subkeys, *peer_u, *peer_v, *ple_wp, *ple_wg, *ple_norm_g, *final_g;
    float* out;
    unsigned char* ws;
    int pad0, pad1;
};

__device__ __forceinline__ int tidx() { int t = (int)threadIdx.x; asm volatile("" : "+v"(t)); return t; }
#define LDS_BARRIER() asm volatile("s_waitcnt lgkmcnt(0)\n\ts_barrier" ::: "memory")
__device__ __forceinline__ float bf2f(bf16 v) { return __uint_as_float((unsigned)v << 16); }
__device__ __forceinline__ unsigned f2bf(float f);
typedef __bf16 bf16x2_t __attribute__((ext_vector_type(2)));
typedef float f32x2_t __attribute__((ext_vector_type(2)));
__device__ __forceinline__ unsigned cvtpk(float lo, float hi) { f32x2_t v = {lo, hi}; bf16x2_t b = __builtin_convertvector(v, bf16x2_t); return __builtin_bit_cast(unsigned, b); }
__device__ __forceinline__ unsigned pk2(float lo, float hi) { return cvtpk(lo, hi); }
__device__ __forceinline__ unsigned f2bf(float f) { return cvtpk(f, 0.f) & 0xffffu; }
__device__ __forceinline__ float lo16(unsigned w) { return __uint_as_float(w << 16); }
__device__ __forceinline__ float hi16(unsigned w) { return __uint_as_float(w & 0xffff0000u); }
template <int N> __device__ __forceinline__ float dpp_ror(float x) { return __builtin_bit_cast(float, __builtin_amdgcn_mov_dpp(__builtin_bit_cast(int, x), 0x120 + N, 0xf, 0xf, true)); }
template <int N> __device__ __forceinline__ unsigned dpp_ror_u(unsigned x) { return (unsigned)__builtin_amdgcn_mov_dpp((int)x, 0x120 + N, 0xf, 0xf, true); }
__device__ __forceinline__ float row16_sum(float x) { x += dpp_ror<8>(x); x += dpp_ror<4>(x); x += dpp_ror<2>(x); x += dpp_ror<1>(x); return x; }
__device__ __forceinline__ float row16_max(float x) { x = fmaxf(x, dpp_ror<8>(x)); x = fmaxf(x, dpp_ror<4>(x)); x = fmaxf(x, dpp_ror<2>(x)); x = fmaxf(x, dpp_ror<1>(x)); return x; }
__device__ __forceinline__ unsigned row16_umax(unsigned x) { unsigned y;
    y = dpp_ror_u<8>(x); x = x > y ? x : y; y = dpp_ror_u<4>(x); x = x > y ? x : y; y = dpp_ror_u<2>(x); x = x > y ? x : y; y = dpp_ror_u<1>(x); x = x > y ? x : y; return x; }
__device__ __forceinline__ float xrow16_max(float x) {
    auto s = __builtin_amdgcn_permlane16_swap(__float_as_uint(x), __float_as_uint(x), false, false);
    x = fmaxf(__uint_as_float(s[0]), __uint_as_float(s[1]));
    auto t = __builtin_amdgcn_permlane32_swap(__float_as_uint(x), __float_as_uint(x), false, false);
    return fmaxf(__uint_as_float(t[0]), __uint_as_float(t[1]));
}
__device__ __forceinline__ float xrow16_sum(float x) {
    auto s = __builtin_amdgcn_permlane16_swap(__float_as_uint(x), __float_as_uint(x), false, false);
    x = __uint_as_float(s[0]) + __uint_as_float(s[1]);
    auto t = __builtin_amdgcn_permlane32_swap(__float_as_uint(x), __float_as_uint(x), false, false);
    return __uint_as_float(t[0]) + __uint_as_float(t[1]);
}
__device__ __forceinline__ float wave_sum(float v) { return xrow16_sum(row16_sum(v)); }
template <int N> __device__ __forceinline__ int dpp_ror_i(int x) { return __builtin_amdgcn_mov_dpp(x, 0x120 + N, 0xf, 0xf, true); }
__device__ __forceinline__ int wave_isum(int x) {
    x += dpp_ror_i<8>(x); x += dpp_ror_i<4>(x); x += dpp_ror_i<2>(x); x += dpp_ror_i<1>(x);
    auto s = __builtin_amdgcn_permlane16_swap((unsigned)x, (unsigned)x, false, false); x = (int)(s[0] + s[1]);
    auto t = __builtin_amdgcn_permlane32_swap((unsigned)x, (unsigned)x, false, false); return (int)(t[0] + t[1]);
}
__device__ __forceinline__ float wave_max(float v) {
#pragma unroll
    for (int o = 32; o; o >>= 1) v = fmaxf(v, __shfl_xor(v, o));
    return v;
}
__device__ __forceinline__ float sigmoidf_(float x) { return __builtin_amdgcn_rcpf(1.f + __expf(-x)); }
__device__ __forceinline__ float dot8(u32x4 a, u32x4 b, float s) {
#pragma unroll
    for (int i = 0; i < 4; ++i) { s += lo16(a[i]) * lo16(b[i]); s += hi16(a[i]) * hi16(b[i]); }
    return s;
}

__host__ __device__ __forceinline__ int lds_byte(int r, int c) { const int st = (r >> 4) * 2 + (c >> 5), rr = r & 15, cc = c & 31, ob = rr * 64 + cc * 2; return st * 1024 + (ob ^ (((ob >> 9) & 1) << 5)); }
__host__ __device__ __forceinline__ void stage_rc(int b, int& R, int& C) { const int st = b / 1024, sb = b % 1024, swz = sb ^ (((sb >> 9) & 1) << 5); R = (st >> 1) * 16 + swz / 64; C = (st & 1) * 32 + (swz % 64) / 2; }
constexpr int HTB = 16384;
template <class F>
__device__ __forceinline__ void gemm_run(LAS unsigned char* lds, const bf16* A, const bf16* Bt, int Mm, int N, int K, const F& f, int bid, int nblk, const float* slots_in = nullptr) {
    LAS float* RS = (LAS float*)(lds + RS_OFF);
    int rs_pm = -1;
    const int tid = tidx(), wid = __builtin_amdgcn_readfirstlane(tid >> 6), lane = tid & 63, wr = wid >> 2, wc = wid & 3, fr = lane & 15, fq = lane >> 4;
    const int nt = K / 64, ntn = N / 256, nunits = (Mm / 256) * ntn;
    unsigned voff[2];
#pragma unroll
    for (int i = 0; i < 2; ++i) { const int uu = tid + 512 * i, r = uu >> 3, c = (uu & 7) ^ ((r >> 1) & 7); voff[i] = (unsigned)(r * K + c * 8) * 2u; }
    const unsigned ldsw = (unsigned)wid * 1024u;
    const int sw7 = (fr >> 1) & 7;
    const int aoff0 = wr * HTB + fr * 128 + ((fq ^ sw7) << 4), aoff1 = wr * HTB + fr * 128 + (((4 + fq) ^ sw7) << 4);
    const int bbase = (2 + (wc >> 1)) * HTB + (wc & 1) * 8192 + fr * 128;
    const int boff0 = bbase + ((fq ^ sw7) << 4), boff1 = bbase + (((4 + fq) ^ sw7) << 4);
#define G_STAGE(bufoff, gbase) do { _Pragma("unroll") for (int _i = 0; _i < 2; ++_i) \
        __builtin_amdgcn_global_load_lds((const unsigned*)((const char*)(gbase) + voff[_i]), (LAS unsigned*)(lds + (bufoff) + ldsw + _i * 8192), 16, 0, 0); } while (0)
    for (int u = bid; u < nunits; u += nblk) {
        const int pm = u % (Mm / 256), pn = u / (Mm / 256);
        if (slots_in && pm != rs_pm) {
            __syncthreads();
            if (tid < 256) { const f32x4* sp = (const f32x4*)(slots_in + ((size_t)pm * 256 + tid) * 16);
                const f32x4 a = sp[0], b = sp[1], c = sp[2], d = sp[3];
                const float s = (((a[0] + a[1]) + (a[2] + a[3])) + ((b[0] + b[1]) + (b[2] + b[3]))) + (((c[0] + c[1]) + (c[2] + c[3])) + ((d[0] + d[1]) + (d[2] + d[3])));
                RS[tid] = rsqrtf(s * (1.f / D) + EPS); }
            __syncthreads();
            rs_pm = pm;
        }
        const char* gA = (const char*)(A + (size_t)pm * 256 * K);
        const char* gB = (const char*)(Bt + (size_t)pn * 256 * K);
        const size_t hstep = (size_t)128 * K * 2;
        f32x4 acc[8][4];
#pragma unroll
        for (int a = 0; a < 8; ++a)
#pragma unroll
            for (int b = 0; b < 4; ++b) acc[a][b] = (f32x4){0.f, 0.f, 0.f, 0.f};
        G_STAGE(0, gA); G_STAGE(HTB, gA + hstep); G_STAGE(2 * HTB, gB); G_STAGE(3 * HTB, gB + hstep);
        for (int t = 0; t < nt; ++t) {
            const int cb = (t & 1) * 4 * HTB, nb = ((t + 1) & 1) * 4 * HTB;
            asm volatile("s_waitcnt vmcnt(0)" ::: "memory");
            __builtin_amdgcn_s_barrier();
            asm volatile("" ::: "memory");
            const size_t ko = (size_t)(t + 1) * 128; const bool more = t + 1 < nt;
#pragma unroll
            for (int k = 0; k < 2; ++k) {
                if (more) { if (k == 0) { G_STAGE(nb, gA + ko); G_STAGE(nb + 2 * HTB, gB + ko); } else { G_STAGE(nb + HTB, gA + hstep + ko); G_STAGE(nb + 3 * HTB, gB + hstep + ko); } }
                bf16x8 bfr[4], acur, anxt;
#pragma unroll
                for (int n = 0; n < 4; ++n) bfr[n] = *(const LAS bf16x8*)(lds + cb + (k ? boff1 : boff0) + n * 2048);
                acur = *(const LAS bf16x8*)(lds + cb + (k ? aoff1 : aoff0));
#pragma unroll
                for (int m = 0; m < 8; ++m) {
                    if (m < 7) anxt = *(const LAS bf16x8*)(lds + cb + (k ? aoff1 : aoff0) + (m + 1) * 2048);
#pragma unroll
                    for (int n = 0; n < 4; ++n) acc[m][n] = __builtin_amdgcn_mfma_f32_16x16x32_bf16(bfr[n], acur, acc[m][n], 0, 0, 0);
                    acur = anxt;
                }
                __builtin_amdgcn_sched_barrier(0);
            }
            asm volatile("s_waitcnt lgkmcnt(0)" ::: "memory");
        }
        {
            int el = lane; asm volatile("" : "+v"(el));
            const int efr = el & 15, efq = el >> 4;
            LAS float* et = (LAS float*)(lds + wid * 4352);
            const int ecol = pn * 256 + wc * 64 + 4 * efr;
            constexpr int LK = F::LOOK;
            typename F::Pre pq[LK][4];
            if constexpr (F::PRE) {
#pragma unroll
                for (int m0 = 0; m0 < LK; ++m0)
#pragma unroll
                    for (int i = 0; i < 4; ++i) pq[m0][i] = f.pre(pm * 256 + wr * 128 + m0 * 16 + 4 * i + efq, ecol);
            }
#pragma unroll
            for (int m = 0; m < 8; ++m) {
#pragma unroll
                for (int n = 0; n < 4; ++n) *(LAS f32x4*)(et + efr * 68 + n * 16 + 4 * efq) = acc[m][n];
                typename F::Pre cur[4];
                if constexpr (F::PRE) {
#pragma unroll
                    for (int i = 0; i < 4; ++i) cur[i] = pq[m % LK][i];
                    if (m + LK < 8) {
#pragma unroll
                        for (int i = 0; i < 4; ++i) pq[m % LK][i] = f.pre(pm * 256 + wr * 128 + (m + LK) * 16 + 4 * i + efq, ecol);
                    }
                }
                asm volatile("s_waitcnt lgkmcnt(0)" ::: "memory");
#pragma unroll
                for (int i = 0; i < 4; ++i) {
                    const int lrow = wr * 128 + m * 16 + 4 * i + efq, row = pm * 256 + lrow;
                    const f32x4 v = *(const LAS f32x4*)(et + (4 * i + efq) * 68 + 4 * efr);
                    f32x4 r;
                    if constexpr (F::PRE) r = f(row, RS[lrow], ecol, v, cur[i]); else r = f(row, RS[lrow], ecol, v);
                    if constexpr (F::STATS) { const float ssq = row16_sum((r[0] * r[0] + r[1] * r[1]) + (r[2] * r[2] + r[3] * r[3])); if (efr == 0) f.slots[(size_t)row * 16 + pn * 4 + wc] = ssq; }
                }
                asm volatile("s_waitcnt lgkmcnt(0)" ::: "memory");
                __builtin_amdgcn_sched_barrier(0);
            }
        }
        __syncthreads();
    }
#undef G_STAGE
}

__device__ __forceinline__ u32x2 pk4(f32x4 a) { u32x2 o; o.x = pk2(a[0], a[1]); o.y = pk2(a[2], a[3]); return o; }
struct NoPre {};
struct EpiProj {
    static constexpr bool STATS = false, PRE = false; static constexpr int LOOK = 1; typedef NoPre Pre; float* slots;
    bf16* proj; float* ba;
    __device__ __forceinline__ f32x4 operator()(int row, float rstd, int col, f32x4 v) const {
        v = v * rstd;
        if (col < PROJ_W) *(u32x2*)(proj + (size_t)row * PROJ_W + col) = pk4(v);
        else if (col < IN_COLS) *(f32x4*)(ba + (size_t)row * 8 + (col - PROJ_W)) = v;
        return v;
    }
};
struct EpiRes {
    static constexpr bool STATS = true, PRE = true; static constexpr int LOOK = 3; float* slots;
    bf16* HB; const bf16* Hin;
    struct Pre { u32x2 h; };
    __device__ __forceinline__ Pre pre(int row, int col) const { Pre q; q.h = *(const u32x2*)(Hin + (size_t)row * D + col); return q; }
    __device__ __forceinline__ f32x4 operator()(int row, float, int col, f32x4 v, const Pre& q) const {
        const f32x4 h = (f32x4){lo16(q.h.x), hi16(q.h.x), lo16(q.h.y), hi16(q.h.y)} + v;
        *(u32x2*)(HB + (size_t)row * D + col) = pk4(h);
        return h;
    }
};
struct EpiQ2 {
    static constexpr bool STATS = false, PRE = false; static constexpr int LOOK = 1; typedef NoPre Pre; float* slots;
    bf16* Q2;
    __device__ __forceinline__ f32x4 operator()(int row, float rstd, int col, f32x4 v) const { v = v * rstd; *(u32x2*)(Q2 + (size_t)row * 2048 + col) = pk4(v); return v; }
};
struct EpiE {
    static constexpr bool STATS = true, PRE = false; static constexpr int LOOK = 1; typedef NoPre Pre; float* slots;
    bf16* E;
    __device__ __forceinline__ f32x4 operator()(int row, float, int col, f32x4 v) const { *(u32x2*)(E + (size_t)row * D + col) = pk4(v); return v; }
};
struct EpiPle {
    static constexpr bool STATS = true, PRE = true; static constexpr int LOOK = 2; float* slots;
    const bf16* Hin; bf16* HB; const bf16* E; const float* g;
    struct Pre { u32x2 h; u32x2 ev; };
    __device__ __forceinline__ Pre pre(int row, int col) const { Pre q; q.h = *(const u32x2*)(Hin + (size_t)row * D + col); q.ev = *(const u32x2*)(E + (size_t)row * D + col); return q; }
    __device__ __forceinline__ f32x4 operator()(int row, float rstde, int col, f32x4 v, const Pre& q) const {
        const u32x2 ev = q.ev;
        const f32x4 gv = *(const f32x4*)(g + col);
        f32x4 h = (f32x4){lo16(q.h.x), hi16(q.h.x), lo16(q.h.y), hi16(q.h.y)};
        h[0] += sigmoidf_(v[0]) * (lo16(ev.x) * rstde * gv[0]); h[1] += sigmoidf_(v[1]) * (hi16(ev.x) * rstde * gv[1]);
        h[2] += sigmoidf_(v[2]) * (lo16(ev.y) * rstde * gv[2]); h[3] += sigmoidf_(v[3]) * (hi16(ev.y) * rstde * gv[3]);
        *(u32x2*)(HB + (size_t)row * D + col) = pk4(h);
        return h;
    }
};

__device__ __forceinline__ void transpose_item(const float* W, int K, int N, int Npad, bf16* WT, const float* rowscale, int qcols, float* scr, int item, int lane) {
    const int nblk = Npad / 32, kb = item / nblk, nb = item % nblk, k0 = 64 * kb, n0 = 32 * nb;
    const int nq = n0 + 4 * (lane & 7);
#pragma unroll
    for (int i = 0; i < 8; ++i) {
        const int kk = 8 * i + (lane >> 3);
        f32x4 v = (nq < N) ? *(const f32x4*)(W + (size_t)(k0 + kk) * N + nq) : (f32x4){0.f, 0.f, 0.f, 0.f};
        if (rowscale) v = v * rowscale[k0 + kk];
        if (nq < qcols) v = v * QSCALE;
        scr[kk * 33 + 4 * (lane & 7)] = v[0]; scr[kk * 33 + 4 * (lane & 7) + 1] = v[1]; scr[kk * 33 + 4 * (lane & 7) + 2] = v[2]; scr[kk * 33 + 4 * (lane & 7) + 3] = v[3];
    }
    asm volatile("s_waitcnt lgkmcnt(0)" ::: "memory");
    const int c = lane & 7;
#pragma unroll
    for (int j = 0; j < 4; ++j) {
        const int nn = (lane >> 3) + 8 * j; const float* s = scr + (8 * c) * 33 + nn;
        u32x4 o; o.x = pk2(s[0 * 33], s[1 * 33]); o.y = pk2(s[2 * 33], s[3 * 33]); o.z = pk2(s[4 * 33], s[5 * 33]); o.w = pk2(s[6 * 33], s[7 * 33]);
        *(u32x4*)(WT + (size_t)(n0 + nn) * K + k0 + 8 * c) = o;
    }
    asm volatile("s_waitcnt lgkmcnt(0)" ::: "memory");
}
__device__ __forceinline__ void convert_bulk(const float* src, bf16* dst, size_t n, size_t gtid, size_t nthr) {
    for (size_t i = gtid * 8; i < n; i += nthr * 8) {
        const f32x4 a = *(const f32x4*)(src + i), b = *(const f32x4*)(src + i + 4);
        u32x4 o; o.x = pk2(a[0], a[1]); o.y = pk2(a[2], a[3]); o.z = pk2(b[0], b[1]); o.w = pk2(b[2], b[3]);
        *(u32x4*)(dst + i) = o;
    }
}
__device__ void phase_prologue(const Params& p, LAS unsigned char* lds_, int bid, int nblk) {
    unsigned char* lds = (unsigned char*)lds_;
    const int tid = tidx(), lane = tid & 63, w = tid >> 6;
    const int gw = bid * NWAVES + w, NGW = nblk * NWAVES;
    {
        float* scr = (float*)lds;
        constexpr int T_IN = 8 * (IN_PAD / 128), T_OUT = 8 * 8, T_Q = 8 * 16, T_G = 8 * 8, T_P = 2 * 8, T_L = T_IN + T_OUT + T_Q + T_G + T_P;
        struct TrTile { const float* W; int K, N; bf16* WT; const float* rowscale; int qcols, k0, n0; };
        auto decode = [&](int it) {
            const int L = it / T_L; int r = it % T_L;
            TrTile t; int npad;
            if (r < T_IN) { t.W = p.w_in + (size_t)L * D * IN_COLS; t.K = D; t.N = IN_COLS; npad = IN_PAD; t.WT = (bf16*)(p.ws + WS_WIN) + (size_t)L * IN_PAD * D; t.rowscale = p.ln_mix_g + L * D; t.qcols = 512; }
            else if ((r -= T_IN) < T_OUT) { t.W = p.w_out + (size_t)L * D * D; t.K = D; t.N = D; npad = D; t.WT = (bf16*)(p.ws + WS_WOUT) + (size_t)L * D * D; t.rowscale = nullptr; t.qcols = 0; }
            else if ((r -= T_OUT) < T_Q) { t.W = p.peer_wq + (size_t)L * D * 2048; t.K = D; t.N = 2048; npad = 2048; t.WT = (bf16*)(p.ws + WS_WQ) + (size_t)L * 2048 * D; t.rowscale = p.ln_ffn_g + L * D; t.qcols = 0; }
            else if ((r -= T_Q) < T_G) { t.W = p.ple_wg + (size_t)L * D * D; t.K = D; t.N = D; npad = D; t.WT = (bf16*)(p.ws + WS_WG) + (size_t)L * D * D; t.rowscale = nullptr; t.qcols = 0; }
            else { r -= T_G; t.W = p.ple_wp + (size_t)L * 256 * D; t.K = 256; t.N = D; npad = D; t.WT = (bf16*)(p.ws + WS_WP) + (size_t)L * D * 256; t.rowscale = nullptr; t.qcols = 0; }
            const int nb_ = npad / 128; t.k0 = 128 * (r / nb_); t.n0 = 128 * (r % nb_);
            return t;
        };
        const int tl = tid & 31, tr = tid >> 5;
        f32x4 v[8]; float rsc[8];
        auto tload = [&](const TrTile& t) {
            const int nq = t.n0 + 4 * tl;
#pragma unroll
            for (int i = 0; i < 8; ++i) {
                const int kk = tr + 16 * i;
                v[i] = (nq < t.N) ? *(const f32x4*)(t.W + (size_t)(t.k0 + kk) * t.N + nq) : (f32x4){0.f, 0.f, 0.f, 0.f};
                rsc[i] = t.rowscale ? t.rowscale[t.k0 + kk] : 1.f;
            }
        };
        const int ntile = DEPTH * T_L;
        TrTile cur = decode(bid < ntile ? bid : 0);
        if (bid < ntile) tload(cur);
        for (int it = bid; it < ntile; it += nblk) {
            {
                const float qs = (cur.n0 + 4 * tl < cur.qcols) ? QSCALE : 1.f;
#pragma unroll
                for (int i = 0; i < 8; ++i) {
                    const f32x4 x = v[i] * (rsc[i] * qs);
                    float* d = scr + (tr + 16 * i) * 129 + 4 * tl;
                    d[0] = x[0]; d[1] = x[1]; d[2] = x[2]; d[3] = x[3];
                }
            }
            const TrTile done = cur;
            if (it + nblk < ntile) { cur = decode(it + nblk); tload(cur); }
            __syncthreads();
#pragma unroll
            for (int j = 0; j < 4; ++j) {
                const int pc = tid + 512 * j, nn = pc >> 4, c = pc & 15;
                const float* s = scr + (8 * c) * 129 + nn;
                u32x4 o; o.x = pk2(s[0 * 129], s[1 * 129]); o.y = pk2(s[2 * 129], s[3 * 129]); o.z = pk2(s[4 * 129], s[5 * 129]); o.w = pk2(s[6 * 129], s[7 * 129]);
                *(u32x4*)(done.WT + (size_t)(done.n0 + nn) * done.K + done.k0 + 8 * c) = o;
            }
            __syncthreads();
        }
    }
    const size_t gtid = (size_t)bid * NTHREADS + tid, nthr = (size_t)nblk * NTHREADS;
    for (int r = gw; r < 2 * DEPTH * NEXP; r += NGW) {
        const int which = r >= DEPTH * NEXP, rr = which ? r - DEPTH * NEXP : r;
        const float* srow = (which ? p.peer_v : p.peer_u) + (size_t)rr * D + 4 * lane;
        f32x4 v[4];
#pragma unroll
        for (int j = 0; j < 4; ++j) v[j] = *(const f32x4*)(srow + 256 * j);
        float mx = 0.f;
#pragma unroll
        for (int j = 0; j < 4; ++j) mx = fmaxf(mx, fmaxf(fmaxf(fabsf(v[j][0]), fabsf(v[j][1])), fmaxf(fabsf(v[j][2]), fabsf(v[j][3]))));
        mx = xrow16_max(row16_max(mx));
        const float inv = mx > 0.f ? 127.f / mx : 0.f;
        u32x4 o;
#pragma unroll
        for (int j = 0; j < 4; ++j) {
            const unsigned b0 = (unsigned)__float2int_rn(v[j][0] * inv) & 0xffu, b1 = (unsigned)__float2int_rn(v[j][1] * inv) & 0xffu, b2 = (unsigned)__float2int_rn(v[j][2] * inv) & 0xffu, b3 = (unsigned)__float2int_rn(v[j][3] * inv) & 0xffu;
            o[j] = b0 | (b1 << 8) | (b2 << 16) | (b3 << 24);
        }
        *(u32x4*)(p.ws + (which ? WS_V : WS_U) + (size_t)rr * D + 16 * lane) = o;
        if (lane == 0) ((float*)(p.ws + (which ? WS_SV : WS_SU)))[rr] = mx * (1.f / 127.f);
    }
    convert_bulk(p.p, (bf16*)(p.ws + WS_PB), (size_t)DEPTH * M * 256, gtid, nthr);
    convert_bulk(p.subkeys, (bf16*)(p.ws + WS_SK), (size_t)DEPTH * 8 * 2 * 128 * 128, gtid, nthr);
    float* H = (float*)(p.ws + WS_H); bf16* HB0 = (bf16*)(p.ws + WS_HB0); float* ss0 = (float*)(p.ws + WS_STAT);
    for (int m = gw; m < M; m += NGW) {
        const f32x4* xr = (const f32x4*)(p.x + (size_t)m * D) + lane;
        float ss = 0.f;
#pragma unroll
        for (int j = 0; j < 4; ++j) {
            const f32x4 v = xr[64 * j];
            ss += v[0] * v[0] + v[1] * v[1] + v[2] * v[2] + v[3] * v[3];
            u32x2 o; o.x = pk2(v[0], v[1]); o.y = pk2(v[2], v[3]);
            ((u32x2*)(HB0 + (size_t)m * D))[lane + 64 * j] = o;
        }
        ss = wave_sum(ss);
        if (lane < 16) ss0[(size_t)m * 16 + lane] = lane == 0 ? ss : 0.f;
    }
}

typedef short v4i16_t __attribute__((ext_vector_type(4)));
__device__ __forceinline__ void glds16_asm(const void* gsrc, unsigned lds_dst) {
    unsigned keep;
    asm volatile("s_mov_b32 %0, m0\n\ts_mov_b32 m0, %2\n\ts_nop 0\n\tglobal_load_lds_dwordx4 %1, off\n\ts_mov_b32 m0, %0" : "=&s"(keep) : "v"(gsrc), "s"(lds_dst) : "memory");
}
__device__ __forceinline__ float max3_(float a, float b, float c) { float r; asm("v_max3_f32 %0, %1, %2, %3" : "=v"(r) : "v"(a), "v"(b), "v"(c)); return r; }
constexpr int ATT_BUF = 32768, ATT_VOFF = 16384;
__device__ __forceinline__ void att_unit(const Params& p, int L, LAS unsigned char* lds, int tid, int b, int hh, int qb, float lam, float lam_init) {
    const int lane = tid & 63, w = __builtin_amdgcn_readfirstlane(tid >> 6), fr = lane & 15, fq = lane >> 4;
    const bool grpB = w >= 4;
    const bf16* proj = (const bf16*)(p.ws + WS_PROJ);
    bf16* obuf = (bf16*)(p.ws + WS_OBUF);
    const float slope2 = 1.4426950408889634f / (float)(1 << (2 * (hh + 1)));
    const bf16* kbase = proj + (size_t)b * SEQ * PROJ_W + 512 + hh * 128;
    const bf16* vbase = proj + (size_t)b * SEQ * PROJ_W + 1024 + hh * 128;
    const int qw0 = qb * 128 + w * 16, T = 2 * (qb + 1);
    const int S_w = ((qw0 + 15) >> 6) + 1;
    bf16x8 qf[2][2];
#pragma unroll
    for (int mp = 0; mp < 2; ++mp)
#pragma unroll
        for (int ks = 0; ks < 2; ++ks) qf[mp][ks] = *(const bf16x8*)(proj + ((size_t)b * SEQ + qw0 + fr) * PROJ_W + hh * 128 + mp * 64 + ks * 32 + 8 * fq);
    f32x4 o[2][8];
#pragma unroll
    for (int mp = 0; mp < 2; ++mp)
#pragma unroll
        for (int dt = 0; dt < 8; ++dt) o[mp][dt] = (f32x4){0.f, 0.f, 0.f, 0.f};
    float mrun[2] = {-INFINITY, -INFINITY}, lrun[2] = {0.f, 0.f};
    int ksrc[2], vsrc[2];
#pragma unroll
    for (int i = 0; i < 2; ++i) { const int pc = tid + 512 * i, key = pc >> 4, ph = pc & 15;
        ksrc[i] = key * PROJ_W + ((ph ^ (key & 15)) * 8); vsrc[i] = key * PROJ_W + ((ph ^ ((key & 7) << 1)) * 8); }
    const unsigned ldsb = (unsigned)(size_t)lds;
    auto dma = [&](int t, int bo) {
#pragma unroll
        for (int i = 0; i < 2; ++i) {
            glds16_asm(kbase + (size_t)t * 64 * PROJ_W + ksrc[i], ldsb + bo + (w * 64 + 512 * i) * 16);
            glds16_asm(vbase + (size_t)t * 64 * PROJ_W + vsrc[i], ldsb + bo + ATT_VOFF + (w * 64 + 512 * i) * 16);
        }
    };
    int koff[2][2];
#pragma unroll
    for (int mp = 0; mp < 2; ++mp)
#pragma unroll
        for (int ks = 0; ks < 2; ++ks) koff[mp][ks] = fr * 256 + (((mp * 8 + ks * 4 + fq) ^ fr) << 4);
    const int gl = lane & 15;
    const int vrd0 = ATT_VOFF + (4 * fq + (gl >> 2)) * 256 + (gl & 3) * 8 + ((4 * (fq & 1) + (gl >> 2)) << 5);
    bf16x8 pb[2][2];
#pragma unroll
    for (int mp = 0; mp < 2; ++mp)
#pragma unroll
        for (int ks = 0; ks < 2; ++ks) pb[mp][ks] = qf[0][0];
#define ATT_SB() __builtin_amdgcn_sched_barrier(0)
#define ATT_VRD(dt) do { _Pragma("unroll") for (int q_ = 0; q_ < 4; ++q_) vf_[dt][q_] = __builtin_amdgcn_ds_read_tr16_b64_v4i16((LAS v4i16_t*)(lds + ((vb_ ^ ((dt) << 5)) + q_ * 4096))); } while (0)
#define ATT_VMM(PB, dt) do { _Pragma("unroll") for (int ks = 0; ks < 2; ++ks) { const v4i16_t v0 = vf_[dt][2 * ks], v1 = vf_[dt][2 * ks + 1]; \
            bf16x8 vf; vf[0] = v0[0]; vf[1] = v0[1]; vf[2] = v0[2]; vf[3] = v0[3]; vf[4] = v1[0]; vf[5] = v1[1]; vf[6] = v1[2]; vf[7] = v1[3]; \
            o[0][dt] = __builtin_amdgcn_mfma_f32_16x16x32_bf16(vf, PB[0][ks], o[0][dt], 0, 0, 0); \
            o[1][dt] = __builtin_amdgcn_mfma_f32_16x16x32_bf16(vf, PB[1][ks], o[1][dt], 0, 0, 0); } } while (0)
#define ATT_PV(PB, BO) do { const int vb_ = (BO) + vrd0; v4i16_t vf_[8][4]; \
        ATT_VRD(0); ATT_VRD(1); ATT_VRD(2); ATT_VRD(3); ATT_SB(); \
        ATT_VMM(PB, 0); ATT_VRD(4); ATT_SB(); ATT_VMM(PB, 1); ATT_VRD(5); ATT_SB(); ATT_VMM(PB, 2); ATT_VRD(6); ATT_SB(); ATT_VMM(PB, 3); ATT_VRD(7); ATT_SB(); \
        ATT_VMM(PB, 4); ATT_VMM(PB, 5); ATT_VMM(PB, 6); ATT_VMM(PB, 7); ATT_SB(); } while (0)
    dma(0, 0);
    asm volatile("" :: "v"(qf[0][0]), "v"(qf[0][1]), "v"(qf[1][0]), "v"(qf[1][1]));
    int bo_prev = 2 * ATT_BUF, bo_cur = 0, bo_next = ATT_BUF;
    for (int s = 0; s < T; ++s) {
        const int k0 = s * 64;
        asm volatile("s_waitcnt vmcnt(0)" ::: "memory");
        LDS_BARRIER();
        if (s + 1 < T) dma(s + 1, bo_next);
        if (grpB && s > 0 && s <= S_w) ATT_PV(pb, bo_prev);
        if (s < S_w) {
            f32x4 sc[2][4];
            const float base = -slope2 * (float)(qw0 + fr - k0 - 4 * fq);
#pragma unroll
            for (int kt = 0; kt < 4; ++kt)
#pragma unroll
                for (int r = 0; r < 4; ++r) { const float v = base + slope2 * (float)(16 * kt + r); sc[0][kt][r] = v; sc[1][kt][r] = v; }
            {
                bf16x8 kf[4][2][2];
#define ATT_KRD(kt) do { _Pragma("unroll") for (int mp = 0; mp < 2; ++mp) _Pragma("unroll") for (int ks = 0; ks < 2; ++ks) kf[kt][mp][ks] = *(const LAS bf16x8*)(lds + bo_cur + (kt) * 4096 + koff[mp][ks]); } while (0)
#define ATT_KMM(kt) do { _Pragma("unroll") for (int ks = 0; ks < 2; ++ks) _Pragma("unroll") for (int mp = 0; mp < 2; ++mp) sc[mp][kt] = __builtin_amdgcn_mfma_f32_16x16x32_bf16(kf[kt][mp][ks], qf[mp][ks], sc[mp][kt], 0, 0, 0); } while (0)
                ATT_KRD(0); ATT_KRD(1); ATT_SB();
                ATT_KMM(0); ATT_KRD(2); ATT_SB();
                ATT_KMM(1); ATT_KRD(3); ATT_SB();
                ATT_KMM(2); ATT_KMM(3); ATT_SB();
#undef ATT_KRD
#undef ATT_KMM
            }
            if (k0 + 63 > qw0) {
                const int lim = qw0 + fr - k0 - 4 * fq;
#pragma unroll
                for (int mp = 0; mp < 2; ++mp)
#pragma unroll
                    for (int kt = 0; kt < 4; ++kt)
#pragma unroll
                        for (int r = 0; r < 4; ++r) if (16 * kt + r > lim) sc[mp][kt][r] = -INFINITY;
            }
#pragma unroll
            for (int mp = 0; mp < 2; ++mp) {
                float mx = max3_(sc[mp][0][0], sc[mp][0][1], sc[mp][0][2]);
                mx = max3_(mx, sc[mp][0][3], sc[mp][1][0]);
#pragma unroll
                for (int kt = 1; kt < 4; ++kt) { mx = max3_(mx, sc[mp][kt][1], sc[mp][kt][2]); if (kt < 3) mx = max3_(mx, sc[mp][kt][3], sc[mp][kt + 1][0]); else mx = max3_(mx, sc[mp][kt][3], mx); }
                mx = xrow16_max(mx);
                const bool resc = __builtin_amdgcn_ballot_w64(mx > mrun[mp] + 8.f) != 0ull;
                if (resc) {
                    const float mnew = fmaxf(mrun[mp], mx);
                    const float alpha = __builtin_amdgcn_exp2f(mrun[mp] - mnew);
                    mrun[mp] = mnew;
                    lrun[mp] = lrun[mp] * alpha;
#pragma unroll
                    for (int dt = 0; dt < 8; ++dt) o[mp][dt] = o[mp][dt] * alpha;
                }
                const float mref = mrun[mp];
                float ps = 0.f;
#pragma unroll
                for (int kt = 0; kt < 4; ++kt)
#pragma unroll
                    for (int r = 0; r < 4; ++r) { const float e = __builtin_amdgcn_exp2f(sc[mp][kt][r] - mref); sc[mp][kt][r] = e; ps += e; }
                lrun[mp] = lrun[mp] + ps;
#pragma unroll
                for (int ks = 0; ks < 2; ++ks) {
                    u32x4 pk; pk.x = cvtpk(sc[mp][2 * ks][0], sc[mp][2 * ks][1]); pk.y = cvtpk(sc[mp][2 * ks][2], sc[mp][2 * ks][3]);
                    pk.z = cvtpk(sc[mp][2 * ks + 1][0], sc[mp][2 * ks + 1][1]); pk.w = cvtpk(sc[mp][2 * ks + 1][2], sc[mp][2 * ks + 1][3]);
                    pb[mp][ks] = __builtin_bit_cast(bf16x8, pk);
                }
            }
            if (!grpB) ATT_PV(pb, bo_cur);
        }
        const int tb = bo_prev; bo_prev = bo_cur; bo_cur = bo_next; bo_next = tb;
    }
    if (grpB && S_w == T) ATT_PV(pb, bo_prev);
#undef ATT_PV
#undef ATT_VRD
#undef ATT_VMM
#undef ATT_SB
    const float i1 = __builtin_amdgcn_rcpf(xrow16_sum(lrun[0])), i2 = lam * __builtin_amdgcn_rcpf(xrow16_sum(lrun[1]));
    float ss = 0.f;
#pragma unroll
    for (int dt = 0; dt < 8; ++dt)
#pragma unroll
        for (int r = 0; r < 4; ++r) { const float v = o[0][dt][r] * i1 - o[1][dt][r] * i2; o[0][dt][r] = v; ss += v * v; }
    ss = xrow16_sum(ss);
    const float rn = rsqrtf(ss * (1.f / 128.f) + EPS) * (1.f - lam_init);
    const float* g = p.subln_g + L * 128;
    bf16* orow = obuf + ((size_t)b * SEQ + qw0 + fr) * D + hh * 128;
#pragma unroll
    for (int dt = 0; dt < 8; ++dt) {
        const f32x4 gv = *(const f32x4*)(g + 16 * dt + 4 * fq);
        u32x2 ov; ov.x = pk2(o[0][dt][0] * rn * gv[0], o[0][dt][1] * rn * gv[1]); ov.y = pk2(o[0][dt][2] * rn * gv[2], o[0][dt][3] * rn * gv[3]);
        *(u32x2*)(orow + 16 * dt + 4 * fq) = ov;
    }
}

__device__ void phase_att_queue(const Params& p, int L, LAS unsigned char* lds, int bid, int nblk) {
    const int tid = tidx(), lane = tid & 63;
    const float* lp = p.diff_lambda + L * 256;
    const float d1 = wave_sum(lp[lane] * lp[64 + lane]), d2 = wave_sum(lp[128 + lane] * lp[192 + lane]);
    const float lam_init = 0.8f - 0.6f * __expf(-0.3f * (float)L);
    const float lam = __expf(d1) - __expf(d2) + lam_init;
    unsigned* head = (unsigned*)(p.ws + WS_CTL) + CW_QUEUE + L;
    volatile LAS int* slot = (volatile LAS int*)(lds + LDS_MISC_OFF + 64);
    for (;;) {
        __syncthreads();
        if (tid == 0) *slot = (int)__hip_atomic_fetch_add(head, 1u, __ATOMIC_RELAXED, __HIP_MEMORY_SCOPE_AGENT);
        __syncthreads();
        const int u = *slot;
        if (u >= 512) break;
        att_unit(p, L, lds, tid, (u & 31) >> 2, u & 3, 15 - (u >> 5), lam, lam_init);
    }
}

constexpr size_t GD_WP = WS_ORAW, GD_QD = WS_ORAW + 16 * MiB, GD_AIP = WS_ORAW + 32 * MiB, GD_KDT = WS_ORAW + 40 * MiB, GD_UT = WS_ORAW + 56 * MiB, GD_GL = WS_ORAW + 72 * MiB;
__device__ __forceinline__ int perm_pos(int k) { return (k & ~31) + 8 * ((k >> 2) & 3) + 4 * ((k >> 4) & 1) + (k & 3); }
__device__ __forceinline__ float softplusf_(float x) { if (x > 20.f) return x; const float e = __expf(x); return e < 0.06f ? e * (1.f - e * (0.5f - e * (0.33333334f - 0.25f * e))) : __logf(1.f + e); }
__device__ __forceinline__ float gelu_erf(float v) {
    const float z = fabsf(v) * 0.70710678118654752f, t = __builtin_amdgcn_rcpf(1.f + 0.3275911f * z);
    const float pl = t * (0.254829592f + t * (-0.284496736f + t * (1.421413741f + t * (-1.453152027f + t * 1.061405429f))));
    const float er = 1.f - pl * __expf(-z * z);
    return 0.5f * v * (1.f + (v < 0.f ? -er : er));
}

constexpr int GP_KN = 0, GP_QN = 17408, GP_RT = 34816, GP_LM = 71680, GP_TB = 89088, GP_GT = 98304, GP_T0T = 99328;
constexpr int GP_KP = 272, GP_RP = 144, GP_LP = 68, GP_TP = 144;
__device__ void phase_gdn_prep(const Params& p, int L, LAS unsigned char* lds, int bid, int nblk) {
    const int tid = tidx(), lane = tid & 63, w = __builtin_amdgcn_readfirstlane(tid >> 6), fr = lane & 15, fq = lane >> 4;
    const bf16* proj = (const bf16*)(p.ws + WS_PROJ);
    const float* BA = (const float*)(p.ws + WS_BA);
    bf16* WP = (bf16*)(p.ws + GD_WP); bf16* QD = (bf16*)(p.ws + GD_QD); bf16* AIP = (bf16*)(p.ws + GD_AIP); bf16* KDT = (bf16*)(p.ws + GD_KDT); bf16* UT = (bf16*)(p.ws + GD_UT);
    float* GL = (float*)(p.ws + GD_GL);
    const float* cw = p.conv_w + (size_t)L * 4 * 1536;
    LAS float* beta_s = (LAS float*)(lds + GP_GT); LAS float* gc_s = beta_s + 64; LAS float* egc_s = gc_s + 64; LAS float* edl_s = egc_s + 64;
    LAS float* Lm = (LAS float*)(lds + GP_LM);
    for (int item = bid; item < 1024; item += nblk) {
        const int n = item & 31, bh = item >> 5, hh = bh & 3, b = bh >> 2, t0 = n * 64;
        const size_t row0 = (size_t)b * SEQ + t0;
        __syncthreads();
        const int colq = hh * 128 + 2 * lane;
        unsigned xq[11], xk[11], xv[11];
#pragma unroll
        for (int r = 0; r < 11; ++r) { const int tt = t0 + 8 * w - 3 + r;
            xq[r] = (tt >= 0) ? *(const unsigned*)(proj + ((size_t)b * SEQ + tt) * PROJ_W + 1536 + colq) : 0u;
            xk[r] = (tt >= 0) ? *(const unsigned*)(proj + ((size_t)b * SEQ + tt) * PROJ_W + 1536 + 512 + colq) : 0u;
            xv[r] = (tt >= 0) ? *(const unsigned*)(proj + ((size_t)b * SEQ + tt) * PROJ_W + 1536 + 1024 + colq) : 0u; }
        if (w == 0) {
            const float negA = -__expf(p.a_log[L * 4 + hh]), dtb = p.dt_bias[L * 4 + hh];
            const float bb = BA[(row0 + lane) * 8 + hh], aa = BA[(row0 + lane) * 8 + 4 + hh] + dtb;
            float c = negA * softplusf_(aa);
#pragma unroll
            for (int o = 1; o < 64; o <<= 1) { const float t = __shfl_up(c, o); if (lane >= o) c += t; }
            const float glast = __shfl(c, 63);
            beta_s[lane] = sigmoidf_(bb); gc_s[lane] = c; egc_s[lane] = __expf(c); edl_s[lane] = __expf(glast - c);
            if (lane == 0) GL[item] = __expf(glast);
        }
        __syncthreads();
        {
            {
                float wq[4][2];
#pragma unroll
                for (int j = 0; j < 4; ++j) { wq[j][0] = cw[j * 1536 + colq]; wq[j][1] = cw[j * 1536 + colq + 1]; }
#pragma unroll
                for (int i = 0; i < 8; ++i) {
                    const int c = 8 * w + i;
                    float q0 = 0.f, q1 = 0.f;
#pragma unroll
                    for (int j = 0; j < 4; ++j) { q0 += wq[j][0] * lo16(xq[i + j]); q1 += wq[j][1] * hi16(xq[i + j]); }
                    q0 *= sigmoidf_(q0); q1 *= sigmoidf_(q1);
                    const float sq = rsqrtf(wave_sum(q0 * q0 + q1 * q1) + EPS) * 0.08838834764831845f;
                    q0 *= sq; q1 *= sq;
                    const float eg = egc_s[c];
                    *(LAS unsigned*)(lds + GP_QN + c * GP_KP + lane * 4) = pk2(q0, q1);
                    *(unsigned*)(QD + ((size_t)item * 64 + c) * 128 + perm_pos(2 * lane)) = pk2(q0 * eg, q1 * eg);
                }
            }
            __builtin_amdgcn_sched_barrier(0);
            {
                float wk[4][2];
#pragma unroll
                for (int j = 0; j < 4; ++j) { wk[j][0] = cw[j * 1536 + 512 + colq]; wk[j][1] = cw[j * 1536 + 512 + colq + 1]; }
                unsigned kd0[8], kd1[8], rk0[8], rk1[8];
#pragma unroll
                for (int i = 0; i < 8; ++i) {
                    const int c = 8 * w + i;
                    float k0 = 0.f, k1 = 0.f;
#pragma unroll
                    for (int j = 0; j < 4; ++j) { k0 += wk[j][0] * lo16(xk[i + j]); k1 += wk[j][1] * hi16(xk[i + j]); }
                    k0 *= sigmoidf_(k0); k1 *= sigmoidf_(k1);
                    const float sk = rsqrtf(wave_sum(k0 * k0 + k1 * k1) + EPS);
                    k0 *= sk; k1 *= sk;
                    const float be = beta_s[c], eg = egc_s[c], ed = edl_s[c];
                    *(LAS unsigned*)(lds + GP_KN + c * GP_KP + lane * 4) = pk2(k0, k1);
                    kd0[i] = f2bf(k0 * ed); kd1[i] = f2bf(k1 * ed);
                    rk0[i] = f2bf(k0 * be * eg); rk1[i] = f2bf(k1 * be * eg);
                }
                u32x4 o;
                o.x = rk0[0] | (rk0[1] << 16); o.y = rk0[2] | (rk0[3] << 16); o.z = rk0[4] | (rk0[5] << 16); o.w = rk0[6] | (rk0[7] << 16); *(LAS u32x4*)(lds + GP_RT + (128 + 2 * lane) * GP_RP + 16 * w) = o;
                o.x = rk1[0] | (rk1[1] << 16); o.y = rk1[2] | (rk1[3] << 16); o.z = rk1[4] | (rk1[5] << 16); o.w = rk1[6] | (rk1[7] << 16); *(LAS u32x4*)(lds + GP_RT + (128 + 2 * lane + 1) * GP_RP + 16 * w) = o;
                const int pa = perm_pos(8 * w), pb = perm_pos(8 * w + 4);
                bf16* kr0 = KDT + ((size_t)item * 128 + 2 * lane) * 64; bf16* kr1 = kr0 + 64;
                u32x2 h2;
                h2.x = kd0[0] | (kd0[1] << 16); h2.y = kd0[2] | (kd0[3] << 16); *(u32x2*)(kr0 + pa) = h2;
                h2.x = kd0[4] | (kd0[5] << 16); h2.y = kd0[6] | (kd0[7] << 16); *(u32x2*)(kr0 + pb) = h2;
                h2.x = kd1[0] | (kd1[1] << 16); h2.y = kd1[2] | (kd1[3] << 16); *(u32x2*)(kr1 + pa) = h2;
                h2.x = kd1[4] | (kd1[5] << 16); h2.y = kd1[6] | (kd1[7] << 16); *(u32x2*)(kr1 + pb) = h2;
            }
            __builtin_amdgcn_sched_barrier(0);
            {
                float wv[4][2];
#pragma unroll
                for (int j = 0; j < 4; ++j) { wv[j][0] = cw[j * 1536 + 1024 + colq]; wv[j][1] = cw[j * 1536 + 1024 + colq + 1]; }
                unsigned rv0[8], rv1[8];
#pragma unroll
                for (int i = 0; i < 8; ++i) {
                    float v0 = 0.f, v1 = 0.f;
#pragma unroll
                    for (int j = 0; j < 4; ++j) { v0 += wv[j][0] * lo16(xv[i + j]); v1 += wv[j][1] * hi16(xv[i + j]); }
                    v0 *= sigmoidf_(v0); v1 *= sigmoidf_(v1);
                    const float be = beta_s[8 * w + i];
                    rv0[i] = f2bf(v0 * be); rv1[i] = f2bf(v1 * be);
                }
                u32x4 o;
                o.x = rv0[0] | (rv0[1] << 16); o.y = rv0[2] | (rv0[3] << 16); o.z = rv0[4] | (rv0[5] << 16); o.w = rv0[6] | (rv0[7] << 16); *(LAS u32x4*)(lds + GP_RT + (2 * lane) * GP_RP + 16 * w) = o;
                o.x = rv1[0] | (rv1[1] << 16); o.y = rv1[2] | (rv1[3] << 16); o.z = rv1[4] | (rv1[5] << 16); o.w = rv1[6] | (rv1[7] << 16); *(LAS u32x4*)(lds + GP_RT + (2 * lane + 1) * GP_RP + 16 * w) = o;
            }
        }
        __syncthreads();
#pragma unroll
        for (int q = 0; q < 2; ++q) {
            const int id = 2 * w + q, ct = id >> 2, st = id & 3;
            if (st <= ct) {
                f32x4 acc = (f32x4){0.f, 0.f, 0.f, 0.f};
#pragma unroll
                for (int ks = 0; ks < 4; ++ks) {
                    const bf16x8 a = *(const LAS bf16x8*)(lds + GP_KN + (16 * ct + fr) * GP_KP + (32 * ks + 8 * fq) * 2);
                    const bf16x8 bb = *(const LAS bf16x8*)(lds + GP_KN + (16 * st + fr) * GP_KP + (32 * ks + 8 * fq) * 2);
                    acc = __builtin_amdgcn_mfma_f32_16x16x32_bf16(a, bb, acc, 0, 0, 0);
                }
                const int s = 16 * st + fr; const float gs = gc_s[s];
#pragma unroll
                for (int r = 0; r < 4; ++r) { const int c = 16 * ct + 4 * fq + r;
                    Lm[c * GP_LP + s] = (s < c) ? beta_s[c] * acc[r] * __expf(fminf(gc_s[c] - gs, 0.f)) : 0.f; }
            }
        }
        __syncthreads();
        if (w < 2) {
            const int o = 32 * w;
            float t[32];
            int zoff = 0; asm volatile("" : "+v"(zoff));
            const LAS float* Lz = Lm + zoff + o * GP_LP + o;
            const int col = lane & 31;
#pragma unroll
            for (int i = 0; i < 32; ++i) {
                float a0 = (i == lane) ? 1.f : 0.f, a1 = 0.f, a2 = 0.f, a3 = 0.f;
#pragma unroll
                for (int s4 = 0; s4 + 4 <= i; s4 += 4) { const f32x4 lv = *(const LAS f32x4*)(Lz + i * GP_LP + s4);
                    a0 -= lv[0] * t[s4]; a1 -= lv[1] * t[s4 + 1]; a2 -= lv[2] * t[s4 + 2]; a3 -= lv[3] * t[s4 + 3]; }
#pragma unroll
                for (int s = i & ~3; s < i; ++s) a0 -= Lz[i * GP_LP + s] * t[s];
                t[i] = (lane < 32) ? (a0 + a1) + (a2 + a3) : 0.f;
                const bf16 tb = (bf16)f2bf(t[i]);
                if (w == 0) { *(LAS bf16*)(lds + GP_TB + i * GP_TP + lane * 2) = tb;
                              if (lane < 32) *(LAS bf16*)(lds + GP_T0T + lane * 80 + i * 2) = tb; }
                else if (lane < 32) *(LAS bf16*)(lds + GP_TB + (32 + i) * GP_TP + (32 + col) * 2) = tb;
                if ((i & 3) == 3) __builtin_amdgcn_sched_barrier(0);
            }
        } else {
            for (int id = w - 2; id < 16; id += 6) {
                const int ct = id >> 2, st = id & 3;
                f32x4 acc = (f32x4){0.f, 0.f, 0.f, 0.f};
                if (st <= ct) {
#pragma unroll
                    for (int ks = 0; ks < 4; ++ks) {
                        const bf16x8 a = *(const LAS bf16x8*)(lds + GP_QN + (16 * ct + fr) * GP_KP + (32 * ks + 8 * fq) * 2);
                        const bf16x8 bb = *(const LAS bf16x8*)(lds + GP_KN + (16 * st + fr) * GP_KP + (32 * ks + 8 * fq) * 2);
                        acc = __builtin_amdgcn_mfma_f32_16x16x32_bf16(a, bb, acc, 0, 0, 0);
                    }
                }
                const int s = 16 * st + fr; const float gs = gc_s[s]; const int ps = perm_pos(s);
#pragma unroll
                for (int r = 0; r < 4; ++r) { const int c = 16 * ct + 4 * fq + r;
                    const float v = (s <= c) ? acc[r] * __expf(fminf(gc_s[c] - gs, 0.f)) : 0.f;
                    AIP[((size_t)item * 64 + c) * 64 + ps] = (bf16)f2bf(v); }
            }
        }
        __syncthreads();
        if (w == 0) {
            f32x4 P[2][2];
#pragma unroll
            for (int it = 0; it < 2; ++it) {
                const LAS float* lr = Lm + (32 + 16 * it + fr) * GP_LP + 8 * fq;
                const f32x4 l0 = *(const LAS f32x4*)lr, l1 = *(const LAS f32x4*)(lr + 4);
                u32x4 pk; pk.x = cvtpk(l0[0], l0[1]); pk.y = cvtpk(l0[2], l0[3]); pk.z = cvtpk(l1[0], l1[1]); pk.w = cvtpk(l1[2], l1[3]);
                const bf16x8 a = __builtin_bit_cast(bf16x8, pk);
#pragma unroll
                for (int jt = 0; jt < 2; ++jt) {
                    const bf16x8 bb = *(const LAS bf16x8*)(lds + GP_T0T + (16 * jt + fr) * 80 + 16 * fq);
                    P[it][jt] = __builtin_amdgcn_mfma_f32_16x16x32_bf16(a, bb, (f32x4){0.f, 0.f, 0.f, 0.f}, 0, 0, 0);
                }
            }
#pragma unroll
            for (int jt = 0; jt < 2; ++jt) {
                u32x4 pk; pk.x = cvtpk(P[0][jt][0], P[0][jt][1]); pk.y = cvtpk(P[0][jt][2], P[0][jt][3]); pk.z = cvtpk(P[1][jt][0], P[1][jt][1]); pk.w = cvtpk(P[1][jt][2], P[1][jt][3]);
                const bf16x8 pb = __builtin_bit_cast(bf16x8, pk);
#pragma unroll
                for (int i2 = 0; i2 < 2; ++i2) {
                    const LAS unsigned char* tr = lds + GP_TB + (32 + 16 * i2 + fr) * GP_TP + (32 + 4 * fq) * 2;
                    const u32x2 ta = *(const LAS u32x2*)tr, tb2 = *(const LAS u32x2*)(tr + 32);
                    u32x4 ak; ak.x = ta.x; ak.y = ta.y; ak.z = tb2.x; ak.w = tb2.y;
                    const f32x4 r = __builtin_amdgcn_mfma_f32_16x16x32_bf16(__builtin_bit_cast(bf16x8, ak), pb, (f32x4){0.f, 0.f, 0.f, 0.f}, 0, 0, 0);
#pragma unroll
                    for (int q = 0; q < 4; ++q) *(LAS bf16*)(lds + GP_TB + (32 + 16 * i2 + 4 * fq + q) * GP_TP + (16 * jt + fr) * 2) = (bf16)f2bf(-r[q]);
                }
            }
        }
        __syncthreads();
#pragma unroll
        for (int q = 0; q < 2; ++q) {
            const int colt = 2 * w + q;
            bf16x8 af[2];
#pragma unroll
            for (int ks = 0; ks < 2; ++ks) af[ks] = *(const LAS bf16x8*)(lds + GP_RT + (16 * colt + fr) * GP_RP + (32 * ks + 8 * fq) * 2);
#pragma unroll
            for (int ct = 0; ct < 4; ++ct) {
                f32x4 acc = (f32x4){0.f, 0.f, 0.f, 0.f};
#pragma unroll
                for (int ks = 0; ks < 2; ++ks) {
                    const bf16x8 bb = *(const LAS bf16x8*)(lds + GP_TB + (16 * ct + fr) * GP_TP + (32 * ks + 8 * fq) * 2);
                    acc = __builtin_amdgcn_mfma_f32_16x16x32_bf16(af[ks], bb, acc, 0, 0, 0);
                }
                const int c = 16 * ct + fr;
                if (colt < 8) {
#pragma unroll
                    for (int r = 0; r < 4; ++r) UT[((size_t)item * 128 + 16 * colt + 4 * fq + r) * 64 + c] = (bf16)f2bf(acc[r]);
                } else {
                    const int kt = colt - 8;
                    u32x2 h2; h2.x = pk2(-acc[0], -acc[1]); h2.y = pk2(-acc[2], -acc[3]);
                    *(u32x2*)(WP + ((size_t)item * 64 + c) * 128 + 32 * (kt >> 1) + 8 * fq + 4 * (kt & 1)) = h2;
                }
            }
        }
    }
    __syncthreads();
}

constexpr int GS_WP = 0, GS_QD = 16384, GS_AIP = 32768, GS_KDT = 40960, GS_BUF = 57344, GS_OB = 2 * GS_BUF, GS_OBP = 272, GS_OBT = 64 * GS_OBP;
__device__ void phase_gdn_scan(const Params& p, int L, LAS unsigned char* lds, int bid, int nblk) {
    const int tid = tidx(), lane = tid & 63, w = __builtin_amdgcn_readfirstlane(tid >> 6), fr = lane & 15, fq = lane >> 4;
    const bf16* proj = (const bf16*)(p.ws + WS_PROJ);
    const bf16* WP = (const bf16*)(p.ws + GD_WP); const bf16* QD = (const bf16*)(p.ws + GD_QD); const bf16* AIP = (const bf16*)(p.ws + GD_AIP);
    const bf16* KDT = (const bf16*)(p.ws + GD_KDT); const bf16* UT = (const bf16*)(p.ws + GD_UT); const float* GL = (const float*)(p.ws + GD_GL);
    bf16* obuf = (bf16*)(p.ws + WS_OBUF);
    for (int item = bid; item < 32; item += nblk) {
        const int hh = item & 3, b = item >> 2;
        const int fc = tid >> 4, fv = tid & 15;
        float gn[8];
#pragma unroll
        for (int i = 0; i < 8; ++i) gn[i] = p.gdn_norm_g[L * 128 + 8 * fv + i];
        f32x4 S[8];
#pragma unroll
        for (int kt = 0; kt < 8; ++kt) S[kt] = (f32x4){0.f, 0.f, 0.f, 0.f};
        auto dma = [&](int ci, int buf) {
#pragma unroll
            for (int i = 0; i < 7; ++i) {
                const int pc = tid + 512 * i;
                const bf16* src;
                if (i < 2) { const int r = pc >> 4; src = WP + (size_t)ci * 8192 + r * 128 + (((pc & 15) ^ (r & 15)) * 8); }
                else if (i < 4) { const int q = pc - 1024, r = q >> 4; src = QD + (size_t)ci * 8192 + r * 128 + (((q & 15) ^ (r & 15)) * 8); }
                else if (i < 5) { const int q = pc - 2048, r = q >> 3; src = AIP + (size_t)ci * 4096 + r * 64 + (((q & 7) ^ ((r >> 1) & 7)) * 8); }
                else { const int q = pc - 2560, r = q >> 3; src = KDT + (size_t)ci * 8192 + r * 64 + (((q & 7) ^ ((r >> 1) & 7)) * 8); }
                __builtin_amdgcn_global_load_lds((const unsigned*)src, (LAS unsigned*)(lds + buf * GS_BUF + (w * 64 + 512 * i) * 16), 16, 0, 0);
            }
        };
        int offk[4], offa[2];
#pragma unroll
        for (int ks = 0; ks < 4; ++ks) offk[ks] = fr * 256 + (((4 * ks + fq) ^ fr) * 16);
#pragma unroll
        for (int ss = 0; ss < 2; ++ss) offa[ss] = fr * 128 + (((4 * ss + fq) ^ ((fr >> 1) & 7)) * 16);
        __syncthreads();
        dma(item * 32, 0);
        u32x2 ut[4]; float gl;
        {
            const int ci = item * 32;
#pragma unroll
            for (int ct = 0; ct < 4; ++ct) ut[ct] = *(const u32x2*)(UT + ((size_t)ci * 128 + 16 * w + fr) * 64 + 16 * ct + 4 * fq);
            gl = GL[ci];
        }
        u32x4 zp[2];
        zp[0] = (u32x4){0u, 0u, 0u, 0u}; zp[1] = zp[0];
        asm volatile("s_waitcnt vmcnt(0)" ::: "memory");
        __syncthreads();
#define GS_FINISH(ps, TILE, DST) do { const int c = 32 * (ps) + fc; \
            const u32x4 ov = *(const LAS u32x4*)(lds + (TILE) + c * GS_OBP + fv * 16); \
            float o8[8]; \
            _Pragma("unroll") for (int i = 0; i < 4; ++i) { o8[2 * i] = lo16(ov[i]); o8[2 * i + 1] = hi16(ov[i]); } \
            float ss = 0.f; \
            _Pragma("unroll") for (int i = 0; i < 8; ++i) ss += o8[i] * o8[i]; \
            const float rn = rsqrtf(row16_sum(ss) * (1.f / 128.f) + EPS); \
            u32x4 res; \
            _Pragma("unroll") for (int i = 0; i < 4; ++i) { \
                const float z0 = lo16(zp[ps][i]), z1 = hi16(zp[ps][i]); \
                res[i] = cvtpk(o8[2 * i] * rn * gn[2 * i] * (z0 * sigmoidf_(z0)), o8[2 * i + 1] * rn * gn[2 * i + 1] * (z1 * sigmoidf_(z1))); } \
            *(u32x4*)((DST) + (size_t)c * D) = res; } while (0)
        bf16* const dummy = (bf16*)(p.ws + WS_Q2) + tid * 8;
        for (int n = 0; n < 32; ++n) {
            const int ci = item * 32 + n, buf = n & 1;
            const size_t rowc = (size_t)b * SEQ + n * 64;
            LAS unsigned char* bb = lds + buf * GS_BUF;
            bf16x8 f0[8], f1[8];
#define LD_A(F, ct) do { _Pragma("unroll") for (int ks = 0; ks < 4; ++ks) { F[ks] = *(const LAS bf16x8*)(bb + GS_WP + (ct) * 4096 + offk[ks]); \
                    F[4 + ks] = *(const LAS bf16x8*)(bb + GS_QD + (ct) * 4096 + offk[ks]); } } while (0)
            LD_A(f0, 0); __builtin_amdgcn_sched_barrier(0);
            if (n + 1 < 32) dma(ci + 1, buf ^ 1);
            u32x2 utn[4]; float gln = 0.f;
            {
                const int cn = ci + (n + 1 < 32 ? 1 : 0);
#pragma unroll
                for (int ct = 0; ct < 4; ++ct) utn[ct] = *(const u32x2*)(UT + ((size_t)cn * 128 + 16 * w + fr) * 64 + 16 * ct + 4 * fq);
                gln = GL[cn];
            }
            u32x4 zq[2];
#pragma unroll
            for (int ps = 0; ps < 2; ++ps) zq[ps] = *(const u32x4*)(proj + (rowc + 32 * ps + fc) * PROJ_W + 3072 + hh * 128 + 8 * fv);
            bf16* const fdst = n > 0 ? obuf + (rowc - 64) * D + 512 + hh * 128 + 8 * fv : dummy;
            const int tprev = GS_OB + (buf ^ 1) * GS_OBT, tcur = GS_OB + buf * GS_OBT;
            f32x4 vn[4], oacc[4];
#pragma unroll
            for (int ct = 0; ct < 4; ++ct) { vn[ct] = (f32x4){lo16(ut[ct].x), hi16(ut[ct].x), lo16(ut[ct].y), hi16(ut[ct].y)}; oacc[ct] = (f32x4){0.f, 0.f, 0.f, 0.f}; }
            bf16x8 sb[4];
#pragma unroll
            for (int ks = 0; ks < 4; ++ks) { u32x4 pk; pk.x = cvtpk(S[2 * ks][0], S[2 * ks][1]); pk.y = cvtpk(S[2 * ks][2], S[2 * ks][3]); pk.z = cvtpk(S[2 * ks + 1][0], S[2 * ks + 1][1]); pk.w = cvtpk(S[2 * ks + 1][2], S[2 * ks + 1][3]);
                sb[ks] = __builtin_bit_cast(bf16x8, pk); }
#define MM_A(F, ct) do { __builtin_amdgcn_s_setprio(1); _Pragma("unroll") for (int ks = 0; ks < 4; ++ks) { vn[ct] = __builtin_amdgcn_mfma_f32_16x16x32_bf16(F[ks], sb[ks], vn[ct], 0, 0, 0); \
                    oacc[ct] = __builtin_amdgcn_mfma_f32_16x16x32_bf16(sb[ks], F[4 + ks], oacc[ct], 0, 0, 0); } __builtin_amdgcn_s_setprio(0); } while (0)
#define SBAR() __builtin_amdgcn_sched_barrier(0)
            SBAR();
            LD_A(f1, 1); MM_A(f0, 0); SBAR();
            LD_A(f0, 2); MM_A(f1, 1); GS_FINISH(0, tprev, fdst); SBAR();
            LD_A(f1, 3); MM_A(f0, 2); SBAR();
#pragma unroll
            for (int ct = 0; ct < 4; ++ct)
#pragma unroll
                for (int ss = 0; ss < 2; ++ss) f0[2 * ct + ss] = *(const LAS bf16x8*)(bb + GS_AIP + ct * 2048 + offa[ss]);
            MM_A(f1, 3); GS_FINISH(1, tprev, fdst); SBAR();
            bf16x8 vb[2];
#pragma unroll
            for (int ss = 0; ss < 2; ++ss) { u32x4 pk; pk.x = cvtpk(vn[2 * ss][0], vn[2 * ss][1]); pk.y = cvtpk(vn[2 * ss][2], vn[2 * ss][3]); pk.z = cvtpk(vn[2 * ss + 1][0], vn[2 * ss + 1][1]); pk.w = cvtpk(vn[2 * ss + 1][2], vn[2 * ss + 1][3]);
                vb[ss] = __builtin_bit_cast(bf16x8, pk); }
#pragma unroll
            for (int kt = 0; kt < 4; ++kt)
#pragma unroll
                for (int ss = 0; ss < 2; ++ss) f1[2 * kt + ss] = *(const LAS bf16x8*)(bb + GS_KDT + kt * 2048 + offa[ss]);
#pragma unroll
            for (int ct = 0; ct < 4; ++ct)
#pragma unroll
                for (int ss = 0; ss < 2; ++ss) oacc[ct] = __builtin_amdgcn_mfma_f32_16x16x32_bf16(vb[ss], f0[2 * ct + ss], oacc[ct], 0, 0, 0);
            SBAR();
#pragma unroll
            for (int kt = 4; kt < 8; ++kt)
#pragma unroll
                for (int ss = 0; ss < 2; ++ss) f0[2 * (kt - 4) + ss] = *(const LAS bf16x8*)(bb + GS_KDT + kt * 2048 + offa[ss]);
#pragma unroll
            for (int kt = 0; kt < 4; ++kt) {
                S[kt] = S[kt] * gl;
#pragma unroll
                for (int ss = 0; ss < 2; ++ss) S[kt] = __builtin_amdgcn_mfma_f32_16x16x32_bf16(f1[2 * kt + ss], vb[ss], S[kt], 0, 0, 0);
            }
#pragma unroll
            for (int ct = 0; ct < 4; ++ct) {
                u32x2 pk; pk.x = cvtpk(oacc[ct][0], oacc[ct][1]); pk.y = cvtpk(oacc[ct][2], oacc[ct][3]);
                *(LAS u32x2*)(lds + tcur + (16 * ct + fr) * GS_OBP + (16 * w + 4 * fq) * 2) = pk;
            }
            SBAR();
#pragma unroll
            for (int kt = 4; kt < 8; ++kt) {
                S[kt] = S[kt] * gl;
#pragma unroll
                for (int ss = 0; ss < 2; ++ss) S[kt] = __builtin_amdgcn_mfma_f32_16x16x32_bf16(f0[2 * (kt - 4) + ss], vb[ss], S[kt], 0, 0, 0);
            }
#undef LD_A
#undef MM_A
#undef SBAR
#pragma unroll
            for (int ct = 0; ct < 4; ++ct) ut[ct] = utn[ct];
            gl = gln; zp[0] = zq[0]; zp[1] = zq[1];
            asm volatile("s_waitcnt vmcnt(0)" ::: "memory");
            LDS_BARRIER();
        }
        {
            bf16* const fdst = obuf + ((size_t)b * SEQ + 31 * 64) * D + 512 + hh * 128 + 8 * fv;
            GS_FINISH(0, GS_OB + GS_OBT, fdst); GS_FINISH(1, GS_OB + GS_OBT, fdst);
        }
#undef GS_FINISH
        __syncthreads();
    }
}

__device__ __forceinline__ unsigned sortable(float f) { const unsigned u = __float_as_uint(f); return u ^ ((unsigned)((int)u >> 31) | 0x80000000u); }
__device__ __forceinline__ float unsortable(unsigned s) { return __uint_as_float((s & 0x80000000u) ? (s ^ 0x80000000u) : ~s); }
#define CE(a, b) do { const unsigned _x = k[a], _y = k[b]; k[a] = _x > _y ? _x : _y; k[b] = _x > _y ? _y : _x; } while (0)
constexpr int PE_TK = 0, PE_TAB = 8192, PE_ID = 8448, PE_GT = PE_ID + 32768, PE_SK = PE_GT + 32768;
__device__ void phase_peer(const Params& p, int L, LAS unsigned char* lds, int bid, int nblk) {
    const int tid = tidx(), lane = tid & 63, w = __builtin_amdgcn_readfirstlane(tid >> 6), fr = lane & 15, fq = lane >> 4;
    const bf16* Q2 = (const bf16*)(p.ws + WS_Q2);
    const bf16* SK = (const bf16*)(p.ws + WS_SK) + (size_t)L * 8 * 2 * 128 * 128;
    const bf16* HB1 = (const bf16*)(p.ws + WS_HB1); bf16* HB2 = (bf16*)(p.ws + WS_HB2);
    const unsigned char* U = p.ws + WS_U + (size_t)L * NEXP * D;
    const unsigned char* V = p.ws + WS_V + (size_t)L * NEXP * D;
    const float* SU = (const float*)(p.ws + WS_SU) + (size_t)L * NEXP; const float* SV = (const float*)(p.ws + WS_SV) + (size_t)L * NEXP;
    const float* g = p.ln_ffn_g + L * D;
    LAS unsigned* TK = (LAS unsigned*)(lds + PE_TK);
    LAS unsigned short* TAB = (LAS unsigned short*)(lds + PE_TAB);
    LAS int* IDL = (LAS int*)(lds + PE_ID); LAS float* GTL = (LAS float*)(lds + PE_GT);
    if (tid < 64) {
        int a = 0, base = 0, q = tid; unsigned short v = 0xffff;
        if (q < 50) { for (;;) { const int cnt = 16 / (a + 1); if (q < base + cnt) break; base += cnt; ++a; } v = (unsigned short)((a << 8) | (q - base)); }
        TAB[tid] = v;
    }
    for (int item = bid; item < M / 64; item += nblk) {
        const int tok0 = item * 64;
        int tid_o = tid; asm volatile("" : "+v"(tid_o));
        const int tid = tid_o, lane = tid & 63, fr = lane & 15, fq = lane >> 4;
        __syncthreads();
        const int tg = w & 3, cc = w >> 2;
        int zs = 0; asm volatile("" : "+v"(zs));
        const bf16* SK_ = SK + zs;
#define SK_FETCH(hd) do { _Pragma("unroll") for (int i = 0; i < 8; ++i) { const int pc = tid + 512 * i, nn = (pc >> 4) & 127; \
            __builtin_amdgcn_global_load_lds((const unsigned*)(SK_ + ((size_t)((hd) * 2 + (pc >> 11)) * 128 + nn) * 128 + (((pc & 15) ^ (nn & 15)) * 8)), \
                                             (LAS unsigned*)(lds + PE_SK + (w * 64 + 512 * i) * 16), 16, 0, 0); } } while (0)
        SK_FETCH(0);
        bf16x8 qn[4];
        const bf16* qrow = Q2 + (size_t)(tok0 + 16 * tg + fr) * 2048 + cc * 128 + 8 * fq;
#pragma unroll
        for (int ks = 0; ks < 4; ++ks) qn[ks] = *(const bf16x8*)(qrow + 32 * ks);
        asm volatile("s_waitcnt vmcnt(0)" ::: "memory");
        __syncthreads();
        for (int hh = 0; hh < 8; ++hh) {
            {
                f32x4 acc[8];
#pragma unroll
                for (int nt = 0; nt < 8; ++nt) acc[nt] = (f32x4){0.f, 0.f, 0.f, 0.f};
                bf16x8 qa[4];
#pragma unroll
                for (int ks = 0; ks < 4; ++ks) qa[ks] = qn[ks];
                {
                    const int hn = hh + 1 < 8 ? hh + 1 : hh;
#pragma unroll
                    for (int ks = 0; ks < 4; ++ks) qn[ks] = *(const bf16x8*)(qrow + hn * 256 + 32 * ks);
                }
                const LAS unsigned char* skb = lds + PE_SK + cc * 32768 + fr * 256;
#pragma unroll
                for (int nt = 0; nt < 8; ++nt)
#pragma unroll
                    for (int ks = 0; ks < 4; ++ks) {
                        const bf16x8 kb = *(const LAS bf16x8*)(skb + nt * 4096 + (((4 * ks + fq) ^ fr) << 4));
                        acc[nt] = __builtin_amdgcn_mfma_f32_16x16x32_bf16(qa[ks], kb, acc[nt], 0, 0, 0);
                    }
#pragma unroll
                for (int r = 0; r < 4; ++r) {
                    unsigned k[8];
#pragma unroll
                    for (int nt = 0; nt < 8; ++nt) k[nt] = (sortable(acc[nt][r]) & ~0x7Fu) | (unsigned)(127 - (16 * nt + fr));
                    CE(0, 1); CE(2, 3); CE(4, 5); CE(6, 7); CE(0, 2); CE(1, 3); CE(4, 6); CE(5, 7); CE(1, 2); CE(5, 6); CE(0, 4); CE(3, 7);
                    CE(1, 5); CE(2, 6); CE(1, 4); CE(3, 6); CE(2, 4); CE(3, 5); CE(3, 4);
                    unsigned res = 0u;
#pragma unroll
                    for (int rd = 0; rd < 16; ++rd) {
                        const unsigned m = row16_umax(k[0]);
                        const bool win = k[0] == m;
#pragma unroll
                        for (int i = 0; i < 7; ++i) k[i] = win ? k[i + 1] : k[i];
                        k[7] = win ? 0u : k[7];
                        res = (fr == rd) ? m : res;
                    }
                    TK[(cc * 64 + 16 * tg + 4 * fq + r) * 16 + fr] = res;
                }
            }
            __syncthreads();
            if (hh + 1 < 8) SK_FETCH(hh + 1);
#pragma unroll
            for (int ps = 0; ps < 2; ++ps) {
                const int tl = 8 * w + 4 * ps + fq;
                unsigned k[4];
#pragma unroll
                for (int sl = 0; sl < 4; ++sl) {
                    const int q = sl * 16 + fr;
                    const unsigned ab = TAB[q];
                    const unsigned k1 = TK[tl * 16 + ((ab >> 8) & 15)], k2 = TK[(64 + tl) * 16 + (ab & 15)];
                    const float v = unsortable(k1 & ~0x7Fu) + unsortable(k2 & ~0x7Fu);
                    k[sl] = (q < 50) ? ((sortable(v) & ~0x3Fu) | (unsigned)(63 - q)) : 0u;
                }
                CE(0, 1); CE(2, 3); CE(0, 2); CE(1, 3); CE(1, 2);
                unsigned res = 0u;
#pragma unroll
                for (int rd = 0; rd < 16; ++rd) {
                    const unsigned m = row16_umax(k[0]);
                    const bool win = k[0] == m;
                    k[0] = win ? k[1] : k[0]; k[1] = win ? k[2] : k[1]; k[2] = win ? k[3] : k[2]; k[3] = win ? 0u : k[3];
                    res = (fr == rd) ? m : res;
                }
                const unsigned ab = TAB[63 - (res & 0x3Fu)];
                const unsigned k1 = TK[tl * 16 + ((ab >> 8) & 15)], k2 = TK[(64 + tl) * 16 + (ab & 15)];
                const float v = unsortable(k1 & ~0x7Fu) + unsortable(k2 & ~0x7Fu);
                const float e = __expf(v - row16_max(v));
                const float sum = row16_sum(e);
                IDL[tl * 128 + hh * 16 + fr] = (int)((127u - (k1 & 0x7Fu)) * 128u + (127u - (k2 & 0x7Fu)));
                GTL[tl * 128 + hh * 16 + fr] = e * __builtin_amdgcn_rcpf(sum);
            }
            asm volatile("s_waitcnt vmcnt(0)" ::: "memory");
            __syncthreads();
        }
#undef SK_FETCH
        for (int ti = 0; ti < 8; ++ti) {
            const int tl = 8 * w + ti;
            unsigned k0 = ((unsigned)IDL[tl * 128 + lane] << 7) | (unsigned)lane, k1 = ((unsigned)IDL[tl * 128 + 64 + lane] << 7) | (unsigned)(64 + lane);
#pragma unroll
            for (int kk = 2; kk <= 128; kk <<= 1) {
#pragma unroll
                for (int j = kk >> 1; j >= 1; j >>= 1) {
                    if (j == 64) { const unsigned lo = k0 < k1 ? k0 : k1, hi = k0 < k1 ? k1 : k0; k0 = lo; k1 = hi; }
                    else {
                        const unsigned p0 = (unsigned)__shfl_xor((int)k0, j), p1 = (unsigned)__shfl_xor((int)k1, j);
                        const bool up0 = ((lane & kk) == 0) || kk == 128, up1 = (((lane + 64) & kk) == 0);
                        const bool low = (lane & j) == 0;
                        k0 = (low == up0) ? (k0 < p0 ? k0 : p0) : (k0 > p0 ? k0 : p0);
                        k1 = (low == (kk == 128 ? true : up1)) ? (k1 < p1 ? k1 : p1) : (k1 > p1 ? k1 : p1);
                    }
                }
            }
            const float g0 = GTL[tl * 128 + (k0 & 127u)], g1 = GTL[tl * 128 + (k1 & 127u)];
            asm volatile("s_waitcnt lgkmcnt(0)" ::: "memory");
            IDL[tl * 128 + lane] = (int)(k0 >> 7); IDL[tl * 128 + 64 + lane] = (int)(k1 >> 7);
            GTL[tl * 128 + lane] = g0; GTL[tl * 128 + 64 + lane] = g1;
        }
        __syncthreads();
        {
            int zo = 0; asm volatile("" : "+v"(zo));
            size_t zu = 0; asm volatile("" : "+s"(zu));
            const float* g_ = g + zo; const unsigned char* U_ = U + zu; const bf16* H_ = HB1 + zo;
            int xq[8][4]; float sx[8];
#pragma unroll
            for (int t = 0; t < 8; ++t) {
                const bf16* hrow = H_ + (size_t)(tok0 + 8 * w + t) * D + 4 * lane;
                float xn[16];
#pragma unroll
                for (int j = 0; j < 4; ++j) { const u32x2 a = *(const u32x2*)(hrow + 256 * j); xn[4 * j] = lo16(a.x); xn[4 * j + 1] = hi16(a.x); xn[4 * j + 2] = lo16(a.y); xn[4 * j + 3] = hi16(a.y); }
                float ss = 0.f;
#pragma unroll
                for (int i = 0; i < 16; ++i) ss += xn[i] * xn[i];
                const float rstd = rsqrtf(wave_sum(ss) * (1.f / D) + EPS);
                float mx = 0.f;
#pragma unroll
                for (int i = 0; i < 16; ++i) { xn[i] = xn[i] * rstd * g_[256 * (i >> 2) + 4 * lane + (i & 3)]; mx = fmaxf(mx, fabsf(xn[i])); }
                mx = xrow16_max(row16_max(mx));
                const float xinv = mx > 0.f ? 127.f / mx : 0.f; sx[t] = mx * (1.f / 127.f);
#pragma unroll
                for (int j = 0; j < 4; ++j) xq[t][j] = (int)(((unsigned)__float2int_rn(xn[4 * j] * xinv) & 0xffu) | (((unsigned)__float2int_rn(xn[4 * j + 1] * xinv) & 0xffu) << 8) |
                                                             (((unsigned)__float2int_rn(xn[4 * j + 2] * xinv) & 0xffu) << 16) | ((unsigned)__float2int_rn(xn[4 * j + 3] * xinv) << 24));
                if (t & 1) { asm volatile("" ::: "memory"); __builtin_amdgcn_sched_barrier(0); }
            }
            LAS int* hil = (LAS int*)(lds + PE_SK) + (8 * w + ((lane >> 2) & 7)) * 128 + (lane >> 5);
            const LAS int* idw = IDL + 8 * w * 128;
            u32x4 ring[16];
#pragma unroll
            for (int j = 0; j < 16; ++j) ring[j] = *(const u32x4*)(U_ + (((unsigned)idw[(j & 7) * 128 + (j >> 3)] << 10) + 16u * (unsigned)lane));
#pragma unroll 1
            for (int k = 0; k < 64; ++k) {
                int d[16];
#pragma unroll
                for (int j = 0; j < 16; ++j) {
                    const int t = j & 7, pos = 2 * k + (j >> 3);
                    const u32x4 a = ring[j];
                    const int d0 = __builtin_amdgcn_sdot4((int)a[1], xq[t][1], __builtin_amdgcn_sdot4((int)a[0], xq[t][0], 0, false), false);
                    d[j] = __builtin_amdgcn_sdot4((int)a[3], xq[t][3], __builtin_amdgcn_sdot4((int)a[2], xq[t][2], d0, false), false);
                    __builtin_amdgcn_sched_barrier(0);
                    ring[j] = *(const u32x4*)(U_ + (((unsigned)idw[t * 128 + (k < 63 ? pos + 2 : pos)] << 10) + 16u * (unsigned)lane));
                    __builtin_amdgcn_sched_barrier(0);
                }
                int e[8], f[4], g[2];
#pragma unroll
                for (int i = 0; i < 8; ++i) { auto s = __builtin_amdgcn_permlane32_swap((unsigned)d[i], (unsigned)d[i + 8], false, false); e[i] = (int)(s[0] + s[1]); }
#pragma unroll
                for (int i = 0; i < 4; ++i) { auto s = __builtin_amdgcn_permlane16_swap((unsigned)e[i], (unsigned)e[i + 4], false, false); f[i] = (int)(s[0] + s[1]); }
#pragma unroll
                for (int i = 0; i < 2; ++i) { const int t_ = f[i] + __builtin_amdgcn_mov_dpp(f[i], 0x128, 0xf, 0xf, true), u_ = f[i + 2] + __builtin_amdgcn_mov_dpp(f[i + 2], 0x128, 0xf, 0xf, true);
                    g[i] = (lane & 8) ? u_ : t_; }
                int hsum;
                { const int t_ = g[0] + __builtin_amdgcn_mov_dpp(g[0], 0x141, 0xf, 0xf, true), u_ = g[1] + __builtin_amdgcn_mov_dpp(g[1], 0x141, 0xf, 0xf, true);
                  hsum = (lane & 4) ? u_ : t_; }
                hsum += __builtin_amdgcn_mov_dpp(hsum, 0xB1, 0xf, 0xf, true);
                hsum += __builtin_amdgcn_mov_dpp(hsum, 0x4E, 0xf, 0xf, true);
                if ((lane & 3) == 0) hil[2 * k] = hsum;
            }
#pragma unroll
            for (int t = 0; t < 8; ++t) {
                const int tl = 8 * w + t;
                const int id0 = IDL[tl * 128 + lane], id1 = IDL[tl * 128 + 64 + lane];
                const float su0 = SU[id0], su1 = SU[id1], sv0 = SV[id0], sv1 = SV[id1];
                const LAS int* hl = (const LAS int*)(lds + PE_SK) + tl * 128;
                const float h0 = su0 * sx[t] * (float)hl[lane], h1 = su1 * sx[t] * (float)hl[64 + lane];
                GTL[tl * 128 + lane] = sv0 * GTL[tl * 128 + lane] * gelu_erf(h0);
                GTL[tl * 128 + 64 + lane] = sv1 * GTL[tl * 128 + 64 + lane] * gelu_erf(h1);

            }
        }
        {
            int zo = 0; asm volatile("" : "+v"(zo));
            size_t zu = 0; asm volatile("" : "+s"(zu));
            const unsigned char* V_ = V + zu; const bf16* H_ = HB1 + zo; bf16* HB2_ = HB2 + zo;
            int wq[8]; float sw[8];
#pragma unroll
            for (int t = 0; t < 8; ++t) {
                const int tl = 8 * w + t;
                const float w0 = GTL[tl * 128 + lane], w1 = GTL[tl * 128 + 64 + lane];
                const float wmx = xrow16_max(row16_max(fmaxf(fabsf(w0), fabsf(w1))));
                const float winv = wmx > 0.f ? 127.f / wmx : 0.f; sw[t] = wmx * (1.f / 127.f);
                const f32x4 wv = *(const LAS f32x4*)(GTL + tl * 128 + 4 * (lane & 31));
                wq[t] = (int)(((unsigned)__float2int_rn(wv[0] * winv) & 0xffu) | (((unsigned)__float2int_rn(wv[1] * winv) & 0xffu) << 8) |
                              (((unsigned)__float2int_rn(wv[2] * winv) & 0xffu) << 16) | ((unsigned)__float2int_rn(wv[3] * winv) << 24));

            }
            const LAS int* idw = IDL + 8 * w * 128;
#pragma unroll
            for (int hf = 0; hf < 2; ++hf) {
                int yi[4][16];
#pragma unroll
                for (int g4 = 0; g4 < 4; ++g4)
#pragma unroll
                    for (int i = 0; i < 16; ++i) yi[g4][i] = 0;
                u32x4 ring[16];
#pragma unroll
                for (int j = 0; j < 16; ++j) ring[j] = *(const u32x4*)(V_ + (((unsigned)idw[(4 * hf + (j >> 2)) * 128 + (j & 3)] << 10) + 16u * (unsigned)lane));
#pragma unroll 1
                for (int s4 = 0; s4 < 32; ++s4) {
#pragma unroll
                    for (int g4 = 0; g4 < 4; ++g4) {
                        const int t = 4 * hf + g4;
                        const int wg = __builtin_amdgcn_readlane(wq[t], s4);
#pragma unroll
                        for (int q = 0; q < 4; ++q) {
                            const unsigned a0 = ring[4 * g4][q], a1 = ring[4 * g4 + 1][q], a2 = ring[4 * g4 + 2][q], a3 = ring[4 * g4 + 3][q];
                            const unsigned p0 = __builtin_amdgcn_perm(a1, a0, 0x05010400u), p1 = __builtin_amdgcn_perm(a1, a0, 0x07030602u);
                            const unsigned p2 = __builtin_amdgcn_perm(a3, a2, 0x05010400u), p3 = __builtin_amdgcn_perm(a3, a2, 0x07030602u);
                            yi[g4][4 * q] = __builtin_amdgcn_sdot4((int)__builtin_amdgcn_perm(p2, p0, 0x05040100u), wg, yi[g4][4 * q], false);
                            yi[g4][4 * q + 1] = __builtin_amdgcn_sdot4((int)__builtin_amdgcn_perm(p2, p0, 0x07060302u), wg, yi[g4][4 * q + 1], false);
                            yi[g4][4 * q + 2] = __builtin_amdgcn_sdot4((int)__builtin_amdgcn_perm(p3, p1, 0x05040100u), wg, yi[g4][4 * q + 2], false);
                            yi[g4][4 * q + 3] = __builtin_amdgcn_sdot4((int)__builtin_amdgcn_perm(p3, p1, 0x07060302u), wg, yi[g4][4 * q + 3], false);
                        }
                        __builtin_amdgcn_sched_barrier(0);
                        {
                            const int sn = s4 < 31 ? s4 + 1 : s4;
#pragma unroll
                            for (int q = 0; q < 4; ++q) ring[4 * g4 + q] = *(const u32x4*)(V_ + (((unsigned)idw[t * 128 + 4 * sn + q] << 10) + 16u * (unsigned)lane));
                        }
                        __builtin_amdgcn_sched_barrier(0);
                    }
                }
#pragma unroll
                for (int g4 = 0; g4 < 4; ++g4) {
                    const int t = 4 * hf + g4, tok = tok0 + 8 * w + t;
                    const bf16* hrow = H_ + (size_t)tok * D + 4 * lane;
                    float y[16];
#pragma unroll
                    for (int j = 0; j < 4; ++j) { const u32x2 a = *(const u32x2*)(hrow + 256 * j); y[4 * j] = lo16(a.x); y[4 * j + 1] = hi16(a.x); y[4 * j + 2] = lo16(a.y); y[4 * j + 3] = hi16(a.y); }
#pragma unroll
                    for (int i = 0; i < 16; ++i) y[i] = y[i] + sw[t] * (float)yi[g4][i];
                    bf16* hb = HB2_ + (size_t)tok * D + 4 * lane;
#pragma unroll
                    for (int j = 0; j < 4; ++j) { u32x2 o2; o2.x = pk2(y[4 * j], y[4 * j + 1]); o2.y = pk2(y[4 * j + 2], y[4 * j + 3]); *(u32x2*)(hb + 256 * j) = o2; }

                }
            }
        }
    }
    __syncthreads();
}
#undef CE

__device__ void phase_final(const Params& p, int bid, int nblk) {
    const int tid = tidx(), lane = tid & 63, gw = bid * NWAVES + (tid >> 6), NGW = nblk * NWAVES;
    const bf16* HB0 = (const bf16*)(p.ws + WS_HB0);
    for (int m = gw; m < M; m += NGW) {
        f32x4 v[4]; float ss = 0.f;
#pragma unroll
        for (int j = 0; j < 4; ++j) { const u32x2 a = ((const u32x2*)(HB0 + (size_t)m * D))[lane + 64 * j]; v[j] = (f32x4){lo16(a.x), hi16(a.x), lo16(a.y), hi16(a.y)}; ss += (v[j][0] * v[j][0] + v[j][1] * v[j][1]) + (v[j][2] * v[j][2] + v[j][3] * v[j][3]); }
        const float r = rsqrtf(wave_sum(ss) * (1.f / D) + EPS);
#pragma unroll
        for (int j = 0; j < 4; ++j) { const f32x4 gv = ((const f32x4*)p.final_g)[lane + 64 * j]; ((f32x4*)(p.out + (size_t)m * D))[lane + 64 * j] = v[j] * r * gv; }
    }
}

#define XB_TMO      128
#define XB_XCNT(j)  (256  + 64 * (j))
#define XB_XSUB(j)  (1280 + 64 * (j))
#define XB_XGEN(j)  (2304 + 64 * (j))
#define XB_TOP      3328
#define XB_TOPGEN   3392
#define XCD_BAR_WORDS 3456
#define XB_SPIN_CAP (1u << 22)
__device__ __forceinline__ unsigned xb_ld(unsigned* p)              { return __hip_atomic_load(p, __ATOMIC_RELAXED, __HIP_MEMORY_SCOPE_AGENT); }
__device__ __forceinline__ unsigned xb_add(unsigned* p, unsigned v) { return __hip_atomic_fetch_add(p, v, __ATOMIC_RELAXED, __HIP_MEMORY_SCOPE_AGENT); }
__device__ __forceinline__ unsigned xb_xcc_id() { return (unsigned)__builtin_amdgcn_s_getreg((3 << 11) | 20) & 0xFu; }
#define XB_SPIN(cond, bar) do { unsigned _sp = 0; while (cond) { __builtin_amdgcn_s_sleep(1); \
    if ((++_sp & 255u) == 0u) { if (xb_ld(&(bar)[XB_TMO])) break; if (_sp > XB_SPIN_CAP) { atomicAdd(&(bar)[XB_TMO], 1u); break; } } } } while (0)
struct XcdBarrier { unsigned* bar; unsigned x; volatile LAS unsigned* st; };
__device__ __forceinline__ XcdBarrier xcd_barrier_post(unsigned* bar, volatile LAS unsigned* st) {
    XcdBarrier b; b.bar = bar; b.x = xb_xcc_id(); b.st = st;
    if (threadIdx.x == 0) (void)xb_add(&bar[XB_XCNT(b.x)], 1u);
    return b;
}
__device__ __forceinline__ void xcd_barrier_complete(unsigned* bar, unsigned x, unsigned& nloc, unsigned& nx) {
    const unsigned G = gridDim.x * gridDim.y * gridDim.z;
    unsigned sum, cnt, mine, sp = 0u;
    for (;;) {
        sum = 0u; cnt = 0u; mine = 0u;
#pragma unroll
        for (unsigned j = 0; j < 16; ++j) { const unsigned c = xb_ld(&bar[XB_XCNT(j)]); sum += c; cnt += (c > 0u) ? 1u : 0u; mine = (j == x) ? c : mine; }
        if (sum == G) break;
        __builtin_amdgcn_s_sleep(1);
        if ((++sp & 255u) == 0u) { if (xb_ld(&bar[XB_TMO])) break; if (sp > XB_SPIN_CAP) { atomicAdd(&bar[XB_TMO], 1u); break; } }
    }
    nloc = mine > 0u ? mine : 1u; nx = cnt > 0u ? cnt : 1u;
}
__device__ __forceinline__ void xcd_barrier(const XcdBarrier& b) {
    asm volatile("s_waitcnt vmcnt(0)" ::: "memory");
    __syncthreads();
    if (threadIdx.x == 0) {
        unsigned* bar = b.bar;
        __builtin_amdgcn_s_waitcnt(0);
        unsigned nloc = b.st[0], nx = b.st[1];
        if (nloc == 0u) { xcd_barrier_complete(bar, b.x, nloc, nx); b.st[0] = nloc; b.st[1] = nx; }
        const unsigned old = xb_add(&bar[XB_XSUB(b.x)], 1u);
        const unsigned gen = old / nloc;
        if (old + 1u == (gen + 1u) * nloc) {
            __builtin_amdgcn_fence(__ATOMIC_RELEASE, "agent");
            asm volatile("s_waitcnt vmcnt(0)" ::: "memory");
            const unsigned og = xb_add(&bar[XB_TOP], 1u);
            const unsigned tg = og / nx;
            if (og + 1u == (tg + 1u) * nx) xb_add(&bar[XB_TOPGEN], 1u);
            else XB_SPIN(xb_ld(&bar[XB_TOPGEN]) == tg, bar);
            __builtin_amdgcn_fence(__ATOMIC_ACQUIRE, "agent");
            xb_add(&bar[XB_XGEN(b.x)], 1u);
            asm volatile("s_waitcnt vmcnt(0)" ::: "memory");
        } else {
            XB_SPIN(xb_ld(&bar[XB_XGEN(b.x)]) == gen, bar);
            __builtin_amdgcn_fence(__ATOMIC_ACQUIRE, "agent");
            asm volatile("s_waitcnt vmcnt(0)" ::: "memory");
        }
    }
    __syncthreads();
}
constexpr int CW_BAR = 4096;

constexpr int K_PROLOGUE = 11, K_FINAL = 12;
template <int KIND>
__device__ __forceinline__ void run_kind(const Params& p, int L, LAS unsigned char* lds, int bid, int nblk) {
    unsigned char* ws = p.ws;
    float* H = (float*)(ws + WS_H);
    float* ss0 = (float*)(ws + WS_STAT); float* ss1 = (float*)(ws + WS_SS1); float* sse = (float*)(ws + WS_SSE);
    if constexpr (KIND == K_PROLOGUE) phase_prologue(p, lds, bid, nblk);
    if constexpr (KIND == K_FINAL) phase_final(p, bid, nblk);
    if constexpr (KIND == 0) { EpiProj E{nullptr, (bf16*)(ws + WS_PROJ), (float*)(ws + WS_BA)};
        gemm_run(lds, (const bf16*)(ws + WS_HB0), (const bf16*)(ws + WS_WIN) + (size_t)L * IN_PAD * D, M, IN_PAD, D, E, bid, nblk, ss0); }
    if constexpr (KIND == 1) phase_gdn_prep(p, L, lds, bid, nblk);
    if constexpr (KIND == 2) { phase_gdn_scan(p, L, lds, bid, nblk); phase_att_queue(p, L, lds, bid, nblk); }
    if constexpr (KIND == 3) { EpiRes E{ss1, (bf16*)(ws + WS_HB1), (const bf16*)(ws + WS_HB0)};
        gemm_run(lds, (const bf16*)(ws + WS_OBUF), (const bf16*)(ws + WS_WOUT) + (size_t)L * D * D, M, D, D, E, bid, nblk); }
    if constexpr (KIND == 4) { EpiQ2 E{nullptr, (bf16*)(ws + WS_Q2)};
        gemm_run(lds, (const bf16*)(ws + WS_HB1), (const bf16*)(ws + WS_WQ) + (size_t)L * 2048 * D, M, 2048, D, E, bid, nblk, ss1); }
    if constexpr (KIND == 5) phase_peer(p, L, lds, bid, nblk);
    if constexpr (KIND == 7) { EpiE E2{sse, (bf16*)(ws + WS_EPRE)};
        gemm_run(lds, (const bf16*)(ws + WS_PB) + (size_t)L * M * 256, (const bf16*)(ws + WS_WP) + (size_t)L * D * 256, M, D, 256, E2, bid, nblk); }
    if constexpr (KIND == 6) { EpiPle E{ss0, (const bf16*)(ws + WS_HB2), (bf16*)(ws + WS_HB0), (const bf16*)(ws + WS_EPRE), p.ple_norm_g + L * D};
        gemm_run(lds, (const bf16*)(ws + WS_HB2), (const bf16*)(ws + WS_WG) + (size_t)L * D * D, M, D, D, E, bid, nblk, sse); }
}

__device__ __forceinline__ Params params_off(const Params& s, size_t z) {
    Params q;
    q.x = s.x + z; q.p = s.p + z; q.ln_mix_g = s.ln_mix_g + z; q.w_in = s.w_in + z; q.conv_w = s.conv_w + z; q.a_log = s.a_log + z; q.dt_bias = s.dt_bias + z;
    q.gdn_norm_g = s.gdn_norm_g + z; q.diff_lambda = s.diff_lambda + z; q.subln_g = s.subln_g + z; q.w_out = s.w_out + z; q.ln_ffn_g = s.ln_ffn_g + z;
    q.peer_wq = s.peer_wq + z; q.subkeys = s.subkeys + z; q.peer_u = s.peer_u + z; q.peer_v = s.peer_v + z; q.ple_wp = s.ple_wp + z; q.ple_wg = s.ple_wg + z;
    q.ple_norm_g = s.ple_norm_g + z; q.final_g = s.final_g + z; q.out = s.out + z; q.ws = s.ws + z; q.pad0 = 0; q.pad1 = 0;
    return q;
}
#define RUN(KIND) do { size_t z_ = 0; int L_ = L; asm volatile("" : "+s"(z_), "+s"(L_)); const Params q_ = params_off(p, z_); run_kind<KIND>(q_, L_, (LAS unsigned char*)lds, (int)blockIdx.x, (int)gridDim.x); } while (0)
#define GRID_BARRIER() do { XcdBarrier b_; b_.bar = (unsigned*)(p.ws + WS_CTL) + CW_BAR; b_.x = xb_xcc_id(); b_.st = (volatile LAS unsigned*)((LAS unsigned char*)lds + LDS_MISC_OFF) + 8; xcd_barrier(b_); } while (0)
__global__ void __launch_bounds__(NTHREADS, 2) mk_fwd(Params p) {
    extern __shared__ __attribute__((aligned(16))) unsigned char lds[];
    {
        volatile LAS unsigned* misc = (volatile LAS unsigned*)((LAS unsigned char*)lds + LDS_MISC_OFF);
        if (threadIdx.x < 64) misc[threadIdx.x] = 0u;
        __syncthreads();
        (void)xcd_barrier_post((unsigned*)(p.ws + WS_CTL) + CW_BAR, misc + 8);
    }
    { int L = 0; RUN(K_PROLOGUE); }
    cg::this_grid().sync();
#define LAYER(LL) do { const int L = (LL); RUN(0); GRID_BARRIER(); RUN(1); GRID_BARRIER(); RUN(2); GRID_BARRIER(); RUN(3); GRID_BARRIER(); RUN(4); GRID_BARRIER(); RUN(5); RUN(7); GRID_BARRIER(); RUN(6); GRID_BARRIER(); } while (0)
    LAYER(0); LAYER(1); LAYER(2); LAYER(3);
#undef LAYER
    { int L = 0; RUN(K_FINAL); }
}

extern "C" void kernel_launch(void* const* d_in, const int* in_sizes, int n_in, void* d_out, int out_size, void* d_ws, size_t ws_size, hipStream_t stream) {
    static int grid = 0;
    if (grid == 0) {
        if (n_in != 20 || out_size != M * D || ws_size < WS_END) { fprintf(stderr, "kernel_launch: unexpected shapes (n_in %d, out %d, ws %zu < %zu)\n", n_in, out_size, ws_size, (size_t)WS_END); grid = -1; return; }
        int dev = 0, cus = 0, per_cu = 0;
        (void)hipGetDevice(&dev); (void)hipDeviceGetAttribute(&cus, hipDeviceAttributeMultiprocessorCount, dev);
        if (hipFuncSetAttribute((const void*)mk_fwd, hipFuncAttributeMaxDynamicSharedMemorySize, LDS_BYTES) != hipSuccess) { fprintf(stderr, "kernel_launch: hipFuncSetAttribute failed\n"); grid = -1; return; }
        if (hipOccupancyMaxActiveBlocksPerMultiprocessor(&per_cu, (const void*)mk_fwd, NTHREADS, LDS_BYTES) != hipSuccess || per_cu < 1) { fprintf(stderr, "kernel_launch: occupancy query says %d blocks per CU\n", per_cu); (void)hipGetLastError(); grid = -1; return; }
        grid = (cus > 0 ? cus : 256);
    }
    if (grid < 0) return;
    (void)hipMemsetAsync((char*)d_ws + WS_CTL, 0, CTL_ZERO_BYTES, stream);
    Params p{};
    const float** pp = (const float**)&p;
    for (int i = 0; i < 20; ++i) pp[i] = (const float*)d_in[i];
    p.out = (float*)d_out; p.ws = (unsigned char*)d_ws;
    void* args[] = {&p};
    hipError_t e = hipLaunchCooperativeKernel((const void*)mk_fwd, dim3(grid), dim3(NTHREADS), args, LDS_BYTES, stream);
    if (e != hipSuccess) fprintf(stderr, "kernel_launch: cooperative launch failed: %s (grid %d)\n", hipGetErrorString(e), grid);
}
```
